# Optimizing an MI355X kernel written in HIP

```python
import math
import jax, jax.numpy as jnp
from jax import lax
import numpy as np

D_MODEL = 1024
BATCH = 8
SEQ = 2048
DEPTH = 1

MEM_LEN = 256
ROPE_THETA = 500000.0
EPS = 1e-6
NEG = -1e30
Q_BLOCK = 128
N_BRANCH = 3
BRANCH_WIDTH = 512
A_HEADS = 8
A_HEAD_DIM = 64
A_ROT = A_HEAD_DIM // 4
IDX_HEADS = 8
IDX_DIM = 64
IDX_ROT = IDX_DIM // 4
TOPK_MAX = 256
B_HEADS = 8
B_NOPE = 64
B_ROPE = 32
B_VDIM = 64
B_QK = B_NOPE + B_ROPE
B_Q_RANK = 384
B_KV_RANK = 256
M_HEADS = 4
M_HEAD_DIM = 128

SPLITS = (
    A_HEADS * A_HEAD_DIM,
    A_HEADS * A_HEAD_DIM,
    A_HEADS * A_HEAD_DIM,
    IDX_HEADS * IDX_DIM,
    IDX_DIM,
    IDX_HEADS,
    BRANCH_WIDTH,
    B_Q_RANK,
    B_KV_RANK,
    B_ROPE,
    BRANCH_WIDTH,
    M_HEADS * M_HEAD_DIM,
    BRANCH_WIDTH,
    N_BRANCH * D_MODEL,
)
D_IN = (4 * A_HEADS * A_HEAD_DIM + IDX_DIM + IDX_HEADS + BRANCH_WIDTH
        + B_Q_RANK + B_KV_RANK + B_ROPE + BRANCH_WIDTH
        + M_HEADS * M_HEAD_DIM + BRANCH_WIDTH + N_BRANCH * D_MODEL)

kernel_name = "hybrid_dsa_mla_memory_gated_block"


def rms_norm(x, g):
    xf = x.astype(jnp.float32)
    y = xf * lax.rsqrt(jnp.mean(xf * xf, axis=-1, keepdims=True) + EPS)
    return (y * g.astype(jnp.float32)).astype(x.dtype)


def rope_tables(positions, rot_dim):
    inv_freq = ROPE_THETA ** (-(jnp.arange(0, rot_dim, 2, dtype=jnp.float32) / rot_dim))
    ang = positions.astype(jnp.float32)[..., None] * inv_freq
    return jnp.cos(ang), jnp.sin(ang)


def rotate(x, cos, sin):
    half = x.shape[-1] // 2
    x1 = x[..., :half].astype(jnp.float32)
    x2 = x[..., half:].astype(jnp.float32)
    return jnp.concatenate([x1 * cos - x2 * sin, x2 * cos + x1 * sin], axis=-1).astype(x.dtype)


def partial_rope(x, cos, sin):
    rd = 2 * cos.shape[-1]
    return jnp.concatenate([rotate(x[..., :rd], cos, sin), x[..., rd:]], axis=-1)


def to_blocks(t, nb):
    b = t.shape[0]
    return jnp.moveaxis(t.reshape((b, nb, Q_BLOCK) + t.shape[2:]), 1, 0)


def from_blocks(t):
    t = jnp.moveaxis(t, 0, 1)
    return t.reshape((t.shape[0], t.shape[1] * t.shape[2]) + t.shape[3:])


def dsa_attention(q, k, v, qi, ki, wi):
    b, s, h, d = q.shape
    nb = s // Q_BLOCK
    topk = min(TOPK_MAX, s // 4)
    key_pos = jnp.arange(s)
    ki_f = ki.astype(jnp.float32)
    scale = d ** -0.5

    def one_block(args):
        qb, qib, wib, start = args
        q_pos = start + jnp.arange(Q_BLOCK)
        causal = key_pos[None, :] <= q_pos[:, None]
        dots = jnp.einsum('bqhc,bsc->bhqs', qib.astype(jnp.float32), ki_f) * (IDX_DIM ** -0.5)
        index = jnp.einsum('bhqs,bqh->bqs', jax.nn.relu(dots),
                           wib.astype(jnp.float32) * (IDX_HEADS ** -0.5))
        index = jnp.where(causal[None], index, NEG)
        _, idx = lax.top_k(index, topk)
        valid = idx <= q_pos[None, :, None]
        k_sel = jax.vmap(lambda kb, ib: kb[ib])(k, idx)
        v_sel = jax.vmap(lambda vb, ib: vb[ib])(v, idx)
        sc = jnp.einsum('bqhd,bqkhd->bhqk', qb, k_sel).astype(jnp.float32) * scale
        sc = jnp.where(valid[:, None], sc, NEG)
        p = jax.nn.softmax(sc, axis=-1).astype(v.dtype)
        return jnp.einsum('bhqk,bqkhd->bqhd', p, v_sel)

    starts = jnp.arange(nb) * Q_BLOCK
    out = lax.map(one_block, (to_blocks(q, nb), to_blocks(qi, nb), to_blocks(wi, nb), starts))
    return from_blocks(out)


def causal_attention(q, k, v):
    b, s, h, dq = q.shape
    nb = s // Q_BLOCK
    key_pos = jnp.arange(s)
    scale = dq ** -0.5

    def one_block(args):
        qb, start = args
        q_pos = start + jnp.arange(Q_BLOCK)
        sc = jnp.einsum('bqhd,bkhd->bhqk', qb, k).astype(jnp.float32) * scale
        sc = jnp.where((key_pos[None, :] <= q_pos[:, None])[None, None], sc, NEG)
        p = jax.nn.softmax(sc, axis=-1).astype(v.dtype)
        return jnp.einsum('bhqk,bkhd->bqhd', p, v)

    starts = jnp.arange(nb) * Q_BLOCK
    return from_blocks(lax.map(one_block, (to_blocks(q, nb), starts)))


def setup_inputs(seed: int = 0) -> dict:
    key = jax.random.key(seed)
    ks = jax.random.split(key, 24)
    f32 = jnp.float32

    def w(k, shape, fan_in):
        return jax.random.normal(k, shape, f32) * (fan_in ** -0.5)

    def gain(k, shape):
        return 1.0 + 0.02 * jax.random.normal(k, shape, f32)

    x = jax.random.normal(ks[0], (BATCH, SEQ, D_MODEL), f32)
    mem = jax.random.normal(ks[1], (BATCH, MEM_LEN, D_MODEL), f32)
    offsets = jax.random.randint(ks[2], (BATCH, 1), 0, 4096, dtype=jnp.int32)
    positions = offsets + jnp.arange(SEQ, dtype=jnp.int32)[None, :]
    return {
        "x": x,
        "mem": mem,
        "positions": positions,
        "g_norm": gain(ks[3], (DEPTH, D_MODEL)),
        "w_in": w(ks[4], (DEPTH, D_MODEL, D_IN), D_MODEL),
        "g_qn_a": gain(ks[5], (DEPTH, A_HEAD_DIM)),
        "g_kn_a": gain(ks[6], (DEPTH, A_HEAD_DIM)),
        "g_cq": gain(ks[7], (DEPTH, B_Q_RANK)),
        "g_ckv": gain(ks[8], (DEPTH, B_KV_RANK)),
        "w_uq": w(ks[9], (DEPTH, B_Q_RANK, B_HEADS * B_QK), B_Q_RANK),
        "w_ukv": w(ks[10], (DEPTH, B_KV_RANK, B_HEADS * (B_NOPE + B_VDIM)), B_KV_RANK),
        "g_qn_b": gain(ks[11], (DEPTH, B_QK)),
        "g_kn_b": gain(ks[12], (DEPTH, B_QK)),
        "g_mem": gain(ks[13], (DEPTH, D_MODEL)),
        "w_mem_kv": w(ks[14], (DEPTH, D_MODEL, 2 * M_HEADS * M_HEAD_DIM), D_MODEL),
        "g_qn_m": gain(ks[15], (DEPTH, M_HEAD_DIM)),
        "g_kn_m": gain(ks[16], (DEPTH, M_HEAD_DIM)),
        "w_branch": w(ks[17], (DEPTH, N_BRANCH, BRANCH_WIDTH, D_MODEL), BRANCH_WIDTH),
        "w_out": w(ks[18], (DEPTH, D_MODEL, D_MODEL), D_MODEL),
    }


def reference(x, mem, positions, g_norm, w_in, g_qn_a, g_kn_a, g_cq, g_ckv, w_uq, w_ukv,
              g_qn_b, g_kn_b, g_mem, w_mem_kv, g_qn_m, g_kn_m, w_branch, w_out):
    b, s, _ = x.shape
    m_len = mem.shape[1]
    cos_a, sin_a = rope_tables(positions, A_ROT)
    cos_b, sin_b = rope_tables(positions, B_ROPE)
    split_at = [int(o) for o in np.cumsum(SPLITS)[:-1]]

    for layer in range(DEPTH):
        h = rms_norm(x, g_norm[layer])
        proj = h @ w_in[layer]
        (q_a, k_a, v_a, q_i, k_i, w_i, z_a, c_q, c_kv, k_rope, z_b, q_m, z_m,
         gate_logits) = jnp.split(proj, split_at, axis=-1)

        q_a = partial_rope(rms_norm(q_a.reshape(b, s, A_HEADS, A_HEAD_DIM), g_qn_a[layer]),
                           cos_a[:, :, None], sin_a[:, :, None])
        k_a = partial_rope(rms_norm(k_a.reshape(b, s, A_HEADS, A_HEAD_DIM), g_kn_a[layer]),
                           cos_a[:, :, None], sin_a[:, :, None])
        v_a = v_a.reshape(b, s, A_HEADS, A_HEAD_DIM)
        q_i = partial_rope(q_i.reshape(b, s, IDX_HEADS, IDX_DIM), cos_a[:, :, None], sin_a[:, :, None])
        k_i = partial_rope(k_i, cos_a, sin_a)
        o_a = dsa_attention(q_a, k_a, v_a, q_i, k_i, w_i)

        q_b = (rms_norm(c_q, g_cq[layer]) @ w_uq[layer]).reshape(b, s, B_HEADS, B_QK)
        kv_b = (rms_norm(c_kv, g_ckv[layer]) @ w_ukv[layer]).reshape(b, s, B_HEADS, B_NOPE + B_VDIM)
        k_nope, v_b = kv_b[..., :B_NOPE], kv_b[..., B_NOPE:]
        k_b = jnp.concatenate(
            [k_nope, jnp.broadcast_to(k_rope[:, :, None, :], (b, s, B_HEADS, B_ROPE))], axis=-1)
        q_b = rms_norm(q_b, g_qn_b[layer])
        k_b = rms_norm(k_b, g_kn_b[layer])
        q_b = jnp.concatenate(
            [q_b[..., :B_NOPE], rotate(q_b[..., B_NOPE:], cos_b[:, :, None], sin_b[:, :, None])], axis=-1)
        k_b = jnp.concatenate(
            [k_b[..., :B_NOPE], rotate(k_b[..., B_NOPE:], cos_b[:, :, None], sin_b[:, :, None])], axis=-1)
        o_b = causal_attention(q_b, k_b, v_b)

        kv_m = (rms_norm(mem, g_mem[layer]) @ w_mem_kv[layer]).reshape(b, m_len, 2, M_HEADS, M_HEAD_DIM)
        k_m = rms_norm(kv_m[:, :, 0], g_kn_m[layer])
        v_m = kv_m[:, :, 1]
        q_m = rms_norm(q_m.reshape(b, s, M_HEADS, M_HEAD_DIM), g_qn_m[layer])
        sc_m = jnp.einsum('bqhd,bmhd->bhqm', q_m, k_m).astype(jnp.float32) * (M_HEAD_DIM ** -0.5)
        p_m = jax.nn.softmax(sc_m, axis=-1).astype(v_m.dtype)
        o_m = jnp.einsum('bhqm,bmhd->bqhd', p_m, v_m)

        ys = jnp.stack([
            o_a.reshape(b, s, BRANCH_WIDTH) * jax.nn.silu(z_a),
            o_b.reshape(b, s, BRANCH_WIDTH) * jax.nn.silu(z_b),
            o_m.reshape(b, s, BRANCH_WIDTH) * jax.nn.silu(z_m),
        ], axis=0)
        branch = jnp.einsum('nbsw,nwd->nbsd', ys, w_branch[layer])
        gates = jax.nn.sigmoid(
            gate_logits.reshape(b, s, N_BRANCH, D_MODEL).astype(jnp.float32)).astype(x.dtype)
        merged = jnp.einsum('bsnd,nbsd->bsd', gates, branch)
        x = x + merged @ w_out[layer]
    return x
```

```cpp
#include <hip/hip_runtime.h>
#include <hip/hip_cooperative_groups.h>
#include <cstdio>
#include <cstdint>
namespace cg = cooperative_groups;
namespace pg8 {
#define PG8_LAS __attribute__((address_space(3)))
typedef unsigned short bf16_t;
typedef short bf16x8 __attribute__((ext_vector_type(8)));
typedef float f32x4 __attribute__((ext_vector_type(4)));
typedef unsigned u32x4 __attribute__((ext_vector_type(4)));
constexpr int BM = 256, BK = 64, HALF = 128, HTB = HALF * BK * 2  , STAGE_BYTES = 8 * HTB, NXCD = 8, WGM = 8;

__host__ __device__ __forceinline__ int lds_byte(int r, int c) { const int st = (r >> 4) * 2 + (c >> 5), rr = r & 15, cc = c & 31, ob = rr * 64 + cc * 2; return st * 1024 + (ob ^ (((ob >> 9) & 1) << 5)); }
__host__ __device__ __forceinline__ void stage_rc(int b, int& R, int& C) { const int st = b / 1024, sb = b % 1024, swz = sb ^ (((sb >> 9) & 1) << 5); R = (st >> 1) * 16 + swz / 64; C = (st & 1) * 32 + (swz % 64) / 2; }
__host__ __device__ __forceinline__ int perm32(int rho) { const int n = rho >> 4, i = rho & 15; return 8 * (i >> 2) + 4 * n + (i & 3); }

struct Unit { int pm, pn; };
struct Gemm { const bf16_t* A; const bf16_t* Bt; int M, N, K, lda; };

struct StaticOrder {
    int nM, nN, nwg, G, c;
    __host__ __device__ void init(int M, int N, int G_, int c_) { nM = M / BM; nN = N / BM; nwg = nM * nN; G = G_; c = c_; }
    __host__ __device__ bool next(int i, Unit& u) const {
        const long L = (long)i * G + c; if (L >= nwg) return false;
        int wgid = (int)L; { const int q = nwg / NXCD, r = nwg % NXCD, xcd = wgid % NXCD, off = wgid / NXCD; wgid = (xcd < r ? xcd * (q + 1) : r * (q + 1) + (xcd - r) * q) + off; }
        const int nig = WGM * nN, gid = wgid / nig, fm = gid * WGM, gsz = (nM - fm) < WGM ? (nM - fm) : WGM;
        u.pm = fm + ((wgid % nig) % gsz); u.pn = (wgid % nig) / gsz; return true;
    }
    __device__ __forceinline__ void a_ready(const Unit&) const {}
    __device__ __forceinline__ void done(const Unit&) const {}
};

__device__ __forceinline__ unsigned cvt_pk_bf16(float lo, float hi) { unsigned r; asm volatile("v_cvt_pk_bf16_f32 %0, %1, %2" : "=v"(r) : "v"(lo), "v"(hi)); return r; }
typedef float f32x2 __attribute__((ext_vector_type(2)));
__device__ __forceinline__ f32x2 gelu_pk(f32x2 v) {
    const f32x2 av = __builtin_elementwise_abs(v), d = av * 0.2316418882f + 1.0f;
    f32x2 t; t.x = __builtin_amdgcn_rcpf(d.x); t.y = __builtin_amdgcn_rcpf(d.y);
    f32x2 q = t * 0.5307027145f + (-0.7265760135f); q = q * t + 0.7107068705f; q = q * t + (-0.142248368f); q = q * t + 0.127414796f; q = q * t;
    const f32x2 s = (v * v) * (-0.72134752044f);
    f32x2 e; e.x = __builtin_amdgcn_exp2f(s.x); e.y = __builtin_amdgcn_exp2f(s.y);
    const f32x2 m = v * (q * e), r = v - m;
    f32x2 o; o.x = v.x < 0.f ? m.x : r.x; o.y = v.y < 0.f ? m.y : r.y; return o;
}

template <int ACT  > struct EpiBf16 {
    static constexpr bool PERM = true, AFTER_DRAIN = false; static_assert(ACT == 0 || ACT == 1, "EpiBf16: ACT is 0 (none) or 1 (gelu_pk)");
    bf16_t* O; int ldc; const float* bias; int split_cols; size_t split_stride; float scale0;
    __device__ __forceinline__ void operator()(const f32x4 (&acc)[2][2][4][2], const Unit& u, int wr, int wc, int fr, int fq) const {
        const int row0 = u.pm * BM + wr * 64 + fr; int colt = u.pn * BM; bf16_t* base = O;
        float sc = 1.f; if (split_cols) { const int t = colt / split_cols; base += (size_t)t * split_stride; colt -= t * split_cols; if (t == 0) sc = scale0; }
        const int col0 = colt + wc * 32 + 8 * fq, bcol0 = u.pn * BM + wc * 32 + 8 * fq;
        f32x4 bv[2][2];
#pragma unroll
        for (int bj = 0; bj < 2; ++bj)
#pragma unroll
            for (int n = 0; n < 2; ++n) bv[bj][n] = bias ? *(const f32x4*)(bias + bcol0 + bj * HALF + 4 * n) : (f32x4){0.f, 0.f, 0.f, 0.f};
#pragma unroll
        for (int ai = 0; ai < 2; ++ai)
#pragma unroll
            for (int m = 0; m < 4; ++m) { bf16_t* rowp = base + (size_t)(row0 + ai * HALF + m * 16) * ldc + col0;
#pragma unroll
                for (int bj = 0; bj < 2; ++bj) { f32x4 v0 = acc[ai][bj][m][0] + bv[bj][0], v1 = acc[ai][bj][m][1] + bv[bj][1];
                    if (ACT == 1) { f32x2 a = gelu_pk((f32x2){v0[0], v0[1]}), b = gelu_pk((f32x2){v0[2], v0[3]}), c = gelu_pk((f32x2){v1[0], v1[1]}), d = gelu_pk((f32x2){v1[2], v1[3]});
                        v0 = (f32x4){a.x, a.y, b.x, b.y}; v1 = (f32x4){c.x, c.y, d.x, d.y}; }
                    v0 = v0 * sc; v1 = v1 * sc; u32x4 w; w.x = cvt_pk_bf16(v0[0], v0[1]); w.y = cvt_pk_bf16(v0[2], v0[3]); w.z = cvt_pk_bf16(v1[0], v1[1]); w.w = cvt_pk_bf16(v1[2], v1[3]);
                    *(u32x4*)(rowp + bj * HALF) = w; } }
    }
};
template <class Epi, class Sched, bool ALIGN_EPI = false, bool SP2 = false>
__device__ __forceinline__ void gemm_phase(PG8_LAS unsigned char* lds, const Gemm g, const Sched& S, const Epi& E) {
    int tid_ = threadIdx.x; asm volatile("" : "+v"(tid_));
    const int tid = tid_, wid = __builtin_amdgcn_readfirstlane(tid >> 6), lane = tid & 63, wr = wid >> 2, wc = wid & 3, fr = lane & 15, fq = lane >> 4;
    const int K = g.K, nt = K / BK;
    unsigned voffA[2], voffB[2];
#pragma unroll
    for (int i = 0; i < 2; ++i) { int R, C; stage_rc(tid * 16 + i * 8192, R, C); const int Rb = Epi::PERM ? ((R & ~31) + perm32(R & 31)) : R;
        voffA[i] = (unsigned)(R * g.lda + C) * 2u; voffB[i] = (unsigned)(Rb * K + C) * 2u; }
    const size_t kstep = (size_t)(BK * 2);
    const size_t hstepA = (size_t)HALF * g.lda * 2, hstepB = (size_t)HALF * K * 2;
    const size_t tstepA = 2 * hstepA, tstepB = 2 * hstepB;
    const unsigned ldsw = (unsigned)wid * 1024u;
    const int aoff = lds_byte(wr * 64 + fr, fq * 8), boff = lds_byte(wc * 32 + fr, fq * 8);
#define PG8_SA(b, h) (((b) * 2 + (h)) * HTB)
#define PG8_SB(b, h) ((4 + (b) * 2 + (h)) * HTB)
#define PG8_STAGE(bufoff, gbase, voff) do { _Pragma("unroll") for (int _i = 0; _i < 2; ++_i) \
        __builtin_amdgcn_global_load_lds((const unsigned*)((const char*)(gbase) + (voff)[_i]), (PG8_LAS unsigned*)(lds + (bufoff) + ldsw + _i * 8192), 16, 0, 0); } while (0)
#define PG8_LDA(dst, b, h) do { _Pragma("unroll") for (int m = 0; m < 4; ++m) _Pragma("unroll") for (int k = 0; k < 2; ++k) dst[m][k] = *(const PG8_LAS bf16x8*)(lds + PG8_SA(b, h) + aoff + m * 2048 + k * 1024); } while (0)
#define PG8_LDB(dst, b, h) do { _Pragma("unroll") for (int n = 0; n < 2; ++n) _Pragma("unroll") for (int k = 0; k < 2; ++k) dst[n][k] = *(const PG8_LAS bf16x8*)(lds + PG8_SB(b, h) + boff + n * 2048 + k * 1024); } while (0)
#define PG8_MMA(ai, bj, At, Bt) do { __builtin_amdgcn_s_setprio(1); _Pragma("unroll") for (int m = 0; m < 4; ++m) _Pragma("unroll") for (int n = 0; n < 2; ++n) _Pragma("unroll") for (int k = 0; k < 2; ++k) \
        acc[ai][bj][m][n] = __builtin_amdgcn_mfma_f32_16x16x32_bf16(Bt[n][k], At[m][k], acc[ai][bj][m][n], 0, 0, 0); __builtin_amdgcn_s_setprio(0); } while (0)
#define PG8_WAIT_V(n) asm volatile("s_waitcnt vmcnt(" #n ")" ::: "memory")
#define PG8_WAIT_L(n) asm volatile("s_waitcnt lgkmcnt(" #n ")" ::: "memory")
#define PG8_BAR __builtin_amdgcn_s_barrier()
#define PG8_SCHED __builtin_amdgcn_sched_barrier(0)
    Unit cur, nxt; int ui = 0;
    if (!S.next(0, cur)) return;
    f32x4 acc[2][2][4][2];
#pragma unroll
    for (int a = 0; a < 2; ++a)
#pragma unroll
        for (int b = 0; b < 2; ++b)
#pragma unroll
            for (int m = 0; m < 4; ++m)
#pragma unroll
                for (int n = 0; n < 2; ++n) acc[a][b][m][n] = (f32x4){0.f, 0.f, 0.f, 0.f};
    bf16x8 At[4][2], B0[2][2], B1[2][2];
    const char* cA = (const char*)g.A + (size_t)cur.pm * tstepA; const char* cB = (const char*)g.Bt + (size_t)cur.pn * tstepB;
    S.a_ready(cur);
    if constexpr (SP2) {
        PG8_STAGE(PG8_SB(0, 0), cB, voffB); PG8_STAGE(PG8_SB(0, 1), cB + hstepB, voffB); PG8_STAGE(PG8_SA(0, 0), cA, voffA); PG8_STAGE(PG8_SA(0, 1), cA + hstepA, voffA);
        if (wr == 1) PG8_BAR;
        PG8_WAIT_V(2); PG8_BAR;
        PG8_STAGE(PG8_SB(1, 0), cB + kstep, voffB); PG8_STAGE(PG8_SA(1, 0), cA + kstep, voffA); PG8_STAGE(PG8_SB(1, 1), cB + hstepB + kstep, voffB);
        PG8_WAIT_V(6); PG8_BAR;
    } else {
        PG8_STAGE(PG8_SB(0, 0), cB, voffB); PG8_STAGE(PG8_SA(0, 0), cA, voffA); PG8_STAGE(PG8_SB(0, 1), cB + hstepB, voffB); PG8_STAGE(PG8_SA(0, 1), cA + hstepA, voffA);
        if (wr == 1) PG8_BAR;
        PG8_WAIT_V(4); PG8_BAR;
        PG8_STAGE(PG8_SB(1, 0), cB + kstep, voffB); PG8_STAGE(PG8_SA(1, 0), cA + kstep, voffA); PG8_STAGE(PG8_SB(1, 1), cB + hstepB + kstep, voffB);
        PG8_WAIT_V(6); PG8_BAR;
    }
    for (;;) {
        const bool has_next = S.next(ui + 1, nxt);
        const char* nA = has_next ? (const char*)g.A + (size_t)nxt.pm * tstepA : cA; const char* nB = has_next ? (const char*)g.Bt + (size_t)nxt.pn * tstepB : cB;
        for (int t = 0; t < nt; t += 2) {
            const bool last = (t == nt - 2);
            const char* a1 = cA + (size_t)(t + 1) * kstep;
            const char* a2 = last ? nA : cA + (size_t)(t + 2) * kstep; const char* b2 = last ? nB : cB + (size_t)(t + 2) * kstep;
            const char* a3 = a2 + kstep; const char* b3 = b2 + kstep;
            if (last && has_next) S.a_ready(nxt);
            if constexpr (SP2) {
            PG8_LDB(B0, 0, 0); PG8_LDB(B1, 0, 1); PG8_SCHED; PG8_LDA(At, 0, 0); PG8_STAGE(PG8_SA(1, 1), a1 + hstepA, voffA);
            PG8_WAIT_V(8); PG8_WAIT_L(0); PG8_BAR; PG8_MMA(0, 0, At, B0); PG8_MMA(0, 1, At, B1); PG8_BAR; PG8_SCHED;
            PG8_LDA(At, 0, 1); PG8_STAGE(PG8_SB(0, 0), b2, voffB); PG8_STAGE(PG8_SB(0, 1), b2 + hstepB, voffB); PG8_STAGE(PG8_SA(0, 0), a2, voffA);
            PG8_WAIT_V(8); PG8_WAIT_L(0); PG8_BAR; PG8_MMA(1, 0, At, B0); PG8_MMA(1, 1, At, B1); PG8_BAR; PG8_SCHED;
            PG8_LDB(B0, 1, 0); PG8_LDB(B1, 1, 1); PG8_SCHED; PG8_LDA(At, 1, 0); PG8_STAGE(PG8_SA(0, 1), a2 + hstepA, voffA);
            PG8_WAIT_V(8); PG8_WAIT_L(0); PG8_BAR; PG8_MMA(0, 0, At, B0); PG8_MMA(0, 1, At, B1); PG8_BAR; PG8_SCHED;
            PG8_LDA(At, 1, 1); PG8_STAGE(PG8_SB(1, 0), b3, voffB); PG8_STAGE(PG8_SB(1, 1), b3 + hstepB, voffB); PG8_STAGE(PG8_SA(1, 0), a3, voffA);
            PG8_WAIT_V(8); PG8_WAIT_L(0); PG8_BAR; PG8_MMA(1, 0, At, B0); PG8_MMA(1, 1, At, B1); PG8_BAR; PG8_SCHED;
            } else {
            PG8_LDB(B0, 0, 0); PG8_SCHED; PG8_LDA(At, 0, 0); PG8_STAGE(PG8_SA(1, 1), a1 + hstepA, voffA);
            PG8_WAIT_L(8); PG8_BAR; PG8_WAIT_L(0); PG8_MMA(0, 0, At, B0); PG8_BAR; PG8_SCHED;
            PG8_LDB(B1, 0, 1); PG8_STAGE(PG8_SB(0, 0), b2, voffB);
            PG8_BAR; PG8_WAIT_L(0); PG8_MMA(0, 1, At, B1); PG8_BAR;
            PG8_LDA(At, 0, 1); PG8_STAGE(PG8_SA(0, 0), a2, voffA);
            PG8_BAR; PG8_WAIT_L(0); PG8_MMA(1, 0, At, B0); PG8_BAR; PG8_SCHED;
            PG8_STAGE(PG8_SB(0, 1), b2 + hstepB, voffB);
            PG8_WAIT_V(6); PG8_BAR; PG8_MMA(1, 1, At, B1); PG8_BAR;
            PG8_LDB(B0, 1, 0); PG8_SCHED; PG8_LDA(At, 1, 0); PG8_STAGE(PG8_SA(0, 1), a2 + hstepA, voffA);
            PG8_WAIT_L(8); PG8_BAR; PG8_WAIT_L(0); PG8_MMA(0, 0, At, B0); PG8_BAR; PG8_SCHED;
            PG8_LDB(B1, 1, 1); PG8_STAGE(PG8_SB(1, 0), b3, voffB);
            PG8_BAR; PG8_WAIT_L(0); PG8_MMA(0, 1, At, B1); PG8_BAR;
            PG8_LDA(At, 1, 1); PG8_STAGE(PG8_SA(1, 0), a3, voffA);
            PG8_BAR; PG8_WAIT_L(0); PG8_MMA(1, 0, At, B0); PG8_BAR; PG8_SCHED;
            PG8_STAGE(PG8_SB(1, 1), b3 + hstepB, voffB);
            PG8_WAIT_V(6); PG8_BAR; PG8_MMA(1, 1, At, B1); PG8_BAR;
            }
        }
        if constexpr (ALIGN_EPI) { if (wr == 0) PG8_BAR; }
        if constexpr (!Epi::AFTER_DRAIN) { E(acc, cur, wr, wc, fr, fq); S.done(cur); }
        if (!has_next) break;
#pragma unroll
        for (int a = 0; a < 2; ++a)
#pragma unroll
            for (int b = 0; b < 2; ++b)
#pragma unroll
                for (int m = 0; m < 4; ++m)
#pragma unroll
                    for (int n = 0; n < 2; ++n) acc[a][b][m][n] = (f32x4){0.f, 0.f, 0.f, 0.f};
        cur = nxt; cA = nA; cB = nB; ++ui;
        if constexpr (ALIGN_EPI) { if (wr == 1) PG8_BAR; }
    }
    PG8_WAIT_V(0);
    if constexpr (!ALIGN_EPI) { if (wr == 0) PG8_BAR; }
    PG8_BAR;
    if constexpr (Epi::AFTER_DRAIN) { E.fused(acc, cur, wr, wc, fr, fq, lds, wid, lane); S.done(cur); }
#undef PG8_SA
#undef PG8_SB
#undef PG8_STAGE
#undef PG8_LDA
#undef PG8_LDB
#undef PG8_MMA
#undef PG8_WAIT_V
#undef PG8_WAIT_L
#undef PG8_BAR
#undef PG8_SCHED
}
}

#define LAS __attribute__((address_space(3)))
typedef unsigned short bf16;
typedef unsigned v4u __attribute__((ext_vector_type(4)));
typedef unsigned v2u __attribute__((ext_vector_type(2)));
typedef float f32x4 __attribute__((ext_vector_type(4)));
typedef float f32x16 __attribute__((ext_vector_type(16)));
typedef short bf16x8 __attribute__((ext_vector_type(8)));
typedef short s16x4 __attribute__((ext_vector_type(4)));
typedef float f32x2_t __attribute__((ext_vector_type(2)));
typedef __bf16 bf16x2_t __attribute__((ext_vector_type(2)));

constexpr int NB = 8, SEQ = 2048, DM = 1024, TT = NB * SEQ;
constexpr int HB = 4, TH = HB * SEQ;
constexpr int DIN = 7912, NP = 7936;
constexpr int MEML = 256;
constexpr float EPS = 1e-6f, NEGF = -1e30f;
constexpr int C_QA = 0, C_KA = 512, C_VA = 1024, C_QI = 1536, C_KI = 2048, C_WI = 2112, C_ZA = 2120, C_CQ = 2632, C_CKV = 3016, C_KR = 3272,
              C_ZB = 3304, C_QM = 3816, C_ZM = 4328, C_GL = 4840;
constexpr float SCALE_A = 0.18033688011112042f;
constexpr float SCALE_B = 0.14724444602590306f;
constexpr float SCALE_M = 0.12751743082459868f;
constexpr float SCALE_I = 0.04419417382415922f;

__constant__ float INVA[8] = {1.0f, 0.1939227432012558f, 0.03760603070259094f, 0.007292664609849453f, 0.0014142135623842478f, 0.00027424818836152554f, 5.3182957344688475e-05f, 1.0313385246263351e-05f};
__constant__ float INVB[16] = {1.0f, 0.44036659598350525f, 0.1939227432012558f, 0.08539710193872452f, 0.03760603070259094f, 0.016560440883040428f, 0.007292664609849453f, 0.0032114461064338684f, 0.0014142135623842478f, 0.0006227724370546639f, 0.00027424818836152554f, 0.00012076973507646471f, 5.3182957344688475e-05f, 2.34199997066753e-05f, 1.0313385246263351e-05f, 4.541670477919979e-06f};

constexpr size_t MiB = 1u << 20;
constexpr size_t WS_CTL = 0;
constexpr size_t WS_WIN = 1 * MiB;
constexpr size_t WS_WUQ = 17 * MiB;
constexpr size_t WS_WUKV = 18 * MiB;
constexpr size_t WS_WMEM = 19 * MiB;
constexpr size_t WS_WBR = 21 * MiB;
constexpr size_t WS_WOUT = 24 * MiB;
constexpr size_t WS_ROPEA = 26 * MiB;
constexpr size_t WS_ROPEB = 27 * MiB;
constexpr size_t WS_MN = 29 * MiB;
constexpr size_t WS_KVM = 33 * MiB;
constexpr size_t WS_VTM = 37 * MiB;
constexpr size_t WS_WI = 39 * MiB;
constexpr size_t WS_MASK = 40 * MiB;
constexpr size_t WS_VTA = 42 * MiB;
constexpr size_t WS_VTB = 50 * MiB;
constexpr size_t WS_H = 58 * MiB;
constexpr size_t WS_QB = 74 * MiB;
constexpr size_t WS_KVB = 86 * MiB;
constexpr size_t WS_YS = 102 * MiB;
constexpr size_t WS_P = 126 * MiB;
constexpr size_t WS_END = 250 * MiB;

constexpr int LDS_BYTES = 147456;
constexpr int LDS_SLOT = LDS_BYTES - 64;

__device__ __forceinline__ unsigned pk2(float lo, float hi) { f32x2_t v = {lo, hi}; bf16x2_t b = __builtin_convertvector(v, bf16x2_t); return __builtin_bit_cast(unsigned, b); }
__device__ __forceinline__ float bflo(unsigned w) { return __uint_as_float(w << 16); }
__device__ __forceinline__ float bfhi(unsigned w) { return __uint_as_float(w & 0xffff0000u); }
__device__ __forceinline__ float bf1(bf16 b) { return __uint_as_float(((unsigned)b) << 16); }
#define UNPACK8(W_, V_) do { V_[0] = bflo((W_)[0]); V_[1] = bfhi((W_)[0]); V_[2] = bflo((W_)[1]); V_[3] = bfhi((W_)[1]); V_[4] = bflo((W_)[2]); V_[5] = bfhi((W_)[2]); V_[6] = bflo((W_)[3]); V_[7] = bfhi((W_)[3]); } while (0)
#define PACK8(V_) (v4u){pk2(V_[0], V_[1]), pk2(V_[2], V_[3]), pk2(V_[4], V_[5]), pk2(V_[6], V_[7])}
__device__ __forceinline__ float wave_sum(float v) {
#pragma unroll
    for (int o = 1; o < 64; o <<= 1) v += __shfl_xor(v, o);
    return v;
}
#define LDS_WAIT() asm volatile("s_waitcnt lgkmcnt(0)" ::: "memory")

__device__ __forceinline__ void transpose_item(const float* W, int K, int N, int Npad, bf16* WT, LAS float* scr, int item, int lane) {
    const int nblk = Npad / 32, kb = item / nblk, nb = item % nblk, k0 = 64 * kb, n0 = 32 * nb;
    const int nn = n0 + (lane & 31); const bool ok = nn < N;
#pragma unroll 8
    for (int i = 0; i < 32; ++i) { const int kk = 2 * i + (lane >> 5); scr[kk * 33 + (lane & 31)] = ok ? W[(size_t)(k0 + kk) * N + nn] : 0.f; }
    LDS_WAIT(); asm volatile("" ::: "memory");
    const int c = lane & 7;
#pragma unroll
    for (int j = 0; j < 4; ++j) { const int n = (lane >> 3) + 8 * j; const LAS float* s = scr + (8 * c) * 33 + n;
        v4u o; o.x = pk2(s[0 * 33], s[1 * 33]); o.y = pk2(s[2 * 33], s[3 * 33]); o.z = pk2(s[4 * 33], s[5 * 33]); o.w = pk2(s[6 * 33], s[7 * 33]);
        *(v4u*)(WT + (size_t)(n0 + n) * K + k0 + 8 * c) = o; }
    LDS_WAIT(); asm volatile("" ::: "memory");
}
__device__ __forceinline__ void rms_row_1024(const float* xrow, const float* g, bf16* orow, int lane) {
    const f32x4* xr = (const f32x4*)xrow + lane; const f32x4* gr = (const f32x4*)g + lane;
    f32x4 v[4]; float s = 0.f;
#pragma unroll
    for (int j = 0; j < 4; ++j) { v[j] = xr[64 * j]; s += (v[j].x * v[j].x + v[j].y * v[j].y) + (v[j].z * v[j].z + v[j].w * v[j].w); }
    const float rstd = 1.0f / sqrtf(wave_sum(s) * (1.f / 1024.f) + EPS);
    v2u* o8 = (v2u*)orow + lane;
#pragma unroll
    for (int j = 0; j < 4; ++j) { const f32x4 gg = gr[64 * j]; v2u w; w.x = pk2(v[j].x * rstd * gg.x, v[j].y * rstd * gg.y); w.y = pk2(v[j].z * rstd * gg.z, v[j].w * rstd * gg.w); o8[64 * j] = w; }
}

#define ROPE8(v, sub, c8, s8) do { _Pragma("unroll") for (int j_ = 0; j_ < 8; ++j_) { const float pv_ = __shfl_xor(v[j_], 1); \
        const float r0_ = v[j_] * c8[j_] - pv_ * s8[j_], r1_ = v[j_] * c8[j_] + pv_ * s8[j_]; v[j_] = (sub) == 0 ? r0_ : ((sub) == 1 ? r1_ : v[j_]); } } while (0)

__device__ __forceinline__ void post1_row(bf16* Prow, const float* ra, const float* gqa, const float* gka, const float* gcq, const float* gckv, const float* gqm, float* WIrow, int lane) {
    const int sub = lane & 7;
    float c8[8], s8[8];
#pragma unroll
    for (int j = 0; j < 8; ++j) { c8[j] = ra[j]; s8[j] = ra[8 + j]; }
    { v4u w = *(const v4u*)(Prow + C_QA + 8 * lane); float v[8]; UNPACK8(w, v); float ss = 0.f;
#pragma unroll
      for (int j = 0; j < 8; ++j) ss += v[j] * v[j];
      ss += __shfl_xor(ss, 1); ss += __shfl_xor(ss, 2); ss += __shfl_xor(ss, 4);
      const float rstd = 1.0f / sqrtf(ss * (1.f / 64.f) + EPS);
#pragma unroll
      for (int j = 0; j < 8; ++j) v[j] = v[j] * rstd * gqa[8 * sub + j];
      ROPE8(v, sub, c8, s8);
#pragma unroll
      for (int j = 0; j < 8; ++j) v[j] *= SCALE_A;
      *(v4u*)(Prow + C_QA + 8 * lane) = PACK8(v); }
    { v4u w = *(const v4u*)(Prow + C_KA + 8 * lane); float v[8]; UNPACK8(w, v); float ss = 0.f;
#pragma unroll
      for (int j = 0; j < 8; ++j) ss += v[j] * v[j];
      ss += __shfl_xor(ss, 1); ss += __shfl_xor(ss, 2); ss += __shfl_xor(ss, 4);
      const float rstd = 1.0f / sqrtf(ss * (1.f / 64.f) + EPS);
#pragma unroll
      for (int j = 0; j < 8; ++j) v[j] = v[j] * rstd * gka[8 * sub + j];
      ROPE8(v, sub, c8, s8);
      *(v4u*)(Prow + C_KA + 8 * lane) = PACK8(v); }
    { v4u w = *(const v4u*)(Prow + C_QI + 8 * lane); float v[8]; UNPACK8(w, v);
      ROPE8(v, sub, c8, s8);
      *(v4u*)(Prow + C_QI + 8 * lane) = PACK8(v); }
    { v4u w = (v4u){0u, 0u, 0u, 0u}; if (lane < 8) w = *(const v4u*)(Prow + C_KI + 8 * lane); float v[8]; UNPACK8(w, v);
      ROPE8(v, sub, c8, s8);
      if (lane < 8) *(v4u*)(Prow + C_KI + 8 * lane) = PACK8(v); }
    if (lane < 8) WIrow[lane] = bf1(Prow[C_WI + lane]) * SCALE_I;
    { v4u w = (v4u){0u, 0u, 0u, 0u}; if (lane < 48) w = *(const v4u*)(Prow + C_CQ + 8 * lane); float v[8]; UNPACK8(w, v); float ss = 0.f;
#pragma unroll
      for (int j = 0; j < 8; ++j) ss += v[j] * v[j];
      ss = wave_sum(ss); const float rstd = 1.0f / sqrtf(ss * (1.f / 384.f) + EPS);
      if (lane < 48) {
#pragma unroll
          for (int j = 0; j < 8; ++j) v[j] = v[j] * rstd * gcq[8 * lane + j];
          *(v4u*)(Prow + C_CQ + 8 * lane) = PACK8(v); } }
    { v4u w = (v4u){0u, 0u, 0u, 0u}; if (lane < 32) w = *(const v4u*)(Prow + C_CKV + 8 * lane); float v[8]; UNPACK8(w, v); float ss = 0.f;
#pragma unroll
      for (int j = 0; j < 8; ++j) ss += v[j] * v[j];
      ss = wave_sum(ss); const float rstd = 1.0f / sqrtf(ss * (1.f / 256.f) + EPS);
      if (lane < 32) {
#pragma unroll
          for (int j = 0; j < 8; ++j) v[j] = v[j] * rstd * gckv[8 * lane + j];
          *(v4u*)(Prow + C_CKV + 8 * lane) = PACK8(v); } }
    { v4u w = *(const v4u*)(Prow + C_QM + 8 * lane); float v[8]; UNPACK8(w, v); float ss = 0.f;
#pragma unroll
      for (int j = 0; j < 8; ++j) ss += v[j] * v[j];
      ss += __shfl_xor(ss, 1); ss += __shfl_xor(ss, 2); ss += __shfl_xor(ss, 4); ss += __shfl_xor(ss, 8);
      const float rstd = 1.0f / sqrtf(ss * (1.f / 128.f) + EPS);
#pragma unroll
      for (int j = 0; j < 8; ++j) v[j] = v[j] * rstd * gqm[8 * (lane & 15) + j] * SCALE_M;
      *(v4u*)(Prow + C_QM + 8 * lane) = PACK8(v); }
}

__device__ __forceinline__ void km_row(bf16* row, const float* gkm, int lane) {
    v4u w = *(const v4u*)(row + 8 * lane); float v[8]; UNPACK8(w, v); float ss = 0.f;
#pragma unroll
    for (int j = 0; j < 8; ++j) ss += v[j] * v[j];
    ss += __shfl_xor(ss, 1); ss += __shfl_xor(ss, 2); ss += __shfl_xor(ss, 4); ss += __shfl_xor(ss, 8);
    const float rstd = 1.0f / sqrtf(ss * (1.f / 128.f) + EPS);
#pragma unroll
    for (int j = 0; j < 8; ++j) v[j] = v[j] * rstd * gkm[8 * (lane & 15) + j];
    *(v4u*)(row + 8 * lane) = PACK8(v);
}

__device__ __forceinline__ void transpose_v(const bf16* src, int pitch, int col0, int hstride, int H, int DV, int S, int nb, bf16* dst, int gw, int NGW, int lane) {
    const int ndq = DV / 64, nsc = S / 64, ntask = nb * H * nsc * ndq;
    for (int task = gw; task < ntask; task += NGW) {
        int x = task; const int dq = x % ndq; x /= ndq; const int sc = x % nsc; x /= nsc; const int h = x % H; const int b = x / H;
        const int s = sc * 64 + lane;
        const bf16* srow = src + (size_t)(b * S + s) * pitch + col0 + h * hstride + dq * 64;
        bf16* drow = dst + ((size_t)((b * H + h) * DV + dq * 64)) * S + s;
#pragma unroll
        for (int c = 0; c < 8; ++c) { const v4u w = *(const v4u*)(srow + 8 * c);
            drow[(size_t)(8 * c + 0) * S] = (bf16)(w.x & 0xffffu); drow[(size_t)(8 * c + 1) * S] = (bf16)(w.x >> 16);
            drow[(size_t)(8 * c + 2) * S] = (bf16)(w.y & 0xffffu); drow[(size_t)(8 * c + 3) * S] = (bf16)(w.y >> 16);
            drow[(size_t)(8 * c + 4) * S] = (bf16)(w.z & 0xffffu); drow[(size_t)(8 * c + 5) * S] = (bf16)(w.z >> 16);
            drow[(size_t)(8 * c + 6) * S] = (bf16)(w.w & 0xffffu); drow[(size_t)(8 * c + 7) * S] = (bf16)(w.w >> 16); }
    }
}

template <int MODE>
__device__ __forceinline__ void post2_row(bf16* QBrow, const bf16* KVBrow, const bf16* Prow, bf16* KBrow, const float* rb, const float* g, LAS float* scr, int lane) {
    const int hd = lane >> 3, d0 = 12 * (lane & 7);
    float v[12];
    if (MODE == 0) {
        const v2u* p = (const v2u*)(QBrow + 12 * lane);
#pragma unroll
        for (int i = 0; i < 3; ++i) { const v2u w = p[i]; v[4 * i] = bflo(w.x); v[4 * i + 1] = bfhi(w.x); v[4 * i + 2] = bflo(w.y); v[4 * i + 3] = bfhi(w.y); }
    } else {
#pragma unroll
        for (int e = 0; e < 12; ++e) { const int d = d0 + e; v[e] = d < 64 ? bf1(KVBrow[hd * 128 + d]) : bf1(Prow[C_KR + d - 64]); }
    }
    float ss = 0.f;
#pragma unroll
    for (int e = 0; e < 12; ++e) ss += v[e] * v[e];
    ss += __shfl_xor(ss, 1); ss += __shfl_xor(ss, 2); ss += __shfl_xor(ss, 4);
    const float rstd = 1.0f / sqrtf(ss * (1.f / 96.f) + EPS);
#pragma unroll
    for (int e = 0; e < 12; ++e) { v[e] = v[e] * rstd * g[d0 + e]; scr[12 * lane + e] = v[e]; }
    LDS_WAIT(); asm volatile("" ::: "memory");
    float o[12];
#pragma unroll
    for (int e = 0; e < 12; ++e) { const int d = d0 + e;
        if (d < 64) o[e] = v[e];
        else { const int i = (d - 64) & 15; const bool first = d < 80; const float pv = scr[12 * lane + e + (first ? 16 : -16)];
               const float cc = rb[i], sn = rb[16 + i]; o[e] = first ? v[e] * cc - pv * sn : v[e] * cc + pv * sn; }
        if (MODE == 0) o[e] *= SCALE_B; }
    LDS_WAIT(); asm volatile("" ::: "memory");
    v2u* q = (v2u*)((MODE == 0 ? QBrow : KBrow) + 12 * lane);
#pragma unroll
    for (int i = 0; i < 3; ++i) { v2u w; w.x = pk2(o[4 * i], o[4 * i + 1]); w.y = pk2(o[4 * i + 2], o[4 * i + 3]); q[i] = w; }
}

__device__ __forceinline__ int next_unit(unsigned* ctr, volatile LAS int* slot) {
    __syncthreads();
    if (threadIdx.x == 0) *slot = (int)atomicAdd(ctr, 1u);
    __syncthreads();
    return *slot;
}

constexpr int SCP = 2052;
__device__ __forceinline__ unsigned ord_key(float v) { const unsigned b = __float_as_uint(v); return b ^ ((unsigned)((int)b >> 31) | 0x80000000u); }
__device__ __forceinline__ void indexer_unit(LAS float* sc, const bf16* P, const float* WI, unsigned* MASK, int bb, int tb) {
    int tid_ = threadIdx.x; asm volatile("" : "+v"(tid_));
    const int tid = tid_, lane = tid & 63, w = __builtin_amdgcn_readfirstlane(tid >> 6);
    const int n = lane & 15, g = lane >> 4;
    const int rowbase = bb * SEQ, t0 = tb * 16;
    {
        bf16x8 qf[8][2]; float wq[8];
        const bf16* qrow = P + (size_t)(rowbase + t0 + n) * NP + C_QI + 8 * g;
#pragma unroll
        for (int h = 0; h < 8; ++h) {
            qf[h][0] = *(const bf16x8*)(qrow + h * 64);
            qf[h][1] = *(const bf16x8*)(qrow + h * 64 + 32);
            wq[h] = WI[(size_t)(rowbase + t0 + n) * 8 + h];
        }
        const int ntile = tb + 1;
        for (int tile = w; tile < ntile; tile += 8) {
            const bf16* krow = P + (size_t)(rowbase + 16 * tile + n) * NP + C_KI + 8 * g;
            const bf16x8 k0 = *(const bf16x8*)(krow), k1 = *(const bf16x8*)(krow + 32);
            f32x4 idx = (f32x4){0.f, 0.f, 0.f, 0.f};
#pragma unroll
            for (int h = 0; h < 8; ++h) {
                f32x4 a = (f32x4){0.f, 0.f, 0.f, 0.f};
                a = __builtin_amdgcn_mfma_f32_16x16x32_bf16(k0, qf[h][0], a, 0, 0, 0);
                a = __builtin_amdgcn_mfma_f32_16x16x32_bf16(k1, qf[h][1], a, 0, 0, 0);
#pragma unroll
                for (int i = 0; i < 4; ++i) idx[i] = __builtin_fmaf(wq[h], __builtin_fmaxf(a[i], 0.f), idx[i]);
            }
            *(LAS f32x4*)(sc + n * SCP + 16 * tile + 4 * g) = idx;
        }
    }
    __syncthreads();
    for (int qq = 0; qq < 2; ++qq) {
        const int q = 2 * w + qq, t = t0 + q;
        unsigned* mrow = MASK + (size_t)(rowbase + t) * 64;
        if (t < 256) {
            unsigned word;
            if (32 * lane + 31 <= t) word = 0xffffffffu; else if (32 * lane > t) word = 0u; else word = (1u << (t - 32 * lane + 1)) - 1u;
            mrow[lane] = word;
        } else {
            unsigned u[32];
            const LAS float* srow = sc + q * SCP;
#pragma unroll
            for (int r = 0; r < 32; ++r) { const int key = 64 * r + lane; u[r] = 0u; if (64 * r <= t) { const float v = srow[key]; u[r] = key <= t ? ord_key(v) : 0u; } }
            unsigned Pv = 0u; bool exact = false;
#pragma unroll 1
            for (int bit = 31; bit >= 0; --bit) {
                const unsigned cand = Pv | (1u << bit);
                int cnt = 0;
#pragma unroll
                for (int r = 0; r < 32; ++r) cnt += __popcll(__ballot(u[r] >= cand));
                if (cnt >= 256) Pv = cand;
                if (cnt == 256) { exact = true; break; }
            }
            const unsigned Pg = exact ? Pv - 1u : Pv;
            int cgt = 0;
#pragma unroll
            for (int r = 0; r < 32; ++r) cgt += __popcll(__ballot(u[r] > Pg));
            int need = exact ? 0 : 256 - cgt;
            unsigned long long mine = 0ull;
#pragma unroll
            for (int r = 0; r < 32; ++r) {
                unsigned long long sel = __ballot(u[r] > Pg);
                if (need > 0) {
                    unsigned long long eq = __ballot(u[r] == Pv);
                    const int c = __popcll(eq);
                    if (c <= need) { sel |= eq; need -= c; }
                    else { while (need > 0) { const unsigned long long low = eq & (~eq + 1ull); sel |= low; eq ^= low; --need; } }
                }
                if (lane == r) mine = sel;
            }
            if (lane < 32) ((unsigned long long*)mrow)[lane] = mine;
        }
    }
    __syncthreads();
}

__device__ __forceinline__ int crow(int r, int hi) { return (r & 3) + 8 * (r >> 2) + 4 * hi; }
template <int DQK, int DV, int MODE>
__device__ __forceinline__ void attn_unit(LAS unsigned char* lds, const bf16* Qb, int qpitch, const bf16* Kb, int kpitch, const bf16* VTb, int skv,
                                          const unsigned* maskb, const bf16* Zb, bf16* Ob, int q0) {
    constexpr int KP = DQK + 8, VP = 72;
    LAS bf16* Ks = (LAS bf16*)lds; LAS bf16* Vs = Ks + 64 * KP;
    constexpr int CPR = DQK / 8;
    constexpr int NCK = 64 * CPR, NCV = DV * 8;
    constexpr int RK = (NCK + 511) / 512, RV = (NCV + 511) / 512;
    constexpr int NKS = DQK / 16, NMT = DV / 32;
    int tid_ = threadIdx.x; asm volatile("" : "+v"(tid_));
    const int tid = tid_, lane = tid & 63, w = __builtin_amdgcn_readfirstlane(tid >> 6), r = lane & 31, hh = lane >> 5;
    const int NT = MODE == 0 ? skv / 64 : (q0 + 256) / 64;
    const int qlo = q0 + 32 * w;
    bf16x8 qf[NKS];
    { const bf16* qrow = Qb + (size_t)(qlo + r) * qpitch + 8 * hh;
#pragma unroll
      for (int ks = 0; ks < NKS; ++ks) qf[ks] = *(const bf16x8*)(qrow + 16 * ks); }
    f32x16 o[NMT];
#pragma unroll
    for (int mt = 0; mt < NMT; ++mt)
#pragma unroll
        for (int i = 0; i < 16; ++i) o[mt][i] = 0.f;
    float m_run = NEGF, l_run = 0.f;
    v4u kreg[RK], vreg[RV];
#define ATT_PREFETCH(tile_) do { \
        _Pragma("unroll") for (int i_ = 0; i_ < RK; ++i_) { const int c_ = tid + 512 * i_; if (c_ < NCK) { const int row_ = c_ / CPR, cc_ = c_ % CPR; kreg[i_] = *(const v4u*)(Kb + (size_t)(64 * (tile_) + row_) * kpitch + 8 * cc_); } } \
        _Pragma("unroll") for (int i_ = 0; i_ < RV; ++i_) { const int c_ = tid + 512 * i_; if (c_ < NCV) { const int d_ = c_ >> 3, cc_ = c_ & 7; vreg[i_] = *(const v4u*)(VTb + (size_t)d_ * skv + 64 * (tile_) + 8 * cc_); } } } while (0)
    ATT_PREFETCH(0);
    for (int tile = 0; tile < NT; ++tile) {
        __syncthreads();
#pragma unroll
        for (int i = 0; i < RK; ++i) { const int c = tid + 512 * i; if (c < NCK) { const int row = c / CPR, cc = c % CPR; *(LAS v4u*)(Ks + row * KP + 8 * cc) = kreg[i]; } }
#pragma unroll
        for (int i = 0; i < RV; ++i) { const int c = tid + 512 * i; if (c < NCV) { const int d = c >> 3, cc = c & 7; *(LAS v4u*)(Vs + d * VP + 8 * cc) = vreg[i]; } }
        __syncthreads();
        if (tile + 1 < NT) ATT_PREFETCH(tile + 1);
        if (MODE != 0 && 64 * tile > qlo + 31) continue;
        unsigned mw0 = 0u, mw1 = 0u;
        if (MODE == 2) { const v2u mm = *(const v2u*)(maskb + (size_t)(qlo + r) * 64 + 2 * tile); mw0 = mm.x >> (4 * hh); mw1 = mm.y >> (4 * hh); }
        f32x16 s0, s1;
#pragma unroll
        for (int i = 0; i < 16; ++i) { s0[i] = 0.f; s1[i] = 0.f; }
#pragma unroll
        for (int ks = 0; ks < NKS; ++ks) {
            const bf16x8 a0 = *(const LAS bf16x8*)(Ks + r * KP + 16 * ks + 8 * hh);
            const bf16x8 a1 = *(const LAS bf16x8*)(Ks + (32 + r) * KP + 16 * ks + 8 * hh);
            s0 = __builtin_amdgcn_mfma_f32_32x32x16_bf16(a0, qf[ks], s0, 0, 0, 0);
            s1 = __builtin_amdgcn_mfma_f32_32x32x16_bf16(a1, qf[ks], s1, 0, 0, 0);
        }
        if (MODE == 1) {
            if (64 * tile + 63 > qlo) { const int qg = qlo + r;
#pragma unroll
                for (int i = 0; i < 16; ++i) { const int key = 64 * tile + crow(i, hh); if (key > qg) s0[i] = NEGF; if (key + 32 > qg) s1[i] = NEGF; } }
        }
        if (MODE == 2) {
#pragma unroll
            for (int i = 0; i < 16; ++i) { const int bit = (i & 3) + 8 * (i >> 2); if (!((mw0 >> bit) & 1u)) s0[i] = NEGF; if (!((mw1 >> bit) & 1u)) s1[i] = NEGF; }
        }
        float mx = s0[0];
#pragma unroll
        for (int i = 1; i < 16; ++i) mx = __builtin_fmaxf(mx, s0[i]);
#pragma unroll
        for (int i = 0; i < 16; ++i) mx = __builtin_fmaxf(mx, s1[i]);
        mx = __builtin_fmaxf(mx, __shfl_xor(mx, 32));
        const float m_new = __builtin_fmaxf(m_run, mx);
        const float alpha = __builtin_amdgcn_exp2f(m_run - m_new);
        m_run = m_new;
        float ls = 0.f;
#pragma unroll
        for (int i = 0; i < 16; ++i) { s0[i] = __builtin_amdgcn_exp2f(s0[i] - m_new); s1[i] = __builtin_amdgcn_exp2f(s1[i] - m_new); ls += s0[i] + s1[i]; }
        l_run = l_run * alpha + ls;
#pragma unroll
        for (int mt = 0; mt < NMT; ++mt)
#pragma unroll
            for (int i = 0; i < 16; ++i) o[mt][i] *= alpha;
        v4u pf[2][2];
#pragma unroll
        for (int s = 0; s < 2; ++s) {
            pf[0][s] = (v4u){pk2(s0[8 * s], s0[8 * s + 1]), pk2(s0[8 * s + 2], s0[8 * s + 3]), pk2(s0[8 * s + 4], s0[8 * s + 5]), pk2(s0[8 * s + 6], s0[8 * s + 7])};
            pf[1][s] = (v4u){pk2(s1[8 * s], s1[8 * s + 1]), pk2(s1[8 * s + 2], s1[8 * s + 3]), pk2(s1[8 * s + 4], s1[8 * s + 5]), pk2(s1[8 * s + 6], s1[8 * s + 7])};
        }
#pragma unroll
        for (int mt = 0; mt < NMT; ++mt)
#pragma unroll
            for (int p = 0; p < 2; ++p)
#pragma unroll
                for (int s = 0; s < 2; ++s) {
                    const LAS bf16* vp = Vs + (32 * mt + r) * VP + 32 * p + 16 * s + 4 * hh;
                    const s16x4 lo = *(const LAS s16x4*)(vp), hi = *(const LAS s16x4*)(vp + 8);
                    const bf16x8 a = (bf16x8){lo[0], lo[1], lo[2], lo[3], hi[0], hi[1], hi[2], hi[3]};
                    o[mt] = __builtin_amdgcn_mfma_f32_32x32x16_bf16(a, __builtin_bit_cast(bf16x8, pf[p][s]), o[mt], 0, 0, 0);
                }
    }
#undef ATT_PREFETCH
    const float l_tot = l_run + __shfl_xor(l_run, 32);
    const float inv = 1.0f / l_tot;
    const size_t row = (size_t)(qlo + r);
#pragma unroll
    for (int mt = 0; mt < NMT; ++mt)
#pragma unroll
        for (int g4 = 0; g4 < 4; ++g4) {
            const int d = 32 * mt + 8 * g4 + 4 * hh;
            const v2u zw = *(const v2u*)(Zb + row * NP + d);
            float z[4] = {bflo(zw.x), bfhi(zw.x), bflo(zw.y), bfhi(zw.y)}, ov[4];
#pragma unroll
            for (int i = 0; i < 4; ++i) { const float sl = z[i] / (1.0f + __expf(-z[i])); ov[i] = o[mt][4 * g4 + i] * inv * sl; }
            v2u ow; ow.x = pk2(ov[0], ov[1]); ow.y = pk2(ov[2], ov[3]);
            *(v2u*)(Ob + row * 512 + d) = ow;
        }
}

struct EpiMerge {
    static constexpr bool PERM = true, AFTER_DRAIN = false;
    bf16* Mg; const bf16* P; int nbr;
    __device__ __forceinline__ void operator()(const pg8::f32x4 (&acc)[2][2][4][2], const pg8::Unit& u, int wr, int wc, int fr, int fq) const {
        const int row0 = u.pm * 256 + wr * 64 + fr, col0 = u.pn * 256 + wc * 32 + 8 * fq;
#pragma unroll
        for (int ai = 0; ai < 2; ++ai)
#pragma unroll
            for (int m = 0; m < 4; ++m) { const size_t row = (size_t)(row0 + ai * 128 + m * 16);
#pragma unroll
                for (int bj = 0; bj < 2; ++bj) { const int col = col0 + bj * 128;
                    const v4u gwd = *(const v4u*)(P + row * NP + C_GL + nbr * 1024 + col);
                    float gl[8]; UNPACK8(gwd, gl);
                    const pg8::f32x4 v0 = acc[ai][bj][m][0], v1 = acc[ai][bj][m][1];
                    float rr[8] = {v0[0], v0[1], v0[2], v0[3], v1[0], v1[1], v1[2], v1[3]};
#pragma unroll
                    for (int e = 0; e < 8; ++e) rr[e] *= 1.0f / (1.0f + __expf(-gl[e]));
                    bf16* dst = Mg + row * 1024 + col;
                    if (nbr > 0) { const v4u old = *(const v4u*)dst; float ol[8]; UNPACK8(old, ol);
#pragma unroll
                        for (int e = 0; e < 8; ++e) rr[e] += ol[e]; }
                    *(v4u*)dst = PACK8(rr); } }
    }
};
struct EpiOut {
    static constexpr bool PERM = true, AFTER_DRAIN = false;
    const float* X; float* Out;
    __device__ __forceinline__ void operator()(const pg8::f32x4 (&acc)[2][2][4][2], const pg8::Unit& u, int wr, int wc, int fr, int fq) const {
        const int row0 = u.pm * 256 + wr * 64 + fr, col0 = u.pn * 256 + wc * 32 + 8 * fq;
#pragma unroll
        for (int ai = 0; ai < 2; ++ai)
#pragma unroll
            for (int m = 0; m < 4; ++m) { const size_t row = (size_t)(row0 + ai * 128 + m * 16);
#pragma unroll
                for (int bj = 0; bj < 2; ++bj) { const size_t p = row * 1024 + col0 + bj * 128;
                    const f32x4 x0 = *(const f32x4*)(X + p), x1 = *(const f32x4*)(X + p + 4);
                    const pg8::f32x4 a0 = acc[ai][bj][m][0], a1 = acc[ai][bj][m][1];
                    *(f32x4*)(Out + p) = (f32x4){x0[0] + a0[0], x0[1] + a0[1], x0[2] + a0[2], x0[3] + a0[3]};
                    *(f32x4*)(Out + p + 4) = (f32x4){x1[0] + a1[0], x1[1] + a1[1], x1[2] + a1[2], x1[3] + a1[3]}; } }
    }
};

struct Args { const float* in[19]; const int* pos; float* out; unsigned char* ws; };

__global__ void __launch_bounds__(512, 2) fwd_kernel(Args a) {
    extern __shared__ __attribute__((aligned(16))) unsigned char lds_raw[];
    cg::grid_group grid = cg::this_grid();
    LAS unsigned char* lds = (LAS unsigned char*)lds_raw;
    volatile LAS int* slot = (volatile LAS int*)(lds + LDS_SLOT);
    int tid = threadIdx.x; asm volatile("" : "+v"(tid));
    int lane = tid & 63, wave = __builtin_amdgcn_readfirstlane(tid >> 6);
    const int G = gridDim.x, NGW = G * 8; int gw = blockIdx.x * 8 + wave;
    unsigned char* ws = a.ws;
    const float* x = a.in[0]; const float* mem = a.in[1];
    const float* g_norm = a.in[3]; const float* w_in = a.in[4]; const float* g_qn_a = a.in[5]; const float* g_kn_a = a.in[6];
    const float* g_cq = a.in[7]; const float* g_ckv = a.in[8]; const float* w_uq = a.in[9]; const float* w_ukv = a.in[10];
    const float* g_qn_b = a.in[11]; const float* g_kn_b = a.in[12]; const float* g_mem = a.in[13]; const float* w_mem_kv = a.in[14];
    const float* g_qn_m = a.in[15]; const float* g_kn_m = a.in[16]; const float* w_branch = a.in[17]; const float* w_out = a.in[18];
    unsigned* ctl = (unsigned*)(ws + WS_CTL);
    bf16* WinT = (bf16*)(ws + WS_WIN); bf16* WuqT = (bf16*)(ws + WS_WUQ); bf16* WukvT = (bf16*)(ws + WS_WUKV); bf16* WmemT = (bf16*)(ws + WS_WMEM);
    bf16* WbrT = (bf16*)(ws + WS_WBR); bf16* WoutT = (bf16*)(ws + WS_WOUT);
    float* ropeA = (float*)(ws + WS_ROPEA); float* ropeB = (float*)(ws + WS_ROPEB);
    bf16* MN = (bf16*)(ws + WS_MN); bf16* KVM = (bf16*)(ws + WS_KVM); bf16* VTM = (bf16*)(ws + WS_VTM);
    float* WI = (float*)(ws + WS_WI); unsigned* MASK = (unsigned*)(ws + WS_MASK);
    bf16* VTA = (bf16*)(ws + WS_VTA); bf16* VTB = (bf16*)(ws + WS_VTB);
    bf16* Hh = (bf16*)(ws + WS_H); bf16* KB = (bf16*)(ws + WS_H); bf16* QB = (bf16*)(ws + WS_QB);
    bf16* KVB = (bf16*)(ws + WS_KVB); bf16* MG = (bf16*)(ws + WS_KVB); bf16* YS = (bf16*)(ws + WS_YS); bf16* P = (bf16*)(ws + WS_P);

    {
        LAS float* scr = (LAS float*)(lds + wave * 16384);
        constexpr int I_IN = 16 * (NP / 32), I_UQ = 6 * 24, I_UKV = 4 * 32, I_MEM = 16 * 32, I_BR = 8 * 32, I_OUT = 16 * 32;
        constexpr int NITEMS = I_IN + I_UQ + I_UKV + I_MEM + 3 * I_BR + I_OUT;
        for (int it = gw; it < NITEMS; it += NGW) {
            int r = it;
            if (r < I_IN) { transpose_item(w_in, 1024, DIN, NP, WinT, scr, r, lane); continue; } r -= I_IN;
            if (r < I_UQ) { transpose_item(w_uq, 384, 768, 768, WuqT, scr, r, lane); continue; } r -= I_UQ;
            if (r < I_UKV) { transpose_item(w_ukv, 256, 1024, 1024, WukvT, scr, r, lane); continue; } r -= I_UKV;
            if (r < I_MEM) { transpose_item(w_mem_kv, 1024, 1024, 1024, WmemT, scr, r, lane); continue; } r -= I_MEM;
            if (r < 3 * I_BR) { const int nb = r / I_BR; transpose_item(w_branch + (size_t)nb * 512 * 1024, 512, 1024, 1024, WbrT + (size_t)nb * 1024 * 512, scr, r % I_BR, lane); continue; } r -= 3 * I_BR;
            transpose_item(w_out, 1024, 1024, 1024, WoutT, scr, r, lane);
        }
        for (int idx = blockIdx.x * 512 + tid; idx < TT * 24; idx += G * 512) {
            const int t = idx / 24, i = idx % 24; const float pf = (float)a.pos[t];
            if (i < 8) { const float ang = pf * INVA[i]; ropeA[t * 16 + i] = cosf(ang); ropeA[t * 16 + 8 + i] = sinf(ang); }
            else { const int j = i - 8; const float ang = pf * INVB[j]; ropeB[t * 32 + j] = cosf(ang); ropeB[t * 32 + 16 + j] = sinf(ang); }
        }
        for (int m = gw; m < NB * MEML; m += NGW) rms_row_1024(mem + (size_t)m * DM, g_mem, MN + (size_t)m * DM, lane);
    }
    grid.sync();

    for (int half = 0; half < 2; ++half) {
        tid = threadIdx.x; asm volatile("" : "+v"(tid)); lane = tid & 63; wave = __builtin_amdgcn_readfirstlane(tid >> 6); gw = blockIdx.x * 8 + wave;
        const size_t tok0 = (size_t)half * TH;
        unsigned* q_idx = ctl + 64 * (2 * half);
        unsigned* q_att = ctl + 64 * (2 * half + 1);
        for (int m = gw; m < TH; m += NGW) rms_row_1024(x + (tok0 + m) * DM, g_norm, Hh + (size_t)m * DM, lane);
        grid.sync();
#ifndef NO_P1
        {
            pg8::Gemm g{Hh, WinT, TH, NP, 1024, 1024}; pg8::StaticOrder S; S.init(TH, NP, G, (int)blockIdx.x);
            pg8::EpiBf16<0> E{P, NP, nullptr, 0, 0, 1.f};
            pg8::gemm_phase<pg8::EpiBf16<0>, pg8::StaticOrder, true, true>(lds, g, S, E);
        }
        if (half == 0) {
            pg8::Gemm g{MN, WmemT, NB * MEML, 1024, 1024, 1024}; pg8::StaticOrder S; S.init(NB * MEML, 1024, G, (int)((blockIdx.x + 128) % G));
            pg8::EpiBf16<0> E{KVM, 1024, nullptr, 0, 0, 1.f};
            pg8::gemm_phase<pg8::EpiBf16<0>, pg8::StaticOrder, true, true>(lds, g, S, E);
        }
#endif
        grid.sync();
#ifndef NO_P2
        for (int m = gw; m < TH; m += NGW)
            post1_row(P + (size_t)m * NP, ropeA + (tok0 + m) * 16, g_qn_a, g_kn_a, g_cq, g_ckv, g_qn_m, WI + (size_t)m * 8, lane);
        transpose_v(P, NP, C_VA, 64, 8, 64, SEQ, HB, VTA, gw, NGW, lane);
        if (half == 0) {
            for (int m = gw; m < NB * MEML; m += NGW) km_row(KVM + (size_t)m * 1024, g_kn_m, lane);
            transpose_v(KVM, 1024, 512, 128, 4, 128, MEML, NB, VTM, gw, NGW, lane);
        }
#endif
        grid.sync();
#ifndef NO_P3G
        {
            pg8::Gemm g{P + C_CQ, WuqT, TH, 768, 384, NP}; pg8::StaticOrder S; S.init(TH, 768, G, (int)blockIdx.x);
            pg8::EpiBf16<0> E{QB, 768, nullptr, 0, 0, 1.f};
            pg8::gemm_phase<pg8::EpiBf16<0>, pg8::StaticOrder, true, true>(lds, g, S, E);
        }
        {
            pg8::Gemm g{P + C_CKV, WukvT, TH, 1024, 256, NP}; pg8::StaticOrder S; S.init(TH, 1024, G, (int)((blockIdx.x + 128) % G));
            pg8::EpiBf16<0> E{KVB, 1024, nullptr, 0, 0, 1.f};
            pg8::gemm_phase<pg8::EpiBf16<0>, pg8::StaticOrder, true, true>(lds, g, S, E);
        }
#endif
#ifndef NO_P3I
        for (;;) {
            const int u = next_unit(q_idx, slot);
            if (u >= HB * 128) break;
            const int tb = 127 - (u >> 2), bb = u & 3;
            indexer_unit((LAS float*)lds, P, WI, MASK, bb, tb);
        }
#endif
        grid.sync();
#ifndef NO_P4
        {
            LAS float* scr = (LAS float*)(lds + wave * 4096);
            for (int m = gw; m < TH; m += NGW) {
                const float* rb = ropeB + (tok0 + m) * 32;
                post2_row<0>(QB + (size_t)m * 768, nullptr, nullptr, nullptr, rb, g_qn_b, scr, lane);
                post2_row<1>(nullptr, KVB + (size_t)m * 1024, P + (size_t)m * NP, KB + (size_t)m * 768, rb, g_kn_b, scr, lane);
            }
            transpose_v(KVB, 1024, 64, 128, 8, 64, SEQ, HB, VTB, gw, NGW, lane);
        }
#endif
        grid.sync();
#ifndef NO_P5
        for (;;) {
            const int u = next_unit(q_att, slot);
            if (u >= 768) break;
            if (u < 512) {
                const int qb = 7 - (u >> 6), wi = u & 63, bh = wi & 31, bb = bh >> 3, h = bh & 7;
                const size_t r0 = (size_t)bb * SEQ;
                if (wi < 32) attn_unit<96, 64, 1>(lds, QB + r0 * 768 + h * 96, 768, KB + r0 * 768 + h * 96, 768, VTB + (size_t)((bb * 8 + h) * 64) * SEQ, SEQ, nullptr,
                                                  P + r0 * NP + C_ZB + h * 64, YS + (size_t)1 * TH * 512 + r0 * 512 + h * 64, qb * 256);
                else attn_unit<64, 64, 2>(lds, P + r0 * NP + C_QA + h * 64, NP, P + r0 * NP + C_KA + h * 64, NP, VTA + (size_t)((bb * 8 + h) * 64) * SEQ, SEQ, MASK + r0 * 64,
                                          P + r0 * NP + C_ZA + h * 64, YS + r0 * 512 + h * 64, qb * 256);
            } else {
                const int v = u - 512, vh = v & 1, qb = (v >> 1) & 7, bh = v >> 4, bb = bh >> 2, h = bh & 3, gb = half * HB + bb;
                const size_t r0 = (size_t)bb * SEQ;
                attn_unit<128, 64, 0>(lds, P + r0 * NP + C_QM + h * 128, NP, KVM + (size_t)gb * MEML * 1024 + h * 128, 1024, VTM + (size_t)((gb * 4 + h) * 128 + vh * 64) * MEML, MEML, nullptr,
                                      P + r0 * NP + C_ZM + h * 128 + vh * 64, YS + (size_t)2 * TH * 512 + r0 * 512 + h * 128 + vh * 64, qb * 256);
            }
        }
#endif
        grid.sync();
#ifndef NO_P6
        for (int nb = 0; nb < 3; ++nb) {
            pg8::Gemm g{YS + (size_t)nb * TH * 512, WbrT + (size_t)nb * 1024 * 512, TH, 1024, 512, 512}; pg8::StaticOrder S; S.init(TH, 1024, G, (int)blockIdx.x);
            EpiMerge E{MG, P, nb};
            pg8::gemm_phase<EpiMerge, pg8::StaticOrder, true, true>(lds, g, S, E);
        }
#endif
        grid.sync();
#ifndef NO_P7
        {
            pg8::Gemm g{MG, WoutT, TH, 1024, 1024, 1024}; pg8::StaticOrder S; S.init(TH, 1024, G, (int)blockIdx.x);
            EpiOut E{x + tok0 * DM, a.out + tok0 * DM};
            pg8::gemm_phase<EpiOut, pg8::StaticOrder, true, true>(lds, g, S, E);
        }
#endif
        grid.sync();
    }
}

extern "C" void kernel_launch(void* const* d_in, const int* in_sizes, int n_in, void* d_out, int out_size, void* d_ws, size_t ws_size, hipStream_t stream) {
    static int grid = 0;
    if (grid == 0) {
        if (n_in != 19 || out_size != TT * DM || ws_size < WS_END) { fprintf(stderr, "kernel_launch: unexpected problem (n_in %d, out %d, ws %zu); nothing launched\n", n_in, out_size, ws_size); grid = -1; return; }
        int dev = 0, cus = 0, per_cu = 0;
        if (hipGetDevice(&dev) != hipSuccess || hipDeviceGetAttribute(&cus, hipDeviceAttributeMultiprocessorCount, dev) != hipSuccess) { grid = -1; return; }
        if (hipFuncSetAttribute((const void*)fwd_kernel, hipFuncAttributeMaxDynamicSharedMemorySize, LDS_BYTES) != hipSuccess) { fprintf(stderr, "kernel_launch: hipFuncSetAttribute failed\n"); grid = -1; return; }
        if (hipOccupancyMaxActiveBlocksPerMultiprocessor(&per_cu, (const void*)fwd_kernel, 512, LDS_BYTES) != hipSuccess || per_cu < 1) { fprintf(stderr, "kernel_launch: occupancy query reports %d blocks per CU\n", per_cu); (void)hipGetLastError(); grid = -1; return; }
        grid = cus;
    }
    if (grid < 0) return;
    (void)hipMemsetAsync((char*)d_ws + WS_CTL, 0, 4096, stream);
    Args a{};
    for (int i = 0; i < 19; ++i) a.in[i] = (const float*)d_in[i];
    a.pos = (const int*)d_in[2]; a.out = (float*)d_out; a.ws = (unsigned char*)d_ws;
    void* args[] = {&a};
    hipError_t e = hipLaunchCooperativeKernel((void*)fwd_kernel, dim3(grid), dim3(512), args, LDS_BYTES, stream);
    if (e != hipSuccess) fprintf(stderr, "kernel_launch: cooperative launch failed: %s (grid %d)\n", hipGetErrorString(e), grid);
}
```

```cpp
#include <hip/hip_runtime.h>
#include <cstdio>
#include <cstdint>
namespace pg8 {
#define PG8_LAS __attribute__((address_space(3)))
typedef unsigned short bf16_t;
typedef short bf16x8 __attribute__((ext_vector_type(8)));
typedef float f32x4 __attribute__((ext_vector_type(4)));
typedef unsigned u32x4 __attribute__((ext_vector_type(4)));
constexpr int BM = 256, BK = 64, HALF = 128, HTB = HALF * BK * 2  , STAGE_BYTES = 8 * HTB, NXCD = 8, WGM = 8;

__host__ __device__ __forceinline__ int lds_byte(int r, int c) { const int st = (r >> 4) * 2 + (c >> 5), rr = r & 15, cc = c & 31, ob = rr * 64 + cc * 2; return st * 1024 + (ob ^ (((ob >> 9) & 1) << 5)); }
__host__ __device__ __forceinline__ void stage_rc(int b, int& R, int& C) { const int st = b / 1024, sb = b % 1024, swz = sb ^ (((sb >> 9) & 1) << 5); R = (st >> 1) * 16 + swz / 64; C = (st & 1) * 32 + (swz % 64) / 2; }
__host__ __device__ __forceinline__ int perm32(int rho) { const int n = rho >> 4, i = rho & 15; return 8 * (i >> 2) + 4 * n + (i & 3); }

struct Unit { int pm, pn; };
struct Gemm { const bf16_t* A; const bf16_t* Bt; int M, N, K, lda; };

struct StaticOrder {
    int nM, nN, nwg, G, c;
    __host__ __device__ void init(int M, int N, int G_, int c_) { nM = M / BM; nN = N / BM; nwg = nM * nN; G = G_; c = c_; }
    __host__ __device__ bool next(int i, Unit& u) const {
        const long L = (long)i * G + c; if (L >= nwg) return false;
        int wgid = (int)L; { const int q = nwg / NXCD, r = nwg % NXCD, xcd = wgid % NXCD, off = wgid / NXCD; wgid = (xcd < r ? xcd * (q + 1) : r * (q + 1) + (xcd - r) * q) + off; }
        const int nig = WGM * nN, gid = wgid / nig, fm = gid * WGM, gsz = (nM - fm) < WGM ? (nM - fm) : WGM;
        u.pm = fm + ((wgid % nig) % gsz); u.pn = (wgid % nig) / gsz; return true;
    }
    __device__ __forceinline__ void a_ready(const Unit&) const {}
    __device__ __forceinline__ void done(const Unit&) const {}
};

__device__ __forceinline__ unsigned cvt_pk_bf16(float lo, float hi) { unsigned r; asm volatile("v_cvt_pk_bf16_f32 %0, %1, %2" : "=v"(r) : "v"(lo), "v"(hi)); return r; }
typedef float f32x2 __attribute__((ext_vector_type(2)));
__device__ __forceinline__ f32x2 gelu_pk(f32x2 v) {
    const f32x2 av = __builtin_elementwise_abs(v), d = av * 0.2316418882f + 1.0f;
    f32x2 t; t.x = __builtin_amdgcn_rcpf(d.x); t.y = __builtin_amdgcn_rcpf(d.y);
    f32x2 q = t * 0.5307027145f + (-0.7265760135f); q = q * t + 0.7107068705f; q = q * t + (-0.142248368f); q = q * t + 0.127414796f; q = q * t;
    const f32x2 s = (v * v) * (-0.72134752044f);
    f32x2 e; e.x = __builtin_amdgcn_exp2f(s.x); e.y = __builtin_amdgcn_exp2f(s.y);
    const f32x2 m = v * (q * e), r = v - m;
    f32x2 o; o.x = v.x < 0.f ? m.x : r.x; o.y = v.y < 0.f ? m.y : r.y; return o;
}

template <int ACT  > struct EpiBf16 {
    static constexpr bool PERM = true, AFTER_DRAIN = false; static_assert(ACT == 0 || ACT == 1, "EpiBf16: ACT is 0 (none) or 1 (gelu_pk)");
    bf16_t* O; int ldc; const float* bias; int split_cols; size_t split_stride; float scale0;
    __device__ __forceinline__ void operator()(const f32x4 (&acc)[2][2][4][2], const Unit& u, int wr, int wc, int fr, int fq) const {
        const int row0 = u.pm * BM + wr * 64 + fr; int colt = u.pn * BM; bf16_t* base = O;
        float sc = 1.f; if (split_cols) { const int t = colt / split_cols; base += (size_t)t * split_stride; colt -= t * split_cols; if (t == 0) sc = scale0; }
        const int col0 = colt + wc * 32 + 8 * fq, bcol0 = u.pn * BM + wc * 32 + 8 * fq;
        f32x4 bv[2][2];
#pragma unroll
        for (int bj = 0; bj < 2; ++bj)
#pragma unroll
            for (int n = 0; n < 2; ++n) bv[bj][n] = bias ? *(const f32x4*)(bias + bcol0 + bj * HALF + 4 * n) : (f32x4){0.f, 0.f, 0.f, 0.f};
#pragma unroll
        for (int ai = 0; ai < 2; ++ai)
#pragma unroll
            for (int m = 0; m < 4; ++m) { bf16_t* rowp = base + (size_t)(row0 + ai * HALF + m * 16) * ldc + col0;
#pragma unroll
                for (int bj = 0; bj < 2; ++bj) { f32x4 v0 = acc[ai][bj][m][0] + bv[bj][0], v1 = acc[ai][bj][m][1] + bv[bj][1];
                    if (ACT == 1) { f32x2 a = gelu_pk((f32x2){v0[0], v0[1]}), b = gelu_pk((f32x2){v0[2], v0[3]}), c = gelu_pk((f32x2){v1[0], v1[1]}), d = gelu_pk((f32x2){v1[2], v1[3]});
                        v0 = (f32x4){a.x, a.y, b.x, b.y}; v1 = (f32x4){c.x, c.y, d.x, d.y}; }
                    v0 = v0 * sc; v1 = v1 * sc; u32x4 w; w.x = cvt_pk_bf16(v0[0], v0[1]); w.y = cvt_pk_bf16(v0[2], v0[3]); w.z = cvt_pk_bf16(v1[0], v1[1]); w.w = cvt_pk_bf16(v1[2], v1[3]);
                    *(u32x4*)(rowp + bj * HALF) = w; } }
    }
};
template <class Epi, class Sched, bool ALIGN_EPI = false, bool SP2 = false>
__device__ __forceinline__ void gemm_phase(PG8_LAS unsigned char* lds, const Gemm g, const Sched& S, const Epi& E) {
    int tid_ = threadIdx.x; asm volatile("" : "+v"(tid_));
    const int tid = tid_, wid = __builtin_amdgcn_readfirstlane(tid >> 6), lane = tid & 63, wr = wid >> 2, wc = wid & 3, fr = lane & 15, fq = lane >> 4;
    const int K = g.K, nt = K / BK;
    unsigned voffA[2], voffB[2];
#pragma unroll
    for (int i = 0; i < 2; ++i) { int R, C; stage_rc(tid * 16 + i * 8192, R, C); const int Rb = Epi::PERM ? ((R & ~31) + perm32(R & 31)) : R;
        voffA[i] = (unsigned)(R * g.lda + C) * 2u; voffB[i] = (unsigned)(Rb * K + C) * 2u; }
    const size_t kstep = (size_t)(BK * 2);
    const size_t hstepA = (size_t)HALF * g.lda * 2, hstepB = (size_t)HALF * K * 2;
    const size_t tstepA = 2 * hstepA, tstepB = 2 * hstepB;
    const unsigned ldsw = (unsigned)wid * 1024u;
    const int aoff = lds_byte(wr * 64 + fr, fq * 8), boff = lds_byte(wc * 32 + fr, fq * 8);
#define PG8_SA(b, h) (((b) * 2 + (h)) * HTB)
#define PG8_SB(b, h) ((4 + (b) * 2 + (h)) * HTB)
#define PG8_STAGE(bufoff, gbase, voff) do { _Pragma("unroll") for (int _i = 0; _i < 2; ++_i) \
        __builtin_amdgcn_global_load_lds((const unsigned*)((const char*)(gbase) + (voff)[_i]), (PG8_LAS unsigned*)(lds + (bufoff) + ldsw + _i * 8192), 16, 0, 0); } while (0)
#define PG8_LDA(dst, b, h) do { _Pragma("unroll") for (int m = 0; m < 4; ++m) _Pragma("unroll") for (int k = 0; k < 2; ++k) dst[m][k] = *(const PG8_LAS bf16x8*)(lds + PG8_SA(b, h) + aoff + m * 2048 + k * 1024); } while (0)
#define PG8_LDB(dst, b, h) do { _Pragma("unroll") for (int n = 0; n < 2; ++n) _Pragma("unroll") for (int k = 0; k < 2; ++k) dst[n][k] = *(const PG8_LAS bf16x8*)(lds + PG8_SB(b, h) + boff + n * 2048 + k * 1024); } while (0)
#define PG8_MMA(ai, bj, At, Bt) do { __builtin_amdgcn_s_setprio(1); _Pragma("unroll") for (int m = 0; m < 4; ++m) _Pragma("unroll") for (int n = 0; n < 2; ++n) _Pragma("unroll") for (int k = 0; k < 2; ++k) \
        acc[ai][bj][m][n] = __builtin_amdgcn_mfma_f32_16x16x32_bf16(Bt[n][k], At[m][k], acc[ai][bj][m][n], 0, 0, 0); __builtin_amdgcn_s_setprio(0); } while (0)
#define PG8_WAIT_V(n) asm volatile("s_waitcnt vmcnt(" #n ")" ::: "memory")
#define PG8_WAIT_L(n) asm volatile("s_waitcnt lgkmcnt(" #n ")" ::: "memory")
#define PG8_BAR __builtin_amdgcn_s_barrier()
#define PG8_SCHED __builtin_amdgcn_sched_barrier(0)
    Unit cur, nxt; int ui = 0;
    if (!S.next(0, cur)) return;
    f32x4 acc[2][2][4][2];
#pragma unroll
    for (int a = 0; a < 2; ++a)
#pragma unroll
        for (int b = 0; b < 2; ++b)
#pragma unroll
            for (int m = 0; m < 4; ++m)
#pragma unroll
                for (int n = 0; n < 2; ++n) acc[a][b][m][n] = (f32x4){0.f, 0.f, 0.f, 0.f};
    bf16x8 At[4][2], B0[2][2], B1[2][2];
    const char* cA = (const char*)g.A + (size_t)cur.pm * tstepA; const char* cB = (const char*)g.Bt + (size_t)cur.pn * tstepB;
    S.a_ready(cur);
    if constexpr (SP2) {
        PG8_STAGE(PG8_SB(0, 0), cB, voffB); PG8_STAGE(PG8_SB(0, 1), cB + hstepB, voffB); PG8_STAGE(PG8_SA(0, 0), cA, voffA); PG8_STAGE(PG8_SA(0, 1), cA + hstepA, voffA);
        if (wr == 1) PG8_BAR;
        PG8_WAIT_V(2); PG8_BAR;
        PG8_STAGE(PG8_SB(1, 0), cB + kstep, voffB); PG8_STAGE(PG8_SA(1, 0), cA + kstep, voffA); PG8_STAGE(PG8_SB(1, 1), cB + hstepB + kstep, voffB);
        PG8_WAIT_V(6); PG8_BAR;
    } else {
        PG8_STAGE(PG8_SB(0, 0), cB, voffB); PG8_STAGE(PG8_SA(0, 0), cA, voffA); PG8_STAGE(PG8_SB(0, 1), cB + hstepB, voffB); PG8_STAGE(PG8_SA(0, 1), cA + hstepA, voffA);
        if (wr == 1) PG8_BAR;
        PG8_WAIT_V(4); PG8_BAR;
        PG8_STAGE(PG8_SB(1, 0), cB + kstep, voffB); PG8_STAGE(PG8_SA(1, 0), cA + kstep, voffA); PG8_STAGE(PG8_SB(1, 1), cB + hstepB + kstep, voffB);
        PG8_WAIT_V(6); PG8_BAR;
    }
    for (;;) {
        const bool has_next = S.next(ui + 1, nxt);
        const char* nA = has_next ? (const char*)g.A + (size_t)nxt.pm * tstepA : cA; const char* nB = has_next ? (const char*)g.Bt + (size_t)nxt.pn * tstepB : cB;
        for (int t = 0; t < nt; t += 2) {
            const bool last = (t == nt - 2);
            const char* a1 = cA + (size_t)(t + 1) * kstep;
            const char* a2 = last ? nA : cA + (size_t)(t + 2) * kstep; const char* b2 = last ? nB : cB + (size_t)(t + 2) * kstep;
            const char* a3 = a2 + kstep; const char* b3 = b2 + kstep;
            if (last && has_next) S.a_ready(nxt);
            if constexpr (SP2) {
            PG8_LDB(B0, 0, 0); PG8_LDB(B1, 0, 1); PG8_SCHED; PG8_LDA(At, 0, 0); PG8_STAGE(PG8_SA(1, 1), a1 + hstepA, voffA);
            PG8_WAIT_V(8); PG8_WAIT_L(0); PG8_BAR; PG8_MMA(0, 0, At, B0); PG8_MMA(0, 1, At, B1); PG8_BAR; PG8_SCHED;
            PG8_LDA(At, 0, 1); PG8_STAGE(PG8_SB(0, 0), b2, voffB); PG8_STAGE(PG8_SB(0, 1), b2 + hstepB, voffB); PG8_STAGE(PG8_SA(0, 0), a2, voffA);
            PG8_WAIT_V(8); PG8_WAIT_L(0); PG8_BAR; PG8_MMA(1, 0, At, B0); PG8_MMA(1, 1, At, B1); PG8_BAR; PG8_SCHED;
            PG8_LDB(B0, 1, 0); PG8_LDB(B1, 1, 1); PG8_SCHED; PG8_LDA(At, 1, 0); PG8_STAGE(PG8_SA(0, 1), a2 + hstepA, voffA);
            PG8_WAIT_V(8); PG8_WAIT_L(0); PG8_BAR; PG8_MMA(0, 0, At, B0); PG8_MMA(0, 1, At, B1); PG8_BAR; PG8_SCHED;
            PG8_LDA(At, 1, 1); PG8_STAGE(PG8_SB(1, 0), b3, voffB); PG8_STAGE(PG8_SB(1, 1), b3 + hstepB, voffB); PG8_STAGE(PG8_SA(1, 0), a3, voffA);
            PG8_WAIT_V(8); PG8_WAIT_L(0); PG8_BAR; PG8_MMA(1, 0, At, B0); PG8_MMA(1, 1, At, B1); PG8_BAR; PG8_SCHED;
            } else {
            PG8_LDB(B0, 0, 0); PG8_SCHED; PG8_LDA(At, 0, 0); PG8_STAGE(PG8_SA(1, 1), a1 + hstepA, voffA);
            PG8_WAIT_L(8); PG8_BAR; PG8_WAIT_L(0); PG8_MMA(0, 0, At, B0); PG8_BAR; PG8_SCHED;
            PG8_LDB(B1, 0, 1); PG8_STAGE(PG8_SB(0, 0), b2, voffB);
            PG8_BAR; PG8_WAIT_L(0); PG8_MMA(0, 1, At, B1); PG8_BAR;
            PG8_LDA(At, 0, 1); PG8_STAGE(PG8_SA(0, 0), a2, voffA);
            PG8_BAR; PG8_WAIT_L(0); PG8_MMA(1, 0, At, B0); PG8_BAR; PG8_SCHED;
            PG8_STAGE(PG8_SB(0, 1), b2 + hstepB, voffB);
            PG8_WAIT_V(6); PG8_BAR; PG8_MMA(1, 1, At, B1); PG8_BAR;
            PG8_LDB(B0, 1, 0); PG8_SCHED; PG8_LDA(At, 1, 0); PG8_STAGE(PG8_SA(0, 1), a2 + hstepA, voffA);
            PG8_WAIT_L(8); PG8_BAR; PG8_WAIT_L(0); PG8_MMA(0, 0, At, B0); PG8_BAR; PG8_SCHED;
            PG8_LDB(B1, 1, 1); PG8_STAGE(PG8_SB(1, 0), b3, voffB);
            PG8_BAR; PG8_WAIT_L(0); PG8_MMA(0, 1, At, B1); PG8_BAR;
            PG8_LDA(At, 1, 1); PG8_STAGE(PG8_SA(1, 0), a3, voffA);
            PG8_BAR; PG8_WAIT_L(0); PG8_MMA(1, 0, At, B0); PG8_BAR; PG8_SCHED;
            PG8_STAGE(PG8_SB(1, 1), b3 + hstepB, voffB);
            PG8_WAIT_V(6); PG8_BAR; PG8_MMA(1, 1, At, B1); PG8_BAR;
            }
        }
        if constexpr (ALIGN_EPI) { if (wr == 0) PG8_BAR; }
        if constexpr (!Epi::AFTER_DRAIN) { E(acc, cur, wr, wc, fr, fq); S.done(cur); }
        if (!has_next) break;
#pragma unroll
        for (int a = 0; a < 2; ++a)
#pragma unroll
            for (int b = 0; b < 2; ++b)
#pragma unroll
                for (int m = 0; m < 4; ++m)
#pragma unroll
                    for (int n = 0; n < 2; ++n) acc[a][b][m][n] = (f32x4){0.f, 0.f, 0.f, 0.f};
        cur = nxt; cA = nA; cB = nB; ++ui;
        if constexpr (ALIGN_EPI) { if (wr == 1) PG8_BAR; }
    }
    PG8_WAIT_V(0);
    if constexpr (!ALIGN_EPI) { if (wr == 0) PG8_BAR; }
    PG8_BAR;
    if constexpr (Epi::AFTER_DRAIN) { E.fused(acc, cur, wr, wc, fr, fq, lds, wid, lane); S.done(cur); }
#undef PG8_SA
#undef PG8_SB
#undef PG8_STAGE
#undef PG8_LDA
#undef PG8_LDB
#undef PG8_MMA
#undef PG8_WAIT_V
#undef PG8_WAIT_L
#undef PG8_BAR
#undef PG8_SCHED
}
}

#define LAS __attribute__((address_space(3)))
typedef unsigned short bf16;
typedef unsigned v4u __attribute__((ext_vector_type(4)));
typedef unsigned v2u __attribute__((ext_vector_type(2)));
typedef float f32x4 __attribute__((ext_vector_type(4)));
typedef float f32x16 __attribute__((ext_vector_type(16)));
typedef short bf16x8 __attribute__((ext_vector_type(8)));
typedef short s16x4 __attribute__((ext_vector_type(4)));
typedef float f32x2_t __attribute__((ext_vector_type(2)));
typedef __bf16 bf16x2_t __attribute__((ext_vector_type(2)));

constexpr int NB = 8, SEQ = 2048, DM = 1024, TT = NB * SEQ;
constexpr int HB = 4, TH = HB * SEQ;
constexpr int DIN = 7912, NP = 7936;
constexpr int MEML = 256;
constexpr float EPS = 1e-6f, NEGF = -1e30f;
constexpr int C_QA = 0, C_KA = 512, C_VA = 1024, C_QI = 1536, C_KI = 2048, C_WI = 2112, C_ZA = 2120, C_CQ = 2632, C_CKV = 3016, C_KR = 3272,
              C_ZB = 3304, C_QM = 3816, C_ZM = 4328, C_GL = 4840;
constexpr float SCALE_A = 0.18033688011112042f;
constexpr float SCALE_B = 0.14724444602590306f;
constexpr float SCALE_M = 0.12751743082459868f;
constexpr float SCALE_I = 0.04419417382415922f;

__constant__ float INVA[8] = {1.0f, 0.1939227432012558f, 0.03760603070259094f, 0.007292664609849453f, 0.0014142135623842478f, 0.00027424818836152554f, 5.3182957344688475e-05f, 1.0313385246263351e-05f};
__constant__ float INVB[16] = {1.0f, 0.44036659598350525f, 0.1939227432012558f, 0.08539710193872452f, 0.03760603070259094f, 0.016560440883040428f, 0.007292664609849453f, 0.0032114461064338684f, 0.0014142135623842478f, 0.0006227724370546639f, 0.00027424818836152554f, 0.00012076973507646471f, 5.3182957344688475e-05f, 2.34199997066753e-05f, 1.0313385246263351e-05f, 4.541670477919979e-06f};

constexpr size_t MiB = 1u << 20;
constexpr size_t WS_CTL = 0;
constexpr size_t WS_WIN = 1 * MiB;
constexpr size_t WS_WUQ = 17 * MiB;
constexpr size_t WS_WUKV = 18 * MiB;
constexpr size_t WS_WMEM = 19 * MiB;
constexpr size_t WS_WBR = 21 * MiB;
constexpr size_t WS_WOUT = 24 * MiB;
constexpr size_t WS_ROPEA = 26 * MiB;
constexpr size_t WS_ROPEB = 27 * MiB;
constexpr size_t WS_MN = 29 * MiB;
constexpr size_t WS_KVM = 33 * MiB;
constexpr size_t WS_VTM = 37 * MiB;
constexpr size_t WS_WI = 39 * MiB;
constexpr size_t WS_MASK = 40 * MiB;
constexpr size_t WS_VTA = 42 * MiB;
constexpr size_t WS_VTB = 50 * MiB;
constexpr size_t WS_H = 58 * MiB;
constexpr size_t WS_QB = 74 * MiB;
constexpr size_t WS_KVB = 86 * MiB;
constexpr size_t WS_YS = 102 * MiB;
constexpr size_t WS_P = 126 * MiB;
constexpr size_t WS_END = 250 * MiB;

constexpr int REP_P0 = 1, REP_PH = 1, REP_G1 = 1, REP_G2 = 1, REP_IDX = 1, REP_ATT = 1, REP_G4 = 1, REP_G5 = 1;
constexpr int EXTRA_SYNCS = 0;
constexpr int LDS_BYTES = 147456;
constexpr int LDS_SLOT = LDS_BYTES - 64;

__device__ __forceinline__ unsigned pk2(float lo, float hi) { f32x2_t v = {lo, hi}; bf16x2_t b = __builtin_convertvector(v, bf16x2_t); return __builtin_bit_cast(unsigned, b); }
__device__ __forceinline__ float bflo(unsigned w) { return __uint_as_float(w << 16); }
__device__ __forceinline__ float bfhi(unsigned w) { return __uint_as_float(w & 0xffff0000u); }
__device__ __forceinline__ float bf1(bf16 b) { return __uint_as_float(((unsigned)b) << 16); }
#define UNPACK8(W_, V_) do { V_[0] = bflo((W_)[0]); V_[1] = bfhi((W_)[0]); V_[2] = bflo((W_)[1]); V_[3] = bfhi((W_)[1]); V_[4] = bflo((W_)[2]); V_[5] = bfhi((W_)[2]); V_[6] = bflo((W_)[3]); V_[7] = bfhi((W_)[3]); } while (0)
#define PACK8(V_) (v4u){pk2(V_[0], V_[1]), pk2(V_[2], V_[3]), pk2(V_[4], V_[5]), pk2(V_[6], V_[7])}
__device__ __forceinline__ float wave_sum(float v) {
#pragma unroll
    for (int o = 1; o < 64; o <<= 1) v += __shfl_xor(v, o);
    return v;
}
#define LDS_WAIT() asm volatile("s_waitcnt lgkmcnt(0)" ::: "memory")

__device__ __forceinline__ void transpose_item(const float* W, int K, int N, int Npad, bf16* WT, LAS float* scr, int item, int lane) {
    const int nblk = Npad / 32, kb = item / nblk, nb = item % nblk, k0 = 64 * kb, n0 = 32 * nb;
    const int nn = n0 + (lane & 31); const bool ok = nn < N;
#pragma unroll 8
    for (int i = 0; i < 32; ++i) { const int kk = 2 * i + (lane >> 5); scr[kk * 33 + (lane & 31)] = ok ? W[(size_t)(k0 + kk) * N + nn] : 0.f; }
    LDS_WAIT(); asm volatile("" ::: "memory");
    const int c = lane & 7;
#pragma unroll
    for (int j = 0; j < 4; ++j) { const int n = (lane >> 3) + 8 * j; const LAS float* s = scr + (8 * c) * 33 + n;
        v4u o; o.x = pk2(s[0 * 33], s[1 * 33]); o.y = pk2(s[2 * 33], s[3 * 33]); o.z = pk2(s[4 * 33], s[5 * 33]); o.w = pk2(s[6 * 33], s[7 * 33]);
        *(v4u*)(WT + (size_t)(n0 + n) * K + k0 + 8 * c) = o; }
    LDS_WAIT(); asm volatile("" ::: "memory");
}
__device__ __forceinline__ void rms_row_1024(const float* xrow, const float* g, bf16* orow, int lane) {
    const f32x4* xr = (const f32x4*)xrow + lane; const f32x4* gr = (const f32x4*)g + lane;
    f32x4 v[4]; float s = 0.f;
#pragma unroll
    for (int j = 0; j < 4; ++j) { v[j] = xr[64 * j]; s += (v[j].x * v[j].x + v[j].y * v[j].y) + (v[j].z * v[j].z + v[j].w * v[j].w); }
    const float rstd = 1.0f / sqrtf(wave_sum(s) * (1.f / 1024.f) + EPS);
    v2u* o8 = (v2u*)orow + lane;
#pragma unroll
    for (int j = 0; j < 4; ++j) { const f32x4 gg = gr[64 * j]; v2u w; w.x = pk2(v[j].x * rstd * gg.x, v[j].y * rstd * gg.y); w.y = pk2(v[j].z * rstd * gg.z, v[j].w * rstd * gg.w); o8[64 * j] = w; }
}

#define ROPE8(v, sub, c8, s8) do { _Pragma("unroll") for (int j_ = 0; j_ < 8; ++j_) { const float pv_ = __shfl_xor(v[j_], 1); \
        const float r0_ = v[j_] * c8[j_] - pv_ * s8[j_], r1_ = v[j_] * c8[j_] + pv_ * s8[j_]; v[j_] = (sub) == 0 ? r0_ : ((sub) == 1 ? r1_ : v[j_]); } } while (0)

__device__ __forceinline__ void post1_row(bf16* Prow, const float* ra, const float* gqa, const float* gka, const float* gcq, const float* gckv, const float* gqm, float* WIrow, int lane) {
    const int sub = lane & 7;
    float c8[8], s8[8];
#pragma unroll
    for (int j = 0; j < 8; ++j) { c8[j] = ra[j]; s8[j] = ra[8 + j]; }
    { v4u w = *(const v4u*)(Prow + C_QA + 8 * lane); float v[8]; UNPACK8(w, v); float ss = 0.f;
#pragma unroll
      for (int j = 0; j < 8; ++j) ss += v[j] * v[j];
      ss += __shfl_xor(ss, 1); ss += __shfl_xor(ss, 2); ss += __shfl_xor(ss, 4);
      const float rstd = 1.0f / sqrtf(ss * (1.f / 64.f) + EPS);
#pragma unroll
      for (int j = 0; j < 8; ++j) v[j] = v[j] * rstd * gqa[8 * sub + j];
      ROPE8(v, sub, c8, s8);
#pragma unroll
      for (int j = 0; j < 8; ++j) v[j] *= SCALE_A;
      *(v4u*)(Prow + C_QA + 8 * lane) = PACK8(v); }
    { v4u w = *(const v4u*)(Prow + C_KA + 8 * lane); float v[8]; UNPACK8(w, v); float ss = 0.f;
#pragma unroll
      for (int j = 0; j < 8; ++j) ss += v[j] * v[j];
      ss += __shfl_xor(ss, 1); ss += __shfl_xor(ss, 2); ss += __shfl_xor(ss, 4);
      const float rstd = 1.0f / sqrtf(ss * (1.f / 64.f) + EPS);
#pragma unroll
      for (int j = 0; j < 8; ++j) v[j] = v[j] * rstd * gka[8 * sub + j];
      ROPE8(v, sub, c8, s8);
      *(v4u*)(Prow + C_KA + 8 * lane) = PACK8(v); }
    { v4u w = *(const v4u*)(Prow + C_QI + 8 * lane); float v[8]; UNPACK8(w, v);
      ROPE8(v, sub, c8, s8);
      *(v4u*)(Prow + C_QI + 8 * lane) = PACK8(v); }
    { v4u w = (v4u){0u, 0u, 0u, 0u}; if (lane < 8) w = *(const v4u*)(Prow + C_KI + 8 * lane); float v[8]; UNPACK8(w, v);
      ROPE8(v, sub, c8, s8);
      if (lane < 8) *(v4u*)(Prow + C_KI + 8 * lane) = PACK8(v); }
    if (lane < 8) WIrow[lane] = bf1(Prow[C_WI + lane]) * SCALE_I;
    { v4u w = (v4u){0u, 0u, 0u, 0u}; if (lane < 48) w = *(const v4u*)(Prow + C_CQ + 8 * lane); float v[8]; UNPACK8(w, v); float ss = 0.f;
#pragma unroll
      for (int j = 0; j < 8; ++j) ss += v[j] * v[j];
      ss = wave_sum(ss); const float rstd = 1.0f / sqrtf(ss * (1.f / 384.f) + EPS);
      if (lane < 48) {
#pragma unroll
          for (int j = 0; j < 8; ++j) v[j] = v[j] * rstd * gcq[8 * lane + j];
          *(v4u*)(Prow + C_CQ + 8 * lane) = PACK8(v); } }
    { v4u w = (v4u){0u, 0u, 0u, 0u}; if (lane < 32) w = *(const v4u*)(Prow + C_CKV + 8 * lane); float v[8]; UNPACK8(w, v); float ss = 0.f;
#pragma unroll
      for (int j = 0; j < 8; ++j) ss += v[j] * v[j];
      ss = wave_sum(ss); const float rstd = 1.0f / sqrtf(ss * (1.f / 256.f) + EPS);
      if (lane < 32) {
#pragma unroll
          for (int j = 0; j < 8; ++j) v[j] = v[j] * rstd * gckv[8 * lane + j];
          *(v4u*)(Prow + C_CKV + 8 * lane) = PACK8(v); } }
    { v4u w = *(const v4u*)(Prow + C_QM + 8 * lane); float v[8]; UNPACK8(w, v); float ss = 0.f;
#pragma unroll
      for (int j = 0; j < 8; ++j) ss += v[j] * v[j];
      ss += __shfl_xor(ss, 1); ss += __shfl_xor(ss, 2); ss += __shfl_xor(ss, 4); ss += __shfl_xor(ss, 8);
      const float rstd = 1.0f / sqrtf(ss * (1.f / 128.f) + EPS);
#pragma unroll
      for (int j = 0; j < 8; ++j) v[j] = v[j] * rstd * gqm[8 * (lane & 15) + j] * SCALE_M;
      *(v4u*)(Prow + C_QM + 8 * lane) = PACK8(v); }
}

__device__ __forceinline__ void km_row(bf16* row, const float* gkm, int lane) {
    v4u w = *(const v4u*)(row + 8 * lane); float v[8]; UNPACK8(w, v); float ss = 0.f;
#pragma unroll
    for (int j = 0; j < 8; ++j) ss += v[j] * v[j];
    ss += __shfl_xor(ss, 1); ss += __shfl_xor(ss, 2); ss += __shfl_xor(ss, 4); ss += __shfl_xor(ss, 8);
    const float rstd = 1.0f / sqrtf(ss * (1.f / 128.f) + EPS);
#pragma unroll
    for (int j = 0; j < 8; ++j) v[j] = v[j] * rstd * gkm[8 * (lane & 15) + j];
    *(v4u*)(row + 8 * lane) = PACK8(v);
}

__device__ __forceinline__ void transpose_v(const bf16* src, int pitch, int col0, int hstride, int H, int DV, int S, int nb, bf16* dst, int gw, int NGW, int lane) {
    const int ndq = DV / 64, nsc = S / 64, ntask = nb * H * nsc * ndq;
    for (int task = gw; task < ntask; task += NGW) {
        int x = task; const int dq = x % ndq; x /= ndq; const int sc = x % nsc; x /= nsc; const int h = x % H; const int b = x / H;
        const int s = sc * 64 + lane;
        const bf16* srow = src + (size_t)(b * S + s) * pitch + col0 + h * hstride + dq * 64;
        bf16* drow = dst + ((size_t)((b * H + h) * DV + dq * 64)) * S + s;
#pragma unroll
        for (int c = 0; c < 8; ++c) { const v4u w = *(const v4u*)(srow + 8 * c);
            drow[(size_t)(8 * c + 0) * S] = (bf16)(w.x & 0xffffu); drow[(size_t)(8 * c + 1) * S] = (bf16)(w.x >> 16);
            drow[(size_t)(8 * c + 2) * S] = (bf16)(w.y & 0xffffu); drow[(size_t)(8 * c + 3) * S] = (bf16)(w.y >> 16);
            drow[(size_t)(8 * c + 4) * S] = (bf16)(w.z & 0xffffu); drow[(size_t)(8 * c + 5) * S] = (bf16)(w.z >> 16);
            drow[(size_t)(8 * c + 6) * S] = (bf16)(w.w & 0xffffu); drow[(size_t)(8 * c + 7) * S] = (bf16)(w.w >> 16); }
    }
}

template <int MODE>
__device__ __forceinline__ void post2_row(bf16* QBrow, const bf16* KVBrow, const bf16* Prow, bf16* KBrow, const float* rb, const float* g, LAS float* scr, int lane) {
    const int hd = lane >> 3, d0 = 12 * (lane & 7);
    float v[12];
    if (MODE == 0) {
        const v2u* p = (const v2u*)(QBrow + 12 * lane);
#pragma unroll
        for (int i = 0; i < 3; ++i) { const v2u w = p[i]; v[4 * i] = bflo(w.x); v[4 * i + 1] = bfhi(w.x); v[4 * i + 2] = bflo(w.y); v[4 * i + 3] = bfhi(w.y); }
    } else {
#pragma unroll
        for (int e = 0; e < 12; ++e) { const int d = d0 + e; v[e] = d < 64 ? bf1(KVBrow[hd * 128 + d]) : bf1(Prow[C_KR + d - 64]); }
    }
    float ss = 0.f;
#pragma unroll
    for (int e = 0; e < 12; ++e) ss += v[e] * v[e];
    ss += __shfl_xor(ss, 1); ss += __shfl_xor(ss, 2); ss += __shfl_xor(ss, 4);
    const float rstd = 1.0f / sqrtf(ss * (1.f / 96.f) + EPS);
#pragma unroll
    for (int e = 0; e < 12; ++e) { v[e] = v[e] * rstd * g[d0 + e]; scr[12 * lane + e] = v[e]; }
    LDS_WAIT(); asm volatile("" ::: "memory");
    float o[12];
#pragma unroll
    for (int e = 0; e < 12; ++e) { const int d = d0 + e;
        if (d < 64) o[e] = v[e];
        else { const int i = (d - 64) & 15; const bool first = d < 80; const float pv = scr[12 * lane + e + (first ? 16 : -16)];
               const float cc = rb[i], sn = rb[16 + i]; o[e] = first ? v[e] * cc - pv * sn : v[e] * cc + pv * sn; }
        if (MODE == 0) o[e] *= SCALE_B; }
    LDS_WAIT(); asm volatile("" ::: "memory");
    v2u* q = (v2u*)((MODE == 0 ? QBrow : KBrow) + 12 * lane);
#pragma unroll
    for (int i = 0; i < 3; ++i) { v2u w; w.x = pk2(o[4 * i], o[4 * i + 1]); w.y = pk2(o[4 * i + 2], o[4 * i + 3]); q[i] = w; }
}

__device__ __forceinline__ int next_unit(unsigned* ctr, volatile LAS int* slot) {
    __syncthreads();
    if (threadIdx.x == 0) *slot = (int)atomicAdd(ctr, 1u);
    __syncthreads();
    return *slot;
}

constexpr int SCP = 2052;
__device__ __forceinline__ unsigned ord_key(float v) { const unsigned b = __float_as_uint(v); return b ^ ((unsigned)((int)b >> 31) | 0x80000000u); }
__device__ __forceinline__ void indexer_unit(LAS float* sc, const bf16* P, const float* WI, unsigned* MASK, int bb, int tb) {
    int tid_ = threadIdx.x; asm volatile("" : "+v"(tid_));
    const int tid = tid_, lane = tid & 63, w = __builtin_amdgcn_readfirstlane(tid >> 6);
    const int n = lane & 15, g = lane >> 4;
    const int rowbase = bb * SEQ, t0 = tb * 16;
    {
        bf16x8 qf[8][2]; float wq[8];
        const bf16* qrow = P + (size_t)(rowbase + t0 + n) * NP + C_QI + 8 * g;
#pragma unroll
        for (int h = 0; h < 8; ++h) {
            qf[h][0] = *(const bf16x8*)(qrow + h * 64);
            qf[h][1] = *(const bf16x8*)(qrow + h * 64 + 32);
            wq[h] = WI[(size_t)(rowbase + t0 + n) * 8 + h];
        }
        const int ntile = tb + 1;
        for (int tile = w; tile < ntile; tile += 8) {
            const bf16* krow = P + (size_t)(rowbase + 16 * tile + n) * NP + C_KI + 8 * g;
            const bf16x8 k0 = *(const bf16x8*)(krow), k1 = *(const bf16x8*)(krow + 32);
            f32x4 idx = (f32x4){0.f, 0.f, 0.f, 0.f};
#pragma unroll
            for (int h = 0; h < 8; ++h) {
                f32x4 a = (f32x4){0.f, 0.f, 0.f, 0.f};
                a = __builtin_amdgcn_mfma_f32_16x16x32_bf16(k0, qf[h][0], a, 0, 0, 0);
                a = __builtin_amdgcn_mfma_f32_16x16x32_bf16(k1, qf[h][1], a, 0, 0, 0);
#pragma unroll
                for (int i = 0; i < 4; ++i) idx[i] = __builtin_fmaf(wq[h], __builtin_fmaxf(a[i], 0.f), idx[i]);
            }
            *(LAS f32x4*)(sc + n * SCP + 16 * tile + 4 * g) = idx;
        }
    }
    __syncthreads();
    for (int qq = 0; qq < 2; ++qq) {
        const int q = 2 * w + qq, t = t0 + q;
        unsigned* mrow = MASK + (size_t)(rowbase + t) * 64;
        if (t < 256) {
            unsigned word;
            if (32 * lane + 31 <= t) word = 0xffffffffu; else if (32 * lane > t) word = 0u; else word = (1u << (t - 32 * lane + 1)) - 1u;
            mrow[lane] = word;
        } else {
            unsigned u[32];
            const LAS float* srow = sc + q * SCP;
#pragma unroll
            for (int r = 0; r < 32; ++r) { const int key = 64 * r + lane; u[r] = 0u; if (64 * r <= t) { const float v = srow[key]; u[r] = key <= t ? ord_key(v) : 0u; } }
            unsigned Pv = 0u; bool exact = false;
#pragma unroll 1
            for (int bit = 31; bit >= 0; --bit) {
                const unsigned cand = Pv | (1u << bit);
                int cnt = 0;
#pragma unroll
                for (int r = 0; r < 32; ++r) { cnt += __popcll(__ballot(u[r] >= cand)); if ((r & 3) == 3) __builtin_amdgcn_sched_barrier(0); }
                if (cnt >= 256) Pv = cand;
                if (cnt == 256) { exact = true; break; }
            }
            const unsigned Pg = exact ? Pv - 1u : Pv;
            int cgt = 0;
#pragma unroll
            for (int r = 0; r < 32; ++r) { cgt += __popcll(__ballot(u[r] > Pg)); if ((r & 3) == 3) __builtin_amdgcn_sched_barrier(0); }
            int need = exact ? 0 : 256 - cgt;
            unsigned long long mine = 0ull;
#pragma unroll
            for (int r = 0; r < 32; ++r) {
                unsigned long long sel = __ballot(u[r] > Pg);
                if (need > 0) {
                    unsigned long long eq = __ballot(u[r] == Pv);
                    const int c = __popcll(eq);
                    if (c <= need) { sel |= eq; need -= c; }
                    else { while (need > 0) { const unsigned long long low = eq & (~eq + 1ull); sel |= low; eq ^= low; --need; } }
                }
                if (lane == r) mine = sel;
                __builtin_amdgcn_sched_barrier(0);
            }
            if (lane < 32) ((unsigned long long*)mrow)[lane] = mine;
        }
    }
    __syncthreads();
}

__device__ __forceinline__ int crow(int r, int hi) { return (r & 3) + 8 * (r >> 2) + 4 * hi; }
template <int DQK, int DV, int MODE>
__device__ __forceinline__ void attn_unit(LAS unsigned char* lds, const bf16* Qb, int qpitch, const bf16* Kb, int kpitch, const bf16* VTb, int skv,
                                          const unsigned* maskb, const bf16* Zb, bf16* Ob, int q0) {
    constexpr int KP = DQK + 8, VP = 72;
    LAS bf16* Ks = (LAS bf16*)lds; LAS bf16* Vs = Ks + 64 * KP;
    constexpr int CPR = DQK / 8;
    constexpr int NCK = 64 * CPR, NCV = DV * 8;
    constexpr int RK = (NCK + 511) / 512, RV = (NCV + 511) / 512;
    constexpr int NKS = DQK / 16, NMT = DV / 32;
    int tid_ = threadIdx.x; asm volatile("" : "+v"(tid_));
    const int tid = tid_, lane = tid & 63, w = __builtin_amdgcn_readfirstlane(tid >> 6), r = lane & 31, hh = lane >> 5;
    const int NT = MODE == 0 ? skv / 64 : (q0 + 256) / 64;
    const int qlo = q0 + 32 * w;
    bf16x8 qf[NKS];
    { const bf16* qrow = Qb + (size_t)(qlo + r) * qpitch + 8 * hh;
#pragma unroll
      for (int ks = 0; ks < NKS; ++ks) qf[ks] = *(const bf16x8*)(qrow + 16 * ks); }
    f32x16 o[NMT];
#pragma unroll
    for (int mt = 0; mt < NMT; ++mt)
#pragma unroll
        for (int i = 0; i < 16; ++i) o[mt][i] = 0.f;
    float m_run = NEGF, l_run = 0.f;
    v4u kreg[RK], vreg[RV];
#define ATT_PREFETCH(tile_) do { \
        _Pragma("unroll") for (int i_ = 0; i_ < RK; ++i_) { const int c_ = tid + 512 * i_; if (c_ < NCK) { const int row_ = c_ / CPR, cc_ = c_ % CPR; kreg[i_] = *(const v4u*)(Kb + (size_t)(64 * (tile_) + row_) * kpitch + 8 * cc_); } } \
        _Pragma("unroll") for (int i_ = 0; i_ < RV; ++i_) { const int c_ = tid + 512 * i_; if (c_ < NCV) { const int d_ = c_ >> 3, cc_ = c_ & 7; vreg[i_] = *(const v4u*)(VTb + (size_t)d_ * skv + 64 * (tile_) + 8 * cc_); } } } while (0)
    ATT_PREFETCH(0);
    for (int tile = 0; tile < NT; ++tile) {
        __syncthreads();
#pragma unroll
        for (int i = 0; i < RK; ++i) { const int c = tid + 512 * i; if (c < NCK) { const int row = c / CPR, cc = c % CPR; *(LAS v4u*)(Ks + row * KP + 8 * cc) = kreg[i]; } }
#pragma unroll
        for (int i = 0; i < RV; ++i) { const int c = tid + 512 * i; if (c < NCV) { const int d = c >> 3, cc = c & 7; *(LAS v4u*)(Vs + d * VP + 8 * cc) = vreg[i]; } }
        __syncthreads();
        if (tile + 1 < NT) ATT_PREFETCH(tile + 1);
        if (MODE != 0 && 64 * tile > qlo + 31) continue;
        unsigned mw0 = 0u, mw1 = 0u;
        if (MODE == 2) { const v2u mm = *(const v2u*)(maskb + (size_t)(qlo + r) * 64 + 2 * tile); mw0 = mm.x >> (4 * hh); mw1 = mm.y >> (4 * hh); }
        f32x16 s0, s1;
#pragma unroll
        for (int i = 0; i < 16; ++i) { s0[i] = 0.f; s1[i] = 0.f; }
#pragma unroll
        for (int ks = 0; ks < NKS; ++ks) {
            const bf16x8 a0 = *(const LAS bf16x8*)(Ks + r * KP + 16 * ks + 8 * hh);
            const bf16x8 a1 = *(const LAS bf16x8*)(Ks + (32 + r) * KP + 16 * ks + 8 * hh);
            s0 = __builtin_amdgcn_mfma_f32_32x32x16_bf16(a0, qf[ks], s0, 0, 0, 0);
            s1 = __builtin_amdgcn_mfma_f32_32x32x16_bf16(a1, qf[ks], s1, 0, 0, 0);
        }
        if (MODE == 1) {
            if (64 * tile + 63 > qlo) { const int qg = qlo + r;
#pragma unroll
                for (int i = 0; i < 16; ++i) { const int key = 64 * tile + crow(i, hh); if (key > qg) s0[i] = NEGF; if (key + 32 > qg) s1[i] = NEGF; } }
        }
        if (MODE == 2) {
#pragma unroll
            for (int i = 0; i < 16; ++i) { const int bit = (i & 3) + 8 * (i >> 2); if (!((mw0 >> bit) & 1u)) s0[i] = NEGF; if (!((mw1 >> bit) & 1u)) s1[i] = NEGF; }
        }
        float mx = s0[0];
#pragma unroll
        for (int i = 1; i < 16; ++i) mx = __builtin_fmaxf(mx, s0[i]);
#pragma unroll
        for (int i = 0; i < 16; ++i) mx = __builtin_fmaxf(mx, s1[i]);
        mx = __builtin_fmaxf(mx, __shfl_xor(mx, 32));
        const float m_new = __builtin_fmaxf(m_run, mx);
        const float alpha = __builtin_amdgcn_exp2f(m_run - m_new);
        m_run = m_new;
        float ls = 0.f;
#pragma unroll
        for (int i = 0; i < 16; ++i) { s0[i] = __builtin_amdgcn_exp2f(s0[i] - m_new); s1[i] = __builtin_amdgcn_exp2f(s1[i] - m_new); ls += s0[i] + s1[i]; }
        l_run = l_run * alpha + ls;
#pragma unroll
        for (int mt = 0; mt < NMT; ++mt)
#pragma unroll
            for (int i = 0; i < 16; ++i) o[mt][i] *= alpha;
        v4u pf[2][2];
#pragma unroll
        for (int s = 0; s < 2; ++s) {
            pf[0][s] = (v4u){pk2(s0[8 * s], s0[8 * s + 1]), pk2(s0[8 * s + 2], s0[8 * s + 3]), pk2(s0[8 * s + 4], s0[8 * s + 5]), pk2(s0[8 * s + 6], s0[8 * s + 7])};
            pf[1][s] = (v4u){pk2(s1[8 * s], s1[8 * s + 1]), pk2(s1[8 * s + 2], s1[8 * s + 3]), pk2(s1[8 * s + 4], s1[8 * s + 5]), pk2(s1[8 * s + 6], s1[8 * s + 7])};
        }
#pragma unroll
        for (int mt = 0; mt < NMT; ++mt)
#pragma unroll
            for (int p = 0; p < 2; ++p)
#pragma unroll
                for (int s = 0; s < 2; ++s) {
                    const LAS bf16* vp = Vs + (32 * mt + r) * VP + 32 * p + 16 * s + 4 * hh;
                    const s16x4 lo = *(const LAS s16x4*)(vp), hi = *(const LAS s16x4*)(vp + 8);
                    const bf16x8 a = (bf16x8){lo[0], lo[1], lo[2], lo[3], hi[0], hi[1], hi[2], hi[3]};
                    o[mt] = __builtin_amdgcn_mfma_f32_32x32x16_bf16(a, __builtin_bit_cast(bf16x8, pf[p][s]), o[mt], 0, 0, 0);
                }
    }
#undef ATT_PREFETCH
    const float l_tot = l_run + __shfl_xor(l_run, 32);
    const float inv = 1.0f / l_tot;
    const size_t row = (size_t)(qlo + r);
#pragma unroll
    for (int mt = 0; mt < NMT; ++mt)
#pragma unroll
        for (int g4 = 0; g4 < 4; ++g4) {
            const int d = 32 * mt + 8 * g4 + 4 * hh;
            const v2u zw = *(const v2u*)(Zb + row * NP + d);
            float z[4] = {bflo(zw.x), bfhi(zw.x), bflo(zw.y), bfhi(zw.y)}, ov[4];
#pragma unroll
            for (int i = 0; i < 4; ++i) { const float sl = z[i] / (1.0f + __expf(-z[i])); ov[i] = o[mt][4 * g4 + i] * inv * sl; }
            v2u ow; ow.x = pk2(ov[0], ov[1]); ow.y = pk2(ov[2], ov[3]);
            *(v2u*)(Ob + row * 512 + d) = ow;
        }
}

struct EpiMerge {
    static constexpr bool PERM = true, AFTER_DRAIN = false;
    bf16* Mg; const bf16* P; int nbr;
    __device__ __forceinline__ void operator()(const pg8::f32x4 (&acc)[2][2][4][2], const pg8::Unit& u, int wr, int wc, int fr, int fq) const {
        const int row0 = u.pm * 256 + wr * 64 + fr, col0 = u.pn * 256 + wc * 32 + 8 * fq;
#pragma unroll
        for (int ai = 0; ai < 2; ++ai)
#pragma unroll
            for (int m = 0; m < 4; ++m) { const size_t row = (size_t)(row0 + ai * 128 + m * 16);
#pragma unroll
                for (int bj = 0; bj < 2; ++bj) { const int col = col0 + bj * 128;
                    const v4u gwd = *(const v4u*)(P + row * NP + C_GL + nbr * 1024 + col);
                    float gl[8]; UNPACK8(gwd, gl);
                    const pg8::f32x4 v0 = acc[ai][bj][m][0], v1 = acc[ai][bj][m][1];
                    float rr[8] = {v0[0], v0[1], v0[2], v0[3], v1[0], v1[1], v1[2], v1[3]};
#pragma unroll
                    for (int e = 0; e < 8; ++e) rr[e] *= 1.0f / (1.0f + __expf(-gl[e]));
                    bf16* dst = Mg + row * 1024 + col;
                    if (nbr > 0) { const v4u old = *(const v4u*)dst; float ol[8]; UNPACK8(old, ol);
#pragma unroll
                        for (int e = 0; e < 8; ++e) rr[e] += ol[e]; }
                    *(v4u*)dst = PACK8(rr); } }
    }
};
struct EpiOut {
    static constexpr bool PERM = true, AFTER_DRAIN = false;
    const float* X; float* Out;
    __device__ __forceinline__ void operator()(const pg8::f32x4 (&acc)[2][2][4][2], const pg8::Unit& u, int wr, int wc, int fr, int fq) const {
        const int row0 = u.pm * 256 + wr * 64 + fr, col0 = u.pn * 256 + wc * 32 + 8 * fq;
#pragma unroll
        for (int ai = 0; ai < 2; ++ai)
#pragma unroll
            for (int m = 0; m < 4; ++m) { const size_t row = (size_t)(row0 + ai * 128 + m * 16);
#pragma unroll
                for (int bj = 0; bj < 2; ++bj) { const size_t p = row * 1024 + col0 + bj * 128;
                    const f32x4 x0 = *(const f32x4*)(X + p), x1 = *(const f32x4*)(X + p + 4);
                    const pg8::f32x4 a0 = acc[ai][bj][m][0], a1 = acc[ai][bj][m][1];
                    *(f32x4*)(Out + p) = (f32x4){x0[0] + a0[0], x0[1] + a0[1], x0[2] + a0[2], x0[3] + a0[3]};
                    *(f32x4*)(Out + p + 4) = (f32x4){x1[0] + a1[0], x1[1] + a1[1], x1[2] + a1[2], x1[3] + a1[3]}; } }
    }
};

#define XB_TMO      128
#define XB_XCNT(j)  (256  + 64 * (j))
#define XB_XSUB(j)  (1280 + 64 * (j))
#define XB_XGEN(j)  (2304 + 64 * (j))
#define XB_TOP      3328
#define XB_TOPGEN   3392
#define XCD_BAR_WORDS 3456
#define XB_SPIN_CAP (1u << 18)

__device__ __forceinline__ unsigned xb_ld(unsigned* p)              { return __hip_atomic_load(p, __ATOMIC_RELAXED, __HIP_MEMORY_SCOPE_AGENT); }
__device__ __forceinline__ unsigned xb_add(unsigned* p, unsigned v) { return __hip_atomic_fetch_add(p, v, __ATOMIC_RELAXED, __HIP_MEMORY_SCOPE_AGENT); }
__device__ __forceinline__ unsigned xb_xcc_id() { return (unsigned)__builtin_amdgcn_s_getreg((3 << 11) | 20) & 0xFu; }
#define XB_SPIN(cond, bar) do { unsigned _sp = 0; while (cond) { __builtin_amdgcn_s_sleep(1); \
    if ((++_sp & 255u) == 0u) { if (xb_ld(&(bar)[XB_TMO])) break; if (_sp > XB_SPIN_CAP) { atomicAdd(&(bar)[XB_TMO], 1u); break; } } } } while (0)

struct XcdBarrier {
    unsigned* bar; unsigned x;
    volatile LAS unsigned* st;
};

__device__ __forceinline__ XcdBarrier xcd_barrier_post(unsigned* bar, volatile LAS unsigned* st) {
    XcdBarrier b; b.bar = bar; b.x = xb_xcc_id(); b.st = st;
    if (threadIdx.x == 0) (void)xb_add(&bar[XB_XCNT(b.x)], 1u);
    return b;
}
__device__ __forceinline__ void xcd_barrier_complete(unsigned* bar, unsigned x, unsigned& nloc, unsigned& nx) {
    const unsigned G = gridDim.x * gridDim.y * gridDim.z;
    unsigned sum, cnt, mine, sp = 0u;
    for (;;) {
        sum = 0u; cnt = 0u; mine = 0u;
#pragma unroll
        for (unsigned j = 0; j < 16; ++j) { const unsigned c = xb_ld(&bar[XB_XCNT(j)]); sum += c; cnt += (c > 0u) ? 1u : 0u; mine = (j == x) ? c : mine; }
        if (sum == G) break;
        __builtin_amdgcn_s_sleep(1);
        if ((++sp & 255u) == 0u) { if (xb_ld(&bar[XB_TMO])) break; if (sp > XB_SPIN_CAP) { atomicAdd(&bar[XB_TMO], 1u); break; } }
    }
    nloc = mine > 0u ? mine : 1u; nx = cnt > 0u ? cnt : 1u;
}

__device__ __forceinline__ void xcd_barrier(const XcdBarrier& b) {
    asm volatile("s_waitcnt vmcnt(0)" ::: "memory");
    __syncthreads();
    if (threadIdx.x == 0) {
        unsigned* bar = b.bar;
        __builtin_amdgcn_s_waitcnt(0);
        unsigned nloc = b.st[0], nx = b.st[1];
        if (nloc == 0u) { xcd_barrier_complete(bar, b.x, nloc, nx); b.st[0] = nloc; b.st[1] = nx; }
        const unsigned old = xb_add(&bar[XB_XSUB(b.x)], 1u);
        const unsigned gen = old / nloc;
        if (old + 1u == (gen + 1u) * nloc) {
            __builtin_amdgcn_fence(__ATOMIC_RELEASE, "agent");
            asm volatile("s_waitcnt vmcnt(0)" ::: "memory");
            const unsigned og = xb_add(&bar[XB_TOP], 1u);
            const unsigned tg = og / nx;
            if (og + 1u == (tg + 1u) * nx) xb_add(&bar[XB_TOPGEN], 1u);
            else XB_SPIN(xb_ld(&bar[XB_TOPGEN]) == tg, bar);
            __builtin_amdgcn_fence(__ATOMIC_ACQUIRE, "agent");
            xb_add(&bar[XB_XGEN(b.x)], 1u);
            asm volatile("s_waitcnt vmcnt(0)" ::: "memory");
        } else {
            XB_SPIN(xb_ld(&bar[XB_XGEN(b.x)]) == gen, bar);
            __builtin_amdgcn_fence(__ATOMIC_ACQUIRE, "agent");
            asm volatile("s_waitcnt vmcnt(0)" ::: "memory");
        }
    }
    __syncthreads();
}

struct Args { const float* in[19]; const int* pos; float* out; unsigned char* ws; };
typedef const __attribute__((address_space(4))) Args* kargs_t;
#define PHASE_BEGIN \
    kargs_t ap_ = (kargs_t)__builtin_amdgcn_kernarg_segment_ptr(); asm volatile("" : "+s"(ap_)); \
    int tid = threadIdx.x; asm volatile("" : "+v"(tid)); \
    const int lane = tid & 63, wave = __builtin_amdgcn_readfirstlane(tid >> 6), G = gridDim.x, NGW = G * 8, gw = blockIdx.x * 8 + wave; \
    const size_t tok0 = (size_t)half * TH; \
    unsigned char* const ws = ap_->ws; const int* const pos = ap_->pos; float* const outp = ap_->out; unsigned* const ctl = (unsigned*)(ws + WS_CTL); \
    const float* const x = ap_->in[0]; const float* const mem = ap_->in[1]; \
    const float* const g_norm = ap_->in[3]; const float* const w_in = ap_->in[4]; const float* const g_qn_a = ap_->in[5]; const float* const g_kn_a = ap_->in[6]; \
    const float* const g_cq = ap_->in[7]; const float* const g_ckv = ap_->in[8]; const float* const w_uq = ap_->in[9]; const float* const w_ukv = ap_->in[10]; \
    const float* const g_qn_b = ap_->in[11]; const float* const g_kn_b = ap_->in[12]; const float* const g_mem = ap_->in[13]; const float* const w_mem_kv = ap_->in[14]; \
    const float* const g_qn_m = ap_->in[15]; const float* const g_kn_m = ap_->in[16]; const float* const w_branch = ap_->in[17]; const float* const w_out = ap_->in[18]; \
    bf16* const WinT = (bf16*)(ws + WS_WIN); bf16* const WuqT = (bf16*)(ws + WS_WUQ); bf16* const WukvT = (bf16*)(ws + WS_WUKV); bf16* const WmemT = (bf16*)(ws + WS_WMEM); \
    bf16* const WbrT = (bf16*)(ws + WS_WBR); bf16* const WoutT = (bf16*)(ws + WS_WOUT); \
    float* const ropeA = (float*)(ws + WS_ROPEA); float* const ropeB = (float*)(ws + WS_ROPEB); \
    bf16* const MN = (bf16*)(ws + WS_MN); bf16* const KVM = (bf16*)(ws + WS_KVM); bf16* const VTM = (bf16*)(ws + WS_VTM); \
    float* const WI = (float*)(ws + WS_WI); unsigned* const MASK = (unsigned*)(ws + WS_MASK); \
    bf16* const VTA = (bf16*)(ws + WS_VTA); bf16* const VTB = (bf16*)(ws + WS_VTB); \
    bf16* const Hh = (bf16*)(ws + WS_H); bf16* const KB = (bf16*)(ws + WS_H); bf16* const QB = (bf16*)(ws + WS_QB); \
    bf16* const KVB = (bf16*)(ws + WS_KVB); bf16* const MG = (bf16*)(ws + WS_KVB); bf16* const YS = (bf16*)(ws + WS_YS); bf16* const P = (bf16*)(ws + WS_P); \
    (void)lane; (void)NGW; (void)gw; (void)tok0; (void)ctl; \
    (void)pos; (void)outp; (void)x; (void)mem; (void)g_norm; (void)w_in; (void)g_qn_a; (void)g_kn_a; (void)g_cq; (void)g_ckv; (void)w_uq; (void)w_ukv; (void)g_qn_b; (void)g_kn_b; (void)g_mem; (void)w_mem_kv; \
    (void)g_qn_m; (void)g_kn_m; (void)w_branch; (void)w_out; (void)WinT; (void)WuqT; (void)WukvT; (void)WmemT; (void)WbrT; (void)WoutT; (void)ropeA; (void)ropeB; (void)MN; (void)KVM; (void)VTM; (void)WI; (void)MASK; \
    (void)VTA; (void)VTB; (void)Hh; (void)KB; (void)QB; (void)KVB; (void)MG; (void)YS; (void)P
#define GRID_BARRIER() do { kargs_t bp_ = (kargs_t)__builtin_amdgcn_kernarg_segment_ptr(); asm volatile("" : "+s"(bp_)); \
    XcdBarrier b_; b_.bar = (unsigned*)(bp_->ws + WS_CTL) + 4096; b_.x = xb_xcc_id(); b_.st = (volatile LAS unsigned*)(lds + LDS_BYTES - 32); xcd_barrier(b_); } while (0)

__global__ void __launch_bounds__(512, 2) fwd_kernel(Args a) {
    extern __shared__ __attribute__((aligned(16))) unsigned char lds_raw[];
    LAS unsigned char* const lds = (LAS unsigned char*)lds_raw;
    volatile LAS int* const slot = (volatile LAS int*)(lds + LDS_SLOT);
    if (threadIdx.x < 16) ((LAS unsigned*)(lds + LDS_BYTES - 64))[threadIdx.x] = 0u;
    __syncthreads();
    (void)xcd_barrier_post((unsigned*)(a.ws + WS_CTL) + 4096, (volatile LAS unsigned*)(lds + LDS_BYTES - 32));

    for (int rep = 0; rep < REP_P0; ++rep) {
        const int half = 0; PHASE_BEGIN;
        LAS float* scr = (LAS float*)(lds + wave * 16384);
        constexpr int I_IN = 16 * (NP / 32), I_UQ = 6 * 24, I_UKV = 4 * 32, I_MEM = 16 * 32, I_BR = 8 * 32, I_OUT = 16 * 32;
        constexpr int NITEMS = I_IN + I_UQ + I_UKV + I_MEM + 3 * I_BR + I_OUT;
        for (int it = gw; it < NITEMS; it += NGW) {
            int r = it;
            if (r < I_IN) { transpose_item(w_in, 1024, DIN, NP, WinT, scr, r, lane); continue; } r -= I_IN;
            if (r < I_UQ) { transpose_item(w_uq, 384, 768, 768, WuqT, scr, r, lane); continue; } r -= I_UQ;
            if (r < I_UKV) { transpose_item(w_ukv, 256, 1024, 1024, WukvT, scr, r, lane); continue; } r -= I_UKV;
            if (r < I_MEM) { transpose_item(w_mem_kv, 1024, 1024, 1024, WmemT, scr, r, lane); continue; } r -= I_MEM;
            if (r < 3 * I_BR) { const int nb = r / I_BR; transpose_item(w_branch + (size_t)nb * 512 * 1024, 512, 1024, 1024, WbrT + (size_t)nb * 1024 * 512, scr, r % I_BR, lane); continue; } r -= 3 * I_BR;
            transpose_item(w_out, 1024, 1024, 1024, WoutT, scr, r, lane);
        }
        for (int idx = blockIdx.x * 512 + tid; idx < TT * 24; idx += G * 512) {
            const int t = idx / 24, i = idx % 24; const float pf = (float)pos[t];
            if (i < 8) { const float ang = pf * INVA[i]; ropeA[t * 16 + i] = cosf(ang); ropeA[t * 16 + 8 + i] = sinf(ang); }
            else { const int j = i - 8; const float ang = pf * INVB[j]; ropeB[t * 32 + j] = cosf(ang); ropeB[t * 32 + 16 + j] = sinf(ang); }
        }
        for (int m = gw; m < NB * MEML; m += NGW) rms_row_1024(mem + (size_t)m * DM, g_mem, MN + (size_t)m * DM, lane);
    }
    GRID_BARRIER();
    for (int es = 0; es < EXTRA_SYNCS; ++es) GRID_BARRIER();

#pragma unroll 1
    for (int half = 0; half < 2; ++half) {
        for (int rep = 0; rep < REP_PH; ++rep) { PHASE_BEGIN;
            for (int m = gw; m < TH; m += NGW) rms_row_1024(x + (tok0 + m) * DM, g_norm, Hh + (size_t)m * DM, lane); }
        GRID_BARRIER();
        for (int rep = 0; rep < REP_G1; ++rep) { PHASE_BEGIN;
            pg8::Gemm g{Hh, WinT, TH, NP, 1024, 1024}; pg8::StaticOrder S; S.init(TH, NP, G, (int)blockIdx.x);
            pg8::EpiBf16<0> E{P, NP, nullptr, 0, 0, 1.f};
            pg8::gemm_phase<pg8::EpiBf16<0>, pg8::StaticOrder, true, true>(lds, g, S, E);
        }
        if (half == 0) { PHASE_BEGIN;
            pg8::Gemm g{MN, WmemT, NB * MEML, 1024, 1024, 1024}; pg8::StaticOrder S; S.init(NB * MEML, 1024, G, (int)((blockIdx.x + 128) % G));
            pg8::EpiBf16<0> E{KVM, 1024, nullptr, 0, 0, 1.f};
            pg8::gemm_phase<pg8::EpiBf16<0>, pg8::StaticOrder, true, true>(lds, g, S, E);
        }
        GRID_BARRIER();
        { PHASE_BEGIN;
            for (int m = gw; m < TH; m += NGW)
                post1_row(P + (size_t)m * NP, ropeA + (tok0 + m) * 16, g_qn_a, g_kn_a, g_cq, g_ckv, g_qn_m, WI + (size_t)m * 8, lane);
            transpose_v(P, NP, C_VA, 64, 8, 64, SEQ, HB, VTA, gw, NGW, lane);
            if (half == 0) {
                for (int m = gw; m < NB * MEML; m += NGW) km_row(KVM + (size_t)m * 1024, g_kn_m, lane);
                transpose_v(KVM, 1024, 512, 128, 4, 128, MEML, NB, VTM, gw, NGW, lane);
            }
        }
        GRID_BARRIER();
        for (int rep = 0; rep < REP_G2; ++rep) { PHASE_BEGIN;
            pg8::Gemm g{P + C_CQ, WuqT, TH, 768, 384, NP}; pg8::StaticOrder S; S.init(TH, 768, G, (int)blockIdx.x);
            pg8::EpiBf16<0> E{QB, 768, nullptr, 0, 0, 1.f};
            pg8::gemm_phase<pg8::EpiBf16<0>, pg8::StaticOrder, true, true>(lds, g, S, E);
        }
        for (int rep = 0; rep < REP_G2; ++rep) { PHASE_BEGIN;
            pg8::Gemm g{P + C_CKV, WukvT, TH, 1024, 256, NP}; pg8::StaticOrder S; S.init(TH, 1024, G, (int)((blockIdx.x + 128) % G));
            pg8::EpiBf16<0> E{KVB, 1024, nullptr, 0, 0, 1.f};
            pg8::gemm_phase<pg8::EpiBf16<0>, pg8::StaticOrder, true, true>(lds, g, S, E);
        }
        for (int rep = 0; rep < REP_IDX; ++rep) { if (rep > 0) GRID_BARRIER();
            PHASE_BEGIN;
            unsigned* const q_idx = ctl + 64 * (2 * half + 8 * rep);
            for (;;) {
                const int u = next_unit(q_idx, slot);
                if (u >= HB * 128) break;
                const int tb = 127 - (u >> 2), bb = u & 3;
                indexer_unit((LAS float*)lds, P, WI, MASK, bb, tb);
            }
        }
        GRID_BARRIER();
        { PHASE_BEGIN;
            LAS float* scr = (LAS float*)(lds + wave * 4096);
            for (int m = gw; m < TH; m += NGW) {
                const float* rb = ropeB + (tok0 + m) * 32;
                post2_row<0>(QB + (size_t)m * 768, nullptr, nullptr, nullptr, rb, g_qn_b, scr, lane);
                post2_row<1>(nullptr, KVB + (size_t)m * 1024, P + (size_t)m * NP, KB + (size_t)m * 768, rb, g_kn_b, scr, lane);
            }
            transpose_v(KVB, 1024, 64, 128, 8, 64, SEQ, HB, VTB, gw, NGW, lane);
        }
        GRID_BARRIER();
        for (int rep = 0; rep < REP_ATT; ++rep) { if (rep > 0) GRID_BARRIER();
            PHASE_BEGIN;
            unsigned* const q_att = ctl + 64 * (2 * half + 1 + 8 * rep);
            for (;;) {
                const int u = next_unit(q_att, slot);
                if (u >= 768) break;
                if (u < 512) {
                    const int qb = 7 - (u >> 6), wi = u & 63, bh = wi & 31, bb = bh >> 3, h = bh & 7;
                    const size_t r0 = (size_t)bb * SEQ;
                    if (wi < 32) attn_unit<96, 64, 1>(lds, QB + r0 * 768 + h * 96, 768, KB + r0 * 768 + h * 96, 768, VTB + (size_t)((bb * 8 + h) * 64) * SEQ, SEQ, nullptr,
                                                      P + r0 * NP + C_ZB + h * 64, YS + (size_t)1 * TH * 512 + r0 * 512 + h * 64, qb * 256);
                    else attn_unit<64, 64, 2>(lds, P + r0 * NP + C_QA + h * 64, NP, P + r0 * NP + C_KA + h * 64, NP, VTA + (size_t)((bb * 8 + h) * 64) * SEQ, SEQ, MASK + r0 * 64,
                                              P + r0 * NP + C_ZA + h * 64, YS + r0 * 512 + h * 64, qb * 256);
                } else {
                    const int v = u - 512, vh = v & 1, qb = (v >> 1) & 7, bh = v >> 4, bb = bh >> 2, h = bh & 3, gb = half * HB + bb;
                    const size_t r0 = (size_t)bb * SEQ;
                    attn_unit<128, 64, 0>(lds, P + r0 * NP + C_QM + h * 128, NP, KVM + (size_t)gb * MEML * 1024 + h * 128, 1024, VTM + (size_t)((gb * 4 + h) * 128 + vh * 64) * MEML, MEML, nullptr,
                                          P + r0 * NP + C_ZM + h * 128 + vh * 64, YS + (size_t)2 * TH * 512 + r0 * 512 + h * 128 + vh * 64, qb * 256);
                }
            }
        }
        GRID_BARRIER();
        for (int nbr = 0; nbr < 3 * REP_G4; ++nbr) { const int nb = nbr % 3; PHASE_BEGIN;
            pg8::Gemm g{YS + (size_t)nb * TH * 512, WbrT + (size_t)nb * 1024 * 512, TH, 1024, 512, 512}; pg8::StaticOrder S; S.init(TH, 1024, G, (int)blockIdx.x);
            EpiMerge E{MG, P, nb};
            pg8::gemm_phase<EpiMerge, pg8::StaticOrder, true, true>(lds, g, S, E);
        }
        GRID_BARRIER();
        for (int rep = 0; rep < REP_G5; ++rep) { PHASE_BEGIN;
            pg8::Gemm g{MG, WoutT, TH, 1024, 1024, 1024}; pg8::StaticOrder S; S.init(TH, 1024, G, (int)blockIdx.x);
            EpiOut E{x + tok0 * DM, outp + tok0 * DM};
            pg8::gemm_phase<EpiOut, pg8::StaticOrder, true, true>(lds, g, S, E);
        }
        GRID_BARRIER();
    }
}

extern "C" void kernel_launch(void* const* d_in, const int* in_sizes, int n_in, void* d_out, int out_size, void* d_ws, size_t ws_size, hipStream_t stream) {
    static int grid = 0;
    if (grid == 0) {
        if (n_in != 19 || out_size != TT * DM || ws_size < WS_END) { fprintf(stderr, "kernel_launch: unexpected problem (n_in %d, out %d, ws %zu); nothing launched\n", n_in, out_size, ws_size); grid = -1; return; }
        int dev = 0, cus = 0, per_cu = 0;
        if (hipGetDevice(&dev) != hipSuccess || hipDeviceGetAttribute(&cus, hipDeviceAttributeMultiprocessorCount, dev) != hipSuccess) { grid = -1; return; }
        if (hipFuncSetAttribute((const void*)fwd_kernel, hipFuncAttributeMaxDynamicSharedMemorySize, LDS_BYTES) != hipSuccess) { fprintf(stderr, "kernel_launch: hipFuncSetAttribute failed\n"); grid = -1; return; }
        if (hipOccupancyMaxActiveBlocksPerMultiprocessor(&per_cu, (const void*)fwd_kernel, 512, LDS_BYTES) != hipSuccess || per_cu < 1) { fprintf(stderr, "kernel_launch: occupancy query reports %d blocks per CU\n", per_cu); (void)hipGetLastError(); grid = -1; return; }
        grid = cus;
    }
    if (grid < 0) return;
    (void)hipMemsetAsync((char*)d_ws + WS_CTL, 0, 65536, stream);
    Args a{};
    for (int i = 0; i < 19; ++i) a.in[i] = (const float*)d_in[i];
    a.pos = (const int*)d_in[2]; a.out = (float*)d_out; a.ws = (unsigned char*)d_ws;
    hipLaunchKernelGGL(fwd_kernel, dim3(grid), dim3(512), LDS_BYTES, stream, a);
    const hipError_t e = hipPeekAtLastError();
    if (e != hipSuccess) fprintf(stderr, "kernel_launch: launch failed: %s (grid %d)\n", hipGetErrorString(e), grid);
}
```

```cpp
#include <hip/hip_runtime.h>
#include <cstdio>
#include <cstdint>
namespace pg8 {
#define PG8_LAS __attribute__((address_space(3)))
typedef unsigned short bf16_t;
typedef short bf16x8 __attribute__((ext_vector_type(8)));
typedef float f32x4 __attribute__((ext_vector_type(4)));
typedef unsigned u32x4 __attribute__((ext_vector_type(4)));
constexpr int BM = 256, BK = 64, HALF = 128, HTB = HALF * BK * 2  , STAGE_BYTES = 8 * HTB, NXCD = 8, WGM = 8;

__host__ __device__ __forceinline__ int lds_byte(int r, int c) { const int st = (r >> 4) * 2 + (c >> 5), rr = r & 15, cc = c & 31, ob = rr * 64 + cc * 2; return st * 1024 + (ob ^ (((ob >> 9) & 1) << 5)); }
__host__ __device__ __forceinline__ void stage_rc(int b, int& R, int& C) { const int st = b / 1024, sb = b % 1024, swz = sb ^ (((sb >> 9) & 1) << 5); R = (st >> 1) * 16 + swz / 64; C = (st & 1) * 32 + (swz % 64) / 2; }
__host__ __device__ __forceinline__ int perm32(int rho) { const int n = rho >> 4, i = rho & 15; return 8 * (i >> 2) + 4 * n + (i & 3); }

struct Unit { int pm, pn; };
struct Gemm { const bf16_t* A; const bf16_t* Bt; int M, N, K, lda; };

struct StaticOrder {
    int nM, nN, nwg, G, c;
    __host__ __device__ void init(int M, int N, int G_, int c_) { nM = M / BM; nN = N / BM; nwg = nM * nN; G = G_; c = c_; }
    __host__ __device__ bool next(int i, Unit& u) const {
        const long L = (long)i * G + c; if (L >= nwg) return false;
        int wgid = (int)L; { const int q = nwg / NXCD, r = nwg % NXCD, xcd = wgid % NXCD, off = wgid / NXCD; wgid = (xcd < r ? xcd * (q + 1) : r * (q + 1) + (xcd - r) * q) + off; }
        const int nig = WGM * nN, gid = wgid / nig, fm = gid * WGM, gsz = (nM - fm) < WGM ? (nM - fm) : WGM;
        u.pm = fm + ((wgid % nig) % gsz); u.pn = (wgid % nig) / gsz; return true;
    }
    __device__ __forceinline__ void a_ready(const Unit&) const {}
    __device__ __forceinline__ void done(const Unit&) const {}
};

__device__ __forceinline__ unsigned cvt_pk_bf16(float lo, float hi) { unsigned r; asm volatile("v_cvt_pk_bf16_f32 %0, %1, %2" : "=v"(r) : "v"(lo), "v"(hi)); return r; }
typedef float f32x2 __attribute__((ext_vector_type(2)));
__device__ __forceinline__ f32x2 gelu_pk(f32x2 v) {
    const f32x2 av = __builtin_elementwise_abs(v), d = av * 0.2316418882f + 1.0f;
    f32x2 t; t.x = __builtin_amdgcn_rcpf(d.x); t.y = __builtin_amdgcn_rcpf(d.y);
    f32x2 q = t * 0.5307027145f + (-0.7265760135f); q = q * t + 0.7107068705f; q = q * t + (-0.142248368f); q = q * t + 0.127414796f; q = q * t;
    const f32x2 s = (v * v) * (-0.72134752044f);
    f32x2 e; e.x = __builtin_amdgcn_exp2f(s.x); e.y = __builtin_amdgcn_exp2f(s.y);
    const f32x2 m = v * (q * e), r = v - m;
    f32x2 o; o.x = v.x < 0.f ? m.x : r.x; o.y = v.y < 0.f ? m.y : r.y; return o;
}

template <int ACT  > struct EpiBf16 {
    static constexpr bool PERM = true, AFTER_DRAIN = false; static_assert(ACT == 0 || ACT == 1, "EpiBf16: ACT is 0 (none) or 1 (gelu_pk)");
    bf16_t* O; int ldc; const float* bias; int split_cols; size_t split_stride; float scale0;
    __device__ __forceinline__ void operator()(const f32x4 (&acc)[2][2][4][2], const Unit& u, int wr, int wc, int fr, int fq) const {
        const int row0 = u.pm * BM + wr * 64 + fr; int colt = u.pn * BM; bf16_t* base = O;
        float sc = 1.f; if (split_cols) { const int t = colt / split_cols; base += (size_t)t * split_stride; colt -= t * split_cols; if (t == 0) sc = scale0; }
        const int col0 = colt + wc * 32 + 8 * fq, bcol0 = u.pn * BM + wc * 32 + 8 * fq;
        f32x4 bv[2][2];
#pragma unroll
        for (int bj = 0; bj < 2; ++bj)
#pragma unroll
            for (int n = 0; n < 2; ++n) bv[bj][n] = bias ? *(const f32x4*)(bias + bcol0 + bj * HALF + 4 * n) : (f32x4){0.f, 0.f, 0.f, 0.f};
#pragma unroll
        for (int ai = 0; ai < 2; ++ai)
#pragma unroll
            for (int m = 0; m < 4; ++m) { bf16_t* rowp = base + (size_t)(row0 + ai * HALF + m * 16) * ldc + col0;
#pragma unroll
                for (int bj = 0; bj < 2; ++bj) { f32x4 v0 = acc[ai][bj][m][0] + bv[bj][0], v1 = acc[ai][bj][m][1] + bv[bj][1];
                    if (ACT == 1) { f32x2 a = gelu_pk((f32x2){v0[0], v0[1]}), b = gelu_pk((f32x2){v0[2], v0[3]}), c = gelu_pk((f32x2){v1[0], v1[1]}), d = gelu_pk((f32x2){v1[2], v1[3]});
                        v0 = (f32x4){a.x, a.y, b.x, b.y}; v1 = (f32x4){c.x, c.y, d.x, d.y}; }
                    v0 = v0 * sc; v1 = v1 * sc; u32x4 w; w.x = cvt_pk_bf16(v0[0], v0[1]); w.y = cvt_pk_bf16(v0[2], v0[3]); w.z = cvt_pk_bf16(v1[0], v1[1]); w.w = cvt_pk_bf16(v1[2], v1[3]);
                    *(u32x4*)(rowp + bj * HALF) = w; } }
    }
};
template <class Epi, class Sched, bool ALIGN_EPI = false, bool SP2 = false>
__device__ __forceinline__ void gemm_phase(PG8_LAS unsigned char* lds, const Gemm g, const Sched& S, const Epi& E) {
    int tid_ = threadIdx.x; asm volatile("" : "+v"(tid_));
    const int tid = tid_, wid = __builtin_amdgcn_readfirstlane(tid >> 6), lane = tid & 63, wr = wid >> 2, wc = wid & 3, fr = lane & 15, fq = lane >> 4;
    const int K = g.K, nt = K / BK;
    unsigned voffA[2], voffB[2];
#pragma unroll
    for (int i = 0; i < 2; ++i) { int R, C; stage_rc(tid * 16 + i * 8192, R, C); const int Rb = Epi::PERM ? ((R & ~31) + perm32(R & 31)) : R;
        voffA[i] = (unsigned)(R * g.lda + C) * 2u; voffB[i] = (unsigned)(Rb * K + C) * 2u; }
    const size_t kstep = (size_t)(BK * 2);
    const size_t hstepA = (size_t)HALF * g.lda * 2, hstepB = (size_t)HALF * K * 2;
    const size_t tstepA = 2 * hstepA, tstepB = 2 * hstepB;
    const unsigned ldsw = (unsigned)wid * 1024u;
    const int aoff = lds_byte(wr * 64 + fr, fq * 8), boff = lds_byte(wc * 32 + fr, fq * 8);
#define PG8_SA(b, h) (((b) * 2 + (h)) * HTB)
#define PG8_SB(b, h) ((4 + (b) * 2 + (h)) * HTB)
#define PG8_STAGE(bufoff, gbase, voff) do { _Pragma("unroll") for (int _i = 0; _i < 2; ++_i) \
        __builtin_amdgcn_global_load_lds((const unsigned*)((const char*)(gbase) + (voff)[_i]), (PG8_LAS unsigned*)(lds + (bufoff) + ldsw + _i * 8192), 16, 0, 0); } while (0)
#define PG8_LDA(dst, b, h) do { _Pragma("unroll") for (int m = 0; m < 4; ++m) _Pragma("unroll") for (int k = 0; k < 2; ++k) dst[m][k] = *(const PG8_LAS bf16x8*)(lds + PG8_SA(b, h) + aoff + m * 2048 + k * 1024); } while (0)
#define PG8_LDB(dst, b, h) do { _Pragma("unroll") for (int n = 0; n < 2; ++n) _Pragma("unroll") for (int k = 0; k < 2; ++k) dst[n][k] = *(const PG8_LAS bf16x8*)(lds + PG8_SB(b, h) + boff + n * 2048 + k * 1024); } while (0)
#define PG8_MMA(ai, bj, At, Bt) do { __builtin_amdgcn_s_setprio(1); _Pragma("unroll") for (int m = 0; m < 4; ++m) _Pragma("unroll") for (int n = 0; n < 2; ++n) _Pragma("unroll") for (int k = 0; k < 2; ++k) \
        acc[ai][bj][m][n] = __builtin_amdgcn_mfma_f32_16x16x32_bf16(Bt[n][k], At[m][k], acc[ai][bj][m][n], 0, 0, 0); __builtin_amdgcn_s_setprio(0); } while (0)
#define PG8_WAIT_V(n) asm volatile("s_waitcnt vmcnt(" #n ")" ::: "memory")
#define PG8_WAIT_L(n) asm volatile("s_waitcnt lgkmcnt(" #n ")" ::: "memory")
#define PG8_BAR __builtin_amdgcn_s_barrier()
#define PG8_SCHED __builtin_amdgcn_sched_barrier(0)
    Unit cur, nxt; int ui = 0;
    if (!S.next(0, cur)) return;
    f32x4 acc[2][2][4][2];
#pragma unroll
    for (int a = 0; a < 2; ++a)
#pragma unroll
        for (int b = 0; b < 2; ++b)
#pragma unroll
            for (int m = 0; m < 4; ++m)
#pragma unroll
                for (int n = 0; n < 2; ++n) acc[a][b][m][n] = (f32x4){0.f, 0.f, 0.f, 0.f};
    bf16x8 At[4][2], B0[2][2], B1[2][2];
    const char* cA = (const char*)g.A + (size_t)cur.pm * tstepA; const char* cB = (const char*)g.Bt + (size_t)cur.pn * tstepB;
    S.a_ready(cur);
    if constexpr (SP2) {
        PG8_STAGE(PG8_SB(0, 0), cB, voffB); PG8_STAGE(PG8_SB(0, 1), cB + hstepB, voffB); PG8_STAGE(PG8_SA(0, 0), cA, voffA); PG8_STAGE(PG8_SA(0, 1), cA + hstepA, voffA);
        if (wr == 1) PG8_BAR;
        PG8_WAIT_V(2); PG8_BAR;
        PG8_STAGE(PG8_SB(1, 0), cB + kstep, voffB); PG8_STAGE(PG8_SA(1, 0), cA + kstep, voffA); PG8_STAGE(PG8_SB(1, 1), cB + hstepB + kstep, voffB);
        PG8_WAIT_V(6); PG8_BAR;
    } else {
        PG8_STAGE(PG8_SB(0, 0), cB, voffB); PG8_STAGE(PG8_SA(0, 0), cA, voffA); PG8_STAGE(PG8_SB(0, 1), cB + hstepB, voffB); PG8_STAGE(PG8_SA(0, 1), cA + hstepA, voffA);
        if (wr == 1) PG8_BAR;
        PG8_WAIT_V(4); PG8_BAR;
        PG8_STAGE(PG8_SB(1, 0), cB + kstep, voffB); PG8_STAGE(PG8_SA(1, 0), cA + kstep, voffA); PG8_STAGE(PG8_SB(1, 1), cB + hstepB + kstep, voffB);
        PG8_WAIT_V(6); PG8_BAR;
    }
    for (;;) {
        const bool has_next = S.next(ui + 1, nxt);
        const char* nA = has_next ? (const char*)g.A + (size_t)nxt.pm * tstepA : cA; const char* nB = has_next ? (const char*)g.Bt + (size_t)nxt.pn * tstepB : cB;
        for (int t = 0; t < nt; t += 2) {
            const bool last = (t == nt - 2);
            const char* a1 = cA + (size_t)(t + 1) * kstep;
            const char* a2 = last ? nA : cA + (size_t)(t + 2) * kstep; const char* b2 = last ? nB : cB + (size_t)(t + 2) * kstep;
            const char* a3 = a2 + kstep; const char* b3 = b2 + kstep;
            if (last && has_next) S.a_ready(nxt);
            if constexpr (SP2) {
            PG8_LDB(B0, 0, 0); PG8_LDB(B1, 0, 1); PG8_SCHED; PG8_LDA(At, 0, 0); PG8_STAGE(PG8_SA(1, 1), a1 + hstepA, voffA);
            PG8_WAIT_V(8); PG8_WAIT_L(0); PG8_BAR; PG8_MMA(0, 0, At, B0); PG8_MMA(0, 1, At, B1); PG8_BAR; PG8_SCHED;
            PG8_LDA(At, 0, 1); PG8_STAGE(PG8_SB(0, 0), b2, voffB); PG8_STAGE(PG8_SB(0, 1), b2 + hstepB, voffB); PG8_STAGE(PG8_SA(0, 0), a2, voffA);
            PG8_WAIT_V(8); PG8_WAIT_L(0); PG8_BAR; PG8_MMA(1, 0, At, B0); PG8_MMA(1, 1, At, B1); PG8_BAR; PG8_SCHED;
            PG8_LDB(B0, 1, 0); PG8_LDB(B1, 1, 1); PG8_SCHED; PG8_LDA(At, 1, 0); PG8_STAGE(PG8_SA(0, 1), a2 + hstepA, voffA);
            PG8_WAIT_V(8); PG8_WAIT_L(0); PG8_BAR; PG8_MMA(0, 0, At, B0); PG8_MMA(0, 1, At, B1); PG8_BAR; PG8_SCHED;
            PG8_LDA(At, 1, 1); PG8_STAGE(PG8_SB(1, 0), b3, voffB); PG8_STAGE(PG8_SB(1, 1), b3 + hstepB, voffB); PG8_STAGE(PG8_SA(1, 0), a3, voffA);
            PG8_WAIT_V(8); PG8_WAIT_L(0); PG8_BAR; PG8_MMA(1, 0, At, B0); PG8_MMA(1, 1, At, B1); PG8_BAR; PG8_SCHED;
            } else {
            PG8_LDB(B0, 0, 0); PG8_SCHED; PG8_LDA(At, 0, 0); PG8_STAGE(PG8_SA(1, 1), a1 + hstepA, voffA);
            PG8_WAIT_L(8); PG8_BAR; PG8_WAIT_L(0); PG8_MMA(0, 0, At, B0); PG8_BAR; PG8_SCHED;
            PG8_LDB(B1, 0, 1); PG8_STAGE(PG8_SB(0, 0), b2, voffB);
            PG8_BAR; PG8_WAIT_L(0); PG8_MMA(0, 1, At, B1); PG8_BAR;
            PG8_LDA(At, 0, 1); PG8_STAGE(PG8_SA(0, 0), a2, voffA);
            PG8_BAR; PG8_WAIT_L(0); PG8_MMA(1, 0, At, B0); PG8_BAR; PG8_SCHED;
            PG8_STAGE(PG8_SB(0, 1), b2 + hstepB, voffB);
            PG8_WAIT_V(6); PG8_BAR; PG8_MMA(1, 1, At, B1); PG8_BAR;
            PG8_LDB(B0, 1, 0); PG8_SCHED; PG8_LDA(At, 1, 0); PG8_STAGE(PG8_SA(0, 1), a2 + hstepA, voffA);
            PG8_WAIT_L(8); PG8_BAR; PG8_WAIT_L(0); PG8_MMA(0, 0, At, B0); PG8_BAR; PG8_SCHED;
            PG8_LDB(B1, 1, 1); PG8_STAGE(PG8_SB(1, 0), b3, voffB);
            PG8_BAR; PG8_WAIT_L(0); PG8_MMA(0, 1, At, B1); PG8_BAR;
            PG8_LDA(At, 1, 1); PG8_STAGE(PG8_SA(1, 0), a3, voffA);
            PG8_BAR; PG8_WAIT_L(0); PG8_MMA(1, 0, At, B0); PG8_BAR; PG8_SCHED;
            PG8_STAGE(PG8_SB(1, 1), b3 + hstepB, voffB);
            PG8_WAIT_V(6); PG8_BAR; PG8_MMA(1, 1, At, B1); PG8_BAR;
            }
        }
        if constexpr (ALIGN_EPI) { if (wr == 0) PG8_BAR; }
        if constexpr (!Epi::AFTER_DRAIN) { E(acc, cur, wr, wc, fr, fq); S.done(cur); }
        if (!has_next) break;
#pragma unroll
        for (int a = 0; a < 2; ++a)
#pragma unroll
            for (int b = 0; b < 2; ++b)
#pragma unroll
                for (int m = 0; m < 4; ++m)
#pragma unroll
                    for (int n = 0; n < 2; ++n) acc[a][b][m][n] = (f32x4){0.f, 0.f, 0.f, 0.f};
        cur = nxt; cA = nA; cB = nB; ++ui;
        if constexpr (ALIGN_EPI) { if (wr == 1) PG8_BAR; }
    }
    PG8_WAIT_V(0);
    if constexpr (!ALIGN_EPI) { if (wr == 0) PG8_BAR; }
    PG8_BAR;
    if constexpr (Epi::AFTER_DRAIN) { E.fused(acc, cur, wr, wc, fr, fq, lds, wid, lane); S.done(cur); }
#undef PG8_SA
#undef PG8_SB
#undef PG8_STAGE
#undef PG8_LDA
#undef PG8_LDB
#undef PG8_MMA
#undef PG8_WAIT_V
#undef PG8_WAIT_L
#undef PG8_BAR
#undef PG8_SCHED
}
}

#define LAS __attribute__((address_space(3)))
typedef unsigned short bf16;
typedef unsigned v4u __attribute__((ext_vector_type(4)));
typedef unsigned v2u __attribute__((ext_vector_type(2)));
typedef float f32x4 __attribute__((ext_vector_type(4)));
typedef float f32x16 __attribute__((ext_vector_type(16)));
typedef short bf16x8 __attribute__((ext_vector_type(8)));
typedef short s16x4 __attribute__((ext_vector_type(4)));
typedef float f32x2_t __attribute__((ext_vector_type(2)));
typedef __bf16 bf16x2_t __attribute__((ext_vector_type(2)));

constexpr int NB = 8, SEQ = 2048, DM = 1024, TT = NB * SEQ;
constexpr int DIN = 7912, NP = 7936;
constexpr int PP = 3840, NZG = 4096;
constexpr int MEML = 256;
constexpr float EPS = 1e-6f, NEGF = -1e30f;
constexpr int C_QA = 0, C_KA = 512, C_VA = 1024, C_QI = 1536, C_KI = 2048, C_WI = 2112, C_CQ = 2120, C_CKV = 2504, C_KR = 2760, C_QM = 2792, C_ZM = 3304;
constexpr int C_YA = C_QI, C_YB = C_CQ, C_YM = C_VA;
constexpr float SCALE_A = 0.18033688011112042f;
constexpr float SCALE_B = 0.14724444602590306f;
constexpr float SCALE_M = 0.12751743082459868f;
constexpr float SCALE_I = 0.04419417382415922f;

__constant__ float INVA[8] = {1.0f, 0.1939227432012558f, 0.03760603070259094f, 0.007292664609849453f, 0.0014142135623842478f, 0.00027424818836152554f, 5.3182957344688475e-05f, 1.0313385246263351e-05f};
__constant__ float INVB[16] = {1.0f, 0.44036659598350525f, 0.1939227432012558f, 0.08539710193872452f, 0.03760603070259094f, 0.016560440883040428f, 0.007292664609849453f, 0.0032114461064338684f, 0.0014142135623842478f, 0.0006227724370546639f, 0.00027424818836152554f, 0.00012076973507646471f, 5.3182957344688475e-05f, 2.34199997066753e-05f, 1.0313385246263351e-05f, 4.541670477919979e-06f};

constexpr size_t MiB = 1u << 20;
constexpr size_t WS_CTL = 0;
constexpr size_t WS_WIN = 1 * MiB;
constexpr size_t WS_WUQ = 17 * MiB;
constexpr size_t WS_WUKV = 18 * MiB;
constexpr size_t WS_WMEM = 19 * MiB;
constexpr size_t WS_WBR = 21 * MiB;
constexpr size_t WS_WOUT = 24 * MiB;
constexpr size_t WS_ROPEA = 26 * MiB;
constexpr size_t WS_ROPEB = 27 * MiB;
constexpr size_t WS_MN = 29 * MiB;
constexpr size_t WS_KVM = 33 * MiB;
constexpr size_t WS_VTM = 37 * MiB;
constexpr size_t WS_WI = 39 * MiB;
constexpr size_t WS_MASK = 40 * MiB;
constexpr size_t WS_H = 44 * MiB;
constexpr size_t WS_P = 76 * MiB;
constexpr size_t WS_QB = 196 * MiB;
constexpr size_t WS_KVB = 220 * MiB;
constexpr size_t WS_G1 = 196 * MiB;
constexpr size_t WS_END = 256 * MiB;
constexpr size_t DO_VTA = 0;
constexpr size_t DO_VTB = 16 * MiB;
constexpr size_t DO_KB = 32 * MiB;
constexpr size_t DO_G0 = 0;

constexpr int REP_P0 = 1, REP_PH = 1, REP_G1 = 1, REP_G2 = 1, REP_IDX = 1, REP_ATT = 1, REP_G4 = 1, REP_G5 = 1;
constexpr int REP_IDX1 = 1, REP_SEL = 1;
constexpr int EXTRA_SYNCS = 0, REP_TR = 1, DUMMY_POST1 = 0, DUMMY_POST2 = 0;
constexpr int LDS_BYTES = 147456;
constexpr int LDS_SLOT = LDS_BYTES - 64;

__device__ __forceinline__ unsigned pk2(float lo, float hi) { f32x2_t v = {lo, hi}; bf16x2_t b = __builtin_convertvector(v, bf16x2_t); return __builtin_bit_cast(unsigned, b); }
__device__ __forceinline__ float bflo(unsigned w) { return __uint_as_float(w << 16); }
__device__ __forceinline__ float bfhi(unsigned w) { return __uint_as_float(w & 0xffff0000u); }
__device__ __forceinline__ float bf1(bf16 b) { return __uint_as_float(((unsigned)b) << 16); }
#define UNPACK8(W_, V_) do { V_[0] = bflo((W_)[0]); V_[1] = bfhi((W_)[0]); V_[2] = bflo((W_)[1]); V_[3] = bfhi((W_)[1]); V_[4] = bflo((W_)[2]); V_[5] = bfhi((W_)[2]); V_[6] = bflo((W_)[3]); V_[7] = bfhi((W_)[3]); } while (0)
#define PACK8(V_) (v4u){pk2(V_[0], V_[1]), pk2(V_[2], V_[3]), pk2(V_[4], V_[5]), pk2(V_[6], V_[7])}
__device__ __forceinline__ float wave_sum(float v) {
#pragma unroll
    for (int o = 1; o < 64; o <<= 1) v += __shfl_xor(v, o);
    return v;
}
#define LDS_WAIT() asm volatile("s_waitcnt lgkmcnt(0)" ::: "memory")

__device__ __forceinline__ int win_src(int d) {
    if (d < 2120) return d;
    if (d < 2792) return d + 512;
    if (d < 3816) return d + 1024;
    if (d < 3840) return -1;
    if (d < 4352) return d - 3840 + 2120;
    if (d < 4864) return d - 4352 + 3304;
    return d - 4864 + 4840;
}
template <bool REMAP>
__device__ __forceinline__ void transpose_item(const float* W, int K, int N, int Npad, bf16* WT, LAS float* scr, int item, int lane) {
    const int nblk = Npad / 32, kb = item / nblk, nb = item % nblk, k0 = 64 * kb, n0 = 32 * nb;
    const int nn = REMAP ? win_src(n0 + (lane & 31)) : n0 + (lane & 31); const bool ok = nn >= 0 && nn < N;
#pragma unroll 8
    for (int i = 0; i < 32; ++i) { const int kk = 2 * i + (lane >> 5); scr[kk * 33 + (lane & 31)] = ok ? W[(size_t)(k0 + kk) * N + nn] : 0.f; }
    LDS_WAIT(); asm volatile("" ::: "memory");
    const int c = lane & 7;
#pragma unroll
    for (int j = 0; j < 4; ++j) { const int n = (lane >> 3) + 8 * j; const LAS float* s = scr + (8 * c) * 33 + n;
        v4u o; o.x = pk2(s[0 * 33], s[1 * 33]); o.y = pk2(s[2 * 33], s[3 * 33]); o.z = pk2(s[4 * 33], s[5 * 33]); o.w = pk2(s[6 * 33], s[7 * 33]);
        *(v4u*)(WT + (size_t)(n0 + n) * K + k0 + 8 * c) = o; }
    LDS_WAIT(); asm volatile("" ::: "memory");
}
__device__ __forceinline__ void rms_row_1024(const float* xrow, const float* g, bf16* orow, int lane) {
    const f32x4* xr = (const f32x4*)xrow + lane; const f32x4* gr = (const f32x4*)g + lane;
    f32x4 v[4]; float s = 0.f;
#pragma unroll
    for (int j = 0; j < 4; ++j) { v[j] = xr[64 * j]; s += (v[j].x * v[j].x + v[j].y * v[j].y) + (v[j].z * v[j].z + v[j].w * v[j].w); }
    const float rstd = 1.0f / sqrtf(wave_sum(s) * (1.f / 1024.f) + EPS);
    v2u* o8 = (v2u*)orow + lane;
#pragma unroll
    for (int j = 0; j < 4; ++j) { const f32x4 gg = gr[64 * j]; v2u w; w.x = pk2(v[j].x * rstd * gg.x, v[j].y * rstd * gg.y); w.y = pk2(v[j].z * rstd * gg.z, v[j].w * rstd * gg.w); o8[64 * j] = w; }
}

#define ROPE8(v, sub, c8, s8) do { _Pragma("unroll") for (int j_ = 0; j_ < 8; ++j_) { const float pv_ = __shfl_xor(v[j_], 1); \
        const float r0_ = v[j_] * c8[j_] - pv_ * s8[j_], r1_ = v[j_] * c8[j_] + pv_ * s8[j_]; v[j_] = (sub) == 0 ? r0_ : ((sub) == 1 ? r1_ : v[j_]); } } while (0)

__device__ __forceinline__ void post1_row(const bf16* Prow, bf16* Orow, const float* ra, const float* gqa, const float* gka, const float* gcq, const float* gckv, const float* gqm, float* WIrow, int lane) {
    const int sub = lane & 7;
    const v4u z4 = (v4u){0u, 0u, 0u, 0u};
    const v4u w_qa = *(const v4u*)(Prow + C_QA + 8 * lane);
    const v4u w_ka = *(const v4u*)(Prow + C_KA + 8 * lane);
    const v4u w_qi = *(const v4u*)(Prow + C_QI + 8 * lane);
    const v4u w_qm = *(const v4u*)(Prow + C_QM + 8 * lane);
    v4u w_ki = z4, w_cq = z4, w_ckv = z4; float w_wi = 0.f;
    if (lane < 8) { w_ki = *(const v4u*)(Prow + C_KI + 8 * lane); w_wi = bf1(Prow[C_WI + lane]); }
    if (lane < 48) w_cq = *(const v4u*)(Prow + C_CQ + 8 * lane);
    if (lane < 32) w_ckv = *(const v4u*)(Prow + C_CKV + 8 * lane);
    float c8[8], s8[8];
#pragma unroll
    for (int j = 0; j < 8; ++j) { c8[j] = ra[j]; s8[j] = ra[8 + j]; }
    float ga[8], gk[8], gm[8], gq[8], gc[8];
#pragma unroll
    for (int j = 0; j < 8; ++j) { ga[j] = gqa[8 * sub + j]; gk[j] = gka[8 * sub + j]; gm[j] = gqm[8 * (lane & 15) + j]; gq[j] = lane < 48 ? gcq[8 * lane + j] : 0.f; gc[j] = lane < 32 ? gckv[8 * lane + j] : 0.f; }
    { float v[8]; UNPACK8(w_qa, v); float ss = 0.f;
#pragma unroll
      for (int j = 0; j < 8; ++j) ss += v[j] * v[j];
      ss += __shfl_xor(ss, 1); ss += __shfl_xor(ss, 2); ss += __shfl_xor(ss, 4);
      const float rstd = 1.0f / sqrtf(ss * (1.f / 64.f) + EPS);
#pragma unroll
      for (int j = 0; j < 8; ++j) v[j] = v[j] * rstd * ga[j];
      ROPE8(v, sub, c8, s8);
#pragma unroll
      for (int j = 0; j < 8; ++j) v[j] *= SCALE_A;
      *(v4u*)(Orow + C_QA + 8 * lane) = PACK8(v); }
    { float v[8]; UNPACK8(w_ka, v); float ss = 0.f;
#pragma unroll
      for (int j = 0; j < 8; ++j) ss += v[j] * v[j];
      ss += __shfl_xor(ss, 1); ss += __shfl_xor(ss, 2); ss += __shfl_xor(ss, 4);
      const float rstd = 1.0f / sqrtf(ss * (1.f / 64.f) + EPS);
#pragma unroll
      for (int j = 0; j < 8; ++j) v[j] = v[j] * rstd * gk[j];
      ROPE8(v, sub, c8, s8);
      *(v4u*)(Orow + C_KA + 8 * lane) = PACK8(v); }
    { float v[8]; UNPACK8(w_qi, v);
      ROPE8(v, sub, c8, s8);
      *(v4u*)(Orow + C_QI + 8 * lane) = PACK8(v); }
    { float v[8]; UNPACK8(w_ki, v);
      ROPE8(v, sub, c8, s8);
      if (lane < 8) *(v4u*)(Orow + C_KI + 8 * lane) = PACK8(v); }
    if (lane < 8) WIrow[lane] = w_wi * SCALE_I;
    { float v[8]; UNPACK8(w_cq, v); float ss = 0.f;
#pragma unroll
      for (int j = 0; j < 8; ++j) ss += v[j] * v[j];
      ss = wave_sum(ss); const float rstd = 1.0f / sqrtf(ss * (1.f / 384.f) + EPS);
      if (lane < 48) {
#pragma unroll
          for (int j = 0; j < 8; ++j) v[j] = v[j] * rstd * gq[j];
          *(v4u*)(Orow + C_CQ + 8 * lane) = PACK8(v); } }
    { float v[8]; UNPACK8(w_ckv, v); float ss = 0.f;
#pragma unroll
      for (int j = 0; j < 8; ++j) ss += v[j] * v[j];
      ss = wave_sum(ss); const float rstd = 1.0f / sqrtf(ss * (1.f / 256.f) + EPS);
      if (lane < 32) {
#pragma unroll
          for (int j = 0; j < 8; ++j) v[j] = v[j] * rstd * gc[j];
          *(v4u*)(Orow + C_CKV + 8 * lane) = PACK8(v); } }
    { float v[8]; UNPACK8(w_qm, v); float ss = 0.f;
#pragma unroll
      for (int j = 0; j < 8; ++j) ss += v[j] * v[j];
      ss += __shfl_xor(ss, 1); ss += __shfl_xor(ss, 2); ss += __shfl_xor(ss, 4); ss += __shfl_xor(ss, 8);
      const float rstd = 1.0f / sqrtf(ss * (1.f / 128.f) + EPS);
#pragma unroll
      for (int j = 0; j < 8; ++j) v[j] = v[j] * rstd * gm[j] * SCALE_M;
      *(v4u*)(Orow + C_QM + 8 * lane) = PACK8(v); }
}

__device__ __forceinline__ void km_row(bf16* row, const float* gkm, int lane) {
    v4u w = *(const v4u*)(row + 8 * lane); float v[8]; UNPACK8(w, v); float ss = 0.f;
#pragma unroll
    for (int j = 0; j < 8; ++j) ss += v[j] * v[j];
    ss += __shfl_xor(ss, 1); ss += __shfl_xor(ss, 2); ss += __shfl_xor(ss, 4); ss += __shfl_xor(ss, 8);
    const float rstd = 1.0f / sqrtf(ss * (1.f / 128.f) + EPS);
#pragma unroll
    for (int j = 0; j < 8; ++j) v[j] = v[j] * rstd * gkm[8 * (lane & 15) + j];
    *(v4u*)(row + 8 * lane) = PACK8(v);
}

__device__ __forceinline__ void transpose_v(const bf16* src, int pitch, int col0, int hstride, int H, int DV, int S, int nb, bf16* dst, int gw, int NGW, int lane) {
    const int ndq = DV / 64, nsc = S / 64, ntask = nb * H * nsc * ndq;
    for (int task = gw; task < ntask; task += NGW) {
        int x = task; const int dq = x % ndq; x /= ndq; const int sc = x % nsc; x /= nsc; const int h = x % H; const int b = x / H;
        const int s = sc * 64 + lane;
        const bf16* srow = src + (size_t)(b * S + s) * pitch + col0 + h * hstride + dq * 64;
        bf16* drow = dst + ((size_t)((b * H + h) * DV + dq * 64)) * S + s;
        v4u wv[8];
#pragma unroll
        for (int c = 0; c < 8; ++c) wv[c] = *(const v4u*)(srow + 8 * c);
#pragma unroll
        for (int c = 0; c < 8; ++c) { const v4u w = wv[c];
            drow[(size_t)(8 * c + 0) * S] = (bf16)(w.x & 0xffffu); drow[(size_t)(8 * c + 1) * S] = (bf16)(w.x >> 16);
            drow[(size_t)(8 * c + 2) * S] = (bf16)(w.y & 0xffffu); drow[(size_t)(8 * c + 3) * S] = (bf16)(w.y >> 16);
            drow[(size_t)(8 * c + 4) * S] = (bf16)(w.z & 0xffffu); drow[(size_t)(8 * c + 5) * S] = (bf16)(w.z >> 16);
            drow[(size_t)(8 * c + 6) * S] = (bf16)(w.w & 0xffffu); drow[(size_t)(8 * c + 7) * S] = (bf16)(w.w >> 16); }
    }
}

__device__ __forceinline__ void post2_row(const bf16* QBrow, bf16* QOrow, const bf16* KVBrow, const bf16* Prow, bf16* KBrow, const float* rb, const float* gq, const float* gk, LAS float* scr, int lane) {
    const int hd = lane >> 3, d0 = 12 * (lane & 7);
    float vq[12], vk[12], gqv[12], gkv[12], cc[12], sn[12];
    { const v2u* p = (const v2u*)(QBrow + 12 * lane);
      const v2u w0 = p[0], w1 = p[1], w2 = p[2];
      bf16 kr[12];
#pragma unroll
      for (int e = 0; e < 12; ++e) { const int d = d0 + e; kr[e] = d < 64 ? KVBrow[hd * 128 + d] : Prow[C_KR + d - 64]; }
#pragma unroll
      for (int e = 0; e < 12; ++e) { const int d = d0 + e; gqv[e] = gq[d]; gkv[e] = gk[d]; const int i = (d - 64) & 15; cc[e] = d < 64 ? 1.f : rb[i]; sn[e] = d < 64 ? 0.f : rb[16 + i]; }
      vq[0] = bflo(w0.x); vq[1] = bfhi(w0.x); vq[2] = bflo(w0.y); vq[3] = bfhi(w0.y); vq[4] = bflo(w1.x); vq[5] = bfhi(w1.x); vq[6] = bflo(w1.y); vq[7] = bfhi(w1.y);
      vq[8] = bflo(w2.x); vq[9] = bfhi(w2.x); vq[10] = bflo(w2.y); vq[11] = bfhi(w2.y);
#pragma unroll
      for (int e = 0; e < 12; ++e) vk[e] = bf1(kr[e]); }
    float sq = 0.f, sk = 0.f;
#pragma unroll
    for (int e = 0; e < 12; ++e) { sq += vq[e] * vq[e]; sk += vk[e] * vk[e]; }
    sq += __shfl_xor(sq, 1); sq += __shfl_xor(sq, 2); sq += __shfl_xor(sq, 4);
    sk += __shfl_xor(sk, 1); sk += __shfl_xor(sk, 2); sk += __shfl_xor(sk, 4);
    const float rq = 1.0f / sqrtf(sq * (1.f / 96.f) + EPS), rk = 1.0f / sqrtf(sk * (1.f / 96.f) + EPS);
#pragma unroll
    for (int e = 0; e < 12; ++e) { vq[e] = vq[e] * rq * gqv[e]; vk[e] = vk[e] * rk * gkv[e]; scr[12 * lane + e] = vq[e]; scr[768 + 12 * lane + e] = vk[e]; }
    LDS_WAIT(); asm volatile("" ::: "memory");
    float oq[12], ok[12];
#pragma unroll
    for (int e = 0; e < 12; ++e) { const int d = d0 + e;
        if (d < 64) { oq[e] = vq[e]; ok[e] = vk[e]; }
        else { const bool first = d < 80; const int off = first ? 16 : -16; const float pq = scr[12 * lane + e + off], pk = scr[768 + 12 * lane + e + off];
               oq[e] = first ? vq[e] * cc[e] - pq * sn[e] : vq[e] * cc[e] + pq * sn[e];
               ok[e] = first ? vk[e] * cc[e] - pk * sn[e] : vk[e] * cc[e] + pk * sn[e]; }
        oq[e] *= SCALE_B; }
    LDS_WAIT(); asm volatile("" ::: "memory");
    v2u* q = (v2u*)(QOrow + 12 * lane); v2u* k = (v2u*)(KBrow + 12 * lane);
#pragma unroll
    for (int i = 0; i < 3; ++i) { v2u w; w.x = pk2(oq[4 * i], oq[4 * i + 1]); w.y = pk2(oq[4 * i + 2], oq[4 * i + 3]); q[i] = w;
                                  v2u u; u.x = pk2(ok[4 * i], ok[4 * i + 1]); u.y = pk2(ok[4 * i + 2], ok[4 * i + 3]); k[i] = u; }
}

__device__ __forceinline__ int next_unit(unsigned* ctr, volatile LAS int* slot) {
    __syncthreads();
    if (threadIdx.x == 0) *slot = (int)atomicAdd(ctr, 1u);
    __syncthreads();
    return *slot;
}

constexpr int SCP = 2052;
__device__ __forceinline__ unsigned ord_key(float v) { const unsigned b = __float_as_uint(v); return b ^ ((unsigned)((int)b >> 31) | 0x80000000u); }
__device__ __forceinline__ void indexer_unit(LAS float* sc, const bf16* P, const float* WI, unsigned* MASK, int bb, int tb) {
    int tid_ = threadIdx.x; asm volatile("" : "+v"(tid_));
    const int tid = tid_, lane = tid & 63, w = __builtin_amdgcn_readfirstlane(tid >> 6);
    const int n = lane & 15, g = lane >> 4;
    const int rowbase = bb * SEQ, t0 = tb * 16;
    for (int rp1 = 0; rp1 < REP_IDX1; ++rp1) {
        bf16x8 qf[8][2]; float wq[8];
        const bf16* qrow = P + (size_t)(rowbase + t0 + n) * PP + C_QI + 8 * g;
#pragma unroll
        for (int h = 0; h < 8; ++h) {
            qf[h][0] = *(const bf16x8*)(qrow + h * 64);
            qf[h][1] = *(const bf16x8*)(qrow + h * 64 + 32);
            wq[h] = WI[(size_t)(rowbase + t0 + n) * 8 + h];
        }
        const int ntile = tb + 1;
        const int nmine = (ntile - w + 7) >> 3;
        const int ngrp = (nmine + 3) >> 2;
        const bf16* kbase = P + (size_t)(rowbase + n) * PP + C_KI + 8 * g;
        bf16x8 kb[2][4][2];
#define IDX_LOAD(BUF, GRP) do { _Pragma("unroll") for (int j_ = 0; j_ < 4; ++j_) { const int tile_ = w + 8 * (4 * (GRP) + j_); const int tl_ = tile_ < ntile ? tile_ : 0; \
            const bf16* kr_ = kbase + (size_t)(16 * tl_) * PP; kb[BUF][j_][0] = *(const bf16x8*)(kr_); kb[BUF][j_][1] = *(const bf16x8*)(kr_ + 32); } } while (0)
#define IDX_COMP(BUF, GRP) do { _Pragma("unroll") for (int j_ = 0; j_ < 4; ++j_) { const int tile_ = w + 8 * (4 * (GRP) + j_); if (tile_ < ntile) { \
            f32x4 idx_ = (f32x4){0.f, 0.f, 0.f, 0.f}; \
            _Pragma("unroll") for (int h_ = 0; h_ < 8; ++h_) { f32x4 a_ = (f32x4){0.f, 0.f, 0.f, 0.f}; \
                a_ = __builtin_amdgcn_mfma_f32_16x16x32_bf16(kb[BUF][j_][0], qf[h_][0], a_, 0, 0, 0); \
                a_ = __builtin_amdgcn_mfma_f32_16x16x32_bf16(kb[BUF][j_][1], qf[h_][1], a_, 0, 0, 0); \
                _Pragma("unroll") for (int i_ = 0; i_ < 4; ++i_) idx_[i_] = __builtin_fmaf(wq[h_], __builtin_fmaxf(a_[i_], 0.f), idx_[i_]); } \
            *(LAS f32x4*)(sc + n * SCP + 16 * tile_ + 4 * g) = idx_; } } } while (0)
        if (ngrp > 0) IDX_LOAD(0, 0);
        for (int gp = 0; gp < ngrp; gp += 2) {
            if (gp + 1 < ngrp) IDX_LOAD(1, gp + 1);
            IDX_COMP(0, gp);
            if (gp + 1 < ngrp) { if (gp + 2 < ngrp) IDX_LOAD(0, gp + 2); IDX_COMP(1, gp + 1); }
        }
#undef IDX_LOAD
#undef IDX_COMP
    }
    __syncthreads();
    for (int qq2 = 0; qq2 < 2 * REP_SEL; ++qq2) { const int qq = qq2 & 1;
        const int q = 2 * w + qq, t = t0 + q;
        unsigned* mrow = MASK + (size_t)(rowbase + t) * 64;
        if (t < 256) {
            unsigned word;
            if (32 * lane + 31 <= t) word = 0xffffffffu; else if (32 * lane > t) word = 0u; else word = (1u << (t - 32 * lane + 1)) - 1u;
            mrow[lane] = word;
        } else {
            unsigned u[32];
            const LAS float* srow = sc + q * SCP;
#pragma unroll
            for (int r = 0; r < 32; ++r) { const int key = 64 * r + lane; u[r] = 0u; if (64 * r <= t) { const float v = srow[key]; u[r] = key <= t ? ord_key(v) : 0u; } }
            unsigned Pv = 0u; bool exact = false;
#pragma unroll 1
            for (int bit = 31; bit >= 0; --bit) {
                const unsigned cand = Pv | (1u << bit);
                int cnt = 0;
#pragma unroll
                for (int r = 0; r < 32; ++r) { cnt += __popcll(__ballot(u[r] >= cand)); if ((r & 3) == 3) __builtin_amdgcn_sched_barrier(0); }
                if (cnt >= 256) Pv = cand;
                if (cnt == 256) { exact = true; break; }
            }
            const unsigned Pg = exact ? Pv - 1u : Pv;
            int cgt = 0;
#pragma unroll
            for (int r = 0; r < 32; ++r) { cgt += __popcll(__ballot(u[r] > Pg)); if ((r & 3) == 3) __builtin_amdgcn_sched_barrier(0); }
            int need = exact ? 0 : 256 - cgt;
            unsigned long long mine = 0ull;
#pragma unroll
            for (int r = 0; r < 32; ++r) {
                unsigned long long sel = __ballot(u[r] > Pg);
                if (need > 0) {
                    unsigned long long eq = __ballot(u[r] == Pv);
                    const int c = __popcll(eq);
                    if (c <= need) { sel |= eq; need -= c; }
                    else { while (need > 0) { const unsigned long long low = eq & (~eq + 1ull); sel |= low; eq ^= low; --need; } }
                }
                if (lane == r) mine = sel;
                __builtin_amdgcn_sched_barrier(0);
            }
            if (lane < 32) ((unsigned long long*)mrow)[lane] = mine;
        }
    }
    __syncthreads();
}

__device__ __forceinline__ int crow(int r, int hi) { return (r & 3) + 8 * (r >> 2) + 4 * hi; }
template <int DQK, int DV, int MODE>
__device__ __forceinline__ void attn_unit(LAS unsigned char* lds, const bf16* Qb, int qpitch, const bf16* Kb, int kpitch, const bf16* VTb, int skv,
                                          const unsigned* maskb, const bf16* Zb, bf16* Ob, int q0) {
    constexpr int KP = DQK + 8, VP = 72;
    LAS bf16* Ks = (LAS bf16*)lds; LAS bf16* Vs = Ks + 64 * KP;
    constexpr int CPR = DQK / 8;
    constexpr int NCK = 64 * CPR, NCV = DV * 8;
    constexpr int RK = (NCK + 511) / 512, RV = (NCV + 511) / 512;
    constexpr int NKS = DQK / 16, NMT = DV / 32;
    int tid_ = threadIdx.x; asm volatile("" : "+v"(tid_));
    const int tid = tid_, lane = tid & 63, w = __builtin_amdgcn_readfirstlane(tid >> 6), r = lane & 31, hh = lane >> 5;
    const int NT = MODE == 0 ? skv / 64 : (q0 + 256) / 64;
    const int qlo = q0 + 32 * w;
    bf16x8 qf[NKS];
    { const bf16* qrow = Qb + (size_t)(qlo + r) * qpitch + 8 * hh;
#pragma unroll
      for (int ks = 0; ks < NKS; ++ks) qf[ks] = *(const bf16x8*)(qrow + 16 * ks); }
    f32x16 o[NMT];
#pragma unroll
    for (int mt = 0; mt < NMT; ++mt)
#pragma unroll
        for (int i = 0; i < 16; ++i) o[mt][i] = 0.f;
    float m_run = NEGF, l_run = 0.f;
    v4u kreg[RK], vreg[RV];
#define ATT_PREFETCH(tile_) do { \
        _Pragma("unroll") for (int i_ = 0; i_ < RK; ++i_) { const int c_ = tid + 512 * i_; if (c_ < NCK) { const int row_ = c_ / CPR, cc_ = c_ % CPR; kreg[i_] = *(const v4u*)(Kb + (size_t)(64 * (tile_) + row_) * kpitch + 8 * cc_); } } \
        _Pragma("unroll") for (int i_ = 0; i_ < RV; ++i_) { const int c_ = tid + 512 * i_; if (c_ < NCV) { const int d_ = c_ >> 3, cc_ = c_ & 7; vreg[i_] = *(const v4u*)(VTb + (size_t)d_ * skv + 64 * (tile_) + 8 * cc_); } } } while (0)
    ATT_PREFETCH(0);
    for (int tile = 0; tile < NT; ++tile) {
        __syncthreads();
#pragma unroll
        for (int i = 0; i < RK; ++i) { const int c = tid + 512 * i; if (c < NCK) { const int row = c / CPR, cc = c % CPR; *(LAS v4u*)(Ks + row * KP + 8 * cc) = kreg[i]; } }
#pragma unroll
        for (int i = 0; i < RV; ++i) { const int c = tid + 512 * i; if (c < NCV) { const int d = c >> 3, cc = c & 7; *(LAS v4u*)(Vs + d * VP + 8 * cc) = vreg[i]; } }
        __syncthreads();
        if (tile + 1 < NT) ATT_PREFETCH(tile + 1);
        if (MODE != 0 && 64 * tile > qlo + 31) continue;
        unsigned mw0 = 0u, mw1 = 0u;
        if (MODE == 2) { const v2u mm = *(const v2u*)(maskb + (size_t)(qlo + r) * 64 + 2 * tile); mw0 = mm.x >> (4 * hh); mw1 = mm.y >> (4 * hh); }
        f32x16 s0, s1;
#pragma unroll
        for (int i = 0; i < 16; ++i) { s0[i] = 0.f; s1[i] = 0.f; }
#pragma unroll
        for (int ks = 0; ks < NKS; ++ks) {
            const bf16x8 a0 = *(const LAS bf16x8*)(Ks + r * KP + 16 * ks + 8 * hh);
            const bf16x8 a1 = *(const LAS bf16x8*)(Ks + (32 + r) * KP + 16 * ks + 8 * hh);
            s0 = __builtin_amdgcn_mfma_f32_32x32x16_bf16(a0, qf[ks], s0, 0, 0, 0);
            s1 = __builtin_amdgcn_mfma_f32_32x32x16_bf16(a1, qf[ks], s1, 0, 0, 0);
        }
        if (MODE == 1) {
            if (64 * tile + 63 > qlo) { const int qg = qlo + r;
#pragma unroll
                for (int i = 0; i < 16; ++i) { const int key = 64 * tile + crow(i, hh); if (key > qg) s0[i] = NEGF; if (key + 32 > qg) s1[i] = NEGF; } }
        }
        if (MODE == 2) {
#pragma unroll
            for (int i = 0; i < 16; ++i) { const int bit = (i & 3) + 8 * (i >> 2); if (!((mw0 >> bit) & 1u)) s0[i] = NEGF; if (!((mw1 >> bit) & 1u)) s1[i] = NEGF; }
        }
        float mx = s0[0];
#pragma unroll
        for (int i = 1; i < 16; ++i) mx = __builtin_fmaxf(mx, s0[i]);
#pragma unroll
        for (int i = 0; i < 16; ++i) mx = __builtin_fmaxf(mx, s1[i]);
        mx = __builtin_fmaxf(mx, __shfl_xor(mx, 32));
        const float m_new = __builtin_fmaxf(m_run, mx);
        const float alpha = __builtin_amdgcn_exp2f(m_run - m_new);
        m_run = m_new;
        float ls = 0.f;
#pragma unroll
        for (int i = 0; i < 16; ++i) { s0[i] = __builtin_amdgcn_exp2f(s0[i] - m_new); s1[i] = __builtin_amdgcn_exp2f(s1[i] - m_new); ls += s0[i] + s1[i]; }
        l_run = l_run * alpha + ls;
#pragma unroll
        for (int mt = 0; mt < NMT; ++mt)
#pragma unroll
            for (int i = 0; i < 16; ++i) o[mt][i] *= alpha;
        v4u pf[2][2];
#pragma unroll
        for (int s = 0; s < 2; ++s) {
            pf[0][s] = (v4u){pk2(s0[8 * s], s0[8 * s + 1]), pk2(s0[8 * s + 2], s0[8 * s + 3]), pk2(s0[8 * s + 4], s0[8 * s + 5]), pk2(s0[8 * s + 6], s0[8 * s + 7])};
            pf[1][s] = (v4u){pk2(s1[8 * s], s1[8 * s + 1]), pk2(s1[8 * s + 2], s1[8 * s + 3]), pk2(s1[8 * s + 4], s1[8 * s + 5]), pk2(s1[8 * s + 6], s1[8 * s + 7])};
        }
#pragma unroll
        for (int mt = 0; mt < NMT; ++mt)
#pragma unroll
            for (int p = 0; p < 2; ++p)
#pragma unroll
                for (int s = 0; s < 2; ++s) {
                    const LAS bf16* vp = Vs + (32 * mt + r) * VP + 32 * p + 16 * s + 4 * hh;
                    const s16x4 lo = *(const LAS s16x4*)(vp), hi = *(const LAS s16x4*)(vp + 8);
                    const bf16x8 a = (bf16x8){lo[0], lo[1], lo[2], lo[3], hi[0], hi[1], hi[2], hi[3]};
                    o[mt] = __builtin_amdgcn_mfma_f32_32x32x16_bf16(a, __builtin_bit_cast(bf16x8, pf[p][s]), o[mt], 0, 0, 0);
                }
    }
#undef ATT_PREFETCH
    const float l_tot = l_run + __shfl_xor(l_run, 32);
    const float inv = 1.0f / l_tot;
    const size_t row = (size_t)(qlo + r);
#pragma unroll
    for (int mt = 0; mt < NMT; ++mt)
#pragma unroll
        for (int g4 = 0; g4 < 4; ++g4) {
            const int d = 32 * mt + 8 * g4 + 4 * hh;
            float ov[4];
#pragma unroll
            for (int i = 0; i < 4; ++i) ov[i] = o[mt][4 * g4 + i] * inv;
            if (Zb) { const v2u zw = *(const v2u*)(Zb + row * PP + d); const float z[4] = {bflo(zw.x), bfhi(zw.x), bflo(zw.y), bfhi(zw.y)};
#pragma unroll
                for (int i = 0; i < 4; ++i) ov[i] *= z[i] / (1.0f + __expf(-z[i])); }
            v2u ow; ow.x = pk2(ov[0], ov[1]); ow.y = pk2(ov[2], ov[3]);
            *(v2u*)(Ob + row * PP + d) = ow;
        }
}

__device__ __forceinline__ bf16* gate_row(bf16* G0, bf16* G1, size_t row) { return row < 8192 ? G0 + row * 3072 : G1 + (row - 8192) * 3072; }
struct EpiZG {
    static constexpr bool PERM = true, AFTER_DRAIN = false;
    bf16* P; bf16* G0; bf16* G1;
    __device__ __forceinline__ void operator()(const pg8::f32x4 (&acc)[2][2][4][2], const pg8::Unit& u, int wr, int wc, int fr, int fq) const {
        const int row0 = u.pm * 256 + wr * 64 + fr, cl = wc * 32 + 8 * fq;
        const bool isz = u.pn < 4;
        const int ycol = (u.pn < 2 ? C_YA : C_YB) + (u.pn & 1) * 256, gcol = (u.pn - 4) * 256;
#pragma unroll
        for (int ai = 0; ai < 2; ++ai)
#pragma unroll
            for (int m = 0; m < 4; ++m) { const size_t row = (size_t)(row0 + ai * 128 + m * 16);
#pragma unroll
                for (int bj = 0; bj < 2; ++bj) {
                    const pg8::f32x4 v0 = acc[ai][bj][m][0], v1 = acc[ai][bj][m][1];
                    float rr[8] = {v0[0], v0[1], v0[2], v0[3], v1[0], v1[1], v1[2], v1[3]};
                    if (isz) { bf16* dst = P + row * PP + ycol + cl + bj * 128; const v4u old = *(const v4u*)dst; float yv[8]; UNPACK8(old, yv);
#pragma unroll
                        for (int e = 0; e < 8; ++e) rr[e] = yv[e] * (rr[e] / (1.0f + __expf(-rr[e])));
                        *(v4u*)dst = PACK8(rr); }
                    else { bf16* dst = gate_row(G0, G1, row) + gcol + cl + bj * 128;
#pragma unroll
                        for (int e = 0; e < 8; ++e) rr[e] = 1.0f / (1.0f + __expf(-rr[e]));
                        *(v4u*)dst = PACK8(rr); } } }
    }
};
struct EpiMerge {
    static constexpr bool PERM = true, AFTER_DRAIN = false;
    bf16* Mg; bf16* G0; bf16* G1; int nbr;
    __device__ __forceinline__ void operator()(const pg8::f32x4 (&acc)[2][2][4][2], const pg8::Unit& u, int wr, int wc, int fr, int fq) const {
        const int row0 = u.pm * 256 + wr * 64 + fr, col0 = u.pn * 256 + wc * 32 + 8 * fq;
#pragma unroll
        for (int ai = 0; ai < 2; ++ai)
#pragma unroll
            for (int m = 0; m < 4; ++m) { const size_t row = (size_t)(row0 + ai * 128 + m * 16);
#pragma unroll
                for (int bj = 0; bj < 2; ++bj) { const int col = col0 + bj * 128;
                    const v4u gwd = *(const v4u*)(gate_row(G0, G1, row) + nbr * 1024 + col);
                    float gl[8]; UNPACK8(gwd, gl);
                    const pg8::f32x4 v0 = acc[ai][bj][m][0], v1 = acc[ai][bj][m][1];
                    float rr[8] = {v0[0], v0[1], v0[2], v0[3], v1[0], v1[1], v1[2], v1[3]};
#pragma unroll
                    for (int e = 0; e < 8; ++e) rr[e] *= gl[e];
                    bf16* dst = Mg + row * 1024 + col;
                    if (nbr > 0) { const v4u old = *(const v4u*)dst; float ol[8]; UNPACK8(old, ol);
#pragma unroll
                        for (int e = 0; e < 8; ++e) rr[e] += ol[e]; }
                    *(v4u*)dst = PACK8(rr); } }
    }
};
struct EpiOut {
    static constexpr bool PERM = true, AFTER_DRAIN = false;
    const float* X; float* Out;
    __device__ __forceinline__ void operator()(const pg8::f32x4 (&acc)[2][2][4][2], const pg8::Unit& u, int wr, int wc, int fr, int fq) const {
        const int row0 = u.pm * 256 + wr * 64 + fr, col0 = u.pn * 256 + wc * 32 + 8 * fq;
#pragma unroll
        for (int ai = 0; ai < 2; ++ai)
#pragma unroll
            for (int m = 0; m < 4; ++m) { const size_t row = (size_t)(row0 + ai * 128 + m * 16);
#pragma unroll
                for (int bj = 0; bj < 2; ++bj) { const size_t p = row * 1024 + col0 + bj * 128;
                    const f32x4 x0 = *(const f32x4*)(X + p), x1 = *(const f32x4*)(X + p + 4);
                    const pg8::f32x4 a0 = acc[ai][bj][m][0], a1 = acc[ai][bj][m][1];
                    *(f32x4*)(Out + p) = (f32x4){x0[0] + a0[0], x0[1] + a0[1], x0[2] + a0[2], x0[3] + a0[3]};
                    *(f32x4*)(Out + p + 4) = (f32x4){x1[0] + a1[0], x1[1] + a1[1], x1[2] + a1[2], x1[3] + a1[3]}; } }
    }
};

#define XB_TMO      128
#define XB_XCNT(j)  (256  + 64 * (j))
#define XB_XSUB(j)  (1280 + 64 * (j))
#define XB_XGEN(j)  (2304 + 64 * (j))
#define XB_TOP      3328
#define XB_TOPGEN   3392
#define XCD_BAR_WORDS 3456
#define XB_SPIN_CAP (1u << 18)

__device__ __forceinline__ unsigned xb_ld(unsigned* p)              { return __hip_atomic_load(p, __ATOMIC_RELAXED, __HIP_MEMORY_SCOPE_AGENT); }
__device__ __forceinline__ unsigned xb_add(unsigned* p, unsigned v) { return __hip_atomic_fetch_add(p, v, __ATOMIC_RELAXED, __HIP_MEMORY_SCOPE_AGENT); }
__device__ __forceinline__ unsigned xb_xcc_id() { return (unsigned)__builtin_amdgcn_s_getreg((3 << 11) | 20) & 0xFu; }
#define XB_SPIN(cond, bar) do { unsigned _sp = 0; while (cond) { __builtin_amdgcn_s_sleep(1); \
    if ((++_sp & 255u) == 0u) { if (xb_ld(&(bar)[XB_TMO])) break; if (_sp > XB_SPIN_CAP) { atomicAdd(&(bar)[XB_TMO], 1u); break; } } } } while (0)

struct XcdBarrier {
    unsigned* bar; unsigned x;
    volatile LAS unsigned* st;
};

__device__ __forceinline__ XcdBarrier xcd_barrier_post(unsigned* bar, volatile LAS unsigned* st) {
    XcdBarrier b; b.bar = bar; b.x = xb_xcc_id(); b.st = st;
    if (threadIdx.x == 0) (void)xb_add(&bar[XB_XCNT(b.x)], 1u);
    return b;
}
__device__ __forceinline__ void xcd_barrier_complete(unsigned* bar, unsigned x, unsigned& nloc, unsigned& nx) {
    const unsigned G = gridDim.x * gridDim.y * gridDim.z;
    unsigned sum, cnt, mine, sp = 0u;
    for (;;) {
        sum = 0u; cnt = 0u; mine = 0u;
#pragma unroll
        for (unsigned j = 0; j < 16; ++j) { const unsigned c = xb_ld(&bar[XB_XCNT(j)]); sum += c; cnt += (c > 0u) ? 1u : 0u; mine = (j == x) ? c : mine; }
        if (sum == G) break;
        __builtin_amdgcn_s_sleep(1);
        if ((++sp & 255u) == 0u) { if (xb_ld(&bar[XB_TMO])) break; if (sp > XB_SPIN_CAP) { atomicAdd(&bar[XB_TMO], 1u); break; } }
    }
    nloc = mine > 0u ? mine : 1u; nx = cnt > 0u ? cnt : 1u;
}

__device__ __forceinline__ void xcd_barrier(const XcdBarrier& b) {
    asm volatile("s_waitcnt vmcnt(0)" ::: "memory");
    __syncthreads();
    if (threadIdx.x == 0) {
        unsigned* bar = b.bar;
        __builtin_amdgcn_s_waitcnt(0);
        unsigned nloc = b.st[0], nx = b.st[1];
        if (nloc == 0u) { xcd_barrier_complete(bar, b.x, nloc, nx); b.st[0] = nloc; b.st[1] = nx; }
        const unsigned old = xb_add(&bar[XB_XSUB(b.x)], 1u);
        const unsigned gen = old / nloc;
        if (old + 1u == (gen + 1u) * nloc) {
            __builtin_amdgcn_fence(__ATOMIC_RELEASE, "agent");
            asm volatile("s_waitcnt vmcnt(0)" ::: "memory");
            const unsigned og = xb_add(&bar[XB_TOP], 1u);
            const unsigned tg = og / nx;
            if (og + 1u == (tg + 1u) * nx) xb_add(&bar[XB_TOPGEN], 1u);
            else XB_SPIN(xb_ld(&bar[XB_TOPGEN]) == tg, bar);
            __builtin_amdgcn_fence(__ATOMIC_ACQUIRE, "agent");
            xb_add(&bar[XB_XGEN(b.x)], 1u);
            asm volatile("s_waitcnt vmcnt(0)" ::: "memory");
        } else {
            XB_SPIN(xb_ld(&bar[XB_XGEN(b.x)]) == gen, bar);
            __builtin_amdgcn_fence(__ATOMIC_ACQUIRE, "agent");
            asm volatile("s_waitcnt vmcnt(0)" ::: "memory");
        }
    }
    __syncthreads();
}

struct Args { const float* in[19]; const int* pos; float* out; unsigned char* ws; };
typedef const __attribute__((address_space(4))) Args* kargs_t;
#define PHASE_BEGIN \
    kargs_t ap_ = (kargs_t)__builtin_amdgcn_kernarg_segment_ptr(); asm volatile("" : "+s"(ap_)); \
    int tid = threadIdx.x; asm volatile("" : "+v"(tid)); \
    const int lane = tid & 63, wave = __builtin_amdgcn_readfirstlane(tid >> 6), G = gridDim.x, NGW = G * 8, gw = blockIdx.x * 8 + wave; \
    unsigned char* const ws = ap_->ws; unsigned char* const dob = (unsigned char*)ap_->out; const int* const pos = ap_->pos; float* const outp = ap_->out; unsigned* const ctl = (unsigned*)(ws + WS_CTL); \
    const float* const x = ap_->in[0]; const float* const mem = ap_->in[1]; \
    const float* const g_norm = ap_->in[3]; const float* const w_in = ap_->in[4]; const float* const g_qn_a = ap_->in[5]; const float* const g_kn_a = ap_->in[6]; \
    const float* const g_cq = ap_->in[7]; const float* const g_ckv = ap_->in[8]; const float* const w_uq = ap_->in[9]; const float* const w_ukv = ap_->in[10]; \
    const float* const g_qn_b = ap_->in[11]; const float* const g_kn_b = ap_->in[12]; const float* const g_mem = ap_->in[13]; const float* const w_mem_kv = ap_->in[14]; \
    const float* const g_qn_m = ap_->in[15]; const float* const g_kn_m = ap_->in[16]; const float* const w_branch = ap_->in[17]; const float* const w_out = ap_->in[18]; \
    bf16* const WinT = (bf16*)(ws + WS_WIN); bf16* const WuqT = (bf16*)(ws + WS_WUQ); bf16* const WukvT = (bf16*)(ws + WS_WUKV); bf16* const WmemT = (bf16*)(ws + WS_WMEM); \
    bf16* const WbrT = (bf16*)(ws + WS_WBR); bf16* const WoutT = (bf16*)(ws + WS_WOUT); \
    float* const ropeA = (float*)(ws + WS_ROPEA); float* const ropeB = (float*)(ws + WS_ROPEB); \
    bf16* const MN = (bf16*)(ws + WS_MN); bf16* const KVM = (bf16*)(ws + WS_KVM); bf16* const VTM = (bf16*)(ws + WS_VTM); \
    float* const WI = (float*)(ws + WS_WI); unsigned* const MASK = (unsigned*)(ws + WS_MASK); \
    bf16* const VTA = (bf16*)(dob + DO_VTA); bf16* const VTB = (bf16*)(dob + DO_VTB); bf16* const KB = (bf16*)(dob + DO_KB); \
    bf16* const Hh = (bf16*)(ws + WS_H); bf16* const MG = (bf16*)(ws + WS_H); bf16* const QB = (bf16*)(ws + WS_QB); \
    bf16* const KVB = (bf16*)(ws + WS_KVB); bf16* const GT0 = (bf16*)(dob + DO_G0); bf16* const GT1 = (bf16*)(ws + WS_G1); bf16* const P = (bf16*)(ws + WS_P); \
    (void)lane; (void)NGW; (void)gw; (void)ctl; \
    (void)pos; (void)outp; (void)x; (void)mem; (void)g_norm; (void)w_in; (void)g_qn_a; (void)g_kn_a; (void)g_cq; (void)g_ckv; (void)w_uq; (void)w_ukv; (void)g_qn_b; (void)g_kn_b; (void)g_mem; (void)w_mem_kv; \
    (void)g_qn_m; (void)g_kn_m; (void)w_branch; (void)w_out; (void)WinT; (void)WuqT; (void)WukvT; (void)WmemT; (void)WbrT; (void)WoutT; (void)ropeA; (void)ropeB; (void)MN; (void)KVM; (void)VTM; (void)WI; (void)MASK; \
    (void)VTA; (void)VTB; (void)Hh; (void)KB; (void)QB; (void)KVB; (void)MG; (void)GT0; (void)GT1; (void)P
#define GRID_BARRIER() do { kargs_t bp_ = (kargs_t)__builtin_amdgcn_kernarg_segment_ptr(); asm volatile("" : "+s"(bp_)); \
    XcdBarrier b_; b_.bar = (unsigned*)(bp_->ws + WS_CTL) + 4096; b_.x = xb_xcc_id(); b_.st = (volatile LAS unsigned*)(lds + LDS_BYTES - 32); xcd_barrier(b_); } while (0)

__global__ void __launch_bounds__(512, 2) fwd_kernel(Args a) {
    extern __shared__ __attribute__((aligned(16))) unsigned char lds_raw[];
    LAS unsigned char* const lds = (LAS unsigned char*)lds_raw;
    volatile LAS int* const slot = (volatile LAS int*)(lds + LDS_SLOT);
    if (threadIdx.x < 16) ((LAS unsigned*)(lds + LDS_BYTES - 64))[threadIdx.x] = 0u;
    __syncthreads();
    (void)xcd_barrier_post((unsigned*)(a.ws + WS_CTL) + 4096, (volatile LAS unsigned*)(lds + LDS_BYTES - 32));

    for (int rep = 0; rep < REP_P0; ++rep) { PHASE_BEGIN;
        LAS float* scr = (LAS float*)(lds + wave * 16384);
        constexpr int I_IN = 16 * (NP / 32), I_UQ = 6 * 24, I_UKV = 4 * 32, I_MEM = 16 * 32, I_BR = 8 * 32, I_OUT = 16 * 32;
        constexpr int NITEMS = I_IN + I_UQ + I_UKV + I_MEM + 3 * I_BR + I_OUT;
        for (int it = gw; it < NITEMS; it += NGW) {
            int r = it;
            if (r < I_IN) { transpose_item<true>(w_in, 1024, DIN, NP, WinT, scr, r, lane); continue; } r -= I_IN;
            if (r < I_UQ) { transpose_item<false>(w_uq, 384, 768, 768, WuqT, scr, r, lane); continue; } r -= I_UQ;
            if (r < I_UKV) { transpose_item<false>(w_ukv, 256, 1024, 1024, WukvT, scr, r, lane); continue; } r -= I_UKV;
            if (r < I_MEM) { transpose_item<false>(w_mem_kv, 1024, 1024, 1024, WmemT, scr, r, lane); continue; } r -= I_MEM;
            if (r < 3 * I_BR) { const int nb = r / I_BR; transpose_item<false>(w_branch + (size_t)nb * 512 * 1024, 512, 1024, 1024, WbrT + (size_t)nb * 1024 * 512, scr, r % I_BR, lane); continue; } r -= 3 * I_BR;
            transpose_item<false>(w_out, 1024, 1024, 1024, WoutT, scr, r, lane);
        }
        for (int idx = blockIdx.x * 512 + tid; idx < TT * 24; idx += G * 512) {
            const int t = idx / 24, i = idx % 24; const float pf = (float)pos[t];
            if (i < 8) { const float ang = pf * INVA[i]; ropeA[t * 16 + i] = cosf(ang); ropeA[t * 16 + 8 + i] = sinf(ang); }
            else { const int j = i - 8; const float ang = pf * INVB[j]; ropeB[t * 32 + j] = cosf(ang); ropeB[t * 32 + 16 + j] = sinf(ang); }
        }
        for (int m = gw; m < NB * MEML; m += NGW) rms_row_1024(mem + (size_t)m * DM, g_mem, MN + (size_t)m * DM, lane);
        for (int rp = 0; rp < REP_PH; ++rp)
        for (int m = gw; m < TT; m += NGW) rms_row_1024(x + (size_t)m * DM, g_norm, Hh + (size_t)m * DM, lane);
    }
    GRID_BARRIER();
    for (int es = 0; es < EXTRA_SYNCS; ++es) GRID_BARRIER();

    for (int rep = 0; rep < REP_G1; ++rep) { PHASE_BEGIN;
        pg8::Gemm g{Hh, WinT, TT, PP, 1024, 1024}; pg8::StaticOrder S; S.init(TT, PP, G, (int)blockIdx.x);
        pg8::EpiBf16<0> E{P, PP, nullptr, 0, 0, 1.f};
        pg8::gemm_phase<pg8::EpiBf16<0>, pg8::StaticOrder, true, true>(lds, g, S, E);
    }
    { PHASE_BEGIN;
        pg8::Gemm g{MN, WmemT, NB * MEML, 1024, 1024, 1024}; pg8::StaticOrder S; S.init(NB * MEML, 1024, G, (int)((blockIdx.x + 64) % G));
        pg8::EpiBf16<0> E{KVM, 1024, nullptr, 0, 0, 1.f};
        pg8::gemm_phase<pg8::EpiBf16<0>, pg8::StaticOrder, true, true>(lds, g, S, E);
    }
    GRID_BARRIER();
    { PHASE_BEGIN;
        for (int dp = 0; dp < DUMMY_POST1; ++dp)
            for (int m = gw; m < TT; m += NGW)
                post1_row(P + (size_t)m * PP, QB + (size_t)(m & 1023) * 4096, ropeA + (size_t)m * 16, g_qn_a, g_kn_a, g_cq, g_ckv, g_qn_m, (float*)KVB + (size_t)m * 8, lane);
        for (int m = gw; m < TT; m += NGW)
            post1_row(P + (size_t)m * PP, P + (size_t)m * PP, ropeA + (size_t)m * 16, g_qn_a, g_kn_a, g_cq, g_ckv, g_qn_m, WI + (size_t)m * 8, lane);
        for (int rt = 0; rt < REP_TR; ++rt)
        transpose_v(P, PP, C_VA, 64, 8, 64, SEQ, NB, VTA, gw, NGW, lane);
        for (int m = gw; m < NB * MEML; m += NGW) km_row(KVM + (size_t)m * 1024, g_kn_m, lane);
        for (int rt = 0; rt < REP_TR; ++rt)
        transpose_v(KVM, 1024, 512, 128, 4, 128, MEML, NB, VTM, gw, NGW, lane);
    }
    GRID_BARRIER();
    for (int rep = 0; rep < REP_G2; ++rep) { PHASE_BEGIN;
        pg8::Gemm g{P + C_CQ, WuqT, TT, 768, 384, PP}; pg8::StaticOrder S; S.init(TT, 768, G, (int)blockIdx.x);
        pg8::EpiBf16<0> E{QB, 768, nullptr, 0, 0, 1.f};
        pg8::gemm_phase<pg8::EpiBf16<0>, pg8::StaticOrder, true, true>(lds, g, S, E);
    }
    for (int rep = 0; rep < REP_G2; ++rep) { PHASE_BEGIN;
        pg8::Gemm g{P + C_CKV, WukvT, TT, 1024, 256, PP}; pg8::StaticOrder S; S.init(TT, 1024, G, (int)((blockIdx.x + 192) % G));
        pg8::EpiBf16<0> E{KVB, 1024, nullptr, 0, 0, 1.f};
        pg8::gemm_phase<pg8::EpiBf16<0>, pg8::StaticOrder, true, true>(lds, g, S, E);
    }
    for (int rep = 0; rep < REP_IDX; ++rep) { if (rep > 0) GRID_BARRIER();
        PHASE_BEGIN;
        unsigned* const q_idx = ctl + 64 * (0 + 4 * rep);
        for (;;) {
            const int u = next_unit(q_idx, slot);
            if (u >= NB * 128) break;
            const int tb = 127 - (u >> 3), bb = u & 7;
            indexer_unit((LAS float*)lds, P, WI, MASK, bb, tb);
        }
    }
    GRID_BARRIER();
    { PHASE_BEGIN;
        LAS float* scr = (LAS float*)(lds + wave * 8192);
        for (int dp = 0; dp < DUMMY_POST2; ++dp)
            for (int m = gw; m < TT; m += NGW)
                post2_row(QB + (size_t)m * 768, (bf16*)MASK + (size_t)(m & 1023) * 768, KVB + (size_t)m * 1024, P + (size_t)m * PP, (bf16*)MASK + (size_t)(1024 + (m & 1023)) * 768, ropeB + (size_t)m * 32, g_qn_b, g_kn_b, scr, lane);
        for (int m = gw; m < TT; m += NGW)
            post2_row(QB + (size_t)m * 768, QB + (size_t)m * 768, KVB + (size_t)m * 1024, P + (size_t)m * PP, KB + (size_t)m * 768, ropeB + (size_t)m * 32, g_qn_b, g_kn_b, scr, lane);
        for (int rt = 0; rt < REP_TR; ++rt)
        transpose_v(KVB, 1024, 64, 128, 8, 64, SEQ, NB, VTB, gw, NGW, lane);
    }
    GRID_BARRIER();
    for (int rep = 0; rep < REP_ATT; ++rep) { if (rep > 0) GRID_BARRIER();
        PHASE_BEGIN;
        unsigned* const q_att = ctl + 64 * (1 + 4 * rep);
        for (;;) {
            const int u = next_unit(q_att, slot);
            if (u >= 1536) break;
            if (u < 1024) {
                const int qb = 7 - (u >> 7), wi = u & 127, bh = wi & 63, bb = bh >> 3, h = bh & 7;
                const size_t r0 = (size_t)bb * SEQ;
                if (wi < 64) attn_unit<96, 64, 1>(lds, QB + r0 * 768 + h * 96, 768, KB + r0 * 768 + h * 96, 768, VTB + (size_t)((bb * 8 + h) * 64) * SEQ, SEQ, nullptr,
                                                  nullptr, P + r0 * PP + C_YB + h * 64, qb * 256);
                else attn_unit<64, 64, 2>(lds, P + r0 * PP + C_QA + h * 64, PP, P + r0 * PP + C_KA + h * 64, PP, VTA + (size_t)((bb * 8 + h) * 64) * SEQ, SEQ, MASK + r0 * 64,
                                          nullptr, P + r0 * PP + C_YA + h * 64, qb * 256);
            } else {
                const int v = u - 1024, vh = v & 1, qb = (v >> 1) & 7, bh = v >> 4, bb = bh >> 2, h = bh & 3;
                const size_t r0 = (size_t)bb * SEQ;
                attn_unit<128, 64, 0>(lds, P + r0 * PP + C_QM + h * 128, PP, KVM + (size_t)bb * MEML * 1024 + h * 128, 1024, VTM + (size_t)((bb * 4 + h) * 128 + vh * 64) * MEML, MEML, nullptr,
                                      P + r0 * PP + C_ZM + h * 128 + vh * 64, P + r0 * PP + C_YM + h * 128 + vh * 64, qb * 256);
            }
        }
    }
    GRID_BARRIER();
    for (int rep = 0; rep < 1; ++rep) { PHASE_BEGIN;
        pg8::Gemm g{Hh, WinT + (size_t)PP * 1024, TT, NZG, 1024, 1024}; pg8::StaticOrder S; S.init(TT, NZG, G, (int)blockIdx.x);
        EpiZG E{P, GT0, GT1};
        pg8::gemm_phase<EpiZG, pg8::StaticOrder, true, true>(lds, g, S, E);
    }
    GRID_BARRIER();
    for (int nbr = 0; nbr < 3 * REP_G4; ++nbr) { const int nb = nbr % 3; PHASE_BEGIN;
        pg8::Gemm g{P + (nb == 0 ? C_YA : (nb == 1 ? C_YB : C_YM)), WbrT + (size_t)nb * 1024 * 512, TT, 1024, 512, PP}; pg8::StaticOrder S; S.init(TT, 1024, G, (int)blockIdx.x);
        EpiMerge E{MG, GT0, GT1, nb};
        pg8::gemm_phase<EpiMerge, pg8::StaticOrder, true, true>(lds, g, S, E);
    }
    GRID_BARRIER();
    for (int rep = 0; rep < REP_G5; ++rep) { PHASE_BEGIN;
        pg8::Gemm g{MG, WoutT, TT, 1024, 1024, 1024}; pg8::StaticOrder S; S.init(TT, 1024, G, (int)blockIdx.x);
        EpiOut E{x, outp};
        pg8::gemm_phase<EpiOut, pg8::StaticOrder, true, true>(lds, g, S, E);
    }
}

extern "C" void kernel_launch(void* const* d_in, const int* in_sizes, int n_in, void* d_out, int out_size, void* d_ws, size_t ws_size, hipStream_t stream) {
    static int grid = 0;
    if (grid == 0) {
        if (n_in != 19 || out_size != TT * DM || ws_size < WS_END) { fprintf(stderr, "kernel_launch: unexpected problem (n_in %d, out %d, ws %zu); nothing launched\n", n_in, out_size, ws_size); grid = -1; return; }
        int dev = 0, cus = 0, per_cu = 0;
        if (hipGetDevice(&dev) != hipSuccess || hipDeviceGetAttribute(&cus, hipDeviceAttributeMultiprocessorCount, dev) != hipSuccess) { grid = -1; return; }
        if (hipFuncSetAttribute((const void*)fwd_kernel, hipFuncAttributeMaxDynamicSharedMemorySize, LDS_BYTES) != hipSuccess) { fprintf(stderr, "kernel_launch: hipFuncSetAttribute failed\n"); grid = -1; return; }
        if (hipOccupancyMaxActiveBlocksPerMultiprocessor(&per_cu, (const void*)fwd_kernel, 512, LDS_BYTES) != hipSuccess || per_cu < 1) { fprintf(stderr, "kernel_launch: occupancy query reports %d blocks per CU\n", per_cu); (void)hipGetLastError(); grid = -1; return; }
        grid = cus;
    }
    if (grid < 0) return;
    (void)hipMemsetAsync((char*)d_ws + WS_CTL, 0, 65536, stream);
    Args a{};
    for (int i = 0; i < 19; ++i) a.in[i] = (const float*)d_in[i];
    a.pos = (const int*)d_in[2]; a.out = (float*)d_out; a.ws = (unsigned char*)d_ws;
    hipLaunchKernelGGL(fwd_kernel, dim3(grid), dim3(512), LDS_BYTES, stream, a);
    const hipError_t e = hipPeekAtLastError();
    if (e != hipSuccess) fprintf(stderr, "kernel_launch: launch failed: %s (grid %d)\n", hipGetErrorString(e), grid);
}
```

```cpp
#include <hip/hip_runtime.h>
#include <cstdio>
#include <cstdint>
namespace pg8 {
#define PG8_LAS __attribute__((address_space(3)))
typedef unsigned short bf16_t;
typedef short bf16x8 __attribute__((ext_vector_type(8)));
typedef float f32x4 __attribute__((ext_vector_type(4)));
typedef unsigned u32x4 __attribute__((ext_vector_type(4)));
constexpr int BM = 256, BK = 64, HALF = 128, HTB = HALF * BK * 2  , STAGE_BYTES = 8 * HTB, NXCD = 8, WGM = 8;

__host__ __device__ __forceinline__ int lds_byte(int r, int c) { const int st = (r >> 4) * 2 + (c >> 5), rr = r & 15, cc = c & 31, ob = rr * 64 + cc * 2; return st * 1024 + (ob ^ (((ob >> 9) & 1) << 5)); }
__host__ __device__ __forceinline__ void stage_rc(int b, int& R, int& C) { const int st = b / 1024, sb = b % 1024, swz = sb ^ (((sb >> 9) & 1) << 5); R = (st >> 1) * 16 + swz / 64; C = (st & 1) * 32 + (swz % 64) / 2; }
__host__ __device__ __forceinline__ int perm32(int rho) { const int n = rho >> 4, i = rho & 15; return 8 * (i >> 2) + 4 * n + (i & 3); }

struct Unit { int pm, pn; };
struct Gemm { const bf16_t* A; const bf16_t* Bt; int M, N, K, lda; };

struct StaticOrder {
    int nM, nN, nwg, G, c;
    __host__ __device__ void init(int M, int N, int G_, int c_) { nM = M / BM; nN = N / BM; nwg = nM * nN; G = G_; c = c_; }
    __host__ __device__ bool next(int i, Unit& u) const {
        const long L = (long)i * G + c; if (L >= nwg) return false;
        int wgid = (int)L; { const int q = nwg / NXCD, r = nwg % NXCD, xcd = wgid % NXCD, off = wgid / NXCD; wgid = (xcd < r ? xcd * (q + 1) : r * (q + 1) + (xcd - r) * q) + off; }
        const int nig = WGM * nN, gid = wgid / nig, fm = gid * WGM, gsz = (nM - fm) < WGM ? (nM - fm) : WGM;
        u.pm = fm + ((wgid % nig) % gsz); u.pn = (wgid % nig) / gsz; return true;
    }
    __device__ __forceinline__ void a_ready(const Unit&) const {}
    __device__ __forceinline__ void done(const Unit&) const {}
};

__device__ __forceinline__ unsigned cvt_pk_bf16(float lo, float hi) { unsigned r; asm volatile("v_cvt_pk_bf16_f32 %0, %1, %2" : "=v"(r) : "v"(lo), "v"(hi)); return r; }
typedef float f32x2 __attribute__((ext_vector_type(2)));
__device__ __forceinline__ f32x2 gelu_pk(f32x2 v) {
    const f32x2 av = __builtin_elementwise_abs(v), d = av * 0.2316418882f + 1.0f;
    f32x2 t; t.x = __builtin_amdgcn_rcpf(d.x); t.y = __builtin_amdgcn_rcpf(d.y);
    f32x2 q = t * 0.5307027145f + (-0.7265760135f); q = q * t + 0.7107068705f; q = q * t + (-0.142248368f); q = q * t + 0.127414796f; q = q * t;
    const f32x2 s = (v * v) * (-0.72134752044f);
    f32x2 e; e.x = __builtin_amdgcn_exp2f(s.x); e.y = __builtin_amdgcn_exp2f(s.y);
    const f32x2 m = v * (q * e), r = v - m;
    f32x2 o; o.x = v.x < 0.f ? m.x : r.x; o.y = v.y < 0.f ? m.y : r.y; return o;
}

template <int ACT  > struct EpiBf16 {
    static constexpr bool PERM = true, AFTER_DRAIN = false; static_assert(ACT == 0 || ACT == 1, "EpiBf16: ACT is 0 (none) or 1 (gelu_pk)");
    bf16_t* O; int ldc; const float* bias; int split_cols; size_t split_stride; float scale0;
    __device__ __forceinline__ void operator()(const f32x4 (&acc)[2][2][4][2], const Unit& u, int wr, int wc, int fr, int fq) const {
        const int row0 = u.pm * BM + wr * 64 + fr; int colt = u.pn * BM; bf16_t* base = O;
        float sc = 1.f; if (split_cols) { const int t = colt / split_cols; base += (size_t)t * split_stride; colt -= t * split_cols; if (t == 0) sc = scale0; }
        const int col0 = colt + wc * 32 + 8 * fq, bcol0 = u.pn * BM + wc * 32 + 8 * fq;
        f32x4 bv[2][2];
#pragma unroll
        for (int bj = 0; bj < 2; ++bj)
#pragma unroll
            for (int n = 0; n < 2; ++n) bv[bj][n] = bias ? *(const f32x4*)(bias + bcol0 + bj * HALF + 4 * n) : (f32x4){0.f, 0.f, 0.f, 0.f};
#pragma unroll
        for (int ai = 0; ai < 2; ++ai)
#pragma unroll
            for (int m = 0; m < 4; ++m) { bf16_t* rowp = base + (size_t)(row0 + ai * HALF + m * 16) * ldc + col0;
#pragma unroll
                for (int bj = 0; bj < 2; ++bj) { f32x4 v0 = acc[ai][bj][m][0] + bv[bj][0], v1 = acc[ai][bj][m][1] + bv[bj][1];
                    if (ACT == 1) { f32x2 a = gelu_pk((f32x2){v0[0], v0[1]}), b = gelu_pk((f32x2){v0[2], v0[3]}), c = gelu_pk((f32x2){v1[0], v1[1]}), d = gelu_pk((f32x2){v1[2], v1[3]});
                        v0 = (f32x4){a.x, a.y, b.x, b.y}; v1 = (f32x4){c.x, c.y, d.x, d.y}; }
                    v0 = v0 * sc; v1 = v1 * sc; u32x4 w; w.x = cvt_pk_bf16(v0[0], v0[1]); w.y = cvt_pk_bf16(v0[2], v0[3]); w.z = cvt_pk_bf16(v1[0], v1[1]); w.w = cvt_pk_bf16(v1[2], v1[3]);
                    *(u32x4*)(rowp + bj * HALF) = w; } }
    }
};
template <class Epi, class Sched, bool ALIGN_EPI = false, bool SP2 = false>
__device__ __forceinline__ void gemm_phase(PG8_LAS unsigned char* lds, const Gemm g, const Sched& S, const Epi& E) {
    int tid_ = threadIdx.x; asm volatile("" : "+v"(tid_));
    const int tid = tid_, wid = __builtin_amdgcn_readfirstlane(tid >> 6), lane = tid & 63, wr = wid >> 2, wc = wid & 3, fr = lane & 15, fq = lane >> 4;
    const int K = g.K, nt = K / BK;
    unsigned voffA[2], voffB[2];
#pragma unroll
    for (int i = 0; i < 2; ++i) { int R, C; stage_rc(tid * 16 + i * 8192, R, C); const int Rb = Epi::PERM ? ((R & ~31) + perm32(R & 31)) : R;
        voffA[i] = (unsigned)(R * g.lda + C) * 2u; voffB[i] = (unsigned)(Rb * K + C) * 2u; }
    const size_t kstep = (size_t)(BK * 2);
    const size_t hstepA = (size_t)HALF * g.lda * 2, hstepB = (size_t)HALF * K * 2;
    const size_t tstepA = 2 * hstepA, tstepB = 2 * hstepB;
    const unsigned ldsw = (unsigned)wid * 1024u;
    const int aoff = lds_byte(wr * 64 + fr, fq * 8), boff = lds_byte(wc * 32 + fr, fq * 8);
#define PG8_SA(b, h) (((b) * 2 + (h)) * HTB)
#define PG8_SB(b, h) ((4 + (b) * 2 + (h)) * HTB)
#define PG8_STAGE(bufoff, gbase, voff) do { _Pragma("unroll") for (int _i = 0; _i < 2; ++_i) \
        __builtin_amdgcn_global_load_lds((const unsigned*)((const char*)(gbase) + (voff)[_i]), (PG8_LAS unsigned*)(lds + (bufoff) + ldsw + _i * 8192), 16, 0, 0); } while (0)
#define PG8_LDA(dst, b, h) do { _Pragma("unroll") for (int m = 0; m < 4; ++m) _Pragma("unroll") for (int k = 0; k < 2; ++k) dst[m][k] = *(const PG8_LAS bf16x8*)(lds + PG8_SA(b, h) + aoff + m * 2048 + k * 1024); } while (0)
#define PG8_LDB(dst, b, h) do { _Pragma("unroll") for (int n = 0; n < 2; ++n) _Pragma("unroll") for (int k = 0; k < 2; ++k) dst[n][k] = *(const PG8_LAS bf16x8*)(lds + PG8_SB(b, h) + boff + n * 2048 + k * 1024); } while (0)
#define PG8_MMA(ai, bj, At, Bt) do { __builtin_amdgcn_s_setprio(1); _Pragma("unroll") for (int m = 0; m < 4; ++m) _Pragma("unroll") for (int n = 0; n < 2; ++n) _Pragma("unroll") for (int k = 0; k < 2; ++k) \
        acc[ai][bj][m][n] = __builtin_amdgcn_mfma_f32_16x16x32_bf16(Bt[n][k], At[m][k], acc[ai][bj][m][n], 0, 0, 0); __builtin_amdgcn_s_setprio(0); } while (0)
#define PG8_WAIT_V(n) asm volatile("s_waitcnt vmcnt(" #n ")" ::: "memory")
#define PG8_WAIT_L(n) asm volatile("s_waitcnt lgkmcnt(" #n ")" ::: "memory")
#define PG8_BAR __builtin_amdgcn_s_barrier()
#define PG8_SCHED __builtin_amdgcn_sched_barrier(0)
    Unit cur, nxt; int ui = 0;
    if (!S.next(0, cur)) return;
    f32x4 acc[2][2][4][2];
#pragma unroll
    for (int a = 0; a < 2; ++a)
#pragma unroll
        for (int b = 0; b < 2; ++b)
#pragma unroll
            for (int m = 0; m < 4; ++m)
#pragma unroll
                for (int n = 0; n < 2; ++n) acc[a][b][m][n] = (f32x4){0.f, 0.f, 0.f, 0.f};
    bf16x8 At[4][2], B0[2][2], B1[2][2];
    const char* cA = (const char*)g.A + (size_t)cur.pm * tstepA; const char* cB = (const char*)g.Bt + (size_t)cur.pn * tstepB;
    S.a_ready(cur);
    if constexpr (SP2) {
        PG8_STAGE(PG8_SB(0, 0), cB, voffB); PG8_STAGE(PG8_SB(0, 1), cB + hstepB, voffB); PG8_STAGE(PG8_SA(0, 0), cA, voffA); PG8_STAGE(PG8_SA(0, 1), cA + hstepA, voffA);
        if (wr == 1) PG8_BAR;
        PG8_WAIT_V(2); PG8_BAR;
        PG8_STAGE(PG8_SB(1, 0), cB + kstep, voffB); PG8_STAGE(PG8_SA(1, 0), cA + kstep, voffA); PG8_STAGE(PG8_SB(1, 1), cB + hstepB + kstep, voffB);
        PG8_WAIT_V(6); PG8_BAR;
    } else {
        PG8_STAGE(PG8_SB(0, 0), cB, voffB); PG8_STAGE(PG8_SA(0, 0), cA, voffA); PG8_STAGE(PG8_SB(0, 1), cB + hstepB, voffB); PG8_STAGE(PG8_SA(0, 1), cA + hstepA, voffA);
        if (wr == 1) PG8_BAR;
        PG8_WAIT_V(4); PG8_BAR;
        PG8_STAGE(PG8_SB(1, 0), cB + kstep, voffB); PG8_STAGE(PG8_SA(1, 0), cA + kstep, voffA); PG8_STAGE(PG8_SB(1, 1), cB + hstepB + kstep, voffB);
        PG8_WAIT_V(6); PG8_BAR;
    }
    for (;;) {
        const bool has_next = S.next(ui + 1, nxt);
        const char* nA = has_next ? (const char*)g.A + (size_t)nxt.pm * tstepA : cA; const char* nB = has_next ? (const char*)g.Bt + (size_t)nxt.pn * tstepB : cB;
        for (int t = 0; t < nt; t += 2) {
            const bool last = (t == nt - 2);
            const char* a1 = cA + (size_t)(t + 1) * kstep;
            const char* a2 = last ? nA : cA + (size_t)(t + 2) * kstep; const char* b2 = last ? nB : cB + (size_t)(t + 2) * kstep;
            const char* a3 = a2 + kstep; const char* b3 = b2 + kstep;
            if (last && has_next) S.a_ready(nxt);
            if constexpr (SP2) {
            PG8_LDB(B0, 0, 0); PG8_LDB(B1, 0, 1); PG8_SCHED; PG8_LDA(At, 0, 0); PG8_STAGE(PG8_SA(1, 1), a1 + hstepA, voffA);
            PG8_WAIT_V(8); PG8_WAIT_L(0); PG8_BAR; PG8_MMA(0, 0, At, B0); PG8_MMA(0, 1, At, B1); PG8_BAR; PG8_SCHED;
            PG8_LDA(At, 0, 1); PG8_STAGE(PG8_SB(0, 0), b2, voffB); PG8_STAGE(PG8_SB(0, 1), b2 + hstepB, voffB); PG8_STAGE(PG8_SA(0, 0), a2, voffA);
            PG8_WAIT_V(8); PG8_WAIT_L(0); PG8_BAR; PG8_MMA(1, 0, At, B0); PG8_MMA(1, 1, At, B1); PG8_BAR; PG8_SCHED;
            PG8_LDB(B0, 1, 0); PG8_LDB(B1, 1, 1); PG8_SCHED; PG8_LDA(At, 1, 0); PG8_STAGE(PG8_SA(0, 1), a2 + hstepA, voffA);
            PG8_WAIT_V(8); PG8_WAIT_L(0); PG8_BAR; PG8_MMA(0, 0, At, B0); PG8_MMA(0, 1, At, B1); PG8_BAR; PG8_SCHED;
            PG8_LDA(At, 1, 1); PG8_STAGE(PG8_SB(1, 0), b3, voffB); PG8_STAGE(PG8_SB(1, 1), b3 + hstepB, voffB); PG8_STAGE(PG8_SA(1, 0), a3, voffA);
            PG8_WAIT_V(8); PG8_WAIT_L(0); PG8_BAR; PG8_MMA(1, 0, At, B0); PG8_MMA(1, 1, At, B1); PG8_BAR; PG8_SCHED;
            } else {
            PG8_LDB(B0, 0, 0); PG8_SCHED; PG8_LDA(At, 0, 0); PG8_STAGE(PG8_SA(1, 1), a1 + hstepA, voffA);
            PG8_WAIT_L(8); PG8_BAR; PG8_WAIT_L(0); PG8_MMA(0, 0, At, B0); PG8_BAR; PG8_SCHED;
            PG8_LDB(B1, 0, 1); PG8_STAGE(PG8_SB(0, 0), b2, voffB);
            PG8_BAR; PG8_WAIT_L(0); PG8_MMA(0, 1, At, B1); PG8_BAR;
            PG8_LDA(At, 0, 1); PG8_STAGE(PG8_SA(0, 0), a2, voffA);
            PG8_BAR; PG8_WAIT_L(0); PG8_MMA(1, 0, At, B0); PG8_BAR; PG8_SCHED;
            PG8_STAGE(PG8_SB(0, 1), b2 + hstepB, voffB);
            PG8_WAIT_V(6); PG8_BAR; PG8_MMA(1, 1, At, B1); PG8_BAR;
            PG8_LDB(B0, 1, 0); PG8_SCHED; PG8_LDA(At, 1, 0); PG8_STAGE(PG8_SA(0, 1), a2 + hstepA, voffA);
            PG8_WAIT_L(8); PG8_BAR; PG8_WAIT_L(0); PG8_MMA(0, 0, At, B0); PG8_BAR; PG8_SCHED;
            PG8_LDB(B1, 1, 1); PG8_STAGE(PG8_SB(1, 0), b3, voffB);
            PG8_BAR; PG8_WAIT_L(0); PG8_MMA(0, 1, At, B1); PG8_BAR;
            PG8_LDA(At, 1, 1); PG8_STAGE(PG8_SA(1, 0), a3, voffA);
            PG8_BAR; PG8_WAIT_L(0); PG8_MMA(1, 0, At, B0); PG8_BAR; PG8_SCHED;
            PG8_STAGE(PG8_SB(1, 1), b3 + hstepB, voffB);
            PG8_WAIT_V(6); PG8_BAR; PG8_MMA(1, 1, At, B1); PG8_BAR;
            }
        }
        if constexpr (ALIGN_EPI) { if (wr == 0) PG8_BAR; }
        if constexpr (!Epi::AFTER_DRAIN) { E(acc, cur, wr, wc, fr, fq); S.done(cur); }
        if (!has_next) break;
#pragma unroll
        for (int a = 0; a < 2; ++a)
#pragma unroll
            for (int b = 0; b < 2; ++b)
#pragma unroll
                for (int m = 0; m < 4; ++m)
#pragma unroll
                    for (int n = 0; n < 2; ++n) acc[a][b][m][n] = (f32x4){0.f, 0.f, 0.f, 0.f};
        cur = nxt; cA = nA; cB = nB; ++ui;
        if constexpr (ALIGN_EPI) { if (wr == 1) PG8_BAR; }
    }
    PG8_WAIT_V(0);
    if constexpr (!ALIGN_EPI) { if (wr == 0) PG8_BAR; }
    PG8_BAR;
    if constexpr (Epi::AFTER_DRAIN) { E.fused(acc, cur, wr, wc, fr, fq, lds, wid, lane); S.done(cur); }
#undef PG8_SA
#undef PG8_SB
#undef PG8_STAGE
#undef PG8_LDA
#undef PG8_LDB
#undef PG8_MMA
#undef PG8_WAIT_V
#undef PG8_WAIT_L
#undef PG8_BAR
#undef PG8_SCHED
}
}

#define LAS __attribute__((address_space(3)))
typedef unsigned short bf16;
typedef unsigned v4u __attribute__((ext_vector_type(4)));
typedef unsigned v2u __attribute__((ext_vector_type(2)));
typedef float f32x4 __attribute__((ext_vector_type(4)));
typedef float f32x16 __attribute__((ext_vector_type(16)));
typedef short bf16x8 __attribute__((ext_vector_type(8)));
typedef short s16x4 __attribute__((ext_vector_type(4)));
typedef float f32x2_t __attribute__((ext_vector_type(2)));
typedef __bf16 bf16x2_t __attribute__((ext_vector_type(2)));

constexpr int NB = 8, SEQ = 2048, DM = 1024, TT = NB * SEQ;
constexpr int DIN = 7912, NP = 7936;
constexpr int PP = 3840, NZG = 4096;
constexpr int MEML = 256;
constexpr float EPS = 1e-6f, NEGF = -1e30f;
constexpr int C_QA = 0, C_KA = 512, C_VA = 1024, C_QI = 1536, C_KI = 2048, C_WI = 2112, C_CQ = 2120, C_CKV = 2504, C_KR = 2760, C_QM = 2792, C_ZM = 3304;
constexpr int C_YA = C_QI, C_YB = C_CQ, C_YM = C_VA;
constexpr float SCALE_A = 0.18033688011112042f;
constexpr float SCALE_B = 0.14724444602590306f;
constexpr float SCALE_M = 0.12751743082459868f;
constexpr float SCALE_I = 0.04419417382415922f;

__constant__ float INVA[8] = {1.0f, 0.1939227432012558f, 0.03760603070259094f, 0.007292664609849453f, 0.0014142135623842478f, 0.00027424818836152554f, 5.3182957344688475e-05f, 1.0313385246263351e-05f};
__constant__ float INVB[16] = {1.0f, 0.44036659598350525f, 0.1939227432012558f, 0.08539710193872452f, 0.03760603070259094f, 0.016560440883040428f, 0.007292664609849453f, 0.0032114461064338684f, 0.0014142135623842478f, 0.0006227724370546639f, 0.00027424818836152554f, 0.00012076973507646471f, 5.3182957344688475e-05f, 2.34199997066753e-05f, 1.0313385246263351e-05f, 4.541670477919979e-06f};

constexpr size_t MiB = 1u << 20;
constexpr size_t WS_CTL = 0;
constexpr size_t WS_WIN = 1 * MiB;
constexpr size_t WS_WUQ = 17 * MiB;
constexpr size_t WS_WUKV = 18 * MiB;
constexpr size_t WS_WMEM = 19 * MiB;
constexpr size_t WS_WBR = 21 * MiB;
constexpr size_t WS_WOUT = 24 * MiB;
constexpr size_t WS_ROPEA = 26 * MiB;
constexpr size_t WS_ROPEB = 27 * MiB;
constexpr size_t WS_MN = 29 * MiB;
constexpr size_t WS_KVM = 33 * MiB;
constexpr size_t WS_VTM = 37 * MiB;
constexpr size_t WS_WI = 39 * MiB;
constexpr size_t WS_MASK = 40 * MiB;
constexpr size_t WS_H = 44 * MiB;
constexpr size_t WS_P = 76 * MiB;
constexpr size_t WS_QB = 196 * MiB;
constexpr size_t WS_KVB = 220 * MiB;
constexpr size_t WS_G1 = 196 * MiB;
constexpr size_t WS_END = 256 * MiB;
constexpr size_t DO_VTA = 0;
constexpr size_t DO_VTB = 16 * MiB;
constexpr size_t DO_KB = 32 * MiB;
constexpr size_t DO_G0 = 0;

constexpr int REP_P0 = 1, REP_PH = 1, REP_G1 = 1, REP_G2 = 1, REP_IDX = 1, REP_ATT = 1, REP_G4 = 1, REP_G5 = 1;
constexpr int REP_IDX1 = 1, REP_SEL = 1;
constexpr int EXTRA_SYNCS = 0, REP_TR = 1, DUMMY_POST1 = 0, DUMMY_POST2 = 0;
constexpr int LDS_BYTES = 147456;
constexpr int LDS_SLOT = LDS_BYTES - 64;

__device__ __forceinline__ unsigned pk2(float lo, float hi) { f32x2_t v = {lo, hi}; bf16x2_t b = __builtin_convertvector(v, bf16x2_t); return __builtin_bit_cast(unsigned, b); }
__device__ __forceinline__ float bflo(unsigned w) { return __uint_as_float(w << 16); }
__device__ __forceinline__ float bfhi(unsigned w) { return __uint_as_float(w & 0xffff0000u); }
__device__ __forceinline__ float bf1(bf16 b) { return __uint_as_float(((unsigned)b) << 16); }
#define UNPACK8(W_, V_) do { V_[0] = bflo((W_)[0]); V_[1] = bfhi((W_)[0]); V_[2] = bflo((W_)[1]); V_[3] = bfhi((W_)[1]); V_[4] = bflo((W_)[2]); V_[5] = bfhi((W_)[2]); V_[6] = bflo((W_)[3]); V_[7] = bfhi((W_)[3]); } while (0)
#define PACK8(V_) (v4u){pk2(V_[0], V_[1]), pk2(V_[2], V_[3]), pk2(V_[4], V_[5]), pk2(V_[6], V_[7])}
__device__ __forceinline__ float wave_sum(float v) {
#pragma unroll
    for (int o = 1; o < 64; o <<= 1) v += __shfl_xor(v, o);
    return v;
}
#define LDS_WAIT() asm volatile("s_waitcnt lgkmcnt(0)" ::: "memory")

__device__ __forceinline__ int win_src(int d) {
    if (d < 2120) return d;
    if (d < 2792) return d + 512;
    if (d < 3816) return d + 1024;
    if (d < 3840) return -1;
    if (d < 4352) return d - 3840 + 2120;
    if (d < 4864) return d - 4352 + 3304;
    return d - 4864 + 4840;
}
template <bool REMAP>
__device__ __forceinline__ void transpose_item(const float* W, int K, int N, int Npad, bf16* WT, LAS float* scr, int item, int lane) {
    const int nblk = Npad / 32, kb = item / nblk, nb = item % nblk, k0 = 64 * kb, n0 = 32 * nb;
    const int nn = REMAP ? win_src(n0 + (lane & 31)) : n0 + (lane & 31); const bool ok = nn >= 0 && nn < N;
#pragma unroll 8
    for (int i = 0; i < 32; ++i) { const int kk = 2 * i + (lane >> 5); scr[kk * 33 + (lane & 31)] = ok ? W[(size_t)(k0 + kk) * N + nn] : 0.f; }
    LDS_WAIT(); asm volatile("" ::: "memory");
    const int c = lane & 7;
#pragma unroll
    for (int j = 0; j < 4; ++j) { const int n = (lane >> 3) + 8 * j; const LAS float* s = scr + (8 * c) * 33 + n;
        v4u o; o.x = pk2(s[0 * 33], s[1 * 33]); o.y = pk2(s[2 * 33], s[3 * 33]); o.z = pk2(s[4 * 33], s[5 * 33]); o.w = pk2(s[6 * 33], s[7 * 33]);
        *(v4u*)(WT + (size_t)(n0 + n) * K + k0 + 8 * c) = o; }
    LDS_WAIT(); asm volatile("" ::: "memory");
}
__device__ __forceinline__ void rms_row_1024(const float* xrow, const float* g, bf16* orow, int lane) {
    const f32x4* xr = (const f32x4*)xrow + lane; const f32x4* gr = (const f32x4*)g + lane;
    f32x4 v[4]; float s = 0.f;
#pragma unroll
    for (int j = 0; j < 4; ++j) { v[j] = xr[64 * j]; s += (v[j].x * v[j].x + v[j].y * v[j].y) + (v[j].z * v[j].z + v[j].w * v[j].w); }
    const float rstd = 1.0f / sqrtf(wave_sum(s) * (1.f / 1024.f) + EPS);
    v2u* o8 = (v2u*)orow + lane;
#pragma unroll
    for (int j = 0; j < 4; ++j) { const f32x4 gg = gr[64 * j]; v2u w; w.x = pk2(v[j].x * rstd * gg.x, v[j].y * rstd * gg.y); w.y = pk2(v[j].z * rstd * gg.z, v[j].w * rstd * gg.w); o8[64 * j] = w; }
}

#define ROPE8(v, sub, c8, s8) do { _Pragma("unroll") for (int j_ = 0; j_ < 8; ++j_) { const float pv_ = __shfl_xor(v[j_], 1); \
        const float r0_ = v[j_] * c8[j_] - pv_ * s8[j_], r1_ = v[j_] * c8[j_] + pv_ * s8[j_]; v[j_] = (sub) == 0 ? r0_ : ((sub) == 1 ? r1_ : v[j_]); } } while (0)

__device__ __forceinline__ void post1_row(const bf16* Prow, bf16* Orow, const float* ra, const float* gqa, const float* gka, const float* gcq, const float* gckv, const float* gqm, float* WIrow, int lane) {
    const int sub = lane & 7;
    const v4u z4 = (v4u){0u, 0u, 0u, 0u};
    const v4u w_qa = *(const v4u*)(Prow + C_QA + 8 * lane);
    const v4u w_ka = *(const v4u*)(Prow + C_KA + 8 * lane);
    const v4u w_qi = *(const v4u*)(Prow + C_QI + 8 * lane);
    const v4u w_qm = *(const v4u*)(Prow + C_QM + 8 * lane);
    v4u w_ki = z4, w_cq = z4, w_ckv = z4; float w_wi = 0.f;
    if (lane < 8) { w_ki = *(const v4u*)(Prow + C_KI + 8 * lane); w_wi = bf1(Prow[C_WI + lane]); }
    if (lane < 48) w_cq = *(const v4u*)(Prow + C_CQ + 8 * lane);
    if (lane < 32) w_ckv = *(const v4u*)(Prow + C_CKV + 8 * lane);
    float c8[8], s8[8];
#pragma unroll
    for (int j = 0; j < 8; ++j) { c8[j] = ra[j]; s8[j] = ra[8 + j]; }
    float ga[8], gk[8], gm[8], gq[8], gc[8];
#pragma unroll
    for (int j = 0; j < 8; ++j) { ga[j] = gqa[8 * sub + j]; gk[j] = gka[8 * sub + j]; gm[j] = gqm[8 * (lane & 15) + j]; gq[j] = lane < 48 ? gcq[8 * lane + j] : 0.f; gc[j] = lane < 32 ? gckv[8 * lane + j] : 0.f; }
    { float v[8]; UNPACK8(w_qa, v); float ss = 0.f;
#pragma unroll
      for (int j = 0; j < 8; ++j) ss += v[j] * v[j];
      ss += __shfl_xor(ss, 1); ss += __shfl_xor(ss, 2); ss += __shfl_xor(ss, 4);
      const float rstd = 1.0f / sqrtf(ss * (1.f / 64.f) + EPS);
#pragma unroll
      for (int j = 0; j < 8; ++j) v[j] = v[j] * rstd * ga[j];
      ROPE8(v, sub, c8, s8);
#pragma unroll
      for (int j = 0; j < 8; ++j) v[j] *= SCALE_A;
      *(v4u*)(Orow + C_QA + 8 * lane) = PACK8(v); }
    { float v[8]; UNPACK8(w_ka, v); float ss = 0.f;
#pragma unroll
      for (int j = 0; j < 8; ++j) ss += v[j] * v[j];
      ss += __shfl_xor(ss, 1); ss += __shfl_xor(ss, 2); ss += __shfl_xor(ss, 4);
      const float rstd = 1.0f / sqrtf(ss * (1.f / 64.f) + EPS);
#pragma unroll
      for (int j = 0; j < 8; ++j) v[j] = v[j] * rstd * gk[j];
      ROPE8(v, sub, c8, s8);
      *(v4u*)(Orow + C_KA + 8 * lane) = PACK8(v); }
    { float v[8]; UNPACK8(w_qi, v);
      ROPE8(v, sub, c8, s8);
      *(v4u*)(Orow + C_QI + 8 * lane) = PACK8(v); }
    { float v[8]; UNPACK8(w_ki, v);
      ROPE8(v, sub, c8, s8);
      if (lane < 8) *(v4u*)(Orow + C_KI + 8 * lane) = PACK8(v); }
    if (lane < 8) WIrow[lane] = w_wi * SCALE_I;
    { float v[8]; UNPACK8(w_cq, v); float ss = 0.f;
#pragma unroll
      for (int j = 0; j < 8; ++j) ss += v[j] * v[j];
      ss = wave_sum(ss); const float rstd = 1.0f / sqrtf(ss * (1.f / 384.f) + EPS);
      if (lane < 48) {
#pragma unroll
          for (int j = 0; j < 8; ++j) v[j] = v[j] * rstd * gq[j];
          *(v4u*)(Orow + C_CQ + 8 * lane) = PACK8(v); } }
    { float v[8]; UNPACK8(w_ckv, v); float ss = 0.f;
#pragma unroll
      for (int j = 0; j < 8; ++j) ss += v[j] * v[j];
      ss = wave_sum(ss); const float rstd = 1.0f / sqrtf(ss * (1.f / 256.f) + EPS);
      if (lane < 32) {
#pragma unroll
          for (int j = 0; j < 8; ++j) v[j] = v[j] * rstd * gc[j];
          *(v4u*)(Orow + C_CKV + 8 * lane) = PACK8(v); } }
    { float v[8]; UNPACK8(w_qm, v); float ss = 0.f;
#pragma unroll
      for (int j = 0; j < 8; ++j) ss += v[j] * v[j];
      ss += __shfl_xor(ss, 1); ss += __shfl_xor(ss, 2); ss += __shfl_xor(ss, 4); ss += __shfl_xor(ss, 8);
      const float rstd = 1.0f / sqrtf(ss * (1.f / 128.f) + EPS);
#pragma unroll
      for (int j = 0; j < 8; ++j) v[j] = v[j] * rstd * gm[j] * SCALE_M;
      *(v4u*)(Orow + C_QM + 8 * lane) = PACK8(v); }
}

__device__ __forceinline__ void km_row(bf16* row, const float* gkm, int lane) {
    v4u w = *(const v4u*)(row + 8 * lane); float v[8]; UNPACK8(w, v); float ss = 0.f;
#pragma unroll
    for (int j = 0; j < 8; ++j) ss += v[j] * v[j];
    ss += __shfl_xor(ss, 1); ss += __shfl_xor(ss, 2); ss += __shfl_xor(ss, 4); ss += __shfl_xor(ss, 8);
    const float rstd = 1.0f / sqrtf(ss * (1.f / 128.f) + EPS);
#pragma unroll
    for (int j = 0; j < 8; ++j) v[j] = v[j] * rstd * gkm[8 * (lane & 15) + j];
    *(v4u*)(row + 8 * lane) = PACK8(v);
}

__device__ __forceinline__ void transpose_v(const bf16* src, int pitch, int col0, int hstride, int H, int DV, int S, int nb, bf16* dst, int gw, int NGW, int lane) {
    const int ndq = DV / 64, nsc = S / 64, ntask = nb * H * nsc * ndq;
    for (int task = gw; task < ntask; task += NGW) {
        int x = task; const int dq = x % ndq; x /= ndq; const int sc = x % nsc; x /= nsc; const int h = x % H; const int b = x / H;
        const int s = sc * 64 + lane;
        const bf16* srow = src + (size_t)(b * S + s) * pitch + col0 + h * hstride + dq * 64;
        bf16* drow = dst + ((size_t)((b * H + h) * DV + dq * 64)) * S + s;
        v4u wv[8];
#pragma unroll
        for (int c = 0; c < 8; ++c) wv[c] = *(const v4u*)(srow + 8 * c);
#pragma unroll
        for (int c = 0; c < 8; ++c) { const v4u w = wv[c];
            drow[(size_t)(8 * c + 0) * S] = (bf16)(w.x & 0xffffu); drow[(size_t)(8 * c + 1) * S] = (bf16)(w.x >> 16);
            drow[(size_t)(8 * c + 2) * S] = (bf16)(w.y & 0xffffu); drow[(size_t)(8 * c + 3) * S] = (bf16)(w.y >> 16);
            drow[(size_t)(8 * c + 4) * S] = (bf16)(w.z & 0xffffu); drow[(size_t)(8 * c + 5) * S] = (bf16)(w.z >> 16);
            drow[(size_t)(8 * c + 6) * S] = (bf16)(w.w & 0xffffu); drow[(size_t)(8 * c + 7) * S] = (bf16)(w.w >> 16); }
    }
}

__device__ __forceinline__ void post2_row(const bf16* QBrow, bf16* QOrow, const bf16* KVBrow, const bf16* Prow, bf16* KBrow, const float* rb, const float* gq, const float* gk, LAS float* scr, int lane) {
    const int hd = lane >> 3, d0 = 12 * (lane & 7);
    float vq[12], vk[12], gqv[12], gkv[12], cc[12], sn[12];
    { const v2u* p = (const v2u*)(QBrow + 12 * lane);
      const v2u w0 = p[0], w1 = p[1], w2 = p[2];
      bf16 kr[12];
#pragma unroll
      for (int e = 0; e < 12; ++e) { const int d = d0 + e; kr[e] = d < 64 ? KVBrow[hd * 128 + d] : Prow[C_KR + d - 64]; }
#pragma unroll
      for (int e = 0; e < 12; ++e) { const int d = d0 + e; gqv[e] = gq[d]; gkv[e] = gk[d]; const int i = (d - 64) & 15; cc[e] = d < 64 ? 1.f : rb[i]; sn[e] = d < 64 ? 0.f : rb[16 + i]; }
      vq[0] = bflo(w0.x); vq[1] = bfhi(w0.x); vq[2] = bflo(w0.y); vq[3] = bfhi(w0.y); vq[4] = bflo(w1.x); vq[5] = bfhi(w1.x); vq[6] = bflo(w1.y); vq[7] = bfhi(w1.y);
      vq[8] = bflo(w2.x); vq[9] = bfhi(w2.x); vq[10] = bflo(w2.y); vq[11] = bfhi(w2.y);
#pragma unroll
      for (int e = 0; e < 12; ++e) vk[e] = bf1(kr[e]); }
    float sq = 0.f, sk = 0.f;
#pragma unroll
    for (int e = 0; e < 12; ++e) { sq += vq[e] * vq[e]; sk += vk[e] * vk[e]; }
    sq += __shfl_xor(sq, 1); sq += __shfl_xor(sq, 2); sq += __shfl_xor(sq, 4);
    sk += __shfl_xor(sk, 1); sk += __shfl_xor(sk, 2); sk += __shfl_xor(sk, 4);
    const float rq = 1.0f / sqrtf(sq * (1.f / 96.f) + EPS), rk = 1.0f / sqrtf(sk * (1.f / 96.f) + EPS);
#pragma unroll
    for (int e = 0; e < 12; ++e) { vq[e] = vq[e] * rq * gqv[e]; vk[e] = vk[e] * rk * gkv[e]; scr[12 * lane + e] = vq[e]; scr[768 + 12 * lane + e] = vk[e]; }
    LDS_WAIT(); asm volatile("" ::: "memory");
    float oq[12], ok[12];
#pragma unroll
    for (int e = 0; e < 12; ++e) { const int d = d0 + e;
        if (d < 64) { oq[e] = vq[e]; ok[e] = vk[e]; }
        else { const bool first = d < 80; const int off = first ? 16 : -16; const float pq = scr[12 * lane + e + off], pk = scr[768 + 12 * lane + e + off];
               oq[e] = first ? vq[e] * cc[e] - pq * sn[e] : vq[e] * cc[e] + pq * sn[e];
               ok[e] = first ? vk[e] * cc[e] - pk * sn[e] : vk[e] * cc[e] + pk * sn[e]; }
        oq[e] *= SCALE_B; }
    LDS_WAIT(); asm volatile("" ::: "memory");
    v2u* q = (v2u*)(QOrow + 12 * lane); v2u* k = (v2u*)(KBrow + 12 * lane);
#pragma unroll
    for (int i = 0; i < 3; ++i) { v2u w; w.x = pk2(oq[4 * i], oq[4 * i + 1]); w.y = pk2(oq[4 * i + 2], oq[4 * i + 3]); q[i] = w;
                                  v2u u; u.x = pk2(ok[4 * i], ok[4 * i + 1]); u.y = pk2(ok[4 * i + 2], ok[4 * i + 3]); k[i] = u; }
}

__device__ __forceinline__ int next_unit(unsigned* ctr, volatile LAS int* slot) {
    __syncthreads();
    if (threadIdx.x == 0) *slot = (int)atomicAdd(ctr, 1u);
    __syncthreads();
    return *slot;
}

constexpr int SCP = 2112;
__device__ __forceinline__ unsigned ord_key(float v) { const unsigned b = __float_as_uint(v); return b ^ ((unsigned)((int)b >> 31) | 0x80000000u); }
__device__ __forceinline__ void indexer_unit(LAS float* sc, const bf16* P, const float* WI, unsigned* MASK, int bb, int tb) {
    int tid_ = threadIdx.x; asm volatile("" : "+v"(tid_));
    const int tid = tid_, lane = tid & 63, w = __builtin_amdgcn_readfirstlane(tid >> 6);
    const int n = lane & 15, g = lane >> 4;
    const int rowbase = bb * SEQ, t0 = tb * 16;
    for (int rp1 = 0; rp1 < REP_IDX1; ++rp1) {
        bf16x8 qf[8][2]; float wq[8];
        const bf16* qrow = P + (size_t)(rowbase + t0 + n) * PP + C_QI + 8 * g;
#pragma unroll
        for (int h = 0; h < 8; ++h) {
            qf[h][0] = *(const bf16x8*)(qrow + h * 64);
            qf[h][1] = *(const bf16x8*)(qrow + h * 64 + 32);
            wq[h] = WI[(size_t)(rowbase + t0 + n) * 8 + h];
        }
        const int ntile = tb + 1;
        const int nmine = (ntile - w + 7) >> 3;
        const int ngrp = (nmine + 3) >> 2;
        const bf16* kbase = P + (size_t)(rowbase + n) * PP + C_KI + 8 * g;
        bf16x8 kb[2][4][2];
#define IDX_LOAD(BUF, GRP) do { _Pragma("unroll") for (int j_ = 0; j_ < 4; ++j_) { const int tile_ = w + 8 * (4 * (GRP) + j_); const int tl_ = tile_ < ntile ? tile_ : 0; \
            const bf16* kr_ = kbase + (size_t)(16 * tl_) * PP; kb[BUF][j_][0] = *(const bf16x8*)(kr_); kb[BUF][j_][1] = *(const bf16x8*)(kr_ + 32); } } while (0)
#define IDX_COMP(BUF, GRP) do { _Pragma("unroll") for (int j_ = 0; j_ < 4; ++j_) { const int tile_ = w + 8 * (4 * (GRP) + j_); if (tile_ < ntile) { \
            f32x4 idx_ = (f32x4){0.f, 0.f, 0.f, 0.f}; \
            _Pragma("unroll") for (int h_ = 0; h_ < 8; ++h_) { f32x4 a_ = (f32x4){0.f, 0.f, 0.f, 0.f}; \
                a_ = __builtin_amdgcn_mfma_f32_16x16x32_bf16(kb[BUF][j_][0], qf[h_][0], a_, 0, 0, 0); \
                a_ = __builtin_amdgcn_mfma_f32_16x16x32_bf16(kb[BUF][j_][1], qf[h_][1], a_, 0, 0, 0); \
                _Pragma("unroll") for (int i_ = 0; i_ < 4; ++i_) idx_[i_] = __builtin_fmaf(wq[h_], __builtin_fmaxf(a_[i_], 0.f), idx_[i_]); } \
            { const int k0_ = 16 * tile_ + 4 * g; LAS float* d_ = sc + n * SCP + k0_ + (k0_ >> 5); d_[0] = idx_[0]; d_[1] = idx_[1]; d_[2] = idx_[2]; d_[3] = idx_[3]; } } } } while (0)
        if (ngrp > 0) IDX_LOAD(0, 0);
        for (int gp = 0; gp < ngrp; gp += 2) {
            if (gp + 1 < ngrp) IDX_LOAD(1, gp + 1);
            IDX_COMP(0, gp);
            if (gp + 1 < ngrp) { if (gp + 2 < ngrp) IDX_LOAD(0, gp + 2); IDX_COMP(1, gp + 1); }
        }
#undef IDX_LOAD
#undef IDX_COMP
    }
    __syncthreads();
#pragma unroll 1
    for (int qq2 = 0; qq2 < 2 * REP_SEL; ++qq2) { const int qq = qq2 & 1;
        const int q = 2 * w + qq, t = t0 + q;
        unsigned* mrow = MASK + (size_t)(rowbase + t) * 64;
        const int nv = t - 32 * lane + 1;
        const unsigned valid = nv >= 32 ? 0xffffffffu : (nv <= 0 ? 0u : ((1u << nv) - 1u));
        if (t < 256) { mrow[lane] = valid; continue; }
        unsigned u[32];
        const LAS float* srow = sc + q * SCP + 33 * lane;
#pragma unroll
        for (int r = 0; r < 32; ++r) { const float v = srow[r]; u[r] = ((valid >> r) & 1u) ? ord_key(v) : 0u; }
#pragma unroll
        for (int si = 0; si < 5; ++si) { const int sft = 16 >> si;
            const unsigned msk = si == 0 ? 0x0000ffffu : (si == 1 ? 0x00ff00ffu : (si == 2 ? 0x0f0f0f0fu : (si == 3 ? 0x33333333u : 0x55555555u)));
#pragma unroll
            for (int k = 0; k < 32; ++k) if (!(k & sft)) { const unsigned tt = ((u[k] >> sft) ^ u[k + sft]) & msk; u[k + sft] ^= tt; u[k] ^= tt << sft; } }
        unsigned alive = valid, sel = 0u; int need = 256;
#pragma unroll
        for (int j = 31; j >= 0; --j) {
            const unsigned ones = alive & u[j];
            const unsigned cl = (unsigned)__popc(ones);
            int c = 0;
#pragma unroll
            for (int bt = 0; bt < 6; ++bt) c += __popcll(__ballot((cl >> bt) & 1u)) << bt;
            if (c >= need) { alive = ones; if (c == need) { sel |= ones; need = 0; break; } }
            else { need -= c; sel |= ones; alive &= ~u[j]; }
        }
        if (need > 0) {
            const int cnt = __popc(alive); int inc = cnt;
#pragma unroll
            for (int d = 1; d < 64; d <<= 1) { const int o = __shfl_up(inc, d); if (lane >= d) inc += o; }
            int k = need - (inc - cnt); k = k < 0 ? 0 : (k > cnt ? cnt : k);
            unsigned m = alive;
            for (int i = 0; i < k; ++i) { const unsigned low = m & (0u - m); sel |= low; m ^= low; }
        }
        mrow[lane] = sel;
    }
    __syncthreads();
}

__device__ __forceinline__ int crow(int r, int hi) { return (r & 3) + 8 * (r >> 2) + 4 * hi; }
template <int DQK, int DV, int MODE>
__device__ __forceinline__ void attn_unit(LAS unsigned char* lds, const bf16* Qb, int qpitch, const bf16* Kb, int kpitch, const bf16* VTb, int skv,
                                          const unsigned* maskb, const bf16* Zb, bf16* Ob, int q0) {
    constexpr int KP = DQK + 8, VP = 72;
    LAS bf16* Ks = (LAS bf16*)lds; LAS bf16* Vs = Ks + 64 * KP;
    constexpr int CPR = DQK / 8;
    constexpr int NCK = 64 * CPR, NCV = DV * 8;
    constexpr int RK = (NCK + 511) / 512, RV = (NCV + 511) / 512;
    constexpr int NKS = DQK / 16, NMT = DV / 32;
    int tid_ = threadIdx.x; asm volatile("" : "+v"(tid_));
    const int tid = tid_, lane = tid & 63, w = __builtin_amdgcn_readfirstlane(tid >> 6), r = lane & 31, hh = lane >> 5;
    const int NT = MODE == 0 ? skv / 64 : (q0 + 256) / 64;
    const int qlo = q0 + 32 * w;
    bf16x8 qf[NKS];
    { const bf16* qrow = Qb + (size_t)(qlo + r) * qpitch + 8 * hh;
#pragma unroll
      for (int ks = 0; ks < NKS; ++ks) qf[ks] = *(const bf16x8*)(qrow + 16 * ks); }
    f32x16 o[NMT];
#pragma unroll
    for (int mt = 0; mt < NMT; ++mt)
#pragma unroll
        for (int i = 0; i < 16; ++i) o[mt][i] = 0.f;
    float m_run = NEGF, l_run = 0.f;
    v4u kreg[RK], vreg[RV];
#define ATT_PREFETCH(tile_) do { \
        _Pragma("unroll") for (int i_ = 0; i_ < RK; ++i_) { const int c_ = tid + 512 * i_; if (c_ < NCK) { const int row_ = c_ / CPR, cc_ = c_ % CPR; kreg[i_] = *(const v4u*)(Kb + (size_t)(64 * (tile_) + row_) * kpitch + 8 * cc_); } } \
        _Pragma("unroll") for (int i_ = 0; i_ < RV; ++i_) { const int c_ = tid + 512 * i_; if (c_ < NCV) { const int d_ = c_ >> 3, cc_ = c_ & 7; vreg[i_] = *(const v4u*)(VTb + (size_t)d_ * skv + 64 * (tile_) + 8 * cc_); } } } while (0)
    ATT_PREFETCH(0);
    for (int tile = 0; tile < NT; ++tile) {
        __syncthreads();
#pragma unroll
        for (int i = 0; i < RK; ++i) { const int c = tid + 512 * i; if (c < NCK) { const int row = c / CPR, cc = c % CPR; *(LAS v4u*)(Ks + row * KP + 8 * cc) = kreg[i]; } }
#pragma unroll
        for (int i = 0; i < RV; ++i) { const int c = tid + 512 * i; if (c < NCV) { const int d = c >> 3, cc = c & 7; *(LAS v4u*)(Vs + d * VP + 8 * cc) = vreg[i]; } }
        __syncthreads();
        if (tile + 1 < NT) ATT_PREFETCH(tile + 1);
        if (MODE != 0 && 64 * tile > qlo + 31) continue;
        unsigned mw0 = 0u, mw1 = 0u;
        if (MODE == 2) { const v2u mm = *(const v2u*)(maskb + (size_t)(qlo + r) * 64 + 2 * tile); mw0 = mm.x >> (4 * hh); mw1 = mm.y >> (4 * hh); }
        f32x16 s0, s1;
#pragma unroll
        for (int i = 0; i < 16; ++i) { s0[i] = 0.f; s1[i] = 0.f; }
#pragma unroll
        for (int ks = 0; ks < NKS; ++ks) {
            const bf16x8 a0 = *(const LAS bf16x8*)(Ks + r * KP + 16 * ks + 8 * hh);
            const bf16x8 a1 = *(const LAS bf16x8*)(Ks + (32 + r) * KP + 16 * ks + 8 * hh);
            s0 = __builtin_amdgcn_mfma_f32_32x32x16_bf16(a0, qf[ks], s0, 0, 0, 0);
            s1 = __builtin_amdgcn_mfma_f32_32x32x16_bf16(a1, qf[ks], s1, 0, 0, 0);
        }
        if (MODE == 1) {
            if (64 * tile + 63 > qlo) { const int qg = qlo + r;
#pragma unroll
                for (int i = 0; i < 16; ++i) { const int key = 64 * tile + crow(i, hh); if (key > qg) s0[i] = NEGF; if (key + 32 > qg) s1[i] = NEGF; } }
        }
        if (MODE == 2) {
#pragma unroll
            for (int i = 0; i < 16; ++i) { const int bit = (i & 3) + 8 * (i >> 2); if (!((mw0 >> bit) & 1u)) s0[i] = NEGF; if (!((mw1 >> bit) & 1u)) s1[i] = NEGF; }
        }
        float mx = s0[0];
#pragma unroll
        for (int i = 1; i < 16; ++i) mx = __builtin_fmaxf(mx, s0[i]);
#pragma unroll
        for (int i = 0; i < 16; ++i) mx = __builtin_fmaxf(mx, s1[i]);
        mx = __builtin_fmaxf(mx, __shfl_xor(mx, 32));
        const float m_new = __builtin_fmaxf(m_run, mx);
        const float alpha = __builtin_amdgcn_exp2f(m_run - m_new);
        m_run = m_new;
        float ls = 0.f;
#pragma unroll
        for (int i = 0; i < 16; ++i) { s0[i] = __builtin_amdgcn_exp2f(s0[i] - m_new); s1[i] = __builtin_amdgcn_exp2f(s1[i] - m_new); ls += s0[i] + s1[i]; }
        l_run = l_run * alpha + ls;
#pragma unroll
        for (int mt = 0; mt < NMT; ++mt)
#pragma unroll
            for (int i = 0; i < 16; ++i) o[mt][i] *= alpha;
        v4u pf[2][2];
#pragma unroll
        for (int s = 0; s < 2; ++s) {
            pf[0][s] = (v4u){pk2(s0[8 * s], s0[8 * s + 1]), pk2(s0[8 * s + 2], s0[8 * s + 3]), pk2(s0[8 * s + 4], s0[8 * s + 5]), pk2(s0[8 * s + 6], s0[8 * s + 7])};
            pf[1][s] = (v4u){pk2(s1[8 * s], s1[8 * s + 1]), pk2(s1[8 * s + 2], s1[8 * s + 3]), pk2(s1[8 * s + 4], s1[8 * s + 5]), pk2(s1[8 * s + 6], s1[8 * s + 7])};
        }
#pragma unroll
        for (int mt = 0; mt < NMT; ++mt)
#pragma unroll
            for (int p = 0; p < 2; ++p)
#pragma unroll
                for (int s = 0; s < 2; ++s) {
                    const LAS bf16* vp = Vs + (32 * mt + r) * VP + 32 * p + 16 * s + 4 * hh;
                    const s16x4 lo = *(const LAS s16x4*)(vp), hi = *(const LAS s16x4*)(vp + 8);
                    const bf16x8 a = (bf16x8){lo[0], lo[1], lo[2], lo[3], hi[0], hi[1], hi[2], hi[3]};
                    o[mt] = __builtin_amdgcn_mfma_f32_32x32x16_bf16(a, __builtin_bit_cast(bf16x8, pf[p][s]), o[mt], 0, 0, 0);
                }
    }
#undef ATT_PREFETCH
    const float l_tot = l_run + __shfl_xor(l_run, 32);
    const float inv = 1.0f / l_tot;
    const size_t row = (size_t)(qlo + r);
#pragma unroll
    for (int mt = 0; mt < NMT; ++mt)
#pragma unroll
        for (int g4 = 0; g4 < 4; ++g4) {
            const int d = 32 * mt + 8 * g4 + 4 * hh;
            float ov[4];
#pragma unroll
            for (int i = 0; i < 4; ++i) ov[i] = o[mt][4 * g4 + i] * inv;
            if (Zb) { const v2u zw = *(const v2u*)(Zb + row * PP + d); const float z[4] = {bflo(zw.x), bfhi(zw.x), bflo(zw.y), bfhi(zw.y)};
#pragma unroll
                for (int i = 0; i < 4; ++i) ov[i] *= z[i] / (1.0f + __expf(-z[i])); }
            v2u ow; ow.x = pk2(ov[0], ov[1]); ow.y = pk2(ov[2], ov[3]);
            *(v2u*)(Ob + row * PP + d) = ow;
        }
}

__device__ __forceinline__ bf16* gate_row(bf16* G0, bf16* G1, size_t row) { return row < 8192 ? G0 + row * 3072 : G1 + (row - 8192) * 3072; }
struct EpiZG {
    static constexpr bool PERM = true, AFTER_DRAIN = false;
    bf16* P; bf16* G0; bf16* G1;
    __device__ __forceinline__ void operator()(const pg8::f32x4 (&acc)[2][2][4][2], const pg8::Unit& u, int wr, int wc, int fr, int fq) const {
        const int row0 = u.pm * 256 + wr * 64 + fr, cl = wc * 32 + 8 * fq;
        const bool isz = u.pn < 4;
        const int ycol = (u.pn < 2 ? C_YA : C_YB) + (u.pn & 1) * 256, gcol = (u.pn - 4) * 256;
#pragma unroll
        for (int ai = 0; ai < 2; ++ai)
#pragma unroll
            for (int m = 0; m < 4; ++m) { const size_t row = (size_t)(row0 + ai * 128 + m * 16);
#pragma unroll
                for (int bj = 0; bj < 2; ++bj) {
                    const pg8::f32x4 v0 = acc[ai][bj][m][0], v1 = acc[ai][bj][m][1];
                    float rr[8] = {v0[0], v0[1], v0[2], v0[3], v1[0], v1[1], v1[2], v1[3]};
                    if (isz) { bf16* dst = P + row * PP + ycol + cl + bj * 128; const v4u old = *(const v4u*)dst; float yv[8]; UNPACK8(old, yv);
#pragma unroll
                        for (int e = 0; e < 8; ++e) rr[e] = yv[e] * (rr[e] / (1.0f + __expf(-rr[e])));
                        *(v4u*)dst = PACK8(rr); }
                    else { bf16* dst = gate_row(G0, G1, row) + gcol + cl + bj * 128;
#pragma unroll
                        for (int e = 0; e < 8; ++e) rr[e] = 1.0f / (1.0f + __expf(-rr[e]));
                        *(v4u*)dst = PACK8(rr); } } }
    }
};
struct EpiMerge {
    static constexpr bool PERM = true, AFTER_DRAIN = false;
    bf16* Mg; bf16* G0; bf16* G1; int nbr;
    __device__ __forceinline__ void operator()(const pg8::f32x4 (&acc)[2][2][4][2], const pg8::Unit& u, int wr, int wc, int fr, int fq) const {
        const int row0 = u.pm * 256 + wr * 64 + fr, col0 = u.pn * 256 + wc * 32 + 8 * fq;
#pragma unroll
        for (int ai = 0; ai < 2; ++ai)
#pragma unroll
            for (int m = 0; m < 4; ++m) { const size_t row = (size_t)(row0 + ai * 128 + m * 16);
#pragma unroll
                for (int bj = 0; bj < 2; ++bj) { const int col = col0 + bj * 128;
                    const v4u gwd = *(const v4u*)(gate_row(G0, G1, row) + nbr * 1024 + col);
                    float gl[8]; UNPACK8(gwd, gl);
                    const pg8::f32x4 v0 = acc[ai][bj][m][0], v1 = acc[ai][bj][m][1];
                    float rr[8] = {v0[0], v0[1], v0[2], v0[3], v1[0], v1[1], v1[2], v1[3]};
#pragma unroll
                    for (int e = 0; e < 8; ++e) rr[e] *= gl[e];
                    bf16* dst = Mg + row * 1024 + col;
                    if (nbr > 0) { const v4u old = *(const v4u*)dst; float ol[8]; UNPACK8(old, ol);
#pragma unroll
                        for (int e = 0; e < 8; ++e) rr[e] += ol[e]; }
                    *(v4u*)dst = PACK8(rr); } }
    }
};
struct EpiOut {
    static constexpr bool PERM = true, AFTER_DRAIN = false;
    const float* X; float* Out;
    __device__ __forceinline__ void operator()(const pg8::f32x4 (&acc)[2][2][4][2], const pg8::Unit& u, int wr, int wc, int fr, int fq) const {
        const int row0 = u.pm * 256 + wr * 64 + fr, col0 = u.pn * 256 + wc * 32 + 8 * fq;
#pragma unroll
        for (int ai = 0; ai < 2; ++ai)
#pragma unroll
            for (int m = 0; m < 4; ++m) { const size_t row = (size_t)(row0 + ai * 128 + m * 16);
#pragma unroll
                for (int bj = 0; bj < 2; ++bj) { const size_t p = row * 1024 + col0 + bj * 128;
                    const f32x4 x0 = *(const f32x4*)(X + p), x1 = *(const f32x4*)(X + p + 4);
                    const pg8::f32x4 a0 = acc[ai][bj][m][0], a1 = acc[ai][bj][m][1];
                    *(f32x4*)(Out + p) = (f32x4){x0[0] + a0[0], x0[1] + a0[1], x0[2] + a0[2], x0[3] + a0[3]};
                    *(f32x4*)(Out + p + 4) = (f32x4){x1[0] + a1[0], x1[1] + a1[1], x1[2] + a1[2], x1[3] + a1[3]}; } }
    }
};

#define XB_TMO      128
#define XB_XCNT(j)  (256  + 64 * (j))
#define XB_XSUB(j)  (1280 + 64 * (j))
#define XB_XGEN(j)  (2304 + 64 * (j))
#define XB_TOP      3328
#define XB_TOPGEN   3392
#define XCD_BAR_WORDS 3456
#define XB_SPIN_CAP (1u << 18)

__device__ __forceinline__ unsigned xb_ld(unsigned* p)              { return __hip_atomic_load(p, __ATOMIC_RELAXED, __HIP_MEMORY_SCOPE_AGENT); }
__device__ __forceinline__ unsigned xb_add(unsigned* p, unsigned v) { return __hip_atomic_fetch_add(p, v, __ATOMIC_RELAXED, __HIP_MEMORY_SCOPE_AGENT); }
__device__ __forceinline__ unsigned xb_xcc_id() { return (unsigned)__builtin_amdgcn_s_getreg((3 << 11) | 20) & 0xFu; }
#define XB_SPIN(cond, bar) do { unsigned _sp = 0; while (cond) { __builtin_amdgcn_s_sleep(1); \
    if ((++_sp & 255u) == 0u) { if (xb_ld(&(bar)[XB_TMO])) break; if (_sp > XB_SPIN_CAP) { atomicAdd(&(bar)[XB_TMO], 1u); break; } } } } while (0)

struct XcdBarrier {
    unsigned* bar; unsigned x;
    volatile LAS unsigned* st;
};

__device__ __forceinline__ XcdBarrier xcd_barrier_post(unsigned* bar, volatile LAS unsigned* st) {
    XcdBarrier b; b.bar = bar; b.x = xb_xcc_id(); b.st = st;
    if (threadIdx.x == 0) (void)xb_add(&bar[XB_XCNT(b.x)], 1u);
    return b;
}
__device__ __forceinline__ void xcd_barrier_complete(unsigned* bar, unsigned x, unsigned& nloc, unsigned& nx) {
    const unsigned G = gridDim.x * gridDim.y * gridDim.z;
    unsigned sum, cnt, mine, sp = 0u;
    for (;;) {
        sum = 0u; cnt = 0u; mine = 0u;
#pragma unroll
        for (unsigned j = 0; j < 16; ++j) { const unsigned c = xb_ld(&bar[XB_XCNT(j)]); sum += c; cnt += (c > 0u) ? 1u : 0u; mine = (j == x) ? c : mine; }
        if (sum == G) break;
        __builtin_amdgcn_s_sleep(1);
        if ((++sp & 255u) == 0u) { if (xb_ld(&bar[XB_TMO])) break; if (sp > XB_SPIN_CAP) { atomicAdd(&bar[XB_TMO], 1u); break; } }
    }
    nloc = mine > 0u ? mine : 1u; nx = cnt > 0u ? cnt : 1u;
}

__device__ __forceinline__ void xcd_barrier(const XcdBarrier& b) {
    asm volatile("s_waitcnt vmcnt(0)" ::: "memory");
    __syncthreads();
    if (threadIdx.x == 0) {
        unsigned* bar = b.bar;
        __builtin_amdgcn_s_waitcnt(0);
        unsigned nloc = b.st[0], nx = b.st[1];
        if (nloc == 0u) { xcd_barrier_complete(bar, b.x, nloc, nx); b.st[0] = nloc; b.st[1] = nx; }
        const unsigned old = xb_add(&bar[XB_XSUB(b.x)], 1u);
        const unsigned gen = old / nloc;
        if (old + 1u == (gen + 1u) * nloc) {
            __builtin_amdgcn_fence(__ATOMIC_RELEASE, "agent");
            asm volatile("s_waitcnt vmcnt(0)" ::: "memory");
            const unsigned og = xb_add(&bar[XB_TOP], 1u);
            const unsigned tg = og / nx;
            if (og + 1u == (tg + 1u) * nx) xb_add(&bar[XB_TOPGEN], 1u);
            else XB_SPIN(xb_ld(&bar[XB_TOPGEN]) == tg, bar);
            __builtin_amdgcn_fence(__ATOMIC_ACQUIRE, "agent");
            xb_add(&bar[XB_XGEN(b.x)], 1u);
            asm volatile("s_waitcnt vmcnt(0)" ::: "memory");
        } else {
            XB_SPIN(xb_ld(&bar[XB_XGEN(b.x)]) == gen, bar);
            __builtin_amdgcn_fence(__ATOMIC_ACQUIRE, "agent");
            asm volatile("s_waitcnt vmcnt(0)" ::: "memory");
        }
    }
    __syncthreads();
}

struct Args { const float* in[19]; const int* pos; float* out; unsigned char* ws; };
typedef const __attribute__((address_space(4))) Args* kargs_t;
#define PHASE_BEGIN \
    kargs_t ap_ = (kargs_t)__builtin_amdgcn_kernarg_segment_ptr(); asm volatile("" : "+s"(ap_)); \
    int tid = threadIdx.x; asm volatile("" : "+v"(tid)); \
    const int lane = tid & 63, wave = __builtin_amdgcn_readfirstlane(tid >> 6), G = gridDim.x, NGW = G * 8, gw = blockIdx.x * 8 + wave; \
    unsigned char* const ws = ap_->ws; unsigned char* const dob = (unsigned char*)ap_->out; const int* const pos = ap_->pos; float* const outp = ap_->out; unsigned* const ctl = (unsigned*)(ws + WS_CTL); \
    const float* const x = ap_->in[0]; const float* const mem = ap_->in[1]; \
    const float* const g_norm = ap_->in[3]; const float* const w_in = ap_->in[4]; const float* const g_qn_a = ap_->in[5]; const float* const g_kn_a = ap_->in[6]; \
    const float* const g_cq = ap_->in[7]; const float* const g_ckv = ap_->in[8]; const float* const w_uq = ap_->in[9]; const float* const w_ukv = ap_->in[10]; \
    const float* const g_qn_b = ap_->in[11]; const float* const g_kn_b = ap_->in[12]; const float* const g_mem = ap_->in[13]; const float* const w_mem_kv = ap_->in[14]; \
    const float* const g_qn_m = ap_->in[15]; const float* const g_kn_m = ap_->in[16]; const float* const w_branch = ap_->in[17]; const float* const w_out = ap_->in[18]; \
    bf16* const WinT = (bf16*)(ws + WS_WIN); bf16* const WuqT = (bf16*)(ws + WS_WUQ); bf16* const WukvT = (bf16*)(ws + WS_WUKV); bf16* const WmemT = (bf16*)(ws + WS_WMEM); \
    bf16* const WbrT = (bf16*)(ws + WS_WBR); bf16* const WoutT = (bf16*)(ws + WS_WOUT); \
    float* const ropeA = (float*)(ws + WS_ROPEA); float* const ropeB = (float*)(ws + WS_ROPEB); \
    bf16* const MN = (bf16*)(ws + WS_MN); bf16* const KVM = (bf16*)(ws + WS_KVM); bf16* const VTM = (bf16*)(ws + WS_VTM); \
    float* const WI = (float*)(ws + WS_WI); unsigned* const MASK = (unsigned*)(ws + WS_MASK); \
    bf16* const VTA = (bf16*)(dob + DO_VTA); bf16* const VTB = (bf16*)(dob + DO_VTB); bf16* const KB = (bf16*)(dob + DO_KB); \
    bf16* const Hh = (bf16*)(ws + WS_H); bf16* const MG = (bf16*)(ws + WS_H); bf16* const QB = (bf16*)(ws + WS_QB); \
    bf16* const KVB = (bf16*)(ws + WS_KVB); bf16* const GT0 = (bf16*)(dob + DO_G0); bf16* const GT1 = (bf16*)(ws + WS_G1); bf16* const P = (bf16*)(ws + WS_P); \
    (void)lane; (void)NGW; (void)gw; (void)ctl; \
    (void)pos; (void)outp; (void)x; (void)mem; (void)g_norm; (void)w_in; (void)g_qn_a; (void)g_kn_a; (void)g_cq; (void)g_ckv; (void)w_uq; (void)w_ukv; (void)g_qn_b; (void)g_kn_b; (void)g_mem; (void)w_mem_kv; \
    (void)g_qn_m; (void)g_kn_m; (void)w_branch; (void)w_out; (void)WinT; (void)WuqT; (void)WukvT; (void)WmemT; (void)WbrT; (void)WoutT; (void)ropeA; (void)ropeB; (void)MN; (void)KVM; (void)VTM; (void)WI; (void)MASK; \
    (void)VTA; (void)VTB; (void)Hh; (void)KB; (void)QB; (void)KVB; (void)MG; (void)GT0; (void)GT1; (void)P
#define GRID_BARRIER() do { kargs_t bp_ = (kargs_t)__builtin_amdgcn_kernarg_segment_ptr(); asm volatile("" : "+s"(bp_)); \
    XcdBarrier b_; b_.bar = (unsigned*)(bp_->ws + WS_CTL) + 4096; b_.x = xb_xcc_id(); b_.st = (volatile LAS unsigned*)(lds + LDS_BYTES - 32); xcd_barrier(b_); } while (0)

__global__ void __launch_bounds__(512, 2) fwd_kernel(Args a) {
    extern __shared__ __attribute__((aligned(16))) unsigned char lds_raw[];
    LAS unsigned char* const lds = (LAS unsigned char*)lds_raw;
    volatile LAS int* const slot = (volatile LAS int*)(lds + LDS_SLOT);
    if (threadIdx.x < 16) ((LAS unsigned*)(lds + LDS_BYTES - 64))[threadIdx.x] = 0u;
    __syncthreads();
    (void)xcd_barrier_post((unsigned*)(a.ws + WS_CTL) + 4096, (volatile LAS unsigned*)(lds + LDS_BYTES - 32));

    for (int rep = 0; rep < REP_P0; ++rep) { PHASE_BEGIN;
        LAS float* scr = (LAS float*)(lds + wave * 16384);
        constexpr int I_IN = 16 * (NP / 32), I_UQ = 6 * 24, I_UKV = 4 * 32, I_MEM = 16 * 32, I_BR = 8 * 32, I_OUT = 16 * 32;
        constexpr int NITEMS = I_IN + I_UQ + I_UKV + I_MEM + 3 * I_BR + I_OUT;
        for (int it = gw; it < NITEMS; it += NGW) {
            int r = it;
            if (r < I_IN) { transpose_item<true>(w_in, 1024, DIN, NP, WinT, scr, r, lane); continue; } r -= I_IN;
            if (r < I_UQ) { transpose_item<false>(w_uq, 384, 768, 768, WuqT, scr, r, lane); continue; } r -= I_UQ;
            if (r < I_UKV) { transpose_item<false>(w_ukv, 256, 1024, 1024, WukvT, scr, r, lane); continue; } r -= I_UKV;
            if (r < I_MEM) { transpose_item<false>(w_mem_kv, 1024, 1024, 1024, WmemT, scr, r, lane); continue; } r -= I_MEM;
            if (r < 3 * I_BR) { const int nb = r / I_BR; transpose_item<false>(w_branch + (size_t)nb * 512 * 1024, 512, 1024, 1024, WbrT + (size_t)nb * 1024 * 512, scr, r % I_BR, lane); continue; } r -= 3 * I_BR;
            transpose_item<false>(w_out, 1024, 1024, 1024, WoutT, scr, r, lane);
        }
        for (int idx = blockIdx.x * 512 + tid; idx < TT * 24; idx += G * 512) {
            const int t = idx / 24, i = idx % 24; const float pf = (float)pos[t];
            if (i < 8) { const float ang = pf * INVA[i]; ropeA[t * 16 + i] = cosf(ang); ropeA[t * 16 + 8 + i] = sinf(ang); }
            else { const int j = i - 8; const float ang = pf * INVB[j]; ropeB[t * 32 + j] = cosf(ang); ropeB[t * 32 + 16 + j] = sinf(ang); }
        }
        for (int m = gw; m < NB * MEML; m += NGW) rms_row_1024(mem + (size_t)m * DM, g_mem, MN + (size_t)m * DM, lane);
        for (int rp = 0; rp < REP_PH; ++rp)
        for (int m = gw; m < TT; m += NGW) rms_row_1024(x + (size_t)m * DM, g_norm, Hh + (size_t)m * DM, lane);
    }
    GRID_BARRIER();
    for (int es = 0; es < EXTRA_SYNCS; ++es) GRID_BARRIER();

    for (int rep = 0; rep < REP_G1; ++rep) { PHASE_BEGIN;
        pg8::Gemm g{Hh, WinT, TT, PP, 1024, 1024}; pg8::StaticOrder S; S.init(TT, PP, G, (int)blockIdx.x);
        pg8::EpiBf16<0> E{P, PP, nullptr, 0, 0, 1.f};
        pg8::gemm_phase<pg8::EpiBf16<0>, pg8::StaticOrder, true, true>(lds, g, S, E);
    }
    { PHASE_BEGIN;
        pg8::Gemm g{MN, WmemT, NB * MEML, 1024, 1024, 1024}; pg8::StaticOrder S; S.init(NB * MEML, 1024, G, (int)((blockIdx.x + 64) % G));
        pg8::EpiBf16<0> E{KVM, 1024, nullptr, 0, 0, 1.f};
        pg8::gemm_phase<pg8::EpiBf16<0>, pg8::StaticOrder, true, true>(lds, g, S, E);
    }
    GRID_BARRIER();
    { PHASE_BEGIN;
        for (int dp = 0; dp < DUMMY_POST1; ++dp)
            for (int m = gw; m < TT; m += NGW)
                post1_row(P + (size_t)m * PP, QB + (size_t)(m & 1023) * 4096, ropeA + (size_t)m * 16, g_qn_a, g_kn_a, g_cq, g_ckv, g_qn_m, (float*)KVB + (size_t)m * 8, lane);
        for (int m = gw; m < TT; m += NGW)
            post1_row(P + (size_t)m * PP, P + (size_t)m * PP, ropeA + (size_t)m * 16, g_qn_a, g_kn_a, g_cq, g_ckv, g_qn_m, WI + (size_t)m * 8, lane);
        for (int rt = 0; rt < REP_TR; ++rt)
        transpose_v(P, PP, C_VA, 64, 8, 64, SEQ, NB, VTA, gw, NGW, lane);
        for (int m = gw; m < NB * MEML; m += NGW) km_row(KVM + (size_t)m * 1024, g_kn_m, lane);
        for (int rt = 0; rt < REP_TR; ++rt)
        transpose_v(KVM, 1024, 512, 128, 4, 128, MEML, NB, VTM, gw, NGW, lane);
    }
    GRID_BARRIER();
    for (int rep = 0; rep < REP_G2; ++rep) { PHASE_BEGIN;
        pg8::Gemm g{P + C_CQ, WuqT, TT, 768, 384, PP}; pg8::StaticOrder S; S.init(TT, 768, G, (int)blockIdx.x);
        pg8::EpiBf16<0> E{QB, 768, nullptr, 0, 0, 1.f};
        pg8::gemm_phase<pg8::EpiBf16<0>, pg8::StaticOrder, true, true>(lds, g, S, E);
    }
    for (int rep = 0; rep < REP_G2; ++rep) { PHASE_BEGIN;
        pg8::Gemm g{P + C_CKV, WukvT, TT, 1024, 256, PP}; pg8::StaticOrder S; S.init(TT, 1024, G, (int)((blockIdx.x + 192) % G));
        pg8::EpiBf16<0> E{KVB, 1024, nullptr, 0, 0, 1.f};
        pg8::gemm_phase<pg8::EpiBf16<0>, pg8::StaticOrder, true, true>(lds, g, S, E);
    }
    for (int rep = 0; rep < REP_IDX; ++rep) { if (rep > 0) GRID_BARRIER();
        PHASE_BEGIN;
        unsigned* const q_idx = ctl + 64 * (0 + 4 * rep);
        for (;;) {
            const int u = next_unit(q_idx, slot);
            if (u >= NB * 128) break;
            const int tb = 127 - (u >> 3), bb = u & 7;
            indexer_unit((LAS float*)lds, P, WI, MASK, bb, tb);
        }
    }
    GRID_BARRIER();
    { PHASE_BEGIN;
        LAS float* scr = (LAS float*)(lds + wave * 8192);
        for (int dp = 0; dp < DUMMY_POST2; ++dp)
            for (int m = gw; m < TT; m += NGW)
                post2_row(QB + (size_t)m * 768, (bf16*)MASK + (size_t)(m & 1023) * 768, KVB + (size_t)m * 1024, P + (size_t)m * PP, (bf16*)MASK + (size_t)(1024 + (m & 1023)) * 768, ropeB + (size_t)m * 32, g_qn_b, g_kn_b, scr, lane);
        for (int m = gw; m < TT; m += NGW)
            post2_row(QB + (size_t)m * 768, QB + (size_t)m * 768, KVB + (size_t)m * 1024, P + (size_t)m * PP, KB + (size_t)m * 768, ropeB + (size_t)m * 32, g_qn_b, g_kn_b, scr, lane);
        for (int rt = 0; rt < REP_TR; ++rt)
        transpose_v(KVB, 1024, 64, 128, 8, 64, SEQ, NB, VTB, gw, NGW, lane);
    }
    GRID_BARRIER();
    for (int rep = 0; rep < REP_ATT; ++rep) { if (rep > 0) GRID_BARRIER();
        PHASE_BEGIN;
        unsigned* const q_att = ctl + 64 * (1 + 4 * rep);
        for (;;) {
            const int u = next_unit(q_att, slot);
            if (u >= 1536) break;
            if (u < 1024) {
                const int qb = 7 - (u >> 7), wi = u & 127, bh = wi & 63, bb = bh >> 3, h = bh & 7;
                const size_t r0 = (size_t)bb * SEQ;
                if (wi < 64) attn_unit<96, 64, 1>(lds, QB + r0 * 768 + h * 96, 768, KB + r0 * 768 + h * 96, 768, VTB + (size_t)((bb * 8 + h) * 64) * SEQ, SEQ, nullptr,
                                                  nullptr, P + r0 * PP + C_YB + h * 64, qb * 256);
                else attn_unit<64, 64, 2>(lds, P + r0 * PP + C_QA + h * 64, PP, P + r0 * PP + C_KA + h * 64, PP, VTA + (size_t)((bb * 8 + h) * 64) * SEQ, SEQ, MASK + r0 * 64,
                                          nullptr, P + r0 * PP + C_YA + h * 64, qb * 256);
            } else {
                const int v = u - 1024, vh = v & 1, qb = (v >> 1) & 7, bh = v >> 4, bb = bh >> 2, h = bh & 3;
                const size_t r0 = (size_t)bb * SEQ;
                attn_unit<128, 64, 0>(lds, P + r0 * PP + C_QM + h * 128, PP, KVM + (size_t)bb * MEML * 1024 + h * 128, 1024, VTM + (size_t)((bb * 4 + h) * 128 + vh * 64) * MEML, MEML, nullptr,
                                      P + r0 * PP + C_ZM + h * 128 + vh * 64, P + r0 * PP + C_YM + h * 128 + vh * 64, qb * 256);
            }
        }
    }
    GRID_BARRIER();
    for (int rep = 0; rep < 1; ++rep) { PHASE_BEGIN;
        pg8::Gemm g{Hh, WinT + (size_t)PP * 1024, TT, NZG, 1024, 1024}; pg8::StaticOrder S; S.init(TT, NZG, G, (int)blockIdx.x);
        EpiZG E{P, GT0, GT1};
        pg8::gemm_phase<EpiZG, pg8::StaticOrder, true, true>(lds, g, S, E);
    }
    GRID_BARRIER();
    for (int nbr = 0; nbr < 3 * REP_G4; ++nbr) { const int nb = nbr % 3; PHASE_BEGIN;
        pg8::Gemm g{P + (nb == 0 ? C_YA : (nb == 1 ? C_YB : C_YM)), WbrT + (size_t)nb * 1024 * 512, TT, 1024, 512, PP}; pg8::StaticOrder S; S.init(TT, 1024, G, (int)blockIdx.x);
        EpiMerge E{MG, GT0, GT1, nb};
        pg8::gemm_phase<EpiMerge, pg8::StaticOrder, true, true>(lds, g, S, E);
    }
    GRID_BARRIER();
    for (int rep = 0; rep < REP_G5; ++rep) { PHASE_BEGIN;
        pg8::Gemm g{MG, WoutT, TT, 1024, 1024, 1024}; pg8::StaticOrder S; S.init(TT, 1024, G, (int)blockIdx.x);
        EpiOut E{x, outp};
        pg8::gemm_phase<EpiOut, pg8::StaticOrder, true, true>(lds, g, S, E);
    }
}

extern "C" void kernel_launch(void* const* d_in, const int* in_sizes, int n_in, void* d_out, int out_size, void* d_ws, size_t ws_size, hipStream_t stream) {
    static int grid = 0;
    if (grid == 0) {
        if (n_in != 19 || out_size != TT * DM || ws_size < WS_END) { fprintf(stderr, "kernel_launch: unexpected problem (n_in %d, out %d, ws %zu); nothing launched\n", n_in, out_size, ws_size); grid = -1; return; }
        int dev = 0, cus = 0, per_cu = 0;
        if (hipGetDevice(&dev) != hipSuccess || hipDeviceGetAttribute(&cus, hipDeviceAttributeMultiprocessorCount, dev) != hipSuccess) { grid = -1; return; }
        if (hipFuncSetAttribute((const void*)fwd_kernel, hipFuncAttributeMaxDynamicSharedMemorySize, LDS_BYTES) != hipSuccess) { fprintf(stderr, "kernel_launch: hipFuncSetAttribute failed\n"); grid = -1; return; }
        if (hipOccupancyMaxActiveBlocksPerMultiprocessor(&per_cu, (const void*)fwd_kernel, 512, LDS_BYTES) != hipSuccess || per_cu < 1) { fprintf(stderr, "kernel_launch: occupancy query reports %d blocks per CU\n", per_cu); (void)hipGetLastError(); grid = -1; return; }
        grid = cus;
    }
    if (grid < 0) return;
    (void)hipMemsetAsync((char*)d_ws + WS_CTL, 0, 65536, stream);
    Args a{};
    for (int i = 0; i < 19; ++i) a.in[i] = (const float*)d_in[i];
    a.pos = (const int*)d_in[2]; a.out = (float*)d_out; a.ws = (unsigned char*)d_ws;
    hipLaunchKernelGGL(fwd_kernel, dim3(grid), dim3(512), LDS_BYTES, stream, a);
    const hipError_t e = hipPeekAtLastError();
    if (e != hipSuccess) fprintf(stderr, "kernel_launch: launch failed: %s (grid %d)\n", hipGetErrorString(e), grid);
}
```

```cpp
#include <hip/hip_runtime.h>
#include <cstdio>
#include <cstdint>
namespace pg8 {
#define PG8_LAS __attribute__((address_space(3)))
typedef unsigned short bf16_t;
typedef short bf16x8 __attribute__((ext_vector_type(8)));
typedef float f32x4 __attribute__((ext_vector_type(4)));
typedef unsigned u32x4 __attribute__((ext_vector_type(4)));
constexpr int BM = 256, BK = 64, HALF = 128, HTB = HALF * BK * 2  , STAGE_BYTES = 8 * HTB, NXCD = 8, WGM = 8;

__host__ __device__ __forceinline__ int lds_byte(int r, int c) { const int st = (r >> 4) * 2 + (c >> 5), rr = r & 15, cc = c & 31, ob = rr * 64 + cc * 2; return st * 1024 + (ob ^ (((ob >> 9) & 1) << 5)); }
__host__ __device__ __forceinline__ void stage_rc(int b, int& R, int& C) { const int st = b / 1024, sb = b % 1024, swz = sb ^ (((sb >> 9) & 1) << 5); R = (st >> 1) * 16 + swz / 64; C = (st & 1) * 32 + (swz % 64) / 2; }
__host__ __device__ __forceinline__ int perm32(int rho) { const int n = rho >> 4, i = rho & 15; return 8 * (i >> 2) + 4 * n + (i & 3); }

struct Unit { int pm, pn; };
struct Gemm { const bf16_t* A; const bf16_t* Bt; int M, N, K, lda; };

struct StaticOrder {
    int nM, nN, nwg, G, c;
    __host__ __device__ void init(int M, int N, int G_, int c_) { nM = M / BM; nN = N / BM; nwg = nM * nN; G = G_; c = c_; }
    __host__ __device__ bool next(int i, Unit& u) const {
        const long L = (long)i * G + c; if (L >= nwg) return false;
        int wgid = (int)L; { const int q = nwg / NXCD, r = nwg % NXCD, xcd = wgid % NXCD, off = wgid / NXCD; wgid = (xcd < r ? xcd * (q + 1) : r * (q + 1) + (xcd - r) * q) + off; }
        const int nig = WGM * nN, gid = wgid / nig, fm = gid * WGM, gsz = (nM - fm) < WGM ? (nM - fm) : WGM;
        u.pm = fm + ((wgid % nig) % gsz); u.pn = (wgid % nig) / gsz; return true;
    }
    __device__ __forceinline__ void a_ready(const Unit&) const {}
    __device__ __forceinline__ void done(const Unit&) const {}
};

__device__ __forceinline__ unsigned cvt_pk_bf16(float lo, float hi) { unsigned r; asm volatile("v_cvt_pk_bf16_f32 %0, %1, %2" : "=v"(r) : "v"(lo), "v"(hi)); return r; }
typedef float f32x2 __attribute__((ext_vector_type(2)));
__device__ __forceinline__ f32x2 gelu_pk(f32x2 v) {
    const f32x2 av = __builtin_elementwise_abs(v), d = av * 0.2316418882f + 1.0f;
    f32x2 t; t.x = __builtin_amdgcn_rcpf(d.x); t.y = __builtin_amdgcn_rcpf(d.y);
    f32x2 q = t * 0.5307027145f + (-0.7265760135f); q = q * t + 0.7107068705f; q = q * t + (-0.142248368f); q = q * t + 0.127414796f; q = q * t;
    const f32x2 s = (v * v) * (-0.72134752044f);
    f32x2 e; e.x = __builtin_amdgcn_exp2f(s.x); e.y = __builtin_amdgcn_exp2f(s.y);
    const f32x2 m = v * (q * e), r = v - m;
    f32x2 o; o.x = v.x < 0.f ? m.x : r.x; o.y = v.y < 0.f ? m.y : r.y; return o;
}

template <int ACT  > struct EpiBf16 {
    static constexpr bool PERM = true, AFTER_DRAIN = false; static_assert(ACT == 0 || ACT == 1, "EpiBf16: ACT is 0 (none) or 1 (gelu_pk)");
    bf16_t* O; int ldc; const float* bias; int split_cols; size_t split_stride; float scale0;
    __device__ __forceinline__ void operator()(const f32x4 (&acc)[2][2][4][2], const Unit& u, int wr, int wc, int fr, int fq) const {
        const int row0 = u.pm * BM + wr * 64 + fr; int colt = u.pn * BM; bf16_t* base = O;
        float sc = 1.f; if (split_cols) { const int t = colt / split_cols; base += (size_t)t * split_stride; colt -= t * split_cols; if (t == 0) sc = scale0; }
        const int col0 = colt + wc * 32 + 8 * fq, bcol0 = u.pn * BM + wc * 32 + 8 * fq;
        f32x4 bv[2][2];
#pragma unroll
        for (int bj = 0; bj < 2; ++bj)
#pragma unroll
            for (int n = 0; n < 2; ++n) bv[bj][n] = bias ? *(const f32x4*)(bias + bcol0 + bj * HALF + 4 * n) : (f32x4){0.f, 0.f, 0.f, 0.f};
#pragma unroll
        for (int ai = 0; ai < 2; ++ai)
#pragma unroll
            for (int m = 0; m < 4; ++m) { bf16_t* rowp = base + (size_t)(row0 + ai * HALF + m * 16) * ldc + col0;
#pragma unroll
                for (int bj = 0; bj < 2; ++bj) { f32x4 v0 = acc[ai][bj][m][0] + bv[bj][0], v1 = acc[ai][bj][m][1] + bv[bj][1];
                    if (ACT == 1) { f32x2 a = gelu_pk((f32x2){v0[0], v0[1]}), b = gelu_pk((f32x2){v0[2], v0[3]}), c = gelu_pk((f32x2){v1[0], v1[1]}), d = gelu_pk((f32x2){v1[2], v1[3]});
                        v0 = (f32x4){a.x, a.y, b.x, b.y}; v1 = (f32x4){c.x, c.y, d.x, d.y}; }
                    v0 = v0 * sc; v1 = v1 * sc; u32x4 w; w.x = cvt_pk_bf16(v0[0], v0[1]); w.y = cvt_pk_bf16(v0[2], v0[3]); w.z = cvt_pk_bf16(v1[0], v1[1]); w.w = cvt_pk_bf16(v1[2], v1[3]);
                    *(u32x4*)(rowp + bj * HALF) = w; } }
    }
};
template <class Epi, class Sched, bool ALIGN_EPI = false, bool SP2 = false>
__device__ __forceinline__ void gemm_phase(PG8_LAS unsigned char* lds, const Gemm g, const Sched& S, const Epi& E) {
    int tid_ = threadIdx.x; asm volatile("" : "+v"(tid_));
    const int tid = tid_, wid = __builtin_amdgcn_readfirstlane(tid >> 6), lane = tid & 63, wr = wid >> 2, wc = wid & 3, fr = lane & 15, fq = lane >> 4;
    const int K = g.K, nt = K / BK;
    unsigned voffA[2], voffB[2];
#pragma unroll
    for (int i = 0; i < 2; ++i) { int R, C; stage_rc(tid * 16 + i * 8192, R, C); const int Rb = Epi::PERM ? ((R & ~31) + perm32(R & 31)) : R;
        voffA[i] = (unsigned)(R * g.lda + C) * 2u; voffB[i] = (unsigned)(Rb * K + C) * 2u; }
    const size_t kstep = (size_t)(BK * 2);
    const size_t hstepA = (size_t)HALF * g.lda * 2, hstepB = (size_t)HALF * K * 2;
    const size_t tstepA = 2 * hstepA, tstepB = 2 * hstepB;
    const unsigned ldsw = (unsigned)wid * 1024u;
    const int aoff = lds_byte(wr * 64 + fr, fq * 8), boff = lds_byte(wc * 32 + fr, fq * 8);
#define PG8_SA(b, h) (((b) * 2 + (h)) * HTB)
#define PG8_SB(b, h) ((4 + (b) * 2 + (h)) * HTB)
#define PG8_STAGE(bufoff, gbase, voff) do { _Pragma("unroll") for (int _i = 0; _i < 2; ++_i) \
        __builtin_amdgcn_global_load_lds((const unsigned*)((const char*)(gbase) + (voff)[_i]), (PG8_LAS unsigned*)(lds + (bufoff) + ldsw + _i * 8192), 16, 0, 0); } while (0)
#define PG8_LDA(dst, b, h) do { _Pragma("unroll") for (int m = 0; m < 4; ++m) _Pragma("unroll") for (int k = 0; k < 2; ++k) dst[m][k] = *(const PG8_LAS bf16x8*)(lds + PG8_SA(b, h) + aoff + m * 2048 + k * 1024); } while (0)
#define PG8_LDB(dst, b, h) do { _Pragma("unroll") for (int n = 0; n < 2; ++n) _Pragma("unroll") for (int k = 0; k < 2; ++k) dst[n][k] = *(const PG8_LAS bf16x8*)(lds + PG8_SB(b, h) + boff + n * 2048 + k * 1024); } while (0)
#define PG8_MMA(ai, bj, At, Bt) do { __builtin_amdgcn_s_setprio(1); _Pragma("unroll") for (int m = 0; m < 4; ++m) _Pragma("unroll") for (int n = 0; n < 2; ++n) _Pragma("unroll") for (int k = 0; k < 2; ++k) \
        acc[ai][bj][m][n] = __builtin_amdgcn_mfma_f32_16x16x32_bf16(Bt[n][k], At[m][k], acc[ai][bj][m][n], 0, 0, 0); __builtin_amdgcn_s_setprio(0); } while (0)
#define PG8_WAIT_V(n) asm volatile("s_waitcnt vmcnt(" #n ")" ::: "memory")
#define PG8_WAIT_L(n) asm volatile("s_waitcnt lgkmcnt(" #n ")" ::: "memory")
#define PG8_BAR __builtin_amdgcn_s_barrier()
#define PG8_SCHED __builtin_amdgcn_sched_barrier(0)
    Unit cur, nxt; int ui = 0;
    if (!S.next(0, cur)) return;
    f32x4 acc[2][2][4][2];
#pragma unroll
    for (int a = 0; a < 2; ++a)
#pragma unroll
        for (int b = 0; b < 2; ++b)
#pragma unroll
            for (int m = 0; m < 4; ++m)
#pragma unroll
                for (int n = 0; n < 2; ++n) acc[a][b][m][n] = (f32x4){0.f, 0.f, 0.f, 0.f};
    bf16x8 At[4][2], B0[2][2], B1[2][2];
    const char* cA = (const char*)g.A + (size_t)cur.pm * tstepA; const char* cB = (const char*)g.Bt + (size_t)cur.pn * tstepB;
    S.a_ready(cur);
    if constexpr (SP2) {
        PG8_STAGE(PG8_SB(0, 0), cB, voffB); PG8_STAGE(PG8_SB(0, 1), cB + hstepB, voffB); PG8_STAGE(PG8_SA(0, 0), cA, voffA); PG8_STAGE(PG8_SA(0, 1), cA + hstepA, voffA);
        if (wr == 1) PG8_BAR;
        PG8_WAIT_V(2); PG8_BAR;
        PG8_STAGE(PG8_SB(1, 0), cB + kstep, voffB); PG8_STAGE(PG8_SA(1, 0), cA + kstep, voffA); PG8_STAGE(PG8_SB(1, 1), cB + hstepB + kstep, voffB);
        PG8_WAIT_V(6); PG8_BAR;
    } else {
        PG8_STAGE(PG8_SB(0, 0), cB, voffB); PG8_STAGE(PG8_SA(0, 0), cA, voffA); PG8_STAGE(PG8_SB(0, 1), cB + hstepB, voffB); PG8_STAGE(PG8_SA(0, 1), cA + hstepA, voffA);
        if (wr == 1) PG8_BAR;
        PG8_WAIT_V(4); PG8_BAR;
        PG8_STAGE(PG8_SB(1, 0), cB + kstep, voffB); PG8_STAGE(PG8_SA(1, 0), cA + kstep, voffA); PG8_STAGE(PG8_SB(1, 1), cB + hstepB + kstep, voffB);
        PG8_WAIT_V(6); PG8_BAR;
    }
    for (;;) {
        const bool has_next = S.next(ui + 1, nxt);
        const char* nA = has_next ? (const char*)g.A + (size_t)nxt.pm * tstepA : cA; const char* nB = has_next ? (const char*)g.Bt + (size_t)nxt.pn * tstepB : cB;
        for (int t = 0; t < nt; t += 2) {
            const bool last = (t == nt - 2);
            const char* a1 = cA + (size_t)(t + 1) * kstep;
            const char* a2 = last ? nA : cA + (size_t)(t + 2) * kstep; const char* b2 = last ? nB : cB + (size_t)(t + 2) * kstep;
            const char* a3 = a2 + kstep; const char* b3 = b2 + kstep;
            if (last && has_next) S.a_ready(nxt);
            if constexpr (SP2) {
            PG8_LDB(B0, 0, 0); PG8_LDB(B1, 0, 1); PG8_SCHED; PG8_LDA(At, 0, 0); PG8_STAGE(PG8_SA(1, 1), a1 + hstepA, voffA);
            PG8_WAIT_V(8); PG8_WAIT_L(0); PG8_BAR; PG8_MMA(0, 0, At, B0); PG8_MMA(0, 1, At, B1); PG8_BAR; PG8_SCHED;
            PG8_LDA(At, 0, 1); PG8_STAGE(PG8_SB(0, 0), b2, voffB); PG8_STAGE(PG8_SB(0, 1), b2 + hstepB, voffB); PG8_STAGE(PG8_SA(0, 0), a2, voffA);
            PG8_WAIT_V(8); PG8_WAIT_L(0); PG8_BAR; PG8_MMA(1, 0, At, B0); PG8_MMA(1, 1, At, B1); PG8_BAR; PG8_SCHED;
            PG8_LDB(B0, 1, 0); PG8_LDB(B1, 1, 1); PG8_SCHED; PG8_LDA(At, 1, 0); PG8_STAGE(PG8_SA(0, 1), a2 + hstepA, voffA);
            PG8_WAIT_V(8); PG8_WAIT_L(0); PG8_BAR; PG8_MMA(0, 0, At, B0); PG8_MMA(0, 1, At, B1); PG8_BAR; PG8_SCHED;
            PG8_LDA(At, 1, 1); PG8_STAGE(PG8_SB(1, 0), b3, voffB); PG8_STAGE(PG8_SB(1, 1), b3 + hstepB, voffB); PG8_STAGE(PG8_SA(1, 0), a3, voffA);
            PG8_WAIT_V(8); PG8_WAIT_L(0); PG8_BAR; PG8_MMA(1, 0, At, B0); PG8_MMA(1, 1, At, B1); PG8_BAR; PG8_SCHED;
            } else {
            PG8_LDB(B0, 0, 0); PG8_SCHED; PG8_LDA(At, 0, 0); PG8_STAGE(PG8_SA(1, 1), a1 + hstepA, voffA);
            PG8_WAIT_L(8); PG8_BAR; PG8_WAIT_L(0); PG8_MMA(0, 0, At, B0); PG8_BAR; PG8_SCHED;
            PG8_LDB(B1, 0, 1); PG8_STAGE(PG8_SB(0, 0), b2, voffB);
            PG8_BAR; PG8_WAIT_L(0); PG8_MMA(0, 1, At, B1); PG8_BAR;
            PG8_LDA(At, 0, 1); PG8_STAGE(PG8_SA(0, 0), a2, voffA);
            PG8_BAR; PG8_WAIT_L(0); PG8_MMA(1, 0, At, B0); PG8_BAR; PG8_SCHED;
            PG8_STAGE(PG8_SB(0, 1), b2 + hstepB, voffB);
            PG8_WAIT_V(6); PG8_BAR; PG8_MMA(1, 1, At, B1); PG8_BAR;
            PG8_LDB(B0, 1, 0); PG8_SCHED; PG8_LDA(At, 1, 0); PG8_STAGE(PG8_SA(0, 1), a2 + hstepA, voffA);
            PG8_WAIT_L(8); PG8_BAR; PG8_WAIT_L(0); PG8_MMA(0, 0, At, B0); PG8_BAR; PG8_SCHED;
            PG8_LDB(B1, 1, 1); PG8_STAGE(PG8_SB(1, 0), b3, voffB);
            PG8_BAR; PG8_WAIT_L(0); PG8_MMA(0, 1, At, B1); PG8_BAR;
            PG8_LDA(At, 1, 1); PG8_STAGE(PG8_SA(1, 0), a3, voffA);
            PG8_BAR; PG8_WAIT_L(0); PG8_MMA(1, 0, At, B0); PG8_BAR; PG8_SCHED;
            PG8_STAGE(PG8_SB(1, 1), b3 + hstepB, voffB);
            PG8_WAIT_V(6); PG8_BAR; PG8_MMA(1, 1, At, B1); PG8_BAR;
            }
        }
        if constexpr (ALIGN_EPI) { if (wr == 0) PG8_BAR; }
        if constexpr (!Epi::AFTER_DRAIN) { E(acc, cur, wr, wc, fr, fq); S.done(cur); }
        if (!has_next) break;
#pragma unroll
        for (int a = 0; a < 2; ++a)
#pragma unroll
            for (int b = 0; b < 2; ++b)
#pragma unroll
                for (int m = 0; m < 4; ++m)
#pragma unroll
                    for (int n = 0; n < 2; ++n) acc[a][b][m][n] = (f32x4){0.f, 0.f, 0.f, 0.f};
        cur = nxt; cA = nA; cB = nB; ++ui;
        if constexpr (ALIGN_EPI) { if (wr == 1) PG8_BAR; }
    }
    PG8_WAIT_V(0);
    if constexpr (!ALIGN_EPI) { if (wr == 0) PG8_BAR; }
    PG8_BAR;
    if constexpr (Epi::AFTER_DRAIN) { E.fused(acc, cur, wr, wc, fr, fq, lds, wid, lane); S.done(cur); }
#undef PG8_SA
#undef PG8_SB
#undef PG8_STAGE
#undef PG8_LDA
#undef PG8_LDB
#undef PG8_MMA
#undef PG8_WAIT_V
#undef PG8_WAIT_L
#undef PG8_BAR
#undef PG8_SCHED
}
}

#define LAS __attribute__((address_space(3)))
typedef unsigned short bf16;
typedef unsigned v4u __attribute__((ext_vector_type(4)));
typedef unsigned v2u __attribute__((ext_vector_type(2)));
typedef float f32x4 __attribute__((ext_vector_type(4)));
typedef float f32x16 __attribute__((ext_vector_type(16)));
typedef short bf16x8 __attribute__((ext_vector_type(8)));
typedef short s16x4 __attribute__((ext_vector_type(4)));
typedef float f32x2_t __attribute__((ext_vector_type(2)));
typedef __bf16 bf16x2_t __attribute__((ext_vector_type(2)));

constexpr int NB = 8, SEQ = 2048, DM = 1024, TT = NB * SEQ;
constexpr int DIN = 7912, NP = 7936;
constexpr int PP = 3840, NZG = 4096;
constexpr int MEML = 256;
constexpr float EPS = 1e-6f, NEGF = -1e30f;
constexpr int C_QA = 0, C_KA = 512, C_VA = 1024, C_QI = 1536, C_KI = 2048, C_WI = 2112, C_CQ = 2120, C_CKV = 2504, C_KR = 2760, C_QM = 2792, C_ZM = 3304;
constexpr int C_YA = C_QI, C_YB = C_CQ, C_YM = C_VA;
constexpr float SCALE_A = 0.18033688011112042f;
constexpr float SCALE_B = 0.14724444602590306f;
constexpr float SCALE_M = 0.12751743082459868f;
constexpr float SCALE_I = 0.04419417382415922f;

__constant__ float INVA[8] = {1.0f, 0.1939227432012558f, 0.03760603070259094f, 0.007292664609849453f, 0.0014142135623842478f, 0.00027424818836152554f, 5.3182957344688475e-05f, 1.0313385246263351e-05f};
__constant__ float INVB[16] = {1.0f, 0.44036659598350525f, 0.1939227432012558f, 0.08539710193872452f, 0.03760603070259094f, 0.016560440883040428f, 0.007292664609849453f, 0.0032114461064338684f, 0.0014142135623842478f, 0.0006227724370546639f, 0.00027424818836152554f, 0.00012076973507646471f, 5.3182957344688475e-05f, 2.34199997066753e-05f, 1.0313385246263351e-05f, 4.541670477919979e-06f};

constexpr size_t MiB = 1u << 20;
constexpr size_t WS_CTL = 0;
constexpr size_t WS_WIN = 1 * MiB;
constexpr size_t WS_WUQ = 17 * MiB;
constexpr size_t WS_WUKV = 18 * MiB;
constexpr size_t WS_WMEM = 19 * MiB;
constexpr size_t WS_WBR = 21 * MiB;
constexpr size_t WS_WOUT = 24 * MiB;
constexpr size_t WS_ROPEA = 26 * MiB;
constexpr size_t WS_ROPEB = 27 * MiB;
constexpr size_t WS_MN = 29 * MiB;
constexpr size_t WS_KVM = 33 * MiB;
constexpr size_t WS_VTM = 37 * MiB;
constexpr size_t WS_WI = 39 * MiB;
constexpr size_t WS_MASK = 40 * MiB;
constexpr size_t WS_H = 44 * MiB;
constexpr size_t WS_P = 76 * MiB;
constexpr size_t WS_QB = 196 * MiB;
constexpr size_t WS_KVB = 220 * MiB;
constexpr size_t WS_G1 = 196 * MiB;
constexpr size_t WS_END = 256 * MiB;
constexpr size_t DO_VTA = 0;
constexpr size_t DO_VTB = 16 * MiB;
constexpr size_t DO_KB = 32 * MiB;
constexpr size_t DO_G0 = 0;

constexpr int REP_P0 = 1, REP_PH = 1, REP_G1 = 1, REP_G2 = 1, REP_IDX = 1, REP_ATT = 1, REP_G4 = 1, REP_G5 = 1;
constexpr int REP_IDX1 = 1, REP_SEL = 1;
constexpr int ATT_STRIP = 0;
constexpr int EXTRA_SYNCS = 0, REP_TR = 1, DUMMY_POST1 = 0, DUMMY_POST2 = 0;
constexpr int LDS_BYTES = 147456;
constexpr int LDS_SLOT = LDS_BYTES - 64;

__device__ __forceinline__ unsigned pk2(float lo, float hi) { f32x2_t v = {lo, hi}; bf16x2_t b = __builtin_convertvector(v, bf16x2_t); return __builtin_bit_cast(unsigned, b); }
__device__ __forceinline__ float bflo(unsigned w) { return __uint_as_float(w << 16); }
__device__ __forceinline__ float bfhi(unsigned w) { return __uint_as_float(w & 0xffff0000u); }
__device__ __forceinline__ float bf1(bf16 b) { return __uint_as_float(((unsigned)b) << 16); }
#define UNPACK8(W_, V_) do { V_[0] = bflo((W_)[0]); V_[1] = bfhi((W_)[0]); V_[2] = bflo((W_)[1]); V_[3] = bfhi((W_)[1]); V_[4] = bflo((W_)[2]); V_[5] = bfhi((W_)[2]); V_[6] = bflo((W_)[3]); V_[7] = bfhi((W_)[3]); } while (0)
#define PACK8(V_) (v4u){pk2(V_[0], V_[1]), pk2(V_[2], V_[3]), pk2(V_[4], V_[5]), pk2(V_[6], V_[7])}
__device__ __forceinline__ float wave_sum(float v) {
#pragma unroll
    for (int o = 1; o < 64; o <<= 1) v += __shfl_xor(v, o);
    return v;
}
#define LDS_WAIT() asm volatile("s_waitcnt lgkmcnt(0)" ::: "memory")

__device__ __forceinline__ int win_src(int d) {
    if (d < 2120) return d;
    if (d < 2792) return d + 512;
    if (d < 3816) return d + 1024;
    if (d < 3840) return -1;
    if (d < 4352) return d - 3840 + 2120;
    if (d < 4864) return d - 4352 + 3304;
    return d - 4864 + 4840;
}
template <bool REMAP>
__device__ __forceinline__ void transpose_item(const float* W, int K, int N, int Npad, bf16* WT, LAS float* scr, int item, int lane) {
    const int nblk = Npad / 32, kb = item / nblk, nb = item % nblk, k0 = 64 * kb, n0 = 32 * nb;
    const int nn = REMAP ? win_src(n0 + (lane & 31)) : n0 + (lane & 31); const bool ok = nn >= 0 && nn < N;
#pragma unroll 8
    for (int i = 0; i < 32; ++i) { const int kk = 2 * i + (lane >> 5); scr[kk * 33 + (lane & 31)] = ok ? W[(size_t)(k0 + kk) * N + nn] : 0.f; }
    LDS_WAIT(); asm volatile("" ::: "memory");
    const int c = lane & 7;
#pragma unroll
    for (int j = 0; j < 4; ++j) { const int n = (lane >> 3) + 8 * j; const LAS float* s = scr + (8 * c) * 33 + n;
        v4u o; o.x = pk2(s[0 * 33], s[1 * 33]); o.y = pk2(s[2 * 33], s[3 * 33]); o.z = pk2(s[4 * 33], s[5 * 33]); o.w = pk2(s[6 * 33], s[7 * 33]);
        *(v4u*)(WT + (size_t)(n0 + n) * K + k0 + 8 * c) = o; }
    LDS_WAIT(); asm volatile("" ::: "memory");
}
__device__ __forceinline__ void rms_row_1024(const float* xrow, const float* g, bf16* orow, int lane) {
    const f32x4* xr = (const f32x4*)xrow + lane; const f32x4* gr = (const f32x4*)g + lane;
    f32x4 v[4]; float s = 0.f;
#pragma unroll
    for (int j = 0; j < 4; ++j) { v[j] = xr[64 * j]; s += (v[j].x * v[j].x + v[j].y * v[j].y) + (v[j].z * v[j].z + v[j].w * v[j].w); }
    const float rstd = 1.0f / sqrtf(wave_sum(s) * (1.f / 1024.f) + EPS);
    v2u* o8 = (v2u*)orow + lane;
#pragma unroll
    for (int j = 0; j < 4; ++j) { const f32x4 gg = gr[64 * j]; v2u w; w.x = pk2(v[j].x * rstd * gg.x, v[j].y * rstd * gg.y); w.y = pk2(v[j].z * rstd * gg.z, v[j].w * rstd * gg.w); o8[64 * j] = w; }
}

#define ROPE8(v, sub, c8, s8) do { _Pragma("unroll") for (int j_ = 0; j_ < 8; ++j_) { const float pv_ = __shfl_xor(v[j_], 1); \
        const float r0_ = v[j_] * c8[j_] - pv_ * s8[j_], r1_ = v[j_] * c8[j_] + pv_ * s8[j_]; v[j_] = (sub) == 0 ? r0_ : ((sub) == 1 ? r1_ : v[j_]); } } while (0)

__device__ __forceinline__ void post1_row(const bf16* Prow, bf16* Orow, const float* ra, const float* gqa, const float* gka, const float* gcq, const float* gckv, const float* gqm, float* WIrow, int lane) {
    const int sub = lane & 7;
    const v4u z4 = (v4u){0u, 0u, 0u, 0u};
    const v4u w_qa = *(const v4u*)(Prow + C_QA + 8 * lane);
    const v4u w_ka = *(const v4u*)(Prow + C_KA + 8 * lane);
    const v4u w_qi = *(const v4u*)(Prow + C_QI + 8 * lane);
    const v4u w_qm = *(const v4u*)(Prow + C_QM + 8 * lane);
    v4u w_ki = z4, w_cq = z4, w_ckv = z4; float w_wi = 0.f;
    if (lane < 8) { w_ki = *(const v4u*)(Prow + C_KI + 8 * lane); w_wi = bf1(Prow[C_WI + lane]); }
    if (lane < 48) w_cq = *(const v4u*)(Prow + C_CQ + 8 * lane);
    if (lane < 32) w_ckv = *(const v4u*)(Prow + C_CKV + 8 * lane);
    float c8[8], s8[8];
#pragma unroll
    for (int j = 0; j < 8; ++j) { c8[j] = ra[j]; s8[j] = ra[8 + j]; }
    float ga[8], gk[8], gm[8], gq[8], gc[8];
#pragma unroll
    for (int j = 0; j < 8; ++j) { ga[j] = gqa[8 * sub + j]; gk[j] = gka[8 * sub + j]; gm[j] = gqm[8 * (lane & 15) + j]; gq[j] = lane < 48 ? gcq[8 * lane + j] : 0.f; gc[j] = lane < 32 ? gckv[8 * lane + j] : 0.f; }
    { float v[8]; UNPACK8(w_qa, v); float ss = 0.f;
#pragma unroll
      for (int j = 0; j < 8; ++j) ss += v[j] * v[j];
      ss += __shfl_xor(ss, 1); ss += __shfl_xor(ss, 2); ss += __shfl_xor(ss, 4);
      const float rstd = 1.0f / sqrtf(ss * (1.f / 64.f) + EPS);
#pragma unroll
      for (int j = 0; j < 8; ++j) v[j] = v[j] * rstd * ga[j];
      ROPE8(v, sub, c8, s8);
#pragma unroll
      for (int j = 0; j < 8; ++j) v[j] *= SCALE_A;
      *(v4u*)(Orow + C_QA + 8 * lane) = PACK8(v); }
    { float v[8]; UNPACK8(w_ka, v); float ss = 0.f;
#pragma unroll
      for (int j = 0; j < 8; ++j) ss += v[j] * v[j];
      ss += __shfl_xor(ss, 1); ss += __shfl_xor(ss, 2); ss += __shfl_xor(ss, 4);
      const float rstd = 1.0f / sqrtf(ss * (1.f / 64.f) + EPS);
#pragma unroll
      for (int j = 0; j < 8; ++j) v[j] = v[j] * rstd * gk[j];
      ROPE8(v, sub, c8, s8);
      *(v4u*)(Orow + C_KA + 8 * lane) = PACK8(v); }
    { float v[8]; UNPACK8(w_qi, v);
      ROPE8(v, sub, c8, s8);
      *(v4u*)(Orow + C_QI + 8 * lane) = PACK8(v); }
    { float v[8]; UNPACK8(w_ki, v);
      ROPE8(v, sub, c8, s8);
      if (lane < 8) *(v4u*)(Orow + C_KI + 8 * lane) = PACK8(v); }
    if (lane < 8) WIrow[lane] = w_wi * SCALE_I;
    { float v[8]; UNPACK8(w_cq, v); float ss = 0.f;
#pragma unroll
      for (int j = 0; j < 8; ++j) ss += v[j] * v[j];
      ss = wave_sum(ss); const float rstd = 1.0f / sqrtf(ss * (1.f / 384.f) + EPS);
      if (lane < 48) {
#pragma unroll
          for (int j = 0; j < 8; ++j) v[j] = v[j] * rstd * gq[j];
          *(v4u*)(Orow + C_CQ + 8 * lane) = PACK8(v); } }
    { float v[8]; UNPACK8(w_ckv, v); float ss = 0.f;
#pragma unroll
      for (int j = 0; j < 8; ++j) ss += v[j] * v[j];
      ss = wave_sum(ss); const float rstd = 1.0f / sqrtf(ss * (1.f / 256.f) + EPS);
      if (lane < 32) {
#pragma unroll
          for (int j = 0; j < 8; ++j) v[j] = v[j] * rstd * gc[j];
          *(v4u*)(Orow + C_CKV + 8 * lane) = PACK8(v); } }
    { float v[8]; UNPACK8(w_qm, v); float ss = 0.f;
#pragma unroll
      for (int j = 0; j < 8; ++j) ss += v[j] * v[j];
      ss += __shfl_xor(ss, 1); ss += __shfl_xor(ss, 2); ss += __shfl_xor(ss, 4); ss += __shfl_xor(ss, 8);
      const float rstd = 1.0f / sqrtf(ss * (1.f / 128.f) + EPS);
#pragma unroll
      for (int j = 0; j < 8; ++j) v[j] = v[j] * rstd * gm[j] * SCALE_M;
      *(v4u*)(Orow + C_QM + 8 * lane) = PACK8(v); }
}

__device__ __forceinline__ void km_row(bf16* row, const float* gkm, int lane) {
    v4u w = *(const v4u*)(row + 8 * lane); float v[8]; UNPACK8(w, v); float ss = 0.f;
#pragma unroll
    for (int j = 0; j < 8; ++j) ss += v[j] * v[j];
    ss += __shfl_xor(ss, 1); ss += __shfl_xor(ss, 2); ss += __shfl_xor(ss, 4); ss += __shfl_xor(ss, 8);
    const float rstd = 1.0f / sqrtf(ss * (1.f / 128.f) + EPS);
#pragma unroll
    for (int j = 0; j < 8; ++j) v[j] = v[j] * rstd * gkm[8 * (lane & 15) + j];
    *(v4u*)(row + 8 * lane) = PACK8(v);
}

__device__ __forceinline__ void transpose_v(const bf16* src, int pitch, int col0, int hstride, int H, int DV, int S, int nb, bf16* dst, int gw, int NGW, int lane) {
    const int ndq = DV / 64, nsc = S / 64, ntask = nb * H * nsc * ndq;
    for (int task = gw; task < ntask; task += NGW) {
        int x = task; const int dq = x % ndq; x /= ndq; const int sc = x % nsc; x /= nsc; const int h = x % H; const int b = x / H;
        const int s = sc * 64 + lane;
        const bf16* srow = src + (size_t)(b * S + s) * pitch + col0 + h * hstride + dq * 64;
        bf16* drow = dst + ((size_t)((b * H + h) * DV + dq * 64)) * S + s;
        v4u wv[8];
#pragma unroll
        for (int c = 0; c < 8; ++c) wv[c] = *(const v4u*)(srow + 8 * c);
#pragma unroll
        for (int c = 0; c < 8; ++c) { const v4u w = wv[c];
            drow[(size_t)(8 * c + 0) * S] = (bf16)(w.x & 0xffffu); drow[(size_t)(8 * c + 1) * S] = (bf16)(w.x >> 16);
            drow[(size_t)(8 * c + 2) * S] = (bf16)(w.y & 0xffffu); drow[(size_t)(8 * c + 3) * S] = (bf16)(w.y >> 16);
            drow[(size_t)(8 * c + 4) * S] = (bf16)(w.z & 0xffffu); drow[(size_t)(8 * c + 5) * S] = (bf16)(w.z >> 16);
            drow[(size_t)(8 * c + 6) * S] = (bf16)(w.w & 0xffffu); drow[(size_t)(8 * c + 7) * S] = (bf16)(w.w >> 16); }
    }
}

__device__ __forceinline__ void post2_row(const bf16* QBrow, bf16* QOrow, const bf16* KVBrow, const bf16* Prow, bf16* KBrow, const float* rb, const float* gq, const float* gk, LAS float* scr, int lane) {
    const int hd = lane >> 3, d0 = 12 * (lane & 7);
    float vq[12], vk[12], gqv[12], gkv[12], cc[12], sn[12];
    { const v2u* p = (const v2u*)(QBrow + 12 * lane);
      const v2u w0 = p[0], w1 = p[1], w2 = p[2];
      bf16 kr[12];
#pragma unroll
      for (int e = 0; e < 12; ++e) { const int d = d0 + e; kr[e] = d < 64 ? KVBrow[hd * 128 + d] : Prow[C_KR + d - 64]; }
#pragma unroll
      for (int e = 0; e < 12; ++e) { const int d = d0 + e; gqv[e] = gq[d]; gkv[e] = gk[d]; const int i = (d - 64) & 15; cc[e] = d < 64 ? 1.f : rb[i]; sn[e] = d < 64 ? 0.f : rb[16 + i]; }
      vq[0] = bflo(w0.x); vq[1] = bfhi(w0.x); vq[2] = bflo(w0.y); vq[3] = bfhi(w0.y); vq[4] = bflo(w1.x); vq[5] = bfhi(w1.x); vq[6] = bflo(w1.y); vq[7] = bfhi(w1.y);
      vq[8] = bflo(w2.x); vq[9] = bfhi(w2.x); vq[10] = bflo(w2.y); vq[11] = bfhi(w2.y);
#pragma unroll
      for (int e = 0; e < 12; ++e) vk[e] = bf1(kr[e]); }
    float sq = 0.f, sk = 0.f;
#pragma unroll
    for (int e = 0; e < 12; ++e) { sq += vq[e] * vq[e]; sk += vk[e] * vk[e]; }
    sq += __shfl_xor(sq, 1); sq += __shfl_xor(sq, 2); sq += __shfl_xor(sq, 4);
    sk += __shfl_xor(sk, 1); sk += __shfl_xor(sk, 2); sk += __shfl_xor(sk, 4);
    const float rq = 1.0f / sqrtf(sq * (1.f / 96.f) + EPS), rk = 1.0f / sqrtf(sk * (1.f / 96.f) + EPS);
#pragma unroll
    for (int e = 0; e < 12; ++e) { vq[e] = vq[e] * rq * gqv[e]; vk[e] = vk[e] * rk * gkv[e]; scr[12 * lane + e] = vq[e]; scr[768 + 12 * lane + e] = vk[e]; }
    LDS_WAIT(); asm volatile("" ::: "memory");
    float oq[12], ok[12];
#pragma unroll
    for (int e = 0; e < 12; ++e) { const int d = d0 + e;
        if (d < 64) { oq[e] = vq[e]; ok[e] = vk[e]; }
        else { const bool first = d < 80; const int off = first ? 16 : -16; const float pq = scr[12 * lane + e + off], pk = scr[768 + 12 * lane + e + off];
               oq[e] = first ? vq[e] * cc[e] - pq * sn[e] : vq[e] * cc[e] + pq * sn[e];
               ok[e] = first ? vk[e] * cc[e] - pk * sn[e] : vk[e] * cc[e] + pk * sn[e]; }
        oq[e] *= SCALE_B; }
    LDS_WAIT(); asm volatile("" ::: "memory");
    v2u* q = (v2u*)(QOrow + 12 * lane); v2u* k = (v2u*)(KBrow + 12 * lane);
#pragma unroll
    for (int i = 0; i < 3; ++i) { v2u w; w.x = pk2(oq[4 * i], oq[4 * i + 1]); w.y = pk2(oq[4 * i + 2], oq[4 * i + 3]); q[i] = w;
                                  v2u u; u.x = pk2(ok[4 * i], ok[4 * i + 1]); u.y = pk2(ok[4 * i + 2], ok[4 * i + 3]); k[i] = u; }
}

__device__ __forceinline__ int next_unit(unsigned* ctr, volatile LAS int* slot) {
    __syncthreads();
    if (threadIdx.x == 0) *slot = (int)atomicAdd(ctr, 1u);
    __syncthreads();
    return *slot;
}

constexpr int SCP = 2112;
__device__ __forceinline__ unsigned ord_key(float v) { const unsigned b = __float_as_uint(v); return b ^ ((unsigned)((int)b >> 31) | 0x80000000u); }
__device__ __forceinline__ void indexer_unit(LAS float* sc, const bf16* P, const float* WI, unsigned* MASK, int bb, int tb) {
    int tid_ = threadIdx.x; asm volatile("" : "+v"(tid_));
    const int tid = tid_, lane = tid & 63, w = __builtin_amdgcn_readfirstlane(tid >> 6);
    const int n = lane & 15, g = lane >> 4;
    const int rowbase = bb * SEQ, t0 = tb * 16;
    for (int rp1 = 0; rp1 < REP_IDX1; ++rp1) {
        bf16x8 qf[8][2]; float wq[8];
        const bf16* qrow = P + (size_t)(rowbase + t0 + n) * PP + C_QI + 8 * g;
#pragma unroll
        for (int h = 0; h < 8; ++h) {
            qf[h][0] = *(const bf16x8*)(qrow + h * 64);
            qf[h][1] = *(const bf16x8*)(qrow + h * 64 + 32);
            wq[h] = WI[(size_t)(rowbase + t0 + n) * 8 + h];
        }
        const int ntile = tb + 1;
        const int nmine = (ntile - w + 7) >> 3;
        const int ngrp = (nmine + 3) >> 2;
        const bf16* kbase = P + (size_t)(rowbase + n) * PP + C_KI + 8 * g;
        bf16x8 kb[2][4][2];
#define IDX_LOAD(BUF, GRP) do { _Pragma("unroll") for (int j_ = 0; j_ < 4; ++j_) { const int tile_ = w + 8 * (4 * (GRP) + j_); const int tl_ = tile_ < ntile ? tile_ : 0; \
            const bf16* kr_ = kbase + (size_t)(16 * tl_) * PP; kb[BUF][j_][0] = *(const bf16x8*)(kr_); kb[BUF][j_][1] = *(const bf16x8*)(kr_ + 32); } } while (0)
#define IDX_COMP(BUF, GRP) do { _Pragma("unroll") for (int j_ = 0; j_ < 4; ++j_) { const int tile_ = w + 8 * (4 * (GRP) + j_); if (tile_ < ntile) { \
            f32x4 idx_ = (f32x4){0.f, 0.f, 0.f, 0.f}; \
            _Pragma("unroll") for (int h_ = 0; h_ < 8; ++h_) { f32x4 a_ = (f32x4){0.f, 0.f, 0.f, 0.f}; \
                a_ = __builtin_amdgcn_mfma_f32_16x16x32_bf16(kb[BUF][j_][0], qf[h_][0], a_, 0, 0, 0); \
                a_ = __builtin_amdgcn_mfma_f32_16x16x32_bf16(kb[BUF][j_][1], qf[h_][1], a_, 0, 0, 0); \
                _Pragma("unroll") for (int i_ = 0; i_ < 4; ++i_) idx_[i_] = __builtin_fmaf(wq[h_], __builtin_fmaxf(a_[i_], 0.f), idx_[i_]); } \
            { const int k0_ = 16 * tile_ + 4 * g; LAS float* d_ = sc + n * SCP + k0_ + (k0_ >> 5); d_[0] = idx_[0]; d_[1] = idx_[1]; d_[2] = idx_[2]; d_[3] = idx_[3]; } } } } while (0)
        if (ngrp > 0) IDX_LOAD(0, 0);
        for (int gp = 0; gp < ngrp; gp += 2) {
            if (gp + 1 < ngrp) IDX_LOAD(1, gp + 1);
            IDX_COMP(0, gp);
            if (gp + 1 < ngrp) { if (gp + 2 < ngrp) IDX_LOAD(0, gp + 2); IDX_COMP(1, gp + 1); }
        }
#undef IDX_LOAD
#undef IDX_COMP
    }
    __syncthreads();
#pragma unroll 1
    for (int qq2 = 0; qq2 < 2 * REP_SEL; ++qq2) { const int qq = qq2 & 1;
        const int q = 2 * w + qq, t = t0 + q;
        unsigned* mrow = MASK + (size_t)(rowbase + t) * 64;
        const int nv = t - 32 * lane + 1;
        const unsigned valid = nv >= 32 ? 0xffffffffu : (nv <= 0 ? 0u : ((1u << nv) - 1u));
        if (t < 256) { mrow[lane] = valid; continue; }
        unsigned u[32];
        const LAS float* srow = sc + q * SCP + 33 * lane;
#pragma unroll
        for (int r = 0; r < 32; ++r) { const float v = srow[r]; u[r] = ((valid >> r) & 1u) ? ord_key(v) : 0u; }
#pragma unroll
        for (int si = 0; si < 5; ++si) { const int sft = 16 >> si;
            const unsigned msk = si == 0 ? 0x0000ffffu : (si == 1 ? 0x00ff00ffu : (si == 2 ? 0x0f0f0f0fu : (si == 3 ? 0x33333333u : 0x55555555u)));
#pragma unroll
            for (int k = 0; k < 32; ++k) if (!(k & sft)) { const unsigned tt = ((u[k] >> sft) ^ u[k + sft]) & msk; u[k + sft] ^= tt; u[k] ^= tt << sft; } }
        unsigned alive = valid, sel = 0u; int need = 256;
#pragma unroll
        for (int j = 31; j >= 0; --j) {
            const unsigned ones = alive & u[j];
            const unsigned cl = (unsigned)__popc(ones);
            int c = 0;
#pragma unroll
            for (int bt = 0; bt < 6; ++bt) c += __popcll(__ballot((cl >> bt) & 1u)) << bt;
            if (c >= need) { alive = ones; if (c == need) { sel |= ones; need = 0; break; } }
            else { need -= c; sel |= ones; alive &= ~u[j]; }
        }
        if (need > 0) {
            const int cnt = __popc(alive); int inc = cnt;
#pragma unroll
            for (int d = 1; d < 64; d <<= 1) { const int o = __shfl_up(inc, d); if (lane >= d) inc += o; }
            int k = need - (inc - cnt); k = k < 0 ? 0 : (k > cnt ? cnt : k);
            unsigned m = alive;
            for (int i = 0; i < k; ++i) { const unsigned low = m & (0u - m); sel |= low; m ^= low; }
        }
        mrow[lane] = sel;
    }
    __syncthreads();
}

__device__ __forceinline__ int crow(int r, int hi) { return (r & 3) + 8 * (r >> 2) + 4 * hi; }
template <int DQK, int DV, int MODE, int STRIP = 0>
__device__ __forceinline__ void attn_unit(LAS unsigned char* lds, const bf16* Qb, int qpitch, const bf16* Kb, int kpitch, const bf16* VTb, int skv,
                                          const unsigned* maskb, const bf16* Zb, bf16* Ob, int q0) {
    constexpr int TK = 128, KP = DQK + 8, VP = TK + 8;
    LAS bf16* Ks = (LAS bf16*)lds; LAS bf16* Vs = Ks + TK * KP;
    constexpr int CPR = DQK / 8;
    constexpr int NCK = TK * CPR, NCV = DV * (TK / 8);
    constexpr int RK = (NCK + 511) / 512, RV = (NCV + 511) / 512;
    constexpr int NKS = DQK / 16, NMT = DV / 32;
    int tid_ = threadIdx.x; asm volatile("" : "+v"(tid_));
    const int tid = tid_, lane = tid & 63, w = __builtin_amdgcn_readfirstlane(tid >> 6), r = lane & 31, hh = lane >> 5;
    const int NT = MODE == 0 ? skv / TK : (q0 + 256) / TK;
    const int qlo = q0 + 32 * w;
    bf16x8 qf[NKS];
    { const bf16* qrow = Qb + (size_t)(qlo + r) * qpitch + 8 * hh;
#pragma unroll
      for (int ks = 0; ks < NKS; ++ks) qf[ks] = *(const bf16x8*)(qrow + 16 * ks); }
    f32x16 o[NMT];
#pragma unroll
    for (int mt = 0; mt < NMT; ++mt)
#pragma unroll
        for (int i = 0; i < 16; ++i) o[mt][i] = 0.f;
    float m_run = NEGF, l_run = 0.f;
    v4u kreg[RK], vreg[RV];
#define ATT_PREFETCH(tile_) do { \
        _Pragma("unroll") for (int i_ = 0; i_ < RK; ++i_) { const int c_ = tid + 512 * i_; if (c_ < NCK) { const int row_ = c_ / CPR, cc_ = c_ % CPR; kreg[i_] = *(const v4u*)(Kb + (size_t)(TK * (tile_) + row_) * kpitch + 8 * cc_); } } \
        _Pragma("unroll") for (int i_ = 0; i_ < RV; ++i_) { const int c_ = tid + 512 * i_; if (c_ < NCV) { const int d_ = c_ >> 4, cc_ = c_ & 15; vreg[i_] = *(const v4u*)(VTb + (size_t)d_ * skv + TK * (tile_) + 8 * cc_); } } } while (0)
    if (STRIP != 2) ATT_PREFETCH(0);
    for (int tile = 0; tile < NT; ++tile) {
        __syncthreads();
        if (STRIP != 2) {
#pragma unroll
        for (int i = 0; i < RK; ++i) { const int c = tid + 512 * i; if (c < NCK) { const int row = c / CPR, cc = c % CPR; *(LAS v4u*)(Ks + row * KP + 8 * cc) = kreg[i]; } }
#pragma unroll
        for (int i = 0; i < RV; ++i) { const int c = tid + 512 * i; if (c < NCV) { const int d = c >> 4, cc = c & 15; *(LAS v4u*)(Vs + d * VP + 8 * cc) = vreg[i]; } }
        }
        __syncthreads();
        if (STRIP != 2 && tile + 1 < NT) ATT_PREFETCH(tile + 1);
        __builtin_amdgcn_sched_barrier(0);
        if (STRIP == 1) continue;
#pragma unroll 1
        for (int sub = 0; sub < 2; ++sub) {
        const int t64 = 2 * tile + sub;
        if (MODE != 0 && 64 * t64 > qlo + 31) continue;
        const LAS bf16* Kc = Ks + 64 * sub * KP; const LAS bf16* Vc = Vs + 64 * sub;
        unsigned mw0 = 0u, mw1 = 0u;
        if (MODE == 2) { const v2u mm = *(const v2u*)(maskb + (size_t)(qlo + r) * 64 + 2 * t64); mw0 = mm.x >> (4 * hh); mw1 = mm.y >> (4 * hh); }
        f32x16 s0, s1;
#pragma unroll
        for (int i = 0; i < 16; ++i) { s0[i] = 0.f; s1[i] = 0.f; }
#pragma unroll
        for (int ks = 0; ks < NKS; ++ks) {
            const bf16x8 a0 = *(const LAS bf16x8*)(Kc + r * KP + 16 * ks + 8 * hh);
            const bf16x8 a1 = *(const LAS bf16x8*)(Kc + (32 + r) * KP + 16 * ks + 8 * hh);
            s0 = __builtin_amdgcn_mfma_f32_32x32x16_bf16(a0, qf[ks], s0, 0, 0, 0);
            s1 = __builtin_amdgcn_mfma_f32_32x32x16_bf16(a1, qf[ks], s1, 0, 0, 0);
        }
        if (MODE == 1) {
            if (64 * t64 + 63 > qlo) { const int qg = qlo + r;
#pragma unroll
                for (int i = 0; i < 16; ++i) { const int key = 64 * t64 + crow(i, hh); if (key > qg) s0[i] = NEGF; if (key + 32 > qg) s1[i] = NEGF; } }
        }
        if (MODE == 2) {
#pragma unroll
            for (int i = 0; i < 16; ++i) { const int bit = (i & 3) + 8 * (i >> 2); if (!((mw0 >> bit) & 1u)) s0[i] = NEGF; if (!((mw1 >> bit) & 1u)) s1[i] = NEGF; }
        }
        float mx = s0[0];
#pragma unroll
        for (int i = 1; i < 16; ++i) mx = __builtin_fmaxf(mx, s0[i]);
#pragma unroll
        for (int i = 0; i < 16; ++i) mx = __builtin_fmaxf(mx, s1[i]);
        mx = __builtin_fmaxf(mx, __shfl_xor(mx, 32));
        const float m_new = __builtin_fmaxf(m_run, mx);
        const float alpha = __builtin_amdgcn_exp2f(m_run - m_new);
        m_run = m_new;
        float ls = 0.f;
#pragma unroll
        for (int i = 0; i < 16; ++i) { s0[i] = __builtin_amdgcn_exp2f(s0[i] - m_new); s1[i] = __builtin_amdgcn_exp2f(s1[i] - m_new); ls += s0[i] + s1[i]; }
        l_run = l_run * alpha + ls;
#pragma unroll
        for (int mt = 0; mt < NMT; ++mt)
#pragma unroll
            for (int i = 0; i < 16; ++i) o[mt][i] *= alpha;
        v4u pf[2][2];
#pragma unroll
        for (int s = 0; s < 2; ++s) {
            pf[0][s] = (v4u){pk2(s0[8 * s], s0[8 * s + 1]), pk2(s0[8 * s + 2], s0[8 * s + 3]), pk2(s0[8 * s + 4], s0[8 * s + 5]), pk2(s0[8 * s + 6], s0[8 * s + 7])};
            pf[1][s] = (v4u){pk2(s1[8 * s], s1[8 * s + 1]), pk2(s1[8 * s + 2], s1[8 * s + 3]), pk2(s1[8 * s + 4], s1[8 * s + 5]), pk2(s1[8 * s + 6], s1[8 * s + 7])};
        }
#pragma unroll
        for (int mt = 0; mt < NMT; ++mt)
#pragma unroll
            for (int p = 0; p < 2; ++p)
#pragma unroll
                for (int s = 0; s < 2; ++s) {
                    const LAS bf16* vp = Vc + (32 * mt + r) * VP + 32 * p + 16 * s + 4 * hh;
                    const s16x4 lo = *(const LAS s16x4*)(vp), hi = *(const LAS s16x4*)(vp + 8);
                    const bf16x8 a = (bf16x8){lo[0], lo[1], lo[2], lo[3], hi[0], hi[1], hi[2], hi[3]};
                    o[mt] = __builtin_amdgcn_mfma_f32_32x32x16_bf16(a, __builtin_bit_cast(bf16x8, pf[p][s]), o[mt], 0, 0, 0);
                }
        }
    }
#undef ATT_PREFETCH
    const float l_tot = l_run + __shfl_xor(l_run, 32);
    const float inv = 1.0f / l_tot;
    const size_t row = (size_t)(qlo + r);
#pragma unroll
    for (int mt = 0; mt < NMT; ++mt)
#pragma unroll
        for (int g4 = 0; g4 < 4; ++g4) {
            const int d = 32 * mt + 8 * g4 + 4 * hh;
            float ov[4];
#pragma unroll
            for (int i = 0; i < 4; ++i) ov[i] = o[mt][4 * g4 + i] * inv;
            if (Zb) { const v2u zw = *(const v2u*)(Zb + row * PP + d); const float z[4] = {bflo(zw.x), bfhi(zw.x), bflo(zw.y), bfhi(zw.y)};
#pragma unroll
                for (int i = 0; i < 4; ++i) ov[i] *= z[i] / (1.0f + __expf(-z[i])); }
            v2u ow; ow.x = pk2(ov[0], ov[1]); ow.y = pk2(ov[2], ov[3]);
            *(v2u*)(Ob + row * PP + d) = ow;
        }
}

__device__ __forceinline__ bf16* gate_row(bf16* G0, bf16* G1, size_t row) { return row < 8192 ? G0 + row * 3072 : G1 + (row - 8192) * 3072; }
struct EpiZG {
    static constexpr bool PERM = true, AFTER_DRAIN = false;
    bf16* P; bf16* G0; bf16* G1;
    __device__ __forceinline__ void operator()(const pg8::f32x4 (&acc)[2][2][4][2], const pg8::Unit& u, int wr, int wc, int fr, int fq) const {
        const int row0 = u.pm * 256 + wr * 64 + fr, cl = wc * 32 + 8 * fq;
        const bool isz = u.pn < 4;
        const int ycol = (u.pn < 2 ? C_YA : C_YB) + (u.pn & 1) * 256, gcol = (u.pn - 4) * 256;
#pragma unroll
        for (int ai = 0; ai < 2; ++ai)
#pragma unroll
            for (int m = 0; m < 4; ++m) { const size_t row = (size_t)(row0 + ai * 128 + m * 16);
#pragma unroll
                for (int bj = 0; bj < 2; ++bj) {
                    const pg8::f32x4 v0 = acc[ai][bj][m][0], v1 = acc[ai][bj][m][1];
                    float rr[8] = {v0[0], v0[1], v0[2], v0[3], v1[0], v1[1], v1[2], v1[3]};
                    if (isz) { bf16* dst = P + row * PP + ycol + cl + bj * 128; const v4u old = *(const v4u*)dst; float yv[8]; UNPACK8(old, yv);
#pragma unroll
                        for (int e = 0; e < 8; ++e) rr[e] = yv[e] * (rr[e] / (1.0f + __expf(-rr[e])));
                        *(v4u*)dst = PACK8(rr); }
                    else { bf16* dst = gate_row(G0, G1, row) + gcol + cl + bj * 128;
#pragma unroll
                        for (int e = 0; e < 8; ++e) rr[e] = 1.0f / (1.0f + __expf(-rr[e]));
                        *(v4u*)dst = PACK8(rr); } } }
    }
};
struct EpiMerge {
    static constexpr bool PERM = true, AFTER_DRAIN = false;
    bf16* Mg; bf16* G0; bf16* G1; int nbr;
    __device__ __forceinline__ void operator()(const pg8::f32x4 (&acc)[2][2][4][2], const pg8::Unit& u, int wr, int wc, int fr, int fq) const {
        const int row0 = u.pm * 256 + wr * 64 + fr, col0 = u.pn * 256 + wc * 32 + 8 * fq;
#pragma unroll
        for (int ai = 0; ai < 2; ++ai)
#pragma unroll
            for (int m = 0; m < 4; ++m) { const size_t row = (size_t)(row0 + ai * 128 + m * 16);
#pragma unroll
                for (int bj = 0; bj < 2; ++bj) { const int col = col0 + bj * 128;
                    const v4u gwd = *(const v4u*)(gate_row(G0, G1, row) + nbr * 1024 + col);
                    float gl[8]; UNPACK8(gwd, gl);
                    const pg8::f32x4 v0 = acc[ai][bj][m][0], v1 = acc[ai][bj][m][1];
                    float rr[8] = {v0[0], v0[1], v0[2], v0[3], v1[0], v1[1], v1[2], v1[3]};
#pragma unroll
                    for (int e = 0; e < 8; ++e) rr[e] *= gl[e];
                    bf16* dst = Mg + row * 1024 + col;
                    if (nbr > 0) { const v4u old = *(const v4u*)dst; float ol[8]; UNPACK8(old, ol);
#pragma unroll
                        for (int e = 0; e < 8; ++e) rr[e] += ol[e]; }
                    *(v4u*)dst = PACK8(rr); } }
    }
};
struct EpiOut {
    static constexpr bool PERM = true, AFTER_DRAIN = false;
    const float* X; float* Out;
    __device__ __forceinline__ void operator()(const pg8::f32x4 (&acc)[2][2][4][2], const pg8::Unit& u, int wr, int wc, int fr, int fq) const {
        const int row0 = u.pm * 256 + wr * 64 + fr, col0 = u.pn * 256 + wc * 32 + 8 * fq;
#pragma unroll
        for (int ai = 0; ai < 2; ++ai)
#pragma unroll
            for (int m = 0; m < 4; ++m) { const size_t row = (size_t)(row0 + ai * 128 + m * 16);
#pragma unroll
                for (int bj = 0; bj < 2; ++bj) { const size_t p = row * 1024 + col0 + bj * 128;
                    const f32x4 x0 = *(const f32x4*)(X + p), x1 = *(const f32x4*)(X + p + 4);
                    const pg8::f32x4 a0 = acc[ai][bj][m][0], a1 = acc[ai][bj][m][1];
                    *(f32x4*)(Out + p) = (f32x4){x0[0] + a0[0], x0[1] + a0[1], x0[2] + a0[2], x0[3] + a0[3]};
                    *(f32x4*)(Out + p + 4) = (f32x4){x1[0] + a1[0], x1[1] + a1[1], x1[2] + a1[2], x1[3] + a1[3]}; } }
    }
};

#define XB_TMO      128
#define XB_XCNT(j)  (256  + 64 * (j))
#define XB_XSUB(j)  (1280 + 64 * (j))
#define XB_XGEN(j)  (2304 + 64 * (j))
#define XB_TOP      3328
#define XB_TOPGEN   3392
#define XCD_BAR_WORDS 3456
#define XB_SPIN_CAP (1u << 18)

__device__ __forceinline__ unsigned xb_ld(unsigned* p)              { return __hip_atomic_load(p, __ATOMIC_RELAXED, __HIP_MEMORY_SCOPE_AGENT); }
__device__ __forceinline__ unsigned xb_add(unsigned* p, unsigned v) { return __hip_atomic_fetch_add(p, v, __ATOMIC_RELAXED, __HIP_MEMORY_SCOPE_AGENT); }
__device__ __forceinline__ unsigned xb_xcc_id() { return (unsigned)__builtin_amdgcn_s_getreg((3 << 11) | 20) & 0xFu; }
#define XB_SPIN(cond, bar) do { unsigned _sp = 0; while (cond) { __builtin_amdgcn_s_sleep(1); \
    if ((++_sp & 255u) == 0u) { if (xb_ld(&(bar)[XB_TMO])) break; if (_sp > XB_SPIN_CAP) { atomicAdd(&(bar)[XB_TMO], 1u); break; } } } } while (0)

struct XcdBarrier {
    unsigned* bar; unsigned x;
    volatile LAS unsigned* st;
};

__device__ __forceinline__ XcdBarrier xcd_barrier_post(unsigned* bar, volatile LAS unsigned* st) {
    XcdBarrier b; b.bar = bar; b.x = xb_xcc_id(); b.st = st;
    if (threadIdx.x == 0) (void)xb_add(&bar[XB_XCNT(b.x)], 1u);
    return b;
}
__device__ __forceinline__ void xcd_barrier_complete(unsigned* bar, unsigned x, unsigned& nloc, unsigned& nx) {
    const unsigned G = gridDim.x * gridDim.y * gridDim.z;
    unsigned sum, cnt, mine, sp = 0u;
    for (;;) {
        sum = 0u; cnt = 0u; mine = 0u;
#pragma unroll
        for (unsigned j = 0; j < 16; ++j) { const unsigned c = xb_ld(&bar[XB_XCNT(j)]); sum += c; cnt += (c > 0u) ? 1u : 0u; mine = (j == x) ? c : mine; }
        if (sum == G) break;
        __builtin_amdgcn_s_sleep(1);
        if ((++sp & 255u) == 0u) { if (xb_ld(&bar[XB_TMO])) break; if (sp > XB_SPIN_CAP) { atomicAdd(&bar[XB_TMO], 1u); break; } }
    }
    nloc = mine > 0u ? mine : 1u; nx = cnt > 0u ? cnt : 1u;
}

__device__ __forceinline__ void xcd_barrier(const XcdBarrier& b) {
    asm volatile("s_waitcnt vmcnt(0)" ::: "memory");
    __syncthreads();
    if (threadIdx.x == 0) {
        unsigned* bar = b.bar;
        __builtin_amdgcn_s_waitcnt(0);
        unsigned nloc = b.st[0], nx = b.st[1];
        if (nloc == 0u) { xcd_barrier_complete(bar, b.x, nloc, nx); b.st[0] = nloc; b.st[1] = nx; }
        const unsigned old = xb_add(&bar[XB_XSUB(b.x)], 1u);
        const unsigned gen = old / nloc;
        if (old + 1u == (gen + 1u) * nloc) {
            __builtin_amdgcn_fence(__ATOMIC_RELEASE, "agent");
            asm volatile("s_waitcnt vmcnt(0)" ::: "memory");
            const unsigned og = xb_add(&bar[XB_TOP], 1u);
            const unsigned tg = og / nx;
            if (og + 1u == (tg + 1u) * nx) xb_add(&bar[XB_TOPGEN], 1u);
            else XB_SPIN(xb_ld(&bar[XB_TOPGEN]) == tg, bar);
            __builtin_amdgcn_fence(__ATOMIC_ACQUIRE, "agent");
            xb_add(&bar[XB_XGEN(b.x)], 1u);
            asm volatile("s_waitcnt vmcnt(0)" ::: "memory");
        } else {
            XB_SPIN(xb_ld(&bar[XB_XGEN(b.x)]) == gen, bar);
            __builtin_amdgcn_fence(__ATOMIC_ACQUIRE, "agent");
            asm volatile("s_waitcnt vmcnt(0)" ::: "memory");
        }
    }
    __syncthreads();
}

template <int DQK, int DV, int MODE>
__device__ __forceinline__ void att_call(bool strip, LAS unsigned char* lds, const bf16* Qb, int qpitch, const bf16* Kb, int kpitch, const bf16* VTb, int skv, const unsigned* maskb, const bf16* Zb, bf16* Ob, int q0) {
    if (ATT_STRIP != 0 && strip) attn_unit<DQK, DV, MODE, ATT_STRIP>(lds, Qb, qpitch, Kb, kpitch, VTb, skv, maskb, Zb, Ob, q0);
    else attn_unit<DQK, DV, MODE, 0>(lds, Qb, qpitch, Kb, kpitch, VTb, skv, maskb, Zb, Ob, q0);
}
struct Args { const float* in[19]; const int* pos; float* out; unsigned char* ws; };
typedef const __attribute__((address_space(4))) Args* kargs_t;
#define PHASE_BEGIN \
    kargs_t ap_ = (kargs_t)__builtin_amdgcn_kernarg_segment_ptr(); asm volatile("" : "+s"(ap_)); \
    int tid = threadIdx.x; asm volatile("" : "+v"(tid)); \
    const int lane = tid & 63, wave = __builtin_amdgcn_readfirstlane(tid >> 6), G = gridDim.x, NGW = G * 8, gw = blockIdx.x * 8 + wave; \
    unsigned char* const ws = ap_->ws; unsigned char* const dob = (unsigned char*)ap_->out; const int* const pos = ap_->pos; float* const outp = ap_->out; unsigned* const ctl = (unsigned*)(ws + WS_CTL); \
    const float* const x = ap_->in[0]; const float* const mem = ap_->in[1]; \
    const float* const g_norm = ap_->in[3]; const float* const w_in = ap_->in[4]; const float* const g_qn_a = ap_->in[5]; const float* const g_kn_a = ap_->in[6]; \
    const float* const g_cq = ap_->in[7]; const float* const g_ckv = ap_->in[8]; const float* const w_uq = ap_->in[9]; const float* const w_ukv = ap_->in[10]; \
    const float* const g_qn_b = ap_->in[11]; const float* const g_kn_b = ap_->in[12]; const float* const g_mem = ap_->in[13]; const float* const w_mem_kv = ap_->in[14]; \
    const float* const g_qn_m = ap_->in[15]; const float* const g_kn_m = ap_->in[16]; const float* const w_branch = ap_->in[17]; const float* const w_out = ap_->in[18]; \
    bf16* const WinT = (bf16*)(ws + WS_WIN); bf16* const WuqT = (bf16*)(ws + WS_WUQ); bf16* const WukvT = (bf16*)(ws + WS_WUKV); bf16* const WmemT = (bf16*)(ws + WS_WMEM); \
    bf16* const WbrT = (bf16*)(ws + WS_WBR); bf16* const WoutT = (bf16*)(ws + WS_WOUT); \
    float* const ropeA = (float*)(ws + WS_ROPEA); float* const ropeB = (float*)(ws + WS_ROPEB); \
    bf16* const MN = (bf16*)(ws + WS_MN); bf16* const KVM = (bf16*)(ws + WS_KVM); bf16* const VTM = (bf16*)(ws + WS_VTM); \
    float* const WI = (float*)(ws + WS_WI); unsigned* const MASK = (unsigned*)(ws + WS_MASK); \
    bf16* const VTA = (bf16*)(dob + DO_VTA); bf16* const VTB = (bf16*)(dob + DO_VTB); bf16* const KB = (bf16*)(dob + DO_KB); \
    bf16* const Hh = (bf16*)(ws + WS_H); bf16* const MG = (bf16*)(ws + WS_H); bf16* const QB = (bf16*)(ws + WS_QB); \
    bf16* const KVB = (bf16*)(ws + WS_KVB); bf16* const GT0 = (bf16*)(dob + DO_G0); bf16* const GT1 = (bf16*)(ws + WS_G1); bf16* const P = (bf16*)(ws + WS_P); \
    (void)lane; (void)NGW; (void)gw; (void)ctl; \
    (void)pos; (void)outp; (void)x; (void)mem; (void)g_norm; (void)w_in; (void)g_qn_a; (void)g_kn_a; (void)g_cq; (void)g_ckv; (void)w_uq; (void)w_ukv; (void)g_qn_b; (void)g_kn_b; (void)g_mem; (void)w_mem_kv; \
    (void)g_qn_m; (void)g_kn_m; (void)w_branch; (void)w_out; (void)WinT; (void)WuqT; (void)WukvT; (void)WmemT; (void)WbrT; (void)WoutT; (void)ropeA; (void)ropeB; (void)MN; (void)KVM; (void)VTM; (void)WI; (void)MASK; \
    (void)VTA; (void)VTB; (void)Hh; (void)KB; (void)QB; (void)KVB; (void)MG; (void)GT0; (void)GT1; (void)P
#define GRID_BARRIER() do { kargs_t bp_ = (kargs_t)__builtin_amdgcn_kernarg_segment_ptr(); asm volatile("" : "+s"(bp_)); \
    XcdBarrier b_; b_.bar = (unsigned*)(bp_->ws + WS_CTL) + 4096; b_.x = xb_xcc_id(); b_.st = (volatile LAS unsigned*)(lds + LDS_BYTES - 32); xcd_barrier(b_); } while (0)

__global__ void __launch_bounds__(512, 2) fwd_kernel(Args a) {
    extern __shared__ __attribute__((aligned(16))) unsigned char lds_raw[];
    LAS unsigned char* const lds = (LAS unsigned char*)lds_raw;
    volatile LAS int* const slot = (volatile LAS int*)(lds + LDS_SLOT);
    if (threadIdx.x < 16) ((LAS unsigned*)(lds + LDS_BYTES - 64))[threadIdx.x] = 0u;
    __syncthreads();
    (void)xcd_barrier_post((unsigned*)(a.ws + WS_CTL) + 4096, (volatile LAS unsigned*)(lds + LDS_BYTES - 32));

    for (int rep = 0; rep < REP_P0; ++rep) { PHASE_BEGIN;
        LAS float* scr = (LAS float*)(lds + wave * 16384);
        constexpr int I_IN = 16 * (NP / 32), I_UQ = 6 * 24, I_UKV = 4 * 32, I_MEM = 16 * 32, I_BR = 8 * 32, I_OUT = 16 * 32;
        constexpr int NITEMS = I_IN + I_UQ + I_UKV + I_MEM + 3 * I_BR + I_OUT;
        for (int it = gw; it < NITEMS; it += NGW) {
            int r = it;
            if (r < I_IN) { transpose_item<true>(w_in, 1024, DIN, NP, WinT, scr, r, lane); continue; } r -= I_IN;
            if (r < I_UQ) { transpose_item<false>(w_uq, 384, 768, 768, WuqT, scr, r, lane); continue; } r -= I_UQ;
            if (r < I_UKV) { transpose_item<false>(w_ukv, 256, 1024, 1024, WukvT, scr, r, lane); continue; } r -= I_UKV;
            if (r < I_MEM) { transpose_item<false>(w_mem_kv, 1024, 1024, 1024, WmemT, scr, r, lane); continue; } r -= I_MEM;
            if (r < 3 * I_BR) { const int nb = r / I_BR; transpose_item<false>(w_branch + (size_t)nb * 512 * 1024, 512, 1024, 1024, WbrT + (size_t)nb * 1024 * 512, scr, r % I_BR, lane); continue; } r -= 3 * I_BR;
            transpose_item<false>(w_out, 1024, 1024, 1024, WoutT, scr, r, lane);
        }
        for (int idx = blockIdx.x * 512 + tid; idx < TT * 24; idx += G * 512) {
            const int t = idx / 24, i = idx % 24; const float pf = (float)pos[t];
            if (i < 8) { const float ang = pf * INVA[i]; ropeA[t * 16 + i] = cosf(ang); ropeA[t * 16 + 8 + i] = sinf(ang); }
            else { const int j = i - 8; const float ang = pf * INVB[j]; ropeB[t * 32 + j] = cosf(ang); ropeB[t * 32 + 16 + j] = sinf(ang); }
        }
        for (int m = gw; m < NB * MEML; m += NGW) rms_row_1024(mem + (size_t)m * DM, g_mem, MN + (size_t)m * DM, lane);
        for (int rp = 0; rp < REP_PH; ++rp)
        for (int m = gw; m < TT; m += NGW) rms_row_1024(x + (size_t)m * DM, g_norm, Hh + (size_t)m * DM, lane);
    }
    GRID_BARRIER();
    for (int es = 0; es < EXTRA_SYNCS; ++es) GRID_BARRIER();

    for (int rep = 0; rep < REP_G1; ++rep) { PHASE_BEGIN;
        pg8::Gemm g{Hh, WinT, TT, PP, 1024, 1024}; pg8::StaticOrder S; S.init(TT, PP, G, (int)blockIdx.x);
        pg8::EpiBf16<0> E{P, PP, nullptr, 0, 0, 1.f};
        pg8::gemm_phase<pg8::EpiBf16<0>, pg8::StaticOrder, true, true>(lds, g, S, E);
    }
    { PHASE_BEGIN;
        pg8::Gemm g{MN, WmemT, NB * MEML, 1024, 1024, 1024}; pg8::StaticOrder S; S.init(NB * MEML, 1024, G, (int)((blockIdx.x + 64) % G));
        pg8::EpiBf16<0> E{KVM, 1024, nullptr, 0, 0, 1.f};
        pg8::gemm_phase<pg8::EpiBf16<0>, pg8::StaticOrder, true, true>(lds, g, S, E);
    }
    GRID_BARRIER();
    { PHASE_BEGIN;
        for (int dp = 0; dp < DUMMY_POST1; ++dp)
            for (int m = gw; m < TT; m += NGW)
                post1_row(P + (size_t)m * PP, QB + (size_t)(m & 1023) * 4096, ropeA + (size_t)m * 16, g_qn_a, g_kn_a, g_cq, g_ckv, g_qn_m, (float*)KVB + (size_t)m * 8, lane);
        for (int m = gw; m < TT; m += NGW)
            post1_row(P + (size_t)m * PP, P + (size_t)m * PP, ropeA + (size_t)m * 16, g_qn_a, g_kn_a, g_cq, g_ckv, g_qn_m, WI + (size_t)m * 8, lane);
        for (int rt = 0; rt < REP_TR; ++rt)
        transpose_v(P, PP, C_VA, 64, 8, 64, SEQ, NB, VTA, gw, NGW, lane);
        for (int m = gw; m < NB * MEML; m += NGW) km_row(KVM + (size_t)m * 1024, g_kn_m, lane);
        for (int rt = 0; rt < REP_TR; ++rt)
        transpose_v(KVM, 1024, 512, 128, 4, 128, MEML, NB, VTM, gw, NGW, lane);
    }
    GRID_BARRIER();
    for (int rep = 0; rep < REP_G2; ++rep) { PHASE_BEGIN;
        pg8::Gemm g{P + C_CQ, WuqT, TT, 768, 384, PP}; pg8::StaticOrder S; S.init(TT, 768, G, (int)blockIdx.x);
        pg8::EpiBf16<0> E{QB, 768, nullptr, 0, 0, 1.f};
        pg8::gemm_phase<pg8::EpiBf16<0>, pg8::StaticOrder, true, true>(lds, g, S, E);
    }
    for (int rep = 0; rep < REP_G2; ++rep) { PHASE_BEGIN;
        pg8::Gemm g{P + C_CKV, WukvT, TT, 1024, 256, PP}; pg8::StaticOrder S; S.init(TT, 1024, G, (int)((blockIdx.x + 192) % G));
        pg8::EpiBf16<0> E{KVB, 1024, nullptr, 0, 0, 1.f};
        pg8::gemm_phase<pg8::EpiBf16<0>, pg8::StaticOrder, true, true>(lds, g, S, E);
    }
    for (int rep = 0; rep < REP_IDX; ++rep) { if (rep > 0) GRID_BARRIER();
        PHASE_BEGIN;
        unsigned* const q_idx = ctl + 64 * (0 + 4 * rep);
        for (;;) {
            const int u = next_unit(q_idx, slot);
            if (u >= NB * 128) break;
            const int tb = 127 - (u >> 3), bb = u & 7;
            indexer_unit((LAS float*)lds, P, WI, MASK, bb, tb);
        }
    }
    GRID_BARRIER();
    { PHASE_BEGIN;
        LAS float* scr = (LAS float*)(lds + wave * 8192);
        for (int dp = 0; dp < DUMMY_POST2; ++dp)
            for (int m = gw; m < TT; m += NGW)
                post2_row(QB + (size_t)m * 768, (bf16*)MASK + (size_t)(m & 1023) * 768, KVB + (size_t)m * 1024, P + (size_t)m * PP, (bf16*)MASK + (size_t)(1024 + (m & 1023)) * 768, ropeB + (size_t)m * 32, g_qn_b, g_kn_b, scr, lane);
        for (int m = gw; m < TT; m += NGW)
            post2_row(QB + (size_t)m * 768, QB + (size_t)m * 768, KVB + (size_t)m * 1024, P + (size_t)m * PP, KB + (size_t)m * 768, ropeB + (size_t)m * 32, g_qn_b, g_kn_b, scr, lane);
        for (int rt = 0; rt < REP_TR; ++rt)
        transpose_v(KVB, 1024, 64, 128, 8, 64, SEQ, NB, VTB, gw, NGW, lane);
    }
    GRID_BARRIER();
    for (int rep = 0; rep < REP_ATT; ++rep) { if (rep > 0) GRID_BARRIER();
        PHASE_BEGIN;
        unsigned* const q_att = ctl + 64 * (1 + 4 * rep);
        for (;;) {
            const int u = next_unit(q_att, slot);
            if (u >= 1280) break;
            if (u < 1024) {
                const int qb = 7 - (u >> 7), wi = u & 127, bh = wi & 63, bb = bh >> 3, h = bh & 7;
                const size_t r0 = (size_t)bb * SEQ;
                if (wi < 64) att_call<96, 64, 1>(rep == 0 && REP_ATT > 1, lds, QB + r0 * 768 + h * 96, 768, KB + r0 * 768 + h * 96, 768, VTB + (size_t)((bb * 8 + h) * 64) * SEQ, SEQ, nullptr,
                                                  nullptr, P + r0 * PP + C_YB + h * 64, qb * 256);
                else att_call<64, 64, 2>(rep == 0 && REP_ATT > 1, lds, P + r0 * PP + C_QA + h * 64, PP, P + r0 * PP + C_KA + h * 64, PP, VTA + (size_t)((bb * 8 + h) * 64) * SEQ, SEQ, MASK + r0 * 64,
                                          nullptr, P + r0 * PP + C_YA + h * 64, qb * 256);
            } else {
                const int v = u - 1024, qb = v & 7, bh = v >> 3, bb = bh >> 2, h = bh & 3;
                const size_t r0 = (size_t)bb * SEQ;
                att_call<128, 128, 0>(rep == 0 && REP_ATT > 1, lds, P + r0 * PP + C_QM + h * 128, PP, KVM + (size_t)bb * MEML * 1024 + h * 128, 1024, VTM + (size_t)((bb * 4 + h) * 128) * MEML, MEML, nullptr,
                                       P + r0 * PP + C_ZM + h * 128, P + r0 * PP + C_YM + h * 128, qb * 256);
            }
        }
    }
    GRID_BARRIER();
    for (int rep = 0; rep < 1; ++rep) { PHASE_BEGIN;
        pg8::Gemm g{Hh, WinT + (size_t)PP * 1024, TT, NZG, 1024, 1024}; pg8::StaticOrder S; S.init(TT, NZG, G, (int)blockIdx.x);
        EpiZG E{P, GT0, GT1};
        pg8::gemm_phase<EpiZG, pg8::StaticOrder, true, true>(lds, g, S, E);
    }
    GRID_BARRIER();
    for (int nbr = 0; nbr < 3 * REP_G4; ++nbr) { const int nb = nbr % 3; PHASE_BEGIN;
        pg8::Gemm g{P + (nb == 0 ? C_YA : (nb == 1 ? C_YB : C_YM)), WbrT + (size_t)nb * 1024 * 512, TT, 1024, 512, PP}; pg8::StaticOrder S; S.init(TT, 1024, G, (int)blockIdx.x);
        EpiMerge E{MG, GT0, GT1, nb};
        pg8::gemm_phase<EpiMerge, pg8::StaticOrder, true, true>(lds, g, S, E);
    }
    GRID_BARRIER();
    for (int rep = 0; rep < REP_G5; ++rep) { PHASE_BEGIN;
        pg8::Gemm g{MG, WoutT, TT, 1024, 1024, 1024}; pg8::StaticOrder S; S.init(TT, 1024, G, (int)blockIdx.x);
        EpiOut E{x, outp};
        pg8::gemm_phase<EpiOut, pg8::StaticOrder, true, true>(lds, g, S, E);
    }
}

extern "C" void kernel_launch(void* const* d_in, const int* in_sizes, int n_in, void* d_out, int out_size, void* d_ws, size_t ws_size, hipStream_t stream) {
    static int grid = 0;
    if (grid == 0) {
        if (n_in != 19 || out_size != TT * DM || ws_size < WS_END) { fprintf(stderr, "kernel_launch: unexpected problem (n_in %d, out %d, ws %zu); nothing launched\n", n_in, out_size, ws_size); grid = -1; return; }
        int dev = 0, cus = 0, per_cu = 0;
        if (hipGetDevice(&dev) != hipSuccess || hipDeviceGetAttribute(&cus, hipDeviceAttributeMultiprocessorCount, dev) != hipSuccess) { grid = -1; return; }
        if (hipFuncSetAttribute((const void*)fwd_kernel, hipFuncAttributeMaxDynamicSharedMemorySize, LDS_BYTES) != hipSuccess) { fprintf(stderr, "kernel_launch: hipFuncSetAttribute failed\n"); grid = -1; return; }
        if (hipOccupancyMaxActiveBlocksPerMultiprocessor(&per_cu, (const void*)fwd_kernel, 512, LDS_BYTES) != hipSuccess || per_cu < 1) { fprintf(stderr, "kernel_launch: occupancy query reports %d blocks per CU\n", per_cu); (void)hipGetLastError(); grid = -1; return; }
        grid = cus;
    }
    if (grid < 0) return;
    (void)hipMemsetAsync((char*)d_ws + WS_CTL, 0, 65536, stream);
    Args a{};
    for (int i = 0; i < 19; ++i) a.in[i] = (const float*)d_in[i];
    a.pos = (const int*)d_in[2]; a.out = (float*)d_out; a.ws = (unsigned char*)d_ws;
    hipLaunchKernelGGL(fwd_kernel, dim3(grid), dim3(512), LDS_BYTES, stream, a);
    const hipError_t e = hipPeekAtLastError();
    if (e != hipSuccess) fprintf(stderr, "kernel_launch: launch failed: %s (grid %d)\n", hipGetErrorString(e), grid);
}
```

```cpp
#include <hip/hip_runtime.h>
#include <cstdio>
#include <cstdint>
namespace pg8 {
#define PG8_LAS __attribute__((address_space(3)))
typedef unsigned short bf16_t;
typedef short bf16x8 __attribute__((ext_vector_type(8)));
typedef float f32x4 __attribute__((ext_vector_type(4)));
typedef unsigned u32x4 __attribute__((ext_vector_type(4)));
constexpr int BM = 256, BK = 64, HALF = 128, HTB = HALF * BK * 2  , STAGE_BYTES = 8 * HTB, NXCD = 8, WGM = 8;

__host__ __device__ __forceinline__ int lds_byte(int r, int c) { const int st = (r >> 4) * 2 + (c >> 5), rr = r & 15, cc = c & 31, ob = rr * 64 + cc * 2; return st * 1024 + (ob ^ (((ob >> 9) & 1) << 5)); }
__host__ __device__ __forceinline__ void stage_rc(int b, int& R, int& C) { const int st = b / 1024, sb = b % 1024, swz = sb ^ (((sb >> 9) & 1) << 5); R = (st >> 1) * 16 + swz / 64; C = (st & 1) * 32 + (swz % 64) / 2; }
__host__ __device__ __forceinline__ int perm32(int rho) { const int n = rho >> 4, i = rho & 15; return 8 * (i >> 2) + 4 * n + (i & 3); }

struct Unit { int pm, pn; };
struct Gemm { const bf16_t* A; const bf16_t* Bt; int M, N, K, lda; };

struct StaticOrder {
    int nM, nN, nwg, G, c;
    __host__ __device__ void init(int M, int N, int G_, int c_) { nM = M / BM; nN = N / BM; nwg = nM * nN; G = G_; c = c_; }
    __host__ __device__ bool next(int i, Unit& u) const {
        const long L = (long)i * G + c; if (L >= nwg) return false;
        int wgid = (int)L; { const int q = nwg / NXCD, r = nwg % NXCD, xcd = wgid % NXCD, off = wgid / NXCD; wgid = (xcd < r ? xcd * (q + 1) : r * (q + 1) + (xcd - r) * q) + off; }
        const int nig = WGM * nN, gid = wgid / nig, fm = gid * WGM, gsz = (nM - fm) < WGM ? (nM - fm) : WGM;
        u.pm = fm + ((wgid % nig) % gsz); u.pn = (wgid % nig) / gsz; return true;
    }
    __device__ __forceinline__ void a_ready(const Unit&) const {}
    __device__ __forceinline__ void done(const Unit&) const {}
};

__device__ __forceinline__ unsigned cvt_pk_bf16(float lo, float hi) { unsigned r; asm volatile("v_cvt_pk_bf16_f32 %0, %1, %2" : "=v"(r) : "v"(lo), "v"(hi)); return r; }
typedef float f32x2 __attribute__((ext_vector_type(2)));
__device__ __forceinline__ f32x2 gelu_pk(f32x2 v) {
    const f32x2 av = __builtin_elementwise_abs(v), d = av * 0.2316418882f + 1.0f;
    f32x2 t; t.x = __builtin_amdgcn_rcpf(d.x); t.y = __builtin_amdgcn_rcpf(d.y);
    f32x2 q = t * 0.5307027145f + (-0.7265760135f); q = q * t + 0.7107068705f; q = q * t + (-0.142248368f); q = q * t + 0.127414796f; q = q * t;
    const f32x2 s = (v * v) * (-0.72134752044f);
    f32x2 e; e.x = __builtin_amdgcn_exp2f(s.x); e.y = __builtin_amdgcn_exp2f(s.y);
    const f32x2 m = v * (q * e), r = v - m;
    f32x2 o; o.x = v.x < 0.f ? m.x : r.x; o.y = v.y < 0.f ? m.y : r.y; return o;
}

template <int ACT  > struct EpiBf16 {
    static constexpr bool PERM = true, AFTER_DRAIN = false; static_assert(ACT == 0 || ACT == 1, "EpiBf16: ACT is 0 (none) or 1 (gelu_pk)");
    bf16_t* O; int ldc; const float* bias; int split_cols; size_t split_stride; float scale0;
    __device__ __forceinline__ void operator()(const f32x4 (&acc)[2][2][4][2], const Unit& u, int wr, int wc, int fr, int fq) const {
        const int row0 = u.pm * BM + wr * 64 + fr; int colt = u.pn * BM; bf16_t* base = O;
        float sc = 1.f; if (split_cols) { const int t = colt / split_cols; base += (size_t)t * split_stride; colt -= t * split_cols; if (t == 0) sc = scale0; }
        const int col0 = colt + wc * 32 + 8 * fq, bcol0 = u.pn * BM + wc * 32 + 8 * fq;
        f32x4 bv[2][2];
#pragma unroll
        for (int bj = 0; bj < 2; ++bj)
#pragma unroll
            for (int n = 0; n < 2; ++n) bv[bj][n] = bias ? *(const f32x4*)(bias + bcol0 + bj * HALF + 4 * n) : (f32x4){0.f, 0.f, 0.f, 0.f};
#pragma unroll
        for (int ai = 0; ai < 2; ++ai)
#pragma unroll
            for (int m = 0; m < 4; ++m) { bf16_t* rowp = base + (size_t)(row0 + ai * HALF + m * 16) * ldc + col0;
#pragma unroll
                for (int bj = 0; bj < 2; ++bj) { f32x4 v0 = acc[ai][bj][m][0] + bv[bj][0], v1 = acc[ai][bj][m][1] + bv[bj][1];
                    if (ACT == 1) { f32x2 a = gelu_pk((f32x2){v0[0], v0[1]}), b = gelu_pk((f32x2){v0[2], v0[3]}), c = gelu_pk((f32x2){v1[0], v1[1]}), d = gelu_pk((f32x2){v1[2], v1[3]});
                        v0 = (f32x4){a.x, a.y, b.x, b.y}; v1 = (f32x4){c.x, c.y, d.x, d.y}; }
                    v0 = v0 * sc; v1 = v1 * sc; u32x4 w; w.x = cvt_pk_bf16(v0[0], v0[1]); w.y = cvt_pk_bf16(v0[2], v0[3]); w.z = cvt_pk_bf16(v1[0], v1[1]); w.w = cvt_pk_bf16(v1[2], v1[3]);
                    *(u32x4*)(rowp + bj * HALF) = w; } }
    }
};
template <class Epi, class Sched, bool ALIGN_EPI = false, bool SP2 = false>
__device__ __forceinline__ void gemm_phase(PG8_LAS unsigned char* lds, const Gemm g, const Sched& S, const Epi& E) {
    int tid_ = threadIdx.x; asm volatile("" : "+v"(tid_));
    const int tid = tid_, wid = __builtin_amdgcn_readfirstlane(tid >> 6), lane = tid & 63, wr = wid >> 2, wc = wid & 3, fr = lane & 15, fq = lane >> 4;
    const int K = g.K, nt = K / BK;
    unsigned voffA[2], voffB[2];
#pragma unroll
    for (int i = 0; i < 2; ++i) { int R, C; stage_rc(tid * 16 + i * 8192, R, C); const int Rb = Epi::PERM ? ((R & ~31) + perm32(R & 31)) : R;
        voffA[i] = (unsigned)(R * g.lda + C) * 2u; voffB[i] = (unsigned)(Rb * K + C) * 2u; }
    const size_t kstep = (size_t)(BK * 2);
    const size_t hstepA = (size_t)HALF * g.lda * 2, hstepB = (size_t)HALF * K * 2;
    const size_t tstepA = 2 * hstepA, tstepB = 2 * hstepB;
    const unsigned ldsw = (unsigned)wid * 1024u;
    const int aoff = lds_byte(wr * 64 + fr, fq * 8), boff = lds_byte(wc * 32 + fr, fq * 8);
#define PG8_SA(b, h) (((b) * 2 + (h)) * HTB)
#define PG8_SB(b, h) ((4 + (b) * 2 + (h)) * HTB)
#define PG8_STAGE(bufoff, gbase, voff) do { _Pragma("unroll") for (int _i = 0; _i < 2; ++_i) \
        __builtin_amdgcn_global_load_lds((const unsigned*)((const char*)(gbase) + (voff)[_i]), (PG8_LAS unsigned*)(lds + (bufoff) + ldsw + _i * 8192), 16, 0, 0); } while (0)
#define PG8_LDA(dst, b, h) do { _Pragma("unroll") for (int m = 0; m < 4; ++m) _Pragma("unroll") for (int k = 0; k < 2; ++k) dst[m][k] = *(const PG8_LAS bf16x8*)(lds + PG8_SA(b, h) + aoff + m * 2048 + k * 1024); } while (0)
#define PG8_LDB(dst, b, h) do { _Pragma("unroll") for (int n = 0; n < 2; ++n) _Pragma("unroll") for (int k = 0; k < 2; ++k) dst[n][k] = *(const PG8_LAS bf16x8*)(lds + PG8_SB(b, h) + boff + n * 2048 + k * 1024); } while (0)
#define PG8_MMA(ai, bj, At, Bt) do { __builtin_amdgcn_s_setprio(1); _Pragma("unroll") for (int m = 0; m < 4; ++m) _Pragma("unroll") for (int n = 0; n < 2; ++n) _Pragma("unroll") for (int k = 0; k < 2; ++k) \
        acc[ai][bj][m][n] = __builtin_amdgcn_mfma_f32_16x16x32_bf16(Bt[n][k], At[m][k], acc[ai][bj][m][n], 0, 0, 0); __builtin_amdgcn_s_setprio(0); } while (0)
#define PG8_WAIT_V(n) asm volatile("s_waitcnt vmcnt(" #n ")" ::: "memory")
#define PG8_WAIT_L(n) asm volatile("s_waitcnt lgkmcnt(" #n ")" ::: "memory")
#define PG8_BAR __builtin_amdgcn_s_barrier()
#define PG8_SCHED __builtin_amdgcn_sched_barrier(0)
    Unit cur, nxt; int ui = 0;
    if (!S.next(0, cur)) return;
    f32x4 acc[2][2][4][2];
#pragma unroll
    for (int a = 0; a < 2; ++a)
#pragma unroll
        for (int b = 0; b < 2; ++b)
#pragma unroll
            for (int m = 0; m < 4; ++m)
#pragma unroll
                for (int n = 0; n < 2; ++n) acc[a][b][m][n] = (f32x4){0.f, 0.f, 0.f, 0.f};
    bf16x8 At[4][2], B0[2][2], B1[2][2];
    const char* cA = (const char*)g.A + (size_t)cur.pm * tstepA; const char* cB = (const char*)g.Bt + (size_t)cur.pn * tstepB;
    S.a_ready(cur);
    if constexpr (SP2) {
        PG8_STAGE(PG8_SB(0, 0), cB, voffB); PG8_STAGE(PG8_SB(0, 1), cB + hstepB, voffB); PG8_STAGE(PG8_SA(0, 0), cA, voffA); PG8_STAGE(PG8_SA(0, 1), cA + hstepA, voffA);
        if (wr == 1) PG8_BAR;
        PG8_WAIT_V(2); PG8_BAR;
        PG8_STAGE(PG8_SB(1, 0), cB + kstep, voffB); PG8_STAGE(PG8_SA(1, 0), cA + kstep, voffA); PG8_STAGE(PG8_SB(1, 1), cB + hstepB + kstep, voffB);
        PG8_WAIT_V(6); PG8_BAR;
    } else {
        PG8_STAGE(PG8_SB(0, 0), cB, voffB); PG8_STAGE(PG8_SA(0, 0), cA, voffA); PG8_STAGE(PG8_SB(0, 1), cB + hstepB, voffB); PG8_STAGE(PG8_SA(0, 1), cA + hstepA, voffA);
        if (wr == 1) PG8_BAR;
        PG8_WAIT_V(4); PG8_BAR;
        PG8_STAGE(PG8_SB(1, 0), cB + kstep, voffB); PG8_STAGE(PG8_SA(1, 0), cA + kstep, voffA); PG8_STAGE(PG8_SB(1, 1), cB + hstepB + kstep, voffB);
        PG8_WAIT_V(6); PG8_BAR;
    }
    for (;;) {
        const bool has_next = S.next(ui + 1, nxt);
        const char* nA = has_next ? (const char*)g.A + (size_t)nxt.pm * tstepA : cA; const char* nB = has_next ? (const char*)g.Bt + (size_t)nxt.pn * tstepB : cB;
        for (int t = 0; t < nt; t += 2) {
            const bool last = (t == nt - 2);
            const char* a1 = cA + (size_t)(t + 1) * kstep;
            const char* a2 = last ? nA : cA + (size_t)(t + 2) * kstep; const char* b2 = last ? nB : cB + (size_t)(t + 2) * kstep;
            const char* a3 = a2 + kstep; const char* b3 = b2 + kstep;
            if (last && has_next) S.a_ready(nxt);
            if constexpr (SP2) {
            PG8_LDB(B0, 0, 0); PG8_LDB(B1, 0, 1); PG8_SCHED; PG8_LDA(At, 0, 0); PG8_STAGE(PG8_SA(1, 1), a1 + hstepA, voffA);
            PG8_WAIT_V(8); PG8_WAIT_L(0); PG8_BAR; PG8_MMA(0, 0, At, B0); PG8_MMA(0, 1, At, B1); PG8_BAR; PG8_SCHED;
            PG8_LDA(At, 0, 1); PG8_STAGE(PG8_SB(0, 0), b2, voffB); PG8_STAGE(PG8_SB(0, 1), b2 + hstepB, voffB); PG8_STAGE(PG8_SA(0, 0), a2, voffA);
            PG8_WAIT_V(8); PG8_WAIT_L(0); PG8_BAR; PG8_MMA(1, 0, At, B0); PG8_MMA(1, 1, At, B1); PG8_BAR; PG8_SCHED;
            PG8_LDB(B0, 1, 0); PG8_LDB(B1, 1, 1); PG8_SCHED; PG8_LDA(At, 1, 0); PG8_STAGE(PG8_SA(0, 1), a2 + hstepA, voffA);
            PG8_WAIT_V(8); PG8_WAIT_L(0); PG8_BAR; PG8_MMA(0, 0, At, B0); PG8_MMA(0, 1, At, B1); PG8_BAR; PG8_SCHED;
            PG8_LDA(At, 1, 1); PG8_STAGE(PG8_SB(1, 0), b3, voffB); PG8_STAGE(PG8_SB(1, 1), b3 + hstepB, voffB); PG8_STAGE(PG8_SA(1, 0), a3, voffA);
            PG8_WAIT_V(8); PG8_WAIT_L(0); PG8_BAR; PG8_MMA(1, 0, At, B0); PG8_MMA(1, 1, At, B1); PG8_BAR; PG8_SCHED;
            } else {
            PG8_LDB(B0, 0, 0); PG8_SCHED; PG8_LDA(At, 0, 0); PG8_STAGE(PG8_SA(1, 1), a1 + hstepA, voffA);
            PG8_WAIT_L(8); PG8_BAR; PG8_WAIT_L(0); PG8_MMA(0, 0, At, B0); PG8_BAR; PG8_SCHED;
            PG8_LDB(B1, 0, 1); PG8_STAGE(PG8_SB(0, 0), b2, voffB);
            PG8_BAR; PG8_WAIT_L(0); PG8_MMA(0, 1, At, B1); PG8_BAR;
            PG8_LDA(At, 0, 1); PG8_STAGE(PG8_SA(0, 0), a2, voffA);
            PG8_BAR; PG8_WAIT_L(0); PG8_MMA(1, 0, At, B0); PG8_BAR; PG8_SCHED;
            PG8_STAGE(PG8_SB(0, 1), b2 + hstepB, voffB);
            PG8_WAIT_V(6); PG8_BAR; PG8_MMA(1, 1, At, B1); PG8_BAR;
            PG8_LDB(B0, 1, 0); PG8_SCHED; PG8_LDA(At, 1, 0); PG8_STAGE(PG8_SA(0, 1), a2 + hstepA, voffA);
            PG8_WAIT_L(8); PG8_BAR; PG8_WAIT_L(0); PG8_MMA(0, 0, At, B0); PG8_BAR; PG8_SCHED;
            PG8_LDB(B1, 1, 1); PG8_STAGE(PG8_SB(1, 0), b3, voffB);
            PG8_BAR; PG8_WAIT_L(0); PG8_MMA(0, 1, At, B1); PG8_BAR;
            PG8_LDA(At, 1, 1); PG8_STAGE(PG8_SA(1, 0), a3, voffA);
            PG8_BAR; PG8_WAIT_L(0); PG8_MMA(1, 0, At, B0); PG8_BAR; PG8_SCHED;
            PG8_STAGE(PG8_SB(1, 1), b3 + hstepB, voffB);
            PG8_WAIT_V(6); PG8_BAR; PG8_MMA(1, 1, At, B1); PG8_BAR;
            }
        }
        if constexpr (ALIGN_EPI) { if (wr == 0) PG8_BAR; }
        if constexpr (!Epi::AFTER_DRAIN) { E(acc, cur, wr, wc, fr, fq); S.done(cur); }
        if (!has_next) break;
#pragma unroll
        for (int a = 0; a < 2; ++a)
#pragma unroll
            for (int b = 0; b < 2; ++b)
#pragma unroll
                for (int m = 0; m < 4; ++m)
#pragma unroll
                    for (int n = 0; n < 2; ++n) acc[a][b][m][n] = (f32x4){0.f, 0.f, 0.f, 0.f};
        cur = nxt; cA = nA; cB = nB; ++ui;
        if constexpr (ALIGN_EPI) { if (wr == 1) PG8_BAR; }
    }
    PG8_WAIT_V(0);
    if constexpr (!ALIGN_EPI) { if (wr == 0) PG8_BAR; }
    PG8_BAR;
    if constexpr (Epi::AFTER_DRAIN) { E.fused(acc, cur, wr, wc, fr, fq, lds, wid, lane); S.done(cur); }
#undef PG8_SA
#undef PG8_SB
#undef PG8_STAGE
#undef PG8_LDA
#undef PG8_LDB
#undef PG8_MMA
#undef PG8_WAIT_V
#undef PG8_WAIT_L
#undef PG8_BAR
#undef PG8_SCHED
}
}

#define LAS __attribute__((address_space(3)))
typedef unsigned short bf16;
typedef unsigned v4u __attribute__((ext_vector_type(4)));
typedef unsigned v2u __attribute__((ext_vector_type(2)));
typedef float f32x4 __attribute__((ext_vector_type(4)));
typedef float f32x16 __attribute__((ext_vector_type(16)));
typedef short bf16x8 __attribute__((ext_vector_type(8)));
typedef short s16x4 __attribute__((ext_vector_type(4)));
typedef float f32x2_t __attribute__((ext_vector_type(2)));
typedef __bf16 bf16x2_t __attribute__((ext_vector_type(2)));

constexpr int NB = 8, SEQ = 2048, DM = 1024, TT = NB * SEQ;
constexpr int DIN = 7912, NP = 7936;
constexpr int PP = 3840, NZG = 4096;
constexpr int MEML = 256;
constexpr float EPS = 1e-6f, NEGF = -1e30f;
constexpr int C_QA = 0, C_KA = 512, C_VA = 1024, C_QI = 1536, C_KI = 2048, C_WI = 2112, C_CQ = 2120, C_CKV = 2504, C_KR = 2760, C_QM = 2792, C_ZM = 3304;
constexpr int C_YA = C_QI, C_YB = C_CQ, C_YM = C_VA;
constexpr float SCALE_A = 0.18033688011112042f;
constexpr float SCALE_B = 0.14724444602590306f;
constexpr float SCALE_M = 0.12751743082459868f;
constexpr float SCALE_I = 0.04419417382415922f;

__constant__ float INVA[8] = {1.0f, 0.1939227432012558f, 0.03760603070259094f, 0.007292664609849453f, 0.0014142135623842478f, 0.00027424818836152554f, 5.3182957344688475e-05f, 1.0313385246263351e-05f};
__constant__ float INVB[16] = {1.0f, 0.44036659598350525f, 0.1939227432012558f, 0.08539710193872452f, 0.03760603070259094f, 0.016560440883040428f, 0.007292664609849453f, 0.0032114461064338684f, 0.0014142135623842478f, 0.0006227724370546639f, 0.00027424818836152554f, 0.00012076973507646471f, 5.3182957344688475e-05f, 2.34199997066753e-05f, 1.0313385246263351e-05f, 4.541670477919979e-06f};

constexpr size_t MiB = 1u << 20;
constexpr size_t WS_CTL = 0;
constexpr size_t WS_WIN = 1 * MiB;
constexpr size_t WS_WUQ = 17 * MiB;
constexpr size_t WS_WUKV = 18 * MiB;
constexpr size_t WS_WMEM = 19 * MiB;
constexpr size_t WS_WBR = 21 * MiB;
constexpr size_t WS_WOUT = 24 * MiB;
constexpr size_t WS_ROPEA = 26 * MiB;
constexpr size_t WS_ROPEB = 27 * MiB;
constexpr size_t WS_MN = 29 * MiB;
constexpr size_t WS_KVM = 33 * MiB;
constexpr size_t WS_VTM = 37 * MiB;
constexpr size_t WS_WI = 39 * MiB;
constexpr size_t WS_MASK = 40 * MiB;
constexpr size_t WS_H = 44 * MiB;
constexpr size_t WS_P = 76 * MiB;
constexpr size_t WS_QB = 196 * MiB;
constexpr size_t WS_KVB = 220 * MiB;
constexpr size_t WS_G1 = 196 * MiB;
constexpr size_t WS_END = 256 * MiB;
constexpr size_t DO_VTA = 0;
constexpr size_t DO_VTB = 16 * MiB;
constexpr size_t DO_KB = 32 * MiB;
constexpr size_t DO_G0 = 0;

constexpr int REP_P0 = 1, REP_PH = 1, REP_G1 = 1, REP_G2 = 1, REP_IDX = 1, REP_ATT = 1, REP_G4 = 1, REP_G5 = 1;
constexpr int REP_IDX1 = 1, REP_SEL = 1;
constexpr int ATT_STRIP = 0;
constexpr int EXTRA_SYNCS = 0, REP_TR = 1, DUMMY_POST1 = 0, DUMMY_POST2 = 0;
constexpr int LDS_BYTES = 147456;
constexpr int LDS_SLOT = LDS_BYTES - 64;

__device__ __forceinline__ unsigned pk2(float lo, float hi) { f32x2_t v = {lo, hi}; bf16x2_t b = __builtin_convertvector(v, bf16x2_t); return __builtin_bit_cast(unsigned, b); }
__device__ __forceinline__ float bflo(unsigned w) { return __uint_as_float(w << 16); }
__device__ __forceinline__ float bfhi(unsigned w) { return __uint_as_float(w & 0xffff0000u); }
__device__ __forceinline__ float bf1(bf16 b) { return __uint_as_float(((unsigned)b) << 16); }
#define UNPACK8(W_, V_) do { V_[0] = bflo((W_)[0]); V_[1] = bfhi((W_)[0]); V_[2] = bflo((W_)[1]); V_[3] = bfhi((W_)[1]); V_[4] = bflo((W_)[2]); V_[5] = bfhi((W_)[2]); V_[6] = bflo((W_)[3]); V_[7] = bfhi((W_)[3]); } while (0)
#define PACK8(V_) (v4u){pk2(V_[0], V_[1]), pk2(V_[2], V_[3]), pk2(V_[4], V_[5]), pk2(V_[6], V_[7])}
__device__ __forceinline__ float wave_sum(float v) {
#pragma unroll
    for (int o = 1; o < 64; o <<= 1) v += __shfl_xor(v, o);
    return v;
}
#define LDS_WAIT() asm volatile("s_waitcnt lgkmcnt(0)" ::: "memory")

__device__ __forceinline__ int win_src(int d) {
    if (d < 2120) return d;
    if (d < 2792) return d + 512;
    if (d < 3816) return d + 1024;
    if (d < 3840) return -1;
    if (d < 4352) return d - 3840 + 2120;
    if (d < 4864) return d - 4352 + 3304;
    return d - 4864 + 4840;
}
template <bool REMAP>
__device__ __forceinline__ void transpose_item(const float* W, int K, int N, int Npad, bf16* WT, LAS float* scr, int item, int lane) {
    const int nblk = Npad / 32, kb = item / nblk, nb = item % nblk, k0 = 64 * kb, n0 = 32 * nb;
    const int n4 = 4 * (lane & 7);
    const int nn = REMAP ? win_src(n0 + n4) : n0 + n4; const bool ok = nn >= 0 && nn < N;
#pragma unroll
    for (int i = 0; i < 8; ++i) { const int kk = 8 * i + (lane >> 3);
        f32x4 v = (f32x4){0.f, 0.f, 0.f, 0.f}; if (ok) v = *(const f32x4*)(W + (size_t)(k0 + kk) * N + nn);
        LAS float* d = scr + kk * 33 + n4; d[0] = v[0]; d[1] = v[1]; d[2] = v[2]; d[3] = v[3]; }
    LDS_WAIT(); asm volatile("" ::: "memory");
    const int c = lane & 7;
#pragma unroll
    for (int j = 0; j < 4; ++j) { const int n = (lane >> 3) + 8 * j; const LAS float* s = scr + (8 * c) * 33 + n;
        v4u o; o.x = pk2(s[0 * 33], s[1 * 33]); o.y = pk2(s[2 * 33], s[3 * 33]); o.z = pk2(s[4 * 33], s[5 * 33]); o.w = pk2(s[6 * 33], s[7 * 33]);
        *(v4u*)(WT + (size_t)(n0 + n) * K + k0 + 8 * c) = o; }
    LDS_WAIT(); asm volatile("" ::: "memory");
}
__device__ __forceinline__ void rms_row_1024(const float* xrow, const float* g, bf16* orow, int lane) {
    const f32x4* xr = (const f32x4*)xrow + lane; const f32x4* gr = (const f32x4*)g + lane;
    f32x4 v[4]; float s = 0.f;
#pragma unroll
    for (int j = 0; j < 4; ++j) { v[j] = xr[64 * j]; s += (v[j].x * v[j].x + v[j].y * v[j].y) + (v[j].z * v[j].z + v[j].w * v[j].w); }
    const float rstd = 1.0f / sqrtf(wave_sum(s) * (1.f / 1024.f) + EPS);
    v2u* o8 = (v2u*)orow + lane;
#pragma unroll
    for (int j = 0; j < 4; ++j) { const f32x4 gg = gr[64 * j]; v2u w; w.x = pk2(v[j].x * rstd * gg.x, v[j].y * rstd * gg.y); w.y = pk2(v[j].z * rstd * gg.z, v[j].w * rstd * gg.w); o8[64 * j] = w; }
}

#define ROPE8(v, sub, c8, s8) do { _Pragma("unroll") for (int j_ = 0; j_ < 8; ++j_) { const float pv_ = __shfl_xor(v[j_], 1); \
        const float r0_ = v[j_] * c8[j_] - pv_ * s8[j_], r1_ = v[j_] * c8[j_] + pv_ * s8[j_]; v[j_] = (sub) == 0 ? r0_ : ((sub) == 1 ? r1_ : v[j_]); } } while (0)

__device__ __forceinline__ void post1_row(const bf16* Prow, bf16* Orow, const float* ra, const float* gqa, const float* gka, const float* gcq, const float* gckv, const float* gqm, float* WIrow, int lane) {
    const int sub = lane & 7;
    const v4u z4 = (v4u){0u, 0u, 0u, 0u};
    const v4u w_qa = *(const v4u*)(Prow + C_QA + 8 * lane);
    const v4u w_ka = *(const v4u*)(Prow + C_KA + 8 * lane);
    const v4u w_qi = *(const v4u*)(Prow + C_QI + 8 * lane);
    const v4u w_qm = *(const v4u*)(Prow + C_QM + 8 * lane);
    v4u w_ki = z4, w_cq = z4, w_ckv = z4; float w_wi = 0.f;
    if (lane < 8) { w_ki = *(const v4u*)(Prow + C_KI + 8 * lane); w_wi = bf1(Prow[C_WI + lane]); }
    if (lane < 48) w_cq = *(const v4u*)(Prow + C_CQ + 8 * lane);
    if (lane < 32) w_ckv = *(const v4u*)(Prow + C_CKV + 8 * lane);
    float c8[8], s8[8];
#pragma unroll
    for (int j = 0; j < 8; ++j) { c8[j] = ra[j]; s8[j] = ra[8 + j]; }
    float ga[8], gk[8], gm[8], gq[8], gc[8];
#pragma unroll
    for (int j = 0; j < 8; ++j) { ga[j] = gqa[8 * sub + j]; gk[j] = gka[8 * sub + j]; gm[j] = gqm[8 * (lane & 15) + j]; gq[j] = lane < 48 ? gcq[8 * lane + j] : 0.f; gc[j] = lane < 32 ? gckv[8 * lane + j] : 0.f; }
    { float v[8]; UNPACK8(w_qa, v); float ss = 0.f;
#pragma unroll
      for (int j = 0; j < 8; ++j) ss += v[j] * v[j];
      ss += __shfl_xor(ss, 1); ss += __shfl_xor(ss, 2); ss += __shfl_xor(ss, 4);
      const float rstd = 1.0f / sqrtf(ss * (1.f / 64.f) + EPS);
#pragma unroll
      for (int j = 0; j < 8; ++j) v[j] = v[j] * rstd * ga[j];
      ROPE8(v, sub, c8, s8);
#pragma unroll
      for (int j = 0; j < 8; ++j) v[j] *= SCALE_A;
      *(v4u*)(Orow + C_QA + 8 * lane) = PACK8(v); }
    { float v[8]; UNPACK8(w_ka, v); float ss = 0.f;
#pragma unroll
      for (int j = 0; j < 8; ++j) ss += v[j] * v[j];
      ss += __shfl_xor(ss, 1); ss += __shfl_xor(ss, 2); ss += __shfl_xor(ss, 4);
      const float rstd = 1.0f / sqrtf(ss * (1.f / 64.f) + EPS);
#pragma unroll
      for (int j = 0; j < 8; ++j) v[j] = v[j] * rstd * gk[j];
      ROPE8(v, sub, c8, s8);
      *(v4u*)(Orow + C_KA + 8 * lane) = PACK8(v); }
    { float v[8]; UNPACK8(w_qi, v);
      ROPE8(v, sub, c8, s8);
      *(v4u*)(Orow + C_QI + 8 * lane) = PACK8(v); }
    { float v[8]; UNPACK8(w_ki, v);
      ROPE8(v, sub, c8, s8);
      if (lane < 8) *(v4u*)(Orow + C_KI + 8 * lane) = PACK8(v); }
    if (lane < 8) WIrow[lane] = w_wi * SCALE_I;
    { float v[8]; UNPACK8(w_cq, v); float ss = 0.f;
#pragma unroll
      for (int j = 0; j < 8; ++j) ss += v[j] * v[j];
      ss = wave_sum(ss); const float rstd = 1.0f / sqrtf(ss * (1.f / 384.f) + EPS);
      if (lane < 48) {
#pragma unroll
          for (int j = 0; j < 8; ++j) v[j] = v[j] * rstd * gq[j];
          *(v4u*)(Orow + C_CQ + 8 * lane) = PACK8(v); } }
    { float v[8]; UNPACK8(w_ckv, v); float ss = 0.f;
#pragma unroll
      for (int j = 0; j < 8; ++j) ss += v[j] * v[j];
      ss = wave_sum(ss); const float rstd = 1.0f / sqrtf(ss * (1.f / 256.f) + EPS);
      if (lane < 32) {
#pragma unroll
          for (int j = 0; j < 8; ++j) v[j] = v[j] * rstd * gc[j];
          *(v4u*)(Orow + C_CKV + 8 * lane) = PACK8(v); } }
    { float v[8]; UNPACK8(w_qm, v); float ss = 0.f;
#pragma unroll
      for (int j = 0; j < 8; ++j) ss += v[j] * v[j];
      ss += __shfl_xor(ss, 1); ss += __shfl_xor(ss, 2); ss += __shfl_xor(ss, 4); ss += __shfl_xor(ss, 8);
      const float rstd = 1.0f / sqrtf(ss * (1.f / 128.f) + EPS);
#pragma unroll
      for (int j = 0; j < 8; ++j) v[j] = v[j] * rstd * gm[j] * SCALE_M;
      *(v4u*)(Orow + C_QM + 8 * lane) = PACK8(v); }
}

__device__ __forceinline__ void km_row(bf16* row, const float* gkm, int lane) {
    v4u w = *(const v4u*)(row + 8 * lane); float v[8]; UNPACK8(w, v); float ss = 0.f;
#pragma unroll
    for (int j = 0; j < 8; ++j) ss += v[j] * v[j];
    ss += __shfl_xor(ss, 1); ss += __shfl_xor(ss, 2); ss += __shfl_xor(ss, 4); ss += __shfl_xor(ss, 8);
    const float rstd = 1.0f / sqrtf(ss * (1.f / 128.f) + EPS);
#pragma unroll
    for (int j = 0; j < 8; ++j) v[j] = v[j] * rstd * gkm[8 * (lane & 15) + j];
    *(v4u*)(row + 8 * lane) = PACK8(v);
}

__device__ __forceinline__ void transpose_v(const bf16* src, int pitch, int col0, int hstride, int H, int DV, int S, int nb, bf16* dst, int gw, int NGW, int lane) {
    const int ndq = DV / 64, nsc = S / 64, ntask = nb * H * nsc * ndq;
    for (int task = gw; task < ntask; task += NGW) {
        int x = task; const int dq = x % ndq; x /= ndq; const int sc = x % nsc; x /= nsc; const int h = x % H; const int b = x / H;
        const int s = sc * 64 + lane;
        const bf16* srow = src + (size_t)(b * S + s) * pitch + col0 + h * hstride + dq * 64;
        bf16* drow = dst + ((size_t)((b * H + h) * DV + dq * 64)) * S + s;
        v4u wv[8];
#pragma unroll
        for (int c = 0; c < 8; ++c) wv[c] = *(const v4u*)(srow + 8 * c);
#pragma unroll
        for (int c = 0; c < 8; ++c) { const v4u w = wv[c];
            drow[(size_t)(8 * c + 0) * S] = (bf16)(w.x & 0xffffu); drow[(size_t)(8 * c + 1) * S] = (bf16)(w.x >> 16);
            drow[(size_t)(8 * c + 2) * S] = (bf16)(w.y & 0xffffu); drow[(size_t)(8 * c + 3) * S] = (bf16)(w.y >> 16);
            drow[(size_t)(8 * c + 4) * S] = (bf16)(w.z & 0xffffu); drow[(size_t)(8 * c + 5) * S] = (bf16)(w.z >> 16);
            drow[(size_t)(8 * c + 6) * S] = (bf16)(w.w & 0xffffu); drow[(size_t)(8 * c + 7) * S] = (bf16)(w.w >> 16); }
    }
}

__device__ __forceinline__ void post2_row(const bf16* QBrow, bf16* QOrow, const bf16* KVBrow, const bf16* Prow, bf16* KBrow, const float* rb, const float* gq, const float* gk, LAS float* scr, int lane) {
    const int hd = lane >> 3, d0 = 12 * (lane & 7);
    float vq[12], vk[12], gqv[12], gkv[12], cc[12], sn[12];
    { const v2u* p = (const v2u*)(QBrow + 12 * lane);
      const v2u w0 = p[0], w1 = p[1], w2 = p[2];
      bf16 kr[12];
#pragma unroll
      for (int e = 0; e < 12; ++e) { const int d = d0 + e; kr[e] = d < 64 ? KVBrow[hd * 128 + d] : Prow[C_KR + d - 64]; }
#pragma unroll
      for (int e = 0; e < 12; ++e) { const int d = d0 + e; gqv[e] = gq[d]; gkv[e] = gk[d]; const int i = (d - 64) & 15; cc[e] = d < 64 ? 1.f : rb[i]; sn[e] = d < 64 ? 0.f : rb[16 + i]; }
      vq[0] = bflo(w0.x); vq[1] = bfhi(w0.x); vq[2] = bflo(w0.y); vq[3] = bfhi(w0.y); vq[4] = bflo(w1.x); vq[5] = bfhi(w1.x); vq[6] = bflo(w1.y); vq[7] = bfhi(w1.y);
      vq[8] = bflo(w2.x); vq[9] = bfhi(w2.x); vq[10] = bflo(w2.y); vq[11] = bfhi(w2.y);
#pragma unroll
      for (int e = 0; e < 12; ++e) vk[e] = bf1(kr[e]); }
    float sq = 0.f, sk = 0.f;
#pragma unroll
    for (int e = 0; e < 12; ++e) { sq += vq[e] * vq[e]; sk += vk[e] * vk[e]; }
    sq += __shfl_xor(sq, 1); sq += __shfl_xor(sq, 2); sq += __shfl_xor(sq, 4);
    sk += __shfl_xor(sk, 1); sk += __shfl_xor(sk, 2); sk += __shfl_xor(sk, 4);
    const float rq = 1.0f / sqrtf(sq * (1.f / 96.f) + EPS), rk = 1.0f / sqrtf(sk * (1.f / 96.f) + EPS);
#pragma unroll
    for (int e = 0; e < 12; ++e) { vq[e] = vq[e] * rq * gqv[e]; vk[e] = vk[e] * rk * gkv[e]; scr[12 * lane + e] = vq[e]; scr[768 + 12 * lane + e] = vk[e]; }
    LDS_WAIT(); asm volatile("" ::: "memory");
    float oq[12], ok[12];
#pragma unroll
    for (int e = 0; e < 12; ++e) { const int d = d0 + e;
        if (d < 64) { oq[e] = vq[e]; ok[e] = vk[e]; }
        else { const bool first = d < 80; const int off = first ? 16 : -16; const float pq = scr[12 * lane + e + off], pk = scr[768 + 12 * lane + e + off];
               oq[e] = first ? vq[e] * cc[e] - pq * sn[e] : vq[e] * cc[e] + pq * sn[e];
               ok[e] = first ? vk[e] * cc[e] - pk * sn[e] : vk[e] * cc[e] + pk * sn[e]; }
        oq[e] *= SCALE_B; }
    LDS_WAIT(); asm volatile("" ::: "memory");
    v2u* q = (v2u*)(QOrow + 12 * lane); v2u* k = (v2u*)(KBrow + 12 * lane);
#pragma unroll
    for (int i = 0; i < 3; ++i) { v2u w; w.x = pk2(oq[4 * i], oq[4 * i + 1]); w.y = pk2(oq[4 * i + 2], oq[4 * i + 3]); q[i] = w;
                                  v2u u; u.x = pk2(ok[4 * i], ok[4 * i + 1]); u.y = pk2(ok[4 * i + 2], ok[4 * i + 3]); k[i] = u; }
}

__device__ __forceinline__ int next_unit(unsigned* ctr, volatile LAS int* slot) {
    __syncthreads();
    if (threadIdx.x == 0) *slot = (int)atomicAdd(ctr, 1u);
    __syncthreads();
    return *slot;
}

constexpr int SCP = 2112;
__device__ __forceinline__ unsigned ord_key(float v) { const unsigned b = __float_as_uint(v); return b ^ ((unsigned)((int)b >> 31) | 0x80000000u); }
__device__ __forceinline__ void indexer_unit(LAS float* sc, const bf16* P, const float* WI, unsigned* MASK, int bb, int tb) {
    int tid_ = threadIdx.x; asm volatile("" : "+v"(tid_));
    const int tid = tid_, lane = tid & 63, w = __builtin_amdgcn_readfirstlane(tid >> 6);
    const int n = lane & 15, g = lane >> 4;
    const int rowbase = bb * SEQ, t0 = tb * 16;
    for (int rp1 = 0; rp1 < REP_IDX1; ++rp1) {
        bf16x8 qf[8][2]; float wq[8];
        const bf16* qrow = P + (size_t)(rowbase + t0 + n) * PP + C_QI + 8 * g;
#pragma unroll
        for (int h = 0; h < 8; ++h) {
            qf[h][0] = *(const bf16x8*)(qrow + h * 64);
            qf[h][1] = *(const bf16x8*)(qrow + h * 64 + 32);
            wq[h] = WI[(size_t)(rowbase + t0 + n) * 8 + h];
        }
        const int ntile = tb + 1;
        const int nmine = (ntile - w + 7) >> 3;
        const int ngrp = (nmine + 3) >> 2;
        const bf16* kbase = P + (size_t)(rowbase + n) * PP + C_KI + 8 * g;
        bf16x8 kb[2][4][2];
#define IDX_LOAD(BUF, GRP) do { _Pragma("unroll") for (int j_ = 0; j_ < 4; ++j_) { const int tile_ = w + 8 * (4 * (GRP) + j_); const int tl_ = tile_ < ntile ? tile_ : 0; \
            const bf16* kr_ = kbase + (size_t)(16 * tl_) * PP; kb[BUF][j_][0] = *(const bf16x8*)(kr_); kb[BUF][j_][1] = *(const bf16x8*)(kr_ + 32); } } while (0)
#define IDX_COMP(BUF, GRP) do { _Pragma("unroll") for (int j_ = 0; j_ < 4; ++j_) { const int tile_ = w + 8 * (4 * (GRP) + j_); if (tile_ < ntile) { \
            f32x4 idx_ = (f32x4){0.f, 0.f, 0.f, 0.f}; \
            _Pragma("unroll") for (int h_ = 0; h_ < 8; ++h_) { f32x4 a_ = (f32x4){0.f, 0.f, 0.f, 0.f}; \
                a_ = __builtin_amdgcn_mfma_f32_16x16x32_bf16(kb[BUF][j_][0], qf[h_][0], a_, 0, 0, 0); \
                a_ = __builtin_amdgcn_mfma_f32_16x16x32_bf16(kb[BUF][j_][1], qf[h_][1], a_, 0, 0, 0); \
                _Pragma("unroll") for (int i_ = 0; i_ < 4; ++i_) idx_[i_] = __builtin_fmaf(wq[h_], __builtin_fmaxf(a_[i_], 0.f), idx_[i_]); } \
            { const int k0_ = 16 * tile_ + 4 * g; LAS float* d_ = sc + n * SCP + k0_ + (k0_ >> 5); d_[0] = idx_[0]; d_[1] = idx_[1]; d_[2] = idx_[2]; d_[3] = idx_[3]; } } } } while (0)
        if (ngrp > 0) IDX_LOAD(0, 0);
        for (int gp = 0; gp < ngrp; gp += 2) {
            if (gp + 1 < ngrp) IDX_LOAD(1, gp + 1);
            IDX_COMP(0, gp);
            if (gp + 1 < ngrp) { if (gp + 2 < ngrp) IDX_LOAD(0, gp + 2); IDX_COMP(1, gp + 1); }
        }
#undef IDX_LOAD
#undef IDX_COMP
    }
    __syncthreads();
#pragma unroll 1
    for (int qq2 = 0; qq2 < 2 * REP_SEL; ++qq2) { const int qq = qq2 & 1;
        const int q = 2 * w + qq, t = t0 + q;
        unsigned* mrow = MASK + (size_t)(rowbase + t) * 64;
        const int nv = t - 32 * lane + 1;
        const unsigned valid = nv >= 32 ? 0xffffffffu : (nv <= 0 ? 0u : ((1u << nv) - 1u));
        if (t < 256) { mrow[lane] = valid; continue; }
        unsigned u[32];
        const LAS float* srow = sc + q * SCP + 33 * lane;
#pragma unroll
        for (int r = 0; r < 32; ++r) { const float v = srow[r]; u[r] = ((valid >> r) & 1u) ? ord_key(v) : 0u; }
#pragma unroll
        for (int si = 0; si < 5; ++si) { const int sft = 16 >> si;
            const unsigned msk = si == 0 ? 0x0000ffffu : (si == 1 ? 0x00ff00ffu : (si == 2 ? 0x0f0f0f0fu : (si == 3 ? 0x33333333u : 0x55555555u)));
#pragma unroll
            for (int k = 0; k < 32; ++k) if (!(k & sft)) { const unsigned tt = ((u[k] >> sft) ^ u[k + sft]) & msk; u[k + sft] ^= tt; u[k] ^= tt << sft; } }
        unsigned alive = valid, sel = 0u; int need = 256;
#pragma unroll
        for (int j = 31; j >= 0; --j) {
            const unsigned ones = alive & u[j];
            const unsigned cl = (unsigned)__popc(ones);
            int c = 0;
#pragma unroll
            for (int bt = 0; bt < 6; ++bt) c += __popcll(__ballot((cl >> bt) & 1u)) << bt;
            if (c >= need) { alive = ones; if (c == need) { sel |= ones; need = 0; break; } }
            else { need -= c; sel |= ones; alive &= ~u[j]; }
        }
        if (need > 0) {
            const int cnt = __popc(alive); int inc = cnt;
#pragma unroll
            for (int d = 1; d < 64; d <<= 1) { const int o = __shfl_up(inc, d); if (lane >= d) inc += o; }
            int k = need - (inc - cnt); k = k < 0 ? 0 : (k > cnt ? cnt : k);
            unsigned m = alive;
            for (int i = 0; i < k; ++i) { const unsigned low = m & (0u - m); sel |= low; m ^= low; }
        }
        mrow[lane] = sel;
    }
    __syncthreads();
}

__device__ __forceinline__ int crow(int r, int hi) { return (r & 3) + 8 * (r >> 2) + 4 * hi; }
template <int DQK, int DV, int MODE, int STRIP = 0>
__device__ __forceinline__ void attn_unit(LAS unsigned char* lds, const bf16* Qb, int qpitch, const bf16* Kb, int kpitch, const bf16* VTb, int skv,
                                          const unsigned* maskb, const bf16* Zb, bf16* Ob, int q0) {
    constexpr int TK = 128, KP = DQK + 8, VP = TK + 8;
    LAS bf16* Ks = (LAS bf16*)lds; LAS bf16* Vs = Ks + TK * KP;
    constexpr int CPR = DQK / 8;
    constexpr int NCK = TK * CPR, NCV = DV * (TK / 8);
    constexpr int RK = (NCK + 511) / 512, RV = (NCV + 511) / 512;
    constexpr int NKS = DQK / 16, NMT = DV / 32;
    int tid_ = threadIdx.x; asm volatile("" : "+v"(tid_));
    const int tid = tid_, lane = tid & 63, w = __builtin_amdgcn_readfirstlane(tid >> 6), r = lane & 31, hh = lane >> 5;
    const int NT = MODE == 0 ? skv / TK : (q0 + 256) / TK;
    const int qlo = q0 + 32 * w;
    bf16x8 qf[NKS];
    { const bf16* qrow = Qb + (size_t)(qlo + r) * qpitch + 8 * hh;
#pragma unroll
      for (int ks = 0; ks < NKS; ++ks) qf[ks] = *(const bf16x8*)(qrow + 16 * ks); }
    f32x16 o[NMT];
#pragma unroll
    for (int mt = 0; mt < NMT; ++mt)
#pragma unroll
        for (int i = 0; i < 16; ++i) o[mt][i] = 0.f;
    float m_run = NEGF, l_run = 0.f;
    v4u kreg[RK], vreg[RV];
#define ATT_PREFETCH(tile_) do { \
        _Pragma("unroll") for (int i_ = 0; i_ < RK; ++i_) { const int c_ = tid + 512 * i_; if (c_ < NCK) { const int row_ = c_ / CPR, cc_ = c_ % CPR; kreg[i_] = *(const v4u*)(Kb + (size_t)(TK * (tile_) + row_) * kpitch + 8 * cc_); } } \
        _Pragma("unroll") for (int i_ = 0; i_ < RV; ++i_) { const int c_ = tid + 512 * i_; if (c_ < NCV) { const int d_ = c_ >> 4, cc_ = c_ & 15; vreg[i_] = *(const v4u*)(VTb + (size_t)d_ * skv + TK * (tile_) + 8 * cc_); } } } while (0)
    if (STRIP != 2) ATT_PREFETCH(0);
    for (int tile = 0; tile < NT; ++tile) {
        __syncthreads();
        if (STRIP != 2) {
#pragma unroll
        for (int i = 0; i < RK; ++i) { const int c = tid + 512 * i; if (c < NCK) { const int row = c / CPR, cc = c % CPR; *(LAS v4u*)(Ks + row * KP + 8 * cc) = kreg[i]; } }
#pragma unroll
        for (int i = 0; i < RV; ++i) { const int c = tid + 512 * i; if (c < NCV) { const int d = c >> 4, cc = c & 15; *(LAS v4u*)(Vs + d * VP + 8 * cc) = vreg[i]; } }
        }
        __syncthreads();
        if (STRIP != 2 && tile + 1 < NT) ATT_PREFETCH(tile + 1);
        __builtin_amdgcn_sched_barrier(0);
        if (STRIP == 1) continue;
#pragma unroll 1
        for (int sub = 0; sub < 2; ++sub) {
        const int t64 = 2 * tile + sub;
        if (MODE != 0 && 64 * t64 > qlo + 31) continue;
        const LAS bf16* Kc = Ks + 64 * sub * KP; const LAS bf16* Vc = Vs + 64 * sub;
        unsigned mw0 = 0u, mw1 = 0u;
        if (MODE == 2) { const v2u mm = *(const v2u*)(maskb + (size_t)(qlo + r) * 64 + 2 * t64); mw0 = mm.x >> (4 * hh); mw1 = mm.y >> (4 * hh); }
        f32x16 s0, s1;
#pragma unroll
        for (int i = 0; i < 16; ++i) { s0[i] = 0.f; s1[i] = 0.f; }
#pragma unroll
        for (int ks = 0; ks < NKS; ++ks) {
            const bf16x8 a0 = *(const LAS bf16x8*)(Kc + r * KP + 16 * ks + 8 * hh);
            const bf16x8 a1 = *(const LAS bf16x8*)(Kc + (32 + r) * KP + 16 * ks + 8 * hh);
            s0 = __builtin_amdgcn_mfma_f32_32x32x16_bf16(a0, qf[ks], s0, 0, 0, 0);
            s1 = __builtin_amdgcn_mfma_f32_32x32x16_bf16(a1, qf[ks], s1, 0, 0, 0);
        }
        if (MODE == 1) {
            if (64 * t64 + 63 > qlo) { const int qg = qlo + r;
#pragma unroll
                for (int i = 0; i < 16; ++i) { const int key = 64 * t64 + crow(i, hh); if (key > qg) s0[i] = NEGF; if (key + 32 > qg) s1[i] = NEGF; } }
        }
        if (MODE == 2) {
#pragma unroll
            for (int i = 0; i < 16; ++i) { const int bit = (i & 3) + 8 * (i >> 2); if (!((mw0 >> bit) & 1u)) s0[i] = NEGF; if (!((mw1 >> bit) & 1u)) s1[i] = NEGF; }
        }
        float mx = s0[0];
#pragma unroll
        for (int i = 1; i < 16; ++i) mx = __builtin_fmaxf(mx, s0[i]);
#pragma unroll
        for (int i = 0; i < 16; ++i) mx = __builtin_fmaxf(mx, s1[i]);
        mx = __builtin_fmaxf(mx, __shfl_xor(mx, 32));
        const float m_new = __builtin_fmaxf(m_run, mx);
        const float alpha = __builtin_amdgcn_exp2f(m_run - m_new);
        m_run = m_new;
        float ls = 0.f;
#pragma unroll
        for (int i = 0; i < 16; ++i) { s0[i] = __builtin_amdgcn_exp2f(s0[i] - m_new); s1[i] = __builtin_amdgcn_exp2f(s1[i] - m_new); ls += s0[i] + s1[i]; }
        l_run = l_run * alpha + ls;
#pragma unroll
        for (int mt = 0; mt < NMT; ++mt)
#pragma unroll
            for (int i = 0; i < 16; ++i) o[mt][i] *= alpha;
        v4u pf[2][2];
#pragma unroll
        for (int s = 0; s < 2; ++s) {
            pf[0][s] = (v4u){pk2(s0[8 * s], s0[8 * s + 1]), pk2(s0[8 * s + 2], s0[8 * s + 3]), pk2(s0[8 * s + 4], s0[8 * s + 5]), pk2(s0[8 * s + 6], s0[8 * s + 7])};
            pf[1][s] = (v4u){pk2(s1[8 * s], s1[8 * s + 1]), pk2(s1[8 * s + 2], s1[8 * s + 3]), pk2(s1[8 * s + 4], s1[8 * s + 5]), pk2(s1[8 * s + 6], s1[8 * s + 7])};
        }
#pragma unroll
        for (int mt = 0; mt < NMT; ++mt)
#pragma unroll
            for (int p = 0; p < 2; ++p)
#pragma unroll
                for (int s = 0; s < 2; ++s) {
                    const LAS bf16* vp = Vc + (32 * mt + r) * VP + 32 * p + 16 * s + 4 * hh;
                    const s16x4 lo = *(const LAS s16x4*)(vp), hi = *(const LAS s16x4*)(vp + 8);
                    const bf16x8 a = (bf16x8){lo[0], lo[1], lo[2], lo[3], hi[0], hi[1], hi[2], hi[3]};
                    o[mt] = __builtin_amdgcn_mfma_f32_32x32x16_bf16(a, __builtin_bit_cast(bf16x8, pf[p][s]), o[mt], 0, 0, 0);
                }
        }
    }
#undef ATT_PREFETCH
    const float l_tot = l_run + __shfl_xor(l_run, 32);
    const float inv = 1.0f / l_tot;
    const size_t row = (size_t)(qlo + r);
#pragma unroll
    for (int mt = 0; mt < NMT; ++mt)
#pragma unroll
        for (int g4 = 0; g4 < 4; ++g4) {
            const int d = 32 * mt + 8 * g4 + 4 * hh;
            float ov[4];
#pragma unroll
            for (int i = 0; i < 4; ++i) ov[i] = o[mt][4 * g4 + i] * inv;
            if (Zb) { const v2u zw = *(const v2u*)(Zb + row * PP + d); const float z[4] = {bflo(zw.x), bfhi(zw.x), bflo(zw.y), bfhi(zw.y)};
#pragma unroll
                for (int i = 0; i < 4; ++i) ov[i] *= z[i] / (1.0f + __expf(-z[i])); }
            v2u ow; ow.x = pk2(ov[0], ov[1]); ow.y = pk2(ov[2], ov[3]);
            *(v2u*)(Ob + row * PP + d) = ow;
        }
}

__device__ __forceinline__ bf16* gate_row(bf16* G0, bf16* G1, size_t row) { return row < 8192 ? G0 + row * 3072 : G1 + (row - 8192) * 3072; }
struct EpiZG {
    static constexpr bool PERM = true, AFTER_DRAIN = false;
    bf16* P; bf16* G0; bf16* G1;
    __device__ __forceinline__ void operator()(const pg8::f32x4 (&acc)[2][2][4][2], const pg8::Unit& u, int wr, int wc, int fr, int fq) const {
        const int row0 = u.pm * 256 + wr * 64 + fr, cl = wc * 32 + 8 * fq;
        const bool isz = u.pn < 4;
        const int ycol = (u.pn < 2 ? C_YA : C_YB) + (u.pn & 1) * 256, gcol = (u.pn - 4) * 256;
#pragma unroll
        for (int ai = 0; ai < 2; ++ai)
#pragma unroll
            for (int m = 0; m < 4; ++m) { const size_t row = (size_t)(row0 + ai * 128 + m * 16);
#pragma unroll
                for (int bj = 0; bj < 2; ++bj) {
                    const pg8::f32x4 v0 = acc[ai][bj][m][0], v1 = acc[ai][bj][m][1];
                    float rr[8] = {v0[0], v0[1], v0[2], v0[3], v1[0], v1[1], v1[2], v1[3]};
                    if (isz) { bf16* dst = P + row * PP + ycol + cl + bj * 128; const v4u old = *(const v4u*)dst; float yv[8]; UNPACK8(old, yv);
#pragma unroll
                        for (int e = 0; e < 8; ++e) rr[e] = yv[e] * (rr[e] / (1.0f + __expf(-rr[e])));
                        *(v4u*)dst = PACK8(rr); }
                    else { bf16* dst = gate_row(G0, G1, row) + gcol + cl + bj * 128;
#pragma unroll
                        for (int e = 0; e < 8; ++e) rr[e] = 1.0f / (1.0f + __expf(-rr[e]));
                        *(v4u*)dst = PACK8(rr); } } }
    }
};
struct EpiMerge {
    static constexpr bool PERM = true, AFTER_DRAIN = false;
    bf16* Mg; bf16* G0; bf16* G1; int nbr;
    __device__ __forceinline__ void operator()(const pg8::f32x4 (&acc)[2][2][4][2], const pg8::Unit& u, int wr, int wc, int fr, int fq) const {
        const int row0 = u.pm * 256 + wr * 64 + fr, col0 = u.pn * 256 + wc * 32 + 8 * fq;
#pragma unroll
        for (int ai = 0; ai < 2; ++ai)
#pragma unroll
            for (int m = 0; m < 4; ++m) { const size_t row = (size_t)(row0 + ai * 128 + m * 16);
#pragma unroll
                for (int bj = 0; bj < 2; ++bj) { const int col = col0 + bj * 128;
                    const v4u gwd = *(const v4u*)(gate_row(G0, G1, row) + nbr * 1024 + col);
                    float gl[8]; UNPACK8(gwd, gl);
                    const pg8::f32x4 v0 = acc[ai][bj][m][0], v1 = acc[ai][bj][m][1];
                    float rr[8] = {v0[0], v0[1], v0[2], v0[3], v1[0], v1[1], v1[2], v1[3]};
#pragma unroll
                    for (int e = 0; e < 8; ++e) rr[e] *= gl[e];
                    bf16* dst = Mg + row * 1024 + col;
                    if (nbr > 0) { const v4u old = *(const v4u*)dst; float ol[8]; UNPACK8(old, ol);
#pragma unroll
                        for (int e = 0; e < 8; ++e) rr[e] += ol[e]; }
                    *(v4u*)dst = PACK8(rr); } }
    }
};
struct EpiOut {
    static constexpr bool PERM = true, AFTER_DRAIN = false;
    const float* X; float* Out;
    __device__ __forceinline__ void operator()(const pg8::f32x4 (&acc)[2][2][4][2], const pg8::Unit& u, int wr, int wc, int fr, int fq) const {
        const int row0 = u.pm * 256 + wr * 64 + fr, col0 = u.pn * 256 + wc * 32 + 8 * fq;
#pragma unroll
        for (int ai = 0; ai < 2; ++ai)
#pragma unroll
            for (int m = 0; m < 4; ++m) { const size_t row = (size_t)(row0 + ai * 128 + m * 16);
#pragma unroll
                for (int bj = 0; bj < 2; ++bj) { const size_t p = row * 1024 + col0 + bj * 128;
                    const f32x4 x0 = *(const f32x4*)(X + p), x1 = *(const f32x4*)(X + p + 4);
                    const pg8::f32x4 a0 = acc[ai][bj][m][0], a1 = acc[ai][bj][m][1];
                    *(f32x4*)(Out + p) = (f32x4){x0[0] + a0[0], x0[1] + a0[1], x0[2] + a0[2], x0[3] + a0[3]};
                    *(f32x4*)(Out + p + 4) = (f32x4){x1[0] + a1[0], x1[1] + a1[1], x1[2] + a1[2], x1[3] + a1[3]}; } }
    }
};

#define XB_TMO      128
#define XB_XCNT(j)  (256  + 64 * (j))
#define XB_XSUB(j)  (1280 + 64 * (j))
#define XB_XGEN(j)  (2304 + 64 * (j))
#define XB_TOP      3328
#define XB_TOPGEN   3392
#define XCD_BAR_WORDS 3456
#define XB_SPIN_CAP (1u << 18)

__device__ __forceinline__ unsigned xb_ld(unsigned* p)              { return __hip_atomic_load(p, __ATOMIC_RELAXED, __HIP_MEMORY_SCOPE_AGENT); }
__device__ __forceinline__ unsigned xb_add(unsigned* p, unsigned v) { return __hip_atomic_fetch_add(p, v, __ATOMIC_RELAXED, __HIP_MEMORY_SCOPE_AGENT); }
__device__ __forceinline__ unsigned xb_xcc_id() { return (unsigned)__builtin_amdgcn_s_getreg((3 << 11) | 20) & 0xFu; }
#define XB_SPIN(cond, bar) do { unsigned _sp = 0; while (cond) { __builtin_amdgcn_s_sleep(1); \
    if ((++_sp & 255u) == 0u) { if (xb_ld(&(bar)[XB_TMO])) break; if (_sp > XB_SPIN_CAP) { atomicAdd(&(bar)[XB_TMO], 1u); break; } } } } while (0)

struct XcdBarrier {
    unsigned* bar; unsigned x;
    volatile LAS unsigned* st;
};

__device__ __forceinline__ XcdBarrier xcd_barrier_post(unsigned* bar, volatile LAS unsigned* st) {
    XcdBarrier b; b.bar = bar; b.x = xb_xcc_id(); b.st = st;
    if (threadIdx.x == 0) (void)xb_add(&bar[XB_XCNT(b.x)], 1u);
    return b;
}
__device__ __forceinline__ void xcd_barrier_complete(unsigned* bar, unsigned x, unsigned& nloc, unsigned& nx) {
    const unsigned G = gridDim.x * gridDim.y * gridDim.z;
    unsigned sum, cnt, mine, sp = 0u;
    for (;;) {
        sum = 0u; cnt = 0u; mine = 0u;
#pragma unroll
        for (unsigned j = 0; j < 16; ++j) { const unsigned c = xb_ld(&bar[XB_XCNT(j)]); sum += c; cnt += (c > 0u) ? 1u : 0u; mine = (j == x) ? c : mine; }
        if (sum == G) break;
        __builtin_amdgcn_s_sleep(1);
        if ((++sp & 255u) == 0u) { if (xb_ld(&bar[XB_TMO])) break; if (sp > XB_SPIN_CAP) { atomicAdd(&bar[XB_TMO], 1u); break; } }
    }
    nloc = mine > 0u ? mine : 1u; nx = cnt > 0u ? cnt : 1u;
}

__device__ __forceinline__ void xcd_barrier(const XcdBarrier& b) {
    asm volatile("s_waitcnt vmcnt(0)" ::: "memory");
    __syncthreads();
    if (threadIdx.x == 0) {
        unsigned* bar = b.bar;
        __builtin_amdgcn_s_waitcnt(0);
        unsigned nloc = b.st[0], nx = b.st[1];
        if (nloc == 0u) { xcd_barrier_complete(bar, b.x, nloc, nx); b.st[0] = nloc; b.st[1] = nx; }
        const unsigned old = xb_add(&bar[XB_XSUB(b.x)], 1u);
        const unsigned gen = old / nloc;
        if (old + 1u == (gen + 1u) * nloc) {
            __builtin_amdgcn_fence(__ATOMIC_RELEASE, "agent");
            asm volatile("s_waitcnt vmcnt(0)" ::: "memory");
            const unsigned og = xb_add(&bar[XB_TOP], 1u);
            const unsigned tg = og / nx;
            if (og + 1u == (tg + 1u) * nx) xb_add(&bar[XB_TOPGEN], 1u);
            else XB_SPIN(xb_ld(&bar[XB_TOPGEN]) == tg, bar);
            __builtin_amdgcn_fence(__ATOMIC_ACQUIRE, "agent");
            xb_add(&bar[XB_XGEN(b.x)], 1u);
            asm volatile("s_waitcnt vmcnt(0)" ::: "memory");
        } else {
            XB_SPIN(xb_ld(&bar[XB_XGEN(b.x)]) == gen, bar);
            __builtin_amdgcn_fence(__ATOMIC_ACQUIRE, "agent");
            asm volatile("s_waitcnt vmcnt(0)" ::: "memory");
        }
    }
    __syncthreads();
}

template <int DQK, int DV, int MODE>
__device__ __forceinline__ void att_call(bool strip, LAS unsigned char* lds, const bf16* Qb, int qpitch, const bf16* Kb, int kpitch, const bf16* VTb, int skv, const unsigned* maskb, const bf16* Zb, bf16* Ob, int q0) {
    if (ATT_STRIP != 0 && strip) attn_unit<DQK, DV, MODE, ATT_STRIP>(lds, Qb, qpitch, Kb, kpitch, VTb, skv, maskb, Zb, Ob, q0);
    else attn_unit<DQK, DV, MODE, 0>(lds, Qb, qpitch, Kb, kpitch, VTb, skv, maskb, Zb, Ob, q0);
}
struct Args { const float* in[19]; const int* pos; float* out; unsigned char* ws; };
typedef const __attribute__((address_space(4))) Args* kargs_t;
#define PHASE_BEGIN \
    kargs_t ap_ = (kargs_t)__builtin_amdgcn_kernarg_segment_ptr(); asm volatile("" : "+s"(ap_)); \
    int tid = threadIdx.x; asm volatile("" : "+v"(tid)); \
    const int lane = tid & 63, wave = __builtin_amdgcn_readfirstlane(tid >> 6), G = gridDim.x, NGW = G * 8, gw = blockIdx.x * 8 + wave; \
    unsigned char* const ws = ap_->ws; unsigned char* const dob = (unsigned char*)ap_->out; const int* const pos = ap_->pos; float* const outp = ap_->out; unsigned* const ctl = (unsigned*)(ws + WS_CTL); \
    const float* const x = ap_->in[0]; const float* const mem = ap_->in[1]; \
    const float* const g_norm = ap_->in[3]; const float* const w_in = ap_->in[4]; const float* const g_qn_a = ap_->in[5]; const float* const g_kn_a = ap_->in[6]; \
    const float* const g_cq = ap_->in[7]; const float* const g_ckv = ap_->in[8]; const float* const w_uq = ap_->in[9]; const float* const w_ukv = ap_->in[10]; \
    const float* const g_qn_b = ap_->in[11]; const float* const g_kn_b = ap_->in[12]; const float* const g_mem = ap_->in[13]; const float* const w_mem_kv = ap_->in[14]; \
    const float* const g_qn_m = ap_->in[15]; const float* const g_kn_m = ap_->in[16]; const float* const w_branch = ap_->in[17]; const float* const w_out = ap_->in[18]; \
    bf16* const WinT = (bf16*)(ws + WS_WIN); bf16* const WuqT = (bf16*)(ws + WS_WUQ); bf16* const WukvT = (bf16*)(ws + WS_WUKV); bf16* const WmemT = (bf16*)(ws + WS_WMEM); \
    bf16* const WbrT = (bf16*)(ws + WS_WBR); bf16* const WoutT = (bf16*)(ws + WS_WOUT); \
    float* const ropeA = (float*)(ws + WS_ROPEA); float* const ropeB = (float*)(ws + WS_ROPEB); \
    bf16* const MN = (bf16*)(ws + WS_MN); bf16* const KVM = (bf16*)(ws + WS_KVM); bf16* const VTM = (bf16*)(ws + WS_VTM); \
    float* const WI = (float*)(ws + WS_WI); unsigned* const MASK = (unsigned*)(ws + WS_MASK); \
    bf16* const VTA = (bf16*)(dob + DO_VTA); bf16* const VTB = (bf16*)(dob + DO_VTB); bf16* const KB = (bf16*)(dob + DO_KB); \
    bf16* const Hh = (bf16*)(ws + WS_H); bf16* const MG = (bf16*)(ws + WS_H); bf16* const QB = (bf16*)(ws + WS_QB); \
    bf16* const KVB = (bf16*)(ws + WS_KVB); bf16* const GT0 = (bf16*)(dob + DO_G0); bf16* const GT1 = (bf16*)(ws + WS_G1); bf16* const P = (bf16*)(ws + WS_P); \
    (void)lane; (void)NGW; (void)gw; (void)ctl; \
    (void)pos; (void)outp; (void)x; (void)mem; (void)g_norm; (void)w_in; (void)g_qn_a; (void)g_kn_a; (void)g_cq; (void)g_ckv; (void)w_uq; (void)w_ukv; (void)g_qn_b; (void)g_kn_b; (void)g_mem; (void)w_mem_kv; \
    (void)g_qn_m; (void)g_kn_m; (void)w_branch; (void)w_out; (void)WinT; (void)WuqT; (void)WukvT; (void)WmemT; (void)WbrT; (void)WoutT; (void)ropeA; (void)ropeB; (void)MN; (void)KVM; (void)VTM; (void)WI; (void)MASK; \
    (void)VTA; (void)VTB; (void)Hh; (void)KB; (void)QB; (void)KVB; (void)MG; (void)GT0; (void)GT1; (void)P
#define GRID_BARRIER() do { kargs_t bp_ = (kargs_t)__builtin_amdgcn_kernarg_segment_ptr(); asm volatile("" : "+s"(bp_)); \
    XcdBarrier b_; b_.bar = (unsigned*)(bp_->ws + WS_CTL) + 4096; b_.x = xb_xcc_id(); b_.st = (volatile LAS unsigned*)(lds + LDS_BYTES - 32); xcd_barrier(b_); } while (0)

__global__ void __launch_bounds__(512, 2) fwd_kernel(Args a) {
    extern __shared__ __attribute__((aligned(16))) unsigned char lds_raw[];
    LAS unsigned char* const lds = (LAS unsigned char*)lds_raw;
    volatile LAS int* const slot = (volatile LAS int*)(lds + LDS_SLOT);
    if (threadIdx.x < 16) ((LAS unsigned*)(lds + LDS_BYTES - 64))[threadIdx.x] = 0u;
    __syncthreads();
    (void)xcd_barrier_post((unsigned*)(a.ws + WS_CTL) + 4096, (volatile LAS unsigned*)(lds + LDS_BYTES - 32));

    for (int rep = 0; rep < REP_P0; ++rep) { PHASE_BEGIN;
        LAS float* scr = (LAS float*)(lds + wave * 16384);
        constexpr int I_IN = 16 * (NP / 32), I_UQ = 6 * 24, I_UKV = 4 * 32, I_MEM = 16 * 32, I_BR = 8 * 32, I_OUT = 16 * 32;
        constexpr int NITEMS = I_IN + I_UQ + I_UKV + I_MEM + 3 * I_BR + I_OUT;
        for (int it = gw; it < NITEMS; it += NGW) {
            int r = it;
            if (r < I_IN) { transpose_item<true>(w_in, 1024, DIN, NP, WinT, scr, r, lane); continue; } r -= I_IN;
            if (r < I_UQ) { transpose_item<false>(w_uq, 384, 768, 768, WuqT, scr, r, lane); continue; } r -= I_UQ;
            if (r < I_UKV) { transpose_item<false>(w_ukv, 256, 1024, 1024, WukvT, scr, r, lane); continue; } r -= I_UKV;
            if (r < I_MEM) { transpose_item<false>(w_mem_kv, 1024, 1024, 1024, WmemT, scr, r, lane); continue; } r -= I_MEM;
            if (r < 3 * I_BR) { const int nb = r / I_BR; transpose_item<false>(w_branch + (size_t)nb * 512 * 1024, 512, 1024, 1024, WbrT + (size_t)nb * 1024 * 512, scr, r % I_BR, lane); continue; } r -= 3 * I_BR;
            transpose_item<false>(w_out, 1024, 1024, 1024, WoutT, scr, r, lane);
        }
        for (int idx = blockIdx.x * 512 + tid; idx < TT * 24; idx += G * 512) {
            const int t = idx / 24, i = idx % 24; const float pf = (float)pos[t];
            if (i < 8) { const float ang = pf * INVA[i]; ropeA[t * 16 + i] = cosf(ang); ropeA[t * 16 + 8 + i] = sinf(ang); }
            else { const int j = i - 8; const float ang = pf * INVB[j]; ropeB[t * 32 + j] = cosf(ang); ropeB[t * 32 + 16 + j] = sinf(ang); }
        }
        for (int m = gw; m < NB * MEML; m += NGW) rms_row_1024(mem + (size_t)m * DM, g_mem, MN + (size_t)m * DM, lane);
        for (int rp = 0; rp < REP_PH; ++rp)
        for (int m = gw; m < TT; m += NGW) rms_row_1024(x + (size_t)m * DM, g_norm, Hh + (size_t)m * DM, lane);
    }
    GRID_BARRIER();
    for (int es = 0; es < EXTRA_SYNCS; ++es) GRID_BARRIER();

    for (int rep = 0; rep < REP_G1; ++rep) { PHASE_BEGIN;
        pg8::Gemm g{Hh, WinT, TT, PP, 1024, 1024}; pg8::StaticOrder S; S.init(TT, PP, G, (int)blockIdx.x);
        pg8::EpiBf16<0> E{P, PP, nullptr, 0, 0, 1.f};
        pg8::gemm_phase<pg8::EpiBf16<0>, pg8::StaticOrder, true, true>(lds, g, S, E);
    }
    { PHASE_BEGIN;
        pg8::Gemm g{MN, WmemT, NB * MEML, 1024, 1024, 1024}; pg8::StaticOrder S; S.init(NB * MEML, 1024, G, (int)((blockIdx.x + 64) % G));
        pg8::EpiBf16<0> E{KVM, 1024, nullptr, 0, 0, 1.f};
        pg8::gemm_phase<pg8::EpiBf16<0>, pg8::StaticOrder, true, true>(lds, g, S, E);
    }
    GRID_BARRIER();
    { PHASE_BEGIN;
        for (int dp = 0; dp < DUMMY_POST1; ++dp)
            for (int m = gw; m < TT; m += NGW)
                post1_row(P + (size_t)m * PP, QB + (size_t)(m & 1023) * 4096, ropeA + (size_t)m * 16, g_qn_a, g_kn_a, g_cq, g_ckv, g_qn_m, (float*)KVB + (size_t)m * 8, lane);
        for (int m = gw; m < TT; m += NGW)
            post1_row(P + (size_t)m * PP, P + (size_t)m * PP, ropeA + (size_t)m * 16, g_qn_a, g_kn_a, g_cq, g_ckv, g_qn_m, WI + (size_t)m * 8, lane);
        for (int rt = 0; rt < REP_TR; ++rt)
        transpose_v(P, PP, C_VA, 64, 8, 64, SEQ, NB, VTA, gw, NGW, lane);
        for (int m = gw; m < NB * MEML; m += NGW) km_row(KVM + (size_t)m * 1024, g_kn_m, lane);
        for (int rt = 0; rt < REP_TR; ++rt)
        transpose_v(KVM, 1024, 512, 128, 4, 128, MEML, NB, VTM, gw, NGW, lane);
    }
    GRID_BARRIER();
    for (int rep = 0; rep < REP_G2; ++rep) { PHASE_BEGIN;
        pg8::Gemm g{P + C_CQ, WuqT, TT, 768, 384, PP}; pg8::StaticOrder S; S.init(TT, 768, G, (int)blockIdx.x);
        pg8::EpiBf16<0> E{QB, 768, nullptr, 0, 0, 1.f};
        pg8::gemm_phase<pg8::EpiBf16<0>, pg8::StaticOrder, true, true>(lds, g, S, E);
    }
    for (int rep = 0; rep < REP_G2; ++rep) { PHASE_BEGIN;
        pg8::Gemm g{P + C_CKV, WukvT, TT, 1024, 256, PP}; pg8::StaticOrder S; S.init(TT, 1024, G, (int)((blockIdx.x + 192) % G));
        pg8::EpiBf16<0> E{KVB, 1024, nullptr, 0, 0, 1.f};
        pg8::gemm_phase<pg8::EpiBf16<0>, pg8::StaticOrder, true, true>(lds, g, S, E);
    }
    for (int rep = 0; rep < REP_IDX; ++rep) { if (rep > 0) GRID_BARRIER();
        PHASE_BEGIN;
        unsigned* const q_idx = ctl + 64 * (0 + 4 * rep);
        for (;;) {
            const int u = next_unit(q_idx, slot);
            if (u >= NB * 128) break;
            const int tb = 127 - (u >> 3), bb = u & 7;
            indexer_unit((LAS float*)lds, P, WI, MASK, bb, tb);
        }
    }
    GRID_BARRIER();
    { PHASE_BEGIN;
        LAS float* scr = (LAS float*)(lds + wave * 8192);
        for (int dp = 0; dp < DUMMY_POST2; ++dp)
            for (int m = gw; m < TT; m += NGW)
                post2_row(QB + (size_t)m * 768, (bf16*)MASK + (size_t)(m & 1023) * 768, KVB + (size_t)m * 1024, P + (size_t)m * PP, (bf16*)MASK + (size_t)(1024 + (m & 1023)) * 768, ropeB + (size_t)m * 32, g_qn_b, g_kn_b, scr, lane);
        for (int m = gw; m < TT; m += NGW)
            post2_row(QB + (size_t)m * 768, QB + (size_t)m * 768, KVB + (size_t)m * 1024, P + (size_t)m * PP, KB + (size_t)m * 768, ropeB + (size_t)m * 32, g_qn_b, g_kn_b, scr, lane);
        for (int rt = 0; rt < REP_TR; ++rt)
        transpose_v(KVB, 1024, 64, 128, 8, 64, SEQ, NB, VTB, gw, NGW, lane);
    }
    GRID_BARRIER();
    for (int rep = 0; rep < REP_ATT; ++rep) { if (rep > 0) GRID_BARRIER();
        PHASE_BEGIN;
        unsigned* const q_att = ctl + 64 * (1 + 4 * rep);
        for (;;) {
            const int u = next_unit(q_att, slot);
            if (u >= 1280) break;
            if (u < 1024) {
                const int qb = 7 - (u >> 7), wi = u & 127, bh = wi & 63, bb = bh >> 3, h = bh & 7;
                const size_t r0 = (size_t)bb * SEQ;
                if (wi < 64) att_call<96, 64, 1>(rep == 0 && REP_ATT > 1, lds, QB + r0 * 768 + h * 96, 768, KB + r0 * 768 + h * 96, 768, VTB + (size_t)((bb * 8 + h) * 64) * SEQ, SEQ, nullptr,
                                                  nullptr, P + r0 * PP + C_YB + h * 64, qb * 256);
                else att_call<64, 64, 2>(rep == 0 && REP_ATT > 1, lds, P + r0 * PP + C_QA + h * 64, PP, P + r0 * PP + C_KA + h * 64, PP, VTA + (size_t)((bb * 8 + h) * 64) * SEQ, SEQ, MASK + r0 * 64,
                                          nullptr, P + r0 * PP + C_YA + h * 64, qb * 256);
            } else {
                const int v = u - 1024, qb = v & 7, bh = v >> 3, bb = bh >> 2, h = bh & 3;
                const size_t r0 = (size_t)bb * SEQ;
                att_call<128, 128, 0>(rep == 0 && REP_ATT > 1, lds, P + r0 * PP + C_QM + h * 128, PP, KVM + (size_t)bb * MEML * 1024 + h * 128, 1024, VTM + (size_t)((bb * 4 + h) * 128) * MEML, MEML, nullptr,
                                       P + r0 * PP + C_ZM + h * 128, P + r0 * PP + C_YM + h * 128, qb * 256);
            }
        }
    }
    GRID_BARRIER();
    for (int rep = 0; rep < 1; ++rep) { PHASE_BEGIN;
        pg8::Gemm g{Hh, WinT + (size_t)PP * 1024, TT, NZG, 1024, 1024}; pg8::StaticOrder S; S.init(TT, NZG, G, (int)blockIdx.x);
        EpiZG E{P, GT0, GT1};
        pg8::gemm_phase<EpiZG, pg8::StaticOrder, true, true>(lds, g, S, E);
    }
    GRID_BARRIER();
    for (int nbr = 0; nbr < 3 * REP_G4; ++nbr) { const int nb = nbr % 3; PHASE_BEGIN;
        pg8::Gemm g{P + (nb == 0 ? C_YA : (nb == 1 ? C_YB : C_YM)), WbrT + (size_t)nb * 1024 * 512, TT, 1024, 512, PP}; pg8::StaticOrder S; S.init(TT, 1024, G, (int)blockIdx.x);
        EpiMerge E{MG, GT0, GT1, nb};
        pg8::gemm_phase<EpiMerge, pg8::StaticOrder, true, true>(lds, g, S, E);
    }
    GRID_BARRIER();
    for (int rep = 0; rep < REP_G5; ++rep) { PHASE_BEGIN;
        pg8::Gemm g{MG, WoutT, TT, 1024, 1024, 1024}; pg8::StaticOrder S; S.init(TT, 1024, G, (int)blockIdx.x);
        EpiOut E{x, outp};
        pg8::gemm_phase<EpiOut, pg8::StaticOrder, true, true>(lds, g, S, E);
    }
}

extern "C" void kernel_launch(void* const* d_in, const int* in_sizes, int n_in, void* d_out, int out_size, void* d_ws, size_t ws_size, hipStream_t stream) {
    static int grid = 0;
    if (grid == 0) {
        if (n_in != 19 || out_size != TT * DM || ws_size < WS_END) { fprintf(stderr, "kernel_launch: unexpected problem (n_in %d, out %d, ws %zu); nothing launched\n", n_in, out_size, ws_size); grid = -1; return; }
        int dev = 0, cus = 0, per_cu = 0;
        if (hipGetDevice(&dev) != hipSuccess || hipDeviceGetAttribute(&cus, hipDeviceAttributeMultiprocessorCount, dev) != hipSuccess) { grid = -1; return; }
        if (hipFuncSetAttribute((const void*)fwd_kernel, hipFuncAttributeMaxDynamicSharedMemorySize, LDS_BYTES) != hipSuccess) { fprintf(stderr, "kernel_launch: hipFuncSetAttribute failed\n"); grid = -1; return; }
        if (hipOccupancyMaxActiveBlocksPerMultiprocessor(&per_cu, (const void*)fwd_kernel, 512, LDS_BYTES) != hipSuccess || per_cu < 1) { fprintf(stderr, "kernel_launch: occupancy query reports %d blocks per CU\n", per_cu); (void)hipGetLastError(); grid = -1; return; }
        grid = cus;
    }
    if (grid < 0) return;
    (void)hipMemsetAsync((char*)d_ws + WS_CTL, 0, 65536, stream);
    Args a{};
    for (int i = 0; i < 19; ++i) a.in[i] = (const float*)d_in[i];
    a.pos = (const int*)d_in[2]; a.out = (float*)d_out; a.ws = (unsigned char*)d_ws;
    hipLaunchKernelGGL(fwd_kernel, dim3(grid), dim3(512), LDS_BYTES, stream, a);
    const hipError_t e = hipPeekAtLastError();
    if (e != hipSuccess) fprintf(stderr, "kernel_launch: launch failed: %s (grid %d)\n", hipGetErrorString(e), grid);
}
```

```cpp
#include <hip/hip_runtime.h>
#include <cstdio>
#include <cstdint>
namespace pg8 {
#define PG8_LAS __attribute__((address_space(3)))
typedef unsigned short bf16_t;
typedef short bf16x8 __attribute__((ext_vector_type(8)));
typedef float f32x4 __attribute__((ext_vector_type(4)));
typedef unsigned u32x4 __attribute__((ext_vector_type(4)));
constexpr int BM = 256, BK = 64, HALF = 128, HTB = HALF * BK * 2  , STAGE_BYTES = 8 * HTB, NXCD = 8, WGM = 8;

__host__ __device__ __forceinline__ int lds_byte(int r, int c) { const int st = (r >> 4) * 2 + (c >> 5), rr = r & 15, cc = c & 31, ob = rr * 64 + cc * 2; return st * 1024 + (ob ^ (((ob >> 9) & 1) << 5)); }
__host__ __device__ __forceinline__ void stage_rc(int b, int& R, int& C) { const int st = b / 1024, sb = b % 1024, swz = sb ^ (((sb >> 9) & 1) << 5); R = (st >> 1) * 16 + swz / 64; C = (st & 1) * 32 + (swz % 64) / 2; }
__host__ __device__ __forceinline__ int perm32(int rho) { const int n = rho >> 4, i = rho & 15; return 8 * (i >> 2) + 4 * n + (i & 3); }

struct Unit { int pm, pn; };
struct Gemm { const bf16_t* A; const bf16_t* Bt; int M, N, K, lda; };

struct StaticOrder {
    int nM, nN, nwg, G, c;
    __host__ __device__ void init(int M, int N, int G_, int c_) { nM = M / BM; nN = N / BM; nwg = nM * nN; G = G_; c = c_; }
    __host__ __device__ bool next(int i, Unit& u) const {
        const long L = (long)i * G + c; if (L >= nwg) return false;
        int wgid = (int)L; { const int q = nwg / NXCD, r = nwg % NXCD, xcd = wgid % NXCD, off = wgid / NXCD; wgid = (xcd < r ? xcd * (q + 1) : r * (q + 1) + (xcd - r) * q) + off; }
        const int nig = WGM * nN, gid = wgid / nig, fm = gid * WGM, gsz = (nM - fm) < WGM ? (nM - fm) : WGM;
        u.pm = fm + ((wgid % nig) % gsz); u.pn = (wgid % nig) / gsz; return true;
    }
    __device__ __forceinline__ void a_ready(const Unit&) const {}
    __device__ __forceinline__ void done(const Unit&) const {}
};

__device__ __forceinline__ unsigned cvt_pk_bf16(float lo, float hi) { unsigned r; asm volatile("v_cvt_pk_bf16_f32 %0, %1, %2" : "=v"(r) : "v"(lo), "v"(hi)); return r; }
typedef float f32x2 __attribute__((ext_vector_type(2)));
__device__ __forceinline__ f32x2 gelu_pk(f32x2 v) {
    const f32x2 av = __builtin_elementwise_abs(v), d = av * 0.2316418882f + 1.0f;
    f32x2 t; t.x = __builtin_amdgcn_rcpf(d.x); t.y = __builtin_amdgcn_rcpf(d.y);
    f32x2 q = t * 0.5307027145f + (-0.7265760135f); q = q * t + 0.7107068705f; q = q * t + (-0.142248368f); q = q * t + 0.127414796f; q = q * t;
    const f32x2 s = (v * v) * (-0.72134752044f);
    f32x2 e; e.x = __builtin_amdgcn_exp2f(s.x); e.y = __builtin_amdgcn_exp2f(s.y);
    const f32x2 m = v * (q * e), r = v - m;
    f32x2 o; o.x = v.x < 0.f ? m.x : r.x; o.y = v.y < 0.f ? m.y : r.y; return o;
}

template <int ACT  > struct EpiBf16 {
    static constexpr bool PERM = true, AFTER_DRAIN = false; static_assert(ACT == 0 || ACT == 1, "EpiBf16: ACT is 0 (none) or 1 (gelu_pk)");
    bf16_t* O; int ldc; const float* bias; int split_cols; size_t split_stride; float scale0;
    __device__ __forceinline__ void operator()(const f32x4 (&acc)[2][2][4][2], const Unit& u, int wr, int wc, int fr, int fq) const {
        const int row0 = u.pm * BM + wr * 64 + fr; int colt = u.pn * BM; bf16_t* base = O;
        float sc = 1.f; if (split_cols) { const int t = colt / split_cols; base += (size_t)t * split_stride; colt -= t * split_cols; if (t == 0) sc = scale0; }
        const int col0 = colt + wc * 32 + 8 * fq, bcol0 = u.pn * BM + wc * 32 + 8 * fq;
        f32x4 bv[2][2];
#pragma unroll
        for (int bj = 0; bj < 2; ++bj)
#pragma unroll
            for (int n = 0; n < 2; ++n) bv[bj][n] = bias ? *(const f32x4*)(bias + bcol0 + bj * HALF + 4 * n) : (f32x4){0.f, 0.f, 0.f, 0.f};
#pragma unroll
        for (int ai = 0; ai < 2; ++ai)
#pragma unroll
            for (int m = 0; m < 4; ++m) { bf16_t* rowp = base + (size_t)(row0 + ai * HALF + m * 16) * ldc + col0;
#pragma unroll
                for (int bj = 0; bj < 2; ++bj) { f32x4 v0 = acc[ai][bj][m][0] + bv[bj][0], v1 = acc[ai][bj][m][1] + bv[bj][1];
                    if (ACT == 1) { f32x2 a = gelu_pk((f32x2){v0[0], v0[1]}), b = gelu_pk((f32x2){v0[2], v0[3]}), c = gelu_pk((f32x2){v1[0], v1[1]}), d = gelu_pk((f32x2){v1[2], v1[3]});
                        v0 = (f32x4){a.x, a.y, b.x, b.y}; v1 = (f32x4){c.x, c.y, d.x, d.y}; }
                    v0 = v0 * sc; v1 = v1 * sc; u32x4 w; w.x = cvt_pk_bf16(v0[0], v0[1]); w.y = cvt_pk_bf16(v0[2], v0[3]); w.z = cvt_pk_bf16(v1[0], v1[1]); w.w = cvt_pk_bf16(v1[2], v1[3]);
                    *(u32x4*)(rowp + bj * HALF) = w; } }
    }
};
template <class Epi, class Sched, bool ALIGN_EPI = false, bool SP2 = false>
__device__ __forceinline__ void gemm_phase(PG8_LAS unsigned char* lds, const Gemm g, const Sched& S, const Epi& E) {
    int tid_ = threadIdx.x; asm volatile("" : "+v"(tid_));
    const int tid = tid_, wid = __builtin_amdgcn_readfirstlane(tid >> 6), lane = tid & 63, wr = wid >> 2, wc = wid & 3, fr = lane & 15, fq = lane >> 4;
    const int K = g.K, nt = K / BK;
    unsigned voffA[2], voffB[2];
#pragma unroll
    for (int i = 0; i < 2; ++i) { int R, C; stage_rc(tid * 16 + i * 8192, R, C); const int Rb = Epi::PERM ? ((R & ~31) + perm32(R & 31)) : R;
        voffA[i] = (unsigned)(R * g.lda + C) * 2u; voffB[i] = (unsigned)(Rb * K + C) * 2u; }
    const size_t kstep = (size_t)(BK * 2);
    const size_t hstepA = (size_t)HALF * g.lda * 2, hstepB = (size_t)HALF * K * 2;
    const size_t tstepA = 2 * hstepA, tstepB = 2 * hstepB;
    const unsigned ldsw = (unsigned)wid * 1024u;
    const int aoff = lds_byte(wr * 64 + fr, fq * 8), boff = lds_byte(wc * 32 + fr, fq * 8);
#define PG8_SA(b, h) (((b) * 2 + (h)) * HTB)
#define PG8_SB(b, h) ((4 + (b) * 2 + (h)) * HTB)
#define PG8_STAGE(bufoff, gbase, voff) do { _Pragma("unroll") for (int _i = 0; _i < 2; ++_i) \
        __builtin_amdgcn_global_load_lds((const unsigned*)((const char*)(gbase) + (voff)[_i]), (PG8_LAS unsigned*)(lds + (bufoff) + ldsw + _i * 8192), 16, 0, 0); } while (0)
#define PG8_LDA(dst, b, h) do { _Pragma("unroll") for (int m = 0; m < 4; ++m) _Pragma("unroll") for (int k = 0; k < 2; ++k) dst[m][k] = *(const PG8_LAS bf16x8*)(lds + PG8_SA(b, h) + aoff + m * 2048 + k * 1024); } while (0)
#define PG8_LDB(dst, b, h) do { _Pragma("unroll") for (int n = 0; n < 2; ++n) _Pragma("unroll") for (int k = 0; k < 2; ++k) dst[n][k] = *(const PG8_LAS bf16x8*)(lds + PG8_SB(b, h) + boff + n * 2048 + k * 1024); } while (0)
#define PG8_MMA(ai, bj, At, Bt) do { __builtin_amdgcn_s_setprio(1); _Pragma("unroll") for (int m = 0; m < 4; ++m) _Pragma("unroll") for (int n = 0; n < 2; ++n) _Pragma("unroll") for (int k = 0; k < 2; ++k) \
        acc[ai][bj][m][n] = __builtin_amdgcn_mfma_f32_16x16x32_bf16(Bt[n][k], At[m][k], acc[ai][bj][m][n], 0, 0, 0); __builtin_amdgcn_s_setprio(0); } while (0)
#define PG8_WAIT_V(n) asm volatile("s_waitcnt vmcnt(" #n ")" ::: "memory")
#define PG8_WAIT_L(n) asm volatile("s_waitcnt lgkmcnt(" #n ")" ::: "memory")
#define PG8_BAR __builtin_amdgcn_s_barrier()
#define PG8_SCHED __builtin_amdgcn_sched_barrier(0)
    Unit cur, nxt; int ui = 0;
    if (!S.next(0, cur)) return;
    f32x4 acc[2][2][4][2];
#pragma unroll
    for (int a = 0; a < 2; ++a)
#pragma unroll
        for (int b = 0; b < 2; ++b)
#pragma unroll
            for (int m = 0; m < 4; ++m)
#pragma unroll
                for (int n = 0; n < 2; ++n) acc[a][b][m][n] = (f32x4){0.f, 0.f, 0.f, 0.f};
    bf16x8 At[4][2], B0[2][2], B1[2][2];
    const char* cA = (const char*)g.A + (size_t)cur.pm * tstepA; const char* cB = (const char*)g.Bt + (size_t)cur.pn * tstepB;
    S.a_ready(cur);
    if constexpr (SP2) {
        PG8_STAGE(PG8_SB(0, 0), cB, voffB); PG8_STAGE(PG8_SB(0, 1), cB + hstepB, voffB); PG8_STAGE(PG8_SA(0, 0), cA, voffA); PG8_STAGE(PG8_SA(0, 1), cA + hstepA, voffA);
        if (wr == 1) PG8_BAR;
        PG8_WAIT_V(2); PG8_BAR;
        PG8_STAGE(PG8_SB(1, 0), cB + kstep, voffB); PG8_STAGE(PG8_SA(1, 0), cA + kstep, voffA); PG8_STAGE(PG8_SB(1, 1), cB + hstepB + kstep, voffB);
        PG8_WAIT_V(6); PG8_BAR;
    } else {
        PG8_STAGE(PG8_SB(0, 0), cB, voffB); PG8_STAGE(PG8_SA(0, 0), cA, voffA); PG8_STAGE(PG8_SB(0, 1), cB + hstepB, voffB); PG8_STAGE(PG8_SA(0, 1), cA + hstepA, voffA);
        if (wr == 1) PG8_BAR;
        PG8_WAIT_V(4); PG8_BAR;
        PG8_STAGE(PG8_SB(1, 0), cB + kstep, voffB); PG8_STAGE(PG8_SA(1, 0), cA + kstep, voffA); PG8_STAGE(PG8_SB(1, 1), cB + hstepB + kstep, voffB);
        PG8_WAIT_V(6); PG8_BAR;
    }
    for (;;) {
        const bool has_next = S.next(ui + 1, nxt);
        const char* nA = has_next ? (const char*)g.A + (size_t)nxt.pm * tstepA : cA; const char* nB = has_next ? (const char*)g.Bt + (size_t)nxt.pn * tstepB : cB;
        for (int t = 0; t < nt; t += 2) {
            const bool last = (t == nt - 2);
            const char* a1 = cA + (size_t)(t + 1) * kstep;
            const char* a2 = last ? nA : cA + (size_t)(t + 2) * kstep; const char* b2 = last ? nB : cB + (size_t)(t + 2) * kstep;
            const char* a3 = a2 + kstep; const char* b3 = b2 + kstep;
            if (last && has_next) S.a_ready(nxt);
            if constexpr (SP2) {
            PG8_LDB(B0, 0, 0); PG8_LDB(B1, 0, 1); PG8_SCHED; PG8_LDA(At, 0, 0); PG8_STAGE(PG8_SA(1, 1), a1 + hstepA, voffA);
            PG8_WAIT_V(8); PG8_WAIT_L(0); PG8_BAR; PG8_MMA(0, 0, At, B0); PG8_MMA(0, 1, At, B1); PG8_BAR; PG8_SCHED;
            PG8_LDA(At, 0, 1); PG8_STAGE(PG8_SB(0, 0), b2, voffB); PG8_STAGE(PG8_SB(0, 1), b2 + hstepB, voffB); PG8_STAGE(PG8_SA(0, 0), a2, voffA);
            PG8_WAIT_V(8); PG8_WAIT_L(0); PG8_BAR; PG8_MMA(1, 0, At, B0); PG8_MMA(1, 1, At, B1); PG8_BAR; PG8_SCHED;
            PG8_LDB(B0, 1, 0); PG8_LDB(B1, 1, 1); PG8_SCHED; PG8_LDA(At, 1, 0); PG8_STAGE(PG8_SA(0, 1), a2 + hstepA, voffA);
            PG8_WAIT_V(8); PG8_WAIT_L(0); PG8_BAR; PG8_MMA(0, 0, At, B0); PG8_MMA(0, 1, At, B1); PG8_BAR; PG8_SCHED;
            PG8_LDA(At, 1, 1); PG8_STAGE(PG8_SB(1, 0), b3, voffB); PG8_STAGE(PG8_SB(1, 1), b3 + hstepB, voffB); PG8_STAGE(PG8_SA(1, 0), a3, voffA);
            PG8_WAIT_V(8); PG8_WAIT_L(0); PG8_BAR; PG8_MMA(1, 0, At, B0); PG8_MMA(1, 1, At, B1); PG8_BAR; PG8_SCHED;
            } else {
            PG8_LDB(B0, 0, 0); PG8_SCHED; PG8_LDA(At, 0, 0); PG8_STAGE(PG8_SA(1, 1), a1 + hstepA, voffA);
            PG8_WAIT_L(8); PG8_BAR; PG8_WAIT_L(0); PG8_MMA(0, 0, At, B0); PG8_BAR; PG8_SCHED;
            PG8_LDB(B1, 0, 1); PG8_STAGE(PG8_SB(0, 0), b2, voffB);
            PG8_BAR; PG8_WAIT_L(0); PG8_MMA(0, 1, At, B1); PG8_BAR;
            PG8_LDA(At, 0, 1); PG8_STAGE(PG8_SA(0, 0), a2, voffA);
            PG8_BAR; PG8_WAIT_L(0); PG8_MMA(1, 0, At, B0); PG8_BAR; PG8_SCHED;
            PG8_STAGE(PG8_SB(0, 1), b2 + hstepB, voffB);
            PG8_WAIT_V(6); PG8_BAR; PG8_MMA(1, 1, At, B1); PG8_BAR;
            PG8_LDB(B0, 1, 0); PG8_SCHED; PG8_LDA(At, 1, 0); PG8_STAGE(PG8_SA(0, 1), a2 + hstepA, voffA);
            PG8_WAIT_L(8); PG8_BAR; PG8_WAIT_L(0); PG8_MMA(0, 0, At, B0); PG8_BAR; PG8_SCHED;
            PG8_LDB(B1, 1, 1); PG8_STAGE(PG8_SB(1, 0), b3, voffB);
            PG8_BAR; PG8_WAIT_L(0); PG8_MMA(0, 1, At, B1); PG8_BAR;
            PG8_LDA(At, 1, 1); PG8_STAGE(PG8_SA(1, 0), a3, voffA);
            PG8_BAR; PG8_WAIT_L(0); PG8_MMA(1, 0, At, B0); PG8_BAR; PG8_SCHED;
            PG8_STAGE(PG8_SB(1, 1), b3 + hstepB, voffB);
            PG8_WAIT_V(6); PG8_BAR; PG8_MMA(1, 1, At, B1); PG8_BAR;
            }
        }
        if constexpr (ALIGN_EPI) { if (wr == 0) PG8_BAR; }
        if constexpr (!Epi::AFTER_DRAIN) { E(acc, cur, wr, wc, fr, fq); S.done(cur); }
        if (!has_next) break;
#pragma unroll
        for (int a = 0; a < 2; ++a)
#pragma unroll
            for (int b = 0; b < 2; ++b)
#pragma unroll
                for (int m = 0; m < 4; ++m)
#pragma unroll
                    for (int n = 0; n < 2; ++n) acc[a][b][m][n] = (f32x4){0.f, 0.f, 0.f, 0.f};
        cur = nxt; cA = nA; cB = nB; ++ui;
        if constexpr (ALIGN_EPI) { if (wr == 1) PG8_BAR; }
    }
    PG8_WAIT_V(0);
    if constexpr (!ALIGN_EPI) { if (wr == 0) PG8_BAR; }
    PG8_BAR;
    if constexpr (Epi::AFTER_DRAIN) { E.fused(acc, cur, wr, wc, fr, fq, lds, wid, lane); S.done(cur); }
#undef PG8_SA
#undef PG8_SB
#undef PG8_STAGE
#undef PG8_LDA
#undef PG8_LDB
#undef PG8_MMA
#undef PG8_WAIT_V
#undef PG8_WAIT_L
#undef PG8_BAR
#undef PG8_SCHED
}
}

#define LAS __attribute__((address_space(3)))
typedef unsigned short bf16;
typedef unsigned v4u __attribute__((ext_vector_type(4)));
typedef unsigned v2u __attribute__((ext_vector_type(2)));
typedef float f32x4 __attribute__((ext_vector_type(4)));
typedef float f32x16 __attribute__((ext_vector_type(16)));
typedef short bf16x8 __attribute__((ext_vector_type(8)));
typedef short s16x4 __attribute__((ext_vector_type(4)));
typedef float f32x2_t __attribute__((ext_vector_type(2)));
typedef __bf16 bf16x2_t __attribute__((ext_vector_type(2)));

constexpr int NB = 8, SEQ = 2048, DM = 1024, TT = NB * SEQ;
constexpr int DIN = 7912, NP = 7936;
constexpr int PP = 3840, NZG = 4096;
constexpr int MEML = 256;
constexpr float EPS = 1e-6f, NEGF = -1e30f;
constexpr int C_QA = 0, C_KA = 512, C_VA = 1024, C_QI = 1536, C_KI = 2048, C_WI = 2112, C_CQ = 2120, C_CKV = 2504, C_KR = 2760, C_QM = 2792, C_ZM = 3304;
constexpr int C_YA = C_QI, C_YB = C_CQ, C_YM = C_VA;
constexpr float SCALE_A = 0.18033688011112042f;
constexpr float SCALE_B = 0.14724444602590306f;
constexpr float SCALE_M = 0.12751743082459868f;
constexpr float SCALE_I = 0.04419417382415922f;

__constant__ float INVA[8] = {1.0f, 0.1939227432012558f, 0.03760603070259094f, 0.007292664609849453f, 0.0014142135623842478f, 0.00027424818836152554f, 5.3182957344688475e-05f, 1.0313385246263351e-05f};
__constant__ float INVB[16] = {1.0f, 0.44036659598350525f, 0.1939227432012558f, 0.08539710193872452f, 0.03760603070259094f, 0.016560440883040428f, 0.007292664609849453f, 0.0032114461064338684f, 0.0014142135623842478f, 0.0006227724370546639f, 0.00027424818836152554f, 0.00012076973507646471f, 5.3182957344688475e-05f, 2.34199997066753e-05f, 1.0313385246263351e-05f, 4.541670477919979e-06f};

constexpr size_t MiB = 1u << 20;
constexpr size_t WS_CTL = 0;
constexpr size_t WS_WIN = 1 * MiB;
constexpr size_t WS_WUQ = 17 * MiB;
constexpr size_t WS_WUKV = 18 * MiB;
constexpr size_t WS_WMEM = 19 * MiB;
constexpr size_t WS_WBR = 21 * MiB;
constexpr size_t WS_WOUT = 24 * MiB;
constexpr size_t WS_ROPEA = 26 * MiB;
constexpr size_t WS_ROPEB = 27 * MiB;
constexpr size_t WS_MN = 29 * MiB;
constexpr size_t WS_KVM = 33 * MiB;
constexpr size_t WS_VTM = 37 * MiB;
constexpr size_t WS_WI = 39 * MiB;
constexpr size_t WS_MASK = 40 * MiB;
constexpr size_t WS_H = 44 * MiB;
constexpr size_t WS_P = 76 * MiB;
constexpr size_t WS_QB = 196 * MiB;
constexpr size_t WS_KVB = 220 * MiB;
constexpr size_t WS_G1 = 196 * MiB;
constexpr size_t WS_END = 256 * MiB;
constexpr size_t DO_VTA = 0;
constexpr size_t DO_VTB = 16 * MiB;
constexpr size_t DO_KB = 32 * MiB;
constexpr size_t DO_G0 = 0;

constexpr int REP_P0 = 1, REP_PH = 1, REP_G1 = 1, REP_G2 = 1, REP_IDX = 1, REP_ATT = 1, REP_G4 = 1, REP_G5 = 1;
constexpr int REP_IDX1 = 1, REP_SEL = 1;
constexpr int ATT_STRIP = 0;
constexpr int EXTRA_SYNCS = 0, REP_TR = 1, DUMMY_POST1 = 0, DUMMY_POST2 = 0;
constexpr int LDS_BYTES = 147456;
constexpr int LDS_SLOT = LDS_BYTES - 64;

__device__ __forceinline__ unsigned pk2(float lo, float hi) { f32x2_t v = {lo, hi}; bf16x2_t b = __builtin_convertvector(v, bf16x2_t); return __builtin_bit_cast(unsigned, b); }
__device__ __forceinline__ float bflo(unsigned w) { return __uint_as_float(w << 16); }
__device__ __forceinline__ float bfhi(unsigned w) { return __uint_as_float(w & 0xffff0000u); }
__device__ __forceinline__ float bf1(bf16 b) { return __uint_as_float(((unsigned)b) << 16); }
#define UNPACK8(W_, V_) do { V_[0] = bflo((W_)[0]); V_[1] = bfhi((W_)[0]); V_[2] = bflo((W_)[1]); V_[3] = bfhi((W_)[1]); V_[4] = bflo((W_)[2]); V_[5] = bfhi((W_)[2]); V_[6] = bflo((W_)[3]); V_[7] = bfhi((W_)[3]); } while (0)
#define PACK8(V_) (v4u){pk2(V_[0], V_[1]), pk2(V_[2], V_[3]), pk2(V_[4], V_[5]), pk2(V_[6], V_[7])}
__device__ __forceinline__ float wave_sum(float v) {
#pragma unroll
    for (int o = 1; o < 64; o <<= 1) v += __shfl_xor(v, o);
    return v;
}
#define LDS_WAIT() asm volatile("s_waitcnt lgkmcnt(0)" ::: "memory")

__device__ __forceinline__ int win_src(int d) {
    if (d < 2120) return d;
    if (d < 2792) return d + 512;
    if (d < 3816) return d + 1024;
    if (d < 3840) return -1;
    if (d < 4352) return d - 3840 + 2120;
    if (d < 4864) return d - 4352 + 3304;
    return d - 4864 + 4840;
}
template <bool REMAP>
__device__ __forceinline__ void transpose_item(const float* W, int K, int N, int Npad, bf16* WT, LAS float* scr, int item, int lane) {
    const int nblk = Npad / 32, kb = item / nblk, nb = item % nblk, k0 = 64 * kb, n0 = 32 * nb;
    const int n4 = 4 * (lane & 7);
    const int nn = REMAP ? win_src(n0 + n4) : n0 + n4; const bool ok = nn >= 0 && nn < N;
#pragma unroll
    for (int i = 0; i < 8; ++i) { const int kk = 8 * i + (lane >> 3);
        f32x4 v = (f32x4){0.f, 0.f, 0.f, 0.f}; if (ok) v = *(const f32x4*)(W + (size_t)(k0 + kk) * N + nn);
        LAS float* d = scr + kk * 33 + n4; d[0] = v[0]; d[1] = v[1]; d[2] = v[2]; d[3] = v[3]; }
    LDS_WAIT(); asm volatile("" ::: "memory");
    const int c = lane & 7;
#pragma unroll
    for (int j = 0; j < 4; ++j) { const int n = (lane >> 3) + 8 * j; const LAS float* s = scr + (8 * c) * 33 + n;
        v4u o; o.x = pk2(s[0 * 33], s[1 * 33]); o.y = pk2(s[2 * 33], s[3 * 33]); o.z = pk2(s[4 * 33], s[5 * 33]); o.w = pk2(s[6 * 33], s[7 * 33]);
        *(v4u*)(WT + (size_t)(n0 + n) * K + k0 + 8 * c) = o; }
    LDS_WAIT(); asm volatile("" ::: "memory");
}
__device__ __forceinline__ void rms_row_1024(const float* xrow, const float* g, bf16* orow, int lane) {
    const f32x4* xr = (const f32x4*)xrow + lane; const f32x4* gr = (const f32x4*)g + lane;
    f32x4 v[4]; float s = 0.f;
#pragma unroll
    for (int j = 0; j < 4; ++j) { v[j] = xr[64 * j]; s += (v[j].x * v[j].x + v[j].y * v[j].y) + (v[j].z * v[j].z + v[j].w * v[j].w); }
    const float rstd = 1.0f / sqrtf(wave_sum(s) * (1.f / 1024.f) + EPS);
    v2u* o8 = (v2u*)orow + lane;
#pragma unroll
    for (int j = 0; j < 4; ++j) { const f32x4 gg = gr[64 * j]; v2u w; w.x = pk2(v[j].x * rstd * gg.x, v[j].y * rstd * gg.y); w.y = pk2(v[j].z * rstd * gg.z, v[j].w * rstd * gg.w); o8[64 * j] = w; }
}

#define ROPE8(v, sub, c8, s8) do { _Pragma("unroll") for (int j_ = 0; j_ < 8; ++j_) { const float pv_ = __shfl_xor(v[j_], 1); \
        const float r0_ = v[j_] * c8[j_] - pv_ * s8[j_], r1_ = v[j_] * c8[j_] + pv_ * s8[j_]; v[j_] = (sub) == 0 ? r0_ : ((sub) == 1 ? r1_ : v[j_]); } } while (0)

__device__ __forceinline__ void post1_row(const bf16* Prow, bf16* Orow, const float* ra, const float (&ga)[8], const float (&gk)[8], const float (&gq)[8], const float (&gc)[8], const float (&gm)[8], float* WIrow, int lane) {
    const int sub = lane & 7;
    const v4u z4 = (v4u){0u, 0u, 0u, 0u};
    const v4u w_qa = *(const v4u*)(Prow + C_QA + 8 * lane);
    const v4u w_ka = *(const v4u*)(Prow + C_KA + 8 * lane);
    const v4u w_qi = *(const v4u*)(Prow + C_QI + 8 * lane);
    const v4u w_qm = *(const v4u*)(Prow + C_QM + 8 * lane);
    v4u w_ki = z4, w_cq = z4, w_ckv = z4; float w_wi = 0.f;
    if (lane < 8) { w_ki = *(const v4u*)(Prow + C_KI + 8 * lane); w_wi = bf1(Prow[C_WI + lane]); }
    if (lane < 48) w_cq = *(const v4u*)(Prow + C_CQ + 8 * lane);
    if (lane < 32) w_ckv = *(const v4u*)(Prow + C_CKV + 8 * lane);
    float c8[8], s8[8];
    { const f32x4 r0 = *(const f32x4*)(ra), r1 = *(const f32x4*)(ra + 4), r2 = *(const f32x4*)(ra + 8), r3 = *(const f32x4*)(ra + 12);
      c8[0] = r0[0]; c8[1] = r0[1]; c8[2] = r0[2]; c8[3] = r0[3]; c8[4] = r1[0]; c8[5] = r1[1]; c8[6] = r1[2]; c8[7] = r1[3];
      s8[0] = r2[0]; s8[1] = r2[1]; s8[2] = r2[2]; s8[3] = r2[3]; s8[4] = r3[0]; s8[5] = r3[1]; s8[6] = r3[2]; s8[7] = r3[3]; }
    { float v[8]; UNPACK8(w_qa, v); float ss = 0.f;
#pragma unroll
      for (int j = 0; j < 8; ++j) ss += v[j] * v[j];
      ss += __shfl_xor(ss, 1); ss += __shfl_xor(ss, 2); ss += __shfl_xor(ss, 4);
      const float rstd = 1.0f / sqrtf(ss * (1.f / 64.f) + EPS);
#pragma unroll
      for (int j = 0; j < 8; ++j) v[j] = v[j] * rstd * ga[j];
      ROPE8(v, sub, c8, s8);
#pragma unroll
      for (int j = 0; j < 8; ++j) v[j] *= SCALE_A;
      *(v4u*)(Orow + C_QA + 8 * lane) = PACK8(v); }
    { float v[8]; UNPACK8(w_ka, v); float ss = 0.f;
#pragma unroll
      for (int j = 0; j < 8; ++j) ss += v[j] * v[j];
      ss += __shfl_xor(ss, 1); ss += __shfl_xor(ss, 2); ss += __shfl_xor(ss, 4);
      const float rstd = 1.0f / sqrtf(ss * (1.f / 64.f) + EPS);
#pragma unroll
      for (int j = 0; j < 8; ++j) v[j] = v[j] * rstd * gk[j];
      ROPE8(v, sub, c8, s8);
      *(v4u*)(Orow + C_KA + 8 * lane) = PACK8(v); }
    { float v[8]; UNPACK8(w_qi, v);
      ROPE8(v, sub, c8, s8);
      *(v4u*)(Orow + C_QI + 8 * lane) = PACK8(v); }
    { float v[8]; UNPACK8(w_ki, v);
      ROPE8(v, sub, c8, s8);
      if (lane < 8) *(v4u*)(Orow + C_KI + 8 * lane) = PACK8(v); }
    if (lane < 8) WIrow[lane] = w_wi * SCALE_I;
    { float v[8]; UNPACK8(w_cq, v); float ss = 0.f;
#pragma unroll
      for (int j = 0; j < 8; ++j) ss += v[j] * v[j];
      ss = wave_sum(ss); const float rstd = 1.0f / sqrtf(ss * (1.f / 384.f) + EPS);
      if (lane < 48) {
#pragma unroll
          for (int j = 0; j < 8; ++j) v[j] = v[j] * rstd * gq[j];
          *(v4u*)(Orow + C_CQ + 8 * lane) = PACK8(v); } }
    { float v[8]; UNPACK8(w_ckv, v); float ss = 0.f;
#pragma unroll
      for (int j = 0; j < 8; ++j) ss += v[j] * v[j];
      ss = wave_sum(ss); const float rstd = 1.0f / sqrtf(ss * (1.f / 256.f) + EPS);
      if (lane < 32) {
#pragma unroll
          for (int j = 0; j < 8; ++j) v[j] = v[j] * rstd * gc[j];
          *(v4u*)(Orow + C_CKV + 8 * lane) = PACK8(v); } }
    { float v[8]; UNPACK8(w_qm, v); float ss = 0.f;
#pragma unroll
      for (int j = 0; j < 8; ++j) ss += v[j] * v[j];
      ss += __shfl_xor(ss, 1); ss += __shfl_xor(ss, 2); ss += __shfl_xor(ss, 4); ss += __shfl_xor(ss, 8);
      const float rstd = 1.0f / sqrtf(ss * (1.f / 128.f) + EPS);
#pragma unroll
      for (int j = 0; j < 8; ++j) v[j] = v[j] * rstd * gm[j] * SCALE_M;
      *(v4u*)(Orow + C_QM + 8 * lane) = PACK8(v); }
}

__device__ __forceinline__ void km_row(bf16* row, const float* gkm, int lane) {
    v4u w = *(const v4u*)(row + 8 * lane); float v[8]; UNPACK8(w, v); float ss = 0.f;
#pragma unroll
    for (int j = 0; j < 8; ++j) ss += v[j] * v[j];
    ss += __shfl_xor(ss, 1); ss += __shfl_xor(ss, 2); ss += __shfl_xor(ss, 4); ss += __shfl_xor(ss, 8);
    const float rstd = 1.0f / sqrtf(ss * (1.f / 128.f) + EPS);
#pragma unroll
    for (int j = 0; j < 8; ++j) v[j] = v[j] * rstd * gkm[8 * (lane & 15) + j];
    *(v4u*)(row + 8 * lane) = PACK8(v);
}

__device__ __forceinline__ void transpose_v(const bf16* src, int pitch, int col0, int hstride, int H, int DV, int S, int nb, bf16* dst, int gw, int NGW, int lane) {
    const int ndq = DV / 64, nsc = S / 64, ntask = nb * H * nsc * ndq;
    for (int task = gw; task < ntask; task += NGW) {
        int x = task; const int dq = x % ndq; x /= ndq; const int sc = x % nsc; x /= nsc; const int h = x % H; const int b = x / H;
        const int s = sc * 64 + lane;
        const bf16* srow = src + (size_t)(b * S + s) * pitch + col0 + h * hstride + dq * 64;
        bf16* drow = dst + ((size_t)((b * H + h) * DV + dq * 64)) * S + s;
        v4u wv[8];
#pragma unroll
        for (int c = 0; c < 8; ++c) wv[c] = *(const v4u*)(srow + 8 * c);
#pragma unroll
        for (int c = 0; c < 8; ++c) { const v4u w = wv[c];
            drow[(size_t)(8 * c + 0) * S] = (bf16)(w.x & 0xffffu); drow[(size_t)(8 * c + 1) * S] = (bf16)(w.x >> 16);
            drow[(size_t)(8 * c + 2) * S] = (bf16)(w.y & 0xffffu); drow[(size_t)(8 * c + 3) * S] = (bf16)(w.y >> 16);
            drow[(size_t)(8 * c + 4) * S] = (bf16)(w.z & 0xffffu); drow[(size_t)(8 * c + 5) * S] = (bf16)(w.z >> 16);
            drow[(size_t)(8 * c + 6) * S] = (bf16)(w.w & 0xffffu); drow[(size_t)(8 * c + 7) * S] = (bf16)(w.w >> 16); }
    }
}

__device__ __forceinline__ void post2_row(const bf16* QBrow, bf16* QOrow, const bf16* KVBrow, const bf16* Prow, bf16* KBrow, const float* rb, const float (&gqv)[12], const float (&gkv)[12], LAS float* scr, int lane) {
    const int hd = lane >> 3, d0 = 12 * (lane & 7);
    float vq[12], vk[12], cc[12], sn[12];
    { const v2u* p = (const v2u*)(QBrow + 12 * lane);
      const v2u w0 = p[0], w1 = p[1], w2 = p[2];
      bf16 kr[12];
#pragma unroll
      for (int e = 0; e < 12; ++e) { const int d = d0 + e; kr[e] = d < 64 ? KVBrow[hd * 128 + d] : Prow[C_KR + d - 64]; }
#pragma unroll
      for (int e = 0; e < 12; ++e) { const int d = d0 + e; const int i = (d - 64) & 15; cc[e] = d < 64 ? 1.f : rb[i]; sn[e] = d < 64 ? 0.f : rb[16 + i]; }
      vq[0] = bflo(w0.x); vq[1] = bfhi(w0.x); vq[2] = bflo(w0.y); vq[3] = bfhi(w0.y); vq[4] = bflo(w1.x); vq[5] = bfhi(w1.x); vq[6] = bflo(w1.y); vq[7] = bfhi(w1.y);
      vq[8] = bflo(w2.x); vq[9] = bfhi(w2.x); vq[10] = bflo(w2.y); vq[11] = bfhi(w2.y);
#pragma unroll
      for (int e = 0; e < 12; ++e) vk[e] = bf1(kr[e]); }
    float sq = 0.f, sk = 0.f;
#pragma unroll
    for (int e = 0; e < 12; ++e) { sq += vq[e] * vq[e]; sk += vk[e] * vk[e]; }
    sq += __shfl_xor(sq, 1); sq += __shfl_xor(sq, 2); sq += __shfl_xor(sq, 4);
    sk += __shfl_xor(sk, 1); sk += __shfl_xor(sk, 2); sk += __shfl_xor(sk, 4);
    const float rq = 1.0f / sqrtf(sq * (1.f / 96.f) + EPS), rk = 1.0f / sqrtf(sk * (1.f / 96.f) + EPS);
#pragma unroll
    for (int e = 0; e < 12; ++e) { vq[e] = vq[e] * rq * gqv[e]; vk[e] = vk[e] * rk * gkv[e]; scr[12 * lane + e] = vq[e]; scr[768 + 12 * lane + e] = vk[e]; }
    LDS_WAIT(); asm volatile("" ::: "memory");
    float oq[12], ok[12];
#pragma unroll
    for (int e = 0; e < 12; ++e) { const int d = d0 + e;
        if (d < 64) { oq[e] = vq[e]; ok[e] = vk[e]; }
        else { const bool first = d < 80; const int off = first ? 16 : -16; const float pq = scr[12 * lane + e + off], pk = scr[768 + 12 * lane + e + off];
               oq[e] = first ? vq[e] * cc[e] - pq * sn[e] : vq[e] * cc[e] + pq * sn[e];
               ok[e] = first ? vk[e] * cc[e] - pk * sn[e] : vk[e] * cc[e] + pk * sn[e]; }
        oq[e] *= SCALE_B; }
    LDS_WAIT(); asm volatile("" ::: "memory");
    v2u* q = (v2u*)(QOrow + 12 * lane); v2u* k = (v2u*)(KBrow + 12 * lane);
#pragma unroll
    for (int i = 0; i < 3; ++i) { v2u w; w.x = pk2(oq[4 * i], oq[4 * i + 1]); w.y = pk2(oq[4 * i + 2], oq[4 * i + 3]); q[i] = w;
                                  v2u u; u.x = pk2(ok[4 * i], ok[4 * i + 1]); u.y = pk2(ok[4 * i + 2], ok[4 * i + 3]); k[i] = u; }
}

__device__ __forceinline__ int next_unit(unsigned* ctr, volatile LAS int* slot) {
    __syncthreads();
    if (threadIdx.x == 0) *slot = (int)atomicAdd(ctr, 1u);
    __syncthreads();
    return *slot;
}

constexpr int SCP = 2112;
__device__ __forceinline__ unsigned ord_key(float v) { const unsigned b = __float_as_uint(v); return b ^ ((unsigned)((int)b >> 31) | 0x80000000u); }
__device__ __forceinline__ void indexer_unit(LAS float* sc, const bf16* P, const float* WI, unsigned* MASK, int bb, int tb) {
    int tid_ = threadIdx.x; asm volatile("" : "+v"(tid_));
    const int tid = tid_, lane = tid & 63, w = __builtin_amdgcn_readfirstlane(tid >> 6);
    const int n = lane & 15, g = lane >> 4;
    const int rowbase = bb * SEQ, t0 = tb * 16;
    for (int rp1 = 0; rp1 < REP_IDX1; ++rp1) {
        bf16x8 qf[8][2]; float wq[8];
        const bf16* qrow = P + (size_t)(rowbase + t0 + n) * PP + C_QI + 8 * g;
#pragma unroll
        for (int h = 0; h < 8; ++h) {
            qf[h][0] = *(const bf16x8*)(qrow + h * 64);
            qf[h][1] = *(const bf16x8*)(qrow + h * 64 + 32);
            wq[h] = WI[(size_t)(rowbase + t0 + n) * 8 + h];
        }
        const int ntile = tb + 1;
        const int nmine = (ntile - w + 7) >> 3;
        const int ngrp = (nmine + 3) >> 2;
        const bf16* kbase = P + (size_t)(rowbase + n) * PP + C_KI + 8 * g;
        bf16x8 kb[2][4][2];
#define IDX_LOAD(BUF, GRP) do { _Pragma("unroll") for (int j_ = 0; j_ < 4; ++j_) { const int tile_ = w + 8 * (4 * (GRP) + j_); const int tl_ = tile_ < ntile ? tile_ : 0; \
            const bf16* kr_ = kbase + (size_t)(16 * tl_) * PP; kb[BUF][j_][0] = *(const bf16x8*)(kr_); kb[BUF][j_][1] = *(const bf16x8*)(kr_ + 32); } } while (0)
#define IDX_COMP(BUF, GRP) do { _Pragma("unroll") for (int j_ = 0; j_ < 4; ++j_) { const int tile_ = w + 8 * (4 * (GRP) + j_); if (tile_ < ntile) { \
            f32x4 idx_ = (f32x4){0.f, 0.f, 0.f, 0.f}; \
            _Pragma("unroll") for (int h_ = 0; h_ < 8; ++h_) { f32x4 a_ = (f32x4){0.f, 0.f, 0.f, 0.f}; \
                a_ = __builtin_amdgcn_mfma_f32_16x16x32_bf16(kb[BUF][j_][0], qf[h_][0], a_, 0, 0, 0); \
                a_ = __builtin_amdgcn_mfma_f32_16x16x32_bf16(kb[BUF][j_][1], qf[h_][1], a_, 0, 0, 0); \
                _Pragma("unroll") for (int i_ = 0; i_ < 4; ++i_) idx_[i_] = __builtin_fmaf(wq[h_], __builtin_fmaxf(a_[i_], 0.f), idx_[i_]); } \
            { const int k0_ = 16 * tile_ + 4 * g; LAS float* d_ = sc + n * SCP + k0_ + (k0_ >> 5); d_[0] = idx_[0]; d_[1] = idx_[1]; d_[2] = idx_[2]; d_[3] = idx_[3]; } } } } while (0)
        if (ngrp > 0) IDX_LOAD(0, 0);
        for (int gp = 0; gp < ngrp; gp += 2) {
            if (gp + 1 < ngrp) IDX_LOAD(1, gp + 1);
            IDX_COMP(0, gp);
            if (gp + 1 < ngrp) { if (gp + 2 < ngrp) IDX_LOAD(0, gp + 2); IDX_COMP(1, gp + 1); }
        }
#undef IDX_LOAD
#undef IDX_COMP
    }
    __syncthreads();
#pragma unroll 1
    for (int qq2 = 0; qq2 < 2 * REP_SEL; ++qq2) { const int qq = qq2 & 1;
        const int q = 2 * w + qq, t = t0 + q;
        unsigned* mrow = MASK + (size_t)(rowbase + t) * 64;
        const int nv = t - 32 * lane + 1;
        const unsigned valid = nv >= 32 ? 0xffffffffu : (nv <= 0 ? 0u : ((1u << nv) - 1u));
        if (t < 256) { mrow[lane] = valid; continue; }
        unsigned u[32];
        const LAS float* srow = sc + q * SCP + 33 * lane;
#pragma unroll
        for (int r = 0; r < 32; ++r) { const float v = srow[r]; u[r] = ((valid >> r) & 1u) ? ord_key(v) : 0u; }
#pragma unroll
        for (int si = 0; si < 5; ++si) { const int sft = 16 >> si;
            const unsigned msk = si == 0 ? 0x0000ffffu : (si == 1 ? 0x00ff00ffu : (si == 2 ? 0x0f0f0f0fu : (si == 3 ? 0x33333333u : 0x55555555u)));
#pragma unroll
            for (int k = 0; k < 32; ++k) if (!(k & sft)) { const unsigned tt = ((u[k] >> sft) ^ u[k + sft]) & msk; u[k + sft] ^= tt; u[k] ^= tt << sft; } }
        unsigned alive = valid, sel = 0u; int need = 256;
#pragma unroll
        for (int j = 31; j >= 0; --j) {
            const unsigned ones = alive & u[j];
            const unsigned cl = (unsigned)__popc(ones);
            int c = 0;
#pragma unroll
            for (int bt = 0; bt < 6; ++bt) c += __popcll(__ballot((cl >> bt) & 1u)) << bt;
            if (c >= need) { alive = ones; if (c == need) { sel |= ones; need = 0; break; } }
            else { need -= c; sel |= ones; alive &= ~u[j]; }
        }
        if (need > 0) {
            const int cnt = __popc(alive); int inc = cnt;
#pragma unroll
            for (int d = 1; d < 64; d <<= 1) { const int o = __shfl_up(inc, d); if (lane >= d) inc += o; }
            int k = need - (inc - cnt); k = k < 0 ? 0 : (k > cnt ? cnt : k);
            unsigned m = alive;
            for (int i = 0; i < k; ++i) { const unsigned low = m & (0u - m); sel |= low; m ^= low; }
        }
        mrow[lane] = sel;
    }
    __syncthreads();
}

__device__ __forceinline__ int crow(int r, int hi) { return (r & 3) + 8 * (r >> 2) + 4 * hi; }
template <int DQK, int DV, int MODE, int STRIP = 0>
__device__ __forceinline__ void attn_unit(LAS unsigned char* lds, const bf16* Qb, int qpitch, const bf16* Kb, int kpitch, const bf16* VTb, int skv,
                                          const unsigned* maskb, const bf16* Zb, bf16* Ob, int q0) {
    constexpr int TK = 128, KP = DQK + 8, VP = TK + 8;
    LAS bf16* Ks = (LAS bf16*)lds; LAS bf16* Vs = Ks + TK * KP;
    constexpr int CPR = DQK / 8;
    constexpr int NCK = TK * CPR, NCV = DV * (TK / 8);
    constexpr int RK = (NCK + 511) / 512, RV = (NCV + 511) / 512;
    constexpr int NKS = DQK / 16, NMT = DV / 32;
    int tid_ = threadIdx.x; asm volatile("" : "+v"(tid_));
    const int tid = tid_, lane = tid & 63, w = __builtin_amdgcn_readfirstlane(tid >> 6), r = lane & 31, hh = lane >> 5;
    const int NT = MODE == 0 ? skv / TK : (q0 + 256) / TK;
    const int qlo = q0 + 32 * w;
    bf16x8 qf[NKS];
    { const bf16* qrow = Qb + (size_t)(qlo + r) * qpitch + 8 * hh;
#pragma unroll
      for (int ks = 0; ks < NKS; ++ks) qf[ks] = *(const bf16x8*)(qrow + 16 * ks); }
    f32x16 o[NMT];
#pragma unroll
    for (int mt = 0; mt < NMT; ++mt)
#pragma unroll
        for (int i = 0; i < 16; ++i) o[mt][i] = 0.f;
    float m_run = NEGF, l_run = 0.f;
    v4u kreg[RK], vreg[RV];
#define ATT_PREFETCH(tile_) do { \
        _Pragma("unroll") for (int i_ = 0; i_ < RK; ++i_) { const int c_ = tid + 512 * i_; if (c_ < NCK) { const int row_ = c_ / CPR, cc_ = c_ % CPR; kreg[i_] = *(const v4u*)(Kb + (size_t)(TK * (tile_) + row_) * kpitch + 8 * cc_); } } \
        _Pragma("unroll") for (int i_ = 0; i_ < RV; ++i_) { const int c_ = tid + 512 * i_; if (c_ < NCV) { const int d_ = c_ >> 4, cc_ = c_ & 15; vreg[i_] = *(const v4u*)(VTb + (size_t)d_ * skv + TK * (tile_) + 8 * cc_); } } } while (0)
    if (STRIP != 2) ATT_PREFETCH(0);
    for (int tile = 0; tile < NT; ++tile) {
        __syncthreads();
        if (STRIP != 2) {
#pragma unroll
        for (int i = 0; i < RK; ++i) { const int c = tid + 512 * i; if (c < NCK) { const int row = c / CPR, cc = c % CPR; *(LAS v4u*)(Ks + row * KP + 8 * cc) = kreg[i]; } }
#pragma unroll
        for (int i = 0; i < RV; ++i) { const int c = tid + 512 * i; if (c < NCV) { const int d = c >> 4, cc = c & 15; *(LAS v4u*)(Vs + d * VP + 8 * cc) = vreg[i]; } }
        }
        __syncthreads();
        if (STRIP != 2 && tile + 1 < NT) ATT_PREFETCH(tile + 1);
        __builtin_amdgcn_sched_barrier(0);
        if (STRIP == 1) continue;
#pragma unroll 1
        for (int sub = 0; sub < 2; ++sub) {
        const int t64 = 2 * tile + sub;
        if (MODE != 0 && 64 * t64 > qlo + 31) continue;
        const LAS bf16* Kc = Ks + 64 * sub * KP; const LAS bf16* Vc = Vs + 64 * sub;
        unsigned mw0 = 0u, mw1 = 0u;
        if (MODE == 2) { const v2u mm = *(const v2u*)(maskb + (size_t)(qlo + r) * 64 + 2 * t64); mw0 = mm.x >> (4 * hh); mw1 = mm.y >> (4 * hh); }
        f32x16 s0, s1;
#pragma unroll
        for (int i = 0; i < 16; ++i) { s0[i] = 0.f; s1[i] = 0.f; }
#pragma unroll
        for (int ks = 0; ks < NKS; ++ks) {
            const bf16x8 a0 = *(const LAS bf16x8*)(Kc + r * KP + 16 * ks + 8 * hh);
            const bf16x8 a1 = *(const LAS bf16x8*)(Kc + (32 + r) * KP + 16 * ks + 8 * hh);
            s0 = __builtin_amdgcn_mfma_f32_32x32x16_bf16(a0, qf[ks], s0, 0, 0, 0);
            s1 = __builtin_amdgcn_mfma_f32_32x32x16_bf16(a1, qf[ks], s1, 0, 0, 0);
        }
        if (MODE == 1) {
            if (64 * t64 + 63 > qlo) { const int qg = qlo + r;
#pragma unroll
                for (int i = 0; i < 16; ++i) { const int key = 64 * t64 + crow(i, hh); if (key > qg) s0[i] = NEGF; if (key + 32 > qg) s1[i] = NEGF; } }
        }
        if (MODE == 2) {
#pragma unroll
            for (int i = 0; i < 16; ++i) { const int bit = (i & 3) + 8 * (i >> 2); if (!((mw0 >> bit) & 1u)) s0[i] = NEGF; if (!((mw1 >> bit) & 1u)) s1[i] = NEGF; }
        }
        float mx = s0[0];
#pragma unroll
        for (int i = 1; i < 16; ++i) mx = __builtin_fmaxf(mx, s0[i]);
#pragma unroll
        for (int i = 0; i < 16; ++i) mx = __builtin_fmaxf(mx, s1[i]);
        mx = __builtin_fmaxf(mx, __shfl_xor(mx, 32));
        const float m_new = __builtin_fmaxf(m_run, mx);
        const float alpha = __builtin_amdgcn_exp2f(m_run - m_new);
        m_run = m_new;
        float ls = 0.f;
#pragma unroll
        for (int i = 0; i < 16; ++i) { s0[i] = __builtin_amdgcn_exp2f(s0[i] - m_new); s1[i] = __builtin_amdgcn_exp2f(s1[i] - m_new); ls += s0[i] + s1[i]; }
        l_run = l_run * alpha + ls;
#pragma unroll
        for (int mt = 0; mt < NMT; ++mt)
#pragma unroll
            for (int i = 0; i < 16; ++i) o[mt][i] *= alpha;
        v4u pf[2][2];
#pragma unroll
        for (int s = 0; s < 2; ++s) {
            pf[0][s] = (v4u){pk2(s0[8 * s], s0[8 * s + 1]), pk2(s0[8 * s + 2], s0[8 * s + 3]), pk2(s0[8 * s + 4], s0[8 * s + 5]), pk2(s0[8 * s + 6], s0[8 * s + 7])};
            pf[1][s] = (v4u){pk2(s1[8 * s], s1[8 * s + 1]), pk2(s1[8 * s + 2], s1[8 * s + 3]), pk2(s1[8 * s + 4], s1[8 * s + 5]), pk2(s1[8 * s + 6], s1[8 * s + 7])};
        }
#pragma unroll
        for (int mt = 0; mt < NMT; ++mt)
#pragma unroll
            for (int p = 0; p < 2; ++p)
#pragma unroll
                for (int s = 0; s < 2; ++s) {
                    const LAS bf16* vp = Vc + (32 * mt + r) * VP + 32 * p + 16 * s + 4 * hh;
                    const s16x4 lo = *(const LAS s16x4*)(vp), hi = *(const LAS s16x4*)(vp + 8);
                    const bf16x8 a = (bf16x8){lo[0], lo[1], lo[2], lo[3], hi[0], hi[1], hi[2], hi[3]};
                    o[mt] = __builtin_amdgcn_mfma_f32_32x32x16_bf16(a, __builtin_bit_cast(bf16x8, pf[p][s]), o[mt], 0, 0, 0);
                }
        }
    }
#undef ATT_PREFETCH
    const float l_tot = l_run + __shfl_xor(l_run, 32);
    const float inv = 1.0f / l_tot;
    const size_t row = (size_t)(qlo + r);
#pragma unroll
    for (int mt = 0; mt < NMT; ++mt)
#pragma unroll
        for (int g4 = 0; g4 < 4; ++g4) {
            const int d = 32 * mt + 8 * g4 + 4 * hh;
            float ov[4];
#pragma unroll
            for (int i = 0; i < 4; ++i) ov[i] = o[mt][4 * g4 + i] * inv;
            if (Zb) { const v2u zw = *(const v2u*)(Zb + row * PP + d); const float z[4] = {bflo(zw.x), bfhi(zw.x), bflo(zw.y), bfhi(zw.y)};
#pragma unroll
                for (int i = 0; i < 4; ++i) ov[i] *= z[i] / (1.0f + __expf(-z[i])); }
            v2u ow; ow.x = pk2(ov[0], ov[1]); ow.y = pk2(ov[2], ov[3]);
            *(v2u*)(Ob + row * PP + d) = ow;
        }
}

__device__ __forceinline__ bf16* gate_row(bf16* G0, bf16* G1, size_t row) { return row < 8192 ? G0 + row * 3072 : G1 + (row - 8192) * 3072; }
struct EpiZG {
    static constexpr bool PERM = true, AFTER_DRAIN = false;
    bf16* P; bf16* G0; bf16* G1;
    __device__ __forceinline__ void operator()(const pg8::f32x4 (&acc)[2][2][4][2], const pg8::Unit& u, int wr, int wc, int fr, int fq) const {
        const int row0 = u.pm * 256 + wr * 64 + fr, cl = wc * 32 + 8 * fq;
        const bool isz = u.pn < 4;
        const int ycol = (u.pn < 2 ? C_YA : C_YB) + (u.pn & 1) * 256, gcol = (u.pn - 4) * 256;
#pragma unroll
        for (int ai = 0; ai < 2; ++ai)
#pragma unroll
            for (int m = 0; m < 4; ++m) { const size_t row = (size_t)(row0 + ai * 128 + m * 16);
#pragma unroll
                for (int bj = 0; bj < 2; ++bj) {
                    const pg8::f32x4 v0 = acc[ai][bj][m][0], v1 = acc[ai][bj][m][1];
                    float rr[8] = {v0[0], v0[1], v0[2], v0[3], v1[0], v1[1], v1[2], v1[3]};
                    if (isz) { bf16* dst = P + row * PP + ycol + cl + bj * 128; const v4u old = *(const v4u*)dst; float yv[8]; UNPACK8(old, yv);
#pragma unroll
                        for (int e = 0; e < 8; ++e) rr[e] = yv[e] * (rr[e] / (1.0f + __expf(-rr[e])));
                        *(v4u*)dst = PACK8(rr); }
                    else { bf16* dst = gate_row(G0, G1, row) + gcol + cl + bj * 128;
#pragma unroll
                        for (int e = 0; e < 8; ++e) rr[e] = 1.0f / (1.0f + __expf(-rr[e]));
                        *(v4u*)dst = PACK8(rr); } } }
    }
};
struct EpiMerge {
    static constexpr bool PERM = true, AFTER_DRAIN = false;
    bf16* Mg; bf16* G0; bf16* G1; int nbr;
    __device__ __forceinline__ void operator()(const pg8::f32x4 (&acc)[2][2][4][2], const pg8::Unit& u, int wr, int wc, int fr, int fq) const {
        const int row0 = u.pm * 256 + wr * 64 + fr, col0 = u.pn * 256 + wc * 32 + 8 * fq;
#pragma unroll
        for (int ai = 0; ai < 2; ++ai)
#pragma unroll
            for (int m = 0; m < 4; ++m) { const size_t row = (size_t)(row0 + ai * 128 + m * 16);
#pragma unroll
                for (int bj = 0; bj < 2; ++bj) { const int col = col0 + bj * 128;
                    const v4u gwd = *(const v4u*)(gate_row(G0, G1, row) + nbr * 1024 + col);
                    float gl[8]; UNPACK8(gwd, gl);
                    const pg8::f32x4 v0 = acc[ai][bj][m][0], v1 = acc[ai][bj][m][1];
                    float rr[8] = {v0[0], v0[1], v0[2], v0[3], v1[0], v1[1], v1[2], v1[3]};
#pragma unroll
                    for (int e = 0; e < 8; ++e) rr[e] *= gl[e];
                    bf16* dst = Mg + row * 1024 + col;
                    if (nbr > 0) { const v4u old = *(const v4u*)dst; float ol[8]; UNPACK8(old, ol);
#pragma unroll
                        for (int e = 0; e < 8; ++e) rr[e] += ol[e]; }
                    *(v4u*)dst = PACK8(rr); } }
    }
};
struct EpiOut {
    static constexpr bool PERM = true, AFTER_DRAIN = false;
    const float* X; float* Out;
    __device__ __forceinline__ void operator()(const pg8::f32x4 (&acc)[2][2][4][2], const pg8::Unit& u, int wr, int wc, int fr, int fq) const {
        const int row0 = u.pm * 256 + wr * 64 + fr, col0 = u.pn * 256 + wc * 32 + 8 * fq;
#pragma unroll
        for (int ai = 0; ai < 2; ++ai)
#pragma unroll
            for (int m = 0; m < 4; ++m) { const size_t row = (size_t)(row0 + ai * 128 + m * 16);
#pragma unroll
                for (int bj = 0; bj < 2; ++bj) { const size_t p = row * 1024 + col0 + bj * 128;
                    const f32x4 x0 = *(const f32x4*)(X + p), x1 = *(const f32x4*)(X + p + 4);
                    const pg8::f32x4 a0 = acc[ai][bj][m][0], a1 = acc[ai][bj][m][1];
                    *(f32x4*)(Out + p) = (f32x4){x0[0] + a0[0], x0[1] + a0[1], x0[2] + a0[2], x0[3] + a0[3]};
                    *(f32x4*)(Out + p + 4) = (f32x4){x1[0] + a1[0], x1[1] + a1[1], x1[2] + a1[2], x1[3] + a1[3]}; } }
    }
};

#define XB_TMO      128
#define XB_XCNT(j)  (256  + 64 * (j))
#define XB_XSUB(j)  (1280 + 64 * (j))
#define XB_XGEN(j)  (2304 + 64 * (j))
#define XB_TOP      3328
#define XB_TOPGEN   3392
#define XCD_BAR_WORDS 3456
#define XB_SPIN_CAP (1u << 18)

__device__ __forceinline__ unsigned xb_ld(unsigned* p)              { return __hip_atomic_load(p, __ATOMIC_RELAXED, __HIP_MEMORY_SCOPE_AGENT); }
__device__ __forceinline__ unsigned xb_add(unsigned* p, unsigned v) { return __hip_atomic_fetch_add(p, v, __ATOMIC_RELAXED, __HIP_MEMORY_SCOPE_AGENT); }
__device__ __forceinline__ unsigned xb_xcc_id() { return (unsigned)__builtin_amdgcn_s_getreg((3 << 11) | 20) & 0xFu; }
#define XB_SPIN(cond, bar) do { unsigned _sp = 0; while (cond) { __builtin_amdgcn_s_sleep(1); \
    if ((++_sp & 255u) == 0u) { if (xb_ld(&(bar)[XB_TMO])) break; if (_sp > XB_SPIN_CAP) { atomicAdd(&(bar)[XB_TMO], 1u); break; } } } } while (0)

struct XcdBarrier {
    unsigned* bar; unsigned x;
    volatile LAS unsigned* st;
};

__device__ __forceinline__ XcdBarrier xcd_barrier_post(unsigned* bar, volatile LAS unsigned* st) {
    XcdBarrier b; b.bar = bar; b.x = xb_xcc_id(); b.st = st;
    if (threadIdx.x == 0) (void)xb_add(&bar[XB_XCNT(b.x)], 1u);
    return b;
}
__device__ __forceinline__ void xcd_barrier_complete(unsigned* bar, unsigned x, unsigned& nloc, unsigned& nx) {
    const unsigned G = gridDim.x * gridDim.y * gridDim.z;
    unsigned sum, cnt, mine, sp = 0u;
    for (;;) {
        sum = 0u; cnt = 0u; mine = 0u;
#pragma unroll
        for (unsigned j = 0; j < 16; ++j) { const unsigned c = xb_ld(&bar[XB_XCNT(j)]); sum += c; cnt += (c > 0u) ? 1u : 0u; mine = (j == x) ? c : mine; }
        if (sum == G) break;
        __builtin_amdgcn_s_sleep(1);
        if ((++sp & 255u) == 0u) { if (xb_ld(&bar[XB_TMO])) break; if (sp > XB_SPIN_CAP) { atomicAdd(&bar[XB_TMO], 1u); break; } }
    }
    nloc = mine > 0u ? mine : 1u; nx = cnt > 0u ? cnt : 1u;
}

__device__ __forceinline__ void xcd_barrier(const XcdBarrier& b) {
    asm volatile("s_waitcnt vmcnt(0)" ::: "memory");
    __syncthreads();
    if (threadIdx.x == 0) {
        unsigned* bar = b.bar;
        __builtin_amdgcn_s_waitcnt(0);
        unsigned nloc = b.st[0], nx = b.st[1];
        if (nloc == 0u) { xcd_barrier_complete(bar, b.x, nloc, nx); b.st[0] = nloc; b.st[1] = nx; }
        const unsigned old = xb_add(&bar[XB_XSUB(b.x)], 1u);
        const unsigned gen = old / nloc;
        if (old + 1u == (gen + 1u) * nloc) {
            __builtin_amdgcn_fence(__ATOMIC_RELEASE, "agent");
            asm volatile("s_waitcnt vmcnt(0)" ::: "memory");
            const unsigned og = xb_add(&bar[XB_TOP], 1u);
            const unsigned tg = og / nx;
            if (og + 1u == (tg + 1u) * nx) xb_add(&bar[XB_TOPGEN], 1u);
            else XB_SPIN(xb_ld(&bar[XB_TOPGEN]) == tg, bar);
            __builtin_amdgcn_fence(__ATOMIC_ACQUIRE, "agent");
            xb_add(&bar[XB_XGEN(b.x)], 1u);
            asm volatile("s_waitcnt vmcnt(0)" ::: "memory");
        } else {
            XB_SPIN(xb_ld(&bar[XB_XGEN(b.x)]) == gen, bar);
            __builtin_amdgcn_fence(__ATOMIC_ACQUIRE, "agent");
            asm volatile("s_waitcnt vmcnt(0)" ::: "memory");
        }
    }
    __syncthreads();
}

template <int DQK, int DV, int MODE>
__device__ __forceinline__ void att_call(bool strip, LAS unsigned char* lds, const bf16* Qb, int qpitch, const bf16* Kb, int kpitch, const bf16* VTb, int skv, const unsigned* maskb, const bf16* Zb, bf16* Ob, int q0) {
    if (ATT_STRIP != 0 && strip) attn_unit<DQK, DV, MODE, ATT_STRIP>(lds, Qb, qpitch, Kb, kpitch, VTb, skv, maskb, Zb, Ob, q0);
    else attn_unit<DQK, DV, MODE, 0>(lds, Qb, qpitch, Kb, kpitch, VTb, skv, maskb, Zb, Ob, q0);
}
struct Args { const float* in[19]; const int* pos; float* out; unsigned char* ws; };
typedef const __attribute__((address_space(4))) Args* kargs_t;
#define PHASE_BEGIN \
    kargs_t ap_ = (kargs_t)__builtin_amdgcn_kernarg_segment_ptr(); asm volatile("" : "+s"(ap_)); \
    int tid = threadIdx.x; asm volatile("" : "+v"(tid)); \
    const int lane = tid & 63, wave = __builtin_amdgcn_readfirstlane(tid >> 6), G = gridDim.x, NGW = G * 8, gw = blockIdx.x * 8 + wave; \
    unsigned char* const ws = ap_->ws; unsigned char* const dob = (unsigned char*)ap_->out; const int* const pos = ap_->pos; float* const outp = ap_->out; unsigned* const ctl = (unsigned*)(ws + WS_CTL); \
    const float* const x = ap_->in[0]; const float* const mem = ap_->in[1]; \
    const float* const g_norm = ap_->in[3]; const float* const w_in = ap_->in[4]; const float* const g_qn_a = ap_->in[5]; const float* const g_kn_a = ap_->in[6]; \
    const float* const g_cq = ap_->in[7]; const float* const g_ckv = ap_->in[8]; const float* const w_uq = ap_->in[9]; const float* const w_ukv = ap_->in[10]; \
    const float* const g_qn_b = ap_->in[11]; const float* const g_kn_b = ap_->in[12]; const float* const g_mem = ap_->in[13]; const float* const w_mem_kv = ap_->in[14]; \
    const float* const g_qn_m = ap_->in[15]; const float* const g_kn_m = ap_->in[16]; const float* const w_branch = ap_->in[17]; const float* const w_out = ap_->in[18]; \
    bf16* const WinT = (bf16*)(ws + WS_WIN); bf16* const WuqT = (bf16*)(ws + WS_WUQ); bf16* const WukvT = (bf16*)(ws + WS_WUKV); bf16* const WmemT = (bf16*)(ws + WS_WMEM); \
    bf16* const WbrT = (bf16*)(ws + WS_WBR); bf16* const WoutT = (bf16*)(ws + WS_WOUT); \
    float* const ropeA = (float*)(ws + WS_ROPEA); float* const ropeB = (float*)(ws + WS_ROPEB); \
    bf16* const MN = (bf16*)(ws + WS_MN); bf16* const KVM = (bf16*)(ws + WS_KVM); bf16* const VTM = (bf16*)(ws + WS_VTM); \
    float* const WI = (float*)(ws + WS_WI); unsigned* const MASK = (unsigned*)(ws + WS_MASK); \
    bf16* const VTA = (bf16*)(dob + DO_VTA); bf16* const VTB = (bf16*)(dob + DO_VTB); bf16* const KB = (bf16*)(dob + DO_KB); \
    bf16* const Hh = (bf16*)(ws + WS_H); bf16* const MG = (bf16*)(ws + WS_H); bf16* const QB = (bf16*)(ws + WS_QB); \
    bf16* const KVB = (bf16*)(ws + WS_KVB); bf16* const GT0 = (bf16*)(dob + DO_G0); bf16* const GT1 = (bf16*)(ws + WS_G1); bf16* const P = (bf16*)(ws + WS_P); \
    (void)lane; (void)NGW; (void)gw; (void)ctl; \
    (void)pos; (void)outp; (void)x; (void)mem; (void)g_norm; (void)w_in; (void)g_qn_a; (void)g_kn_a; (void)g_cq; (void)g_ckv; (void)w_uq; (void)w_ukv; (void)g_qn_b; (void)g_kn_b; (void)g_mem; (void)w_mem_kv; \
    (void)g_qn_m; (void)g_kn_m; (void)w_branch; (void)w_out; (void)WinT; (void)WuqT; (void)WukvT; (void)WmemT; (void)WbrT; (void)WoutT; (void)ropeA; (void)ropeB; (void)MN; (void)KVM; (void)VTM; (void)WI; (void)MASK; \
    (void)VTA; (void)VTB; (void)Hh; (void)KB; (void)QB; (void)KVB; (void)MG; (void)GT0; (void)GT1; (void)P
#define GRID_BARRIER() do { kargs_t bp_ = (kargs_t)__builtin_amdgcn_kernarg_segment_ptr(); asm volatile("" : "+s"(bp_)); \
    XcdBarrier b_; b_.bar = (unsigned*)(bp_->ws + WS_CTL) + 4096; b_.x = xb_xcc_id(); b_.st = (volatile LAS unsigned*)(lds + LDS_BYTES - 32); xcd_barrier(b_); } while (0)

__global__ void __launch_bounds__(512, 2) fwd_kernel(Args a) {
    extern __shared__ __attribute__((aligned(16))) unsigned char lds_raw[];
    LAS unsigned char* const lds = (LAS unsigned char*)lds_raw;
    volatile LAS int* const slot = (volatile LAS int*)(lds + LDS_SLOT);
    if (threadIdx.x < 16) ((LAS unsigned*)(lds + LDS_BYTES - 64))[threadIdx.x] = 0u;
    __syncthreads();
    (void)xcd_barrier_post((unsigned*)(a.ws + WS_CTL) + 4096, (volatile LAS unsigned*)(lds + LDS_BYTES - 32));

    for (int rep = 0; rep < REP_P0; ++rep) { PHASE_BEGIN;
        LAS float* scr = (LAS float*)(lds + wave * 16384);
        constexpr int I_IN = 16 * (NP / 32), I_UQ = 6 * 24, I_UKV = 4 * 32, I_MEM = 16 * 32, I_BR = 8 * 32, I_OUT = 16 * 32;
        constexpr int NITEMS = I_IN + I_UQ + I_UKV + I_MEM + 3 * I_BR + I_OUT;
        for (int it = gw; it < NITEMS; it += NGW) {
            int r = it;
            if (r < I_IN) { transpose_item<true>(w_in, 1024, DIN, NP, WinT, scr, r, lane); continue; } r -= I_IN;
            if (r < I_UQ) { transpose_item<false>(w_uq, 384, 768, 768, WuqT, scr, r, lane); continue; } r -= I_UQ;
            if (r < I_UKV) { transpose_item<false>(w_ukv, 256, 1024, 1024, WukvT, scr, r, lane); continue; } r -= I_UKV;
            if (r < I_MEM) { transpose_item<false>(w_mem_kv, 1024, 1024, 1024, WmemT, scr, r, lane); continue; } r -= I_MEM;
            if (r < 3 * I_BR) { const int nb = r / I_BR; transpose_item<false>(w_branch + (size_t)nb * 512 * 1024, 512, 1024, 1024, WbrT + (size_t)nb * 1024 * 512, scr, r % I_BR, lane); continue; } r -= 3 * I_BR;
            transpose_item<false>(w_out, 1024, 1024, 1024, WoutT, scr, r, lane);
        }
        for (int idx = blockIdx.x * 512 + tid; idx < TT * 24; idx += G * 512) {
            const int t = idx / 24, i = idx % 24; const float pf = (float)pos[t];
            if (i < 8) { const float ang = pf * INVA[i]; ropeA[t * 16 + i] = cosf(ang); ropeA[t * 16 + 8 + i] = sinf(ang); }
            else { const int j = i - 8; const float ang = pf * INVB[j]; ropeB[t * 32 + j] = cosf(ang); ropeB[t * 32 + 16 + j] = sinf(ang); }
        }
        for (int m = gw; m < NB * MEML; m += NGW) rms_row_1024(mem + (size_t)m * DM, g_mem, MN + (size_t)m * DM, lane);
        for (int rp = 0; rp < REP_PH; ++rp)
        for (int m = gw; m < TT; m += NGW) rms_row_1024(x + (size_t)m * DM, g_norm, Hh + (size_t)m * DM, lane);
    }
    GRID_BARRIER();
    for (int es = 0; es < EXTRA_SYNCS; ++es) GRID_BARRIER();

    for (int rep = 0; rep < REP_G1; ++rep) { PHASE_BEGIN;
        pg8::Gemm g{Hh, WinT, TT, PP, 1024, 1024}; pg8::StaticOrder S; S.init(TT, PP, G, (int)blockIdx.x);
        pg8::EpiBf16<0> E{P, PP, nullptr, 0, 0, 1.f};
        pg8::gemm_phase<pg8::EpiBf16<0>, pg8::StaticOrder, true, true>(lds, g, S, E);
    }
    { PHASE_BEGIN;
        pg8::Gemm g{MN, WmemT, NB * MEML, 1024, 1024, 1024}; pg8::StaticOrder S; S.init(NB * MEML, 1024, G, (int)((blockIdx.x + 64) % G));
        pg8::EpiBf16<0> E{KVM, 1024, nullptr, 0, 0, 1.f};
        pg8::gemm_phase<pg8::EpiBf16<0>, pg8::StaticOrder, true, true>(lds, g, S, E);
    }
    GRID_BARRIER();
    { PHASE_BEGIN;
        float ga[8], gk[8], gq[8], gc[8], gm[8];
#pragma unroll
        for (int j = 0; j < 8; ++j) { ga[j] = g_qn_a[8 * (lane & 7) + j]; gk[j] = g_kn_a[8 * (lane & 7) + j]; gm[j] = g_qn_m[8 * (lane & 15) + j]; gq[j] = lane < 48 ? g_cq[8 * lane + j] : 0.f; gc[j] = lane < 32 ? g_ckv[8 * lane + j] : 0.f; }
        for (int dp = 0; dp < DUMMY_POST1; ++dp)
            for (int m = gw; m < TT; m += NGW)
                post1_row(P + (size_t)m * PP, QB + (size_t)(m & 1023) * 4096, ropeA + (size_t)m * 16, ga, gk, gq, gc, gm, (float*)KVB + (size_t)m * 8, lane);
        for (int m = gw; m < TT; m += NGW)
            post1_row(P + (size_t)m * PP, P + (size_t)m * PP, ropeA + (size_t)m * 16, ga, gk, gq, gc, gm, WI + (size_t)m * 8, lane);
        for (int rt = 0; rt < REP_TR; ++rt)
        transpose_v(P, PP, C_VA, 64, 8, 64, SEQ, NB, VTA, gw, NGW, lane);
        for (int m = gw; m < NB * MEML; m += NGW) km_row(KVM + (size_t)m * 1024, g_kn_m, lane);
        for (int rt = 0; rt < REP_TR; ++rt)
        transpose_v(KVM, 1024, 512, 128, 4, 128, MEML, NB, VTM, gw, NGW, lane);
    }
    GRID_BARRIER();
    for (int rep = 0; rep < REP_G2; ++rep) { PHASE_BEGIN;
        pg8::Gemm g{P + C_CQ, WuqT, TT, 768, 384, PP}; pg8::StaticOrder S; S.init(TT, 768, G, (int)blockIdx.x);
        pg8::EpiBf16<0> E{QB, 768, nullptr, 0, 0, 1.f};
        pg8::gemm_phase<pg8::EpiBf16<0>, pg8::StaticOrder, true, true>(lds, g, S, E);
    }
    for (int rep = 0; rep < REP_G2; ++rep) { PHASE_BEGIN;
        pg8::Gemm g{P + C_CKV, WukvT, TT, 1024, 256, PP}; pg8::StaticOrder S; S.init(TT, 1024, G, (int)((blockIdx.x + 192) % G));
        pg8::EpiBf16<0> E{KVB, 1024, nullptr, 0, 0, 1.f};
        pg8::gemm_phase<pg8::EpiBf16<0>, pg8::StaticOrder, true, true>(lds, g, S, E);
    }
    for (int rep = 0; rep < REP_IDX; ++rep) { if (rep > 0) GRID_BARRIER();
        PHASE_BEGIN;
        unsigned* const q_idx = ctl + 64 * (0 + 4 * rep);
        for (;;) {
            const int u = next_unit(q_idx, slot);
            if (u >= NB * 128) break;
            const int tb = 127 - (u >> 3), bb = u & 7;
            indexer_unit((LAS float*)lds, P, WI, MASK, bb, tb);
        }
    }
    GRID_BARRIER();
    { PHASE_BEGIN;
        LAS float* scr = (LAS float*)(lds + wave * 8192);
        float gqv[12], gkv[12];
#pragma unroll
        for (int e = 0; e < 12; ++e) { gqv[e] = g_qn_b[12 * (lane & 7) + e]; gkv[e] = g_kn_b[12 * (lane & 7) + e]; }
        for (int dp = 0; dp < DUMMY_POST2; ++dp)
            for (int m = gw; m < TT; m += NGW)
                post2_row(QB + (size_t)m * 768, (bf16*)MASK + (size_t)(m & 1023) * 768, KVB + (size_t)m * 1024, P + (size_t)m * PP, (bf16*)MASK + (size_t)(1024 + (m & 1023)) * 768, ropeB + (size_t)m * 32, gqv, gkv, scr, lane);
        for (int m = gw; m < TT; m += NGW)
            post2_row(QB + (size_t)m * 768, QB + (size_t)m * 768, KVB + (size_t)m * 1024, P + (size_t)m * PP, KB + (size_t)m * 768, ropeB + (size_t)m * 32, gqv, gkv, scr, lane);
        for (int rt = 0; rt < REP_TR; ++rt)
        transpose_v(KVB, 1024, 64, 128, 8, 64, SEQ, NB, VTB, gw, NGW, lane);
    }
    GRID_BARRIER();
    for (int rep = 0; rep < REP_ATT; ++rep) { if (rep > 0) GRID_BARRIER();
        PHASE_BEGIN;
        unsigned* const q_att = ctl + 64 * (1 + 4 * rep);
        for (;;) {
            const int u = next_unit(q_att, slot);
            if (u >= 1280) break;
            if (u < 1024) {
                const int qb = 7 - (u >> 7), wi = u & 127, bh = wi & 63, bb = bh >> 3, h = bh & 7;
                const size_t r0 = (size_t)bb * SEQ;
                if (wi < 64) att_call<96, 64, 1>(rep == 0 && REP_ATT > 1, lds, QB + r0 * 768 + h * 96, 768, KB + r0 * 768 + h * 96, 768, VTB + (size_t)((bb * 8 + h) * 64) * SEQ, SEQ, nullptr,
                                                  nullptr, P + r0 * PP + C_YB + h * 64, qb * 256);
                else att_call<64, 64, 2>(rep == 0 && REP_ATT > 1, lds, P + r0 * PP + C_QA + h * 64, PP, P + r0 * PP + C_KA + h * 64, PP, VTA + (size_t)((bb * 8 + h) * 64) * SEQ, SEQ, MASK + r0 * 64,
                                          nullptr, P + r0 * PP + C_YA + h * 64, qb * 256);
            } else {
                const int v = u - 1024, qb = v & 7, bh = v >> 3, bb = bh >> 2, h = bh & 3;
                const size_t r0 = (size_t)bb * SEQ;
                att_call<128, 128, 0>(rep == 0 && REP_ATT > 1, lds, P + r0 * PP + C_QM + h * 128, PP, KVM + (size_t)bb * MEML * 1024 + h * 128, 1024, VTM + (size_t)((bb * 4 + h) * 128) * MEML, MEML, nullptr,
                                       P + r0 * PP + C_ZM + h * 128, P + r0 * PP + C_YM + h * 128, qb * 256);
            }
        }
    }
    GRID_BARRIER();
    for (int rep = 0; rep < 1; ++rep) { PHASE_BEGIN;
        pg8::Gemm g{Hh, WinT + (size_t)PP * 1024, TT, NZG, 1024, 1024}; pg8::StaticOrder S; S.init(TT, NZG, G, (int)blockIdx.x);
        EpiZG E{P, GT0, GT1};
        pg8::gemm_phase<EpiZG, pg8::StaticOrder, true, true>(lds, g, S, E);
    }
    GRID_BARRIER();
    for (int nbr = 0; nbr < 3 * REP_G4; ++nbr) { const int nb = nbr % 3; PHASE_BEGIN;
        pg8::Gemm g{P + (nb == 0 ? C_YA : (nb == 1 ? C_YB : C_YM)), WbrT + (size_t)nb * 1024 * 512, TT, 1024, 512, PP}; pg8::StaticOrder S; S.init(TT, 1024, G, (int)blockIdx.x);
        EpiMerge E{MG, GT0, GT1, nb};
        pg8::gemm_phase<EpiMerge, pg8::StaticOrder, true, true>(lds, g, S, E);
    }
    GRID_BARRIER();
    for (int rep = 0; rep < REP_G5; ++rep) { PHASE_BEGIN;
        pg8::Gemm g{MG, WoutT, TT, 1024, 1024, 1024}; pg8::StaticOrder S; S.init(TT, 1024, G, (int)blockIdx.x);
        EpiOut E{x, outp};
        pg8::gemm_phase<EpiOut, pg8::StaticOrder, true, true>(lds, g, S, E);
    }
}

extern "C" void kernel_launch(void* const* d_in, const int* in_sizes, int n_in, void* d_out, int out_size, void* d_ws, size_t ws_size, hipStream_t stream) {
    static int grid = 0;
    if (grid == 0) {
        if (n_in != 19 || out_size != TT * DM || ws_size < WS_END) { fprintf(stderr, "kernel_launch: unexpected problem (n_in %d, out %d, ws %zu); nothing launched\n", n_in, out_size, ws_size); grid = -1; return; }
        int dev = 0, cus = 0, per_cu = 0;
        if (hipGetDevice(&dev) != hipSuccess || hipDeviceGetAttribute(&cus, hipDeviceAttributeMultiprocessorCount, dev) != hipSuccess) { grid = -1; return; }
        if (hipFuncSetAttribute((const void*)fwd_kernel, hipFuncAttributeMaxDynamicSharedMemorySize, LDS_BYTES) != hipSuccess) { fprintf(stderr, "kernel_launch: hipFuncSetAttribute failed\n"); grid = -1; return; }
        if (hipOccupancyMaxActiveBlocksPerMultiprocessor(&per_cu, (const void*)fwd_kernel, 512, LDS_BYTES) != hipSuccess || per_cu < 1) { fprintf(stderr, "kernel_launch: occupancy query reports %d blocks per CU\n", per_cu); (void)hipGetLastError(); grid = -1; return; }
        grid = cus;
    }
    if (grid < 0) return;
    (void)hipMemsetAsync((char*)d_ws + WS_CTL, 0, 65536, stream);
    Args a{};
    for (int i = 0; i < 19; ++i) a.in[i] = (const float*)d_in[i];
    a.pos = (const int*)d_in[2]; a.out = (float*)d_out; a.ws = (unsigned char*)d_ws;
    hipLaunchKernelGGL(fwd_kernel, dim3(grid), dim3(512), LDS_BYTES, stream, a);
    const hipError_t e = hipPeekAtLastError();
    if (e != hipSuccess) fprintf(stderr, "kernel_launch: launch failed: %s (grid %d)\n", hipGetErrorString(e), grid);
}
```

```cpp
#include <hip/hip_runtime.h>
#include <cstdio>
#include <cstdint>
namespace pg8 {
#define PG8_LAS __attribute__((address_space(3)))
typedef unsigned short bf16_t;
typedef short bf16x8 __attribute__((ext_vector_type(8)));
typedef float f32x4 __attribute__((ext_vector_type(4)));
typedef unsigned u32x4 __attribute__((ext_vector_type(4)));
constexpr int BM = 256, BK = 64, HALF = 128, HTB = HALF * BK * 2  , STAGE_BYTES = 8 * HTB, NXCD = 8, WGM = 8;

__host__ __device__ __forceinline__ int lds_byte(int r, int c) { const int st = (r >> 4) * 2 + (c >> 5), rr = r & 15, cc = c & 31, ob = rr * 64 + cc * 2; return st * 1024 + (ob ^ (((ob >> 9) & 1) << 5)); }
__host__ __device__ __forceinline__ void stage_rc(int b, int& R, int& C) { const int st = b / 1024, sb = b % 1024, swz = sb ^ (((sb >> 9) & 1) << 5); R = (st >> 1) * 16 + swz / 64; C = (st & 1) * 32 + (swz % 64) / 2; }
__host__ __device__ __forceinline__ int perm32(int rho) { const int n = rho >> 4, i = rho & 15; return 8 * (i >> 2) + 4 * n + (i & 3); }

struct Unit { int pm, pn; };
struct Gemm { const bf16_t* A; const bf16_t* Bt; int M, N, K, lda; };

struct StaticOrder {
    int nM, nN, nwg, G, c;
    __host__ __device__ void init(int M, int N, int G_, int c_) { nM = M / BM; nN = N / BM; nwg = nM * nN; G = G_; c = c_; }
    __host__ __device__ bool next(int i, Unit& u) const {
        const long L = (long)i * G + c; if (L >= nwg) return false;
        int wgid = (int)L; { const int q = nwg / NXCD, r = nwg % NXCD, xcd = wgid % NXCD, off = wgid / NXCD; wgid = (xcd < r ? xcd * (q + 1) : r * (q + 1) + (xcd - r) * q) + off; }
        const int nig = WGM * nN, gid = wgid / nig, fm = gid * WGM, gsz = (nM - fm) < WGM ? (nM - fm) : WGM;
        u.pm = fm + ((wgid % nig) % gsz); u.pn = (wgid % nig) / gsz; return true;
    }
    __device__ __forceinline__ void a_ready(const Unit&) const {}
    __device__ __forceinline__ void done(const Unit&) const {}
};

__device__ __forceinline__ unsigned cvt_pk_bf16(float lo, float hi) { unsigned r; asm volatile("v_cvt_pk_bf16_f32 %0, %1, %2" : "=v"(r) : "v"(lo), "v"(hi)); return r; }
typedef float f32x2 __attribute__((ext_vector_type(2)));
__device__ __forceinline__ f32x2 gelu_pk(f32x2 v) {
    const f32x2 av = __builtin_elementwise_abs(v), d = av * 0.2316418882f + 1.0f;
    f32x2 t; t.x = __builtin_amdgcn_rcpf(d.x); t.y = __builtin_amdgcn_rcpf(d.y);
    f32x2 q = t * 0.5307027145f + (-0.7265760135f); q = q * t + 0.7107068705f; q = q * t + (-0.142248368f); q = q * t + 0.127414796f; q = q * t;
    const f32x2 s = (v * v) * (-0.72134752044f);
    f32x2 e; e.x = __builtin_amdgcn_exp2f(s.x); e.y = __builtin_amdgcn_exp2f(s.y);
    const f32x2 m = v * (q * e), r = v - m;
    f32x2 o; o.x = v.x < 0.f ? m.x : r.x; o.y = v.y < 0.f ? m.y : r.y; return o;
}

template <int ACT  > struct EpiBf16 {
    static constexpr bool PERM = true, AFTER_DRAIN = false; static_assert(ACT == 0 || ACT == 1, "EpiBf16: ACT is 0 (none) or 1 (gelu_pk)");
    bf16_t* O; int ldc; const float* bias; int split_cols; size_t split_stride; float scale0;
    __device__ __forceinline__ void operator()(const f32x4 (&acc)[2][2][4][2], const Unit& u, int wr, int wc, int fr, int fq) const {
        const int row0 = u.pm * BM + wr * 64 + fr; int colt = u.pn * BM; bf16_t* base = O;
        float sc = 1.f; if (split_cols) { const int t = colt / split_cols; base += (size_t)t * split_stride; colt -= t * split_cols; if (t == 0) sc = scale0; }
        const int col0 = colt + wc * 32 + 8 * fq, bcol0 = u.pn * BM + wc * 32 + 8 * fq;
        f32x4 bv[2][2];
#pragma unroll
        for (int bj = 0; bj < 2; ++bj)
#pragma unroll
            for (int n = 0; n < 2; ++n) bv[bj][n] = bias ? *(const f32x4*)(bias + bcol0 + bj * HALF + 4 * n) : (f32x4){0.f, 0.f, 0.f, 0.f};
#pragma unroll
        for (int ai = 0; ai < 2; ++ai)
#pragma unroll
            for (int m = 0; m < 4; ++m) { bf16_t* rowp = base + (size_t)(row0 + ai * HALF + m * 16) * ldc + col0;
#pragma unroll
                for (int bj = 0; bj < 2; ++bj) { f32x4 v0 = acc[ai][bj][m][0] + bv[bj][0], v1 = acc[ai][bj][m][1] + bv[bj][1];
                    if (ACT == 1) { f32x2 a = gelu_pk((f32x2){v0[0], v0[1]}), b = gelu_pk((f32x2){v0[2], v0[3]}), c = gelu_pk((f32x2){v1[0], v1[1]}), d = gelu_pk((f32x2){v1[2], v1[3]});
                        v0 = (f32x4){a.x, a.y, b.x, b.y}; v1 = (f32x4){c.x, c.y, d.x, d.y}; }
                    v0 = v0 * sc; v1 = v1 * sc; u32x4 w; w.x = cvt_pk_bf16(v0[0], v0[1]); w.y = cvt_pk_bf16(v0[2], v0[3]); w.z = cvt_pk_bf16(v1[0], v1[1]); w.w = cvt_pk_bf16(v1[2], v1[3]);
                    *(u32x4*)(rowp + bj * HALF) = w; } }
    }
};
template <class Epi, class Sched, bool ALIGN_EPI = false, bool SP2 = false>
__device__ __forceinline__ void gemm_phase(PG8_LAS unsigned char* lds, const Gemm g, const Sched& S, const Epi& E) {
    int tid_ = threadIdx.x; asm volatile("" : "+v"(tid_));
    const int tid = tid_, wid = __builtin_amdgcn_readfirstlane(tid >> 6), lane = tid & 63, wr = wid >> 2, wc = wid & 3, fr = lane & 15, fq = lane >> 4;
    const int K = g.K, nt = K / BK;
    unsigned voffA[2], voffB[2];
#pragma unroll
    for (int i = 0; i < 2; ++i) { int R, C; stage_rc(tid * 16 + i * 8192, R, C); const int Rb = Epi::PERM ? ((R & ~31) + perm32(R & 31)) : R;
        voffA[i] = (unsigned)(R * g.lda + C) * 2u; voffB[i] = (unsigned)(Rb * K + C) * 2u; }
    const size_t kstep = (size_t)(BK * 2);
    const size_t hstepA = (size_t)HALF * g.lda * 2, hstepB = (size_t)HALF * K * 2;
    const size_t tstepA = 2 * hstepA, tstepB = 2 * hstepB;
    const unsigned ldsw = (unsigned)wid * 1024u;
    const int aoff = lds_byte(wr * 64 + fr, fq * 8), boff = lds_byte(wc * 32 + fr, fq * 8);
#define PG8_SA(b, h) (((b) * 2 + (h)) * HTB)
#define PG8_SB(b, h) ((4 + (b) * 2 + (h)) * HTB)
#define PG8_STAGE(bufoff, gbase, voff) do { _Pragma("unroll") for (int _i = 0; _i < 2; ++_i) \
        __builtin_amdgcn_global_load_lds((const unsigned*)((const char*)(gbase) + (voff)[_i]), (PG8_LAS unsigned*)(lds + (bufoff) + ldsw + _i * 8192), 16, 0, 0); } while (0)
#define PG8_LDA(dst, b, h) do { _Pragma("unroll") for (int m = 0; m < 4; ++m) _Pragma("unroll") for (int k = 0; k < 2; ++k) dst[m][k] = *(const PG8_LAS bf16x8*)(lds + PG8_SA(b, h) + aoff + m * 2048 + k * 1024); } while (0)
#define PG8_LDB(dst, b, h) do { _Pragma("unroll") for (int n = 0; n < 2; ++n) _Pragma("unroll") for (int k = 0; k < 2; ++k) dst[n][k] = *(const PG8_LAS bf16x8*)(lds + PG8_SB(b, h) + boff + n * 2048 + k * 1024); } while (0)
#define PG8_MMA(ai, bj, At, Bt) do { __builtin_amdgcn_s_setprio(1); _Pragma("unroll") for (int m = 0; m < 4; ++m) _Pragma("unroll") for (int n = 0; n < 2; ++n) _Pragma("unroll") for (int k = 0; k < 2; ++k) \
        acc[ai][bj][m][n] = __builtin_amdgcn_mfma_f32_16x16x32_bf16(Bt[n][k], At[m][k], acc[ai][bj][m][n], 0, 0, 0); __builtin_amdgcn_s_setprio(0); } while (0)
#define PG8_WAIT_V(n) asm volatile("s_waitcnt vmcnt(" #n ")" ::: "memory")
#define PG8_WAIT_L(n) asm volatile("s_waitcnt lgkmcnt(" #n ")" ::: "memory")
#define PG8_BAR __builtin_amdgcn_s_barrier()
#define PG8_SCHED __builtin_amdgcn_sched_barrier(0)
    Unit cur, nxt; int ui = 0;
    if (!S.next(0, cur)) return;
    f32x4 acc[2][2][4][2];
#pragma unroll
    for (int a = 0; a < 2; ++a)
#pragma unroll
        for (int b = 0; b < 2; ++b)
#pragma unroll
            for (int m = 0; m < 4; ++m)
#pragma unroll
                for (int n = 0; n < 2; ++n) acc[a][b][m][n] = (f32x4){0.f, 0.f, 0.f, 0.f};
    bf16x8 At[4][2], B0[2][2], B1[2][2];
    const char* cA = (const char*)g.A + (size_t)cur.pm * tstepA; const char* cB = (const char*)g.Bt + (size_t)cur.pn * tstepB;
    S.a_ready(cur);
    if constexpr (SP2) {
        PG8_STAGE(PG8_SB(0, 0), cB, voffB); PG8_STAGE(PG8_SB(0, 1), cB + hstepB, voffB); PG8_STAGE(PG8_SA(0, 0), cA, voffA); PG8_STAGE(PG8_SA(0, 1), cA + hstepA, voffA);
        if (wr == 1) PG8_BAR;
        PG8_WAIT_V(2); PG8_BAR;
        PG8_STAGE(PG8_SB(1, 0), cB + kstep, voffB); PG8_STAGE(PG8_SA(1, 0), cA + kstep, voffA); PG8_STAGE(PG8_SB(1, 1), cB + hstepB + kstep, voffB);
        PG8_WAIT_V(6); PG8_BAR;
    } else {
        PG8_STAGE(PG8_SB(0, 0), cB, voffB); PG8_STAGE(PG8_SA(0, 0), cA, voffA); PG8_STAGE(PG8_SB(0, 1), cB + hstepB, voffB); PG8_STAGE(PG8_SA(0, 1), cA + hstepA, voffA);
        if (wr == 1) PG8_BAR;
        PG8_WAIT_V(4); PG8_BAR;
        PG8_STAGE(PG8_SB(1, 0), cB + kstep, voffB); PG8_STAGE(PG8_SA(1, 0), cA + kstep, voffA); PG8_STAGE(PG8_SB(1, 1), cB + hstepB + kstep, voffB);
        PG8_WAIT_V(6); PG8_BAR;
    }
    for (;;) {
        const bool has_next = S.next(ui + 1, nxt);
        const char* nA = has_next ? (const char*)g.A + (size_t)nxt.pm * tstepA : cA; const char* nB = has_next ? (const char*)g.Bt + (size_t)nxt.pn * tstepB : cB;
        for (int t = 0; t < nt; t += 2) {
            const bool last = (t == nt - 2);
            const char* a1 = cA + (size_t)(t + 1) * kstep;
            const char* a2 = last ? nA : cA + (size_t)(t + 2) * kstep; const char* b2 = last ? nB : cB + (size_t)(t + 2) * kstep;
            const char* a3 = a2 + kstep; const char* b3 = b2 + kstep;
            if (last && has_next) S.a_ready(nxt);
            if constexpr (SP2) {
            PG8_LDB(B0, 0, 0); PG8_LDB(B1, 0, 1); PG8_SCHED; PG8_LDA(At, 0, 0); PG8_STAGE(PG8_SA(1, 1), a1 + hstepA, voffA);
            PG8_WAIT_V(8); PG8_WAIT_L(0); PG8_BAR; PG8_MMA(0, 0, At, B0); PG8_MMA(0, 1, At, B1); PG8_BAR; PG8_SCHED;
            PG8_LDA(At, 0, 1); PG8_STAGE(PG8_SB(0, 0), b2, voffB); PG8_STAGE(PG8_SB(0, 1), b2 + hstepB, voffB); PG8_STAGE(PG8_SA(0, 0), a2, voffA);
            PG8_WAIT_V(8); PG8_WAIT_L(0); PG8_BAR; PG8_MMA(1, 0, At, B0); PG8_MMA(1, 1, At, B1); PG8_BAR; PG8_SCHED;
            PG8_LDB(B0, 1, 0); PG8_LDB(B1, 1, 1); PG8_SCHED; PG8_LDA(At, 1, 0); PG8_STAGE(PG8_SA(0, 1), a2 + hstepA, voffA);
            PG8_WAIT_V(8); PG8_WAIT_L(0); PG8_BAR; PG8_MMA(0, 0, At, B0); PG8_MMA(0, 1, At, B1); PG8_BAR; PG8_SCHED;
            PG8_LDA(At, 1, 1); PG8_STAGE(PG8_SB(1, 0), b3, voffB); PG8_STAGE(PG8_SB(1, 1), b3 + hstepB, voffB); PG8_STAGE(PG8_SA(1, 0), a3, voffA);
            PG8_WAIT_V(8); PG8_WAIT_L(0); PG8_BAR; PG8_MMA(1, 0, At, B0); PG8_MMA(1, 1, At, B1); PG8_BAR; PG8_SCHED;
            } else {
            PG8_LDB(B0, 0, 0); PG8_SCHED; PG8_LDA(At, 0, 0); PG8_STAGE(PG8_SA(1, 1), a1 + hstepA, voffA);
            PG8_WAIT_L(8); PG8_BAR; PG8_WAIT_L(0); PG8_MMA(0, 0, At, B0); PG8_BAR; PG8_SCHED;
            PG8_LDB(B1, 0, 1); PG8_STAGE(PG8_SB(0, 0), b2, voffB);
            PG8_BAR; PG8_WAIT_L(0); PG8_MMA(0, 1, At, B1); PG8_BAR;
            PG8_LDA(At, 0, 1); PG8_STAGE(PG8_SA(0, 0), a2, voffA);
            PG8_BAR; PG8_WAIT_L(0); PG8_MMA(1, 0, At, B0); PG8_BAR; PG8_SCHED;
            PG8_STAGE(PG8_SB(0, 1), b2 + hstepB, voffB);
            PG8_WAIT_V(6); PG8_BAR; PG8_MMA(1, 1, At, B1); PG8_BAR;
            PG8_LDB(B0, 1, 0); PG8_SCHED; PG8_LDA(At, 1, 0); PG8_STAGE(PG8_SA(0, 1), a2 + hstepA, voffA);
            PG8_WAIT_L(8); PG8_BAR; PG8_WAIT_L(0); PG8_MMA(0, 0, At, B0); PG8_BAR; PG8_SCHED;
            PG8_LDB(B1, 1, 1); PG8_STAGE(PG8_SB(1, 0), b3, voffB);
            PG8_BAR; PG8_WAIT_L(0); PG8_MMA(0, 1, At, B1); PG8_BAR;
            PG8_LDA(At, 1, 1); PG8_STAGE(PG8_SA(1, 0), a3, voffA);
            PG8_BAR; PG8_WAIT_L(0); PG8_MMA(1, 0, At, B0); PG8_BAR; PG8_SCHED;
            PG8_STAGE(PG8_SB(1, 1), b3 + hstepB, voffB);
            PG8_WAIT_V(6); PG8_BAR; PG8_MMA(1, 1, At, B1); PG8_BAR;
            }
        }
        if constexpr (ALIGN_EPI) { if (wr == 0) PG8_BAR; }
        if constexpr (!Epi::AFTER_DRAIN) { E(acc, cur, wr, wc, fr, fq); S.done(cur); }
        if (!has_next) break;
#pragma unroll
        for (int a = 0; a < 2; ++a)
#pragma unroll
            for (int b = 0; b < 2; ++b)
#pragma unroll
                for (int m = 0; m < 4; ++m)
#pragma unroll
                    for (int n = 0; n < 2; ++n) acc[a][b][m][n] = (f32x4){0.f, 0.f, 0.f, 0.f};
        cur = nxt; cA = nA; cB = nB; ++ui;
        if constexpr (ALIGN_EPI) { if (wr == 1) PG8_BAR; }
    }
    PG8_WAIT_V(0);
    if constexpr (!ALIGN_EPI) { if (wr == 0) PG8_BAR; }
    PG8_BAR;
    if constexpr (Epi::AFTER_DRAIN) { E.fused(acc, cur, wr, wc, fr, fq, lds, wid, lane); S.done(cur); }
#undef PG8_SA
#undef PG8_SB
#undef PG8_STAGE
#undef PG8_LDA
#undef PG8_LDB
#undef PG8_MMA
#undef PG8_WAIT_V
#undef PG8_WAIT_L
#undef PG8_BAR
#undef PG8_SCHED
}
}

#define LAS __attribute__((address_space(3)))
typedef unsigned short bf16;
typedef unsigned v4u __attribute__((ext_vector_type(4)));
typedef unsigned v2u __attribute__((ext_vector_type(2)));
typedef float f32x4 __attribute__((ext_vector_type(4)));
typedef float f32x16 __attribute__((ext_vector_type(16)));
typedef short bf16x8 __attribute__((ext_vector_type(8)));
typedef short s16x4 __attribute__((ext_vector_type(4)));
typedef float f32x2_t __attribute__((ext_vector_type(2)));
typedef __bf16 bf16x2_t __attribute__((ext_vector_type(2)));

constexpr int NB = 8, SEQ = 2048, DM = 1024, TT = NB * SEQ;
constexpr int DIN = 7912, NP = 7936;
constexpr int PP = 3840, NZG = 4096;
constexpr int MEML = 256;
constexpr float EPS = 1e-6f, NEGF = -1e30f;
constexpr int C_QA = 0, C_KA = 512, C_VA = 1024, C_QI = 1536, C_KI = 2048, C_WI = 2112, C_CQ = 2120, C_CKV = 2504, C_KR = 2760, C_QM = 2792, C_ZM = 3304;
constexpr int C_YA = C_QI, C_YB = C_CQ, C_YM = C_VA;
constexpr float SCALE_A = 0.18033688011112042f;
constexpr float SCALE_B = 0.14724444602590306f;
constexpr float SCALE_M = 0.12751743082459868f;
constexpr float SCALE_I = 0.04419417382415922f;

__constant__ float INVA[8] = {1.0f, 0.1939227432012558f, 0.03760603070259094f, 0.007292664609849453f, 0.0014142135623842478f, 0.00027424818836152554f, 5.3182957344688475e-05f, 1.0313385246263351e-05f};
__constant__ float INVB[16] = {1.0f, 0.44036659598350525f, 0.1939227432012558f, 0.08539710193872452f, 0.03760603070259094f, 0.016560440883040428f, 0.007292664609849453f, 0.0032114461064338684f, 0.0014142135623842478f, 0.0006227724370546639f, 0.00027424818836152554f, 0.00012076973507646471f, 5.3182957344688475e-05f, 2.34199997066753e-05f, 1.0313385246263351e-05f, 4.541670477919979e-06f};

constexpr size_t MiB = 1u << 20;
constexpr size_t WS_CTL = 0;
constexpr size_t WS_WIN = 1 * MiB;
constexpr size_t WS_WUQ = 17 * MiB;
constexpr size_t WS_WUKV = 18 * MiB;
constexpr size_t WS_WMEM = 19 * MiB;
constexpr size_t WS_WBR = 21 * MiB;
constexpr size_t WS_WOUT = 24 * MiB;
constexpr size_t WS_ROPEA = 26 * MiB;
constexpr size_t WS_ROPEB = 27 * MiB;
constexpr size_t WS_MN = 29 * MiB;
constexpr size_t WS_KVM = 33 * MiB;
constexpr size_t WS_VTM = 37 * MiB;
constexpr size_t WS_WI = 39 * MiB;
constexpr size_t WS_MASK = 40 * MiB;
constexpr size_t WS_H = 44 * MiB;
constexpr size_t WS_P = 76 * MiB;
constexpr size_t WS_QB = 196 * MiB;
constexpr size_t WS_KVB = 220 * MiB;
constexpr size_t WS_G1 = 196 * MiB;
constexpr size_t WS_END = 256 * MiB;
constexpr size_t DO_VTA = 0;
constexpr size_t DO_VTB = 16 * MiB;
constexpr size_t DO_KB = 32 * MiB;
constexpr size_t DO_G0 = 0;

constexpr int REP_P0 = 1, REP_PH = 1, REP_G1 = 1, REP_G2 = 1, REP_IDX = 1, REP_ATT = 1, REP_G4 = 1, REP_G5 = 1;
constexpr int REP_IDX1 = 1, REP_SEL = 1;
constexpr int ATT_STRIP = 0;
constexpr int EXTRA_SYNCS = 0, REP_TR = 1, DUMMY_POST1 = 0, DUMMY_POST2 = 0;
constexpr int LDS_BYTES = 147456;
constexpr int LDS_SLOT = LDS_BYTES - 64;

__device__ __forceinline__ unsigned pk2(float lo, float hi) { f32x2_t v = {lo, hi}; bf16x2_t b = __builtin_convertvector(v, bf16x2_t); return __builtin_bit_cast(unsigned, b); }
__device__ __forceinline__ float bflo(unsigned w) { return __uint_as_float(w << 16); }
__device__ __forceinline__ float bfhi(unsigned w) { return __uint_as_float(w & 0xffff0000u); }
__device__ __forceinline__ float bf1(bf16 b) { return __uint_as_float(((unsigned)b) << 16); }
#define UNPACK8(W_, V_) do { V_[0] = bflo((W_)[0]); V_[1] = bfhi((W_)[0]); V_[2] = bflo((W_)[1]); V_[3] = bfhi((W_)[1]); V_[4] = bflo((W_)[2]); V_[5] = bfhi((W_)[2]); V_[6] = bflo((W_)[3]); V_[7] = bfhi((W_)[3]); } while (0)
#define PACK8(V_) (v4u){pk2(V_[0], V_[1]), pk2(V_[2], V_[3]), pk2(V_[4], V_[5]), pk2(V_[6], V_[7])}
__device__ __forceinline__ float wave_sum(float v) {
#pragma unroll
    for (int o = 1; o < 64; o <<= 1) v += __shfl_xor(v, o);
    return v;
}
#define LDS_WAIT() asm volatile("s_waitcnt lgkmcnt(0)" ::: "memory")

__device__ __forceinline__ int win_src(int d) {
    if (d < 2120) return d;
    if (d < 2792) return d + 512;
    if (d < 3816) return d + 1024;
    if (d < 3840) return -1;
    if (d < 4352) return d - 3840 + 2120;
    if (d < 4864) return d - 4352 + 3304;
    return d - 4864 + 4840;
}
template <bool REMAP>
__device__ __forceinline__ void transpose_item(const float* W, int K, int N, int Npad, bf16* WT, LAS float* scr, int item, int lane) {
    const int nblk = Npad / 32, kb = item / nblk, nb = item % nblk, k0 = 64 * kb, n0 = 32 * nb;
    const int n4 = 4 * (lane & 7);
    const int nn = REMAP ? win_src(n0 + n4) : n0 + n4; const bool ok = nn >= 0 && nn < N;
#pragma unroll
    for (int i = 0; i < 8; ++i) { const int kk = 8 * i + (lane >> 3);
        f32x4 v = (f32x4){0.f, 0.f, 0.f, 0.f}; if (ok) v = *(const f32x4*)(W + (size_t)(k0 + kk) * N + nn);
        LAS float* d = scr + kk * 33 + n4; d[0] = v[0]; d[1] = v[1]; d[2] = v[2]; d[3] = v[3]; }
    LDS_WAIT(); asm volatile("" ::: "memory");
    const int c = lane & 7;
#pragma unroll
    for (int j = 0; j < 4; ++j) { const int n = (lane >> 3) + 8 * j; const LAS float* s = scr + (8 * c) * 33 + n;
        v4u o; o.x = pk2(s[0 * 33], s[1 * 33]); o.y = pk2(s[2 * 33], s[3 * 33]); o.z = pk2(s[4 * 33], s[5 * 33]); o.w = pk2(s[6 * 33], s[7 * 33]);
        *(v4u*)(WT + (size_t)(n0 + n) * K + k0 + 8 * c) = o; }
    LDS_WAIT(); asm volatile("" ::: "memory");
}
__device__ __forceinline__ void rms_row_1024(const float* xrow, const float* g, bf16* orow, int lane) {
    const f32x4* xr = (const f32x4*)xrow + lane; const f32x4* gr = (const f32x4*)g + lane;
    f32x4 v[4]; float s = 0.f;
#pragma unroll
    for (int j = 0; j < 4; ++j) { v[j] = xr[64 * j]; s += (v[j].x * v[j].x + v[j].y * v[j].y) + (v[j].z * v[j].z + v[j].w * v[j].w); }
    const float rstd = 1.0f / sqrtf(wave_sum(s) * (1.f / 1024.f) + EPS);
    v2u* o8 = (v2u*)orow + lane;
#pragma unroll
    for (int j = 0; j < 4; ++j) { const f32x4 gg = gr[64 * j]; v2u w; w.x = pk2(v[j].x * rstd * gg.x, v[j].y * rstd * gg.y); w.y = pk2(v[j].z * rstd * gg.z, v[j].w * rstd * gg.w); o8[64 * j] = w; }
}

#define ROPE8(v, sub, c8, s8) do { _Pragma("unroll") for (int j_ = 0; j_ < 8; ++j_) { const float pv_ = __shfl_xor(v[j_], 1); \
        const float r0_ = v[j_] * c8[j_] - pv_ * s8[j_], r1_ = v[j_] * c8[j_] + pv_ * s8[j_]; v[j_] = (sub) == 0 ? r0_ : ((sub) == 1 ? r1_ : v[j_]); } } while (0)

__device__ __forceinline__ void post1_row(const bf16* Prow, bf16* Orow, const float* ra, const float (&ga)[8], const float (&gk)[8], const float (&gq)[8], const float (&gc)[8], const float (&gm)[8], float* WIrow, int lane) {
    const int sub = lane & 7;
    const v4u z4 = (v4u){0u, 0u, 0u, 0u};
    const v4u w_qa = *(const v4u*)(Prow + C_QA + 8 * lane);
    const v4u w_ka = *(const v4u*)(Prow + C_KA + 8 * lane);
    const v4u w_qi = *(const v4u*)(Prow + C_QI + 8 * lane);
    const v4u w_qm = *(const v4u*)(Prow + C_QM + 8 * lane);
    v4u w_ki = z4, w_cq = z4, w_ckv = z4; float w_wi = 0.f;
    if (lane < 8) { w_ki = *(const v4u*)(Prow + C_KI + 8 * lane); w_wi = bf1(Prow[C_WI + lane]); }
    if (lane < 48) w_cq = *(const v4u*)(Prow + C_CQ + 8 * lane);
    if (lane < 32) w_ckv = *(const v4u*)(Prow + C_CKV + 8 * lane);
    float c8[8], s8[8];
    { const f32x4 r0 = *(const f32x4*)(ra), r1 = *(const f32x4*)(ra + 4), r2 = *(const f32x4*)(ra + 8), r3 = *(const f32x4*)(ra + 12);
      c8[0] = r0[0]; c8[1] = r0[1]; c8[2] = r0[2]; c8[3] = r0[3]; c8[4] = r1[0]; c8[5] = r1[1]; c8[6] = r1[2]; c8[7] = r1[3];
      s8[0] = r2[0]; s8[1] = r2[1]; s8[2] = r2[2]; s8[3] = r2[3]; s8[4] = r3[0]; s8[5] = r3[1]; s8[6] = r3[2]; s8[7] = r3[3]; }
    { float v[8]; UNPACK8(w_qa, v); float ss = 0.f;
#pragma unroll
      for (int j = 0; j < 8; ++j) ss += v[j] * v[j];
      ss += __shfl_xor(ss, 1); ss += __shfl_xor(ss, 2); ss += __shfl_xor(ss, 4);
      const float rstd = 1.0f / sqrtf(ss * (1.f / 64.f) + EPS);
#pragma unroll
      for (int j = 0; j < 8; ++j) v[j] = v[j] * rstd * ga[j];
      ROPE8(v, sub, c8, s8);
#pragma unroll
      for (int j = 0; j < 8; ++j) v[j] *= SCALE_A;
      *(v4u*)(Orow + C_QA + 8 * lane) = PACK8(v); }
    { float v[8]; UNPACK8(w_ka, v); float ss = 0.f;
#pragma unroll
      for (int j = 0; j < 8; ++j) ss += v[j] * v[j];
      ss += __shfl_xor(ss, 1); ss += __shfl_xor(ss, 2); ss += __shfl_xor(ss, 4);
      const float rstd = 1.0f / sqrtf(ss * (1.f / 64.f) + EPS);
#pragma unroll
      for (int j = 0; j < 8; ++j) v[j] = v[j] * rstd * gk[j];
      ROPE8(v, sub, c8, s8);
      *(v4u*)(Orow + C_KA + 8 * lane) = PACK8(v); }
    { float v[8]; UNPACK8(w_qi, v);
      ROPE8(v, sub, c8, s8);
      *(v4u*)(Orow + C_QI + 8 * lane) = PACK8(v); }
    { float v[8]; UNPACK8(w_ki, v);
      ROPE8(v, sub, c8, s8);
      if (lane < 8) *(v4u*)(Orow + C_KI + 8 * lane) = PACK8(v); }
    if (lane < 8) WIrow[lane] = w_wi * SCALE_I;
    { float v[8]; UNPACK8(w_cq, v); float ss = 0.f;
#pragma unroll
      for (int j = 0; j < 8; ++j) ss += v[j] * v[j];
      ss = wave_sum(ss); const float rstd = 1.0f / sqrtf(ss * (1.f / 384.f) + EPS);
      if (lane < 48) {
#pragma unroll
          for (int j = 0; j < 8; ++j) v[j] = v[j] * rstd * gq[j];
          *(v4u*)(Orow + C_CQ + 8 * lane) = PACK8(v); } }
    { float v[8]; UNPACK8(w_ckv, v); float ss = 0.f;
#pragma unroll
      for (int j = 0; j < 8; ++j) ss += v[j] * v[j];
      ss = wave_sum(ss); const float rstd = 1.0f / sqrtf(ss * (1.f / 256.f) + EPS);
      if (lane < 32) {
#pragma unroll
          for (int j = 0; j < 8; ++j) v[j] = v[j] * rstd * gc[j];
          *(v4u*)(Orow + C_CKV + 8 * lane) = PACK8(v); } }
    { float v[8]; UNPACK8(w_qm, v); float ss = 0.f;
#pragma unroll
      for (int j = 0; j < 8; ++j) ss += v[j] * v[j];
      ss += __shfl_xor(ss, 1); ss += __shfl_xor(ss, 2); ss += __shfl_xor(ss, 4); ss += __shfl_xor(ss, 8);
      const float rstd = 1.0f / sqrtf(ss * (1.f / 128.f) + EPS);
#pragma unroll
      for (int j = 0; j < 8; ++j) v[j] = v[j] * rstd * gm[j] * SCALE_M;
      *(v4u*)(Orow + C_QM + 8 * lane) = PACK8(v); }
}

__device__ __forceinline__ void km_row(bf16* row, const float* gkm, int lane) {
    v4u w = *(const v4u*)(row + 8 * lane); float v[8]; UNPACK8(w, v); float ss = 0.f;
#pragma unroll
    for (int j = 0; j < 8; ++j) ss += v[j] * v[j];
    ss += __shfl_xor(ss, 1); ss += __shfl_xor(ss, 2); ss += __shfl_xor(ss, 4); ss += __shfl_xor(ss, 8);
    const float rstd = 1.0f / sqrtf(ss * (1.f / 128.f) + EPS);
#pragma unroll
    for (int j = 0; j < 8; ++j) v[j] = v[j] * rstd * gkm[8 * (lane & 15) + j];
    *(v4u*)(row + 8 * lane) = PACK8(v);
}

__device__ __forceinline__ void transpose_v(const bf16* src, int pitch, int col0, int hstride, int H, int DV, int S, int nb, bf16* dst, int gw, int NGW, int lane) {
    const int ndq = DV / 64, nsc = S / 64, ntask = nb * H * nsc * ndq;
    for (int task = gw; task < ntask; task += NGW) {
        int x = task; const int dq = x % ndq; x /= ndq; const int sc = x % nsc; x /= nsc; const int h = x % H; const int b = x / H;
        const int s = sc * 64 + lane;
        const bf16* srow = src + (size_t)(b * S + s) * pitch + col0 + h * hstride + dq * 64;
        bf16* drow = dst + ((size_t)((b * H + h) * DV + dq * 64)) * S + s;
        v4u wv[8];
#pragma unroll
        for (int c = 0; c < 8; ++c) wv[c] = *(const v4u*)(srow + 8 * c);
#pragma unroll
        for (int c = 0; c < 8; ++c) { const v4u w = wv[c];
            drow[(size_t)(8 * c + 0) * S] = (bf16)(w.x & 0xffffu); drow[(size_t)(8 * c + 1) * S] = (bf16)(w.x >> 16);
            drow[(size_t)(8 * c + 2) * S] = (bf16)(w.y & 0xffffu); drow[(size_t)(8 * c + 3) * S] = (bf16)(w.y >> 16);
            drow[(size_t)(8 * c + 4) * S] = (bf16)(w.z & 0xffffu); drow[(size_t)(8 * c + 5) * S] = (bf16)(w.z >> 16);
            drow[(size_t)(8 * c + 6) * S] = (bf16)(w.w & 0xffffu); drow[(size_t)(8 * c + 7) * S] = (bf16)(w.w >> 16); }
    }
}

__device__ __forceinline__ void post2_row(const bf16* QBrow, bf16* QOrow, const bf16* KVBrow, const bf16* Prow, bf16* KBrow, const float* rb, const float (&gqv)[12], const float (&gkv)[12], LAS float* scr, int lane) {
    const int hd = lane >> 3, d0 = 12 * (lane & 7);
    float vq[12], vk[12], cc[12], sn[12];
    { const v2u* p = (const v2u*)(QBrow + 12 * lane);
      const v2u w0 = p[0], w1 = p[1], w2 = p[2];
      bf16 kr[12];
#pragma unroll
      for (int e = 0; e < 12; ++e) { const int d = d0 + e; kr[e] = d < 64 ? KVBrow[hd * 128 + d] : Prow[C_KR + d - 64]; }
#pragma unroll
      for (int e = 0; e < 12; ++e) { const int d = d0 + e; const int i = (d - 64) & 15; cc[e] = d < 64 ? 1.f : rb[i]; sn[e] = d < 64 ? 0.f : rb[16 + i]; }
      vq[0] = bflo(w0.x); vq[1] = bfhi(w0.x); vq[2] = bflo(w0.y); vq[3] = bfhi(w0.y); vq[4] = bflo(w1.x); vq[5] = bfhi(w1.x); vq[6] = bflo(w1.y); vq[7] = bfhi(w1.y);
      vq[8] = bflo(w2.x); vq[9] = bfhi(w2.x); vq[10] = bflo(w2.y); vq[11] = bfhi(w2.y);
#pragma unroll
      for (int e = 0; e < 12; ++e) vk[e] = bf1(kr[e]); }
    float sq = 0.f, sk = 0.f;
#pragma unroll
    for (int e = 0; e < 12; ++e) { sq += vq[e] * vq[e]; sk += vk[e] * vk[e]; }
    sq += __shfl_xor(sq, 1); sq += __shfl_xor(sq, 2); sq += __shfl_xor(sq, 4);
    sk += __shfl_xor(sk, 1); sk += __shfl_xor(sk, 2); sk += __shfl_xor(sk, 4);
    const float rq = 1.0f / sqrtf(sq * (1.f / 96.f) + EPS), rk = 1.0f / sqrtf(sk * (1.f / 96.f) + EPS);
#pragma unroll
    for (int e = 0; e < 12; ++e) { vq[e] = vq[e] * rq * gqv[e]; vk[e] = vk[e] * rk * gkv[e]; scr[12 * lane + e] = vq[e]; scr[768 + 12 * lane + e] = vk[e]; }
    LDS_WAIT(); asm volatile("" ::: "memory");
    float oq[12], ok[12];
#pragma unroll
    for (int e = 0; e < 12; ++e) { const int d = d0 + e;
        if (d < 64) { oq[e] = vq[e]; ok[e] = vk[e]; }
        else { const bool first = d < 80; const int off = first ? 16 : -16; const float pq = scr[12 * lane + e + off], pk = scr[768 + 12 * lane + e + off];
               oq[e] = first ? vq[e] * cc[e] - pq * sn[e] : vq[e] * cc[e] + pq * sn[e];
               ok[e] = first ? vk[e] * cc[e] - pk * sn[e] : vk[e] * cc[e] + pk * sn[e]; }
        oq[e] *= SCALE_B; }
    LDS_WAIT(); asm volatile("" ::: "memory");
    v2u* q = (v2u*)(QOrow + 12 * lane); v2u* k = (v2u*)(KBrow + 12 * lane);
#pragma unroll
    for (int i = 0; i < 3; ++i) { v2u w; w.x = pk2(oq[4 * i], oq[4 * i + 1]); w.y = pk2(oq[4 * i + 2], oq[4 * i + 3]); q[i] = w;
                                  v2u u; u.x = pk2(ok[4 * i], ok[4 * i + 1]); u.y = pk2(ok[4 * i + 2], ok[4 * i + 3]); k[i] = u; }
}

__device__ __forceinline__ int next_unit(unsigned* ctr, volatile LAS int* slot) {
    __syncthreads();
    if (threadIdx.x == 0) *slot = (int)atomicAdd(ctr, 1u);
    __syncthreads();
    return *slot;
}

constexpr int SCP = 2112;
__device__ __forceinline__ unsigned ord_key(float v) { const unsigned b = __float_as_uint(v); return b ^ ((unsigned)((int)b >> 31) | 0x80000000u); }
__device__ __forceinline__ void indexer_unit(LAS float* sc, const bf16* P, const float* WI, unsigned* MASK, int bb, int tb) {
    int tid_ = threadIdx.x; asm volatile("" : "+v"(tid_));
    const int tid = tid_, lane = tid & 63, w = __builtin_amdgcn_readfirstlane(tid >> 6);
    const int n = lane & 15, g = lane >> 4;
    const int rowbase = bb * SEQ, t0 = tb * 16;
    for (int rp1 = 0; rp1 < REP_IDX1; ++rp1) {
        bf16x8 qf[8][2]; float wq[8];
        const bf16* qrow = P + (size_t)(rowbase + t0 + n) * PP + C_QI + 8 * g;
#pragma unroll
        for (int h = 0; h < 8; ++h) {
            qf[h][0] = *(const bf16x8*)(qrow + h * 64);
            qf[h][1] = *(const bf16x8*)(qrow + h * 64 + 32);
            wq[h] = WI[(size_t)(rowbase + t0 + n) * 8 + h];
        }
        const int ntile = tb + 1;
        const int nmine = (ntile - w + 7) >> 3;
        const int ngrp = (nmine + 3) >> 2;
        const bf16* kbase = P + (size_t)(rowbase + n) * PP + C_KI + 8 * g;
        bf16x8 kb[2][4][2];
#define IDX_LOAD(BUF, GRP) do { _Pragma("unroll") for (int j_ = 0; j_ < 4; ++j_) { const int tile_ = w + 8 * (4 * (GRP) + j_); const int tl_ = tile_ < ntile ? tile_ : 0; \
            const bf16* kr_ = kbase + (size_t)(16 * tl_) * PP; kb[BUF][j_][0] = *(const bf16x8*)(kr_); kb[BUF][j_][1] = *(const bf16x8*)(kr_ + 32); } } while (0)
#define IDX_COMP(BUF, GRP) do { _Pragma("unroll") for (int j_ = 0; j_ < 4; ++j_) { const int tile_ = w + 8 * (4 * (GRP) + j_); if (tile_ < ntile) { \
            f32x4 idx_ = (f32x4){0.f, 0.f, 0.f, 0.f}; \
            _Pragma("unroll") for (int h_ = 0; h_ < 8; ++h_) { f32x4 a_ = (f32x4){0.f, 0.f, 0.f, 0.f}; \
                a_ = __builtin_amdgcn_mfma_f32_16x16x32_bf16(kb[BUF][j_][0], qf[h_][0], a_, 0, 0, 0); \
                a_ = __builtin_amdgcn_mfma_f32_16x16x32_bf16(kb[BUF][j_][1], qf[h_][1], a_, 0, 0, 0); \
                _Pragma("unroll") for (int i_ = 0; i_ < 4; ++i_) idx_[i_] = __builtin_fmaf(wq[h_], __builtin_fmaxf(a_[i_], 0.f), idx_[i_]); } \
            { const int k0_ = 16 * tile_ + 4 * g; LAS float* d_ = sc + n * SCP + k0_ + (k0_ >> 5); d_[0] = idx_[0]; d_[1] = idx_[1]; d_[2] = idx_[2]; d_[3] = idx_[3]; } } } } while (0)
        if (ngrp > 0) IDX_LOAD(0, 0);
        for (int gp = 0; gp < ngrp; gp += 2) {
            if (gp + 1 < ngrp) IDX_LOAD(1, gp + 1);
            IDX_COMP(0, gp);
            if (gp + 1 < ngrp) { if (gp + 2 < ngrp) IDX_LOAD(0, gp + 2); IDX_COMP(1, gp + 1); }
        }
#undef IDX_LOAD
#undef IDX_COMP
    }
    __syncthreads();
#pragma unroll 1
    for (int qq2 = 0; qq2 < 2 * REP_SEL; ++qq2) { const int qq = qq2 & 1;
        const int q = 2 * w + qq, t = t0 + q;
        unsigned* mrow = MASK + (size_t)(rowbase + t) * 64;
        const int nv = t - 32 * lane + 1;
        const unsigned valid = nv >= 32 ? 0xffffffffu : (nv <= 0 ? 0u : ((1u << nv) - 1u));
        if (t < 256) { mrow[lane] = valid; continue; }
        unsigned u[32];
        const LAS float* srow = sc + q * SCP + 33 * lane;
#pragma unroll
        for (int r = 0; r < 32; ++r) { const float v = srow[r]; u[r] = ((valid >> r) & 1u) ? ord_key(v) : 0u; }
#pragma unroll
        for (int si = 0; si < 5; ++si) { const int sft = 16 >> si;
            const unsigned msk = si == 0 ? 0x0000ffffu : (si == 1 ? 0x00ff00ffu : (si == 2 ? 0x0f0f0f0fu : (si == 3 ? 0x33333333u : 0x55555555u)));
#pragma unroll
            for (int k = 0; k < 32; ++k) if (!(k & sft)) { const unsigned tt = ((u[k] >> sft) ^ u[k + sft]) & msk; u[k + sft] ^= tt; u[k] ^= tt << sft; } }
        unsigned alive = valid, sel = 0u; int need = 256;
#pragma unroll
        for (int j = 31; j >= 0; --j) {
            const unsigned ones = alive & u[j];
            const unsigned cl = (unsigned)__popc(ones);
            int c = 0;
#pragma unroll
            for (int bt = 0; bt < 6; ++bt) c += __popcll(__ballot((cl >> bt) & 1u)) << bt;
            if (c >= need) { alive = ones; if (c == need) { sel |= ones; need = 0; break; } }
            else { need -= c; sel |= ones; alive &= ~u[j]; }
        }
        if (need > 0) {
            const int cnt = __popc(alive); int inc = cnt;
#pragma unroll
            for (int d = 1; d < 64; d <<= 1) { const int o = __shfl_up(inc, d); if (lane >= d) inc += o; }
            int k = need - (inc - cnt); k = k < 0 ? 0 : (k > cnt ? cnt : k);
            unsigned m = alive;
            for (int i = 0; i < k; ++i) { const unsigned low = m & (0u - m); sel |= low; m ^= low; }
        }
        mrow[lane] = sel;
    }
    __syncthreads();
}

__device__ __forceinline__ int crow(int r, int hi) { return (r & 3) + 8 * (r >> 2) + 4 * hi; }
template <int DQK, int DV, int MODE, int STRIP = 0>
__device__ __forceinline__ void attn_unit(LAS unsigned char* lds, const bf16* Qb, int qpitch, const bf16* Kb, int kpitch, const bf16* VTb, int skv,
                                          const unsigned* maskb, const bf16* Zb, bf16* Ob, int q0) {
    constexpr int TK = 128, KP = DQK + 8, VP = TK + 8;
    LAS bf16* Ks = (LAS bf16*)lds; LAS bf16* Vs = Ks + TK * KP;
    constexpr int CPR = DQK / 8;
    constexpr int NCK = TK * CPR, NCV = DV * (TK / 8);
    constexpr int RK = (NCK + 511) / 512, RV = (NCV + 511) / 512;
    constexpr int NKS = DQK / 16, NMT = DV / 32;
    int tid_ = threadIdx.x; asm volatile("" : "+v"(tid_));
    const int tid = tid_, lane = tid & 63, w = __builtin_amdgcn_readfirstlane(tid >> 6), r = lane & 31, hh = lane >> 5;
    const int NT = MODE == 0 ? skv / TK : (q0 + 256) / TK;
    const int qlo = q0 + 32 * w;
    bf16x8 qf[NKS];
    { const bf16* qrow = Qb + (size_t)(qlo + r) * qpitch + 8 * hh;
#pragma unroll
      for (int ks = 0; ks < NKS; ++ks) qf[ks] = *(const bf16x8*)(qrow + 16 * ks); }
    f32x16 o[NMT];
#pragma unroll
    for (int mt = 0; mt < NMT; ++mt)
#pragma unroll
        for (int i = 0; i < 16; ++i) o[mt][i] = 0.f;
    float m_run = NEGF, l_run = 0.f;
    v4u kreg[RK], vreg[RV];
#define ATT_PREFETCH(tile_) do { \
        _Pragma("unroll") for (int i_ = 0; i_ < RK; ++i_) { const int c_ = tid + 512 * i_; if (c_ < NCK) { const int row_ = c_ / CPR, cc_ = c_ % CPR; kreg[i_] = *(const v4u*)(Kb + (size_t)(TK * (tile_) + row_) * kpitch + 8 * cc_); } } \
        _Pragma("unroll") for (int i_ = 0; i_ < RV; ++i_) { const int c_ = tid + 512 * i_; if (c_ < NCV) { const int d_ = c_ >> 4, cc_ = c_ & 15; vreg[i_] = *(const v4u*)(VTb + (size_t)d_ * skv + TK * (tile_) + 8 * cc_); } } } while (0)
    if (STRIP != 2) ATT_PREFETCH(0);
    for (int tile = 0; tile < NT; ++tile) {
        __syncthreads();
        if (STRIP != 2) {
#pragma unroll
        for (int i = 0; i < RK; ++i) { const int c = tid + 512 * i; if (c < NCK) { const int row = c / CPR, cc = c % CPR; *(LAS v4u*)(Ks + row * KP + 8 * cc) = kreg[i]; } }
#pragma unroll
        for (int i = 0; i < RV; ++i) { const int c = tid + 512 * i; if (c < NCV) { const int d = c >> 4, cc = c & 15; *(LAS v4u*)(Vs + d * VP + 8 * cc) = vreg[i]; } }
        }
        __syncthreads();
        if (STRIP != 2 && tile + 1 < NT) ATT_PREFETCH(tile + 1);
        __builtin_amdgcn_sched_barrier(0);
        if (STRIP == 1) continue;
#pragma unroll 1
        for (int sub = 0; sub < 2; ++sub) {
        const int t64 = 2 * tile + sub;
        if (MODE != 0 && 64 * t64 > qlo + 31) continue;
        const LAS bf16* Kc = Ks + 64 * sub * KP; const LAS bf16* Vc = Vs + 64 * sub;
        unsigned mw0 = 0u, mw1 = 0u;
        if (MODE == 2) { const v2u mm = *(const v2u*)(maskb + (size_t)(qlo + r) * 64 + 2 * t64); mw0 = mm.x >> (4 * hh); mw1 = mm.y >> (4 * hh); }
        f32x16 s0, s1;
#pragma unroll
        for (int i = 0; i < 16; ++i) { s0[i] = 0.f; s1[i] = 0.f; }
#pragma unroll
        for (int ks = 0; ks < NKS; ++ks) {
            const bf16x8 a0 = *(const LAS bf16x8*)(Kc + r * KP + 16 * ks + 8 * hh);
            const bf16x8 a1 = *(const LAS bf16x8*)(Kc + (32 + r) * KP + 16 * ks + 8 * hh);
            s0 = __builtin_amdgcn_mfma_f32_32x32x16_bf16(a0, qf[ks], s0, 0, 0, 0);
            s1 = __builtin_amdgcn_mfma_f32_32x32x16_bf16(a1, qf[ks], s1, 0, 0, 0);
        }
        if (MODE == 1) {
            if (64 * t64 + 63 > qlo) { const int qg = qlo + r;
#pragma unroll
                for (int i = 0; i < 16; ++i) { const int key = 64 * t64 + crow(i, hh); if (key > qg) s0[i] = NEGF; if (key + 32 > qg) s1[i] = NEGF; } }
        }
        if (MODE == 2) {
#pragma unroll
            for (int i = 0; i < 16; ++i) { const int bit = (i & 3) + 8 * (i >> 2); if (!((mw0 >> bit) & 1u)) s0[i] = NEGF; if (!((mw1 >> bit) & 1u)) s1[i] = NEGF; }
        }
        float mx = s0[0];
#pragma unroll
        for (int i = 1; i < 16; ++i) mx = __builtin_fmaxf(mx, s0[i]);
#pragma unroll
        for (int i = 0; i < 16; ++i) mx = __builtin_fmaxf(mx, s1[i]);
        mx = __builtin_fmaxf(mx, __shfl_xor(mx, 32));
        const float m_new = __builtin_fmaxf(m_run, mx);
        const float alpha = __builtin_amdgcn_exp2f(m_run - m_new);
        m_run = m_new;
        float ls = 0.f;
#pragma unroll
        for (int i = 0; i < 16; ++i) { s0[i] = __builtin_amdgcn_exp2f(s0[i] - m_new); s1[i] = __builtin_amdgcn_exp2f(s1[i] - m_new); ls += s0[i] + s1[i]; }
        l_run = l_run * alpha + ls;
#pragma unroll
        for (int mt = 0; mt < NMT; ++mt)
#pragma unroll
            for (int i = 0; i < 16; ++i) o[mt][i] *= alpha;
        v4u pf[2][2];
#pragma unroll
        for (int s = 0; s < 2; ++s) {
            pf[0][s] = (v4u){pk2(s0[8 * s], s0[8 * s + 1]), pk2(s0[8 * s + 2], s0[8 * s + 3]), pk2(s0[8 * s + 4], s0[8 * s + 5]), pk2(s0[8 * s + 6], s0[8 * s + 7])};
            pf[1][s] = (v4u){pk2(s1[8 * s], s1[8 * s + 1]), pk2(s1[8 * s + 2], s1[8 * s + 3]), pk2(s1[8 * s + 4], s1[8 * s + 5]), pk2(s1[8 * s + 6], s1[8 * s + 7])};
        }
#pragma unroll
        for (int mt = 0; mt < NMT; ++mt)
#pragma unroll
            for (int p = 0; p < 2; ++p)
#pragma unroll
                for (int s = 0; s < 2; ++s) {
                    const LAS bf16* vp = Vc + (32 * mt + r) * VP + 32 * p + 16 * s + 4 * hh;
                    const s16x4 lo = *(const LAS s16x4*)(vp), hi = *(const LAS s16x4*)(vp + 8);
                    const bf16x8 a = (bf16x8){lo[0], lo[1], lo[2], lo[3], hi[0], hi[1], hi[2], hi[3]};
                    o[mt] = __builtin_amdgcn_mfma_f32_32x32x16_bf16(a, __builtin_bit_cast(bf16x8, pf[p][s]), o[mt], 0, 0, 0);
                }
        }
    }
#undef ATT_PREFETCH
    const float l_tot = l_run + __shfl_xor(l_run, 32);
    const float inv = 1.0f / l_tot;
    const size_t row = (size_t)(qlo + r);
#pragma unroll
    for (int mt = 0; mt < NMT; ++mt)
#pragma unroll
        for (int g4 = 0; g4 < 4; ++g4) {
            const int d = 32 * mt + 8 * g4 + 4 * hh;
            float ov[4];
#pragma unroll
            for (int i = 0; i < 4; ++i) ov[i] = o[mt][4 * g4 + i] * inv;
            if (Zb) { const v2u zw = *(const v2u*)(Zb + row * PP + d); const float z[4] = {bflo(zw.x), bfhi(zw.x), bflo(zw.y), bfhi(zw.y)};
#pragma unroll
                for (int i = 0; i < 4; ++i) ov[i] *= z[i] / (1.0f + __expf(-z[i])); }
            v2u ow; ow.x = pk2(ov[0], ov[1]); ow.y = pk2(ov[2], ov[3]);
            *(v2u*)(Ob + row * PP + d) = ow;
        }
}

template <int DQK, int MODE>
__device__ __forceinline__ void attn_unit_pipe(LAS unsigned char* lds, const bf16* Qb, int qpitch, const bf16* Kb, int kpitch, const bf16* VTb, int skv,
                                               const unsigned* maskb, bf16* Ob, int q0) {
    constexpr int DV = 64, KP = DQK + 8, VP = 72, BUFE = 64 * KP + DV * VP;
    constexpr int CPR = DQK / 8, NCK = 64 * CPR, NCV = DV * 8, RK = (NCK + 511) / 512, RV = (NCV + 511) / 512, NKS = DQK / 16, NMT = DV / 32;
    static_assert(NCV == 512 && (NCK == 512 || NCK == 768), "staging map");
    int tid_ = threadIdx.x; asm volatile("" : "+v"(tid_));
    const int tid = tid_, lane = tid & 63, w = __builtin_amdgcn_readfirstlane(tid >> 6), r = lane & 31, hh = lane >> 5;
    const int NT = (q0 + 256) / 64;
    const int qlo = q0 + 32 * w;
    const int NTw = ((qlo + 31) >> 6) + 1;
    int krow[RK], kcc[RK];
#pragma unroll
    for (int i = 0; i < RK; ++i) { int c = tid + 512 * i; if (c >= NCK) c -= 256; krow[i] = c / CPR; kcc[i] = c % CPR; }
    const int vd = tid >> 3, vcc = tid & 7;
    bf16x8 qf[NKS];
    { const bf16* qrow = Qb + (size_t)(qlo + r) * qpitch + 8 * hh;
#pragma unroll
      for (int ks = 0; ks < NKS; ++ks) qf[ks] = *(const bf16x8*)(qrow + 16 * ks); }
    f32x16 o[NMT];
#pragma unroll
    for (int mt = 0; mt < NMT; ++mt)
#pragma unroll
        for (int i = 0; i < 16; ++i) o[mt][i] = 0.f;
    float m_run = NEGF, l_run = 0.f, alpha = 1.f;
    v4u kreg[2][RK], vreg[2][RV]; v2u mset[2];
    const unsigned* mrowp = MODE == 2 ? maskb + (size_t)(qlo + r) * 64 : nullptr;
#define PL_LOAD(S_, tile_) do { const int tl_ = (tile_) < NT ? (tile_) : NT - 1; \
        if (MODE == 2) { const int mt_ = (tile_) >= 2 ? ((tile_) - 2 < 32 ? (tile_) - 2 : 31) : 0; mset[S_] = *(const v2u*)(mrowp + 2 * mt_); }     \
        _Pragma("unroll") for (int i_ = 0; i_ < RK; ++i_) kreg[S_][i_] = *(const v4u*)(Kb + (size_t)(64 * tl_ + krow[i_]) * kpitch + 8 * kcc[i_]); \
        vreg[S_][0] = *(const v4u*)(VTb + (size_t)vd * skv + 64 * tl_ + 8 * vcc); } while (0)
#define PL_STAGE(S_, buf_) do { LAS bf16* Kd_ = (LAS bf16*)lds + (buf_) * BUFE; LAS bf16* Vd_ = Kd_ + 64 * KP; \
        _Pragma("unroll") for (int i_ = 0; i_ < RK; ++i_) *(LAS v4u*)(Kd_ + krow[i_] * KP + 8 * kcc[i_]) = kreg[S_][i_]; \
        *(LAS v4u*)(Vd_ + vd * VP + 8 * vcc) = vreg[S_][0]; } while (0)
#define PL_QK(t_, D0_, D1_) do { const LAS bf16* Kc_ = (const LAS bf16*)lds + ((t_) & 3) * BUFE; \
        _Pragma("unroll") for (int i_ = 0; i_ < 16; ++i_) { D0_[i_] = 0.f; D1_[i_] = 0.f; } \
        _Pragma("unroll") for (int ks_ = 0; ks_ < NKS; ++ks_) { \
            const bf16x8 a0_ = *(const LAS bf16x8*)(Kc_ + r * KP + 16 * ks_ + 8 * hh); const bf16x8 a1_ = *(const LAS bf16x8*)(Kc_ + (32 + r) * KP + 16 * ks_ + 8 * hh); \
            D0_ = __builtin_amdgcn_mfma_f32_32x32x16_bf16(a0_, qf[ks_], D0_, 0, 0, 0); D1_ = __builtin_amdgcn_mfma_f32_32x32x16_bf16(a1_, qf[ks_], D1_, 0, 0, 0); } } while (0)
#define PL_PV(t_) do { const LAS bf16* Vc_ = (const LAS bf16*)lds + ((t_) & 3) * BUFE + 64 * KP; \
        _Pragma("unroll") for (int mt_ = 0; mt_ < NMT; ++mt_) _Pragma("unroll") for (int i_ = 0; i_ < 16; ++i_) o[mt_][i_] *= alpha; \
        _Pragma("unroll") for (int mt_ = 0; mt_ < NMT; ++mt_) _Pragma("unroll") for (int p_ = 0; p_ < 2; ++p_) _Pragma("unroll") for (int s_ = 0; s_ < 2; ++s_) { \
            const LAS bf16* vp_ = Vc_ + (32 * mt_ + r) * VP + 32 * p_ + 16 * s_ + 4 * hh; \
            const s16x4 lo_ = *(const LAS s16x4*)(vp_), hi_ = *(const LAS s16x4*)(vp_ + 8); \
            const bf16x8 a_ = (bf16x8){lo_[0], lo_[1], lo_[2], lo_[3], hi_[0], hi_[1], hi_[2], hi_[3]}; \
            o[mt_] = __builtin_amdgcn_mfma_f32_32x32x16_bf16(a_, __builtin_bit_cast(bf16x8, pf[p_][s_]), o[mt_], 0, 0, 0); } } while (0)
#define PL_SOFTMAX(t_, C0_, C1_, MK_, CAUSAL_) do { \
        if (MODE == 2) { const unsigned w0_ = (MK_).x >> (4 * hh), w1_ = (MK_).y >> (4 * hh); \
            _Pragma("unroll") for (int i_ = 0; i_ < 16; ++i_) { const int bit_ = (i_ & 3) + 8 * (i_ >> 2); if (!((w0_ >> bit_) & 1u)) C0_[i_] = NEGF; if (!((w1_ >> bit_) & 1u)) C1_[i_] = NEGF; } } \
        if (CAUSAL_) { const int qg_ = qlo + r; \
            _Pragma("unroll") for (int i_ = 0; i_ < 16; ++i_) { const int key_ = 64 * (t_) + crow(i_, hh); if (key_ > qg_) C0_[i_] = NEGF; if (key_ + 32 > qg_) C1_[i_] = NEGF; } } \
        float mx_ = C0_[0]; \
        _Pragma("unroll") for (int i_ = 1; i_ < 16; ++i_) mx_ = __builtin_fmaxf(mx_, C0_[i_]); \
        _Pragma("unroll") for (int i_ = 0; i_ < 16; ++i_) mx_ = __builtin_fmaxf(mx_, C1_[i_]); \
        mx_ = __builtin_fmaxf(mx_, __shfl_xor(mx_, 32)); \
        const float mn_ = __builtin_fmaxf(m_run, mx_); alpha = __builtin_amdgcn_exp2f(m_run - mn_); m_run = mn_; \
        float ls_ = 0.f; \
        _Pragma("unroll") for (int i_ = 0; i_ < 16; ++i_) { C0_[i_] = __builtin_amdgcn_exp2f(C0_[i_] - mn_); C1_[i_] = __builtin_amdgcn_exp2f(C1_[i_] - mn_); ls_ += C0_[i_] + C1_[i_]; } \
        l_run = l_run * alpha + ls_; \
        _Pragma("unroll") for (int s_ = 0; s_ < 2; ++s_) { \
            pf[0][s_] = (v4u){pk2(C0_[8 * s_], C0_[8 * s_ + 1]), pk2(C0_[8 * s_ + 2], C0_[8 * s_ + 3]), pk2(C0_[8 * s_ + 4], C0_[8 * s_ + 5]), pk2(C0_[8 * s_ + 6], C0_[8 * s_ + 7])}; \
            pf[1][s_] = (v4u){pk2(C1_[8 * s_], C1_[8 * s_ + 1]), pk2(C1_[8 * s_ + 2], C1_[8 * s_ + 3]), pk2(C1_[8 * s_ + 4], C1_[8 * s_ + 5]), pk2(C1_[8 * s_ + 6], C1_[8 * s_ + 7])}; } } while (0)
#define PL_IO(t_, S_) do { PL_STAGE(S_, ((t_) + 2) & 3); PL_LOAD(S_, (t_) + 4); } while (0)
#define PL_STEADY(t_, S_) do { const v2u mk_ = mset[S_]; PL_IO(t_, S_); if (MODE == 2) { asm volatile("" :: "v"(mk_.x), "v"(mk_.y)); } \
        PL_QK((t_) + 1, n0, n1); PL_PV((t_) - 1); PL_SOFTMAX(t_, c0, c1, mk_, false); c0 = n0; c1 = n1; __syncthreads(); } while (0)
#define PL_TAIL(t_, S_) do { const v2u mk_ = mset[S_]; PL_IO(t_, S_); if ((t_) >= 1) PL_PV((t_) - 1); PL_SOFTMAX(t_, c0, c1, mk_, MODE == 1); PL_PV(t_); __syncthreads(); } while (0)
    f32x16 c0, c1, n0, n1; v4u pf[2][2];
    PL_LOAD(0, 0); PL_LOAD(1, 1);
    PL_STAGE(0, 0); PL_STAGE(1, 1);
    PL_LOAD(0, 2); PL_LOAD(1, 3);
    __syncthreads();
    PL_QK(0, c0, c1);
    int t = 0;
    if (NTw >= 2) {
        { const v2u mk_ = mset[0]; PL_IO(0, 0); PL_QK(1, n0, n1); PL_SOFTMAX(0, c0, c1, mk_, false); c0 = n0; c1 = n1; __syncthreads(); }
        for (t = 1; t + 1 < NTw; ) {
            PL_STEADY(t, 1); ++t;
            if (t + 1 < NTw) { PL_STEADY(t, 0); ++t; }
        }
    }
    if (t & 1) PL_TAIL(t, 1); else PL_TAIL(t, 0);
    for (++t; t < NT; ++t) { if (t & 1) PL_IO(t, 1); else PL_IO(t, 0); __syncthreads(); }
#undef PL_LOAD
#undef PL_STAGE
#undef PL_QK
#undef PL_PV
#undef PL_SOFTMAX
#undef PL_IO
#undef PL_STEADY
#undef PL_TAIL
    const float l_tot = l_run + __shfl_xor(l_run, 32);
    const float inv = 1.0f / l_tot;
    const size_t row = (size_t)(qlo + r);
#pragma unroll
    for (int mt = 0; mt < NMT; ++mt)
#pragma unroll
        for (int g4 = 0; g4 < 4; ++g4) {
            const int d = 32 * mt + 8 * g4 + 4 * hh;
            v2u ow; ow.x = pk2(o[mt][4 * g4] * inv, o[mt][4 * g4 + 1] * inv); ow.y = pk2(o[mt][4 * g4 + 2] * inv, o[mt][4 * g4 + 3] * inv);
            *(v2u*)(Ob + row * PP + d) = ow;
        }
}

__device__ __forceinline__ bf16* gate_row(bf16* G0, bf16* G1, size_t row) { return row < 8192 ? G0 + row * 3072 : G1 + (row - 8192) * 3072; }
struct EpiZG {
    static constexpr bool PERM = true, AFTER_DRAIN = false;
    bf16* P; bf16* G0; bf16* G1;
    __device__ __forceinline__ void operator()(const pg8::f32x4 (&acc)[2][2][4][2], const pg8::Unit& u, int wr, int wc, int fr, int fq) const {
        const int row0 = u.pm * 256 + wr * 64 + fr, cl = wc * 32 + 8 * fq;
        const bool isz = u.pn < 4;
        const int ycol = (u.pn < 2 ? C_YA : C_YB) + (u.pn & 1) * 256, gcol = (u.pn - 4) * 256;
#pragma unroll
        for (int ai = 0; ai < 2; ++ai)
#pragma unroll
            for (int m = 0; m < 4; ++m) { const size_t row = (size_t)(row0 + ai * 128 + m * 16);
#pragma unroll
                for (int bj = 0; bj < 2; ++bj) {
                    const pg8::f32x4 v0 = acc[ai][bj][m][0], v1 = acc[ai][bj][m][1];
                    float rr[8] = {v0[0], v0[1], v0[2], v0[3], v1[0], v1[1], v1[2], v1[3]};
                    if (isz) { bf16* dst = P + row * PP + ycol + cl + bj * 128; const v4u old = *(const v4u*)dst; float yv[8]; UNPACK8(old, yv);
#pragma unroll
                        for (int e = 0; e < 8; ++e) rr[e] = yv[e] * (rr[e] / (1.0f + __expf(-rr[e])));
                        *(v4u*)dst = PACK8(rr); }
                    else { bf16* dst = gate_row(G0, G1, row) + gcol + cl + bj * 128;
#pragma unroll
                        for (int e = 0; e < 8; ++e) rr[e] = 1.0f / (1.0f + __expf(-rr[e]));
                        *(v4u*)dst = PACK8(rr); } } }
    }
};
struct EpiMerge {
    static constexpr bool PERM = true, AFTER_DRAIN = false;
    bf16* Mg; bf16* G0; bf16* G1; int nbr;
    __device__ __forceinline__ void operator()(const pg8::f32x4 (&acc)[2][2][4][2], const pg8::Unit& u, int wr, int wc, int fr, int fq) const {
        const int row0 = u.pm * 256 + wr * 64 + fr, col0 = u.pn * 256 + wc * 32 + 8 * fq;
#pragma unroll
        for (int ai = 0; ai < 2; ++ai)
#pragma unroll
            for (int m = 0; m < 4; ++m) { const size_t row = (size_t)(row0 + ai * 128 + m * 16);
#pragma unroll
                for (int bj = 0; bj < 2; ++bj) { const int col = col0 + bj * 128;
                    const v4u gwd = *(const v4u*)(gate_row(G0, G1, row) + nbr * 1024 + col);
                    float gl[8]; UNPACK8(gwd, gl);
                    const pg8::f32x4 v0 = acc[ai][bj][m][0], v1 = acc[ai][bj][m][1];
                    float rr[8] = {v0[0], v0[1], v0[2], v0[3], v1[0], v1[1], v1[2], v1[3]};
#pragma unroll
                    for (int e = 0; e < 8; ++e) rr[e] *= gl[e];
                    bf16* dst = Mg + row * 1024 + col;
                    if (nbr > 0) { const v4u old = *(const v4u*)dst; float ol[8]; UNPACK8(old, ol);
#pragma unroll
                        for (int e = 0; e < 8; ++e) rr[e] += ol[e]; }
                    *(v4u*)dst = PACK8(rr); } }
    }
};
struct EpiOut {
    static constexpr bool PERM = true, AFTER_DRAIN = false;
    const float* X; float* Out;
    __device__ __forceinline__ void operator()(const pg8::f32x4 (&acc)[2][2][4][2], const pg8::Unit& u, int wr, int wc, int fr, int fq) const {
        const int row0 = u.pm * 256 + wr * 64 + fr, col0 = u.pn * 256 + wc * 32 + 8 * fq;
#pragma unroll
        for (int ai = 0; ai < 2; ++ai)
#pragma unroll
            for (int m = 0; m < 4; ++m) { const size_t row = (size_t)(row0 + ai * 128 + m * 16);
#pragma unroll
                for (int bj = 0; bj < 2; ++bj) { const size_t p = row * 1024 + col0 + bj * 128;
                    const f32x4 x0 = *(const f32x4*)(X + p), x1 = *(const f32x4*)(X + p + 4);
                    const pg8::f32x4 a0 = acc[ai][bj][m][0], a1 = acc[ai][bj][m][1];
                    *(f32x4*)(Out + p) = (f32x4){x0[0] + a0[0], x0[1] + a0[1], x0[2] + a0[2], x0[3] + a0[3]};
                    *(f32x4*)(Out + p + 4) = (f32x4){x1[0] + a1[0], x1[1] + a1[1], x1[2] + a1[2], x1[3] + a1[3]}; } }
    }
};

#define XB_TMO      128
#define XB_XCNT(j)  (256  + 64 * (j))
#define XB_XSUB(j)  (1280 + 64 * (j))
#define XB_XGEN(j)  (2304 + 64 * (j))
#define XB_TOP      3328
#define XB_TOPGEN   3392
#define XCD_BAR_WORDS 3456
#define XB_SPIN_CAP (1u << 18)

__device__ __forceinline__ unsigned xb_ld(unsigned* p)              { return __hip_atomic_load(p, __ATOMIC_RELAXED, __HIP_MEMORY_SCOPE_AGENT); }
__device__ __forceinline__ unsigned xb_add(unsigned* p, unsigned v) { return __hip_atomic_fetch_add(p, v, __ATOMIC_RELAXED, __HIP_MEMORY_SCOPE_AGENT); }
__device__ __forceinline__ unsigned xb_xcc_id() { return (unsigned)__builtin_amdgcn_s_getreg((3 << 11) | 20) & 0xFu; }
#define XB_SPIN(cond, bar) do { unsigned _sp = 0; while (cond) { __builtin_amdgcn_s_sleep(1); \
    if ((++_sp & 255u) == 0u) { if (xb_ld(&(bar)[XB_TMO])) break; if (_sp > XB_SPIN_CAP) { atomicAdd(&(bar)[XB_TMO], 1u); break; } } } } while (0)

struct XcdBarrier {
    unsigned* bar; unsigned x;
    volatile LAS unsigned* st;
};

__device__ __forceinline__ XcdBarrier xcd_barrier_post(unsigned* bar, volatile LAS unsigned* st) {
    XcdBarrier b; b.bar = bar; b.x = xb_xcc_id(); b.st = st;
    if (threadIdx.x == 0) (void)xb_add(&bar[XB_XCNT(b.x)], 1u);
    return b;
}
__device__ __forceinline__ void xcd_barrier_complete(unsigned* bar, unsigned x, unsigned& nloc, unsigned& nx) {
    const unsigned G = gridDim.x * gridDim.y * gridDim.z;
    unsigned sum, cnt, mine, sp = 0u;
    for (;;) {
        sum = 0u; cnt = 0u; mine = 0u;
#pragma unroll
        for (unsigned j = 0; j < 16; ++j) { const unsigned c = xb_ld(&bar[XB_XCNT(j)]); sum += c; cnt += (c > 0u) ? 1u : 0u; mine = (j == x) ? c : mine; }
        if (sum == G) break;
        __builtin_amdgcn_s_sleep(1);
        if ((++sp & 255u) == 0u) { if (xb_ld(&bar[XB_TMO])) break; if (sp > XB_SPIN_CAP) { atomicAdd(&bar[XB_TMO], 1u); break; } }
    }
    nloc = mine > 0u ? mine : 1u; nx = cnt > 0u ? cnt : 1u;
}

__device__ __forceinline__ void xcd_barrier(const XcdBarrier& b) {
    asm volatile("s_waitcnt vmcnt(0)" ::: "memory");
    __syncthreads();
    if (threadIdx.x == 0) {
        unsigned* bar = b.bar;
        __builtin_amdgcn_s_waitcnt(0);
        unsigned nloc = b.st[0], nx = b.st[1];
        if (nloc == 0u) { xcd_barrier_complete(bar, b.x, nloc, nx); b.st[0] = nloc; b.st[1] = nx; }
        const unsigned old = xb_add(&bar[XB_XSUB(b.x)], 1u);
        const unsigned gen = old / nloc;
        if (old + 1u == (gen + 1u) * nloc) {
            __builtin_amdgcn_fence(__ATOMIC_RELEASE, "agent");
            asm volatile("s_waitcnt vmcnt(0)" ::: "memory");
            const unsigned og = xb_add(&bar[XB_TOP], 1u);
            const unsigned tg = og / nx;
            if (og + 1u == (tg + 1u) * nx) xb_add(&bar[XB_TOPGEN], 1u);
            else XB_SPIN(xb_ld(&bar[XB_TOPGEN]) == tg, bar);
            __builtin_amdgcn_fence(__ATOMIC_ACQUIRE, "agent");
            xb_add(&bar[XB_XGEN(b.x)], 1u);
            asm volatile("s_waitcnt vmcnt(0)" ::: "memory");
        } else {
            XB_SPIN(xb_ld(&bar[XB_XGEN(b.x)]) == gen, bar);
            __builtin_amdgcn_fence(__ATOMIC_ACQUIRE, "agent");
            asm volatile("s_waitcnt vmcnt(0)" ::: "memory");
        }
    }
    __syncthreads();
}

template <int DQK, int DV, int MODE>
__device__ __forceinline__ void att_call(bool strip, LAS unsigned char* lds, const bf16* Qb, int qpitch, const bf16* Kb, int kpitch, const bf16* VTb, int skv, const unsigned* maskb, const bf16* Zb, bf16* Ob, int q0) {
    if (ATT_STRIP != 0 && strip) attn_unit<DQK, DV, MODE, ATT_STRIP>(lds, Qb, qpitch, Kb, kpitch, VTb, skv, maskb, Zb, Ob, q0);
    else attn_unit<DQK, DV, MODE, 0>(lds, Qb, qpitch, Kb, kpitch, VTb, skv, maskb, Zb, Ob, q0);
}
struct Args { const float* in[19]; const int* pos; float* out; unsigned char* ws; };
typedef const __attribute__((address_space(4))) Args* kargs_t;
#define PHASE_BEGIN \
    kargs_t ap_ = (kargs_t)__builtin_amdgcn_kernarg_segment_ptr(); asm volatile("" : "+s"(ap_)); \
    int tid = threadIdx.x; asm volatile("" : "+v"(tid)); \
    const int lane = tid & 63, wave = __builtin_amdgcn_readfirstlane(tid >> 6), G = gridDim.x, NGW = G * 8, gw = blockIdx.x * 8 + wave; \
    unsigned char* const ws = ap_->ws; unsigned char* const dob = (unsigned char*)ap_->out; const int* const pos = ap_->pos; float* const outp = ap_->out; unsigned* const ctl = (unsigned*)(ws + WS_CTL); \
    const float* const x = ap_->in[0]; const float* const mem = ap_->in[1]; \
    const float* const g_norm = ap_->in[3]; const float* const w_in = ap_->in[4]; const float* const g_qn_a = ap_->in[5]; const float* const g_kn_a = ap_->in[6]; \
    const float* const g_cq = ap_->in[7]; const float* const g_ckv = ap_->in[8]; const float* const w_uq = ap_->in[9]; const float* const w_ukv = ap_->in[10]; \
    const float* const g_qn_b = ap_->in[11]; const float* const g_kn_b = ap_->in[12]; const float* const g_mem = ap_->in[13]; const float* const w_mem_kv = ap_->in[14]; \
    const float* const g_qn_m = ap_->in[15]; const float* const g_kn_m = ap_->in[16]; const float* const w_branch = ap_->in[17]; const float* const w_out = ap_->in[18]; \
    bf16* const WinT = (bf16*)(ws + WS_WIN); bf16* const WuqT = (bf16*)(ws + WS_WUQ); bf16* const WukvT = (bf16*)(ws + WS_WUKV); bf16* const WmemT = (bf16*)(ws + WS_WMEM); \
    bf16* const WbrT = (bf16*)(ws + WS_WBR); bf16* const WoutT = (bf16*)(ws + WS_WOUT); \
    float* const ropeA = (float*)(ws + WS_ROPEA); float* const ropeB = (float*)(ws + WS_ROPEB); \
    bf16* const MN = (bf16*)(ws + WS_MN); bf16* const KVM = (bf16*)(ws + WS_KVM); bf16* const VTM = (bf16*)(ws + WS_VTM); \
    float* const WI = (float*)(ws + WS_WI); unsigned* const MASK = (unsigned*)(ws + WS_MASK); \
    bf16* const VTA = (bf16*)(dob + DO_VTA); bf16* const VTB = (bf16*)(dob + DO_VTB); bf16* const KB = (bf16*)(dob + DO_KB); \
    bf16* const Hh = (bf16*)(ws + WS_H); bf16* const MG = (bf16*)(ws + WS_H); bf16* const QB = (bf16*)(ws + WS_QB); \
    bf16* const KVB = (bf16*)(ws + WS_KVB); bf16* const GT0 = (bf16*)(dob + DO_G0); bf16* const GT1 = (bf16*)(ws + WS_G1); bf16* const P = (bf16*)(ws + WS_P); \
    (void)lane; (void)NGW; (void)gw; (void)ctl; \
    (void)pos; (void)outp; (void)x; (void)mem; (void)g_norm; (void)w_in; (void)g_qn_a; (void)g_kn_a; (void)g_cq; (void)g_ckv; (void)w_uq; (void)w_ukv; (void)g_qn_b; (void)g_kn_b; (void)g_mem; (void)w_mem_kv; \
    (void)g_qn_m; (void)g_kn_m; (void)w_branch; (void)w_out; (void)WinT; (void)WuqT; (void)WukvT; (void)WmemT; (void)WbrT; (void)WoutT; (void)ropeA; (void)ropeB; (void)MN; (void)KVM; (void)VTM; (void)WI; (void)MASK; \
    (void)VTA; (void)VTB; (void)Hh; (void)KB; (void)QB; (void)KVB; (void)MG; (void)GT0; (void)GT1; (void)P
#define GRID_BARRIER() do { kargs_t bp_ = (kargs_t)__builtin_amdgcn_kernarg_segment_ptr(); asm volatile("" : "+s"(bp_)); \
    XcdBarrier b_; b_.bar = (unsigned*)(bp_->ws + WS_CTL) + 4096; b_.x = xb_xcc_id(); b_.st = (volatile LAS unsigned*)(lds + LDS_BYTES - 32); xcd_barrier(b_); } while (0)

__global__ void __launch_bounds__(512, 2) fwd_kernel(Args a) {
    extern __shared__ __attribute__((aligned(16))) unsigned char lds_raw[];
    LAS unsigned char* const lds = (LAS unsigned char*)lds_raw;
    volatile LAS int* const slot = (volatile LAS int*)(lds + LDS_SLOT);
    if (threadIdx.x < 16) ((LAS unsigned*)(lds + LDS_BYTES - 64))[threadIdx.x] = 0u;
    __syncthreads();
    (void)xcd_barrier_post((unsigned*)(a.ws + WS_CTL) + 4096, (volatile LAS unsigned*)(lds + LDS_BYTES - 32));

    for (int rep = 0; rep < REP_P0; ++rep) { PHASE_BEGIN;
        LAS float* scr = (LAS float*)(lds + wave * 16384);
        constexpr int I_IN = 16 * (NP / 32), I_UQ = 6 * 24, I_UKV = 4 * 32, I_MEM = 16 * 32, I_BR = 8 * 32, I_OUT = 16 * 32;
        constexpr int NITEMS = I_IN + I_UQ + I_UKV + I_MEM + 3 * I_BR + I_OUT;
        for (int it = gw; it < NITEMS; it += NGW) {
            int r = it;
            if (r < I_IN) { transpose_item<true>(w_in, 1024, DIN, NP, WinT, scr, r, lane); continue; } r -= I_IN;
            if (r < I_UQ) { transpose_item<false>(w_uq, 384, 768, 768, WuqT, scr, r, lane); continue; } r -= I_UQ;
            if (r < I_UKV) { transpose_item<false>(w_ukv, 256, 1024, 1024, WukvT, scr, r, lane); continue; } r -= I_UKV;
            if (r < I_MEM) { transpose_item<false>(w_mem_kv, 1024, 1024, 1024, WmemT, scr, r, lane); continue; } r -= I_MEM;
            if (r < 3 * I_BR) { const int nb = r / I_BR; transpose_item<false>(w_branch + (size_t)nb * 512 * 1024, 512, 1024, 1024, WbrT + (size_t)nb * 1024 * 512, scr, r % I_BR, lane); continue; } r -= 3 * I_BR;
            transpose_item<false>(w_out, 1024, 1024, 1024, WoutT, scr, r, lane);
        }
        for (int idx = blockIdx.x * 512 + tid; idx < TT * 24; idx += G * 512) {
            const int t = idx / 24, i = idx % 24; const float pf = (float)pos[t];
            if (i < 8) { const float ang = pf * INVA[i]; ropeA[t * 16 + i] = cosf(ang); ropeA[t * 16 + 8 + i] = sinf(ang); }
            else { const int j = i - 8; const float ang = pf * INVB[j]; ropeB[t * 32 + j] = cosf(ang); ropeB[t * 32 + 16 + j] = sinf(ang); }
        }
        for (int m = gw; m < NB * MEML; m += NGW) rms_row_1024(mem + (size_t)m * DM, g_mem, MN + (size_t)m * DM, lane);
        for (int rp = 0; rp < REP_PH; ++rp)
        for (int m = gw; m < TT; m += NGW) rms_row_1024(x + (size_t)m * DM, g_norm, Hh + (size_t)m * DM, lane);
    }
    GRID_BARRIER();
    for (int es = 0; es < EXTRA_SYNCS; ++es) GRID_BARRIER();

    for (int rep = 0; rep < REP_G1; ++rep) { PHASE_BEGIN;
        pg8::Gemm g{Hh, WinT, TT, PP, 1024, 1024}; pg8::StaticOrder S; S.init(TT, PP, G, (int)blockIdx.x);
        pg8::EpiBf16<0> E{P, PP, nullptr, 0, 0, 1.f};
        pg8::gemm_phase<pg8::EpiBf16<0>, pg8::StaticOrder, true, true>(lds, g, S, E);
    }
    { PHASE_BEGIN;
        pg8::Gemm g{MN, WmemT, NB * MEML, 1024, 1024, 1024}; pg8::StaticOrder S; S.init(NB * MEML, 1024, G, (int)((blockIdx.x + 64) % G));
        pg8::EpiBf16<0> E{KVM, 1024, nullptr, 0, 0, 1.f};
        pg8::gemm_phase<pg8::EpiBf16<0>, pg8::StaticOrder, true, true>(lds, g, S, E);
    }
    GRID_BARRIER();
    { PHASE_BEGIN;
        float ga[8], gk[8], gq[8], gc[8], gm[8];
#pragma unroll
        for (int j = 0; j < 8; ++j) { ga[j] = g_qn_a[8 * (lane & 7) + j]; gk[j] = g_kn_a[8 * (lane & 7) + j]; gm[j] = g_qn_m[8 * (lane & 15) + j]; gq[j] = lane < 48 ? g_cq[8 * lane + j] : 0.f; gc[j] = lane < 32 ? g_ckv[8 * lane + j] : 0.f; }
        for (int dp = 0; dp < DUMMY_POST1; ++dp)
            for (int m = gw; m < TT; m += NGW)
                post1_row(P + (size_t)m * PP, QB + (size_t)(m & 1023) * 4096, ropeA + (size_t)m * 16, ga, gk, gq, gc, gm, (float*)KVB + (size_t)m * 8, lane);
        for (int m = gw; m < TT; m += NGW)
            post1_row(P + (size_t)m * PP, P + (size_t)m * PP, ropeA + (size_t)m * 16, ga, gk, gq, gc, gm, WI + (size_t)m * 8, lane);
        for (int rt = 0; rt < REP_TR; ++rt)
        transpose_v(P, PP, C_VA, 64, 8, 64, SEQ, NB, VTA, gw, NGW, lane);
        for (int m = gw; m < NB * MEML; m += NGW) km_row(KVM + (size_t)m * 1024, g_kn_m, lane);
        for (int rt = 0; rt < REP_TR; ++rt)
        transpose_v(KVM, 1024, 512, 128, 4, 128, MEML, NB, VTM, gw, NGW, lane);
    }
    GRID_BARRIER();
    for (int rep = 0; rep < REP_G2; ++rep) { PHASE_BEGIN;
        pg8::Gemm g{P + C_CQ, WuqT, TT, 768, 384, PP}; pg8::StaticOrder S; S.init(TT, 768, G, (int)blockIdx.x);
        pg8::EpiBf16<0> E{QB, 768, nullptr, 0, 0, 1.f};
        pg8::gemm_phase<pg8::EpiBf16<0>, pg8::StaticOrder, true, true>(lds, g, S, E);
    }
    for (int rep = 0; rep < REP_G2; ++rep) { PHASE_BEGIN;
        pg8::Gemm g{P + C_CKV, WukvT, TT, 1024, 256, PP}; pg8::StaticOrder S; S.init(TT, 1024, G, (int)((blockIdx.x + 192) % G));
        pg8::EpiBf16<0> E{KVB, 1024, nullptr, 0, 0, 1.f};
        pg8::gemm_phase<pg8::EpiBf16<0>, pg8::StaticOrder, true, true>(lds, g, S, E);
    }
    for (int rep = 0; rep < REP_IDX; ++rep) { if (rep > 0) GRID_BARRIER();
        PHASE_BEGIN;
        unsigned* const q_idx = ctl + 64 * (0 + 4 * rep);
        for (;;) {
            const int u = next_unit(q_idx, slot);
            if (u >= NB * 128) break;
            const int tb = 127 - (u >> 3), bb = u & 7;
            indexer_unit((LAS float*)lds, P, WI, MASK, bb, tb);
        }
    }
    GRID_BARRIER();
    { PHASE_BEGIN;
        LAS float* scr = (LAS float*)(lds + wave * 8192);
        float gqv[12], gkv[12];
#pragma unroll
        for (int e = 0; e < 12; ++e) { gqv[e] = g_qn_b[12 * (lane & 7) + e]; gkv[e] = g_kn_b[12 * (lane & 7) + e]; }
        for (int dp = 0; dp < DUMMY_POST2; ++dp)
            for (int m = gw; m < TT; m += NGW)
                post2_row(QB + (size_t)m * 768, (bf16*)MASK + (size_t)(m & 1023) * 768, KVB + (size_t)m * 1024, P + (size_t)m * PP, (bf16*)MASK + (size_t)(1024 + (m & 1023)) * 768, ropeB + (size_t)m * 32, gqv, gkv, scr, lane);
        for (int m = gw; m < TT; m += NGW)
            post2_row(QB + (size_t)m * 768, QB + (size_t)m * 768, KVB + (size_t)m * 1024, P + (size_t)m * PP, KB + (size_t)m * 768, ropeB + (size_t)m * 32, gqv, gkv, scr, lane);
        for (int rt = 0; rt < REP_TR; ++rt)
        transpose_v(KVB, 1024, 64, 128, 8, 64, SEQ, NB, VTB, gw, NGW, lane);
    }
    GRID_BARRIER();
    for (int rep = 0; rep < REP_ATT; ++rep) { if (rep > 0) GRID_BARRIER();
        PHASE_BEGIN;
        unsigned* const q_att = ctl + 64 * (1 + 4 * rep);
        for (;;) {
            const int u = next_unit(q_att, slot);
            if (u >= 1280) break;
            if (u < 1024) {
                const int qb = 7 - (u >> 7), wi = u & 127, bh = wi & 63, bb = bh >> 3, h = bh & 7;
                const size_t r0 = (size_t)bb * SEQ;
                if (wi < 64) attn_unit_pipe<96, 1>(lds, QB + r0 * 768 + h * 96, 768, KB + r0 * 768 + h * 96, 768, VTB + (size_t)((bb * 8 + h) * 64) * SEQ, SEQ, nullptr,
                                                   P + r0 * PP + C_YB + h * 64, qb * 256);
                else attn_unit_pipe<64, 2>(lds, P + r0 * PP + C_QA + h * 64, PP, P + r0 * PP + C_KA + h * 64, PP, VTA + (size_t)((bb * 8 + h) * 64) * SEQ, SEQ, MASK + r0 * 64,
                                           P + r0 * PP + C_YA + h * 64, qb * 256);
            } else {
                const int v = u - 1024, qb = v & 7, bh = v >> 3, bb = bh >> 2, h = bh & 3;
                const size_t r0 = (size_t)bb * SEQ;
                att_call<128, 128, 0>(rep == 0 && REP_ATT > 1, lds, P + r0 * PP + C_QM + h * 128, PP, KVM + (size_t)bb * MEML * 1024 + h * 128, 1024, VTM + (size_t)((bb * 4 + h) * 128) * MEML, MEML, nullptr,
                                       P + r0 * PP + C_ZM + h * 128, P + r0 * PP + C_YM + h * 128, qb * 256);
            }
        }
    }
    GRID_BARRIER();
    for (int rep = 0; rep < 1; ++rep) { PHASE_BEGIN;
        pg8::Gemm g{Hh, WinT + (size_t)PP * 1024, TT, NZG, 1024, 1024}; pg8::StaticOrder S; S.init(TT, NZG, G, (int)blockIdx.x);
        EpiZG E{P, GT0, GT1};
        pg8::gemm_phase<EpiZG, pg8::StaticOrder, true, true>(lds, g, S, E);
    }
    GRID_BARRIER();
    for (int nbr = 0; nbr < 3 * REP_G4; ++nbr) { const int nb = nbr % 3; PHASE_BEGIN;
        pg8::Gemm g{P + (nb == 0 ? C_YA : (nb == 1 ? C_YB : C_YM)), WbrT + (size_t)nb * 1024 * 512, TT, 1024, 512, PP}; pg8::StaticOrder S; S.init(TT, 1024, G, (int)blockIdx.x);
        EpiMerge E{MG, GT0, GT1, nb};
        pg8::gemm_phase<EpiMerge, pg8::StaticOrder, true, true>(lds, g, S, E);
    }
    GRID_BARRIER();
    for (int rep = 0; rep < REP_G5; ++rep) { PHASE_BEGIN;
        pg8::Gemm g{MG, WoutT, TT, 1024, 1024, 1024}; pg8::StaticOrder S; S.init(TT, 1024, G, (int)blockIdx.x);
        EpiOut E{x, outp};
        pg8::gemm_phase<EpiOut, pg8::StaticOrder, true, true>(lds, g, S, E);
    }
}

extern "C" void kernel_launch(void* const* d_in, const int* in_sizes, int n_in, void* d_out, int out_size, void* d_ws, size_t ws_size, hipStream_t stream) {
    static int grid = 0;
    if (grid == 0) {
        if (n_in != 19 || out_size != TT * DM || ws_size < WS_END) { fprintf(stderr, "kernel_launch: unexpected problem (n_in %d, out %d, ws %zu); nothing launched\n", n_in, out_size, ws_size); grid = -1; return; }
        int dev = 0, cus = 0, per_cu = 0;
        if (hipGetDevice(&dev) != hipSuccess || hipDeviceGetAttribute(&cus, hipDeviceAttributeMultiprocessorCount, dev) != hipSuccess) { grid = -1; return; }
        if (hipFuncSetAttribute((const void*)fwd_kernel, hipFuncAttributeMaxDynamicSharedMemorySize, LDS_BYTES) != hipSuccess) { fprintf(stderr, "kernel_launch: hipFuncSetAttribute failed\n"); grid = -1; return; }
        if (hipOccupancyMaxActiveBlocksPerMultiprocessor(&per_cu, (const void*)fwd_kernel, 512, LDS_BYTES) != hipSuccess || per_cu < 1) { fprintf(stderr, "kernel_launch: occupancy query reports %d blocks per CU\n", per_cu); (void)hipGetLastError(); grid = -1; return; }
        grid = cus;
    }
    if (grid < 0) return;
    (void)hipMemsetAsync((char*)d_ws + WS_CTL, 0, 65536, stream);
    Args a{};
    for (int i = 0; i < 19; ++i) a.in[i] = (const float*)d_in[i];
    a.pos = (const int*)d_in[2]; a.out = (float*)d_out; a.ws = (unsigned char*)d_ws;
    hipLaunchKernelGGL(fwd_kernel, dim3(grid), dim3(512), LDS_BYTES, stream, a);
    const hipError_t e = hipPeekAtLastError();
    if (e != hipSuccess) fprintf(stderr, "kernel_launch: launch failed: %s (grid %d)\n", hipGetErrorString(e), grid);
}
```

```cpp
#include <hip/hip_runtime.h>
#include <cstdio>
#include <cstdint>
namespace pg8 {
#define PG8_LAS __attribute__((address_space(3)))
typedef unsigned short bf16_t;
typedef short bf16x8 __attribute__((ext_vector_type(8)));
typedef float f32x4 __attribute__((ext_vector_type(4)));
typedef unsigned u32x4 __attribute__((ext_vector_type(4)));
constexpr int BM = 256, BK = 64, HALF = 128, HTB = HALF * BK * 2  , STAGE_BYTES = 8 * HTB, NXCD = 8, WGM = 8;

__host__ __device__ __forceinline__ int lds_byte(int r, int c) { const int st = (r >> 4) * 2 + (c >> 5), rr = r & 15, cc = c & 31, ob = rr * 64 + cc * 2; return st * 1024 + (ob ^ (((ob >> 9) & 1) << 5)); }
__host__ __device__ __forceinline__ void stage_rc(int b, int& R, int& C) { const int st = b / 1024, sb = b % 1024, swz = sb ^ (((sb >> 9) & 1) << 5); R = (st >> 1) * 16 + swz / 64; C = (st & 1) * 32 + (swz % 64) / 2; }
__host__ __device__ __forceinline__ int perm32(int rho) { const int n = rho >> 4, i = rho & 15; return 8 * (i >> 2) + 4 * n + (i & 3); }

struct Unit { int pm, pn; };
struct Gemm { const bf16_t* A; const bf16_t* Bt; int M, N, K, lda; };

struct StaticOrder {
    int nM, nN, nwg, G, c;
    __host__ __device__ void init(int M, int N, int G_, int c_) { nM = M / BM; nN = N / BM; nwg = nM * nN; G = G_; c = c_; }
    __host__ __device__ bool next(int i, Unit& u) const {
        const long L = (long)i * G + c; if (L >= nwg) return false;
        int wgid = (int)L; { const int q = nwg / NXCD, r = nwg % NXCD, xcd = wgid % NXCD, off = wgid / NXCD; wgid = (xcd < r ? xcd * (q + 1) : r * (q + 1) + (xcd - r) * q) + off; }
        const int nig = WGM * nN, gid = wgid / nig, fm = gid * WGM, gsz = (nM - fm) < WGM ? (nM - fm) : WGM;
        u.pm = fm + ((wgid % nig) % gsz); u.pn = (wgid % nig) / gsz; return true;
    }
    __device__ __forceinline__ void a_ready(const Unit&) const {}
    __device__ __forceinline__ void done(const Unit&) const {}
};

__device__ __forceinline__ unsigned cvt_pk_bf16(float lo, float hi) { unsigned r; asm volatile("v_cvt_pk_bf16_f32 %0, %1, %2" : "=v"(r) : "v"(lo), "v"(hi)); return r; }
typedef float f32x2 __attribute__((ext_vector_type(2)));
__device__ __forceinline__ f32x2 gelu_pk(f32x2 v) {
    const f32x2 av = __builtin_elementwise_abs(v), d = av * 0.2316418882f + 1.0f;
    f32x2 t; t.x = __builtin_amdgcn_rcpf(d.x); t.y = __builtin_amdgcn_rcpf(d.y);
    f32x2 q = t * 0.5307027145f + (-0.7265760135f); q = q * t + 0.7107068705f; q = q * t + (-0.142248368f); q = q * t + 0.127414796f; q = q * t;
    const f32x2 s = (v * v) * (-0.72134752044f);
    f32x2 e; e.x = __builtin_amdgcn_exp2f(s.x); e.y = __builtin_amdgcn_exp2f(s.y);
    const f32x2 m = v * (q * e), r = v - m;
    f32x2 o; o.x = v.x < 0.f ? m.x : r.x; o.y = v.y < 0.f ? m.y : r.y; return o;
}

template <int ACT  > struct EpiBf16 {
    static constexpr bool PERM = true, AFTER_DRAIN = false; static_assert(ACT == 0 || ACT == 1, "EpiBf16: ACT is 0 (none) or 1 (gelu_pk)");
    bf16_t* O; int ldc; const float* bias; int split_cols; size_t split_stride; float scale0;
    __device__ __forceinline__ void operator()(const f32x4 (&acc)[2][2][4][2], const Unit& u, int wr, int wc, int fr, int fq) const {
        const int row0 = u.pm * BM + wr * 64 + fr; int colt = u.pn * BM; bf16_t* base = O;
        float sc = 1.f; if (split_cols) { const int t = colt / split_cols; base += (size_t)t * split_stride; colt -= t * split_cols; if (t == 0) sc = scale0; }
        const int col0 = colt + wc * 32 + 8 * fq, bcol0 = u.pn * BM + wc * 32 + 8 * fq;
        f32x4 bv[2][2];
#pragma unroll
        for (int bj = 0; bj < 2; ++bj)
#pragma unroll
            for (int n = 0; n < 2; ++n) bv[bj][n] = bias ? *(const f32x4*)(bias + bcol0 + bj * HALF + 4 * n) : (f32x4){0.f, 0.f, 0.f, 0.f};
#pragma unroll
        for (int ai = 0; ai < 2; ++ai)
#pragma unroll
            for (int m = 0; m < 4; ++m) { bf16_t* rowp = base + (size_t)(row0 + ai * HALF + m * 16) * ldc + col0;
#pragma unroll
                for (int bj = 0; bj < 2; ++bj) { f32x4 v0 = acc[ai][bj][m][0] + bv[bj][0], v1 = acc[ai][bj][m][1] + bv[bj][1];
                    if (ACT == 1) { f32x2 a = gelu_pk((f32x2){v0[0], v0[1]}), b = gelu_pk((f32x2){v0[2], v0[3]}), c = gelu_pk((f32x2){v1[0], v1[1]}), d = gelu_pk((f32x2){v1[2], v1[3]});
                        v0 = (f32x4){a.x, a.y, b.x, b.y}; v1 = (f32x4){c.x, c.y, d.x, d.y}; }
                    v0 = v0 * sc; v1 = v1 * sc; u32x4 w; w.x = cvt_pk_bf16(v0[0], v0[1]); w.y = cvt_pk_bf16(v0[2], v0[3]); w.z = cvt_pk_bf16(v1[0], v1[1]); w.w = cvt_pk_bf16(v1[2], v1[3]);
                    *(u32x4*)(rowp + bj * HALF) = w; } }
    }
};
template <class Epi, class Sched, bool ALIGN_EPI = false, bool SP2 = false>
__device__ __forceinline__ void gemm_phase(PG8_LAS unsigned char* lds, const Gemm g, const Sched& S, const Epi& E) {
    int tid_ = threadIdx.x; asm volatile("" : "+v"(tid_));
    const int tid = tid_, wid = __builtin_amdgcn_readfirstlane(tid >> 6), lane = tid & 63, wr = wid >> 2, wc = wid & 3, fr = lane & 15, fq = lane >> 4;
    const int K = g.K, nt = K / BK;
    unsigned voffA[2], voffB[2];
#pragma unroll
    for (int i = 0; i < 2; ++i) { int R, C; stage_rc(tid * 16 + i * 8192, R, C); const int Rb = Epi::PERM ? ((R & ~31) + perm32(R & 31)) : R;
        voffA[i] = (unsigned)(R * g.lda + C) * 2u; voffB[i] = (unsigned)(Rb * K + C) * 2u; }
    const size_t kstep = (size_t)(BK * 2);
    const size_t hstepA = (size_t)HALF * g.lda * 2, hstepB = (size_t)HALF * K * 2;
    const size_t tstepA = 2 * hstepA, tstepB = 2 * hstepB;
    const unsigned ldsw = (unsigned)wid * 1024u;
    const int aoff = lds_byte(wr * 64 + fr, fq * 8), boff = lds_byte(wc * 32 + fr, fq * 8);
#define PG8_SA(b, h) (((b) * 2 + (h)) * HTB)
#define PG8_SB(b, h) ((4 + (b) * 2 + (h)) * HTB)
#define PG8_STAGE(bufoff, gbase, voff) do { _Pragma("unroll") for (int _i = 0; _i < 2; ++_i) \
        __builtin_amdgcn_global_load_lds((const unsigned*)((const char*)(gbase) + (voff)[_i]), (PG8_LAS unsigned*)(lds + (bufoff) + ldsw + _i * 8192), 16, 0, 0); } while (0)
#define PG8_LDA(dst, b, h) do { _Pragma("unroll") for (int m = 0; m < 4; ++m) _Pragma("unroll") for (int k = 0; k < 2; ++k) dst[m][k] = *(const PG8_LAS bf16x8*)(lds + PG8_SA(b, h) + aoff + m * 2048 + k * 1024); } while (0)
#define PG8_LDB(dst, b, h) do { _Pragma("unroll") for (int n = 0; n < 2; ++n) _Pragma("unroll") for (int k = 0; k < 2; ++k) dst[n][k] = *(const PG8_LAS bf16x8*)(lds + PG8_SB(b, h) + boff + n * 2048 + k * 1024); } while (0)
#define PG8_MMA(ai, bj, At, Bt) do { __builtin_amdgcn_s_setprio(1); _Pragma("unroll") for (int m = 0; m < 4; ++m) _Pragma("unroll") for (int n = 0; n < 2; ++n) _Pragma("unroll") for (int k = 0; k < 2; ++k) \
        acc[ai][bj][m][n] = __builtin_amdgcn_mfma_f32_16x16x32_bf16(Bt[n][k], At[m][k], acc[ai][bj][m][n], 0, 0, 0); __builtin_amdgcn_s_setprio(0); } while (0)
#define PG8_WAIT_V(n) asm volatile("s_waitcnt vmcnt(" #n ")" ::: "memory")
#define PG8_WAIT_L(n) asm volatile("s_waitcnt lgkmcnt(" #n ")" ::: "memory")
#define PG8_BAR __builtin_amdgcn_s_barrier()
#define PG8_SCHED __builtin_amdgcn_sched_barrier(0)
    Unit cur, nxt; int ui = 0;
    if (!S.next(0, cur)) return;
    f32x4 acc[2][2][4][2];
#pragma unroll
    for (int a = 0; a < 2; ++a)
#pragma unroll
        for (int b = 0; b < 2; ++b)
#pragma unroll
            for (int m = 0; m < 4; ++m)
#pragma unroll
                for (int n = 0; n < 2; ++n) acc[a][b][m][n] = (f32x4){0.f, 0.f, 0.f, 0.f};
    bf16x8 At[4][2], B0[2][2], B1[2][2];
    const char* cA = (const char*)g.A + (size_t)cur.pm * tstepA; const char* cB = (const char*)g.Bt + (size_t)cur.pn * tstepB;
    S.a_ready(cur);
    if constexpr (SP2) {
        PG8_STAGE(PG8_SB(0, 0), cB, voffB); PG8_STAGE(PG8_SB(0, 1), cB + hstepB, voffB); PG8_STAGE(PG8_SA(0, 0), cA, voffA); PG8_STAGE(PG8_SA(0, 1), cA + hstepA, voffA);
        if (wr == 1) PG8_BAR;
        PG8_WAIT_V(2); PG8_BAR;
        PG8_STAGE(PG8_SB(1, 0), cB + kstep, voffB); PG8_STAGE(PG8_SA(1, 0), cA + kstep, voffA); PG8_STAGE(PG8_SB(1, 1), cB + hstepB + kstep, voffB);
        PG8_WAIT_V(6); PG8_BAR;
    } else {
        PG8_STAGE(PG8_SB(0, 0), cB, voffB); PG8_STAGE(PG8_SA(0, 0), cA, voffA); PG8_STAGE(PG8_SB(0, 1), cB + hstepB, voffB); PG8_STAGE(PG8_SA(0, 1), cA + hstepA, voffA);
        if (wr == 1) PG8_BAR;
        PG8_WAIT_V(4); PG8_BAR;
        PG8_STAGE(PG8_SB(1, 0), cB + kstep, voffB); PG8_STAGE(PG8_SA(1, 0), cA + kstep, voffA); PG8_STAGE(PG8_SB(1, 1), cB + hstepB + kstep, voffB);
        PG8_WAIT_V(6); PG8_BAR;
    }
    for (;;) {
        const bool has_next = S.next(ui + 1, nxt);
        const char* nA = has_next ? (const char*)g.A + (size_t)nxt.pm * tstepA : cA; const char* nB = has_next ? (const char*)g.Bt + (size_t)nxt.pn * tstepB : cB;
        for (int t = 0; t < nt; t += 2) {
            const bool last = (t == nt - 2);
            const char* a1 = cA + (size_t)(t + 1) * kstep;
            const char* a2 = last ? nA : cA + (size_t)(t + 2) * kstep; const char* b2 = last ? nB : cB + (size_t)(t + 2) * kstep;
            const char* a3 = a2 + kstep; const char* b3 = b2 + kstep;
            if (last && has_next) S.a_ready(nxt);
            if constexpr (SP2) {
            PG8_LDB(B0, 0, 0); PG8_LDB(B1, 0, 1); PG8_SCHED; PG8_LDA(At, 0, 0); PG8_STAGE(PG8_SA(1, 1), a1 + hstepA, voffA);
            PG8_WAIT_V(8); PG8_WAIT_L(0); PG8_BAR; PG8_MMA(0, 0, At, B0); PG8_MMA(0, 1, At, B1); PG8_BAR; PG8_SCHED;
            PG8_LDA(At, 0, 1); PG8_STAGE(PG8_SB(0, 0), b2, voffB); PG8_STAGE(PG8_SB(0, 1), b2 + hstepB, voffB); PG8_STAGE(PG8_SA(0, 0), a2, voffA);
            PG8_WAIT_V(8); PG8_WAIT_L(0); PG8_BAR; PG8_MMA(1, 0, At, B0); PG8_MMA(1, 1, At, B1); PG8_BAR; PG8_SCHED;
            PG8_LDB(B0, 1, 0); PG8_LDB(B1, 1, 1); PG8_SCHED; PG8_LDA(At, 1, 0); PG8_STAGE(PG8_SA(0, 1), a2 + hstepA, voffA);
            PG8_WAIT_V(8); PG8_WAIT_L(0); PG8_BAR; PG8_MMA(0, 0, At, B0); PG8_MMA(0, 1, At, B1); PG8_BAR; PG8_SCHED;
            PG8_LDA(At, 1, 1); PG8_STAGE(PG8_SB(1, 0), b3, voffB); PG8_STAGE(PG8_SB(1, 1), b3 + hstepB, voffB); PG8_STAGE(PG8_SA(1, 0), a3, voffA);
            PG8_WAIT_V(8); PG8_WAIT_L(0); PG8_BAR; PG8_MMA(1, 0, At, B0); PG8_MMA(1, 1, At, B1); PG8_BAR; PG8_SCHED;
            } else {
            PG8_LDB(B0, 0, 0); PG8_SCHED; PG8_LDA(At, 0, 0); PG8_STAGE(PG8_SA(1, 1), a1 + hstepA, voffA);
            PG8_WAIT_L(8); PG8_BAR; PG8_WAIT_L(0); PG8_MMA(0, 0, At, B0); PG8_BAR; PG8_SCHED;
            PG8_LDB(B1, 0, 1); PG8_STAGE(PG8_SB(0, 0), b2, voffB);
            PG8_BAR; PG8_WAIT_L(0); PG8_MMA(0, 1, At, B1); PG8_BAR;
            PG8_LDA(At, 0, 1); PG8_STAGE(PG8_SA(0, 0), a2, voffA);
            PG8_BAR; PG8_WAIT_L(0); PG8_MMA(1, 0, At, B0); PG8_BAR; PG8_SCHED;
            PG8_STAGE(PG8_SB(0, 1), b2 + hstepB, voffB);
            PG8_WAIT_V(6); PG8_BAR; PG8_MMA(1, 1, At, B1); PG8_BAR;
            PG8_LDB(B0, 1, 0); PG8_SCHED; PG8_LDA(At, 1, 0); PG8_STAGE(PG8_SA(0, 1), a2 + hstepA, voffA);
            PG8_WAIT_L(8); PG8_BAR; PG8_WAIT_L(0); PG8_MMA(0, 0, At, B0); PG8_BAR; PG8_SCHED;
            PG8_LDB(B1, 1, 1); PG8_STAGE(PG8_SB(1, 0), b3, voffB);
            PG8_BAR; PG8_WAIT_L(0); PG8_MMA(0, 1, At, B1); PG8_BAR;
            PG8_LDA(At, 1, 1); PG8_STAGE(PG8_SA(1, 0), a3, voffA);
            PG8_BAR; PG8_WAIT_L(0); PG8_MMA(1, 0, At, B0); PG8_BAR; PG8_SCHED;
            PG8_STAGE(PG8_SB(1, 1), b3 + hstepB, voffB);
            PG8_WAIT_V(6); PG8_BAR; PG8_MMA(1, 1, At, B1); PG8_BAR;
            }
        }
        if constexpr (ALIGN_EPI) { if (wr == 0) PG8_BAR; }
        if constexpr (!Epi::AFTER_DRAIN) { E(acc, cur, wr, wc, fr, fq); S.done(cur); }
        if (!has_next) break;
#pragma unroll
        for (int a = 0; a < 2; ++a)
#pragma unroll
            for (int b = 0; b < 2; ++b)
#pragma unroll
                for (int m = 0; m < 4; ++m)
#pragma unroll
                    for (int n = 0; n < 2; ++n) acc[a][b][m][n] = (f32x4){0.f, 0.f, 0.f, 0.f};
        cur = nxt; cA = nA; cB = nB; ++ui;
        if constexpr (ALIGN_EPI) { if (wr == 1) PG8_BAR; }
    }
    PG8_WAIT_V(0);
    if constexpr (!ALIGN_EPI) { if (wr == 0) PG8_BAR; }
    PG8_BAR;
    if constexpr (Epi::AFTER_DRAIN) { E.fused(acc, cur, wr, wc, fr, fq, lds, wid, lane); S.done(cur); }
#undef PG8_SA
#undef PG8_SB
#undef PG8_STAGE
#undef PG8_LDA
#undef PG8_LDB
#undef PG8_MMA
#undef PG8_WAIT_V
#undef PG8_WAIT_L
#undef PG8_BAR
#undef PG8_SCHED
}
}

#define LAS __attribute__((address_space(3)))
typedef unsigned short bf16;
typedef unsigned v4u __attribute__((ext_vector_type(4)));
typedef unsigned v2u __attribute__((ext_vector_type(2)));
typedef float f32x4 __attribute__((ext_vector_type(4)));
typedef float f32x16 __attribute__((ext_vector_type(16)));
typedef short bf16x8 __attribute__((ext_vector_type(8)));
typedef short s16x4 __attribute__((ext_vector_type(4)));
typedef float f32x2_t __attribute__((ext_vector_type(2)));
typedef __bf16 bf16x2_t __attribute__((ext_vector_type(2)));

constexpr int NB = 8, SEQ = 2048, DM = 1024, TT = NB * SEQ;
constexpr int DIN = 7912, NP = 7936;
constexpr int PP = 3840, NZG = 4096;
constexpr int MEML = 256;
constexpr float EPS = 1e-6f, NEGF = -1e30f;
constexpr int C_QA = 0, C_KA = 512, C_VA = 1024, C_QI = 1536, C_KI = 2048, C_WI = 2112, C_CQ = 2120, C_CKV = 2504, C_KR = 2760, C_QM = 2792, C_ZM = 3304;
constexpr int C_YA = C_QI, C_YB = C_CQ, C_YM = C_VA;
constexpr float SCALE_A = 0.18033688011112042f;
constexpr float SCALE_B = 0.14724444602590306f;
constexpr float SCALE_M = 0.12751743082459868f;
constexpr float SCALE_I = 0.04419417382415922f;

__constant__ float INVA[8] = {1.0f, 0.1939227432012558f, 0.03760603070259094f, 0.007292664609849453f, 0.0014142135623842478f, 0.00027424818836152554f, 5.3182957344688475e-05f, 1.0313385246263351e-05f};
__constant__ float INVB[16] = {1.0f, 0.44036659598350525f, 0.1939227432012558f, 0.08539710193872452f, 0.03760603070259094f, 0.016560440883040428f, 0.007292664609849453f, 0.0032114461064338684f, 0.0014142135623842478f, 0.0006227724370546639f, 0.00027424818836152554f, 0.00012076973507646471f, 5.3182957344688475e-05f, 2.34199997066753e-05f, 1.0313385246263351e-05f, 4.541670477919979e-06f};

constexpr size_t MiB = 1u << 20;
constexpr size_t WS_CTL = 0;
constexpr size_t WS_WIN = 1 * MiB;
constexpr size_t WS_WUQ = 17 * MiB;
constexpr size_t WS_WUKV = 18 * MiB;
constexpr size_t WS_WMEM = 19 * MiB;
constexpr size_t WS_WBR = 21 * MiB;
constexpr size_t WS_WOUT = 24 * MiB;
constexpr size_t WS_ROPEA = 26 * MiB;
constexpr size_t WS_ROPEB = 27 * MiB;
constexpr size_t WS_MN = 29 * MiB;
constexpr size_t WS_KVM = 33 * MiB;
constexpr size_t WS_VTM = 37 * MiB;
constexpr size_t WS_WI = 39 * MiB;
constexpr size_t WS_MASK = 40 * MiB;
constexpr size_t WS_H = 44 * MiB;
constexpr size_t WS_P = 76 * MiB;
constexpr size_t WS_QB = 196 * MiB;
constexpr size_t WS_KVB = 220 * MiB;
constexpr size_t WS_G1 = 196 * MiB;
constexpr size_t WS_END = 256 * MiB;
constexpr size_t DO_VTA = 0;
constexpr size_t DO_VTB = 16 * MiB;
constexpr size_t DO_KB = 32 * MiB;
constexpr size_t DO_G0 = 0;

constexpr int REP_P0 = 1, REP_PH = 1, REP_G1 = 1, REP_G2 = 1, REP_IDX = 1, REP_ATT = 1, REP_G4 = 1, REP_G5 = 1;
constexpr int REP_IDX1 = 1, REP_SEL = 1;
constexpr int ATT_STRIP = 0;
constexpr int EXTRA_SYNCS = 0, REP_TR = 1, DUMMY_POST1 = 0, DUMMY_POST2 = 0;
constexpr int LDS_BYTES = 147456;
constexpr int LDS_SLOT = LDS_BYTES - 64;

__device__ __forceinline__ unsigned pk2(float lo, float hi) { f32x2_t v = {lo, hi}; bf16x2_t b = __builtin_convertvector(v, bf16x2_t); return __builtin_bit_cast(unsigned, b); }
__device__ __forceinline__ float bflo(unsigned w) { return __uint_as_float(w << 16); }
__device__ __forceinline__ float bfhi(unsigned w) { return __uint_as_float(w & 0xffff0000u); }
__device__ __forceinline__ float bf1(bf16 b) { return __uint_as_float(((unsigned)b) << 16); }
#define UNPACK8(W_, V_) do { V_[0] = bflo((W_)[0]); V_[1] = bfhi((W_)[0]); V_[2] = bflo((W_)[1]); V_[3] = bfhi((W_)[1]); V_[4] = bflo((W_)[2]); V_[5] = bfhi((W_)[2]); V_[6] = bflo((W_)[3]); V_[7] = bfhi((W_)[3]); } while (0)
#define PACK8(V_) (v4u){pk2(V_[0], V_[1]), pk2(V_[2], V_[3]), pk2(V_[4], V_[5]), pk2(V_[6], V_[7])}
template <int CTRL> __device__ __forceinline__ float dpp_f(float v) { return __int_as_float(__builtin_amdgcn_update_dpp(0, __float_as_int(v), CTRL, 0xF, 0xF, false)); }
#define SUM8(x) do { x += dpp_f<0xB1>(x); x += dpp_f<0x4E>(x); x += dpp_f<0x141>(x); } while (0)
#define SUM16(x) do { SUM8(x); x += dpp_f<0x140>(x); } while (0)
__device__ __forceinline__ float wave_sum(float v) {
    SUM16(v);
    return __int_as_float(__builtin_amdgcn_readlane(__float_as_int(v), 0)) + __int_as_float(__builtin_amdgcn_readlane(__float_as_int(v), 16))
         + __int_as_float(__builtin_amdgcn_readlane(__float_as_int(v), 32)) + __int_as_float(__builtin_amdgcn_readlane(__float_as_int(v), 48));
}
#define LDS_WAIT() asm volatile("s_waitcnt lgkmcnt(0)" ::: "memory")

__device__ __forceinline__ int win_src(int d) {
    if (d < 2120) return d;
    if (d < 2792) return d + 512;
    if (d < 3816) return d + 1024;
    if (d < 3840) return -1;
    if (d < 4352) return d - 3840 + 2120;
    if (d < 4864) return d - 4352 + 3304;
    return d - 4864 + 4840;
}
template <bool REMAP>
__device__ __forceinline__ void transpose_item(const float* W, int K, int N, int Npad, bf16* WT, LAS float* scr, int item, int lane) {
    const int nblk = Npad / 32, kb = item / nblk, nb = item % nblk, k0 = 64 * kb, n0 = 32 * nb;
    const int n4 = 4 * (lane & 7);
    const int nn = REMAP ? win_src(n0 + n4) : n0 + n4; const bool ok = nn >= 0 && nn < N;
#pragma unroll
    for (int i = 0; i < 8; ++i) { const int kk = 8 * i + (lane >> 3);
        f32x4 v = (f32x4){0.f, 0.f, 0.f, 0.f}; if (ok) v = *(const f32x4*)(W + (size_t)(k0 + kk) * N + nn);
        LAS float* d = scr + kk * 33 + n4; d[0] = v[0]; d[1] = v[1]; d[2] = v[2]; d[3] = v[3]; }
    LDS_WAIT(); asm volatile("" ::: "memory");
    const int c = lane & 7;
#pragma unroll
    for (int j = 0; j < 4; ++j) { const int n = (lane >> 3) + 8 * j; const LAS float* s = scr + (8 * c) * 33 + n;
        v4u o; o.x = pk2(s[0 * 33], s[1 * 33]); o.y = pk2(s[2 * 33], s[3 * 33]); o.z = pk2(s[4 * 33], s[5 * 33]); o.w = pk2(s[6 * 33], s[7 * 33]);
        *(v4u*)(WT + (size_t)(n0 + n) * K + k0 + 8 * c) = o; }
    LDS_WAIT(); asm volatile("" ::: "memory");
}
__device__ __forceinline__ void rms_row_1024(const float* xrow, const float* g, bf16* orow, int lane) {
    const f32x4* xr = (const f32x4*)xrow + lane; const f32x4* gr = (const f32x4*)g + lane;
    f32x4 v[4]; float s = 0.f;
#pragma unroll
    for (int j = 0; j < 4; ++j) { v[j] = xr[64 * j]; s += (v[j].x * v[j].x + v[j].y * v[j].y) + (v[j].z * v[j].z + v[j].w * v[j].w); }
    const float rstd = 1.0f / sqrtf(wave_sum(s) * (1.f / 1024.f) + EPS);
    v2u* o8 = (v2u*)orow + lane;
#pragma unroll
    for (int j = 0; j < 4; ++j) { const f32x4 gg = gr[64 * j]; v2u w; w.x = pk2(v[j].x * rstd * gg.x, v[j].y * rstd * gg.y); w.y = pk2(v[j].z * rstd * gg.z, v[j].w * rstd * gg.w); o8[64 * j] = w; }
}

#define ROPE8(v, sub, c8, s8) do { _Pragma("unroll") for (int j_ = 0; j_ < 8; ++j_) { const float pv_ = dpp_f<0xB1>(v[j_]); \
        const float r0_ = v[j_] * c8[j_] - pv_ * s8[j_], r1_ = v[j_] * c8[j_] + pv_ * s8[j_]; v[j_] = (sub) == 0 ? r0_ : ((sub) == 1 ? r1_ : v[j_]); } } while (0)

__device__ __forceinline__ void post1_row(const bf16* Prow, bf16* Orow, const float* ra, const float (&ga)[8], const float (&gk)[8], const float (&gq)[8], const float (&gc)[8], const float (&gm)[8], float* WIrow, int lane) {
    const int sub = lane & 7;
    const v4u z4 = (v4u){0u, 0u, 0u, 0u};
    const v4u w_qa = *(const v4u*)(Prow + C_QA + 8 * lane);
    const v4u w_ka = *(const v4u*)(Prow + C_KA + 8 * lane);
    const v4u w_qi = *(const v4u*)(Prow + C_QI + 8 * lane);
    const v4u w_qm = *(const v4u*)(Prow + C_QM + 8 * lane);
    v4u w_ki = z4, w_cq = z4, w_ckv = z4; float w_wi = 0.f;
    if (lane < 8) { w_ki = *(const v4u*)(Prow + C_KI + 8 * lane); w_wi = bf1(Prow[C_WI + lane]); }
    if (lane < 48) w_cq = *(const v4u*)(Prow + C_CQ + 8 * lane);
    if (lane < 32) w_ckv = *(const v4u*)(Prow + C_CKV + 8 * lane);
    float c8[8], s8[8];
    { const f32x4 r0 = *(const f32x4*)(ra), r1 = *(const f32x4*)(ra + 4), r2 = *(const f32x4*)(ra + 8), r3 = *(const f32x4*)(ra + 12);
      c8[0] = r0[0]; c8[1] = r0[1]; c8[2] = r0[2]; c8[3] = r0[3]; c8[4] = r1[0]; c8[5] = r1[1]; c8[6] = r1[2]; c8[7] = r1[3];
      s8[0] = r2[0]; s8[1] = r2[1]; s8[2] = r2[2]; s8[3] = r2[3]; s8[4] = r3[0]; s8[5] = r3[1]; s8[6] = r3[2]; s8[7] = r3[3]; }
    { float v[8]; UNPACK8(w_qa, v); float ss = 0.f;
#pragma unroll
      for (int j = 0; j < 8; ++j) ss += v[j] * v[j];
      SUM8(ss);
      const float rstd = 1.0f / sqrtf(ss * (1.f / 64.f) + EPS);
#pragma unroll
      for (int j = 0; j < 8; ++j) v[j] = v[j] * rstd * ga[j];
      ROPE8(v, sub, c8, s8);
#pragma unroll
      for (int j = 0; j < 8; ++j) v[j] *= SCALE_A;
      *(v4u*)(Orow + C_QA + 8 * lane) = PACK8(v); }
    { float v[8]; UNPACK8(w_ka, v); float ss = 0.f;
#pragma unroll
      for (int j = 0; j < 8; ++j) ss += v[j] * v[j];
      SUM8(ss);
      const float rstd = 1.0f / sqrtf(ss * (1.f / 64.f) + EPS);
#pragma unroll
      for (int j = 0; j < 8; ++j) v[j] = v[j] * rstd * gk[j];
      ROPE8(v, sub, c8, s8);
      *(v4u*)(Orow + C_KA + 8 * lane) = PACK8(v); }
    { float v[8]; UNPACK8(w_qi, v);
      ROPE8(v, sub, c8, s8);
      *(v4u*)(Orow + C_QI + 8 * lane) = PACK8(v); }
    { float v[8]; UNPACK8(w_ki, v);
      ROPE8(v, sub, c8, s8);
      if (lane < 8) *(v4u*)(Orow + C_KI + 8 * lane) = PACK8(v); }
    if (lane < 8) WIrow[lane] = w_wi * SCALE_I;
    { float v[8]; UNPACK8(w_cq, v); float ss = 0.f;
#pragma unroll
      for (int j = 0; j < 8; ++j) ss += v[j] * v[j];
      ss = wave_sum(ss); const float rstd = 1.0f / sqrtf(ss * (1.f / 384.f) + EPS);
      if (lane < 48) {
#pragma unroll
          for (int j = 0; j < 8; ++j) v[j] = v[j] * rstd * gq[j];
          *(v4u*)(Orow + C_CQ + 8 * lane) = PACK8(v); } }
    { float v[8]; UNPACK8(w_ckv, v); float ss = 0.f;
#pragma unroll
      for (int j = 0; j < 8; ++j) ss += v[j] * v[j];
      ss = wave_sum(ss); const float rstd = 1.0f / sqrtf(ss * (1.f / 256.f) + EPS);
      if (lane < 32) {
#pragma unroll
          for (int j = 0; j < 8; ++j) v[j] = v[j] * rstd * gc[j];
          *(v4u*)(Orow + C_CKV + 8 * lane) = PACK8(v); } }
    { float v[8]; UNPACK8(w_qm, v); float ss = 0.f;
#pragma unroll
      for (int j = 0; j < 8; ++j) ss += v[j] * v[j];
      SUM16(ss);
      const float rstd = 1.0f / sqrtf(ss * (1.f / 128.f) + EPS);
#pragma unroll
      for (int j = 0; j < 8; ++j) v[j] = v[j] * rstd * gm[j] * SCALE_M;
      *(v4u*)(Orow + C_QM + 8 * lane) = PACK8(v); }
}

__device__ __forceinline__ void km_row(bf16* row, const float* gkm, int lane) {
    v4u w = *(const v4u*)(row + 8 * lane); float v[8]; UNPACK8(w, v); float ss = 0.f;
#pragma unroll
    for (int j = 0; j < 8; ++j) ss += v[j] * v[j];
    SUM16(ss);
    const float rstd = 1.0f / sqrtf(ss * (1.f / 128.f) + EPS);
#pragma unroll
    for (int j = 0; j < 8; ++j) v[j] = v[j] * rstd * gkm[8 * (lane & 15) + j];
    *(v4u*)(row + 8 * lane) = PACK8(v);
}

__device__ __forceinline__ void transpose_v(const bf16* src, int pitch, int col0, int hstride, int H, int DV, int S, int nb, bf16* dst, int gw, int NGW, int lane) {
    const int ndq = DV / 64, nsc = S / 64, ntask = nb * H * nsc * ndq;
    for (int task = gw; task < ntask; task += NGW) {
        int x = task; const int dq = x % ndq; x /= ndq; const int sc = x % nsc; x /= nsc; const int h = x % H; const int b = x / H;
        const int s = sc * 64 + lane;
        const bf16* srow = src + (size_t)(b * S + s) * pitch + col0 + h * hstride + dq * 64;
        bf16* drow = dst + ((size_t)((b * H + h) * DV + dq * 64)) * S + s;
        v4u wv[8];
#pragma unroll
        for (int c = 0; c < 8; ++c) wv[c] = *(const v4u*)(srow + 8 * c);
#pragma unroll
        for (int c = 0; c < 8; ++c) { const v4u w = wv[c];
            drow[(size_t)(8 * c + 0) * S] = (bf16)(w.x & 0xffffu); drow[(size_t)(8 * c + 1) * S] = (bf16)(w.x >> 16);
            drow[(size_t)(8 * c + 2) * S] = (bf16)(w.y & 0xffffu); drow[(size_t)(8 * c + 3) * S] = (bf16)(w.y >> 16);
            drow[(size_t)(8 * c + 4) * S] = (bf16)(w.z & 0xffffu); drow[(size_t)(8 * c + 5) * S] = (bf16)(w.z >> 16);
            drow[(size_t)(8 * c + 6) * S] = (bf16)(w.w & 0xffffu); drow[(size_t)(8 * c + 7) * S] = (bf16)(w.w >> 16); }
    }
}

__device__ __forceinline__ void post2_row(const bf16* QBrow, bf16* QOrow, const bf16* KVBrow, const bf16* Prow, bf16* KBrow, const float* rb, const float (&gqv)[12], const float (&gkv)[12], LAS float* scr, int lane) {
    const int hd = lane >> 3, d0 = 12 * (lane & 7);
    float vq[12], vk[12], cc[12], sn[12];
    { const v2u* p = (const v2u*)(QBrow + 12 * lane);
      const v2u w0 = p[0], w1 = p[1], w2 = p[2];
      bf16 kr[12];
#pragma unroll
      for (int e = 0; e < 12; ++e) { const int d = d0 + e; kr[e] = d < 64 ? KVBrow[hd * 128 + d] : Prow[C_KR + d - 64]; }
#pragma unroll
      for (int e = 0; e < 12; ++e) { const int d = d0 + e; const int i = (d - 64) & 15; cc[e] = d < 64 ? 1.f : rb[i]; sn[e] = d < 64 ? 0.f : rb[16 + i]; }
      vq[0] = bflo(w0.x); vq[1] = bfhi(w0.x); vq[2] = bflo(w0.y); vq[3] = bfhi(w0.y); vq[4] = bflo(w1.x); vq[5] = bfhi(w1.x); vq[6] = bflo(w1.y); vq[7] = bfhi(w1.y);
      vq[8] = bflo(w2.x); vq[9] = bfhi(w2.x); vq[10] = bflo(w2.y); vq[11] = bfhi(w2.y);
#pragma unroll
      for (int e = 0; e < 12; ++e) vk[e] = bf1(kr[e]); }
    float sq = 0.f, sk = 0.f;
#pragma unroll
    for (int e = 0; e < 12; ++e) { sq += vq[e] * vq[e]; sk += vk[e] * vk[e]; }
    SUM8(sq); SUM8(sk);
    const float rq = 1.0f / sqrtf(sq * (1.f / 96.f) + EPS), rk = 1.0f / sqrtf(sk * (1.f / 96.f) + EPS);
#pragma unroll
    for (int e = 0; e < 12; ++e) { vq[e] = vq[e] * rq * gqv[e]; vk[e] = vk[e] * rk * gkv[e]; scr[12 * lane + e] = vq[e]; scr[768 + 12 * lane + e] = vk[e]; }
    LDS_WAIT(); asm volatile("" ::: "memory");
    float oq[12], ok[12];
#pragma unroll
    for (int e = 0; e < 12; ++e) { const int d = d0 + e;
        if (d < 64) { oq[e] = vq[e]; ok[e] = vk[e]; }
        else { const bool first = d < 80; const int off = first ? 16 : -16; const float pq = scr[12 * lane + e + off], pk = scr[768 + 12 * lane + e + off];
               oq[e] = first ? vq[e] * cc[e] - pq * sn[e] : vq[e] * cc[e] + pq * sn[e];
               ok[e] = first ? vk[e] * cc[e] - pk * sn[e] : vk[e] * cc[e] + pk * sn[e]; }
        oq[e] *= SCALE_B; }
    LDS_WAIT(); asm volatile("" ::: "memory");
    v2u* q = (v2u*)(QOrow + 12 * lane); v2u* k = (v2u*)(KBrow + 12 * lane);
#pragma unroll
    for (int i = 0; i < 3; ++i) { v2u w; w.x = pk2(oq[4 * i], oq[4 * i + 1]); w.y = pk2(oq[4 * i + 2], oq[4 * i + 3]); q[i] = w;
                                  v2u u; u.x = pk2(ok[4 * i], ok[4 * i + 1]); u.y = pk2(ok[4 * i + 2], ok[4 * i + 3]); k[i] = u; }
}

__device__ __forceinline__ int next_unit(unsigned* ctr, volatile LAS int* slot) {
    __syncthreads();
    if (threadIdx.x == 0) *slot = (int)atomicAdd(ctr, 1u);
    __syncthreads();
    return *slot;
}

constexpr int SCP = 2112;
__device__ __forceinline__ unsigned ord_key(float v) { const unsigned b = __float_as_uint(v); return b ^ ((unsigned)((int)b >> 31) | 0x80000000u); }
__device__ __forceinline__ void indexer_unit(LAS float* sc, const bf16* P, const float* WI, unsigned* MASK, int bb, int tb) {
    int tid_ = threadIdx.x; asm volatile("" : "+v"(tid_));
    const int tid = tid_, lane = tid & 63, w = __builtin_amdgcn_readfirstlane(tid >> 6);
    const int n = lane & 15, g = lane >> 4;
    const int rowbase = bb * SEQ, t0 = tb * 16;
    for (int rp1 = 0; rp1 < REP_IDX1; ++rp1) {
        bf16x8 qf[8][2]; float wq[8];
        const bf16* qrow = P + (size_t)(rowbase + t0 + n) * PP + C_QI + 8 * g;
#pragma unroll
        for (int h = 0; h < 8; ++h) {
            qf[h][0] = *(const bf16x8*)(qrow + h * 64);
            qf[h][1] = *(const bf16x8*)(qrow + h * 64 + 32);
            wq[h] = WI[(size_t)(rowbase + t0 + n) * 8 + h];
        }
        const int ntile = tb + 1;
        const int nmine = (ntile - w + 7) >> 3;
        const int ngrp = (nmine + 3) >> 2;
        const bf16* kbase = P + (size_t)(rowbase + n) * PP + C_KI + 8 * g;
        bf16x8 kb[2][4][2];
#define IDX_LOAD(BUF, GRP) do { _Pragma("unroll") for (int j_ = 0; j_ < 4; ++j_) { const int tile_ = w + 8 * (4 * (GRP) + j_); const int tl_ = tile_ < ntile ? tile_ : 0; \
            const bf16* kr_ = kbase + (size_t)(16 * tl_) * PP; kb[BUF][j_][0] = *(const bf16x8*)(kr_); kb[BUF][j_][1] = *(const bf16x8*)(kr_ + 32); } } while (0)
#define IDX_COMP(BUF, GRP) do { _Pragma("unroll") for (int j_ = 0; j_ < 4; ++j_) { const int tile_ = w + 8 * (4 * (GRP) + j_); if (tile_ < ntile) { \
            f32x4 idx_ = (f32x4){0.f, 0.f, 0.f, 0.f}; \
            _Pragma("unroll") for (int h_ = 0; h_ < 8; ++h_) { f32x4 a_ = (f32x4){0.f, 0.f, 0.f, 0.f}; \
                a_ = __builtin_amdgcn_mfma_f32_16x16x32_bf16(kb[BUF][j_][0], qf[h_][0], a_, 0, 0, 0); \
                a_ = __builtin_amdgcn_mfma_f32_16x16x32_bf16(kb[BUF][j_][1], qf[h_][1], a_, 0, 0, 0); \
                _Pragma("unroll") for (int i_ = 0; i_ < 4; ++i_) idx_[i_] = __builtin_fmaf(wq[h_], __builtin_fmaxf(a_[i_], 0.f), idx_[i_]); } \
            { const int k0_ = 16 * tile_ + 4 * g; LAS float* d_ = sc + n * SCP + k0_ + (k0_ >> 5); d_[0] = idx_[0]; d_[1] = idx_[1]; d_[2] = idx_[2]; d_[3] = idx_[3]; } } } } while (0)
        if (ngrp > 0) IDX_LOAD(0, 0);
        for (int gp = 0; gp < ngrp; gp += 2) {
            if (gp + 1 < ngrp) IDX_LOAD(1, gp + 1);
            IDX_COMP(0, gp);
            if (gp + 1 < ngrp) { if (gp + 2 < ngrp) IDX_LOAD(0, gp + 2); IDX_COMP(1, gp + 1); }
        }
#undef IDX_LOAD
#undef IDX_COMP
    }
    __syncthreads();
    for (int rs = 0; rs < REP_SEL; ++rs) {
        const int ta = t0 + 2 * w, tb2 = ta + 1;
        unsigned* mra = MASK + (size_t)(rowbase + ta) * 64; unsigned* mrb = mra + 64;
        const int nva = ta - 32 * lane + 1, nvb = nva + 1;
        const unsigned valid_a = nva >= 32 ? 0xffffffffu : (nva <= 0 ? 0u : ((1u << nva) - 1u));
        const unsigned valid_b = nvb >= 32 ? 0xffffffffu : (nvb <= 0 ? 0u : ((1u << nvb) - 1u));
        if (ta < 256) { mra[lane] = valid_a; mrb[lane] = valid_b; continue; }
        unsigned ua[32], ub[32];
        { const LAS float* sra = sc + (2 * w) * SCP + 33 * lane; const LAS float* srb = sra + SCP;
#pragma unroll
          for (int r = 0; r < 32; ++r) { const float va = sra[r], vb = srb[r]; ua[r] = ((valid_a >> r) & 1u) ? ord_key(va) : 0u; ub[r] = ((valid_b >> r) & 1u) ? ord_key(vb) : 0u; } }
#pragma unroll
        for (int si = 0; si < 5; ++si) { const int sft = 16 >> si;
            const unsigned msk = si == 0 ? 0x0000ffffu : (si == 1 ? 0x00ff00ffu : (si == 2 ? 0x0f0f0f0fu : (si == 3 ? 0x33333333u : 0x55555555u)));
#pragma unroll
            for (int k = 0; k < 32; ++k) if (!(k & sft)) {
                const unsigned ta_ = ((ua[k] >> sft) ^ ua[k + sft]) & msk; ua[k + sft] ^= ta_; ua[k] ^= ta_ << sft;
                const unsigned tb_ = ((ub[k] >> sft) ^ ub[k + sft]) & msk; ub[k + sft] ^= tb_; ub[k] ^= tb_ << sft; } }
        unsigned alive_a = valid_a, sel_a = 0u, alive_b = valid_b, sel_b = 0u; int need_a = 256, need_b = 256; bool run_a = true, run_b = true;
#pragma unroll
        for (int j = 31; j >= 0; --j) {
            const unsigned ones_a = alive_a & ua[j], ones_b = alive_b & ub[j];
            int v = (int)((unsigned)__popc(ones_a) | ((unsigned)__popc(ones_b) << 16));
            v += __builtin_amdgcn_update_dpp(0, v, 0xB1, 0xF, 0xF, false);
            v += __builtin_amdgcn_update_dpp(0, v, 0x4E, 0xF, 0xF, false);
            v += __builtin_amdgcn_update_dpp(0, v, 0x141, 0xF, 0xF, false);
            v += __builtin_amdgcn_update_dpp(0, v, 0x140, 0xF, 0xF, false);
            const unsigned tot = (unsigned)(__builtin_amdgcn_readlane(v, 0) + __builtin_amdgcn_readlane(v, 16) + __builtin_amdgcn_readlane(v, 32) + __builtin_amdgcn_readlane(v, 48));
            const int ca = (int)(tot & 0xffffu), cb = (int)(tot >> 16);
            if (run_a) { if (ca >= need_a) { alive_a = ones_a; if (ca == need_a) { sel_a |= ones_a; need_a = 0; run_a = false; } }
                         else { need_a -= ca; sel_a |= ones_a; alive_a &= ~ua[j]; } }
            if (run_b) { if (cb >= need_b) { alive_b = ones_b; if (cb == need_b) { sel_b |= ones_b; need_b = 0; run_b = false; } }
                         else { need_b -= cb; sel_b |= ones_b; alive_b &= ~ub[j]; } }
            if (!run_a && !run_b) break;
        }
        if (need_a > 0) {
            const int cnt = __popc(alive_a); int inc = cnt;
#pragma unroll
            for (int d = 1; d < 64; d <<= 1) { const int o = __shfl_up(inc, d); if (lane >= d) inc += o; }
            int k = need_a - (inc - cnt); k = k < 0 ? 0 : (k > cnt ? cnt : k);
            unsigned m = alive_a;
            for (int i = 0; i < k; ++i) { const unsigned low = m & (0u - m); sel_a |= low; m ^= low; }
        }
        if (need_b > 0) {
            const int cnt = __popc(alive_b); int inc = cnt;
#pragma unroll
            for (int d = 1; d < 64; d <<= 1) { const int o = __shfl_up(inc, d); if (lane >= d) inc += o; }
            int k = need_b - (inc - cnt); k = k < 0 ? 0 : (k > cnt ? cnt : k);
            unsigned m = alive_b;
            for (int i = 0; i < k; ++i) { const unsigned low = m & (0u - m); sel_b |= low; m ^= low; }
        }
        mra[lane] = sel_a; mrb[lane] = sel_b;
        (void)tb2;
    }
    __syncthreads();
}

__device__ __forceinline__ float half_max(float m) { auto rr = __builtin_amdgcn_permlane32_swap(__float_as_uint(m), __float_as_uint(m), false, false); return __builtin_fmaxf(__uint_as_float(rr[0]), __uint_as_float(rr[1])); }
__device__ __forceinline__ float half_sum(float m) { auto rr = __builtin_amdgcn_permlane32_swap(__float_as_uint(m), __float_as_uint(m), false, false); return __uint_as_float(rr[0]) + __uint_as_float(rr[1]); }
__device__ __forceinline__ int crow(int r, int hi) { return (r & 3) + 8 * (r >> 2) + 4 * hi; }
template <int DQK, int DV, int MODE, int STRIP = 0>
__device__ __forceinline__ void attn_unit(LAS unsigned char* lds, const bf16* Qb, int qpitch, const bf16* Kb, int kpitch, const bf16* VTb, int skv,
                                          const unsigned* maskb, const bf16* Zb, bf16* Ob, int q0) {
    constexpr int TK = 128, KP = DQK + 8, VP = TK + 8;
    LAS bf16* Ks = (LAS bf16*)lds; LAS bf16* Vs = Ks + TK * KP;
    constexpr int CPR = DQK / 8;
    constexpr int NCK = TK * CPR, NCV = DV * (TK / 8);
    constexpr int RK = (NCK + 511) / 512, RV = (NCV + 511) / 512;
    constexpr int NKS = DQK / 16, NMT = DV / 32;
    int tid_ = threadIdx.x; asm volatile("" : "+v"(tid_));
    const int tid = tid_, lane = tid & 63, w = __builtin_amdgcn_readfirstlane(tid >> 6), r = lane & 31, hh = lane >> 5;
    const int NT = MODE == 0 ? skv / TK : (q0 + 256) / TK;
    const int qlo = q0 + 32 * w;
    bf16x8 qf[NKS];
    { const bf16* qrow = Qb + (size_t)(qlo + r) * qpitch + 8 * hh;
#pragma unroll
      for (int ks = 0; ks < NKS; ++ks) qf[ks] = *(const bf16x8*)(qrow + 16 * ks); }
    f32x16 o[NMT];
#pragma unroll
    for (int mt = 0; mt < NMT; ++mt)
#pragma unroll
        for (int i = 0; i < 16; ++i) o[mt][i] = 0.f;
    float m_run = NEGF, l_run = 0.f;
    v4u kreg[RK], vreg[RV];
#define ATT_PREFETCH(tile_) do { \
        _Pragma("unroll") for (int i_ = 0; i_ < RK; ++i_) { const int c_ = tid + 512 * i_; if (c_ < NCK) { const int row_ = c_ / CPR, cc_ = c_ % CPR; kreg[i_] = *(const v4u*)(Kb + (size_t)(TK * (tile_) + row_) * kpitch + 8 * cc_); } } \
        _Pragma("unroll") for (int i_ = 0; i_ < RV; ++i_) { const int c_ = tid + 512 * i_; if (c_ < NCV) { const int d_ = c_ >> 4, cc_ = c_ & 15; vreg[i_] = *(const v4u*)(VTb + (size_t)d_ * skv + TK * (tile_) + 8 * cc_); } } } while (0)
    if (STRIP != 2) ATT_PREFETCH(0);
    for (int tile = 0; tile < NT; ++tile) {
        __syncthreads();
        if (STRIP != 2) {
#pragma unroll
        for (int i = 0; i < RK; ++i) { const int c = tid + 512 * i; if (c < NCK) { const int row = c / CPR, cc = c % CPR; *(LAS v4u*)(Ks + row * KP + 8 * cc) = kreg[i]; } }
#pragma unroll
        for (int i = 0; i < RV; ++i) { const int c = tid + 512 * i; if (c < NCV) { const int d = c >> 4, cc = c & 15; *(LAS v4u*)(Vs + d * VP + 8 * cc) = vreg[i]; } }
        }
        __syncthreads();
        if (STRIP != 2 && tile + 1 < NT) ATT_PREFETCH(tile + 1);
        __builtin_amdgcn_sched_barrier(0);
        if (STRIP == 1) continue;
#pragma unroll 1
        for (int sub = 0; sub < 2; ++sub) {
        const int t64 = 2 * tile + sub;
        if (MODE != 0 && 64 * t64 > qlo + 31) continue;
        const LAS bf16* Kc = Ks + 64 * sub * KP; const LAS bf16* Vc = Vs + 64 * sub;
        unsigned mw0 = 0u, mw1 = 0u;
        if (MODE == 2) { const v2u mm = *(const v2u*)(maskb + (size_t)(qlo + r) * 64 + 2 * t64); mw0 = mm.x >> (4 * hh); mw1 = mm.y >> (4 * hh); }
        f32x16 s0, s1;
#pragma unroll
        for (int i = 0; i < 16; ++i) { s0[i] = 0.f; s1[i] = 0.f; }
#pragma unroll
        for (int ks = 0; ks < NKS; ++ks) {
            const bf16x8 a0 = *(const LAS bf16x8*)(Kc + r * KP + 16 * ks + 8 * hh);
            const bf16x8 a1 = *(const LAS bf16x8*)(Kc + (32 + r) * KP + 16 * ks + 8 * hh);
            s0 = __builtin_amdgcn_mfma_f32_32x32x16_bf16(a0, qf[ks], s0, 0, 0, 0);
            s1 = __builtin_amdgcn_mfma_f32_32x32x16_bf16(a1, qf[ks], s1, 0, 0, 0);
        }
        if (MODE == 1) {
            if (64 * t64 + 63 > qlo) { const int qg = qlo + r;
#pragma unroll
                for (int i = 0; i < 16; ++i) { const int key = 64 * t64 + crow(i, hh); if (key > qg) s0[i] = NEGF; if (key + 32 > qg) s1[i] = NEGF; } }
        }
        if (MODE == 2) {
#pragma unroll
            for (int i = 0; i < 16; ++i) { const int bit = (i & 3) + 8 * (i >> 2); if (!((mw0 >> bit) & 1u)) s0[i] = NEGF; if (!((mw1 >> bit) & 1u)) s1[i] = NEGF; }
        }
        float mx = s0[0];
#pragma unroll
        for (int i = 1; i < 16; ++i) mx = __builtin_fmaxf(mx, s0[i]);
#pragma unroll
        for (int i = 0; i < 16; ++i) mx = __builtin_fmaxf(mx, s1[i]);
        mx = half_max(mx);
        const float m_new = __builtin_fmaxf(m_run, mx);
        const float alpha = __builtin_amdgcn_exp2f(m_run - m_new);
        m_run = m_new;
        float ls = 0.f;
#pragma unroll
        for (int i = 0; i < 16; ++i) { s0[i] = __builtin_amdgcn_exp2f(s0[i] - m_new); s1[i] = __builtin_amdgcn_exp2f(s1[i] - m_new); ls += s0[i] + s1[i]; }
        l_run = l_run * alpha + ls;
#pragma unroll
        for (int mt = 0; mt < NMT; ++mt)
#pragma unroll
            for (int i = 0; i < 16; ++i) o[mt][i] *= alpha;
        v4u pf[2][2];
#pragma unroll
        for (int s = 0; s < 2; ++s) {
            pf[0][s] = (v4u){pk2(s0[8 * s], s0[8 * s + 1]), pk2(s0[8 * s + 2], s0[8 * s + 3]), pk2(s0[8 * s + 4], s0[8 * s + 5]), pk2(s0[8 * s + 6], s0[8 * s + 7])};
            pf[1][s] = (v4u){pk2(s1[8 * s], s1[8 * s + 1]), pk2(s1[8 * s + 2], s1[8 * s + 3]), pk2(s1[8 * s + 4], s1[8 * s + 5]), pk2(s1[8 * s + 6], s1[8 * s + 7])};
        }
#pragma unroll
        for (int mt = 0; mt < NMT; ++mt)
#pragma unroll
            for (int p = 0; p < 2; ++p)
#pragma unroll
                for (int s = 0; s < 2; ++s) {
                    const LAS bf16* vp = Vc + (32 * mt + r) * VP + 32 * p + 16 * s + 4 * hh;
                    const s16x4 lo = *(const LAS s16x4*)(vp), hi = *(const LAS s16x4*)(vp + 8);
                    const bf16x8 a = (bf16x8){lo[0], lo[1], lo[2], lo[3], hi[0], hi[1], hi[2], hi[3]};
                    o[mt] = __builtin_amdgcn_mfma_f32_32x32x16_bf16(a, __builtin_bit_cast(bf16x8, pf[p][s]), o[mt], 0, 0, 0);
                }
        }
    }
#undef ATT_PREFETCH
    const float l_tot = half_sum(l_run);
    const float inv = 1.0f / l_tot;
    const size_t row = (size_t)(qlo + r);
#pragma unroll
    for (int mt = 0; mt < NMT; ++mt)
#pragma unroll
        for (int g4 = 0; g4 < 4; ++g4) {
            const int d = 32 * mt + 8 * g4 + 4 * hh;
            float ov[4];
#pragma unroll
            for (int i = 0; i < 4; ++i) ov[i] = o[mt][4 * g4 + i] * inv;
            if (Zb) { const v2u zw = *(const v2u*)(Zb + row * PP + d); const float z[4] = {bflo(zw.x), bfhi(zw.x), bflo(zw.y), bfhi(zw.y)};
#pragma unroll
                for (int i = 0; i < 4; ++i) ov[i] *= z[i] / (1.0f + __expf(-z[i])); }
            v2u ow; ow.x = pk2(ov[0], ov[1]); ow.y = pk2(ov[2], ov[3]);
            *(v2u*)(Ob + row * PP + d) = ow;
        }
}

template <int DQK, int MODE>
__device__ __forceinline__ void attn_unit_pipe(LAS unsigned char* lds, const bf16* Qb, int qpitch, const bf16* Kb, int kpitch, const bf16* VTb, int skv,
                                               const unsigned* maskb, bf16* Ob, int q0) {
    constexpr int DV = 64, KP = DQK + 8, VP = 72, BUFE = 64 * KP + DV * VP;
    constexpr int CPR = DQK / 8, NCK = 64 * CPR, NCV = DV * 8, RK = (NCK + 511) / 512, RV = (NCV + 511) / 512, NKS = DQK / 16, NMT = DV / 32;
    static_assert(NCV == 512 && (NCK == 512 || NCK == 768), "staging map");
    int tid_ = threadIdx.x; asm volatile("" : "+v"(tid_));
    const int tid = tid_, lane = tid & 63, w = __builtin_amdgcn_readfirstlane(tid >> 6), r = lane & 31, hh = lane >> 5;
    const int NT = (q0 + 256) / 64;
    const int qlo = q0 + 32 * w;
    const int NTw = ((qlo + 31) >> 6) + 1;
    int krow[RK], kcc[RK];
#pragma unroll
    for (int i = 0; i < RK; ++i) { int c = tid + 512 * i; if (c >= NCK) c -= 256; krow[i] = c / CPR; kcc[i] = c % CPR; }
    const int vd = tid >> 3, vcc = tid & 7;
    bf16x8 qf[NKS];
    { const bf16* qrow = Qb + (size_t)(qlo + r) * qpitch + 8 * hh;
#pragma unroll
      for (int ks = 0; ks < NKS; ++ks) qf[ks] = *(const bf16x8*)(qrow + 16 * ks); }
    f32x16 o[NMT];
#pragma unroll
    for (int mt = 0; mt < NMT; ++mt)
#pragma unroll
        for (int i = 0; i < 16; ++i) o[mt][i] = 0.f;
    float m_run = NEGF, l_run = 0.f, alpha = 1.f;
    v4u kreg[2][RK], vreg[2][RV]; v2u mset[2];
    const unsigned* mrowp = MODE == 2 ? maskb + (size_t)(qlo + r) * 64 : nullptr;
#define PL_LOAD(S_, tile_) do { const int tl_ = (tile_) < NT ? (tile_) : NT - 1; \
        if (MODE == 2) { const int mt_ = (tile_) >= 2 ? ((tile_) - 2 < 32 ? (tile_) - 2 : 31) : 0; mset[S_] = *(const v2u*)(mrowp + 2 * mt_); }     \
        _Pragma("unroll") for (int i_ = 0; i_ < RK; ++i_) kreg[S_][i_] = *(const v4u*)(Kb + (size_t)(64 * tl_ + krow[i_]) * kpitch + 8 * kcc[i_]); \
        vreg[S_][0] = *(const v4u*)(VTb + (size_t)vd * skv + 64 * tl_ + 8 * vcc); } while (0)
#define PL_STAGE(S_, buf_) do { LAS bf16* Kd_ = (LAS bf16*)lds + (buf_) * BUFE; LAS bf16* Vd_ = Kd_ + 64 * KP; \
        _Pragma("unroll") for (int i_ = 0; i_ < RK; ++i_) *(LAS v4u*)(Kd_ + krow[i_] * KP + 8 * kcc[i_]) = kreg[S_][i_]; \
        *(LAS v4u*)(Vd_ + vd * VP + 8 * vcc) = vreg[S_][0]; } while (0)
#define PL_QK(t_, D0_, D1_) do { const LAS bf16* Kc_ = (const LAS bf16*)lds + ((t_) & 3) * BUFE; \
        _Pragma("unroll") for (int i_ = 0; i_ < 16; ++i_) { D0_[i_] = 0.f; D1_[i_] = 0.f; } \
        _Pragma("unroll") for (int ks_ = 0; ks_ < NKS; ++ks_) { \
            const bf16x8 a0_ = *(const LAS bf16x8*)(Kc_ + r * KP + 16 * ks_ + 8 * hh); const bf16x8 a1_ = *(const LAS bf16x8*)(Kc_ + (32 + r) * KP + 16 * ks_ + 8 * hh); \
            D0_ = __builtin_amdgcn_mfma_f32_32x32x16_bf16(a0_, qf[ks_], D0_, 0, 0, 0); D1_ = __builtin_amdgcn_mfma_f32_32x32x16_bf16(a1_, qf[ks_], D1_, 0, 0, 0); } } while (0)
#define PL_PV(t_) do { const LAS bf16* Vc_ = (const LAS bf16*)lds + ((t_) & 3) * BUFE + 64 * KP; \
        _Pragma("unroll") for (int mt_ = 0; mt_ < NMT; ++mt_) _Pragma("unroll") for (int i_ = 0; i_ < 16; ++i_) o[mt_][i_] *= alpha; \
        _Pragma("unroll") for (int mt_ = 0; mt_ < NMT; ++mt_) _Pragma("unroll") for (int p_ = 0; p_ < 2; ++p_) _Pragma("unroll") for (int s_ = 0; s_ < 2; ++s_) { \
            const LAS bf16* vp_ = Vc_ + (32 * mt_ + r) * VP + 32 * p_ + 16 * s_ + 4 * hh; \
            const s16x4 lo_ = *(const LAS s16x4*)(vp_), hi_ = *(const LAS s16x4*)(vp_ + 8); \
            const bf16x8 a_ = (bf16x8){lo_[0], lo_[1], lo_[2], lo_[3], hi_[0], hi_[1], hi_[2], hi_[3]}; \
            o[mt_] = __builtin_amdgcn_mfma_f32_32x32x16_bf16(a_, __builtin_bit_cast(bf16x8, pf[p_][s_]), o[mt_], 0, 0, 0); } } while (0)
#define PL_SOFTMAX(t_, C0_, C1_, MK_, CAUSAL_) do { \
        if (MODE == 2) { const unsigned w0_ = (MK_).x >> (4 * hh), w1_ = (MK_).y >> (4 * hh); \
            _Pragma("unroll") for (int i_ = 0; i_ < 16; ++i_) { const int bit_ = (i_ & 3) + 8 * (i_ >> 2); if (!((w0_ >> bit_) & 1u)) C0_[i_] = NEGF; if (!((w1_ >> bit_) & 1u)) C1_[i_] = NEGF; } } \
        if (CAUSAL_) { const int qg_ = qlo + r; \
            _Pragma("unroll") for (int i_ = 0; i_ < 16; ++i_) { const int key_ = 64 * (t_) + crow(i_, hh); if (key_ > qg_) C0_[i_] = NEGF; if (key_ + 32 > qg_) C1_[i_] = NEGF; } } \
        float mx_ = C0_[0]; \
        _Pragma("unroll") for (int i_ = 1; i_ < 16; ++i_) mx_ = __builtin_fmaxf(mx_, C0_[i_]); \
        _Pragma("unroll") for (int i_ = 0; i_ < 16; ++i_) mx_ = __builtin_fmaxf(mx_, C1_[i_]); \
        mx_ = half_max(mx_); \
        const float mn_ = __builtin_fmaxf(m_run, mx_); alpha = __builtin_amdgcn_exp2f(m_run - mn_); m_run = mn_; \
        float ls_ = 0.f; \
        _Pragma("unroll") for (int i_ = 0; i_ < 16; ++i_) { C0_[i_] = __builtin_amdgcn_exp2f(C0_[i_] - mn_); C1_[i_] = __builtin_amdgcn_exp2f(C1_[i_] - mn_); ls_ += C0_[i_] + C1_[i_]; } \
        l_run = l_run * alpha + ls_; \
        _Pragma("unroll") for (int s_ = 0; s_ < 2; ++s_) { \
            pf[0][s_] = (v4u){pk2(C0_[8 * s_], C0_[8 * s_ + 1]), pk2(C0_[8 * s_ + 2], C0_[8 * s_ + 3]), pk2(C0_[8 * s_ + 4], C0_[8 * s_ + 5]), pk2(C0_[8 * s_ + 6], C0_[8 * s_ + 7])}; \
            pf[1][s_] = (v4u){pk2(C1_[8 * s_], C1_[8 * s_ + 1]), pk2(C1_[8 * s_ + 2], C1_[8 * s_ + 3]), pk2(C1_[8 * s_ + 4], C1_[8 * s_ + 5]), pk2(C1_[8 * s_ + 6], C1_[8 * s_ + 7])}; } } while (0)
#define PL_IO(t_, S_) do { PL_STAGE(S_, ((t_) + 2) & 3); PL_LOAD(S_, (t_) + 4); } while (0)
#define PL_STEADY(t_, S_) do { const v2u mk_ = mset[S_]; PL_IO(t_, S_); if (MODE == 2) { asm volatile("" :: "v"(mk_.x), "v"(mk_.y)); } \
        PL_QK((t_) + 1, n0, n1); PL_PV((t_) - 1); PL_SOFTMAX(t_, c0, c1, mk_, false); c0 = n0; c1 = n1; __syncthreads(); } while (0)
#define PL_TAIL(t_, S_) do { const v2u mk_ = mset[S_]; PL_IO(t_, S_); if ((t_) >= 1) PL_PV((t_) - 1); PL_SOFTMAX(t_, c0, c1, mk_, MODE == 1); PL_PV(t_); __syncthreads(); } while (0)
    f32x16 c0, c1, n0, n1; v4u pf[2][2];
    PL_LOAD(0, 0); PL_LOAD(1, 1);
    PL_STAGE(0, 0); PL_STAGE(1, 1);
    PL_LOAD(0, 2); PL_LOAD(1, 3);
    __syncthreads();
    PL_QK(0, c0, c1);
    int t = 0;
    if (NTw >= 2) {
        { const v2u mk_ = mset[0]; PL_IO(0, 0); PL_QK(1, n0, n1); PL_SOFTMAX(0, c0, c1, mk_, false); c0 = n0; c1 = n1; __syncthreads(); }
        for (t = 1; t + 1 < NTw; ) {
            PL_STEADY(t, 1); ++t;
            if (t + 1 < NTw) { PL_STEADY(t, 0); ++t; }
        }
    }
    if (t & 1) PL_TAIL(t, 1); else PL_TAIL(t, 0);
    for (++t; t < NT; ++t) { if (t & 1) PL_IO(t, 1); else PL_IO(t, 0); __syncthreads(); }
#undef PL_LOAD
#undef PL_STAGE
#undef PL_QK
#undef PL_PV
#undef PL_SOFTMAX
#undef PL_IO
#undef PL_STEADY
#undef PL_TAIL
    const float l_tot = half_sum(l_run);
    const float inv = 1.0f / l_tot;
    const size_t row = (size_t)(qlo + r);
#pragma unroll
    for (int mt = 0; mt < NMT; ++mt)
#pragma unroll
        for (int g4 = 0; g4 < 4; ++g4) {
            const int d = 32 * mt + 8 * g4 + 4 * hh;
            v2u ow; ow.x = pk2(o[mt][4 * g4] * inv, o[mt][4 * g4 + 1] * inv); ow.y = pk2(o[mt][4 * g4 + 2] * inv, o[mt][4 * g4 + 3] * inv);
            *(v2u*)(Ob + row * PP + d) = ow;
        }
}

__device__ __forceinline__ bf16* gate_row(bf16* G0, bf16* G1, size_t row) { return row < 8192 ? G0 + row * 3072 : G1 + (row - 8192) * 3072; }
struct EpiZG {
    static constexpr bool PERM = true, AFTER_DRAIN = false;
    bf16* P; bf16* G0; bf16* G1;
    __device__ __forceinline__ void operator()(const pg8::f32x4 (&acc)[2][2][4][2], const pg8::Unit& u, int wr, int wc, int fr, int fq) const {
        const int row0 = u.pm * 256 + wr * 64 + fr, cl = wc * 32 + 8 * fq;
        const bool isz = u.pn < 4;
        const int ycol = (u.pn < 2 ? C_YA : C_YB) + (u.pn & 1) * 256, gcol = (u.pn - 4) * 256;
#pragma unroll
        for (int ai = 0; ai < 2; ++ai)
#pragma unroll
            for (int m = 0; m < 4; ++m) { const size_t row = (size_t)(row0 + ai * 128 + m * 16);
#pragma unroll
                for (int bj = 0; bj < 2; ++bj) {
                    const pg8::f32x4 v0 = acc[ai][bj][m][0], v1 = acc[ai][bj][m][1];
                    float rr[8] = {v0[0], v0[1], v0[2], v0[3], v1[0], v1[1], v1[2], v1[3]};
                    if (isz) { bf16* dst = P + row * PP + ycol + cl + bj * 128; const v4u old = *(const v4u*)dst; float yv[8]; UNPACK8(old, yv);
#pragma unroll
                        for (int e = 0; e < 8; ++e) rr[e] = yv[e] * (rr[e] / (1.0f + __expf(-rr[e])));
                        *(v4u*)dst = PACK8(rr); }
                    else { bf16* dst = gate_row(G0, G1, row) + gcol + cl + bj * 128;
#pragma unroll
                        for (int e = 0; e < 8; ++e) rr[e] = 1.0f / (1.0f + __expf(-rr[e]));
                        *(v4u*)dst = PACK8(rr); } } }
    }
};
struct EpiMerge {
    static constexpr bool PERM = true, AFTER_DRAIN = false;
    bf16* Mg; bf16* G0; bf16* G1; int nbr;
    __device__ __forceinline__ void operator()(const pg8::f32x4 (&acc)[2][2][4][2], const pg8::Unit& u, int wr, int wc, int fr, int fq) const {
        const int row0 = u.pm * 256 + wr * 64 + fr, col0 = u.pn * 256 + wc * 32 + 8 * fq;
#pragma unroll
        for (int ai = 0; ai < 2; ++ai)
#pragma unroll
            for (int m = 0; m < 4; ++m) { const size_t row = (size_t)(row0 + ai * 128 + m * 16);
#pragma unroll
                for (int bj = 0; bj < 2; ++bj) { const int col = col0 + bj * 128;
                    const v4u gwd = *(const v4u*)(gate_row(G0, G1, row) + nbr * 1024 + col);
                    float gl[8]; UNPACK8(gwd, gl);
                    const pg8::f32x4 v0 = acc[ai][bj][m][0], v1 = acc[ai][bj][m][1];
                    float rr[8] = {v0[0], v0[1], v0[2], v0[3], v1[0], v1[1], v1[2], v1[3]};
#pragma unroll
                    for (int e = 0; e < 8; ++e) rr[e] *= gl[e];
                    bf16* dst = Mg + row * 1024 + col;
                    if (nbr > 0) { const v4u old = *(const v4u*)dst; float ol[8]; UNPACK8(old, ol);
#pragma unroll
                        for (int e = 0; e < 8; ++e) rr[e] += ol[e]; }
                    *(v4u*)dst = PACK8(rr); } }
    }
};
struct EpiOut {
    static constexpr bool PERM = true, AFTER_DRAIN = false;
    const float* X; float* Out;
    __device__ __forceinline__ void operator()(const pg8::f32x4 (&acc)[2][2][4][2], const pg8::Unit& u, int wr, int wc, int fr, int fq) const {
        const int row0 = u.pm * 256 + wr * 64 + fr, col0 = u.pn * 256 + wc * 32 + 8 * fq;
#pragma unroll
        for (int ai = 0; ai < 2; ++ai)
#pragma unroll
            for (int m = 0; m < 4; ++m) { const size_t row = (size_t)(row0 + ai * 128 + m * 16);
#pragma unroll
                for (int bj = 0; bj < 2; ++bj) { const size_t p = row * 1024 + col0 + bj * 128;
                    const f32x4 x0 = *(const f32x4*)(X + p), x1 = *(const f32x4*)(X + p + 4);
                    const pg8::f32x4 a0 = acc[ai][bj][m][0], a1 = acc[ai][bj][m][1];
                    *(f32x4*)(Out + p) = (f32x4){x0[0] + a0[0], x0[1] + a0[1], x0[2] + a0[2], x0[3] + a0[3]};
                    *(f32x4*)(Out + p + 4) = (f32x4){x1[0] + a1[0], x1[1] + a1[1], x1[2] + a1[2], x1[3] + a1[3]}; } }
    }
};

#define XB_TMO      128
#define XB_XCNT(j)  (256  + 64 * (j))
#define XB_XSUB(j)  (1280 + 64 * (j))
#define XB_XGEN(j)  (2304 + 64 * (j))
#define XB_TOP      3328
#define XB_TOPGEN   3392
#define XCD_BAR_WORDS 3456
#define XB_SPIN_CAP (1u << 18)

__device__ __forceinline__ unsigned xb_ld(unsigned* p)              { return __hip_atomic_load(p, __ATOMIC_RELAXED, __HIP_MEMORY_SCOPE_AGENT); }
__device__ __forceinline__ unsigned xb_add(unsigned* p, unsigned v) { return __hip_atomic_fetch_add(p, v, __ATOMIC_RELAXED, __HIP_MEMORY_SCOPE_AGENT); }
__device__ __forceinline__ unsigned xb_xcc_id() { return (unsigned)__builtin_amdgcn_s_getreg((3 << 11) | 20) & 0xFu; }
#define XB_SPIN(cond, bar) do { unsigned _sp = 0; while (cond) { __builtin_amdgcn_s_sleep(1); \
    if ((++_sp & 255u) == 0u) { if (xb_ld(&(bar)[XB_TMO])) break; if (_sp > XB_SPIN_CAP) { atomicAdd(&(bar)[XB_TMO], 1u); break; } } } } while (0)

struct XcdBarrier {
    unsigned* bar; unsigned x;
    volatile LAS unsigned* st;
};

__device__ __forceinline__ XcdBarrier xcd_barrier_post(unsigned* bar, volatile LAS unsigned* st) {
    XcdBarrier b; b.bar = bar; b.x = xb_xcc_id(); b.st = st;
    if (threadIdx.x == 0) (void)xb_add(&bar[XB_XCNT(b.x)], 1u);
    return b;
}
__device__ __forceinline__ void xcd_barrier_complete(unsigned* bar, unsigned x, unsigned& nloc, unsigned& nx) {
    const unsigned G = gridDim.x * gridDim.y * gridDim.z;
    unsigned sum, cnt, mine, sp = 0u;
    for (;;) {
        sum = 0u; cnt = 0u; mine = 0u;
#pragma unroll
        for (unsigned j = 0; j < 16; ++j) { const unsigned c = xb_ld(&bar[XB_XCNT(j)]); sum += c; cnt += (c > 0u) ? 1u : 0u; mine = (j == x) ? c : mine; }
        if (sum == G) break;
        __builtin_amdgcn_s_sleep(1);
        if ((++sp & 255u) == 0u) { if (xb_ld(&bar[XB_TMO])) break; if (sp > XB_SPIN_CAP) { atomicAdd(&bar[XB_TMO], 1u); break; } }
    }
    nloc = mine > 0u ? mine : 1u; nx = cnt > 0u ? cnt : 1u;
}

__device__ __forceinline__ void xcd_barrier(const XcdBarrier& b) {
    asm volatile("s_waitcnt vmcnt(0)" ::: "memory");
    __syncthreads();
    if (threadIdx.x == 0) {
        unsigned* bar = b.bar;
        __builtin_amdgcn_s_waitcnt(0);
        unsigned nloc = b.st[0], nx = b.st[1];
        if (nloc == 0u) { xcd_barrier_complete(bar, b.x, nloc, nx); b.st[0] = nloc; b.st[1] = nx; }
        const unsigned old = xb_add(&bar[XB_XSUB(b.x)], 1u);
        const unsigned gen = old / nloc;
        if (old + 1u == (gen + 1u) * nloc) {
            __builtin_amdgcn_fence(__ATOMIC_RELEASE, "agent");
            asm volatile("s_waitcnt vmcnt(0)" ::: "memory");
            const unsigned og = xb_add(&bar[XB_TOP], 1u);
            const unsigned tg = og / nx;
            if (og + 1u == (tg + 1u) * nx) xb_add(&bar[XB_TOPGEN], 1u);
            else XB_SPIN(xb_ld(&bar[XB_TOPGEN]) == tg, bar);
            __builtin_amdgcn_fence(__ATOMIC_ACQUIRE, "agent");
            xb_add(&bar[XB_XGEN(b.x)], 1u);
            asm volatile("s_waitcnt vmcnt(0)" ::: "memory");
        } else {
            XB_SPIN(xb_ld(&bar[XB_XGEN(b.x)]) == gen, bar);
            __builtin_amdgcn_fence(__ATOMIC_ACQUIRE, "agent");
            asm volatile("s_waitcnt vmcnt(0)" ::: "memory");
        }
    }
    __syncthreads();
}

template <int DQK, int DV, int MODE>
__device__ __forceinline__ void att_call(bool strip, LAS unsigned char* lds, const bf16* Qb, int qpitch, const bf16* Kb, int kpitch, const bf16* VTb, int skv, const unsigned* maskb, const bf16* Zb, bf16* Ob, int q0) {
    if (ATT_STRIP != 0 && strip) attn_unit<DQK, DV, MODE, ATT_STRIP>(lds, Qb, qpitch, Kb, kpitch, VTb, skv, maskb, Zb, Ob, q0);
    else attn_unit<DQK, DV, MODE, 0>(lds, Qb, qpitch, Kb, kpitch, VTb, skv, maskb, Zb, Ob, q0);
}
struct Args { const float* in[19]; const int* pos; float* out; unsigned char* ws; };
typedef const __attribute__((address_space(4))) Args* kargs_t;
#define PHASE_BEGIN \
    kargs_t ap_ = (kargs_t)__builtin_amdgcn_kernarg_segment_ptr(); asm volatile("" : "+s"(ap_)); \
    int tid = threadIdx.x; asm volatile("" : "+v"(tid)); \
    const int lane = tid & 63, wave = __builtin_amdgcn_readfirstlane(tid >> 6), G = gridDim.x, NGW = G * 8, gw = blockIdx.x * 8 + wave; \
    unsigned char* const ws = ap_->ws; unsigned char* const dob = (unsigned char*)ap_->out; const int* const pos = ap_->pos; float* const outp = ap_->out; unsigned* const ctl = (unsigned*)(ws + WS_CTL); \
    const float* const x = ap_->in[0]; const float* const mem = ap_->in[1]; \
    const float* const g_norm = ap_->in[3]; const float* const w_in = ap_->in[4]; const float* const g_qn_a = ap_->in[5]; const float* const g_kn_a = ap_->in[6]; \
    const float* const g_cq = ap_->in[7]; const float* const g_ckv = ap_->in[8]; const float* const w_uq = ap_->in[9]; const float* const w_ukv = ap_->in[10]; \
    const float* const g_qn_b = ap_->in[11]; const float* const g_kn_b = ap_->in[12]; const float* const g_mem = ap_->in[13]; const float* const w_mem_kv = ap_->in[14]; \
    const float* const g_qn_m = ap_->in[15]; const float* const g_kn_m = ap_->in[16]; const float* const w_branch = ap_->in[17]; const float* const w_out = ap_->in[18]; \
    bf16* const WinT = (bf16*)(ws + WS_WIN); bf16* const WuqT = (bf16*)(ws + WS_WUQ); bf16* const WukvT = (bf16*)(ws + WS_WUKV); bf16* const WmemT = (bf16*)(ws + WS_WMEM); \
    bf16* const WbrT = (bf16*)(ws + WS_WBR); bf16* const WoutT = (bf16*)(ws + WS_WOUT); \
    float* const ropeA = (float*)(ws + WS_ROPEA); float* const ropeB = (float*)(ws + WS_ROPEB); \
    bf16* const MN = (bf16*)(ws + WS_MN); bf16* const KVM = (bf16*)(ws + WS_KVM); bf16* const VTM = (bf16*)(ws + WS_VTM); \
    float* const WI = (float*)(ws + WS_WI); unsigned* const MASK = (unsigned*)(ws + WS_MASK); \
    bf16* const VTA = (bf16*)(dob + DO_VTA); bf16* const VTB = (bf16*)(dob + DO_VTB); bf16* const KB = (bf16*)(dob + DO_KB); \
    bf16* const Hh = (bf16*)(ws + WS_H); bf16* const MG = (bf16*)(ws + WS_H); bf16* const QB = (bf16*)(ws + WS_QB); \
    bf16* const KVB = (bf16*)(ws + WS_KVB); bf16* const GT0 = (bf16*)(dob + DO_G0); bf16* const GT1 = (bf16*)(ws + WS_G1); bf16* const P = (bf16*)(ws + WS_P); \
    (void)lane; (void)NGW; (void)gw; (void)ctl; \
    (void)pos; (void)outp; (void)x; (void)mem; (void)g_norm; (void)w_in; (void)g_qn_a; (void)g_kn_a; (void)g_cq; (void)g_ckv; (void)w_uq; (void)w_ukv; (void)g_qn_b; (void)g_kn_b; (void)g_mem; (void)w_mem_kv; \
    (void)g_qn_m; (void)g_kn_m; (void)w_branch; (void)w_out; (void)WinT; (void)WuqT; (void)WukvT; (void)WmemT; (void)WbrT; (void)WoutT; (void)ropeA; (void)ropeB; (void)MN; (void)KVM; (void)VTM; (void)WI; (void)MASK; \
    (void)VTA; (void)VTB; (void)Hh; (void)KB; (void)QB; (void)KVB; (void)MG; (void)GT0; (void)GT1; (void)P
#define GRID_BARRIER() do { kargs_t bp_ = (kargs_t)__builtin_amdgcn_kernarg_segment_ptr(); asm volatile("" : "+s"(bp_)); \
    XcdBarrier b_; b_.bar = (unsigned*)(bp_->ws + WS_CTL) + 4096; b_.x = xb_xcc_id(); b_.st = (volatile LAS unsigned*)(lds + LDS_BYTES - 32); xcd_barrier(b_); } while (0)

__global__ void __launch_bounds__(512, 2) fwd_kernel(Args a) {
    extern __shared__ __attribute__((aligned(16))) unsigned char lds_raw[];
    LAS unsigned char* const lds = (LAS unsigned char*)lds_raw;
    volatile LAS int* const slot = (volatile LAS int*)(lds + LDS_SLOT);
    if (threadIdx.x < 16) ((LAS unsigned*)(lds + LDS_BYTES - 64))[threadIdx.x] = 0u;
    __syncthreads();
    (void)xcd_barrier_post((unsigned*)(a.ws + WS_CTL) + 4096, (volatile LAS unsigned*)(lds + LDS_BYTES - 32));

    for (int rep = 0; rep < REP_P0; ++rep) { PHASE_BEGIN;
        LAS float* scr = (LAS float*)(lds + wave * 16384);
        constexpr int I_IN = 16 * (NP / 32), I_UQ = 6 * 24, I_UKV = 4 * 32, I_MEM = 16 * 32, I_BR = 8 * 32, I_OUT = 16 * 32;
        constexpr int NITEMS = I_IN + I_UQ + I_UKV + I_MEM + 3 * I_BR + I_OUT;
        for (int it = gw; it < NITEMS; it += NGW) {
            int r = it;
            if (r < I_IN) { transpose_item<true>(w_in, 1024, DIN, NP, WinT, scr, r, lane); continue; } r -= I_IN;
            if (r < I_UQ) { transpose_item<false>(w_uq, 384, 768, 768, WuqT, scr, r, lane); continue; } r -= I_UQ;
            if (r < I_UKV) { transpose_item<false>(w_ukv, 256, 1024, 1024, WukvT, scr, r, lane); continue; } r -= I_UKV;
            if (r < I_MEM) { transpose_item<false>(w_mem_kv, 1024, 1024, 1024, WmemT, scr, r, lane); continue; } r -= I_MEM;
            if (r < 3 * I_BR) { const int nb = r / I_BR; transpose_item<false>(w_branch + (size_t)nb * 512 * 1024, 512, 1024, 1024, WbrT + (size_t)nb * 1024 * 512, scr, r % I_BR, lane); continue; } r -= 3 * I_BR;
            transpose_item<false>(w_out, 1024, 1024, 1024, WoutT, scr, r, lane);
        }
        for (int idx = blockIdx.x * 512 + tid; idx < TT * 24; idx += G * 512) {
            const int t = idx / 24, i = idx % 24; const float pf = (float)pos[t];
            if (i < 8) { const float ang = pf * INVA[i]; ropeA[t * 16 + i] = cosf(ang); ropeA[t * 16 + 8 + i] = sinf(ang); }
            else { const int j = i - 8; const float ang = pf * INVB[j]; ropeB[t * 32 + j] = cosf(ang); ropeB[t * 32 + 16 + j] = sinf(ang); }
        }
        for (int m = gw; m < NB * MEML; m += NGW) rms_row_1024(mem + (size_t)m * DM, g_mem, MN + (size_t)m * DM, lane);
        for (int rp = 0; rp < REP_PH; ++rp)
        for (int m = gw; m < TT; m += NGW) rms_row_1024(x + (size_t)m * DM, g_norm, Hh + (size_t)m * DM, lane);
    }
    GRID_BARRIER();
    for (int es = 0; es < EXTRA_SYNCS; ++es) GRID_BARRIER();

    for (int rep = 0; rep < REP_G1; ++rep) { PHASE_BEGIN;
        pg8::Gemm g{Hh, WinT, TT, PP, 1024, 1024}; pg8::StaticOrder S; S.init(TT, PP, G, (int)blockIdx.x);
        pg8::EpiBf16<0> E{P, PP, nullptr, 0, 0, 1.f};
        pg8::gemm_phase<pg8::EpiBf16<0>, pg8::StaticOrder, true, true>(lds, g, S, E);
    }
    { PHASE_BEGIN;
        pg8::Gemm g{MN, WmemT, NB * MEML, 1024, 1024, 1024}; pg8::StaticOrder S; S.init(NB * MEML, 1024, G, (int)((blockIdx.x + 64) % G));
        pg8::EpiBf16<0> E{KVM, 1024, nullptr, 0, 0, 1.f};
        pg8::gemm_phase<pg8::EpiBf16<0>, pg8::StaticOrder, true, true>(lds, g, S, E);
    }
    GRID_BARRIER();
    { PHASE_BEGIN;
        float ga[8], gk[8], gq[8], gc[8], gm[8];
#pragma unroll
        for (int j = 0; j < 8; ++j) { ga[j] = g_qn_a[8 * (lane & 7) + j]; gk[j] = g_kn_a[8 * (lane & 7) + j]; gm[j] = g_qn_m[8 * (lane & 15) + j]; gq[j] = lane < 48 ? g_cq[8 * lane + j] : 0.f; gc[j] = lane < 32 ? g_ckv[8 * lane + j] : 0.f; }
        for (int dp = 0; dp < DUMMY_POST1; ++dp)
            for (int m = gw; m < TT; m += NGW)
                post1_row(P + (size_t)m * PP, QB + (size_t)(m & 1023) * 4096, ropeA + (size_t)m * 16, ga, gk, gq, gc, gm, (float*)KVB + (size_t)m * 8, lane);
        for (int m = gw; m < TT; m += NGW)
            post1_row(P + (size_t)m * PP, P + (size_t)m * PP, ropeA + (size_t)m * 16, ga, gk, gq, gc, gm, WI + (size_t)m * 8, lane);
        for (int rt = 0; rt < REP_TR; ++rt)
        transpose_v(P, PP, C_VA, 64, 8, 64, SEQ, NB, VTA, gw, NGW, lane);
        for (int m = gw; m < NB * MEML; m += NGW) km_row(KVM + (size_t)m * 1024, g_kn_m, lane);
        for (int rt = 0; rt < REP_TR; ++rt)
        transpose_v(KVM, 1024, 512, 128, 4, 128, MEML, NB, VTM, gw, NGW, lane);
    }
    GRID_BARRIER();
    for (int rep = 0; rep < REP_G2; ++rep) { PHASE_BEGIN;
        pg8::Gemm g{P + C_CQ, WuqT, TT, 768, 384, PP}; pg8::StaticOrder S; S.init(TT, 768, G, (int)blockIdx.x);
        pg8::EpiBf16<0> E{QB, 768, nullptr, 0, 0, 1.f};
        pg8::gemm_phase<pg8::EpiBf16<0>, pg8::StaticOrder, true, true>(lds, g, S, E);
    }
    for (int rep = 0; rep < REP_G2; ++rep) { PHASE_BEGIN;
        pg8::Gemm g{P + C_CKV, WukvT, TT, 1024, 256, PP}; pg8::StaticOrder S; S.init(TT, 1024, G, (int)((blockIdx.x + 192) % G));
        pg8::EpiBf16<0> E{KVB, 1024, nullptr, 0, 0, 1.f};
        pg8::gemm_phase<pg8::EpiBf16<0>, pg8::StaticOrder, true, true>(lds, g, S, E);
    }
    for (int rep = 0; rep < REP_IDX; ++rep) { if (rep > 0) GRID_BARRIER();
        PHASE_BEGIN;
        unsigned* const q_idx = ctl + 64 * (0 + 4 * rep);
        for (;;) {
            const int u = next_unit(q_idx, slot);
            if (u >= NB * 128) break;
            const int tb = 127 - (u >> 3), bb = u & 7;
            indexer_unit((LAS float*)lds, P, WI, MASK, bb, tb);
        }
    }
    GRID_BARRIER();
    { PHASE_BEGIN;
        LAS float* scr = (LAS float*)(lds + wave * 8192);
        float gqv[12], gkv[12];
#pragma unroll
        for (int e = 0; e < 12; ++e) { gqv[e] = g_qn_b[12 * (lane & 7) + e]; gkv[e] = g_kn_b[12 * (lane & 7) + e]; }
        for (int dp = 0; dp < DUMMY_POST2; ++dp)
            for (int m = gw; m < TT; m += NGW)
                post2_row(QB + (size_t)m * 768, (bf16*)MASK + (size_t)(m & 1023) * 768, KVB + (size_t)m * 1024, P + (size_t)m * PP, (bf16*)MASK + (size_t)(1024 + (m & 1023)) * 768, ropeB + (size_t)m * 32, gqv, gkv, scr, lane);
        for (int m = gw; m < TT; m += NGW)
            post2_row(QB + (size_t)m * 768, QB + (size_t)m * 768, KVB + (size_t)m * 1024, P + (size_t)m * PP, KB + (size_t)m * 768, ropeB + (size_t)m * 32, gqv, gkv, scr, lane);
        for (int rt = 0; rt < REP_TR; ++rt)
        transpose_v(KVB, 1024, 64, 128, 8, 64, SEQ, NB, VTB, gw, NGW, lane);
    }
    GRID_BARRIER();
    for (int rep = 0; rep < REP_ATT; ++rep) { if (rep > 0) GRID_BARRIER();
        PHASE_BEGIN;
        unsigned* const q_att = ctl + 64 * (1 + 4 * rep);
        for (;;) {
            const int u = next_unit(q_att, slot);
            if (u >= 1280) break;
            if (u < 1024) {
                const int qb = 7 - (u >> 7), wi = u & 127, bh = wi & 63, bb = bh >> 3, h = bh & 7;
                const size_t r0 = (size_t)bb * SEQ;
                if (wi < 64) attn_unit_pipe<96, 1>(lds, QB + r0 * 768 + h * 96, 768, KB + r0 * 768 + h * 96, 768, VTB + (size_t)((bb * 8 + h) * 64) * SEQ, SEQ, nullptr,
                                                   P + r0 * PP + C_YB + h * 64, qb * 256);
                else attn_unit_pipe<64, 2>(lds, P + r0 * PP + C_QA + h * 64, PP, P + r0 * PP + C_KA + h * 64, PP, VTA + (size_t)((bb * 8 + h) * 64) * SEQ, SEQ, MASK + r0 * 64,
                                           P + r0 * PP + C_YA + h * 64, qb * 256);
            } else {
                const int v = u - 1024, qb = v & 7, bh = v >> 3, bb = bh >> 2, h = bh & 3;
                const size_t r0 = (size_t)bb * SEQ;
                att_call<128, 128, 0>(rep == 0 && REP_ATT > 1, lds, P + r0 * PP + C_QM + h * 128, PP, KVM + (size_t)bb * MEML * 1024 + h * 128, 1024, VTM + (size_t)((bb * 4 + h) * 128) * MEML, MEML, nullptr,
                                       P + r0 * PP + C_ZM + h * 128, P + r0 * PP + C_YM + h * 128, qb * 256);
            }
        }
    }
    GRID_BARRIER();
    for (int rep = 0; rep < 1; ++rep) { PHASE_BEGIN;
        pg8::Gemm g{Hh, WinT + (size_t)PP * 1024, TT, NZG, 1024, 1024}; pg8::StaticOrder S; S.init(TT, NZG, G, (int)blockIdx.x);
        EpiZG E{P, GT0, GT1};
        pg8::gemm_phase<EpiZG, pg8::StaticOrder, true, true>(lds, g, S, E);
    }
    GRID_BARRIER();
    for (int nbr = 0; nbr < 3 * REP_G4; ++nbr) { const int nb = nbr % 3; PHASE_BEGIN;
        pg8::Gemm g{P + (nb == 0 ? C_YA : (nb == 1 ? C_YB : C_YM)), WbrT + (size_t)nb * 1024 * 512, TT, 1024, 512, PP}; pg8::StaticOrder S; S.init(TT, 1024, G, (int)blockIdx.x);
        EpiMerge E{MG, GT0, GT1, nb};
        pg8::gemm_phase<EpiMerge, pg8::StaticOrder, true, true>(lds, g, S, E);
    }
    GRID_BARRIER();
    for (int rep = 0; rep < REP_G5; ++rep) { PHASE_BEGIN;
        pg8::Gemm g{MG, WoutT, TT, 1024, 1024, 1024}; pg8::StaticOrder S; S.init(TT, 1024, G, (int)blockIdx.x);
        EpiOut E{x, outp};
        pg8::gemm_phase<EpiOut, pg8::StaticOrder, true, true>(lds, g, S, E);
    }
}

extern "C" void kernel_launch(void* const* d_in, const int* in_sizes, int n_in, void* d_out, int out_size, void* d_ws, size_t ws_size, hipStream_t stream) {
    static int grid = 0;
    if (grid == 0) {
        if (n_in != 19 || out_size != TT * DM || ws_size < WS_END) { fprintf(stderr, "kernel_launch: unexpected problem (n_in %d, out %d, ws %zu); nothing launched\n", n_in, out_size, ws_size); grid = -1; return; }
        int dev = 0, cus = 0, per_cu = 0;
        if (hipGetDevice(&dev) != hipSuccess || hipDeviceGetAttribute(&cus, hipDeviceAttributeMultiprocessorCount, dev) != hipSuccess) { grid = -1; return; }
        if (hipFuncSetAttribute((const void*)fwd_kernel, hipFuncAttributeMaxDynamicSharedMemorySize, LDS_BYTES) != hipSuccess) { fprintf(stderr, "kernel_launch: hipFuncSetAttribute failed\n"); grid = -1; return; }
        if (hipOccupancyMaxActiveBlocksPerMultiprocessor(&per_cu, (const void*)fwd_kernel, 512, LDS_BYTES) != hipSuccess || per_cu < 1) { fprintf(stderr, "kernel_launch: occupancy query reports %d blocks per CU\n", per_cu); (void)hipGetLastError(); grid = -1; return; }
        grid = cus;
    }
    if (grid < 0) return;
    (void)hipMemsetAsync((char*)d_ws + WS_CTL, 0, 65536, stream);
    Args a{};
    for (int i = 0; i < 19; ++i) a.in[i] = (const float*)d_in[i];
    a.pos = (const int*)d_in[2]; a.out = (float*)d_out; a.ws = (unsigned char*)d_ws;
    hipLaunchKernelGGL(fwd_kernel, dim3(grid), dim3(512), LDS_BYTES, stream, a);
    const hipError_t e = hipPeekAtLastError();
    if (e != hipSuccess) fprintf(stderr, "kernel_launch: launch failed: %s (grid %d)\n", hipGetErrorString(e), grid);
}
```

```cpp
#include <hip/hip_runtime.h>
#include <cstdio>
#include <cstdint>
namespace pg8 {
#define PG8_LAS __attribute__((address_space(3)))
typedef unsigned short bf16_t;
typedef short bf16x8 __attribute__((ext_vector_type(8)));
typedef float f32x4 __attribute__((ext_vector_type(4)));
typedef unsigned u32x4 __attribute__((ext_vector_type(4)));
constexpr int BM = 256, BK = 64, HALF = 128, HTB = HALF * BK * 2  , STAGE_BYTES = 8 * HTB, NXCD = 8, WGM = 8;

__host__ __device__ __forceinline__ int lds_byte(int r, int c) { const int st = (r >> 4) * 2 + (c >> 5), rr = r & 15, cc = c & 31, ob = rr * 64 + cc * 2; return st * 1024 + (ob ^ (((ob >> 9) & 1) << 5)); }
__host__ __device__ __forceinline__ void stage_rc(int b, int& R, int& C) { const int st = b / 1024, sb = b % 1024, swz = sb ^ (((sb >> 9) & 1) << 5); R = (st >> 1) * 16 + swz / 64; C = (st & 1) * 32 + (swz % 64) / 2; }
__host__ __device__ __forceinline__ int perm32(int rho) { const int n = rho >> 4, i = rho & 15; return 8 * (i >> 2) + 4 * n + (i & 3); }

struct Unit { int pm, pn; };
struct Gemm { const bf16_t* A; const bf16_t* Bt; int M, N, K, lda; };

struct StaticOrder {
    int nM, nN, nwg, G, c;
    __host__ __device__ void init(int M, int N, int G_, int c_) { nM = M / BM; nN = N / BM; nwg = nM * nN; G = G_; c = c_; }
    __host__ __device__ bool next(int i, Unit& u) const {
        const long L = (long)i * G + c; if (L >= nwg) return false;
        int wgid = (int)L; { const int q = nwg / NXCD, r = nwg % NXCD, xcd = wgid % NXCD, off = wgid / NXCD; wgid = (xcd < r ? xcd * (q + 1) : r * (q + 1) + (xcd - r) * q) + off; }
        const int nig = WGM * nN, gid = wgid / nig, fm = gid * WGM, gsz = (nM - fm) < WGM ? (nM - fm) : WGM;
        u.pm = fm + ((wgid % nig) % gsz); u.pn = (wgid % nig) / gsz; return true;
    }
    __device__ __forceinline__ void a_ready(const Unit&) const {}
    __device__ __forceinline__ void done(const Unit&) const {}
};

__device__ __forceinline__ unsigned cvt_pk_bf16(float lo, float hi) { unsigned r; asm volatile("v_cvt_pk_bf16_f32 %0, %1, %2" : "=v"(r) : "v"(lo), "v"(hi)); return r; }
typedef float f32x2 __attribute__((ext_vector_type(2)));
__device__ __forceinline__ f32x2 gelu_pk(f32x2 v) {
    const f32x2 av = __builtin_elementwise_abs(v), d = av * 0.2316418882f + 1.0f;
    f32x2 t; t.x = __builtin_amdgcn_rcpf(d.x); t.y = __builtin_amdgcn_rcpf(d.y);
    f32x2 q = t * 0.5307027145f + (-0.7265760135f); q = q * t + 0.7107068705f; q = q * t + (-0.142248368f); q = q * t + 0.127414796f; q = q * t;
    const f32x2 s = (v * v) * (-0.72134752044f);
    f32x2 e; e.x = __builtin_amdgcn_exp2f(s.x); e.y = __builtin_amdgcn_exp2f(s.y);
    const f32x2 m = v * (q * e), r = v - m;
    f32x2 o; o.x = v.x < 0.f ? m.x : r.x; o.y = v.y < 0.f ? m.y : r.y; return o;
}

template <int ACT  > struct EpiBf16 {
    static constexpr bool PERM = true, AFTER_DRAIN = false; static_assert(ACT == 0 || ACT == 1, "EpiBf16: ACT is 0 (none) or 1 (gelu_pk)");
    bf16_t* O; int ldc; const float* bias; int split_cols; size_t split_stride; float scale0;
    __device__ __forceinline__ void operator()(const f32x4 (&acc)[2][2][4][2], const Unit& u, int wr, int wc, int fr, int fq) const {
        const int row0 = u.pm * BM + wr * 64 + fr; int colt = u.pn * BM; bf16_t* base = O;
        float sc = 1.f; if (split_cols) { const int t = colt / split_cols; base += (size_t)t * split_stride; colt -= t * split_cols; if (t == 0) sc = scale0; }
        const int col0 = colt + wc * 32 + 8 * fq, bcol0 = u.pn * BM + wc * 32 + 8 * fq;
        f32x4 bv[2][2];
#pragma unroll
        for (int bj = 0; bj < 2; ++bj)
#pragma unroll
            for (int n = 0; n < 2; ++n) bv[bj][n] = bias ? *(const f32x4*)(bias + bcol0 + bj * HALF + 4 * n) : (f32x4){0.f, 0.f, 0.f, 0.f};
#pragma unroll
        for (int ai = 0; ai < 2; ++ai)
#pragma unroll
            for (int m = 0; m < 4; ++m) { bf16_t* rowp = base + (size_t)(row0 + ai * HALF + m * 16) * ldc + col0;
#pragma unroll
                for (int bj = 0; bj < 2; ++bj) { f32x4 v0 = acc[ai][bj][m][0] + bv[bj][0], v1 = acc[ai][bj][m][1] + bv[bj][1];
                    if (ACT == 1) { f32x2 a = gelu_pk((f32x2){v0[0], v0[1]}), b = gelu_pk((f32x2){v0[2], v0[3]}), c = gelu_pk((f32x2){v1[0], v1[1]}), d = gelu_pk((f32x2){v1[2], v1[3]});
                        v0 = (f32x4){a.x, a.y, b.x, b.y}; v1 = (f32x4){c.x, c.y, d.x, d.y}; }
                    v0 = v0 * sc; v1 = v1 * sc; u32x4 w; w.x = cvt_pk_bf16(v0[0], v0[1]); w.y = cvt_pk_bf16(v0[2], v0[3]); w.z = cvt_pk_bf16(v1[0], v1[1]); w.w = cvt_pk_bf16(v1[2], v1[3]);
                    *(u32x4*)(rowp + bj * HALF) = w; } }
    }
};
template <class Epi, class Sched, bool ALIGN_EPI = false, bool SP2 = false>
__device__ __forceinline__ void gemm_phase(PG8_LAS unsigned char* lds, const Gemm g, const Sched& S, const Epi& E) {
    int tid_ = threadIdx.x; asm volatile("" : "+v"(tid_));
    const int tid = tid_, wid = __builtin_amdgcn_readfirstlane(tid >> 6), lane = tid & 63, wr = wid >> 2, wc = wid & 3, fr = lane & 15, fq = lane >> 4;
    const int K = g.K, nt = K / BK;
    unsigned voffA[2], voffB[2];
#pragma unroll
    for (int i = 0; i < 2; ++i) { int R, C; stage_rc(tid * 16 + i * 8192, R, C); const int Rb = Epi::PERM ? ((R & ~31) + perm32(R & 31)) : R;
        voffA[i] = (unsigned)(R * g.lda + C) * 2u; voffB[i] = (unsigned)(Rb * K + C) * 2u; }
    const size_t kstep = (size_t)(BK * 2);
    const size_t hstepA = (size_t)HALF * g.lda * 2, hstepB = (size_t)HALF * K * 2;
    const size_t tstepA = 2 * hstepA, tstepB = 2 * hstepB;
    const unsigned ldsw = (unsigned)wid * 1024u;
    const int aoff = lds_byte(wr * 64 + fr, fq * 8), boff = lds_byte(wc * 32 + fr, fq * 8);
#define PG8_SA(b, h) (((b) * 2 + (h)) * HTB)
#define PG8_SB(b, h) ((4 + (b) * 2 + (h)) * HTB)
#define PG8_STAGE(bufoff, gbase, voff) do { _Pragma("unroll") for (int _i = 0; _i < 2; ++_i) \
        __builtin_amdgcn_global_load_lds((const unsigned*)((const char*)(gbase) + (voff)[_i]), (PG8_LAS unsigned*)(lds + (bufoff) + ldsw + _i * 8192), 16, 0, 0); } while (0)
#define PG8_LDA(dst, b, h) do { _Pragma("unroll") for (int m = 0; m < 4; ++m) _Pragma("unroll") for (int k = 0; k < 2; ++k) dst[m][k] = *(const PG8_LAS bf16x8*)(lds + PG8_SA(b, h) + aoff + m * 2048 + k * 1024); } while (0)
#define PG8_LDB(dst, b, h) do { _Pragma("unroll") for (int n = 0; n < 2; ++n) _Pragma("unroll") for (int k = 0; k < 2; ++k) dst[n][k] = *(const PG8_LAS bf16x8*)(lds + PG8_SB(b, h) + boff + n * 2048 + k * 1024); } while (0)
#define PG8_MMA(ai, bj, At, Bt) do { __builtin_amdgcn_s_setprio(1); _Pragma("unroll") for (int m = 0; m < 4; ++m) _Pragma("unroll") for (int n = 0; n < 2; ++n) _Pragma("unroll") for (int k = 0; k < 2; ++k) \
        acc[ai][bj][m][n] = __builtin_amdgcn_mfma_f32_16x16x32_bf16(Bt[n][k], At[m][k], acc[ai][bj][m][n], 0, 0, 0); __builtin_amdgcn_s_setprio(0); } while (0)
#define PG8_WAIT_V(n) asm volatile("s_waitcnt vmcnt(" #n ")" ::: "memory")
#define PG8_WAIT_L(n) asm volatile("s_waitcnt lgkmcnt(" #n ")" ::: "memory")
#define PG8_BAR __builtin_amdgcn_s_barrier()
#define PG8_SCHED __builtin_amdgcn_sched_barrier(0)
    Unit cur, nxt; int ui = 0;
    if (!S.next(0, cur)) return;
    f32x4 acc[2][2][4][2];
#pragma unroll
    for (int a = 0; a < 2; ++a)
#pragma unroll
        for (int b = 0; b < 2; ++b)
#pragma unroll
            for (int m = 0; m < 4; ++m)
#pragma unroll
                for (int n = 0; n < 2; ++n) acc[a][b][m][n] = (f32x4){0.f, 0.f, 0.f, 0.f};
    bf16x8 At[4][2], B0[2][2], B1[2][2];
    const char* cA = (const char*)g.A + (size_t)cur.pm * tstepA; const char* cB = (const char*)g.Bt + (size_t)cur.pn * tstepB;
    S.a_ready(cur);
    if constexpr (SP2) {
        PG8_STAGE(PG8_SB(0, 0), cB, voffB); PG8_STAGE(PG8_SB(0, 1), cB + hstepB, voffB); PG8_STAGE(PG8_SA(0, 0), cA, voffA); PG8_STAGE(PG8_SA(0, 1), cA + hstepA, voffA);
        if (wr == 1) PG8_BAR;
        PG8_WAIT_V(2); PG8_BAR;
        PG8_STAGE(PG8_SB(1, 0), cB + kstep, voffB); PG8_STAGE(PG8_SA(1, 0), cA + kstep, voffA); PG8_STAGE(PG8_SB(1, 1), cB + hstepB + kstep, voffB);
        PG8_WAIT_V(6); PG8_BAR;
    } else {
        PG8_STAGE(PG8_SB(0, 0), cB, voffB); PG8_STAGE(PG8_SA(0, 0), cA, voffA); PG8_STAGE(PG8_SB(0, 1), cB + hstepB, voffB); PG8_STAGE(PG8_SA(0, 1), cA + hstepA, voffA);
        if (wr == 1) PG8_BAR;
        PG8_WAIT_V(4); PG8_BAR;
        PG8_STAGE(PG8_SB(1, 0), cB + kstep, voffB); PG8_STAGE(PG8_SA(1, 0), cA + kstep, voffA); PG8_STAGE(PG8_SB(1, 1), cB + hstepB + kstep, voffB);
        PG8_WAIT_V(6); PG8_BAR;
    }
    for (;;) {
        const bool has_next = S.next(ui + 1, nxt);
        const char* nA = has_next ? (const char*)g.A + (size_t)nxt.pm * tstepA : cA; const char* nB = has_next ? (const char*)g.Bt + (size_t)nxt.pn * tstepB : cB;
        for (int t = 0; t < nt; t += 2) {
            const bool last = (t == nt - 2);
            const char* a1 = cA + (size_t)(t + 1) * kstep;
            const char* a2 = last ? nA : cA + (size_t)(t + 2) * kstep; const char* b2 = last ? nB : cB + (size_t)(t + 2) * kstep;
            const char* a3 = a2 + kstep; const char* b3 = b2 + kstep;
            if (last && has_next) S.a_ready(nxt);
            if constexpr (SP2) {
            PG8_LDB(B0, 0, 0); PG8_LDB(B1, 0, 1); PG8_SCHED; PG8_LDA(At, 0, 0); PG8_STAGE(PG8_SA(1, 1), a1 + hstepA, voffA);
            PG8_WAIT_V(8); PG8_WAIT_L(0); PG8_BAR; PG8_MMA(0, 0, At, B0); PG8_MMA(0, 1, At, B1); PG8_BAR; PG8_SCHED;
            PG8_LDA(At, 0, 1); PG8_STAGE(PG8_SB(0, 0), b2, voffB); PG8_STAGE(PG8_SB(0, 1), b2 + hstepB, voffB); PG8_STAGE(PG8_SA(0, 0), a2, voffA);
            PG8_WAIT_V(8); PG8_WAIT_L(0); PG8_BAR; PG8_MMA(1, 0, At, B0); PG8_MMA(1, 1, At, B1); PG8_BAR; PG8_SCHED;
            PG8_LDB(B0, 1, 0); PG8_LDB(B1, 1, 1); PG8_SCHED; PG8_LDA(At, 1, 0); PG8_STAGE(PG8_SA(0, 1), a2 + hstepA, voffA);
            PG8_WAIT_V(8); PG8_WAIT_L(0); PG8_BAR; PG8_MMA(0, 0, At, B0); PG8_MMA(0, 1, At, B1); PG8_BAR; PG8_SCHED;
            PG8_LDA(At, 1, 1); PG8_STAGE(PG8_SB(1, 0), b3, voffB); PG8_STAGE(PG8_SB(1, 1), b3 + hstepB, voffB); PG8_STAGE(PG8_SA(1, 0), a3, voffA);
            PG8_WAIT_V(8); PG8_WAIT_L(0); PG8_BAR; PG8_MMA(1, 0, At, B0); PG8_MMA(1, 1, At, B1); PG8_BAR; PG8_SCHED;
            } else {
            PG8_LDB(B0, 0, 0); PG8_SCHED; PG8_LDA(At, 0, 0); PG8_STAGE(PG8_SA(1, 1), a1 + hstepA, voffA);
            PG8_WAIT_L(8); PG8_BAR; PG8_WAIT_L(0); PG8_MMA(0, 0, At, B0); PG8_BAR; PG8_SCHED;
            PG8_LDB(B1, 0, 1); PG8_STAGE(PG8_SB(0, 0), b2, voffB);
            PG8_BAR; PG8_WAIT_L(0); PG8_MMA(0, 1, At, B1); PG8_BAR;
            PG8_LDA(At, 0, 1); PG8_STAGE(PG8_SA(0, 0), a2, voffA);
            PG8_BAR; PG8_WAIT_L(0); PG8_MMA(1, 0, At, B0); PG8_BAR; PG8_SCHED;
            PG8_STAGE(PG8_SB(0, 1), b2 + hstepB, voffB);
            PG8_WAIT_V(6); PG8_BAR; PG8_MMA(1, 1, At, B1); PG8_BAR;
            PG8_LDB(B0, 1, 0); PG8_SCHED; PG8_LDA(At, 1, 0); PG8_STAGE(PG8_SA(0, 1), a2 + hstepA, voffA);
            PG8_WAIT_L(8); PG8_BAR; PG8_WAIT_L(0); PG8_MMA(0, 0, At, B0); PG8_BAR; PG8_SCHED;
            PG8_LDB(B1, 1, 1); PG8_STAGE(PG8_SB(1, 0), b3, voffB);
            PG8_BAR; PG8_WAIT_L(0); PG8_MMA(0, 1, At, B1); PG8_BAR;
            PG8_LDA(At, 1, 1); PG8_STAGE(PG8_SA(1, 0), a3, voffA);
            PG8_BAR; PG8_WAIT_L(0); PG8_MMA(1, 0, At, B0); PG8_BAR; PG8_SCHED;
            PG8_STAGE(PG8_SB(1, 1), b3 + hstepB, voffB);
            PG8_WAIT_V(6); PG8_BAR; PG8_MMA(1, 1, At, B1); PG8_BAR;
            }
        }
        if constexpr (ALIGN_EPI) { if (wr == 0) PG8_BAR; }
        if constexpr (!Epi::AFTER_DRAIN) { E(acc, cur, wr, wc, fr, fq); S.done(cur); }
        if (!has_next) break;
#pragma unroll
        for (int a = 0; a < 2; ++a)
#pragma unroll
            for (int b = 0; b < 2; ++b)
#pragma unroll
                for (int m = 0; m < 4; ++m)
#pragma unroll
                    for (int n = 0; n < 2; ++n) acc[a][b][m][n] = (f32x4){0.f, 0.f, 0.f, 0.f};
        cur = nxt; cA = nA; cB = nB; ++ui;
        if constexpr (ALIGN_EPI) { if (wr == 1) PG8_BAR; }
    }
    PG8_WAIT_V(0);
    if constexpr (!ALIGN_EPI) { if (wr == 0) PG8_BAR; }
    PG8_BAR;
    if constexpr (Epi::AFTER_DRAIN) { E.fused(acc, cur, wr, wc, fr, fq, lds, wid, lane); S.done(cur); }
#undef PG8_SA
#undef PG8_SB
#undef PG8_STAGE
#undef PG8_LDA
#undef PG8_LDB
#undef PG8_MMA
#undef PG8_WAIT_V
#undef PG8_WAIT_L
#undef PG8_BAR
#undef PG8_SCHED
}
}

#define LAS __attribute__((address_space(3)))
typedef unsigned short bf16;
typedef unsigned v4u __attribute__((ext_vector_type(4)));
typedef unsigned v2u __attribute__((ext_vector_type(2)));
typedef float f32x4 __attribute__((ext_vector_type(4)));
typedef float f32x16 __attribute__((ext_vector_type(16)));
typedef short bf16x8 __attribute__((ext_vector_type(8)));
typedef short s16x4 __attribute__((ext_vector_type(4)));
typedef float f32x2_t __attribute__((ext_vector_type(2)));
typedef __bf16 bf16x2_t __attribute__((ext_vector_type(2)));

constexpr int NB = 8, SEQ = 2048, DM = 1024, TT = NB * SEQ;
constexpr int DIN = 7912, NP = 7936;
constexpr int PP = 3840, NZG = 4096;
constexpr int MEML = 256;
constexpr float EPS = 1e-6f, NEGF = -1e30f;
constexpr int C_QA = 0, C_KA = 512, C_VA = 1024, C_QI = 1536, C_KI = 2048, C_WI = 2112, C_CQ = 2120, C_CKV = 2504, C_KR = 2760, C_QM = 2792, C_ZM = 3304;
constexpr int C_YA = C_QI, C_YB = C_CQ, C_YM = C_VA;
constexpr float SCALE_A = 0.18033688011112042f;
constexpr float SCALE_B = 0.14724444602590306f;
constexpr float SCALE_M = 0.12751743082459868f;
constexpr float SCALE_I = 0.04419417382415922f;

__constant__ float INVA[8] = {1.0f, 0.1939227432012558f, 0.03760603070259094f, 0.007292664609849453f, 0.0014142135623842478f, 0.00027424818836152554f, 5.3182957344688475e-05f, 1.0313385246263351e-05f};
__constant__ float INVB[16] = {1.0f, 0.44036659598350525f, 0.1939227432012558f, 0.08539710193872452f, 0.03760603070259094f, 0.016560440883040428f, 0.007292664609849453f, 0.0032114461064338684f, 0.0014142135623842478f, 0.0006227724370546639f, 0.00027424818836152554f, 0.00012076973507646471f, 5.3182957344688475e-05f, 2.34199997066753e-05f, 1.0313385246263351e-05f, 4.541670477919979e-06f};

constexpr size_t MiB = 1u << 20;
constexpr size_t WS_CTL = 0;
constexpr size_t WS_WIN = 1 * MiB;
constexpr size_t WS_WUQ = 17 * MiB;
constexpr size_t WS_WUKV = 18 * MiB;
constexpr size_t WS_WMEM = 19 * MiB;
constexpr size_t WS_WBR = 21 * MiB;
constexpr size_t WS_WOUT = 24 * MiB;
constexpr size_t WS_ROPEA = 26 * MiB;
constexpr size_t WS_ROPEB = 27 * MiB;
constexpr size_t WS_MN = 29 * MiB;
constexpr size_t WS_KVM = 33 * MiB;
constexpr size_t WS_VTM = 37 * MiB;
constexpr size_t WS_WI = 39 * MiB;
constexpr size_t WS_MASK = 40 * MiB;
constexpr size_t WS_H = 44 * MiB;
constexpr size_t WS_P = 76 * MiB;
constexpr size_t WS_QB = 196 * MiB;
constexpr size_t WS_KVB = 220 * MiB;
constexpr size_t WS_G1 = 196 * MiB;
constexpr size_t WS_END = 256 * MiB;
constexpr size_t DO_VTA = 0;
constexpr size_t DO_VTB = 16 * MiB;
constexpr size_t DO_KB = 32 * MiB;
constexpr size_t DO_G0 = 0;

constexpr int REP_P0 = 1, REP_PH = 1, REP_G1 = 1, REP_G2 = 1, REP_IDX = 1, REP_ATT = 1, REP_G4 = 1, REP_G5 = 1;
constexpr int REP_IDX1 = 1, REP_SEL = 1;
constexpr int ATT_STRIP = 0;
constexpr int EXTRA_SYNCS = 0, REP_TR = 1, DUMMY_POST1 = 0, DUMMY_POST2 = 0;
constexpr int LDS_BYTES = 147456;
constexpr int LDS_SLOT = LDS_BYTES - 64;

__device__ __forceinline__ unsigned pk2(float lo, float hi) { f32x2_t v = {lo, hi}; bf16x2_t b = __builtin_convertvector(v, bf16x2_t); return __builtin_bit_cast(unsigned, b); }
__device__ __forceinline__ float bflo(unsigned w) { return __uint_as_float(w << 16); }
__device__ __forceinline__ float bfhi(unsigned w) { return __uint_as_float(w & 0xffff0000u); }
__device__ __forceinline__ float bf1(bf16 b) { return __uint_as_float(((unsigned)b) << 16); }
#define UNPACK8(W_, V_) do { V_[0] = bflo((W_)[0]); V_[1] = bfhi((W_)[0]); V_[2] = bflo((W_)[1]); V_[3] = bfhi((W_)[1]); V_[4] = bflo((W_)[2]); V_[5] = bfhi((W_)[2]); V_[6] = bflo((W_)[3]); V_[7] = bfhi((W_)[3]); } while (0)
#define PACK8(V_) (v4u){pk2(V_[0], V_[1]), pk2(V_[2], V_[3]), pk2(V_[4], V_[5]), pk2(V_[6], V_[7])}
template <int CTRL> __device__ __forceinline__ float dpp_f(float v) { return __int_as_float(__builtin_amdgcn_update_dpp(0, __float_as_int(v), CTRL, 0xF, 0xF, false)); }
#define SUM8(x) do { x += dpp_f<0xB1>(x); x += dpp_f<0x4E>(x); x += dpp_f<0x141>(x); } while (0)
#define SUM16(x) do { SUM8(x); x += dpp_f<0x140>(x); } while (0)
__device__ __forceinline__ float wave_sum(float v) {
    SUM16(v);
    return __int_as_float(__builtin_amdgcn_readlane(__float_as_int(v), 0)) + __int_as_float(__builtin_amdgcn_readlane(__float_as_int(v), 16))
         + __int_as_float(__builtin_amdgcn_readlane(__float_as_int(v), 32)) + __int_as_float(__builtin_amdgcn_readlane(__float_as_int(v), 48));
}
#define LDS_WAIT() asm volatile("s_waitcnt lgkmcnt(0)" ::: "memory")

__device__ __forceinline__ int win_src(int d) {
    if (d < 2120) return d;
    if (d < 2792) return d + 512;
    if (d < 3816) return d + 1024;
    if (d < 3840) return -1;
    if (d < 4352) return d - 3840 + 2120;
    if (d < 4864) return d - 4352 + 3304;
    return d - 4864 + 4840;
}
template <bool REMAP>
__device__ __forceinline__ void transpose_item(const float* W, int K, int N, int Npad, bf16* WT, LAS float* scr, int item, int lane) {
    const int nblk = Npad / 32, kb = item / nblk, nb = item % nblk, k0 = 64 * kb, n0 = 32 * nb;
    const int n4 = 4 * (lane & 7);
    const int nn = REMAP ? win_src(n0 + n4) : n0 + n4; const bool ok = nn >= 0 && nn < N;
#pragma unroll
    for (int i = 0; i < 8; ++i) { const int kk = 8 * i + (lane >> 3);
        f32x4 v = (f32x4){0.f, 0.f, 0.f, 0.f}; if (ok) v = *(const f32x4*)(W + (size_t)(k0 + kk) * N + nn);
        LAS float* d = scr + kk * 33 + n4; d[0] = v[0]; d[1] = v[1]; d[2] = v[2]; d[3] = v[3]; }
    LDS_WAIT(); asm volatile("" ::: "memory");
    const int c = lane & 7;
#pragma unroll
    for (int j = 0; j < 4; ++j) { const int n = (lane >> 3) + 8 * j; const LAS float* s = scr + (8 * c) * 33 + n;
        v4u o; o.x = pk2(s[0 * 33], s[1 * 33]); o.y = pk2(s[2 * 33], s[3 * 33]); o.z = pk2(s[4 * 33], s[5 * 33]); o.w = pk2(s[6 * 33], s[7 * 33]);
        *(v4u*)(WT + (size_t)(n0 + n) * K + k0 + 8 * c) = o; }
    LDS_WAIT(); asm volatile("" ::: "memory");
}
__device__ __forceinline__ void rms_row_1024(const float* xrow, const float* g, bf16* orow, int lane) {
    const f32x4* xr = (const f32x4*)xrow + lane; const f32x4* gr = (const f32x4*)g + lane;
    f32x4 v[4]; float s = 0.f;
#pragma unroll
    for (int j = 0; j < 4; ++j) { v[j] = xr[64 * j]; s += (v[j].x * v[j].x + v[j].y * v[j].y) + (v[j].z * v[j].z + v[j].w * v[j].w); }
    const float rstd = __builtin_amdgcn_rsqf(wave_sum(s) * (1.f / 1024.f) + EPS);
    v2u* o8 = (v2u*)orow + lane;
#pragma unroll
    for (int j = 0; j < 4; ++j) { const f32x4 gg = gr[64 * j]; v2u w; w.x = pk2(v[j].x * rstd * gg.x, v[j].y * rstd * gg.y); w.y = pk2(v[j].z * rstd * gg.z, v[j].w * rstd * gg.w); o8[64 * j] = w; }
}

#define ROPE8(v, sub, c8, s8) do { _Pragma("unroll") for (int j_ = 0; j_ < 8; ++j_) { const float pv_ = dpp_f<0xB1>(v[j_]); \
        const float r0_ = v[j_] * c8[j_] - pv_ * s8[j_], r1_ = v[j_] * c8[j_] + pv_ * s8[j_]; v[j_] = (sub) == 0 ? r0_ : ((sub) == 1 ? r1_ : v[j_]); } } while (0)

__device__ __forceinline__ void post1_row(const bf16* Prow, bf16* Orow, const float* ra, const float (&ga)[8], const float (&gk)[8], const float (&gq)[8], const float (&gc)[8], const float (&gm)[8], float* WIrow, int lane) {
    const int sub = lane & 7;
    const v4u z4 = (v4u){0u, 0u, 0u, 0u};
    const v4u w_qa = *(const v4u*)(Prow + C_QA + 8 * lane);
    const v4u w_ka = *(const v4u*)(Prow + C_KA + 8 * lane);
    const v4u w_qi = *(const v4u*)(Prow + C_QI + 8 * lane);
    const v4u w_qm = *(const v4u*)(Prow + C_QM + 8 * lane);
    v4u w_ki = z4, w_cq = z4, w_ckv = z4; float w_wi = 0.f;
    if (lane < 8) { w_ki = *(const v4u*)(Prow + C_KI + 8 * lane); w_wi = bf1(Prow[C_WI + lane]); }
    if (lane < 48) w_cq = *(const v4u*)(Prow + C_CQ + 8 * lane);
    if (lane < 32) w_ckv = *(const v4u*)(Prow + C_CKV + 8 * lane);
    float c8[8], s8[8];
    { const f32x4 r0 = *(const f32x4*)(ra), r1 = *(const f32x4*)(ra + 4), r2 = *(const f32x4*)(ra + 8), r3 = *(const f32x4*)(ra + 12);
      c8[0] = r0[0]; c8[1] = r0[1]; c8[2] = r0[2]; c8[3] = r0[3]; c8[4] = r1[0]; c8[5] = r1[1]; c8[6] = r1[2]; c8[7] = r1[3];
      s8[0] = r2[0]; s8[1] = r2[1]; s8[2] = r2[2]; s8[3] = r2[3]; s8[4] = r3[0]; s8[5] = r3[1]; s8[6] = r3[2]; s8[7] = r3[3]; }
    { float v[8]; UNPACK8(w_qa, v); float ss = 0.f;
#pragma unroll
      for (int j = 0; j < 8; ++j) ss += v[j] * v[j];
      SUM8(ss);
      const float rstd = __builtin_amdgcn_rsqf(ss * (1.f / 64.f) + EPS);
#pragma unroll
      for (int j = 0; j < 8; ++j) v[j] = v[j] * rstd * ga[j];
      ROPE8(v, sub, c8, s8);
#pragma unroll
      for (int j = 0; j < 8; ++j) v[j] *= SCALE_A;
      *(v4u*)(Orow + C_QA + 8 * lane) = PACK8(v); }
    { float v[8]; UNPACK8(w_ka, v); float ss = 0.f;
#pragma unroll
      for (int j = 0; j < 8; ++j) ss += v[j] * v[j];
      SUM8(ss);
      const float rstd = __builtin_amdgcn_rsqf(ss * (1.f / 64.f) + EPS);
#pragma unroll
      for (int j = 0; j < 8; ++j) v[j] = v[j] * rstd * gk[j];
      ROPE8(v, sub, c8, s8);
      *(v4u*)(Orow + C_KA + 8 * lane) = PACK8(v); }
    { float v[8]; UNPACK8(w_qi, v);
      ROPE8(v, sub, c8, s8);
      *(v4u*)(Orow + C_QI + 8 * lane) = PACK8(v); }
    { float v[8]; UNPACK8(w_ki, v);
      ROPE8(v, sub, c8, s8);
      if (lane < 8) *(v4u*)(Orow + C_KI + 8 * lane) = PACK8(v); }
    if (lane < 8) WIrow[lane] = w_wi * SCALE_I;
    { float v[8]; UNPACK8(w_cq, v); float ss = 0.f;
#pragma unroll
      for (int j = 0; j < 8; ++j) ss += v[j] * v[j];
      ss = wave_sum(ss); const float rstd = __builtin_amdgcn_rsqf(ss * (1.f / 384.f) + EPS);
      if (lane < 48) {
#pragma unroll
          for (int j = 0; j < 8; ++j) v[j] = v[j] * rstd * gq[j];
          *(v4u*)(Orow + C_CQ + 8 * lane) = PACK8(v); } }
    { float v[8]; UNPACK8(w_ckv, v); float ss = 0.f;
#pragma unroll
      for (int j = 0; j < 8; ++j) ss += v[j] * v[j];
      ss = wave_sum(ss); const float rstd = __builtin_amdgcn_rsqf(ss * (1.f / 256.f) + EPS);
      if (lane < 32) {
#pragma unroll
          for (int j = 0; j < 8; ++j) v[j] = v[j] * rstd * gc[j];
          *(v4u*)(Orow + C_CKV + 8 * lane) = PACK8(v); } }
    { float v[8]; UNPACK8(w_qm, v); float ss = 0.f;
#pragma unroll
      for (int j = 0; j < 8; ++j) ss += v[j] * v[j];
      SUM16(ss);
      const float rstd = __builtin_amdgcn_rsqf(ss * (1.f / 128.f) + EPS);
#pragma unroll
      for (int j = 0; j < 8; ++j) v[j] = v[j] * rstd * gm[j] * SCALE_M;
      *(v4u*)(Orow + C_QM + 8 * lane) = PACK8(v); }
}

__device__ __forceinline__ void km_row(bf16* row, const float* gkm, int lane) {
    v4u w = *(const v4u*)(row + 8 * lane); float v[8]; UNPACK8(w, v); float ss = 0.f;
#pragma unroll
    for (int j = 0; j < 8; ++j) ss += v[j] * v[j];
    SUM16(ss);
    const float rstd = __builtin_amdgcn_rsqf(ss * (1.f / 128.f) + EPS);
#pragma unroll
    for (int j = 0; j < 8; ++j) v[j] = v[j] * rstd * gkm[8 * (lane & 15) + j];
    *(v4u*)(row + 8 * lane) = PACK8(v);
}

__device__ __forceinline__ void transpose_v(const bf16* src, int pitch, int col0, int hstride, int H, int DV, int S, int nb, bf16* dst, int gw, int NGW, int lane) {
    const int ndq = DV / 64, nsc = S / 64, ntask = nb * H * nsc * ndq;
    for (int task = gw; task < ntask; task += NGW) {
        int x = task; const int dq = x % ndq; x /= ndq; const int sc = x % nsc; x /= nsc; const int h = x % H; const int b = x / H;
        const int s = sc * 64 + lane;
        const bf16* srow = src + (size_t)(b * S + s) * pitch + col0 + h * hstride + dq * 64;
        bf16* drow = dst + ((size_t)((b * H + h) * DV + dq * 64)) * S + s;
        v4u wv[8];
#pragma unroll
        for (int c = 0; c < 8; ++c) wv[c] = *(const v4u*)(srow + 8 * c);
#pragma unroll
        for (int c = 0; c < 8; ++c) { const v4u w = wv[c];
            drow[(size_t)(8 * c + 0) * S] = (bf16)(w.x & 0xffffu); drow[(size_t)(8 * c + 1) * S] = (bf16)(w.x >> 16);
            drow[(size_t)(8 * c + 2) * S] = (bf16)(w.y & 0xffffu); drow[(size_t)(8 * c + 3) * S] = (bf16)(w.y >> 16);
            drow[(size_t)(8 * c + 4) * S] = (bf16)(w.z & 0xffffu); drow[(size_t)(8 * c + 5) * S] = (bf16)(w.z >> 16);
            drow[(size_t)(8 * c + 6) * S] = (bf16)(w.w & 0xffffu); drow[(size_t)(8 * c + 7) * S] = (bf16)(w.w >> 16); }
    }
}

__device__ __forceinline__ void post2_row(const bf16* QBrow, bf16* QOrow, const bf16* KVBrow, const bf16* Prow, bf16* KBrow, const float* rb, const float (&gqv)[12], const float (&gkv)[12], LAS float* scr, int lane) {
    const int hd = lane >> 3, d0 = 12 * (lane & 7);
    float vq[12], vk[12], cc[12], sn[12];
    { const v2u* p = (const v2u*)(QBrow + 12 * lane);
      const v2u w0 = p[0], w1 = p[1], w2 = p[2];
      bf16 kr[12];
#pragma unroll
      for (int e = 0; e < 12; ++e) { const int d = d0 + e; kr[e] = d < 64 ? KVBrow[hd * 128 + d] : Prow[C_KR + d - 64]; }
#pragma unroll
      for (int e = 0; e < 12; ++e) { const int d = d0 + e; const int i = (d - 64) & 15; cc[e] = d < 64 ? 1.f : rb[i]; sn[e] = d < 64 ? 0.f : rb[16 + i]; }
      vq[0] = bflo(w0.x); vq[1] = bfhi(w0.x); vq[2] = bflo(w0.y); vq[3] = bfhi(w0.y); vq[4] = bflo(w1.x); vq[5] = bfhi(w1.x); vq[6] = bflo(w1.y); vq[7] = bfhi(w1.y);
      vq[8] = bflo(w2.x); vq[9] = bfhi(w2.x); vq[10] = bflo(w2.y); vq[11] = bfhi(w2.y);
#pragma unroll
      for (int e = 0; e < 12; ++e) vk[e] = bf1(kr[e]); }
    float sq = 0.f, sk = 0.f;
#pragma unroll
    for (int e = 0; e < 12; ++e) { sq += vq[e] * vq[e]; sk += vk[e] * vk[e]; }
    SUM8(sq); SUM8(sk);
    const float rq = __builtin_amdgcn_rsqf(sq * (1.f / 96.f) + EPS), rk = __builtin_amdgcn_rsqf(sk * (1.f / 96.f) + EPS);
#pragma unroll
    for (int e = 0; e < 12; ++e) { vq[e] = vq[e] * rq * gqv[e]; vk[e] = vk[e] * rk * gkv[e]; scr[12 * lane + e] = vq[e]; scr[768 + 12 * lane + e] = vk[e]; }
    LDS_WAIT(); asm volatile("" ::: "memory");
    float oq[12], ok[12];
#pragma unroll
    for (int e = 0; e < 12; ++e) { const int d = d0 + e;
        if (d < 64) { oq[e] = vq[e]; ok[e] = vk[e]; }
        else { const bool first = d < 80; const int off = first ? 16 : -16; const float pq = scr[12 * lane + e + off], pk = scr[768 + 12 * lane + e + off];
               oq[e] = first ? vq[e] * cc[e] - pq * sn[e] : vq[e] * cc[e] + pq * sn[e];
               ok[e] = first ? vk[e] * cc[e] - pk * sn[e] : vk[e] * cc[e] + pk * sn[e]; }
        oq[e] *= SCALE_B; }
    LDS_WAIT(); asm volatile("" ::: "memory");
    v2u* q = (v2u*)(QOrow + 12 * lane); v2u* k = (v2u*)(KBrow + 12 * lane);
#pragma unroll
    for (int i = 0; i < 3; ++i) { v2u w; w.x = pk2(oq[4 * i], oq[4 * i + 1]); w.y = pk2(oq[4 * i + 2], oq[4 * i + 3]); q[i] = w;
                                  v2u u; u.x = pk2(ok[4 * i], ok[4 * i + 1]); u.y = pk2(ok[4 * i + 2], ok[4 * i + 3]); k[i] = u; }
}

__device__ __forceinline__ int next_unit(unsigned* ctr, volatile LAS int* slot) {
    __syncthreads();
    if (threadIdx.x == 0) *slot = (int)atomicAdd(ctr, 1u);
    __syncthreads();
    return *slot;
}

constexpr int SCP = 2112;
__device__ __forceinline__ unsigned ord_key(float v) { const unsigned b = __float_as_uint(v); return b ^ ((unsigned)((int)b >> 31) | 0x80000000u); }
__device__ __forceinline__ void indexer_unit(LAS float* sc, const bf16* P, const float* WI, unsigned* MASK, int bb, int tb) {
    int tid_ = threadIdx.x; asm volatile("" : "+v"(tid_));
    const int tid = tid_, lane = tid & 63, w = __builtin_amdgcn_readfirstlane(tid >> 6);
    const int n = lane & 15, g = lane >> 4;
    const int rowbase = bb * SEQ, t0 = tb * 16;
    for (int rp1 = 0; rp1 < REP_IDX1; ++rp1) {
        bf16x8 qf[8][2]; float wq[8];
        const bf16* qrow = P + (size_t)(rowbase + t0 + n) * PP + C_QI + 8 * g;
#pragma unroll
        for (int h = 0; h < 8; ++h) {
            qf[h][0] = *(const bf16x8*)(qrow + h * 64);
            qf[h][1] = *(const bf16x8*)(qrow + h * 64 + 32);
            wq[h] = WI[(size_t)(rowbase + t0 + n) * 8 + h];
        }
        const int ntile = tb + 1;
        const int nmine = (ntile - w + 7) >> 3;
        const int ngrp = (nmine + 3) >> 2;
        const bf16* kbase = P + (size_t)(rowbase + n) * PP + C_KI + 8 * g;
        bf16x8 kb[2][4][2];
#define IDX_LOAD(BUF, GRP) do { _Pragma("unroll") for (int j_ = 0; j_ < 4; ++j_) { const int tile_ = w + 8 * (4 * (GRP) + j_); const int tl_ = tile_ < ntile ? tile_ : 0; \
            const bf16* kr_ = kbase + (size_t)(16 * tl_) * PP; kb[BUF][j_][0] = *(const bf16x8*)(kr_); kb[BUF][j_][1] = *(const bf16x8*)(kr_ + 32); } } while (0)
#define IDX_COMP(BUF, GRP) do { _Pragma("unroll") for (int j_ = 0; j_ < 4; ++j_) { const int tile_ = w + 8 * (4 * (GRP) + j_); if (tile_ < ntile) { \
            f32x4 idx_ = (f32x4){0.f, 0.f, 0.f, 0.f}; \
            _Pragma("unroll") for (int h_ = 0; h_ < 8; ++h_) { f32x4 a_ = (f32x4){0.f, 0.f, 0.f, 0.f}; \
                a_ = __builtin_amdgcn_mfma_f32_16x16x32_bf16(kb[BUF][j_][0], qf[h_][0], a_, 0, 0, 0); \
                a_ = __builtin_amdgcn_mfma_f32_16x16x32_bf16(kb[BUF][j_][1], qf[h_][1], a_, 0, 0, 0); \
                _Pragma("unroll") for (int i_ = 0; i_ < 4; ++i_) idx_[i_] = __builtin_fmaf(wq[h_], __builtin_fmaxf(a_[i_], 0.f), idx_[i_]); } \
            { const int k0_ = 16 * tile_ + 4 * g; LAS float* d_ = sc + n * SCP + k0_ + (k0_ >> 5); d_[0] = idx_[0]; d_[1] = idx_[1]; d_[2] = idx_[2]; d_[3] = idx_[3]; } } } } while (0)
        if (ngrp > 0) IDX_LOAD(0, 0);
        for (int gp = 0; gp < ngrp; gp += 2) {
            if (gp + 1 < ngrp) IDX_LOAD(1, gp + 1);
            IDX_COMP(0, gp);
            if (gp + 1 < ngrp) { if (gp + 2 < ngrp) IDX_LOAD(0, gp + 2); IDX_COMP(1, gp + 1); }
        }
#undef IDX_LOAD
#undef IDX_COMP
    }
    __syncthreads();
    for (int rs = 0; rs < REP_SEL; ++rs) {
        const int ta = t0 + 2 * w, tb2 = ta + 1;
        unsigned* mra = MASK + (size_t)(rowbase + ta) * 64; unsigned* mrb = mra + 64;
        const int nva = ta - 32 * lane + 1, nvb = nva + 1;
        const unsigned valid_a = nva >= 32 ? 0xffffffffu : (nva <= 0 ? 0u : ((1u << nva) - 1u));
        const unsigned valid_b = nvb >= 32 ? 0xffffffffu : (nvb <= 0 ? 0u : ((1u << nvb) - 1u));
        if (ta < 256) { mra[lane] = valid_a; mrb[lane] = valid_b; continue; }
        unsigned ua[32], ub[32];
        { const LAS float* sra = sc + (2 * w) * SCP + 33 * lane; const LAS float* srb = sra + SCP;
#pragma unroll
          for (int r = 0; r < 32; ++r) { const float va = sra[r], vb = srb[r]; ua[r] = ((valid_a >> r) & 1u) ? ord_key(va) : 0u; ub[r] = ((valid_b >> r) & 1u) ? ord_key(vb) : 0u; } }
#pragma unroll
        for (int si = 0; si < 5; ++si) { const int sft = 16 >> si;
            const unsigned msk = si == 0 ? 0x0000ffffu : (si == 1 ? 0x00ff00ffu : (si == 2 ? 0x0f0f0f0fu : (si == 3 ? 0x33333333u : 0x55555555u)));
#pragma unroll
            for (int k = 0; k < 32; ++k) if (!(k & sft)) {
                const unsigned ta_ = ((ua[k] >> sft) ^ ua[k + sft]) & msk; ua[k + sft] ^= ta_; ua[k] ^= ta_ << sft;
                const unsigned tb_ = ((ub[k] >> sft) ^ ub[k + sft]) & msk; ub[k + sft] ^= tb_; ub[k] ^= tb_ << sft; } }
        unsigned alive_a = valid_a, sel_a = 0u, alive_b = valid_b, sel_b = 0u; int need_a = 256, need_b = 256; bool run_a = true, run_b = true;
#pragma unroll
        for (int j = 31; j >= 0; --j) {
            const unsigned ones_a = alive_a & ua[j], ones_b = alive_b & ub[j];
            int v = (int)((unsigned)__popc(ones_a) | ((unsigned)__popc(ones_b) << 16));
            v += __builtin_amdgcn_update_dpp(0, v, 0xB1, 0xF, 0xF, false);
            v += __builtin_amdgcn_update_dpp(0, v, 0x4E, 0xF, 0xF, false);
            v += __builtin_amdgcn_update_dpp(0, v, 0x141, 0xF, 0xF, false);
            v += __builtin_amdgcn_update_dpp(0, v, 0x140, 0xF, 0xF, false);
            const unsigned tot = (unsigned)(__builtin_amdgcn_readlane(v, 0) + __builtin_amdgcn_readlane(v, 16) + __builtin_amdgcn_readlane(v, 32) + __builtin_amdgcn_readlane(v, 48));
            const int ca = (int)(tot & 0xffffu), cb = (int)(tot >> 16);
            if (run_a) { if (ca >= need_a) { alive_a = ones_a; if (ca == need_a) { sel_a |= ones_a; need_a = 0; run_a = false; } }
                         else { need_a -= ca; sel_a |= ones_a; alive_a &= ~ua[j]; } }
            if (run_b) { if (cb >= need_b) { alive_b = ones_b; if (cb == need_b) { sel_b |= ones_b; need_b = 0; run_b = false; } }
                         else { need_b -= cb; sel_b |= ones_b; alive_b &= ~ub[j]; } }
            if (!run_a && !run_b) break;
        }
        if (need_a > 0) {
            const int cnt = __popc(alive_a); int inc = cnt;
#pragma unroll
            for (int d = 1; d < 64; d <<= 1) { const int o = __shfl_up(inc, d); if (lane >= d) inc += o; }
            int k = need_a - (inc - cnt); k = k < 0 ? 0 : (k > cnt ? cnt : k);
            unsigned m = alive_a;
            for (int i = 0; i < k; ++i) { const unsigned low = m & (0u - m); sel_a |= low; m ^= low; }
        }
        if (need_b > 0) {
            const int cnt = __popc(alive_b); int inc = cnt;
#pragma unroll
            for (int d = 1; d < 64; d <<= 1) { const int o = __shfl_up(inc, d); if (lane >= d) inc += o; }
            int k = need_b - (inc - cnt); k = k < 0 ? 0 : (k > cnt ? cnt : k);
            unsigned m = alive_b;
            for (int i = 0; i < k; ++i) { const unsigned low = m & (0u - m); sel_b |= low; m ^= low; }
        }
        mra[lane] = sel_a; mrb[lane] = sel_b;
        (void)tb2;
    }
    __syncthreads();
}

__device__ __forceinline__ float half_max(float m) { auto rr = __builtin_amdgcn_permlane32_swap(__float_as_uint(m), __float_as_uint(m), false, false); return __builtin_fmaxf(__uint_as_float(rr[0]), __uint_as_float(rr[1])); }
__device__ __forceinline__ float half_sum(float m) { auto rr = __builtin_amdgcn_permlane32_swap(__float_as_uint(m), __float_as_uint(m), false, false); return __uint_as_float(rr[0]) + __uint_as_float(rr[1]); }
__device__ __forceinline__ int crow(int r, int hi) { return (r & 3) + 8 * (r >> 2) + 4 * hi; }
template <int DQK, int DV, int MODE, int STRIP = 0>
__device__ __forceinline__ void attn_unit(LAS unsigned char* lds, const bf16* Qb, int qpitch, const bf16* Kb, int kpitch, const bf16* VTb, int skv,
                                          const unsigned* maskb, const bf16* Zb, bf16* Ob, int q0) {
    constexpr int TK = 128, KP = DQK + 8, VP = TK + 8;
    LAS bf16* Ks = (LAS bf16*)lds; LAS bf16* Vs = Ks + TK * KP;
    constexpr int CPR = DQK / 8;
    constexpr int NCK = TK * CPR, NCV = DV * (TK / 8);
    constexpr int RK = (NCK + 511) / 512, RV = (NCV + 511) / 512;
    constexpr int NKS = DQK / 16, NMT = DV / 32;
    int tid_ = threadIdx.x; asm volatile("" : "+v"(tid_));
    const int tid = tid_, lane = tid & 63, w = __builtin_amdgcn_readfirstlane(tid >> 6), r = lane & 31, hh = lane >> 5;
    const int NT = MODE == 0 ? skv / TK : (q0 + 256) / TK;
    const int qlo = q0 + 32 * w;
    bf16x8 qf[NKS];
    { const bf16* qrow = Qb + (size_t)(qlo + r) * qpitch + 8 * hh;
#pragma unroll
      for (int ks = 0; ks < NKS; ++ks) qf[ks] = *(const bf16x8*)(qrow + 16 * ks); }
    f32x16 o[NMT];
#pragma unroll
    for (int mt = 0; mt < NMT; ++mt)
#pragma unroll
        for (int i = 0; i < 16; ++i) o[mt][i] = 0.f;
    float m_run = NEGF, l_run = 0.f;
    v4u kreg[RK], vreg[RV];
#define ATT_PREFETCH(tile_) do { \
        _Pragma("unroll") for (int i_ = 0; i_ < RK; ++i_) { const int c_ = tid + 512 * i_; if (c_ < NCK) { const int row_ = c_ / CPR, cc_ = c_ % CPR; kreg[i_] = *(const v4u*)(Kb + (size_t)(TK * (tile_) + row_) * kpitch + 8 * cc_); } } \
        _Pragma("unroll") for (int i_ = 0; i_ < RV; ++i_) { const int c_ = tid + 512 * i_; if (c_ < NCV) { const int d_ = c_ >> 4, cc_ = c_ & 15; vreg[i_] = *(const v4u*)(VTb + (size_t)d_ * skv + TK * (tile_) + 8 * cc_); } } } while (0)
    if (STRIP != 2) ATT_PREFETCH(0);
    for (int tile = 0; tile < NT; ++tile) {
        __syncthreads();
        if (STRIP != 2) {
#pragma unroll
        for (int i = 0; i < RK; ++i) { const int c = tid + 512 * i; if (c < NCK) { const int row = c / CPR, cc = c % CPR; *(LAS v4u*)(Ks + row * KP + 8 * cc) = kreg[i]; } }
#pragma unroll
        for (int i = 0; i < RV; ++i) { const int c = tid + 512 * i; if (c < NCV) { const int d = c >> 4, cc = c & 15; *(LAS v4u*)(Vs + d * VP + 8 * cc) = vreg[i]; } }
        }
        __syncthreads();
        if (STRIP != 2 && tile + 1 < NT) ATT_PREFETCH(tile + 1);
        __builtin_amdgcn_sched_barrier(0);
        if (STRIP == 1) continue;
#pragma unroll 1
        for (int sub = 0; sub < 2; ++sub) {
        const int t64 = 2 * tile + sub;
        if (MODE != 0 && 64 * t64 > qlo + 31) continue;
        const LAS bf16* Kc = Ks + 64 * sub * KP; const LAS bf16* Vc = Vs + 64 * sub;
        unsigned mw0 = 0u, mw1 = 0u;
        if (MODE == 2) { const v2u mm = *(const v2u*)(maskb + (size_t)(qlo + r) * 64 + 2 * t64); mw0 = mm.x >> (4 * hh); mw1 = mm.y >> (4 * hh); }
        f32x16 s0, s1;
#pragma unroll
        for (int i = 0; i < 16; ++i) { s0[i] = 0.f; s1[i] = 0.f; }
#pragma unroll
        for (int ks = 0; ks < NKS; ++ks) {
            const bf16x8 a0 = *(const LAS bf16x8*)(Kc + r * KP + 16 * ks + 8 * hh);
            const bf16x8 a1 = *(const LAS bf16x8*)(Kc + (32 + r) * KP + 16 * ks + 8 * hh);
            s0 = __builtin_amdgcn_mfma_f32_32x32x16_bf16(a0, qf[ks], s0, 0, 0, 0);
            s1 = __builtin_amdgcn_mfma_f32_32x32x16_bf16(a1, qf[ks], s1, 0, 0, 0);
        }
        if (MODE == 1) {
            if (64 * t64 + 63 > qlo) { const int qg = qlo + r;
#pragma unroll
                for (int i = 0; i < 16; ++i) { const int key = 64 * t64 + crow(i, hh); if (key > qg) s0[i] = NEGF; if (key + 32 > qg) s1[i] = NEGF; } }
        }
        if (MODE == 2) {
#pragma unroll
            for (int i = 0; i < 16; ++i) { const int bit = (i & 3) + 8 * (i >> 2); if (!((mw0 >> bit) & 1u)) s0[i] = NEGF; if (!((mw1 >> bit) & 1u)) s1[i] = NEGF; }
        }
        float mx = s0[0];
#pragma unroll
        for (int i = 1; i < 16; ++i) mx = __builtin_fmaxf(mx, s0[i]);
#pragma unroll
        for (int i = 0; i < 16; ++i) mx = __builtin_fmaxf(mx, s1[i]);
        mx = half_max(mx);
        const float m_new = __builtin_fmaxf(m_run, mx);
        const float alpha = __builtin_amdgcn_exp2f(m_run - m_new);
        m_run = m_new;
        float ls = 0.f;
#pragma unroll
        for (int i = 0; i < 16; ++i) { s0[i] = __builtin_amdgcn_exp2f(s0[i] - m_new); s1[i] = __builtin_amdgcn_exp2f(s1[i] - m_new); ls += s0[i] + s1[i]; }
        l_run = l_run * alpha + ls;
#pragma unroll
        for (int mt = 0; mt < NMT; ++mt)
#pragma unroll
            for (int i = 0; i < 16; ++i) o[mt][i] *= alpha;
        v4u pf[2][2];
#pragma unroll
        for (int s = 0; s < 2; ++s) {
            pf[0][s] = (v4u){pk2(s0[8 * s], s0[8 * s + 1]), pk2(s0[8 * s + 2], s0[8 * s + 3]), pk2(s0[8 * s + 4], s0[8 * s + 5]), pk2(s0[8 * s + 6], s0[8 * s + 7])};
            pf[1][s] = (v4u){pk2(s1[8 * s], s1[8 * s + 1]), pk2(s1[8 * s + 2], s1[8 * s + 3]), pk2(s1[8 * s + 4], s1[8 * s + 5]), pk2(s1[8 * s + 6], s1[8 * s + 7])};
        }
#pragma unroll
        for (int mt = 0; mt < NMT; ++mt)
#pragma unroll
            for (int p = 0; p < 2; ++p)
#pragma unroll
                for (int s = 0; s < 2; ++s) {
                    const LAS bf16* vp = Vc + (32 * mt + r) * VP + 32 * p + 16 * s + 4 * hh;
                    const s16x4 lo = *(const LAS s16x4*)(vp), hi = *(const LAS s16x4*)(vp + 8);
                    const bf16x8 a = (bf16x8){lo[0], lo[1], lo[2], lo[3], hi[0], hi[1], hi[2], hi[3]};
                    o[mt] = __builtin_amdgcn_mfma_f32_32x32x16_bf16(a, __builtin_bit_cast(bf16x8, pf[p][s]), o[mt], 0, 0, 0);
                }
        }
    }
#undef ATT_PREFETCH
    const float l_tot = half_sum(l_run);
    const float inv = 1.0f / l_tot;
    const size_t row = (size_t)(qlo + r);
#pragma unroll
    for (int mt = 0; mt < NMT; ++mt)
#pragma unroll
        for (int g4 = 0; g4 < 4; ++g4) {
            const int d = 32 * mt + 8 * g4 + 4 * hh;
            float ov[4];
#pragma unroll
            for (int i = 0; i < 4; ++i) ov[i] = o[mt][4 * g4 + i] * inv;
            if (Zb) { const v2u zw = *(const v2u*)(Zb + row * PP + d); const float z[4] = {bflo(zw.x), bfhi(zw.x), bflo(zw.y), bfhi(zw.y)};
#pragma unroll
                for (int i = 0; i < 4; ++i) ov[i] *= z[i] * __builtin_amdgcn_rcpf(1.0f + __expf(-z[i])); }
            v2u ow; ow.x = pk2(ov[0], ov[1]); ow.y = pk2(ov[2], ov[3]);
            *(v2u*)(Ob + row * PP + d) = ow;
        }
}

template <int DQK, int MODE>
__device__ __forceinline__ void attn_unit_pipe(LAS unsigned char* lds, const bf16* Qb, int qpitch, const bf16* Kb, int kpitch, const bf16* VTb, int skv,
                                               const unsigned* maskb, bf16* Ob, int q0) {
    constexpr int DV = 64, KP = DQK + 8, VP = 72, BUFE = 64 * KP + DV * VP;
    constexpr int CPR = DQK / 8, NCK = 64 * CPR, NCV = DV * 8, RK = (NCK + 511) / 512, RV = (NCV + 511) / 512, NKS = DQK / 16, NMT = DV / 32;
    static_assert(NCV == 512 && (NCK == 512 || NCK == 768), "staging map");
    int tid_ = threadIdx.x; asm volatile("" : "+v"(tid_));
    const int tid = tid_, lane = tid & 63, w = __builtin_amdgcn_readfirstlane(tid >> 6), r = lane & 31, hh = lane >> 5;
    const int NT = (q0 + 256) / 64;
    const int qlo = q0 + 32 * w;
    const int NTw = ((qlo + 31) >> 6) + 1;
    int krow[RK], kcc[RK];
#pragma unroll
    for (int i = 0; i < RK; ++i) { int c = tid + 512 * i; if (c >= NCK) c -= 256; krow[i] = c / CPR; kcc[i] = c % CPR; }
    const int vd = tid >> 3, vcc = tid & 7;
    bf16x8 qf[NKS];
    { const bf16* qrow = Qb + (size_t)(qlo + r) * qpitch + 8 * hh;
#pragma unroll
      for (int ks = 0; ks < NKS; ++ks) qf[ks] = *(const bf16x8*)(qrow + 16 * ks); }
    f32x16 o[NMT];
#pragma unroll
    for (int mt = 0; mt < NMT; ++mt)
#pragma unroll
        for (int i = 0; i < 16; ++i) o[mt][i] = 0.f;
    float m_run = NEGF, l_run = 0.f, alpha = 1.f;
    v4u kreg[2][RK], vreg[2][RV]; v2u mset[2];
    const unsigned* mrowp = MODE == 2 ? maskb + (size_t)(qlo + r) * 64 : nullptr;
#define PL_LOAD(S_, tile_) do { const int tl_ = (tile_) < NT ? (tile_) : NT - 1; \
        if (MODE == 2) { const int mt_ = (tile_) >= 2 ? ((tile_) - 2 < 32 ? (tile_) - 2 : 31) : 0; mset[S_] = *(const v2u*)(mrowp + 2 * mt_); }     \
        _Pragma("unroll") for (int i_ = 0; i_ < RK; ++i_) kreg[S_][i_] = *(const v4u*)(Kb + (size_t)(64 * tl_ + krow[i_]) * kpitch + 8 * kcc[i_]); \
        vreg[S_][0] = *(const v4u*)(VTb + (size_t)vd * skv + 64 * tl_ + 8 * vcc); } while (0)
#define PL_STAGE(S_, buf_) do { LAS bf16* Kd_ = (LAS bf16*)lds + (buf_) * BUFE; LAS bf16* Vd_ = Kd_ + 64 * KP; \
        _Pragma("unroll") for (int i_ = 0; i_ < RK; ++i_) *(LAS v4u*)(Kd_ + krow[i_] * KP + 8 * kcc[i_]) = kreg[S_][i_]; \
        *(LAS v4u*)(Vd_ + vd * VP + 8 * vcc) = vreg[S_][0]; } while (0)
#define PL_QK(t_, D0_, D1_) do { const LAS bf16* Kc_ = (const LAS bf16*)lds + ((t_) & 3) * BUFE; \
        _Pragma("unroll") for (int i_ = 0; i_ < 16; ++i_) { D0_[i_] = 0.f; D1_[i_] = 0.f; } \
        _Pragma("unroll") for (int ks_ = 0; ks_ < NKS; ++ks_) { \
            const bf16x8 a0_ = *(const LAS bf16x8*)(Kc_ + r * KP + 16 * ks_ + 8 * hh); const bf16x8 a1_ = *(const LAS bf16x8*)(Kc_ + (32 + r) * KP + 16 * ks_ + 8 * hh); \
            D0_ = __builtin_amdgcn_mfma_f32_32x32x16_bf16(a0_, qf[ks_], D0_, 0, 0, 0); D1_ = __builtin_amdgcn_mfma_f32_32x32x16_bf16(a1_, qf[ks_], D1_, 0, 0, 0); } } while (0)
#define PL_PV(t_) do { const LAS bf16* Vc_ = (const LAS bf16*)lds + ((t_) & 3) * BUFE + 64 * KP; \
        _Pragma("unroll") for (int mt_ = 0; mt_ < NMT; ++mt_) _Pragma("unroll") for (int i_ = 0; i_ < 16; ++i_) o[mt_][i_] *= alpha; \
        _Pragma("unroll") for (int mt_ = 0; mt_ < NMT; ++mt_) _Pragma("unroll") for (int p_ = 0; p_ < 2; ++p_) _Pragma("unroll") for (int s_ = 0; s_ < 2; ++s_) { \
            const LAS bf16* vp_ = Vc_ + (32 * mt_ + r) * VP + 32 * p_ + 16 * s_ + 4 * hh; \
            const s16x4 lo_ = *(const LAS s16x4*)(vp_), hi_ = *(const LAS s16x4*)(vp_ + 8); \
            const bf16x8 a_ = (bf16x8){lo_[0], lo_[1], lo_[2], lo_[3], hi_[0], hi_[1], hi_[2], hi_[3]}; \
            o[mt_] = __builtin_amdgcn_mfma_f32_32x32x16_bf16(a_, __builtin_bit_cast(bf16x8, pf[p_][s_]), o[mt_], 0, 0, 0); } } while (0)
#define PL_SOFTMAX(t_, C0_, C1_, MK_, CAUSAL_) do { \
        if (MODE == 2) { const unsigned w0_ = (MK_).x >> (4 * hh), w1_ = (MK_).y >> (4 * hh); \
            _Pragma("unroll") for (int i_ = 0; i_ < 16; ++i_) { const int bit_ = (i_ & 3) + 8 * (i_ >> 2); if (!((w0_ >> bit_) & 1u)) C0_[i_] = NEGF; if (!((w1_ >> bit_) & 1u)) C1_[i_] = NEGF; } } \
        if (CAUSAL_) { const int qg_ = qlo + r; \
            _Pragma("unroll") for (int i_ = 0; i_ < 16; ++i_) { const int key_ = 64 * (t_) + crow(i_, hh); if (key_ > qg_) C0_[i_] = NEGF; if (key_ + 32 > qg_) C1_[i_] = NEGF; } } \
        float mx_ = C0_[0]; \
        _Pragma("unroll") for (int i_ = 1; i_ < 16; ++i_) mx_ = __builtin_fmaxf(mx_, C0_[i_]); \
        _Pragma("unroll") for (int i_ = 0; i_ < 16; ++i_) mx_ = __builtin_fmaxf(mx_, C1_[i_]); \
        mx_ = half_max(mx_); \
        const float mn_ = __builtin_fmaxf(m_run, mx_); alpha = __builtin_amdgcn_exp2f(m_run - mn_); m_run = mn_; \
        float ls_ = 0.f; \
        _Pragma("unroll") for (int i_ = 0; i_ < 16; ++i_) { C0_[i_] = __builtin_amdgcn_exp2f(C0_[i_] - mn_); C1_[i_] = __builtin_amdgcn_exp2f(C1_[i_] - mn_); ls_ += C0_[i_] + C1_[i_]; } \
        l_run = l_run * alpha + ls_; \
        _Pragma("unroll") for (int s_ = 0; s_ < 2; ++s_) { \
            pf[0][s_] = (v4u){pk2(C0_[8 * s_], C0_[8 * s_ + 1]), pk2(C0_[8 * s_ + 2], C0_[8 * s_ + 3]), pk2(C0_[8 * s_ + 4], C0_[8 * s_ + 5]), pk2(C0_[8 * s_ + 6], C0_[8 * s_ + 7])}; \
            pf[1][s_] = (v4u){pk2(C1_[8 * s_], C1_[8 * s_ + 1]), pk2(C1_[8 * s_ + 2], C1_[8 * s_ + 3]), pk2(C1_[8 * s_ + 4], C1_[8 * s_ + 5]), pk2(C1_[8 * s_ + 6], C1_[8 * s_ + 7])}; } } while (0)
#define PL_IO(t_, S_) do { PL_STAGE(S_, ((t_) + 2) & 3); PL_LOAD(S_, (t_) + 4); } while (0)
#define PL_STEADY(t_, S_) do { const v2u mk_ = mset[S_]; PL_IO(t_, S_); if (MODE == 2) { asm volatile("" :: "v"(mk_.x), "v"(mk_.y)); } \
        PL_QK((t_) + 1, n0, n1); PL_PV((t_) - 1); PL_SOFTMAX(t_, c0, c1, mk_, false); c0 = n0; c1 = n1; __syncthreads(); } while (0)
#define PL_TAIL(t_, S_) do { const v2u mk_ = mset[S_]; PL_IO(t_, S_); if ((t_) >= 1) PL_PV((t_) - 1); PL_SOFTMAX(t_, c0, c1, mk_, MODE == 1); PL_PV(t_); __syncthreads(); } while (0)
    f32x16 c0, c1, n0, n1; v4u pf[2][2];
    PL_LOAD(0, 0); PL_LOAD(1, 1);
    PL_STAGE(0, 0); PL_STAGE(1, 1);
    PL_LOAD(0, 2); PL_LOAD(1, 3);
    __syncthreads();
    PL_QK(0, c0, c1);
    int t = 0;
    if (NTw >= 2) {
        { const v2u mk_ = mset[0]; PL_IO(0, 0); PL_QK(1, n0, n1); PL_SOFTMAX(0, c0, c1, mk_, false); c0 = n0; c1 = n1; __syncthreads(); }
        for (t = 1; t + 1 < NTw; ) {
            PL_STEADY(t, 1); ++t;
            if (t + 1 < NTw) { PL_STEADY(t, 0); ++t; }
        }
    }
    if (t & 1) PL_TAIL(t, 1); else PL_TAIL(t, 0);
    for (++t; t < NT; ++t) { if (t & 1) PL_IO(t, 1); else PL_IO(t, 0); __syncthreads(); }
#undef PL_LOAD
#undef PL_STAGE
#undef PL_QK
#undef PL_PV
#undef PL_SOFTMAX
#undef PL_IO
#undef PL_STEADY
#undef PL_TAIL
    const float l_tot = half_sum(l_run);
    const float inv = 1.0f / l_tot;
    const size_t row = (size_t)(qlo + r);
#pragma unroll
    for (int mt = 0; mt < NMT; ++mt)
#pragma unroll
        for (int g4 = 0; g4 < 4; ++g4) {
            const int d = 32 * mt + 8 * g4 + 4 * hh;
            v2u ow; ow.x = pk2(o[mt][4 * g4] * inv, o[mt][4 * g4 + 1] * inv); ow.y = pk2(o[mt][4 * g4 + 2] * inv, o[mt][4 * g4 + 3] * inv);
            *(v2u*)(Ob + row * PP + d) = ow;
        }
}

__device__ __forceinline__ bf16* gate_row(bf16* G0, bf16* G1, size_t row) { return row < 8192 ? G0 + row * 3072 : G1 + (row - 8192) * 3072; }
struct EpiZG {
    static constexpr bool PERM = true, AFTER_DRAIN = false;
    bf16* P; bf16* G0; bf16* G1;
    __device__ __forceinline__ void operator()(const pg8::f32x4 (&acc)[2][2][4][2], const pg8::Unit& u, int wr, int wc, int fr, int fq) const {
        const int row0 = u.pm * 256 + wr * 64 + fr, cl = wc * 32 + 8 * fq;
        const bool isz = u.pn < 4;
        const int ycol = (u.pn < 2 ? C_YA : C_YB) + (u.pn & 1) * 256, gcol = (u.pn - 4) * 256;
#pragma unroll
        for (int ai = 0; ai < 2; ++ai)
#pragma unroll
            for (int m = 0; m < 4; ++m) { const size_t row = (size_t)(row0 + ai * 128 + m * 16);
#pragma unroll
                for (int bj = 0; bj < 2; ++bj) {
                    const pg8::f32x4 v0 = acc[ai][bj][m][0], v1 = acc[ai][bj][m][1];
                    float rr[8] = {v0[0], v0[1], v0[2], v0[3], v1[0], v1[1], v1[2], v1[3]};
                    if (isz) { bf16* dst = P + row * PP + ycol + cl + bj * 128; const v4u old = *(const v4u*)dst; float yv[8]; UNPACK8(old, yv);
#pragma unroll
                        for (int e = 0; e < 8; ++e) rr[e] = yv[e] * (rr[e] * __builtin_amdgcn_rcpf(1.0f + __expf(-rr[e])));
                        *(v4u*)dst = PACK8(rr); }
                    else { bf16* dst = gate_row(G0, G1, row) + gcol + cl + bj * 128;
#pragma unroll
                        for (int e = 0; e < 8; ++e) rr[e] = __builtin_amdgcn_rcpf(1.0f + __expf(-rr[e]));
                        *(v4u*)dst = PACK8(rr); } } }
    }
};
struct EpiMerge {
    static constexpr bool PERM = true, AFTER_DRAIN = false;
    bf16* Mg; bf16* G0; bf16* G1; int nbr;
    __device__ __forceinline__ void operator()(const pg8::f32x4 (&acc)[2][2][4][2], const pg8::Unit& u, int wr, int wc, int fr, int fq) const {
        const int row0 = u.pm * 256 + wr * 64 + fr, col0 = u.pn * 256 + wc * 32 + 8 * fq;
#pragma unroll
        for (int ai = 0; ai < 2; ++ai)
#pragma unroll
            for (int m = 0; m < 4; ++m) { const size_t row = (size_t)(row0 + ai * 128 + m * 16);
#pragma unroll
                for (int bj = 0; bj < 2; ++bj) { const int col = col0 + bj * 128;
                    const v4u gwd = *(const v4u*)(gate_row(G0, G1, row) + nbr * 1024 + col);
                    float gl[8]; UNPACK8(gwd, gl);
                    const pg8::f32x4 v0 = acc[ai][bj][m][0], v1 = acc[ai][bj][m][1];
                    float rr[8] = {v0[0], v0[1], v0[2], v0[3], v1[0], v1[1], v1[2], v1[3]};
#pragma unroll
                    for (int e = 0; e < 8; ++e) rr[e] *= gl[e];
                    bf16* dst = Mg + row * 1024 + col;
                    if (nbr > 0) { const v4u old = *(const v4u*)dst; float ol[8]; UNPACK8(old, ol);
#pragma unroll
                        for (int e = 0; e < 8; ++e) rr[e] += ol[e]; }
                    *(v4u*)dst = PACK8(rr); } }
    }
};
struct EpiOut {
    static constexpr bool PERM = true, AFTER_DRAIN = false;
    const float* X; float* Out;
    __device__ __forceinline__ void operator()(const pg8::f32x4 (&acc)[2][2][4][2], const pg8::Unit& u, int wr, int wc, int fr, int fq) const {
        const int row0 = u.pm * 256 + wr * 64 + fr, col0 = u.pn * 256 + wc * 32 + 8 * fq;
#pragma unroll
        for (int ai = 0; ai < 2; ++ai)
#pragma unroll
            for (int m = 0; m < 4; ++m) { const size_t row = (size_t)(row0 + ai * 128 + m * 16);
#pragma unroll
                for (int bj = 0; bj < 2; ++bj) { const size_t p = row * 1024 + col0 + bj * 128;
                    const f32x4 x0 = *(const f32x4*)(X + p), x1 = *(const f32x4*)(X + p + 4);
                    const pg8::f32x4 a0 = acc[ai][bj][m][0], a1 = acc[ai][bj][m][1];
                    *(f32x4*)(Out + p) = (f32x4){x0[0] + a0[0], x0[1] + a0[1], x0[2] + a0[2], x0[3] + a0[3]};
                    *(f32x4*)(Out + p + 4) = (f32x4){x1[0] + a1[0], x1[1] + a1[1], x1[2] + a1[2], x1[3] + a1[3]}; } }
    }
};

#define XB_TMO      128
#define XB_XCNT(j)  (256  + 64 * (j))
#define XB_XSUB(j)  (1280 + 64 * (j))
#define XB_XGEN(j)  (2304 + 64 * (j))
#define XB_TOP      3328
#define XB_TOPGEN   3392
#define XCD_BAR_WORDS 3456
#define XB_SPIN_CAP (1u << 18)

__device__ __forceinline__ unsigned xb_ld(unsigned* p)              { return __hip_atomic_load(p, __ATOMIC_RELAXED, __HIP_MEMORY_SCOPE_AGENT); }
__device__ __forceinline__ unsigned xb_add(unsigned* p, unsigned v) { return __hip_atomic_fetch_add(p, v, __ATOMIC_RELAXED, __HIP_MEMORY_SCOPE_AGENT); }
__device__ __forceinline__ unsigned xb_xcc_id() { return (unsigned)__builtin_amdgcn_s_getreg((3 << 11) | 20) & 0xFu; }
#define XB_SPIN(cond, bar) do { unsigned _sp = 0; while (cond) { __builtin_amdgcn_s_sleep(1); \
    if ((++_sp & 255u) == 0u) { if (xb_ld(&(bar)[XB_TMO])) break; if (_sp > XB_SPIN_CAP) { atomicAdd(&(bar)[XB_TMO], 1u); break; } } } } while (0)

struct XcdBarrier {
    unsigned* bar; unsigned x;
    volatile LAS unsigned* st;
};

__device__ __forceinline__ XcdBarrier xcd_barrier_post(unsigned* bar, volatile LAS unsigned* st) {
    XcdBarrier b; b.bar = bar; b.x = xb_xcc_id(); b.st = st;
    if (threadIdx.x == 0) (void)xb_add(&bar[XB_XCNT(b.x)], 1u);
    return b;
}
__device__ __forceinline__ void xcd_barrier_complete(unsigned* bar, unsigned x, unsigned& nloc, unsigned& nx) {
    const unsigned G = gridDim.x * gridDim.y * gridDim.z;
    unsigned sum, cnt, mine, sp = 0u;
    for (;;) {
        sum = 0u; cnt = 0u; mine = 0u;
#pragma unroll
        for (unsigned j = 0; j < 16; ++j) { const unsigned c = xb_ld(&bar[XB_XCNT(j)]); sum += c; cnt += (c > 0u) ? 1u : 0u; mine = (j == x) ? c : mine; }
        if (sum == G) break;
        __builtin_amdgcn_s_sleep(1);
        if ((++sp & 255u) == 0u) { if (xb_ld(&bar[XB_TMO])) break; if (sp > XB_SPIN_CAP) { atomicAdd(&bar[XB_TMO], 1u); break; } }
    }
    nloc = mine > 0u ? mine : 1u; nx = cnt > 0u ? cnt : 1u;
}

__device__ __forceinline__ void xcd_barrier(const XcdBarrier& b) {
    asm volatile("s_waitcnt vmcnt(0)" ::: "memory");
    __syncthreads();
    if (threadIdx.x == 0) {
        unsigned* bar = b.bar;
        __builtin_amdgcn_s_waitcnt(0);
        unsigned nloc = b.st[0], nx = b.st[1];
        if (nloc == 0u) { xcd_barrier_complete(bar, b.x, nloc, nx); b.st[0] = nloc; b.st[1] = nx; }
        const unsigned old = xb_add(&bar[XB_XSUB(b.x)], 1u);
        const unsigned gen = old / nloc;
        if (old + 1u == (gen + 1u) * nloc) {
            __builtin_amdgcn_fence(__ATOMIC_RELEASE, "agent");
            asm volatile("s_waitcnt vmcnt(0)" ::: "memory");
            const unsigned og = xb_add(&bar[XB_TOP], 1u);
            const unsigned tg = og / nx;
            if (og + 1u == (tg + 1u) * nx) xb_add(&bar[XB_TOPGEN], 1u);
            else XB_SPIN(xb_ld(&bar[XB_TOPGEN]) == tg, bar);
            __builtin_amdgcn_fence(__ATOMIC_ACQUIRE, "agent");
            xb_add(&bar[XB_XGEN(b.x)], 1u);
            asm volatile("s_waitcnt vmcnt(0)" ::: "memory");
        } else {
            XB_SPIN(xb_ld(&bar[XB_XGEN(b.x)]) == gen, bar);
            __builtin_amdgcn_fence(__ATOMIC_ACQUIRE, "agent");
            asm volatile("s_waitcnt vmcnt(0)" ::: "memory");
        }
    }
    __syncthreads();
}

template <int DQK, int DV, int MODE>
__device__ __forceinline__ void att_call(bool strip, LAS unsigned char* lds, const bf16* Qb, int qpitch, const bf16* Kb, int kpitch, const bf16* VTb, int skv, const unsigned* maskb, const bf16* Zb, bf16* Ob, int q0) {
    if (ATT_STRIP != 0 && strip) attn_unit<DQK, DV, MODE, ATT_STRIP>(lds, Qb, qpitch, Kb, kpitch, VTb, skv, maskb, Zb, Ob, q0);
    else attn_unit<DQK, DV, MODE, 0>(lds, Qb, qpitch, Kb, kpitch, VTb, skv, maskb, Zb, Ob, q0);
}
struct Args { const float* in[19]; const int* pos; float* out; unsigned char* ws; };
typedef const __attribute__((address_space(4))) Args* kargs_t;
#define PHASE_BEGIN \
    kargs_t ap_ = (kargs_t)__builtin_amdgcn_kernarg_segment_ptr(); asm volatile("" : "+s"(ap_)); \
    int tid = threadIdx.x; asm volatile("" : "+v"(tid)); \
    const int lane = tid & 63, wave = __builtin_amdgcn_readfirstlane(tid >> 6), G = gridDim.x, NGW = G * 8, gw = blockIdx.x * 8 + wave; \
    unsigned char* const ws = ap_->ws; unsigned char* const dob = (unsigned char*)ap_->out; const int* const pos = ap_->pos; float* const outp = ap_->out; unsigned* const ctl = (unsigned*)(ws + WS_CTL); \
    const float* const x = ap_->in[0]; const float* const mem = ap_->in[1]; \
    const float* const g_norm = ap_->in[3]; const float* const w_in = ap_->in[4]; const float* const g_qn_a = ap_->in[5]; const float* const g_kn_a = ap_->in[6]; \
    const float* const g_cq = ap_->in[7]; const float* const g_ckv = ap_->in[8]; const float* const w_uq = ap_->in[9]; const float* const w_ukv = ap_->in[10]; \
    const float* const g_qn_b = ap_->in[11]; const float* const g_kn_b = ap_->in[12]; const float* const g_mem = ap_->in[13]; const float* const w_mem_kv = ap_->in[14]; \
    const float* const g_qn_m = ap_->in[15]; const float* const g_kn_m = ap_->in[16]; const float* const w_branch = ap_->in[17]; const float* const w_out = ap_->in[18]; \
    bf16* const WinT = (bf16*)(ws + WS_WIN); bf16* const WuqT = (bf16*)(ws + WS_WUQ); bf16* const WukvT = (bf16*)(ws + WS_WUKV); bf16* const WmemT = (bf16*)(ws + WS_WMEM); \
    bf16* const WbrT = (bf16*)(ws + WS_WBR); bf16* const WoutT = (bf16*)(ws + WS_WOUT); \
    float* const ropeA = (float*)(ws + WS_ROPEA); float* const ropeB = (float*)(ws + WS_ROPEB); \
    bf16* const MN = (bf16*)(ws + WS_MN); bf16* const KVM = (bf16*)(ws + WS_KVM); bf16* const VTM = (bf16*)(ws + WS_VTM); \
    float* const WI = (float*)(ws + WS_WI); unsigned* const MASK = (unsigned*)(ws + WS_MASK); \
    bf16* const VTA = (bf16*)(dob + DO_VTA); bf16* const VTB = (bf16*)(dob + DO_VTB); bf16* const KB = (bf16*)(dob + DO_KB); \
    bf16* const Hh = (bf16*)(ws + WS_H); bf16* const MG = (bf16*)(ws + WS_H); bf16* const QB = (bf16*)(ws + WS_QB); \
    bf16* const KVB = (bf16*)(ws + WS_KVB); bf16* const GT0 = (bf16*)(dob + DO_G0); bf16* const GT1 = (bf16*)(ws + WS_G1); bf16* const P = (bf16*)(ws + WS_P); \
    (void)lane; (void)NGW; (void)gw; (void)ctl; \
    (void)pos; (void)outp; (void)x; (void)mem; (void)g_norm; (void)w_in; (void)g_qn_a; (void)g_kn_a; (void)g_cq; (void)g_ckv; (void)w_uq; (void)w_ukv; (void)g_qn_b; (void)g_kn_b; (void)g_mem; (void)w_mem_kv; \
    (void)g_qn_m; (void)g_kn_m; (void)w_branch; (void)w_out; (void)WinT; (void)WuqT; (void)WukvT; (void)WmemT; (void)WbrT; (void)WoutT; (void)ropeA; (void)ropeB; (void)MN; (void)KVM; (void)VTM; (void)WI; (void)MASK; \
    (void)VTA; (void)VTB; (void)Hh; (void)KB; (void)QB; (void)KVB; (void)MG; (void)GT0; (void)GT1; (void)P
#define GRID_BARRIER() do { kargs_t bp_ = (kargs_t)__builtin_amdgcn_kernarg_segment_ptr(); asm volatile("" : "+s"(bp_)); \
    XcdBarrier b_; b_.bar = (unsigned*)(bp_->ws + WS_CTL) + 4096; b_.x = xb_xcc_id(); b_.st = (volatile LAS unsigned*)(lds + LDS_BYTES - 32); xcd_barrier(b_); } while (0)

__global__ void __launch_bounds__(512, 2) fwd_kernel(Args a) {
    extern __shared__ __attribute__((aligned(16))) unsigned char lds_raw[];
    LAS unsigned char* const lds = (LAS unsigned char*)lds_raw;
    volatile LAS int* const slot = (volatile LAS int*)(lds + LDS_SLOT);
    if (threadIdx.x < 16) ((LAS unsigned*)(lds + LDS_BYTES - 64))[threadIdx.x] = 0u;
    __syncthreads();
    (void)xcd_barrier_post((unsigned*)(a.ws + WS_CTL) + 4096, (volatile LAS unsigned*)(lds + LDS_BYTES - 32));

    for (int rep = 0; rep < REP_P0; ++rep) { PHASE_BEGIN;
        LAS float* scr = (LAS float*)(lds + wave * 16384);
        constexpr int I_IN = 16 * (NP / 32), I_UQ = 6 * 24, I_UKV = 4 * 32, I_MEM = 16 * 32, I_BR = 8 * 32, I_OUT = 16 * 32;
        constexpr int NITEMS = I_IN + I_UQ + I_UKV + I_MEM + 3 * I_BR + I_OUT;
        for (int it = gw; it < NITEMS; it += NGW) {
            int r = it;
            if (r < I_IN) { transpose_item<true>(w_in, 1024, DIN, NP, WinT, scr, r, lane); continue; } r -= I_IN;
            if (r < I_UQ) { transpose_item<false>(w_uq, 384, 768, 768, WuqT, scr, r, lane); continue; } r -= I_UQ;
            if (r < I_UKV) { transpose_item<false>(w_ukv, 256, 1024, 1024, WukvT, scr, r, lane); continue; } r -= I_UKV;
            if (r < I_MEM) { transpose_item<false>(w_mem_kv, 1024, 1024, 1024, WmemT, scr, r, lane); continue; } r -= I_MEM;
            if (r < 3 * I_BR) { const int nb = r / I_BR; transpose_item<false>(w_branch + (size_t)nb * 512 * 1024, 512, 1024, 1024, WbrT + (size_t)nb * 1024 * 512, scr, r % I_BR, lane); continue; } r -= 3 * I_BR;
            transpose_item<false>(w_out, 1024, 1024, 1024, WoutT, scr, r, lane);
        }
        for (int idx = blockIdx.x * 512 + tid; idx < TT * 24; idx += G * 512) {
            const int t = idx / 24, i = idx % 24; const float pf = (float)pos[t];
            if (i < 8) { const float ang = pf * INVA[i]; ropeA[t * 16 + i] = cosf(ang); ropeA[t * 16 + 8 + i] = sinf(ang); }
            else { const int j = i - 8; const float ang = pf * INVB[j]; ropeB[t * 32 + j] = cosf(ang); ropeB[t * 32 + 16 + j] = sinf(ang); }
        }
        for (int m = gw; m < NB * MEML; m += NGW) rms_row_1024(mem + (size_t)m * DM, g_mem, MN + (size_t)m * DM, lane);
        for (int rp = 0; rp < REP_PH; ++rp)
        for (int m = gw; m < TT; m += NGW) rms_row_1024(x + (size_t)m * DM, g_norm, Hh + (size_t)m * DM, lane);
    }
    GRID_BARRIER();
    for (int es = 0; es < EXTRA_SYNCS; ++es) GRID_BARRIER();

    for (int rep = 0; rep < REP_G1; ++rep) { PHASE_BEGIN;
        pg8::Gemm g{Hh, WinT, TT, PP, 1024, 1024}; pg8::StaticOrder S; S.init(TT, PP, G, (int)blockIdx.x);
        pg8::EpiBf16<0> E{P, PP, nullptr, 0, 0, 1.f};
        pg8::gemm_phase<pg8::EpiBf16<0>, pg8::StaticOrder, true, true>(lds, g, S, E);
    }
    { PHASE_BEGIN;
        pg8::Gemm g{MN, WmemT, NB * MEML, 1024, 1024, 1024}; pg8::StaticOrder S; S.init(NB * MEML, 1024, G, (int)((blockIdx.x + 64) % G));
        pg8::EpiBf16<0> E{KVM, 1024, nullptr, 0, 0, 1.f};
        pg8::gemm_phase<pg8::EpiBf16<0>, pg8::StaticOrder, true, true>(lds, g, S, E);
    }
    GRID_BARRIER();
    { PHASE_BEGIN;
        float ga[8], gk[8], gq[8], gc[8], gm[8];
#pragma unroll
        for (int j = 0; j < 8; ++j) { ga[j] = g_qn_a[8 * (lane & 7) + j]; gk[j] = g_kn_a[8 * (lane & 7) + j]; gm[j] = g_qn_m[8 * (lane & 15) + j]; gq[j] = lane < 48 ? g_cq[8 * lane + j] : 0.f; gc[j] = lane < 32 ? g_ckv[8 * lane + j] : 0.f; }
        for (int dp = 0; dp < DUMMY_POST1; ++dp)
            for (int m = gw; m < TT; m += NGW)
                post1_row(P + (size_t)m * PP, QB + (size_t)(m & 1023) * 4096, ropeA + (size_t)m * 16, ga, gk, gq, gc, gm, (float*)KVB + (size_t)m * 8, lane);
        for (int m = gw; m < TT; m += NGW)
            post1_row(P + (size_t)m * PP, P + (size_t)m * PP, ropeA + (size_t)m * 16, ga, gk, gq, gc, gm, WI + (size_t)m * 8, lane);
        for (int rt = 0; rt < REP_TR; ++rt)
        transpose_v(P, PP, C_VA, 64, 8, 64, SEQ, NB, VTA, gw, NGW, lane);
        for (int m = gw; m < NB * MEML; m += NGW) km_row(KVM + (size_t)m * 1024, g_kn_m, lane);
        for (int rt = 0; rt < REP_TR; ++rt)
        transpose_v(KVM, 1024, 512, 128, 4, 128, MEML, NB, VTM, gw, NGW, lane);
    }
    GRID_BARRIER();
    for (int rep = 0; rep < REP_G2; ++rep) { PHASE_BEGIN;
        pg8::Gemm g{P + C_CQ, WuqT, TT, 768, 384, PP}; pg8::StaticOrder S; S.init(TT, 768, G, (int)blockIdx.x);
        pg8::EpiBf16<0> E{QB, 768, nullptr, 0, 0, 1.f};
        pg8::gemm_phase<pg8::EpiBf16<0>, pg8::StaticOrder, true, true>(lds, g, S, E);
    }
    for (int rep = 0; rep < REP_G2; ++rep) { PHASE_BEGIN;
        pg8::Gemm g{P + C_CKV, WukvT, TT, 1024, 256, PP}; pg8::StaticOrder S; S.init(TT, 1024, G, (int)((blockIdx.x + 192) % G));
        pg8::EpiBf16<0> E{KVB, 1024, nullptr, 0, 0, 1.f};
        pg8::gemm_phase<pg8::EpiBf16<0>, pg8::StaticOrder, true, true>(lds, g, S, E);
    }
    for (int rep = 0; rep < REP_IDX; ++rep) { if (rep > 0) GRID_BARRIER();
        PHASE_BEGIN;
        unsigned* const q_idx = ctl + 64 * (0 + 4 * rep);
        for (;;) {
            const int u = next_unit(q_idx, slot);
            if (u >= NB * 128) break;
            const int tb = 127 - (u >> 3), bb = u & 7;
            indexer_unit((LAS float*)lds, P, WI, MASK, bb, tb);
        }
    }
    GRID_BARRIER();
    { PHASE_BEGIN;
        LAS float* scr = (LAS float*)(lds + wave * 8192);
        float gqv[12], gkv[12];
#pragma unroll
        for (int e = 0; e < 12; ++e) { gqv[e] = g_qn_b[12 * (lane & 7) + e]; gkv[e] = g_kn_b[12 * (lane & 7) + e]; }
        for (int dp = 0; dp < DUMMY_POST2; ++dp)
            for (int m = gw; m < TT; m += NGW)
                post2_row(QB + (size_t)m * 768, (bf16*)MASK + (size_t)(m & 1023) * 768, KVB + (size_t)m * 1024, P + (size_t)m * PP, (bf16*)MASK + (size_t)(1024 + (m & 1023)) * 768, ropeB + (size_t)m * 32, gqv, gkv, scr, lane);
        for (int m = gw; m < TT; m += NGW)
            post2_row(QB + (size_t)m * 768, QB + (size_t)m * 768, KVB + (size_t)m * 1024, P + (size_t)m * PP, KB + (size_t)m * 768, ropeB + (size_t)m * 32, gqv, gkv, scr, lane);
        for (int rt = 0; rt < REP_TR; ++rt)
        transpose_v(KVB, 1024, 64, 128, 8, 64, SEQ, NB, VTB, gw, NGW, lane);
    }
    GRID_BARRIER();
    for (int rep = 0; rep < REP_ATT; ++rep) { if (rep > 0) GRID_BARRIER();
        PHASE_BEGIN;
        unsigned* const q_att = ctl + 64 * (1 + 4 * rep);
        for (;;) {
            const int u = next_unit(q_att, slot);
            if (u >= 1280) break;
            if (u < 1024) {
                const int qb = 7 - (u >> 7), wi = u & 127, bh = wi & 63, bb = bh >> 3, h = bh & 7;
                const size_t r0 = (size_t)bb * SEQ;
                if (wi < 64) attn_unit_pipe<96, 1>(lds, QB + r0 * 768 + h * 96, 768, KB + r0 * 768 + h * 96, 768, VTB + (size_t)((bb * 8 + h) * 64) * SEQ, SEQ, nullptr,
                                                   P + r0 * PP + C_YB + h * 64, qb * 256);
                else attn_unit_pipe<64, 2>(lds, P + r0 * PP + C_QA + h * 64, PP, P + r0 * PP + C_KA + h * 64, PP, VTA + (size_t)((bb * 8 + h) * 64) * SEQ, SEQ, MASK + r0 * 64,
                                           P + r0 * PP + C_YA + h * 64, qb * 256);
            } else {
                const int v = u - 1024, qb = v & 7, bh = v >> 3, bb = bh >> 2, h = bh & 3;
                const size_t r0 = (size_t)bb * SEQ;
                att_call<128, 128, 0>(rep == 0 && REP_ATT > 1, lds, P + r0 * PP + C_QM + h * 128, PP, KVM + (size_t)bb * MEML * 1024 + h * 128, 1024, VTM + (size_t)((bb * 4 + h) * 128) * MEML, MEML, nullptr,
                                       P + r0 * PP + C_ZM + h * 128, P + r0 * PP + C_YM + h * 128, qb * 256);
            }
        }
    }
    GRID_BARRIER();
    for (int rep = 0; rep < 1; ++rep) { PHASE_BEGIN;
        pg8::Gemm g{Hh, WinT + (size_t)PP * 1024, TT, NZG, 1024, 1024}; pg8::StaticOrder S; S.init(TT, NZG, G, (int)blockIdx.x);
        EpiZG E{P, GT0, GT1};
        pg8::gemm_phase<EpiZG, pg8::StaticOrder, true, true>(lds, g, S, E);
    }
    GRID_BARRIER();
    for (int nbr = 0; nbr < 3 * REP_G4; ++nbr) { const int nb = nbr % 3; PHASE_BEGIN;
        pg8::Gemm g{P + (nb == 0 ? C_YA : (nb == 1 ? C_YB : C_YM)), WbrT + (size_t)nb * 1024 * 512, TT, 1024, 512, PP}; pg8::StaticOrder S; S.init(TT, 1024, G, (int)blockIdx.x);
        EpiMerge E{MG, GT0, GT1, nb};
        pg8::gemm_phase<EpiMerge, pg8::StaticOrder, true, true>(lds, g, S, E);
    }
    GRID_BARRIER();
    for (int rep = 0; rep < REP_G5; ++rep) { PHASE_BEGIN;
        pg8::Gemm g{MG, WoutT, TT, 1024, 1024, 1024}; pg8::StaticOrder S; S.init(TT, 1024, G, (int)blockIdx.x);
        EpiOut E{x, outp};
        pg8::gemm_phase<EpiOut, pg8::StaticOrder, true, true>(lds, g, S, E);
    }
}

extern "C" void kernel_launch(void* const* d_in, const int* in_sizes, int n_in, void* d_out, int out_size, void* d_ws, size_t ws_size, hipStream_t stream) {
    static int grid = 0;
    if (grid == 0) {
        if (n_in != 19 || out_size != TT * DM || ws_size < WS_END) { fprintf(stderr, "kernel_launch: unexpected problem (n_in %d, out %d, ws %zu); nothing launched\n", n_in, out_size, ws_size); grid = -1; return; }
        int dev = 0, cus = 0, per_cu = 0;
        if (hipGetDevice(&dev) != hipSuccess || hipDeviceGetAttribute(&cus, hipDeviceAttributeMultiprocessorCount, dev) != hipSuccess) { grid = -1; return; }
        if (hipFuncSetAttribute((const void*)fwd_kernel, hipFuncAttributeMaxDynamicSharedMemorySize, LDS_BYTES) != hipSuccess) { fprintf(stderr, "kernel_launch: hipFuncSetAttribute failed\n"); grid = -1; return; }
        if (hipOccupancyMaxActiveBlocksPerMultiprocessor(&per_cu, (const void*)fwd_kernel, 512, LDS_BYTES) != hipSuccess || per_cu < 1) { fprintf(stderr, "kernel_launch: occupancy query reports %d blocks per CU\n", per_cu); (void)hipGetLastError(); grid = -1; return; }
        grid = cus;
    }
    if (grid < 0) return;
    (void)hipMemsetAsync((char*)d_ws + WS_CTL, 0, 65536, stream);
    Args a{};
    for (int i = 0; i < 19; ++i) a.in[i] = (const float*)d_in[i];
    a.pos = (const int*)d_in[2]; a.out = (float*)d_out; a.ws = (unsigned char*)d_ws;
    hipLaunchKernelGGL(fwd_kernel, dim3(grid), dim3(512), LDS_BYTES, stream, a);
    const hipError_t e = hipPeekAtLastError();
    if (e != hipSuccess) fprintf(stderr, "kernel_launch: launch failed: %s (grid %d)\n", hipGetErrorString(e), grid);
}
```

```cpp
#include <hip/hip_runtime.h>
#include <cstdio>
#include <cstdint>
namespace pg8 {
#define PG8_LAS __attribute__((address_space(3)))
typedef unsigned short bf16_t;
typedef short bf16x8 __attribute__((ext_vector_type(8)));
typedef float f32x4 __attribute__((ext_vector_type(4)));
typedef unsigned u32x4 __attribute__((ext_vector_type(4)));
constexpr int BM = 256, BK = 64, HALF = 128, HTB = HALF * BK * 2  , STAGE_BYTES = 8 * HTB, NXCD = 8, WGM = 8;

__host__ __device__ __forceinline__ int lds_byte(int r, int c) { const int st = (r >> 4) * 2 + (c >> 5), rr = r & 15, cc = c & 31, ob = rr * 64 + cc * 2; return st * 1024 + (ob ^ (((ob >> 9) & 1) << 5)); }
__host__ __device__ __forceinline__ void stage_rc(int b, int& R, int& C) { const int st = b / 1024, sb = b % 1024, swz = sb ^ (((sb >> 9) & 1) << 5); R = (st >> 1) * 16 + swz / 64; C = (st & 1) * 32 + (swz % 64) / 2; }
__host__ __device__ __forceinline__ int perm32(int rho) { const int n = rho >> 4, i = rho & 15; return 8 * (i >> 2) + 4 * n + (i & 3); }

struct Unit { int pm, pn; };
struct Gemm { const bf16_t* A; const bf16_t* Bt; int M, N, K, lda; };

struct StaticOrder {
    int nM, nN, nwg, G, c;
    __host__ __device__ void init(int M, int N, int G_, int c_) { nM = M / BM; nN = N / BM; nwg = nM * nN; G = G_; c = c_; }
    __host__ __device__ bool next(int i, Unit& u) const {
        const long L = (long)i * G + c; if (L >= nwg) return false;
        int wgid = (int)L; { const int q = nwg / NXCD, r = nwg % NXCD, xcd = wgid % NXCD, off = wgid / NXCD; wgid = (xcd < r ? xcd * (q + 1) : r * (q + 1) + (xcd - r) * q) + off; }
        const int nig = WGM * nN, gid = wgid / nig, fm = gid * WGM, gsz = (nM - fm) < WGM ? (nM - fm) : WGM;
        u.pm = fm + ((wgid % nig) % gsz); u.pn = (wgid % nig) / gsz; return true;
    }
    __device__ __forceinline__ void a_ready(const Unit&) const {}
    __device__ __forceinline__ void done(const Unit&) const {}
};

__device__ __forceinline__ unsigned cvt_pk_bf16(float lo, float hi) { unsigned r; asm volatile("v_cvt_pk_bf16_f32 %0, %1, %2" : "=v"(r) : "v"(lo), "v"(hi)); return r; }
typedef float f32x2 __attribute__((ext_vector_type(2)));
__device__ __forceinline__ f32x2 gelu_pk(f32x2 v) {
    const f32x2 av = __builtin_elementwise_abs(v), d = av * 0.2316418882f + 1.0f;
    f32x2 t; t.x = __builtin_amdgcn_rcpf(d.x); t.y = __builtin_amdgcn_rcpf(d.y);
    f32x2 q = t * 0.5307027145f + (-0.7265760135f); q = q * t + 0.7107068705f; q = q * t + (-0.142248368f); q = q * t + 0.127414796f; q = q * t;
    const f32x2 s = (v * v) * (-0.72134752044f);
    f32x2 e; e.x = __builtin_amdgcn_exp2f(s.x); e.y = __builtin_amdgcn_exp2f(s.y);
    const f32x2 m = v * (q * e), r = v - m;
    f32x2 o; o.x = v.x < 0.f ? m.x : r.x; o.y = v.y < 0.f ? m.y : r.y; return o;
}

template <int ACT  > struct EpiBf16 {
    static constexpr bool PERM = true, AFTER_DRAIN = false; static_assert(ACT == 0 || ACT == 1, "EpiBf16: ACT is 0 (none) or 1 (gelu_pk)");
    bf16_t* O; int ldc; const float* bias; int split_cols; size_t split_stride; float scale0;
    __device__ __forceinline__ void operator()(const f32x4 (&acc)[2][2][4][2], const Unit& u, int wr, int wc, int fr, int fq) const {
        const int row0 = u.pm * BM + wr * 64 + fr; int colt = u.pn * BM; bf16_t* base = O;
        float sc = 1.f; if (split_cols) { const int t = colt / split_cols; base += (size_t)t * split_stride; colt -= t * split_cols; if (t == 0) sc = scale0; }
        const int col0 = colt + wc * 32 + 8 * fq, bcol0 = u.pn * BM + wc * 32 + 8 * fq;
        f32x4 bv[2][2];
#pragma unroll
        for (int bj = 0; bj < 2; ++bj)
#pragma unroll
            for (int n = 0; n < 2; ++n) bv[bj][n] = bias ? *(const f32x4*)(bias + bcol0 + bj * HALF + 4 * n) : (f32x4){0.f, 0.f, 0.f, 0.f};
#pragma unroll
        for (int ai = 0; ai < 2; ++ai)
#pragma unroll
            for (int m = 0; m < 4; ++m) { bf16_t* rowp = base + (size_t)(row0 + ai * HALF + m * 16) * ldc + col0;
#pragma unroll
                for (int bj = 0; bj < 2; ++bj) { f32x4 v0 = acc[ai][bj][m][0] + bv[bj][0], v1 = acc[ai][bj][m][1] + bv[bj][1];
                    if (ACT == 1) { f32x2 a = gelu_pk((f32x2){v0[0], v0[1]}), b = gelu_pk((f32x2){v0[2], v0[3]}), c = gelu_pk((f32x2){v1[0], v1[1]}), d = gelu_pk((f32x2){v1[2], v1[3]});
                        v0 = (f32x4){a.x, a.y, b.x, b.y}; v1 = (f32x4){c.x, c.y, d.x, d.y}; }
                    v0 = v0 * sc; v1 = v1 * sc; u32x4 w; w.x = cvt_pk_bf16(v0[0], v0[1]); w.y = cvt_pk_bf16(v0[2], v0[3]); w.z = cvt_pk_bf16(v1[0], v1[1]); w.w = cvt_pk_bf16(v1[2], v1[3]);
                    *(u32x4*)(rowp + bj * HALF) = w; } }
    }
};
template <class Epi, class Sched, bool ALIGN_EPI = false, bool SP2 = false>
__device__ __forceinline__ void gemm_phase(PG8_LAS unsigned char* lds, const Gemm g, const Sched& S, const Epi& E) {
    int tid_ = threadIdx.x; asm volatile("" : "+v"(tid_));
    const int tid = tid_, wid = __builtin_amdgcn_readfirstlane(tid >> 6), lane = tid & 63, wr = wid >> 2, wc = wid & 3, fr = lane & 15, fq = lane >> 4;
    const int K = g.K, nt = K / BK;
    unsigned voffA[2], voffB[2];
#pragma unroll
    for (int i = 0; i < 2; ++i) { int R, C; stage_rc(tid * 16 + i * 8192, R, C); const int Rb = Epi::PERM ? ((R & ~31) + perm32(R & 31)) : R;
        voffA[i] = (unsigned)(R * g.lda + C) * 2u; voffB[i] = (unsigned)(Rb * K + C) * 2u; }
    const size_t kstep = (size_t)(BK * 2);
    const size_t hstepA = (size_t)HALF * g.lda * 2, hstepB = (size_t)HALF * K * 2;
    const size_t tstepA = 2 * hstepA, tstepB = 2 * hstepB;
    const unsigned ldsw = (unsigned)wid * 1024u;
    const int aoff = lds_byte(wr * 64 + fr, fq * 8), boff = lds_byte(wc * 32 + fr, fq * 8);
#define PG8_SA(b, h) (((b) * 2 + (h)) * HTB)
#define PG8_SB(b, h) ((4 + (b) * 2 + (h)) * HTB)
#define PG8_STAGE(bufoff, gbase, voff) do { _Pragma("unroll") for (int _i = 0; _i < 2; ++_i) \
        __builtin_amdgcn_global_load_lds((const unsigned*)((const char*)(gbase) + (voff)[_i]), (PG8_LAS unsigned*)(lds + (bufoff) + ldsw + _i * 8192), 16, 0, 0); } while (0)
#define PG8_LDA(dst, b, h) do { _Pragma("unroll") for (int m = 0; m < 4; ++m) _Pragma("unroll") for (int k = 0; k < 2; ++k) dst[m][k] = *(const PG8_LAS bf16x8*)(lds + PG8_SA(b, h) + aoff + m * 2048 + k * 1024); } while (0)
#define PG8_LDB(dst, b, h) do { _Pragma("unroll") for (int n = 0; n < 2; ++n) _Pragma("unroll") for (int k = 0; k < 2; ++k) dst[n][k] = *(const PG8_LAS bf16x8*)(lds + PG8_SB(b, h) + boff + n * 2048 + k * 1024); } while (0)
#define PG8_MMA(ai, bj, At, Bt) do { __builtin_amdgcn_s_setprio(1); _Pragma("unroll") for (int m = 0; m < 4; ++m) _Pragma("unroll") for (int n = 0; n < 2; ++n) _Pragma("unroll") for (int k = 0; k < 2; ++k) \
        acc[ai][bj][m][n] = __builtin_amdgcn_mfma_f32_16x16x32_bf16(Bt[n][k], At[m][k], acc[ai][bj][m][n], 0, 0, 0); __builtin_amdgcn_s_setprio(0); } while (0)
#define PG8_WAIT_V(n) asm volatile("s_waitcnt vmcnt(" #n ")" ::: "memory")
#define PG8_WAIT_L(n) asm volatile("s_waitcnt lgkmcnt(" #n ")" ::: "memory")
#define PG8_BAR __builtin_amdgcn_s_barrier()
#define PG8_SCHED __builtin_amdgcn_sched_barrier(0)
    Unit cur, nxt; int ui = 0;
    if (!S.next(0, cur)) return;
    f32x4 acc[2][2][4][2];
#pragma unroll
    for (int a = 0; a < 2; ++a)
#pragma unroll
        for (int b = 0; b < 2; ++b)
#pragma unroll
            for (int m = 0; m < 4; ++m)
#pragma unroll
                for (int n = 0; n < 2; ++n) acc[a][b][m][n] = (f32x4){0.f, 0.f, 0.f, 0.f};
    bf16x8 At[4][2], B0[2][2], B1[2][2];
    const char* cA = (const char*)g.A + (size_t)cur.pm * tstepA; const char* cB = (const char*)g.Bt + (size_t)cur.pn * tstepB;
    S.a_ready(cur);
    if constexpr (SP2) {
        PG8_STAGE(PG8_SB(0, 0), cB, voffB); PG8_STAGE(PG8_SB(0, 1), cB + hstepB, voffB); PG8_STAGE(PG8_SA(0, 0), cA, voffA); PG8_STAGE(PG8_SA(0, 1), cA + hstepA, voffA);
        if (wr == 1) PG8_BAR;
        PG8_WAIT_V(2); PG8_BAR;
        PG8_STAGE(PG8_SB(1, 0), cB + kstep, voffB); PG8_STAGE(PG8_SA(1, 0), cA + kstep, voffA); PG8_STAGE(PG8_SB(1, 1), cB + hstepB + kstep, voffB);
        PG8_WAIT_V(6); PG8_BAR;
    } else {
        PG8_STAGE(PG8_SB(0, 0), cB, voffB); PG8_STAGE(PG8_SA(0, 0), cA, voffA); PG8_STAGE(PG8_SB(0, 1), cB + hstepB, voffB); PG8_STAGE(PG8_SA(0, 1), cA + hstepA, voffA);
        if (wr == 1) PG8_BAR;
        PG8_WAIT_V(4); PG8_BAR;
        PG8_STAGE(PG8_SB(1, 0), cB + kstep, voffB); PG8_STAGE(PG8_SA(1, 0), cA + kstep, voffA); PG8_STAGE(PG8_SB(1, 1), cB + hstepB + kstep, voffB);
        PG8_WAIT_V(6); PG8_BAR;
    }
    for (;;) {
        const bool has_next = S.next(ui + 1, nxt);
        const char* nA = has_next ? (const char*)g.A + (size_t)nxt.pm * tstepA : cA; const char* nB = has_next ? (const char*)g.Bt + (size_t)nxt.pn * tstepB : cB;
        for (int t = 0; t < nt; t += 2) {
            const bool last = (t == nt - 2);
            const char* a1 = cA + (size_t)(t + 1) * kstep;
            const char* a2 = last ? nA : cA + (size_t)(t + 2) * kstep; const char* b2 = last ? nB : cB + (size_t)(t + 2) * kstep;
            const char* a3 = a2 + kstep; const char* b3 = b2 + kstep;
            if (last && has_next) S.a_ready(nxt);
            if constexpr (SP2) {
            PG8_LDB(B0, 0, 0); PG8_LDB(B1, 0, 1); PG8_SCHED; PG8_LDA(At, 0, 0); PG8_STAGE(PG8_SA(1, 1), a1 + hstepA, voffA);
            PG8_WAIT_V(8); PG8_WAIT_L(0); PG8_BAR; PG8_MMA(0, 0, At, B0); PG8_MMA(0, 1, At, B1); PG8_BAR; PG8_SCHED;
            PG8_LDA(At, 0, 1); PG8_STAGE(PG8_SB(0, 0), b2, voffB); PG8_STAGE(PG8_SB(0, 1), b2 + hstepB, voffB); PG8_STAGE(PG8_SA(0, 0), a2, voffA);
            PG8_WAIT_V(8); PG8_WAIT_L(0); PG8_BAR; PG8_MMA(1, 0, At, B0); PG8_MMA(1, 1, At, B1); PG8_BAR; PG8_SCHED;
            PG8_LDB(B0, 1, 0); PG8_LDB(B1, 1, 1); PG8_SCHED; PG8_LDA(At, 1, 0); PG8_STAGE(PG8_SA(0, 1), a2 + hstepA, voffA);
            PG8_WAIT_V(8); PG8_WAIT_L(0); PG8_BAR; PG8_MMA(0, 0, At, B0); PG8_MMA(0, 1, At, B1); PG8_BAR; PG8_SCHED;
            PG8_LDA(At, 1, 1); PG8_STAGE(PG8_SB(1, 0), b3, voffB); PG8_STAGE(PG8_SB(1, 1), b3 + hstepB, voffB); PG8_STAGE(PG8_SA(1, 0), a3, voffA);
            PG8_WAIT_V(8); PG8_WAIT_L(0); PG8_BAR; PG8_MMA(1, 0, At, B0); PG8_MMA(1, 1, At, B1); PG8_BAR; PG8_SCHED;
            } else {
            PG8_LDB(B0, 0, 0); PG8_SCHED; PG8_LDA(At, 0, 0); PG8_STAGE(PG8_SA(1, 1), a1 + hstepA, voffA);
            PG8_WAIT_L(8); PG8_BAR; PG8_WAIT_L(0); PG8_MMA(0, 0, At, B0); PG8_BAR; PG8_SCHED;
            PG8_LDB(B1, 0, 1); PG8_STAGE(PG8_SB(0, 0), b2, voffB);
            PG8_BAR; PG8_WAIT_L(0); PG8_MMA(0, 1, At, B1); PG8_BAR;
            PG8_LDA(At, 0, 1); PG8_STAGE(PG8_SA(0, 0), a2, voffA);
            PG8_BAR; PG8_WAIT_L(0); PG8_MMA(1, 0, At, B0); PG8_BAR; PG8_SCHED;
            PG8_STAGE(PG8_SB(0, 1), b2 + hstepB, voffB);
            PG8_WAIT_V(6); PG8_BAR; PG8_MMA(1, 1, At, B1); PG8_BAR;
            PG8_LDB(B0, 1, 0); PG8_SCHED; PG8_LDA(At, 1, 0); PG8_STAGE(PG8_SA(0, 1), a2 + hstepA, voffA);
            PG8_WAIT_L(8); PG8_BAR; PG8_WAIT_L(0); PG8_MMA(0, 0, At, B0); PG8_BAR; PG8_SCHED;
            PG8_LDB(B1, 1, 1); PG8_STAGE(PG8_SB(1, 0), b3, voffB);
            PG8_BAR; PG8_WAIT_L(0); PG8_MMA(0, 1, At, B1); PG8_BAR;
            PG8_LDA(At, 1, 1); PG8_STAGE(PG8_SA(1, 0), a3, voffA);
            PG8_BAR; PG8_WAIT_L(0); PG8_MMA(1, 0, At, B0); PG8_BAR; PG8_SCHED;
            PG8_STAGE(PG8_SB(1, 1), b3 + hstepB, voffB);
            PG8_WAIT_V(6); PG8_BAR; PG8_MMA(1, 1, At, B1); PG8_BAR;
            }
        }
        if constexpr (ALIGN_EPI) { if (wr == 0) PG8_BAR; }
        if constexpr (!Epi::AFTER_DRAIN) { E(acc, cur, wr, wc, fr, fq); S.done(cur); }
        if (!has_next) break;
#pragma unroll
        for (int a = 0; a < 2; ++a)
#pragma unroll
            for (int b = 0; b < 2; ++b)
#pragma unroll
                for (int m = 0; m < 4; ++m)
#pragma unroll
                    for (int n = 0; n < 2; ++n) acc[a][b][m][n] = (f32x4){0.f, 0.f, 0.f, 0.f};
        cur = nxt; cA = nA; cB = nB; ++ui;
        if constexpr (ALIGN_EPI) { if (wr == 1) PG8_BAR; }
    }
    PG8_WAIT_V(0);
    if constexpr (!ALIGN_EPI) { if (wr == 0) PG8_BAR; }
    PG8_BAR;
    if constexpr (Epi::AFTER_DRAIN) { E.fused(acc, cur, wr, wc, fr, fq, lds, wid, lane); S.done(cur); }
#undef PG8_SA
#undef PG8_SB
#undef PG8_STAGE
#undef PG8_LDA
#undef PG8_LDB
#undef PG8_MMA
#undef PG8_WAIT_V
#undef PG8_WAIT_L
#undef PG8_BAR
#undef PG8_SCHED
}
}

#define LAS __attribute__((address_space(3)))
typedef unsigned short bf16;
typedef unsigned v4u __attribute__((ext_vector_type(4)));
typedef unsigned v2u __attribute__((ext_vector_type(2)));
typedef float f32x4 __attribute__((ext_vector_type(4)));
typedef float f32x16 __attribute__((ext_vector_type(16)));
typedef short bf16x8 __attribute__((ext_vector_type(8)));
typedef short s16x4 __attribute__((ext_vector_type(4)));
typedef float f32x2_t __attribute__((ext_vector_type(2)));
typedef __bf16 bf16x2_t __attribute__((ext_vector_type(2)));

constexpr int NB = 8, SEQ = 2048, DM = 1024, TT = NB * SEQ;
constexpr int DIN = 7912, NP = 7936;
constexpr int PP = 3840, NZG = 4096;
constexpr int MEML = 256;
constexpr float EPS = 1e-6f, NEGF = -1e30f;
constexpr int C_QA = 0, C_KA = 512, C_VA = 1024, C_QI = 1536, C_KI = 2048, C_WI = 2112, C_CQ = 2120, C_CKV = 2504, C_KR = 2760, C_QM = 2792, C_ZM = 3304;
constexpr int C_YA = C_QI, C_YB = C_CQ, C_YM = C_VA;
constexpr float SCALE_A = 0.18033688011112042f;
constexpr float SCALE_B = 0.14724444602590306f;
constexpr float SCALE_M = 0.12751743082459868f;
constexpr float SCALE_I = 0.04419417382415922f;

__constant__ float INVA[8] = {1.0f, 0.1939227432012558f, 0.03760603070259094f, 0.007292664609849453f, 0.0014142135623842478f, 0.00027424818836152554f, 5.3182957344688475e-05f, 1.0313385246263351e-05f};
__constant__ float INVB[16] = {1.0f, 0.44036659598350525f, 0.1939227432012558f, 0.08539710193872452f, 0.03760603070259094f, 0.016560440883040428f, 0.007292664609849453f, 0.0032114461064338684f, 0.0014142135623842478f, 0.0006227724370546639f, 0.00027424818836152554f, 0.00012076973507646471f, 5.3182957344688475e-05f, 2.34199997066753e-05f, 1.0313385246263351e-05f, 4.541670477919979e-06f};

constexpr size_t MiB = 1u << 20;
constexpr size_t WS_CTL = 0;
constexpr size_t WS_WIN = 1 * MiB;
constexpr size_t WS_WUQ = 17 * MiB;
constexpr size_t WS_WUKV = 18 * MiB;
constexpr size_t WS_WMEM = 19 * MiB;
constexpr size_t WS_WBR = 21 * MiB;
constexpr size_t WS_WOUT = 24 * MiB;
constexpr size_t WS_ROPEA = 26 * MiB;
constexpr size_t WS_ROPEB = 27 * MiB;
constexpr size_t WS_MN = 29 * MiB;
constexpr size_t WS_KVM = 33 * MiB;
constexpr size_t WS_VTM = 37 * MiB;
constexpr size_t WS_WI = 39 * MiB;
constexpr size_t WS_MASK = 40 * MiB;
constexpr size_t WS_H = 44 * MiB;
constexpr size_t WS_P = 76 * MiB;
constexpr size_t WS_QB = 196 * MiB;
constexpr size_t WS_KVB = 220 * MiB;
constexpr size_t WS_G1 = 196 * MiB;
constexpr size_t WS_END = 256 * MiB;
constexpr size_t DO_VTA = 0;
constexpr size_t DO_VTB = 16 * MiB;
constexpr size_t DO_KB = 32 * MiB;
constexpr size_t DO_G0 = 0;

constexpr int REP_P0 = 1, REP_PH = 1, REP_G1 = 1, REP_G2 = 1, REP_IDX = 1, REP_ATT = 1, REP_G4 = 1, REP_G5 = 1;
constexpr int REP_IDX1 = 1, REP_SEL = 1;
constexpr int ATT_STRIP = 0;
constexpr int EXTRA_SYNCS = 0, REP_TR = 1, DUMMY_POST1 = 0, DUMMY_POST2 = 0;
constexpr int LDS_BYTES = 147456;
constexpr int LDS_SLOT = LDS_BYTES - 64;

__device__ __forceinline__ unsigned pk2(float lo, float hi) { f32x2_t v = {lo, hi}; bf16x2_t b = __builtin_convertvector(v, bf16x2_t); return __builtin_bit_cast(unsigned, b); }
__device__ __forceinline__ float bflo(unsigned w) { return __uint_as_float(w << 16); }
__device__ __forceinline__ float bfhi(unsigned w) { return __uint_as_float(w & 0xffff0000u); }
__device__ __forceinline__ float bf1(bf16 b) { return __uint_as_float(((unsigned)b) << 16); }
#define UNPACK8(W_, V_) do { V_[0] = bflo((W_)[0]); V_[1] = bfhi((W_)[0]); V_[2] = bflo((W_)[1]); V_[3] = bfhi((W_)[1]); V_[4] = bflo((W_)[2]); V_[5] = bfhi((W_)[2]); V_[6] = bflo((W_)[3]); V_[7] = bfhi((W_)[3]); } while (0)
#define PACK8(V_) (v4u){pk2(V_[0], V_[1]), pk2(V_[2], V_[3]), pk2(V_[4], V_[5]), pk2(V_[6], V_[7])}
template <int CTRL> __device__ __forceinline__ float dpp_f(float v) { return __int_as_float(__builtin_amdgcn_update_dpp(0, __float_as_int(v), CTRL, 0xF, 0xF, false)); }
#define SUM8(x) do { x += dpp_f<0xB1>(x); x += dpp_f<0x4E>(x); x += dpp_f<0x141>(x); } while (0)
#define SUM16(x) do { SUM8(x); x += dpp_f<0x140>(x); } while (0)
__device__ __forceinline__ float wave_sum(float v) {
    SUM16(v);
    return __int_as_float(__builtin_amdgcn_readlane(__float_as_int(v), 0)) + __int_as_float(__builtin_amdgcn_readlane(__float_as_int(v), 16))
         + __int_as_float(__builtin_amdgcn_readlane(__float_as_int(v), 32)) + __int_as_float(__builtin_amdgcn_readlane(__float_as_int(v), 48));
}
#define LDS_WAIT() asm volatile("s_waitcnt lgkmcnt(0)" ::: "memory")

__device__ __forceinline__ int win_src(int d) {
    if (d < 2120) return d;
    if (d < 2792) return d + 512;
    if (d < 3816) return d + 1024;
    if (d < 3840) return -1;
    if (d < 4352) return d - 3840 + 2120;
    if (d < 4864) return d - 4352 + 3304;
    return d - 4864 + 4840;
}
template <bool REMAP>
__device__ __forceinline__ void transpose_item(const float* W, int K, int N, int Npad, bf16* WT, LAS float* scr, int item, int lane) {
    const int nblk = Npad / 32, kb = item / nblk, nb = item % nblk, k0 = 64 * kb, n0 = 32 * nb;
    const int n4 = 4 * (lane & 7);
    const int nn = REMAP ? win_src(n0 + n4) : n0 + n4; const bool ok = nn >= 0 && nn < N;
#pragma unroll
    for (int i = 0; i < 8; ++i) { const int kk = 8 * i + (lane >> 3);
        f32x4 v = (f32x4){0.f, 0.f, 0.f, 0.f}; if (ok) v = *(const f32x4*)(W + (size_t)(k0 + kk) * N + nn);
        LAS float* d = scr + kk * 33 + n4; d[0] = v[0]; d[1] = v[1]; d[2] = v[2]; d[3] = v[3]; }
    LDS_WAIT(); asm volatile("" ::: "memory");
    const int c = lane & 7;
#pragma unroll
    for (int j = 0; j < 4; ++j) { const int n = (lane >> 3) + 8 * j; const LAS float* s = scr + (8 * c) * 33 + n;
        v4u o; o.x = pk2(s[0 * 33], s[1 * 33]); o.y = pk2(s[2 * 33], s[3 * 33]); o.z = pk2(s[4 * 33], s[5 * 33]); o.w = pk2(s[6 * 33], s[7 * 33]);
        *(v4u*)(WT + (size_t)(n0 + n) * K + k0 + 8 * c) = o; }
    LDS_WAIT(); asm volatile("" ::: "memory");
}
__device__ __forceinline__ void rms_row_1024(const float* xrow, const float* g, bf16* orow, int lane) {
    const f32x4* xr = (const f32x4*)xrow + lane; const f32x4* gr = (const f32x4*)g + lane;
    f32x4 v[4]; float s = 0.f;
#pragma unroll
    for (int j = 0; j < 4; ++j) { v[j] = xr[64 * j]; s += (v[j].x * v[j].x + v[j].y * v[j].y) + (v[j].z * v[j].z + v[j].w * v[j].w); }
    const float rstd = __builtin_amdgcn_rsqf(wave_sum(s) * (1.f / 1024.f) + EPS);
    v2u* o8 = (v2u*)orow + lane;
#pragma unroll
    for (int j = 0; j < 4; ++j) { const f32x4 gg = gr[64 * j]; v2u w; w.x = pk2(v[j].x * rstd * gg.x, v[j].y * rstd * gg.y); w.y = pk2(v[j].z * rstd * gg.z, v[j].w * rstd * gg.w); o8[64 * j] = w; }
}

#define ROPE8(v, sub, c8, s8) do { _Pragma("unroll") for (int j_ = 0; j_ < 8; ++j_) { const float pv_ = dpp_f<0xB1>(v[j_]); \
        const float r0_ = v[j_] * c8[j_] - pv_ * s8[j_], r1_ = v[j_] * c8[j_] + pv_ * s8[j_]; v[j_] = (sub) == 0 ? r0_ : ((sub) == 1 ? r1_ : v[j_]); } } while (0)

__device__ __forceinline__ void post1_row(const bf16* Prow, bf16* Orow, const float* ra, const float (&ga)[8], const float (&gk)[8], const float (&gq)[8], const float (&gc)[8], const float (&gm)[8], float* WIrow, int lane) {
    const int sub = lane & 7;
    const v4u z4 = (v4u){0u, 0u, 0u, 0u};
    const v4u w_qa = *(const v4u*)(Prow + C_QA + 8 * lane);
    const v4u w_ka = *(const v4u*)(Prow + C_KA + 8 * lane);
    const v4u w_qi = *(const v4u*)(Prow + C_QI + 8 * lane);
    const v4u w_qm = *(const v4u*)(Prow + C_QM + 8 * lane);
    v4u w_ki = z4, w_cq = z4, w_ckv = z4; float w_wi = 0.f;
    if (lane < 8) { w_ki = *(const v4u*)(Prow + C_KI + 8 * lane); w_wi = bf1(Prow[C_WI + lane]); }
    if (lane < 48) w_cq = *(const v4u*)(Prow + C_CQ + 8 * lane);
    if (lane < 32) w_ckv = *(const v4u*)(Prow + C_CKV + 8 * lane);
    float c8[8], s8[8];
    { const f32x4 r0 = *(const f32x4*)(ra), r1 = *(const f32x4*)(ra + 4), r2 = *(const f32x4*)(ra + 8), r3 = *(const f32x4*)(ra + 12);
      c8[0] = r0[0]; c8[1] = r0[1]; c8[2] = r0[2]; c8[3] = r0[3]; c8[4] = r1[0]; c8[5] = r1[1]; c8[6] = r1[2]; c8[7] = r1[3];
      s8[0] = r2[0]; s8[1] = r2[1]; s8[2] = r2[2]; s8[3] = r2[3]; s8[4] = r3[0]; s8[5] = r3[1]; s8[6] = r3[2]; s8[7] = r3[3]; }
    { float v[8]; UNPACK8(w_qa, v); float ss = 0.f;
#pragma unroll
      for (int j = 0; j < 8; ++j) ss += v[j] * v[j];
      SUM8(ss);
      const float rstd = __builtin_amdgcn_rsqf(ss * (1.f / 64.f) + EPS);
#pragma unroll
      for (int j = 0; j < 8; ++j) v[j] = v[j] * rstd * ga[j];
      ROPE8(v, sub, c8, s8);
#pragma unroll
      for (int j = 0; j < 8; ++j) v[j] *= SCALE_A;
      *(v4u*)(Orow + C_QA + 8 * lane) = PACK8(v); }
    { float v[8]; UNPACK8(w_ka, v); float ss = 0.f;
#pragma unroll
      for (int j = 0; j < 8; ++j) ss += v[j] * v[j];
      SUM8(ss);
      const float rstd = __builtin_amdgcn_rsqf(ss * (1.f / 64.f) + EPS);
#pragma unroll
      for (int j = 0; j < 8; ++j) v[j] = v[j] * rstd * gk[j];
      ROPE8(v, sub, c8, s8);
      *(v4u*)(Orow + C_KA + 8 * lane) = PACK8(v); }
    { float v[8]; UNPACK8(w_qi, v);
      ROPE8(v, sub, c8, s8);
      *(v4u*)(Orow + C_QI + 8 * lane) = PACK8(v); }
    { float v[8]; UNPACK8(w_ki, v);
      ROPE8(v, sub, c8, s8);
      if (lane < 8) *(v4u*)(Orow + C_KI + 8 * lane) = PACK8(v); }
    if (lane < 8) WIrow[lane] = w_wi * SCALE_I;
    { float v[8]; UNPACK8(w_cq, v); float ss = 0.f;
#pragma unroll
      for (int j = 0; j < 8; ++j) ss += v[j] * v[j];
      ss = wave_sum(ss); const float rstd = __builtin_amdgcn_rsqf(ss * (1.f / 384.f) + EPS);
      if (lane < 48) {
#pragma unroll
          for (int j = 0; j < 8; ++j) v[j] = v[j] * rstd * gq[j];
          *(v4u*)(Orow + C_CQ + 8 * lane) = PACK8(v); } }
    { float v[8]; UNPACK8(w_ckv, v); float ss = 0.f;
#pragma unroll
      for (int j = 0; j < 8; ++j) ss += v[j] * v[j];
      ss = wave_sum(ss); const float rstd = __builtin_amdgcn_rsqf(ss * (1.f / 256.f) + EPS);
      if (lane < 32) {
#pragma unroll
          for (int j = 0; j < 8; ++j) v[j] = v[j] * rstd * gc[j];
          *(v4u*)(Orow + C_CKV + 8 * lane) = PACK8(v); } }
    { float v[8]; UNPACK8(w_qm, v); float ss = 0.f;
#pragma unroll
      for (int j = 0; j < 8; ++j) ss += v[j] * v[j];
      SUM16(ss);
      const float rstd = __builtin_amdgcn_rsqf(ss * (1.f / 128.f) + EPS);
#pragma unroll
      for (int j = 0; j < 8; ++j) v[j] = v[j] * rstd * gm[j] * SCALE_M;
      *(v4u*)(Orow + C_QM + 8 * lane) = PACK8(v); }
}

__device__ __forceinline__ void km_row(bf16* row, const float* gkm, int lane) {
    v4u w = *(const v4u*)(row + 8 * lane); float v[8]; UNPACK8(w, v); float ss = 0.f;
#pragma unroll
    for (int j = 0; j < 8; ++j) ss += v[j] * v[j];
    SUM16(ss);
    const float rstd = __builtin_amdgcn_rsqf(ss * (1.f / 128.f) + EPS);
#pragma unroll
    for (int j = 0; j < 8; ++j) v[j] = v[j] * rstd * gkm[8 * (lane & 15) + j];
    *(v4u*)(row + 8 * lane) = PACK8(v);
}

__device__ __forceinline__ void transpose_v(const bf16* src, int pitch, int col0, int hstride, int H, int DV, int S, int nb, bf16* dst, int gw, int NGW, int lane) {
    const int ndq = DV / 64, nsc = S / 64, ntask = nb * H * nsc * ndq;
    for (int task = gw; task < ntask; task += NGW) {
        int x = task; const int dq = x % ndq; x /= ndq; const int sc = x % nsc; x /= nsc; const int h = x % H; const int b = x / H;
        const int s = sc * 64 + lane;
        const bf16* srow = src + (size_t)(b * S + s) * pitch + col0 + h * hstride + dq * 64;
        bf16* drow = dst + ((size_t)((b * H + h) * DV + dq * 64)) * S + s;
        v4u wv[8];
#pragma unroll
        for (int c = 0; c < 8; ++c) wv[c] = *(const v4u*)(srow + 8 * c);
#pragma unroll
        for (int c = 0; c < 8; ++c) { const v4u w = wv[c];
            drow[(size_t)(8 * c + 0) * S] = (bf16)(w.x & 0xffffu); drow[(size_t)(8 * c + 1) * S] = (bf16)(w.x >> 16);
            drow[(size_t)(8 * c + 2) * S] = (bf16)(w.y & 0xffffu); drow[(size_t)(8 * c + 3) * S] = (bf16)(w.y >> 16);
            drow[(size_t)(8 * c + 4) * S] = (bf16)(w.z & 0xffffu); drow[(size_t)(8 * c + 5) * S] = (bf16)(w.z >> 16);
            drow[(size_t)(8 * c + 6) * S] = (bf16)(w.w & 0xffffu); drow[(size_t)(8 * c + 7) * S] = (bf16)(w.w >> 16); }
    }
}

__device__ __forceinline__ void post2_row(const bf16* QBrow, bf16* QOrow, const bf16* KVBrow, const bf16* Prow, bf16* KBrow, const float* rb, const float (&gqv)[12], const float (&gkv)[12], LAS float* scr, int lane) {
    const int hd = lane >> 3, d0 = 12 * (lane & 7);
    float vq[12], vk[12], cc[12], sn[12];
    { const v2u* p = (const v2u*)(QBrow + 12 * lane);
      const v2u w0 = p[0], w1 = p[1], w2 = p[2];
      bf16 kr[12];
#pragma unroll
      for (int e = 0; e < 12; ++e) { const int d = d0 + e; kr[e] = d < 64 ? KVBrow[hd * 128 + d] : Prow[C_KR + d - 64]; }
#pragma unroll
      for (int e = 0; e < 12; ++e) { const int d = d0 + e; const int i = (d - 64) & 15; cc[e] = d < 64 ? 1.f : rb[i]; sn[e] = d < 64 ? 0.f : rb[16 + i]; }
      vq[0] = bflo(w0.x); vq[1] = bfhi(w0.x); vq[2] = bflo(w0.y); vq[3] = bfhi(w0.y); vq[4] = bflo(w1.x); vq[5] = bfhi(w1.x); vq[6] = bflo(w1.y); vq[7] = bfhi(w1.y);
      vq[8] = bflo(w2.x); vq[9] = bfhi(w2.x); vq[10] = bflo(w2.y); vq[11] = bfhi(w2.y);
#pragma unroll
      for (int e = 0; e < 12; ++e) vk[e] = bf1(kr[e]); }
    float sq = 0.f, sk = 0.f;
#pragma unroll
    for (int e = 0; e < 12; ++e) { sq += vq[e] * vq[e]; sk += vk[e] * vk[e]; }
    SUM8(sq); SUM8(sk);
    const float rq = __builtin_amdgcn_rsqf(sq * (1.f / 96.f) + EPS), rk = __builtin_amdgcn_rsqf(sk * (1.f / 96.f) + EPS);
#pragma unroll
    for (int e = 0; e < 12; ++e) { vq[e] = vq[e] * rq * gqv[e]; vk[e] = vk[e] * rk * gkv[e]; scr[12 * lane + e] = vq[e]; scr[768 + 12 * lane + e] = vk[e]; }
    LDS_WAIT(); asm volatile("" ::: "memory");
    float oq[12], ok[12];
#pragma unroll
    for (int e = 0; e < 12; ++e) { const int d = d0 + e;
        if (d < 64) { oq[e] = vq[e]; ok[e] = vk[e]; }
        else { const bool first = d < 80; const int off = first ? 16 : -16; const float pq = scr[12 * lane + e + off], pk = scr[768 + 12 * lane + e + off];
               oq[e] = first ? vq[e] * cc[e] - pq * sn[e] : vq[e] * cc[e] + pq * sn[e];
               ok[e] = first ? vk[e] * cc[e] - pk * sn[e] : vk[e] * cc[e] + pk * sn[e]; }
        oq[e] *= SCALE_B; }
    LDS_WAIT(); asm volatile("" ::: "memory");
    v2u* q = (v2u*)(QOrow + 12 * lane); v2u* k = (v2u*)(KBrow + 12 * lane);
#pragma unroll
    for (int i = 0; i < 3; ++i) { v2u w; w.x = pk2(oq[4 * i], oq[4 * i + 1]); w.y = pk2(oq[4 * i + 2], oq[4 * i + 3]); q[i] = w;
                                  v2u u; u.x = pk2(ok[4 * i], ok[4 * i + 1]); u.y = pk2(ok[4 * i + 2], ok[4 * i + 3]); k[i] = u; }
}

__device__ __forceinline__ int next_unit(unsigned* ctr, volatile LAS int* slot) {
    __syncthreads();
    if (threadIdx.x == 0) *slot = (int)atomicAdd(ctr, 1u);
    __syncthreads();
    return *slot;
}

constexpr int SCP = 2112;
__device__ __forceinline__ unsigned ord_key(float v) { const unsigned b = __float_as_uint(v); return b ^ ((unsigned)((int)b >> 31) | 0x80000000u); }
__device__ __forceinline__ void indexer_unit(LAS float* sc, const bf16* P, const float* WI, unsigned* MASK, int bb, int tb) {
    int tid_ = threadIdx.x; asm volatile("" : "+v"(tid_));
    const int tid = tid_, lane = tid & 63, w = __builtin_amdgcn_readfirstlane(tid >> 6);
    const int n = lane & 15, g = lane >> 4;
    const int rowbase = bb * SEQ, t0 = tb * 16;
    for (int rp1 = 0; rp1 < REP_IDX1; ++rp1) {
        bf16x8 qf[8][2]; float wq[8];
        const bf16* qrow = P + (size_t)(rowbase + t0 + n) * PP + C_QI + 8 * g;
#pragma unroll
        for (int h = 0; h < 8; ++h) {
            qf[h][0] = *(const bf16x8*)(qrow + h * 64);
            qf[h][1] = *(const bf16x8*)(qrow + h * 64 + 32);
            wq[h] = WI[(size_t)(rowbase + t0 + n) * 8 + h];
        }
        const int ntile = tb + 1;
        const int nmine = (ntile - w + 7) >> 3;
        const int ngrp = (nmine + 3) >> 2;
        const bf16* kbase = P + (size_t)(rowbase + n) * PP + C_KI + 8 * g;
        bf16x8 kb[2][4][2];
#define IDX_LOAD(BUF, GRP) do { _Pragma("unroll") for (int j_ = 0; j_ < 4; ++j_) { const int tile_ = w + 8 * (4 * (GRP) + j_); const int tl_ = tile_ < ntile ? tile_ : 0; \
            const bf16* kr_ = kbase + (size_t)(16 * tl_) * PP; kb[BUF][j_][0] = *(const bf16x8*)(kr_); kb[BUF][j_][1] = *(const bf16x8*)(kr_ + 32); } } while (0)
#define IDX_COMP(BUF, GRP) do { _Pragma("unroll") for (int j_ = 0; j_ < 4; ++j_) { const int tile_ = w + 8 * (4 * (GRP) + j_); if (tile_ < ntile) { \
            f32x4 idx_ = (f32x4){0.f, 0.f, 0.f, 0.f}; \
            _Pragma("unroll") for (int h_ = 0; h_ < 8; ++h_) { f32x4 a_ = (f32x4){0.f, 0.f, 0.f, 0.f}; \
                a_ = __builtin_amdgcn_mfma_f32_16x16x32_bf16(kb[BUF][j_][0], qf[h_][0], a_, 0, 0, 0); \
                a_ = __builtin_amdgcn_mfma_f32_16x16x32_bf16(kb[BUF][j_][1], qf[h_][1], a_, 0, 0, 0); \
                _Pragma("unroll") for (int i_ = 0; i_ < 4; ++i_) idx_[i_] = __builtin_fmaf(wq[h_], __builtin_fmaxf(a_[i_], 0.f), idx_[i_]); } \
            { const int k0_ = 16 * tile_ + 4 * g; LAS float* d_ = sc + n * SCP + k0_ + (k0_ >> 5); d_[0] = idx_[0]; d_[1] = idx_[1]; d_[2] = idx_[2]; d_[3] = idx_[3]; } } } } while (0)
        if (ngrp > 0) IDX_LOAD(0, 0);
        for (int gp = 0; gp < ngrp; gp += 2) {
            if (gp + 1 < ngrp) IDX_LOAD(1, gp + 1);
            IDX_COMP(0, gp);
            if (gp + 1 < ngrp) { if (gp + 2 < ngrp) IDX_LOAD(0, gp + 2); IDX_COMP(1, gp + 1); }
        }
#undef IDX_LOAD
#undef IDX_COMP
    }
    __syncthreads();
    for (int rs = 0; rs < REP_SEL; ++rs) {
        const int ta = t0 + 2 * w, tb2 = ta + 1;
        unsigned* mra = MASK + (size_t)(rowbase + ta) * 64; unsigned* mrb = mra + 64;
        const int nva = ta - 32 * lane + 1, nvb = nva + 1;
        const unsigned valid_a = nva >= 32 ? 0xffffffffu : (nva <= 0 ? 0u : ((1u << nva) - 1u));
        const unsigned valid_b = nvb >= 32 ? 0xffffffffu : (nvb <= 0 ? 0u : ((1u << nvb) - 1u));
        if (ta < 256) { mra[lane] = valid_a; mrb[lane] = valid_b; continue; }
        unsigned ua[32], ub[32];
        { const LAS float* sra = sc + (2 * w) * SCP + 33 * lane; const LAS float* srb = sra + SCP;
#pragma unroll
          for (int r = 0; r < 32; ++r) { const float va = sra[r], vb = srb[r]; ua[r] = ((valid_a >> r) & 1u) ? ord_key(va) : 0u; ub[r] = ((valid_b >> r) & 1u) ? ord_key(vb) : 0u; } }
#pragma unroll
        for (int k = 0; k < 16; ++k) {
            const unsigned a0 = ua[k], a1 = ua[k + 16]; ua[k] = __builtin_amdgcn_perm(a1, a0, 0x05040100u); ua[k + 16] = __builtin_amdgcn_perm(a1, a0, 0x07060302u);
            const unsigned b0 = ub[k], b1 = ub[k + 16]; ub[k] = __builtin_amdgcn_perm(b1, b0, 0x05040100u); ub[k + 16] = __builtin_amdgcn_perm(b1, b0, 0x07060302u); }
#pragma unroll
        for (int k = 0; k < 32; ++k) if (!(k & 8)) {
            const unsigned a0 = ua[k], a1 = ua[k + 8]; ua[k] = __builtin_amdgcn_perm(a1, a0, 0x06020400u); ua[k + 8] = __builtin_amdgcn_perm(a1, a0, 0x07030501u);
            const unsigned b0 = ub[k], b1 = ub[k + 8]; ub[k] = __builtin_amdgcn_perm(b1, b0, 0x06020400u); ub[k + 8] = __builtin_amdgcn_perm(b1, b0, 0x07030501u); }
#pragma unroll
        for (int si = 2; si < 5; ++si) { const int sft = 16 >> si;
            const unsigned msk = si == 2 ? 0x0f0f0f0fu : (si == 3 ? 0x33333333u : 0x55555555u);
#pragma unroll
            for (int k = 0; k < 32; ++k) if (!(k & sft)) {
                const unsigned a0 = ua[k], a1 = ua[k + sft]; ua[k] = (a0 & msk) | ((a1 << sft) & ~msk); ua[k + sft] = ((a0 >> sft) & msk) | (a1 & ~msk);
                const unsigned b0 = ub[k], b1 = ub[k + sft]; ub[k] = (b0 & msk) | ((b1 << sft) & ~msk); ub[k + sft] = ((b0 >> sft) & msk) | (b1 & ~msk); } }
        unsigned alive_a = valid_a, sel_a = 0u, alive_b = valid_b, sel_b = 0u; int need_a = 256, need_b = 256; bool run_a = true, run_b = true;
#pragma unroll
        for (int j = 31; j >= 0; --j) {
            const unsigned ones_a = alive_a & ua[j], ones_b = alive_b & ub[j];
            int v = (int)((unsigned)__popc(ones_a) | ((unsigned)__popc(ones_b) << 16));
            v += __builtin_amdgcn_update_dpp(0, v, 0xB1, 0xF, 0xF, false);
            v += __builtin_amdgcn_update_dpp(0, v, 0x4E, 0xF, 0xF, false);
            v += __builtin_amdgcn_update_dpp(0, v, 0x141, 0xF, 0xF, false);
            v += __builtin_amdgcn_update_dpp(0, v, 0x140, 0xF, 0xF, false);
            const unsigned tot = (unsigned)(__builtin_amdgcn_readlane(v, 0) + __builtin_amdgcn_readlane(v, 16) + __builtin_amdgcn_readlane(v, 32) + __builtin_amdgcn_readlane(v, 48));
            const int ca = (int)(tot & 0xffffu), cb = (int)(tot >> 16);
            if (run_a) { if (ca >= need_a) { alive_a = ones_a; if (ca == need_a) { sel_a |= ones_a; need_a = 0; run_a = false; } }
                         else { need_a -= ca; sel_a |= ones_a; alive_a &= ~ua[j]; } }
            if (run_b) { if (cb >= need_b) { alive_b = ones_b; if (cb == need_b) { sel_b |= ones_b; need_b = 0; run_b = false; } }
                         else { need_b -= cb; sel_b |= ones_b; alive_b &= ~ub[j]; } }
            if (!run_a && !run_b) break;
        }
        if (need_a > 0) {
            const int cnt = __popc(alive_a); int inc = cnt;
#pragma unroll
            for (int d = 1; d < 64; d <<= 1) { const int o = __shfl_up(inc, d); if (lane >= d) inc += o; }
            int k = need_a - (inc - cnt); k = k < 0 ? 0 : (k > cnt ? cnt : k);
            unsigned m = alive_a;
            for (int i = 0; i < k; ++i) { const unsigned low = m & (0u - m); sel_a |= low; m ^= low; }
        }
        if (need_b > 0) {
            const int cnt = __popc(alive_b); int inc = cnt;
#pragma unroll
            for (int d = 1; d < 64; d <<= 1) { const int o = __shfl_up(inc, d); if (lane >= d) inc += o; }
            int k = need_b - (inc - cnt); k = k < 0 ? 0 : (k > cnt ? cnt : k);
            unsigned m = alive_b;
            for (int i = 0; i < k; ++i) { const unsigned low = m & (0u - m); sel_b |= low; m ^= low; }
        }
        mra[lane] = sel_a; mrb[lane] = sel_b;
        (void)tb2;
    }
    __syncthreads();
}

__device__ __forceinline__ float half_max(float m) { auto rr = __builtin_amdgcn_permlane32_swap(__float_as_uint(m), __float_as_uint(m), false, false); return __builtin_fmaxf(__uint_as_float(rr[0]), __uint_as_float(rr[1])); }
__device__ __forceinline__ float half_sum(float m) { auto rr = __builtin_amdgcn_permlane32_swap(__float_as_uint(m), __float_as_uint(m), false, false); return __uint_as_float(rr[0]) + __uint_as_float(rr[1]); }
__device__ __forceinline__ int crow(int r, int hi) { return (r & 3) + 8 * (r >> 2) + 4 * hi; }
template <int DQK, int DV, int MODE, int STRIP = 0>
__device__ __forceinline__ void attn_unit(LAS unsigned char* lds, const bf16* Qb, int qpitch, const bf16* Kb, int kpitch, const bf16* VTb, int skv,
                                          const unsigned* maskb, const bf16* Zb, bf16* Ob, int q0) {
    constexpr int TK = 128, KP = DQK + 8, VP = TK + 8;
    LAS bf16* Ks = (LAS bf16*)lds; LAS bf16* Vs = Ks + TK * KP;
    constexpr int CPR = DQK / 8;
    constexpr int NCK = TK * CPR, NCV = DV * (TK / 8);
    constexpr int RK = (NCK + 511) / 512, RV = (NCV + 511) / 512;
    constexpr int NKS = DQK / 16, NMT = DV / 32;
    int tid_ = threadIdx.x; asm volatile("" : "+v"(tid_));
    const int tid = tid_, lane = tid & 63, w = __builtin_amdgcn_readfirstlane(tid >> 6), r = lane & 31, hh = lane >> 5;
    const int NT = MODE == 0 ? skv / TK : (q0 + 256) / TK;
    const int qlo = q0 + 32 * w;
    bf16x8 qf[NKS];
    { const bf16* qrow = Qb + (size_t)(qlo + r) * qpitch + 8 * hh;
#pragma unroll
      for (int ks = 0; ks < NKS; ++ks) qf[ks] = *(const bf16x8*)(qrow + 16 * ks); }
    f32x16 o[NMT];
#pragma unroll
    for (int mt = 0; mt < NMT; ++mt)
#pragma unroll
        for (int i = 0; i < 16; ++i) o[mt][i] = 0.f;
    float m_run = NEGF, l_run = 0.f;
    v4u kreg[RK], vreg[RV];
#define ATT_PREFETCH(tile_) do { \
        _Pragma("unroll") for (int i_ = 0; i_ < RK; ++i_) { const int c_ = tid + 512 * i_; if (c_ < NCK) { const int row_ = c_ / CPR, cc_ = c_ % CPR; kreg[i_] = *(const v4u*)(Kb + (size_t)(TK * (tile_) + row_) * kpitch + 8 * cc_); } } \
        _Pragma("unroll") for (int i_ = 0; i_ < RV; ++i_) { const int c_ = tid + 512 * i_; if (c_ < NCV) { const int d_ = c_ >> 4, cc_ = c_ & 15; vreg[i_] = *(const v4u*)(VTb + (size_t)d_ * skv + TK * (tile_) + 8 * cc_); } } } while (0)
    if (STRIP != 2) ATT_PREFETCH(0);
    for (int tile = 0; tile < NT; ++tile) {
        __syncthreads();
        if (STRIP != 2) {
#pragma unroll
        for (int i = 0; i < RK; ++i) { const int c = tid + 512 * i; if (c < NCK) { const int row = c / CPR, cc = c % CPR; *(LAS v4u*)(Ks + row * KP + 8 * cc) = kreg[i]; } }
#pragma unroll
        for (int i = 0; i < RV; ++i) { const int c = tid + 512 * i; if (c < NCV) { const int d = c >> 4, cc = c & 15; *(LAS v4u*)(Vs + d * VP + 8 * cc) = vreg[i]; } }
        }
        __syncthreads();
        if (STRIP != 2 && tile + 1 < NT) ATT_PREFETCH(tile + 1);
        __builtin_amdgcn_sched_barrier(0);
        if (STRIP == 1) continue;
#pragma unroll 1
        for (int sub = 0; sub < 2; ++sub) {
        const int t64 = 2 * tile + sub;
        if (MODE != 0 && 64 * t64 > qlo + 31) continue;
        const LAS bf16* Kc = Ks + 64 * sub * KP; const LAS bf16* Vc = Vs + 64 * sub;
        unsigned mw0 = 0u, mw1 = 0u;
        if (MODE == 2) { const v2u mm = *(const v2u*)(maskb + (size_t)(qlo + r) * 64 + 2 * t64); mw0 = mm.x >> (4 * hh); mw1 = mm.y >> (4 * hh); }
        f32x16 s0, s1;
#pragma unroll
        for (int i = 0; i < 16; ++i) { s0[i] = 0.f; s1[i] = 0.f; }
#pragma unroll
        for (int ks = 0; ks < NKS; ++ks) {
            const bf16x8 a0 = *(const LAS bf16x8*)(Kc + r * KP + 16 * ks + 8 * hh);
            const bf16x8 a1 = *(const LAS bf16x8*)(Kc + (32 + r) * KP + 16 * ks + 8 * hh);
            s0 = __builtin_amdgcn_mfma_f32_32x32x16_bf16(a0, qf[ks], s0, 0, 0, 0);
            s1 = __builtin_amdgcn_mfma_f32_32x32x16_bf16(a1, qf[ks], s1, 0, 0, 0);
        }
        if (MODE == 1) {
            if (64 * t64 + 63 > qlo) { const int qg = qlo + r;
#pragma unroll
                for (int i = 0; i < 16; ++i) { const int key = 64 * t64 + crow(i, hh); if (key > qg) s0[i] = NEGF; if (key + 32 > qg) s1[i] = NEGF; } }
        }
        if (MODE == 2) {
#pragma unroll
            for (int i = 0; i < 16; ++i) { const int bit = (i & 3) + 8 * (i >> 2); if (!((mw0 >> bit) & 1u)) s0[i] = NEGF; if (!((mw1 >> bit) & 1u)) s1[i] = NEGF; }
        }
        float mx = s0[0];
#pragma unroll
        for (int i = 1; i < 16; ++i) mx = __builtin_fmaxf(mx, s0[i]);
#pragma unroll
        for (int i = 0; i < 16; ++i) mx = __builtin_fmaxf(mx, s1[i]);
        mx = half_max(mx);
        const float m_new = __builtin_fmaxf(m_run, mx);
        const float alpha = __builtin_amdgcn_exp2f(m_run - m_new);
        m_run = m_new;
        float ls = 0.f;
#pragma unroll
        for (int i = 0; i < 16; ++i) { s0[i] = __builtin_amdgcn_exp2f(s0[i] - m_new); s1[i] = __builtin_amdgcn_exp2f(s1[i] - m_new); ls += s0[i] + s1[i]; }
        l_run = l_run * alpha + ls;
#pragma unroll
        for (int mt = 0; mt < NMT; ++mt)
#pragma unroll
            for (int i = 0; i < 16; ++i) o[mt][i] *= alpha;
        v4u pf[2][2];
#pragma unroll
        for (int s = 0; s < 2; ++s) {
            pf[0][s] = (v4u){pk2(s0[8 * s], s0[8 * s + 1]), pk2(s0[8 * s + 2], s0[8 * s + 3]), pk2(s0[8 * s + 4], s0[8 * s + 5]), pk2(s0[8 * s + 6], s0[8 * s + 7])};
            pf[1][s] = (v4u){pk2(s1[8 * s], s1[8 * s + 1]), pk2(s1[8 * s + 2], s1[8 * s + 3]), pk2(s1[8 * s + 4], s1[8 * s + 5]), pk2(s1[8 * s + 6], s1[8 * s + 7])};
        }
#pragma unroll
        for (int mt = 0; mt < NMT; ++mt)
#pragma unroll
            for (int p = 0; p < 2; ++p)
#pragma unroll
                for (int s = 0; s < 2; ++s) {
                    const LAS bf16* vp = Vc + (32 * mt + r) * VP + 32 * p + 16 * s + 4 * hh;
                    const s16x4 lo = *(const LAS s16x4*)(vp), hi = *(const LAS s16x4*)(vp + 8);
                    const bf16x8 a = (bf16x8){lo[0], lo[1], lo[2], lo[3], hi[0], hi[1], hi[2], hi[3]};
                    o[mt] = __builtin_amdgcn_mfma_f32_32x32x16_bf16(a, __builtin_bit_cast(bf16x8, pf[p][s]), o[mt], 0, 0, 0);
                }
        }
    }
#undef ATT_PREFETCH
    const float l_tot = half_sum(l_run);
    const float inv = 1.0f / l_tot;
    const size_t row = (size_t)(qlo + r);
#pragma unroll
    for (int mt = 0; mt < NMT; ++mt)
#pragma unroll
        for (int g4 = 0; g4 < 4; ++g4) {
            const int d = 32 * mt + 8 * g4 + 4 * hh;
            float ov[4];
#pragma unroll
            for (int i = 0; i < 4; ++i) ov[i] = o[mt][4 * g4 + i] * inv;
            if (Zb) { const v2u zw = *(const v2u*)(Zb + row * PP + d); const float z[4] = {bflo(zw.x), bfhi(zw.x), bflo(zw.y), bfhi(zw.y)};
#pragma unroll
                for (int i = 0; i < 4; ++i) ov[i] *= z[i] * __builtin_amdgcn_rcpf(1.0f + __expf(-z[i])); }
            v2u ow; ow.x = pk2(ov[0], ov[1]); ow.y = pk2(ov[2], ov[3]);
            *(v2u*)(Ob + row * PP + d) = ow;
        }
}

template <int DQK, int MODE>
__device__ __forceinline__ void attn_unit_pipe(LAS unsigned char* lds, const bf16* Qb, int qpitch, const bf16* Kb, int kpitch, const bf16* VTb, int skv,
                                               const unsigned* maskb, bf16* Ob, int q0) {
    constexpr int DV = 64, KP = DQK + 8, VP = 72, BUFE = 64 * KP + DV * VP;
    constexpr int CPR = DQK / 8, NCK = 64 * CPR, NCV = DV * 8, RK = (NCK + 511) / 512, RV = (NCV + 511) / 512, NKS = DQK / 16, NMT = DV / 32;
    static_assert(NCV == 512 && (NCK == 512 || NCK == 768), "staging map");
    int tid_ = threadIdx.x; asm volatile("" : "+v"(tid_));
    const int tid = tid_, lane = tid & 63, w = __builtin_amdgcn_readfirstlane(tid >> 6), r = lane & 31, hh = lane >> 5;
    const int NT = (q0 + 256) / 64;
    const int qlo = q0 + 32 * w;
    const int NTw = ((qlo + 31) >> 6) + 1;
    int krow[RK], kcc[RK];
#pragma unroll
    for (int i = 0; i < RK; ++i) { int c = tid + 512 * i; if (c >= NCK) c -= 256; krow[i] = c / CPR; kcc[i] = c % CPR; }
    const int vd = tid >> 3, vcc = tid & 7;
    bf16x8 qf[NKS];
    { const bf16* qrow = Qb + (size_t)(qlo + r) * qpitch + 8 * hh;
#pragma unroll
      for (int ks = 0; ks < NKS; ++ks) qf[ks] = *(const bf16x8*)(qrow + 16 * ks); }
    f32x16 o[NMT];
#pragma unroll
    for (int mt = 0; mt < NMT; ++mt)
#pragma unroll
        for (int i = 0; i < 16; ++i) o[mt][i] = 0.f;
    float m_run = NEGF, l_run = 0.f, alpha = 1.f;
    v4u kreg[2][RK], vreg[2][RV]; v2u mset[2];
    const unsigned* mrowp = MODE == 2 ? maskb + (size_t)(qlo + r) * 64 : nullptr;
#define PL_LOAD(S_, tile_) do { const int tl_ = (tile_) < NT ? (tile_) : NT - 1; \
        if (MODE == 2) { const int mt_ = (tile_) >= 2 ? ((tile_) - 2 < 32 ? (tile_) - 2 : 31) : 0; mset[S_] = *(const v2u*)(mrowp + 2 * mt_); }     \
        _Pragma("unroll") for (int i_ = 0; i_ < RK; ++i_) kreg[S_][i_] = *(const v4u*)(Kb + (size_t)(64 * tl_ + krow[i_]) * kpitch + 8 * kcc[i_]); \
        vreg[S_][0] = *(const v4u*)(VTb + (size_t)vd * skv + 64 * tl_ + 8 * vcc); } while (0)
#define PL_STAGE(S_, buf_) do { LAS bf16* Kd_ = (LAS bf16*)lds + (buf_) * BUFE; LAS bf16* Vd_ = Kd_ + 64 * KP; \
        _Pragma("unroll") for (int i_ = 0; i_ < RK; ++i_) *(LAS v4u*)(Kd_ + krow[i_] * KP + 8 * kcc[i_]) = kreg[S_][i_]; \
        *(LAS v4u*)(Vd_ + vd * VP + 8 * vcc) = vreg[S_][0]; } while (0)
#define PL_QK(t_, D0_, D1_) do { const LAS bf16* Kc_ = (const LAS bf16*)lds + ((t_) & 3) * BUFE; \
        _Pragma("unroll") for (int i_ = 0; i_ < 16; ++i_) { D0_[i_] = 0.f; D1_[i_] = 0.f; } \
        _Pragma("unroll") for (int ks_ = 0; ks_ < NKS; ++ks_) { \
            const bf16x8 a0_ = *(const LAS bf16x8*)(Kc_ + r * KP + 16 * ks_ + 8 * hh); const bf16x8 a1_ = *(const LAS bf16x8*)(Kc_ + (32 + r) * KP + 16 * ks_ + 8 * hh); \
            D0_ = __builtin_amdgcn_mfma_f32_32x32x16_bf16(a0_, qf[ks_], D0_, 0, 0, 0); D1_ = __builtin_amdgcn_mfma_f32_32x32x16_bf16(a1_, qf[ks_], D1_, 0, 0, 0); } } while (0)
#define PL_PV(t_) do { const LAS bf16* Vc_ = (const LAS bf16*)lds + ((t_) & 3) * BUFE + 64 * KP; \
        _Pragma("unroll") for (int mt_ = 0; mt_ < NMT; ++mt_) _Pragma("unroll") for (int i_ = 0; i_ < 16; ++i_) o[mt_][i_] *= alpha; \
        _Pragma("unroll") for (int mt_ = 0; mt_ < NMT; ++mt_) _Pragma("unroll") for (int p_ = 0; p_ < 2; ++p_) _Pragma("unroll") for (int s_ = 0; s_ < 2; ++s_) { \
            const LAS bf16* vp_ = Vc_ + (32 * mt_ + r) * VP + 32 * p_ + 16 * s_ + 4 * hh; \
            const s16x4 lo_ = *(const LAS s16x4*)(vp_), hi_ = *(const LAS s16x4*)(vp_ + 8); \
            const bf16x8 a_ = (bf16x8){lo_[0], lo_[1], lo_[2], lo_[3], hi_[0], hi_[1], hi_[2], hi_[3]}; \
            o[mt_] = __builtin_amdgcn_mfma_f32_32x32x16_bf16(a_, __builtin_bit_cast(bf16x8, pf[p_][s_]), o[mt_], 0, 0, 0); } } while (0)
#define PL_SOFTMAX(t_, C0_, C1_, MK_, CAUSAL_) do { \
        if (MODE == 2) { const unsigned w0_ = (MK_).x >> (4 * hh), w1_ = (MK_).y >> (4 * hh); \
            _Pragma("unroll") for (int i_ = 0; i_ < 16; ++i_) { const int bit_ = (i_ & 3) + 8 * (i_ >> 2); if (!((w0_ >> bit_) & 1u)) C0_[i_] = NEGF; if (!((w1_ >> bit_) & 1u)) C1_[i_] = NEGF; } } \
        if (CAUSAL_) { const int qg_ = qlo + r; \
            _Pragma("unroll") for (int i_ = 0; i_ < 16; ++i_) { const int key_ = 64 * (t_) + crow(i_, hh); if (key_ > qg_) C0_[i_] = NEGF; if (key_ + 32 > qg_) C1_[i_] = NEGF; } } \
        float mx_ = C0_[0]; \
        _Pragma("unroll") for (int i_ = 1; i_ < 16; ++i_) mx_ = __builtin_fmaxf(mx_, C0_[i_]); \
        _Pragma("unroll") for (int i_ = 0; i_ < 16; ++i_) mx_ = __builtin_fmaxf(mx_, C1_[i_]); \
        mx_ = half_max(mx_); \
        const float mn_ = __builtin_fmaxf(m_run, mx_); alpha = __builtin_amdgcn_exp2f(m_run - mn_); m_run = mn_; \
        float ls_ = 0.f; \
        _Pragma("unroll") for (int i_ = 0; i_ < 16; ++i_) { C0_[i_] = __builtin_amdgcn_exp2f(C0_[i_] - mn_); C1_[i_] = __builtin_amdgcn_exp2f(C1_[i_] - mn_); ls_ += C0_[i_] + C1_[i_]; } \
        l_run = l_run * alpha + ls_; \
        _Pragma("unroll") for (int s_ = 0; s_ < 2; ++s_) { \
            pf[0][s_] = (v4u){pk2(C0_[8 * s_], C0_[8 * s_ + 1]), pk2(C0_[8 * s_ + 2], C0_[8 * s_ + 3]), pk2(C0_[8 * s_ + 4], C0_[8 * s_ + 5]), pk2(C0_[8 * s_ + 6], C0_[8 * s_ + 7])}; \
            pf[1][s_] = (v4u){pk2(C1_[8 * s_], C1_[8 * s_ + 1]), pk2(C1_[8 * s_ + 2], C1_[8 * s_ + 3]), pk2(C1_[8 * s_ + 4], C1_[8 * s_ + 5]), pk2(C1_[8 * s_ + 6], C1_[8 * s_ + 7])}; } } while (0)
#define PL_IO(t_, S_) do { PL_STAGE(S_, ((t_) + 2) & 3); PL_LOAD(S_, (t_) + 4); } while (0)
#define PL_STEADY(t_, S_) do { const v2u mk_ = mset[S_]; PL_IO(t_, S_); if (MODE == 2) { asm volatile("" :: "v"(mk_.x), "v"(mk_.y)); } \
        PL_QK((t_) + 1, n0, n1); PL_PV((t_) - 1); PL_SOFTMAX(t_, c0, c1, mk_, false); c0 = n0; c1 = n1; __syncthreads(); } while (0)
#define PL_TAIL(t_, S_) do { const v2u mk_ = mset[S_]; PL_IO(t_, S_); if ((t_) >= 1) PL_PV((t_) - 1); PL_SOFTMAX(t_, c0, c1, mk_, MODE == 1); PL_PV(t_); __syncthreads(); } while (0)
    f32x16 c0, c1, n0, n1; v4u pf[2][2];
    PL_LOAD(0, 0); PL_LOAD(1, 1);
    PL_STAGE(0, 0); PL_STAGE(1, 1);
    PL_LOAD(0, 2); PL_LOAD(1, 3);
    __syncthreads();
    PL_QK(0, c0, c1);
    int t = 0;
    if (NTw >= 2) {
        { const v2u mk_ = mset[0]; PL_IO(0, 0); PL_QK(1, n0, n1); PL_SOFTMAX(0, c0, c1, mk_, false); c0 = n0; c1 = n1; __syncthreads(); }
        for (t = 1; t + 1 < NTw; ) {
            PL_STEADY(t, 1); ++t;
            if (t + 1 < NTw) { PL_STEADY(t, 0); ++t; }
        }
    }
    if (t & 1) PL_TAIL(t, 1); else PL_TAIL(t, 0);
    for (++t; t < NT; ++t) { if (t & 1) PL_IO(t, 1); else PL_IO(t, 0); __syncthreads(); }
#undef PL_LOAD
#undef PL_STAGE
#undef PL_QK
#undef PL_PV
#undef PL_SOFTMAX
#undef PL_IO
#undef PL_STEADY
#undef PL_TAIL
    const float l_tot = half_sum(l_run);
    const float inv = 1.0f / l_tot;
    const size_t row = (size_t)(qlo + r);
#pragma unroll
    for (int mt = 0; mt < NMT; ++mt)
#pragma unroll
        for (int g4 = 0; g4 < 4; ++g4) {
            const int d = 32 * mt + 8 * g4 + 4 * hh;
            v2u ow; ow.x = pk2(o[mt][4 * g4] * inv, o[mt][4 * g4 + 1] * inv); ow.y = pk2(o[mt][4 * g4 + 2] * inv, o[mt][4 * g4 + 3] * inv);
            *(v2u*)(Ob + row * PP + d) = ow;
        }
}

__device__ __forceinline__ bf16* gate_row(bf16* G0, bf16* G1, size_t row) { return row < 8192 ? G0 + row * 3072 : G1 + (row - 8192) * 3072; }
struct EpiZG {
    static constexpr bool PERM = true, AFTER_DRAIN = false;
    bf16* P; bf16* G0; bf16* G1;
    __device__ __forceinline__ void operator()(const pg8::f32x4 (&acc)[2][2][4][2], const pg8::Unit& u, int wr, int wc, int fr, int fq) const {
        const int row0 = u.pm * 256 + wr * 64 + fr, cl = wc * 32 + 8 * fq;
        const bool isz = u.pn < 4;
        const int ycol = (u.pn < 2 ? C_YA : C_YB) + (u.pn & 1) * 256, gcol = (u.pn - 4) * 256;
#pragma unroll
        for (int ai = 0; ai < 2; ++ai)
#pragma unroll
            for (int m = 0; m < 4; ++m) { const size_t row = (size_t)(row0 + ai * 128 + m * 16);
#pragma unroll
                for (int bj = 0; bj < 2; ++bj) {
                    const pg8::f32x4 v0 = acc[ai][bj][m][0], v1 = acc[ai][bj][m][1];
                    float rr[8] = {v0[0], v0[1], v0[2], v0[3], v1[0], v1[1], v1[2], v1[3]};
                    if (isz) { bf16* dst = P + row * PP + ycol + cl + bj * 128; const v4u old = *(const v4u*)dst; float yv[8]; UNPACK8(old, yv);
#pragma unroll
                        for (int e = 0; e < 8; ++e) rr[e] = yv[e] * (rr[e] * __builtin_amdgcn_rcpf(1.0f + __expf(-rr[e])));
                        *(v4u*)dst = PACK8(rr); }
                    else { bf16* dst = gate_row(G0, G1, row) + gcol + cl + bj * 128;
#pragma unroll
                        for (int e = 0; e < 8; ++e) rr[e] = __builtin_amdgcn_rcpf(1.0f + __expf(-rr[e]));
                        *(v4u*)dst = PACK8(rr); } } }
    }
};
struct EpiMerge {
    static constexpr bool PERM = true, AFTER_DRAIN = false;
    bf16* Mg; bf16* G0; bf16* G1; int nbr;
    __device__ __forceinline__ void operator()(const pg8::f32x4 (&acc)[2][2][4][2], const pg8::Unit& u, int wr, int wc, int fr, int fq) const {
        const int row0 = u.pm * 256 + wr * 64 + fr, col0 = u.pn * 256 + wc * 32 + 8 * fq;
#pragma unroll
        for (int ai = 0; ai < 2; ++ai)
#pragma unroll
            for (int m = 0; m < 4; ++m) { const size_t row = (size_t)(row0 + ai * 128 + m * 16);
#pragma unroll
                for (int bj = 0; bj < 2; ++bj) { const int col = col0 + bj * 128;
                    const v4u gwd = *(const v4u*)(gate_row(G0, G1, row) + nbr * 1024 + col);
                    float gl[8]; UNPACK8(gwd, gl);
                    const pg8::f32x4 v0 = acc[ai][bj][m][0], v1 = acc[ai][bj][m][1];
                    float rr[8] = {v0[0], v0[1], v0[2], v0[3], v1[0], v1[1], v1[2], v1[3]};
#pragma unroll
                    for (int e = 0; e < 8; ++e) rr[e] *= gl[e];
                    bf16* dst = Mg + row * 1024 + col;
                    if (nbr > 0) { const v4u old = *(const v4u*)dst; float ol[8]; UNPACK8(old, ol);
#pragma unroll
                        for (int e = 0; e < 8; ++e) rr[e] += ol[e]; }
                    *(v4u*)dst = PACK8(rr); } }
    }
};
struct EpiOut {
    static constexpr bool PERM = true, AFTER_DRAIN = false;
    const float* X; float* Out;
    __device__ __forceinline__ void operator()(const pg8::f32x4 (&acc)[2][2][4][2], const pg8::Unit& u, int wr, int wc, int fr, int fq) const {
        const int row0 = u.pm * 256 + wr * 64 + fr, col0 = u.pn * 256 + wc * 32 + 8 * fq;
#pragma unroll
        for (int ai = 0; ai < 2; ++ai)
#pragma unroll
            for (int m = 0; m < 4; ++m) { const size_t row = (size_t)(row0 + ai * 128 + m * 16);
#pragma unroll
                for (int bj = 0; bj < 2; ++bj) { const size_t p = row * 1024 + col0 + bj * 128;
                    const f32x4 x0 = *(const f32x4*)(X + p), x1 = *(const f32x4*)(X + p + 4);
                    const pg8::f32x4 a0 = acc[ai][bj][m][0], a1 = acc[ai][bj][m][1];
                    *(f32x4*)(Out + p) = (f32x4){x0[0] + a0[0], x0[1] + a0[1], x0[2] + a0[2], x0[3] + a0[3]};
                    *(f32x4*)(Out + p + 4) = (f32x4){x1[0] + a1[0], x1[1] + a1[1], x1[2] + a1[2], x1[3] + a1[3]}; } }
    }
};

#define XB_TMO      128
#define XB_XCNT(j)  (256  + 64 * (j))
#define XB_XSUB(j)  (1280 + 64 * (j))
#define XB_XGEN(j)  (2304 + 64 * (j))
#define XB_TOP      3328
#define XB_TOPGEN   3392
#define XCD_BAR_WORDS 3456
#define XB_SPIN_CAP (1u << 18)

__device__ __forceinline__ unsigned xb_ld(unsigned* p)              { return __hip_atomic_load(p, __ATOMIC_RELAXED, __HIP_MEMORY_SCOPE_AGENT); }
__device__ __forceinline__ unsigned xb_add(unsigned* p, unsigned v) { return __hip_atomic_fetch_add(p, v, __ATOMIC_RELAXED, __HIP_MEMORY_SCOPE_AGENT); }
__device__ __forceinline__ unsigned xb_xcc_id() { return (unsigned)__builtin_amdgcn_s_getreg((3 << 11) | 20) & 0xFu; }
#define XB_SPIN(cond, bar) do { unsigned _sp = 0; while (cond) { __builtin_amdgcn_s_sleep(1); \
    if ((++_sp & 255u) == 0u) { if (xb_ld(&(bar)[XB_TMO])) break; if (_sp > XB_SPIN_CAP) { atomicAdd(&(bar)[XB_TMO], 1u); break; } } } } while (0)

struct XcdBarrier {
    unsigned* bar; unsigned x;
    volatile LAS unsigned* st;
};

__device__ __forceinline__ XcdBarrier xcd_barrier_post(unsigned* bar, volatile LAS unsigned* st) {
    XcdBarrier b; b.bar = bar; b.x = xb_xcc_id(); b.st = st;
    if (threadIdx.x == 0) (void)xb_add(&bar[XB_XCNT(b.x)], 1u);
    return b;
}
__device__ __forceinline__ void xcd_barrier_complete(unsigned* bar, unsigned x, unsigned& nloc, unsigned& nx) {
    const unsigned G = gridDim.x * gridDim.y * gridDim.z;
    unsigned sum, cnt, mine, sp = 0u;
    for (;;) {
        sum = 0u; cnt = 0u; mine = 0u;
#pragma unroll
        for (unsigned j = 0; j < 16; ++j) { const unsigned c = xb_ld(&bar[XB_XCNT(j)]); sum += c; cnt += (c > 0u) ? 1u : 0u; mine = (j == x) ? c : mine; }
        if (sum == G) break;
        __builtin_amdgcn_s_sleep(1);
        if ((++sp & 255u) == 0u) { if (xb_ld(&bar[XB_TMO])) break; if (sp > XB_SPIN_CAP) { atomicAdd(&bar[XB_TMO], 1u); break; } }
    }
    nloc = mine > 0u ? mine : 1u; nx = cnt > 0u ? cnt : 1u;
}

__device__ __forceinline__ void xcd_barrier(const XcdBarrier& b) {
    asm volatile("s_waitcnt vmcnt(0)" ::: "memory");
    __syncthreads();
    if (threadIdx.x == 0) {
        unsigned* bar = b.bar;
        __builtin_amdgcn_s_waitcnt(0);
        unsigned nloc = b.st[0], nx = b.st[1];
        if (nloc == 0u) { xcd_barrier_complete(bar, b.x, nloc, nx); b.st[0] = nloc; b.st[1] = nx; }
        const unsigned old = xb_add(&bar[XB_XSUB(b.x)], 1u);
        const unsigned gen = old / nloc;
        if (old + 1u == (gen + 1u) * nloc) {
            __builtin_amdgcn_fence(__ATOMIC_RELEASE, "agent");
            asm volatile("s_waitcnt vmcnt(0)" ::: "memory");
            const unsigned og = xb_add(&bar[XB_TOP], 1u);
            const unsigned tg = og / nx;
            if (og + 1u == (tg + 1u) * nx) xb_add(&bar[XB_TOPGEN], 1u);
            else XB_SPIN(xb_ld(&bar[XB_TOPGEN]) == tg, bar);
            __builtin_amdgcn_fence(__ATOMIC_ACQUIRE, "agent");
            xb_add(&bar[XB_XGEN(b.x)], 1u);
            asm volatile("s_waitcnt vmcnt(0)" ::: "memory");
        } else {
            XB_SPIN(xb_ld(&bar[XB_XGEN(b.x)]) == gen, bar);
            __builtin_amdgcn_fence(__ATOMIC_ACQUIRE, "agent");
            asm volatile("s_waitcnt vmcnt(0)" ::: "memory");
        }
    }
    __syncthreads();
}

template <int DQK, int DV, int MODE>
__device__ __forceinline__ void att_call(bool strip, LAS unsigned char* lds, const bf16* Qb, int qpitch, const bf16* Kb, int kpitch, const bf16* VTb, int skv, const unsigned* maskb, const bf16* Zb, bf16* Ob, int q0) {
    if (ATT_STRIP != 0 && strip) attn_unit<DQK, DV, MODE, ATT_STRIP>(lds, Qb, qpitch, Kb, kpitch, VTb, skv, maskb, Zb, Ob, q0);
    else attn_unit<DQK, DV, MODE, 0>(lds, Qb, qpitch, Kb, kpitch, VTb, skv, maskb, Zb, Ob, q0);
}
struct Args { const float* in[19]; const int* pos; float* out; unsigned char* ws; };
typedef const __attribute__((address_space(4))) Args* kargs_t;
#define PHASE_BEGIN \
    kargs_t ap_ = (kargs_t)__builtin_amdgcn_kernarg_segment_ptr(); asm volatile("" : "+s"(ap_)); \
    int tid = threadIdx.x; asm volatile("" : "+v"(tid)); \
    const int lane = tid & 63, wave = __builtin_amdgcn_readfirstlane(tid >> 6), G = gridDim.x, NGW = G * 8, gw = blockIdx.x * 8 + wave; \
    unsigned char* const ws = ap_->ws; unsigned char* const dob = (unsigned char*)ap_->out; const int* const pos = ap_->pos; float* const outp = ap_->out; unsigned* const ctl = (unsigned*)(ws + WS_CTL); \
    const float* const x = ap_->in[0]; const float* const mem = ap_->in[1]; \
    const float* const g_norm = ap_->in[3]; const float* const w_in = ap_->in[4]; const float* const g_qn_a = ap_->in[5]; const float* const g_kn_a = ap_->in[6]; \
    const float* const g_cq = ap_->in[7]; const float* const g_ckv = ap_->in[8]; const float* const w_uq = ap_->in[9]; const float* const w_ukv = ap_->in[10]; \
    const float* const g_qn_b = ap_->in[11]; const float* const g_kn_b = ap_->in[12]; const float* const g_mem = ap_->in[13]; const float* const w_mem_kv = ap_->in[14]; \
    const float* const g_qn_m = ap_->in[15]; const float* const g_kn_m = ap_->in[16]; const float* const w_branch = ap_->in[17]; const float* const w_out = ap_->in[18]; \
    bf16* const WinT = (bf16*)(ws + WS_WIN); bf16* const WuqT = (bf16*)(ws + WS_WUQ); bf16* const WukvT = (bf16*)(ws + WS_WUKV); bf16* const WmemT = (bf16*)(ws + WS_WMEM); \
    bf16* const WbrT = (bf16*)(ws + WS_WBR); bf16* const WoutT = (bf16*)(ws + WS_WOUT); \
    float* const ropeA = (float*)(ws + WS_ROPEA); float* const ropeB = (float*)(ws + WS_ROPEB); \
    bf16* const MN = (bf16*)(ws + WS_MN); bf16* const KVM = (bf16*)(ws + WS_KVM); bf16* const VTM = (bf16*)(ws + WS_VTM); \
    float* const WI = (float*)(ws + WS_WI); unsigned* const MASK = (unsigned*)(ws + WS_MASK); \
    bf16* const VTA = (bf16*)(dob + DO_VTA); bf16* const VTB = (bf16*)(dob + DO_VTB); bf16* const KB = (bf16*)(dob + DO_KB); \
    bf16* const Hh = (bf16*)(ws + WS_H); bf16* const MG = (bf16*)(ws + WS_H); bf16* const QB = (bf16*)(ws + WS_QB); \
    bf16* const KVB = (bf16*)(ws + WS_KVB); bf16* const GT0 = (bf16*)(dob + DO_G0); bf16* const GT1 = (bf16*)(ws + WS_G1); bf16* const P = (bf16*)(ws + WS_P); \
    (void)lane; (void)NGW; (void)gw; (void)ctl; \
    (void)pos; (void)outp; (void)x; (void)mem; (void)g_norm; (void)w_in; (void)g_qn_a; (void)g_kn_a; (void)g_cq; (void)g_ckv; (void)w_uq; (void)w_ukv; (void)g_qn_b; (void)g_kn_b; (void)g_mem; (void)w_mem_kv; \
    (void)g_qn_m; (void)g_kn_m; (void)w_branch; (void)w_out; (void)WinT; (void)WuqT; (void)WukvT; (void)WmemT; (void)WbrT; (void)WoutT; (void)ropeA; (void)ropeB; (void)MN; (void)KVM; (void)VTM; (void)WI; (void)MASK; \
    (void)VTA; (void)VTB; (void)Hh; (void)KB; (void)QB; (void)KVB; (void)MG; (void)GT0; (void)GT1; (void)P
#define GRID_BARRIER() do { kargs_t bp_ = (kargs_t)__builtin_amdgcn_kernarg_segment_ptr(); asm volatile("" : "+s"(bp_)); \
    XcdBarrier b_; b_.bar = (unsigned*)(bp_->ws + WS_CTL) + 4096; b_.x = xb_xcc_id(); b_.st = (volatile LAS unsigned*)(lds + LDS_BYTES - 32); xcd_barrier(b_); } while (0)

__global__ void __launch_bounds__(512, 2) fwd_kernel(Args a) {
    extern __shared__ __attribute__((aligned(16))) unsigned char lds_raw[];
    LAS unsigned char* const lds = (LAS unsigned char*)lds_raw;
    volatile LAS int* const slot = (volatile LAS int*)(lds + LDS_SLOT);
    if (threadIdx.x < 16) ((LAS unsigned*)(lds + LDS_BYTES - 64))[threadIdx.x] = 0u;
    __syncthreads();
    (void)xcd_barrier_post((unsigned*)(a.ws + WS_CTL) + 4096, (volatile LAS unsigned*)(lds + LDS_BYTES - 32));

    for (int rep = 0; rep < REP_P0; ++rep) { PHASE_BEGIN;
        LAS float* scr = (LAS float*)(lds + wave * 16384);
        constexpr int I_IN = 16 * (NP / 32), I_UQ = 6 * 24, I_UKV = 4 * 32, I_MEM = 16 * 32, I_BR = 8 * 32, I_OUT = 16 * 32;
        constexpr int NITEMS = I_IN + I_UQ + I_UKV + I_MEM + 3 * I_BR + I_OUT;
        for (int it = gw; it < NITEMS; it += NGW) {
            int r = it;
            if (r < I_IN) { transpose_item<true>(w_in, 1024, DIN, NP, WinT, scr, r, lane); continue; } r -= I_IN;
            if (r < I_UQ) { transpose_item<false>(w_uq, 384, 768, 768, WuqT, scr, r, lane); continue; } r -= I_UQ;
            if (r < I_UKV) { transpose_item<false>(w_ukv, 256, 1024, 1024, WukvT, scr, r, lane); continue; } r -= I_UKV;
            if (r < I_MEM) { transpose_item<false>(w_mem_kv, 1024, 1024, 1024, WmemT, scr, r, lane); continue; } r -= I_MEM;
            if (r < 3 * I_BR) { const int nb = r / I_BR; transpose_item<false>(w_branch + (size_t)nb * 512 * 1024, 512, 1024, 1024, WbrT + (size_t)nb * 1024 * 512, scr, r % I_BR, lane); continue; } r -= 3 * I_BR;
            transpose_item<false>(w_out, 1024, 1024, 1024, WoutT, scr, r, lane);
        }
        for (int idx = blockIdx.x * 512 + tid; idx < TT * 24; idx += G * 512) {
            const int t = idx / 24, i = idx % 24; const float pf = (float)pos[t];
            if (i < 8) { const float ang = pf * INVA[i]; ropeA[t * 16 + i] = cosf(ang); ropeA[t * 16 + 8 + i] = sinf(ang); }
            else { const int j = i - 8; const float ang = pf * INVB[j]; ropeB[t * 32 + j] = cosf(ang); ropeB[t * 32 + 16 + j] = sinf(ang); }
        }
        for (int m = gw; m < NB * MEML; m += NGW) rms_row_1024(mem + (size_t)m * DM, g_mem, MN + (size_t)m * DM, lane);
        for (int rp = 0; rp < REP_PH; ++rp)
        for (int m = gw; m < TT; m += NGW) rms_row_1024(x + (size_t)m * DM, g_norm, Hh + (size_t)m * DM, lane);
    }
    GRID_BARRIER();
    for (int es = 0; es < EXTRA_SYNCS; ++es) GRID_BARRIER();

    for (int rep = 0; rep < REP_G1; ++rep) { PHASE_BEGIN;
        pg8::Gemm g{Hh, WinT, TT, PP, 1024, 1024}; pg8::StaticOrder S; S.init(TT, PP, G, (int)blockIdx.x);
        pg8::EpiBf16<0> E{P, PP, nullptr, 0, 0, 1.f};
        pg8::gemm_phase<pg8::EpiBf16<0>, pg8::StaticOrder, true, true>(lds, g, S, E);
    }
    { PHASE_BEGIN;
        pg8::Gemm g{MN, WmemT, NB * MEML, 1024, 1024, 1024}; pg8::StaticOrder S; S.init(NB * MEML, 1024, G, (int)((blockIdx.x + 64) % G));
        pg8::EpiBf16<0> E{KVM, 1024, nullptr, 0, 0, 1.f};
        pg8::gemm_phase<pg8::EpiBf16<0>, pg8::StaticOrder, true, true>(lds, g, S, E);
    }
    GRID_BARRIER();
    { PHASE_BEGIN;
        float ga[8], gk[8], gq[8], gc[8], gm[8];
#pragma unroll
        for (int j = 0; j < 8; ++j) { ga[j] = g_qn_a[8 * (lane & 7) + j]; gk[j] = g_kn_a[8 * (lane & 7) + j]; gm[j] = g_qn_m[8 * (lane & 15) + j]; gq[j] = lane < 48 ? g_cq[8 * lane + j] : 0.f; gc[j] = lane < 32 ? g_ckv[8 * lane + j] : 0.f; }
        for (int dp = 0; dp < DUMMY_POST1; ++dp)
            for (int m = gw; m < TT; m += NGW)
                post1_row(P + (size_t)m * PP, QB + (size_t)(m & 1023) * 4096, ropeA + (size_t)m * 16, ga, gk, gq, gc, gm, (float*)KVB + (size_t)m * 8, lane);
        for (int m = gw; m < TT; m += NGW)
            post1_row(P + (size_t)m * PP, P + (size_t)m * PP, ropeA + (size_t)m * 16, ga, gk, gq, gc, gm, WI + (size_t)m * 8, lane);
        for (int rt = 0; rt < REP_TR; ++rt)
        transpose_v(P, PP, C_VA, 64, 8, 64, SEQ, NB, VTA, gw, NGW, lane);
        for (int m = gw; m < NB * MEML; m += NGW) km_row(KVM + (size_t)m * 1024, g_kn_m, lane);
        for (int rt = 0; rt < REP_TR; ++rt)
        transpose_v(KVM, 1024, 512, 128, 4, 128, MEML, NB, VTM, gw, NGW, lane);
    }
    GRID_BARRIER();
    for (int rep = 0; rep < REP_G2; ++rep) { PHASE_BEGIN;
        pg8::Gemm g{P + C_CQ, WuqT, TT, 768, 384, PP}; pg8::StaticOrder S; S.init(TT, 768, G, (int)blockIdx.x);
        pg8::EpiBf16<0> E{QB, 768, nullptr, 0, 0, 1.f};
        pg8::gemm_phase<pg8::EpiBf16<0>, pg8::StaticOrder, true, true>(lds, g, S, E);
    }
    for (int rep = 0; rep < REP_G2; ++rep) { PHASE_BEGIN;
        pg8::Gemm g{P + C_CKV, WukvT, TT, 1024, 256, PP}; pg8::StaticOrder S; S.init(TT, 1024, G, (int)((blockIdx.x + 192) % G));
        pg8::EpiBf16<0> E{KVB, 1024, nullptr, 0, 0, 1.f};
        pg8::gemm_phase<pg8::EpiBf16<0>, pg8::StaticOrder, true, true>(lds, g, S, E);
    }
    for (int rep = 0; rep < REP_IDX; ++rep) { if (rep > 0) GRID_BARRIER();
        PHASE_BEGIN;
        unsigned* const q_idx = ctl + 64 * (0 + 4 * rep);
        for (;;) {
            const int u = next_unit(q_idx, slot);
            if (u >= NB * 128) break;
            const int tb = 127 - (u >> 3), bb = u & 7;
            indexer_unit((LAS float*)lds, P, WI, MASK, bb, tb);
        }
    }
    GRID_BARRIER();
    { PHASE_BEGIN;
        LAS float* scr = (LAS float*)(lds + wave * 8192);
        float gqv[12], gkv[12];
#pragma unroll
        for (int e = 0; e < 12; ++e) { gqv[e] = g_qn_b[12 * (lane & 7) + e]; gkv[e] = g_kn_b[12 * (lane & 7) + e]; }
        for (int dp = 0; dp < DUMMY_POST2; ++dp)
            for (int m = gw; m < TT; m += NGW)
                post2_row(QB + (size_t)m * 768, (bf16*)MASK + (size_t)(m & 1023) * 768, KVB + (size_t)m * 1024, P + (size_t)m * PP, (bf16*)MASK + (size_t)(1024 + (m & 1023)) * 768, ropeB + (size_t)m * 32, gqv, gkv, scr, lane);
        for (int m = gw; m < TT; m += NGW)
            post2_row(QB + (size_t)m * 768, QB + (size_t)m * 768, KVB + (size_t)m * 1024, P + (size_t)m * PP, KB + (size_t)m * 768, ropeB + (size_t)m * 32, gqv, gkv, scr, lane);
        for (int rt = 0; rt < REP_TR; ++rt)
        transpose_v(KVB, 1024, 64, 128, 8, 64, SEQ, NB, VTB, gw, NGW, lane);
    }
    GRID_BARRIER();
    for (int rep = 0; rep < REP_ATT; ++rep) { if (rep > 0) GRID_BARRIER();
        PHASE_BEGIN;
        unsigned* const q_att = ctl + 64 * (1 + 4 * rep);
        for (;;) {
            const int u = next_unit(q_att, slot);
            if (u >= 1280) break;
            if (u < 1024) {
                const int qb = 7 - (u >> 7), wi = u & 127, bh = wi & 63, bb = bh >> 3, h = bh & 7;
                const size_t r0 = (size_t)bb * SEQ;
                if (wi < 64) attn_unit_pipe<96, 1>(lds, QB + r0 * 768 + h * 96, 768, KB + r0 * 768 + h * 96, 768, VTB + (size_t)((bb * 8 + h) * 64) * SEQ, SEQ, nullptr,
                                                   P + r0 * PP + C_YB + h * 64, qb * 256);
                else attn_unit_pipe<64, 2>(lds, P + r0 * PP + C_QA + h * 64, PP, P + r0 * PP + C_KA + h * 64, PP, VTA + (size_t)((bb * 8 + h) * 64) * SEQ, SEQ, MASK + r0 * 64,
                                           P + r0 * PP + C_YA + h * 64, qb * 256);
            } else {
                const int v = u - 1024, qb = v & 7, bh = v >> 3, bb = bh >> 2, h = bh & 3;
                const size_t r0 = (size_t)bb * SEQ;
                att_call<128, 128, 0>(rep == 0 && REP_ATT > 1, lds, P + r0 * PP + C_QM + h * 128, PP, KVM + (size_t)bb * MEML * 1024 + h * 128, 1024, VTM + (size_t)((bb * 4 + h) * 128) * MEML, MEML, nullptr,
                                       P + r0 * PP + C_ZM + h * 128, P + r0 * PP + C_YM + h * 128, qb * 256);
            }
        }
    }
    GRID_BARRIER();
    for (int rep = 0; rep < 1; ++rep) { PHASE_BEGIN;
        pg8::Gemm g{Hh, WinT + (size_t)PP * 1024, TT, NZG, 1024, 1024}; pg8::StaticOrder S; S.init(TT, NZG, G, (int)blockIdx.x);
        EpiZG E{P, GT0, GT1};
        pg8::gemm_phase<EpiZG, pg8::StaticOrder, true, true>(lds, g, S, E);
    }
    GRID_BARRIER();
    for (int nbr = 0; nbr < 3 * REP_G4; ++nbr) { const int nb = nbr % 3; PHASE_BEGIN;
        pg8::Gemm g{P + (nb == 0 ? C_YA : (nb == 1 ? C_YB : C_YM)), WbrT + (size_t)nb * 1024 * 512, TT, 1024, 512, PP}; pg8::StaticOrder S; S.init(TT, 1024, G, (int)blockIdx.x);
        EpiMerge E{MG, GT0, GT1, nb};
        pg8::gemm_phase<EpiMerge, pg8::StaticOrder, true, true>(lds, g, S, E);
    }
    GRID_BARRIER();
    for (int rep = 0; rep < REP_G5; ++rep) { PHASE_BEGIN;
        pg8::Gemm g{MG, WoutT, TT, 1024, 1024, 1024}; pg8::StaticOrder S; S.init(TT, 1024, G, (int)blockIdx.x);
        EpiOut E{x, outp};
        pg8::gemm_phase<EpiOut, pg8::StaticOrder, true, true>(lds, g, S, E);
    }
}

extern "C" void kernel_launch(void* const* d_in, const int* in_sizes, int n_in, void* d_out, int out_size, void* d_ws, size_t ws_size, hipStream_t stream) {
    static int grid = 0;
    if (grid == 0) {
        if (n_in != 19 || out_size != TT * DM || ws_size < WS_END) { fprintf(stderr, "kernel_launch: unexpected problem (n_in %d, out %d, ws %zu); nothing launched\n", n_in, out_size, ws_size); grid = -1; return; }
        int dev = 0, cus = 0, per_cu = 0;
        if (hipGetDevice(&dev) != hipSuccess || hipDeviceGetAttribute(&cus, hipDeviceAttributeMultiprocessorCount, dev) != hipSuccess) { grid = -1; return; }
        if (hipFuncSetAttribute((const void*)fwd_kernel, hipFuncAttributeMaxDynamicSharedMemorySize, LDS_BYTES) != hipSuccess) { fprintf(stderr, "kernel_launch: hipFuncSetAttribute failed\n"); grid = -1; return; }
        if (hipOccupancyMaxActiveBlocksPerMultiprocessor(&per_cu, (const void*)fwd_kernel, 512, LDS_BYTES) != hipSuccess || per_cu < 1) { fprintf(stderr, "kernel_launch: occupancy query reports %d blocks per CU\n", per_cu); (void)hipGetLastError(); grid = -1; return; }
        grid = cus;
    }
    if (grid < 0) return;
    (void)hipMemsetAsync((char*)d_ws + WS_CTL, 0, 65536, stream);
    Args a{};
    for (int i = 0; i < 19; ++i) a.in[i] = (const float*)d_in[i];
    a.pos = (const int*)d_in[2]; a.out = (float*)d_out; a.ws = (unsigned char*)d_ws;
    hipLaunchKernelGGL(fwd_kernel, dim3(grid), dim3(512), LDS_BYTES, stream, a);
    const hipError_t e = hipPeekAtLastError();
    if (e != hipSuccess) fprintf(stderr, "kernel_launch: launch failed: %s (grid %d)\n", hipGetErrorString(e), grid);
}
```

```cpp
#include <hip/hip_runtime.h>
#include <cstdio>
#include <cstdint>
namespace pg8 {
#define PG8_LAS __attribute__((address_space(3)))
typedef unsigned short bf16_t;
typedef short bf16x8 __attribute__((ext_vector_type(8)));
typedef float f32x4 __attribute__((ext_vector_type(4)));
typedef unsigned u32x4 __attribute__((ext_vector_type(4)));
constexpr int BM = 256, BK = 64, HALF = 128, HTB = HALF * BK * 2  , STAGE_BYTES = 8 * HTB, NXCD = 8, WGM = 8;

__host__ __device__ __forceinline__ int lds_byte(int r, int c) { const int st = (r >> 4) * 2 + (c >> 5), rr = r & 15, cc = c & 31, ob = rr * 64 + cc * 2; return st * 1024 + (ob ^ (((ob >> 9) & 1) << 5)); }
__host__ __device__ __forceinline__ void stage_rc(int b, int& R, int& C) { const int st = b / 1024, sb = b % 1024, swz = sb ^ (((sb >> 9) & 1) << 5); R = (st >> 1) * 16 + swz / 64; C = (st & 1) * 32 + (swz % 64) / 2; }
__host__ __device__ __forceinline__ int perm32(int rho) { const int n = rho >> 4, i = rho & 15; return 8 * (i >> 2) + 4 * n + (i & 3); }

struct Unit { int pm, pn; };
struct Gemm { const bf16_t* A; const bf16_t* Bt; int M, N, K, lda; };

struct StaticOrder {
    int nM, nN, nwg, G, c;
    __host__ __device__ void init(int M, int N, int G_, int c_) { nM = M / BM; nN = N / BM; nwg = nM * nN; G = G_; c = c_; }
    __host__ __device__ bool next(int i, Unit& u) const {
        const long L = (long)i * G + c; if (L >= nwg) return false;
        int wgid = (int)L; { const int q = nwg / NXCD, r = nwg % NXCD, xcd = wgid % NXCD, off = wgid / NXCD; wgid = (xcd < r ? xcd * (q + 1) : r * (q + 1) + (xcd - r) * q) + off; }
        const int nig = WGM * nN, gid = wgid / nig, fm = gid * WGM, gsz = (nM - fm) < WGM ? (nM - fm) : WGM;
        u.pm = fm + ((wgid % nig) % gsz); u.pn = (wgid % nig) / gsz; return true;
    }
    __device__ __forceinline__ void a_ready(const Unit&) const {}
    __device__ __forceinline__ void done(const Unit&) const {}
};

__device__ __forceinline__ unsigned cvt_pk_bf16(float lo, float hi) { unsigned r; asm volatile("v_cvt_pk_bf16_f32 %0, %1, %2" : "=v"(r) : "v"(lo), "v"(hi)); return r; }
typedef float f32x2 __attribute__((ext_vector_type(2)));
__device__ __forceinline__ f32x2 gelu_pk(f32x2 v) {
    const f32x2 av = __builtin_elementwise_abs(v), d = av * 0.2316418882f + 1.0f;
    f32x2 t; t.x = __builtin_amdgcn_rcpf(d.x); t.y = __builtin_amdgcn_rcpf(d.y);
    f32x2 q = t * 0.5307027145f + (-0.7265760135f); q = q * t + 0.7107068705f; q = q * t + (-0.142248368f); q = q * t + 0.127414796f; q = q * t;
    const f32x2 s = (v * v) * (-0.72134752044f);
    f32x2 e; e.x = __builtin_amdgcn_exp2f(s.x); e.y = __builtin_amdgcn_exp2f(s.y);
    const f32x2 m = v * (q * e), r = v - m;
    f32x2 o; o.x = v.x < 0.f ? m.x : r.x; o.y = v.y < 0.f ? m.y : r.y; return o;
}

template <int ACT  > struct EpiBf16 {
    static constexpr bool PERM = true, AFTER_DRAIN = false; static_assert(ACT == 0 || ACT == 1, "EpiBf16: ACT is 0 (none) or 1 (gelu_pk)");
    bf16_t* O; int ldc; const float* bias; int split_cols; size_t split_stride; float scale0;
    __device__ __forceinline__ void operator()(const f32x4 (&acc)[2][2][4][2], const Unit& u, int wr, int wc, int fr, int fq) const {
        const int row0 = u.pm * BM + wr * 64 + fr; int colt = u.pn * BM; bf16_t* base = O;
        float sc = 1.f; if (split_cols) { const int t = colt / split_cols; base += (size_t)t * split_stride; colt -= t * split_cols; if (t == 0) sc = scale0; }
        const int col0 = colt + wc * 32 + 8 * fq, bcol0 = u.pn * BM + wc * 32 + 8 * fq;
        f32x4 bv[2][2];
#pragma unroll
        for (int bj = 0; bj < 2; ++bj)
#pragma unroll
            for (int n = 0; n < 2; ++n) bv[bj][n] = bias ? *(const f32x4*)(bias + bcol0 + bj * HALF + 4 * n) : (f32x4){0.f, 0.f, 0.f, 0.f};
#pragma unroll
        for (int ai = 0; ai < 2; ++ai)
#pragma unroll
            for (int m = 0; m < 4; ++m) { bf16_t* rowp = base + (size_t)(row0 + ai * HALF + m * 16) * ldc + col0;
#pragma unroll
                for (int bj = 0; bj < 2; ++bj) { f32x4 v0 = acc[ai][bj][m][0] + bv[bj][0], v1 = acc[ai][bj][m][1] + bv[bj][1];
                    if (ACT == 1) { f32x2 a = gelu_pk((f32x2){v0[0], v0[1]}), b = gelu_pk((f32x2){v0[2], v0[3]}), c = gelu_pk((f32x2){v1[0], v1[1]}), d = gelu_pk((f32x2){v1[2], v1[3]});
                        v0 = (f32x4){a.x, a.y, b.x, b.y}; v1 = (f32x4){c.x, c.y, d.x, d.y}; }
                    v0 = v0 * sc; v1 = v1 * sc; u32x4 w; w.x = cvt_pk_bf16(v0[0], v0[1]); w.y = cvt_pk_bf16(v0[2], v0[3]); w.z = cvt_pk_bf16(v1[0], v1[1]); w.w = cvt_pk_bf16(v1[2], v1[3]);
                    *(u32x4*)(rowp + bj * HALF) = w; } }
    }
};
template <class Epi, class Sched, bool ALIGN_EPI = false, bool SP2 = false>
__device__ __forceinline__ void gemm_phase(PG8_LAS unsigned char* lds, const Gemm g, const Sched& S, const Epi& E) {
    int tid_ = threadIdx.x; asm volatile("" : "+v"(tid_));
    const int tid = tid_, wid = __builtin_amdgcn_readfirstlane(tid >> 6), lane = tid & 63, wr = wid >> 2, wc = wid & 3, fr = lane & 15, fq = lane >> 4;
    const int K = g.K, nt = K / BK;
    unsigned voffA[2], voffB[2];
#pragma unroll
    for (int i = 0; i < 2; ++i) { int R, C; stage_rc(tid * 16 + i * 8192, R, C); const int Rb = Epi::PERM ? ((R & ~31) + perm32(R & 31)) : R;
        voffA[i] = (unsigned)(R * g.lda + C) * 2u; voffB[i] = (unsigned)(Rb * K + C) * 2u; }
    const size_t kstep = (size_t)(BK * 2);
    const size_t hstepA = (size_t)HALF * g.lda * 2, hstepB = (size_t)HALF * K * 2;
    const size_t tstepA = 2 * hstepA, tstepB = 2 * hstepB;
    const unsigned ldsw = (unsigned)wid * 1024u;
    const int aoff = lds_byte(wr * 64 + fr, fq * 8), boff = lds_byte(wc * 32 + fr, fq * 8);
#define PG8_SA(b, h) (((b) * 2 + (h)) * HTB)
#define PG8_SB(b, h) ((4 + (b) * 2 + (h)) * HTB)
#define PG8_STAGE(bufoff, gbase, voff) do { _Pragma("unroll") for (int _i = 0; _i < 2; ++_i) \
        __builtin_amdgcn_global_load_lds((const unsigned*)((const char*)(gbase) + (voff)[_i]), (PG8_LAS unsigned*)(lds + (bufoff) + ldsw + _i * 8192), 16, 0, 0); } while (0)
#define PG8_LDA(dst, b, h) do { _Pragma("unroll") for (int m = 0; m < 4; ++m) _Pragma("unroll") for (int k = 0; k < 2; ++k) dst[m][k] = *(const PG8_LAS bf16x8*)(lds + PG8_SA(b, h) + aoff + m * 2048 + k * 1024); } while (0)
#define PG8_LDB(dst, b, h) do { _Pragma("unroll") for (int n = 0; n < 2; ++n) _Pragma("unroll") for (int k = 0; k < 2; ++k) dst[n][k] = *(const PG8_LAS bf16x8*)(lds + PG8_SB(b, h) + boff + n * 2048 + k * 1024); } while (0)
#define PG8_MMA(ai, bj, At, Bt) do { __builtin_amdgcn_s_setprio(1); _Pragma("unroll") for (int m = 0; m < 4; ++m) _Pragma("unroll") for (int n = 0; n < 2; ++n) _Pragma("unroll") for (int k = 0; k < 2; ++k) \
        acc[ai][bj][m][n] = __builtin_amdgcn_mfma_f32_16x16x32_bf16(Bt[n][k], At[m][k], acc[ai][bj][m][n], 0, 0, 0); __builtin_amdgcn_s_setprio(0); } while (0)
#define PG8_WAIT_V(n) asm volatile("s_waitcnt vmcnt(" #n ")" ::: "memory")
#define PG8_WAIT_L(n) asm volatile("s_waitcnt lgkmcnt(" #n ")" ::: "memory")
#define PG8_BAR __builtin_amdgcn_s_barrier()
#define PG8_SCHED __builtin_amdgcn_sched_barrier(0)
    Unit cur, nxt; int ui = 0;
    if (!S.next(0, cur)) return;
    f32x4 acc[2][2][4][2];
#pragma unroll
    for (int a = 0; a < 2; ++a)
#pragma unroll
        for (int b = 0; b < 2; ++b)
#pragma unroll
            for (int m = 0; m < 4; ++m)
#pragma unroll
                for (int n = 0; n < 2; ++n) acc[a][b][m][n] = (f32x4){0.f, 0.f, 0.f, 0.f};
    bf16x8 At[4][2], B0[2][2], B1[2][2];
    const char* cA = (const char*)g.A + (size_t)cur.pm * tstepA; const char* cB = (const char*)g.Bt + (size_t)cur.pn * tstepB;
    S.a_ready(cur);
    if constexpr (SP2) {
        PG8_STAGE(PG8_SB(0, 0), cB, voffB); PG8_STAGE(PG8_SB(0, 1), cB + hstepB, voffB); PG8_STAGE(PG8_SA(0, 0), cA, voffA); PG8_STAGE(PG8_SA(0, 1), cA + hstepA, voffA);
        if (wr == 1) PG8_BAR;
        PG8_WAIT_V(2); PG8_BAR;
        PG8_STAGE(PG8_SB(1, 0), cB + kstep, voffB); PG8_STAGE(PG8_SA(1, 0), cA + kstep, voffA); PG8_STAGE(PG8_SB(1, 1), cB + hstepB + kstep, voffB);
        PG8_WAIT_V(6); PG8_BAR;
    } else {
        PG8_STAGE(PG8_SB(0, 0), cB, voffB); PG8_STAGE(PG8_SA(0, 0), cA, voffA); PG8_STAGE(PG8_SB(0, 1), cB + hstepB, voffB); PG8_STAGE(PG8_SA(0, 1), cA + hstepA, voffA);
        if (wr == 1) PG8_BAR;
        PG8_WAIT_V(4); PG8_BAR;
        PG8_STAGE(PG8_SB(1, 0), cB + kstep, voffB); PG8_STAGE(PG8_SA(1, 0), cA + kstep, voffA); PG8_STAGE(PG8_SB(1, 1), cB + hstepB + kstep, voffB);
        PG8_WAIT_V(6); PG8_BAR;
    }
    for (;;) {
        const bool has_next = S.next(ui + 1, nxt);
        const char* nA = has_next ? (const char*)g.A + (size_t)nxt.pm * tstepA : cA; const char* nB = has_next ? (const char*)g.Bt + (size_t)nxt.pn * tstepB : cB;
        for (int t = 0; t < nt; t += 2) {
            const bool last = (t == nt - 2);
            const char* a1 = cA + (size_t)(t + 1) * kstep;
            const char* a2 = last ? nA : cA + (size_t)(t + 2) * kstep; const char* b2 = last ? nB : cB + (size_t)(t + 2) * kstep;
            const char* a3 = a2 + kstep; const char* b3 = b2 + kstep;
            if (last && has_next) S.a_ready(nxt);
            if constexpr (SP2) {
            PG8_LDB(B0, 0, 0); PG8_LDB(B1, 0, 1); PG8_SCHED; PG8_LDA(At, 0, 0); PG8_STAGE(PG8_SA(1, 1), a1 + hstepA, voffA);
            PG8_WAIT_V(8); PG8_WAIT_L(0); PG8_BAR; PG8_MMA(0, 0, At, B0); PG8_MMA(0, 1, At, B1); PG8_BAR; PG8_SCHED;
            PG8_LDA(At, 0, 1); PG8_STAGE(PG8_SB(0, 0), b2, voffB); PG8_STAGE(PG8_SB(0, 1), b2 + hstepB, voffB); PG8_STAGE(PG8_SA(0, 0), a2, voffA);
            PG8_WAIT_V(8); PG8_WAIT_L(0); PG8_BAR; PG8_MMA(1, 0, At, B0); PG8_MMA(1, 1, At, B1); PG8_BAR; PG8_SCHED;
            PG8_LDB(B0, 1, 0); PG8_LDB(B1, 1, 1); PG8_SCHED; PG8_LDA(At, 1, 0); PG8_STAGE(PG8_SA(0, 1), a2 + hstepA, voffA);
            PG8_WAIT_V(8); PG8_WAIT_L(0); PG8_BAR; PG8_MMA(0, 0, At, B0); PG8_MMA(0, 1, At, B1); PG8_BAR; PG8_SCHED;
            PG8_LDA(At, 1, 1); PG8_STAGE(PG8_SB(1, 0), b3, voffB); PG8_STAGE(PG8_SB(1, 1), b3 + hstepB, voffB); PG8_STAGE(PG8_SA(1, 0), a3, voffA);
            PG8_WAIT_V(8); PG8_WAIT_L(0); PG8_BAR; PG8_MMA(1, 0, At, B0); PG8_MMA(1, 1, At, B1); PG8_BAR; PG8_SCHED;
            } else {
            PG8_LDB(B0, 0, 0); PG8_SCHED; PG8_LDA(At, 0, 0); PG8_STAGE(PG8_SA(1, 1), a1 + hstepA, voffA);
            PG8_WAIT_L(8); PG8_BAR; PG8_WAIT_L(0); PG8_MMA(0, 0, At, B0); PG8_BAR; PG8_SCHED;
            PG8_LDB(B1, 0, 1); PG8_STAGE(PG8_SB(0, 0), b2, voffB);
            PG8_BAR; PG8_WAIT_L(0); PG8_MMA(0, 1, At, B1); PG8_BAR;
            PG8_LDA(At, 0, 1); PG8_STAGE(PG8_SA(0, 0), a2, voffA);
            PG8_BAR; PG8_WAIT_L(0); PG8_MMA(1, 0, At, B0); PG8_BAR; PG8_SCHED;
            PG8_STAGE(PG8_SB(0, 1), b2 + hstepB, voffB);
            PG8_WAIT_V(6); PG8_BAR; PG8_MMA(1, 1, At, B1); PG8_BAR;
            PG8_LDB(B0, 1, 0); PG8_SCHED; PG8_LDA(At, 1, 0); PG8_STAGE(PG8_SA(0, 1), a2 + hstepA, voffA);
            PG8_WAIT_L(8); PG8_BAR; PG8_WAIT_L(0); PG8_MMA(0, 0, At, B0); PG8_BAR; PG8_SCHED;
            PG8_LDB(B1, 1, 1); PG8_STAGE(PG8_SB(1, 0), b3, voffB);
            PG8_BAR; PG8_WAIT_L(0); PG8_MMA(0, 1, At, B1); PG8_BAR;
            PG8_LDA(At, 1, 1); PG8_STAGE(PG8_SA(1, 0), a3, voffA);
            PG8_BAR; PG8_WAIT_L(0); PG8_MMA(1, 0, At, B0); PG8_BAR; PG8_SCHED;
            PG8_STAGE(PG8_SB(1, 1), b3 + hstepB, voffB);
            PG8_WAIT_V(6); PG8_BAR; PG8_MMA(1, 1, At, B1); PG8_BAR;
            }
        }
        if constexpr (ALIGN_EPI) { if (wr == 0) PG8_BAR; }
        if constexpr (!Epi::AFTER_DRAIN) { E(acc, cur, wr, wc, fr, fq); S.done(cur); }
        if (!has_next) break;
#pragma unroll
        for (int a = 0; a < 2; ++a)
#pragma unroll
            for (int b = 0; b < 2; ++b)
#pragma unroll
                for (int m = 0; m < 4; ++m)
#pragma unroll
                    for (int n = 0; n < 2; ++n) acc[a][b][m][n] = (f32x4){0.f, 0.f, 0.f, 0.f};
        cur = nxt; cA = nA; cB = nB; ++ui;
        if constexpr (ALIGN_EPI) { if (wr == 1) PG8_BAR; }
    }
    PG8_WAIT_V(0);
    if constexpr (!ALIGN_EPI) { if (wr == 0) PG8_BAR; }
    PG8_BAR;
    if constexpr (Epi::AFTER_DRAIN) { E.fused(acc, cur, wr, wc, fr, fq, lds, wid, lane); S.done(cur); }
#undef PG8_SA
#undef PG8_SB
#undef PG8_STAGE
#undef PG8_LDA
#undef PG8_LDB
#undef PG8_MMA
#undef PG8_WAIT_V
#undef PG8_WAIT_L
#undef PG8_BAR
#undef PG8_SCHED
}
}

#define LAS __attribute__((address_space(3)))
typedef unsigned short bf16;
typedef unsigned v4u __attribute__((ext_vector_type(4)));
typedef unsigned v2u __attribute__((ext_vector_type(2)));
typedef float f32x4 __attribute__((ext_vector_type(4)));
typedef float f32x16 __attribute__((ext_vector_type(16)));
typedef short bf16x8 __attribute__((ext_vector_type(8)));
typedef short s16x4 __attribute__((ext_vector_type(4)));
typedef float f32x2_t __attribute__((ext_vector_type(2)));
typedef __bf16 bf16x2_t __attribute__((ext_vector_type(2)));

constexpr int NB = 8, SEQ = 2048, DM = 1024, TT = NB * SEQ;
constexpr int DIN = 7912, NP = 7936;
constexpr int PP = 3840, NZG = 4096;
constexpr int MEML = 256;
constexpr float EPS = 1e-6f, NEGF = -1e30f;
constexpr int C_QA = 0, C_KA = 512, C_VA = 1024, C_QI = 1536, C_KI = 2048, C_WI = 2112, C_CQ = 2120, C_CKV = 2504, C_KR = 2760, C_QM = 2792, C_ZM = 3304;
constexpr int C_YA = C_QI, C_YB = C_CQ, C_YM = C_VA;
constexpr float SCALE_A = 0.18033688011112042f;
constexpr float SCALE_B = 0.14724444602590306f;
constexpr float SCALE_M = 0.12751743082459868f;
constexpr float SCALE_I = 0.04419417382415922f;

__constant__ float INVA[8] = {1.0f, 0.1939227432012558f, 0.03760603070259094f, 0.007292664609849453f, 0.0014142135623842478f, 0.00027424818836152554f, 5.3182957344688475e-05f, 1.0313385246263351e-05f};
__constant__ float INVB[16] = {1.0f, 0.44036659598350525f, 0.1939227432012558f, 0.08539710193872452f, 0.03760603070259094f, 0.016560440883040428f, 0.007292664609849453f, 0.0032114461064338684f, 0.0014142135623842478f, 0.0006227724370546639f, 0.00027424818836152554f, 0.00012076973507646471f, 5.3182957344688475e-05f, 2.34199997066753e-05f, 1.0313385246263351e-05f, 4.541670477919979e-06f};

constexpr size_t MiB = 1u << 20;
constexpr size_t WS_CTL = 0;
constexpr size_t WS_WIN = 1 * MiB;
constexpr size_t WS_WUQ = 17 * MiB;
constexpr size_t WS_WUKV = 18 * MiB;
constexpr size_t WS_WMEM = 19 * MiB;
constexpr size_t WS_WBR = 21 * MiB;
constexpr size_t WS_WOUT = 24 * MiB;
constexpr size_t WS_ROPEA = 26 * MiB;
constexpr size_t WS_ROPEB = 27 * MiB;
constexpr size_t WS_MN = 29 * MiB;
constexpr size_t WS_KVM = 33 * MiB;
constexpr size_t WS_VTM = 37 * MiB;
constexpr size_t WS_WI = 39 * MiB;
constexpr size_t WS_MASK = 40 * MiB;
constexpr size_t WS_H = 44 * MiB;
constexpr size_t WS_P = 76 * MiB;
constexpr size_t WS_QB = 196 * MiB;
constexpr size_t WS_KVB = 220 * MiB;
constexpr size_t WS_G1 = 196 * MiB;
constexpr size_t WS_END = 256 * MiB;
constexpr size_t DO_VTA = 0;
constexpr size_t DO_VTB = 16 * MiB;
constexpr size_t DO_KB = 32 * MiB;
constexpr size_t DO_G0 = 0;

constexpr int REP_P0 = 1, REP_PH = 1, REP_G1 = 1, REP_G2 = 1, REP_IDX = 1, REP_ATT = 1, REP_G4 = 1, REP_G5 = 1;
constexpr int REP_IDX1 = 1, REP_SEL = 1;
constexpr int ATT_STRIP = 0;
constexpr int EXTRA_SYNCS = 0, REP_TR = 1, DUMMY_POST1 = 0, DUMMY_POST2 = 0;
constexpr int LDS_BYTES = 147456;
constexpr int LDS_SLOT = LDS_BYTES - 64;

__device__ __forceinline__ unsigned pk2(float lo, float hi) { f32x2_t v = {lo, hi}; bf16x2_t b = __builtin_convertvector(v, bf16x2_t); return __builtin_bit_cast(unsigned, b); }
__device__ __forceinline__ float bflo(unsigned w) { return __uint_as_float(w << 16); }
__device__ __forceinline__ float bfhi(unsigned w) { return __uint_as_float(w & 0xffff0000u); }
__device__ __forceinline__ float bf1(bf16 b) { return __uint_as_float(((unsigned)b) << 16); }
#define UNPACK8(W_, V_) do { V_[0] = bflo((W_)[0]); V_[1] = bfhi((W_)[0]); V_[2] = bflo((W_)[1]); V_[3] = bfhi((W_)[1]); V_[4] = bflo((W_)[2]); V_[5] = bfhi((W_)[2]); V_[6] = bflo((W_)[3]); V_[7] = bfhi((W_)[3]); } while (0)
#define PACK8(V_) (v4u){pk2(V_[0], V_[1]), pk2(V_[2], V_[3]), pk2(V_[4], V_[5]), pk2(V_[6], V_[7])}
template <int CTRL> __device__ __forceinline__ float dpp_f(float v) { return __int_as_float(__builtin_amdgcn_update_dpp(0, __float_as_int(v), CTRL, 0xF, 0xF, false)); }
#define SUM8(x) do { x += dpp_f<0xB1>(x); x += dpp_f<0x4E>(x); x += dpp_f<0x141>(x); } while (0)
#define SUM16(x) do { SUM8(x); x += dpp_f<0x140>(x); } while (0)
__device__ __forceinline__ float wave_sum(float v) {
    SUM16(v);
    return __int_as_float(__builtin_amdgcn_readlane(__float_as_int(v), 0)) + __int_as_float(__builtin_amdgcn_readlane(__float_as_int(v), 16))
         + __int_as_float(__builtin_amdgcn_readlane(__float_as_int(v), 32)) + __int_as_float(__builtin_amdgcn_readlane(__float_as_int(v), 48));
}
#define LDS_WAIT() asm volatile("s_waitcnt lgkmcnt(0)" ::: "memory")

__device__ __forceinline__ int win_src(int d) {
    if (d < 2120) return d;
    if (d < 2792) return d + 512;
    if (d < 3816) return d + 1024;
    if (d < 3840) return -1;
    if (d < 4352) return d - 3840 + 2120;
    if (d < 4864) return d - 4352 + 3304;
    return d - 4864 + 4840;
}
template <bool REMAP>
__device__ __forceinline__ void transpose_item(const float* W, int K, int N, int Npad, bf16* WT, LAS float* scr, int item, int lane) {
    const int nblk = Npad / 32, kb = item / nblk, nb = item % nblk, k0 = 64 * kb, n0 = 32 * nb;
    const int n4 = 4 * (lane & 7);
    const int nn = REMAP ? win_src(n0 + n4) : n0 + n4; const bool ok = nn >= 0 && nn < N;
#pragma unroll
    for (int i = 0; i < 8; ++i) { const int kk = 8 * i + (lane >> 3);
        f32x4 v = (f32x4){0.f, 0.f, 0.f, 0.f}; if (ok) v = *(const f32x4*)(W + (size_t)(k0 + kk) * N + nn);
        LAS float* d = scr + kk * 33 + n4; d[0] = v[0]; d[1] = v[1]; d[2] = v[2]; d[3] = v[3]; }
    LDS_WAIT(); asm volatile("" ::: "memory");
    const int c = lane & 7;
#pragma unroll
    for (int j = 0; j < 4; ++j) { const int n = (lane >> 3) + 8 * j; const LAS float* s = scr + (8 * c) * 33 + n;
        v4u o; o.x = pk2(s[0 * 33], s[1 * 33]); o.y = pk2(s[2 * 33], s[3 * 33]); o.z = pk2(s[4 * 33], s[5 * 33]); o.w = pk2(s[6 * 33], s[7 * 33]);
        *(v4u*)(WT + (size_t)(n0 + n) * K + k0 + 8 * c) = o; }
    LDS_WAIT(); asm volatile("" ::: "memory");
}
__device__ __forceinline__ void rms_row_1024(const float* xrow, const float* g, bf16* orow, int lane) {
    const f32x4* xr = (const f32x4*)xrow + lane; const f32x4* gr = (const f32x4*)g + lane;
    f32x4 v[4]; float s = 0.f;
#pragma unroll
    for (int j = 0; j < 4; ++j) { v[j] = xr[64 * j]; s += (v[j].x * v[j].x + v[j].y * v[j].y) + (v[j].z * v[j].z + v[j].w * v[j].w); }
    const float rstd = __builtin_amdgcn_rsqf(wave_sum(s) * (1.f / 1024.f) + EPS);
    v2u* o8 = (v2u*)orow + lane;
#pragma unroll
    for (int j = 0; j < 4; ++j) { const f32x4 gg = gr[64 * j]; v2u w; w.x = pk2(v[j].x * rstd * gg.x, v[j].y * rstd * gg.y); w.y = pk2(v[j].z * rstd * gg.z, v[j].w * rstd * gg.w); o8[64 * j] = w; }
}

#define ROPE8(v, sub, c8, s8) do { _Pragma("unroll") for (int j_ = 0; j_ < 8; ++j_) { const float pv_ = dpp_f<0xB1>(v[j_]); \
        const float r0_ = v[j_] * c8[j_] - pv_ * s8[j_], r1_ = v[j_] * c8[j_] + pv_ * s8[j_]; v[j_] = (sub) == 0 ? r0_ : ((sub) == 1 ? r1_ : v[j_]); } } while (0)

__device__ __forceinline__ void post1_row(const bf16* Prow, bf16* Orow, const float* ra, const float (&ga)[8], const float (&gk)[8], const float (&gq)[8], const float (&gc)[8], const float (&gm)[8], float* WIrow, int lane) {
    const int sub = lane & 7;
    const v4u z4 = (v4u){0u, 0u, 0u, 0u};
    const v4u w_qa = *(const v4u*)(Prow + C_QA + 8 * lane);
    const v4u w_ka = *(const v4u*)(Prow + C_KA + 8 * lane);
    const v4u w_qi = *(const v4u*)(Prow + C_QI + 8 * lane);
    const v4u w_qm = *(const v4u*)(Prow + C_QM + 8 * lane);
    v4u w_ki = z4, w_cq = z4, w_ckv = z4; float w_wi = 0.f;
    if (lane < 8) { w_ki = *(const v4u*)(Prow + C_KI + 8 * lane); w_wi = bf1(Prow[C_WI + lane]); }
    if (lane < 48) w_cq = *(const v4u*)(Prow + C_CQ + 8 * lane);
    if (lane < 32) w_ckv = *(const v4u*)(Prow + C_CKV + 8 * lane);
    float c8[8], s8[8];
    { const f32x4 r0 = *(const f32x4*)(ra), r1 = *(const f32x4*)(ra + 4), r2 = *(const f32x4*)(ra + 8), r3 = *(const f32x4*)(ra + 12);
      c8[0] = r0[0]; c8[1] = r0[1]; c8[2] = r0[2]; c8[3] = r0[3]; c8[4] = r1[0]; c8[5] = r1[1]; c8[6] = r1[2]; c8[7] = r1[3];
      s8[0] = r2[0]; s8[1] = r2[1]; s8[2] = r2[2]; s8[3] = r2[3]; s8[4] = r3[0]; s8[5] = r3[1]; s8[6] = r3[2]; s8[7] = r3[3]; }
    { float v[8]; UNPACK8(w_qa, v); float ss = 0.f;
#pragma unroll
      for (int j = 0; j < 8; ++j) ss += v[j] * v[j];
      SUM8(ss);
      const float rstd = __builtin_amdgcn_rsqf(ss * (1.f / 64.f) + EPS);
#pragma unroll
      for (int j = 0; j < 8; ++j) v[j] = v[j] * rstd * ga[j];
      ROPE8(v, sub, c8, s8);
#pragma unroll
      for (int j = 0; j < 8; ++j) v[j] *= SCALE_A;
      *(v4u*)(Orow + C_QA + 8 * lane) = PACK8(v); }
    { float v[8]; UNPACK8(w_ka, v); float ss = 0.f;
#pragma unroll
      for (int j = 0; j < 8; ++j) ss += v[j] * v[j];
      SUM8(ss);
      const float rstd = __builtin_amdgcn_rsqf(ss * (1.f / 64.f) + EPS);
#pragma unroll
      for (int j = 0; j < 8; ++j) v[j] = v[j] * rstd * gk[j];
      ROPE8(v, sub, c8, s8);
      *(v4u*)(Orow + C_KA + 8 * lane) = PACK8(v); }
    { float v[8]; UNPACK8(w_qi, v);
      ROPE8(v, sub, c8, s8);
      *(v4u*)(Orow + C_QI + 8 * lane) = PACK8(v); }
    { float v[8]; UNPACK8(w_ki, v);
      ROPE8(v, sub, c8, s8);
      if (lane < 8) *(v4u*)(Orow + C_KI + 8 * lane) = PACK8(v); }
    if (lane < 8) WIrow[lane] = w_wi * SCALE_I;
    { float v[8]; UNPACK8(w_cq, v); float ss = 0.f;
#pragma unroll
      for (int j = 0; j < 8; ++j) ss += v[j] * v[j];
      ss = wave_sum(ss); const float rstd = __builtin_amdgcn_rsqf(ss * (1.f / 384.f) + EPS);
      if (lane < 48) {
#pragma unroll
          for (int j = 0; j < 8; ++j) v[j] = v[j] * rstd * gq[j];
          *(v4u*)(Orow + C_CQ + 8 * lane) = PACK8(v); } }
    { float v[8]; UNPACK8(w_ckv, v); float ss = 0.f;
#pragma unroll
      for (int j = 0; j < 8; ++j) ss += v[j] * v[j];
      ss = wave_sum(ss); const float rstd = __builtin_amdgcn_rsqf(ss * (1.f / 256.f) + EPS);
      if (lane < 32) {
#pragma unroll
          for (int j = 0; j < 8; ++j) v[j] = v[j] * rstd * gc[j];
          *(v4u*)(Orow + C_CKV + 8 * lane) = PACK8(v); } }
    { float v[8]; UNPACK8(w_qm, v); float ss = 0.f;
#pragma unroll
      for (int j = 0; j < 8; ++j) ss += v[j] * v[j];
      SUM16(ss);
      const float rstd = __builtin_amdgcn_rsqf(ss * (1.f / 128.f) + EPS);
#pragma unroll
      for (int j = 0; j < 8; ++j) v[j] = v[j] * rstd * gm[j] * SCALE_M;
      *(v4u*)(Orow + C_QM + 8 * lane) = PACK8(v); }
}

__device__ __forceinline__ void km_row(bf16* row, const float* gkm, int lane) {
    v4u w = *(const v4u*)(row + 8 * lane); float v[8]; UNPACK8(w, v); float ss = 0.f;
#pragma unroll
    for (int j = 0; j < 8; ++j) ss += v[j] * v[j];
    SUM16(ss);
    const float rstd = __builtin_amdgcn_rsqf(ss * (1.f / 128.f) + EPS);
#pragma unroll
    for (int j = 0; j < 8; ++j) v[j] = v[j] * rstd * gkm[8 * (lane & 15) + j];
    *(v4u*)(row + 8 * lane) = PACK8(v);
}

__device__ __forceinline__ void transpose_v(const bf16* src, int pitch, int col0, int hstride, int H, int DV, int S, int nb, bf16* dst, int gw, int NGW, int lane) {
    const int ndq = DV / 64, nsc = S / 64, ntask = nb * H * nsc * ndq;
    for (int task = gw; task < ntask; task += NGW) {
        int x = task; const int dq = x % ndq; x /= ndq; const int sc = x % nsc; x /= nsc; const int h = x % H; const int b = x / H;
        const int s = sc * 64 + lane;
        const bf16* srow = src + (size_t)(b * S + s) * pitch + col0 + h * hstride + dq * 64;
        bf16* drow = dst + ((size_t)((b * H + h) * DV + dq * 64)) * S + s;
        v4u wv[8];
#pragma unroll
        for (int c = 0; c < 8; ++c) wv[c] = *(const v4u*)(srow + 8 * c);
#pragma unroll
        for (int c = 0; c < 8; ++c) { const v4u w = wv[c];
            drow[(size_t)(8 * c + 0) * S] = (bf16)(w.x & 0xffffu); drow[(size_t)(8 * c + 1) * S] = (bf16)(w.x >> 16);
            drow[(size_t)(8 * c + 2) * S] = (bf16)(w.y & 0xffffu); drow[(size_t)(8 * c + 3) * S] = (bf16)(w.y >> 16);
            drow[(size_t)(8 * c + 4) * S] = (bf16)(w.z & 0xffffu); drow[(size_t)(8 * c + 5) * S] = (bf16)(w.z >> 16);
            drow[(size_t)(8 * c + 6) * S] = (bf16)(w.w & 0xffffu); drow[(size_t)(8 * c + 7) * S] = (bf16)(w.w >> 16); }
    }
}

__device__ __forceinline__ void post2_row(const bf16* QBrow, bf16* QOrow, const bf16* KVBrow, const bf16* Prow, bf16* KBrow, const float* rb, const float (&gqv)[12], const float (&gkv)[12], LAS float* scr, int lane) {
    const int hd = lane >> 3, d0 = 12 * (lane & 7);
    float vq[12], vk[12], cc[12], sn[12];
    { const v2u* p = (const v2u*)(QBrow + 12 * lane);
      const v2u w0 = p[0], w1 = p[1], w2 = p[2];
      bf16 kr[12];
#pragma unroll
      for (int e = 0; e < 12; ++e) { const int d = d0 + e; kr[e] = d < 64 ? KVBrow[hd * 128 + d] : Prow[C_KR + d - 64]; }
#pragma unroll
      for (int e = 0; e < 12; ++e) { const int d = d0 + e; const int i = (d - 64) & 15; cc[e] = d < 64 ? 1.f : rb[i]; sn[e] = d < 64 ? 0.f : rb[16 + i]; }
      vq[0] = bflo(w0.x); vq[1] = bfhi(w0.x); vq[2] = bflo(w0.y); vq[3] = bfhi(w0.y); vq[4] = bflo(w1.x); vq[5] = bfhi(w1.x); vq[6] = bflo(w1.y); vq[7] = bfhi(w1.y);
      vq[8] = bflo(w2.x); vq[9] = bfhi(w2.x); vq[10] = bflo(w2.y); vq[11] = bfhi(w2.y);
#pragma unroll
      for (int e = 0; e < 12; ++e) vk[e] = bf1(kr[e]); }
    float sq = 0.f, sk = 0.f;
#pragma unroll
    for (int e = 0; e < 12; ++e) { sq += vq[e] * vq[e]; sk += vk[e] * vk[e]; }
    SUM8(sq); SUM8(sk);
    const float rq = __builtin_amdgcn_rsqf(sq * (1.f / 96.f) + EPS), rk = __builtin_amdgcn_rsqf(sk * (1.f / 96.f) + EPS);
#pragma unroll
    for (int e = 0; e < 12; ++e) { vq[e] = vq[e] * rq * gqv[e]; vk[e] = vk[e] * rk * gkv[e]; scr[12 * lane + e] = vq[e]; scr[768 + 12 * lane + e] = vk[e]; }
    LDS_WAIT(); asm volatile("" ::: "memory");
    float oq[12], ok[12];
#pragma unroll
    for (int e = 0; e < 12; ++e) { const int d = d0 + e;
        if (d < 64) { oq[e] = vq[e]; ok[e] = vk[e]; }
        else { const bool first = d < 80; const int off = first ? 16 : -16; const float pq = scr[12 * lane + e + off], pk = scr[768 + 12 * lane + e + off];
               oq[e] = first ? vq[e] * cc[e] - pq * sn[e] : vq[e] * cc[e] + pq * sn[e];
               ok[e] = first ? vk[e] * cc[e] - pk * sn[e] : vk[e] * cc[e] + pk * sn[e]; }
        oq[e] *= SCALE_B; }
    LDS_WAIT(); asm volatile("" ::: "memory");
    v2u* q = (v2u*)(QOrow + 12 * lane); v2u* k = (v2u*)(KBrow + 12 * lane);
#pragma unroll
    for (int i = 0; i < 3; ++i) { v2u w; w.x = pk2(oq[4 * i], oq[4 * i + 1]); w.y = pk2(oq[4 * i + 2], oq[4 * i + 3]); q[i] = w;
                                  v2u u; u.x = pk2(ok[4 * i], ok[4 * i + 1]); u.y = pk2(ok[4 * i + 2], ok[4 * i + 3]); k[i] = u; }
}

__device__ __forceinline__ int next_unit(unsigned* ctr, volatile LAS int* slot) {
    __syncthreads();
    if (threadIdx.x == 0) *slot = (int)atomicAdd(ctr, 1u);
    __syncthreads();
    return *slot;
}

constexpr int SCP = 2112;
__device__ __forceinline__ unsigned ord_key(float v) { const unsigned b = __float_as_uint(v); return b ^ ((unsigned)((int)b >> 31) | 0x80000000u); }
__device__ __forceinline__ void indexer_unit(LAS float* sc, const bf16* P, const float* WI, unsigned* MASK, int bb, int tb) {
    int tid_ = threadIdx.x; asm volatile("" : "+v"(tid_));
    const int tid = tid_, lane = tid & 63, w = __builtin_amdgcn_readfirstlane(tid >> 6);
    const int n = lane & 15, g = lane >> 4;
    const int rowbase = bb * SEQ, t0 = tb * 16;
    for (int rp1 = 0; rp1 < REP_IDX1; ++rp1) {
        bf16x8 qf[8][2]; float wq[8];
        const bf16* qrow = P + (size_t)(rowbase + t0 + n) * PP + C_QI + 8 * g;
#pragma unroll
        for (int h = 0; h < 8; ++h) {
            qf[h][0] = *(const bf16x8*)(qrow + h * 64);
            qf[h][1] = *(const bf16x8*)(qrow + h * 64 + 32);
            wq[h] = WI[(size_t)(rowbase + t0 + n) * 8 + h];
        }
        const int ntile = tb + 1;
        const int nmine = (ntile - w + 7) >> 3;
        const int ngrp = (nmine + 3) >> 2;
        const bf16* kbase = P + (size_t)(rowbase + n) * PP + C_KI + 8 * g;
        bf16x8 kb[2][4][2];
#define IDX_LOAD(BUF, GRP) do { _Pragma("unroll") for (int j_ = 0; j_ < 4; ++j_) { const int tile_ = w + 8 * (4 * (GRP) + j_); const int tl_ = tile_ < ntile ? tile_ : 0; \
            const bf16* kr_ = kbase + (size_t)(16 * tl_) * PP; kb[BUF][j_][0] = *(const bf16x8*)(kr_); kb[BUF][j_][1] = *(const bf16x8*)(kr_ + 32); } } while (0)
#define IDX_COMP(BUF, GRP) do { _Pragma("unroll") for (int j_ = 0; j_ < 4; ++j_) { const int tile_ = w + 8 * (4 * (GRP) + j_); if (tile_ < ntile) { \
            f32x4 idx_ = (f32x4){0.f, 0.f, 0.f, 0.f}; \
            _Pragma("unroll") for (int h_ = 0; h_ < 8; ++h_) { f32x4 a_ = (f32x4){0.f, 0.f, 0.f, 0.f}; \
                a_ = __builtin_amdgcn_mfma_f32_16x16x32_bf16(kb[BUF][j_][0], qf[h_][0], a_, 0, 0, 0); \
                a_ = __builtin_amdgcn_mfma_f32_16x16x32_bf16(kb[BUF][j_][1], qf[h_][1], a_, 0, 0, 0); \
                _Pragma("unroll") for (int i_ = 0; i_ < 4; ++i_) idx_[i_] = __builtin_fmaf(wq[h_], __builtin_fmaxf(a_[i_], 0.f), idx_[i_]); } \
            { const int k0_ = 16 * tile_ + 4 * g; LAS float* d_ = sc + n * SCP + k0_ + (k0_ >> 5); d_[0] = idx_[0]; d_[1] = idx_[1]; d_[2] = idx_[2]; d_[3] = idx_[3]; } } } } while (0)
        if (ngrp > 0) IDX_LOAD(0, 0);
        for (int gp = 0; gp < ngrp; gp += 2) {
            if (gp + 1 < ngrp) IDX_LOAD(1, gp + 1);
            IDX_COMP(0, gp);
            if (gp + 1 < ngrp) { if (gp + 2 < ngrp) IDX_LOAD(0, gp + 2); IDX_COMP(1, gp + 1); }
        }
#undef IDX_LOAD
#undef IDX_COMP
    }
    __syncthreads();
    for (int rs = 0; rs < REP_SEL; ++rs) {
        const int ta = t0 + 2 * w, tb2 = ta + 1;
        unsigned* mra = MASK + (size_t)(rowbase + ta) * 64; unsigned* mrb = mra + 64;
        const int nva = ta - 32 * lane + 1, nvb = nva + 1;
        const unsigned valid_a = nva >= 32 ? 0xffffffffu : (nva <= 0 ? 0u : ((1u << nva) - 1u));
        const unsigned valid_b = nvb >= 32 ? 0xffffffffu : (nvb <= 0 ? 0u : ((1u << nvb) - 1u));
        if (ta < 256) { mra[lane] = valid_a; mrb[lane] = valid_b; continue; }
        unsigned ua[32], ub[32];
        { const LAS float* sra = sc + (2 * w) * SCP + 33 * lane; const LAS float* srb = sra + SCP;
#pragma unroll
          for (int r = 0; r < 32; ++r) { const float va = sra[r], vb = srb[r]; ua[r] = ((valid_a >> r) & 1u) ? ord_key(va) : 0u; ub[r] = ((valid_b >> r) & 1u) ? ord_key(vb) : 0u; } }
#pragma unroll
        for (int k = 0; k < 16; ++k) {
            const unsigned a0 = ua[k], a1 = ua[k + 16]; ua[k] = __builtin_amdgcn_perm(a1, a0, 0x05040100u); ua[k + 16] = __builtin_amdgcn_perm(a1, a0, 0x07060302u);
            const unsigned b0 = ub[k], b1 = ub[k + 16]; ub[k] = __builtin_amdgcn_perm(b1, b0, 0x05040100u); ub[k + 16] = __builtin_amdgcn_perm(b1, b0, 0x07060302u); }
#pragma unroll
        for (int k = 0; k < 32; ++k) if (!(k & 8)) {
            const unsigned a0 = ua[k], a1 = ua[k + 8]; ua[k] = __builtin_amdgcn_perm(a1, a0, 0x06020400u); ua[k + 8] = __builtin_amdgcn_perm(a1, a0, 0x07030501u);
            const unsigned b0 = ub[k], b1 = ub[k + 8]; ub[k] = __builtin_amdgcn_perm(b1, b0, 0x06020400u); ub[k + 8] = __builtin_amdgcn_perm(b1, b0, 0x07030501u); }
#pragma unroll
        for (int si = 2; si < 5; ++si) { const int sft = 16 >> si;
            const unsigned msk = si == 2 ? 0x0f0f0f0fu : (si == 3 ? 0x33333333u : 0x55555555u);
#pragma unroll
            for (int k = 0; k < 32; ++k) if (!(k & sft)) {
                const unsigned a0 = ua[k], a1 = ua[k + sft]; ua[k] = (a0 & msk) | ((a1 << sft) & ~msk); ua[k + sft] = ((a0 >> sft) & msk) | (a1 & ~msk);
                const unsigned b0 = ub[k], b1 = ub[k + sft]; ub[k] = (b0 & msk) | ((b1 << sft) & ~msk); ub[k + sft] = ((b0 >> sft) & msk) | (b1 & ~msk); } }
        unsigned alive_a = valid_a, sel_a = 0u, alive_b = valid_b, sel_b = 0u; int need_a = 256, need_b = 256; bool run_a = true, run_b = true;
#pragma unroll
        for (int j = 31; j >= 0; --j) {
            const unsigned ones_a = alive_a & ua[j], ones_b = alive_b & ub[j];
            int v = (int)((unsigned)__popc(ones_a) | ((unsigned)__popc(ones_b) << 16));
            v += __builtin_amdgcn_update_dpp(0, v, 0xB1, 0xF, 0xF, false);
            v += __builtin_amdgcn_update_dpp(0, v, 0x4E, 0xF, 0xF, false);
            v += __builtin_amdgcn_update_dpp(0, v, 0x141, 0xF, 0xF, false);
            v += __builtin_amdgcn_update_dpp(0, v, 0x140, 0xF, 0xF, false);
            const unsigned tot = (unsigned)(__builtin_amdgcn_readlane(v, 0) + __builtin_amdgcn_readlane(v, 16) + __builtin_amdgcn_readlane(v, 32) + __builtin_amdgcn_readlane(v, 48));
            const int ca = (int)(tot & 0xffffu), cb = (int)(tot >> 16);
            if (run_a) { if (ca >= need_a) { alive_a = ones_a; if (ca == need_a) { sel_a |= ones_a; need_a = 0; run_a = false; } }
                         else { need_a -= ca; sel_a |= ones_a; alive_a &= ~ua[j]; } }
            if (run_b) { if (cb >= need_b) { alive_b = ones_b; if (cb == need_b) { sel_b |= ones_b; need_b = 0; run_b = false; } }
                         else { need_b -= cb; sel_b |= ones_b; alive_b &= ~ub[j]; } }
            if (!run_a && !run_b) break;
        }
        if (need_a > 0) {
            const int cnt = __popc(alive_a); int inc = cnt;
#pragma unroll
            for (int d = 1; d < 64; d <<= 1) { const int o = __shfl_up(inc, d); if (lane >= d) inc += o; }
            int k = need_a - (inc - cnt); k = k < 0 ? 0 : (k > cnt ? cnt : k);
            unsigned m = alive_a;
            for (int i = 0; i < k; ++i) { const unsigned low = m & (0u - m); sel_a |= low; m ^= low; }
        }
        if (need_b > 0) {
            const int cnt = __popc(alive_b); int inc = cnt;
#pragma unroll
            for (int d = 1; d < 64; d <<= 1) { const int o = __shfl_up(inc, d); if (lane >= d) inc += o; }
            int k = need_b - (inc - cnt); k = k < 0 ? 0 : (k > cnt ? cnt : k);
            unsigned m = alive_b;
            for (int i = 0; i < k; ++i) { const unsigned low = m & (0u - m); sel_b |= low; m ^= low; }
        }
        mra[lane] = sel_a; mrb[lane] = sel_b;
        (void)tb2;
    }
    __syncthreads();
}

__device__ __forceinline__ float half_max(float m) { auto rr = __builtin_amdgcn_permlane32_swap(__float_as_uint(m), __float_as_uint(m), false, false); return __builtin_fmaxf(__uint_as_float(rr[0]), __uint_as_float(rr[1])); }
__device__ __forceinline__ float half_sum(float m) { auto rr = __builtin_amdgcn_permlane32_swap(__float_as_uint(m), __float_as_uint(m), false, false); return __uint_as_float(rr[0]) + __uint_as_float(rr[1]); }
__device__ __forceinline__ int crow(int r, int hi) { return (r & 3) + 8 * (r >> 2) + 4 * hi; }
template <int DQK, int DV, int MODE, int STRIP = 0>
__device__ __forceinline__ void attn_unit(LAS unsigned char* lds, const bf16* Qb, int qpitch, const bf16* Kb, int kpitch, const bf16* VTb, int skv,
                                          const unsigned* maskb, const bf16* Zb, bf16* Ob, int q0) {
    constexpr int TK = 128, KP = DQK + 8, VP = TK + 8;
    LAS bf16* Ks = (LAS bf16*)lds; LAS bf16* Vs = Ks + TK * KP;
    constexpr int CPR = DQK / 8;
    constexpr int NCK = TK * CPR, NCV = DV * (TK / 8);
    constexpr int RK = (NCK + 511) / 512, RV = (NCV + 511) / 512;
    constexpr int NKS = DQK / 16, NMT = DV / 32;
    int tid_ = threadIdx.x; asm volatile("" : "+v"(tid_));
    const int tid = tid_, lane = tid & 63, w = __builtin_amdgcn_readfirstlane(tid >> 6), r = lane & 31, hh = lane >> 5;
    const int NT = MODE == 0 ? skv / TK : (q0 + 256) / TK;
    const int qlo = q0 + 32 * w;
    bf16x8 qf[NKS];
    { const bf16* qrow = Qb + (size_t)(qlo + r) * qpitch + 8 * hh;
#pragma unroll
      for (int ks = 0; ks < NKS; ++ks) qf[ks] = *(const bf16x8*)(qrow + 16 * ks); }
    f32x16 o[NMT];
#pragma unroll
    for (int mt = 0; mt < NMT; ++mt)
#pragma unroll
        for (int i = 0; i < 16; ++i) o[mt][i] = 0.f;
    float m_run = NEGF, l_run = 0.f;
    v4u kreg[RK], vreg[RV];
#define ATT_PREFETCH(tile_) do { \
        _Pragma("unroll") for (int i_ = 0; i_ < RK; ++i_) { const int c_ = tid + 512 * i_; if (c_ < NCK) { const int row_ = c_ / CPR, cc_ = c_ % CPR; kreg[i_] = *(const v4u*)(Kb + (size_t)(TK * (tile_) + row_) * kpitch + 8 * cc_); } } \
        _Pragma("unroll") for (int i_ = 0; i_ < RV; ++i_) { const int c_ = tid + 512 * i_; if (c_ < NCV) { const int d_ = c_ >> 4, cc_ = c_ & 15; vreg[i_] = *(const v4u*)(VTb + (size_t)d_ * skv + TK * (tile_) + 8 * cc_); } } } while (0)
    if (STRIP != 2) ATT_PREFETCH(0);
    for (int tile = 0; tile < NT; ++tile) {
        __syncthreads();
        if (STRIP != 2) {
#pragma unroll
        for (int i = 0; i < RK; ++i) { const int c = tid + 512 * i; if (c < NCK) { const int row = c / CPR, cc = c % CPR; *(LAS v4u*)(Ks + row * KP + 8 * cc) = kreg[i]; } }
#pragma unroll
        for (int i = 0; i < RV; ++i) { const int c = tid + 512 * i; if (c < NCV) { const int d = c >> 4, cc = c & 15; *(LAS v4u*)(Vs + d * VP + 8 * cc) = vreg[i]; } }
        }
        __syncthreads();
        if (STRIP != 2 && tile + 1 < NT) ATT_PREFETCH(tile + 1);
        __builtin_amdgcn_sched_barrier(0);
        if (STRIP == 1) continue;
#pragma unroll 1
        for (int sub = 0; sub < 2; ++sub) {
        const int t64 = 2 * tile + sub;
        if (MODE != 0 && 64 * t64 > qlo + 31) continue;
        const LAS bf16* Kc = Ks + 64 * sub * KP; const LAS bf16* Vc = Vs + 64 * sub;
        unsigned mw0 = 0u, mw1 = 0u;
        if (MODE == 2) { const v2u mm = *(const v2u*)(maskb + (size_t)(qlo + r) * 64 + 2 * t64); mw0 = mm.x >> (4 * hh); mw1 = mm.y >> (4 * hh); }
        f32x16 s0, s1;
#pragma unroll
        for (int i = 0; i < 16; ++i) { s0[i] = 0.f; s1[i] = 0.f; }
#pragma unroll
        for (int ks = 0; ks < NKS; ++ks) {
            const bf16x8 a0 = *(const LAS bf16x8*)(Kc + r * KP + 16 * ks + 8 * hh);
            const bf16x8 a1 = *(const LAS bf16x8*)(Kc + (32 + r) * KP + 16 * ks + 8 * hh);
            s0 = __builtin_amdgcn_mfma_f32_32x32x16_bf16(a0, qf[ks], s0, 0, 0, 0);
            s1 = __builtin_amdgcn_mfma_f32_32x32x16_bf16(a1, qf[ks], s1, 0, 0, 0);
        }
        if (MODE == 1) {
            if (64 * t64 + 63 > qlo) { const int qg = qlo + r;
#pragma unroll
                for (int i = 0; i < 16; ++i) { const int key = 64 * t64 + crow(i, hh); if (key > qg) s0[i] = NEGF; if (key + 32 > qg) s1[i] = NEGF; } }
        }
        if (MODE == 2) {
#pragma unroll
            for (int i = 0; i < 16; ++i) { const int bit = (i & 3) + 8 * (i >> 2); if (!((mw0 >> bit) & 1u)) s0[i] = NEGF; if (!((mw1 >> bit) & 1u)) s1[i] = NEGF; }
        }
        float mx = s0[0];
#pragma unroll
        for (int i = 1; i < 16; ++i) mx = __builtin_fmaxf(mx, s0[i]);
#pragma unroll
        for (int i = 0; i < 16; ++i) mx = __builtin_fmaxf(mx, s1[i]);
        mx = half_max(mx);
        const float m_new = __builtin_fmaxf(m_run, mx);
        const float alpha = __builtin_amdgcn_exp2f(m_run - m_new);
        m_run = m_new;
        float ls = 0.f;
#pragma unroll
        for (int i = 0; i < 16; ++i) { s0[i] = __builtin_amdgcn_exp2f(s0[i] - m_new); s1[i] = __builtin_amdgcn_exp2f(s1[i] - m_new); ls += s0[i] + s1[i]; }
        l_run = l_run * alpha + ls;
#pragma unroll
        for (int mt = 0; mt < NMT; ++mt)
#pragma unroll
            for (int i = 0; i < 16; ++i) o[mt][i] *= alpha;
        v4u pf[2][2];
#pragma unroll
        for (int s = 0; s < 2; ++s) {
            pf[0][s] = (v4u){pk2(s0[8 * s], s0[8 * s + 1]), pk2(s0[8 * s + 2], s0[8 * s + 3]), pk2(s0[8 * s + 4], s0[8 * s + 5]), pk2(s0[8 * s + 6], s0[8 * s + 7])};
            pf[1][s] = (v4u){pk2(s1[8 * s], s1[8 * s + 1]), pk2(s1[8 * s + 2], s1[8 * s + 3]), pk2(s1[8 * s + 4], s1[8 * s + 5]), pk2(s1[8 * s + 6], s1[8 * s + 7])};
        }
#pragma unroll
        for (int mt = 0; mt < NMT; ++mt)
#pragma unroll
            for (int p = 0; p < 2; ++p)
#pragma unroll
                for (int s = 0; s < 2; ++s) {
                    const LAS bf16* vp = Vc + (32 * mt + r) * VP + 32 * p + 16 * s + 4 * hh;
                    const s16x4 lo = *(const LAS s16x4*)(vp), hi = *(const LAS s16x4*)(vp + 8);
                    const bf16x8 a = (bf16x8){lo[0], lo[1], lo[2], lo[3], hi[0], hi[1], hi[2], hi[3]};
                    o[mt] = __builtin_amdgcn_mfma_f32_32x32x16_bf16(a, __builtin_bit_cast(bf16x8, pf[p][s]), o[mt], 0, 0, 0);
                }
        }
    }
#undef ATT_PREFETCH
    const float l_tot = half_sum(l_run);
    const float inv = 1.0f / l_tot;
    const size_t row = (size_t)(qlo + r);
#pragma unroll
    for (int mt = 0; mt < NMT; ++mt)
#pragma unroll
        for (int g4 = 0; g4 < 4; ++g4) {
            const int d = 32 * mt + 8 * g4 + 4 * hh;
            float ov[4];
#pragma unroll
            for (int i = 0; i < 4; ++i) ov[i] = o[mt][4 * g4 + i] * inv;
            if (Zb) { const v2u zw = *(const v2u*)(Zb + row * PP + d); const float z[4] = {bflo(zw.x), bfhi(zw.x), bflo(zw.y), bfhi(zw.y)};
#pragma unroll
                for (int i = 0; i < 4; ++i) ov[i] *= z[i] * __builtin_amdgcn_rcpf(1.0f + __expf(-z[i])); }
            v2u ow; ow.x = pk2(ov[0], ov[1]); ow.y = pk2(ov[2], ov[3]);
            *(v2u*)(Ob + row * PP + d) = ow;
        }
}

template <int DQK, int MODE>
__device__ __forceinline__ void attn_unit_pipe(LAS unsigned char* lds, const bf16* Qb, int qpitch, const bf16* Kb, int kpitch, const bf16* VTb, int skv,
                                               const unsigned* maskb, bf16* Ob, int q0) {
    constexpr int DV = 64, KP = DQK + 8, VP = 72, BUFE = 64 * KP + DV * VP;
    constexpr int CPR = DQK / 8, NCK = 64 * CPR, NCV = DV * 8, RK = (NCK + 511) / 512, RV = (NCV + 511) / 512, NKS = DQK / 16, NMT = DV / 32;
    static_assert(NCV == 512 && (NCK == 512 || NCK == 768), "staging map");
    int tid_ = threadIdx.x; asm volatile("" : "+v"(tid_));
    const int tid = tid_, lane = tid & 63, w = __builtin_amdgcn_readfirstlane(tid >> 6), r = lane & 31, hh = lane >> 5;
    const int NT = (q0 + 256) / 64;
    const int qlo = q0 + 32 * w;
    const int NTw = ((qlo + 31) >> 6) + 1;
    int krow[RK], kcc[RK];
#pragma unroll
    for (int i = 0; i < RK; ++i) { int c = tid + 512 * i; if (c >= NCK) c -= 256; krow[i] = c / CPR; kcc[i] = c % CPR; }
    const int vd = tid >> 3, vcc = tid & 7;
    bf16x8 qf[NKS];
    { const bf16* qrow = Qb + (size_t)(qlo + r) * qpitch + 8 * hh;
#pragma unroll
      for (int ks = 0; ks < NKS; ++ks) qf[ks] = *(const bf16x8*)(qrow + 16 * ks); }
    f32x16 o[NMT];
#pragma unroll
    for (int mt = 0; mt < NMT; ++mt)
#pragma unroll
        for (int i = 0; i < 16; ++i) o[mt][i] = 0.f;
    float m_run = NEGF, l_run = 0.f, alpha = 1.f;
    v4u kreg[2][RK], vreg[2][RV]; v2u mset[2];
    const unsigned* mrowp = MODE == 2 ? maskb + (size_t)(qlo + r) * 64 : nullptr;
#define PL_LOAD(S_, tile_) do { const int tl_ = (tile_) < NT ? (tile_) : NT - 1; \
        if (MODE == 2) { const int mt_ = (tile_) >= 2 ? ((tile_) - 2 < 32 ? (tile_) - 2 : 31) : 0; mset[S_] = *(const v2u*)(mrowp + 2 * mt_); }     \
        _Pragma("unroll") for (int i_ = 0; i_ < RK; ++i_) kreg[S_][i_] = *(const v4u*)(Kb + (size_t)(64 * tl_ + krow[i_]) * kpitch + 8 * kcc[i_]); \
        vreg[S_][0] = *(const v4u*)(VTb + (size_t)vd * skv + 64 * tl_ + 8 * vcc); } while (0)
#define PL_STAGE(S_, buf_) do { LAS bf16* Kd_ = (LAS bf16*)lds + (buf_) * BUFE; LAS bf16* Vd_ = Kd_ + 64 * KP; \
        _Pragma("unroll") for (int i_ = 0; i_ < RK; ++i_) *(LAS v4u*)(Kd_ + krow[i_] * KP + 8 * kcc[i_]) = kreg[S_][i_]; \
        *(LAS v4u*)(Vd_ + vd * VP + 8 * vcc) = vreg[S_][0]; } while (0)
#define PL_QK(t_, D0_, D1_) do { const LAS bf16* Kc_ = (const LAS bf16*)lds + ((t_) & 3) * BUFE; \
        _Pragma("unroll") for (int i_ = 0; i_ < 16; ++i_) { D0_[i_] = 0.f; D1_[i_] = 0.f; } \
        _Pragma("unroll") for (int ks_ = 0; ks_ < NKS; ++ks_) { \
            const bf16x8 a0_ = *(const LAS bf16x8*)(Kc_ + r * KP + 16 * ks_ + 8 * hh); const bf16x8 a1_ = *(const LAS bf16x8*)(Kc_ + (32 + r) * KP + 16 * ks_ + 8 * hh); \
            D0_ = __builtin_amdgcn_mfma_f32_32x32x16_bf16(a0_, qf[ks_], D0_, 0, 0, 0); D1_ = __builtin_amdgcn_mfma_f32_32x32x16_bf16(a1_, qf[ks_], D1_, 0, 0, 0); } } while (0)
#define PL_PV(t_) do { const LAS bf16* Vc_ = (const LAS bf16*)lds + ((t_) & 3) * BUFE + 64 * KP; \
        _Pragma("unroll") for (int mt_ = 0; mt_ < NMT; ++mt_) _Pragma("unroll") for (int i_ = 0; i_ < 16; ++i_) o[mt_][i_] *= alpha; \
        _Pragma("unroll") for (int mt_ = 0; mt_ < NMT; ++mt_) _Pragma("unroll") for (int p_ = 0; p_ < 2; ++p_) _Pragma("unroll") for (int s_ = 0; s_ < 2; ++s_) { \
            const LAS bf16* vp_ = Vc_ + (32 * mt_ + r) * VP + 32 * p_ + 16 * s_ + 4 * hh; \
            const s16x4 lo_ = *(const LAS s16x4*)(vp_), hi_ = *(const LAS s16x4*)(vp_ + 8); \
            const bf16x8 a_ = (bf16x8){lo_[0], lo_[1], lo_[2], lo_[3], hi_[0], hi_[1], hi_[2], hi_[3]}; \
            o[mt_] = __builtin_amdgcn_mfma_f32_32x32x16_bf16(a_, __builtin_bit_cast(bf16x8, pf[p_][s_]), o[mt_], 0, 0, 0); } } while (0)
#define PL_SOFTMAX(t_, C0_, C1_, MK_, CAUSAL_) do { \
        if (MODE == 2) { const unsigned w0_ = (MK_).x >> (4 * hh), w1_ = (MK_).y >> (4 * hh); \
            _Pragma("unroll") for (int i_ = 0; i_ < 16; ++i_) { const int bit_ = (i_ & 3) + 8 * (i_ >> 2); if (!((w0_ >> bit_) & 1u)) C0_[i_] = NEGF; if (!((w1_ >> bit_) & 1u)) C1_[i_] = NEGF; } } \
        if (CAUSAL_) { const int qg_ = qlo + r; \
            _Pragma("unroll") for (int i_ = 0; i_ < 16; ++i_) { const int key_ = 64 * (t_) + crow(i_, hh); if (key_ > qg_) C0_[i_] = NEGF; if (key_ + 32 > qg_) C1_[i_] = NEGF; } } \
        float mx_ = C0_[0]; \
        _Pragma("unroll") for (int i_ = 1; i_ < 16; ++i_) mx_ = __builtin_fmaxf(mx_, C0_[i_]); \
        _Pragma("unroll") for (int i_ = 0; i_ < 16; ++i_) mx_ = __builtin_fmaxf(mx_, C1_[i_]); \
        mx_ = half_max(mx_); \
        const float mn_ = __builtin_fmaxf(m_run, mx_); alpha = __builtin_amdgcn_exp2f(m_run - mn_); m_run = mn_; \
        float ls_ = 0.f; \
        _Pragma("unroll") for (int i_ = 0; i_ < 16; ++i_) { C0_[i_] = __builtin_amdgcn_exp2f(C0_[i_] - mn_); C1_[i_] = __builtin_amdgcn_exp2f(C1_[i_] - mn_); ls_ += C0_[i_] + C1_[i_]; } \
        l_run = l_run * alpha + ls_; \
        _Pragma("unroll") for (int s_ = 0; s_ < 2; ++s_) { \
            pf[0][s_] = (v4u){pk2(C0_[8 * s_], C0_[8 * s_ + 1]), pk2(C0_[8 * s_ + 2], C0_[8 * s_ + 3]), pk2(C0_[8 * s_ + 4], C0_[8 * s_ + 5]), pk2(C0_[8 * s_ + 6], C0_[8 * s_ + 7])}; \
            pf[1][s_] = (v4u){pk2(C1_[8 * s_], C1_[8 * s_ + 1]), pk2(C1_[8 * s_ + 2], C1_[8 * s_ + 3]), pk2(C1_[8 * s_ + 4], C1_[8 * s_ + 5]), pk2(C1_[8 * s_ + 6], C1_[8 * s_ + 7])}; } } while (0)
#define PL_IO(t_, S_) do { PL_STAGE(S_, ((t_) + 2) & 3); PL_LOAD(S_, (t_) + 4); } while (0)
#define PL_STEADY(t_, S_) do { const v2u mk_ = mset[S_]; PL_IO(t_, S_); if (MODE == 2) { asm volatile("" :: "v"(mk_.x), "v"(mk_.y)); } \
        PL_QK((t_) + 1, n0, n1); PL_PV((t_) - 1); PL_SOFTMAX(t_, c0, c1, mk_, false); c0 = n0; c1 = n1; __syncthreads(); } while (0)
#define PL_TAIL(t_, S_) do { const v2u mk_ = mset[S_]; PL_IO(t_, S_); if ((t_) >= 1) PL_PV((t_) - 1); PL_SOFTMAX(t_, c0, c1, mk_, MODE == 1); PL_PV(t_); __syncthreads(); } while (0)
    f32x16 c0, c1, n0, n1; v4u pf[2][2];
    PL_LOAD(0, 0); PL_LOAD(1, 1);
    PL_STAGE(0, 0); PL_STAGE(1, 1);
    PL_LOAD(0, 2); PL_LOAD(1, 3);
    __syncthreads();
    PL_QK(0, c0, c1);
    int t = 0;
    if (NTw >= 2) {
        { const v2u mk_ = mset[0]; PL_IO(0, 0); PL_QK(1, n0, n1); PL_SOFTMAX(0, c0, c1, mk_, false); c0 = n0; c1 = n1; __syncthreads(); }
        for (t = 1; t + 1 < NTw; ) {
            PL_STEADY(t, 1); ++t;
            if (t + 1 < NTw) { PL_STEADY(t, 0); ++t; }
        }
    }
    if (t & 1) PL_TAIL(t, 1); else PL_TAIL(t, 0);
    for (++t; t < NT; ++t) { if (t & 1) PL_IO(t, 1); else PL_IO(t, 0); __syncthreads(); }
#undef PL_LOAD
#undef PL_STAGE
#undef PL_QK
#undef PL_PV
#undef PL_SOFTMAX
#undef PL_IO
#undef PL_STEADY
#undef PL_TAIL
    const float l_tot = half_sum(l_run);
    const float inv = 1.0f / l_tot;
    const size_t row = (size_t)(qlo + r);
#pragma unroll
    for (int mt = 0; mt < NMT; ++mt)
#pragma unroll
        for (int g4 = 0; g4 < 4; ++g4) {
            const int d = 32 * mt + 8 * g4 + 4 * hh;
            v2u ow; ow.x = pk2(o[mt][4 * g4] * inv, o[mt][4 * g4 + 1] * inv); ow.y = pk2(o[mt][4 * g4 + 2] * inv, o[mt][4 * g4 + 3] * inv);
            *(v2u*)(Ob + row * PP + d) = ow;
        }
}

__device__ __forceinline__ void attn_unit_mem(LAS unsigned char* lds, const bf16* Qb, const bf16* Kb, const bf16* VTb, const bf16* Zb, bf16* Ob, int q0) {
    constexpr int DQK = 128, KP = DQK + 8, VP = MEML + 8, NKS = DQK / 16, NMT = 4;
    LAS bf16* Ks = (LAS bf16*)lds; LAS bf16* Vs = Ks + MEML * KP;
    int tid_ = threadIdx.x; asm volatile("" : "+v"(tid_));
    const int tid = tid_, lane = tid & 63, w = __builtin_amdgcn_readfirstlane(tid >> 6), r = lane & 31, hh = lane >> 5;
    { v4u kk[8], vv[8];
#pragma unroll
      for (int i = 0; i < 8; ++i) { const int c = tid + 512 * i; kk[i] = *(const v4u*)(Kb + (size_t)(c >> 4) * 1024 + 8 * (c & 15)); vv[i] = *(const v4u*)(VTb + (size_t)(c >> 5) * MEML + 8 * (c & 31)); }
#pragma unroll
      for (int i = 0; i < 8; ++i) { const int c = tid + 512 * i; *(LAS v4u*)(Ks + (c >> 4) * KP + 8 * (c & 15)) = kk[i]; *(LAS v4u*)(Vs + (c >> 5) * VP + 8 * (c & 31)) = vv[i]; } }
    __syncthreads();
#pragma unroll 1
    for (int qb = 0; qb < 2; ++qb) {
        const int qlo = q0 + 256 * qb + 32 * w;
        bf16x8 qf[NKS];
        { const bf16* qrow = Qb + (size_t)(qlo + r) * PP + 8 * hh;
#pragma unroll
          for (int ks = 0; ks < NKS; ++ks) qf[ks] = *(const bf16x8*)(qrow + 16 * ks); }
        f32x16 o[NMT];
#pragma unroll
        for (int mt = 0; mt < NMT; ++mt)
#pragma unroll
            for (int i = 0; i < 16; ++i) o[mt][i] = 0.f;
        float m_run = NEGF, l_run = 0.f;
#pragma unroll 1
        for (int sub = 0; sub < MEML / 64; ++sub) {
            const LAS bf16* Kc = Ks + 64 * sub * KP; const LAS bf16* Vc = Vs + 64 * sub;
            f32x16 s0, s1;
#pragma unroll
            for (int i = 0; i < 16; ++i) { s0[i] = 0.f; s1[i] = 0.f; }
#pragma unroll
            for (int ks = 0; ks < NKS; ++ks) {
                const bf16x8 a0 = *(const LAS bf16x8*)(Kc + r * KP + 16 * ks + 8 * hh);
                const bf16x8 a1 = *(const LAS bf16x8*)(Kc + (32 + r) * KP + 16 * ks + 8 * hh);
                s0 = __builtin_amdgcn_mfma_f32_32x32x16_bf16(a0, qf[ks], s0, 0, 0, 0);
                s1 = __builtin_amdgcn_mfma_f32_32x32x16_bf16(a1, qf[ks], s1, 0, 0, 0);
            }
            float mx = s0[0];
#pragma unroll
            for (int i = 1; i < 16; ++i) mx = __builtin_fmaxf(mx, s0[i]);
#pragma unroll
            for (int i = 0; i < 16; ++i) mx = __builtin_fmaxf(mx, s1[i]);
            mx = half_max(mx);
            const float m_new = __builtin_fmaxf(m_run, mx);
            const float alpha = __builtin_amdgcn_exp2f(m_run - m_new);
            m_run = m_new;
            float ls = 0.f;
#pragma unroll
            for (int i = 0; i < 16; ++i) { s0[i] = __builtin_amdgcn_exp2f(s0[i] - m_new); s1[i] = __builtin_amdgcn_exp2f(s1[i] - m_new); ls += s0[i] + s1[i]; }
            l_run = l_run * alpha + ls;
#pragma unroll
            for (int mt = 0; mt < NMT; ++mt)
#pragma unroll
                for (int i = 0; i < 16; ++i) o[mt][i] *= alpha;
            v4u pf[2][2];
#pragma unroll
            for (int s = 0; s < 2; ++s) {
                pf[0][s] = (v4u){pk2(s0[8 * s], s0[8 * s + 1]), pk2(s0[8 * s + 2], s0[8 * s + 3]), pk2(s0[8 * s + 4], s0[8 * s + 5]), pk2(s0[8 * s + 6], s0[8 * s + 7])};
                pf[1][s] = (v4u){pk2(s1[8 * s], s1[8 * s + 1]), pk2(s1[8 * s + 2], s1[8 * s + 3]), pk2(s1[8 * s + 4], s1[8 * s + 5]), pk2(s1[8 * s + 6], s1[8 * s + 7])};
            }
#pragma unroll
            for (int mt = 0; mt < NMT; ++mt)
#pragma unroll
                for (int p = 0; p < 2; ++p)
#pragma unroll
                    for (int s = 0; s < 2; ++s) {
                        const LAS bf16* vp = Vc + (32 * mt + r) * VP + 32 * p + 16 * s + 4 * hh;
                        const s16x4 lo = *(const LAS s16x4*)(vp), hi = *(const LAS s16x4*)(vp + 8);
                        const bf16x8 a = (bf16x8){lo[0], lo[1], lo[2], lo[3], hi[0], hi[1], hi[2], hi[3]};
                        o[mt] = __builtin_amdgcn_mfma_f32_32x32x16_bf16(a, __builtin_bit_cast(bf16x8, pf[p][s]), o[mt], 0, 0, 0);
                    }
        }
        const float inv = 1.0f / half_sum(l_run);
        const size_t row = (size_t)(qlo + r);
#pragma unroll
        for (int mt = 0; mt < NMT; ++mt)
#pragma unroll
            for (int g4 = 0; g4 < 4; ++g4) {
                const int d = 32 * mt + 8 * g4 + 4 * hh;
                const v2u zw = *(const v2u*)(Zb + row * PP + d); const float z[4] = {bflo(zw.x), bfhi(zw.x), bflo(zw.y), bfhi(zw.y)};
                float ov[4];
#pragma unroll
                for (int i = 0; i < 4; ++i) ov[i] = o[mt][4 * g4 + i] * inv * (z[i] * __builtin_amdgcn_rcpf(1.0f + __expf(-z[i])));
                v2u ow; ow.x = pk2(ov[0], ov[1]); ow.y = pk2(ov[2], ov[3]);
                *(v2u*)(Ob + row * PP + d) = ow;
            }
    }
}

__device__ __forceinline__ bf16* gate_row(bf16* G0, bf16* G1, size_t row) { return row < 8192 ? G0 + row * 3072 : G1 + (row - 8192) * 3072; }
struct EpiZG {
    static constexpr bool PERM = true, AFTER_DRAIN = false;
    bf16* P; bf16* G0; bf16* G1;
    __device__ __forceinline__ void operator()(const pg8::f32x4 (&acc)[2][2][4][2], const pg8::Unit& u, int wr, int wc, int fr, int fq) const {
        const int row0 = u.pm * 256 + wr * 64 + fr, cl = wc * 32 + 8 * fq;
        const bool isz = u.pn < 4;
        const int ycol = (u.pn < 2 ? C_YA : C_YB) + (u.pn & 1) * 256, gcol = (u.pn - 4) * 256;
#pragma unroll
        for (int ai = 0; ai < 2; ++ai)
#pragma unroll
            for (int m = 0; m < 4; ++m) { const size_t row = (size_t)(row0 + ai * 128 + m * 16);
#pragma unroll
                for (int bj = 0; bj < 2; ++bj) {
                    const pg8::f32x4 v0 = acc[ai][bj][m][0], v1 = acc[ai][bj][m][1];
                    float rr[8] = {v0[0], v0[1], v0[2], v0[3], v1[0], v1[1], v1[2], v1[3]};
                    if (isz) { bf16* dst = P + row * PP + ycol + cl + bj * 128; const v4u old = *(const v4u*)dst; float yv[8]; UNPACK8(old, yv);
#pragma unroll
                        for (int e = 0; e < 8; ++e) rr[e] = yv[e] * (rr[e] * __builtin_amdgcn_rcpf(1.0f + __expf(-rr[e])));
                        *(v4u*)dst = PACK8(rr); }
                    else { bf16* dst = gate_row(G0, G1, row) + gcol + cl + bj * 128;
#pragma unroll
                        for (int e = 0; e < 8; ++e) rr[e] = __builtin_amdgcn_rcpf(1.0f + __expf(-rr[e]));
                        *(v4u*)dst = PACK8(rr); } } }
    }
};
struct EpiMerge {
    static constexpr bool PERM = true, AFTER_DRAIN = false;
    bf16* Mg; bf16* G0; bf16* G1; int nbr;
    __device__ __forceinline__ void operator()(const pg8::f32x4 (&acc)[2][2][4][2], const pg8::Unit& u, int wr, int wc, int fr, int fq) const {
        const int row0 = u.pm * 256 + wr * 64 + fr, col0 = u.pn * 256 + wc * 32 + 8 * fq;
#pragma unroll
        for (int ai = 0; ai < 2; ++ai)
#pragma unroll
            for (int m = 0; m < 4; ++m) { const size_t row = (size_t)(row0 + ai * 128 + m * 16);
#pragma unroll
                for (int bj = 0; bj < 2; ++bj) { const int col = col0 + bj * 128;
                    const v4u gwd = *(const v4u*)(gate_row(G0, G1, row) + nbr * 1024 + col);
                    float gl[8]; UNPACK8(gwd, gl);
                    const pg8::f32x4 v0 = acc[ai][bj][m][0], v1 = acc[ai][bj][m][1];
                    float rr[8] = {v0[0], v0[1], v0[2], v0[3], v1[0], v1[1], v1[2], v1[3]};
#pragma unroll
                    for (int e = 0; e < 8; ++e) rr[e] *= gl[e];
                    bf16* dst = Mg + row * 1024 + col;
                    if (nbr > 0) { const v4u old = *(const v4u*)dst; float ol[8]; UNPACK8(old, ol);
#pragma unroll
                        for (int e = 0; e < 8; ++e) rr[e] += ol[e]; }
                    *(v4u*)dst = PACK8(rr); } }
    }
};
struct EpiOut {
    static constexpr bool PERM = true, AFTER_DRAIN = false;
    const float* X; float* Out;
    __device__ __forceinline__ void operator()(const pg8::f32x4 (&acc)[2][2][4][2], const pg8::Unit& u, int wr, int wc, int fr, int fq) const {
        const int row0 = u.pm * 256 + wr * 64 + fr, col0 = u.pn * 256 + wc * 32 + 8 * fq;
#pragma unroll
        for (int ai = 0; ai < 2; ++ai)
#pragma unroll
            for (int m = 0; m < 4; ++m) { const size_t row = (size_t)(row0 + ai * 128 + m * 16);
#pragma unroll
                for (int bj = 0; bj < 2; ++bj) { const size_t p = row * 1024 + col0 + bj * 128;
                    const f32x4 x0 = *(const f32x4*)(X + p), x1 = *(const f32x4*)(X + p + 4);
                    const pg8::f32x4 a0 = acc[ai][bj][m][0], a1 = acc[ai][bj][m][1];
                    *(f32x4*)(Out + p) = (f32x4){x0[0] + a0[0], x0[1] + a0[1], x0[2] + a0[2], x0[3] + a0[3]};
                    *(f32x4*)(Out + p + 4) = (f32x4){x1[0] + a1[0], x1[1] + a1[1], x1[2] + a1[2], x1[3] + a1[3]}; } }
    }
};

#define XB_TMO      128
#define XB_XCNT(j)  (256  + 64 * (j))
#define XB_XSUB(j)  (1280 + 64 * (j))
#define XB_XGEN(j)  (2304 + 64 * (j))
#define XB_TOP      3328
#define XB_TOPGEN   3392
#define XCD_BAR_WORDS 3456
#define XB_SPIN_CAP (1u << 18)

__device__ __forceinline__ unsigned xb_ld(unsigned* p)              { return __hip_atomic_load(p, __ATOMIC_RELAXED, __HIP_MEMORY_SCOPE_AGENT); }
__device__ __forceinline__ unsigned xb_add(unsigned* p, unsigned v) { return __hip_atomic_fetch_add(p, v, __ATOMIC_RELAXED, __HIP_MEMORY_SCOPE_AGENT); }
__device__ __forceinline__ unsigned xb_xcc_id() { return (unsigned)__builtin_amdgcn_s_getreg((3 << 11) | 20) & 0xFu; }
#define XB_SPIN(cond, bar) do { unsigned _sp = 0; while (cond) { __builtin_amdgcn_s_sleep(1); \
    if ((++_sp & 255u) == 0u) { if (xb_ld(&(bar)[XB_TMO])) break; if (_sp > XB_SPIN_CAP) { atomicAdd(&(bar)[XB_TMO], 1u); break; } } } } while (0)

struct XcdBarrier {
    unsigned* bar; unsigned x;
    volatile LAS unsigned* st;
};

__device__ __forceinline__ XcdBarrier xcd_barrier_post(unsigned* bar, volatile LAS unsigned* st) {
    XcdBarrier b; b.bar = bar; b.x = xb_xcc_id(); b.st = st;
    if (threadIdx.x == 0) (void)xb_add(&bar[XB_XCNT(b.x)], 1u);
    return b;
}
__device__ __forceinline__ void xcd_barrier_complete(unsigned* bar, unsigned x, unsigned& nloc, unsigned& nx) {
    const unsigned G = gridDim.x * gridDim.y * gridDim.z;
    unsigned sum, cnt, mine, sp = 0u;
    for (;;) {
        sum = 0u; cnt = 0u; mine = 0u;
#pragma unroll
        for (unsigned j = 0; j < 16; ++j) { const unsigned c = xb_ld(&bar[XB_XCNT(j)]); sum += c; cnt += (c > 0u) ? 1u : 0u; mine = (j == x) ? c : mine; }
        if (sum == G) break;
        __builtin_amdgcn_s_sleep(1);
        if ((++sp & 255u) == 0u) { if (xb_ld(&bar[XB_TMO])) break; if (sp > XB_SPIN_CAP) { atomicAdd(&bar[XB_TMO], 1u); break; } }
    }
    nloc = mine > 0u ? mine : 1u; nx = cnt > 0u ? cnt : 1u;
}

__device__ __forceinline__ void xcd_barrier(const XcdBarrier& b) {
    asm volatile("s_waitcnt vmcnt(0)" ::: "memory");
    __syncthreads();
    if (threadIdx.x == 0) {
        unsigned* bar = b.bar;
        __builtin_amdgcn_s_waitcnt(0);
        unsigned nloc = b.st[0], nx = b.st[1];
        if (nloc == 0u) { xcd_barrier_complete(bar, b.x, nloc, nx); b.st[0] = nloc; b.st[1] = nx; }
        const unsigned old = xb_add(&bar[XB_XSUB(b.x)], 1u);
        const unsigned gen = old / nloc;
        if (old + 1u == (gen + 1u) * nloc) {
            __builtin_amdgcn_fence(__ATOMIC_RELEASE, "agent");
            asm volatile("s_waitcnt vmcnt(0)" ::: "memory");
            const unsigned og = xb_add(&bar[XB_TOP], 1u);
            const unsigned tg = og / nx;
            if (og + 1u == (tg + 1u) * nx) xb_add(&bar[XB_TOPGEN], 1u);
            else XB_SPIN(xb_ld(&bar[XB_TOPGEN]) == tg, bar);
            __builtin_amdgcn_fence(__ATOMIC_ACQUIRE, "agent");
            xb_add(&bar[XB_XGEN(b.x)], 1u);
            asm volatile("s_waitcnt vmcnt(0)" ::: "memory");
        } else {
            XB_SPIN(xb_ld(&bar[XB_XGEN(b.x)]) == gen, bar);
            __builtin_amdgcn_fence(__ATOMIC_ACQUIRE, "agent");
            asm volatile("s_waitcnt vmcnt(0)" ::: "memory");
        }
    }
    __syncthreads();
}

template <int DQK, int DV, int MODE>
__device__ __forceinline__ void att_call(bool strip, LAS unsigned char* lds, const bf16* Qb, int qpitch, const bf16* Kb, int kpitch, const bf16* VTb, int skv, const unsigned* maskb, const bf16* Zb, bf16* Ob, int q0) {
    if (ATT_STRIP != 0 && strip) attn_unit<DQK, DV, MODE, ATT_STRIP>(lds, Qb, qpitch, Kb, kpitch, VTb, skv, maskb, Zb, Ob, q0);
    else attn_unit<DQK, DV, MODE, 0>(lds, Qb, qpitch, Kb, kpitch, VTb, skv, maskb, Zb, Ob, q0);
}
struct Args { const float* in[19]; const int* pos; float* out; unsigned char* ws; };
typedef const __attribute__((address_space(4))) Args* kargs_t;
#define PHASE_BEGIN \
    kargs_t ap_ = (kargs_t)__builtin_amdgcn_kernarg_segment_ptr(); asm volatile("" : "+s"(ap_)); \
    int tid = threadIdx.x; asm volatile("" : "+v"(tid)); \
    const int lane = tid & 63, wave = __builtin_amdgcn_readfirstlane(tid >> 6), G = gridDim.x, NGW = G * 8, gw = blockIdx.x * 8 + wave; \
    unsigned char* const ws = ap_->ws; unsigned char* const dob = (unsigned char*)ap_->out; const int* const pos = ap_->pos; float* const outp = ap_->out; unsigned* const ctl = (unsigned*)(ws + WS_CTL); \
    const float* const x = ap_->in[0]; const float* const mem = ap_->in[1]; \
    const float* const g_norm = ap_->in[3]; const float* const w_in = ap_->in[4]; const float* const g_qn_a = ap_->in[5]; const float* const g_kn_a = ap_->in[6]; \
    const float* const g_cq = ap_->in[7]; const float* const g_ckv = ap_->in[8]; const float* const w_uq = ap_->in[9]; const float* const w_ukv = ap_->in[10]; \
    const float* const g_qn_b = ap_->in[11]; const float* const g_kn_b = ap_->in[12]; const float* const g_mem = ap_->in[13]; const float* const w_mem_kv = ap_->in[14]; \
    const float* const g_qn_m = ap_->in[15]; const float* const g_kn_m = ap_->in[16]; const float* const w_branch = ap_->in[17]; const float* const w_out = ap_->in[18]; \
    bf16* const WinT = (bf16*)(ws + WS_WIN); bf16* const WuqT = (bf16*)(ws + WS_WUQ); bf16* const WukvT = (bf16*)(ws + WS_WUKV); bf16* const WmemT = (bf16*)(ws + WS_WMEM); \
    bf16* const WbrT = (bf16*)(ws + WS_WBR); bf16* const WoutT = (bf16*)(ws + WS_WOUT); \
    float* const ropeA = (float*)(ws + WS_ROPEA); float* const ropeB = (float*)(ws + WS_ROPEB); \
    bf16* const MN = (bf16*)(ws + WS_MN); bf16* const KVM = (bf16*)(ws + WS_KVM); bf16* const VTM = (bf16*)(ws + WS_VTM); \
    float* const WI = (float*)(ws + WS_WI); unsigned* const MASK = (unsigned*)(ws + WS_MASK); \
    bf16* const VTA = (bf16*)(dob + DO_VTA); bf16* const VTB = (bf16*)(dob + DO_VTB); bf16* const KB = (bf16*)(dob + DO_KB); \
    bf16* const Hh = (bf16*)(ws + WS_H); bf16* const MG = (bf16*)(ws + WS_H); bf16* const QB = (bf16*)(ws + WS_QB); \
    bf16* const KVB = (bf16*)(ws + WS_KVB); bf16* const GT0 = (bf16*)(dob + DO_G0); bf16* const GT1 = (bf16*)(ws + WS_G1); bf16* const P = (bf16*)(ws + WS_P); \
    (void)lane; (void)NGW; (void)gw; (void)ctl; \
    (void)pos; (void)outp; (void)x; (void)mem; (void)g_norm; (void)w_in; (void)g_qn_a; (void)g_kn_a; (void)g_cq; (void)g_ckv; (void)w_uq; (void)w_ukv; (void)g_qn_b; (void)g_kn_b; (void)g_mem; (void)w_mem_kv; \
    (void)g_qn_m; (void)g_kn_m; (void)w_branch; (void)w_out; (void)WinT; (void)WuqT; (void)WukvT; (void)WmemT; (void)WbrT; (void)WoutT; (void)ropeA; (void)ropeB; (void)MN; (void)KVM; (void)VTM; (void)WI; (void)MASK; \
    (void)VTA; (void)VTB; (void)Hh; (void)KB; (void)QB; (void)KVB; (void)MG; (void)GT0; (void)GT1; (void)P
#define GRID_BARRIER() do { kargs_t bp_ = (kargs_t)__builtin_amdgcn_kernarg_segment_ptr(); asm volatile("" : "+s"(bp_)); \
    XcdBarrier b_; b_.bar = (unsigned*)(bp_->ws + WS_CTL) + 4096; b_.x = xb_xcc_id(); b_.st = (volatile LAS unsigned*)(lds + LDS_BYTES - 32); xcd_barrier(b_); } while (0)

__global__ void __launch_bounds__(512, 2) fwd_kernel(Args a) {
    extern __shared__ __attribute__((aligned(16))) unsigned char lds_raw[];
    LAS unsigned char* const lds = (LAS unsigned char*)lds_raw;
    volatile LAS int* const slot = (volatile LAS int*)(lds + LDS_SLOT);
    if (threadIdx.x < 16) ((LAS unsigned*)(lds + LDS_BYTES - 64))[threadIdx.x] = 0u;
    __syncthreads();
    (void)xcd_barrier_post((unsigned*)(a.ws + WS_CTL) + 4096, (volatile LAS unsigned*)(lds + LDS_BYTES - 32));

    for (int rep = 0; rep < REP_P0; ++rep) { PHASE_BEGIN;
        LAS float* scr = (LAS float*)(lds + wave * 16384);
        constexpr int I_IN = 16 * (NP / 32), I_UQ = 6 * 24, I_UKV = 4 * 32, I_MEM = 16 * 32, I_BR = 8 * 32, I_OUT = 16 * 32;
        constexpr int NITEMS = I_IN + I_UQ + I_UKV + I_MEM + 3 * I_BR + I_OUT;
        for (int it = gw; it < NITEMS; it += NGW) {
            int r = it;
            if (r < I_IN) { transpose_item<true>(w_in, 1024, DIN, NP, WinT, scr, r, lane); continue; } r -= I_IN;
            if (r < I_UQ) { transpose_item<false>(w_uq, 384, 768, 768, WuqT, scr, r, lane); continue; } r -= I_UQ;
            if (r < I_UKV) { transpose_item<false>(w_ukv, 256, 1024, 1024, WukvT, scr, r, lane); continue; } r -= I_UKV;
            if (r < I_MEM) { transpose_item<false>(w_mem_kv, 1024, 1024, 1024, WmemT, scr, r, lane); continue; } r -= I_MEM;
            if (r < 3 * I_BR) { const int nb = r / I_BR; transpose_item<false>(w_branch + (size_t)nb * 512 * 1024, 512, 1024, 1024, WbrT + (size_t)nb * 1024 * 512, scr, r % I_BR, lane); continue; } r -= 3 * I_BR;
            transpose_item<false>(w_out, 1024, 1024, 1024, WoutT, scr, r, lane);
        }
        for (int idx = blockIdx.x * 512 + tid; idx < TT * 24; idx += G * 512) {
            const int t = idx / 24, i = idx % 24; const float pf = (float)pos[t];
            if (i < 8) { const float ang = pf * INVA[i]; ropeA[t * 16 + i] = cosf(ang); ropeA[t * 16 + 8 + i] = sinf(ang); }
            else { const int j = i - 8; const float ang = pf * INVB[j]; ropeB[t * 32 + j] = cosf(ang); ropeB[t * 32 + 16 + j] = sinf(ang); }
        }
        for (int m = gw; m < NB * MEML; m += NGW) rms_row_1024(mem + (size_t)m * DM, g_mem, MN + (size_t)m * DM, lane);
        for (int rp = 0; rp < REP_PH; ++rp)
        for (int m = gw; m < TT; m += NGW) rms_row_1024(x + (size_t)m * DM, g_norm, Hh + (size_t)m * DM, lane);
    }
    GRID_BARRIER();
    for (int es = 0; es < EXTRA_SYNCS; ++es) GRID_BARRIER();

    for (int rep = 0; rep < REP_G1; ++rep) { PHASE_BEGIN;
        pg8::Gemm g{Hh, WinT, TT, PP, 1024, 1024}; pg8::StaticOrder S; S.init(TT, PP, G, (int)blockIdx.x);
        pg8::EpiBf16<0> E{P, PP, nullptr, 0, 0, 1.f};
        pg8::gemm_phase<pg8::EpiBf16<0>, pg8::StaticOrder, true, true>(lds, g, S, E);
    }
    { PHASE_BEGIN;
        pg8::Gemm g{MN, WmemT, NB * MEML, 1024, 1024, 1024}; pg8::StaticOrder S; S.init(NB * MEML, 1024, G, (int)((blockIdx.x + 64) % G));
        pg8::EpiBf16<0> E{KVM, 1024, nullptr, 0, 0, 1.f};
        pg8::gemm_phase<pg8::EpiBf16<0>, pg8::StaticOrder, true, true>(lds, g, S, E);
    }
    GRID_BARRIER();
    { PHASE_BEGIN;
        float ga[8], gk[8], gq[8], gc[8], gm[8];
#pragma unroll
        for (int j = 0; j < 8; ++j) { ga[j] = g_qn_a[8 * (lane & 7) + j]; gk[j] = g_kn_a[8 * (lane & 7) + j]; gm[j] = g_qn_m[8 * (lane & 15) + j]; gq[j] = lane < 48 ? g_cq[8 * lane + j] : 0.f; gc[j] = lane < 32 ? g_ckv[8 * lane + j] : 0.f; }
        for (int dp = 0; dp < DUMMY_POST1; ++dp)
            for (int m = gw; m < TT; m += NGW)
                post1_row(P + (size_t)m * PP, QB + (size_t)(m & 1023) * 4096, ropeA + (size_t)m * 16, ga, gk, gq, gc, gm, (float*)KVB + (size_t)m * 8, lane);
        for (int m = gw; m < TT; m += NGW)
            post1_row(P + (size_t)m * PP, P + (size_t)m * PP, ropeA + (size_t)m * 16, ga, gk, gq, gc, gm, WI + (size_t)m * 8, lane);
        for (int rt = 0; rt < REP_TR; ++rt)
        transpose_v(P, PP, C_VA, 64, 8, 64, SEQ, NB, VTA, gw, NGW, lane);
        for (int m = gw; m < NB * MEML; m += NGW) km_row(KVM + (size_t)m * 1024, g_kn_m, lane);
        for (int rt = 0; rt < REP_TR; ++rt)
        transpose_v(KVM, 1024, 512, 128, 4, 128, MEML, NB, VTM, gw, NGW, lane);
    }
    GRID_BARRIER();
    for (int rep = 0; rep < REP_G2; ++rep) { PHASE_BEGIN;
        pg8::Gemm g{P + C_CQ, WuqT, TT, 768, 384, PP}; pg8::StaticOrder S; S.init(TT, 768, G, (int)blockIdx.x);
        pg8::EpiBf16<0> E{QB, 768, nullptr, 0, 0, 1.f};
        pg8::gemm_phase<pg8::EpiBf16<0>, pg8::StaticOrder, true, true>(lds, g, S, E);
    }
    for (int rep = 0; rep < REP_G2; ++rep) { PHASE_BEGIN;
        pg8::Gemm g{P + C_CKV, WukvT, TT, 1024, 256, PP}; pg8::StaticOrder S; S.init(TT, 1024, G, (int)((blockIdx.x + 192) % G));
        pg8::EpiBf16<0> E{KVB, 1024, nullptr, 0, 0, 1.f};
        pg8::gemm_phase<pg8::EpiBf16<0>, pg8::StaticOrder, true, true>(lds, g, S, E);
    }
    for (int rep = 0; rep < REP_IDX; ++rep) { if (rep > 0) GRID_BARRIER();
        PHASE_BEGIN;
        unsigned* const q_idx = ctl + 64 * (0 + 4 * rep);
        for (;;) {
            const int u = next_unit(q_idx, slot);
            if (u >= NB * 128) break;
            const int tb = 127 - (u >> 3), bb = u & 7;
            indexer_unit((LAS float*)lds, P, WI, MASK, bb, tb);
        }
    }
    GRID_BARRIER();
    { PHASE_BEGIN;
        LAS float* scr = (LAS float*)(lds + wave * 8192);
        float gqv[12], gkv[12];
#pragma unroll
        for (int e = 0; e < 12; ++e) { gqv[e] = g_qn_b[12 * (lane & 7) + e]; gkv[e] = g_kn_b[12 * (lane & 7) + e]; }
        for (int dp = 0; dp < DUMMY_POST2; ++dp)
            for (int m = gw; m < TT; m += NGW)
                post2_row(QB + (size_t)m * 768, (bf16*)MASK + (size_t)(m & 1023) * 768, KVB + (size_t)m * 1024, P + (size_t)m * PP, (bf16*)MASK + (size_t)(1024 + (m & 1023)) * 768, ropeB + (size_t)m * 32, gqv, gkv, scr, lane);
        for (int m = gw; m < TT; m += NGW)
            post2_row(QB + (size_t)m * 768, QB + (size_t)m * 768, KVB + (size_t)m * 1024, P + (size_t)m * PP, KB + (size_t)m * 768, ropeB + (size_t)m * 32, gqv, gkv, scr, lane);
        for (int rt = 0; rt < REP_TR; ++rt)
        transpose_v(KVB, 1024, 64, 128, 8, 64, SEQ, NB, VTB, gw, NGW, lane);
    }
    GRID_BARRIER();
    for (int rep = 0; rep < REP_ATT; ++rep) { if (rep > 0) GRID_BARRIER();
        PHASE_BEGIN;
        unsigned* const q_att = ctl + 64 * (1 + 4 * rep);
        for (;;) {
            const int u = next_unit(q_att, slot);
            if (u >= 1152) break;
            if (u < 704 || u >= 832) {
                const int uu = u < 704 ? u : u - 128, cls = uu >> 6, bh = uu & 63, bb = bh >> 3, h = bh & 7;
                const bool isA = (0x52a7u >> cls) & 1u; const int qb = (int)((0x11232435467567ull >> (4 * cls)) & 15ull);
                const size_t r0 = (size_t)bb * SEQ;
                if (!isA) attn_unit_pipe<96, 1>(lds, QB + r0 * 768 + h * 96, 768, KB + r0 * 768 + h * 96, 768, VTB + (size_t)((bb * 8 + h) * 64) * SEQ, SEQ, nullptr,
                                                   P + r0 * PP + C_YB + h * 64, qb * 256);
                else attn_unit_pipe<64, 2>(lds, P + r0 * PP + C_QA + h * 64, PP, P + r0 * PP + C_KA + h * 64, PP, VTA + (size_t)((bb * 8 + h) * 64) * SEQ, SEQ, MASK + r0 * 64,
                                           P + r0 * PP + C_YA + h * 64, qb * 256);
            } else {
                const int v = u - 704, hq = v & 3, bh = v >> 2, bb = bh >> 2, h = bh & 3;
                const size_t r0 = (size_t)bb * SEQ;
                attn_unit_mem(lds, P + r0 * PP + C_QM + h * 128, KVM + (size_t)bb * MEML * 1024 + h * 128, VTM + (size_t)((bb * 4 + h) * 128) * MEML,
                              P + r0 * PP + C_ZM + h * 128, P + r0 * PP + C_YM + h * 128, hq * 512);
            }
        }
    }
    GRID_BARRIER();
    for (int rep = 0; rep < 1; ++rep) { PHASE_BEGIN;
        pg8::Gemm g{Hh, WinT + (size_t)PP * 1024, TT, NZG, 1024, 1024}; pg8::StaticOrder S; S.init(TT, NZG, G, (int)blockIdx.x);
        EpiZG E{P, GT0, GT1};
        pg8::gemm_phase<EpiZG, pg8::StaticOrder, true, true>(lds, g, S, E);
    }
    GRID_BARRIER();
    for (int nbr = 0; nbr < 3 * REP_G4; ++nbr) { const int nb = nbr % 3; PHASE_BEGIN;
        pg8::Gemm g{P + (nb == 0 ? C_YA : (nb == 1 ? C_YB : C_YM)), WbrT + (size_t)nb * 1024 * 512, TT, 1024, 512, PP}; pg8::StaticOrder S; S.init(TT, 1024, G, (int)blockIdx.x);
        EpiMerge E{MG, GT0, GT1, nb};
        pg8::gemm_phase<EpiMerge, pg8::StaticOrder, true, true>(lds, g, S, E);
    }
    GRID_BARRIER();
    for (int rep = 0; rep < REP_G5; ++rep) { PHASE_BEGIN;
        pg8::Gemm g{MG, WoutT, TT, 1024, 1024, 1024}; pg8::StaticOrder S; S.init(TT, 1024, G, (int)blockIdx.x);
        EpiOut E{x, outp};
        pg8::gemm_phase<EpiOut, pg8::StaticOrder, true, true>(lds, g, S, E);
    }
}

extern "C" void kernel_launch(void* const* d_in, const int* in_sizes, int n_in, void* d_out, int out_size, void* d_ws, size_t ws_size, hipStream_t stream) {
    static int grid = 0;
    if (grid == 0) {
        if (n_in != 19 || out_size != TT * DM || ws_size < WS_END) { fprintf(stderr, "kernel_launch: unexpected problem (n_in %d, out %d, ws %zu); nothing launched\n", n_in, out_size, ws_size); grid = -1; return; }
        int dev = 0, cus = 0, per_cu = 0;
        if (hipGetDevice(&dev) != hipSuccess || hipDeviceGetAttribute(&cus, hipDeviceAttributeMultiprocessorCount, dev) != hipSuccess) { grid = -1; return; }
        if (hipFuncSetAttribute((const void*)fwd_kernel, hipFuncAttributeMaxDynamicSharedMemorySize, LDS_BYTES) != hipSuccess) { fprintf(stderr, "kernel_launch: hipFuncSetAttribute failed\n"); grid = -1; return; }
        if (hipOccupancyMaxActiveBlocksPerMultiprocessor(&per_cu, (const void*)fwd_kernel, 512, LDS_BYTES) != hipSuccess || per_cu < 1) { fprintf(stderr, "kernel_launch: occupancy query reports %d blocks per CU\n", per_cu); (void)hipGetLastError(); grid = -1; return; }
        grid = cus;
    }
    if (grid < 0) return;
    (void)hipMemsetAsync((char*)d_ws + WS_CTL, 0, 65536, stream);
    Args a{};
    for (int i = 0; i < 19; ++i) a.in[i] = (const float*)d_in[i];
    a.pos = (const int*)d_in[2]; a.out = (float*)d_out; a.ws = (unsigned char*)d_ws;
    hipLaunchKernelGGL(fwd_kernel, dim3(grid), dim3(512), LDS_BYTES, stream, a);
    const hipError_t e = hipPeekAtLastError();
    if (e != hipSuccess) fprintf(stderr, "kernel_launch: launch failed: %s (grid %d)\n", hipGetErrorString(e), grid);
}
```

```cpp
#include <hip/hip_runtime.h>
#include <cstdio>
#include <cstdint>
namespace pg8 {
#define PG8_LAS __attribute__((address_space(3)))
typedef unsigned short bf16_t;
typedef short bf16x8 __attribute__((ext_vector_type(8)));
typedef float f32x4 __attribute__((ext_vector_type(4)));
typedef unsigned u32x4 __attribute__((ext_vector_type(4)));
constexpr int BM = 256, BK = 64, HALF = 128, HTB = HALF * BK * 2  , STAGE_BYTES = 8 * HTB, NXCD = 8, WGM = 8;

__host__ __device__ __forceinline__ int lds_byte(int r, int c) { const int st = (r >> 4) * 2 + (c >> 5), rr = r & 15, cc = c & 31, ob = rr * 64 + cc * 2; return st * 1024 + (ob ^ (((ob >> 9) & 1) << 5)); }
__host__ __device__ __forceinline__ void stage_rc(int b, int& R, int& C) { const int st = b / 1024, sb = b % 1024, swz = sb ^ (((sb >> 9) & 1) << 5); R = (st >> 1) * 16 + swz / 64; C = (st & 1) * 32 + (swz % 64) / 2; }
__host__ __device__ __forceinline__ int perm32(int rho) { const int n = rho >> 4, i = rho & 15; return 8 * (i >> 2) + 4 * n + (i & 3); }

struct Unit { int pm, pn; };
struct Gemm { const bf16_t* A; const bf16_t* Bt; int M, N, K, lda; };

struct StaticOrder {
    int nM, nN, nwg, G, c;
    __host__ __device__ void init(int M, int N, int G_, int c_) { nM = M / BM; nN = N / BM; nwg = nM * nN; G = G_; c = c_; }
    __host__ __device__ bool next(int i, Unit& u) const {
        const long L = (long)i * G + c; if (L >= nwg) return false;
        int wgid = (int)L; { const int q = nwg / NXCD, r = nwg % NXCD, xcd = wgid % NXCD, off = wgid / NXCD; wgid = (xcd < r ? xcd * (q + 1) : r * (q + 1) + (xcd - r) * q) + off; }
        const int nig = WGM * nN, gid = wgid / nig, fm = gid * WGM, gsz = (nM - fm) < WGM ? (nM - fm) : WGM;
        u.pm = fm + ((wgid % nig) % gsz); u.pn = (wgid % nig) / gsz; return true;
    }
    __device__ __forceinline__ void a_ready(const Unit&) const {}
    __device__ __forceinline__ void done(const Unit&) const {}
};

__device__ __forceinline__ unsigned cvt_pk_bf16(float lo, float hi) { unsigned r; asm volatile("v_cvt_pk_bf16_f32 %0, %1, %2" : "=v"(r) : "v"(lo), "v"(hi)); return r; }
typedef float f32x2 __attribute__((ext_vector_type(2)));
__device__ __forceinline__ f32x2 gelu_pk(f32x2 v) {
    const f32x2 av = __builtin_elementwise_abs(v), d = av * 0.2316418882f + 1.0f;
    f32x2 t; t.x = __builtin_amdgcn_rcpf(d.x); t.y = __builtin_amdgcn_rcpf(d.y);
    f32x2 q = t * 0.5307027145f + (-0.7265760135f); q = q * t + 0.7107068705f; q = q * t + (-0.142248368f); q = q * t + 0.127414796f; q = q * t;
    const f32x2 s = (v * v) * (-0.72134752044f);
    f32x2 e; e.x = __builtin_amdgcn_exp2f(s.x); e.y = __builtin_amdgcn_exp2f(s.y);
    const f32x2 m = v * (q * e), r = v - m;
    f32x2 o; o.x = v.x < 0.f ? m.x : r.x; o.y = v.y < 0.f ? m.y : r.y; return o;
}

template <int ACT  > struct EpiBf16 {
    static constexpr bool PERM = true, AFTER_DRAIN = false; static_assert(ACT == 0 || ACT == 1, "EpiBf16: ACT is 0 (none) or 1 (gelu_pk)");
    bf16_t* O; int ldc; const float* bias; int split_cols; size_t split_stride; float scale0;
    __device__ __forceinline__ void operator()(const f32x4 (&acc)[2][2][4][2], const Unit& u, int wr, int wc, int fr, int fq) const {
        const int row0 = u.pm * BM + wr * 64 + fr; int colt = u.pn * BM; bf16_t* base = O;
        float sc = 1.f; if (split_cols) { const int t = colt / split_cols; base += (size_t)t * split_stride; colt -= t * split_cols; if (t == 0) sc = scale0; }
        const int col0 = colt + wc * 32 + 8 * fq, bcol0 = u.pn * BM + wc * 32 + 8 * fq;
        f32x4 bv[2][2];
#pragma unroll
        for (int bj = 0; bj < 2; ++bj)
#pragma unroll
            for (int n = 0; n < 2; ++n) bv[bj][n] = bias ? *(const f32x4*)(bias + bcol0 + bj * HALF + 4 * n) : (f32x4){0.f, 0.f, 0.f, 0.f};
#pragma unroll
        for (int ai = 0; ai < 2; ++ai)
#pragma unroll
            for (int m = 0; m < 4; ++m) { bf16_t* rowp = base + (size_t)(row0 + ai * HALF + m * 16) * ldc + col0;
#pragma unroll
                for (int bj = 0; bj < 2; ++bj) { f32x4 v0 = acc[ai][bj][m][0] + bv[bj][0], v1 = acc[ai][bj][m][1] + bv[bj][1];
                    if (ACT == 1) { f32x2 a = gelu_pk((f32x2){v0[0], v0[1]}), b = gelu_pk((f32x2){v0[2], v0[3]}), c = gelu_pk((f32x2){v1[0], v1[1]}), d = gelu_pk((f32x2){v1[2], v1[3]});
                        v0 = (f32x4){a.x, a.y, b.x, b.y}; v1 = (f32x4){c.x, c.y, d.x, d.y}; }
                    v0 = v0 * sc; v1 = v1 * sc; u32x4 w; w.x = cvt_pk_bf16(v0[0], v0[1]); w.y = cvt_pk_bf16(v0[2], v0[3]); w.z = cvt_pk_bf16(v1[0], v1[1]); w.w = cvt_pk_bf16(v1[2], v1[3]);
                    *(u32x4*)(rowp + bj * HALF) = w; } }
    }
};
template <class Epi, class Sched, bool ALIGN_EPI = false, bool SP2 = false>
__device__ __forceinline__ void gemm_phase(PG8_LAS unsigned char* lds, const Gemm g, const Sched& S, const Epi& E) {
    int tid_ = threadIdx.x; asm volatile("" : "+v"(tid_));
    const int tid = tid_, wid = __builtin_amdgcn_readfirstlane(tid >> 6), lane = tid & 63, wr = wid >> 2, wc = wid & 3, fr = lane & 15, fq = lane >> 4;
    const int K = g.K, nt = K / BK;
    unsigned voffA[2], voffB[2];
#pragma unroll
    for (int i = 0; i < 2; ++i) { int R, C; stage_rc(tid * 16 + i * 8192, R, C); const int Rb = Epi::PERM ? ((R & ~31) + perm32(R & 31)) : R;
        voffA[i] = (unsigned)(R * g.lda + C) * 2u; voffB[i] = (unsigned)(Rb * K + C) * 2u; }
    const size_t kstep = (size_t)(BK * 2);
    const size_t hstepA = (size_t)HALF * g.lda * 2, hstepB = (size_t)HALF * K * 2;
    const size_t tstepA = 2 * hstepA, tstepB = 2 * hstepB;
    const unsigned ldsw = (unsigned)wid * 1024u;
    const int aoff = lds_byte(wr * 64 + fr, fq * 8), boff = lds_byte(wc * 32 + fr, fq * 8);
#define PG8_SA(b, h) (((b) * 2 + (h)) * HTB)
#define PG8_SB(b, h) ((4 + (b) * 2 + (h)) * HTB)
#define PG8_STAGE(bufoff, gbase, voff) do { _Pragma("unroll") for (int _i = 0; _i < 2; ++_i) \
        __builtin_amdgcn_global_load_lds((const unsigned*)((const char*)(gbase) + (voff)[_i]), (PG8_LAS unsigned*)(lds + (bufoff) + ldsw + _i * 8192), 16, 0, 0); } while (0)
#define PG8_LDA(dst, b, h) do { _Pragma("unroll") for (int m = 0; m < 4; ++m) _Pragma("unroll") for (int k = 0; k < 2; ++k) dst[m][k] = *(const PG8_LAS bf16x8*)(lds + PG8_SA(b, h) + aoff + m * 2048 + k * 1024); } while (0)
#define PG8_LDB(dst, b, h) do { _Pragma("unroll") for (int n = 0; n < 2; ++n) _Pragma("unroll") for (int k = 0; k < 2; ++k) dst[n][k] = *(const PG8_LAS bf16x8*)(lds + PG8_SB(b, h) + boff + n * 2048 + k * 1024); } while (0)
#define PG8_MMA(ai, bj, At, Bt) do { __builtin_amdgcn_s_setprio(1); _Pragma("unroll") for (int m = 0; m < 4; ++m) _Pragma("unroll") for (int n = 0; n < 2; ++n) _Pragma("unroll") for (int k = 0; k < 2; ++k) \
        acc[ai][bj][m][n] = __builtin_amdgcn_mfma_f32_16x16x32_bf16(Bt[n][k], At[m][k], acc[ai][bj][m][n], 0, 0, 0); __builtin_amdgcn_s_setprio(0); } while (0)
#define PG8_WAIT_V(n) asm volatile("s_waitcnt vmcnt(" #n ")" ::: "memory")
#define PG8_WAIT_L(n) asm volatile("s_waitcnt lgkmcnt(" #n ")" ::: "memory")
#define PG8_BAR __builtin_amdgcn_s_barrier()
#define PG8_SCHED __builtin_amdgcn_sched_barrier(0)
    Unit cur, nxt; int ui = 0;
    if (!S.next(0, cur)) return;
    f32x4 acc[2][2][4][2];
#pragma unroll
    for (int a = 0; a < 2; ++a)
#pragma unroll
        for (int b = 0; b < 2; ++b)
#pragma unroll
            for (int m = 0; m < 4; ++m)
#pragma unroll
                for (int n = 0; n < 2; ++n) acc[a][b][m][n] = (f32x4){0.f, 0.f, 0.f, 0.f};
    bf16x8 At[4][2], B0[2][2], B1[2][2];
    const char* cA = (const char*)g.A + (size_t)cur.pm * tstepA; const char* cB = (const char*)g.Bt + (size_t)cur.pn * tstepB;
    S.a_ready(cur);
    if constexpr (SP2) {
        PG8_STAGE(PG8_SB(0, 0), cB, voffB); PG8_STAGE(PG8_SB(0, 1), cB + hstepB, voffB); PG8_STAGE(PG8_SA(0, 0), cA, voffA); PG8_STAGE(PG8_SA(0, 1), cA + hstepA, voffA);
        if (wr == 1) PG8_BAR;
        PG8_WAIT_V(2); PG8_BAR;
        PG8_STAGE(PG8_SB(1, 0), cB + kstep, voffB); PG8_STAGE(PG8_SA(1, 0), cA + kstep, voffA); PG8_STAGE(PG8_SB(1, 1), cB + hstepB + kstep, voffB);
        PG8_WAIT_V(6); PG8_BAR;
    } else {
        PG8_STAGE(PG8_SB(0, 0), cB, voffB); PG8_STAGE(PG8_SA(0, 0), cA, voffA); PG8_STAGE(PG8_SB(0, 1), cB + hstepB, voffB); PG8_STAGE(PG8_SA(0, 1), cA + hstepA, voffA);
        if (wr == 1) PG8_BAR;
        PG8_WAIT_V(4); PG8_BAR;
        PG8_STAGE(PG8_SB(1, 0), cB + kstep, voffB); PG8_STAGE(PG8_SA(1, 0), cA + kstep, voffA); PG8_STAGE(PG8_SB(1, 1), cB + hstepB + kstep, voffB);
        PG8_WAIT_V(6); PG8_BAR;
    }
    for (;;) {
        const bool has_next = S.next(ui + 1, nxt);
        const char* nA = has_next ? (const char*)g.A + (size_t)nxt.pm * tstepA : cA; const char* nB = has_next ? (const char*)g.Bt + (size_t)nxt.pn * tstepB : cB;
        for (int t = 0; t < nt; t += 2) {
            const bool last = (t == nt - 2);
            const char* a1 = cA + (size_t)(t + 1) * kstep;
            const char* a2 = last ? nA : cA + (size_t)(t + 2) * kstep; const char* b2 = last ? nB : cB + (size_t)(t + 2) * kstep;
            const char* a3 = a2 + kstep; const char* b3 = b2 + kstep;
            if (last && has_next) S.a_ready(nxt);
            if constexpr (SP2) {
            PG8_LDB(B0, 0, 0); PG8_LDB(B1, 0, 1); PG8_SCHED; PG8_LDA(At, 0, 0); PG8_STAGE(PG8_SA(1, 1), a1 + hstepA, voffA);
            PG8_WAIT_V(8); PG8_WAIT_L(0); PG8_BAR; PG8_MMA(0, 0, At, B0); PG8_MMA(0, 1, At, B1); PG8_BAR; PG8_SCHED;
            PG8_LDA(At, 0, 1); PG8_STAGE(PG8_SB(0, 0), b2, voffB); PG8_STAGE(PG8_SB(0, 1), b2 + hstepB, voffB); PG8_STAGE(PG8_SA(0, 0), a2, voffA);
            PG8_WAIT_V(8); PG8_WAIT_L(0); PG8_BAR; PG8_MMA(1, 0, At, B0); PG8_MMA(1, 1, At, B1); PG8_BAR; PG8_SCHED;
            PG8_LDB(B0, 1, 0); PG8_LDB(B1, 1, 1); PG8_SCHED; PG8_LDA(At, 1, 0); PG8_STAGE(PG8_SA(0, 1), a2 + hstepA, voffA);
            PG8_WAIT_V(8); PG8_WAIT_L(0); PG8_BAR; PG8_MMA(0, 0, At, B0); PG8_MMA(0, 1, At, B1); PG8_BAR; PG8_SCHED;
            PG8_LDA(At, 1, 1); PG8_STAGE(PG8_SB(1, 0), b3, voffB); PG8_STAGE(PG8_SB(1, 1), b3 + hstepB, voffB); PG8_STAGE(PG8_SA(1, 0), a3, voffA);
            PG8_WAIT_V(8); PG8_WAIT_L(0); PG8_BAR; PG8_MMA(1, 0, At, B0); PG8_MMA(1, 1, At, B1); PG8_BAR; PG8_SCHED;
            } else {
            PG8_LDB(B0, 0, 0); PG8_SCHED; PG8_LDA(At, 0, 0); PG8_STAGE(PG8_SA(1, 1), a1 + hstepA, voffA);
            PG8_WAIT_L(8); PG8_BAR; PG8_WAIT_L(0); PG8_MMA(0, 0, At, B0); PG8_BAR; PG8_SCHED;
            PG8_LDB(B1, 0, 1); PG8_STAGE(PG8_SB(0, 0), b2, voffB);
            PG8_BAR; PG8_WAIT_L(0); PG8_MMA(0, 1, At, B1); PG8_BAR;
            PG8_LDA(At, 0, 1); PG8_STAGE(PG8_SA(0, 0), a2, voffA);
            PG8_BAR; PG8_WAIT_L(0); PG8_MMA(1, 0, At, B0); PG8_BAR; PG8_SCHED;
            PG8_STAGE(PG8_SB(0, 1), b2 + hstepB, voffB);
            PG8_WAIT_V(6); PG8_BAR; PG8_MMA(1, 1, At, B1); PG8_BAR;
            PG8_LDB(B0, 1, 0); PG8_SCHED; PG8_LDA(At, 1, 0); PG8_STAGE(PG8_SA(0, 1), a2 + hstepA, voffA);
            PG8_WAIT_L(8); PG8_BAR; PG8_WAIT_L(0); PG8_MMA(0, 0, At, B0); PG8_BAR; PG8_SCHED;
            PG8_LDB(B1, 1, 1); PG8_STAGE(PG8_SB(1, 0), b3, voffB);
            PG8_BAR; PG8_WAIT_L(0); PG8_MMA(0, 1, At, B1); PG8_BAR;
            PG8_LDA(At, 1, 1); PG8_STAGE(PG8_SA(1, 0), a3, voffA);
            PG8_BAR; PG8_WAIT_L(0); PG8_MMA(1, 0, At, B0); PG8_BAR; PG8_SCHED;
            PG8_STAGE(PG8_SB(1, 1), b3 + hstepB, voffB);
            PG8_WAIT_V(6); PG8_BAR; PG8_MMA(1, 1, At, B1); PG8_BAR;
            }
        }
        if constexpr (ALIGN_EPI) { if (wr == 0) PG8_BAR; }
        if constexpr (!Epi::AFTER_DRAIN) { E(acc, cur, wr, wc, fr, fq); S.done(cur); }
        if (!has_next) break;
#pragma unroll
        for (int a = 0; a < 2; ++a)
#pragma unroll
            for (int b = 0; b < 2; ++b)
#pragma unroll
                for (int m = 0; m < 4; ++m)
#pragma unroll
                    for (int n = 0; n < 2; ++n) acc[a][b][m][n] = (f32x4){0.f, 0.f, 0.f, 0.f};
        cur = nxt; cA = nA; cB = nB; ++ui;
        if constexpr (ALIGN_EPI) { if (wr == 1) PG8_BAR; }
    }
    PG8_WAIT_V(0);
    if constexpr (!ALIGN_EPI) { if (wr == 0) PG8_BAR; }
    PG8_BAR;
    if constexpr (Epi::AFTER_DRAIN) { E.fused(acc, cur, wr, wc, fr, fq, lds, wid, lane); S.done(cur); }
#undef PG8_SA
#undef PG8_SB
#undef PG8_STAGE
#undef PG8_LDA
#undef PG8_LDB
#undef PG8_MMA
#undef PG8_WAIT_V
#undef PG8_WAIT_L
#undef PG8_BAR
#undef PG8_SCHED
}
}

#define LAS __attribute__((address_space(3)))
typedef unsigned short bf16;
typedef unsigned v4u __attribute__((ext_vector_type(4)));
typedef unsigned v2u __attribute__((ext_vector_type(2)));
typedef float f32x4 __attribute__((ext_vector_type(4)));
typedef float f32x16 __attribute__((ext_vector_type(16)));
typedef short bf16x8 __attribute__((ext_vector_type(8)));
typedef short s16x4 __attribute__((ext_vector_type(4)));
typedef float f32x2_t __attribute__((ext_vector_type(2)));
typedef __bf16 bf16x2_t __attribute__((ext_vector_type(2)));

constexpr int NB = 8, SEQ = 2048, DM = 1024, TT = NB * SEQ;
constexpr int DIN = 7912, NP = 7936;
constexpr int PP = 3840, NZG = 4096;
constexpr int MEML = 256;
constexpr float EPS = 1e-6f, NEGF = -1e30f;
constexpr int C_QA = 0, C_KA = 512, C_VA = 1024, C_QI = 1536, C_KI = 2048, C_WI = 2112, C_CQ = 2120, C_CKV = 2504, C_KR = 2760, C_QM = 2792, C_ZM = 3304;
constexpr int C_YA = C_QI, C_YB = C_CQ, C_YM = C_VA;
constexpr float SCALE_A = 0.18033688011112042f;
constexpr float SCALE_B = 0.14724444602590306f;
constexpr float SCALE_M = 0.12751743082459868f;
constexpr float SCALE_I = 0.04419417382415922f;

__constant__ float INVA[8] = {1.0f, 0.1939227432012558f, 0.03760603070259094f, 0.007292664609849453f, 0.0014142135623842478f, 0.00027424818836152554f, 5.3182957344688475e-05f, 1.0313385246263351e-05f};
__constant__ float INVB[16] = {1.0f, 0.44036659598350525f, 0.1939227432012558f, 0.08539710193872452f, 0.03760603070259094f, 0.016560440883040428f, 0.007292664609849453f, 0.0032114461064338684f, 0.0014142135623842478f, 0.0006227724370546639f, 0.00027424818836152554f, 0.00012076973507646471f, 5.3182957344688475e-05f, 2.34199997066753e-05f, 1.0313385246263351e-05f, 4.541670477919979e-06f};

constexpr size_t MiB = 1u << 20;
constexpr size_t WS_CTL = 0;
constexpr size_t WS_WIN = 1 * MiB;
constexpr size_t WS_WUQ = 17 * MiB;
constexpr size_t WS_WUKV = 18 * MiB;
constexpr size_t WS_WMEM = 19 * MiB;
constexpr size_t WS_WBR = 21 * MiB;
constexpr size_t WS_WOUT = 24 * MiB;
constexpr size_t WS_ROPEA = 26 * MiB;
constexpr size_t WS_ROPEB = 27 * MiB;
constexpr size_t WS_MN = 29 * MiB;
constexpr size_t WS_KVM = 33 * MiB;
constexpr size_t WS_VTM = 37 * MiB;
constexpr size_t WS_WI = 39 * MiB;
constexpr size_t WS_MASK = 40 * MiB;
constexpr size_t WS_H = 44 * MiB;
constexpr size_t WS_P = 76 * MiB;
constexpr size_t WS_QB = 196 * MiB;
constexpr size_t WS_KVB = 220 * MiB;
constexpr size_t WS_G1 = 196 * MiB;
constexpr size_t WS_END = 256 * MiB;
constexpr size_t DO_VTA = 0;
constexpr size_t DO_VTB = 16 * MiB;
constexpr size_t DO_KB = 32 * MiB;
constexpr size_t DO_G0 = 0;

constexpr int REP_P0 = 1, REP_PH = 1, REP_G1 = 1, REP_G2 = 1, REP_IDX = 1, REP_ATT = 1, REP_G4 = 1, REP_G5 = 1;
constexpr int REP_IDX1 = 1, REP_SEL = 1;
constexpr int ATT_STRIP = 0;
constexpr int EXTRA_SYNCS = 0, REP_TR = 1, DUMMY_POST1 = 0, DUMMY_POST2 = 0;
constexpr int LDS_BYTES = 147456;
constexpr int LDS_SLOT = LDS_BYTES - 64;

__device__ __forceinline__ unsigned pk2(float lo, float hi) { f32x2_t v = {lo, hi}; bf16x2_t b = __builtin_convertvector(v, bf16x2_t); return __builtin_bit_cast(unsigned, b); }
__device__ __forceinline__ float bflo(unsigned w) { return __uint_as_float(w << 16); }
__device__ __forceinline__ float bfhi(unsigned w) { return __uint_as_float(w & 0xffff0000u); }
__device__ __forceinline__ float bf1(bf16 b) { return __uint_as_float(((unsigned)b) << 16); }
#define UNPACK8(W_, V_) do { V_[0] = bflo((W_)[0]); V_[1] = bfhi((W_)[0]); V_[2] = bflo((W_)[1]); V_[3] = bfhi((W_)[1]); V_[4] = bflo((W_)[2]); V_[5] = bfhi((W_)[2]); V_[6] = bflo((W_)[3]); V_[7] = bfhi((W_)[3]); } while (0)
#define PACK8(V_) (v4u){pk2(V_[0], V_[1]), pk2(V_[2], V_[3]), pk2(V_[4], V_[5]), pk2(V_[6], V_[7])}
template <int CTRL> __device__ __forceinline__ float dpp_f(float v) { return __int_as_float(__builtin_amdgcn_update_dpp(0, __float_as_int(v), CTRL, 0xF, 0xF, false)); }
#define SUM8(x) do { x += dpp_f<0xB1>(x); x += dpp_f<0x4E>(x); x += dpp_f<0x141>(x); } while (0)
#define SUM16(x) do { SUM8(x); x += dpp_f<0x140>(x); } while (0)
__device__ __forceinline__ float wave_sum(float v) {
    SUM16(v);
    return __int_as_float(__builtin_amdgcn_readlane(__float_as_int(v), 0)) + __int_as_float(__builtin_amdgcn_readlane(__float_as_int(v), 16))
         + __int_as_float(__builtin_amdgcn_readlane(__float_as_int(v), 32)) + __int_as_float(__builtin_amdgcn_readlane(__float_as_int(v), 48));
}
#define LDS_WAIT() asm volatile("s_waitcnt lgkmcnt(0)" ::: "memory")

__device__ __forceinline__ int win_src(int d) {
    if (d < 2120) return d;
    if (d < 2792) return d + 512;
    if (d < 3816) return d + 1024;
    if (d < 3840) return -1;
    if (d < 4352) return d - 3840 + 2120;
    if (d < 4864) return d - 4352 + 3304;
    return d - 4864 + 4840;
}
template <bool REMAP>
__device__ __forceinline__ void transpose_item(const float* W, int K, int N, int Npad, bf16* WT, LAS float* scr, int item, int lane) {
    const int nblk = Npad / 32, kb = item / nblk, nb = item % nblk, k0 = 64 * kb, n0 = 32 * nb;
    const int n4 = 4 * (lane & 7);
    const int nn = REMAP ? win_src(n0 + n4) : n0 + n4; const bool ok = nn >= 0 && nn < N;
#pragma unroll
    for (int i = 0; i < 8; ++i) { const int kk = 8 * i + (lane >> 3);
        f32x4 v = (f32x4){0.f, 0.f, 0.f, 0.f}; if (ok) v = *(const f32x4*)(W + (size_t)(k0 + kk) * N + nn);
        LAS float* d = scr + kk * 33 + n4; d[0] = v[0]; d[1] = v[1]; d[2] = v[2]; d[3] = v[3]; }
    LDS_WAIT(); asm volatile("" ::: "memory");
    const int c = lane & 7;
#pragma unroll
    for (int j = 0; j < 4; ++j) { const int n = (lane >> 3) + 8 * j; const LAS float* s = scr + (8 * c) * 33 + n;
        v4u o; o.x = pk2(s[0 * 33], s[1 * 33]); o.y = pk2(s[2 * 33], s[3 * 33]); o.z = pk2(s[4 * 33], s[5 * 33]); o.w = pk2(s[6 * 33], s[7 * 33]);
        *(v4u*)(WT + (size_t)(n0 + n) * K + k0 + 8 * c) = o; }
    LDS_WAIT(); asm volatile("" ::: "memory");
}
__device__ __forceinline__ void rms_row_1024(const float* xrow, const float* g, bf16* orow, int lane) {
    const f32x4* xr = (const f32x4*)xrow + lane; const f32x4* gr = (const f32x4*)g + lane;
    f32x4 v[4]; float s = 0.f;
#pragma unroll
    for (int j = 0; j < 4; ++j) { v[j] = xr[64 * j]; s += (v[j].x * v[j].x + v[j].y * v[j].y) + (v[j].z * v[j].z + v[j].w * v[j].w); }
    const float rstd = __builtin_amdgcn_rsqf(wave_sum(s) * (1.f / 1024.f) + EPS);
    v2u* o8 = (v2u*)orow + lane;
#pragma unroll
    for (int j = 0; j < 4; ++j) { const f32x4 gg = gr[64 * j]; v2u w; w.x = pk2(v[j].x * rstd * gg.x, v[j].y * rstd * gg.y); w.y = pk2(v[j].z * rstd * gg.z, v[j].w * rstd * gg.w); o8[64 * j] = w; }
}

#define ROPE8(v, sub, c8, s8) do { _Pragma("unroll") for (int j_ = 0; j_ < 8; ++j_) { const float pv_ = dpp_f<0xB1>(v[j_]); \
        const float r0_ = v[j_] * c8[j_] - pv_ * s8[j_], r1_ = v[j_] * c8[j_] + pv_ * s8[j_]; v[j_] = (sub) == 0 ? r0_ : ((sub) == 1 ? r1_ : v[j_]); } } while (0)

__device__ __forceinline__ void post1_row(const bf16* Prow, bf16* Orow, const float* ra, const float (&ga)[8], const float (&gk)[8], const float (&gq)[8], const float (&gc)[8], const float (&gm)[8], float* WIrow, int lane) {
    const int sub = lane & 7;
    const v4u z4 = (v4u){0u, 0u, 0u, 0u};
    const v4u w_qa = *(const v4u*)(Prow + C_QA + 8 * lane);
    const v4u w_ka = *(const v4u*)(Prow + C_KA + 8 * lane);
    const v4u w_qi = *(const v4u*)(Prow + C_QI + 8 * lane);
    const v4u w_qm = *(const v4u*)(Prow + C_QM + 8 * lane);
    v4u w_ki = z4, w_cq = z4, w_ckv = z4; float w_wi = 0.f;
    if (lane < 8) { w_ki = *(const v4u*)(Prow + C_KI + 8 * lane); w_wi = bf1(Prow[C_WI + lane]); }
    if (lane < 48) w_cq = *(const v4u*)(Prow + C_CQ + 8 * lane);
    if (lane < 32) w_ckv = *(const v4u*)(Prow + C_CKV + 8 * lane);
    float c8[8], s8[8];
    { const f32x4 r0 = *(const f32x4*)(ra), r1 = *(const f32x4*)(ra + 4), r2 = *(const f32x4*)(ra + 8), r3 = *(const f32x4*)(ra + 12);
      c8[0] = r0[0]; c8[1] = r0[1]; c8[2] = r0[2]; c8[3] = r0[3]; c8[4] = r1[0]; c8[5] = r1[1]; c8[6] = r1[2]; c8[7] = r1[3];
      s8[0] = r2[0]; s8[1] = r2[1]; s8[2] = r2[2]; s8[3] = r2[3]; s8[4] = r3[0]; s8[5] = r3[1]; s8[6] = r3[2]; s8[7] = r3[3]; }
    { float v[8]; UNPACK8(w_qa, v); float ss = 0.f;
#pragma unroll
      for (int j = 0; j < 8; ++j) ss += v[j] * v[j];
      SUM8(ss);
      const float rstd = __builtin_amdgcn_rsqf(ss * (1.f / 64.f) + EPS);
#pragma unroll
      for (int j = 0; j < 8; ++j) v[j] = v[j] * rstd * ga[j];
      ROPE8(v, sub, c8, s8);
#pragma unroll
      for (int j = 0; j < 8; ++j) v[j] *= SCALE_A;
      *(v4u*)(Orow + C_QA + 8 * lane) = PACK8(v); }
    { float v[8]; UNPACK8(w_ka, v); float ss = 0.f;
#pragma unroll
      for (int j = 0; j < 8; ++j) ss += v[j] * v[j];
      SUM8(ss);
      const float rstd = __builtin_amdgcn_rsqf(ss * (1.f / 64.f) + EPS);
#pragma unroll
      for (int j = 0; j < 8; ++j) v[j] = v[j] * rstd * gk[j];
      ROPE8(v, sub, c8, s8);
      *(v4u*)(Orow + C_KA + 8 * lane) = PACK8(v); }
    { float v[8]; UNPACK8(w_qi, v);
      ROPE8(v, sub, c8, s8);
      *(v4u*)(Orow + C_QI + 8 * lane) = PACK8(v); }
    { float v[8]; UNPACK8(w_ki, v);
      ROPE8(v, sub, c8, s8);
      if (lane < 8) *(v4u*)(Orow + C_KI + 8 * lane) = PACK8(v); }
    if (lane < 8) WIrow[lane] = w_wi * SCALE_I;
    { float v[8]; UNPACK8(w_cq, v); float ss = 0.f;
#pragma unroll
      for (int j = 0; j < 8; ++j) ss += v[j] * v[j];
      ss = wave_sum(ss); const float rstd = __builtin_amdgcn_rsqf(ss * (1.f / 384.f) + EPS);
      if (lane < 48) {
#pragma unroll
          for (int j = 0; j < 8; ++j) v[j] = v[j] * rstd * gq[j];
          *(v4u*)(Orow + C_CQ + 8 * lane) = PACK8(v); } }
    { float v[8]; UNPACK8(w_ckv, v); float ss = 0.f;
#pragma unroll
      for (int j = 0; j < 8; ++j) ss += v[j] * v[j];
      ss = wave_sum(ss); const float rstd = __builtin_amdgcn_rsqf(ss * (1.f / 256.f) + EPS);
      if (lane < 32) {
#pragma unroll
          for (int j = 0; j < 8; ++j) v[j] = v[j] * rstd * gc[j];
          *(v4u*)(Orow + C_CKV + 8 * lane) = PACK8(v); } }
    { float v[8]; UNPACK8(w_qm, v); float ss = 0.f;
#pragma unroll
      for (int j = 0; j < 8; ++j) ss += v[j] * v[j];
      SUM16(ss);
      const float rstd = __builtin_amdgcn_rsqf(ss * (1.f / 128.f) + EPS);
#pragma unroll
      for (int j = 0; j < 8; ++j) v[j] = v[j] * rstd * gm[j] * SCALE_M;
      *(v4u*)(Orow + C_QM + 8 * lane) = PACK8(v); }
}

__device__ __forceinline__ void km_row(bf16* row, const float* gkm, int lane) {
    v4u w = *(const v4u*)(row + 8 * lane); float v[8]; UNPACK8(w, v); float ss = 0.f;
#pragma unroll
    for (int j = 0; j < 8; ++j) ss += v[j] * v[j];
    SUM16(ss);
    const float rstd = __builtin_amdgcn_rsqf(ss * (1.f / 128.f) + EPS);
#pragma unroll
    for (int j = 0; j < 8; ++j) v[j] = v[j] * rstd * gkm[8 * (lane & 15) + j];
    *(v4u*)(row + 8 * lane) = PACK8(v);
}

__device__ __forceinline__ void transpose_v(const bf16* src, int pitch, int col0, int hstride, int H, int DV, int S, int nb, bf16* dst, int gw, int NGW, int lane) {
    const int ndq = DV / 64, nsc = S / 64, ntask = nb * H * nsc * ndq;
    for (int task = gw; task < ntask; task += NGW) {
        int x = task; const int dq = x % ndq; x /= ndq; const int sc = x % nsc; x /= nsc; const int h = x % H; const int b = x / H;
        const int s = sc * 64 + lane;
        const bf16* srow = src + (size_t)(b * S + s) * pitch + col0 + h * hstride + dq * 64;
        bf16* drow = dst + ((size_t)((b * H + h) * DV + dq * 64)) * S + s;
        v4u wv[8];
#pragma unroll
        for (int c = 0; c < 8; ++c) wv[c] = *(const v4u*)(srow + 8 * c);
#pragma unroll
        for (int c = 0; c < 8; ++c) { const v4u w = wv[c];
            drow[(size_t)(8 * c + 0) * S] = (bf16)(w.x & 0xffffu); drow[(size_t)(8 * c + 1) * S] = (bf16)(w.x >> 16);
            drow[(size_t)(8 * c + 2) * S] = (bf16)(w.y & 0xffffu); drow[(size_t)(8 * c + 3) * S] = (bf16)(w.y >> 16);
            drow[(size_t)(8 * c + 4) * S] = (bf16)(w.z & 0xffffu); drow[(size_t)(8 * c + 5) * S] = (bf16)(w.z >> 16);
            drow[(size_t)(8 * c + 6) * S] = (bf16)(w.w & 0xffffu); drow[(size_t)(8 * c + 7) * S] = (bf16)(w.w >> 16); }
    }
}

__device__ __forceinline__ void post2_row(const bf16* QBrow, bf16* QOrow, const bf16* KVBrow, const bf16* Prow, bf16* KBrow, const float* rb, const float (&gqv)[12], const float (&gkv)[12], LAS float* scr, int lane) {
    const int hd = lane >> 3, d0 = 12 * (lane & 7);
    float vq[12], vk[12], cc[12], sn[12];
    { const v2u* p = (const v2u*)(QBrow + 12 * lane);
      const v2u w0 = p[0], w1 = p[1], w2 = p[2];
      bf16 kr[12];
#pragma unroll
      for (int e = 0; e < 12; ++e) { const int d = d0 + e; kr[e] = d < 64 ? KVBrow[hd * 128 + d] : Prow[C_KR + d - 64]; }
#pragma unroll
      for (int e = 0; e < 12; ++e) { const int d = d0 + e; const int i = (d - 64) & 15; cc[e] = d < 64 ? 1.f : rb[i]; sn[e] = d < 64 ? 0.f : rb[16 + i]; }
      vq[0] = bflo(w0.x); vq[1] = bfhi(w0.x); vq[2] = bflo(w0.y); vq[3] = bfhi(w0.y); vq[4] = bflo(w1.x); vq[5] = bfhi(w1.x); vq[6] = bflo(w1.y); vq[7] = bfhi(w1.y);
      vq[8] = bflo(w2.x); vq[9] = bfhi(w2.x); vq[10] = bflo(w2.y); vq[11] = bfhi(w2.y);
#pragma unroll
      for (int e = 0; e < 12; ++e) vk[e] = bf1(kr[e]); }
    float sq = 0.f, sk = 0.f;
#pragma unroll
    for (int e = 0; e < 12; ++e) { sq += vq[e] * vq[e]; sk += vk[e] * vk[e]; }
    SUM8(sq); SUM8(sk);
    const float rq = __builtin_amdgcn_rsqf(sq * (1.f / 96.f) + EPS), rk = __builtin_amdgcn_rsqf(sk * (1.f / 96.f) + EPS);
#pragma unroll
    for (int e = 0; e < 12; ++e) { vq[e] = vq[e] * rq * gqv[e]; vk[e] = vk[e] * rk * gkv[e]; scr[12 * lane + e] = vq[e]; scr[768 + 12 * lane + e] = vk[e]; }
    LDS_WAIT(); asm volatile("" ::: "memory");
    float oq[12], ok[12];
#pragma unroll
    for (int e = 0; e < 12; ++e) { const int d = d0 + e;
        if (d < 64) { oq[e] = vq[e]; ok[e] = vk[e]; }
        else { const bool first = d < 80; const int off = first ? 16 : -16; const float pq = scr[12 * lane + e + off], pk = scr[768 + 12 * lane + e + off];
               oq[e] = first ? vq[e] * cc[e] - pq * sn[e] : vq[e] * cc[e] + pq * sn[e];
               ok[e] = first ? vk[e] * cc[e] - pk * sn[e] : vk[e] * cc[e] + pk * sn[e]; }
        oq[e] *= SCALE_B; }
    LDS_WAIT(); asm volatile("" ::: "memory");
    v2u* q = (v2u*)(QOrow + 12 * lane); v2u* k = (v2u*)(KBrow + 12 * lane);
#pragma unroll
    for (int i = 0; i < 3; ++i) { v2u w; w.x = pk2(oq[4 * i], oq[4 * i + 1]); w.y = pk2(oq[4 * i + 2], oq[4 * i + 3]); q[i] = w;
                                  v2u u; u.x = pk2(ok[4 * i], ok[4 * i + 1]); u.y = pk2(ok[4 * i + 2], ok[4 * i + 3]); k[i] = u; }
}

__device__ __forceinline__ int next_unit(unsigned* ctr, volatile LAS int* slot) {
    __syncthreads();
    if (threadIdx.x == 0) *slot = (int)atomicAdd(ctr, 1u);
    __syncthreads();
    return *slot;
}

constexpr int SCP = 2112;
__device__ __forceinline__ unsigned ord_key(float v) { const unsigned b = __float_as_uint(v); return b ^ ((unsigned)((int)b >> 31) | 0x80000000u); }
__device__ __forceinline__ void indexer_unit(LAS float* sc, const bf16* P, const float* WI, unsigned* MASK, int bb, int tb) {
    int tid_ = threadIdx.x; asm volatile("" : "+v"(tid_));
    const int tid = tid_, lane = tid & 63, w = __builtin_amdgcn_readfirstlane(tid >> 6);
    const int n = lane & 15, g = lane >> 4;
    const int rowbase = bb * SEQ, t0 = tb * 16;
    for (int rp1 = 0; rp1 < REP_IDX1; ++rp1) {
        bf16x8 qf[8][2]; float wq[8];
        const bf16* qrow = P + (size_t)(rowbase + t0 + n) * PP + C_QI + 8 * g;
#pragma unroll
        for (int h = 0; h < 8; ++h) {
            qf[h][0] = *(const bf16x8*)(qrow + h * 64);
            qf[h][1] = *(const bf16x8*)(qrow + h * 64 + 32);
            wq[h] = WI[(size_t)(rowbase + t0 + n) * 8 + h];
        }
        const int ntile = tb + 1;
        const int nmine = (ntile - w + 7) >> 3;
        const int ngrp = (nmine + 3) >> 2;
        const bf16* kbase = P + (size_t)(rowbase + n) * PP + C_KI + 8 * g;
        bf16x8 kb[2][4][2];
#define IDX_LOAD(BUF, GRP) do { _Pragma("unroll") for (int j_ = 0; j_ < 4; ++j_) { const int tile_ = w + 8 * (4 * (GRP) + j_); const int tl_ = tile_ < ntile ? tile_ : 0; \
            const bf16* kr_ = kbase + (size_t)(16 * tl_) * PP; kb[BUF][j_][0] = *(const bf16x8*)(kr_); kb[BUF][j_][1] = *(const bf16x8*)(kr_ + 32); } } while (0)
#define IDX_COMP(BUF, GRP) do { _Pragma("unroll") for (int j_ = 0; j_ < 4; ++j_) { const int tile_ = w + 8 * (4 * (GRP) + j_); if (tile_ < ntile) { \
            f32x4 idx_ = (f32x4){0.f, 0.f, 0.f, 0.f}; \
            _Pragma("unroll") for (int h_ = 0; h_ < 8; ++h_) { f32x4 a_ = (f32x4){0.f, 0.f, 0.f, 0.f}; \
                a_ = __builtin_amdgcn_mfma_f32_16x16x32_bf16(kb[BUF][j_][0], qf[h_][0], a_, 0, 0, 0); \
                a_ = __builtin_amdgcn_mfma_f32_16x16x32_bf16(kb[BUF][j_][1], qf[h_][1], a_, 0, 0, 0); \
                _Pragma("unroll") for (int i_ = 0; i_ < 4; ++i_) idx_[i_] = __builtin_fmaf(wq[h_], __builtin_fmaxf(a_[i_], 0.f), idx_[i_]); } \
            { const int k0_ = 16 * tile_ + 4 * g; LAS float* d_ = sc + n * SCP + k0_ + (k0_ >> 5); d_[0] = idx_[0]; d_[1] = idx_[1]; d_[2] = idx_[2]; d_[3] = idx_[3]; } } } } while (0)
        if (ngrp > 0) IDX_LOAD(0, 0);
        for (int gp = 0; gp < ngrp; gp += 2) {
            if (gp + 1 < ngrp) IDX_LOAD(1, gp + 1);
            IDX_COMP(0, gp);
            if (gp + 1 < ngrp) { if (gp + 2 < ngrp) IDX_LOAD(0, gp + 2); IDX_COMP(1, gp + 1); }
        }
#undef IDX_LOAD
#undef IDX_COMP
    }
    __syncthreads();
    for (int rs = 0; rs < REP_SEL; ++rs) {
        const int ta = t0 + 2 * w, tb2 = ta + 1;
        unsigned* mra = MASK + (size_t)(rowbase + ta) * 64; unsigned* mrb = mra + 64;
        const int nva = ta - 32 * lane + 1, nvb = nva + 1;
        const unsigned valid_a = nva >= 32 ? 0xffffffffu : (nva <= 0 ? 0u : ((1u << nva) - 1u));
        const unsigned valid_b = nvb >= 32 ? 0xffffffffu : (nvb <= 0 ? 0u : ((1u << nvb) - 1u));
        if (ta < 256) { mra[lane] = valid_a; mrb[lane] = valid_b; continue; }
        unsigned ua[32], ub[32];
        { const LAS float* sra = sc + (2 * w) * SCP + 33 * lane; const LAS float* srb = sra + SCP;
#pragma unroll
          for (int r = 0; r < 32; ++r) { const float va = sra[r], vb = srb[r]; ua[r] = ((valid_a >> r) & 1u) ? ord_key(va) : 0u; ub[r] = ((valid_b >> r) & 1u) ? ord_key(vb) : 0u; } }
#pragma unroll
        for (int k = 0; k < 16; ++k) {
            const unsigned a0 = ua[k], a1 = ua[k + 16]; ua[k] = __builtin_amdgcn_perm(a1, a0, 0x05040100u); ua[k + 16] = __builtin_amdgcn_perm(a1, a0, 0x07060302u);
            const unsigned b0 = ub[k], b1 = ub[k + 16]; ub[k] = __builtin_amdgcn_perm(b1, b0, 0x05040100u); ub[k + 16] = __builtin_amdgcn_perm(b1, b0, 0x07060302u); }
#pragma unroll
        for (int k = 0; k < 32; ++k) if (!(k & 8)) {
            const unsigned a0 = ua[k], a1 = ua[k + 8]; ua[k] = __builtin_amdgcn_perm(a1, a0, 0x06020400u); ua[k + 8] = __builtin_amdgcn_perm(a1, a0, 0x07030501u);
            const unsigned b0 = ub[k], b1 = ub[k + 8]; ub[k] = __builtin_amdgcn_perm(b1, b0, 0x06020400u); ub[k + 8] = __builtin_amdgcn_perm(b1, b0, 0x07030501u); }
#pragma unroll
        for (int si = 2; si < 5; ++si) { const int sft = 16 >> si;
            const unsigned msk = si == 2 ? 0x0f0f0f0fu : (si == 3 ? 0x33333333u : 0x55555555u);
#pragma unroll
            for (int k = 0; k < 32; ++k) if (!(k & sft)) {
                const unsigned a0 = ua[k], a1 = ua[k + sft]; ua[k] = (a0 & msk) | ((a1 << sft) & ~msk); ua[k + sft] = ((a0 >> sft) & msk) | (a1 & ~msk);
                const unsigned b0 = ub[k], b1 = ub[k + sft]; ub[k] = (b0 & msk) | ((b1 << sft) & ~msk); ub[k + sft] = ((b0 >> sft) & msk) | (b1 & ~msk); } }
        unsigned alive_a = valid_a, sel_a = 0u, alive_b = valid_b, sel_b = 0u; int need_a = 256, need_b = 256; bool run_a = true, run_b = true;
#pragma unroll
        for (int j = 31; j >= 0; --j) {
            const unsigned ones_a = alive_a & ua[j], ones_b = alive_b & ub[j];
            int v = (int)((unsigned)__popc(ones_a) | ((unsigned)__popc(ones_b) << 16));
            v += __builtin_amdgcn_update_dpp(0, v, 0xB1, 0xF, 0xF, false);
            v += __builtin_amdgcn_update_dpp(0, v, 0x4E, 0xF, 0xF, false);
            v += __builtin_amdgcn_update_dpp(0, v, 0x141, 0xF, 0xF, false);
            v += __builtin_amdgcn_update_dpp(0, v, 0x140, 0xF, 0xF, false);
            const unsigned tot = (unsigned)(__builtin_amdgcn_readlane(v, 0) + __builtin_amdgcn_readlane(v, 16) + __builtin_amdgcn_readlane(v, 32) + __builtin_amdgcn_readlane(v, 48));
            const int ca = (int)(tot & 0xffffu), cb = (int)(tot >> 16);
            if (run_a) { if (ca >= need_a) { alive_a = ones_a; if (ca == need_a) { sel_a |= ones_a; need_a = 0; run_a = false; } }
                         else { need_a -= ca; sel_a |= ones_a; alive_a &= ~ua[j]; } }
            if (run_b) { if (cb >= need_b) { alive_b = ones_b; if (cb == need_b) { sel_b |= ones_b; need_b = 0; run_b = false; } }
                         else { need_b -= cb; sel_b |= ones_b; alive_b &= ~ub[j]; } }
            if (!run_a && !run_b) break;
        }
        if (need_a > 0) {
            const int cnt = __popc(alive_a); int inc = cnt;
#pragma unroll
            for (int d = 1; d < 64; d <<= 1) { const int o = __shfl_up(inc, d); if (lane >= d) inc += o; }
            int k = need_a - (inc - cnt); k = k < 0 ? 0 : (k > cnt ? cnt : k);
            unsigned m = alive_a;
            for (int i = 0; i < k; ++i) { const unsigned low = m & (0u - m); sel_a |= low; m ^= low; }
        }
        if (need_b > 0) {
            const int cnt = __popc(alive_b); int inc = cnt;
#pragma unroll
            for (int d = 1; d < 64; d <<= 1) { const int o = __shfl_up(inc, d); if (lane >= d) inc += o; }
            int k = need_b - (inc - cnt); k = k < 0 ? 0 : (k > cnt ? cnt : k);
            unsigned m = alive_b;
            for (int i = 0; i < k; ++i) { const unsigned low = m & (0u - m); sel_b |= low; m ^= low; }
        }
        mra[lane] = sel_a; mrb[lane] = sel_b;
        (void)tb2;
    }
    __syncthreads();
}

__device__ __forceinline__ float half_max(float m) { auto rr = __builtin_amdgcn_permlane32_swap(__float_as_uint(m), __float_as_uint(m), false, false); return __builtin_fmaxf(__uint_as_float(rr[0]), __uint_as_float(rr[1])); }
__device__ __forceinline__ float half_sum(float m) { auto rr = __builtin_amdgcn_permlane32_swap(__float_as_uint(m), __float_as_uint(m), false, false); return __uint_as_float(rr[0]) + __uint_as_float(rr[1]); }
__device__ __forceinline__ int crow(int r, int hi) { return (r & 3) + 8 * (r >> 2) + 4 * hi; }
template <int DQK, int DV, int MODE, int STRIP = 0>
__device__ __forceinline__ void attn_unit(LAS unsigned char* lds, const bf16* Qb, int qpitch, const bf16* Kb, int kpitch, const bf16* VTb, int skv,
                                          const unsigned* maskb, const bf16* Zb, bf16* Ob, int q0) {
    constexpr int TK = 128, KP = DQK + 8, VP = TK + 8;
    LAS bf16* Ks = (LAS bf16*)lds; LAS bf16* Vs = Ks + TK * KP;
    constexpr int CPR = DQK / 8;
    constexpr int NCK = TK * CPR, NCV = DV * (TK / 8);
    constexpr int RK = (NCK + 511) / 512, RV = (NCV + 511) / 512;
    constexpr int NKS = DQK / 16, NMT = DV / 32;
    int tid_ = threadIdx.x; asm volatile("" : "+v"(tid_));
    const int tid = tid_, lane = tid & 63, w = __builtin_amdgcn_readfirstlane(tid >> 6), r = lane & 31, hh = lane >> 5;
    const int NT = MODE == 0 ? skv / TK : (q0 + 256) / TK;
    const int qlo = q0 + 32 * w;
    bf16x8 qf[NKS];
    { const bf16* qrow = Qb + (size_t)(qlo + r) * qpitch + 8 * hh;
#pragma unroll
      for (int ks = 0; ks < NKS; ++ks) qf[ks] = *(const bf16x8*)(qrow + 16 * ks); }
    f32x16 o[NMT];
#pragma unroll
    for (int mt = 0; mt < NMT; ++mt)
#pragma unroll
        for (int i = 0; i < 16; ++i) o[mt][i] = 0.f;
    float m_run = NEGF, l_run = 0.f;
    v4u kreg[RK], vreg[RV];
#define ATT_PREFETCH(tile_) do { \
        _Pragma("unroll") for (int i_ = 0; i_ < RK; ++i_) { const int c_ = tid + 512 * i_; if (c_ < NCK) { const int row_ = c_ / CPR, cc_ = c_ % CPR; kreg[i_] = *(const v4u*)(Kb + (size_t)(TK * (tile_) + row_) * kpitch + 8 * cc_); } } \
        _Pragma("unroll") for (int i_ = 0; i_ < RV; ++i_) { const int c_ = tid + 512 * i_; if (c_ < NCV) { const int d_ = c_ >> 4, cc_ = c_ & 15; vreg[i_] = *(const v4u*)(VTb + (size_t)d_ * skv + TK * (tile_) + 8 * cc_); } } } while (0)
    if (STRIP != 2) ATT_PREFETCH(0);
    for (int tile = 0; tile < NT; ++tile) {
        __syncthreads();
        if (STRIP != 2) {
#pragma unroll
        for (int i = 0; i < RK; ++i) { const int c = tid + 512 * i; if (c < NCK) { const int row = c / CPR, cc = c % CPR; *(LAS v4u*)(Ks + row * KP + 8 * cc) = kreg[i]; } }
#pragma unroll
        for (int i = 0; i < RV; ++i) { const int c = tid + 512 * i; if (c < NCV) { const int d = c >> 4, cc = c & 15; *(LAS v4u*)(Vs + d * VP + 8 * cc) = vreg[i]; } }
        }
        __syncthreads();
        if (STRIP != 2 && tile + 1 < NT) ATT_PREFETCH(tile + 1);
        __builtin_amdgcn_sched_barrier(0);
        if (STRIP == 1) continue;
#pragma unroll 1
        for (int sub = 0; sub < 2; ++sub) {
        const int t64 = 2 * tile + sub;
        if (MODE != 0 && 64 * t64 > qlo + 31) continue;
        const LAS bf16* Kc = Ks + 64 * sub * KP; const LAS bf16* Vc = Vs + 64 * sub;
        unsigned mw0 = 0u, mw1 = 0u;
        if (MODE == 2) { const v2u mm = *(const v2u*)(maskb + (size_t)(qlo + r) * 64 + 2 * t64); mw0 = mm.x >> (4 * hh); mw1 = mm.y >> (4 * hh); }
        f32x16 s0, s1;
#pragma unroll
        for (int i = 0; i < 16; ++i) { s0[i] = 0.f; s1[i] = 0.f; }
#pragma unroll
        for (int ks = 0; ks < NKS; ++ks) {
            const bf16x8 a0 = *(const LAS bf16x8*)(Kc + r * KP + 16 * ks + 8 * hh);
            const bf16x8 a1 = *(const LAS bf16x8*)(Kc + (32 + r) * KP + 16 * ks + 8 * hh);
            s0 = __builtin_amdgcn_mfma_f32_32x32x16_bf16(a0, qf[ks], s0, 0, 0, 0);
            s1 = __builtin_amdgcn_mfma_f32_32x32x16_bf16(a1, qf[ks], s1, 0, 0, 0);
        }
        if (MODE == 1) {
            if (64 * t64 + 63 > qlo) { const int qg = qlo + r;
#pragma unroll
                for (int i = 0; i < 16; ++i) { const int key = 64 * t64 + crow(i, hh); if (key > qg) s0[i] = NEGF; if (key + 32 > qg) s1[i] = NEGF; } }
        }
        if (MODE == 2) {
#pragma unroll
            for (int i = 0; i < 16; ++i) { const int bit = (i & 3) + 8 * (i >> 2); if (!((mw0 >> bit) & 1u)) s0[i] = NEGF; if (!((mw1 >> bit) & 1u)) s1[i] = NEGF; }
        }
        float mx = s0[0];
#pragma unroll
        for (int i = 1; i < 16; ++i) mx = __builtin_fmaxf(mx, s0[i]);
#pragma unroll
        for (int i = 0; i < 16; ++i) mx = __builtin_fmaxf(mx, s1[i]);
        mx = half_max(mx);
        const float m_new = __builtin_fmaxf(m_run, mx);
        const float alpha = __builtin_amdgcn_exp2f(m_run - m_new);
        m_run = m_new;
        float ls = 0.f;
#pragma unroll
        for (int i = 0; i < 16; ++i) { s0[i] = __builtin_amdgcn_exp2f(s0[i] - m_new); s1[i] = __builtin_amdgcn_exp2f(s1[i] - m_new); ls += s0[i] + s1[i]; }
        l_run = l_run * alpha + ls;
#pragma unroll
        for (int mt = 0; mt < NMT; ++mt)
#pragma unroll
            for (int i = 0; i < 16; ++i) o[mt][i] *= alpha;
        v4u pf[2][2];
#pragma unroll
        for (int s = 0; s < 2; ++s) {
            pf[0][s] = (v4u){pk2(s0[8 * s], s0[8 * s + 1]), pk2(s0[8 * s + 2], s0[8 * s + 3]), pk2(s0[8 * s + 4], s0[8 * s + 5]), pk2(s0[8 * s + 6], s0[8 * s + 7])};
            pf[1][s] = (v4u){pk2(s1[8 * s], s1[8 * s + 1]), pk2(s1[8 * s + 2], s1[8 * s + 3]), pk2(s1[8 * s + 4], s1[8 * s + 5]), pk2(s1[8 * s + 6], s1[8 * s + 7])};
        }
#pragma unroll
        for (int mt = 0; mt < NMT; ++mt)
#pragma unroll
            for (int p = 0; p < 2; ++p)
#pragma unroll
                for (int s = 0; s < 2; ++s) {
                    const LAS bf16* vp = Vc + (32 * mt + r) * VP + 32 * p + 16 * s + 4 * hh;
                    const s16x4 lo = *(const LAS s16x4*)(vp), hi = *(const LAS s16x4*)(vp + 8);
                    const bf16x8 a = (bf16x8){lo[0], lo[1], lo[2], lo[3], hi[0], hi[1], hi[2], hi[3]};
                    o[mt] = __builtin_amdgcn_mfma_f32_32x32x16_bf16(a, __builtin_bit_cast(bf16x8, pf[p][s]), o[mt], 0, 0, 0);
                }
        }
    }
#undef ATT_PREFETCH
    const float l_tot = half_sum(l_run);
    const float inv = 1.0f / l_tot;
    const size_t row = (size_t)(qlo + r);
#pragma unroll
    for (int mt = 0; mt < NMT; ++mt)
#pragma unroll
        for (int g4 = 0; g4 < 4; ++g4) {
            const int d = 32 * mt + 8 * g4 + 4 * hh;
            float ov[4];
#pragma unroll
            for (int i = 0; i < 4; ++i) ov[i] = o[mt][4 * g4 + i] * inv;
            if (Zb) { const v2u zw = *(const v2u*)(Zb + row * PP + d); const float z[4] = {bflo(zw.x), bfhi(zw.x), bflo(zw.y), bfhi(zw.y)};
#pragma unroll
                for (int i = 0; i < 4; ++i) ov[i] *= z[i] * __builtin_amdgcn_rcpf(1.0f + __expf(-z[i])); }
            v2u ow; ow.x = pk2(ov[0], ov[1]); ow.y = pk2(ov[2], ov[3]);
            *(v2u*)(Ob + row * PP + d) = ow;
        }
}

template <int DQK, int MODE>
__device__ __forceinline__ void attn_unit_pipe(LAS unsigned char* lds, const bf16* Qb, int qpitch, const bf16* Kb, int kpitch, const bf16* VTb, int skv,
                                               const unsigned* maskb, bf16* Ob, int q0) {
    constexpr int DV = 64, KP = DQK + 8, VP = 72, BUFE = 64 * KP + DV * VP;
    constexpr int CPR = DQK / 8, NCK = 64 * CPR, NCV = DV * 8, RK = (NCK + 511) / 512, RV = (NCV + 511) / 512, NKS = DQK / 16, NMT = DV / 32;
    static_assert(NCV == 512 && (NCK == 512 || NCK == 768), "staging map");
    int tid_ = threadIdx.x; asm volatile("" : "+v"(tid_));
    const int tid = tid_, lane = tid & 63, w = __builtin_amdgcn_readfirstlane(tid >> 6), r = lane & 31, hh = lane >> 5;
    const int NT = (q0 + 256) / 64;
    const int qlo = q0 + 32 * w;
    const int NTw = ((qlo + 31) >> 6) + 1;
    int krow[RK], kcc[RK];
#pragma unroll
    for (int i = 0; i < RK; ++i) { int c = tid + 512 * i; if (c >= NCK) c -= 256; krow[i] = c / CPR; kcc[i] = c % CPR; }
    const int vd = tid >> 3, vcc = tid & 7;
    bf16x8 qf[NKS];
    { const bf16* qrow = Qb + (size_t)(qlo + r) * qpitch + 8 * hh;
#pragma unroll
      for (int ks = 0; ks < NKS; ++ks) qf[ks] = *(const bf16x8*)(qrow + 16 * ks); }
    f32x16 o[NMT];
#pragma unroll
    for (int mt = 0; mt < NMT; ++mt)
#pragma unroll
        for (int i = 0; i < 16; ++i) o[mt][i] = 0.f;
    float m_run = NEGF, l_run = 0.f, alpha = 1.f;
    v4u kreg[2][RK], vreg[2][RV]; v2u mset[2];
    const unsigned* mrowp = MODE == 2 ? maskb + (size_t)(qlo + r) * 64 : nullptr;
#define PL_LOAD(S_, tile_) do { const int tl_ = (tile_) < NT ? (tile_) : NT - 1; \
        if (MODE == 2) { const int mt_ = (tile_) >= 2 ? ((tile_) - 2 < 32 ? (tile_) - 2 : 31) : 0; mset[S_] = *(const v2u*)(mrowp + 2 * mt_); }     \
        _Pragma("unroll") for (int i_ = 0; i_ < RK; ++i_) kreg[S_][i_] = *(const v4u*)(Kb + (size_t)(64 * tl_ + krow[i_]) * kpitch + 8 * kcc[i_]); \
        vreg[S_][0] = *(const v4u*)(VTb + (size_t)vd * skv + 64 * tl_ + 8 * vcc); } while (0)
#define PL_STAGE(S_, buf_) do { LAS bf16* Kd_ = (LAS bf16*)lds + (buf_) * BUFE; LAS bf16* Vd_ = Kd_ + 64 * KP; \
        _Pragma("unroll") for (int i_ = 0; i_ < RK; ++i_) *(LAS v4u*)(Kd_ + krow[i_] * KP + 8 * kcc[i_]) = kreg[S_][i_]; \
        *(LAS v4u*)(Vd_ + vd * VP + 8 * vcc) = vreg[S_][0]; } while (0)
#define PL_QK(t_, D0_, D1_) do { const LAS bf16* Kc_ = (const LAS bf16*)lds + ((t_) & 3) * BUFE; \
        _Pragma("unroll") for (int i_ = 0; i_ < 16; ++i_) { D0_[i_] = 0.f; D1_[i_] = 0.f; } \
        _Pragma("unroll") for (int ks_ = 0; ks_ < NKS; ++ks_) { \
            const bf16x8 a0_ = *(const LAS bf16x8*)(Kc_ + r * KP + 16 * ks_ + 8 * hh); const bf16x8 a1_ = *(const LAS bf16x8*)(Kc_ + (32 + r) * KP + 16 * ks_ + 8 * hh); \
            D0_ = __builtin_amdgcn_mfma_f32_32x32x16_bf16(a0_, qf[ks_], D0_, 0, 0, 0); D1_ = __builtin_amdgcn_mfma_f32_32x32x16_bf16(a1_, qf[ks_], D1_, 0, 0, 0); } } while (0)
#define PL_PV(t_) do { const LAS bf16* Vc_ = (const LAS bf16*)lds + ((t_) & 3) * BUFE + 64 * KP; \
        _Pragma("unroll") for (int mt_ = 0; mt_ < NMT; ++mt_) _Pragma("unroll") for (int i_ = 0; i_ < 16; ++i_) o[mt_][i_] *= alpha; \
        _Pragma("unroll") for (int mt_ = 0; mt_ < NMT; ++mt_) _Pragma("unroll") for (int p_ = 0; p_ < 2; ++p_) _Pragma("unroll") for (int s_ = 0; s_ < 2; ++s_) { \
            const LAS bf16* vp_ = Vc_ + (32 * mt_ + r) * VP + 32 * p_ + 16 * s_ + 4 * hh; \
            const s16x4 lo_ = *(const LAS s16x4*)(vp_), hi_ = *(const LAS s16x4*)(vp_ + 8); \
            const bf16x8 a_ = (bf16x8){lo_[0], lo_[1], lo_[2], lo_[3], hi_[0], hi_[1], hi_[2], hi_[3]}; \
            o[mt_] = __builtin_amdgcn_mfma_f32_32x32x16_bf16(a_, __builtin_bit_cast(bf16x8, pf[p_][s_]), o[mt_], 0, 0, 0); } } while (0)
#define PL_SOFTMAX(t_, C0_, C1_, MK_, CAUSAL_) do { \
        if (MODE == 2) { const unsigned w0_ = (MK_).x >> (4 * hh), w1_ = (MK_).y >> (4 * hh); \
            _Pragma("unroll") for (int i_ = 0; i_ < 16; ++i_) { const int bit_ = (i_ & 3) + 8 * (i_ >> 2); if (!((w0_ >> bit_) & 1u)) C0_[i_] = NEGF; if (!((w1_ >> bit_) & 1u)) C1_[i_] = NEGF; } } \
        if (CAUSAL_) { const int qg_ = qlo + r; \
            _Pragma("unroll") for (int i_ = 0; i_ < 16; ++i_) { const int key_ = 64 * (t_) + crow(i_, hh); if (key_ > qg_) C0_[i_] = NEGF; if (key_ + 32 > qg_) C1_[i_] = NEGF; } } \
        float mx_ = C0_[0]; \
        _Pragma("unroll") for (int i_ = 1; i_ < 16; ++i_) mx_ = __builtin_fmaxf(mx_, C0_[i_]); \
        _Pragma("unroll") for (int i_ = 0; i_ < 16; ++i_) mx_ = __builtin_fmaxf(mx_, C1_[i_]); \
        mx_ = half_max(mx_); \
        const float mn_ = __builtin_fmaxf(m_run, mx_); alpha = __builtin_amdgcn_exp2f(m_run - mn_); m_run = mn_; \
        float ls_ = 0.f; \
        _Pragma("unroll") for (int i_ = 0; i_ < 16; ++i_) { C0_[i_] = __builtin_amdgcn_exp2f(C0_[i_] - mn_); C1_[i_] = __builtin_amdgcn_exp2f(C1_[i_] - mn_); ls_ += C0_[i_] + C1_[i_]; } \
        l_run = l_run * alpha + ls_; \
        _Pragma("unroll") for (int s_ = 0; s_ < 2; ++s_) { \
            pf[0][s_] = (v4u){pk2(C0_[8 * s_], C0_[8 * s_ + 1]), pk2(C0_[8 * s_ + 2], C0_[8 * s_ + 3]), pk2(C0_[8 * s_ + 4], C0_[8 * s_ + 5]), pk2(C0_[8 * s_ + 6], C0_[8 * s_ + 7])}; \
            pf[1][s_] = (v4u){pk2(C1_[8 * s_], C1_[8 * s_ + 1]), pk2(C1_[8 * s_ + 2], C1_[8 * s_ + 3]), pk2(C1_[8 * s_ + 4], C1_[8 * s_ + 5]), pk2(C1_[8 * s_ + 6], C1_[8 * s_ + 7])}; } } while (0)
#define PL_IO(t_, S_) do { PL_STAGE(S_, ((t_) + 2) & 3); PL_LOAD(S_, (t_) + 4); } while (0)
#define PL_STEADY(t_, S_) do { const v2u mk_ = mset[S_]; PL_IO(t_, S_); if (MODE == 2) { asm volatile("" :: "v"(mk_.x), "v"(mk_.y)); } \
        PL_QK((t_) + 1, n0, n1); PL_PV((t_) - 1); PL_SOFTMAX(t_, c0, c1, mk_, false); c0 = n0; c1 = n1; __syncthreads(); } while (0)
#define PL_TAIL(t_, S_) do { const v2u mk_ = mset[S_]; PL_IO(t_, S_); if ((t_) >= 1) PL_PV((t_) - 1); PL_SOFTMAX(t_, c0, c1, mk_, MODE == 1); PL_PV(t_); __syncthreads(); } while (0)
    f32x16 c0, c1, n0, n1; v4u pf[2][2];
    PL_LOAD(0, 0); PL_LOAD(1, 1);
    PL_STAGE(0, 0); PL_STAGE(1, 1);
    PL_LOAD(0, 2); PL_LOAD(1, 3);
    __syncthreads();
    PL_QK(0, c0, c1);
    int t = 0;
    if (NTw >= 2) {
        { const v2u mk_ = mset[0]; PL_IO(0, 0); PL_QK(1, n0, n1); PL_SOFTMAX(0, c0, c1, mk_, false); c0 = n0; c1 = n1; __syncthreads(); }
        for (t = 1; t + 1 < NTw; ) {
            PL_STEADY(t, 1); ++t;
            if (t + 1 < NTw) { PL_STEADY(t, 0); ++t; }
        }
    }
    if (t & 1) PL_TAIL(t, 1); else PL_TAIL(t, 0);
    for (++t; t < NT; ++t) { if (t & 1) PL_IO(t, 1); else PL_IO(t, 0); __syncthreads(); }
#undef PL_LOAD
#undef PL_STAGE
#undef PL_QK
#undef PL_PV
#undef PL_SOFTMAX
#undef PL_IO
#undef PL_STEADY
#undef PL_TAIL
    const float l_tot = half_sum(l_run);
    const float inv = 1.0f / l_tot;
    const size_t row = (size_t)(qlo + r);
#pragma unroll
    for (int mt = 0; mt < NMT; ++mt)
#pragma unroll
        for (int g4 = 0; g4 < 4; ++g4) {
            const int d = 32 * mt + 8 * g4 + 4 * hh;
            v2u ow; ow.x = pk2(o[mt][4 * g4] * inv, o[mt][4 * g4 + 1] * inv); ow.y = pk2(o[mt][4 * g4 + 2] * inv, o[mt][4 * g4 + 3] * inv);
            *(v2u*)(Ob + row * PP + d) = ow;
        }
}

__device__ __forceinline__ void attn_unit_mem(LAS unsigned char* lds, const bf16* Qb, const bf16* Kb, const bf16* VTb, const bf16* Zb, bf16* Ob, int q0) {
    constexpr int DQK = 128, KP = DQK + 8, VP = MEML + 8, NKS = DQK / 16, NMT = 4;
    LAS bf16* Ks = (LAS bf16*)lds; LAS bf16* Vs = Ks + MEML * KP;
    int tid_ = threadIdx.x; asm volatile("" : "+v"(tid_));
    const int tid = tid_, lane = tid & 63, w = __builtin_amdgcn_readfirstlane(tid >> 6), r = lane & 31, hh = lane >> 5;
    { v4u kk[8], vv[8];
#pragma unroll
      for (int i = 0; i < 8; ++i) { const int c = tid + 512 * i; kk[i] = *(const v4u*)(Kb + (size_t)(c >> 4) * 1024 + 8 * (c & 15)); vv[i] = *(const v4u*)(VTb + (size_t)(c >> 5) * MEML + 8 * (c & 31)); }
#pragma unroll
      for (int i = 0; i < 8; ++i) { const int c = tid + 512 * i; *(LAS v4u*)(Ks + (c >> 4) * KP + 8 * (c & 15)) = kk[i]; *(LAS v4u*)(Vs + (c >> 5) * VP + 8 * (c & 31)) = vv[i]; } }
    __syncthreads();
#pragma unroll 1
    for (int qb = 0; qb < 2; ++qb) {
        const int qlo = q0 + 256 * qb + 32 * w;
        bf16x8 qf[NKS];
        { const bf16* qrow = Qb + (size_t)(qlo + r) * PP + 8 * hh;
#pragma unroll
          for (int ks = 0; ks < NKS; ++ks) qf[ks] = *(const bf16x8*)(qrow + 16 * ks); }
        f32x16 o[NMT];
#pragma unroll
        for (int mt = 0; mt < NMT; ++mt)
#pragma unroll
            for (int i = 0; i < 16; ++i) o[mt][i] = 0.f;
        float m_run = NEGF, l_run = 0.f;
#pragma unroll 1
        for (int sub = 0; sub < MEML / 64; ++sub) {
            const LAS bf16* Kc = Ks + 64 * sub * KP; const LAS bf16* Vc = Vs + 64 * sub;
            f32x16 s0, s1;
#pragma unroll
            for (int i = 0; i < 16; ++i) { s0[i] = 0.f; s1[i] = 0.f; }
#pragma unroll
            for (int ks = 0; ks < NKS; ++ks) {
                const bf16x8 a0 = *(const LAS bf16x8*)(Kc + r * KP + 16 * ks + 8 * hh);
                const bf16x8 a1 = *(const LAS bf16x8*)(Kc + (32 + r) * KP + 16 * ks + 8 * hh);
                s0 = __builtin_amdgcn_mfma_f32_32x32x16_bf16(a0, qf[ks], s0, 0, 0, 0);
                s1 = __builtin_amdgcn_mfma_f32_32x32x16_bf16(a1, qf[ks], s1, 0, 0, 0);
            }
            float mx = s0[0];
#pragma unroll
            for (int i = 1; i < 16; ++i) mx = __builtin_fmaxf(mx, s0[i]);
#pragma unroll
            for (int i = 0; i < 16; ++i) mx = __builtin_fmaxf(mx, s1[i]);
            mx = half_max(mx);
            const float m_new = __builtin_fmaxf(m_run, mx);
            const float alpha = __builtin_amdgcn_exp2f(m_run - m_new);
            m_run = m_new;
            float ls = 0.f;
#pragma unroll
            for (int i = 0; i < 16; ++i) { s0[i] = __builtin_amdgcn_exp2f(s0[i] - m_new); s1[i] = __builtin_amdgcn_exp2f(s1[i] - m_new); ls += s0[i] + s1[i]; }
            l_run = l_run * alpha + ls;
#pragma unroll
            for (int mt = 0; mt < NMT; ++mt)
#pragma unroll
                for (int i = 0; i < 16; ++i) o[mt][i] *= alpha;
            v4u pf[2][2];
#pragma unroll
            for (int s = 0; s < 2; ++s) {
                pf[0][s] = (v4u){pk2(s0[8 * s], s0[8 * s + 1]), pk2(s0[8 * s + 2], s0[8 * s + 3]), pk2(s0[8 * s + 4], s0[8 * s + 5]), pk2(s0[8 * s + 6], s0[8 * s + 7])};
                pf[1][s] = (v4u){pk2(s1[8 * s], s1[8 * s + 1]), pk2(s1[8 * s + 2], s1[8 * s + 3]), pk2(s1[8 * s + 4], s1[8 * s + 5]), pk2(s1[8 * s + 6], s1[8 * s + 7])};
            }
#pragma unroll
            for (int mt = 0; mt < NMT; ++mt)
#pragma unroll
                for (int p = 0; p < 2; ++p)
#pragma unroll
                    for (int s = 0; s < 2; ++s) {
                        const LAS bf16* vp = Vc + (32 * mt + r) * VP + 32 * p + 16 * s + 4 * hh;
                        const s16x4 lo = *(const LAS s16x4*)(vp), hi = *(const LAS s16x4*)(vp + 8);
                        const bf16x8 a = (bf16x8){lo[0], lo[1], lo[2], lo[3], hi[0], hi[1], hi[2], hi[3]};
                        o[mt] = __builtin_amdgcn_mfma_f32_32x32x16_bf16(a, __builtin_bit_cast(bf16x8, pf[p][s]), o[mt], 0, 0, 0);
                    }
        }
        const float inv = 1.0f / half_sum(l_run);
        const size_t row = (size_t)(qlo + r);
#pragma unroll
        for (int mt = 0; mt < NMT; ++mt)
#pragma unroll
            for (int g4 = 0; g4 < 4; ++g4) {
                const int d = 32 * mt + 8 * g4 + 4 * hh;
                const v2u zw = *(const v2u*)(Zb + row * PP + d); const float z[4] = {bflo(zw.x), bfhi(zw.x), bflo(zw.y), bfhi(zw.y)};
                float ov[4];
#pragma unroll
                for (int i = 0; i < 4; ++i) ov[i] = o[mt][4 * g4 + i] * inv * (z[i] * __builtin_amdgcn_rcpf(1.0f + __expf(-z[i])));
                v2u ow; ow.x = pk2(ov[0], ov[1]); ow.y = pk2(ov[2], ov[3]);
                *(v2u*)(Ob + row * PP + d) = ow;
            }
    }
}

__device__ __forceinline__ bf16* gate_row(bf16* G0, bf16* G1, size_t row) { return row < 8192 ? G0 + row * 3072 : G1 + (row - 8192) * 3072; }
struct EpiZG {
    static constexpr bool PERM = true, AFTER_DRAIN = false;
    bf16* P; bf16* G0; bf16* G1;
    __device__ __forceinline__ void operator()(const pg8::f32x4 (&acc)[2][2][4][2], const pg8::Unit& u, int wr, int wc, int fr, int fq) const {
        const int row0 = u.pm * 256 + wr * 64 + fr, cl = wc * 32 + 8 * fq;
        const bool isz = u.pn < 4;
        const int ycol = (u.pn < 2 ? C_YA : C_YB) + (u.pn & 1) * 256, gcol = (u.pn - 4) * 256;
#pragma unroll
        for (int ai = 0; ai < 2; ++ai)
#pragma unroll
            for (int m = 0; m < 4; ++m) { const size_t row = (size_t)(row0 + ai * 128 + m * 16);
#pragma unroll
                for (int bj = 0; bj < 2; ++bj) {
                    const pg8::f32x4 v0 = acc[ai][bj][m][0], v1 = acc[ai][bj][m][1];
                    float rr[8] = {v0[0], v0[1], v0[2], v0[3], v1[0], v1[1], v1[2], v1[3]};
                    if (isz) { bf16* dst = P + row * PP + ycol + cl + bj * 128; const v4u old = *(const v4u*)dst; float yv[8]; UNPACK8(old, yv);
#pragma unroll
                        for (int e = 0; e < 8; ++e) rr[e] = yv[e] * (rr[e] * __builtin_amdgcn_rcpf(1.0f + __expf(-rr[e])));
                        *(v4u*)dst = PACK8(rr); }
                    else { bf16* dst = gate_row(G0, G1, row) + gcol + cl + bj * 128;
#pragma unroll
                        for (int e = 0; e < 8; ++e) rr[e] = __builtin_amdgcn_rcpf(1.0f + __expf(-rr[e]));
                        *(v4u*)dst = PACK8(rr); } } }
    }
};
struct EpiMerge {
    static constexpr bool PERM = true, AFTER_DRAIN = false;
    bf16* Mg; bf16* G0; bf16* G1; int nbr;
    __device__ __forceinline__ void operator()(const pg8::f32x4 (&acc)[2][2][4][2], const pg8::Unit& u, int wr, int wc, int fr, int fq) const {
        const int row0 = u.pm * 256 + wr * 64 + fr, col0 = u.pn * 256 + wc * 32 + 8 * fq;
#pragma unroll
        for (int ai = 0; ai < 2; ++ai)
#pragma unroll
            for (int m = 0; m < 4; ++m) { const size_t row = (size_t)(row0 + ai * 128 + m * 16);
#pragma unroll
                for (int bj = 0; bj < 2; ++bj) { const int col = col0 + bj * 128;
                    const v4u gwd = *(const v4u*)(gate_row(G0, G1, row) + nbr * 1024 + col);
                    float gl[8]; UNPACK8(gwd, gl);
                    const pg8::f32x4 v0 = acc[ai][bj][m][0], v1 = acc[ai][bj][m][1];
                    float rr[8] = {v0[0], v0[1], v0[2], v0[3], v1[0], v1[1], v1[2], v1[3]};
#pragma unroll
                    for (int e = 0; e < 8; ++e) rr[e] *= gl[e];
                    bf16* dst = Mg + row * 1024 + col;
                    if (nbr > 0) { const v4u old = *(const v4u*)dst; float ol[8]; UNPACK8(old, ol);
#pragma unroll
                        for (int e = 0; e < 8; ++e) rr[e] += ol[e]; }
                    *(v4u*)dst = PACK8(rr); } }
    }
};
struct EpiOut {
    static constexpr bool PERM = true, AFTER_DRAIN = false;
    const float* X; float* Out;
    __device__ __forceinline__ void operator()(const pg8::f32x4 (&acc)[2][2][4][2], const pg8::Unit& u, int wr, int wc, int fr, int fq) const {
        const int row0 = u.pm * 256 + wr * 64 + fr, col0 = u.pn * 256 + wc * 32 + 8 * fq;
#pragma unroll
        for (int ai = 0; ai < 2; ++ai)
#pragma unroll
            for (int m = 0; m < 4; ++m) { const size_t row = (size_t)(row0 + ai * 128 + m * 16);
#pragma unroll
                for (int bj = 0; bj < 2; ++bj) { const size_t p = row * 1024 + col0 + bj * 128;
                    const f32x4 x0 = *(const f32x4*)(X + p), x1 = *(const f32x4*)(X + p + 4);
                    const pg8::f32x4 a0 = acc[ai][bj][m][0], a1 = acc[ai][bj][m][1];
                    *(f32x4*)(Out + p) = (f32x4){x0[0] + a0[0], x0[1] + a0[1], x0[2] + a0[2], x0[3] + a0[3]};
                    *(f32x4*)(Out + p + 4) = (f32x4){x1[0] + a1[0], x1[1] + a1[1], x1[2] + a1[2], x1[3] + a1[3]}; } }
    }
};

#define XB_TMO      128
#define XB_XCNT(j)  (256  + 64 * (j))
#define XB_XSUB(j)  (1280 + 64 * (j))
#define XB_XGEN(j)  (2304 + 64 * (j))
#define XB_TOP      3328
#define XB_TOPGEN   3392
#define XCD_BAR_WORDS 3456
#define XB_SPIN_CAP (1u << 18)

__device__ __forceinline__ unsigned xb_ld(unsigned* p)              { return __hip_atomic_load(p, __ATOMIC_RELAXED, __HIP_MEMORY_SCOPE_AGENT); }
__device__ __forceinline__ unsigned xb_add(unsigned* p, unsigned v) { return __hip_atomic_fetch_add(p, v, __ATOMIC_RELAXED, __HIP_MEMORY_SCOPE_AGENT); }
__device__ __forceinline__ unsigned xb_xcc_id() { return (unsigned)__builtin_amdgcn_s_getreg((3 << 11) | 20) & 0xFu; }
#define XB_SPIN(cond, bar) do { unsigned _sp = 0; while (cond) { __builtin_amdgcn_s_sleep(1); \
    if ((++_sp & 255u) == 0u) { if (xb_ld(&(bar)[XB_TMO])) break; if (_sp > XB_SPIN_CAP) { atomicAdd(&(bar)[XB_TMO], 1u); break; } } } } while (0)

struct XcdBarrier {
    unsigned* bar; unsigned x;
    volatile LAS unsigned* st;
};

__device__ __forceinline__ XcdBarrier xcd_barrier_post(unsigned* bar, volatile LAS unsigned* st) {
    XcdBarrier b; b.bar = bar; b.x = xb_xcc_id(); b.st = st;
    if (threadIdx.x == 0) (void)xb_add(&bar[XB_XCNT(b.x)], 1u);
    return b;
}
__device__ __forceinline__ void xcd_barrier_complete(unsigned* bar, unsigned x, unsigned& nloc, unsigned& nx) {
    const unsigned G = gridDim.x * gridDim.y * gridDim.z;
    unsigned sum, cnt, mine, sp = 0u;
    for (;;) {
        sum = 0u; cnt = 0u; mine = 0u;
#pragma unroll
        for (unsigned j = 0; j < 16; ++j) { const unsigned c = xb_ld(&bar[XB_XCNT(j)]); sum += c; cnt += (c > 0u) ? 1u : 0u; mine = (j == x) ? c : mine; }
        if (sum == G) break;
        __builtin_amdgcn_s_sleep(1);
        if ((++sp & 255u) == 0u) { if (xb_ld(&bar[XB_TMO])) break; if (sp > XB_SPIN_CAP) { atomicAdd(&bar[XB_TMO], 1u); break; } }
    }
    nloc = mine > 0u ? mine : 1u; nx = cnt > 0u ? cnt : 1u;
}

__device__ __forceinline__ void xcd_barrier(const XcdBarrier& b) {
    asm volatile("s_waitcnt vmcnt(0)" ::: "memory");
    __syncthreads();
    if (threadIdx.x == 0) {
        unsigned* bar = b.bar;
        __builtin_amdgcn_s_waitcnt(0);
        unsigned nloc = b.st[0], nx = b.st[1];
        if (nloc == 0u) { xcd_barrier_complete(bar, b.x, nloc, nx); b.st[0] = nloc; b.st[1] = nx; }
        const unsigned old = xb_add(&bar[XB_XSUB(b.x)], 1u);
        const unsigned gen = old / nloc;
        if (old + 1u == (gen + 1u) * nloc) {
            __builtin_amdgcn_fence(__ATOMIC_RELEASE, "agent");
            asm volatile("s_waitcnt vmcnt(0)" ::: "memory");
            const unsigned og = xb_add(&bar[XB_TOP], 1u);
            const unsigned tg = og / nx;
            if (og + 1u == (tg + 1u) * nx) xb_add(&bar[XB_TOPGEN], 1u);
            else XB_SPIN(xb_ld(&bar[XB_TOPGEN]) == tg, bar);
            __builtin_amdgcn_fence(__ATOMIC_ACQUIRE, "agent");
            xb_add(&bar[XB_XGEN(b.x)], 1u);
            asm volatile("s_waitcnt vmcnt(0)" ::: "memory");
        } else {
            XB_SPIN(xb_ld(&bar[XB_XGEN(b.x)]) == gen, bar);
            __builtin_amdgcn_fence(__ATOMIC_ACQUIRE, "agent");
            asm volatile("s_waitcnt vmcnt(0)" ::: "memory");
        }
    }
    __syncthreads();
}

template <int DQK, int DV, int MODE>
__device__ __forceinline__ void att_call(bool strip, LAS unsigned char* lds, const bf16* Qb, int qpitch, const bf16* Kb, int kpitch, const bf16* VTb, int skv, const unsigned* maskb, const bf16* Zb, bf16* Ob, int q0) {
    if (ATT_STRIP != 0 && strip) attn_unit<DQK, DV, MODE, ATT_STRIP>(lds, Qb, qpitch, Kb, kpitch, VTb, skv, maskb, Zb, Ob, q0);
    else attn_unit<DQK, DV, MODE, 0>(lds, Qb, qpitch, Kb, kpitch, VTb, skv, maskb, Zb, Ob, q0);
}
struct Args { const float* in[19]; const int* pos; float* out; unsigned char* ws; };
typedef const __attribute__((address_space(4))) Args* kargs_t;
#define PHASE_BEGIN \
    kargs_t ap_ = (kargs_t)__builtin_amdgcn_kernarg_segment_ptr(); asm volatile("" : "+s"(ap_)); \
    int tid = threadIdx.x; asm volatile("" : "+v"(tid)); \
    const int lane = tid & 63, wave = __builtin_amdgcn_readfirstlane(tid >> 6), G = gridDim.x, NGW = G * 8, gw = blockIdx.x * 8 + wave; \
    unsigned char* const ws = ap_->ws; unsigned char* const dob = (unsigned char*)ap_->out; const int* const pos = ap_->pos; float* const outp = ap_->out; unsigned* const ctl = (unsigned*)(ws + WS_CTL); \
    const float* const x = ap_->in[0]; const float* const mem = ap_->in[1]; \
    const float* const g_norm = ap_->in[3]; const float* const w_in = ap_->in[4]; const float* const g_qn_a = ap_->in[5]; const float* const g_kn_a = ap_->in[6]; \
    const float* const g_cq = ap_->in[7]; const float* const g_ckv = ap_->in[8]; const float* const w_uq = ap_->in[9]; const float* const w_ukv = ap_->in[10]; \
    const float* const g_qn_b = ap_->in[11]; const float* const g_kn_b = ap_->in[12]; const float* const g_mem = ap_->in[13]; const float* const w_mem_kv = ap_->in[14]; \
    const float* const g_qn_m = ap_->in[15]; const float* const g_kn_m = ap_->in[16]; const float* const w_branch = ap_->in[17]; const float* const w_out = ap_->in[18]; \
    bf16* const WinT = (bf16*)(ws + WS_WIN); bf16* const WuqT = (bf16*)(ws + WS_WUQ); bf16* const WukvT = (bf16*)(ws + WS_WUKV); bf16* const WmemT = (bf16*)(ws + WS_WMEM); \
    bf16* const WbrT = (bf16*)(ws + WS_WBR); bf16* const WoutT = (bf16*)(ws + WS_WOUT); \
    float* const ropeA = (float*)(ws + WS_ROPEA); float* const ropeB = (float*)(ws + WS_ROPEB); \
    bf16* const MN = (bf16*)(ws + WS_MN); bf16* const KVM = (bf16*)(ws + WS_KVM); bf16* const VTM = (bf16*)(ws + WS_VTM); \
    float* const WI = (float*)(ws + WS_WI); unsigned* const MASK = (unsigned*)(ws + WS_MASK); \
    bf16* const VTA = (bf16*)(dob + DO_VTA); bf16* const VTB = (bf16*)(dob + DO_VTB); bf16* const KB = (bf16*)(dob + DO_KB); \
    bf16* const Hh = (bf16*)(ws + WS_H); bf16* const MG = (bf16*)(ws + WS_H); bf16* const QB = (bf16*)(ws + WS_QB); \
    bf16* const KVB = (bf16*)(ws + WS_KVB); bf16* const GT0 = (bf16*)(dob + DO_G0); bf16* const GT1 = (bf16*)(ws + WS_G1); bf16* const P = (bf16*)(ws + WS_P); \
    (void)lane; (void)NGW; (void)gw; (void)ctl; \
    (void)pos; (void)outp; (void)x; (void)mem; (void)g_norm; (void)w_in; (void)g_qn_a; (void)g_kn_a; (void)g_cq; (void)g_ckv; (void)w_uq; (void)w_ukv; (void)g_qn_b; (void)g_kn_b; (void)g_mem; (void)w_mem_kv; \
    (void)g_qn_m; (void)g_kn_m; (void)w_branch; (void)w_out; (void)WinT; (void)WuqT; (void)WukvT; (void)WmemT; (void)WbrT; (void)WoutT; (void)ropeA; (void)ropeB; (void)MN; (void)KVM; (void)VTM; (void)WI; (void)MASK; \
    (void)VTA; (void)VTB; (void)Hh; (void)KB; (void)QB; (void)KVB; (void)MG; (void)GT0; (void)GT1; (void)P
#define GRID_BARRIER() do { kargs_t bp_ = (kargs_t)__builtin_amdgcn_kernarg_segment_ptr(); asm volatile("" : "+s"(bp_)); \
    XcdBarrier b_; b_.bar = (unsigned*)(bp_->ws + WS_CTL) + 4096; b_.x = xb_xcc_id(); b_.st = (volatile LAS unsigned*)(lds + LDS_BYTES - 32); xcd_barrier(b_); } while (0)

__global__ void __launch_bounds__(512, 2) fwd_kernel(Args a) {
    extern __shared__ __attribute__((aligned(16))) unsigned char lds_raw[];
    LAS unsigned char* const lds = (LAS unsigned char*)lds_raw;
    volatile LAS int* const slot = (volatile LAS int*)(lds + LDS_SLOT);
    if (threadIdx.x < 16) ((LAS unsigned*)(lds + LDS_BYTES - 64))[threadIdx.x] = 0u;
    __syncthreads();
    (void)xcd_barrier_post((unsigned*)(a.ws + WS_CTL) + 4096, (volatile LAS unsigned*)(lds + LDS_BYTES - 32));

    for (int rep = 0; rep < REP_P0; ++rep) { PHASE_BEGIN;
        LAS float* scr = (LAS float*)(lds + wave * 16384);
        constexpr int I_IN = 16 * (NP / 32), I_UQ = 6 * 24, I_UKV = 4 * 32, I_MEM = 16 * 32, I_BR = 8 * 32, I_OUT = 16 * 32;
        constexpr int NITEMS = I_IN + I_UQ + I_UKV + I_MEM + 3 * I_BR + I_OUT;
        for (int it = gw; it < NITEMS; it += NGW) {
            int r = it;
            if (r < I_IN) { transpose_item<true>(w_in, 1024, DIN, NP, WinT, scr, r, lane); continue; } r -= I_IN;
            if (r < I_UQ) { transpose_item<false>(w_uq, 384, 768, 768, WuqT, scr, r, lane); continue; } r -= I_UQ;
            if (r < I_UKV) { transpose_item<false>(w_ukv, 256, 1024, 1024, WukvT, scr, r, lane); continue; } r -= I_UKV;
            if (r < I_MEM) { transpose_item<false>(w_mem_kv, 1024, 1024, 1024, WmemT, scr, r, lane); continue; } r -= I_MEM;
            if (r < 3 * I_BR) { const int nb = r / I_BR; transpose_item<false>(w_branch + (size_t)nb * 512 * 1024, 512, 1024, 1024, WbrT + (size_t)nb * 1024 * 512, scr, r % I_BR, lane); continue; } r -= 3 * I_BR;
            transpose_item<false>(w_out, 1024, 1024, 1024, WoutT, scr, r, lane);
        }
        for (int idx = blockIdx.x * 512 + tid; idx < TT * 24; idx += G * 512) {
            const int t = idx / 24, i = idx % 24; const float pf = (float)pos[t];
            if (i < 8) { const float ang = pf * INVA[i]; ropeA[t * 16 + i] = cosf(ang); ropeA[t * 16 + 8 + i] = sinf(ang); }
            else { const int j = i - 8; const float ang = pf * INVB[j]; ropeB[t * 32 + j] = cosf(ang); ropeB[t * 32 + 16 + j] = sinf(ang); }
        }
        for (int m = gw; m < NB * MEML; m += NGW) rms_row_1024(mem + (size_t)m * DM, g_mem, MN + (size_t)m * DM, lane);
        for (int rp = 0; rp < REP_PH; ++rp)
        for (int m = gw; m < TT; m += NGW) rms_row_1024(x + (size_t)m * DM, g_norm, Hh + (size_t)m * DM, lane);
    }
    GRID_BARRIER();
    for (int es = 0; es < EXTRA_SYNCS; ++es) GRID_BARRIER();

    for (int rep = 0; rep < REP_G1; ++rep) { PHASE_BEGIN;
        pg8::Gemm g{Hh, WinT, TT, PP, 1024, 1024}; pg8::StaticOrder S; S.init(TT, PP, G, (int)blockIdx.x);
        pg8::EpiBf16<0> E{P, PP, nullptr, 0, 0, 1.f};
        pg8::gemm_phase<pg8::EpiBf16<0>, pg8::StaticOrder, true, true>(lds, g, S, E);
    }
    { PHASE_BEGIN;
        pg8::Gemm g{MN, WmemT, NB * MEML, 1024, 1024, 1024}; pg8::StaticOrder S; S.init(NB * MEML, 1024, G, (int)((blockIdx.x + 64) % G));
        pg8::EpiBf16<0> E{KVM, 1024, nullptr, 0, 0, 1.f};
        pg8::gemm_phase<pg8::EpiBf16<0>, pg8::StaticOrder, true, true>(lds, g, S, E);
    }
    GRID_BARRIER();
    { PHASE_BEGIN;
        float ga[8], gk[8], gq[8], gc[8], gm[8];
#pragma unroll
        for (int j = 0; j < 8; ++j) { ga[j] = g_qn_a[8 * (lane & 7) + j]; gk[j] = g_kn_a[8 * (lane & 7) + j]; gm[j] = g_qn_m[8 * (lane & 15) + j]; gq[j] = lane < 48 ? g_cq[8 * lane + j] : 0.f; gc[j] = lane < 32 ? g_ckv[8 * lane + j] : 0.f; }
        for (int dp = 0; dp < DUMMY_POST1; ++dp)
            for (int m = gw; m < TT; m += NGW)
                post1_row(P + (size_t)m * PP, QB + (size_t)(m & 1023) * 4096, ropeA + (size_t)m * 16, ga, gk, gq, gc, gm, (float*)KVB + (size_t)m * 8, lane);
        for (int m = gw; m < TT; m += NGW)
            post1_row(P + (size_t)m * PP, P + (size_t)m * PP, ropeA + (size_t)m * 16, ga, gk, gq, gc, gm, WI + (size_t)m * 8, lane);
        for (int rt = 0; rt < REP_TR; ++rt)
        transpose_v(P, PP, C_VA, 64, 8, 64, SEQ, NB, VTA, gw, NGW, lane);
        for (int m = gw; m < NB * MEML; m += NGW) km_row(KVM + (size_t)m * 1024, g_kn_m, lane);
        for (int rt = 0; rt < REP_TR; ++rt)
        transpose_v(KVM, 1024, 512, 128, 4, 128, MEML, NB, VTM, gw, NGW, lane);
    }
    GRID_BARRIER();
    for (int rep = 0; rep < REP_G2; ++rep) { PHASE_BEGIN;
        pg8::Gemm g{P + C_CQ, WuqT, TT, 768, 384, PP}; pg8::StaticOrder S; S.init(TT, 768, G, (int)blockIdx.x);
        pg8::EpiBf16<0> E{QB, 768, nullptr, 0, 0, 1.f};
        pg8::gemm_phase<pg8::EpiBf16<0>, pg8::StaticOrder, true, true>(lds, g, S, E);
    }
    for (int rep = 0; rep < REP_G2; ++rep) { PHASE_BEGIN;
        pg8::Gemm g{P + C_CKV, WukvT, TT, 1024, 256, PP}; pg8::StaticOrder S; S.init(TT, 1024, G, (int)((blockIdx.x + 192) % G));
        pg8::EpiBf16<0> E{KVB, 1024, nullptr, 0, 0, 1.f};
        pg8::gemm_phase<pg8::EpiBf16<0>, pg8::StaticOrder, true, true>(lds, g, S, E);
    }
    for (int rep = 0; rep < REP_IDX; ++rep) { if (rep > 0) GRID_BARRIER();
        PHASE_BEGIN;
        unsigned* const q_idx = ctl + 64 * (0 + 4 * rep);
        int u = next_unit(q_idx, slot);
        while (u < NB * 128) {
            int tk = 0; if (tid == 0) tk = (int)atomicAdd(q_idx, 1u);
            const int tb = 127 - (u >> 3), bb = u & 7;
            indexer_unit((LAS float*)lds, P, WI, MASK, bb, tb);
            if (tid == 0) *slot = tk;
            __syncthreads();
            u = *slot;
        }
    }
    GRID_BARRIER();
    { PHASE_BEGIN;
        LAS float* scr = (LAS float*)(lds + wave * 8192);
        float gqv[12], gkv[12];
#pragma unroll
        for (int e = 0; e < 12; ++e) { gqv[e] = g_qn_b[12 * (lane & 7) + e]; gkv[e] = g_kn_b[12 * (lane & 7) + e]; }
        for (int dp = 0; dp < DUMMY_POST2; ++dp)
            for (int m = gw; m < TT; m += NGW)
                post2_row(QB + (size_t)m * 768, (bf16*)MASK + (size_t)(m & 1023) * 768, KVB + (size_t)m * 1024, P + (size_t)m * PP, (bf16*)MASK + (size_t)(1024 + (m & 1023)) * 768, ropeB + (size_t)m * 32, gqv, gkv, scr, lane);
        for (int m = gw; m < TT; m += NGW)
            post2_row(QB + (size_t)m * 768, QB + (size_t)m * 768, KVB + (size_t)m * 1024, P + (size_t)m * PP, KB + (size_t)m * 768, ropeB + (size_t)m * 32, gqv, gkv, scr, lane);
        for (int rt = 0; rt < REP_TR; ++rt)
        transpose_v(KVB, 1024, 64, 128, 8, 64, SEQ, NB, VTB, gw, NGW, lane);
    }
    GRID_BARRIER();
    for (int rep = 0; rep < REP_ATT; ++rep) { if (rep > 0) GRID_BARRIER();
        PHASE_BEGIN;
        unsigned* const q_att = ctl + 64 * (1 + 4 * rep);
        for (;;) {
            const int u = next_unit(q_att, slot);
            if (u >= 1152) break;
            if (u < 704 || u >= 832) {
                const int uu = u < 704 ? u : u - 128, cls = uu >> 6, bh = uu & 63, bb = bh >> 3, h = bh & 7;
                const bool isA = (0x52a7u >> cls) & 1u; const int qb = (int)((0x11232435467567ull >> (4 * cls)) & 15ull);
                const size_t r0 = (size_t)bb * SEQ;
                if (!isA) attn_unit_pipe<96, 1>(lds, QB + r0 * 768 + h * 96, 768, KB + r0 * 768 + h * 96, 768, VTB + (size_t)((bb * 8 + h) * 64) * SEQ, SEQ, nullptr,
                                                   P + r0 * PP + C_YB + h * 64, qb * 256);
                else attn_unit_pipe<64, 2>(lds, P + r0 * PP + C_QA + h * 64, PP, P + r0 * PP + C_KA + h * 64, PP, VTA + (size_t)((bb * 8 + h) * 64) * SEQ, SEQ, MASK + r0 * 64,
                                           P + r0 * PP + C_YA + h * 64, qb * 256);
            } else {
                const int v = u - 704, hq = v & 3, bh = v >> 2, bb = bh >> 2, h = bh & 3;
                const size_t r0 = (size_t)bb * SEQ;
                attn_unit_mem(lds, P + r0 * PP + C_QM + h * 128, KVM + (size_t)bb * MEML * 1024 + h * 128, VTM + (size_t)((bb * 4 + h) * 128) * MEML,
                              P + r0 * PP + C_ZM + h * 128, P + r0 * PP + C_YM + h * 128, hq * 512);
            }
        }
    }
    GRID_BARRIER();
    for (int rep = 0; rep < 1; ++rep) { PHASE_BEGIN;
        pg8::Gemm g{Hh, WinT + (size_t)PP * 1024, TT, NZG, 1024, 1024}; pg8::StaticOrder S; S.init(TT, NZG, G, (int)blockIdx.x);
        EpiZG E{P, GT0, GT1};
        pg8::gemm_phase<EpiZG, pg8::StaticOrder, true, true>(lds, g, S, E);
    }
    GRID_BARRIER();
    for (int nbr = 0; nbr < 3 * REP_G4; ++nbr) { const int nb = nbr % 3; PHASE_BEGIN;
        pg8::Gemm g{P + (nb == 0 ? C_YA : (nb == 1 ? C_YB : C_YM)), WbrT + (size_t)nb * 1024 * 512, TT, 1024, 512, PP}; pg8::StaticOrder S; S.init(TT, 1024, G, (int)blockIdx.x);
        EpiMerge E{MG, GT0, GT1, nb};
        pg8::gemm_phase<EpiMerge, pg8::StaticOrder, true, true>(lds, g, S, E);
    }
    GRID_BARRIER();
    for (int rep = 0; rep < REP_G5; ++rep) { PHASE_BEGIN;
        pg8::Gemm g{MG, WoutT, TT, 1024, 1024, 1024}; pg8::StaticOrder S; S.init(TT, 1024, G, (int)blockIdx.x);
        EpiOut E{x, outp};
        pg8::gemm_phase<EpiOut, pg8::StaticOrder, true, true>(lds, g, S, E);
    }
}

extern "C" void kernel_launch(void* const* d_in, const int* in_sizes, int n_in, void* d_out, int out_size, void* d_ws, size_t ws_size, hipStream_t stream) {
    static int grid = 0;
    if (grid == 0) {
        if (n_in != 19 || out_size != TT * DM || ws_size < WS_END) { fprintf(stderr, "kernel_launch: unexpected problem (n_in %d, out %d, ws %zu); nothing launched\n", n_in, out_size, ws_size); grid = -1; return; }
        int dev = 0, cus = 0, per_cu = 0;
        if (hipGetDevice(&dev) != hipSuccess || hipDeviceGetAttribute(&cus, hipDeviceAttributeMultiprocessorCount, dev) != hipSuccess) { grid = -1; return; }
        if (hipFuncSetAttribute((const void*)fwd_kernel, hipFuncAttributeMaxDynamicSharedMemorySize, LDS_BYTES) != hipSuccess) { fprintf(stderr, "kernel_launch: hipFuncSetAttribute failed\n"); grid = -1; return; }
        if (hipOccupancyMaxActiveBlocksPerMultiprocessor(&per_cu, (const void*)fwd_kernel, 512, LDS_BYTES) != hipSuccess || per_cu < 1) { fprintf(stderr, "kernel_launch: occupancy query reports %d blocks per CU\n", per_cu); (void)hipGetLastError(); grid = -1; return; }
        grid = cus;
    }
    if (grid < 0) return;
    (void)hipMemsetAsync((char*)d_ws + WS_CTL, 0, 65536, stream);
    Args a{};
    for (int i = 0; i < 19; ++i) a.in[i] = (const float*)d_in[i];
    a.pos = (const int*)d_in[2]; a.out = (float*)d_out; a.ws = (unsigned char*)d_ws;
    hipLaunchKernelGGL(fwd_kernel, dim3(grid), dim3(512), LDS_BYTES, stream, a);
    const hipError_t e = hipPeekAtLastError();
    if (e != hipSuccess) fprintf(stderr, "kernel_launch: launch failed: %s (grid %d)\n", hipGetErrorString(e), grid);
}
```

```cpp
#include <hip/hip_runtime.h>
#include <cstdio>
#include <cstdint>
namespace pg8 {
#define PG8_LAS __attribute__((address_space(3)))
typedef unsigned short bf16_t;
typedef short bf16x8 __attribute__((ext_vector_type(8)));
typedef float f32x4 __attribute__((ext_vector_type(4)));
typedef unsigned u32x4 __attribute__((ext_vector_type(4)));
constexpr int BM = 256, BK = 64, HALF = 128, HTB = HALF * BK * 2  , STAGE_BYTES = 8 * HTB, NXCD = 8, WGM = 8;

__host__ __device__ __forceinline__ int lds_byte(int r, int c) { const int st = (r >> 4) * 2 + (c >> 5), rr = r & 15, cc = c & 31, ob = rr * 64 + cc * 2; return st * 1024 + (ob ^ (((ob >> 9) & 1) << 5)); }
__host__ __device__ __forceinline__ void stage_rc(int b, int& R, int& C) { const int st = b / 1024, sb = b % 1024, swz = sb ^ (((sb >> 9) & 1) << 5); R = (st >> 1) * 16 + swz / 64; C = (st & 1) * 32 + (swz % 64) / 2; }
__host__ __device__ __forceinline__ int perm32(int rho) { const int n = rho >> 4, i = rho & 15; return 8 * (i >> 2) + 4 * n + (i & 3); }

struct Unit { int pm, pn; };
struct Gemm { const bf16_t* A; const bf16_t* Bt; int M, N, K, lda; };

struct StaticOrder {
    int nM, nN, nwg, G, c;
    __host__ __device__ void init(int M, int N, int G_, int c_) { nM = M / BM; nN = N / BM; nwg = nM * nN; G = G_; c = c_; }
    __host__ __device__ bool next(int i, Unit& u) const {
        const long L = (long)i * G + c; if (L >= nwg) return false;
        int wgid = (int)L; { const int q = nwg / NXCD, r = nwg % NXCD, xcd = wgid % NXCD, off = wgid / NXCD; wgid = (xcd < r ? xcd * (q + 1) : r * (q + 1) + (xcd - r) * q) + off; }
        const int nig = WGM * nN, gid = wgid / nig, fm = gid * WGM, gsz = (nM - fm) < WGM ? (nM - fm) : WGM;
        u.pm = fm + ((wgid % nig) % gsz); u.pn = (wgid % nig) / gsz; return true;
    }
    __device__ __forceinline__ void a_ready(const Unit&) const {}
    __device__ __forceinline__ void done(const Unit&) const {}
};

__device__ __forceinline__ unsigned cvt_pk_bf16(float lo, float hi) { unsigned r; asm volatile("v_cvt_pk_bf16_f32 %0, %1, %2" : "=v"(r) : "v"(lo), "v"(hi)); return r; }
typedef float f32x2 __attribute__((ext_vector_type(2)));
__device__ __forceinline__ f32x2 gelu_pk(f32x2 v) {
    const f32x2 av = __builtin_elementwise_abs(v), d = av * 0.2316418882f + 1.0f;
    f32x2 t; t.x = __builtin_amdgcn_rcpf(d.x); t.y = __builtin_amdgcn_rcpf(d.y);
    f32x2 q = t * 0.5307027145f + (-0.7265760135f); q = q * t + 0.7107068705f; q = q * t + (-0.142248368f); q = q * t + 0.127414796f; q = q * t;
    const f32x2 s = (v * v) * (-0.72134752044f);
    f32x2 e; e.x = __builtin_amdgcn_exp2f(s.x); e.y = __builtin_amdgcn_exp2f(s.y);
    const f32x2 m = v * (q * e), r = v - m;
    f32x2 o; o.x = v.x < 0.f ? m.x : r.x; o.y = v.y < 0.f ? m.y : r.y; return o;
}

template <int ACT  > struct EpiBf16 {
    static constexpr bool PERM = true, AFTER_DRAIN = false; static_assert(ACT == 0 || ACT == 1, "EpiBf16: ACT is 0 (none) or 1 (gelu_pk)");
    bf16_t* O; int ldc; const float* bias; int split_cols; size_t split_stride; float scale0;
    __device__ __forceinline__ void operator()(const f32x4 (&acc)[2][2][4][2], const Unit& u, int wr, int wc, int fr, int fq) const {
        const int row0 = u.pm * BM + wr * 64 + fr; int colt = u.pn * BM; bf16_t* base = O;
        float sc = 1.f; if (split_cols) { const int t = colt / split_cols; base += (size_t)t * split_stride; colt -= t * split_cols; if (t == 0) sc = scale0; }
        const int col0 = colt + wc * 32 + 8 * fq, bcol0 = u.pn * BM + wc * 32 + 8 * fq;
        f32x4 bv[2][2];
#pragma unroll
        for (int bj = 0; bj < 2; ++bj)
#pragma unroll
            for (int n = 0; n < 2; ++n) bv[bj][n] = bias ? *(const f32x4*)(bias + bcol0 + bj * HALF + 4 * n) : (f32x4){0.f, 0.f, 0.f, 0.f};
#pragma unroll
        for (int ai = 0; ai < 2; ++ai)
#pragma unroll
            for (int m = 0; m < 4; ++m) { bf16_t* rowp = base + (size_t)(row0 + ai * HALF + m * 16) * ldc + col0;
#pragma unroll
                for (int bj = 0; bj < 2; ++bj) { f32x4 v0 = acc[ai][bj][m][0] + bv[bj][0], v1 = acc[ai][bj][m][1] + bv[bj][1];
                    if (ACT == 1) { f32x2 a = gelu_pk((f32x2){v0[0], v0[1]}), b = gelu_pk((f32x2){v0[2], v0[3]}), c = gelu_pk((f32x2){v1[0], v1[1]}), d = gelu_pk((f32x2){v1[2], v1[3]});
                        v0 = (f32x4){a.x, a.y, b.x, b.y}; v1 = (f32x4){c.x, c.y, d.x, d.y}; }
                    v0 = v0 * sc; v1 = v1 * sc; u32x4 w; w.x = cvt_pk_bf16(v0[0], v0[1]); w.y = cvt_pk_bf16(v0[2], v0[3]); w.z = cvt_pk_bf16(v1[0], v1[1]); w.w = cvt_pk_bf16(v1[2], v1[3]);
                    *(u32x4*)(rowp + bj * HALF) = w; } }
    }
};
template <class Epi, class Sched, bool ALIGN_EPI = false, bool SP2 = false>
__device__ __forceinline__ void gemm_phase(PG8_LAS unsigned char* lds, const Gemm g, const Sched& S, const Epi& E) {
    int tid_ = threadIdx.x; asm volatile("" : "+v"(tid_));
    const int tid = tid_, wid = __builtin_amdgcn_readfirstlane(tid >> 6), lane = tid & 63, wr = wid >> 2, wc = wid & 3, fr = lane & 15, fq = lane >> 4;
    const int K = g.K, nt = K / BK;
    unsigned voffA[2], voffB[2];
#pragma unroll
    for (int i = 0; i < 2; ++i) { int R, C; stage_rc(tid * 16 + i * 8192, R, C); const int Rb = Epi::PERM ? ((R & ~31) + perm32(R & 31)) : R;
        voffA[i] = (unsigned)(R * g.lda + C) * 2u; voffB[i] = (unsigned)(Rb * K + C) * 2u; }
    const size_t kstep = (size_t)(BK * 2);
    const size_t hstepA = (size_t)HALF * g.lda * 2, hstepB = (size_t)HALF * K * 2;
    const size_t tstepA = 2 * hstepA, tstepB = 2 * hstepB;
    const unsigned ldsw = (unsigned)wid * 1024u;
    const int aoff = lds_byte(wr * 64 + fr, fq * 8), boff = lds_byte(wc * 32 + fr, fq * 8);
#define PG8_SA(b, h) (((b) * 2 + (h)) * HTB)
#define PG8_SB(b, h) ((4 + (b) * 2 + (h)) * HTB)
#define PG8_STAGE(bufoff, gbase, voff) do { _Pragma("unroll") for (int _i = 0; _i < 2; ++_i) \
        __builtin_amdgcn_global_load_lds((const unsigned*)((const char*)(gbase) + (voff)[_i]), (PG8_LAS unsigned*)(lds + (bufoff) + ldsw + _i * 8192), 16, 0, 0); } while (0)
#define PG8_LDA(dst, b, h) do { _Pragma("unroll") for (int m = 0; m < 4; ++m) _Pragma("unroll") for (int k = 0; k < 2; ++k) dst[m][k] = *(const PG8_LAS bf16x8*)(lds + PG8_SA(b, h) + aoff + m * 2048 + k * 1024); } while (0)
#define PG8_LDB(dst, b, h) do { _Pragma("unroll") for (int n = 0; n < 2; ++n) _Pragma("unroll") for (int k = 0; k < 2; ++k) dst[n][k] = *(const PG8_LAS bf16x8*)(lds + PG8_SB(b, h) + boff + n * 2048 + k * 1024); } while (0)
#define PG8_MMA(ai, bj, At, Bt) do { __builtin_amdgcn_s_setprio(1); _Pragma("unroll") for (int m = 0; m < 4; ++m) _Pragma("unroll") for (int n = 0; n < 2; ++n) _Pragma("unroll") for (int k = 0; k < 2; ++k) \
        acc[ai][bj][m][n] = __builtin_amdgcn_mfma_f32_16x16x32_bf16(Bt[n][k], At[m][k], acc[ai][bj][m][n], 0, 0, 0); __builtin_amdgcn_s_setprio(0); } while (0)
#define PG8_WAIT_V(n) asm volatile("s_waitcnt vmcnt(" #n ")" ::: "memory")
#define PG8_WAIT_L(n) asm volatile("s_waitcnt lgkmcnt(" #n ")" ::: "memory")
#define PG8_BAR __builtin_amdgcn_s_barrier()
#define PG8_SCHED __builtin_amdgcn_sched_barrier(0)
    Unit cur, nxt; int ui = 0;
    if (!S.next(0, cur)) return;
    f32x4 acc[2][2][4][2];
#pragma unroll
    for (int a = 0; a < 2; ++a)
#pragma unroll
        for (int b = 0; b < 2; ++b)
#pragma unroll
            for (int m = 0; m < 4; ++m)
#pragma unroll
                for (int n = 0; n < 2; ++n) acc[a][b][m][n] = (f32x4){0.f, 0.f, 0.f, 0.f};
    bf16x8 At[4][2], B0[2][2], B1[2][2];
    const char* cA = (const char*)g.A + (size_t)cur.pm * tstepA; const char* cB = (const char*)g.Bt + (size_t)cur.pn * tstepB;
    S.a_ready(cur);
    if constexpr (SP2) {
        PG8_STAGE(PG8_SB(0, 0), cB, voffB); PG8_STAGE(PG8_SB(0, 1), cB + hstepB, voffB); PG8_STAGE(PG8_SA(0, 0), cA, voffA); PG8_STAGE(PG8_SA(0, 1), cA + hstepA, voffA);
        if (wr == 1) PG8_BAR;
        PG8_WAIT_V(2); PG8_BAR;
        PG8_STAGE(PG8_SB(1, 0), cB + kstep, voffB); PG8_STAGE(PG8_SA(1, 0), cA + kstep, voffA); PG8_STAGE(PG8_SB(1, 1), cB + hstepB + kstep, voffB);
        PG8_WAIT_V(6); PG8_BAR;
    } else {
        PG8_STAGE(PG8_SB(0, 0), cB, voffB); PG8_STAGE(PG8_SA(0, 0), cA, voffA); PG8_STAGE(PG8_SB(0, 1), cB + hstepB, voffB); PG8_STAGE(PG8_SA(0, 1), cA + hstepA, voffA);
        if (wr == 1) PG8_BAR;
        PG8_WAIT_V(4); PG8_BAR;
        PG8_STAGE(PG8_SB(1, 0), cB + kstep, voffB); PG8_STAGE(PG8_SA(1, 0), cA + kstep, voffA); PG8_STAGE(PG8_SB(1, 1), cB + hstepB + kstep, voffB);
        PG8_WAIT_V(6); PG8_BAR;
    }
    for (;;) {
        const bool has_next = S.next(ui + 1, nxt);
        const char* nA = has_next ? (const char*)g.A + (size_t)nxt.pm * tstepA : cA; const char* nB = has_next ? (const char*)g.Bt + (size_t)nxt.pn * tstepB : cB;
        for (int t = 0; t < nt; t += 2) {
            const bool last = (t == nt - 2);
            const char* a1 = cA + (size_t)(t + 1) * kstep;
            const char* a2 = last ? nA : cA + (size_t)(t + 2) * kstep; const char* b2 = last ? nB : cB + (size_t)(t + 2) * kstep;
            const char* a3 = a2 + kstep; const char* b3 = b2 + kstep;
            if (last && has_next) S.a_ready(nxt);
            if constexpr (SP2) {
            PG8_LDB(B0, 0, 0); PG8_LDB(B1, 0, 1); PG8_SCHED; PG8_LDA(At, 0, 0); PG8_STAGE(PG8_SA(1, 1), a1 + hstepA, voffA);
            PG8_WAIT_V(8); PG8_WAIT_L(0); PG8_BAR; PG8_MMA(0, 0, At, B0); PG8_MMA(0, 1, At, B1); PG8_BAR; PG8_SCHED;
            PG8_LDA(At, 0, 1); PG8_STAGE(PG8_SB(0, 0), b2, voffB); PG8_STAGE(PG8_SB(0, 1), b2 + hstepB, voffB); PG8_STAGE(PG8_SA(0, 0), a2, voffA);
            PG8_WAIT_V(8); PG8_WAIT_L(0); PG8_BAR; PG8_MMA(1, 0, At, B0); PG8_MMA(1, 1, At, B1); PG8_BAR; PG8_SCHED;
            PG8_LDB(B0, 1, 0); PG8_LDB(B1, 1, 1); PG8_SCHED; PG8_LDA(At, 1, 0); PG8_STAGE(PG8_SA(0, 1), a2 + hstepA, voffA);
            PG8_WAIT_V(8); PG8_WAIT_L(0); PG8_BAR; PG8_MMA(0, 0, At, B0); PG8_MMA(0, 1, At, B1); PG8_BAR; PG8_SCHED;
            PG8_LDA(At, 1, 1); PG8_STAGE(PG8_SB(1, 0), b3, voffB); PG8_STAGE(PG8_SB(1, 1), b3 + hstepB, voffB); PG8_STAGE(PG8_SA(1, 0), a3, voffA);
            PG8_WAIT_V(8); PG8_WAIT_L(0); PG8_BAR; PG8_MMA(1, 0, At, B0); PG8_MMA(1, 1, At, B1); PG8_BAR; PG8_SCHED;
            } else {
            PG8_LDB(B0, 0, 0); PG8_SCHED; PG8_LDA(At, 0, 0); PG8_STAGE(PG8_SA(1, 1), a1 + hstepA, voffA);
            PG8_WAIT_L(8); PG8_BAR; PG8_WAIT_L(0); PG8_MMA(0, 0, At, B0); PG8_BAR; PG8_SCHED;
            PG8_LDB(B1, 0, 1); PG8_STAGE(PG8_SB(0, 0), b2, voffB);
            PG8_BAR; PG8_WAIT_L(0); PG8_MMA(0, 1, At, B1); PG8_BAR;
            PG8_LDA(At, 0, 1); PG8_STAGE(PG8_SA(0, 0), a2, voffA);
            PG8_BAR; PG8_WAIT_L(0); PG8_MMA(1, 0, At, B0); PG8_BAR; PG8_SCHED;
            PG8_STAGE(PG8_SB(0, 1), b2 + hstepB, voffB);
            PG8_WAIT_V(6); PG8_BAR; PG8_MMA(1, 1, At, B1); PG8_BAR;
            PG8_LDB(B0, 1, 0); PG8_SCHED; PG8_LDA(At, 1, 0); PG8_STAGE(PG8_SA(0, 1), a2 + hstepA, voffA);
            PG8_WAIT_L(8); PG8_BAR; PG8_WAIT_L(0); PG8_MMA(0, 0, At, B0); PG8_BAR; PG8_SCHED;
            PG8_LDB(B1, 1, 1); PG8_STAGE(PG8_SB(1, 0), b3, voffB);
            PG8_BAR; PG8_WAIT_L(0); PG8_MMA(0, 1, At, B1); PG8_BAR;
            PG8_LDA(At, 1, 1); PG8_STAGE(PG8_SA(1, 0), a3, voffA);
            PG8_BAR; PG8_WAIT_L(0); PG8_MMA(1, 0, At, B0); PG8_BAR; PG8_SCHED;
            PG8_STAGE(PG8_SB(1, 1), b3 + hstepB, voffB);
            PG8_WAIT_V(6); PG8_BAR; PG8_MMA(1, 1, At, B1); PG8_BAR;
            }
        }
        if constexpr (ALIGN_EPI) { if (wr == 0) PG8_BAR; }
        if constexpr (!Epi::AFTER_DRAIN) { E(acc, cur, wr, wc, fr, fq); S.done(cur); }
        if (!has_next) break;
#pragma unroll
        for (int a = 0; a < 2; ++a)
#pragma unroll
            for (int b = 0; b < 2; ++b)
#pragma unroll
                for (int m = 0; m < 4; ++m)
#pragma unroll
                    for (int n = 0; n < 2; ++n) acc[a][b][m][n] = (f32x4){0.f, 0.f, 0.f, 0.f};
        cur = nxt; cA = nA; cB = nB; ++ui;
        if constexpr (ALIGN_EPI) { if (wr == 1) PG8_BAR; }
    }
    PG8_WAIT_V(0);
    if constexpr (!ALIGN_EPI) { if (wr == 0) PG8_BAR; }
    PG8_BAR;
    if constexpr (Epi::AFTER_DRAIN) { E.fused(acc, cur, wr, wc, fr, fq, lds, wid, lane); S.done(cur); }
#undef PG8_SA
#undef PG8_SB
#undef PG8_STAGE
#undef PG8_LDA
#undef PG8_LDB
#undef PG8_MMA
#undef PG8_WAIT_V
#undef PG8_WAIT_L
#undef PG8_BAR
#undef PG8_SCHED
}
}

#define LAS __attribute__((address_space(3)))
typedef unsigned short bf16;
typedef unsigned v4u __attribute__((ext_vector_type(4)));
typedef unsigned v2u __attribute__((ext_vector_type(2)));
typedef float f32x4 __attribute__((ext_vector_type(4)));
typedef float f32x16 __attribute__((ext_vector_type(16)));
typedef short bf16x8 __attribute__((ext_vector_type(8)));
typedef short s16x4 __attribute__((ext_vector_type(4)));
typedef float f32x2_t __attribute__((ext_vector_type(2)));
typedef __bf16 bf16x2_t __attribute__((ext_vector_type(2)));

constexpr int NB = 8, SEQ = 2048, DM = 1024, TT = NB * SEQ;
constexpr int DIN = 7912, NP = 7936;
constexpr int PP = 3840, NZG = 4096;
constexpr int MEML = 256;
constexpr float EPS = 1e-6f, NEGF = -1e30f;
constexpr int C_QA = 0, C_KA = 512, C_VA = 1024, C_QI = 1536, C_KI = 2048, C_WI = 2112, C_CQ = 2120, C_CKV = 2504, C_KR = 2760, C_QM = 2792, C_ZM = 3304;
constexpr int C_YA = C_QI, C_YB = C_CQ, C_YM = C_VA;
constexpr float SCALE_A = 0.18033688011112042f;
constexpr float SCALE_B = 0.14724444602590306f;
constexpr float SCALE_M = 0.12751743082459868f;
constexpr float SCALE_I = 0.04419417382415922f;

__constant__ float INVA[8] = {1.0f, 0.1939227432012558f, 0.03760603070259094f, 0.007292664609849453f, 0.0014142135623842478f, 0.00027424818836152554f, 5.3182957344688475e-05f, 1.0313385246263351e-05f};
__constant__ float INVB[16] = {1.0f, 0.44036659598350525f, 0.1939227432012558f, 0.08539710193872452f, 0.03760603070259094f, 0.016560440883040428f, 0.007292664609849453f, 0.0032114461064338684f, 0.0014142135623842478f, 0.0006227724370546639f, 0.00027424818836152554f, 0.00012076973507646471f, 5.3182957344688475e-05f, 2.34199997066753e-05f, 1.0313385246263351e-05f, 4.541670477919979e-06f};

constexpr size_t MiB = 1u << 20;
constexpr size_t WS_CTL = 0;
constexpr size_t WS_WIN = 1 * MiB;
constexpr size_t WS_WUQ = 17 * MiB;
constexpr size_t WS_WUKV = 18 * MiB;
constexpr size_t WS_WMEM = 19 * MiB;
constexpr size_t WS_WBR = 21 * MiB;
constexpr size_t WS_WOUT = 24 * MiB;
constexpr size_t WS_ROPEA = 26 * MiB;
constexpr size_t WS_ROPEB = 27 * MiB;
constexpr size_t WS_MN = 29 * MiB;
constexpr size_t WS_KVM = 33 * MiB;
constexpr size_t WS_VTM = 37 * MiB;
constexpr size_t WS_WI = 39 * MiB;
constexpr size_t WS_MASK = 40 * MiB;
constexpr size_t WS_H = 44 * MiB;
constexpr size_t WS_P = 76 * MiB;
constexpr size_t WS_QB = 196 * MiB;
constexpr size_t WS_KVB = 220 * MiB;
constexpr size_t WS_G1 = 196 * MiB;
constexpr size_t WS_END = 256 * MiB;
constexpr size_t DO_VTA = 0;
constexpr size_t DO_VTB = 16 * MiB;
constexpr size_t DO_KB = 32 * MiB;
constexpr size_t DO_G0 = 0;

constexpr int REP_P0 = 1, REP_PH = 1, REP_G1 = 1, REP_G2 = 1, REP_IDX = 1, REP_ATT = 1, REP_G4 = 1, REP_G5 = 1;
constexpr int REP_IDX1 = 1, REP_SEL = 1;
constexpr int ATT_STRIP = 0;
constexpr int EXTRA_SYNCS = 0, REP_TR = 1, DUMMY_POST1 = 0, DUMMY_POST2 = 0;
constexpr int LDS_BYTES = 147456;
constexpr int LDS_SLOT = LDS_BYTES - 64;

__device__ __forceinline__ unsigned pk2(float lo, float hi) { f32x2_t v = {lo, hi}; bf16x2_t b = __builtin_convertvector(v, bf16x2_t); return __builtin_bit_cast(unsigned, b); }
__device__ __forceinline__ float bflo(unsigned w) { return __uint_as_float(w << 16); }
__device__ __forceinline__ float bfhi(unsigned w) { return __uint_as_float(w & 0xffff0000u); }
__device__ __forceinline__ float bf1(bf16 b) { return __uint_as_float(((unsigned)b) << 16); }
#define UNPACK8(W_, V_) do { V_[0] = bflo((W_)[0]); V_[1] = bfhi((W_)[0]); V_[2] = bflo((W_)[1]); V_[3] = bfhi((W_)[1]); V_[4] = bflo((W_)[2]); V_[5] = bfhi((W_)[2]); V_[6] = bflo((W_)[3]); V_[7] = bfhi((W_)[3]); } while (0)
#define PACK8(V_) (v4u){pk2(V_[0], V_[1]), pk2(V_[2], V_[3]), pk2(V_[4], V_[5]), pk2(V_[6], V_[7])}
template <int CTRL> __device__ __forceinline__ float dpp_f(float v) { return __int_as_float(__builtin_amdgcn_update_dpp(0, __float_as_int(v), CTRL, 0xF, 0xF, false)); }
#define SUM8(x) do { x += dpp_f<0xB1>(x); x += dpp_f<0x4E>(x); x += dpp_f<0x141>(x); } while (0)
#define SUM16(x) do { SUM8(x); x += dpp_f<0x140>(x); } while (0)
__device__ __forceinline__ float wave_sum(float v) {
    SUM16(v);
    return __int_as_float(__builtin_amdgcn_readlane(__float_as_int(v), 0)) + __int_as_float(__builtin_amdgcn_readlane(__float_as_int(v), 16))
         + __int_as_float(__builtin_amdgcn_readlane(__float_as_int(v), 32)) + __int_as_float(__builtin_amdgcn_readlane(__float_as_int(v), 48));
}
#define LDS_WAIT() asm volatile("s_waitcnt lgkmcnt(0)" ::: "memory")

__device__ __forceinline__ int win_src(int d) {
    if (d < 2120) return d;
    if (d < 2792) return d + 512;
    if (d < 3816) return d + 1024;
    if (d < 3840) return -1;
    if (d < 4352) return d - 3840 + 2120;
    if (d < 4864) return d - 4352 + 3304;
    return d - 4864 + 4840;
}
template <bool REMAP>
__device__ __forceinline__ void transpose_item(const float* W, int K, int N, int Npad, bf16* WT, LAS float* scr, int item, int lane) {
    const int nblk = Npad / 32, kb = item / nblk, nb = item % nblk, k0 = 64 * kb, n0 = 32 * nb;
    const int n4 = 4 * (lane & 7);
    const int nn = REMAP ? win_src(n0 + n4) : n0 + n4; const bool ok = nn >= 0 && nn < N;
#pragma unroll
    for (int i = 0; i < 8; ++i) { const int kk = 8 * i + (lane >> 3);
        f32x4 v = (f32x4){0.f, 0.f, 0.f, 0.f}; if (ok) v = *(const f32x4*)(W + (size_t)(k0 + kk) * N + nn);
        LAS float* d = scr + kk * 33 + n4; d[0] = v[0]; d[1] = v[1]; d[2] = v[2]; d[3] = v[3]; }
    LDS_WAIT(); asm volatile("" ::: "memory");
    const int c = lane & 7;
#pragma unroll
    for (int j = 0; j < 4; ++j) { const int n = (lane >> 3) + 8 * j; const LAS float* s = scr + (8 * c) * 33 + n;
        v4u o; o.x = pk2(s[0 * 33], s[1 * 33]); o.y = pk2(s[2 * 33], s[3 * 33]); o.z = pk2(s[4 * 33], s[5 * 33]); o.w = pk2(s[6 * 33], s[7 * 33]);
        *(v4u*)(WT + (size_t)(n0 + n) * K + k0 + 8 * c) = o; }
    LDS_WAIT(); asm volatile("" ::: "memory");
}
__device__ __forceinline__ void rms_row_1024(const float* xrow, const float* g, bf16* orow, int lane) {
    const f32x4* xr = (const f32x4*)xrow + lane; const f32x4* gr = (const f32x4*)g + lane;
    f32x4 v[4]; float s = 0.f;
#pragma unroll
    for (int j = 0; j < 4; ++j) { v[j] = xr[64 * j]; s += (v[j].x * v[j].x + v[j].y * v[j].y) + (v[j].z * v[j].z + v[j].w * v[j].w); }
    const float rstd = __builtin_amdgcn_rsqf(wave_sum(s) * (1.f / 1024.f) + EPS);
    v2u* o8 = (v2u*)orow + lane;
#pragma unroll
    for (int j = 0; j < 4; ++j) { const f32x4 gg = gr[64 * j]; v2u w; w.x = pk2(v[j].x * rstd * gg.x, v[j].y * rstd * gg.y); w.y = pk2(v[j].z * rstd * gg.z, v[j].w * rstd * gg.w); o8[64 * j] = w; }
}

#define ROPE8(v, sub, c8, s8) do { _Pragma("unroll") for (int j_ = 0; j_ < 8; ++j_) { const float pv_ = dpp_f<0xB1>(v[j_]); \
        const float r0_ = v[j_] * c8[j_] - pv_ * s8[j_], r1_ = v[j_] * c8[j_] + pv_ * s8[j_]; v[j_] = (sub) == 0 ? r0_ : ((sub) == 1 ? r1_ : v[j_]); } } while (0)

__device__ __forceinline__ void post1_row(const bf16* Prow, bf16* Orow, const float* ra, const float (&ga)[8], const float (&gk)[8], const float (&gq)[8], const float (&gc)[8], const float (&gm)[8], float* WIrow, int lane) {
    const int sub = lane & 7;
    const v4u z4 = (v4u){0u, 0u, 0u, 0u};
    const v4u w_qa = *(const v4u*)(Prow + C_QA + 8 * lane);
    const v4u w_ka = *(const v4u*)(Prow + C_KA + 8 * lane);
    const v4u w_qi = *(const v4u*)(Prow + C_QI + 8 * lane);
    const v4u w_qm = *(const v4u*)(Prow + C_QM + 8 * lane);
    v4u w_ki = z4, w_cq = z4, w_ckv = z4; float w_wi = 0.f;
    if (lane < 8) { w_ki = *(const v4u*)(Prow + C_KI + 8 * lane); w_wi = bf1(Prow[C_WI + lane]); }
    if (lane < 48) w_cq = *(const v4u*)(Prow + C_CQ + 8 * lane);
    if (lane < 32) w_ckv = *(const v4u*)(Prow + C_CKV + 8 * lane);
    float c8[8], s8[8];
    { const f32x4 r0 = *(const f32x4*)(ra), r1 = *(const f32x4*)(ra + 4), r2 = *(const f32x4*)(ra + 8), r3 = *(const f32x4*)(ra + 12);
      c8[0] = r0[0]; c8[1] = r0[1]; c8[2] = r0[2]; c8[3] = r0[3]; c8[4] = r1[0]; c8[5] = r1[1]; c8[6] = r1[2]; c8[7] = r1[3];
      s8[0] = r2[0]; s8[1] = r2[1]; s8[2] = r2[2]; s8[3] = r2[3]; s8[4] = r3[0]; s8[5] = r3[1]; s8[6] = r3[2]; s8[7] = r3[3]; }
    { float v[8]; UNPACK8(w_qa, v); float ss = 0.f;
#pragma unroll
      for (int j = 0; j < 8; ++j) ss += v[j] * v[j];
      SUM8(ss);
      const float rstd = __builtin_amdgcn_rsqf(ss * (1.f / 64.f) + EPS);
#pragma unroll
      for (int j = 0; j < 8; ++j) v[j] = v[j] * rstd * ga[j];
      ROPE8(v, sub, c8, s8);
#pragma unroll
      for (int j = 0; j < 8; ++j) v[j] *= SCALE_A;
      *(v4u*)(Orow + C_QA + 8 * lane) = PACK8(v); }
    { float v[8]; UNPACK8(w_ka, v); float ss = 0.f;
#pragma unroll
      for (int j = 0; j < 8; ++j) ss += v[j] * v[j];
      SUM8(ss);
      const float rstd = __builtin_amdgcn_rsqf(ss * (1.f / 64.f) + EPS);
#pragma unroll
      for (int j = 0; j < 8; ++j) v[j] = v[j] * rstd * gk[j];
      ROPE8(v, sub, c8, s8);
      *(v4u*)(Orow + C_KA + 8 * lane) = PACK8(v); }
    { float v[8]; UNPACK8(w_qi, v);
      ROPE8(v, sub, c8, s8);
      *(v4u*)(Orow + C_QI + 8 * lane) = PACK8(v); }
    { float v[8]; UNPACK8(w_ki, v);
      ROPE8(v, sub, c8, s8);
      if (lane < 8) *(v4u*)(Orow + C_KI + 8 * lane) = PACK8(v); }
    if (lane < 8) WIrow[lane] = w_wi * SCALE_I;
    { float v[8]; UNPACK8(w_cq, v); float ss = 0.f;
#pragma unroll
      for (int j = 0; j < 8; ++j) ss += v[j] * v[j];
      ss = wave_sum(ss); const float rstd = __builtin_amdgcn_rsqf(ss * (1.f / 384.f) + EPS);
      if (lane < 48) {
#pragma unroll
          for (int j = 0; j < 8; ++j) v[j] = v[j] * rstd * gq[j];
          *(v4u*)(Orow + C_CQ + 8 * lane) = PACK8(v); } }
    { float v[8]; UNPACK8(w_ckv, v); float ss = 0.f;
#pragma unroll
      for (int j = 0; j < 8; ++j) ss += v[j] * v[j];
      ss = wave_sum(ss); const float rstd = __builtin_amdgcn_rsqf(ss * (1.f / 256.f) + EPS);
      if (lane < 32) {
#pragma unroll
          for (int j = 0; j < 8; ++j) v[j] = v[j] * rstd * gc[j];
          *(v4u*)(Orow + C_CKV + 8 * lane) = PACK8(v); } }
    { float v[8]; UNPACK8(w_qm, v); float ss = 0.f;
#pragma unroll
      for (int j = 0; j < 8; ++j) ss += v[j] * v[j];
      SUM16(ss);
      const float rstd = __builtin_amdgcn_rsqf(ss * (1.f / 128.f) + EPS);
#pragma unroll
      for (int j = 0; j < 8; ++j) v[j] = v[j] * rstd * gm[j] * SCALE_M;
      *(v4u*)(Orow + C_QM + 8 * lane) = PACK8(v); }
}

__device__ __forceinline__ void km_row(bf16* row, const float* gkm, int lane) {
    v4u w = *(const v4u*)(row + 8 * lane); float v[8]; UNPACK8(w, v); float ss = 0.f;
#pragma unroll
    for (int j = 0; j < 8; ++j) ss += v[j] * v[j];
    SUM16(ss);
    const float rstd = __builtin_amdgcn_rsqf(ss * (1.f / 128.f) + EPS);
#pragma unroll
    for (int j = 0; j < 8; ++j) v[j] = v[j] * rstd * gkm[8 * (lane & 15) + j];
    *(v4u*)(row + 8 * lane) = PACK8(v);
}

__device__ __forceinline__ void transpose_v(const bf16* src, int pitch, int col0, int hstride, int H, int DV, int S, int nb, bf16* dst, int gw, int NGW, int lane) {
    const int ndq = DV / 64, nsc = S / 64, ntask = nb * H * nsc * ndq;
    for (int task = gw; task < ntask; task += NGW) {
        int x = task; const int dq = x % ndq; x /= ndq; const int sc = x % nsc; x /= nsc; const int h = x % H; const int b = x / H;
        const int s = sc * 64 + lane;
        const bf16* srow = src + (size_t)(b * S + s) * pitch + col0 + h * hstride + dq * 64;
        bf16* drow = dst + ((size_t)((b * H + h) * DV + dq * 64)) * S + s;
        v4u wv[8];
#pragma unroll
        for (int c = 0; c < 8; ++c) wv[c] = *(const v4u*)(srow + 8 * c);
#pragma unroll
        for (int c = 0; c < 8; ++c) { const v4u w = wv[c];
            drow[(size_t)(8 * c + 0) * S] = (bf16)(w.x & 0xffffu); drow[(size_t)(8 * c + 1) * S] = (bf16)(w.x >> 16);
            drow[(size_t)(8 * c + 2) * S] = (bf16)(w.y & 0xffffu); drow[(size_t)(8 * c + 3) * S] = (bf16)(w.y >> 16);
            drow[(size_t)(8 * c + 4) * S] = (bf16)(w.z & 0xffffu); drow[(size_t)(8 * c + 5) * S] = (bf16)(w.z >> 16);
            drow[(size_t)(8 * c + 6) * S] = (bf16)(w.w & 0xffffu); drow[(size_t)(8 * c + 7) * S] = (bf16)(w.w >> 16); }
    }
}

__device__ __forceinline__ void post2_row(const bf16* QBrow, bf16* QOrow, const bf16* KVBrow, const bf16* Prow, bf16* KBrow, const float* rb, const float (&gqv)[12], const float (&gkv)[12], LAS float* scr, int lane) {
    const int hd = lane >> 3, d0 = 12 * (lane & 7);
    float vq[12], vk[12], cc[12], sn[12];
    { const v2u* p = (const v2u*)(QBrow + 12 * lane);
      const v2u w0 = p[0], w1 = p[1], w2 = p[2];
      bf16 kr[12];
#pragma unroll
      for (int e = 0; e < 12; ++e) { const int d = d0 + e; kr[e] = d < 64 ? KVBrow[hd * 128 + d] : Prow[C_KR + d - 64]; }
#pragma unroll
      for (int e = 0; e < 12; ++e) { const int d = d0 + e; const int i = (d - 64) & 15; cc[e] = d < 64 ? 1.f : rb[i]; sn[e] = d < 64 ? 0.f : rb[16 + i]; }
      vq[0] = bflo(w0.x); vq[1] = bfhi(w0.x); vq[2] = bflo(w0.y); vq[3] = bfhi(w0.y); vq[4] = bflo(w1.x); vq[5] = bfhi(w1.x); vq[6] = bflo(w1.y); vq[7] = bfhi(w1.y);
      vq[8] = bflo(w2.x); vq[9] = bfhi(w2.x); vq[10] = bflo(w2.y); vq[11] = bfhi(w2.y);
#pragma unroll
      for (int e = 0; e < 12; ++e) vk[e] = bf1(kr[e]); }
    float sq = 0.f, sk = 0.f;
#pragma unroll
    for (int e = 0; e < 12; ++e) { sq += vq[e] * vq[e]; sk += vk[e] * vk[e]; }
    SUM8(sq); SUM8(sk);
    const float rq = __builtin_amdgcn_rsqf(sq * (1.f / 96.f) + EPS), rk = __builtin_amdgcn_rsqf(sk * (1.f / 96.f) + EPS);
#pragma unroll
    for (int e = 0; e < 12; ++e) { vq[e] = vq[e] * rq * gqv[e]; vk[e] = vk[e] * rk * gkv[e]; scr[12 * lane + e] = vq[e]; scr[768 + 12 * lane + e] = vk[e]; }
    LDS_WAIT(); asm volatile("" ::: "memory");
    float oq[12], ok[12];
#pragma unroll
    for (int e = 0; e < 12; ++e) { const int d = d0 + e;
        if (d < 64) { oq[e] = vq[e]; ok[e] = vk[e]; }
        else { const bool first = d < 80; const int off = first ? 16 : -16; const float pq = scr[12 * lane + e + off], pk = scr[768 + 12 * lane + e + off];
               oq[e] = first ? vq[e] * cc[e] - pq * sn[e] : vq[e] * cc[e] + pq * sn[e];
               ok[e] = first ? vk[e] * cc[e] - pk * sn[e] : vk[e] * cc[e] + pk * sn[e]; }
        oq[e] *= SCALE_B; }
    LDS_WAIT(); asm volatile("" ::: "memory");
    v2u* q = (v2u*)(QOrow + 12 * lane); v2u* k = (v2u*)(KBrow + 12 * lane);
#pragma unroll
    for (int i = 0; i < 3; ++i) { v2u w; w.x = pk2(oq[4 * i], oq[4 * i + 1]); w.y = pk2(oq[4 * i + 2], oq[4 * i + 3]); q[i] = w;
                                  v2u u; u.x = pk2(ok[4 * i], ok[4 * i + 1]); u.y = pk2(ok[4 * i + 2], ok[4 * i + 3]); k[i] = u; }
}

__device__ __forceinline__ int next_unit(unsigned* ctr, volatile LAS int* slot) {
    __syncthreads();
    if (threadIdx.x == 0) *slot = (int)atomicAdd(ctr, 1u);
    __syncthreads();
    return *slot;
}

constexpr int SCP = 2112;
__device__ __forceinline__ unsigned ord_key(float v) { const unsigned b = __float_as_uint(v); return b ^ ((unsigned)((int)b >> 31) | 0x80000000u); }
__device__ __forceinline__ void indexer_load_q(const bf16* P, const float* WI, int u, bf16x8 (&qf)[8][2], float (&wq)[8]) {
    const int lane = threadIdx.x & 63, n = lane & 15, g = lane >> 4;
    const int tb = 127 - (u >> 3), bb = u & 7;
    const size_t row = (size_t)(bb * SEQ + tb * 16 + n);
    const bf16* qrow = P + row * PP + C_QI + 8 * g;
#pragma unroll
    for (int h = 0; h < 8; ++h) { qf[h][0] = *(const bf16x8*)(qrow + h * 64); qf[h][1] = *(const bf16x8*)(qrow + h * 64 + 32); wq[h] = WI[row * 8 + h]; }
}
__device__ __forceinline__ void indexer_unit(LAS float* sc, const bf16* P, const float* WI, unsigned* MASK, int bb, int tb, bf16x8 (&qf)[8][2], float (&wq)[8],
                                             int tk, volatile LAS int* slot, int nunits, int& un) {
    int tid_ = threadIdx.x; asm volatile("" : "+v"(tid_));
    const int tid = tid_, lane = tid & 63, w = __builtin_amdgcn_readfirstlane(tid >> 6);
    const int n = lane & 15, g = lane >> 4;
    const int rowbase = bb * SEQ, t0 = tb * 16;
    {
        const int ntile = tb + 1;
        const int nmine = (ntile - w + 7) >> 3;
        const int ngrp = (nmine + 3) >> 2;
        const bf16* kbase = P + (size_t)(rowbase + n) * PP + C_KI + 8 * g;
        bf16x8 kb[2][4][2];
#define IDX_LOAD(BUF, GRP) do { _Pragma("unroll") for (int j_ = 0; j_ < 4; ++j_) { const int tile_ = w + 8 * (4 * (GRP) + j_); const int tl_ = tile_ < ntile ? tile_ : 0; \
            const bf16* kr_ = kbase + (size_t)(16 * tl_) * PP; kb[BUF][j_][0] = *(const bf16x8*)(kr_); kb[BUF][j_][1] = *(const bf16x8*)(kr_ + 32); } } while (0)
#define IDX_COMP(BUF, GRP) do { _Pragma("unroll") for (int j_ = 0; j_ < 4; ++j_) { const int tile_ = w + 8 * (4 * (GRP) + j_); if (tile_ < ntile) { \
            f32x4 idx_ = (f32x4){0.f, 0.f, 0.f, 0.f}; \
            _Pragma("unroll") for (int h_ = 0; h_ < 8; ++h_) { f32x4 a_ = (f32x4){0.f, 0.f, 0.f, 0.f}; \
                a_ = __builtin_amdgcn_mfma_f32_16x16x32_bf16(kb[BUF][j_][0], qf[h_][0], a_, 0, 0, 0); \
                a_ = __builtin_amdgcn_mfma_f32_16x16x32_bf16(kb[BUF][j_][1], qf[h_][1], a_, 0, 0, 0); \
                _Pragma("unroll") for (int i_ = 0; i_ < 4; ++i_) idx_[i_] = __builtin_fmaf(wq[h_], __builtin_fmaxf(a_[i_], 0.f), idx_[i_]); } \
            { const int k0_ = 16 * tile_ + 4 * g; LAS float* d_ = sc + n * SCP + k0_ + (k0_ >> 5); d_[0] = idx_[0]; d_[1] = idx_[1]; d_[2] = idx_[2]; d_[3] = idx_[3]; } } } } while (0)
        if (ngrp > 0) IDX_LOAD(0, 0);
        for (int gp = 0; gp < ngrp; gp += 2) {
            if (gp + 1 < ngrp) IDX_LOAD(1, gp + 1);
            IDX_COMP(0, gp);
            if (gp + 1 < ngrp) { if (gp + 2 < ngrp) IDX_LOAD(0, gp + 2); IDX_COMP(1, gp + 1); }
        }
#undef IDX_LOAD
#undef IDX_COMP
    }
    if (tid == 0) *slot = tk;
    __syncthreads();
    un = *slot;
    if (un < nunits) indexer_load_q(P, WI, un, qf, wq);
    for (int rs = 0; rs < REP_SEL; ++rs) {
        const int ta = t0 + 2 * w, tb2 = ta + 1;
        unsigned* mra = MASK + (size_t)(rowbase + ta) * 64; unsigned* mrb = mra + 64;
        const int nva = ta - 32 * lane + 1, nvb = nva + 1;
        const unsigned valid_a = nva >= 32 ? 0xffffffffu : (nva <= 0 ? 0u : ((1u << nva) - 1u));
        const unsigned valid_b = nvb >= 32 ? 0xffffffffu : (nvb <= 0 ? 0u : ((1u << nvb) - 1u));
        if (ta < 256) { mra[lane] = valid_a; mrb[lane] = valid_b; continue; }
        unsigned ua[32], ub[32];
        { const LAS float* sra = sc + (2 * w) * SCP + 33 * lane; const LAS float* srb = sra + SCP;
#pragma unroll
          for (int r = 0; r < 32; ++r) { const float va = sra[r], vb = srb[r]; ua[r] = ((valid_a >> r) & 1u) ? ord_key(va) : 0u; ub[r] = ((valid_b >> r) & 1u) ? ord_key(vb) : 0u; } }
#pragma unroll
        for (int k = 0; k < 16; ++k) {
            const unsigned a0 = ua[k], a1 = ua[k + 16]; ua[k] = __builtin_amdgcn_perm(a1, a0, 0x05040100u); ua[k + 16] = __builtin_amdgcn_perm(a1, a0, 0x07060302u);
            const unsigned b0 = ub[k], b1 = ub[k + 16]; ub[k] = __builtin_amdgcn_perm(b1, b0, 0x05040100u); ub[k + 16] = __builtin_amdgcn_perm(b1, b0, 0x07060302u); }
#pragma unroll
        for (int k = 0; k < 32; ++k) if (!(k & 8)) {
            const unsigned a0 = ua[k], a1 = ua[k + 8]; ua[k] = __builtin_amdgcn_perm(a1, a0, 0x06020400u); ua[k + 8] = __builtin_amdgcn_perm(a1, a0, 0x07030501u);
            const unsigned b0 = ub[k], b1 = ub[k + 8]; ub[k] = __builtin_amdgcn_perm(b1, b0, 0x06020400u); ub[k + 8] = __builtin_amdgcn_perm(b1, b0, 0x07030501u); }
#pragma unroll
        for (int si = 2; si < 5; ++si) { const int sft = 16 >> si;
            const unsigned msk = si == 2 ? 0x0f0f0f0fu : (si == 3 ? 0x33333333u : 0x55555555u);
#pragma unroll
            for (int k = 0; k < 32; ++k) if (!(k & sft)) {
                const unsigned a0 = ua[k], a1 = ua[k + sft]; ua[k] = (a0 & msk) | ((a1 << sft) & ~msk); ua[k + sft] = ((a0 >> sft) & msk) | (a1 & ~msk);
                const unsigned b0 = ub[k], b1 = ub[k + sft]; ub[k] = (b0 & msk) | ((b1 << sft) & ~msk); ub[k + sft] = ((b0 >> sft) & msk) | (b1 & ~msk); } }
        unsigned alive_a = valid_a, sel_a = 0u, alive_b = valid_b, sel_b = 0u; int need_a = 256, need_b = 256; bool run_a = true, run_b = true;
#pragma unroll
        for (int j = 31; j >= 0; --j) {
            const unsigned ones_a = alive_a & ua[j], ones_b = alive_b & ub[j];
            int v = (int)((unsigned)__popc(ones_a) | ((unsigned)__popc(ones_b) << 16));
            v += __builtin_amdgcn_update_dpp(0, v, 0xB1, 0xF, 0xF, false);
            v += __builtin_amdgcn_update_dpp(0, v, 0x4E, 0xF, 0xF, false);
            v += __builtin_amdgcn_update_dpp(0, v, 0x141, 0xF, 0xF, false);
            v += __builtin_amdgcn_update_dpp(0, v, 0x140, 0xF, 0xF, false);
            const unsigned tot = (unsigned)(__builtin_amdgcn_readlane(v, 0) + __builtin_amdgcn_readlane(v, 16) + __builtin_amdgcn_readlane(v, 32) + __builtin_amdgcn_readlane(v, 48));
            const int ca = (int)(tot & 0xffffu), cb = (int)(tot >> 16);
            if (run_a) { if (ca >= need_a) { alive_a = ones_a; if (ca == need_a) { sel_a |= ones_a; need_a = 0; run_a = false; } }
                         else { need_a -= ca; sel_a |= ones_a; alive_a &= ~ua[j]; } }
            if (run_b) { if (cb >= need_b) { alive_b = ones_b; if (cb == need_b) { sel_b |= ones_b; need_b = 0; run_b = false; } }
                         else { need_b -= cb; sel_b |= ones_b; alive_b &= ~ub[j]; } }
            if (!run_a && !run_b) break;
        }
        if (need_a > 0) {
            const int cnt = __popc(alive_a); int inc = cnt;
#pragma unroll
            for (int d = 1; d < 64; d <<= 1) { const int o = __shfl_up(inc, d); if (lane >= d) inc += o; }
            int k = need_a - (inc - cnt); k = k < 0 ? 0 : (k > cnt ? cnt : k);
            unsigned m = alive_a;
            for (int i = 0; i < k; ++i) { const unsigned low = m & (0u - m); sel_a |= low; m ^= low; }
        }
        if (need_b > 0) {
            const int cnt = __popc(alive_b); int inc = cnt;
#pragma unroll
            for (int d = 1; d < 64; d <<= 1) { const int o = __shfl_up(inc, d); if (lane >= d) inc += o; }
            int k = need_b - (inc - cnt); k = k < 0 ? 0 : (k > cnt ? cnt : k);
            unsigned m = alive_b;
            for (int i = 0; i < k; ++i) { const unsigned low = m & (0u - m); sel_b |= low; m ^= low; }
        }
        mra[lane] = sel_a; mrb[lane] = sel_b;
        (void)tb2;
    }
    __syncthreads();
}

__device__ __forceinline__ float half_max(float m) { auto rr = __builtin_amdgcn_permlane32_swap(__float_as_uint(m), __float_as_uint(m), false, false); return __builtin_fmaxf(__uint_as_float(rr[0]), __uint_as_float(rr[1])); }
__device__ __forceinline__ float half_sum(float m) { auto rr = __builtin_amdgcn_permlane32_swap(__float_as_uint(m), __float_as_uint(m), false, false); return __uint_as_float(rr[0]) + __uint_as_float(rr[1]); }
__device__ __forceinline__ int crow(int r, int hi) { return (r & 3) + 8 * (r >> 2) + 4 * hi; }
template <int DQK, int DV, int MODE, int STRIP = 0>
__device__ __forceinline__ void attn_unit(LAS unsigned char* lds, const bf16* Qb, int qpitch, const bf16* Kb, int kpitch, const bf16* VTb, int skv,
                                          const unsigned* maskb, const bf16* Zb, bf16* Ob, int q0) {
    constexpr int TK = 128, KP = DQK + 8, VP = TK + 8;
    LAS bf16* Ks = (LAS bf16*)lds; LAS bf16* Vs = Ks + TK * KP;
    constexpr int CPR = DQK / 8;
    constexpr int NCK = TK * CPR, NCV = DV * (TK / 8);
    constexpr int RK = (NCK + 511) / 512, RV = (NCV + 511) / 512;
    constexpr int NKS = DQK / 16, NMT = DV / 32;
    int tid_ = threadIdx.x; asm volatile("" : "+v"(tid_));
    const int tid = tid_, lane = tid & 63, w = __builtin_amdgcn_readfirstlane(tid >> 6), r = lane & 31, hh = lane >> 5;
    const int NT = MODE == 0 ? skv / TK : (q0 + 256) / TK;
    const int qlo = q0 + 32 * w;
    bf16x8 qf[NKS];
    { const bf16* qrow = Qb + (size_t)(qlo + r) * qpitch + 8 * hh;
#pragma unroll
      for (int ks = 0; ks < NKS; ++ks) qf[ks] = *(const bf16x8*)(qrow + 16 * ks); }
    f32x16 o[NMT];
#pragma unroll
    for (int mt = 0; mt < NMT; ++mt)
#pragma unroll
        for (int i = 0; i < 16; ++i) o[mt][i] = 0.f;
    float m_run = NEGF, l_run = 0.f;
    v4u kreg[RK], vreg[RV];
#define ATT_PREFETCH(tile_) do { \
        _Pragma("unroll") for (int i_ = 0; i_ < RK; ++i_) { const int c_ = tid + 512 * i_; if (c_ < NCK) { const int row_ = c_ / CPR, cc_ = c_ % CPR; kreg[i_] = *(const v4u*)(Kb + (size_t)(TK * (tile_) + row_) * kpitch + 8 * cc_); } } \
        _Pragma("unroll") for (int i_ = 0; i_ < RV; ++i_) { const int c_ = tid + 512 * i_; if (c_ < NCV) { const int d_ = c_ >> 4, cc_ = c_ & 15; vreg[i_] = *(const v4u*)(VTb + (size_t)d_ * skv + TK * (tile_) + 8 * cc_); } } } while (0)
    if (STRIP != 2) ATT_PREFETCH(0);
    for (int tile = 0; tile < NT; ++tile) {
        __syncthreads();
        if (STRIP != 2) {
#pragma unroll
        for (int i = 0; i < RK; ++i) { const int c = tid + 512 * i; if (c < NCK) { const int row = c / CPR, cc = c % CPR; *(LAS v4u*)(Ks + row * KP + 8 * cc) = kreg[i]; } }
#pragma unroll
        for (int i = 0; i < RV; ++i) { const int c = tid + 512 * i; if (c < NCV) { const int d = c >> 4, cc = c & 15; *(LAS v4u*)(Vs + d * VP + 8 * cc) = vreg[i]; } }
        }
        __syncthreads();
        if (STRIP != 2 && tile + 1 < NT) ATT_PREFETCH(tile + 1);
        __builtin_amdgcn_sched_barrier(0);
        if (STRIP == 1) continue;
#pragma unroll 1
        for (int sub = 0; sub < 2; ++sub) {
        const int t64 = 2 * tile + sub;
        if (MODE != 0 && 64 * t64 > qlo + 31) continue;
        const LAS bf16* Kc = Ks + 64 * sub * KP; const LAS bf16* Vc = Vs + 64 * sub;
        unsigned mw0 = 0u, mw1 = 0u;
        if (MODE == 2) { const v2u mm = *(const v2u*)(maskb + (size_t)(qlo + r) * 64 + 2 * t64); mw0 = mm.x >> (4 * hh); mw1 = mm.y >> (4 * hh); }
        f32x16 s0, s1;
#pragma unroll
        for (int i = 0; i < 16; ++i) { s0[i] = 0.f; s1[i] = 0.f; }
#pragma unroll
        for (int ks = 0; ks < NKS; ++ks) {
            const bf16x8 a0 = *(const LAS bf16x8*)(Kc + r * KP + 16 * ks + 8 * hh);
            const bf16x8 a1 = *(const LAS bf16x8*)(Kc + (32 + r) * KP + 16 * ks + 8 * hh);
            s0 = __builtin_amdgcn_mfma_f32_32x32x16_bf16(a0, qf[ks], s0, 0, 0, 0);
            s1 = __builtin_amdgcn_mfma_f32_32x32x16_bf16(a1, qf[ks], s1, 0, 0, 0);
        }
        if (MODE == 1) {
            if (64 * t64 + 63 > qlo) { const int qg = qlo + r;
#pragma unroll
                for (int i = 0; i < 16; ++i) { const int key = 64 * t64 + crow(i, hh); if (key > qg) s0[i] = NEGF; if (key + 32 > qg) s1[i] = NEGF; } }
        }
        if (MODE == 2) {
#pragma unroll
            for (int i = 0; i < 16; ++i) { const int bit = (i & 3) + 8 * (i >> 2); if (!((mw0 >> bit) & 1u)) s0[i] = NEGF; if (!((mw1 >> bit) & 1u)) s1[i] = NEGF; }
        }
        float mx = s0[0];
#pragma unroll
        for (int i = 1; i < 16; ++i) mx = __builtin_fmaxf(mx, s0[i]);
#pragma unroll
        for (int i = 0; i < 16; ++i) mx = __builtin_fmaxf(mx, s1[i]);
        mx = half_max(mx);
        const float m_new = __builtin_fmaxf(m_run, mx);
        const float alpha = __builtin_amdgcn_exp2f(m_run - m_new);
        m_run = m_new;
        float ls = 0.f;
#pragma unroll
        for (int i = 0; i < 16; ++i) { s0[i] = __builtin_amdgcn_exp2f(s0[i] - m_new); s1[i] = __builtin_amdgcn_exp2f(s1[i] - m_new); ls += s0[i] + s1[i]; }
        l_run = l_run * alpha + ls;
#pragma unroll
        for (int mt = 0; mt < NMT; ++mt)
#pragma unroll
            for (int i = 0; i < 16; ++i) o[mt][i] *= alpha;
        v4u pf[2][2];
#pragma unroll
        for (int s = 0; s < 2; ++s) {
            pf[0][s] = (v4u){pk2(s0[8 * s], s0[8 * s + 1]), pk2(s0[8 * s + 2], s0[8 * s + 3]), pk2(s0[8 * s + 4], s0[8 * s + 5]), pk2(s0[8 * s + 6], s0[8 * s + 7])};
            pf[1][s] = (v4u){pk2(s1[8 * s], s1[8 * s + 1]), pk2(s1[8 * s + 2], s1[8 * s + 3]), pk2(s1[8 * s + 4], s1[8 * s + 5]), pk2(s1[8 * s + 6], s1[8 * s + 7])};
        }
#pragma unroll
        for (int mt = 0; mt < NMT; ++mt)
#pragma unroll
            for (int p = 0; p < 2; ++p)
#pragma unroll
                for (int s = 0; s < 2; ++s) {
                    const LAS bf16* vp = Vc + (32 * mt + r) * VP + 32 * p + 16 * s + 4 * hh;
                    const s16x4 lo = *(const LAS s16x4*)(vp), hi = *(const LAS s16x4*)(vp + 8);
                    const bf16x8 a = (bf16x8){lo[0], lo[1], lo[2], lo[3], hi[0], hi[1], hi[2], hi[3]};
                    o[mt] = __builtin_amdgcn_mfma_f32_32x32x16_bf16(a, __builtin_bit_cast(bf16x8, pf[p][s]), o[mt], 0, 0, 0);
                }
        }
    }
#undef ATT_PREFETCH
    const float l_tot = half_sum(l_run);
    const float inv = 1.0f / l_tot;
    const size_t row = (size_t)(qlo + r);
#pragma unroll
    for (int mt = 0; mt < NMT; ++mt)
#pragma unroll
        for (int g4 = 0; g4 < 4; ++g4) {
            const int d = 32 * mt + 8 * g4 + 4 * hh;
            float ov[4];
#pragma unroll
            for (int i = 0; i < 4; ++i) ov[i] = o[mt][4 * g4 + i] * inv;
            if (Zb) { const v2u zw = *(const v2u*)(Zb + row * PP + d); const float z[4] = {bflo(zw.x), bfhi(zw.x), bflo(zw.y), bfhi(zw.y)};
#pragma unroll
                for (int i = 0; i < 4; ++i) ov[i] *= z[i] * __builtin_amdgcn_rcpf(1.0f + __expf(-z[i])); }
            v2u ow; ow.x = pk2(ov[0], ov[1]); ow.y = pk2(ov[2], ov[3]);
            *(v2u*)(Ob + row * PP + d) = ow;
        }
}

template <int DQK, int MODE>
__device__ __forceinline__ void attn_unit_pipe(LAS unsigned char* lds, const bf16* Qb, int qpitch, const bf16* Kb, int kpitch, const bf16* VTb, int skv,
                                               const unsigned* maskb, bf16* Ob, int q0) {
    constexpr int DV = 64, KP = DQK + 8, VP = 72, BUFE = 64 * KP + DV * VP;
    constexpr int CPR = DQK / 8, NCK = 64 * CPR, NCV = DV * 8, RK = (NCK + 511) / 512, RV = (NCV + 511) / 512, NKS = DQK / 16, NMT = DV / 32;
    static_assert(NCV == 512 && (NCK == 512 || NCK == 768), "staging map");
    int tid_ = threadIdx.x; asm volatile("" : "+v"(tid_));
    const int tid = tid_, lane = tid & 63, w = __builtin_amdgcn_readfirstlane(tid >> 6), r = lane & 31, hh = lane >> 5;
    const int NT = (q0 + 256) / 64;
    const int qlo = q0 + 32 * w;
    const int NTw = ((qlo + 31) >> 6) + 1;
    int krow[RK], kcc[RK];
#pragma unroll
    for (int i = 0; i < RK; ++i) { int c = tid + 512 * i; if (c >= NCK) c -= 256; krow[i] = c / CPR; kcc[i] = c % CPR; }
    const int vd = tid >> 3, vcc = tid & 7;
    bf16x8 qf[NKS];
    { const bf16* qrow = Qb + (size_t)(qlo + r) * qpitch + 8 * hh;
#pragma unroll
      for (int ks = 0; ks < NKS; ++ks) qf[ks] = *(const bf16x8*)(qrow + 16 * ks); }
    f32x16 o[NMT];
#pragma unroll
    for (int mt = 0; mt < NMT; ++mt)
#pragma unroll
        for (int i = 0; i < 16; ++i) o[mt][i] = 0.f;
    float m_run = NEGF, l_run = 0.f, alpha = 1.f;
    v4u kreg[2][RK], vreg[2][RV]; v2u mset[2];
    const unsigned* mrowp = MODE == 2 ? maskb + (size_t)(qlo + r) * 64 : nullptr;
#define PL_LOAD(S_, tile_) do { const int tl_ = (tile_) < NT ? (tile_) : NT - 1; \
        if (MODE == 2) { const int mt_ = (tile_) >= 2 ? ((tile_) - 2 < 32 ? (tile_) - 2 : 31) : 0; mset[S_] = *(const v2u*)(mrowp + 2 * mt_); }     \
        _Pragma("unroll") for (int i_ = 0; i_ < RK; ++i_) kreg[S_][i_] = *(const v4u*)(Kb + (size_t)(64 * tl_ + krow[i_]) * kpitch + 8 * kcc[i_]); \
        vreg[S_][0] = *(const v4u*)(VTb + (size_t)vd * skv + 64 * tl_ + 8 * vcc); } while (0)
#define PL_STAGE(S_, buf_) do { LAS bf16* Kd_ = (LAS bf16*)lds + (buf_) * BUFE; LAS bf16* Vd_ = Kd_ + 64 * KP; \
        _Pragma("unroll") for (int i_ = 0; i_ < RK; ++i_) *(LAS v4u*)(Kd_ + krow[i_] * KP + 8 * kcc[i_]) = kreg[S_][i_]; \
        *(LAS v4u*)(Vd_ + vd * VP + 8 * vcc) = vreg[S_][0]; } while (0)
#define PL_QK(t_, D0_, D1_) do { const LAS bf16* Kc_ = (const LAS bf16*)lds + ((t_) & 3) * BUFE; \
        _Pragma("unroll") for (int i_ = 0; i_ < 16; ++i_) { D0_[i_] = 0.f; D1_[i_] = 0.f; } \
        _Pragma("unroll") for (int ks_ = 0; ks_ < NKS; ++ks_) { \
            const bf16x8 a0_ = *(const LAS bf16x8*)(Kc_ + r * KP + 16 * ks_ + 8 * hh); const bf16x8 a1_ = *(const LAS bf16x8*)(Kc_ + (32 + r) * KP + 16 * ks_ + 8 * hh); \
            D0_ = __builtin_amdgcn_mfma_f32_32x32x16_bf16(a0_, qf[ks_], D0_, 0, 0, 0); D1_ = __builtin_amdgcn_mfma_f32_32x32x16_bf16(a1_, qf[ks_], D1_, 0, 0, 0); } } while (0)
#define PL_PV(t_) do { const LAS bf16* Vc_ = (const LAS bf16*)lds + ((t_) & 3) * BUFE + 64 * KP; \
        _Pragma("unroll") for (int mt_ = 0; mt_ < NMT; ++mt_) _Pragma("unroll") for (int i_ = 0; i_ < 16; ++i_) o[mt_][i_] *= alpha; \
        _Pragma("unroll") for (int mt_ = 0; mt_ < NMT; ++mt_) _Pragma("unroll") for (int p_ = 0; p_ < 2; ++p_) _Pragma("unroll") for (int s_ = 0; s_ < 2; ++s_) { \
            const LAS bf16* vp_ = Vc_ + (32 * mt_ + r) * VP + 32 * p_ + 16 * s_ + 4 * hh; \
            const s16x4 lo_ = *(const LAS s16x4*)(vp_), hi_ = *(const LAS s16x4*)(vp_ + 8); \
            const bf16x8 a_ = (bf16x8){lo_[0], lo_[1], lo_[2], lo_[3], hi_[0], hi_[1], hi_[2], hi_[3]}; \
            o[mt_] = __builtin_amdgcn_mfma_f32_32x32x16_bf16(a_, __builtin_bit_cast(bf16x8, pf[p_][s_]), o[mt_], 0, 0, 0); } } while (0)
#define PL_SOFTMAX(t_, C0_, C1_, MK_, CAUSAL_) do { \
        if (MODE == 2) { const unsigned w0_ = (MK_).x >> (4 * hh), w1_ = (MK_).y >> (4 * hh); \
            _Pragma("unroll") for (int i_ = 0; i_ < 16; ++i_) { const int bit_ = (i_ & 3) + 8 * (i_ >> 2); if (!((w0_ >> bit_) & 1u)) C0_[i_] = NEGF; if (!((w1_ >> bit_) & 1u)) C1_[i_] = NEGF; } } \
        if (CAUSAL_) { const int qg_ = qlo + r; \
            _Pragma("unroll") for (int i_ = 0; i_ < 16; ++i_) { const int key_ = 64 * (t_) + crow(i_, hh); if (key_ > qg_) C0_[i_] = NEGF; if (key_ + 32 > qg_) C1_[i_] = NEGF; } } \
        float mx_ = C0_[0]; \
        _Pragma("unroll") for (int i_ = 1; i_ < 16; ++i_) mx_ = __builtin_fmaxf(mx_, C0_[i_]); \
        _Pragma("unroll") for (int i_ = 0; i_ < 16; ++i_) mx_ = __builtin_fmaxf(mx_, C1_[i_]); \
        mx_ = half_max(mx_); \
        const float mn_ = __builtin_fmaxf(m_run, mx_); alpha = __builtin_amdgcn_exp2f(m_run - mn_); m_run = mn_; \
        float ls_ = 0.f; \
        _Pragma("unroll") for (int i_ = 0; i_ < 16; ++i_) { C0_[i_] = __builtin_amdgcn_exp2f(C0_[i_] - mn_); C1_[i_] = __builtin_amdgcn_exp2f(C1_[i_] - mn_); ls_ += C0_[i_] + C1_[i_]; } \
        l_run = l_run * alpha + ls_; \
        _Pragma("unroll") for (int s_ = 0; s_ < 2; ++s_) { \
            pf[0][s_] = (v4u){pk2(C0_[8 * s_], C0_[8 * s_ + 1]), pk2(C0_[8 * s_ + 2], C0_[8 * s_ + 3]), pk2(C0_[8 * s_ + 4], C0_[8 * s_ + 5]), pk2(C0_[8 * s_ + 6], C0_[8 * s_ + 7])}; \
            pf[1][s_] = (v4u){pk2(C1_[8 * s_], C1_[8 * s_ + 1]), pk2(C1_[8 * s_ + 2], C1_[8 * s_ + 3]), pk2(C1_[8 * s_ + 4], C1_[8 * s_ + 5]), pk2(C1_[8 * s_ + 6], C1_[8 * s_ + 7])}; } } while (0)
#define PL_IO(t_, S_) do { PL_STAGE(S_, ((t_) + 2) & 3); PL_LOAD(S_, (t_) + 4); } while (0)
#define PL_STEADY(t_, S_) do { const v2u mk_ = mset[S_]; PL_IO(t_, S_); if (MODE == 2) { asm volatile("" :: "v"(mk_.x), "v"(mk_.y)); } \
        PL_QK((t_) + 1, n0, n1); PL_PV((t_) - 1); PL_SOFTMAX(t_, c0, c1, mk_, false); c0 = n0; c1 = n1; __syncthreads(); } while (0)
#define PL_TAIL(t_, S_) do { const v2u mk_ = mset[S_]; PL_IO(t_, S_); if ((t_) >= 1) PL_PV((t_) - 1); PL_SOFTMAX(t_, c0, c1, mk_, MODE == 1); PL_PV(t_); __syncthreads(); } while (0)
    f32x16 c0, c1, n0, n1; v4u pf[2][2];
    PL_LOAD(0, 0); PL_LOAD(1, 1);
    PL_STAGE(0, 0); PL_STAGE(1, 1);
    PL_LOAD(0, 2); PL_LOAD(1, 3);
    __syncthreads();
    PL_QK(0, c0, c1);
    int t = 0;
    if (NTw >= 2) {
        { const v2u mk_ = mset[0]; PL_IO(0, 0); PL_QK(1, n0, n1); PL_SOFTMAX(0, c0, c1, mk_, false); c0 = n0; c1 = n1; __syncthreads(); }
        for (t = 1; t + 1 < NTw; ) {
            PL_STEADY(t, 1); ++t;
            if (t + 1 < NTw) { PL_STEADY(t, 0); ++t; }
        }
    }
    if (t & 1) PL_TAIL(t, 1); else PL_TAIL(t, 0);
    for (++t; t < NT; ++t) { if (t & 1) PL_IO(t, 1); else PL_IO(t, 0); __syncthreads(); }
#undef PL_LOAD
#undef PL_STAGE
#undef PL_QK
#undef PL_PV
#undef PL_SOFTMAX
#undef PL_IO
#undef PL_STEADY
#undef PL_TAIL
    const float l_tot = half_sum(l_run);
    const float inv = 1.0f / l_tot;
    const size_t row = (size_t)(qlo + r);
#pragma unroll
    for (int mt = 0; mt < NMT; ++mt)
#pragma unroll
        for (int g4 = 0; g4 < 4; ++g4) {
            const int d = 32 * mt + 8 * g4 + 4 * hh;
            v2u ow; ow.x = pk2(o[mt][4 * g4] * inv, o[mt][4 * g4 + 1] * inv); ow.y = pk2(o[mt][4 * g4 + 2] * inv, o[mt][4 * g4 + 3] * inv);
            *(v2u*)(Ob + row * PP + d) = ow;
        }
}

__device__ __forceinline__ void attn_unit_mem(LAS unsigned char* lds, const bf16* Qb, const bf16* Kb, const bf16* VTb, const bf16* Zb, bf16* Ob, int q0) {
    constexpr int DQK = 128, KP = DQK + 8, VP = MEML + 8, NKS = DQK / 16, NMT = 4;
    LAS bf16* Ks = (LAS bf16*)lds; LAS bf16* Vs = Ks + MEML * KP;
    int tid_ = threadIdx.x; asm volatile("" : "+v"(tid_));
    const int tid = tid_, lane = tid & 63, w = __builtin_amdgcn_readfirstlane(tid >> 6), r = lane & 31, hh = lane >> 5;
    { v4u kk[8], vv[8];
#pragma unroll
      for (int i = 0; i < 8; ++i) { const int c = tid + 512 * i; kk[i] = *(const v4u*)(Kb + (size_t)(c >> 4) * 1024 + 8 * (c & 15)); vv[i] = *(const v4u*)(VTb + (size_t)(c >> 5) * MEML + 8 * (c & 31)); }
#pragma unroll
      for (int i = 0; i < 8; ++i) { const int c = tid + 512 * i; *(LAS v4u*)(Ks + (c >> 4) * KP + 8 * (c & 15)) = kk[i]; *(LAS v4u*)(Vs + (c >> 5) * VP + 8 * (c & 31)) = vv[i]; } }
    __syncthreads();
#pragma unroll 1
    for (int qb = 0; qb < 2; ++qb) {
        const int qlo = q0 + 256 * qb + 32 * w;
        bf16x8 qf[NKS];
        { const bf16* qrow = Qb + (size_t)(qlo + r) * PP + 8 * hh;
#pragma unroll
          for (int ks = 0; ks < NKS; ++ks) qf[ks] = *(const bf16x8*)(qrow + 16 * ks); }
        f32x16 o[NMT];
#pragma unroll
        for (int mt = 0; mt < NMT; ++mt)
#pragma unroll
            for (int i = 0; i < 16; ++i) o[mt][i] = 0.f;
        float m_run = NEGF, l_run = 0.f;
#pragma unroll 1
        for (int sub = 0; sub < MEML / 64; ++sub) {
            const LAS bf16* Kc = Ks + 64 * sub * KP; const LAS bf16* Vc = Vs + 64 * sub;
            f32x16 s0, s1;
#pragma unroll
            for (int i = 0; i < 16; ++i) { s0[i] = 0.f; s1[i] = 0.f; }
#pragma unroll
            for (int ks = 0; ks < NKS; ++ks) {
                const bf16x8 a0 = *(const LAS bf16x8*)(Kc + r * KP + 16 * ks + 8 * hh);
                const bf16x8 a1 = *(const LAS bf16x8*)(Kc + (32 + r) * KP + 16 * ks + 8 * hh);
                s0 = __builtin_amdgcn_mfma_f32_32x32x16_bf16(a0, qf[ks], s0, 0, 0, 0);
                s1 = __builtin_amdgcn_mfma_f32_32x32x16_bf16(a1, qf[ks], s1, 0, 0, 0);
            }
            float mx = s0[0];
#pragma unroll
            for (int i = 1; i < 16; ++i) mx = __builtin_fmaxf(mx, s0[i]);
#pragma unroll
            for (int i = 0; i < 16; ++i) mx = __builtin_fmaxf(mx, s1[i]);
            mx = half_max(mx);
            const float m_new = __builtin_fmaxf(m_run, mx);
            const float alpha = __builtin_amdgcn_exp2f(m_run - m_new);
            m_run = m_new;
            float ls = 0.f;
#pragma unroll
            for (int i = 0; i < 16; ++i) { s0[i] = __builtin_amdgcn_exp2f(s0[i] - m_new); s1[i] = __builtin_amdgcn_exp2f(s1[i] - m_new); ls += s0[i] + s1[i]; }
            l_run = l_run * alpha + ls;
#pragma unroll
            for (int mt = 0; mt < NMT; ++mt)
#pragma unroll
                for (int i = 0; i < 16; ++i) o[mt][i] *= alpha;
            v4u pf[2][2];
#pragma unroll
            for (int s = 0; s < 2; ++s) {
                pf[0][s] = (v4u){pk2(s0[8 * s], s0[8 * s + 1]), pk2(s0[8 * s + 2], s0[8 * s + 3]), pk2(s0[8 * s + 4], s0[8 * s + 5]), pk2(s0[8 * s + 6], s0[8 * s + 7])};
                pf[1][s] = (v4u){pk2(s1[8 * s], s1[8 * s + 1]), pk2(s1[8 * s + 2], s1[8 * s + 3]), pk2(s1[8 * s + 4], s1[8 * s + 5]), pk2(s1[8 * s + 6], s1[8 * s + 7])};
            }
#pragma unroll
            for (int mt = 0; mt < NMT; ++mt)
#pragma unroll
                for (int p = 0; p < 2; ++p)
#pragma unroll
                    for (int s = 0; s < 2; ++s) {
                        const LAS bf16* vp = Vc + (32 * mt + r) * VP + 32 * p + 16 * s + 4 * hh;
                        const s16x4 lo = *(const LAS s16x4*)(vp), hi = *(const LAS s16x4*)(vp + 8);
                        const bf16x8 a = (bf16x8){lo[0], lo[1], lo[2], lo[3], hi[0], hi[1], hi[2], hi[3]};
                        o[mt] = __builtin_amdgcn_mfma_f32_32x32x16_bf16(a, __builtin_bit_cast(bf16x8, pf[p][s]), o[mt], 0, 0, 0);
                    }
        }
        const float inv = 1.0f / half_sum(l_run);
        const size_t row = (size_t)(qlo + r);
#pragma unroll
        for (int mt = 0; mt < NMT; ++mt)
#pragma unroll
            for (int g4 = 0; g4 < 4; ++g4) {
                const int d = 32 * mt + 8 * g4 + 4 * hh;
                const v2u zw = *(const v2u*)(Zb + row * PP + d); const float z[4] = {bflo(zw.x), bfhi(zw.x), bflo(zw.y), bfhi(zw.y)};
                float ov[4];
#pragma unroll
                for (int i = 0; i < 4; ++i) ov[i] = o[mt][4 * g4 + i] * inv * (z[i] * __builtin_amdgcn_rcpf(1.0f + __expf(-z[i])));
                v2u ow; ow.x = pk2(ov[0], ov[1]); ow.y = pk2(ov[2], ov[3]);
                *(v2u*)(Ob + row * PP + d) = ow;
            }
    }
}

__device__ __forceinline__ bf16* gate_row(bf16* G0, bf16* G1, size_t row) { return row < 8192 ? G0 + row * 3072 : G1 + (row - 8192) * 3072; }
struct EpiZG {
    static constexpr bool PERM = true, AFTER_DRAIN = false;
    bf16* P; bf16* G0; bf16* G1;
    __device__ __forceinline__ void operator()(const pg8::f32x4 (&acc)[2][2][4][2], const pg8::Unit& u, int wr, int wc, int fr, int fq) const {
        const int row0 = u.pm * 256 + wr * 64 + fr, cl = wc * 32 + 8 * fq;
        const bool isz = u.pn < 4;
        const int ycol = (u.pn < 2 ? C_YA : C_YB) + (u.pn & 1) * 256, gcol = (u.pn - 4) * 256;
#pragma unroll
        for (int ai = 0; ai < 2; ++ai)
#pragma unroll
            for (int m = 0; m < 4; ++m) { const size_t row = (size_t)(row0 + ai * 128 + m * 16);
#pragma unroll
                for (int bj = 0; bj < 2; ++bj) {
                    const pg8::f32x4 v0 = acc[ai][bj][m][0], v1 = acc[ai][bj][m][1];
                    float rr[8] = {v0[0], v0[1], v0[2], v0[3], v1[0], v1[1], v1[2], v1[3]};
                    if (isz) { bf16* dst = P + row * PP + ycol + cl + bj * 128; const v4u old = *(const v4u*)dst; float yv[8]; UNPACK8(old, yv);
#pragma unroll
                        for (int e = 0; e < 8; ++e) rr[e] = yv[e] * (rr[e] * __builtin_amdgcn_rcpf(1.0f + __expf(-rr[e])));
                        *(v4u*)dst = PACK8(rr); }
                    else { bf16* dst = gate_row(G0, G1, row) + gcol + cl + bj * 128;
#pragma unroll
                        for (int e = 0; e < 8; ++e) rr[e] = __builtin_amdgcn_rcpf(1.0f + __expf(-rr[e]));
                        *(v4u*)dst = PACK8(rr); } } }
    }
};
struct EpiMerge {
    static constexpr bool PERM = true, AFTER_DRAIN = false;
    bf16* Mg; bf16* G0; bf16* G1; int nbr;
    __device__ __forceinline__ void operator()(const pg8::f32x4 (&acc)[2][2][4][2], const pg8::Unit& u, int wr, int wc, int fr, int fq) const {
        const int row0 = u.pm * 256 + wr * 64 + fr, col0 = u.pn * 256 + wc * 32 + 8 * fq;
#pragma unroll
        for (int ai = 0; ai < 2; ++ai)
#pragma unroll
            for (int m = 0; m < 4; ++m) { const size_t row = (size_t)(row0 + ai * 128 + m * 16);
#pragma unroll
                for (int bj = 0; bj < 2; ++bj) { const int col = col0 + bj * 128;
                    const v4u gwd = *(const v4u*)(gate_row(G0, G1, row) + nbr * 1024 + col);
                    float gl[8]; UNPACK8(gwd, gl);
                    const pg8::f32x4 v0 = acc[ai][bj][m][0], v1 = acc[ai][bj][m][1];
                    float rr[8] = {v0[0], v0[1], v0[2], v0[3], v1[0], v1[1], v1[2], v1[3]};
#pragma unroll
                    for (int e = 0; e < 8; ++e) rr[e] *= gl[e];
                    bf16* dst = Mg + row * 1024 + col;
                    if (nbr > 0) { const v4u old = *(const v4u*)dst; float ol[8]; UNPACK8(old, ol);
#pragma unroll
                        for (int e = 0; e < 8; ++e) rr[e] += ol[e]; }
                    *(v4u*)dst = PACK8(rr); } }
    }
};
struct EpiOut {
    static constexpr bool PERM = true, AFTER_DRAIN = false;
    const float* X; float* Out;
    __device__ __forceinline__ void operator()(const pg8::f32x4 (&acc)[2][2][4][2], const pg8::Unit& u, int wr, int wc, int fr, int fq) const {
        const int row0 = u.pm * 256 + wr * 64 + fr, col0 = u.pn * 256 + wc * 32 + 8 * fq;
#pragma unroll
        for (int ai = 0; ai < 2; ++ai)
#pragma unroll
            for (int m = 0; m < 4; ++m) { const size_t row = (size_t)(row0 + ai * 128 + m * 16);
#pragma unroll
                for (int bj = 0; bj < 2; ++bj) { const size_t p = row * 1024 + col0 + bj * 128;
                    const f32x4 x0 = *(const f32x4*)(X + p), x1 = *(const f32x4*)(X + p + 4);
                    const pg8::f32x4 a0 = acc[ai][bj][m][0], a1 = acc[ai][bj][m][1];
                    *(f32x4*)(Out + p) = (f32x4){x0[0] + a0[0], x0[1] + a0[1], x0[2] + a0[2], x0[3] + a0[3]};
                    *(f32x4*)(Out + p + 4) = (f32x4){x1[0] + a1[0], x1[1] + a1[1], x1[2] + a1[2], x1[3] + a1[3]}; } }
    }
};

#define XB_TMO      128
#define XB_XCNT(j)  (256  + 64 * (j))
#define XB_XSUB(j)  (1280 + 64 * (j))
#define XB_XGEN(j)  (2304 + 64 * (j))
#define XB_TOP      3328
#define XB_TOPGEN   3392
#define XCD_BAR_WORDS 3456
#define XB_SPIN_CAP (1u << 18)

__device__ __forceinline__ unsigned xb_ld(unsigned* p)              { return __hip_atomic_load(p, __ATOMIC_RELAXED, __HIP_MEMORY_SCOPE_AGENT); }
__device__ __forceinline__ unsigned xb_add(unsigned* p, unsigned v) { return __hip_atomic_fetch_add(p, v, __ATOMIC_RELAXED, __HIP_MEMORY_SCOPE_AGENT); }
__device__ __forceinline__ unsigned xb_xcc_id() { return (unsigned)__builtin_amdgcn_s_getreg((3 << 11) | 20) & 0xFu; }
#define XB_SPIN(cond, bar) do { unsigned _sp = 0; while (cond) { __builtin_amdgcn_s_sleep(1); \
    if ((++_sp & 255u) == 0u) { if (xb_ld(&(bar)[XB_TMO])) break; if (_sp > XB_SPIN_CAP) { atomicAdd(&(bar)[XB_TMO], 1u); break; } } } } while (0)

struct XcdBarrier {
    unsigned* bar; unsigned x;
    volatile LAS unsigned* st;
};

__device__ __forceinline__ XcdBarrier xcd_barrier_post(unsigned* bar, volatile LAS unsigned* st) {
    XcdBarrier b; b.bar = bar; b.x = xb_xcc_id(); b.st = st;
    if (threadIdx.x == 0) (void)xb_add(&bar[XB_XCNT(b.x)], 1u);
    return b;
}
__device__ __forceinline__ void xcd_barrier_complete(unsigned* bar, unsigned x, unsigned& nloc, unsigned& nx) {
    const unsigned G = gridDim.x * gridDim.y * gridDim.z;
    unsigned sum, cnt, mine, sp = 0u;
    for (;;) {
        sum = 0u; cnt = 0u; mine = 0u;
#pragma unroll
        for (unsigned j = 0; j < 16; ++j) { const unsigned c = xb_ld(&bar[XB_XCNT(j)]); sum += c; cnt += (c > 0u) ? 1u : 0u; mine = (j == x) ? c : mine; }
        if (sum == G) break;
        __builtin_amdgcn_s_sleep(1);
        if ((++sp & 255u) == 0u) { if (xb_ld(&bar[XB_TMO])) break; if (sp > XB_SPIN_CAP) { atomicAdd(&bar[XB_TMO], 1u); break; } }
    }
    nloc = mine > 0u ? mine : 1u; nx = cnt > 0u ? cnt : 1u;
}

__device__ __forceinline__ void xcd_barrier(const XcdBarrier& b) {
    asm volatile("s_waitcnt vmcnt(0)" ::: "memory");
    __syncthreads();
    if (threadIdx.x == 0) {
        unsigned* bar = b.bar;
        __builtin_amdgcn_s_waitcnt(0);
        unsigned nloc = b.st[0], nx = b.st[1];
        if (nloc == 0u) { xcd_barrier_complete(bar, b.x, nloc, nx); b.st[0] = nloc; b.st[1] = nx; }
        const unsigned old = xb_add(&bar[XB_XSUB(b.x)], 1u);
        const unsigned gen = old / nloc;
        if (old + 1u == (gen + 1u) * nloc) {
            __builtin_amdgcn_fence(__ATOMIC_RELEASE, "agent");
            asm volatile("s_waitcnt vmcnt(0)" ::: "memory");
            const unsigned og = xb_add(&bar[XB_TOP], 1u);
            const unsigned tg = og / nx;
            if (og + 1u == (tg + 1u) * nx) xb_add(&bar[XB_TOPGEN], 1u);
            else XB_SPIN(xb_ld(&bar[XB_TOPGEN]) == tg, bar);
            __builtin_amdgcn_fence(__ATOMIC_ACQUIRE, "agent");
            xb_add(&bar[XB_XGEN(b.x)], 1u);
            asm volatile("s_waitcnt vmcnt(0)" ::: "memory");
        } else {
            XB_SPIN(xb_ld(&bar[XB_XGEN(b.x)]) == gen, bar);
            __builtin_amdgcn_fence(__ATOMIC_ACQUIRE, "agent");
            asm volatile("s_waitcnt vmcnt(0)" ::: "memory");
        }
    }
    __syncthreads();
}

template <int DQK, int DV, int MODE>
__device__ __forceinline__ void att_call(bool strip, LAS unsigned char* lds, const bf16* Qb, int qpitch, const bf16* Kb, int kpitch, const bf16* VTb, int skv, const unsigned* maskb, const bf16* Zb, bf16* Ob, int q0) {
    if (ATT_STRIP != 0 && strip) attn_unit<DQK, DV, MODE, ATT_STRIP>(lds, Qb, qpitch, Kb, kpitch, VTb, skv, maskb, Zb, Ob, q0);
    else attn_unit<DQK, DV, MODE, 0>(lds, Qb, qpitch, Kb, kpitch, VTb, skv, maskb, Zb, Ob, q0);
}
struct Args { const float* in[19]; const int* pos; float* out; unsigned char* ws; };
typedef const __attribute__((address_space(4))) Args* kargs_t;
#define PHASE_BEGIN \
    kargs_t ap_ = (kargs_t)__builtin_amdgcn_kernarg_segment_ptr(); asm volatile("" : "+s"(ap_)); \
    int tid = threadIdx.x; asm volatile("" : "+v"(tid)); \
    const int lane = tid & 63, wave = __builtin_amdgcn_readfirstlane(tid >> 6), G = gridDim.x, NGW = G * 8, gw = blockIdx.x * 8 + wave; \
    unsigned char* const ws = ap_->ws; unsigned char* const dob = (unsigned char*)ap_->out; const int* const pos = ap_->pos; float* const outp = ap_->out; unsigned* const ctl = (unsigned*)(ws + WS_CTL); \
    const float* const x = ap_->in[0]; const float* const mem = ap_->in[1]; \
    const float* const g_norm = ap_->in[3]; const float* const w_in = ap_->in[4]; const float* const g_qn_a = ap_->in[5]; const float* const g_kn_a = ap_->in[6]; \
    const float* const g_cq = ap_->in[7]; const float* const g_ckv = ap_->in[8]; const float* const w_uq = ap_->in[9]; const float* const w_ukv = ap_->in[10]; \
    const float* const g_qn_b = ap_->in[11]; const float* const g_kn_b = ap_->in[12]; const float* const g_mem = ap_->in[13]; const float* const w_mem_kv = ap_->in[14]; \
    const float* const g_qn_m = ap_->in[15]; const float* const g_kn_m = ap_->in[16]; const float* const w_branch = ap_->in[17]; const float* const w_out = ap_->in[18]; \
    bf16* const WinT = (bf16*)(ws + WS_WIN); bf16* const WuqT = (bf16*)(ws + WS_WUQ); bf16* const WukvT = (bf16*)(ws + WS_WUKV); bf16* const WmemT = (bf16*)(ws + WS_WMEM); \
    bf16* const WbrT = (bf16*)(ws + WS_WBR); bf16* const WoutT = (bf16*)(ws + WS_WOUT); \
    float* const ropeA = (float*)(ws + WS_ROPEA); float* const ropeB = (float*)(ws + WS_ROPEB); \
    bf16* const MN = (bf16*)(ws + WS_MN); bf16* const KVM = (bf16*)(ws + WS_KVM); bf16* const VTM = (bf16*)(ws + WS_VTM); \
    float* const WI = (float*)(ws + WS_WI); unsigned* const MASK = (unsigned*)(ws + WS_MASK); \
    bf16* const VTA = (bf16*)(dob + DO_VTA); bf16* const VTB = (bf16*)(dob + DO_VTB); bf16* const KB = (bf16*)(dob + DO_KB); \
    bf16* const Hh = (bf16*)(ws + WS_H); bf16* const MG = (bf16*)(ws + WS_H); bf16* const QB = (bf16*)(ws + WS_QB); \
    bf16* const KVB = (bf16*)(ws + WS_KVB); bf16* const GT0 = (bf16*)(dob + DO_G0); bf16* const GT1 = (bf16*)(ws + WS_G1); bf16* const P = (bf16*)(ws + WS_P); \
    (void)lane; (void)NGW; (void)gw; (void)ctl; \
    (void)pos; (void)outp; (void)x; (void)mem; (void)g_norm; (void)w_in; (void)g_qn_a; (void)g_kn_a; (void)g_cq; (void)g_ckv; (void)w_uq; (void)w_ukv; (void)g_qn_b; (void)g_kn_b; (void)g_mem; (void)w_mem_kv; \
    (void)g_qn_m; (void)g_kn_m; (void)w_branch; (void)w_out; (void)WinT; (void)WuqT; (void)WukvT; (void)WmemT; (void)WbrT; (void)WoutT; (void)ropeA; (void)ropeB; (void)MN; (void)KVM; (void)VTM; (void)WI; (void)MASK; \
    (void)VTA; (void)VTB; (void)Hh; (void)KB; (void)QB; (void)KVB; (void)MG; (void)GT0; (void)GT1; (void)P
#define GRID_BARRIER() do { kargs_t bp_ = (kargs_t)__builtin_amdgcn_kernarg_segment_ptr(); asm volatile("" : "+s"(bp_)); \
    XcdBarrier b_; b_.bar = (unsigned*)(bp_->ws + WS_CTL) + 4096; b_.x = xb_xcc_id(); b_.st = (volatile LAS unsigned*)(lds + LDS_BYTES - 32); xcd_barrier(b_); } while (0)

__global__ void __launch_bounds__(512, 2) fwd_kernel(Args a) {
    extern __shared__ __attribute__((aligned(16))) unsigned char lds_raw[];
    LAS unsigned char* const lds = (LAS unsigned char*)lds_raw;
    volatile LAS int* const slot = (volatile LAS int*)(lds + LDS_SLOT);
    if (threadIdx.x < 16) ((LAS unsigned*)(lds + LDS_BYTES - 64))[threadIdx.x] = 0u;
    __syncthreads();
    (void)xcd_barrier_post((unsigned*)(a.ws + WS_CTL) + 4096, (volatile LAS unsigned*)(lds + LDS_BYTES - 32));

    for (int rep = 0; rep < REP_P0; ++rep) { PHASE_BEGIN;
        LAS float* scr = (LAS float*)(lds + wave * 16384);
        constexpr int I_IN = 16 * (NP / 32), I_UQ = 6 * 24, I_UKV = 4 * 32, I_MEM = 16 * 32, I_BR = 8 * 32, I_OUT = 16 * 32;
        constexpr int NITEMS = I_IN + I_UQ + I_UKV + I_MEM + 3 * I_BR + I_OUT;
        for (int it = gw; it < NITEMS; it += NGW) {
            int r = it;
            if (r < I_IN) { transpose_item<true>(w_in, 1024, DIN, NP, WinT, scr, r, lane); continue; } r -= I_IN;
            if (r < I_UQ) { transpose_item<false>(w_uq, 384, 768, 768, WuqT, scr, r, lane); continue; } r -= I_UQ;
            if (r < I_UKV) { transpose_item<false>(w_ukv, 256, 1024, 1024, WukvT, scr, r, lane); continue; } r -= I_UKV;
            if (r < I_MEM) { transpose_item<false>(w_mem_kv, 1024, 1024, 1024, WmemT, scr, r, lane); continue; } r -= I_MEM;
            if (r < 3 * I_BR) { const int nb = r / I_BR; transpose_item<false>(w_branch + (size_t)nb * 512 * 1024, 512, 1024, 1024, WbrT + (size_t)nb * 1024 * 512, scr, r % I_BR, lane); continue; } r -= 3 * I_BR;
            transpose_item<false>(w_out, 1024, 1024, 1024, WoutT, scr, r, lane);
        }
        for (int idx = blockIdx.x * 512 + tid; idx < TT * 24; idx += G * 512) {
            const int t = idx / 24, i = idx % 24; const float pf = (float)pos[t];
            if (i < 8) { const float ang = pf * INVA[i]; ropeA[t * 16 + i] = cosf(ang); ropeA[t * 16 + 8 + i] = sinf(ang); }
            else { const int j = i - 8; const float ang = pf * INVB[j]; ropeB[t * 32 + j] = cosf(ang); ropeB[t * 32 + 16 + j] = sinf(ang); }
        }
        for (int m = gw; m < NB * MEML; m += NGW) rms_row_1024(mem + (size_t)m * DM, g_mem, MN + (size_t)m * DM, lane);
        for (int rp = 0; rp < REP_PH; ++rp)
        for (int m = gw; m < TT; m += NGW) rms_row_1024(x + (size_t)m * DM, g_norm, Hh + (size_t)m * DM, lane);
    }
    GRID_BARRIER();
    for (int es = 0; es < EXTRA_SYNCS; ++es) GRID_BARRIER();

    for (int rep = 0; rep < REP_G1; ++rep) { PHASE_BEGIN;
        pg8::Gemm g{Hh, WinT, TT, PP, 1024, 1024}; pg8::StaticOrder S; S.init(TT, PP, G, (int)blockIdx.x);
        pg8::EpiBf16<0> E{P, PP, nullptr, 0, 0, 1.f};
        pg8::gemm_phase<pg8::EpiBf16<0>, pg8::StaticOrder, true, true>(lds, g, S, E);
    }
    { PHASE_BEGIN;
        pg8::Gemm g{MN, WmemT, NB * MEML, 1024, 1024, 1024}; pg8::StaticOrder S; S.init(NB * MEML, 1024, G, (int)((blockIdx.x + 64) % G));
        pg8::EpiBf16<0> E{KVM, 1024, nullptr, 0, 0, 1.f};
        pg8::gemm_phase<pg8::EpiBf16<0>, pg8::StaticOrder, true, true>(lds, g, S, E);
    }
    GRID_BARRIER();
    { PHASE_BEGIN;
        float ga[8], gk[8], gq[8], gc[8], gm[8];
#pragma unroll
        for (int j = 0; j < 8; ++j) { ga[j] = g_qn_a[8 * (lane & 7) + j]; gk[j] = g_kn_a[8 * (lane & 7) + j]; gm[j] = g_qn_m[8 * (lane & 15) + j]; gq[j] = lane < 48 ? g_cq[8 * lane + j] : 0.f; gc[j] = lane < 32 ? g_ckv[8 * lane + j] : 0.f; }
        for (int dp = 0; dp < DUMMY_POST1; ++dp)
            for (int m = gw; m < TT; m += NGW)
                post1_row(P + (size_t)m * PP, QB + (size_t)(m & 1023) * 4096, ropeA + (size_t)m * 16, ga, gk, gq, gc, gm, (float*)KVB + (size_t)m * 8, lane);
        for (int m = gw; m < TT; m += NGW)
            post1_row(P + (size_t)m * PP, P + (size_t)m * PP, ropeA + (size_t)m * 16, ga, gk, gq, gc, gm, WI + (size_t)m * 8, lane);
        for (int rt = 0; rt < REP_TR; ++rt)
        transpose_v(P, PP, C_VA, 64, 8, 64, SEQ, NB, VTA, gw, NGW, lane);
        for (int m = gw; m < NB * MEML; m += NGW) km_row(KVM + (size_t)m * 1024, g_kn_m, lane);
        for (int rt = 0; rt < REP_TR; ++rt)
        transpose_v(KVM, 1024, 512, 128, 4, 128, MEML, NB, VTM, gw, NGW, lane);
    }
    GRID_BARRIER();
    for (int rep = 0; rep < REP_G2; ++rep) { PHASE_BEGIN;
        pg8::Gemm g{P + C_CQ, WuqT, TT, 768, 384, PP}; pg8::StaticOrder S; S.init(TT, 768, G, (int)blockIdx.x);
        pg8::EpiBf16<0> E{QB, 768, nullptr, 0, 0, 1.f};
        pg8::gemm_phase<pg8::EpiBf16<0>, pg8::StaticOrder, true, true>(lds, g, S, E);
    }
    for (int rep = 0; rep < REP_G2; ++rep) { PHASE_BEGIN;
        pg8::Gemm g{P + C_CKV, WukvT, TT, 1024, 256, PP}; pg8::StaticOrder S; S.init(TT, 1024, G, (int)((blockIdx.x + 192) % G));
        pg8::EpiBf16<0> E{KVB, 1024, nullptr, 0, 0, 1.f};
        pg8::gemm_phase<pg8::EpiBf16<0>, pg8::StaticOrder, true, true>(lds, g, S, E);
    }
    for (int rep = 0; rep < REP_IDX; ++rep) { if (rep > 0) GRID_BARRIER();
        PHASE_BEGIN;
        unsigned* const q_idx = ctl + 64 * (0 + 4 * rep);
        int u = next_unit(q_idx, slot);
        bf16x8 qf[8][2]; float wq[8];
        if (u < NB * 128) indexer_load_q(P, WI, u, qf, wq);
        while (u < NB * 128) {
            int tk = 0; if (tid == 0) tk = (int)atomicAdd(q_idx, 1u);
            const int tb = 127 - (u >> 3), bb = u & 7;
            int un;
            indexer_unit((LAS float*)lds, P, WI, MASK, bb, tb, qf, wq, tk, slot, NB * 128, un);
            u = un;
        }
    }
    GRID_BARRIER();
    { PHASE_BEGIN;
        LAS float* scr = (LAS float*)(lds + wave * 8192);
        float gqv[12], gkv[12];
#pragma unroll
        for (int e = 0; e < 12; ++e) { gqv[e] = g_qn_b[12 * (lane & 7) + e]; gkv[e] = g_kn_b[12 * (lane & 7) + e]; }
        for (int dp = 0; dp < DUMMY_POST2; ++dp)
            for (int m = gw; m < TT; m += NGW)
                post2_row(QB + (size_t)m * 768, (bf16*)MASK + (size_t)(m & 1023) * 768, KVB + (size_t)m * 1024, P + (size_t)m * PP, (bf16*)MASK + (size_t)(1024 + (m & 1023)) * 768, ropeB + (size_t)m * 32, gqv, gkv, scr, lane);
        for (int m = gw; m < TT; m += NGW)
            post2_row(QB + (size_t)m * 768, QB + (size_t)m * 768, KVB + (size_t)m * 1024, P + (size_t)m * PP, KB + (size_t)m * 768, ropeB + (size_t)m * 32, gqv, gkv, scr, lane);
        for (int rt = 0; rt < REP_TR; ++rt)
        transpose_v(KVB, 1024, 64, 128, 8, 64, SEQ, NB, VTB, gw, NGW, lane);
    }
    GRID_BARRIER();
    for (int rep = 0; rep < REP_ATT; ++rep) { if (rep > 0) GRID_BARRIER();
        PHASE_BEGIN;
        unsigned* const q_att = ctl + 64 * (1 + 4 * rep);
        for (;;) {
            const int u = next_unit(q_att, slot);
            if (u >= 1152) break;
            if (u < 704 || u >= 832) {
                const int uu = u < 704 ? u : u - 128, cls = uu >> 6, bh = uu & 63, bb = bh >> 3, h = bh & 7;
                const bool isA = (0x52a7u >> cls) & 1u; const int qb = (int)((0x11232435467567ull >> (4 * cls)) & 15ull);
                const size_t r0 = (size_t)bb * SEQ;
                if (!isA) attn_unit_pipe<96, 1>(lds, QB + r0 * 768 + h * 96, 768, KB + r0 * 768 + h * 96, 768, VTB + (size_t)((bb * 8 + h) * 64) * SEQ, SEQ, nullptr,
                                                   P + r0 * PP + C_YB + h * 64, qb * 256);
                else attn_unit_pipe<64, 2>(lds, P + r0 * PP + C_QA + h * 64, PP, P + r0 * PP + C_KA + h * 64, PP, VTA + (size_t)((bb * 8 + h) * 64) * SEQ, SEQ, MASK + r0 * 64,
                                           P + r0 * PP + C_YA + h * 64, qb * 256);
            } else {
                const int v = u - 704, hq = v & 3, bh = v >> 2, bb = bh >> 2, h = bh & 3;
                const size_t r0 = (size_t)bb * SEQ;
                attn_unit_mem(lds, P + r0 * PP + C_QM + h * 128, KVM + (size_t)bb * MEML * 1024 + h * 128, VTM + (size_t)((bb * 4 + h) * 128) * MEML,
                              P + r0 * PP + C_ZM + h * 128, P + r0 * PP + C_YM + h * 128, hq * 512);
            }
        }
    }
    GRID_BARRIER();
    for (int rep = 0; rep < 1; ++rep) { PHASE_BEGIN;
        pg8::Gemm g{Hh, WinT + (size_t)PP * 1024, TT, NZG, 1024, 1024}; pg8::StaticOrder S; S.init(TT, NZG, G, (int)blockIdx.x);
        EpiZG E{P, GT0, GT1};
        pg8::gemm_phase<EpiZG, pg8::StaticOrder, true, true>(lds, g, S, E);
    }
    GRID_BARRIER();
    for (int nbr = 0; nbr < 3 * REP_G4; ++nbr) { const int nb = nbr % 3; PHASE_BEGIN;
        pg8::Gemm g{P + (nb == 0 ? C_YA : (nb == 1 ? C_YB : C_YM)), WbrT + (size_t)nb * 1024 * 512, TT, 1024, 512, PP}; pg8::StaticOrder S; S.init(TT, 1024, G, (int)blockIdx.x);
        EpiMerge E{MG, GT0, GT1, nb};
        pg8::gemm_phase<EpiMerge, pg8::StaticOrder, true, true>(lds, g, S, E);
    }
    GRID_BARRIER();
    for (int rep = 0; rep < REP_G5; ++rep) { PHASE_BEGIN;
        pg8::Gemm g{MG, WoutT, TT, 1024, 1024, 1024}; pg8::StaticOrder S; S.init(TT, 1024, G, (int)blockIdx.x);
        EpiOut E{x, outp};
        pg8::gemm_phase<EpiOut, pg8::StaticOrder, true, true>(lds, g, S, E);
    }
}

extern "C" void kernel_launch(void* const* d_in, const int* in_sizes, int n_in, void* d_out, int out_size, void* d_ws, size_t ws_size, hipStream_t stream) {
    static int grid = 0;
    if (grid == 0) {
        if (n_in != 19 || out_size != TT * DM || ws_size < WS_END) { fprintf(stderr, "kernel_launch: unexpected problem (n_in %d, out %d, ws %zu); nothing launched\n", n_in, out_size, ws_size); grid = -1; return; }
        int dev = 0, cus = 0, per_cu = 0;
        if (hipGetDevice(&dev) != hipSuccess || hipDeviceGetAttribute(&cus, hipDeviceAttributeMultiprocessorCount, dev) != hipSuccess) { grid = -1; return; }
        if (hipFuncSetAttribute((const void*)fwd_kernel, hipFuncAttributeMaxDynamicSharedMemorySize, LDS_BYTES) != hipSuccess) { fprintf(stderr, "kernel_launch: hipFuncSetAttribute failed\n"); grid = -1; return; }
        if (hipOccupancyMaxActiveBlocksPerMultiprocessor(&per_cu, (const void*)fwd_kernel, 512, LDS_BYTES) != hipSuccess || per_cu < 1) { fprintf(stderr, "kernel_launch: occupancy query reports %d blocks per CU\n", per_cu); (void)hipGetLastError(); grid = -1; return; }
        grid = cus;
    }
    if (grid < 0) return;
    (void)hipMemsetAsync((char*)d_ws + WS_CTL, 0, 65536, stream);
    Args a{};
    for (int i = 0; i < 19; ++i) a.in[i] = (const float*)d_in[i];
    a.pos = (const int*)d_in[2]; a.out = (float*)d_out; a.ws = (unsigned char*)d_ws;
    hipLaunchKernelGGL(fwd_kernel, dim3(grid), dim3(512), LDS_BYTES, stream, a);
    const hipError_t e = hipPeekAtLastError();
    if (e != hipSuccess) fprintf(stderr, "kernel_launch: launch failed: %s (grid %d)\n", hipGetErrorString(e), grid);
}
```

```cpp
#include <hip/hip_runtime.h>
#include <cstdio>
#include <cstdint>
namespace pg8 {
#define PG8_LAS __attribute__((address_space(3)))
typedef unsigned short bf16_t;
typedef short bf16x8 __attribute__((ext_vector_type(8)));
typedef float f32x4 __attribute__((ext_vector_type(4)));
typedef unsigned u32x4 __attribute__((ext_vector_type(4)));
constexpr int BM = 256, BK = 64, HALF = 128, HTB = HALF * BK * 2  , STAGE_BYTES = 8 * HTB, NXCD = 8, WGM = 8;

__host__ __device__ __forceinline__ int lds_byte(int r, int c) { const int st = (r >> 4) * 2 + (c >> 5), rr = r & 15, cc = c & 31, ob = rr * 64 + cc * 2; return st * 1024 + (ob ^ (((ob >> 9) & 1) << 5)); }
__host__ __device__ __forceinline__ void stage_rc(int b, int& R, int& C) { const int st = b / 1024, sb = b % 1024, swz = sb ^ (((sb >> 9) & 1) << 5); R = (st >> 1) * 16 + swz / 64; C = (st & 1) * 32 + (swz % 64) / 2; }
__host__ __device__ __forceinline__ int perm32(int rho) { const int n = rho >> 4, i = rho & 15; return 8 * (i >> 2) + 4 * n + (i & 3); }

struct Unit { int pm, pn; };
struct Gemm { const bf16_t* A; const bf16_t* Bt; int M, N, K, lda; const bf16_t* Ag0; const bf16_t* Ag1; const bf16_t* Ag2; int ngrp; };
__device__ __forceinline__ const char* a_base(const Gemm& g, const Unit& u) { if (!g.ngrp) return (const char*)g.A; const int j = u.pn / g.ngrp; return (const char*)(j == 0 ? g.Ag0 : (j == 1 ? g.Ag1 : g.Ag2)); }

struct StaticOrder {
    int nM, nN, nwg, G, c;
    __host__ __device__ void init(int M, int N, int G_, int c_) { nM = M / BM; nN = N / BM; nwg = nM * nN; G = G_; c = c_; }
    __host__ __device__ bool next(int i, Unit& u) const {
        const long L = (long)i * G + c; if (L >= nwg) return false;
        int wgid = (int)L; { const int q = nwg / NXCD, r = nwg % NXCD, xcd = wgid % NXCD, off = wgid / NXCD; wgid = (xcd < r ? xcd * (q + 1) : r * (q + 1) + (xcd - r) * q) + off; }
        const int nig = WGM * nN, gid = wgid / nig, fm = gid * WGM, gsz = (nM - fm) < WGM ? (nM - fm) : WGM;
        u.pm = fm + ((wgid % nig) % gsz); u.pn = (wgid % nig) / gsz; return true;
    }
    __device__ __forceinline__ void a_ready(const Unit&) const {}
    __device__ __forceinline__ void done(const Unit&) const {}
};

__device__ __forceinline__ unsigned cvt_pk_bf16(float lo, float hi) { unsigned r; asm volatile("v_cvt_pk_bf16_f32 %0, %1, %2" : "=v"(r) : "v"(lo), "v"(hi)); return r; }
typedef float f32x2 __attribute__((ext_vector_type(2)));
__device__ __forceinline__ f32x2 gelu_pk(f32x2 v) {
    const f32x2 av = __builtin_elementwise_abs(v), d = av * 0.2316418882f + 1.0f;
    f32x2 t; t.x = __builtin_amdgcn_rcpf(d.x); t.y = __builtin_amdgcn_rcpf(d.y);
    f32x2 q = t * 0.5307027145f + (-0.7265760135f); q = q * t + 0.7107068705f; q = q * t + (-0.142248368f); q = q * t + 0.127414796f; q = q * t;
    const f32x2 s = (v * v) * (-0.72134752044f);
    f32x2 e; e.x = __builtin_amdgcn_exp2f(s.x); e.y = __builtin_amdgcn_exp2f(s.y);
    const f32x2 m = v * (q * e), r = v - m;
    f32x2 o; o.x = v.x < 0.f ? m.x : r.x; o.y = v.y < 0.f ? m.y : r.y; return o;
}

template <int ACT  > struct EpiBf16 {
    static constexpr bool PERM = true, AFTER_DRAIN = false; static_assert(ACT == 0 || ACT == 1, "EpiBf16: ACT is 0 (none) or 1 (gelu_pk)");
    bf16_t* O; int ldc; const float* bias; int split_cols; size_t split_stride; float scale0;
    __device__ __forceinline__ void operator()(const f32x4 (&acc)[2][2][4][2], const Unit& u, int wr, int wc, int fr, int fq) const {
        const int row0 = u.pm * BM + wr * 64 + fr; int colt = u.pn * BM; bf16_t* base = O;
        float sc = 1.f; if (split_cols) { const int t = colt / split_cols; base += (size_t)t * split_stride; colt -= t * split_cols; if (t == 0) sc = scale0; }
        const int col0 = colt + wc * 32 + 8 * fq, bcol0 = u.pn * BM + wc * 32 + 8 * fq;
        f32x4 bv[2][2];
#pragma unroll
        for (int bj = 0; bj < 2; ++bj)
#pragma unroll
            for (int n = 0; n < 2; ++n) bv[bj][n] = bias ? *(const f32x4*)(bias + bcol0 + bj * HALF + 4 * n) : (f32x4){0.f, 0.f, 0.f, 0.f};
#pragma unroll
        for (int ai = 0; ai < 2; ++ai)
#pragma unroll
            for (int m = 0; m < 4; ++m) { bf16_t* rowp = base + (size_t)(row0 + ai * HALF + m * 16) * ldc + col0;
#pragma unroll
                for (int bj = 0; bj < 2; ++bj) { f32x4 v0 = acc[ai][bj][m][0] + bv[bj][0], v1 = acc[ai][bj][m][1] + bv[bj][1];
                    if (ACT == 1) { f32x2 a = gelu_pk((f32x2){v0[0], v0[1]}), b = gelu_pk((f32x2){v0[2], v0[3]}), c = gelu_pk((f32x2){v1[0], v1[1]}), d = gelu_pk((f32x2){v1[2], v1[3]});
                        v0 = (f32x4){a.x, a.y, b.x, b.y}; v1 = (f32x4){c.x, c.y, d.x, d.y}; }
                    v0 = v0 * sc; v1 = v1 * sc; u32x4 w; w.x = cvt_pk_bf16(v0[0], v0[1]); w.y = cvt_pk_bf16(v0[2], v0[3]); w.z = cvt_pk_bf16(v1[0], v1[1]); w.w = cvt_pk_bf16(v1[2], v1[3]);
                    *(u32x4*)(rowp + bj * HALF) = w; } }
    }
};
template <class Epi, class Sched, bool ALIGN_EPI = false, bool SP2 = false>
__device__ __forceinline__ void gemm_phase(PG8_LAS unsigned char* lds, const Gemm g, const Sched& S, const Epi& E) {
    int tid_ = threadIdx.x; asm volatile("" : "+v"(tid_));
    const int tid = tid_, wid = __builtin_amdgcn_readfirstlane(tid >> 6), lane = tid & 63, wr = wid >> 2, wc = wid & 3, fr = lane & 15, fq = lane >> 4;
    const int K = g.K, nt = K / BK;
    unsigned voffA[2], voffB[2];
#pragma unroll
    for (int i = 0; i < 2; ++i) { int R, C; stage_rc(tid * 16 + i * 8192, R, C); const int Rb = Epi::PERM ? ((R & ~31) + perm32(R & 31)) : R;
        voffA[i] = (unsigned)(R * g.lda + C) * 2u; voffB[i] = (unsigned)(Rb * K + C) * 2u; }
    const size_t kstep = (size_t)(BK * 2);
    const size_t hstepA = (size_t)HALF * g.lda * 2, hstepB = (size_t)HALF * K * 2;
    const size_t tstepA = 2 * hstepA, tstepB = 2 * hstepB;
    const unsigned ldsw = (unsigned)wid * 1024u;
    const int aoff = lds_byte(wr * 64 + fr, fq * 8), boff = lds_byte(wc * 32 + fr, fq * 8);
#define PG8_SA(b, h) (((b) * 2 + (h)) * HTB)
#define PG8_SB(b, h) ((4 + (b) * 2 + (h)) * HTB)
#define PG8_STAGE(bufoff, gbase, voff) do { _Pragma("unroll") for (int _i = 0; _i < 2; ++_i) \
        __builtin_amdgcn_global_load_lds((const unsigned*)((const char*)(gbase) + (voff)[_i]), (PG8_LAS unsigned*)(lds + (bufoff) + ldsw + _i * 8192), 16, 0, 0); } while (0)
#define PG8_LDA(dst, b, h) do { _Pragma("unroll") for (int m = 0; m < 4; ++m) _Pragma("unroll") for (int k = 0; k < 2; ++k) dst[m][k] = *(const PG8_LAS bf16x8*)(lds + PG8_SA(b, h) + aoff + m * 2048 + k * 1024); } while (0)
#define PG8_LDB(dst, b, h) do { _Pragma("unroll") for (int n = 0; n < 2; ++n) _Pragma("unroll") for (int k = 0; k < 2; ++k) dst[n][k] = *(const PG8_LAS bf16x8*)(lds + PG8_SB(b, h) + boff + n * 2048 + k * 1024); } while (0)
#define PG8_MMA(ai, bj, At, Bt) do { __builtin_amdgcn_s_setprio(1); _Pragma("unroll") for (int m = 0; m < 4; ++m) _Pragma("unroll") for (int n = 0; n < 2; ++n) _Pragma("unroll") for (int k = 0; k < 2; ++k) \
        acc[ai][bj][m][n] = __builtin_amdgcn_mfma_f32_16x16x32_bf16(Bt[n][k], At[m][k], acc[ai][bj][m][n], 0, 0, 0); __builtin_amdgcn_s_setprio(0); } while (0)
#define PG8_WAIT_V(n) asm volatile("s_waitcnt vmcnt(" #n ")" ::: "memory")
#define PG8_WAIT_L(n) asm volatile("s_waitcnt lgkmcnt(" #n ")" ::: "memory")
#define PG8_BAR __builtin_amdgcn_s_barrier()
#define PG8_SCHED __builtin_amdgcn_sched_barrier(0)
    Unit cur, nxt; int ui = 0;
    if (!S.next(0, cur)) return;
    f32x4 acc[2][2][4][2];
#pragma unroll
    for (int a = 0; a < 2; ++a)
#pragma unroll
        for (int b = 0; b < 2; ++b)
#pragma unroll
            for (int m = 0; m < 4; ++m)
#pragma unroll
                for (int n = 0; n < 2; ++n) acc[a][b][m][n] = (f32x4){0.f, 0.f, 0.f, 0.f};
    bf16x8 At[4][2], B0[2][2], B1[2][2];
    const char* cA = a_base(g, cur) + (size_t)cur.pm * tstepA; const char* cB = (const char*)g.Bt + (size_t)cur.pn * tstepB;
    S.a_ready(cur);
    if constexpr (SP2) {
        PG8_STAGE(PG8_SB(0, 0), cB, voffB); PG8_STAGE(PG8_SB(0, 1), cB + hstepB, voffB); PG8_STAGE(PG8_SA(0, 0), cA, voffA); PG8_STAGE(PG8_SA(0, 1), cA + hstepA, voffA);
        if (wr == 1) PG8_BAR;
        PG8_WAIT_V(2); PG8_BAR;
        PG8_STAGE(PG8_SB(1, 0), cB + kstep, voffB); PG8_STAGE(PG8_SA(1, 0), cA + kstep, voffA); PG8_STAGE(PG8_SB(1, 1), cB + hstepB + kstep, voffB);
        PG8_WAIT_V(6); PG8_BAR;
    } else {
        PG8_STAGE(PG8_SB(0, 0), cB, voffB); PG8_STAGE(PG8_SA(0, 0), cA, voffA); PG8_STAGE(PG8_SB(0, 1), cB + hstepB, voffB); PG8_STAGE(PG8_SA(0, 1), cA + hstepA, voffA);
        if (wr == 1) PG8_BAR;
        PG8_WAIT_V(4); PG8_BAR;
        PG8_STAGE(PG8_SB(1, 0), cB + kstep, voffB); PG8_STAGE(PG8_SA(1, 0), cA + kstep, voffA); PG8_STAGE(PG8_SB(1, 1), cB + hstepB + kstep, voffB);
        PG8_WAIT_V(6); PG8_BAR;
    }
    for (;;) {
        const bool has_next = S.next(ui + 1, nxt);
        const char* nA = has_next ? a_base(g, nxt) + (size_t)nxt.pm * tstepA : cA; const char* nB = has_next ? (const char*)g.Bt + (size_t)nxt.pn * tstepB : cB;
        for (int t = 0; t < nt; t += 2) {
            const bool last = (t == nt - 2);
            const char* a1 = cA + (size_t)(t + 1) * kstep;
            const char* a2 = last ? nA : cA + (size_t)(t + 2) * kstep; const char* b2 = last ? nB : cB + (size_t)(t + 2) * kstep;
            const char* a3 = a2 + kstep; const char* b3 = b2 + kstep;
            if (last && has_next) S.a_ready(nxt);
            if constexpr (SP2) {
            PG8_LDB(B0, 0, 0); PG8_LDB(B1, 0, 1); PG8_SCHED; PG8_LDA(At, 0, 0); PG8_STAGE(PG8_SA(1, 1), a1 + hstepA, voffA);
            PG8_WAIT_V(8); PG8_WAIT_L(0); PG8_BAR; PG8_MMA(0, 0, At, B0); PG8_MMA(0, 1, At, B1); PG8_BAR; PG8_SCHED;
            PG8_LDA(At, 0, 1); PG8_STAGE(PG8_SB(0, 0), b2, voffB); PG8_STAGE(PG8_SB(0, 1), b2 + hstepB, voffB); PG8_STAGE(PG8_SA(0, 0), a2, voffA);
            PG8_WAIT_V(8); PG8_WAIT_L(0); PG8_BAR; PG8_MMA(1, 0, At, B0); PG8_MMA(1, 1, At, B1); PG8_BAR; PG8_SCHED;
            PG8_LDB(B0, 1, 0); PG8_LDB(B1, 1, 1); PG8_SCHED; PG8_LDA(At, 1, 0); PG8_STAGE(PG8_SA(0, 1), a2 + hstepA, voffA);
            PG8_WAIT_V(8); PG8_WAIT_L(0); PG8_BAR; PG8_MMA(0, 0, At, B0); PG8_MMA(0, 1, At, B1); PG8_BAR; PG8_SCHED;
            PG8_LDA(At, 1, 1); PG8_STAGE(PG8_SB(1, 0), b3, voffB); PG8_STAGE(PG8_SB(1, 1), b3 + hstepB, voffB); PG8_STAGE(PG8_SA(1, 0), a3, voffA);
            PG8_WAIT_V(8); PG8_WAIT_L(0); PG8_BAR; PG8_MMA(1, 0, At, B0); PG8_MMA(1, 1, At, B1); PG8_BAR; PG8_SCHED;
            } else {
            PG8_LDB(B0, 0, 0); PG8_SCHED; PG8_LDA(At, 0, 0); PG8_STAGE(PG8_SA(1, 1), a1 + hstepA, voffA);
            PG8_WAIT_L(8); PG8_BAR; PG8_WAIT_L(0); PG8_MMA(0, 0, At, B0); PG8_BAR; PG8_SCHED;
            PG8_LDB(B1, 0, 1); PG8_STAGE(PG8_SB(0, 0), b2, voffB);
            PG8_BAR; PG8_WAIT_L(0); PG8_MMA(0, 1, At, B1); PG8_BAR;
            PG8_LDA(At, 0, 1); PG8_STAGE(PG8_SA(0, 0), a2, voffA);
            PG8_BAR; PG8_WAIT_L(0); PG8_MMA(1, 0, At, B0); PG8_BAR; PG8_SCHED;
            PG8_STAGE(PG8_SB(0, 1), b2 + hstepB, voffB);
            PG8_WAIT_V(6); PG8_BAR; PG8_MMA(1, 1, At, B1); PG8_BAR;
            PG8_LDB(B0, 1, 0); PG8_SCHED; PG8_LDA(At, 1, 0); PG8_STAGE(PG8_SA(0, 1), a2 + hstepA, voffA);
            PG8_WAIT_L(8); PG8_BAR; PG8_WAIT_L(0); PG8_MMA(0, 0, At, B0); PG8_BAR; PG8_SCHED;
            PG8_LDB(B1, 1, 1); PG8_STAGE(PG8_SB(1, 0), b3, voffB);
            PG8_BAR; PG8_WAIT_L(0); PG8_MMA(0, 1, At, B1); PG8_BAR;
            PG8_LDA(At, 1, 1); PG8_STAGE(PG8_SA(1, 0), a3, voffA);
            PG8_BAR; PG8_WAIT_L(0); PG8_MMA(1, 0, At, B0); PG8_BAR; PG8_SCHED;
            PG8_STAGE(PG8_SB(1, 1), b3 + hstepB, voffB);
            PG8_WAIT_V(6); PG8_BAR; PG8_MMA(1, 1, At, B1); PG8_BAR;
            }
        }
        if constexpr (ALIGN_EPI) { if (wr == 0) PG8_BAR; }
        if constexpr (!Epi::AFTER_DRAIN) { E(acc, cur, wr, wc, fr, fq); S.done(cur); }
        if (!has_next) break;
#pragma unroll
        for (int a = 0; a < 2; ++a)
#pragma unroll
            for (int b = 0; b < 2; ++b)
#pragma unroll
                for (int m = 0; m < 4; ++m)
#pragma unroll
                    for (int n = 0; n < 2; ++n) acc[a][b][m][n] = (f32x4){0.f, 0.f, 0.f, 0.f};
        cur = nxt; cA = nA; cB = nB; ++ui;
        if constexpr (ALIGN_EPI) { if (wr == 1) PG8_BAR; }
    }
    PG8_WAIT_V(0);
    if constexpr (!ALIGN_EPI) { if (wr == 0) PG8_BAR; }
    PG8_BAR;
    if constexpr (Epi::AFTER_DRAIN) { E.fused(acc, cur, wr, wc, fr, fq, lds, wid, lane); S.done(cur); }
#undef PG8_SA
#undef PG8_SB
#undef PG8_STAGE
#undef PG8_LDA
#undef PG8_LDB
#undef PG8_MMA
#undef PG8_WAIT_V
#undef PG8_WAIT_L
#undef PG8_BAR
#undef PG8_SCHED
}
}

#define LAS __attribute__((address_space(3)))
typedef unsigned short bf16;
typedef unsigned v4u __attribute__((ext_vector_type(4)));
typedef unsigned v2u __attribute__((ext_vector_type(2)));
typedef float f32x4 __attribute__((ext_vector_type(4)));
typedef float f32x16 __attribute__((ext_vector_type(16)));
typedef short bf16x8 __attribute__((ext_vector_type(8)));
typedef short s16x4 __attribute__((ext_vector_type(4)));
typedef float f32x2_t __attribute__((ext_vector_type(2)));
typedef __bf16 bf16x2_t __attribute__((ext_vector_type(2)));

constexpr int NB = 8, SEQ = 2048, DM = 1024, TT = NB * SEQ;
constexpr int DIN = 7912, NP = 7936;
constexpr int PP = 3840, NZG = 4096;
constexpr int MEML = 256;
constexpr float EPS = 1e-6f, NEGF = -1e30f;
constexpr int C_QA = 0, C_KA = 512, C_VA = 1024, C_QI = 1536, C_KI = 2048, C_WI = 2112, C_CQ = 2120, C_CKV = 2504, C_KR = 2760, C_QM = 2792, C_ZM = 3304;
constexpr int C_YA = C_QI, C_YB = C_CQ, C_YM = C_VA;
constexpr float SCALE_A = 0.18033688011112042f;
constexpr float SCALE_B = 0.14724444602590306f;
constexpr float SCALE_M = 0.12751743082459868f;
constexpr float SCALE_I = 0.04419417382415922f;

__constant__ float INVA[8] = {1.0f, 0.1939227432012558f, 0.03760603070259094f, 0.007292664609849453f, 0.0014142135623842478f, 0.00027424818836152554f, 5.3182957344688475e-05f, 1.0313385246263351e-05f};
__constant__ float INVB[16] = {1.0f, 0.44036659598350525f, 0.1939227432012558f, 0.08539710193872452f, 0.03760603070259094f, 0.016560440883040428f, 0.007292664609849453f, 0.0032114461064338684f, 0.0014142135623842478f, 0.0006227724370546639f, 0.00027424818836152554f, 0.00012076973507646471f, 5.3182957344688475e-05f, 2.34199997066753e-05f, 1.0313385246263351e-05f, 4.541670477919979e-06f};

constexpr size_t MiB = 1u << 20;
constexpr size_t WS_CTL = 0;
constexpr size_t WS_WIN = 1 * MiB;
constexpr size_t WS_WUQ = 17 * MiB;
constexpr size_t WS_WUKV = 18 * MiB;
constexpr size_t WS_WMEM = 19 * MiB;
constexpr size_t WS_WBR = 21 * MiB;
constexpr size_t WS_WOUT = 24 * MiB;
constexpr size_t WS_ROPEA = 26 * MiB;
constexpr size_t WS_ROPEB = 27 * MiB;
constexpr size_t WS_MN = 29 * MiB;
constexpr size_t WS_KVM = 33 * MiB;
constexpr size_t WS_VTM = 37 * MiB;
constexpr size_t WS_WI = 39 * MiB;
constexpr size_t WS_MASK = 40 * MiB;
constexpr size_t WS_H = 44 * MiB;
constexpr size_t WS_P = 76 * MiB;
constexpr size_t WS_QB = 196 * MiB;
constexpr size_t WS_KVB = 220 * MiB;
constexpr size_t WS_G1 = 196 * MiB;
constexpr size_t WS_END = 256 * MiB;
constexpr size_t DO_VTA = 0;
constexpr size_t DO_VTB = 16 * MiB;
constexpr size_t DO_KB = 32 * MiB;
constexpr size_t DO_G0 = 0;

constexpr int REP_P0 = 1, REP_PH = 1, REP_G1 = 1, REP_G2 = 1, REP_IDX = 1, REP_ATT = 1, REP_G4 = 1, REP_G5 = 1;
constexpr int REP_IDX1 = 1, REP_SEL = 1;
constexpr int ATT_STRIP = 0;
constexpr int EXTRA_SYNCS = 0, REP_TR = 1, DUMMY_POST1 = 0, DUMMY_POST2 = 0;
constexpr int LDS_BYTES = 147456;
constexpr int LDS_SLOT = LDS_BYTES - 64;

__device__ __forceinline__ unsigned pk2(float lo, float hi) { f32x2_t v = {lo, hi}; bf16x2_t b = __builtin_convertvector(v, bf16x2_t); return __builtin_bit_cast(unsigned, b); }
__device__ __forceinline__ float bflo(unsigned w) { return __uint_as_float(w << 16); }
__device__ __forceinline__ float bfhi(unsigned w) { return __uint_as_float(w & 0xffff0000u); }
__device__ __forceinline__ float bf1(bf16 b) { return __uint_as_float(((unsigned)b) << 16); }
#define UNPACK8(W_, V_) do { V_[0] = bflo((W_)[0]); V_[1] = bfhi((W_)[0]); V_[2] = bflo((W_)[1]); V_[3] = bfhi((W_)[1]); V_[4] = bflo((W_)[2]); V_[5] = bfhi((W_)[2]); V_[6] = bflo((W_)[3]); V_[7] = bfhi((W_)[3]); } while (0)
#define PACK8(V_) (v4u){pk2(V_[0], V_[1]), pk2(V_[2], V_[3]), pk2(V_[4], V_[5]), pk2(V_[6], V_[7])}
template <int CTRL> __device__ __forceinline__ float dpp_f(float v) { return __int_as_float(__builtin_amdgcn_update_dpp(0, __float_as_int(v), CTRL, 0xF, 0xF, false)); }
#define SUM8(x) do { x += dpp_f<0xB1>(x); x += dpp_f<0x4E>(x); x += dpp_f<0x141>(x); } while (0)
#define SUM16(x) do { SUM8(x); x += dpp_f<0x140>(x); } while (0)
__device__ __forceinline__ float wave_sum(float v) {
    SUM16(v);
    return __int_as_float(__builtin_amdgcn_readlane(__float_as_int(v), 0)) + __int_as_float(__builtin_amdgcn_readlane(__float_as_int(v), 16))
         + __int_as_float(__builtin_amdgcn_readlane(__float_as_int(v), 32)) + __int_as_float(__builtin_amdgcn_readlane(__float_as_int(v), 48));
}
#define LDS_WAIT() asm volatile("s_waitcnt lgkmcnt(0)" ::: "memory")

__device__ __forceinline__ int win_src(int d) {
    if (d < 2120) return d;
    if (d < 2792) return d + 512;
    if (d < 3816) return d + 1024;
    if (d < 3840) return -1;
    if (d < 4352) return d - 3840 + 2120;
    if (d < 4864) return d - 4352 + 3304;
    return d - 4864 + 4840;
}
template <bool REMAP>
__device__ __forceinline__ void transpose_item(const float* W, int K, int N, int Npad, bf16* WT, LAS float* scr, int item, int lane) {
    const int nblk = Npad / 32, kb = item / nblk, nb = item % nblk, k0 = 64 * kb, n0 = 32 * nb;
    const int n4 = 4 * (lane & 7);
    const int nn = REMAP ? win_src(n0 + n4) : n0 + n4; const bool ok = nn >= 0 && nn < N;
#pragma unroll
    for (int i = 0; i < 8; ++i) { const int kk = 8 * i + (lane >> 3);
        f32x4 v = (f32x4){0.f, 0.f, 0.f, 0.f}; if (ok) v = *(const f32x4*)(W + (size_t)(k0 + kk) * N + nn);
        LAS float* d = scr + kk * 33 + n4; d[0] = v[0]; d[1] = v[1]; d[2] = v[2]; d[3] = v[3]; }
    LDS_WAIT(); asm volatile("" ::: "memory");
    const int c = lane & 7;
#pragma unroll
    for (int j = 0; j < 4; ++j) { const int n = (lane >> 3) + 8 * j; const LAS float* s = scr + (8 * c) * 33 + n;
        v4u o; o.x = pk2(s[0 * 33], s[1 * 33]); o.y = pk2(s[2 * 33], s[3 * 33]); o.z = pk2(s[4 * 33], s[5 * 33]); o.w = pk2(s[6 * 33], s[7 * 33]);
        *(v4u*)(WT + (size_t)(n0 + n) * K + k0 + 8 * c) = o; }
    LDS_WAIT(); asm volatile("" ::: "memory");
}
__device__ __forceinline__ void rms_row_1024(const float* xrow, const float* g, bf16* orow, int lane) {
    const f32x4* xr = (const f32x4*)xrow + lane; const f32x4* gr = (const f32x4*)g + lane;
    f32x4 v[4]; float s = 0.f;
#pragma unroll
    for (int j = 0; j < 4; ++j) { v[j] = xr[64 * j]; s += (v[j].x * v[j].x + v[j].y * v[j].y) + (v[j].z * v[j].z + v[j].w * v[j].w); }
    const float rstd = __builtin_amdgcn_rsqf(wave_sum(s) * (1.f / 1024.f) + EPS);
    v2u* o8 = (v2u*)orow + lane;
#pragma unroll
    for (int j = 0; j < 4; ++j) { const f32x4 gg = gr[64 * j]; v2u w; w.x = pk2(v[j].x * rstd * gg.x, v[j].y * rstd * gg.y); w.y = pk2(v[j].z * rstd * gg.z, v[j].w * rstd * gg.w); o8[64 * j] = w; }
}

#define ROPE8(v, sub, c8, s8) do { _Pragma("unroll") for (int j_ = 0; j_ < 8; ++j_) { const float pv_ = dpp_f<0xB1>(v[j_]); \
        const float r0_ = v[j_] * c8[j_] - pv_ * s8[j_], r1_ = v[j_] * c8[j_] + pv_ * s8[j_]; v[j_] = (sub) == 0 ? r0_ : ((sub) == 1 ? r1_ : v[j_]); } } while (0)

__device__ __forceinline__ void post1_row(const bf16* Prow, bf16* Orow, const float* ra, const float (&ga)[8], const float (&gk)[8], const float (&gq)[8], const float (&gc)[8], const float (&gm)[8], float* WIrow, int lane) {
    const int sub = lane & 7;
    const v4u z4 = (v4u){0u, 0u, 0u, 0u};
    const v4u w_qa = *(const v4u*)(Prow + C_QA + 8 * lane);
    const v4u w_ka = *(const v4u*)(Prow + C_KA + 8 * lane);
    const v4u w_qi = *(const v4u*)(Prow + C_QI + 8 * lane);
    const v4u w_qm = *(const v4u*)(Prow + C_QM + 8 * lane);
    v4u w_ki = z4, w_cq = z4, w_ckv = z4; float w_wi = 0.f;
    if (lane < 8) { w_ki = *(const v4u*)(Prow + C_KI + 8 * lane); w_wi = bf1(Prow[C_WI + lane]); }
    if (lane < 48) w_cq = *(const v4u*)(Prow + C_CQ + 8 * lane);
    if (lane < 32) w_ckv = *(const v4u*)(Prow + C_CKV + 8 * lane);
    float c8[8], s8[8];
    { const f32x4 r0 = *(const f32x4*)(ra), r1 = *(const f32x4*)(ra + 4), r2 = *(const f32x4*)(ra + 8), r3 = *(const f32x4*)(ra + 12);
      c8[0] = r0[0]; c8[1] = r0[1]; c8[2] = r0[2]; c8[3] = r0[3]; c8[4] = r1[0]; c8[5] = r1[1]; c8[6] = r1[2]; c8[7] = r1[3];
      s8[0] = r2[0]; s8[1] = r2[1]; s8[2] = r2[2]; s8[3] = r2[3]; s8[4] = r3[0]; s8[5] = r3[1]; s8[6] = r3[2]; s8[7] = r3[3]; }
    { float v[8]; UNPACK8(w_qa, v); float ss = 0.f;
#pragma unroll
      for (int j = 0; j < 8; ++j) ss += v[j] * v[j];
      SUM8(ss);
      const float rstd = __builtin_amdgcn_rsqf(ss * (1.f / 64.f) + EPS);
#pragma unroll
      for (int j = 0; j < 8; ++j) v[j] = v[j] * rstd * ga[j];
      ROPE8(v, sub, c8, s8);
#pragma unroll
      for (int j = 0; j < 8; ++j) v[j] *= SCALE_A;
      *(v4u*)(Orow + C_QA + 8 * lane) = PACK8(v); }
    { float v[8]; UNPACK8(w_ka, v); float ss = 0.f;
#pragma unroll
      for (int j = 0; j < 8; ++j) ss += v[j] * v[j];
      SUM8(ss);
      const float rstd = __builtin_amdgcn_rsqf(ss * (1.f / 64.f) + EPS);
#pragma unroll
      for (int j = 0; j < 8; ++j) v[j] = v[j] * rstd * gk[j];
      ROPE8(v, sub, c8, s8);
      *(v4u*)(Orow + C_KA + 8 * lane) = PACK8(v); }
    { float v[8]; UNPACK8(w_qi, v);
      ROPE8(v, sub, c8, s8);
      *(v4u*)(Orow + C_QI + 8 * lane) = PACK8(v); }
    { float v[8]; UNPACK8(w_ki, v);
      ROPE8(v, sub, c8, s8);
      if (lane < 8) *(v4u*)(Orow + C_KI + 8 * lane) = PACK8(v); }
    if (lane < 8) WIrow[lane] = w_wi * SCALE_I;
    { float v[8]; UNPACK8(w_cq, v); float ss = 0.f;
#pragma unroll
      for (int j = 0; j < 8; ++j) ss += v[j] * v[j];
      ss = wave_sum(ss); const float rstd = __builtin_amdgcn_rsqf(ss * (1.f / 384.f) + EPS);
      if (lane < 48) {
#pragma unroll
          for (int j = 0; j < 8; ++j) v[j] = v[j] * rstd * gq[j];
          *(v4u*)(Orow + C_CQ + 8 * lane) = PACK8(v); } }
    { float v[8]; UNPACK8(w_ckv, v); float ss = 0.f;
#pragma unroll
      for (int j = 0; j < 8; ++j) ss += v[j] * v[j];
      ss = wave_sum(ss); const float rstd = __builtin_amdgcn_rsqf(ss * (1.f / 256.f) + EPS);
      if (lane < 32) {
#pragma unroll
          for (int j = 0; j < 8; ++j) v[j] = v[j] * rstd * gc[j];
          *(v4u*)(Orow + C_CKV + 8 * lane) = PACK8(v); } }
    { float v[8]; UNPACK8(w_qm, v); float ss = 0.f;
#pragma unroll
      for (int j = 0; j < 8; ++j) ss += v[j] * v[j];
      SUM16(ss);
      const float rstd = __builtin_amdgcn_rsqf(ss * (1.f / 128.f) + EPS);
#pragma unroll
      for (int j = 0; j < 8; ++j) v[j] = v[j] * rstd * gm[j] * SCALE_M;
      *(v4u*)(Orow + C_QM + 8 * lane) = PACK8(v); }
}

__device__ __forceinline__ void km_row(bf16* row, const float* gkm, int lane) {
    v4u w = *(const v4u*)(row + 8 * lane); float v[8]; UNPACK8(w, v); float ss = 0.f;
#pragma unroll
    for (int j = 0; j < 8; ++j) ss += v[j] * v[j];
    SUM16(ss);
    const float rstd = __builtin_amdgcn_rsqf(ss * (1.f / 128.f) + EPS);
#pragma unroll
    for (int j = 0; j < 8; ++j) v[j] = v[j] * rstd * gkm[8 * (lane & 15) + j];
    *(v4u*)(row + 8 * lane) = PACK8(v);
}

__device__ __forceinline__ void transpose_v(const bf16* src, int pitch, int col0, int hstride, int H, int DV, int S, int nb, bf16* dst, int gw, int NGW, int lane) {
    const int ndq = DV / 64, nsc = S / 64, ntask = nb * H * nsc * ndq;
    for (int task = gw; task < ntask; task += NGW) {
        int x = task; const int dq = x % ndq; x /= ndq; const int sc = x % nsc; x /= nsc; const int h = x % H; const int b = x / H;
        const int s = sc * 64 + lane;
        const bf16* srow = src + (size_t)(b * S + s) * pitch + col0 + h * hstride + dq * 64;
        bf16* drow = dst + ((size_t)((b * H + h) * DV + dq * 64)) * S + s;
        v4u wv[8];
#pragma unroll
        for (int c = 0; c < 8; ++c) wv[c] = *(const v4u*)(srow + 8 * c);
#pragma unroll
        for (int c = 0; c < 8; ++c) { const v4u w = wv[c];
            drow[(size_t)(8 * c + 0) * S] = (bf16)(w.x & 0xffffu); drow[(size_t)(8 * c + 1) * S] = (bf16)(w.x >> 16);
            drow[(size_t)(8 * c + 2) * S] = (bf16)(w.y & 0xffffu); drow[(size_t)(8 * c + 3) * S] = (bf16)(w.y >> 16);
            drow[(size_t)(8 * c + 4) * S] = (bf16)(w.z & 0xffffu); drow[(size_t)(8 * c + 5) * S] = (bf16)(w.z >> 16);
            drow[(size_t)(8 * c + 6) * S] = (bf16)(w.w & 0xffffu); drow[(size_t)(8 * c + 7) * S] = (bf16)(w.w >> 16); }
    }
}

__device__ __forceinline__ void post2_row(const bf16* QBrow, bf16* QOrow, const bf16* KVBrow, const bf16* Prow, bf16* KBrow, const float* rb, const float (&gqv)[12], const float (&gkv)[12], LAS float* scr, int lane) {
    const int hd = lane >> 3, d0 = 12 * (lane & 7);
    float vq[12], vk[12], cc[12], sn[12];
    { const v2u* p = (const v2u*)(QBrow + 12 * lane);
      const v2u w0 = p[0], w1 = p[1], w2 = p[2];
      bf16 kr[12];
#pragma unroll
      for (int e = 0; e < 12; ++e) { const int d = d0 + e; kr[e] = d < 64 ? KVBrow[hd * 128 + d] : Prow[C_KR + d - 64]; }
#pragma unroll
      for (int e = 0; e < 12; ++e) { const int d = d0 + e; const int i = (d - 64) & 15; cc[e] = d < 64 ? 1.f : rb[i]; sn[e] = d < 64 ? 0.f : rb[16 + i]; }
      vq[0] = bflo(w0.x); vq[1] = bfhi(w0.x); vq[2] = bflo(w0.y); vq[3] = bfhi(w0.y); vq[4] = bflo(w1.x); vq[5] = bfhi(w1.x); vq[6] = bflo(w1.y); vq[7] = bfhi(w1.y);
      vq[8] = bflo(w2.x); vq[9] = bfhi(w2.x); vq[10] = bflo(w2.y); vq[11] = bfhi(w2.y);
#pragma unroll
      for (int e = 0; e < 12; ++e) vk[e] = bf1(kr[e]); }
    float sq = 0.f, sk = 0.f;
#pragma unroll
    for (int e = 0; e < 12; ++e) { sq += vq[e] * vq[e]; sk += vk[e] * vk[e]; }
    SUM8(sq); SUM8(sk);
    const float rq = __builtin_amdgcn_rsqf(sq * (1.f / 96.f) + EPS), rk = __builtin_amdgcn_rsqf(sk * (1.f / 96.f) + EPS);
#pragma unroll
    for (int e = 0; e < 12; ++e) { vq[e] = vq[e] * rq * gqv[e]; vk[e] = vk[e] * rk * gkv[e]; scr[12 * lane + e] = vq[e]; scr[768 + 12 * lane + e] = vk[e]; }
    LDS_WAIT(); asm volatile("" ::: "memory");
    float oq[12], ok[12];
#pragma unroll
    for (int e = 0; e < 12; ++e) { const int d = d0 + e;
        if (d < 64) { oq[e] = vq[e]; ok[e] = vk[e]; }
        else { const bool first = d < 80; const int off = first ? 16 : -16; const float pq = scr[12 * lane + e + off], pk = scr[768 + 12 * lane + e + off];
               oq[e] = first ? vq[e] * cc[e] - pq * sn[e] : vq[e] * cc[e] + pq * sn[e];
               ok[e] = first ? vk[e] * cc[e] - pk * sn[e] : vk[e] * cc[e] + pk * sn[e]; }
        oq[e] *= SCALE_B; }
    LDS_WAIT(); asm volatile("" ::: "memory");
    v2u* q = (v2u*)(QOrow + 12 * lane); v2u* k = (v2u*)(KBrow + 12 * lane);
#pragma unroll
    for (int i = 0; i < 3; ++i) { v2u w; w.x = pk2(oq[4 * i], oq[4 * i + 1]); w.y = pk2(oq[4 * i + 2], oq[4 * i + 3]); q[i] = w;
                                  v2u u; u.x = pk2(ok[4 * i], ok[4 * i + 1]); u.y = pk2(ok[4 * i + 2], ok[4 * i + 3]); k[i] = u; }
}

__device__ __forceinline__ int next_unit(unsigned* ctr, volatile LAS int* slot) {
    __syncthreads();
    if (threadIdx.x == 0) *slot = (int)atomicAdd(ctr, 1u);
    __syncthreads();
    return *slot;
}

constexpr int SCP = 2112;
__device__ __forceinline__ unsigned ord_key(float v) { const unsigned b = __float_as_uint(v); return b ^ ((unsigned)((int)b >> 31) | 0x80000000u); }
__device__ __forceinline__ void indexer_load_q(const bf16* P, const float* WI, int u, bf16x8 (&qf)[8][2], float (&wq)[8]) {
    const int lane = threadIdx.x & 63, n = lane & 15, g = lane >> 4;
    const int tb = 127 - (u >> 3), bb = u & 7;
    const size_t row = (size_t)(bb * SEQ + tb * 16 + n);
    const bf16* qrow = P + row * PP + C_QI + 8 * g;
#pragma unroll
    for (int h = 0; h < 8; ++h) { qf[h][0] = *(const bf16x8*)(qrow + h * 64); qf[h][1] = *(const bf16x8*)(qrow + h * 64 + 32); wq[h] = WI[row * 8 + h]; }
}
__device__ __forceinline__ void indexer_unit(LAS float* sc, const bf16* P, const float* WI, unsigned* MASK, int bb, int tb, bf16x8 (&qf)[8][2], float (&wq)[8],
                                             int tk, volatile LAS int* slot, int nunits, int& un) {
    int tid_ = threadIdx.x; asm volatile("" : "+v"(tid_));
    const int tid = tid_, lane = tid & 63, w = __builtin_amdgcn_readfirstlane(tid >> 6);
    const int n = lane & 15, g = lane >> 4;
    const int rowbase = bb * SEQ, t0 = tb * 16;
    {
        const int ntile = tb + 1;
        const int nmine = (ntile - w + 7) >> 3;
        const int ngrp = (nmine + 3) >> 2;
        const bf16* kbase = P + (size_t)(rowbase + n) * PP + C_KI + 8 * g;
        bf16x8 kb[2][4][2];
#define IDX_LOAD(BUF, GRP) do { _Pragma("unroll") for (int j_ = 0; j_ < 4; ++j_) { const int tile_ = w + 8 * (4 * (GRP) + j_); const int tl_ = tile_ < ntile ? tile_ : 0; \
            const bf16* kr_ = kbase + (size_t)(16 * tl_) * PP; kb[BUF][j_][0] = *(const bf16x8*)(kr_); kb[BUF][j_][1] = *(const bf16x8*)(kr_ + 32); } } while (0)
#define IDX_COMP(BUF, GRP) do { _Pragma("unroll") for (int j_ = 0; j_ < 4; ++j_) { const int tile_ = w + 8 * (4 * (GRP) + j_); if (tile_ < ntile) { \
            f32x4 idx_ = (f32x4){0.f, 0.f, 0.f, 0.f}; \
            _Pragma("unroll") for (int h_ = 0; h_ < 8; ++h_) { f32x4 a_ = (f32x4){0.f, 0.f, 0.f, 0.f}; \
                a_ = __builtin_amdgcn_mfma_f32_16x16x32_bf16(kb[BUF][j_][0], qf[h_][0], a_, 0, 0, 0); \
                a_ = __builtin_amdgcn_mfma_f32_16x16x32_bf16(kb[BUF][j_][1], qf[h_][1], a_, 0, 0, 0); \
                _Pragma("unroll") for (int i_ = 0; i_ < 4; ++i_) idx_[i_] = __builtin_fmaf(wq[h_], __builtin_fmaxf(a_[i_], 0.f), idx_[i_]); } \
            { const int k0_ = 16 * tile_ + 4 * g; LAS float* d_ = sc + n * SCP + k0_ + (k0_ >> 5); d_[0] = idx_[0]; d_[1] = idx_[1]; d_[2] = idx_[2]; d_[3] = idx_[3]; } } } } while (0)
        if (ngrp > 0) IDX_LOAD(0, 0);
        for (int gp = 0; gp < ngrp; gp += 2) {
            if (gp + 1 < ngrp) IDX_LOAD(1, gp + 1);
            IDX_COMP(0, gp);
            if (gp + 1 < ngrp) { if (gp + 2 < ngrp) IDX_LOAD(0, gp + 2); IDX_COMP(1, gp + 1); }
        }
#undef IDX_LOAD
#undef IDX_COMP
    }
    if (tid == 0) *slot = tk;
    __syncthreads();
    un = *slot;
    if (un < nunits) indexer_load_q(P, WI, un, qf, wq);
    for (int rs = 0; rs < REP_SEL; ++rs) {
        const int ta = t0 + 2 * w, tb2 = ta + 1;
        unsigned* mra = MASK + (size_t)(rowbase + ta) * 64; unsigned* mrb = mra + 64;
        const int nva = ta - 32 * lane + 1, nvb = nva + 1;
        const unsigned valid_a = nva >= 32 ? 0xffffffffu : (nva <= 0 ? 0u : ((1u << nva) - 1u));
        const unsigned valid_b = nvb >= 32 ? 0xffffffffu : (nvb <= 0 ? 0u : ((1u << nvb) - 1u));
        if (ta < 256) { mra[lane] = valid_a; mrb[lane] = valid_b; continue; }
        unsigned ua[32], ub[32];
        { const LAS float* sra = sc + (2 * w) * SCP + 33 * lane; const LAS float* srb = sra + SCP;
#pragma unroll
          for (int r = 0; r < 32; ++r) { const float va = sra[r], vb = srb[r]; ua[r] = ((valid_a >> r) & 1u) ? ord_key(va) : 0u; ub[r] = ((valid_b >> r) & 1u) ? ord_key(vb) : 0u; } }
#pragma unroll
        for (int k = 0; k < 16; ++k) {
            const unsigned a0 = ua[k], a1 = ua[k + 16]; ua[k] = __builtin_amdgcn_perm(a1, a0, 0x05040100u); ua[k + 16] = __builtin_amdgcn_perm(a1, a0, 0x07060302u);
            const unsigned b0 = ub[k], b1 = ub[k + 16]; ub[k] = __builtin_amdgcn_perm(b1, b0, 0x05040100u); ub[k + 16] = __builtin_amdgcn_perm(b1, b0, 0x07060302u); }
#pragma unroll
        for (int k = 0; k < 32; ++k) if (!(k & 8)) {
            const unsigned a0 = ua[k], a1 = ua[k + 8]; ua[k] = __builtin_amdgcn_perm(a1, a0, 0x06020400u); ua[k + 8] = __builtin_amdgcn_perm(a1, a0, 0x07030501u);
            const unsigned b0 = ub[k], b1 = ub[k + 8]; ub[k] = __builtin_amdgcn_perm(b1, b0, 0x06020400u); ub[k + 8] = __builtin_amdgcn_perm(b1, b0, 0x07030501u); }
#pragma unroll
        for (int si = 2; si < 5; ++si) { const int sft = 16 >> si;
            const unsigned msk = si == 2 ? 0x0f0f0f0fu : (si == 3 ? 0x33333333u : 0x55555555u);
#pragma unroll
            for (int k = 0; k < 32; ++k) if (!(k & sft)) {
                const unsigned a0 = ua[k], a1 = ua[k + sft]; ua[k] = (a0 & msk) | ((a1 << sft) & ~msk); ua[k + sft] = ((a0 >> sft) & msk) | (a1 & ~msk);
                const unsigned b0 = ub[k], b1 = ub[k + sft]; ub[k] = (b0 & msk) | ((b1 << sft) & ~msk); ub[k + sft] = ((b0 >> sft) & msk) | (b1 & ~msk); } }
        unsigned alive_a = valid_a, sel_a = 0u, alive_b = valid_b, sel_b = 0u; int need_a = 256, need_b = 256; bool run_a = true, run_b = true;
#pragma unroll
        for (int j = 31; j >= 0; --j) {
            const unsigned ones_a = alive_a & ua[j], ones_b = alive_b & ub[j];
            int v = (int)((unsigned)__popc(ones_a) | ((unsigned)__popc(ones_b) << 16));
            v += __builtin_amdgcn_update_dpp(0, v, 0xB1, 0xF, 0xF, false);
            v += __builtin_amdgcn_update_dpp(0, v, 0x4E, 0xF, 0xF, false);
            v += __builtin_amdgcn_update_dpp(0, v, 0x141, 0xF, 0xF, false);
            v += __builtin_amdgcn_update_dpp(0, v, 0x140, 0xF, 0xF, false);
            const unsigned tot = (unsigned)(__builtin_amdgcn_readlane(v, 0) + __builtin_amdgcn_readlane(v, 16) + __builtin_amdgcn_readlane(v, 32) + __builtin_amdgcn_readlane(v, 48));
            const int ca = (int)(tot & 0xffffu), cb = (int)(tot >> 16);
            if (run_a) { if (ca >= need_a) { alive_a = ones_a; if (ca == need_a) { sel_a |= ones_a; need_a = 0; run_a = false; } }
                         else { need_a -= ca; sel_a |= ones_a; alive_a &= ~ua[j]; } }
            if (run_b) { if (cb >= need_b) { alive_b = ones_b; if (cb == need_b) { sel_b |= ones_b; need_b = 0; run_b = false; } }
                         else { need_b -= cb; sel_b |= ones_b; alive_b &= ~ub[j]; } }
            if (!run_a && !run_b) break;
        }
        if (need_a > 0) {
            const int cnt = __popc(alive_a); int inc = cnt;
#pragma unroll
            for (int d = 1; d < 64; d <<= 1) { const int o = __shfl_up(inc, d); if (lane >= d) inc += o; }
            int k = need_a - (inc - cnt); k = k < 0 ? 0 : (k > cnt ? cnt : k);
            unsigned m = alive_a;
            for (int i = 0; i < k; ++i) { const unsigned low = m & (0u - m); sel_a |= low; m ^= low; }
        }
        if (need_b > 0) {
            const int cnt = __popc(alive_b); int inc = cnt;
#pragma unroll
            for (int d = 1; d < 64; d <<= 1) { const int o = __shfl_up(inc, d); if (lane >= d) inc += o; }
            int k = need_b - (inc - cnt); k = k < 0 ? 0 : (k > cnt ? cnt : k);
            unsigned m = alive_b;
            for (int i = 0; i < k; ++i) { const unsigned low = m & (0u - m); sel_b |= low; m ^= low; }
        }
        mra[lane] = sel_a; mrb[lane] = sel_b;
        (void)tb2;
    }
    __syncthreads();
}

__device__ __forceinline__ float half_max(float m) { auto rr = __builtin_amdgcn_permlane32_swap(__float_as_uint(m), __float_as_uint(m), false, false); return __builtin_fmaxf(__uint_as_float(rr[0]), __uint_as_float(rr[1])); }
__device__ __forceinline__ float half_sum(float m) { auto rr = __builtin_amdgcn_permlane32_swap(__float_as_uint(m), __float_as_uint(m), false, false); return __uint_as_float(rr[0]) + __uint_as_float(rr[1]); }
__device__ __forceinline__ int crow(int r, int hi) { return (r & 3) + 8 * (r >> 2) + 4 * hi; }
template <int DQK, int DV, int MODE, int STRIP = 0>
__device__ __forceinline__ void attn_unit(LAS unsigned char* lds, const bf16* Qb, int qpitch, const bf16* Kb, int kpitch, const bf16* VTb, int skv,
                                          const unsigned* maskb, const bf16* Zb, bf16* Ob, int q0) {
    constexpr int TK = 128, KP = DQK + 8, VP = TK + 8;
    LAS bf16* Ks = (LAS bf16*)lds; LAS bf16* Vs = Ks + TK * KP;
    constexpr int CPR = DQK / 8;
    constexpr int NCK = TK * CPR, NCV = DV * (TK / 8);
    constexpr int RK = (NCK + 511) / 512, RV = (NCV + 511) / 512;
    constexpr int NKS = DQK / 16, NMT = DV / 32;
    int tid_ = threadIdx.x; asm volatile("" : "+v"(tid_));
    const int tid = tid_, lane = tid & 63, w = __builtin_amdgcn_readfirstlane(tid >> 6), r = lane & 31, hh = lane >> 5;
    const int NT = MODE == 0 ? skv / TK : (q0 + 256) / TK;
    const int qlo = q0 + 32 * w;
    bf16x8 qf[NKS];
    { const bf16* qrow = Qb + (size_t)(qlo + r) * qpitch + 8 * hh;
#pragma unroll
      for (int ks = 0; ks < NKS; ++ks) qf[ks] = *(const bf16x8*)(qrow + 16 * ks); }
    f32x16 o[NMT];
#pragma unroll
    for (int mt = 0; mt < NMT; ++mt)
#pragma unroll
        for (int i = 0; i < 16; ++i) o[mt][i] = 0.f;
    float m_run = NEGF, l_run = 0.f;
    v4u kreg[RK], vreg[RV];
#define ATT_PREFETCH(tile_) do { \
        _Pragma("unroll") for (int i_ = 0; i_ < RK; ++i_) { const int c_ = tid + 512 * i_; if (c_ < NCK) { const int row_ = c_ / CPR, cc_ = c_ % CPR; kreg[i_] = *(const v4u*)(Kb + (size_t)(TK * (tile_) + row_) * kpitch + 8 * cc_); } } \
        _Pragma("unroll") for (int i_ = 0; i_ < RV; ++i_) { const int c_ = tid + 512 * i_; if (c_ < NCV) { const int d_ = c_ >> 4, cc_ = c_ & 15; vreg[i_] = *(const v4u*)(VTb + (size_t)d_ * skv + TK * (tile_) + 8 * cc_); } } } while (0)
    if (STRIP != 2) ATT_PREFETCH(0);
    for (int tile = 0; tile < NT; ++tile) {
        __syncthreads();
        if (STRIP != 2) {
#pragma unroll
        for (int i = 0; i < RK; ++i) { const int c = tid + 512 * i; if (c < NCK) { const int row = c / CPR, cc = c % CPR; *(LAS v4u*)(Ks + row * KP + 8 * cc) = kreg[i]; } }
#pragma unroll
        for (int i = 0; i < RV; ++i) { const int c = tid + 512 * i; if (c < NCV) { const int d = c >> 4, cc = c & 15; *(LAS v4u*)(Vs + d * VP + 8 * cc) = vreg[i]; } }
        }
        __syncthreads();
        if (STRIP != 2 && tile + 1 < NT) ATT_PREFETCH(tile + 1);
        __builtin_amdgcn_sched_barrier(0);
        if (STRIP == 1) continue;
#pragma unroll 1
        for (int sub = 0; sub < 2; ++sub) {
        const int t64 = 2 * tile + sub;
        if (MODE != 0 && 64 * t64 > qlo + 31) continue;
        const LAS bf16* Kc = Ks + 64 * sub * KP; const LAS bf16* Vc = Vs + 64 * sub;
        unsigned mw0 = 0u, mw1 = 0u;
        if (MODE == 2) { const v2u mm = *(const v2u*)(maskb + (size_t)(qlo + r) * 64 + 2 * t64); mw0 = mm.x >> (4 * hh); mw1 = mm.y >> (4 * hh); }
        f32x16 s0, s1;
#pragma unroll
        for (int i = 0; i < 16; ++i) { s0[i] = 0.f; s1[i] = 0.f; }
#pragma unroll
        for (int ks = 0; ks < NKS; ++ks) {
            const bf16x8 a0 = *(const LAS bf16x8*)(Kc + r * KP + 16 * ks + 8 * hh);
            const bf16x8 a1 = *(const LAS bf16x8*)(Kc + (32 + r) * KP + 16 * ks + 8 * hh);
            s0 = __builtin_amdgcn_mfma_f32_32x32x16_bf16(a0, qf[ks], s0, 0, 0, 0);
            s1 = __builtin_amdgcn_mfma_f32_32x32x16_bf16(a1, qf[ks], s1, 0, 0, 0);
        }
        if (MODE == 1) {
            if (64 * t64 + 63 > qlo) { const int qg = qlo + r;
#pragma unroll
                for (int i = 0; i < 16; ++i) { const int key = 64 * t64 + crow(i, hh); if (key > qg) s0[i] = NEGF; if (key + 32 > qg) s1[i] = NEGF; } }
        }
        if (MODE == 2) {
#pragma unroll
            for (int i = 0; i < 16; ++i) { const int bit = (i & 3) + 8 * (i >> 2); if (!((mw0 >> bit) & 1u)) s0[i] = NEGF; if (!((mw1 >> bit) & 1u)) s1[i] = NEGF; }
        }
        float mx = s0[0];
#pragma unroll
        for (int i = 1; i < 16; ++i) mx = __builtin_fmaxf(mx, s0[i]);
#pragma unroll
        for (int i = 0; i < 16; ++i) mx = __builtin_fmaxf(mx, s1[i]);
        mx = half_max(mx);
        const float m_new = __builtin_fmaxf(m_run, mx);
        const float alpha = __builtin_amdgcn_exp2f(m_run - m_new);
        m_run = m_new;
        float ls = 0.f;
#pragma unroll
        for (int i = 0; i < 16; ++i) { s0[i] = __builtin_amdgcn_exp2f(s0[i] - m_new); s1[i] = __builtin_amdgcn_exp2f(s1[i] - m_new); ls += s0[i] + s1[i]; }
        l_run = l_run * alpha + ls;
#pragma unroll
        for (int mt = 0; mt < NMT; ++mt)
#pragma unroll
            for (int i = 0; i < 16; ++i) o[mt][i] *= alpha;
        v4u pf[2][2];
#pragma unroll
        for (int s = 0; s < 2; ++s) {
            pf[0][s] = (v4u){pk2(s0[8 * s], s0[8 * s + 1]), pk2(s0[8 * s + 2], s0[8 * s + 3]), pk2(s0[8 * s + 4], s0[8 * s + 5]), pk2(s0[8 * s + 6], s0[8 * s + 7])};
            pf[1][s] = (v4u){pk2(s1[8 * s], s1[8 * s + 1]), pk2(s1[8 * s + 2], s1[8 * s + 3]), pk2(s1[8 * s + 4], s1[8 * s + 5]), pk2(s1[8 * s + 6], s1[8 * s + 7])};
        }
#pragma unroll
        for (int mt = 0; mt < NMT; ++mt)
#pragma unroll
            for (int p = 0; p < 2; ++p)
#pragma unroll
                for (int s = 0; s < 2; ++s) {
                    const LAS bf16* vp = Vc + (32 * mt + r) * VP + 32 * p + 16 * s + 4 * hh;
                    const s16x4 lo = *(const LAS s16x4*)(vp), hi = *(const LAS s16x4*)(vp + 8);
                    const bf16x8 a = (bf16x8){lo[0], lo[1], lo[2], lo[3], hi[0], hi[1], hi[2], hi[3]};
                    o[mt] = __builtin_amdgcn_mfma_f32_32x32x16_bf16(a, __builtin_bit_cast(bf16x8, pf[p][s]), o[mt], 0, 0, 0);
                }
        }
    }
#undef ATT_PREFETCH
    const float l_tot = half_sum(l_run);
    const float inv = 1.0f / l_tot;
    const size_t row = (size_t)(qlo + r);
#pragma unroll
    for (int mt = 0; mt < NMT; ++mt)
#pragma unroll
        for (int g4 = 0; g4 < 4; ++g4) {
            const int d = 32 * mt + 8 * g4 + 4 * hh;
            float ov[4];
#pragma unroll
            for (int i = 0; i < 4; ++i) ov[i] = o[mt][4 * g4 + i] * inv;
            if (Zb) { const v2u zw = *(const v2u*)(Zb + row * PP + d); const float z[4] = {bflo(zw.x), bfhi(zw.x), bflo(zw.y), bfhi(zw.y)};
#pragma unroll
                for (int i = 0; i < 4; ++i) ov[i] *= z[i] * __builtin_amdgcn_rcpf(1.0f + __expf(-z[i])); }
            v2u ow; ow.x = pk2(ov[0], ov[1]); ow.y = pk2(ov[2], ov[3]);
            *(v2u*)(Ob + row * PP + d) = ow;
        }
}

template <int DQK, int MODE>
__device__ __forceinline__ void attn_unit_pipe(LAS unsigned char* lds, const bf16* Qb, int qpitch, const bf16* Kb, int kpitch, const bf16* VTb, int skv,
                                               const unsigned* maskb, bf16* Ob, int q0) {
    constexpr int DV = 64, KP = DQK + 8, VP = 72, BUFE = 64 * KP + DV * VP;
    constexpr int CPR = DQK / 8, NCK = 64 * CPR, NCV = DV * 8, RK = (NCK + 511) / 512, RV = (NCV + 511) / 512, NKS = DQK / 16, NMT = DV / 32;
    static_assert(NCV == 512 && (NCK == 512 || NCK == 768), "staging map");
    int tid_ = threadIdx.x; asm volatile("" : "+v"(tid_));
    const int tid = tid_, lane = tid & 63, w = __builtin_amdgcn_readfirstlane(tid >> 6), r = lane & 31, hh = lane >> 5;
    const int NT = (q0 + 256) / 64;
    const int qlo = q0 + 32 * w;
    const int NTw = ((qlo + 31) >> 6) + 1;
    int krow[RK], kcc[RK];
#pragma unroll
    for (int i = 0; i < RK; ++i) { int c = tid + 512 * i; if (c >= NCK) c -= 256; krow[i] = c / CPR; kcc[i] = c % CPR; }
    const int vd = tid >> 3, vcc = tid & 7;
    bf16x8 qf[NKS];
    { const bf16* qrow = Qb + (size_t)(qlo + r) * qpitch + 8 * hh;
#pragma unroll
      for (int ks = 0; ks < NKS; ++ks) qf[ks] = *(const bf16x8*)(qrow + 16 * ks); }
    f32x16 o[NMT];
#pragma unroll
    for (int mt = 0; mt < NMT; ++mt)
#pragma unroll
        for (int i = 0; i < 16; ++i) o[mt][i] = 0.f;
    float m_run = NEGF, l_run = 0.f, alpha = 1.f;
    v4u kreg[2][RK], vreg[2][RV]; v2u mset[2];
    const unsigned* mrowp = MODE == 2 ? maskb + (size_t)(qlo + r) * 64 : nullptr;
#define PL_LOAD(S_, tile_) do { const int tl_ = (tile_) < NT ? (tile_) : NT - 1; \
        if (MODE == 2) { const int mt_ = (tile_) >= 2 ? ((tile_) - 2 < 32 ? (tile_) - 2 : 31) : 0; mset[S_] = *(const v2u*)(mrowp + 2 * mt_); }     \
        _Pragma("unroll") for (int i_ = 0; i_ < RK; ++i_) kreg[S_][i_] = *(const v4u*)(Kb + (size_t)(64 * tl_ + krow[i_]) * kpitch + 8 * kcc[i_]); \
        vreg[S_][0] = *(const v4u*)(VTb + (size_t)vd * skv + 64 * tl_ + 8 * vcc); } while (0)
#define PL_STAGE(S_, buf_) do { LAS bf16* Kd_ = (LAS bf16*)lds + (buf_) * BUFE; LAS bf16* Vd_ = Kd_ + 64 * KP; \
        _Pragma("unroll") for (int i_ = 0; i_ < RK; ++i_) *(LAS v4u*)(Kd_ + krow[i_] * KP + 8 * kcc[i_]) = kreg[S_][i_]; \
        *(LAS v4u*)(Vd_ + vd * VP + 8 * vcc) = vreg[S_][0]; } while (0)
#define PL_QK(t_, D0_, D1_) do { const LAS bf16* Kc_ = (const LAS bf16*)lds + ((t_) & 3) * BUFE; \
        _Pragma("unroll") for (int i_ = 0; i_ < 16; ++i_) { D0_[i_] = 0.f; D1_[i_] = 0.f; } \
        _Pragma("unroll") for (int ks_ = 0; ks_ < NKS; ++ks_) { \
            const bf16x8 a0_ = *(const LAS bf16x8*)(Kc_ + r * KP + 16 * ks_ + 8 * hh); const bf16x8 a1_ = *(const LAS bf16x8*)(Kc_ + (32 + r) * KP + 16 * ks_ + 8 * hh); \
            D0_ = __builtin_amdgcn_mfma_f32_32x32x16_bf16(a0_, qf[ks_], D0_, 0, 0, 0); D1_ = __builtin_amdgcn_mfma_f32_32x32x16_bf16(a1_, qf[ks_], D1_, 0, 0, 0); } } while (0)
#define PL_PV(t_) do { const LAS bf16* Vc_ = (const LAS bf16*)lds + ((t_) & 3) * BUFE + 64 * KP; \
        _Pragma("unroll") for (int mt_ = 0; mt_ < NMT; ++mt_) _Pragma("unroll") for (int i_ = 0; i_ < 16; ++i_) o[mt_][i_] *= alpha; \
        _Pragma("unroll") for (int mt_ = 0; mt_ < NMT; ++mt_) _Pragma("unroll") for (int p_ = 0; p_ < 2; ++p_) _Pragma("unroll") for (int s_ = 0; s_ < 2; ++s_) { \
            const LAS bf16* vp_ = Vc_ + (32 * mt_ + r) * VP + 32 * p_ + 16 * s_ + 4 * hh; \
            const s16x4 lo_ = *(const LAS s16x4*)(vp_), hi_ = *(const LAS s16x4*)(vp_ + 8); \
            const bf16x8 a_ = (bf16x8){lo_[0], lo_[1], lo_[2], lo_[3], hi_[0], hi_[1], hi_[2], hi_[3]}; \
            o[mt_] = __builtin_amdgcn_mfma_f32_32x32x16_bf16(a_, __builtin_bit_cast(bf16x8, pf[p_][s_]), o[mt_], 0, 0, 0); } } while (0)
#define PL_SOFTMAX(t_, C0_, C1_, MK_, CAUSAL_) do { \
        if (MODE == 2) { const unsigned w0_ = (MK_).x >> (4 * hh), w1_ = (MK_).y >> (4 * hh); \
            _Pragma("unroll") for (int i_ = 0; i_ < 16; ++i_) { const int bit_ = (i_ & 3) + 8 * (i_ >> 2); if (!((w0_ >> bit_) & 1u)) C0_[i_] = NEGF; if (!((w1_ >> bit_) & 1u)) C1_[i_] = NEGF; } } \
        if (CAUSAL_) { const int qg_ = qlo + r; \
            _Pragma("unroll") for (int i_ = 0; i_ < 16; ++i_) { const int key_ = 64 * (t_) + crow(i_, hh); if (key_ > qg_) C0_[i_] = NEGF; if (key_ + 32 > qg_) C1_[i_] = NEGF; } } \
        float mx_ = C0_[0]; \
        _Pragma("unroll") for (int i_ = 1; i_ < 16; ++i_) mx_ = __builtin_fmaxf(mx_, C0_[i_]); \
        _Pragma("unroll") for (int i_ = 0; i_ < 16; ++i_) mx_ = __builtin_fmaxf(mx_, C1_[i_]); \
        mx_ = half_max(mx_); \
        const float mn_ = __builtin_fmaxf(m_run, mx_); alpha = __builtin_amdgcn_exp2f(m_run - mn_); m_run = mn_; \
        float ls_ = 0.f; \
        _Pragma("unroll") for (int i_ = 0; i_ < 16; ++i_) { C0_[i_] = __builtin_amdgcn_exp2f(C0_[i_] - mn_); C1_[i_] = __builtin_amdgcn_exp2f(C1_[i_] - mn_); ls_ += C0_[i_] + C1_[i_]; } \
        l_run = l_run * alpha + ls_; \
        _Pragma("unroll") for (int s_ = 0; s_ < 2; ++s_) { \
            pf[0][s_] = (v4u){pk2(C0_[8 * s_], C0_[8 * s_ + 1]), pk2(C0_[8 * s_ + 2], C0_[8 * s_ + 3]), pk2(C0_[8 * s_ + 4], C0_[8 * s_ + 5]), pk2(C0_[8 * s_ + 6], C0_[8 * s_ + 7])}; \
            pf[1][s_] = (v4u){pk2(C1_[8 * s_], C1_[8 * s_ + 1]), pk2(C1_[8 * s_ + 2], C1_[8 * s_ + 3]), pk2(C1_[8 * s_ + 4], C1_[8 * s_ + 5]), pk2(C1_[8 * s_ + 6], C1_[8 * s_ + 7])}; } } while (0)
#define PL_IO(t_, S_) do { PL_STAGE(S_, ((t_) + 2) & 3); PL_LOAD(S_, (t_) + 4); } while (0)
#define PL_STEADY(t_, S_) do { const v2u mk_ = mset[S_]; PL_IO(t_, S_); if (MODE == 2) { asm volatile("" :: "v"(mk_.x), "v"(mk_.y)); } \
        PL_QK((t_) + 1, n0, n1); PL_PV((t_) - 1); PL_SOFTMAX(t_, c0, c1, mk_, false); c0 = n0; c1 = n1; __syncthreads(); } while (0)
#define PL_TAIL(t_, S_) do { const v2u mk_ = mset[S_]; PL_IO(t_, S_); if ((t_) >= 1) PL_PV((t_) - 1); PL_SOFTMAX(t_, c0, c1, mk_, MODE == 1); PL_PV(t_); __syncthreads(); } while (0)
    f32x16 c0, c1, n0, n1; v4u pf[2][2];
    PL_LOAD(0, 0); PL_LOAD(1, 1);
    PL_STAGE(0, 0); PL_STAGE(1, 1);
    PL_LOAD(0, 2); PL_LOAD(1, 3);
    __syncthreads();
    PL_QK(0, c0, c1);
    int t = 0;
    if (NTw >= 2) {
        { const v2u mk_ = mset[0]; PL_IO(0, 0); PL_QK(1, n0, n1); PL_SOFTMAX(0, c0, c1, mk_, false); c0 = n0; c1 = n1; __syncthreads(); }
        for (t = 1; t + 1 < NTw; ) {
            PL_STEADY(t, 1); ++t;
            if (t + 1 < NTw) { PL_STEADY(t, 0); ++t; }
        }
    }
    if (t & 1) PL_TAIL(t, 1); else PL_TAIL(t, 0);
    for (++t; t < NT; ++t) { if (t & 1) PL_IO(t, 1); else PL_IO(t, 0); __syncthreads(); }
#undef PL_LOAD
#undef PL_STAGE
#undef PL_QK
#undef PL_PV
#undef PL_SOFTMAX
#undef PL_IO
#undef PL_STEADY
#undef PL_TAIL
    const float l_tot = half_sum(l_run);
    const float inv = 1.0f / l_tot;
    const size_t row = (size_t)(qlo + r);
#pragma unroll
    for (int mt = 0; mt < NMT; ++mt)
#pragma unroll
        for (int g4 = 0; g4 < 4; ++g4) {
            const int d = 32 * mt + 8 * g4 + 4 * hh;
            v2u ow; ow.x = pk2(o[mt][4 * g4] * inv, o[mt][4 * g4 + 1] * inv); ow.y = pk2(o[mt][4 * g4 + 2] * inv, o[mt][4 * g4 + 3] * inv);
            *(v2u*)(Ob + row * PP + d) = ow;
        }
}

__device__ __forceinline__ void attn_unit_mem(LAS unsigned char* lds, const bf16* Qb, const bf16* Kb, const bf16* VTb, const bf16* Zb, bf16* Ob, int q0) {
    constexpr int DQK = 128, KP = DQK + 8, VP = MEML + 8, NKS = DQK / 16, NMT = 4;
    LAS bf16* Ks = (LAS bf16*)lds; LAS bf16* Vs = Ks + MEML * KP;
    int tid_ = threadIdx.x; asm volatile("" : "+v"(tid_));
    const int tid = tid_, lane = tid & 63, w = __builtin_amdgcn_readfirstlane(tid >> 6), r = lane & 31, hh = lane >> 5;
    { v4u kk[8], vv[8];
#pragma unroll
      for (int i = 0; i < 8; ++i) { const int c = tid + 512 * i; kk[i] = *(const v4u*)(Kb + (size_t)(c >> 4) * 1024 + 8 * (c & 15)); vv[i] = *(const v4u*)(VTb + (size_t)(c >> 5) * MEML + 8 * (c & 31)); }
#pragma unroll
      for (int i = 0; i < 8; ++i) { const int c = tid + 512 * i; *(LAS v4u*)(Ks + (c >> 4) * KP + 8 * (c & 15)) = kk[i]; *(LAS v4u*)(Vs + (c >> 5) * VP + 8 * (c & 31)) = vv[i]; } }
    __syncthreads();
#pragma unroll 1
    for (int qb = 0; qb < 2; ++qb) {
        const int qlo = q0 + 256 * qb + 32 * w;
        bf16x8 qf[NKS];
        { const bf16* qrow = Qb + (size_t)(qlo + r) * PP + 8 * hh;
#pragma unroll
          for (int ks = 0; ks < NKS; ++ks) qf[ks] = *(const bf16x8*)(qrow + 16 * ks); }
        f32x16 o[NMT];
#pragma unroll
        for (int mt = 0; mt < NMT; ++mt)
#pragma unroll
            for (int i = 0; i < 16; ++i) o[mt][i] = 0.f;
        float m_run = NEGF, l_run = 0.f;
#pragma unroll 1
        for (int sub = 0; sub < MEML / 64; ++sub) {
            const LAS bf16* Kc = Ks + 64 * sub * KP; const LAS bf16* Vc = Vs + 64 * sub;
            f32x16 s0, s1;
#pragma unroll
            for (int i = 0; i < 16; ++i) { s0[i] = 0.f; s1[i] = 0.f; }
#pragma unroll
            for (int ks = 0; ks < NKS; ++ks) {
                const bf16x8 a0 = *(const LAS bf16x8*)(Kc + r * KP + 16 * ks + 8 * hh);
                const bf16x8 a1 = *(const LAS bf16x8*)(Kc + (32 + r) * KP + 16 * ks + 8 * hh);
                s0 = __builtin_amdgcn_mfma_f32_32x32x16_bf16(a0, qf[ks], s0, 0, 0, 0);
                s1 = __builtin_amdgcn_mfma_f32_32x32x16_bf16(a1, qf[ks], s1, 0, 0, 0);
            }
            float mx = s0[0];
#pragma unroll
            for (int i = 1; i < 16; ++i) mx = __builtin_fmaxf(mx, s0[i]);
#pragma unroll
            for (int i = 0; i < 16; ++i) mx = __builtin_fmaxf(mx, s1[i]);
            mx = half_max(mx);
            const float m_new = __builtin_fmaxf(m_run, mx);
            const float alpha = __builtin_amdgcn_exp2f(m_run - m_new);
            m_run = m_new;
            float ls = 0.f;
#pragma unroll
            for (int i = 0; i < 16; ++i) { s0[i] = __builtin_amdgcn_exp2f(s0[i] - m_new); s1[i] = __builtin_amdgcn_exp2f(s1[i] - m_new); ls += s0[i] + s1[i]; }
            l_run = l_run * alpha + ls;
#pragma unroll
            for (int mt = 0; mt < NMT; ++mt)
#pragma unroll
                for (int i = 0; i < 16; ++i) o[mt][i] *= alpha;
            v4u pf[2][2];
#pragma unroll
            for (int s = 0; s < 2; ++s) {
                pf[0][s] = (v4u){pk2(s0[8 * s], s0[8 * s + 1]), pk2(s0[8 * s + 2], s0[8 * s + 3]), pk2(s0[8 * s + 4], s0[8 * s + 5]), pk2(s0[8 * s + 6], s0[8 * s + 7])};
                pf[1][s] = (v4u){pk2(s1[8 * s], s1[8 * s + 1]), pk2(s1[8 * s + 2], s1[8 * s + 3]), pk2(s1[8 * s + 4], s1[8 * s + 5]), pk2(s1[8 * s + 6], s1[8 * s + 7])};
            }
#pragma unroll
            for (int mt = 0; mt < NMT; ++mt)
#pragma unroll
                for (int p = 0; p < 2; ++p)
#pragma unroll
                    for (int s = 0; s < 2; ++s) {
                        const LAS bf16* vp = Vc + (32 * mt + r) * VP + 32 * p + 16 * s + 4 * hh;
                        const s16x4 lo = *(const LAS s16x4*)(vp), hi = *(const LAS s16x4*)(vp + 8);
                        const bf16x8 a = (bf16x8){lo[0], lo[1], lo[2], lo[3], hi[0], hi[1], hi[2], hi[3]};
                        o[mt] = __builtin_amdgcn_mfma_f32_32x32x16_bf16(a, __builtin_bit_cast(bf16x8, pf[p][s]), o[mt], 0, 0, 0);
                    }
        }
        const float inv = 1.0f / half_sum(l_run);
        const size_t row = (size_t)(qlo + r);
#pragma unroll
        for (int mt = 0; mt < NMT; ++mt)
#pragma unroll
            for (int g4 = 0; g4 < 4; ++g4) {
                const int d = 32 * mt + 8 * g4 + 4 * hh;
                const v2u zw = *(const v2u*)(Zb + row * PP + d); const float z[4] = {bflo(zw.x), bfhi(zw.x), bflo(zw.y), bfhi(zw.y)};
                float ov[4];
#pragma unroll
                for (int i = 0; i < 4; ++i) ov[i] = o[mt][4 * g4 + i] * inv * (z[i] * __builtin_amdgcn_rcpf(1.0f + __expf(-z[i])));
                v2u ow; ow.x = pk2(ov[0], ov[1]); ow.y = pk2(ov[2], ov[3]);
                *(v2u*)(Ob + row * PP + d) = ow;
            }
    }
}

__device__ __forceinline__ bf16* gate_row(bf16* G0, bf16* G1, size_t row) { return row < 8192 ? G0 + row * 3072 : G1 + (row - 8192) * 3072; }
struct EpiZG {
    static constexpr bool PERM = true, AFTER_DRAIN = false;
    bf16* P; bf16* G0; bf16* G1;
    __device__ __forceinline__ void operator()(const pg8::f32x4 (&acc)[2][2][4][2], const pg8::Unit& u, int wr, int wc, int fr, int fq) const {
        const int row0 = u.pm * 256 + wr * 64 + fr, cl = wc * 32 + 8 * fq;
        const bool isz = u.pn < 4;
        const int ycol = (u.pn < 2 ? C_YA : C_YB) + (u.pn & 1) * 256, gcol = (u.pn - 4) * 256;
#pragma unroll
        for (int ai = 0; ai < 2; ++ai)
#pragma unroll
            for (int m = 0; m < 4; ++m) { const size_t row = (size_t)(row0 + ai * 128 + m * 16);
#pragma unroll
                for (int bj = 0; bj < 2; ++bj) {
                    const pg8::f32x4 v0 = acc[ai][bj][m][0], v1 = acc[ai][bj][m][1];
                    float rr[8] = {v0[0], v0[1], v0[2], v0[3], v1[0], v1[1], v1[2], v1[3]};
                    if (isz) { bf16* dst = P + row * PP + ycol + cl + bj * 128; const v4u old = *(const v4u*)dst; float yv[8]; UNPACK8(old, yv);
#pragma unroll
                        for (int e = 0; e < 8; ++e) rr[e] = yv[e] * (rr[e] * __builtin_amdgcn_rcpf(1.0f + __expf(-rr[e])));
                        *(v4u*)dst = PACK8(rr); }
                    else { bf16* dst = gate_row(G0, G1, row) + gcol + cl + bj * 128;
#pragma unroll
                        for (int e = 0; e < 8; ++e) rr[e] = __builtin_amdgcn_rcpf(1.0f + __expf(-rr[e]));
                        *(v4u*)dst = PACK8(rr); } } }
    }
};
struct MergeOrder {
    pg8::StaticOrder so;
    __device__ __forceinline__ bool next(int i, pg8::Unit& u) const { pg8::Unit b; if (!so.next(i / 3, b)) return false; u.pm = b.pm; u.pn = (i % 3) * 4 + b.pn; return true; }
    __device__ __forceinline__ void a_ready(const pg8::Unit&) const {}
    __device__ __forceinline__ void done(const pg8::Unit&) const {}
};
struct EpiMerge {
    static constexpr bool PERM = true, AFTER_DRAIN = false;
    bf16* Mg; bf16* G0; bf16* G1;
    __device__ __forceinline__ void operator()(const pg8::f32x4 (&acc)[2][2][4][2], const pg8::Unit& u, int wr, int wc, int fr, int fq) const {
        const int nbr = u.pn >> 2;
        const int row0 = u.pm * 256 + wr * 64 + fr, col0 = (u.pn & 3) * 256 + wc * 32 + 8 * fq;
#pragma unroll
        for (int ai = 0; ai < 2; ++ai)
#pragma unroll
            for (int m = 0; m < 4; ++m) { const size_t row = (size_t)(row0 + ai * 128 + m * 16);
#pragma unroll
                for (int bj = 0; bj < 2; ++bj) { const int col = col0 + bj * 128;
                    const v4u gwd = *(const v4u*)(gate_row(G0, G1, row) + nbr * 1024 + col);
                    float gl[8]; UNPACK8(gwd, gl);
                    const pg8::f32x4 v0 = acc[ai][bj][m][0], v1 = acc[ai][bj][m][1];
                    float rr[8] = {v0[0], v0[1], v0[2], v0[3], v1[0], v1[1], v1[2], v1[3]};
#pragma unroll
                    for (int e = 0; e < 8; ++e) rr[e] *= gl[e];
                    bf16* dst = Mg + row * 1024 + col;
                    if (nbr > 0) { const v4u old = *(const v4u*)dst; float ol[8]; UNPACK8(old, ol);
#pragma unroll
                        for (int e = 0; e < 8; ++e) rr[e] += ol[e]; }
                    *(v4u*)dst = PACK8(rr); } }
    }
};
struct EpiOut {
    static constexpr bool PERM = true, AFTER_DRAIN = false;
    const float* X; float* Out;
    __device__ __forceinline__ void operator()(const pg8::f32x4 (&acc)[2][2][4][2], const pg8::Unit& u, int wr, int wc, int fr, int fq) const {
        const int row0 = u.pm * 256 + wr * 64 + fr, col0 = u.pn * 256 + wc * 32 + 8 * fq;
#pragma unroll
        for (int ai = 0; ai < 2; ++ai)
#pragma unroll
            for (int m = 0; m < 4; ++m) { const size_t row = (size_t)(row0 + ai * 128 + m * 16);
#pragma unroll
                for (int bj = 0; bj < 2; ++bj) { const size_t p = row * 1024 + col0 + bj * 128;
                    const f32x4 x0 = *(const f32x4*)(X + p), x1 = *(const f32x4*)(X + p + 4);
                    const pg8::f32x4 a0 = acc[ai][bj][m][0], a1 = acc[ai][bj][m][1];
                    *(f32x4*)(Out + p) = (f32x4){x0[0] + a0[0], x0[1] + a0[1], x0[2] + a0[2], x0[3] + a0[3]};
                    *(f32x4*)(Out + p + 4) = (f32x4){x1[0] + a1[0], x1[1] + a1[1], x1[2] + a1[2], x1[3] + a1[3]}; } }
    }
};

#define XB_TMO      128
#define XB_XCNT(j)  (256  + 64 * (j))
#define XB_XSUB(j)  (1280 + 64 * (j))
#define XB_XGEN(j)  (2304 + 64 * (j))
#define XB_TOP      3328
#define XB_TOPGEN   3392
#define XCD_BAR_WORDS 3456
#define XB_SPIN_CAP (1u << 18)

__device__ __forceinline__ unsigned xb_ld(unsigned* p)              { return __hip_atomic_load(p, __ATOMIC_RELAXED, __HIP_MEMORY_SCOPE_AGENT); }
__device__ __forceinline__ unsigned xb_add(unsigned* p, unsigned v) { return __hip_atomic_fetch_add(p, v, __ATOMIC_RELAXED, __HIP_MEMORY_SCOPE_AGENT); }
__device__ __forceinline__ unsigned xb_xcc_id() { return (unsigned)__builtin_amdgcn_s_getreg((3 << 11) | 20) & 0xFu; }
#define XB_SPIN(cond, bar) do { unsigned _sp = 0; while (cond) { __builtin_amdgcn_s_sleep(1); \
    if ((++_sp & 255u) == 0u) { if (xb_ld(&(bar)[XB_TMO])) break; if (_sp > XB_SPIN_CAP) { atomicAdd(&(bar)[XB_TMO], 1u); break; } } } } while (0)

struct XcdBarrier {
    unsigned* bar; unsigned x;
    volatile LAS unsigned* st;
};

__device__ __forceinline__ XcdBarrier xcd_barrier_post(unsigned* bar, volatile LAS unsigned* st) {
    XcdBarrier b; b.bar = bar; b.x = xb_xcc_id(); b.st = st;
    if (threadIdx.x == 0) (void)xb_add(&bar[XB_XCNT(b.x)], 1u);
    return b;
}
__device__ __forceinline__ void xcd_barrier_complete(unsigned* bar, unsigned x, unsigned& nloc, unsigned& nx) {
    const unsigned G = gridDim.x * gridDim.y * gridDim.z;
    unsigned sum, cnt, mine, sp = 0u;
    for (;;) {
        sum = 0u; cnt = 0u; mine = 0u;
#pragma unroll
        for (unsigned j = 0; j < 16; ++j) { const unsigned c = xb_ld(&bar[XB_XCNT(j)]); sum += c; cnt += (c > 0u) ? 1u : 0u; mine = (j == x) ? c : mine; }
        if (sum == G) break;
        __builtin_amdgcn_s_sleep(1);
        if ((++sp & 255u) == 0u) { if (xb_ld(&bar[XB_TMO])) break; if (sp > XB_SPIN_CAP) { atomicAdd(&bar[XB_TMO], 1u); break; } }
    }
    nloc = mine > 0u ? mine : 1u; nx = cnt > 0u ? cnt : 1u;
}

__device__ __forceinline__ void xcd_barrier(const XcdBarrier& b) {
    asm volatile("s_waitcnt vmcnt(0)" ::: "memory");
    __syncthreads();
    if (threadIdx.x == 0) {
        unsigned* bar = b.bar;
        __builtin_amdgcn_s_waitcnt(0);
        unsigned nloc = b.st[0], nx = b.st[1];
        if (nloc == 0u) { xcd_barrier_complete(bar, b.x, nloc, nx); b.st[0] = nloc; b.st[1] = nx; }
        const unsigned old = xb_add(&bar[XB_XSUB(b.x)], 1u);
        const unsigned gen = old / nloc;
        if (old + 1u == (gen + 1u) * nloc) {
            __builtin_amdgcn_fence(__ATOMIC_RELEASE, "agent");
            asm volatile("s_waitcnt vmcnt(0)" ::: "memory");
            const unsigned og = xb_add(&bar[XB_TOP], 1u);
            const unsigned tg = og / nx;
            if (og + 1u == (tg + 1u) * nx) xb_add(&bar[XB_TOPGEN], 1u);
            else XB_SPIN(xb_ld(&bar[XB_TOPGEN]) == tg, bar);
            __builtin_amdgcn_fence(__ATOMIC_ACQUIRE, "agent");
            xb_add(&bar[XB_XGEN(b.x)], 1u);
            asm volatile("s_waitcnt vmcnt(0)" ::: "memory");
        } else {
            XB_SPIN(xb_ld(&bar[XB_XGEN(b.x)]) == gen, bar);
            __builtin_amdgcn_fence(__ATOMIC_ACQUIRE, "agent");
            asm volatile("s_waitcnt vmcnt(0)" ::: "memory");
        }
    }
    __syncthreads();
}

template <int DQK, int DV, int MODE>
__device__ __forceinline__ void att_call(bool strip, LAS unsigned char* lds, const bf16* Qb, int qpitch, const bf16* Kb, int kpitch, const bf16* VTb, int skv, const unsigned* maskb, const bf16* Zb, bf16* Ob, int q0) {
    if (ATT_STRIP != 0 && strip) attn_unit<DQK, DV, MODE, ATT_STRIP>(lds, Qb, qpitch, Kb, kpitch, VTb, skv, maskb, Zb, Ob, q0);
    else attn_unit<DQK, DV, MODE, 0>(lds, Qb, qpitch, Kb, kpitch, VTb, skv, maskb, Zb, Ob, q0);
}
struct Args { const float* in[19]; const int* pos; float* out; unsigned char* ws; };
typedef const __attribute__((address_space(4))) Args* kargs_t;
#define PHASE_BEGIN \
    kargs_t ap_ = (kargs_t)__builtin_amdgcn_kernarg_segment_ptr(); asm volatile("" : "+s"(ap_)); \
    int tid = threadIdx.x; asm volatile("" : "+v"(tid)); \
    const int lane = tid & 63, wave = __builtin_amdgcn_readfirstlane(tid >> 6), G = gridDim.x, NGW = G * 8, gw = blockIdx.x * 8 + wave; \
    unsigned char* const ws = ap_->ws; unsigned char* const dob = (unsigned char*)ap_->out; const int* const pos = ap_->pos; float* const outp = ap_->out; unsigned* const ctl = (unsigned*)(ws + WS_CTL); \
    const float* const x = ap_->in[0]; const float* const mem = ap_->in[1]; \
    const float* const g_norm = ap_->in[3]; const float* const w_in = ap_->in[4]; const float* const g_qn_a = ap_->in[5]; const float* const g_kn_a = ap_->in[6]; \
    const float* const g_cq = ap_->in[7]; const float* const g_ckv = ap_->in[8]; const float* const w_uq = ap_->in[9]; const float* const w_ukv = ap_->in[10]; \
    const float* const g_qn_b = ap_->in[11]; const float* const g_kn_b = ap_->in[12]; const float* const g_mem = ap_->in[13]; const float* const w_mem_kv = ap_->in[14]; \
    const float* const g_qn_m = ap_->in[15]; const float* const g_kn_m = ap_->in[16]; const float* const w_branch = ap_->in[17]; const float* const w_out = ap_->in[18]; \
    bf16* const WinT = (bf16*)(ws + WS_WIN); bf16* const WuqT = (bf16*)(ws + WS_WUQ); bf16* const WukvT = (bf16*)(ws + WS_WUKV); bf16* const WmemT = (bf16*)(ws + WS_WMEM); \
    bf16* const WbrT = (bf16*)(ws + WS_WBR); bf16* const WoutT = (bf16*)(ws + WS_WOUT); \
    float* const ropeA = (float*)(ws + WS_ROPEA); float* const ropeB = (float*)(ws + WS_ROPEB); \
    bf16* const MN = (bf16*)(ws + WS_MN); bf16* const KVM = (bf16*)(ws + WS_KVM); bf16* const VTM = (bf16*)(ws + WS_VTM); \
    float* const WI = (float*)(ws + WS_WI); unsigned* const MASK = (unsigned*)(ws + WS_MASK); \
    bf16* const VTA = (bf16*)(dob + DO_VTA); bf16* const VTB = (bf16*)(dob + DO_VTB); bf16* const KB = (bf16*)(dob + DO_KB); \
    bf16* const Hh = (bf16*)(ws + WS_H); bf16* const MG = (bf16*)(ws + WS_H); bf16* const QB = (bf16*)(ws + WS_QB); \
    bf16* const KVB = (bf16*)(ws + WS_KVB); bf16* const GT0 = (bf16*)(dob + DO_G0); bf16* const GT1 = (bf16*)(ws + WS_G1); bf16* const P = (bf16*)(ws + WS_P); \
    (void)lane; (void)NGW; (void)gw; (void)ctl; \
    (void)pos; (void)outp; (void)x; (void)mem; (void)g_norm; (void)w_in; (void)g_qn_a; (void)g_kn_a; (void)g_cq; (void)g_ckv; (void)w_uq; (void)w_ukv; (void)g_qn_b; (void)g_kn_b; (void)g_mem; (void)w_mem_kv; \
    (void)g_qn_m; (void)g_kn_m; (void)w_branch; (void)w_out; (void)WinT; (void)WuqT; (void)WukvT; (void)WmemT; (void)WbrT; (void)WoutT; (void)ropeA; (void)ropeB; (void)MN; (void)KVM; (void)VTM; (void)WI; (void)MASK; \
    (void)VTA; (void)VTB; (void)Hh; (void)KB; (void)QB; (void)KVB; (void)MG; (void)GT0; (void)GT1; (void)P
#define GRID_BARRIER() do { kargs_t bp_ = (kargs_t)__builtin_amdgcn_kernarg_segment_ptr(); asm volatile("" : "+s"(bp_)); \
    XcdBarrier b_; b_.bar = (unsigned*)(bp_->ws + WS_CTL) + 4096; b_.x = xb_xcc_id(); b_.st = (volatile LAS unsigned*)(lds + LDS_BYTES - 32); xcd_barrier(b_); } while (0)

__global__ void __launch_bounds__(512, 2) fwd_kernel(Args a) {
    extern __shared__ __attribute__((aligned(16))) unsigned char lds_raw[];
    LAS unsigned char* const lds = (LAS unsigned char*)lds_raw;
    volatile LAS int* const slot = (volatile LAS int*)(lds + LDS_SLOT);
    if (threadIdx.x < 16) ((LAS unsigned*)(lds + LDS_BYTES - 64))[threadIdx.x] = 0u;
    __syncthreads();
    (void)xcd_barrier_post((unsigned*)(a.ws + WS_CTL) + 4096, (volatile LAS unsigned*)(lds + LDS_BYTES - 32));

    for (int rep = 0; rep < REP_P0; ++rep) { PHASE_BEGIN;
        LAS float* scr = (LAS float*)(lds + wave * 16384);
        constexpr int I_IN = 16 * (NP / 32), I_UQ = 6 * 24, I_UKV = 4 * 32, I_MEM = 16 * 32, I_BR = 8 * 32, I_OUT = 16 * 32;
        constexpr int NITEMS = I_IN + I_UQ + I_UKV + I_MEM + 3 * I_BR + I_OUT;
        for (int it = gw; it < NITEMS; it += NGW) {
            int r = it;
            if (r < I_IN) { transpose_item<true>(w_in, 1024, DIN, NP, WinT, scr, r, lane); continue; } r -= I_IN;
            if (r < I_UQ) { transpose_item<false>(w_uq, 384, 768, 768, WuqT, scr, r, lane); continue; } r -= I_UQ;
            if (r < I_UKV) { transpose_item<false>(w_ukv, 256, 1024, 1024, WukvT, scr, r, lane); continue; } r -= I_UKV;
            if (r < I_MEM) { transpose_item<false>(w_mem_kv, 1024, 1024, 1024, WmemT, scr, r, lane); continue; } r -= I_MEM;
            if (r < 3 * I_BR) { const int nb = r / I_BR; transpose_item<false>(w_branch + (size_t)nb * 512 * 1024, 512, 1024, 1024, WbrT + (size_t)nb * 1024 * 512, scr, r % I_BR, lane); continue; } r -= 3 * I_BR;
            transpose_item<false>(w_out, 1024, 1024, 1024, WoutT, scr, r, lane);
        }
        for (int idx = blockIdx.x * 512 + tid; idx < TT * 24; idx += G * 512) {
            const int t = idx / 24, i = idx % 24; const float pf = (float)pos[t];
            if (i < 8) { const float ang = pf * INVA[i]; ropeA[t * 16 + i] = cosf(ang); ropeA[t * 16 + 8 + i] = sinf(ang); }
            else { const int j = i - 8; const float ang = pf * INVB[j]; ropeB[t * 32 + j] = cosf(ang); ropeB[t * 32 + 16 + j] = sinf(ang); }
        }
        for (int m = gw; m < NB * MEML; m += NGW) rms_row_1024(mem + (size_t)m * DM, g_mem, MN + (size_t)m * DM, lane);
        for (int rp = 0; rp < REP_PH; ++rp)
        for (int m = gw; m < TT; m += NGW) rms_row_1024(x + (size_t)m * DM, g_norm, Hh + (size_t)m * DM, lane);
    }
    GRID_BARRIER();
    for (int es = 0; es < EXTRA_SYNCS; ++es) GRID_BARRIER();

    for (int rep = 0; rep < REP_G1; ++rep) { PHASE_BEGIN;
        pg8::Gemm g{Hh, WinT, TT, PP, 1024, 1024, nullptr, nullptr, nullptr, 0}; pg8::StaticOrder S; S.init(TT, PP, G, (int)blockIdx.x);
        pg8::EpiBf16<0> E{P, PP, nullptr, 0, 0, 1.f};
        pg8::gemm_phase<pg8::EpiBf16<0>, pg8::StaticOrder, true, true>(lds, g, S, E);
    }
    { PHASE_BEGIN;
        pg8::Gemm g{MN, WmemT, NB * MEML, 1024, 1024, 1024, nullptr, nullptr, nullptr, 0}; pg8::StaticOrder S; S.init(NB * MEML, 1024, G, (int)((blockIdx.x + 64) % G));
        pg8::EpiBf16<0> E{KVM, 1024, nullptr, 0, 0, 1.f};
        pg8::gemm_phase<pg8::EpiBf16<0>, pg8::StaticOrder, true, true>(lds, g, S, E);
    }
    GRID_BARRIER();
    { PHASE_BEGIN;
        float ga[8], gk[8], gq[8], gc[8], gm[8];
#pragma unroll
        for (int j = 0; j < 8; ++j) { ga[j] = g_qn_a[8 * (lane & 7) + j]; gk[j] = g_kn_a[8 * (lane & 7) + j]; gm[j] = g_qn_m[8 * (lane & 15) + j]; gq[j] = lane < 48 ? g_cq[8 * lane + j] : 0.f; gc[j] = lane < 32 ? g_ckv[8 * lane + j] : 0.f; }
        for (int dp = 0; dp < DUMMY_POST1; ++dp)
            for (int m = gw; m < TT; m += NGW)
                post1_row(P + (size_t)m * PP, QB + (size_t)(m & 1023) * 4096, ropeA + (size_t)m * 16, ga, gk, gq, gc, gm, (float*)KVB + (size_t)m * 8, lane);
        for (int m = gw; m < TT; m += NGW)
            post1_row(P + (size_t)m * PP, P + (size_t)m * PP, ropeA + (size_t)m * 16, ga, gk, gq, gc, gm, WI + (size_t)m * 8, lane);
        for (int rt = 0; rt < REP_TR; ++rt)
        transpose_v(P, PP, C_VA, 64, 8, 64, SEQ, NB, VTA, gw, NGW, lane);
        for (int m = gw; m < NB * MEML; m += NGW) km_row(KVM + (size_t)m * 1024, g_kn_m, lane);
        for (int rt = 0; rt < REP_TR; ++rt)
        transpose_v(KVM, 1024, 512, 128, 4, 128, MEML, NB, VTM, gw, NGW, lane);
    }
    GRID_BARRIER();
    for (int rep = 0; rep < REP_G2; ++rep) { PHASE_BEGIN;
        pg8::Gemm g{P + C_CQ, WuqT, TT, 768, 384, PP, nullptr, nullptr, nullptr, 0}; pg8::StaticOrder S; S.init(TT, 768, G, (int)blockIdx.x);
        pg8::EpiBf16<0> E{QB, 768, nullptr, 0, 0, 1.f};
        pg8::gemm_phase<pg8::EpiBf16<0>, pg8::StaticOrder, true, true>(lds, g, S, E);
    }
    for (int rep = 0; rep < REP_G2; ++rep) { PHASE_BEGIN;
        pg8::Gemm g{P + C_CKV, WukvT, TT, 1024, 256, PP, nullptr, nullptr, nullptr, 0}; pg8::StaticOrder S; S.init(TT, 1024, G, (int)((blockIdx.x + 192) % G));
        pg8::EpiBf16<0> E{KVB, 1024, nullptr, 0, 0, 1.f};
        pg8::gemm_phase<pg8::EpiBf16<0>, pg8::StaticOrder, true, true>(lds, g, S, E);
    }
    for (int rep = 0; rep < REP_IDX; ++rep) { if (rep > 0) GRID_BARRIER();
        PHASE_BEGIN;
        unsigned* const q_idx = ctl + 64 * (0 + 4 * rep);
        int u = next_unit(q_idx, slot);
        bf16x8 qf[8][2]; float wq[8];
        if (u < NB * 128) indexer_load_q(P, WI, u, qf, wq);
        while (u < NB * 128) {
            int tk = 0; if (tid == 0) tk = (int)atomicAdd(q_idx, 1u);
            const int tb = 127 - (u >> 3), bb = u & 7;
            int un;
            indexer_unit((LAS float*)lds, P, WI, MASK, bb, tb, qf, wq, tk, slot, NB * 128, un);
            u = un;
        }
    }
    GRID_BARRIER();
    { PHASE_BEGIN;
        LAS float* scr = (LAS float*)(lds + wave * 8192);
        float gqv[12], gkv[12];
#pragma unroll
        for (int e = 0; e < 12; ++e) { gqv[e] = g_qn_b[12 * (lane & 7) + e]; gkv[e] = g_kn_b[12 * (lane & 7) + e]; }
        for (int dp = 0; dp < DUMMY_POST2; ++dp)
            for (int m = gw; m < TT; m += NGW)
                post2_row(QB + (size_t)m * 768, (bf16*)MASK + (size_t)(m & 1023) * 768, KVB + (size_t)m * 1024, P + (size_t)m * PP, (bf16*)MASK + (size_t)(1024 + (m & 1023)) * 768, ropeB + (size_t)m * 32, gqv, gkv, scr, lane);
        for (int m = gw; m < TT; m += NGW)
            post2_row(QB + (size_t)m * 768, QB + (size_t)m * 768, KVB + (size_t)m * 1024, P + (size_t)m * PP, KB + (size_t)m * 768, ropeB + (size_t)m * 32, gqv, gkv, scr, lane);
        for (int rt = 0; rt < REP_TR; ++rt)
        transpose_v(KVB, 1024, 64, 128, 8, 64, SEQ, NB, VTB, gw, NGW, lane);
    }
    GRID_BARRIER();
    for (int rep = 0; rep < REP_ATT; ++rep) { if (rep > 0) GRID_BARRIER();
        PHASE_BEGIN;
        unsigned* const q_att = ctl + 64 * (1 + 4 * rep);
        for (;;) {
            const int u = next_unit(q_att, slot);
            if (u >= 1152) break;
            if (u < 704 || u >= 832) {
                const int uu = u < 704 ? u : u - 128, cls = uu >> 6, bh = uu & 63, bb = bh >> 3, h = bh & 7;
                const bool isA = (0x52a7u >> cls) & 1u; const int qb = (int)((0x11232435467567ull >> (4 * cls)) & 15ull);
                const size_t r0 = (size_t)bb * SEQ;
                if (!isA) attn_unit_pipe<96, 1>(lds, QB + r0 * 768 + h * 96, 768, KB + r0 * 768 + h * 96, 768, VTB + (size_t)((bb * 8 + h) * 64) * SEQ, SEQ, nullptr,
                                                   P + r0 * PP + C_YB + h * 64, qb * 256);
                else attn_unit_pipe<64, 2>(lds, P + r0 * PP + C_QA + h * 64, PP, P + r0 * PP + C_KA + h * 64, PP, VTA + (size_t)((bb * 8 + h) * 64) * SEQ, SEQ, MASK + r0 * 64,
                                           P + r0 * PP + C_YA + h * 64, qb * 256);
            } else {
                const int v = u - 704, hq = v & 3, bh = v >> 2, bb = bh >> 2, h = bh & 3;
                const size_t r0 = (size_t)bb * SEQ;
                attn_unit_mem(lds, P + r0 * PP + C_QM + h * 128, KVM + (size_t)bb * MEML * 1024 + h * 128, VTM + (size_t)((bb * 4 + h) * 128) * MEML,
                              P + r0 * PP + C_ZM + h * 128, P + r0 * PP + C_YM + h * 128, hq * 512);
            }
        }
    }
    GRID_BARRIER();
    for (int rep = 0; rep < 1; ++rep) { PHASE_BEGIN;
        pg8::Gemm g{Hh, WinT + (size_t)PP * 1024, TT, NZG, 1024, 1024, nullptr, nullptr, nullptr, 0}; pg8::StaticOrder S; S.init(TT, NZG, G, (int)blockIdx.x);
        EpiZG E{P, GT0, GT1};
        pg8::gemm_phase<EpiZG, pg8::StaticOrder, true, true>(lds, g, S, E);
    }
    GRID_BARRIER();
    for (int rep = 0; rep < REP_G4; ++rep) { PHASE_BEGIN;
        pg8::Gemm g{P + C_YA, WbrT, TT, 3072, 512, PP, P + C_YA, P + C_YB, P + C_YM, 4};
        MergeOrder S; S.so.init(TT, 1024, G, (int)blockIdx.x);
        EpiMerge E{MG, GT0, GT1};
        pg8::gemm_phase<EpiMerge, MergeOrder, true, true>(lds, g, S, E);
    }
    GRID_BARRIER();
    for (int rep = 0; rep < REP_G5; ++rep) { PHASE_BEGIN;
        pg8::Gemm g{MG, WoutT, TT, 1024, 1024, 1024, nullptr, nullptr, nullptr, 0}; pg8::StaticOrder S; S.init(TT, 1024, G, (int)blockIdx.x);
        EpiOut E{x, outp};
        pg8::gemm_phase<EpiOut, pg8::StaticOrder, true, true>(lds, g, S, E);
    }
}

extern "C" void kernel_launch(void* const* d_in, const int* in_sizes, int n_in, void* d_out, int out_size, void* d_ws, size_t ws_size, hipStream_t stream) {
    static int grid = 0;
    if (grid == 0) {
        if (n_in != 19 || out_size != TT * DM || ws_size < WS_END) { fprintf(stderr, "kernel_launch: unexpected problem (n_in %d, out %d, ws %zu); nothing launched\n", n_in, out_size, ws_size); grid = -1; return; }
        int dev = 0, cus = 0, per_cu = 0;
        if (hipGetDevice(&dev) != hipSuccess || hipDeviceGetAttribute(&cus, hipDeviceAttributeMultiprocessorCount, dev) != hipSuccess) { grid = -1; return; }
        if (hipFuncSetAttribute((const void*)fwd_kernel, hipFuncAttributeMaxDynamicSharedMemorySize, LDS_BYTES) != hipSuccess) { fprintf(stderr, "kernel_launch: hipFuncSetAttribute failed\n"); grid = -1; return; }
        if (hipOccupancyMaxActiveBlocksPerMultiprocessor(&per_cu, (const void*)fwd_kernel, 512, LDS_BYTES) != hipSuccess || per_cu < 1) { fprintf(stderr, "kernel_launch: occupancy query reports %d blocks per CU\n", per_cu); (void)hipGetLastError(); grid = -1; return; }
        grid = cus;
    }
    if (grid < 0) return;
    (void)hipMemsetAsync((char*)d_ws + WS_CTL, 0, 65536, stream);
    Args a{};
    for (int i = 0; i < 19; ++i) a.in[i] = (const float*)d_in[i];
    a.pos = (const int*)d_in[2]; a.out = (float*)d_out; a.ws = (unsigned char*)d_ws;
    hipLaunchKernelGGL(fwd_kernel, dim3(grid), dim3(512), LDS_BYTES, stream, a);
    const hipError_t e = hipPeekAtLastError();
    if (e != hipSuccess) fprintf(stderr, "kernel_launch: launch failed: %s (grid %d)\n", hipGetErrorString(e), grid);
}
```

```cpp
#include <hip/hip_runtime.h>
#include <cstdio>
#include <cstdint>
namespace pg8 {
#define PG8_LAS __attribute__((address_space(3)))
typedef unsigned short bf16_t;
typedef short bf16x8 __attribute__((ext_vector_type(8)));
typedef float f32x4 __attribute__((ext_vector_type(4)));
typedef unsigned u32x4 __attribute__((ext_vector_type(4)));
constexpr int BM = 256, BK = 64, HALF = 128, HTB = HALF * BK * 2  , STAGE_BYTES = 8 * HTB, NXCD = 8, WGM = 8;

__host__ __device__ __forceinline__ int lds_byte(int r, int c) { const int st = (r >> 4) * 2 + (c >> 5), rr = r & 15, cc = c & 31, ob = rr * 64 + cc * 2; return st * 1024 + (ob ^ (((ob >> 9) & 1) << 5)); }
__host__ __device__ __forceinline__ void stage_rc(int b, int& R, int& C) { const int st = b / 1024, sb = b % 1024, swz = sb ^ (((sb >> 9) & 1) << 5); R = (st >> 1) * 16 + swz / 64; C = (st & 1) * 32 + (swz % 64) / 2; }
__host__ __device__ __forceinline__ int perm32(int rho) { const int n = rho >> 4, i = rho & 15; return 8 * (i >> 2) + 4 * n + (i & 3); }

struct Unit { int pm, pn; };
struct Gemm { const bf16_t* A; const bf16_t* Bt; int M, N, K, lda; const bf16_t* Ag0; const bf16_t* Ag1; const bf16_t* Ag2; int ngrp; };
__device__ __forceinline__ const char* a_base(const Gemm& g, const Unit& u) { if (!g.ngrp) return (const char*)g.A; const int j = u.pn / g.ngrp; return (const char*)(j == 0 ? g.Ag0 : (j == 1 ? g.Ag1 : g.Ag2)); }

struct StaticOrder {
    int nM, nN, nwg, G, c;
    __host__ __device__ void init(int M, int N, int G_, int c_) { nM = M / BM; nN = N / BM; nwg = nM * nN; G = G_; c = c_; }
    __host__ __device__ bool next(int i, Unit& u) const {
        const long L = (long)i * G + c; if (L >= nwg) return false;
        int wgid = (int)L; { const int q = nwg / NXCD, r = nwg % NXCD, xcd = wgid % NXCD, off = wgid / NXCD; wgid = (xcd < r ? xcd * (q + 1) : r * (q + 1) + (xcd - r) * q) + off; }
        const int nig = WGM * nN, gid = wgid / nig, fm = gid * WGM, gsz = (nM - fm) < WGM ? (nM - fm) : WGM;
        u.pm = fm + ((wgid % nig) % gsz); u.pn = (wgid % nig) / gsz; return true;
    }
    __device__ __forceinline__ void a_ready(const Unit&) const {}
    __device__ __forceinline__ void done(const Unit&) const {}
};

__device__ __forceinline__ unsigned cvt_pk_bf16(float lo, float hi) { unsigned r; asm volatile("v_cvt_pk_bf16_f32 %0, %1, %2" : "=v"(r) : "v"(lo), "v"(hi)); return r; }
typedef float f32x2 __attribute__((ext_vector_type(2)));
__device__ __forceinline__ f32x2 gelu_pk(f32x2 v) {
    const f32x2 av = __builtin_elementwise_abs(v), d = av * 0.2316418882f + 1.0f;
    f32x2 t; t.x = __builtin_amdgcn_rcpf(d.x); t.y = __builtin_amdgcn_rcpf(d.y);
    f32x2 q = t * 0.5307027145f + (-0.7265760135f); q = q * t + 0.7107068705f; q = q * t + (-0.142248368f); q = q * t + 0.127414796f; q = q * t;
    const f32x2 s = (v * v) * (-0.72134752044f);
    f32x2 e; e.x = __builtin_amdgcn_exp2f(s.x); e.y = __builtin_amdgcn_exp2f(s.y);
    const f32x2 m = v * (q * e), r = v - m;
    f32x2 o; o.x = v.x < 0.f ? m.x : r.x; o.y = v.y < 0.f ? m.y : r.y; return o;
}

template <int ACT  > struct EpiBf16 {
    static constexpr bool PERM = true, AFTER_DRAIN = false; static_assert(ACT == 0 || ACT == 1, "EpiBf16: ACT is 0 (none) or 1 (gelu_pk)");
    bf16_t* O; int ldc; const float* bias; int split_cols; size_t split_stride; float scale0;
    __device__ __forceinline__ void operator()(const f32x4 (&acc)[2][2][4][2], const Unit& u, int wr, int wc, int fr, int fq) const {
        const int row0 = u.pm * BM + wr * 64 + fr; int colt = u.pn * BM; bf16_t* base = O;
        float sc = 1.f; if (split_cols) { const int t = colt / split_cols; base += (size_t)t * split_stride; colt -= t * split_cols; if (t == 0) sc = scale0; }
        const int col0 = colt + wc * 32 + 8 * fq, bcol0 = u.pn * BM + wc * 32 + 8 * fq;
        f32x4 bv[2][2];
#pragma unroll
        for (int bj = 0; bj < 2; ++bj)
#pragma unroll
            for (int n = 0; n < 2; ++n) bv[bj][n] = bias ? *(const f32x4*)(bias + bcol0 + bj * HALF + 4 * n) : (f32x4){0.f, 0.f, 0.f, 0.f};
#pragma unroll
        for (int ai = 0; ai < 2; ++ai)
#pragma unroll
            for (int m = 0; m < 4; ++m) { bf16_t* rowp = base + (size_t)(row0 + ai * HALF + m * 16) * ldc + col0;
#pragma unroll
                for (int bj = 0; bj < 2; ++bj) { f32x4 v0 = acc[ai][bj][m][0] + bv[bj][0], v1 = acc[ai][bj][m][1] + bv[bj][1];
                    if (ACT == 1) { f32x2 a = gelu_pk((f32x2){v0[0], v0[1]}), b = gelu_pk((f32x2){v0[2], v0[3]}), c = gelu_pk((f32x2){v1[0], v1[1]}), d = gelu_pk((f32x2){v1[2], v1[3]});
                        v0 = (f32x4){a.x, a.y, b.x, b.y}; v1 = (f32x4){c.x, c.y, d.x, d.y}; }
                    v0 = v0 * sc; v1 = v1 * sc; u32x4 w; w.x = cvt_pk_bf16(v0[0], v0[1]); w.y = cvt_pk_bf16(v0[2], v0[3]); w.z = cvt_pk_bf16(v1[0], v1[1]); w.w = cvt_pk_bf16(v1[2], v1[3]);
                    *(u32x4*)(rowp + bj * HALF) = w; } }
    }
};
template <class Epi, class Sched, bool ALIGN_EPI = false, bool SP2 = false>
__device__ __forceinline__ void gemm_phase(PG8_LAS unsigned char* lds, const Gemm g, const Sched& S, const Epi& E) {
    int tid_ = threadIdx.x; asm volatile("" : "+v"(tid_));
    const int tid = tid_, wid = __builtin_amdgcn_readfirstlane(tid >> 6), lane = tid & 63, wr = wid >> 2, wc = wid & 3, fr = lane & 15, fq = lane >> 4;
    const int K = g.K, nt = K / BK;
    unsigned voffA[2], voffB[2];
#pragma unroll
    for (int i = 0; i < 2; ++i) { int R, C; stage_rc(tid * 16 + i * 8192, R, C); const int Rb = Epi::PERM ? ((R & ~31) + perm32(R & 31)) : R;
        voffA[i] = (unsigned)(R * g.lda + C) * 2u; voffB[i] = (unsigned)(Rb * K + C) * 2u; }
    const size_t kstep = (size_t)(BK * 2);
    const size_t hstepA = (size_t)HALF * g.lda * 2, hstepB = (size_t)HALF * K * 2;
    const size_t tstepA = 2 * hstepA, tstepB = 2 * hstepB;
    const unsigned ldsw = (unsigned)wid * 1024u;
    const int aoff = lds_byte(wr * 64 + fr, fq * 8), boff = lds_byte(wc * 32 + fr, fq * 8);
#define PG8_SA(b, h) (((b) * 2 + (h)) * HTB)
#define PG8_SB(b, h) ((4 + (b) * 2 + (h)) * HTB)
#define PG8_STAGE(bufoff, gbase, voff) do { _Pragma("unroll") for (int _i = 0; _i < 2; ++_i) \
        __builtin_amdgcn_global_load_lds((const unsigned*)((const char*)(gbase) + (voff)[_i]), (PG8_LAS unsigned*)(lds + (bufoff) + ldsw + _i * 8192), 16, 0, 0); } while (0)
#define PG8_LDA(dst, b, h) do { _Pragma("unroll") for (int m = 0; m < 4; ++m) _Pragma("unroll") for (int k = 0; k < 2; ++k) dst[m][k] = *(const PG8_LAS bf16x8*)(lds + PG8_SA(b, h) + aoff + m * 2048 + k * 1024); } while (0)
#define PG8_LDB(dst, b, h) do { _Pragma("unroll") for (int n = 0; n < 2; ++n) _Pragma("unroll") for (int k = 0; k < 2; ++k) dst[n][k] = *(const PG8_LAS bf16x8*)(lds + PG8_SB(b, h) + boff + n * 2048 + k * 1024); } while (0)
#define PG8_MMA(ai, bj, At, Bt) do { __builtin_amdgcn_s_setprio(1); _Pragma("unroll") for (int m = 0; m < 4; ++m) _Pragma("unroll") for (int n = 0; n < 2; ++n) _Pragma("unroll") for (int k = 0; k < 2; ++k) \
        acc[ai][bj][m][n] = __builtin_amdgcn_mfma_f32_16x16x32_bf16(Bt[n][k], At[m][k], acc[ai][bj][m][n], 0, 0, 0); __builtin_amdgcn_s_setprio(0); } while (0)
#define PG8_WAIT_V(n) asm volatile("s_waitcnt vmcnt(" #n ")" ::: "memory")
#define PG8_WAIT_L(n) asm volatile("s_waitcnt lgkmcnt(" #n ")" ::: "memory")
#define PG8_BAR __builtin_amdgcn_s_barrier()
#define PG8_SCHED __builtin_amdgcn_sched_barrier(0)
    Unit cur, nxt; int ui = 0;
    if (!S.next(0, cur)) return;
    f32x4 acc[2][2][4][2];
#pragma unroll
    for (int a = 0; a < 2; ++a)
#pragma unroll
        for (int b = 0; b < 2; ++b)
#pragma unroll
            for (int m = 0; m < 4; ++m)
#pragma unroll
                for (int n = 0; n < 2; ++n) acc[a][b][m][n] = (f32x4){0.f, 0.f, 0.f, 0.f};
    bf16x8 At[4][2], B0[2][2], B1[2][2];
    const char* cA = a_base(g, cur) + (size_t)cur.pm * tstepA; const char* cB = (const char*)g.Bt + (size_t)cur.pn * tstepB;
    S.a_ready(cur);
    if constexpr (SP2) {
        PG8_STAGE(PG8_SB(0, 0), cB, voffB); PG8_STAGE(PG8_SB(0, 1), cB + hstepB, voffB); PG8_STAGE(PG8_SA(0, 0), cA, voffA); PG8_STAGE(PG8_SA(0, 1), cA + hstepA, voffA);
        if (wr == 1) PG8_BAR;
        PG8_WAIT_V(2); PG8_BAR;
        PG8_STAGE(PG8_SB(1, 0), cB + kstep, voffB); PG8_STAGE(PG8_SA(1, 0), cA + kstep, voffA); PG8_STAGE(PG8_SB(1, 1), cB + hstepB + kstep, voffB);
        PG8_WAIT_V(6); PG8_BAR;
    } else {
        PG8_STAGE(PG8_SB(0, 0), cB, voffB); PG8_STAGE(PG8_SA(0, 0), cA, voffA); PG8_STAGE(PG8_SB(0, 1), cB + hstepB, voffB); PG8_STAGE(PG8_SA(0, 1), cA + hstepA, voffA);
        if (wr == 1) PG8_BAR;
        PG8_WAIT_V(4); PG8_BAR;
        PG8_STAGE(PG8_SB(1, 0), cB + kstep, voffB); PG8_STAGE(PG8_SA(1, 0), cA + kstep, voffA); PG8_STAGE(PG8_SB(1, 1), cB + hstepB + kstep, voffB);
        PG8_WAIT_V(6); PG8_BAR;
    }
    for (;;) {
        const bool has_next = S.next(ui + 1, nxt);
        const char* nA = has_next ? a_base(g, nxt) + (size_t)nxt.pm * tstepA : cA; const char* nB = has_next ? (const char*)g.Bt + (size_t)nxt.pn * tstepB : cB;
        for (int t = 0; t < nt; t += 2) {
            const bool last = (t == nt - 2);
            const char* a1 = cA + (size_t)(t + 1) * kstep;
            const char* a2 = last ? nA : cA + (size_t)(t + 2) * kstep; const char* b2 = last ? nB : cB + (size_t)(t + 2) * kstep;
            const char* a3 = a2 + kstep; const char* b3 = b2 + kstep;
            if (last && has_next) S.a_ready(nxt);
            if constexpr (SP2) {
            PG8_LDB(B0, 0, 0); PG8_LDB(B1, 0, 1); PG8_SCHED; PG8_LDA(At, 0, 0); PG8_STAGE(PG8_SA(1, 1), a1 + hstepA, voffA);
            PG8_WAIT_V(8); PG8_WAIT_L(0); PG8_BAR; PG8_MMA(0, 0, At, B0); PG8_MMA(0, 1, At, B1); PG8_BAR; PG8_SCHED;
            PG8_LDA(At, 0, 1); PG8_STAGE(PG8_SB(0, 0), b2, voffB); PG8_STAGE(PG8_SB(0, 1), b2 + hstepB, voffB); PG8_STAGE(PG8_SA(0, 0), a2, voffA);
            PG8_WAIT_V(8); PG8_WAIT_L(0); PG8_BAR; PG8_MMA(1, 0, At, B0); PG8_MMA(1, 1, At, B1); PG8_BAR; PG8_SCHED;
            PG8_LDB(B0, 1, 0); PG8_LDB(B1, 1, 1); PG8_SCHED; PG8_LDA(At, 1, 0); PG8_STAGE(PG8_SA(0, 1), a2 + hstepA, voffA);
            PG8_WAIT_V(8); PG8_WAIT_L(0); PG8_BAR; PG8_MMA(0, 0, At, B0); PG8_MMA(0, 1, At, B1); PG8_BAR; PG8_SCHED;
            PG8_LDA(At, 1, 1); PG8_STAGE(PG8_SB(1, 0), b3, voffB); PG8_STAGE(PG8_SB(1, 1), b3 + hstepB, voffB); PG8_STAGE(PG8_SA(1, 0), a3, voffA);
            PG8_WAIT_V(8); PG8_WAIT_L(0); PG8_BAR; PG8_MMA(1, 0, At, B0); PG8_MMA(1, 1, At, B1); PG8_BAR; PG8_SCHED;
            } else {
            PG8_LDB(B0, 0, 0); PG8_SCHED; PG8_LDA(At, 0, 0); PG8_STAGE(PG8_SA(1, 1), a1 + hstepA, voffA);
            PG8_WAIT_L(8); PG8_BAR; PG8_WAIT_L(0); PG8_MMA(0, 0, At, B0); PG8_BAR; PG8_SCHED;
            PG8_LDB(B1, 0, 1); PG8_STAGE(PG8_SB(0, 0), b2, voffB);
            PG8_BAR; PG8_WAIT_L(0); PG8_MMA(0, 1, At, B1); PG8_BAR;
            PG8_LDA(At, 0, 1); PG8_STAGE(PG8_SA(0, 0), a2, voffA);
            PG8_BAR; PG8_WAIT_L(0); PG8_MMA(1, 0, At, B0); PG8_BAR; PG8_SCHED;
            PG8_STAGE(PG8_SB(0, 1), b2 + hstepB, voffB);
            PG8_WAIT_V(6); PG8_BAR; PG8_MMA(1, 1, At, B1); PG8_BAR;
            PG8_LDB(B0, 1, 0); PG8_SCHED; PG8_LDA(At, 1, 0); PG8_STAGE(PG8_SA(0, 1), a2 + hstepA, voffA);
            PG8_WAIT_L(8); PG8_BAR; PG8_WAIT_L(0); PG8_MMA(0, 0, At, B0); PG8_BAR; PG8_SCHED;
            PG8_LDB(B1, 1, 1); PG8_STAGE(PG8_SB(1, 0), b3, voffB);
            PG8_BAR; PG8_WAIT_L(0); PG8_MMA(0, 1, At, B1); PG8_BAR;
            PG8_LDA(At, 1, 1); PG8_STAGE(PG8_SA(1, 0), a3, voffA);
            PG8_BAR; PG8_WAIT_L(0); PG8_MMA(1, 0, At, B0); PG8_BAR; PG8_SCHED;
            PG8_STAGE(PG8_SB(1, 1), b3 + hstepB, voffB);
            PG8_WAIT_V(6); PG8_BAR; PG8_MMA(1, 1, At, B1); PG8_BAR;
            }
        }
        if constexpr (ALIGN_EPI) { if (wr == 0) PG8_BAR; }
        if constexpr (!Epi::AFTER_DRAIN) { E(acc, cur, wr, wc, fr, fq); S.done(cur); }
        if (!has_next) break;
#pragma unroll
        for (int a = 0; a < 2; ++a)
#pragma unroll
            for (int b = 0; b < 2; ++b)
#pragma unroll
                for (int m = 0; m < 4; ++m)
#pragma unroll
                    for (int n = 0; n < 2; ++n) acc[a][b][m][n] = (f32x4){0.f, 0.f, 0.f, 0.f};
        cur = nxt; cA = nA; cB = nB; ++ui;
        if constexpr (ALIGN_EPI) { if (wr == 1) PG8_BAR; }
    }
    PG8_WAIT_V(0);
    if constexpr (!ALIGN_EPI) { if (wr == 0) PG8_BAR; }
    PG8_BAR;
    if constexpr (Epi::AFTER_DRAIN) { E.fused(acc, cur, wr, wc, fr, fq, lds, wid, lane); S.done(cur); }
#undef PG8_SA
#undef PG8_SB
#undef PG8_STAGE
#undef PG8_LDA
#undef PG8_LDB
#undef PG8_MMA
#undef PG8_WAIT_V
#undef PG8_WAIT_L
#undef PG8_BAR
#undef PG8_SCHED
}
}

#define LAS __attribute__((address_space(3)))
typedef unsigned short bf16;
typedef unsigned v4u __attribute__((ext_vector_type(4)));
typedef unsigned v2u __attribute__((ext_vector_type(2)));
typedef float f32x4 __attribute__((ext_vector_type(4)));
typedef float f32x16 __attribute__((ext_vector_type(16)));
typedef short bf16x8 __attribute__((ext_vector_type(8)));
typedef short s16x4 __attribute__((ext_vector_type(4)));
typedef float f32x2_t __attribute__((ext_vector_type(2)));
typedef __bf16 bf16x2_t __attribute__((ext_vector_type(2)));

constexpr int NB = 8, SEQ = 2048, DM = 1024, TT = NB * SEQ;
constexpr int DIN = 7912, NP = 7936;
constexpr int PP = 3840, NZG = 4096;
constexpr int MEML = 256;
constexpr float EPS = 1e-6f, NEGF = -1e30f;
constexpr int C_QA = 0, C_KA = 512, C_VA = 1024, C_QI = 1536, C_KI = 2048, C_WI = 2112, C_CQ = 2120, C_CKV = 2504, C_KR = 2760, C_QM = 2792, C_ZM = 3304;
constexpr int C_YA = C_QI, C_YB = C_CQ, C_YM = C_VA;
constexpr float SCALE_A = 0.18033688011112042f;
constexpr float SCALE_B = 0.14724444602590306f;
constexpr float SCALE_M = 0.12751743082459868f;
constexpr float SCALE_I = 0.04419417382415922f;

__constant__ float INVA[8] = {1.0f, 0.1939227432012558f, 0.03760603070259094f, 0.007292664609849453f, 0.0014142135623842478f, 0.00027424818836152554f, 5.3182957344688475e-05f, 1.0313385246263351e-05f};
__constant__ float INVB[16] = {1.0f, 0.44036659598350525f, 0.1939227432012558f, 0.08539710193872452f, 0.03760603070259094f, 0.016560440883040428f, 0.007292664609849453f, 0.0032114461064338684f, 0.0014142135623842478f, 0.0006227724370546639f, 0.00027424818836152554f, 0.00012076973507646471f, 5.3182957344688475e-05f, 2.34199997066753e-05f, 1.0313385246263351e-05f, 4.541670477919979e-06f};

constexpr size_t MiB = 1u << 20;
constexpr size_t WS_CTL = 0;
constexpr size_t WS_WIN = 1 * MiB;
constexpr size_t WS_WUQ = 17 * MiB;
constexpr size_t WS_WUKV = 18 * MiB;
constexpr size_t WS_WMEM = 19 * MiB;
constexpr size_t WS_WBR = 21 * MiB;
constexpr size_t WS_WOUT = 24 * MiB;
constexpr size_t WS_ROPEA = 26 * MiB;
constexpr size_t WS_ROPEB = 27 * MiB;
constexpr size_t WS_MN = 29 * MiB;
constexpr size_t WS_KVM = 33 * MiB;
constexpr size_t WS_VTM = 37 * MiB;
constexpr size_t WS_WI = 39 * MiB;
constexpr size_t WS_MASK = 40 * MiB;
constexpr size_t WS_H = 44 * MiB;
constexpr size_t WS_P = 76 * MiB;
constexpr size_t WS_QB = 196 * MiB;
constexpr size_t WS_KVB = 220 * MiB;
constexpr size_t WS_G1 = 196 * MiB;
constexpr size_t WS_END = 256 * MiB;
constexpr size_t DO_VTA = 0;
constexpr size_t DO_VTB = 16 * MiB;
constexpr size_t DO_KB = 32 * MiB;
constexpr size_t DO_G0 = 0;

constexpr int REP_P0 = 1, REP_PH = 1, REP_G1 = 1, REP_G2 = 1, REP_IDX = 1, REP_ATT = 1, REP_G4 = 1, REP_G5 = 1;
constexpr int REP_IDX1 = 1, REP_SEL = 1;
constexpr int ATT_STRIP = 0;
constexpr int EXTRA_SYNCS = 0, REP_TR = 1, DUMMY_POST1 = 0, DUMMY_POST2 = 0;
constexpr int LDS_BYTES = 147456;
constexpr int LDS_SLOT = LDS_BYTES - 64;

__device__ __forceinline__ unsigned pk2(float lo, float hi) { f32x2_t v = {lo, hi}; bf16x2_t b = __builtin_convertvector(v, bf16x2_t); return __builtin_bit_cast(unsigned, b); }
__device__ __forceinline__ float bflo(unsigned w) { return __uint_as_float(w << 16); }
__device__ __forceinline__ float bfhi(unsigned w) { return __uint_as_float(w & 0xffff0000u); }
__device__ __forceinline__ float bf1(bf16 b) { return __uint_as_float(((unsigned)b) << 16); }
#define UNPACK8(W_, V_) do { V_[0] = bflo((W_)[0]); V_[1] = bfhi((W_)[0]); V_[2] = bflo((W_)[1]); V_[3] = bfhi((W_)[1]); V_[4] = bflo((W_)[2]); V_[5] = bfhi((W_)[2]); V_[6] = bflo((W_)[3]); V_[7] = bfhi((W_)[3]); } while (0)
#define PACK8(V_) (v4u){pk2(V_[0], V_[1]), pk2(V_[2], V_[3]), pk2(V_[4], V_[5]), pk2(V_[6], V_[7])}
template <int CTRL> __device__ __forceinline__ float dpp_f(float v) { return __int_as_float(__builtin_amdgcn_update_dpp(0, __float_as_int(v), CTRL, 0xF, 0xF, false)); }
#define SUM8(x) do { x += dpp_f<0xB1>(x); x += dpp_f<0x4E>(x); x += dpp_f<0x141>(x); } while (0)
#define SUM16(x) do { SUM8(x); x += dpp_f<0x140>(x); } while (0)
__device__ __forceinline__ float wave_sum(float v) {
    SUM16(v);
    return __int_as_float(__builtin_amdgcn_readlane(__float_as_int(v), 0)) + __int_as_float(__builtin_amdgcn_readlane(__float_as_int(v), 16))
         + __int_as_float(__builtin_amdgcn_readlane(__float_as_int(v), 32)) + __int_as_float(__builtin_amdgcn_readlane(__float_as_int(v), 48));
}
#define LDS_WAIT() asm volatile("s_waitcnt lgkmcnt(0)" ::: "memory")

__device__ __forceinline__ int win_src(int d) {
    if (d < 2120) return d;
    if (d < 2792) return d + 512;
    if (d < 3816) return d + 1024;
    if (d < 3840) return -1;
    if (d < 4352) return d - 3840 + 2120;
    if (d < 4864) return d - 4352 + 3304;
    return d - 4864 + 4840;
}
template <bool REMAP>
__device__ __forceinline__ void transpose_item(const float* W, int K, int N, int Npad, bf16* WT, LAS float* scr, int item, int lane) {
    const int nblk = Npad / 32, kb = item / nblk, nb = item % nblk, k0 = 64 * kb, n0 = 32 * nb;
    const int n4 = 4 * (lane & 7);
    const int nn = REMAP ? win_src(n0 + n4) : n0 + n4; const bool ok = nn >= 0 && nn < N;
#pragma unroll
    for (int i = 0; i < 8; ++i) { const int kk = 8 * i + (lane >> 3);
        f32x4 v = (f32x4){0.f, 0.f, 0.f, 0.f}; if (ok) v = *(const f32x4*)(W + (size_t)(k0 + kk) * N + nn);
        LAS float* d = scr + kk * 33 + n4; d[0] = v[0]; d[1] = v[1]; d[2] = v[2]; d[3] = v[3]; }
    LDS_WAIT(); asm volatile("" ::: "memory");
    const int c = lane & 7;
#pragma unroll
    for (int j = 0; j < 4; ++j) { const int n = (lane >> 3) + 8 * j; const LAS float* s = scr + (8 * c) * 33 + n;
        v4u o; o.x = pk2(s[0 * 33], s[1 * 33]); o.y = pk2(s[2 * 33], s[3 * 33]); o.z = pk2(s[4 * 33], s[5 * 33]); o.w = pk2(s[6 * 33], s[7 * 33]);
        *(v4u*)(WT + (size_t)(n0 + n) * K + k0 + 8 * c) = o; }
    LDS_WAIT(); asm volatile("" ::: "memory");
}
__device__ __forceinline__ void rms_row_1024(const float* xrow, const float* g, bf16* orow, int lane) {
    const f32x4* xr = (const f32x4*)xrow + lane; const f32x4* gr = (const f32x4*)g + lane;
    f32x4 v[4]; float s = 0.f;
#pragma unroll
    for (int j = 0; j < 4; ++j) { v[j] = xr[64 * j]; s += (v[j].x * v[j].x + v[j].y * v[j].y) + (v[j].z * v[j].z + v[j].w * v[j].w); }
    const float rstd = __builtin_amdgcn_rsqf(wave_sum(s) * (1.f / 1024.f) + EPS);
    v2u* o8 = (v2u*)orow + lane;
#pragma unroll
    for (int j = 0; j < 4; ++j) { const f32x4 gg = gr[64 * j]; v2u w; w.x = pk2(v[j].x * rstd * gg.x, v[j].y * rstd * gg.y); w.y = pk2(v[j].z * rstd * gg.z, v[j].w * rstd * gg.w); o8[64 * j] = w; }
}

#define ROPE8(v, sub, c8, s8) do { _Pragma("unroll") for (int j_ = 0; j_ < 8; ++j_) { const float pv_ = dpp_f<0xB1>(v[j_]); \
        const float r0_ = v[j_] * c8[j_] - pv_ * s8[j_], r1_ = v[j_] * c8[j_] + pv_ * s8[j_]; v[j_] = (sub) == 0 ? r0_ : ((sub) == 1 ? r1_ : v[j_]); } } while (0)

__device__ __forceinline__ void post1_row(const bf16* Prow, bf16* Orow, const float* ra, const float (&ga)[8], const float (&gk)[8], const float (&gq)[8], const float (&gc)[8], const float (&gm)[8], float* WIrow, int lane) {
    const int sub = lane & 7;
    const v4u z4 = (v4u){0u, 0u, 0u, 0u};
    const v4u w_qa = *(const v4u*)(Prow + C_QA + 8 * lane);
    const v4u w_ka = *(const v4u*)(Prow + C_KA + 8 * lane);
    const v4u w_qi = *(const v4u*)(Prow + C_QI + 8 * lane);
    const v4u w_qm = *(const v4u*)(Prow + C_QM + 8 * lane);
    v4u w_ki = z4, w_cq = z4, w_ckv = z4; float w_wi = 0.f;
    if (lane < 8) { w_ki = *(const v4u*)(Prow + C_KI + 8 * lane); w_wi = bf1(Prow[C_WI + lane]); }
    if (lane < 48) w_cq = *(const v4u*)(Prow + C_CQ + 8 * lane);
    if (lane < 32) w_ckv = *(const v4u*)(Prow + C_CKV + 8 * lane);
    float c8[8], s8[8];
    { const f32x4 r0 = *(const f32x4*)(ra), r1 = *(const f32x4*)(ra + 4), r2 = *(const f32x4*)(ra + 8), r3 = *(const f32x4*)(ra + 12);
      c8[0] = r0[0]; c8[1] = r0[1]; c8[2] = r0[2]; c8[3] = r0[3]; c8[4] = r1[0]; c8[5] = r1[1]; c8[6] = r1[2]; c8[7] = r1[3];
      s8[0] = r2[0]; s8[1] = r2[1]; s8[2] = r2[2]; s8[3] = r2[3]; s8[4] = r3[0]; s8[5] = r3[1]; s8[6] = r3[2]; s8[7] = r3[3]; }
    { float v[8]; UNPACK8(w_qa, v); float ss = 0.f;
#pragma unroll
      for (int j = 0; j < 8; ++j) ss += v[j] * v[j];
      SUM8(ss);
      const float rstd = __builtin_amdgcn_rsqf(ss * (1.f / 64.f) + EPS);
#pragma unroll
      for (int j = 0; j < 8; ++j) v[j] = v[j] * rstd * ga[j];
      ROPE8(v, sub, c8, s8);
#pragma unroll
      for (int j = 0; j < 8; ++j) v[j] *= SCALE_A;
      *(v4u*)(Orow + C_QA + 8 * lane) = PACK8(v); }
    { float v[8]; UNPACK8(w_ka, v); float ss = 0.f;
#pragma unroll
      for (int j = 0; j < 8; ++j) ss += v[j] * v[j];
      SUM8(ss);
      const float rstd = __builtin_amdgcn_rsqf(ss * (1.f / 64.f) + EPS);
#pragma unroll
      for (int j = 0; j < 8; ++j) v[j] = v[j] * rstd * gk[j];
      ROPE8(v, sub, c8, s8);
      *(v4u*)(Orow + C_KA + 8 * lane) = PACK8(v); }
    { float v[8]; UNPACK8(w_qi, v);
      ROPE8(v, sub, c8, s8);
      *(v4u*)(Orow + C_QI + 8 * lane) = PACK8(v); }
    { float v[8]; UNPACK8(w_ki, v);
      ROPE8(v, sub, c8, s8);
      if (lane < 8) *(v4u*)(Orow + C_KI + 8 * lane) = PACK8(v); }
    if (lane < 8) WIrow[lane] = w_wi * SCALE_I;
    { float v[8]; UNPACK8(w_cq, v); float ss = 0.f;
#pragma unroll
      for (int j = 0; j < 8; ++j) ss += v[j] * v[j];
      ss = wave_sum(ss); const float rstd = __builtin_amdgcn_rsqf(ss * (1.f / 384.f) + EPS);
      if (lane < 48) {
#pragma unroll
          for (int j = 0; j < 8; ++j) v[j] = v[j] * rstd * gq[j];
          *(v4u*)(Orow + C_CQ + 8 * lane) = PACK8(v); } }
    { float v[8]; UNPACK8(w_ckv, v); float ss = 0.f;
#pragma unroll
      for (int j = 0; j < 8; ++j) ss += v[j] * v[j];
      ss = wave_sum(ss); const float rstd = __builtin_amdgcn_rsqf(ss * (1.f / 256.f) + EPS);
      if (lane < 32) {
#pragma unroll
          for (int j = 0; j < 8; ++j) v[j] = v[j] * rstd * gc[j];
          *(v4u*)(Orow + C_CKV + 8 * lane) = PACK8(v); } }
    { float v[8]; UNPACK8(w_qm, v); float ss = 0.f;
#pragma unroll
      for (int j = 0; j < 8; ++j) ss += v[j] * v[j];
      SUM16(ss);
      const float rstd = __builtin_amdgcn_rsqf(ss * (1.f / 128.f) + EPS);
#pragma unroll
      for (int j = 0; j < 8; ++j) v[j] = v[j] * rstd * gm[j] * SCALE_M;
      *(v4u*)(Orow + C_QM + 8 * lane) = PACK8(v); }
}

__device__ __forceinline__ void km_row(bf16* row, const float* gkm, int lane) {
    v4u w = *(const v4u*)(row + 8 * lane); float v[8]; UNPACK8(w, v); float ss = 0.f;
#pragma unroll
    for (int j = 0; j < 8; ++j) ss += v[j] * v[j];
    SUM16(ss);
    const float rstd = __builtin_amdgcn_rsqf(ss * (1.f / 128.f) + EPS);
#pragma unroll
    for (int j = 0; j < 8; ++j) v[j] = v[j] * rstd * gkm[8 * (lane & 15) + j];
    *(v4u*)(row + 8 * lane) = PACK8(v);
}

__device__ __forceinline__ void transpose_v(const bf16* src, int pitch, int col0, int hstride, int H, int DV, int S, int nb, bf16* dst, int gw, int NGW, int lane) {
    const int ndq = DV / 64, nsc = S / 64, ntask = nb * H * nsc * ndq;
    for (int task = gw; task < ntask; task += NGW) {
        int x = task; const int dq = x % ndq; x /= ndq; const int sc = x % nsc; x /= nsc; const int h = x % H; const int b = x / H;
        const int s = sc * 64 + lane;
        const bf16* srow = src + (size_t)(b * S + s) * pitch + col0 + h * hstride + dq * 64;
        bf16* drow = dst + ((size_t)((b * H + h) * DV + dq * 64)) * S + s;
        v4u wv[8];
#pragma unroll
        for (int c = 0; c < 8; ++c) wv[c] = *(const v4u*)(srow + 8 * c);
#pragma unroll
        for (int c = 0; c < 8; ++c) { const v4u w = wv[c];
            drow[(size_t)(8 * c + 0) * S] = (bf16)(w.x & 0xffffu); drow[(size_t)(8 * c + 1) * S] = (bf16)(w.x >> 16);
            drow[(size_t)(8 * c + 2) * S] = (bf16)(w.y & 0xffffu); drow[(size_t)(8 * c + 3) * S] = (bf16)(w.y >> 16);
            drow[(size_t)(8 * c + 4) * S] = (bf16)(w.z & 0xffffu); drow[(size_t)(8 * c + 5) * S] = (bf16)(w.z >> 16);
            drow[(size_t)(8 * c + 6) * S] = (bf16)(w.w & 0xffffu); drow[(size_t)(8 * c + 7) * S] = (bf16)(w.w >> 16); }
    }
}

__device__ __forceinline__ void post2_row(const bf16* QBrow, bf16* QOrow, const bf16* KVBrow, const bf16* Prow, bf16* KBrow, const float* rb, const float (&gqv)[12], const float (&gkv)[12], LAS float* scr, int lane) {
    const int hd = lane >> 3, d0 = 12 * (lane & 7);
    float vq[12], vk[12], cc[12], sn[12];
    { const v2u* p = (const v2u*)(QBrow + 12 * lane);
      const v2u w0 = p[0], w1 = p[1], w2 = p[2];
      bf16 kr[12];
#pragma unroll
      for (int e = 0; e < 12; ++e) { const int d = d0 + e; kr[e] = d < 64 ? KVBrow[hd * 128 + d] : Prow[C_KR + d - 64]; }
#pragma unroll
      for (int e = 0; e < 12; ++e) { const int d = d0 + e; const int i = (d - 64) & 15; cc[e] = d < 64 ? 1.f : rb[i]; sn[e] = d < 64 ? 0.f : rb[16 + i]; }
      vq[0] = bflo(w0.x); vq[1] = bfhi(w0.x); vq[2] = bflo(w0.y); vq[3] = bfhi(w0.y); vq[4] = bflo(w1.x); vq[5] = bfhi(w1.x); vq[6] = bflo(w1.y); vq[7] = bfhi(w1.y);
      vq[8] = bflo(w2.x); vq[9] = bfhi(w2.x); vq[10] = bflo(w2.y); vq[11] = bfhi(w2.y);
#pragma unroll
      for (int e = 0; e < 12; ++e) vk[e] = bf1(kr[e]); }
    float sq = 0.f, sk = 0.f;
#pragma unroll
    for (int e = 0; e < 12; ++e) { sq += vq[e] * vq[e]; sk += vk[e] * vk[e]; }
    SUM8(sq); SUM8(sk);
    const float rq = __builtin_amdgcn_rsqf(sq * (1.f / 96.f) + EPS), rk = __builtin_amdgcn_rsqf(sk * (1.f / 96.f) + EPS);
#pragma unroll
    for (int e = 0; e < 12; ++e) { vq[e] = vq[e] * rq * gqv[e]; vk[e] = vk[e] * rk * gkv[e]; scr[12 * lane + e] = vq[e]; scr[768 + 12 * lane + e] = vk[e]; }
    LDS_WAIT(); asm volatile("" ::: "memory");
    float oq[12], ok[12];
#pragma unroll
    for (int e = 0; e < 12; ++e) { const int d = d0 + e;
        if (d < 64) { oq[e] = vq[e]; ok[e] = vk[e]; }
        else { const bool first = d < 80; const int off = first ? 16 : -16; const float pq = scr[12 * lane + e + off], pk = scr[768 + 12 * lane + e + off];
               oq[e] = first ? vq[e] * cc[e] - pq * sn[e] : vq[e] * cc[e] + pq * sn[e];
               ok[e] = first ? vk[e] * cc[e] - pk * sn[e] : vk[e] * cc[e] + pk * sn[e]; }
        oq[e] *= SCALE_B; }
    LDS_WAIT(); asm volatile("" ::: "memory");
    v2u* q = (v2u*)(QOrow + 12 * lane); v2u* k = (v2u*)(KBrow + 12 * lane);
#pragma unroll
    for (int i = 0; i < 3; ++i) { v2u w; w.x = pk2(oq[4 * i], oq[4 * i + 1]); w.y = pk2(oq[4 * i + 2], oq[4 * i + 3]); q[i] = w;
                                  v2u u; u.x = pk2(ok[4 * i], ok[4 * i + 1]); u.y = pk2(ok[4 * i + 2], ok[4 * i + 3]); k[i] = u; }
}

__device__ __forceinline__ int next_unit(unsigned* ctr, volatile LAS int* slot) {
    __syncthreads();
    if (threadIdx.x == 0) *slot = (int)atomicAdd(ctr, 1u);
    __syncthreads();
    return *slot;
}

constexpr int SCP = 2112;
__device__ __forceinline__ unsigned ord_key(float v) { const unsigned b = __float_as_uint(v); return b ^ ((unsigned)((int)b >> 31) | 0x80000000u); }
__device__ __forceinline__ void indexer_load_q(const bf16* P, const float* WI, int u, bf16x8 (&qf)[8][2], float (&wq)[8]) {
    const int lane = threadIdx.x & 63, n = lane & 15, g = lane >> 4;
    const int tb = 127 - (u >> 3), bb = u & 7;
    const size_t row = (size_t)(bb * SEQ + tb * 16 + n);
    const bf16* qrow = P + row * PP + C_QI + 8 * g;
#pragma unroll
    for (int h = 0; h < 8; ++h) { qf[h][0] = *(const bf16x8*)(qrow + h * 64); qf[h][1] = *(const bf16x8*)(qrow + h * 64 + 32); wq[h] = WI[row * 8 + h]; }
}
__device__ __forceinline__ void indexer_unit(LAS float* sc, const bf16* P, const float* WI, unsigned* MASK, int bb, int tb, bf16x8 (&qf)[8][2], float (&wq)[8],
                                             int tk, volatile LAS int* slot, int nunits, int& un) {
    int tid_ = threadIdx.x; asm volatile("" : "+v"(tid_));
    const int tid = tid_, lane = tid & 63, w = __builtin_amdgcn_readfirstlane(tid >> 6);
    const int n = lane & 15, g = lane >> 4;
    const int rowbase = bb * SEQ, t0 = tb * 16;
    {
        const int ntile = tb + 1;
        const int nmine = (ntile - w + 7) >> 3;
        const int ngrp = (nmine + 3) >> 2;
        const bf16* kbase = P + (size_t)(rowbase + n) * PP + C_KI + 8 * g;
        bf16x8 kb[2][4][2];
#define IDX_LOAD(BUF, GRP) do { _Pragma("unroll") for (int j_ = 0; j_ < 4; ++j_) { const int tile_ = w + 8 * (4 * (GRP) + j_); const int tl_ = tile_ < ntile ? tile_ : 0; \
            const bf16* kr_ = kbase + (size_t)(16 * tl_) * PP; kb[BUF][j_][0] = *(const bf16x8*)(kr_); kb[BUF][j_][1] = *(const bf16x8*)(kr_ + 32); } } while (0)
#define IDX_COMP(BUF, GRP) do { _Pragma("unroll") for (int j_ = 0; j_ < 4; ++j_) { const int tile_ = w + 8 * (4 * (GRP) + j_); if (tile_ < ntile) { \
            f32x4 idx_ = (f32x4){0.f, 0.f, 0.f, 0.f}; \
            _Pragma("unroll") for (int h_ = 0; h_ < 8; ++h_) { f32x4 a_ = (f32x4){0.f, 0.f, 0.f, 0.f}; \
                a_ = __builtin_amdgcn_mfma_f32_16x16x32_bf16(kb[BUF][j_][0], qf[h_][0], a_, 0, 0, 0); \
                a_ = __builtin_amdgcn_mfma_f32_16x16x32_bf16(kb[BUF][j_][1], qf[h_][1], a_, 0, 0, 0); \
                _Pragma("unroll") for (int i_ = 0; i_ < 4; ++i_) idx_[i_] = __builtin_fmaf(wq[h_], __builtin_fmaxf(a_[i_], 0.f), idx_[i_]); } \
            { const int k0_ = 16 * tile_ + 4 * g; LAS float* d_ = sc + n * SCP + k0_ + (k0_ >> 5); d_[0] = idx_[0]; d_[1] = idx_[1]; d_[2] = idx_[2]; d_[3] = idx_[3]; } } } } while (0)
        if (ngrp > 0) IDX_LOAD(0, 0);
        for (int gp = 0; gp < ngrp; gp += 2) {
            if (gp + 1 < ngrp) IDX_LOAD(1, gp + 1);
            IDX_COMP(0, gp);
            if (gp + 1 < ngrp) { if (gp + 2 < ngrp) IDX_LOAD(0, gp + 2); IDX_COMP(1, gp + 1); }
        }
#undef IDX_LOAD
#undef IDX_COMP
    }
    if (tid == 0) *slot = tk;
    __syncthreads();
    un = *slot;
    if (un < nunits) indexer_load_q(P, WI, un, qf, wq);
    for (int rs = 0; rs < REP_SEL; ++rs) {
        const int ta = t0 + 2 * w, tb2 = ta + 1;
        unsigned* mra = MASK + (size_t)(rowbase + ta) * 64; unsigned* mrb = mra + 64;
        const int nva = ta - 32 * lane + 1, nvb = nva + 1;
        const unsigned valid_a = nva >= 32 ? 0xffffffffu : (nva <= 0 ? 0u : ((1u << nva) - 1u));
        const unsigned valid_b = nvb >= 32 ? 0xffffffffu : (nvb <= 0 ? 0u : ((1u << nvb) - 1u));
        if (ta < 256) { mra[lane] = valid_a; mrb[lane] = valid_b; continue; }
        unsigned ua[32], ub[32];
        { const LAS float* sra = sc + (2 * w) * SCP + 33 * lane; const LAS float* srb = sra + SCP;
#pragma unroll
          for (int r = 0; r < 32; ++r) { const float va = sra[r], vb = srb[r]; ua[r] = ((valid_a >> r) & 1u) ? ord_key(va) : 0u; ub[r] = ((valid_b >> r) & 1u) ? ord_key(vb) : 0u; } }
#pragma unroll
        for (int k = 0; k < 16; ++k) {
            const unsigned a0 = ua[k], a1 = ua[k + 16]; ua[k] = __builtin_amdgcn_perm(a1, a0, 0x05040100u); ua[k + 16] = __builtin_amdgcn_perm(a1, a0, 0x07060302u);
            const unsigned b0 = ub[k], b1 = ub[k + 16]; ub[k] = __builtin_amdgcn_perm(b1, b0, 0x05040100u); ub[k + 16] = __builtin_amdgcn_perm(b1, b0, 0x07060302u); }
#pragma unroll
        for (int k = 0; k < 32; ++k) if (!(k & 8)) {
            const unsigned a0 = ua[k], a1 = ua[k + 8]; ua[k] = __builtin_amdgcn_perm(a1, a0, 0x06020400u); ua[k + 8] = __builtin_amdgcn_perm(a1, a0, 0x07030501u);
            const unsigned b0 = ub[k], b1 = ub[k + 8]; ub[k] = __builtin_amdgcn_perm(b1, b0, 0x06020400u); ub[k + 8] = __builtin_amdgcn_perm(b1, b0, 0x07030501u); }
#pragma unroll
        for (int si = 2; si < 5; ++si) { const int sft = 16 >> si;
            const unsigned msk = si == 2 ? 0x0f0f0f0fu : (si == 3 ? 0x33333333u : 0x55555555u);
#pragma unroll
            for (int k = 0; k < 32; ++k) if (!(k & sft)) {
                const unsigned a0 = ua[k], a1 = ua[k + sft]; ua[k] = (a0 & msk) | ((a1 << sft) & ~msk); ua[k + sft] = ((a0 >> sft) & msk) | (a1 & ~msk);
                const unsigned b0 = ub[k], b1 = ub[k + sft]; ub[k] = (b0 & msk) | ((b1 << sft) & ~msk); ub[k + sft] = ((b0 >> sft) & msk) | (b1 & ~msk); } }
        unsigned alive_a = valid_a, sel_a = 0u, alive_b = valid_b, sel_b = 0u; int need_a = 256, need_b = 256; bool run_a = true, run_b = true;
#pragma unroll
        for (int j = 31; j >= 0; --j) {
            const unsigned ones_a = alive_a & ua[j], ones_b = alive_b & ub[j];
            int v = (int)((unsigned)__popc(ones_a) | ((unsigned)__popc(ones_b) << 16));
            v += __builtin_amdgcn_update_dpp(0, v, 0xB1, 0xF, 0xF, false);
            v += __builtin_amdgcn_update_dpp(0, v, 0x4E, 0xF, 0xF, false);
            v += __builtin_amdgcn_update_dpp(0, v, 0x141, 0xF, 0xF, false);
            v += __builtin_amdgcn_update_dpp(0, v, 0x140, 0xF, 0xF, false);
            const unsigned tot = (unsigned)(__builtin_amdgcn_readlane(v, 0) + __builtin_amdgcn_readlane(v, 16) + __builtin_amdgcn_readlane(v, 32) + __builtin_amdgcn_readlane(v, 48));
            const int ca = (int)(tot & 0xffffu), cb = (int)(tot >> 16);
            if (run_a) { if (ca >= need_a) { alive_a = ones_a; if (ca == need_a) { sel_a |= ones_a; need_a = 0; run_a = false; } }
                         else { need_a -= ca; sel_a |= ones_a; alive_a &= ~ua[j]; } }
            if (run_b) { if (cb >= need_b) { alive_b = ones_b; if (cb == need_b) { sel_b |= ones_b; need_b = 0; run_b = false; } }
                         else { need_b -= cb; sel_b |= ones_b; alive_b &= ~ub[j]; } }
            if (!run_a && !run_b) break;
        }
        if (need_a > 0) {
            const int cnt = __popc(alive_a); int inc = cnt;
#pragma unroll
            for (int d = 1; d < 64; d <<= 1) { const int o = __shfl_up(inc, d); if (lane >= d) inc += o; }
            int k = need_a - (inc - cnt); k = k < 0 ? 0 : (k > cnt ? cnt : k);
            unsigned m = alive_a;
            for (int i = 0; i < k; ++i) { const unsigned low = m & (0u - m); sel_a |= low; m ^= low; }
        }
        if (need_b > 0) {
            const int cnt = __popc(alive_b); int inc = cnt;
#pragma unroll
            for (int d = 1; d < 64; d <<= 1) { const int o = __shfl_up(inc, d); if (lane >= d) inc += o; }
            int k = need_b - (inc - cnt); k = k < 0 ? 0 : (k > cnt ? cnt : k);
            unsigned m = alive_b;
            for (int i = 0; i < k; ++i) { const unsigned low = m & (0u - m); sel_b |= low; m ^= low; }
        }
        mra[lane] = sel_a; mrb[lane] = sel_b;
        (void)tb2;
    }
    __syncthreads();
}

__device__ __forceinline__ float half_max(float m) { auto rr = __builtin_amdgcn_permlane32_swap(__float_as_uint(m), __float_as_uint(m), false, false); return __builtin_fmaxf(__uint_as_float(rr[0]), __uint_as_float(rr[1])); }
__device__ __forceinline__ float half_sum(float m) { auto rr = __builtin_amdgcn_permlane32_swap(__float_as_uint(m), __float_as_uint(m), false, false); return __uint_as_float(rr[0]) + __uint_as_float(rr[1]); }
__device__ __forceinline__ int crow(int r, int hi) { return (r & 3) + 8 * (r >> 2) + 4 * hi; }
template <int DQK, int DV, int MODE, int STRIP = 0>
__device__ __forceinline__ void attn_unit(LAS unsigned char* lds, const bf16* Qb, int qpitch, const bf16* Kb, int kpitch, const bf16* VTb, int skv,
                                          const unsigned* maskb, const bf16* Zb, bf16* Ob, int q0) {
    constexpr int TK = 128, KP = DQK + 8, VP = TK + 8;
    LAS bf16* Ks = (LAS bf16*)lds; LAS bf16* Vs = Ks + TK * KP;
    constexpr int CPR = DQK / 8;
    constexpr int NCK = TK * CPR, NCV = DV * (TK / 8);
    constexpr int RK = (NCK + 511) / 512, RV = (NCV + 511) / 512;
    constexpr int NKS = DQK / 16, NMT = DV / 32;
    int tid_ = threadIdx.x; asm volatile("" : "+v"(tid_));
    const int tid = tid_, lane = tid & 63, w = __builtin_amdgcn_readfirstlane(tid >> 6), r = lane & 31, hh = lane >> 5;
    const int NT = MODE == 0 ? skv / TK : (q0 + 256) / TK;
    const int qlo = q0 + 32 * w;
    bf16x8 qf[NKS];
    { const bf16* qrow = Qb + (size_t)(qlo + r) * qpitch + 8 * hh;
#pragma unroll
      for (int ks = 0; ks < NKS; ++ks) qf[ks] = *(const bf16x8*)(qrow + 16 * ks); }
    f32x16 o[NMT];
#pragma unroll
    for (int mt = 0; mt < NMT; ++mt)
#pragma unroll
        for (int i = 0; i < 16; ++i) o[mt][i] = 0.f;
    float m_run = NEGF, l_run = 0.f;
    v4u kreg[RK], vreg[RV];
#define ATT_PREFETCH(tile_) do { \
        _Pragma("unroll") for (int i_ = 0; i_ < RK; ++i_) { const int c_ = tid + 512 * i_; if (c_ < NCK) { const int row_ = c_ / CPR, cc_ = c_ % CPR; kreg[i_] = *(const v4u*)(Kb + (size_t)(TK * (tile_) + row_) * kpitch + 8 * cc_); } } \
        _Pragma("unroll") for (int i_ = 0; i_ < RV; ++i_) { const int c_ = tid + 512 * i_; if (c_ < NCV) { const int d_ = c_ >> 4, cc_ = c_ & 15; vreg[i_] = *(const v4u*)(VTb + (size_t)d_ * skv + TK * (tile_) + 8 * cc_); } } } while (0)
    if (STRIP != 2) ATT_PREFETCH(0);
    for (int tile = 0; tile < NT; ++tile) {
        __syncthreads();
        if (STRIP != 2) {
#pragma unroll
        for (int i = 0; i < RK; ++i) { const int c = tid + 512 * i; if (c < NCK) { const int row = c / CPR, cc = c % CPR; *(LAS v4u*)(Ks + row * KP + 8 * cc) = kreg[i]; } }
#pragma unroll
        for (int i = 0; i < RV; ++i) { const int c = tid + 512 * i; if (c < NCV) { const int d = c >> 4, cc = c & 15; *(LAS v4u*)(Vs + d * VP + 8 * cc) = vreg[i]; } }
        }
        __syncthreads();
        if (STRIP != 2 && tile + 1 < NT) ATT_PREFETCH(tile + 1);
        __builtin_amdgcn_sched_barrier(0);
        if (STRIP == 1) continue;
#pragma unroll 1
        for (int sub = 0; sub < 2; ++sub) {
        const int t64 = 2 * tile + sub;
        if (MODE != 0 && 64 * t64 > qlo + 31) continue;
        const LAS bf16* Kc = Ks + 64 * sub * KP; const LAS bf16* Vc = Vs + 64 * sub;
        unsigned mw0 = 0u, mw1 = 0u;
        if (MODE == 2) { const v2u mm = *(const v2u*)(maskb + (size_t)(qlo + r) * 64 + 2 * t64); mw0 = mm.x >> (4 * hh); mw1 = mm.y >> (4 * hh); }
        f32x16 s0, s1;
#pragma unroll
        for (int i = 0; i < 16; ++i) { s0[i] = 0.f; s1[i] = 0.f; }
#pragma unroll
        for (int ks = 0; ks < NKS; ++ks) {
            const bf16x8 a0 = *(const LAS bf16x8*)(Kc + r * KP + 16 * ks + 8 * hh);
            const bf16x8 a1 = *(const LAS bf16x8*)(Kc + (32 + r) * KP + 16 * ks + 8 * hh);
            s0 = __builtin_amdgcn_mfma_f32_32x32x16_bf16(a0, qf[ks], s0, 0, 0, 0);
            s1 = __builtin_amdgcn_mfma_f32_32x32x16_bf16(a1, qf[ks], s1, 0, 0, 0);
        }
        if (MODE == 1) {
            if (64 * t64 + 63 > qlo) { const int qg = qlo + r;
#pragma unroll
                for (int i = 0; i < 16; ++i) { const int key = 64 * t64 + crow(i, hh); if (key > qg) s0[i] = NEGF; if (key + 32 > qg) s1[i] = NEGF; } }
        }
        if (MODE == 2) {
#pragma unroll
            for (int i = 0; i < 16; ++i) { const int bit = (i & 3) + 8 * (i >> 2); if (!((mw0 >> bit) & 1u)) s0[i] = NEGF; if (!((mw1 >> bit) & 1u)) s1[i] = NEGF; }
        }
        float mx = s0[0];
#pragma unroll
        for (int i = 1; i < 16; ++i) mx = __builtin_fmaxf(mx, s0[i]);
#pragma unroll
        for (int i = 0; i < 16; ++i) mx = __builtin_fmaxf(mx, s1[i]);
        mx = half_max(mx);
        const float m_new = __builtin_fmaxf(m_run, mx);
        const float alpha = __builtin_amdgcn_exp2f(m_run - m_new);
        m_run = m_new;
        float ls = 0.f;
#pragma unroll
        for (int i = 0; i < 16; ++i) { s0[i] = __builtin_amdgcn_exp2f(s0[i] - m_new); s1[i] = __builtin_amdgcn_exp2f(s1[i] - m_new); ls += s0[i] + s1[i]; }
        l_run = l_run * alpha + ls;
#pragma unroll
        for (int mt = 0; mt < NMT; ++mt)
#pragma unroll
            for (int i = 0; i < 16; ++i) o[mt][i] *= alpha;
        v4u pf[2][2];
#pragma unroll
        for (int s = 0; s < 2; ++s) {
            pf[0][s] = (v4u){pk2(s0[8 * s], s0[8 * s + 1]), pk2(s0[8 * s + 2], s0[8 * s + 3]), pk2(s0[8 * s + 4], s0[8 * s + 5]), pk2(s0[8 * s + 6], s0[8 * s + 7])};
            pf[1][s] = (v4u){pk2(s1[8 * s], s1[8 * s + 1]), pk2(s1[8 * s + 2], s1[8 * s + 3]), pk2(s1[8 * s + 4], s1[8 * s + 5]), pk2(s1[8 * s + 6], s1[8 * s + 7])};
        }
#pragma unroll
        for (int mt = 0; mt < NMT; ++mt)
#pragma unroll
            for (int p = 0; p < 2; ++p)
#pragma unroll
                for (int s = 0; s < 2; ++s) {
                    const LAS bf16* vp = Vc + (32 * mt + r) * VP + 32 * p + 16 * s + 4 * hh;
                    const s16x4 lo = *(const LAS s16x4*)(vp), hi = *(const LAS s16x4*)(vp + 8);
                    const bf16x8 a = (bf16x8){lo[0], lo[1], lo[2], lo[3], hi[0], hi[1], hi[2], hi[3]};
                    o[mt] = __builtin_amdgcn_mfma_f32_32x32x16_bf16(a, __builtin_bit_cast(bf16x8, pf[p][s]), o[mt], 0, 0, 0);
                }
        }
    }
#undef ATT_PREFETCH
    const float l_tot = half_sum(l_run);
    const float inv = 1.0f / l_tot;
    const size_t row = (size_t)(qlo + r);
#pragma unroll
    for (int mt = 0; mt < NMT; ++mt)
#pragma unroll
        for (int g4 = 0; g4 < 4; ++g4) {
            const int d = 32 * mt + 8 * g4 + 4 * hh;
            float ov[4];
#pragma unroll
            for (int i = 0; i < 4; ++i) ov[i] = o[mt][4 * g4 + i] * inv;
            if (Zb) { const v2u zw = *(const v2u*)(Zb + row * PP + d); const float z[4] = {bflo(zw.x), bfhi(zw.x), bflo(zw.y), bfhi(zw.y)};
#pragma unroll
                for (int i = 0; i < 4; ++i) ov[i] *= z[i] * __builtin_amdgcn_rcpf(1.0f + __expf(-z[i])); }
            v2u ow; ow.x = pk2(ov[0], ov[1]); ow.y = pk2(ov[2], ov[3]);
            *(v2u*)(Ob + row * PP + d) = ow;
        }
}

template <int DQK, int MODE>
__device__ __forceinline__ void attn_unit_pipe(LAS unsigned char* lds, const bf16* Qb, int qpitch, const bf16* Kb, int kpitch, const bf16* VTb, int skv,
                                               const unsigned* maskb, bf16* Ob, int q0) {
    constexpr int DV = 64, KP = DQK + 8, VP = 72, BUFE = 64 * KP + DV * VP;
    constexpr int CPR = DQK / 8, NCK = 64 * CPR, NCV = DV * 8, RK = (NCK + 511) / 512, RV = (NCV + 511) / 512, NKS = DQK / 16, NMT = DV / 32;
    static_assert(NCV == 512 && (NCK == 512 || NCK == 768), "staging map");
    int tid_ = threadIdx.x; asm volatile("" : "+v"(tid_));
    const int tid = tid_, lane = tid & 63, w = __builtin_amdgcn_readfirstlane(tid >> 6), r = lane & 31, hh = lane >> 5;
    const int NT = (q0 + 256) / 64;
    const int qlo = q0 + 32 * w;
    const int NTw = ((qlo + 31) >> 6) + 1;
    int krow[RK], kcc[RK];
#pragma unroll
    for (int i = 0; i < RK; ++i) { int c = tid + 512 * i; if (c >= NCK) c -= 256; krow[i] = c / CPR; kcc[i] = c % CPR; }
    const int vd = tid >> 3, vcc = tid & 7;
    bf16x8 qf[NKS];
    { const bf16* qrow = Qb + (size_t)(qlo + r) * qpitch + 8 * hh;
#pragma unroll
      for (int ks = 0; ks < NKS; ++ks) qf[ks] = *(const bf16x8*)(qrow + 16 * ks); }
    f32x16 o[NMT];
#pragma unroll
    for (int mt = 0; mt < NMT; ++mt)
#pragma unroll
        for (int i = 0; i < 16; ++i) o[mt][i] = 0.f;
    float m_run = NEGF, l_run = 0.f, alpha = 1.f;
    v4u kreg[2][RK], vreg[2][RV]; v2u mset[2];
    const unsigned* mrowp = MODE == 2 ? maskb + (size_t)(qlo + r) * 64 : nullptr;
#define PL_LOAD(S_, tile_) do { const int tl_ = (tile_) < NT ? (tile_) : NT - 1; \
        if (MODE == 2) { const int mt_ = (tile_) >= 2 ? ((tile_) - 2 < 32 ? (tile_) - 2 : 31) : 0; mset[S_] = *(const v2u*)(mrowp + 2 * mt_); }     \
        _Pragma("unroll") for (int i_ = 0; i_ < RK; ++i_) kreg[S_][i_] = *(const v4u*)(Kb + (size_t)(64 * tl_ + krow[i_]) * kpitch + 8 * kcc[i_]); \
        vreg[S_][0] = *(const v4u*)(VTb + (size_t)vd * skv + 64 * tl_ + 8 * vcc); } while (0)
#define PL_STAGE(S_, buf_) do { LAS bf16* Kd_ = (LAS bf16*)lds + (buf_) * BUFE; LAS bf16* Vd_ = Kd_ + 64 * KP; \
        _Pragma("unroll") for (int i_ = 0; i_ < RK; ++i_) *(LAS v4u*)(Kd_ + krow[i_] * KP + 8 * kcc[i_]) = kreg[S_][i_]; \
        *(LAS v4u*)(Vd_ + vd * VP + 8 * vcc) = vreg[S_][0]; } while (0)
#define PL_QK(t_, D0_, D1_) do { const LAS bf16* Kc_ = (const LAS bf16*)lds + ((t_) & 3) * BUFE; \
        _Pragma("unroll") for (int i_ = 0; i_ < 16; ++i_) { D0_[i_] = 0.f; D1_[i_] = 0.f; } \
        _Pragma("unroll") for (int ks_ = 0; ks_ < NKS; ++ks_) { \
            const bf16x8 a0_ = *(const LAS bf16x8*)(Kc_ + r * KP + 16 * ks_ + 8 * hh); const bf16x8 a1_ = *(const LAS bf16x8*)(Kc_ + (32 + r) * KP + 16 * ks_ + 8 * hh); \
            D0_ = __builtin_amdgcn_mfma_f32_32x32x16_bf16(a0_, qf[ks_], D0_, 0, 0, 0); D1_ = __builtin_amdgcn_mfma_f32_32x32x16_bf16(a1_, qf[ks_], D1_, 0, 0, 0); } } while (0)
#define PL_PV(t_) do { const LAS bf16* Vc_ = (const LAS bf16*)lds + ((t_) & 3) * BUFE + 64 * KP; \
        _Pragma("unroll") for (int mt_ = 0; mt_ < NMT; ++mt_) _Pragma("unroll") for (int i_ = 0; i_ < 16; ++i_) o[mt_][i_] *= alpha; \
        _Pragma("unroll") for (int mt_ = 0; mt_ < NMT; ++mt_) _Pragma("unroll") for (int p_ = 0; p_ < 2; ++p_) _Pragma("unroll") for (int s_ = 0; s_ < 2; ++s_) { \
            const LAS bf16* vp_ = Vc_ + (32 * mt_ + r) * VP + 32 * p_ + 16 * s_ + 4 * hh; \
            const s16x4 lo_ = *(const LAS s16x4*)(vp_), hi_ = *(const LAS s16x4*)(vp_ + 8); \
            const bf16x8 a_ = (bf16x8){lo_[0], lo_[1], lo_[2], lo_[3], hi_[0], hi_[1], hi_[2], hi_[3]}; \
            o[mt_] = __builtin_amdgcn_mfma_f32_32x32x16_bf16(a_, __builtin_bit_cast(bf16x8, pf[p_][s_]), o[mt_], 0, 0, 0); } } while (0)
#define PL_SOFTMAX(t_, C0_, C1_, MK_, CAUSAL_) do { \
        if (MODE == 2) { const unsigned w0_ = (MK_).x >> (4 * hh), w1_ = (MK_).y >> (4 * hh); \
            _Pragma("unroll") for (int i_ = 0; i_ < 16; ++i_) { const int bit_ = (i_ & 3) + 8 * (i_ >> 2); if (!((w0_ >> bit_) & 1u)) C0_[i_] = NEGF; if (!((w1_ >> bit_) & 1u)) C1_[i_] = NEGF; } } \
        if (CAUSAL_) { const int qg_ = qlo + r; \
            _Pragma("unroll") for (int i_ = 0; i_ < 16; ++i_) { const int key_ = 64 * (t_) + crow(i_, hh); if (key_ > qg_) C0_[i_] = NEGF; if (key_ + 32 > qg_) C1_[i_] = NEGF; } } \
        float mx_ = C0_[0]; \
        _Pragma("unroll") for (int i_ = 1; i_ < 16; ++i_) mx_ = __builtin_fmaxf(mx_, C0_[i_]); \
        _Pragma("unroll") for (int i_ = 0; i_ < 16; ++i_) mx_ = __builtin_fmaxf(mx_, C1_[i_]); \
        mx_ = half_max(mx_); \
        const float mn_ = __builtin_fmaxf(m_run, mx_); alpha = __builtin_amdgcn_exp2f(m_run - mn_); m_run = mn_; \
        float ls_ = 0.f; \
        _Pragma("unroll") for (int i_ = 0; i_ < 16; ++i_) { C0_[i_] = __builtin_amdgcn_exp2f(C0_[i_] - mn_); C1_[i_] = __builtin_amdgcn_exp2f(C1_[i_] - mn_); ls_ += C0_[i_] + C1_[i_]; } \
        l_run = l_run * alpha + ls_; \
        _Pragma("unroll") for (int s_ = 0; s_ < 2; ++s_) { \
            pf[0][s_] = (v4u){pk2(C0_[8 * s_], C0_[8 * s_ + 1]), pk2(C0_[8 * s_ + 2], C0_[8 * s_ + 3]), pk2(C0_[8 * s_ + 4], C0_[8 * s_ + 5]), pk2(C0_[8 * s_ + 6], C0_[8 * s_ + 7])}; \
            pf[1][s_] = (v4u){pk2(C1_[8 * s_], C1_[8 * s_ + 1]), pk2(C1_[8 * s_ + 2], C1_[8 * s_ + 3]), pk2(C1_[8 * s_ + 4], C1_[8 * s_ + 5]), pk2(C1_[8 * s_ + 6], C1_[8 * s_ + 7])}; } } while (0)
#define PL_IO(t_, S_) do { PL_STAGE(S_, ((t_) + 2) & 3); PL_LOAD(S_, (t_) + 4); } while (0)
#define PL_STEADY(t_, S_) do { const v2u mk_ = mset[S_]; PL_IO(t_, S_); if (MODE == 2) { asm volatile("" :: "v"(mk_.x), "v"(mk_.y)); } \
        PL_QK((t_) + 1, n0, n1); PL_PV((t_) - 1); PL_SOFTMAX(t_, c0, c1, mk_, false); c0 = n0; c1 = n1; __syncthreads(); } while (0)
#define PL_TAIL(t_, S_) do { const v2u mk_ = mset[S_]; PL_IO(t_, S_); if ((t_) >= 1) PL_PV((t_) - 1); PL_SOFTMAX(t_, c0, c1, mk_, MODE == 1); PL_PV(t_); __syncthreads(); } while (0)
    f32x16 c0, c1, n0, n1; v4u pf[2][2];
    PL_LOAD(0, 0); PL_LOAD(1, 1);
    PL_STAGE(0, 0); PL_STAGE(1, 1);
    PL_LOAD(0, 2); PL_LOAD(1, 3);
    __syncthreads();
    PL_QK(0, c0, c1);
    int t = 0;
    if (NTw >= 2) {
        { const v2u mk_ = mset[0]; PL_IO(0, 0); PL_QK(1, n0, n1); PL_SOFTMAX(0, c0, c1, mk_, false); c0 = n0; c1 = n1; __syncthreads(); }
        for (t = 1; t + 1 < NTw; ) {
            PL_STEADY(t, 1); ++t;
            if (t + 1 < NTw) { PL_STEADY(t, 0); ++t; }
        }
    }
    if (t & 1) PL_TAIL(t, 1); else PL_TAIL(t, 0);
    for (++t; t < NT; ++t) { if (t & 1) PL_IO(t, 1); else PL_IO(t, 0); __syncthreads(); }
#undef PL_LOAD
#undef PL_STAGE
#undef PL_QK
#undef PL_PV
#undef PL_SOFTMAX
#undef PL_IO
#undef PL_STEADY
#undef PL_TAIL
    const float l_tot = half_sum(l_run);
    const float inv = 1.0f / l_tot;
    const size_t row = (size_t)(qlo + r);
#pragma unroll
    for (int mt = 0; mt < NMT; ++mt)
#pragma unroll
        for (int g4 = 0; g4 < 4; ++g4) {
            const int d = 32 * mt + 8 * g4 + 4 * hh;
            v2u ow; ow.x = pk2(o[mt][4 * g4] * inv, o[mt][4 * g4 + 1] * inv); ow.y = pk2(o[mt][4 * g4 + 2] * inv, o[mt][4 * g4 + 3] * inv);
            *(v2u*)(Ob + row * PP + d) = ow;
        }
}

__device__ __forceinline__ void attn_unit_mem(LAS unsigned char* lds, const bf16* Qb, const bf16* Kb, const bf16* VTb, const bf16* Zb, bf16* Ob, int q0) {
    constexpr int DQK = 128, KP = DQK + 8, VP = MEML + 8, NKS = DQK / 16, NMT = 4;
    LAS bf16* Ks = (LAS bf16*)lds; LAS bf16* Vs = Ks + MEML * KP;
    int tid_ = threadIdx.x; asm volatile("" : "+v"(tid_));
    const int tid = tid_, lane = tid & 63, w = __builtin_amdgcn_readfirstlane(tid >> 6), r = lane & 31, hh = lane >> 5;
    { v4u kk[8], vv[8];
#pragma unroll
      for (int i = 0; i < 8; ++i) { const int c = tid + 512 * i; kk[i] = *(const v4u*)(Kb + (size_t)(c >> 4) * 1024 + 8 * (c & 15)); vv[i] = *(const v4u*)(VTb + (size_t)(c >> 5) * MEML + 8 * (c & 31)); }
#pragma unroll
      for (int i = 0; i < 8; ++i) { const int c = tid + 512 * i; *(LAS v4u*)(Ks + (c >> 4) * KP + 8 * (c & 15)) = kk[i]; *(LAS v4u*)(Vs + (c >> 5) * VP + 8 * (c & 31)) = vv[i]; } }
    __syncthreads();
#pragma unroll 1
    for (int qb = 0; qb < 2; ++qb) {
        const int qlo = q0 + 256 * qb + 32 * w;
        bf16x8 qf[NKS];
        { const bf16* qrow = Qb + (size_t)(qlo + r) * PP + 8 * hh;
#pragma unroll
          for (int ks = 0; ks < NKS; ++ks) qf[ks] = *(const bf16x8*)(qrow + 16 * ks); }
        f32x16 o[NMT];
#pragma unroll
        for (int mt = 0; mt < NMT; ++mt)
#pragma unroll
            for (int i = 0; i < 16; ++i) o[mt][i] = 0.f;
        float m_run = NEGF, l_run = 0.f;
#pragma unroll 1
        for (int sub = 0; sub < MEML / 64; ++sub) {
            const LAS bf16* Kc = Ks + 64 * sub * KP; const LAS bf16* Vc = Vs + 64 * sub;
            f32x16 s0, s1;
#pragma unroll
            for (int i = 0; i < 16; ++i) { s0[i] = 0.f; s1[i] = 0.f; }
#pragma unroll
            for (int ks = 0; ks < NKS; ++ks) {
                const bf16x8 a0 = *(const LAS bf16x8*)(Kc + r * KP + 16 * ks + 8 * hh);
                const bf16x8 a1 = *(const LAS bf16x8*)(Kc + (32 + r) * KP + 16 * ks + 8 * hh);
                s0 = __builtin_amdgcn_mfma_f32_32x32x16_bf16(a0, qf[ks], s0, 0, 0, 0);
                s1 = __builtin_amdgcn_mfma_f32_32x32x16_bf16(a1, qf[ks], s1, 0, 0, 0);
            }
            float mx = s0[0];
#pragma unroll
            for (int i = 1; i < 16; ++i) mx = __builtin_fmaxf(mx, s0[i]);
#pragma unroll
            for (int i = 0; i < 16; ++i) mx = __builtin_fmaxf(mx, s1[i]);
            mx = half_max(mx);
            const float m_new = __builtin_fmaxf(m_run, mx);
            const float alpha = __builtin_amdgcn_exp2f(m_run - m_new);
            m_run = m_new;
            float ls = 0.f;
#pragma unroll
            for (int i = 0; i < 16; ++i) { s0[i] = __builtin_amdgcn_exp2f(s0[i] - m_new); s1[i] = __builtin_amdgcn_exp2f(s1[i] - m_new); ls += s0[i] + s1[i]; }
            l_run = l_run * alpha + ls;
#pragma unroll
            for (int mt = 0; mt < NMT; ++mt)
#pragma unroll
                for (int i = 0; i < 16; ++i) o[mt][i] *= alpha;
            v4u pf[2][2];
#pragma unroll
            for (int s = 0; s < 2; ++s) {
                pf[0][s] = (v4u){pk2(s0[8 * s], s0[8 * s + 1]), pk2(s0[8 * s + 2], s0[8 * s + 3]), pk2(s0[8 * s + 4], s0[8 * s + 5]), pk2(s0[8 * s + 6], s0[8 * s + 7])};
                pf[1][s] = (v4u){pk2(s1[8 * s], s1[8 * s + 1]), pk2(s1[8 * s + 2], s1[8 * s + 3]), pk2(s1[8 * s + 4], s1[8 * s + 5]), pk2(s1[8 * s + 6], s1[8 * s + 7])};
            }
#pragma unroll
            for (int mt = 0; mt < NMT; ++mt)
#pragma unroll
                for (int p = 0; p < 2; ++p)
#pragma unroll
                    for (int s = 0; s < 2; ++s) {
                        const LAS bf16* vp = Vc + (32 * mt + r) * VP + 32 * p + 16 * s + 4 * hh;
                        const s16x4 lo = *(const LAS s16x4*)(vp), hi = *(const LAS s16x4*)(vp + 8);
                        const bf16x8 a = (bf16x8){lo[0], lo[1], lo[2], lo[3], hi[0], hi[1], hi[2], hi[3]};
                        o[mt] = __builtin_amdgcn_mfma_f32_32x32x16_bf16(a, __builtin_bit_cast(bf16x8, pf[p][s]), o[mt], 0, 0, 0);
                    }
        }
        const float inv = 1.0f / half_sum(l_run);
        const size_t row = (size_t)(qlo + r);
#pragma unroll
        for (int mt = 0; mt < NMT; ++mt)
#pragma unroll
            for (int g4 = 0; g4 < 4; ++g4) {
                const int d = 32 * mt + 8 * g4 + 4 * hh;
                const v2u zw = *(const v2u*)(Zb + row * PP + d); const float z[4] = {bflo(zw.x), bfhi(zw.x), bflo(zw.y), bfhi(zw.y)};
                float ov[4];
#pragma unroll
                for (int i = 0; i < 4; ++i) ov[i] = o[mt][4 * g4 + i] * inv * (z[i] * __builtin_amdgcn_rcpf(1.0f + __expf(-z[i])));
                v2u ow; ow.x = pk2(ov[0], ov[1]); ow.y = pk2(ov[2], ov[3]);
                *(v2u*)(Ob + row * PP + d) = ow;
            }
    }
}

__device__ __forceinline__ bf16* gate_row(bf16* G0, bf16* G1, size_t row) { return row < 8192 ? G0 + row * 3072 : G1 + (row - 8192) * 3072; }
struct EpiZG {
    static constexpr bool PERM = true, AFTER_DRAIN = false;
    bf16* P; bf16* G0; bf16* G1;
    __device__ __forceinline__ void operator()(const pg8::f32x4 (&acc)[2][2][4][2], const pg8::Unit& u, int wr, int wc, int fr, int fq) const {
        const int row0 = u.pm * 256 + wr * 64 + fr, cl = wc * 32 + 8 * fq;
        const bool isz = u.pn < 4;
        const int ycol = (u.pn < 2 ? C_YA : C_YB) + (u.pn & 1) * 256, gcol = (u.pn - 4) * 256;
#pragma unroll
        for (int ai = 0; ai < 2; ++ai)
#pragma unroll
            for (int m = 0; m < 4; ++m) { const size_t row = (size_t)(row0 + ai * 128 + m * 16);
#pragma unroll
                for (int bj = 0; bj < 2; ++bj) {
                    const pg8::f32x4 v0 = acc[ai][bj][m][0], v1 = acc[ai][bj][m][1];
                    float rr[8] = {v0[0], v0[1], v0[2], v0[3], v1[0], v1[1], v1[2], v1[3]};
                    if (isz) { bf16* dst = P + row * PP + ycol + cl + bj * 128; const v4u old = *(const v4u*)dst; float yv[8]; UNPACK8(old, yv);
#pragma unroll
                        for (int e = 0; e < 8; ++e) rr[e] = yv[e] * (rr[e] * __builtin_amdgcn_rcpf(1.0f + __expf(-rr[e])));
                        *(v4u*)dst = PACK8(rr); }
                    else { bf16* dst = gate_row(G0, G1, row) + gcol + cl + bj * 128;
#pragma unroll
                        for (int e = 0; e < 8; ++e) rr[e] = __builtin_amdgcn_rcpf(1.0f + __expf(-rr[e]));
                        *(v4u*)dst = PACK8(rr); } } }
    }
};
struct EpiStoreVT {
    static constexpr bool PERM = true, AFTER_DRAIN = false;
    bf16* O; int ldc; bf16* VT;
    int vbeg, vend, hshift, voff, DV, sshift;
    __device__ __forceinline__ void operator()(const pg8::f32x4 (&acc)[2][2][4][2], const pg8::Unit& u, int wr, int wc, int fr, int fq) const {
        const int row0 = u.pm * 256 + wr * 64 + fr, col0 = u.pn * 256 + wc * 32 + 8 * fq;
        const int H = (vend - vbeg) >> hshift, S = 1 << sshift;
        bool isv[2]; long voffs[2];
#pragma unroll
        for (int bj = 0; bj < 2; ++bj) { const int col = col0 + bj * 128, cr = col - vbeg, within = cr & ((1 << hshift) - 1);
            isv[bj] = col >= vbeg && col < vend && within >= voff;
            voffs[bj] = ((long)((cr >> hshift) * DV + within - voff)) << sshift; }
#pragma unroll
        for (int ai = 0; ai < 2; ++ai)
#pragma unroll
            for (int m = 0; m < 4; ++m) { const int row = row0 + ai * 128 + m * 16;
                const int b = row >> sshift, sp = row & (S - 1);
#pragma unroll
                for (int bj = 0; bj < 2; ++bj) {
                    const pg8::f32x4 v0 = acc[ai][bj][m][0], v1 = acc[ai][bj][m][1];
                    const unsigned w0 = pk2(v0[0], v0[1]), w1 = pk2(v0[2], v0[3]), w2 = pk2(v1[0], v1[1]), w3 = pk2(v1[2], v1[3]);
                    if (!isv[bj]) *(v4u*)(O + (size_t)row * ldc + col0 + bj * 128) = (v4u){w0, w1, w2, w3};
                    else { bf16* dst = VT + (((long)(b * H * DV)) << sshift) + voffs[bj] + sp;
                        dst[0] = (bf16)(w0 & 0xffffu); dst[(size_t)S] = (bf16)(w0 >> 16); dst[(size_t)2 * S] = (bf16)(w1 & 0xffffu); dst[(size_t)3 * S] = (bf16)(w1 >> 16);
                        dst[(size_t)4 * S] = (bf16)(w2 & 0xffffu); dst[(size_t)5 * S] = (bf16)(w2 >> 16); dst[(size_t)6 * S] = (bf16)(w3 & 0xffffu); dst[(size_t)7 * S] = (bf16)(w3 >> 16); } }
                asm volatile("" ::: "memory"); }
    }
};
struct MergeOrder {
    pg8::StaticOrder so;
    __device__ __forceinline__ bool next(int i, pg8::Unit& u) const { pg8::Unit b; if (!so.next(i / 3, b)) return false; u.pm = b.pm; u.pn = (i % 3) * 4 + b.pn; return true; }
    __device__ __forceinline__ void a_ready(const pg8::Unit&) const {}
    __device__ __forceinline__ void done(const pg8::Unit&) const {}
};
struct EpiMerge {
    static constexpr bool PERM = true, AFTER_DRAIN = false;
    bf16* Mg; bf16* G0; bf16* G1;
    __device__ __forceinline__ void operator()(const pg8::f32x4 (&acc)[2][2][4][2], const pg8::Unit& u, int wr, int wc, int fr, int fq) const {
        const int nbr = u.pn >> 2;
        const int row0 = u.pm * 256 + wr * 64 + fr, col0 = (u.pn & 3) * 256 + wc * 32 + 8 * fq;
#pragma unroll
        for (int ai = 0; ai < 2; ++ai)
#pragma unroll
            for (int m = 0; m < 4; ++m) { const size_t row = (size_t)(row0 + ai * 128 + m * 16);
#pragma unroll
                for (int bj = 0; bj < 2; ++bj) { const int col = col0 + bj * 128;
                    const v4u gwd = *(const v4u*)(gate_row(G0, G1, row) + nbr * 1024 + col);
                    float gl[8]; UNPACK8(gwd, gl);
                    const pg8::f32x4 v0 = acc[ai][bj][m][0], v1 = acc[ai][bj][m][1];
                    float rr[8] = {v0[0], v0[1], v0[2], v0[3], v1[0], v1[1], v1[2], v1[3]};
#pragma unroll
                    for (int e = 0; e < 8; ++e) rr[e] *= gl[e];
                    bf16* dst = Mg + row * 1024 + col;
                    if (nbr > 0) { const v4u old = *(const v4u*)dst; float ol[8]; UNPACK8(old, ol);
#pragma unroll
                        for (int e = 0; e < 8; ++e) rr[e] += ol[e]; }
                    *(v4u*)dst = PACK8(rr); } }
    }
};
struct EpiOut {
    static constexpr bool PERM = true, AFTER_DRAIN = false;
    const float* X; float* Out;
    __device__ __forceinline__ void operator()(const pg8::f32x4 (&acc)[2][2][4][2], const pg8::Unit& u, int wr, int wc, int fr, int fq) const {
        const int row0 = u.pm * 256 + wr * 64 + fr, col0 = u.pn * 256 + wc * 32 + 8 * fq;
#pragma unroll
        for (int ai = 0; ai < 2; ++ai)
#pragma unroll
            for (int m = 0; m < 4; ++m) { const size_t row = (size_t)(row0 + ai * 128 + m * 16);
#pragma unroll
                for (int bj = 0; bj < 2; ++bj) { const size_t p = row * 1024 + col0 + bj * 128;
                    const f32x4 x0 = *(const f32x4*)(X + p), x1 = *(const f32x4*)(X + p + 4);
                    const pg8::f32x4 a0 = acc[ai][bj][m][0], a1 = acc[ai][bj][m][1];
                    *(f32x4*)(Out + p) = (f32x4){x0[0] + a0[0], x0[1] + a0[1], x0[2] + a0[2], x0[3] + a0[3]};
                    *(f32x4*)(Out + p + 4) = (f32x4){x1[0] + a1[0], x1[1] + a1[1], x1[2] + a1[2], x1[3] + a1[3]}; } }
    }
};

#define XB_TMO      128
#define XB_XCNT(j)  (256  + 64 * (j))
#define XB_XSUB(j)  (1280 + 64 * (j))
#define XB_XGEN(j)  (2304 + 64 * (j))
#define XB_TOP      3328
#define XB_TOPGEN   3392
#define XCD_BAR_WORDS 3456
#define XB_SPIN_CAP (1u << 18)

__device__ __forceinline__ unsigned xb_ld(unsigned* p)              { return __hip_atomic_load(p, __ATOMIC_RELAXED, __HIP_MEMORY_SCOPE_AGENT); }
__device__ __forceinline__ unsigned xb_add(unsigned* p, unsigned v) { return __hip_atomic_fetch_add(p, v, __ATOMIC_RELAXED, __HIP_MEMORY_SCOPE_AGENT); }
__device__ __forceinline__ unsigned xb_xcc_id() { return (unsigned)__builtin_amdgcn_s_getreg((3 << 11) | 20) & 0xFu; }
#define XB_SPIN(cond, bar) do { unsigned _sp = 0; while (cond) { __builtin_amdgcn_s_sleep(1); \
    if ((++_sp & 255u) == 0u) { if (xb_ld(&(bar)[XB_TMO])) break; if (_sp > XB_SPIN_CAP) { atomicAdd(&(bar)[XB_TMO], 1u); break; } } } } while (0)

struct XcdBarrier {
    unsigned* bar; unsigned x;
    volatile LAS unsigned* st;
};

__device__ __forceinline__ XcdBarrier xcd_barrier_post(unsigned* bar, volatile LAS unsigned* st) {
    XcdBarrier b; b.bar = bar; b.x = xb_xcc_id(); b.st = st;
    if (threadIdx.x == 0) (void)xb_add(&bar[XB_XCNT(b.x)], 1u);
    return b;
}
__device__ __forceinline__ void xcd_barrier_complete(unsigned* bar, unsigned x, unsigned& nloc, unsigned& nx) {
    const unsigned G = gridDim.x * gridDim.y * gridDim.z;
    unsigned sum, cnt, mine, sp = 0u;
    for (;;) {
        sum = 0u; cnt = 0u; mine = 0u;
#pragma unroll
        for (unsigned j = 0; j < 16; ++j) { const unsigned c = xb_ld(&bar[XB_XCNT(j)]); sum += c; cnt += (c > 0u) ? 1u : 0u; mine = (j == x) ? c : mine; }
        if (sum == G) break;
        __builtin_amdgcn_s_sleep(1);
        if ((++sp & 255u) == 0u) { if (xb_ld(&bar[XB_TMO])) break; if (sp > XB_SPIN_CAP) { atomicAdd(&bar[XB_TMO], 1u); break; } }
    }
    nloc = mine > 0u ? mine : 1u; nx = cnt > 0u ? cnt : 1u;
}

__device__ __forceinline__ void xcd_barrier(const XcdBarrier& b) {
    asm volatile("s_waitcnt vmcnt(0)" ::: "memory");
    __syncthreads();
    if (threadIdx.x == 0) {
        unsigned* bar = b.bar;
        __builtin_amdgcn_s_waitcnt(0);
        unsigned nloc = b.st[0], nx = b.st[1];
        if (nloc == 0u) { xcd_barrier_complete(bar, b.x, nloc, nx); b.st[0] = nloc; b.st[1] = nx; }
        const unsigned old = xb_add(&bar[XB_XSUB(b.x)], 1u);
        const unsigned gen = old / nloc;
        if (old + 1u == (gen + 1u) * nloc) {
            __builtin_amdgcn_fence(__ATOMIC_RELEASE, "agent");
            asm volatile("s_waitcnt vmcnt(0)" ::: "memory");
            const unsigned og = xb_add(&bar[XB_TOP], 1u);
            const unsigned tg = og / nx;
            if (og + 1u == (tg + 1u) * nx) xb_add(&bar[XB_TOPGEN], 1u);
            else XB_SPIN(xb_ld(&bar[XB_TOPGEN]) == tg, bar);
            __builtin_amdgcn_fence(__ATOMIC_ACQUIRE, "agent");
            xb_add(&bar[XB_XGEN(b.x)], 1u);
            asm volatile("s_waitcnt vmcnt(0)" ::: "memory");
        } else {
            XB_SPIN(xb_ld(&bar[XB_XGEN(b.x)]) == gen, bar);
            __builtin_amdgcn_fence(__ATOMIC_ACQUIRE, "agent");
            asm volatile("s_waitcnt vmcnt(0)" ::: "memory");
        }
    }
    __syncthreads();
}

template <int DQK, int DV, int MODE>
__device__ __forceinline__ void att_call(bool strip, LAS unsigned char* lds, const bf16* Qb, int qpitch, const bf16* Kb, int kpitch, const bf16* VTb, int skv, const unsigned* maskb, const bf16* Zb, bf16* Ob, int q0) {
    if (ATT_STRIP != 0 && strip) attn_unit<DQK, DV, MODE, ATT_STRIP>(lds, Qb, qpitch, Kb, kpitch, VTb, skv, maskb, Zb, Ob, q0);
    else attn_unit<DQK, DV, MODE, 0>(lds, Qb, qpitch, Kb, kpitch, VTb, skv, maskb, Zb, Ob, q0);
}
struct Args { const float* in[19]; const int* pos; float* out; unsigned char* ws; };
typedef const __attribute__((address_space(4))) Args* kargs_t;
#define PHASE_BEGIN \
    kargs_t ap_ = (kargs_t)__builtin_amdgcn_kernarg_segment_ptr(); asm volatile("" : "+s"(ap_)); \
    int tid = threadIdx.x; asm volatile("" : "+v"(tid)); \
    const int lane = tid & 63, wave = __builtin_amdgcn_readfirstlane(tid >> 6), G = gridDim.x, NGW = G * 8, gw = blockIdx.x * 8 + wave; \
    unsigned char* const ws = ap_->ws; unsigned char* const dob = (unsigned char*)ap_->out; const int* const pos = ap_->pos; float* const outp = ap_->out; unsigned* const ctl = (unsigned*)(ws + WS_CTL); \
    const float* const x = ap_->in[0]; const float* const mem = ap_->in[1]; \
    const float* const g_norm = ap_->in[3]; const float* const w_in = ap_->in[4]; const float* const g_qn_a = ap_->in[5]; const float* const g_kn_a = ap_->in[6]; \
    const float* const g_cq = ap_->in[7]; const float* const g_ckv = ap_->in[8]; const float* const w_uq = ap_->in[9]; const float* const w_ukv = ap_->in[10]; \
    const float* const g_qn_b = ap_->in[11]; const float* const g_kn_b = ap_->in[12]; const float* const g_mem = ap_->in[13]; const float* const w_mem_kv = ap_->in[14]; \
    const float* const g_qn_m = ap_->in[15]; const float* const g_kn_m = ap_->in[16]; const float* const w_branch = ap_->in[17]; const float* const w_out = ap_->in[18]; \
    bf16* const WinT = (bf16*)(ws + WS_WIN); bf16* const WuqT = (bf16*)(ws + WS_WUQ); bf16* const WukvT = (bf16*)(ws + WS_WUKV); bf16* const WmemT = (bf16*)(ws + WS_WMEM); \
    bf16* const WbrT = (bf16*)(ws + WS_WBR); bf16* const WoutT = (bf16*)(ws + WS_WOUT); \
    float* const ropeA = (float*)(ws + WS_ROPEA); float* const ropeB = (float*)(ws + WS_ROPEB); \
    bf16* const MN = (bf16*)(ws + WS_MN); bf16* const KVM = (bf16*)(ws + WS_KVM); bf16* const VTM = (bf16*)(ws + WS_VTM); \
    float* const WI = (float*)(ws + WS_WI); unsigned* const MASK = (unsigned*)(ws + WS_MASK); \
    bf16* const VTA = (bf16*)(dob + DO_VTA); bf16* const VTB = (bf16*)(dob + DO_VTB); bf16* const KB = (bf16*)(dob + DO_KB); \
    bf16* const Hh = (bf16*)(ws + WS_H); bf16* const MG = (bf16*)(ws + WS_H); bf16* const QB = (bf16*)(ws + WS_QB); \
    bf16* const KVB = (bf16*)(ws + WS_KVB); bf16* const GT0 = (bf16*)(dob + DO_G0); bf16* const GT1 = (bf16*)(ws + WS_G1); bf16* const P = (bf16*)(ws + WS_P); \
    (void)lane; (void)NGW; (void)gw; (void)ctl; \
    (void)pos; (void)outp; (void)x; (void)mem; (void)g_norm; (void)w_in; (void)g_qn_a; (void)g_kn_a; (void)g_cq; (void)g_ckv; (void)w_uq; (void)w_ukv; (void)g_qn_b; (void)g_kn_b; (void)g_mem; (void)w_mem_kv; \
    (void)g_qn_m; (void)g_kn_m; (void)w_branch; (void)w_out; (void)WinT; (void)WuqT; (void)WukvT; (void)WmemT; (void)WbrT; (void)WoutT; (void)ropeA; (void)ropeB; (void)MN; (void)KVM; (void)VTM; (void)WI; (void)MASK; \
    (void)VTA; (void)VTB; (void)Hh; (void)KB; (void)QB; (void)KVB; (void)MG; (void)GT0; (void)GT1; (void)P
#define GRID_BARRIER() do { kargs_t bp_ = (kargs_t)__builtin_amdgcn_kernarg_segment_ptr(); asm volatile("" : "+s"(bp_)); \
    XcdBarrier b_; b_.bar = (unsigned*)(bp_->ws + WS_CTL) + 4096; b_.x = xb_xcc_id(); b_.st = (volatile LAS unsigned*)(lds + LDS_BYTES - 32); xcd_barrier(b_); } while (0)

__global__ void __launch_bounds__(512, 2) fwd_kernel(Args a) {
    extern __shared__ __attribute__((aligned(16))) unsigned char lds_raw[];
    LAS unsigned char* const lds = (LAS unsigned char*)lds_raw;
    volatile LAS int* const slot = (volatile LAS int*)(lds + LDS_SLOT);
    if (threadIdx.x < 16) ((LAS unsigned*)(lds + LDS_BYTES - 64))[threadIdx.x] = 0u;
    __syncthreads();
    (void)xcd_barrier_post((unsigned*)(a.ws + WS_CTL) + 4096, (volatile LAS unsigned*)(lds + LDS_BYTES - 32));

    for (int rep = 0; rep < REP_P0; ++rep) { PHASE_BEGIN;
        LAS float* scr = (LAS float*)(lds + wave * 16384);
        constexpr int I_IN = 16 * (NP / 32), I_UQ = 6 * 24, I_UKV = 4 * 32, I_MEM = 16 * 32, I_BR = 8 * 32, I_OUT = 16 * 32;
        constexpr int NITEMS = I_IN + I_UQ + I_UKV + I_MEM + 3 * I_BR + I_OUT;
        for (int it = gw; it < NITEMS; it += NGW) {
            int r = it;
            if (r < I_IN) { transpose_item<true>(w_in, 1024, DIN, NP, WinT, scr, r, lane); continue; } r -= I_IN;
            if (r < I_UQ) { transpose_item<false>(w_uq, 384, 768, 768, WuqT, scr, r, lane); continue; } r -= I_UQ;
            if (r < I_UKV) { transpose_item<false>(w_ukv, 256, 1024, 1024, WukvT, scr, r, lane); continue; } r -= I_UKV;
            if (r < I_MEM) { transpose_item<false>(w_mem_kv, 1024, 1024, 1024, WmemT, scr, r, lane); continue; } r -= I_MEM;
            if (r < 3 * I_BR) { const int nb = r / I_BR; transpose_item<false>(w_branch + (size_t)nb * 512 * 1024, 512, 1024, 1024, WbrT + (size_t)nb * 1024 * 512, scr, r % I_BR, lane); continue; } r -= 3 * I_BR;
            transpose_item<false>(w_out, 1024, 1024, 1024, WoutT, scr, r, lane);
        }
        for (int idx = blockIdx.x * 512 + tid; idx < TT * 24; idx += G * 512) {
            const int t = idx / 24, i = idx % 24; const float pf = (float)pos[t];
            if (i < 8) { const float ang = pf * INVA[i]; ropeA[t * 16 + i] = cosf(ang); ropeA[t * 16 + 8 + i] = sinf(ang); }
            else { const int j = i - 8; const float ang = pf * INVB[j]; ropeB[t * 32 + j] = cosf(ang); ropeB[t * 32 + 16 + j] = sinf(ang); }
        }
        for (int m = gw; m < NB * MEML; m += NGW) rms_row_1024(mem + (size_t)m * DM, g_mem, MN + (size_t)m * DM, lane);
        for (int rp = 0; rp < REP_PH; ++rp)
        for (int m = gw; m < TT; m += NGW) rms_row_1024(x + (size_t)m * DM, g_norm, Hh + (size_t)m * DM, lane);
    }
    GRID_BARRIER();
    for (int es = 0; es < EXTRA_SYNCS; ++es) GRID_BARRIER();

    for (int rep = 0; rep < REP_G1; ++rep) { PHASE_BEGIN;
        pg8::Gemm g{Hh, WinT, TT, PP, 1024, 1024, nullptr, nullptr, nullptr, 0}; pg8::StaticOrder S; S.init(TT, PP, G, (int)blockIdx.x);
        EpiStoreVT E{P, PP, VTA, C_VA, C_VA + 512, 6, 0, 64, 11};
        pg8::gemm_phase<EpiStoreVT, pg8::StaticOrder, true, true>(lds, g, S, E);
    }
    { PHASE_BEGIN;
        pg8::Gemm g{MN, WmemT, NB * MEML, 1024, 1024, 1024, nullptr, nullptr, nullptr, 0}; pg8::StaticOrder S; S.init(NB * MEML, 1024, G, (int)((blockIdx.x + 64) % G));
        EpiStoreVT E{KVM, 1024, VTM, 512, 1024, 7, 0, 128, 8};
        pg8::gemm_phase<EpiStoreVT, pg8::StaticOrder, true, true>(lds, g, S, E);
    }
    GRID_BARRIER();
    { PHASE_BEGIN;
        float ga[8], gk[8], gq[8], gc[8], gm[8];
#pragma unroll
        for (int j = 0; j < 8; ++j) { ga[j] = g_qn_a[8 * (lane & 7) + j]; gk[j] = g_kn_a[8 * (lane & 7) + j]; gm[j] = g_qn_m[8 * (lane & 15) + j]; gq[j] = lane < 48 ? g_cq[8 * lane + j] : 0.f; gc[j] = lane < 32 ? g_ckv[8 * lane + j] : 0.f; }
        for (int dp = 0; dp < DUMMY_POST1; ++dp)
            for (int m = gw; m < TT; m += NGW)
                post1_row(P + (size_t)m * PP, QB + (size_t)(m & 1023) * 4096, ropeA + (size_t)m * 16, ga, gk, gq, gc, gm, (float*)KVB + (size_t)m * 8, lane);
        for (int m = gw; m < TT; m += NGW)
            post1_row(P + (size_t)m * PP, P + (size_t)m * PP, ropeA + (size_t)m * 16, ga, gk, gq, gc, gm, WI + (size_t)m * 8, lane);
        for (int m = gw; m < NB * MEML; m += NGW) km_row(KVM + (size_t)m * 1024, g_kn_m, lane);
    }
    GRID_BARRIER();
    for (int rep = 0; rep < REP_G2; ++rep) { PHASE_BEGIN;
        pg8::Gemm g{P + C_CQ, WuqT, TT, 768, 384, PP, nullptr, nullptr, nullptr, 0}; pg8::StaticOrder S; S.init(TT, 768, G, (int)blockIdx.x);
        pg8::EpiBf16<0> E{QB, 768, nullptr, 0, 0, 1.f};
        pg8::gemm_phase<pg8::EpiBf16<0>, pg8::StaticOrder, true, true>(lds, g, S, E);
    }
    for (int rep = 0; rep < REP_G2; ++rep) { PHASE_BEGIN;
        pg8::Gemm g{P + C_CKV, WukvT, TT, 1024, 256, PP, nullptr, nullptr, nullptr, 0}; pg8::StaticOrder S; S.init(TT, 1024, G, (int)((blockIdx.x + 192) % G));
        pg8::EpiBf16<0> E{KVB, 1024, nullptr, 0, 0, 1.f};
        pg8::gemm_phase<pg8::EpiBf16<0>, pg8::StaticOrder, true, true>(lds, g, S, E);
    }
    for (int rep = 0; rep < REP_IDX; ++rep) { if (rep > 0) GRID_BARRIER();
        PHASE_BEGIN;
        unsigned* const q_idx = ctl + 64 * (0 + 4 * rep);
        int u = next_unit(q_idx, slot);
        bf16x8 qf[8][2]; float wq[8];
        if (u < NB * 128) indexer_load_q(P, WI, u, qf, wq);
        while (u < NB * 128) {
            int tk = 0; if (tid == 0) tk = (int)atomicAdd(q_idx, 1u);
            const int tb = 127 - (u >> 3), bb = u & 7;
            int un;
            indexer_unit((LAS float*)lds, P, WI, MASK, bb, tb, qf, wq, tk, slot, NB * 128, un);
            u = un;
        }
    }
    GRID_BARRIER();
    { PHASE_BEGIN;
        LAS float* scr = (LAS float*)(lds + wave * 8192);
        float gqv[12], gkv[12];
#pragma unroll
        for (int e = 0; e < 12; ++e) { gqv[e] = g_qn_b[12 * (lane & 7) + e]; gkv[e] = g_kn_b[12 * (lane & 7) + e]; }
        for (int dp = 0; dp < DUMMY_POST2; ++dp)
            for (int m = gw; m < TT; m += NGW)
                post2_row(QB + (size_t)m * 768, (bf16*)MASK + (size_t)(m & 1023) * 768, KVB + (size_t)m * 1024, P + (size_t)m * PP, (bf16*)MASK + (size_t)(1024 + (m & 1023)) * 768, ropeB + (size_t)m * 32, gqv, gkv, scr, lane);
        for (int m = gw; m < TT; m += NGW)
            post2_row(QB + (size_t)m * 768, QB + (size_t)m * 768, KVB + (size_t)m * 1024, P + (size_t)m * PP, KB + (size_t)m * 768, ropeB + (size_t)m * 32, gqv, gkv, scr, lane);
        transpose_v(KVB, 1024, 64, 128, 8, 64, SEQ, NB, VTB, gw, NGW, lane);
    }
    GRID_BARRIER();
    for (int rep = 0; rep < REP_ATT; ++rep) { if (rep > 0) GRID_BARRIER();
        PHASE_BEGIN;
        unsigned* const q_att = ctl + 64 * (1 + 4 * rep);
        for (;;) {
            const int u = next_unit(q_att, slot);
            if (u >= 1152) break;
            if (u < 704 || u >= 832) {
                const int uu = u < 704 ? u : u - 128, cls = uu >> 6, bh = uu & 63, bb = bh >> 3, h = bh & 7;
                const bool isA = (0x52a7u >> cls) & 1u; const int qb = (int)((0x11232435467567ull >> (4 * cls)) & 15ull);
                const size_t r0 = (size_t)bb * SEQ;
                if (!isA) attn_unit_pipe<96, 1>(lds, QB + r0 * 768 + h * 96, 768, KB + r0 * 768 + h * 96, 768, VTB + (size_t)((bb * 8 + h) * 64) * SEQ, SEQ, nullptr,
                                                   P + r0 * PP + C_YB + h * 64, qb * 256);
                else attn_unit_pipe<64, 2>(lds, P + r0 * PP + C_QA + h * 64, PP, P + r0 * PP + C_KA + h * 64, PP, VTA + (size_t)((bb * 8 + h) * 64) * SEQ, SEQ, MASK + r0 * 64,
                                           P + r0 * PP + C_YA + h * 64, qb * 256);
            } else {
                const int v = u - 704, hq = v & 3, bh = v >> 2, bb = bh >> 2, h = bh & 3;
                const size_t r0 = (size_t)bb * SEQ;
                attn_unit_mem(lds, P + r0 * PP + C_QM + h * 128, KVM + (size_t)bb * MEML * 1024 + h * 128, VTM + (size_t)((bb * 4 + h) * 128) * MEML,
                              P + r0 * PP + C_ZM + h * 128, P + r0 * PP + C_YM + h * 128, hq * 512);
            }
        }
    }
    GRID_BARRIER();
    for (int rep = 0; rep < 1; ++rep) { PHASE_BEGIN;
        pg8::Gemm g{Hh, WinT + (size_t)PP * 1024, TT, NZG, 1024, 1024, nullptr, nullptr, nullptr, 0}; pg8::StaticOrder S; S.init(TT, NZG, G, (int)blockIdx.x);
        EpiZG E{P, GT0, GT1};
        pg8::gemm_phase<EpiZG, pg8::StaticOrder, true, true>(lds, g, S, E);
    }
    GRID_BARRIER();
    for (int rep = 0; rep < REP_G4; ++rep) { PHASE_BEGIN;
        pg8::Gemm g{P + C_YA, WbrT, TT, 3072, 512, PP, P + C_YA, P + C_YB, P + C_YM, 4};
        MergeOrder S; S.so.init(TT, 1024, G, (int)blockIdx.x);
        EpiMerge E{MG, GT0, GT1};
        pg8::gemm_phase<EpiMerge, MergeOrder, true, true>(lds, g, S, E);
    }
    GRID_BARRIER();
    for (int rep = 0; rep < REP_G5; ++rep) { PHASE_BEGIN;
        pg8::Gemm g{MG, WoutT, TT, 1024, 1024, 1024, nullptr, nullptr, nullptr, 0}; pg8::StaticOrder S; S.init(TT, 1024, G, (int)blockIdx.x);
        EpiOut E{x, outp};
        pg8::gemm_phase<EpiOut, pg8::StaticOrder, true, true>(lds, g, S, E);
    }
}

extern "C" void kernel_launch(void* const* d_in, const int* in_sizes, int n_in, void* d_out, int out_size, void* d_ws, size_t ws_size, hipStream_t stream) {
    static int grid = 0;
    if (grid == 0) {
        if (n_in != 19 || out_size != TT * DM || ws_size < WS_END) { fprintf(stderr, "kernel_launch: unexpected problem (n_in %d, out %d, ws %zu); nothing launched\n", n_in, out_size, ws_size); grid = -1; return; }
        int dev = 0, cus = 0, per_cu = 0;
        if (hipGetDevice(&dev) != hipSuccess || hipDeviceGetAttribute(&cus, hipDeviceAttributeMultiprocessorCount, dev) != hipSuccess) { grid = -1; return; }
        if (hipFuncSetAttribute((const void*)fwd_kernel, hipFuncAttributeMaxDynamicSharedMemorySize, LDS_BYTES) != hipSuccess) { fprintf(stderr, "kernel_launch: hipFuncSetAttribute failed\n"); grid = -1; return; }
        if (hipOccupancyMaxActiveBlocksPerMultiprocessor(&per_cu, (const void*)fwd_kernel, 512, LDS_BYTES) != hipSuccess || per_cu < 1) { fprintf(stderr, "kernel_launch: occupancy query reports %d blocks per CU\n", per_cu); (void)hipGetLastError(); grid = -1; return; }
        grid = cus;
    }
    if (grid < 0) return;
    (void)hipMemsetAsync((char*)d_ws + WS_CTL, 0, 65536, stream);
    Args a{};
    for (int i = 0; i < 19; ++i) a.in[i] = (const float*)d_in[i];
    a.pos = (const int*)d_in[2]; a.out = (float*)d_out; a.ws = (unsigned char*)d_ws;
    hipLaunchKernelGGL(fwd_kernel, dim3(grid), dim3(512), LDS_BYTES, stream, a);
    const hipError_t e = hipPeekAtLastError();
    if (e != hipSuccess) fprintf(stderr, "kernel_launch: launch failed: %s (grid %d)\n", hipGetErrorString(e), grid);
}
```

```cpp
#include <hip/hip_runtime.h>
#include <cstdio>
#include <cstdint>
namespace pg8 {
#define PG8_LAS __attribute__((address_space(3)))
typedef unsigned short bf16_t;
typedef short bf16x8 __attribute__((ext_vector_type(8)));
typedef float f32x4 __attribute__((ext_vector_type(4)));
typedef unsigned u32x4 __attribute__((ext_vector_type(4)));
constexpr int BM = 256, BK = 64, HALF = 128, HTB = HALF * BK * 2  , STAGE_BYTES = 8 * HTB, NXCD = 8, WGM = 8;

__host__ __device__ __forceinline__ int lds_byte(int r, int c) { const int st = (r >> 4) * 2 + (c >> 5), rr = r & 15, cc = c & 31, ob = rr * 64 + cc * 2; return st * 1024 + (ob ^ (((ob >> 9) & 1) << 5)); }
__host__ __device__ __forceinline__ void stage_rc(int b, int& R, int& C) { const int st = b / 1024, sb = b % 1024, swz = sb ^ (((sb >> 9) & 1) << 5); R = (st >> 1) * 16 + swz / 64; C = (st & 1) * 32 + (swz % 64) / 2; }
__host__ __device__ __forceinline__ int perm32(int rho) { const int n = rho >> 4, i = rho & 15; return 8 * (i >> 2) + 4 * n + (i & 3); }

struct Unit { int pm, pn; };
struct Gemm { const bf16_t* A; const bf16_t* Bt; int M, N, K, lda; const bf16_t* Ag0; const bf16_t* Ag1; const bf16_t* Ag2; int ngrp; };
__device__ __forceinline__ const char* a_base(const Gemm& g, const Unit& u) { if (!g.ngrp) return (const char*)g.A; const int j = u.pn / g.ngrp; return (const char*)(j == 0 ? g.Ag0 : (j == 1 ? g.Ag1 : g.Ag2)); }

struct StaticOrder {
    int nM, nN, nwg, G, c;
    __host__ __device__ void init(int M, int N, int G_, int c_) { nM = M / BM; nN = N / BM; nwg = nM * nN; G = G_; c = c_; }
    __host__ __device__ bool next(int i, Unit& u) const {
        const long L = (long)i * G + c; if (L >= nwg) return false;
        int wgid = (int)L; { const int q = nwg / NXCD, r = nwg % NXCD, xcd = wgid % NXCD, off = wgid / NXCD; wgid = (xcd < r ? xcd * (q + 1) : r * (q + 1) + (xcd - r) * q) + off; }
        const int nig = WGM * nN, gid = wgid / nig, fm = gid * WGM, gsz = (nM - fm) < WGM ? (nM - fm) : WGM;
        u.pm = fm + ((wgid % nig) % gsz); u.pn = (wgid % nig) / gsz; return true;
    }
    __device__ __forceinline__ void a_ready(const Unit&) const {}
    __device__ __forceinline__ void done(const Unit&) const {}
};

__device__ __forceinline__ unsigned cvt_pk_bf16(float lo, float hi) { unsigned r; asm volatile("v_cvt_pk_bf16_f32 %0, %1, %2" : "=v"(r) : "v"(lo), "v"(hi)); return r; }
typedef float f32x2 __attribute__((ext_vector_type(2)));
__device__ __forceinline__ f32x2 gelu_pk(f32x2 v) {
    const f32x2 av = __builtin_elementwise_abs(v), d = av * 0.2316418882f + 1.0f;
    f32x2 t; t.x = __builtin_amdgcn_rcpf(d.x); t.y = __builtin_amdgcn_rcpf(d.y);
    f32x2 q = t * 0.5307027145f + (-0.7265760135f); q = q * t + 0.7107068705f; q = q * t + (-0.142248368f); q = q * t + 0.127414796f; q = q * t;
    const f32x2 s = (v * v) * (-0.72134752044f);
    f32x2 e; e.x = __builtin_amdgcn_exp2f(s.x); e.y = __builtin_amdgcn_exp2f(s.y);
    const f32x2 m = v * (q * e), r = v - m;
    f32x2 o; o.x = v.x < 0.f ? m.x : r.x; o.y = v.y < 0.f ? m.y : r.y; return o;
}

template <int ACT  > struct EpiBf16 {
    static constexpr bool PERM = true, AFTER_DRAIN = false; static_assert(ACT == 0 || ACT == 1, "EpiBf16: ACT is 0 (none) or 1 (gelu_pk)");
    bf16_t* O; int ldc; const float* bias; int split_cols; size_t split_stride; float scale0;
    __device__ __forceinline__ void operator()(const f32x4 (&acc)[2][2][4][2], const Unit& u, int wr, int wc, int fr, int fq) const {
        const int row0 = u.pm * BM + wr * 64 + fr; int colt = u.pn * BM; bf16_t* base = O;
        float sc = 1.f; if (split_cols) { const int t = colt / split_cols; base += (size_t)t * split_stride; colt -= t * split_cols; if (t == 0) sc = scale0; }
        const int col0 = colt + wc * 32 + 8 * fq, bcol0 = u.pn * BM + wc * 32 + 8 * fq;
        f32x4 bv[2][2];
#pragma unroll
        for (int bj = 0; bj < 2; ++bj)
#pragma unroll
            for (int n = 0; n < 2; ++n) bv[bj][n] = bias ? *(const f32x4*)(bias + bcol0 + bj * HALF + 4 * n) : (f32x4){0.f, 0.f, 0.f, 0.f};
#pragma unroll
        for (int ai = 0; ai < 2; ++ai)
#pragma unroll
            for (int m = 0; m < 4; ++m) { bf16_t* rowp = base + (size_t)(row0 + ai * HALF + m * 16) * ldc + col0;
#pragma unroll
                for (int bj = 0; bj < 2; ++bj) { f32x4 v0 = acc[ai][bj][m][0] + bv[bj][0], v1 = acc[ai][bj][m][1] + bv[bj][1];
                    if (ACT == 1) { f32x2 a = gelu_pk((f32x2){v0[0], v0[1]}), b = gelu_pk((f32x2){v0[2], v0[3]}), c = gelu_pk((f32x2){v1[0], v1[1]}), d = gelu_pk((f32x2){v1[2], v1[3]});
                        v0 = (f32x4){a.x, a.y, b.x, b.y}; v1 = (f32x4){c.x, c.y, d.x, d.y}; }
                    v0 = v0 * sc; v1 = v1 * sc; u32x4 w; w.x = cvt_pk_bf16(v0[0], v0[1]); w.y = cvt_pk_bf16(v0[2], v0[3]); w.z = cvt_pk_bf16(v1[0], v1[1]); w.w = cvt_pk_bf16(v1[2], v1[3]);
                    *(u32x4*)(rowp + bj * HALF) = w; } }
    }
};
template <class Epi, class Sched, bool ALIGN_EPI = false, bool SP2 = false>
__device__ __forceinline__ void gemm_phase(PG8_LAS unsigned char* lds, const Gemm g, const Sched& S, const Epi& E) {
    int tid_ = threadIdx.x; asm volatile("" : "+v"(tid_));
    const int tid = tid_, wid = __builtin_amdgcn_readfirstlane(tid >> 6), lane = tid & 63, wr = wid >> 2, wc = wid & 3, fr = lane & 15, fq = lane >> 4;
    const int K = g.K, nt = K / BK;
    unsigned voffA[2], voffB[2];
#pragma unroll
    for (int i = 0; i < 2; ++i) { int R, C; stage_rc(tid * 16 + i * 8192, R, C); const int Rb = Epi::PERM ? ((R & ~31) + perm32(R & 31)) : R;
        voffA[i] = (unsigned)(R * g.lda + C) * 2u; voffB[i] = (unsigned)(Rb * K + C) * 2u; }
    const size_t kstep = (size_t)(BK * 2);
    const size_t hstepA = (size_t)HALF * g.lda * 2, hstepB = (size_t)HALF * K * 2;
    const size_t tstepA = 2 * hstepA, tstepB = 2 * hstepB;
    const unsigned ldsw = (unsigned)wid * 1024u;
    const int aoff = lds_byte(wr * 64 + fr, fq * 8), boff = lds_byte(wc * 32 + fr, fq * 8);
#define PG8_SA(b, h) (((b) * 2 + (h)) * HTB)
#define PG8_SB(b, h) ((4 + (b) * 2 + (h)) * HTB)
#define PG8_STAGE(bufoff, gbase, voff) do { _Pragma("unroll") for (int _i = 0; _i < 2; ++_i) \
        __builtin_amdgcn_global_load_lds((const unsigned*)((const char*)(gbase) + (voff)[_i]), (PG8_LAS unsigned*)(lds + (bufoff) + ldsw + _i * 8192), 16, 0, 0); } while (0)
#define PG8_LDA(dst, b, h) do { _Pragma("unroll") for (int m = 0; m < 4; ++m) _Pragma("unroll") for (int k = 0; k < 2; ++k) dst[m][k] = *(const PG8_LAS bf16x8*)(lds + PG8_SA(b, h) + aoff + m * 2048 + k * 1024); } while (0)
#define PG8_LDB(dst, b, h) do { _Pragma("unroll") for (int n = 0; n < 2; ++n) _Pragma("unroll") for (int k = 0; k < 2; ++k) dst[n][k] = *(const PG8_LAS bf16x8*)(lds + PG8_SB(b, h) + boff + n * 2048 + k * 1024); } while (0)
#define PG8_MMA(ai, bj, At, Bt) do { __builtin_amdgcn_s_setprio(1); _Pragma("unroll") for (int m = 0; m < 4; ++m) _Pragma("unroll") for (int n = 0; n < 2; ++n) _Pragma("unroll") for (int k = 0; k < 2; ++k) \
        acc[ai][bj][m][n] = __builtin_amdgcn_mfma_f32_16x16x32_bf16(Bt[n][k], At[m][k], acc[ai][bj][m][n], 0, 0, 0); __builtin_amdgcn_s_setprio(0); } while (0)
#define PG8_WAIT_V(n) asm volatile("s_waitcnt vmcnt(" #n ")" ::: "memory")
#define PG8_WAIT_L(n) asm volatile("s_waitcnt lgkmcnt(" #n ")" ::: "memory")
#define PG8_BAR __builtin_amdgcn_s_barrier()
#define PG8_SCHED __builtin_amdgcn_sched_barrier(0)
    Unit cur, nxt; int ui = 0;
    if (!S.next(0, cur)) return;
    f32x4 acc[2][2][4][2];
#pragma unroll
    for (int a = 0; a < 2; ++a)
#pragma unroll
        for (int b = 0; b < 2; ++b)
#pragma unroll
            for (int m = 0; m < 4; ++m)
#pragma unroll
                for (int n = 0; n < 2; ++n) acc[a][b][m][n] = (f32x4){0.f, 0.f, 0.f, 0.f};
    bf16x8 At[4][2], B0[2][2], B1[2][2];
    const char* cA = a_base(g, cur) + (size_t)cur.pm * tstepA; const char* cB = (const char*)g.Bt + (size_t)cur.pn * tstepB;
    S.a_ready(cur);
    if constexpr (SP2) {
        PG8_STAGE(PG8_SB(0, 0), cB, voffB); PG8_STAGE(PG8_SB(0, 1), cB + hstepB, voffB); PG8_STAGE(PG8_SA(0, 0), cA, voffA); PG8_STAGE(PG8_SA(0, 1), cA + hstepA, voffA);
        if (wr == 1) PG8_BAR;
        PG8_WAIT_V(2); PG8_BAR;
        PG8_STAGE(PG8_SB(1, 0), cB + kstep, voffB); PG8_STAGE(PG8_SA(1, 0), cA + kstep, voffA); PG8_STAGE(PG8_SB(1, 1), cB + hstepB + kstep, voffB);
        PG8_WAIT_V(6); PG8_BAR;
    } else {
        PG8_STAGE(PG8_SB(0, 0), cB, voffB); PG8_STAGE(PG8_SA(0, 0), cA, voffA); PG8_STAGE(PG8_SB(0, 1), cB + hstepB, voffB); PG8_STAGE(PG8_SA(0, 1), cA + hstepA, voffA);
        if (wr == 1) PG8_BAR;
        PG8_WAIT_V(4); PG8_BAR;
        PG8_STAGE(PG8_SB(1, 0), cB + kstep, voffB); PG8_STAGE(PG8_SA(1, 0), cA + kstep, voffA); PG8_STAGE(PG8_SB(1, 1), cB + hstepB + kstep, voffB);
        PG8_WAIT_V(6); PG8_BAR;
    }
    for (;;) {
        const bool has_next = S.next(ui + 1, nxt);
        const char* nA = has_next ? a_base(g, nxt) + (size_t)nxt.pm * tstepA : cA; const char* nB = has_next ? (const char*)g.Bt + (size_t)nxt.pn * tstepB : cB;
        for (int t = 0; t < nt; t += 2) {
            const bool last = (t == nt - 2);
            const char* a1 = cA + (size_t)(t + 1) * kstep;
            const char* a2 = last ? nA : cA + (size_t)(t + 2) * kstep; const char* b2 = last ? nB : cB + (size_t)(t + 2) * kstep;
            const char* a3 = a2 + kstep; const char* b3 = b2 + kstep;
            if (last && has_next) S.a_ready(nxt);
            if constexpr (SP2) {
            PG8_LDB(B0, 0, 0); PG8_LDB(B1, 0, 1); PG8_SCHED; PG8_LDA(At, 0, 0); PG8_STAGE(PG8_SA(1, 1), a1 + hstepA, voffA);
            PG8_WAIT_V(8); PG8_WAIT_L(0); PG8_BAR; PG8_MMA(0, 0, At, B0); PG8_MMA(0, 1, At, B1); PG8_BAR; PG8_SCHED;
            PG8_LDA(At, 0, 1); PG8_STAGE(PG8_SB(0, 0), b2, voffB); PG8_STAGE(PG8_SB(0, 1), b2 + hstepB, voffB); PG8_STAGE(PG8_SA(0, 0), a2, voffA);
            PG8_WAIT_V(8); PG8_WAIT_L(0); PG8_BAR; PG8_MMA(1, 0, At, B0); PG8_MMA(1, 1, At, B1); PG8_BAR; PG8_SCHED;
            PG8_LDB(B0, 1, 0); PG8_LDB(B1, 1, 1); PG8_SCHED; PG8_LDA(At, 1, 0); PG8_STAGE(PG8_SA(0, 1), a2 + hstepA, voffA);
            PG8_WAIT_V(8); PG8_WAIT_L(0); PG8_BAR; PG8_MMA(0, 0, At, B0); PG8_MMA(0, 1, At, B1); PG8_BAR; PG8_SCHED;
            PG8_LDA(At, 1, 1); PG8_STAGE(PG8_SB(1, 0), b3, voffB); PG8_STAGE(PG8_SB(1, 1), b3 + hstepB, voffB); PG8_STAGE(PG8_SA(1, 0), a3, voffA);
            PG8_WAIT_V(8); PG8_WAIT_L(0); PG8_BAR; PG8_MMA(1, 0, At, B0); PG8_MMA(1, 1, At, B1); PG8_BAR; PG8_SCHED;
            } else {
            PG8_LDB(B0, 0, 0); PG8_SCHED; PG8_LDA(At, 0, 0); PG8_STAGE(PG8_SA(1, 1), a1 + hstepA, voffA);
            PG8_WAIT_L(8); PG8_BAR; PG8_WAIT_L(0); PG8_MMA(0, 0, At, B0); PG8_BAR; PG8_SCHED;
            PG8_LDB(B1, 0, 1); PG8_STAGE(PG8_SB(0, 0), b2, voffB);
            PG8_BAR; PG8_WAIT_L(0); PG8_MMA(0, 1, At, B1); PG8_BAR;
            PG8_LDA(At, 0, 1); PG8_STAGE(PG8_SA(0, 0), a2, voffA);
            PG8_BAR; PG8_WAIT_L(0); PG8_MMA(1, 0, At, B0); PG8_BAR; PG8_SCHED;
            PG8_STAGE(PG8_SB(0, 1), b2 + hstepB, voffB);
            PG8_WAIT_V(6); PG8_BAR; PG8_MMA(1, 1, At, B1); PG8_BAR;
            PG8_LDB(B0, 1, 0); PG8_SCHED; PG8_LDA(At, 1, 0); PG8_STAGE(PG8_SA(0, 1), a2 + hstepA, voffA);
            PG8_WAIT_L(8); PG8_BAR; PG8_WAIT_L(0); PG8_MMA(0, 0, At, B0); PG8_BAR; PG8_SCHED;
            PG8_LDB(B1, 1, 1); PG8_STAGE(PG8_SB(1, 0), b3, voffB);
            PG8_BAR; PG8_WAIT_L(0); PG8_MMA(0, 1, At, B1); PG8_BAR;
            PG8_LDA(At, 1, 1); PG8_STAGE(PG8_SA(1, 0), a3, voffA);
            PG8_BAR; PG8_WAIT_L(0); PG8_MMA(1, 0, At, B0); PG8_BAR; PG8_SCHED;
            PG8_STAGE(PG8_SB(1, 1), b3 + hstepB, voffB);
            PG8_WAIT_V(6); PG8_BAR; PG8_MMA(1, 1, At, B1); PG8_BAR;
            }
        }
        if constexpr (ALIGN_EPI) { if (wr == 0) PG8_BAR; }
        if constexpr (!Epi::AFTER_DRAIN) { E(acc, cur, wr, wc, fr, fq); S.done(cur); }
        if (!has_next) break;
#pragma unroll
        for (int a = 0; a < 2; ++a)
#pragma unroll
            for (int b = 0; b < 2; ++b)
#pragma unroll
                for (int m = 0; m < 4; ++m)
#pragma unroll
                    for (int n = 0; n < 2; ++n) acc[a][b][m][n] = (f32x4){0.f, 0.f, 0.f, 0.f};
        cur = nxt; cA = nA; cB = nB; ++ui;
        if constexpr (ALIGN_EPI) { if (wr == 1) PG8_BAR; }
    }
    PG8_WAIT_V(0);
    if constexpr (!ALIGN_EPI) { if (wr == 0) PG8_BAR; }
    PG8_BAR;
    if constexpr (Epi::AFTER_DRAIN) { E.fused(acc, cur, wr, wc, fr, fq, lds, wid, lane); S.done(cur); }
#undef PG8_SA
#undef PG8_SB
#undef PG8_STAGE
#undef PG8_LDA
#undef PG8_LDB
#undef PG8_MMA
#undef PG8_WAIT_V
#undef PG8_WAIT_L
#undef PG8_BAR
#undef PG8_SCHED
}
}

#define LAS __attribute__((address_space(3)))
typedef unsigned short bf16;
typedef unsigned v4u __attribute__((ext_vector_type(4)));
typedef unsigned v2u __attribute__((ext_vector_type(2)));
typedef float f32x4 __attribute__((ext_vector_type(4)));
typedef float f32x16 __attribute__((ext_vector_type(16)));
typedef short bf16x8 __attribute__((ext_vector_type(8)));
typedef short s16x4 __attribute__((ext_vector_type(4)));
typedef float f32x2_t __attribute__((ext_vector_type(2)));
typedef __bf16 bf16x2_t __attribute__((ext_vector_type(2)));

constexpr int NB = 8, SEQ = 2048, DM = 1024, TT = NB * SEQ;
constexpr int DIN = 7912, NP = 7936;
constexpr int PP = 3840, NZG = 4096;
constexpr int MEML = 256;
constexpr float EPS = 1e-6f, NEGF = -1e30f;
constexpr int C_QA = 0, C_KA = 512, C_VA = 1024, C_QI = 1536, C_KI = 2048, C_WI = 2112, C_CQ = 2120, C_CKV = 2504, C_KR = 2760, C_QM = 2792, C_ZM = 3304;
constexpr int C_YA = C_QI, C_YB = C_CQ, C_YM = C_VA;
constexpr float SCALE_A = 0.18033688011112042f;
constexpr float SCALE_B = 0.14724444602590306f;
constexpr float SCALE_M = 0.12751743082459868f;
constexpr float SCALE_I = 0.04419417382415922f;

__constant__ float INVA[8] = {1.0f, 0.1939227432012558f, 0.03760603070259094f, 0.007292664609849453f, 0.0014142135623842478f, 0.00027424818836152554f, 5.3182957344688475e-05f, 1.0313385246263351e-05f};
__constant__ float INVB[16] = {1.0f, 0.44036659598350525f, 0.1939227432012558f, 0.08539710193872452f, 0.03760603070259094f, 0.016560440883040428f, 0.007292664609849453f, 0.0032114461064338684f, 0.0014142135623842478f, 0.0006227724370546639f, 0.00027424818836152554f, 0.00012076973507646471f, 5.3182957344688475e-05f, 2.34199997066753e-05f, 1.0313385246263351e-05f, 4.541670477919979e-06f};

constexpr size_t MiB = 1u << 20;
constexpr size_t WS_CTL = 0;
constexpr size_t WS_WIN = 1 * MiB;
constexpr size_t WS_WUQ = 17 * MiB;
constexpr size_t WS_WUKV = 18 * MiB;
constexpr size_t WS_WMEM = 19 * MiB;
constexpr size_t WS_WBR = 21 * MiB;
constexpr size_t WS_WOUT = 24 * MiB;
constexpr size_t WS_ROPEA = 26 * MiB;
constexpr size_t WS_ROPEB = 27 * MiB;
constexpr size_t WS_MN = 29 * MiB;
constexpr size_t WS_KVM = 33 * MiB;
constexpr size_t WS_VTM = 37 * MiB;
constexpr size_t WS_WI = 39 * MiB;
constexpr size_t WS_MASK = 40 * MiB;
constexpr size_t WS_H = 44 * MiB;
constexpr size_t WS_P = 76 * MiB;
constexpr size_t WS_QB = 196 * MiB;
constexpr size_t WS_KVB = 220 * MiB;
constexpr size_t WS_G1 = 196 * MiB;
constexpr size_t WS_END = 256 * MiB;
constexpr size_t DO_VTA = 0;
constexpr size_t DO_VTB = 16 * MiB;
constexpr size_t DO_KB = 32 * MiB;
constexpr size_t DO_G0 = 0;

constexpr int REP_P0 = 1, REP_PH = 1, REP_G1 = 1, REP_G2 = 1, REP_IDX = 1, REP_ATT = 1, REP_G4 = 1, REP_G5 = 1;
constexpr int REP_IDX1 = 1, REP_SEL = 1;
constexpr int ATT_STRIP = 0;
constexpr int EXTRA_SYNCS = 0, REP_TR = 1, DUMMY_POST1 = 0, DUMMY_POST2 = 0;
constexpr int LDS_BYTES = 147456;
constexpr int LDS_SLOT = LDS_BYTES - 64;

__device__ __forceinline__ unsigned pk2(float lo, float hi) { f32x2_t v = {lo, hi}; bf16x2_t b = __builtin_convertvector(v, bf16x2_t); return __builtin_bit_cast(unsigned, b); }
__device__ __forceinline__ float bflo(unsigned w) { return __uint_as_float(w << 16); }
__device__ __forceinline__ float bfhi(unsigned w) { return __uint_as_float(w & 0xffff0000u); }
__device__ __forceinline__ float bf1(bf16 b) { return __uint_as_float(((unsigned)b) << 16); }
#define UNPACK8(W_, V_) do { V_[0] = bflo((W_)[0]); V_[1] = bfhi((W_)[0]); V_[2] = bflo((W_)[1]); V_[3] = bfhi((W_)[1]); V_[4] = bflo((W_)[2]); V_[5] = bfhi((W_)[2]); V_[6] = bflo((W_)[3]); V_[7] = bfhi((W_)[3]); } while (0)
#define PACK8(V_) (v4u){pk2(V_[0], V_[1]), pk2(V_[2], V_[3]), pk2(V_[4], V_[5]), pk2(V_[6], V_[7])}
template <int CTRL> __device__ __forceinline__ float dpp_f(float v) { return __int_as_float(__builtin_amdgcn_update_dpp(0, __float_as_int(v), CTRL, 0xF, 0xF, false)); }
#define SUM8(x) do { x += dpp_f<0xB1>(x); x += dpp_f<0x4E>(x); x += dpp_f<0x141>(x); } while (0)
#define SUM16(x) do { SUM8(x); x += dpp_f<0x140>(x); } while (0)
__device__ __forceinline__ float wave_sum(float v) {
    SUM16(v);
    return __int_as_float(__builtin_amdgcn_readlane(__float_as_int(v), 0)) + __int_as_float(__builtin_amdgcn_readlane(__float_as_int(v), 16))
         + __int_as_float(__builtin_amdgcn_readlane(__float_as_int(v), 32)) + __int_as_float(__builtin_amdgcn_readlane(__float_as_int(v), 48));
}
#define LDS_WAIT() asm volatile("s_waitcnt lgkmcnt(0)" ::: "memory")

__device__ __forceinline__ int win_src(int d) {
    if (d < 2120) return d;
    if (d < 2792) return d + 512;
    if (d < 3816) return d + 1024;
    if (d < 3840) return -1;
    if (d < 4352) return d - 3840 + 2120;
    if (d < 4864) return d - 4352 + 3304;
    return d - 4864 + 4840;
}
template <bool REMAP>
__device__ __forceinline__ void transpose_item(const float* W, int K, int N, int Npad, bf16* WT, LAS float* scr, int item, int lane) {
    const int nblk = Npad / 32, kb = item / nblk, nb = item % nblk, k0 = 64 * kb, n0 = 32 * nb;
    const int n4 = 4 * (lane & 7);
    const int nn = REMAP ? win_src(n0 + n4) : n0 + n4; const bool ok = nn >= 0 && nn < N;
#pragma unroll
    for (int i = 0; i < 8; ++i) { const int kk = 8 * i + (lane >> 3);
        f32x4 v = (f32x4){0.f, 0.f, 0.f, 0.f}; if (ok) v = *(const f32x4*)(W + (size_t)(k0 + kk) * N + nn);
        LAS float* d = scr + kk * 33 + n4; d[0] = v[0]; d[1] = v[1]; d[2] = v[2]; d[3] = v[3]; }
    LDS_WAIT(); asm volatile("" ::: "memory");
    const int c = lane & 7;
#pragma unroll
    for (int j = 0; j < 4; ++j) { const int n = (lane >> 3) + 8 * j; const LAS float* s = scr + (8 * c) * 33 + n;
        v4u o; o.x = pk2(s[0 * 33], s[1 * 33]); o.y = pk2(s[2 * 33], s[3 * 33]); o.z = pk2(s[4 * 33], s[5 * 33]); o.w = pk2(s[6 * 33], s[7 * 33]);
        *(v4u*)(WT + (size_t)(n0 + n) * K + k0 + 8 * c) = o; }
    LDS_WAIT(); asm volatile("" ::: "memory");
}
__device__ __forceinline__ void rms_row_1024(const float* xrow, const float* g, bf16* orow, int lane) {
    const f32x4* xr = (const f32x4*)xrow + lane; const f32x4* gr = (const f32x4*)g + lane;
    f32x4 v[4]; float s = 0.f;
#pragma unroll
    for (int j = 0; j < 4; ++j) { v[j] = xr[64 * j]; s += (v[j].x * v[j].x + v[j].y * v[j].y) + (v[j].z * v[j].z + v[j].w * v[j].w); }
    const float rstd = __builtin_amdgcn_rsqf(wave_sum(s) * (1.f / 1024.f) + EPS);
    v2u* o8 = (v2u*)orow + lane;
#pragma unroll
    for (int j = 0; j < 4; ++j) { const f32x4 gg = gr[64 * j]; v2u w; w.x = pk2(v[j].x * rstd * gg.x, v[j].y * rstd * gg.y); w.y = pk2(v[j].z * rstd * gg.z, v[j].w * rstd * gg.w); o8[64 * j] = w; }
}

#define ROPE8(v, sub, c8, s8) do { _Pragma("unroll") for (int j_ = 0; j_ < 8; ++j_) { const float pv_ = dpp_f<0xB1>(v[j_]); \
        const float r0_ = v[j_] * c8[j_] - pv_ * s8[j_], r1_ = v[j_] * c8[j_] + pv_ * s8[j_]; v[j_] = (sub) == 0 ? r0_ : ((sub) == 1 ? r1_ : v[j_]); } } while (0)

__device__ __forceinline__ void post1_row(const bf16* Prow, bf16* Orow, const float* ra, const float (&ga)[8], const float (&gk)[8], const float (&gq)[8], const float (&gc)[8], const float (&gm)[8], float* WIrow, int lane) {
    const int sub = lane & 7;
    const v4u z4 = (v4u){0u, 0u, 0u, 0u};
    const v4u w_qa = *(const v4u*)(Prow + C_QA + 8 * lane);
    const v4u w_ka = *(const v4u*)(Prow + C_KA + 8 * lane);
    const v4u w_qi = *(const v4u*)(Prow + C_QI + 8 * lane);
    v4u w_ki = z4, w_cq = z4, w_ckv = z4; float w_wi = 0.f;
    if (lane < 8) { w_ki = *(const v4u*)(Prow + C_KI + 8 * lane); w_wi = bf1(Prow[C_WI + lane]); }
    if (lane < 48) w_cq = *(const v4u*)(Prow + C_CQ + 8 * lane);
    if (lane < 32) w_ckv = *(const v4u*)(Prow + C_CKV + 8 * lane);
    float c8[8], s8[8];
    { const f32x4 r0 = *(const f32x4*)(ra), r1 = *(const f32x4*)(ra + 4), r2 = *(const f32x4*)(ra + 8), r3 = *(const f32x4*)(ra + 12);
      c8[0] = r0[0]; c8[1] = r0[1]; c8[2] = r0[2]; c8[3] = r0[3]; c8[4] = r1[0]; c8[5] = r1[1]; c8[6] = r1[2]; c8[7] = r1[3];
      s8[0] = r2[0]; s8[1] = r2[1]; s8[2] = r2[2]; s8[3] = r2[3]; s8[4] = r3[0]; s8[5] = r3[1]; s8[6] = r3[2]; s8[7] = r3[3]; }
    { float v[8]; UNPACK8(w_qa, v); float ss = 0.f;
#pragma unroll
      for (int j = 0; j < 8; ++j) ss += v[j] * v[j];
      SUM8(ss);
      const float rstd = __builtin_amdgcn_rsqf(ss * (1.f / 64.f) + EPS);
#pragma unroll
      for (int j = 0; j < 8; ++j) v[j] = v[j] * rstd * ga[j];
      ROPE8(v, sub, c8, s8);
#pragma unroll
      for (int j = 0; j < 8; ++j) v[j] *= SCALE_A;
      *(v4u*)(Orow + C_QA + 8 * lane) = PACK8(v); }
    { float v[8]; UNPACK8(w_ka, v); float ss = 0.f;
#pragma unroll
      for (int j = 0; j < 8; ++j) ss += v[j] * v[j];
      SUM8(ss);
      const float rstd = __builtin_amdgcn_rsqf(ss * (1.f / 64.f) + EPS);
#pragma unroll
      for (int j = 0; j < 8; ++j) v[j] = v[j] * rstd * gk[j];
      ROPE8(v, sub, c8, s8);
      *(v4u*)(Orow + C_KA + 8 * lane) = PACK8(v); }
    { float v[8]; UNPACK8(w_qi, v);
      ROPE8(v, sub, c8, s8);
      *(v4u*)(Orow + C_QI + 8 * lane) = PACK8(v); }
    { float v[8]; UNPACK8(w_ki, v);
      ROPE8(v, sub, c8, s8);
      if (lane < 8) *(v4u*)(Orow + C_KI + 8 * lane) = PACK8(v); }
    if (lane < 8) WIrow[lane] = w_wi * SCALE_I;
    { float v[8]; UNPACK8(w_cq, v); float ss = 0.f;
#pragma unroll
      for (int j = 0; j < 8; ++j) ss += v[j] * v[j];
      ss = wave_sum(ss); const float rstd = __builtin_amdgcn_rsqf(ss * (1.f / 384.f) + EPS);
      if (lane < 48) {
#pragma unroll
          for (int j = 0; j < 8; ++j) v[j] = v[j] * rstd * gq[j];
          *(v4u*)(Orow + C_CQ + 8 * lane) = PACK8(v); } }
    { float v[8]; UNPACK8(w_ckv, v); float ss = 0.f;
#pragma unroll
      for (int j = 0; j < 8; ++j) ss += v[j] * v[j];
      ss = wave_sum(ss); const float rstd = __builtin_amdgcn_rsqf(ss * (1.f / 256.f) + EPS);
      if (lane < 32) {
#pragma unroll
          for (int j = 0; j < 8; ++j) v[j] = v[j] * rstd * gc[j];
          *(v4u*)(Orow + C_CKV + 8 * lane) = PACK8(v); } }
}

__device__ __forceinline__ void km_row(bf16* row, const float* gkm, int lane) {
    v4u w = *(const v4u*)(row + 8 * lane); float v[8]; UNPACK8(w, v); float ss = 0.f;
#pragma unroll
    for (int j = 0; j < 8; ++j) ss += v[j] * v[j];
    SUM16(ss);
    const float rstd = __builtin_amdgcn_rsqf(ss * (1.f / 128.f) + EPS);
#pragma unroll
    for (int j = 0; j < 8; ++j) v[j] = v[j] * rstd * gkm[8 * (lane & 15) + j];
    *(v4u*)(row + 8 * lane) = PACK8(v);
}

__device__ __forceinline__ void transpose_v(const bf16* src, int pitch, int col0, int hstride, int H, int DV, int S, int nb, bf16* dst, int gw, int NGW, int lane) {
    const int ndq = DV / 64, nsc = S / 64, ntask = nb * H * nsc * ndq;
    for (int task = gw; task < ntask; task += NGW) {
        int x = task; const int dq = x % ndq; x /= ndq; const int sc = x % nsc; x /= nsc; const int h = x % H; const int b = x / H;
        const int s = sc * 64 + lane;
        const bf16* srow = src + (size_t)(b * S + s) * pitch + col0 + h * hstride + dq * 64;
        bf16* drow = dst + ((size_t)((b * H + h) * DV + dq * 64)) * S + s;
        v4u wv[8];
#pragma unroll
        for (int c = 0; c < 8; ++c) wv[c] = *(const v4u*)(srow + 8 * c);
#pragma unroll
        for (int c = 0; c < 8; ++c) { const v4u w = wv[c];
            drow[(size_t)(8 * c + 0) * S] = (bf16)(w.x & 0xffffu); drow[(size_t)(8 * c + 1) * S] = (bf16)(w.x >> 16);
            drow[(size_t)(8 * c + 2) * S] = (bf16)(w.y & 0xffffu); drow[(size_t)(8 * c + 3) * S] = (bf16)(w.y >> 16);
            drow[(size_t)(8 * c + 4) * S] = (bf16)(w.z & 0xffffu); drow[(size_t)(8 * c + 5) * S] = (bf16)(w.z >> 16);
            drow[(size_t)(8 * c + 6) * S] = (bf16)(w.w & 0xffffu); drow[(size_t)(8 * c + 7) * S] = (bf16)(w.w >> 16); }
    }
}

__device__ __forceinline__ void post2_row(const bf16* QBrow, bf16* QOrow, const bf16* KVBrow, const bf16* Prow, bf16* KBrow, const float* rb, const float (&gqv)[12], const float (&gkv)[12], LAS float* scr, int lane) {
    const int hd = lane >> 3, d0 = 12 * (lane & 7);
    float vq[12], vk[12], cc[12], sn[12];
    { const v2u* p = (const v2u*)(QBrow + 12 * lane);
      const v2u w0 = p[0], w1 = p[1], w2 = p[2];
      bf16 kr[12];
#pragma unroll
      for (int e = 0; e < 12; ++e) { const int d = d0 + e; kr[e] = d < 64 ? KVBrow[hd * 128 + d] : Prow[C_KR + d - 64]; }
#pragma unroll
      for (int e = 0; e < 12; ++e) { const int d = d0 + e; const int i = (d - 64) & 15; cc[e] = d < 64 ? 1.f : rb[i]; sn[e] = d < 64 ? 0.f : rb[16 + i]; }
      vq[0] = bflo(w0.x); vq[1] = bfhi(w0.x); vq[2] = bflo(w0.y); vq[3] = bfhi(w0.y); vq[4] = bflo(w1.x); vq[5] = bfhi(w1.x); vq[6] = bflo(w1.y); vq[7] = bfhi(w1.y);
      vq[8] = bflo(w2.x); vq[9] = bfhi(w2.x); vq[10] = bflo(w2.y); vq[11] = bfhi(w2.y);
#pragma unroll
      for (int e = 0; e < 12; ++e) vk[e] = bf1(kr[e]); }
    float sq = 0.f, sk = 0.f;
#pragma unroll
    for (int e = 0; e < 12; ++e) { sq += vq[e] * vq[e]; sk += vk[e] * vk[e]; }
    SUM8(sq); SUM8(sk);
    const float rq = __builtin_amdgcn_rsqf(sq * (1.f / 96.f) + EPS), rk = __builtin_amdgcn_rsqf(sk * (1.f / 96.f) + EPS);
#pragma unroll
    for (int e = 0; e < 12; ++e) { vq[e] = vq[e] * rq * gqv[e]; vk[e] = vk[e] * rk * gkv[e]; scr[12 * lane + e] = vq[e]; scr[768 + 12 * lane + e] = vk[e]; }
    LDS_WAIT(); asm volatile("" ::: "memory");
    float oq[12], ok[12];
#pragma unroll
    for (int e = 0; e < 12; ++e) { const int d = d0 + e;
        if (d < 64) { oq[e] = vq[e]; ok[e] = vk[e]; }
        else { const bool first = d < 80; const int off = first ? 16 : -16; const float pq = scr[12 * lane + e + off], pk = scr[768 + 12 * lane + e + off];
               oq[e] = first ? vq[e] * cc[e] - pq * sn[e] : vq[e] * cc[e] + pq * sn[e];
               ok[e] = first ? vk[e] * cc[e] - pk * sn[e] : vk[e] * cc[e] + pk * sn[e]; }
        oq[e] *= SCALE_B; }
    LDS_WAIT(); asm volatile("" ::: "memory");
    v2u* q = (v2u*)(QOrow + 12 * lane); v2u* k = (v2u*)(KBrow + 12 * lane);
#pragma unroll
    for (int i = 0; i < 3; ++i) { v2u w; w.x = pk2(oq[4 * i], oq[4 * i + 1]); w.y = pk2(oq[4 * i + 2], oq[4 * i + 3]); q[i] = w;
                                  v2u u; u.x = pk2(ok[4 * i], ok[4 * i + 1]); u.y = pk2(ok[4 * i + 2], ok[4 * i + 3]); k[i] = u; }
}

__device__ __forceinline__ int next_unit(unsigned* ctr, volatile LAS int* slot) {
    __syncthreads();
    if (threadIdx.x == 0) *slot = (int)atomicAdd(ctr, 1u);
    __syncthreads();
    return *slot;
}

constexpr int SCP = 2112;
__device__ __forceinline__ unsigned ord_key(float v) { const unsigned b = __float_as_uint(v); return b ^ ((unsigned)((int)b >> 31) | 0x80000000u); }
__device__ __forceinline__ void indexer_load_q(const bf16* P, const float* WI, int u, bf16x8 (&qf)[8][2], float (&wq)[8]) {
    const int lane = threadIdx.x & 63, n = lane & 15, g = lane >> 4;
    const int tb = 127 - (u >> 3), bb = u & 7;
    const size_t row = (size_t)(bb * SEQ + tb * 16 + n);
    const bf16* qrow = P + row * PP + C_QI + 8 * g;
#pragma unroll
    for (int h = 0; h < 8; ++h) { qf[h][0] = *(const bf16x8*)(qrow + h * 64); qf[h][1] = *(const bf16x8*)(qrow + h * 64 + 32); wq[h] = WI[row * 8 + h]; }
}
__device__ __forceinline__ void indexer_unit(LAS float* sc, const bf16* P, const float* WI, unsigned* MASK, int bb, int tb, bf16x8 (&qf)[8][2], float (&wq)[8],
                                             int tk, volatile LAS int* slot, int nunits, int& un) {
    int tid_ = threadIdx.x; asm volatile("" : "+v"(tid_));
    const int tid = tid_, lane = tid & 63, w = __builtin_amdgcn_readfirstlane(tid >> 6);
    const int n = lane & 15, g = lane >> 4;
    const int rowbase = bb * SEQ, t0 = tb * 16;
    {
        const int ntile = tb + 1;
        const int nmine = (ntile - w + 7) >> 3;
        const int ngrp = (nmine + 3) >> 2;
        const bf16* kbase = P + (size_t)(rowbase + n) * PP + C_KI + 8 * g;
        bf16x8 kb[2][4][2];
#define IDX_LOAD(BUF, GRP) do { _Pragma("unroll") for (int j_ = 0; j_ < 4; ++j_) { const int tile_ = w + 8 * (4 * (GRP) + j_); const int tl_ = tile_ < ntile ? tile_ : 0; \
            const bf16* kr_ = kbase + (size_t)(16 * tl_) * PP; kb[BUF][j_][0] = *(const bf16x8*)(kr_); kb[BUF][j_][1] = *(const bf16x8*)(kr_ + 32); } } while (0)
#define IDX_COMP(BUF, GRP) do { _Pragma("unroll") for (int j_ = 0; j_ < 4; ++j_) { const int tile_ = w + 8 * (4 * (GRP) + j_); if (tile_ < ntile) { \
            f32x4 idx_ = (f32x4){0.f, 0.f, 0.f, 0.f}; \
            _Pragma("unroll") for (int h_ = 0; h_ < 8; ++h_) { f32x4 a_ = (f32x4){0.f, 0.f, 0.f, 0.f}; \
                a_ = __builtin_amdgcn_mfma_f32_16x16x32_bf16(kb[BUF][j_][0], qf[h_][0], a_, 0, 0, 0); \
                a_ = __builtin_amdgcn_mfma_f32_16x16x32_bf16(kb[BUF][j_][1], qf[h_][1], a_, 0, 0, 0); \
                _Pragma("unroll") for (int i_ = 0; i_ < 4; ++i_) idx_[i_] = __builtin_fmaf(wq[h_], __builtin_fmaxf(a_[i_], 0.f), idx_[i_]); } \
            { const int k0_ = 16 * tile_ + 4 * g; LAS float* d_ = sc + n * SCP + k0_ + (k0_ >> 5); d_[0] = idx_[0]; d_[1] = idx_[1]; d_[2] = idx_[2]; d_[3] = idx_[3]; } } } } while (0)
        if (ngrp > 0) IDX_LOAD(0, 0);
        for (int gp = 0; gp < ngrp; gp += 2) {
            if (gp + 1 < ngrp) IDX_LOAD(1, gp + 1);
            IDX_COMP(0, gp);
            if (gp + 1 < ngrp) { if (gp + 2 < ngrp) IDX_LOAD(0, gp + 2); IDX_COMP(1, gp + 1); }
        }
#undef IDX_LOAD
#undef IDX_COMP
    }
    if (tid == 0) *slot = tk;
    __syncthreads();
    un = *slot;
    if (un < nunits) indexer_load_q(P, WI, un, qf, wq);
    for (int rs = 0; rs < REP_SEL; ++rs) {
        const int ta = t0 + 2 * w, tb2 = ta + 1;
        unsigned* mra = MASK + (size_t)(rowbase + ta) * 64; unsigned* mrb = mra + 64;
        const int nva = ta - 32 * lane + 1, nvb = nva + 1;
        const unsigned valid_a = nva >= 32 ? 0xffffffffu : (nva <= 0 ? 0u : ((1u << nva) - 1u));
        const unsigned valid_b = nvb >= 32 ? 0xffffffffu : (nvb <= 0 ? 0u : ((1u << nvb) - 1u));
        if (ta < 256) { mra[lane] = valid_a; mrb[lane] = valid_b; continue; }
        unsigned ua[32], ub[32];
        { const LAS float* sra = sc + (2 * w) * SCP + 33 * lane; const LAS float* srb = sra + SCP;
#pragma unroll
          for (int r = 0; r < 32; ++r) { const float va = sra[r], vb = srb[r]; ua[r] = ((valid_a >> r) & 1u) ? ord_key(va) : 0u; ub[r] = ((valid_b >> r) & 1u) ? ord_key(vb) : 0u; } }
#pragma unroll
        for (int k = 0; k < 16; ++k) {
            const unsigned a0 = ua[k], a1 = ua[k + 16]; ua[k] = __builtin_amdgcn_perm(a1, a0, 0x05040100u); ua[k + 16] = __builtin_amdgcn_perm(a1, a0, 0x07060302u);
            const unsigned b0 = ub[k], b1 = ub[k + 16]; ub[k] = __builtin_amdgcn_perm(b1, b0, 0x05040100u); ub[k + 16] = __builtin_amdgcn_perm(b1, b0, 0x07060302u); }
#pragma unroll
        for (int k = 0; k < 32; ++k) if (!(k & 8)) {
            const unsigned a0 = ua[k], a1 = ua[k + 8]; ua[k] = __builtin_amdgcn_perm(a1, a0, 0x06020400u); ua[k + 8] = __builtin_amdgcn_perm(a1, a0, 0x07030501u);
            const unsigned b0 = ub[k], b1 = ub[k + 8]; ub[k] = __builtin_amdgcn_perm(b1, b0, 0x06020400u); ub[k + 8] = __builtin_amdgcn_perm(b1, b0, 0x07030501u); }
#pragma unroll
        for (int si = 2; si < 5; ++si) { const int sft = 16 >> si;
            const unsigned msk = si == 2 ? 0x0f0f0f0fu : (si == 3 ? 0x33333333u : 0x55555555u);
#pragma unroll
            for (int k = 0; k < 32; ++k) if (!(k & sft)) {
                const unsigned a0 = ua[k], a1 = ua[k + sft]; ua[k] = (a0 & msk) | ((a1 << sft) & ~msk); ua[k + sft] = ((a0 >> sft) & msk) | (a1 & ~msk);
                const unsigned b0 = ub[k], b1 = ub[k + sft]; ub[k] = (b0 & msk) | ((b1 << sft) & ~msk); ub[k + sft] = ((b0 >> sft) & msk) | (b1 & ~msk); } }
        unsigned alive_a = valid_a, sel_a = 0u, alive_b = valid_b, sel_b = 0u; int need_a = 256, need_b = 256; bool run_a = true, run_b = true;
#pragma unroll
        for (int j = 31; j >= 0; --j) {
            const unsigned ones_a = alive_a & ua[j], ones_b = alive_b & ub[j];
            int v = (int)((unsigned)__popc(ones_a) | ((unsigned)__popc(ones_b) << 16));
            v += __builtin_amdgcn_update_dpp(0, v, 0xB1, 0xF, 0xF, false);
            v += __builtin_amdgcn_update_dpp(0, v, 0x4E, 0xF, 0xF, false);
            v += __builtin_amdgcn_update_dpp(0, v, 0x141, 0xF, 0xF, false);
            v += __builtin_amdgcn_update_dpp(0, v, 0x140, 0xF, 0xF, false);
            const unsigned tot = (unsigned)(__builtin_amdgcn_readlane(v, 0) + __builtin_amdgcn_readlane(v, 16) + __builtin_amdgcn_readlane(v, 32) + __builtin_amdgcn_readlane(v, 48));
            const int ca = (int)(tot & 0xffffu), cb = (int)(tot >> 16);
            if (run_a) { if (ca >= need_a) { alive_a = ones_a; if (ca == need_a) { sel_a |= ones_a; need_a = 0; run_a = false; } }
                         else { need_a -= ca; sel_a |= ones_a; alive_a &= ~ua[j]; } }
            if (run_b) { if (cb >= need_b) { alive_b = ones_b; if (cb == need_b) { sel_b |= ones_b; need_b = 0; run_b = false; } }
                         else { need_b -= cb; sel_b |= ones_b; alive_b &= ~ub[j]; } }
            if (!run_a && !run_b) break;
        }
        if (need_a > 0) {
            const int cnt = __popc(alive_a); int inc = cnt;
#pragma unroll
            for (int d = 1; d < 64; d <<= 1) { const int o = __shfl_up(inc, d); if (lane >= d) inc += o; }
            int k = need_a - (inc - cnt); k = k < 0 ? 0 : (k > cnt ? cnt : k);
            unsigned m = alive_a;
            for (int i = 0; i < k; ++i) { const unsigned low = m & (0u - m); sel_a |= low; m ^= low; }
        }
        if (need_b > 0) {
            const int cnt = __popc(alive_b); int inc = cnt;
#pragma unroll
            for (int d = 1; d < 64; d <<= 1) { const int o = __shfl_up(inc, d); if (lane >= d) inc += o; }
            int k = need_b - (inc - cnt); k = k < 0 ? 0 : (k > cnt ? cnt : k);
            unsigned m = alive_b;
            for (int i = 0; i < k; ++i) { const unsigned low = m & (0u - m); sel_b |= low; m ^= low; }
        }
        mra[lane] = sel_a; mrb[lane] = sel_b;
        (void)tb2;
    }
    __syncthreads();
}

__device__ __forceinline__ float half_max(float m) { auto rr = __builtin_amdgcn_permlane32_swap(__float_as_uint(m), __float_as_uint(m), false, false); return __builtin_fmaxf(__uint_as_float(rr[0]), __uint_as_float(rr[1])); }
__device__ __forceinline__ float half_sum(float m) { auto rr = __builtin_amdgcn_permlane32_swap(__float_as_uint(m), __float_as_uint(m), false, false); return __uint_as_float(rr[0]) + __uint_as_float(rr[1]); }
__device__ __forceinline__ int crow(int r, int hi) { return (r & 3) + 8 * (r >> 2) + 4 * hi; }
template <int DQK, int DV, int MODE, int STRIP = 0>
__device__ __forceinline__ void attn_unit(LAS unsigned char* lds, const bf16* Qb, int qpitch, const bf16* Kb, int kpitch, const bf16* VTb, int skv,
                                          const unsigned* maskb, const bf16* Zb, bf16* Ob, int q0) {
    constexpr int TK = 128, KP = DQK + 8, VP = TK + 8;
    LAS bf16* Ks = (LAS bf16*)lds; LAS bf16* Vs = Ks + TK * KP;
    constexpr int CPR = DQK / 8;
    constexpr int NCK = TK * CPR, NCV = DV * (TK / 8);
    constexpr int RK = (NCK + 511) / 512, RV = (NCV + 511) / 512;
    constexpr int NKS = DQK / 16, NMT = DV / 32;
    int tid_ = threadIdx.x; asm volatile("" : "+v"(tid_));
    const int tid = tid_, lane = tid & 63, w = __builtin_amdgcn_readfirstlane(tid >> 6), r = lane & 31, hh = lane >> 5;
    const int NT = MODE == 0 ? skv / TK : (q0 + 256) / TK;
    const int qlo = q0 + 32 * w;
    bf16x8 qf[NKS];
    { const bf16* qrow = Qb + (size_t)(qlo + r) * qpitch + 8 * hh;
#pragma unroll
      for (int ks = 0; ks < NKS; ++ks) qf[ks] = *(const bf16x8*)(qrow + 16 * ks); }
    f32x16 o[NMT];
#pragma unroll
    for (int mt = 0; mt < NMT; ++mt)
#pragma unroll
        for (int i = 0; i < 16; ++i) o[mt][i] = 0.f;
    float m_run = NEGF, l_run = 0.f;
    v4u kreg[RK], vreg[RV];
#define ATT_PREFETCH(tile_) do { \
        _Pragma("unroll") for (int i_ = 0; i_ < RK; ++i_) { const int c_ = tid + 512 * i_; if (c_ < NCK) { const int row_ = c_ / CPR, cc_ = c_ % CPR; kreg[i_] = *(const v4u*)(Kb + (size_t)(TK * (tile_) + row_) * kpitch + 8 * cc_); } } \
        _Pragma("unroll") for (int i_ = 0; i_ < RV; ++i_) { const int c_ = tid + 512 * i_; if (c_ < NCV) { const int d_ = c_ >> 4, cc_ = c_ & 15; vreg[i_] = *(const v4u*)(VTb + (size_t)d_ * skv + TK * (tile_) + 8 * cc_); } } } while (0)
    if (STRIP != 2) ATT_PREFETCH(0);
    for (int tile = 0; tile < NT; ++tile) {
        __syncthreads();
        if (STRIP != 2) {
#pragma unroll
        for (int i = 0; i < RK; ++i) { const int c = tid + 512 * i; if (c < NCK) { const int row = c / CPR, cc = c % CPR; *(LAS v4u*)(Ks + row * KP + 8 * cc) = kreg[i]; } }
#pragma unroll
        for (int i = 0; i < RV; ++i) { const int c = tid + 512 * i; if (c < NCV) { const int d = c >> 4, cc = c & 15; *(LAS v4u*)(Vs + d * VP + 8 * cc) = vreg[i]; } }
        }
        __syncthreads();
        if (STRIP != 2 && tile + 1 < NT) ATT_PREFETCH(tile + 1);
        __builtin_amdgcn_sched_barrier(0);
        if (STRIP == 1) continue;
#pragma unroll 1
        for (int sub = 0; sub < 2; ++sub) {
        const int t64 = 2 * tile + sub;
        if (MODE != 0 && 64 * t64 > qlo + 31) continue;
        const LAS bf16* Kc = Ks + 64 * sub * KP; const LAS bf16* Vc = Vs + 64 * sub;
        unsigned mw0 = 0u, mw1 = 0u;
        if (MODE == 2) { const v2u mm = *(const v2u*)(maskb + (size_t)(qlo + r) * 64 + 2 * t64); mw0 = mm.x >> (4 * hh); mw1 = mm.y >> (4 * hh); }
        f32x16 s0, s1;
#pragma unroll
        for (int i = 0; i < 16; ++i) { s0[i] = 0.f; s1[i] = 0.f; }
#pragma unroll
        for (int ks = 0; ks < NKS; ++ks) {
            const bf16x8 a0 = *(const LAS bf16x8*)(Kc + r * KP + 16 * ks + 8 * hh);
            const bf16x8 a1 = *(const LAS bf16x8*)(Kc + (32 + r) * KP + 16 * ks + 8 * hh);
            s0 = __builtin_amdgcn_mfma_f32_32x32x16_bf16(a0, qf[ks], s0, 0, 0, 0);
            s1 = __builtin_amdgcn_mfma_f32_32x32x16_bf16(a1, qf[ks], s1, 0, 0, 0);
        }
        if (MODE == 1) {
            if (64 * t64 + 63 > qlo) { const int qg = qlo + r;
#pragma unroll
                for (int i = 0; i < 16; ++i) { const int key = 64 * t64 + crow(i, hh); if (key > qg) s0[i] = NEGF; if (key + 32 > qg) s1[i] = NEGF; } }
        }
        if (MODE == 2) {
#pragma unroll
            for (int i = 0; i < 16; ++i) { const int bit = (i & 3) + 8 * (i >> 2); if (!((mw0 >> bit) & 1u)) s0[i] = NEGF; if (!((mw1 >> bit) & 1u)) s1[i] = NEGF; }
        }
        float mx = s0[0];
#pragma unroll
        for (int i = 1; i < 16; ++i) mx = __builtin_fmaxf(mx, s0[i]);
#pragma unroll
        for (int i = 0; i < 16; ++i) mx = __builtin_fmaxf(mx, s1[i]);
        mx = half_max(mx);
        const float m_new = __builtin_fmaxf(m_run, mx);
        const float alpha = __builtin_amdgcn_exp2f(m_run - m_new);
        m_run = m_new;
        float ls = 0.f;
#pragma unroll
        for (int i = 0; i < 16; ++i) { s0[i] = __builtin_amdgcn_exp2f(s0[i] - m_new); s1[i] = __builtin_amdgcn_exp2f(s1[i] - m_new); ls += s0[i] + s1[i]; }
        l_run = l_run * alpha + ls;
#pragma unroll
        for (int mt = 0; mt < NMT; ++mt)
#pragma unroll
            for (int i = 0; i < 16; ++i) o[mt][i] *= alpha;
        v4u pf[2][2];
#pragma unroll
        for (int s = 0; s < 2; ++s) {
            pf[0][s] = (v4u){pk2(s0[8 * s], s0[8 * s + 1]), pk2(s0[8 * s + 2], s0[8 * s + 3]), pk2(s0[8 * s + 4], s0[8 * s + 5]), pk2(s0[8 * s + 6], s0[8 * s + 7])};
            pf[1][s] = (v4u){pk2(s1[8 * s], s1[8 * s + 1]), pk2(s1[8 * s + 2], s1[8 * s + 3]), pk2(s1[8 * s + 4], s1[8 * s + 5]), pk2(s1[8 * s + 6], s1[8 * s + 7])};
        }
#pragma unroll
        for (int mt = 0; mt < NMT; ++mt)
#pragma unroll
            for (int p = 0; p < 2; ++p)
#pragma unroll
                for (int s = 0; s < 2; ++s) {
                    const LAS bf16* vp = Vc + (32 * mt + r) * VP + 32 * p + 16 * s + 4 * hh;
                    const s16x4 lo = *(const LAS s16x4*)(vp), hi = *(const LAS s16x4*)(vp + 8);
                    const bf16x8 a = (bf16x8){lo[0], lo[1], lo[2], lo[3], hi[0], hi[1], hi[2], hi[3]};
                    o[mt] = __builtin_amdgcn_mfma_f32_32x32x16_bf16(a, __builtin_bit_cast(bf16x8, pf[p][s]), o[mt], 0, 0, 0);
                }
        }
    }
#undef ATT_PREFETCH
    const float l_tot = half_sum(l_run);
    const float inv = 1.0f / l_tot;
    const size_t row = (size_t)(qlo + r);
#pragma unroll
    for (int mt = 0; mt < NMT; ++mt)
#pragma unroll
        for (int g4 = 0; g4 < 4; ++g4) {
            const int d = 32 * mt + 8 * g4 + 4 * hh;
            float ov[4];
#pragma unroll
            for (int i = 0; i < 4; ++i) ov[i] = o[mt][4 * g4 + i] * inv;
            if (Zb) { const v2u zw = *(const v2u*)(Zb + row * PP + d); const float z[4] = {bflo(zw.x), bfhi(zw.x), bflo(zw.y), bfhi(zw.y)};
#pragma unroll
                for (int i = 0; i < 4; ++i) ov[i] *= z[i] * __builtin_amdgcn_rcpf(1.0f + __expf(-z[i])); }
            v2u ow; ow.x = pk2(ov[0], ov[1]); ow.y = pk2(ov[2], ov[3]);
            *(v2u*)(Ob + row * PP + d) = ow;
        }
}

template <int DQK, int MODE>
__device__ __forceinline__ void attn_unit_pipe(LAS unsigned char* lds, const bf16* Qb, int qpitch, const bf16* Kb, int kpitch, const bf16* VTb, int skv,
                                               const unsigned* maskb, bf16* Ob, int q0) {
    constexpr int DV = 64, KP = DQK + 8, VP = 72, BUFE = 64 * KP + DV * VP;
    constexpr int CPR = DQK / 8, NCK = 64 * CPR, NCV = DV * 8, RK = (NCK + 511) / 512, RV = (NCV + 511) / 512, NKS = DQK / 16, NMT = DV / 32;
    static_assert(NCV == 512 && (NCK == 512 || NCK == 768), "staging map");
    int tid_ = threadIdx.x; asm volatile("" : "+v"(tid_));
    const int tid = tid_, lane = tid & 63, w = __builtin_amdgcn_readfirstlane(tid >> 6), r = lane & 31, hh = lane >> 5;
    const int NT = (q0 + 256) / 64;
    const int qlo = q0 + 32 * w;
    const int NTw = ((qlo + 31) >> 6) + 1;
    int krow[RK], kcc[RK];
#pragma unroll
    for (int i = 0; i < RK; ++i) { int c = tid + 512 * i; if (c >= NCK) c -= 256; krow[i] = c / CPR; kcc[i] = c % CPR; }
    const int vd = tid >> 3, vcc = tid & 7;
    bf16x8 qf[NKS];
    { const bf16* qrow = Qb + (size_t)(qlo + r) * qpitch + 8 * hh;
#pragma unroll
      for (int ks = 0; ks < NKS; ++ks) qf[ks] = *(const bf16x8*)(qrow + 16 * ks); }
    f32x16 o[NMT];
#pragma unroll
    for (int mt = 0; mt < NMT; ++mt)
#pragma unroll
        for (int i = 0; i < 16; ++i) o[mt][i] = 0.f;
    float m_run = NEGF, l_run = 0.f, alpha = 1.f;
    v4u kreg[2][RK], vreg[2][RV]; v2u mset[2];
    const unsigned* mrowp = MODE == 2 ? maskb + (size_t)(qlo + r) * 64 : nullptr;
#define PL_LOAD(S_, tile_) do { const int tl_ = (tile_) < NT ? (tile_) : NT - 1; \
        if (MODE == 2) { const int mt_ = (tile_) >= 2 ? ((tile_) - 2 < 32 ? (tile_) - 2 : 31) : 0; mset[S_] = *(const v2u*)(mrowp + 2 * mt_); }     \
        _Pragma("unroll") for (int i_ = 0; i_ < RK; ++i_) kreg[S_][i_] = *(const v4u*)(Kb + (size_t)(64 * tl_ + krow[i_]) * kpitch + 8 * kcc[i_]); \
        vreg[S_][0] = *(const v4u*)(VTb + (size_t)vd * skv + 64 * tl_ + 8 * vcc); } while (0)
#define PL_STAGE(S_, buf_) do { LAS bf16* Kd_ = (LAS bf16*)lds + (buf_) * BUFE; LAS bf16* Vd_ = Kd_ + 64 * KP; \
        _Pragma("unroll") for (int i_ = 0; i_ < RK; ++i_) *(LAS v4u*)(Kd_ + krow[i_] * KP + 8 * kcc[i_]) = kreg[S_][i_]; \
        *(LAS v4u*)(Vd_ + vd * VP + 8 * vcc) = vreg[S_][0]; } while (0)
#define PL_QK(t_, D0_, D1_) do { const LAS bf16* Kc_ = (const LAS bf16*)lds + ((t_) & 3) * BUFE; \
        _Pragma("unroll") for (int i_ = 0; i_ < 16; ++i_) { D0_[i_] = 0.f; D1_[i_] = 0.f; } \
        _Pragma("unroll") for (int ks_ = 0; ks_ < NKS; ++ks_) { \
            const bf16x8 a0_ = *(const LAS bf16x8*)(Kc_ + r * KP + 16 * ks_ + 8 * hh); const bf16x8 a1_ = *(const LAS bf16x8*)(Kc_ + (32 + r) * KP + 16 * ks_ + 8 * hh); \
            D0_ = __builtin_amdgcn_mfma_f32_32x32x16_bf16(a0_, qf[ks_], D0_, 0, 0, 0); D1_ = __builtin_amdgcn_mfma_f32_32x32x16_bf16(a1_, qf[ks_], D1_, 0, 0, 0); } } while (0)
#define PL_PV(t_) do { const LAS bf16* Vc_ = (const LAS bf16*)lds + ((t_) & 3) * BUFE + 64 * KP; \
        _Pragma("unroll") for (int mt_ = 0; mt_ < NMT; ++mt_) _Pragma("unroll") for (int i_ = 0; i_ < 16; ++i_) o[mt_][i_] *= alpha; \
        _Pragma("unroll") for (int mt_ = 0; mt_ < NMT; ++mt_) _Pragma("unroll") for (int p_ = 0; p_ < 2; ++p_) _Pragma("unroll") for (int s_ = 0; s_ < 2; ++s_) { \
            const LAS bf16* vp_ = Vc_ + (32 * mt_ + r) * VP + 32 * p_ + 16 * s_ + 4 * hh; \
            const s16x4 lo_ = *(const LAS s16x4*)(vp_), hi_ = *(const LAS s16x4*)(vp_ + 8); \
            const bf16x8 a_ = (bf16x8){lo_[0], lo_[1], lo_[2], lo_[3], hi_[0], hi_[1], hi_[2], hi_[3]}; \
            o[mt_] = __builtin_amdgcn_mfma_f32_32x32x16_bf16(a_, __builtin_bit_cast(bf16x8, pf[p_][s_]), o[mt_], 0, 0, 0); } } while (0)
#define PL_SOFTMAX(t_, C0_, C1_, MK_, CAUSAL_) do { \
        if (MODE == 2) { const unsigned w0_ = (MK_).x >> (4 * hh), w1_ = (MK_).y >> (4 * hh); \
            _Pragma("unroll") for (int i_ = 0; i_ < 16; ++i_) { const int bit_ = (i_ & 3) + 8 * (i_ >> 2); if (!((w0_ >> bit_) & 1u)) C0_[i_] = NEGF; if (!((w1_ >> bit_) & 1u)) C1_[i_] = NEGF; } } \
        if (CAUSAL_) { const int qg_ = qlo + r; \
            _Pragma("unroll") for (int i_ = 0; i_ < 16; ++i_) { const int key_ = 64 * (t_) + crow(i_, hh); if (key_ > qg_) C0_[i_] = NEGF; if (key_ + 32 > qg_) C1_[i_] = NEGF; } } \
        float mx_ = C0_[0]; \
        _Pragma("unroll") for (int i_ = 1; i_ < 16; ++i_) mx_ = __builtin_fmaxf(mx_, C0_[i_]); \
        _Pragma("unroll") for (int i_ = 0; i_ < 16; ++i_) mx_ = __builtin_fmaxf(mx_, C1_[i_]); \
        mx_ = half_max(mx_); \
        const float mn_ = __builtin_fmaxf(m_run, mx_); alpha = __builtin_amdgcn_exp2f(m_run - mn_); m_run = mn_; \
        float ls_ = 0.f; \
        _Pragma("unroll") for (int i_ = 0; i_ < 16; ++i_) { C0_[i_] = __builtin_amdgcn_exp2f(C0_[i_] - mn_); C1_[i_] = __builtin_amdgcn_exp2f(C1_[i_] - mn_); ls_ += C0_[i_] + C1_[i_]; } \
        l_run = l_run * alpha + ls_; \
        _Pragma("unroll") for (int s_ = 0; s_ < 2; ++s_) { \
            pf[0][s_] = (v4u){pk2(C0_[8 * s_], C0_[8 * s_ + 1]), pk2(C0_[8 * s_ + 2], C0_[8 * s_ + 3]), pk2(C0_[8 * s_ + 4], C0_[8 * s_ + 5]), pk2(C0_[8 * s_ + 6], C0_[8 * s_ + 7])}; \
            pf[1][s_] = (v4u){pk2(C1_[8 * s_], C1_[8 * s_ + 1]), pk2(C1_[8 * s_ + 2], C1_[8 * s_ + 3]), pk2(C1_[8 * s_ + 4], C1_[8 * s_ + 5]), pk2(C1_[8 * s_ + 6], C1_[8 * s_ + 7])}; } } while (0)
#define PL_IO(t_, S_) do { PL_STAGE(S_, ((t_) + 2) & 3); PL_LOAD(S_, (t_) + 4); } while (0)
#define PL_STEADY(t_, S_) do { const v2u mk_ = mset[S_]; PL_IO(t_, S_); if (MODE == 2) { asm volatile("" :: "v"(mk_.x), "v"(mk_.y)); } \
        PL_QK((t_) + 1, n0, n1); PL_PV((t_) - 1); PL_SOFTMAX(t_, c0, c1, mk_, false); c0 = n0; c1 = n1; __syncthreads(); } while (0)
#define PL_TAIL(t_, S_) do { const v2u mk_ = mset[S_]; PL_IO(t_, S_); if ((t_) >= 1) PL_PV((t_) - 1); PL_SOFTMAX(t_, c0, c1, mk_, MODE == 1); PL_PV(t_); __syncthreads(); } while (0)
    f32x16 c0, c1, n0, n1; v4u pf[2][2];
    PL_LOAD(0, 0); PL_LOAD(1, 1);
    PL_STAGE(0, 0); PL_STAGE(1, 1);
    PL_LOAD(0, 2); PL_LOAD(1, 3);
    __syncthreads();
    PL_QK(0, c0, c1);
    int t = 0;
    if (NTw >= 2) {
        { const v2u mk_ = mset[0]; PL_IO(0, 0); PL_QK(1, n0, n1); PL_SOFTMAX(0, c0, c1, mk_, false); c0 = n0; c1 = n1; __syncthreads(); }
        for (t = 1; t + 1 < NTw; ) {
            PL_STEADY(t, 1); ++t;
            if (t + 1 < NTw) { PL_STEADY(t, 0); ++t; }
        }
    }
    if (t & 1) PL_TAIL(t, 1); else PL_TAIL(t, 0);
    for (++t; t < NT; ++t) { if (t & 1) PL_IO(t, 1); else PL_IO(t, 0); __syncthreads(); }
#undef PL_LOAD
#undef PL_STAGE
#undef PL_QK
#undef PL_PV
#undef PL_SOFTMAX
#undef PL_IO
#undef PL_STEADY
#undef PL_TAIL
    const float l_tot = half_sum(l_run);
    const float inv = 1.0f / l_tot;
    const size_t row = (size_t)(qlo + r);
#pragma unroll
    for (int mt = 0; mt < NMT; ++mt)
#pragma unroll
        for (int g4 = 0; g4 < 4; ++g4) {
            const int d = 32 * mt + 8 * g4 + 4 * hh;
            v2u ow; ow.x = pk2(o[mt][4 * g4] * inv, o[mt][4 * g4 + 1] * inv); ow.y = pk2(o[mt][4 * g4 + 2] * inv, o[mt][4 * g4 + 3] * inv);
            *(v2u*)(Ob + row * PP + d) = ow;
        }
}

__device__ __forceinline__ void attn_unit_mem(LAS unsigned char* lds, const bf16* Qb, const float* gqm, const bf16* Kb, const bf16* VTb, const bf16* Zb, bf16* Ob, int q0) {
    constexpr int DQK = 128, KP = DQK + 8, VP = MEML + 8, NKS = DQK / 16, NMT = 4;
    LAS bf16* Ks = (LAS bf16*)lds; LAS bf16* Vs = Ks + MEML * KP;
    int tid_ = threadIdx.x; asm volatile("" : "+v"(tid_));
    const int tid = tid_, lane = tid & 63, w = __builtin_amdgcn_readfirstlane(tid >> 6), r = lane & 31, hh = lane >> 5;
    { v4u kk[8], vv[8];
#pragma unroll
      for (int i = 0; i < 8; ++i) { const int c = tid + 512 * i; kk[i] = *(const v4u*)(Kb + (size_t)(c >> 4) * 1024 + 8 * (c & 15)); vv[i] = *(const v4u*)(VTb + (size_t)(c >> 5) * MEML + 8 * (c & 31)); }
#pragma unroll
      for (int i = 0; i < 8; ++i) { const int c = tid + 512 * i; *(LAS v4u*)(Ks + (c >> 4) * KP + 8 * (c & 15)) = kk[i]; *(LAS v4u*)(Vs + (c >> 5) * VP + 8 * (c & 31)) = vv[i]; } }
    __syncthreads();
#pragma unroll 1
    for (int qb = 0; qb < 2; ++qb) {
        const int qlo = q0 + 256 * qb + 32 * w;
        bf16x8 qf[NKS];
        { const bf16* qrow = Qb + (size_t)(qlo + r) * PP + 8 * hh;
#pragma unroll
          for (int ks = 0; ks < NKS; ++ks) qf[ks] = *(const bf16x8*)(qrow + 16 * ks);
          float ss = 0.f;
#pragma unroll
          for (int ks = 0; ks < NKS; ++ks) { const v4u w = __builtin_bit_cast(v4u, qf[ks]); float v[8]; UNPACK8(w, v);
#pragma unroll
              for (int j = 0; j < 8; ++j) ss += v[j] * v[j]; }
          const float rs = __builtin_amdgcn_rsqf(half_sum(ss) * (1.f / 128.f) + EPS) * SCALE_M;
#pragma unroll
          for (int ks = 0; ks < NKS; ++ks) { const v4u w = __builtin_bit_cast(v4u, qf[ks]); float v[8]; UNPACK8(w, v);
              const f32x4 g0 = *(const f32x4*)(gqm + 16 * ks + 8 * hh), g1 = *(const f32x4*)(gqm + 16 * ks + 8 * hh + 4);
              v[0] *= rs * g0[0]; v[1] *= rs * g0[1]; v[2] *= rs * g0[2]; v[3] *= rs * g0[3]; v[4] *= rs * g1[0]; v[5] *= rs * g1[1]; v[6] *= rs * g1[2]; v[7] *= rs * g1[3];
              const v4u p = PACK8(v); qf[ks] = __builtin_bit_cast(bf16x8, p); } }
        f32x16 o[NMT];
#pragma unroll
        for (int mt = 0; mt < NMT; ++mt)
#pragma unroll
            for (int i = 0; i < 16; ++i) o[mt][i] = 0.f;
        float m_run = NEGF, l_run = 0.f;
#pragma unroll 1
        for (int sub = 0; sub < MEML / 64; ++sub) {
            const LAS bf16* Kc = Ks + 64 * sub * KP; const LAS bf16* Vc = Vs + 64 * sub;
            f32x16 s0, s1;
#pragma unroll
            for (int i = 0; i < 16; ++i) { s0[i] = 0.f; s1[i] = 0.f; }
#pragma unroll
            for (int ks = 0; ks < NKS; ++ks) {
                const bf16x8 a0 = *(const LAS bf16x8*)(Kc + r * KP + 16 * ks + 8 * hh);
                const bf16x8 a1 = *(const LAS bf16x8*)(Kc + (32 + r) * KP + 16 * ks + 8 * hh);
                s0 = __builtin_amdgcn_mfma_f32_32x32x16_bf16(a0, qf[ks], s0, 0, 0, 0);
                s1 = __builtin_amdgcn_mfma_f32_32x32x16_bf16(a1, qf[ks], s1, 0, 0, 0);
            }
            float mx = s0[0];
#pragma unroll
            for (int i = 1; i < 16; ++i) mx = __builtin_fmaxf(mx, s0[i]);
#pragma unroll
            for (int i = 0; i < 16; ++i) mx = __builtin_fmaxf(mx, s1[i]);
            mx = half_max(mx);
            const float m_new = __builtin_fmaxf(m_run, mx);
            const float alpha = __builtin_amdgcn_exp2f(m_run - m_new);
            m_run = m_new;
            float ls = 0.f;
#pragma unroll
            for (int i = 0; i < 16; ++i) { s0[i] = __builtin_amdgcn_exp2f(s0[i] - m_new); s1[i] = __builtin_amdgcn_exp2f(s1[i] - m_new); ls += s0[i] + s1[i]; }
            l_run = l_run * alpha + ls;
#pragma unroll
            for (int mt = 0; mt < NMT; ++mt)
#pragma unroll
                for (int i = 0; i < 16; ++i) o[mt][i] *= alpha;
            v4u pf[2][2];
#pragma unroll
            for (int s = 0; s < 2; ++s) {
                pf[0][s] = (v4u){pk2(s0[8 * s], s0[8 * s + 1]), pk2(s0[8 * s + 2], s0[8 * s + 3]), pk2(s0[8 * s + 4], s0[8 * s + 5]), pk2(s0[8 * s + 6], s0[8 * s + 7])};
                pf[1][s] = (v4u){pk2(s1[8 * s], s1[8 * s + 1]), pk2(s1[8 * s + 2], s1[8 * s + 3]), pk2(s1[8 * s + 4], s1[8 * s + 5]), pk2(s1[8 * s + 6], s1[8 * s + 7])};
            }
#pragma unroll
            for (int mt = 0; mt < NMT; ++mt)
#pragma unroll
                for (int p = 0; p < 2; ++p)
#pragma unroll
                    for (int s = 0; s < 2; ++s) {
                        const LAS bf16* vp = Vc + (32 * mt + r) * VP + 32 * p + 16 * s + 4 * hh;
                        const s16x4 lo = *(const LAS s16x4*)(vp), hi = *(const LAS s16x4*)(vp + 8);
                        const bf16x8 a = (bf16x8){lo[0], lo[1], lo[2], lo[3], hi[0], hi[1], hi[2], hi[3]};
                        o[mt] = __builtin_amdgcn_mfma_f32_32x32x16_bf16(a, __builtin_bit_cast(bf16x8, pf[p][s]), o[mt], 0, 0, 0);
                    }
        }
        const float inv = 1.0f / half_sum(l_run);
        const size_t row = (size_t)(qlo + r);
#pragma unroll
        for (int mt = 0; mt < NMT; ++mt)
#pragma unroll
            for (int g4 = 0; g4 < 4; ++g4) {
                const int d = 32 * mt + 8 * g4 + 4 * hh;
                const v2u zw = *(const v2u*)(Zb + row * PP + d); const float z[4] = {bflo(zw.x), bfhi(zw.x), bflo(zw.y), bfhi(zw.y)};
                float ov[4];
#pragma unroll
                for (int i = 0; i < 4; ++i) ov[i] = o[mt][4 * g4 + i] * inv * (z[i] * __builtin_amdgcn_rcpf(1.0f + __expf(-z[i])));
                v2u ow; ow.x = pk2(ov[0], ov[1]); ow.y = pk2(ov[2], ov[3]);
                *(v2u*)(Ob + row * PP + d) = ow;
            }
    }
}

__device__ __forceinline__ bf16* gate_row(bf16* G0, bf16* G1, size_t row) { return row < 8192 ? G0 + row * 3072 : G1 + (row - 8192) * 3072; }
struct EpiZG {
    static constexpr bool PERM = true, AFTER_DRAIN = false;
    bf16* P; bf16* G0; bf16* G1;
    __device__ __forceinline__ void operator()(const pg8::f32x4 (&acc)[2][2][4][2], const pg8::Unit& u, int wr, int wc, int fr, int fq) const {
        const int row0 = u.pm * 256 + wr * 64 + fr, cl = wc * 32 + 8 * fq;
        const bool isz = u.pn < 4;
        const int ycol = (u.pn < 2 ? C_YA : C_YB) + (u.pn & 1) * 256, gcol = (u.pn - 4) * 256;
#pragma unroll
        for (int ai = 0; ai < 2; ++ai)
#pragma unroll
            for (int m = 0; m < 4; ++m) { const size_t row = (size_t)(row0 + ai * 128 + m * 16);
#pragma unroll
                for (int bj = 0; bj < 2; ++bj) {
                    const pg8::f32x4 v0 = acc[ai][bj][m][0], v1 = acc[ai][bj][m][1];
                    float rr[8] = {v0[0], v0[1], v0[2], v0[3], v1[0], v1[1], v1[2], v1[3]};
                    if (isz) { bf16* dst = P + row * PP + ycol + cl + bj * 128; const v4u old = *(const v4u*)dst; float yv[8]; UNPACK8(old, yv);
#pragma unroll
                        for (int e = 0; e < 8; ++e) rr[e] = yv[e] * (rr[e] * __builtin_amdgcn_rcpf(1.0f + __expf(-rr[e])));
                        *(v4u*)dst = PACK8(rr); }
                    else { bf16* dst = gate_row(G0, G1, row) + gcol + cl + bj * 128;
#pragma unroll
                        for (int e = 0; e < 8; ++e) rr[e] = __builtin_amdgcn_rcpf(1.0f + __expf(-rr[e]));
                        *(v4u*)dst = PACK8(rr); } } }
    }
};
struct EpiStoreVT {
    static constexpr bool PERM = true, AFTER_DRAIN = false;
    bf16* O; int ldc; bf16* VT;
    int vbeg, vend, hshift, voff, DV, sshift;
    __device__ __forceinline__ void operator()(const pg8::f32x4 (&acc)[2][2][4][2], const pg8::Unit& u, int wr, int wc, int fr, int fq) const {
        const int row0 = u.pm * 256 + wr * 64 + fr, col0 = u.pn * 256 + wc * 32 + 8 * fq;
        const int H = (vend - vbeg) >> hshift, S = 1 << sshift;
        bool isv[2]; long voffs[2];
#pragma unroll
        for (int bj = 0; bj < 2; ++bj) { const int col = col0 + bj * 128, cr = col - vbeg, within = cr & ((1 << hshift) - 1);
            isv[bj] = col >= vbeg && col < vend && within >= voff;
            voffs[bj] = ((long)((cr >> hshift) * DV + within - voff)) << sshift; }
#pragma unroll
        for (int ai = 0; ai < 2; ++ai)
#pragma unroll
            for (int m = 0; m < 4; ++m) { const int row = row0 + ai * 128 + m * 16;
                const int b = row >> sshift, sp = row & (S - 1);
#pragma unroll
                for (int bj = 0; bj < 2; ++bj) {
                    const pg8::f32x4 v0 = acc[ai][bj][m][0], v1 = acc[ai][bj][m][1];
                    const unsigned w0 = pk2(v0[0], v0[1]), w1 = pk2(v0[2], v0[3]), w2 = pk2(v1[0], v1[1]), w3 = pk2(v1[2], v1[3]);
                    if (!isv[bj]) *(v4u*)(O + (size_t)row * ldc + col0 + bj * 128) = (v4u){w0, w1, w2, w3};
                    else { bf16* dst = VT + (((long)(b * H * DV)) << sshift) + voffs[bj] + sp;
                        dst[0] = (bf16)(w0 & 0xffffu); dst[(size_t)S] = (bf16)(w0 >> 16); dst[(size_t)2 * S] = (bf16)(w1 & 0xffffu); dst[(size_t)3 * S] = (bf16)(w1 >> 16);
                        dst[(size_t)4 * S] = (bf16)(w2 & 0xffffu); dst[(size_t)5 * S] = (bf16)(w2 >> 16); dst[(size_t)6 * S] = (bf16)(w3 & 0xffffu); dst[(size_t)7 * S] = (bf16)(w3 >> 16); } }
                asm volatile("" ::: "memory"); }
    }
};
struct MergeOrder {
    pg8::StaticOrder so;
    __device__ __forceinline__ bool next(int i, pg8::Unit& u) const { pg8::Unit b; if (!so.next(i / 3, b)) return false; u.pm = b.pm; u.pn = (i % 3) * 4 + b.pn; return true; }
    __device__ __forceinline__ void a_ready(const pg8::Unit&) const {}
    __device__ __forceinline__ void done(const pg8::Unit&) const {}
};
struct EpiMerge {
    static constexpr bool PERM = true, AFTER_DRAIN = false;
    bf16* Mg; bf16* G0; bf16* G1;
    __device__ __forceinline__ void operator()(const pg8::f32x4 (&acc)[2][2][4][2], const pg8::Unit& u, int wr, int wc, int fr, int fq) const {
        const int nbr = u.pn >> 2;
        const int row0 = u.pm * 256 + wr * 64 + fr, col0 = (u.pn & 3) * 256 + wc * 32 + 8 * fq;
#pragma unroll
        for (int ai = 0; ai < 2; ++ai)
#pragma unroll
            for (int m = 0; m < 4; ++m) { const size_t row = (size_t)(row0 + ai * 128 + m * 16);
#pragma unroll
                for (int bj = 0; bj < 2; ++bj) { const int col = col0 + bj * 128;
                    const v4u gwd = *(const v4u*)(gate_row(G0, G1, row) + nbr * 1024 + col);
                    float gl[8]; UNPACK8(gwd, gl);
                    const pg8::f32x4 v0 = acc[ai][bj][m][0], v1 = acc[ai][bj][m][1];
                    float rr[8] = {v0[0], v0[1], v0[2], v0[3], v1[0], v1[1], v1[2], v1[3]};
#pragma unroll
                    for (int e = 0; e < 8; ++e) rr[e] *= gl[e];
                    bf16* dst = Mg + row * 1024 + col;
                    if (nbr > 0) { const v4u old = *(const v4u*)dst; float ol[8]; UNPACK8(old, ol);
#pragma unroll
                        for (int e = 0; e < 8; ++e) rr[e] += ol[e]; }
                    *(v4u*)dst = PACK8(rr); } }
    }
};
struct EpiOut {
    static constexpr bool PERM = true, AFTER_DRAIN = false;
    const float* X; float* Out;
    __device__ __forceinline__ void operator()(const pg8::f32x4 (&acc)[2][2][4][2], const pg8::Unit& u, int wr, int wc, int fr, int fq) const {
        const int row0 = u.pm * 256 + wr * 64 + fr, col0 = u.pn * 256 + wc * 32 + 8 * fq;
#pragma unroll
        for (int ai = 0; ai < 2; ++ai)
#pragma unroll
            for (int m = 0; m < 4; ++m) { const size_t row = (size_t)(row0 + ai * 128 + m * 16);
#pragma unroll
                for (int bj = 0; bj < 2; ++bj) { const size_t p = row * 1024 + col0 + bj * 128;
                    const f32x4 x0 = *(const f32x4*)(X + p), x1 = *(const f32x4*)(X + p + 4);
                    const pg8::f32x4 a0 = acc[ai][bj][m][0], a1 = acc[ai][bj][m][1];
                    *(f32x4*)(Out + p) = (f32x4){x0[0] + a0[0], x0[1] + a0[1], x0[2] + a0[2], x0[3] + a0[3]};
                    *(f32x4*)(Out + p + 4) = (f32x4){x1[0] + a1[0], x1[1] + a1[1], x1[2] + a1[2], x1[3] + a1[3]}; } }
    }
};

#define XB_TMO      128
#define XB_XCNT(j)  (256  + 64 * (j))
#define XB_XSUB(j)  (1280 + 64 * (j))
#define XB_XGEN(j)  (2304 + 64 * (j))
#define XB_TOP      3328
#define XB_TOPGEN   3392
#define XCD_BAR_WORDS 3456
#define XB_SPIN_CAP (1u << 18)

__device__ __forceinline__ unsigned xb_ld(unsigned* p)              { return __hip_atomic_load(p, __ATOMIC_RELAXED, __HIP_MEMORY_SCOPE_AGENT); }
__device__ __forceinline__ unsigned xb_add(unsigned* p, unsigned v) { return __hip_atomic_fetch_add(p, v, __ATOMIC_RELAXED, __HIP_MEMORY_SCOPE_AGENT); }
__device__ __forceinline__ unsigned xb_xcc_id() { return (unsigned)__builtin_amdgcn_s_getreg((3 << 11) | 20) & 0xFu; }
#define XB_SPIN(cond, bar) do { unsigned _sp = 0; while (cond) { __builtin_amdgcn_s_sleep(1); \
    if ((++_sp & 255u) == 0u) { if (xb_ld(&(bar)[XB_TMO])) break; if (_sp > XB_SPIN_CAP) { atomicAdd(&(bar)[XB_TMO], 1u); break; } } } } while (0)

struct XcdBarrier {
    unsigned* bar; unsigned x;
    volatile LAS unsigned* st;
};

__device__ __forceinline__ XcdBarrier xcd_barrier_post(unsigned* bar, volatile LAS unsigned* st) {
    XcdBarrier b; b.bar = bar; b.x = xb_xcc_id(); b.st = st;
    if (threadIdx.x == 0) (void)xb_add(&bar[XB_XCNT(b.x)], 1u);
    return b;
}
__device__ __forceinline__ void xcd_barrier_complete(unsigned* bar, unsigned x, unsigned& nloc, unsigned& nx) {
    const unsigned G = gridDim.x * gridDim.y * gridDim.z;
    unsigned sum, cnt, mine, sp = 0u;
    for (;;) {
        sum = 0u; cnt = 0u; mine = 0u;
#pragma unroll
        for (unsigned j = 0; j < 16; ++j) { const unsigned c = xb_ld(&bar[XB_XCNT(j)]); sum += c; cnt += (c > 0u) ? 1u : 0u; mine = (j == x) ? c : mine; }
        if (sum == G) break;
        __builtin_amdgcn_s_sleep(1);
        if ((++sp & 255u) == 0u) { if (xb_ld(&bar[XB_TMO])) break; if (sp > XB_SPIN_CAP) { atomicAdd(&bar[XB_TMO], 1u); break; } }
    }
    nloc = mine > 0u ? mine : 1u; nx = cnt > 0u ? cnt : 1u;
}

__device__ __forceinline__ void xcd_barrier(const XcdBarrier& b) {
    asm volatile("s_waitcnt vmcnt(0)" ::: "memory");
    __syncthreads();
    if (threadIdx.x == 0) {
        unsigned* bar = b.bar;
        __builtin_amdgcn_s_waitcnt(0);
        unsigned nloc = b.st[0], nx = b.st[1];
        if (nloc == 0u) { xcd_barrier_complete(bar, b.x, nloc, nx); b.st[0] = nloc; b.st[1] = nx; }
        const unsigned old = xb_add(&bar[XB_XSUB(b.x)], 1u);
        const unsigned gen = old / nloc;
        if (old + 1u == (gen + 1u) * nloc) {
            __builtin_amdgcn_fence(__ATOMIC_RELEASE, "agent");
            asm volatile("s_waitcnt vmcnt(0)" ::: "memory");
            const unsigned og = xb_add(&bar[XB_TOP], 1u);
            const unsigned tg = og / nx;
            if (og + 1u == (tg + 1u) * nx) xb_add(&bar[XB_TOPGEN], 1u);
            else XB_SPIN(xb_ld(&bar[XB_TOPGEN]) == tg, bar);
            __builtin_amdgcn_fence(__ATOMIC_ACQUIRE, "agent");
            xb_add(&bar[XB_XGEN(b.x)], 1u);
            asm volatile("s_waitcnt vmcnt(0)" ::: "memory");
        } else {
            XB_SPIN(xb_ld(&bar[XB_XGEN(b.x)]) == gen, bar);
            __builtin_amdgcn_fence(__ATOMIC_ACQUIRE, "agent");
            asm volatile("s_waitcnt vmcnt(0)" ::: "memory");
        }
    }
    __syncthreads();
}

template <int DQK, int DV, int MODE>
__device__ __forceinline__ void att_call(bool strip, LAS unsigned char* lds, const bf16* Qb, int qpitch, const bf16* Kb, int kpitch, const bf16* VTb, int skv, const unsigned* maskb, const bf16* Zb, bf16* Ob, int q0) {
    if (ATT_STRIP != 0 && strip) attn_unit<DQK, DV, MODE, ATT_STRIP>(lds, Qb, qpitch, Kb, kpitch, VTb, skv, maskb, Zb, Ob, q0);
    else attn_unit<DQK, DV, MODE, 0>(lds, Qb, qpitch, Kb, kpitch, VTb, skv, maskb, Zb, Ob, q0);
}
struct Args { const float* in[19]; const int* pos; float* out; unsigned char* ws; };
typedef const __attribute__((address_space(4))) Args* kargs_t;
#define PHASE_BEGIN \
    kargs_t ap_ = (kargs_t)__builtin_amdgcn_kernarg_segment_ptr(); asm volatile("" : "+s"(ap_)); \
    int tid = threadIdx.x; asm volatile("" : "+v"(tid)); \
    const int lane = tid & 63, wave = __builtin_amdgcn_readfirstlane(tid >> 6), G = gridDim.x, NGW = G * 8, gw = blockIdx.x * 8 + wave; \
    unsigned char* const ws = ap_->ws; unsigned char* const dob = (unsigned char*)ap_->out; const int* const pos = ap_->pos; float* const outp = ap_->out; unsigned* const ctl = (unsigned*)(ws + WS_CTL); \
    const float* const x = ap_->in[0]; const float* const mem = ap_->in[1]; \
    const float* const g_norm = ap_->in[3]; const float* const w_in = ap_->in[4]; const float* const g_qn_a = ap_->in[5]; const float* const g_kn_a = ap_->in[6]; \
    const float* const g_cq = ap_->in[7]; const float* const g_ckv = ap_->in[8]; const float* const w_uq = ap_->in[9]; const float* const w_ukv = ap_->in[10]; \
    const float* const g_qn_b = ap_->in[11]; const float* const g_kn_b = ap_->in[12]; const float* const g_mem = ap_->in[13]; const float* const w_mem_kv = ap_->in[14]; \
    const float* const g_qn_m = ap_->in[15]; const float* const g_kn_m = ap_->in[16]; const float* const w_branch = ap_->in[17]; const float* const w_out = ap_->in[18]; \
    bf16* const WinT = (bf16*)(ws + WS_WIN); bf16* const WuqT = (bf16*)(ws + WS_WUQ); bf16* const WukvT = (bf16*)(ws + WS_WUKV); bf16* const WmemT = (bf16*)(ws + WS_WMEM); \
    bf16* const WbrT = (bf16*)(ws + WS_WBR); bf16* const WoutT = (bf16*)(ws + WS_WOUT); \
    float* const ropeA = (float*)(ws + WS_ROPEA); float* const ropeB = (float*)(ws + WS_ROPEB); \
    bf16* const MN = (bf16*)(ws + WS_MN); bf16* const KVM = (bf16*)(ws + WS_KVM); bf16* const VTM = (bf16*)(ws + WS_VTM); \
    float* const WI = (float*)(ws + WS_WI); unsigned* const MASK = (unsigned*)(ws + WS_MASK); \
    bf16* const VTA = (bf16*)(dob + DO_VTA); bf16* const VTB = (bf16*)(dob + DO_VTB); bf16* const KB = (bf16*)(dob + DO_KB); \
    bf16* const Hh = (bf16*)(ws + WS_H); bf16* const MG = (bf16*)(ws + WS_H); bf16* const QB = (bf16*)(ws + WS_QB); \
    bf16* const KVB = (bf16*)(ws + WS_KVB); bf16* const GT0 = (bf16*)(dob + DO_G0); bf16* const GT1 = (bf16*)(ws + WS_G1); bf16* const P = (bf16*)(ws + WS_P); \
    (void)lane; (void)NGW; (void)gw; (void)ctl; \
    (void)pos; (void)outp; (void)x; (void)mem; (void)g_norm; (void)w_in; (void)g_qn_a; (void)g_kn_a; (void)g_cq; (void)g_ckv; (void)w_uq; (void)w_ukv; (void)g_qn_b; (void)g_kn_b; (void)g_mem; (void)w_mem_kv; \
    (void)g_qn_m; (void)g_kn_m; (void)w_branch; (void)w_out; (void)WinT; (void)WuqT; (void)WukvT; (void)WmemT; (void)WbrT; (void)WoutT; (void)ropeA; (void)ropeB; (void)MN; (void)KVM; (void)VTM; (void)WI; (void)MASK; \
    (void)VTA; (void)VTB; (void)Hh; (void)KB; (void)QB; (void)KVB; (void)MG; (void)GT0; (void)GT1; (void)P
#define GRID_BARRIER() do { kargs_t bp_ = (kargs_t)__builtin_amdgcn_kernarg_segment_ptr(); asm volatile("" : "+s"(bp_)); \
    XcdBarrier b_; b_.bar = (unsigned*)(bp_->ws + WS_CTL) + 4096; b_.x = xb_xcc_id(); b_.st = (volatile LAS unsigned*)(lds + LDS_BYTES - 32); xcd_barrier(b_); } while (0)

__global__ void __launch_bounds__(512, 2) fwd_kernel(Args a) {
    extern __shared__ __attribute__((aligned(16))) unsigned char lds_raw[];
    LAS unsigned char* const lds = (LAS unsigned char*)lds_raw;
    volatile LAS int* const slot = (volatile LAS int*)(lds + LDS_SLOT);
    if (threadIdx.x < 16) ((LAS unsigned*)(lds + LDS_BYTES - 64))[threadIdx.x] = 0u;
    __syncthreads();
    (void)xcd_barrier_post((unsigned*)(a.ws + WS_CTL) + 4096, (volatile LAS unsigned*)(lds + LDS_BYTES - 32));

    for (int rep = 0; rep < REP_P0; ++rep) { PHASE_BEGIN;
        LAS float* scr = (LAS float*)(lds + wave * 16384);
        constexpr int I_IN = 16 * (NP / 32), I_UQ = 6 * 24, I_UKV = 4 * 32, I_MEM = 16 * 32, I_BR = 8 * 32, I_OUT = 16 * 32;
        constexpr int NITEMS = I_IN + I_UQ + I_UKV + I_MEM + 3 * I_BR + I_OUT;
        for (int it = gw; it < NITEMS; it += NGW) {
            int r = it;
            if (r < I_IN) { transpose_item<true>(w_in, 1024, DIN, NP, WinT, scr, r, lane); continue; } r -= I_IN;
            if (r < I_UQ) { transpose_item<false>(w_uq, 384, 768, 768, WuqT, scr, r, lane); continue; } r -= I_UQ;
            if (r < I_UKV) { transpose_item<false>(w_ukv, 256, 1024, 1024, WukvT, scr, r, lane); continue; } r -= I_UKV;
            if (r < I_MEM) { transpose_item<false>(w_mem_kv, 1024, 1024, 1024, WmemT, scr, r, lane); continue; } r -= I_MEM;
            if (r < 3 * I_BR) { const int nb = r / I_BR; transpose_item<false>(w_branch + (size_t)nb * 512 * 1024, 512, 1024, 1024, WbrT + (size_t)nb * 1024 * 512, scr, r % I_BR, lane); continue; } r -= 3 * I_BR;
            transpose_item<false>(w_out, 1024, 1024, 1024, WoutT, scr, r, lane);
        }
        for (int idx = blockIdx.x * 512 + tid; idx < TT * 24; idx += G * 512) {
            const int t = idx / 24, i = idx % 24; const float pf = (float)pos[t];
            if (i < 8) { const float ang = pf * INVA[i]; ropeA[t * 16 + i] = cosf(ang); ropeA[t * 16 + 8 + i] = sinf(ang); }
            else { const int j = i - 8; const float ang = pf * INVB[j]; ropeB[t * 32 + j] = cosf(ang); ropeB[t * 32 + 16 + j] = sinf(ang); }
        }
        for (int m = gw; m < NB * MEML; m += NGW) rms_row_1024(mem + (size_t)m * DM, g_mem, MN + (size_t)m * DM, lane);
        for (int rp = 0; rp < REP_PH; ++rp)
        for (int m = gw; m < TT; m += NGW) rms_row_1024(x + (size_t)m * DM, g_norm, Hh + (size_t)m * DM, lane);
    }
    GRID_BARRIER();
    for (int es = 0; es < EXTRA_SYNCS; ++es) GRID_BARRIER();

    for (int rep = 0; rep < REP_G1; ++rep) { PHASE_BEGIN;
        pg8::Gemm g{Hh, WinT, TT, PP, 1024, 1024, nullptr, nullptr, nullptr, 0}; pg8::StaticOrder S; S.init(TT, PP, G, (int)blockIdx.x);
        EpiStoreVT E{P, PP, VTA, C_VA, C_VA + 512, 6, 0, 64, 11};
        pg8::gemm_phase<EpiStoreVT, pg8::StaticOrder, true, true>(lds, g, S, E);
    }
    { PHASE_BEGIN;
        pg8::Gemm g{MN, WmemT, NB * MEML, 1024, 1024, 1024, nullptr, nullptr, nullptr, 0}; pg8::StaticOrder S; S.init(NB * MEML, 1024, G, (int)((blockIdx.x + 64) % G));
        EpiStoreVT E{KVM, 1024, VTM, 512, 1024, 7, 0, 128, 8};
        pg8::gemm_phase<EpiStoreVT, pg8::StaticOrder, true, true>(lds, g, S, E);
    }
    GRID_BARRIER();
    { PHASE_BEGIN;
        float ga[8], gk[8], gq[8], gc[8], gm[8];
#pragma unroll
        for (int j = 0; j < 8; ++j) { ga[j] = g_qn_a[8 * (lane & 7) + j]; gk[j] = g_kn_a[8 * (lane & 7) + j]; gm[j] = g_qn_m[8 * (lane & 15) + j]; gq[j] = lane < 48 ? g_cq[8 * lane + j] : 0.f; gc[j] = lane < 32 ? g_ckv[8 * lane + j] : 0.f; }
        for (int dp = 0; dp < DUMMY_POST1; ++dp)
            for (int m = gw; m < TT; m += NGW)
                post1_row(P + (size_t)m * PP, QB + (size_t)(m & 1023) * 4096, ropeA + (size_t)m * 16, ga, gk, gq, gc, gm, (float*)KVB + (size_t)m * 8, lane);
        for (int m = gw; m < TT; m += NGW)
            post1_row(P + (size_t)m * PP, P + (size_t)m * PP, ropeA + (size_t)m * 16, ga, gk, gq, gc, gm, WI + (size_t)m * 8, lane);
        for (int m = gw; m < NB * MEML; m += NGW) km_row(KVM + (size_t)m * 1024, g_kn_m, lane);
    }
    GRID_BARRIER();
    for (int rep = 0; rep < REP_G2; ++rep) { PHASE_BEGIN;
        pg8::Gemm g{P + C_CQ, WuqT, TT, 768, 384, PP, nullptr, nullptr, nullptr, 0}; pg8::StaticOrder S; S.init(TT, 768, G, (int)blockIdx.x);
        pg8::EpiBf16<0> E{QB, 768, nullptr, 0, 0, 1.f};
        pg8::gemm_phase<pg8::EpiBf16<0>, pg8::StaticOrder, true, true>(lds, g, S, E);
    }
    for (int rep = 0; rep < REP_G2; ++rep) { PHASE_BEGIN;
        pg8::Gemm g{P + C_CKV, WukvT, TT, 1024, 256, PP, nullptr, nullptr, nullptr, 0}; pg8::StaticOrder S; S.init(TT, 1024, G, (int)((blockIdx.x + 192) % G));
        pg8::EpiBf16<0> E{KVB, 1024, nullptr, 0, 0, 1.f};
        pg8::gemm_phase<pg8::EpiBf16<0>, pg8::StaticOrder, true, true>(lds, g, S, E);
    }
    for (int rep = 0; rep < REP_IDX; ++rep) { if (rep > 0) GRID_BARRIER();
        PHASE_BEGIN;
        unsigned* const q_idx = ctl + 64 * (0 + 4 * rep);
        int u = next_unit(q_idx, slot);
        bf16x8 qf[8][2]; float wq[8];
        if (u < NB * 128) indexer_load_q(P, WI, u, qf, wq);
        while (u < NB * 128) {
            int tk = 0; if (tid == 0) tk = (int)atomicAdd(q_idx, 1u);
            const int tb = 127 - (u >> 3), bb = u & 7;
            int un;
            indexer_unit((LAS float*)lds, P, WI, MASK, bb, tb, qf, wq, tk, slot, NB * 128, un);
            u = un;
        }
    }
    GRID_BARRIER();
    { PHASE_BEGIN;
        LAS float* scr = (LAS float*)(lds + wave * 8192);
        float gqv[12], gkv[12];
#pragma unroll
        for (int e = 0; e < 12; ++e) { gqv[e] = g_qn_b[12 * (lane & 7) + e]; gkv[e] = g_kn_b[12 * (lane & 7) + e]; }
        for (int dp = 0; dp < DUMMY_POST2; ++dp)
            for (int m = gw; m < TT; m += NGW)
                post2_row(QB + (size_t)m * 768, (bf16*)MASK + (size_t)(m & 1023) * 768, KVB + (size_t)m * 1024, P + (size_t)m * PP, (bf16*)MASK + (size_t)(1024 + (m & 1023)) * 768, ropeB + (size_t)m * 32, gqv, gkv, scr, lane);
        for (int m = gw; m < TT; m += NGW)
            post2_row(QB + (size_t)m * 768, QB + (size_t)m * 768, KVB + (size_t)m * 1024, P + (size_t)m * PP, KB + (size_t)m * 768, ropeB + (size_t)m * 32, gqv, gkv, scr, lane);
        transpose_v(KVB, 1024, 64, 128, 8, 64, SEQ, NB, VTB, gw, NGW, lane);
    }
    GRID_BARRIER();
    for (int rep = 0; rep < REP_ATT; ++rep) { if (rep > 0) GRID_BARRIER();
        PHASE_BEGIN;
        unsigned* const q_att = ctl + 64 * (1 + 4 * rep);
        for (;;) {
            const int u = next_unit(q_att, slot);
            if (u >= 1152) break;
            if (u < 704 || u >= 832) {
                const int uu = u < 704 ? u : u - 128, cls = uu >> 6, bh = uu & 63, bb = bh >> 3, h = bh & 7;
                const bool isA = (0x52a7u >> cls) & 1u; const int qb = (int)((0x11232435467567ull >> (4 * cls)) & 15ull);
                const size_t r0 = (size_t)bb * SEQ;
                if (!isA) attn_unit_pipe<96, 1>(lds, QB + r0 * 768 + h * 96, 768, KB + r0 * 768 + h * 96, 768, VTB + (size_t)((bb * 8 + h) * 64) * SEQ, SEQ, nullptr,
                                                   P + r0 * PP + C_YB + h * 64, qb * 256);
                else attn_unit_pipe<64, 2>(lds, P + r0 * PP + C_QA + h * 64, PP, P + r0 * PP + C_KA + h * 64, PP, VTA + (size_t)((bb * 8 + h) * 64) * SEQ, SEQ, MASK + r0 * 64,
                                           P + r0 * PP + C_YA + h * 64, qb * 256);
            } else {
                const int v = u - 704, hq = v & 3, bh = v >> 2, bb = bh >> 2, h = bh & 3;
                const size_t r0 = (size_t)bb * SEQ;
                attn_unit_mem(lds, P + r0 * PP + C_QM + h * 128, g_qn_m, KVM + (size_t)bb * MEML * 1024 + h * 128, VTM + (size_t)((bb * 4 + h) * 128) * MEML,
                              P + r0 * PP + C_ZM + h * 128, P + r0 * PP + C_YM + h * 128, hq * 512);
            }
        }
    }
    GRID_BARRIER();
    for (int rep = 0; rep < 1; ++rep) { PHASE_BEGIN;
        pg8::Gemm g{Hh, WinT + (size_t)PP * 1024, TT, NZG, 1024, 1024, nullptr, nullptr, nullptr, 0}; pg8::StaticOrder S; S.init(TT, NZG, G, (int)blockIdx.x);
        EpiZG E{P, GT0, GT1};
        pg8::gemm_phase<EpiZG, pg8::StaticOrder, true, true>(lds, g, S, E);
    }
    GRID_BARRIER();
    for (int rep = 0; rep < REP_G4; ++rep) { PHASE_BEGIN;
        pg8::Gemm g{P + C_YA, WbrT, TT, 3072, 512, PP, P + C_YA, P + C_YB, P + C_YM, 4};
        MergeOrder S; S.so.init(TT, 1024, G, (int)blockIdx.x);
        EpiMerge E{MG, GT0, GT1};
        pg8::gemm_phase<EpiMerge, MergeOrder, true, true>(lds, g, S, E);
    }
    GRID_BARRIER();
    for (int rep = 0; rep < REP_G5; ++rep) { PHASE_BEGIN;
        pg8::Gemm g{MG, WoutT, TT, 1024, 1024, 1024, nullptr, nullptr, nullptr, 0}; pg8::StaticOrder S; S.init(TT, 1024, G, (int)blockIdx.x);
        EpiOut E{x, outp};
        pg8::gemm_phase<EpiOut, pg8::StaticOrder, true, true>(lds, g, S, E);
    }
}

extern "C" void kernel_launch(void* const* d_in, const int* in_sizes, int n_in, void* d_out, int out_size, void* d_ws, size_t ws_size, hipStream_t stream) {
    static int grid = 0;
    if (grid == 0) {
        if (n_in != 19 || out_size != TT * DM || ws_size < WS_END) { fprintf(stderr, "kernel_launch: unexpected problem (n_in %d, out %d, ws %zu); nothing launched\n", n_in, out_size, ws_size); grid = -1; return; }
        int dev = 0, cus = 0, per_cu = 0;
        if (hipGetDevice(&dev) != hipSuccess || hipDeviceGetAttribute(&cus, hipDeviceAttributeMultiprocessorCount, dev) != hipSuccess) { grid = -1; return; }
        if (hipFuncSetAttribute((const void*)fwd_kernel, hipFuncAttributeMaxDynamicSharedMemorySize, LDS_BYTES) != hipSuccess) { fprintf(stderr, "kernel_launch: hipFuncSetAttribute failed\n"); grid = -1; return; }
        if (hipOccupancyMaxActiveBlocksPerMultiprocessor(&per_cu, (const void*)fwd_kernel, 512, LDS_BYTES) != hipSuccess || per_cu < 1) { fprintf(stderr, "kernel_launch: occupancy query reports %d blocks per CU\n", per_cu); (void)hipGetLastError(); grid = -1; return; }
        grid = cus;
    }
    if (grid < 0) return;
    (void)hipMemsetAsync((char*)d_ws + WS_CTL, 0, 65536, stream);
    Args a{};
    for (int i = 0; i < 19; ++i) a.in[i] = (const float*)d_in[i];
    a.pos = (const int*)d_in[2]; a.out = (float*)d_out; a.ws = (unsigned char*)d_ws;
    hipLaunchKernelGGL(fwd_kernel, dim3(grid), dim3(512), LDS_BYTES, stream, a);
    const hipError_t e = hipPeekAtLastError();
    if (e != hipSuccess) fprintf(stderr, "kernel_launch: launch failed: %s (grid %d)\n", hipGetErrorString(e), grid);
}
```

```cpp
#include <hip/hip_runtime.h>
#include <cstdio>
#include <cstdint>
namespace pg8 {
#define PG8_LAS __attribute__((address_space(3)))
typedef unsigned short bf16_t;
typedef short bf16x8 __attribute__((ext_vector_type(8)));
typedef float f32x4 __attribute__((ext_vector_type(4)));
typedef unsigned u32x4 __attribute__((ext_vector_type(4)));
constexpr int BM = 256, BK = 64, HALF = 128, HTB = HALF * BK * 2  , STAGE_BYTES = 8 * HTB, NXCD = 8, WGM = 8;

__host__ __device__ __forceinline__ int lds_byte(int r, int c) { const int st = (r >> 4) * 2 + (c >> 5), rr = r & 15, cc = c & 31, ob = rr * 64 + cc * 2; return st * 1024 + (ob ^ (((ob >> 9) & 1) << 5)); }
__host__ __device__ __forceinline__ void stage_rc(int b, int& R, int& C) { const int st = b / 1024, sb = b % 1024, swz = sb ^ (((sb >> 9) & 1) << 5); R = (st >> 1) * 16 + swz / 64; C = (st & 1) * 32 + (swz % 64) / 2; }
__host__ __device__ __forceinline__ int perm32(int rho) { const int n = rho >> 4, i = rho & 15; return 8 * (i >> 2) + 4 * n + (i & 3); }

struct Unit { int pm, pn; };
struct Gemm { const bf16_t* A; const bf16_t* Bt; int M, N, K, lda; const bf16_t* Ag0; const bf16_t* Ag1; const bf16_t* Ag2; int ngrp; };
__device__ __forceinline__ const char* a_base(const Gemm& g, const Unit& u) { if (!g.ngrp) return (const char*)g.A; const int j = u.pn / g.ngrp; return (const char*)(j == 0 ? g.Ag0 : (j == 1 ? g.Ag1 : g.Ag2)); }

struct StaticOrder {
    int nM, nN, nwg, G, c;
    __host__ __device__ void init(int M, int N, int G_, int c_) { nM = M / BM; nN = N / BM; nwg = nM * nN; G = G_; c = c_; }
    __host__ __device__ bool next(int i, Unit& u) const {
        const long L = (long)i * G + c; if (L >= nwg) return false;
        int wgid = (int)L; { const int q = nwg / NXCD, r = nwg % NXCD, xcd = wgid % NXCD, off = wgid / NXCD; wgid = (xcd < r ? xcd * (q + 1) : r * (q + 1) + (xcd - r) * q) + off; }
        const int nig = WGM * nN, gid = wgid / nig, fm = gid * WGM, gsz = (nM - fm) < WGM ? (nM - fm) : WGM;
        u.pm = fm + ((wgid % nig) % gsz); u.pn = (wgid % nig) / gsz; return true;
    }
    __device__ __forceinline__ void a_ready(const Unit&) const {}
    __device__ __forceinline__ void done(const Unit&) const {}
};

__device__ __forceinline__ unsigned cvt_pk_bf16(float lo, float hi) { unsigned r; asm volatile("v_cvt_pk_bf16_f32 %0, %1, %2" : "=v"(r) : "v"(lo), "v"(hi)); return r; }
typedef float f32x2 __attribute__((ext_vector_type(2)));
__device__ __forceinline__ f32x2 gelu_pk(f32x2 v) {
    const f32x2 av = __builtin_elementwise_abs(v), d = av * 0.2316418882f + 1.0f;
    f32x2 t; t.x = __builtin_amdgcn_rcpf(d.x); t.y = __builtin_amdgcn_rcpf(d.y);
    f32x2 q = t * 0.5307027145f + (-0.7265760135f); q = q * t + 0.7107068705f; q = q * t + (-0.142248368f); q = q * t + 0.127414796f; q = q * t;
    const f32x2 s = (v * v) * (-0.72134752044f);
    f32x2 e; e.x = __builtin_amdgcn_exp2f(s.x); e.y = __builtin_amdgcn_exp2f(s.y);
    const f32x2 m = v * (q * e), r = v - m;
    f32x2 o; o.x = v.x < 0.f ? m.x : r.x; o.y = v.y < 0.f ? m.y : r.y; return o;
}

template <int ACT  > struct EpiBf16 {
    static constexpr bool PERM = true, AFTER_DRAIN = false; static_assert(ACT == 0 || ACT == 1, "EpiBf16: ACT is 0 (none) or 1 (gelu_pk)");
    bf16_t* O; int ldc; const float* bias; int split_cols; size_t split_stride; float scale0;
    __device__ __forceinline__ void operator()(const f32x4 (&acc)[2][2][4][2], const Unit& u, int wr, int wc, int fr, int fq) const {
        const int row0 = u.pm * BM + wr * 64 + fr; int colt = u.pn * BM; bf16_t* base = O;
        float sc = 1.f; if (split_cols) { const int t = colt / split_cols; base += (size_t)t * split_stride; colt -= t * split_cols; if (t == 0) sc = scale0; }
        const int col0 = colt + wc * 32 + 8 * fq, bcol0 = u.pn * BM + wc * 32 + 8 * fq;
        f32x4 bv[2][2];
#pragma unroll
        for (int bj = 0; bj < 2; ++bj)
#pragma unroll
            for (int n = 0; n < 2; ++n) bv[bj][n] = bias ? *(const f32x4*)(bias + bcol0 + bj * HALF + 4 * n) : (f32x4){0.f, 0.f, 0.f, 0.f};
#pragma unroll
        for (int ai = 0; ai < 2; ++ai)
#pragma unroll
            for (int m = 0; m < 4; ++m) { bf16_t* rowp = base + (size_t)(row0 + ai * HALF + m * 16) * ldc + col0;
#pragma unroll
                for (int bj = 0; bj < 2; ++bj) { f32x4 v0 = acc[ai][bj][m][0] + bv[bj][0], v1 = acc[ai][bj][m][1] + bv[bj][1];
                    if (ACT == 1) { f32x2 a = gelu_pk((f32x2){v0[0], v0[1]}), b = gelu_pk((f32x2){v0[2], v0[3]}), c = gelu_pk((f32x2){v1[0], v1[1]}), d = gelu_pk((f32x2){v1[2], v1[3]});
                        v0 = (f32x4){a.x, a.y, b.x, b.y}; v1 = (f32x4){c.x, c.y, d.x, d.y}; }
                    v0 = v0 * sc; v1 = v1 * sc; u32x4 w; w.x = cvt_pk_bf16(v0[0], v0[1]); w.y = cvt_pk_bf16(v0[2], v0[3]); w.z = cvt_pk_bf16(v1[0], v1[1]); w.w = cvt_pk_bf16(v1[2], v1[3]);
                    *(u32x4*)(rowp + bj * HALF) = w; } }
    }
};
template <class Epi, class Sched, bool ALIGN_EPI = false, bool SP2 = false>
__device__ __forceinline__ void gemm_phase(PG8_LAS unsigned char* lds, const Gemm g, const Sched& S, const Epi& E) {
    int tid_ = threadIdx.x; asm volatile("" : "+v"(tid_));
    const int tid = tid_, wid = __builtin_amdgcn_readfirstlane(tid >> 6), lane = tid & 63, wr = wid >> 2, wc = wid & 3, fr = lane & 15, fq = lane >> 4;
    const int K = g.K, nt = K / BK;
    unsigned voffA[2], voffB[2];
#pragma unroll
    for (int i = 0; i < 2; ++i) { int R, C; stage_rc(tid * 16 + i * 8192, R, C); const int Rb = Epi::PERM ? ((R & ~31) + perm32(R & 31)) : R;
        voffA[i] = (unsigned)(R * g.lda + C) * 2u; voffB[i] = (unsigned)(Rb * K + C) * 2u; }
    const size_t kstep = (size_t)(BK * 2);
    const size_t hstepA = (size_t)HALF * g.lda * 2, hstepB = (size_t)HALF * K * 2;
    const size_t tstepA = 2 * hstepA, tstepB = 2 * hstepB;
    const unsigned ldsw = (unsigned)wid * 1024u;
    const int aoff = lds_byte(wr * 64 + fr, fq * 8), boff = lds_byte(wc * 32 + fr, fq * 8);
#define PG8_SA(b, h) (((b) * 2 + (h)) * HTB)
#define PG8_SB(b, h) ((4 + (b) * 2 + (h)) * HTB)
#define PG8_STAGE(bufoff, gbase, voff) do { _Pragma("unroll") for (int _i = 0; _i < 2; ++_i) \
        __builtin_amdgcn_global_load_lds((const unsigned*)((const char*)(gbase) + (voff)[_i]), (PG8_LAS unsigned*)(lds + (bufoff) + ldsw + _i * 8192), 16, 0, 0); } while (0)
#define PG8_LDA(dst, b, h) do { _Pragma("unroll") for (int m = 0; m < 4; ++m) _Pragma("unroll") for (int k = 0; k < 2; ++k) dst[m][k] = *(const PG8_LAS bf16x8*)(lds + PG8_SA(b, h) + aoff + m * 2048 + k * 1024); } while (0)
#define PG8_LDB(dst, b, h) do { _Pragma("unroll") for (int n = 0; n < 2; ++n) _Pragma("unroll") for (int k = 0; k < 2; ++k) dst[n][k] = *(const PG8_LAS bf16x8*)(lds + PG8_SB(b, h) + boff + n * 2048 + k * 1024); } while (0)
#define PG8_MMA(ai, bj, At, Bt) do { __builtin_amdgcn_s_setprio(1); _Pragma("unroll") for (int m = 0; m < 4; ++m) _Pragma("unroll") for (int n = 0; n < 2; ++n) _Pragma("unroll") for (int k = 0; k < 2; ++k) \
        acc[ai][bj][m][n] = __builtin_amdgcn_mfma_f32_16x16x32_bf16(Bt[n][k], At[m][k], acc[ai][bj][m][n], 0, 0, 0); __builtin_amdgcn_s_setprio(0); } while (0)
#define PG8_WAIT_V(n) asm volatile("s_waitcnt vmcnt(" #n ")" ::: "memory")
#define PG8_WAIT_L(n) asm volatile("s_waitcnt lgkmcnt(" #n ")" ::: "memory")
#define PG8_BAR __builtin_amdgcn_s_barrier()
#define PG8_SCHED __builtin_amdgcn_sched_barrier(0)
    Unit cur, nxt; int ui = 0;
    if (!S.next(0, cur)) return;
    f32x4 acc[2][2][4][2];
#pragma unroll
    for (int a = 0; a < 2; ++a)
#pragma unroll
        for (int b = 0; b < 2; ++b)
#pragma unroll
            for (int m = 0; m < 4; ++m)
#pragma unroll
                for (int n = 0; n < 2; ++n) acc[a][b][m][n] = (f32x4){0.f, 0.f, 0.f, 0.f};
    bf16x8 At[4][2], B0[2][2], B1[2][2];
    const char* cA = a_base(g, cur) + (size_t)cur.pm * tstepA; const char* cB = (const char*)g.Bt + (size_t)cur.pn * tstepB;
    S.a_ready(cur);
    if constexpr (SP2) {
        PG8_STAGE(PG8_SB(0, 0), cB, voffB); PG8_STAGE(PG8_SB(0, 1), cB + hstepB, voffB); PG8_STAGE(PG8_SA(0, 0), cA, voffA); PG8_STAGE(PG8_SA(0, 1), cA + hstepA, voffA);
        if (wr == 1) PG8_BAR;
        PG8_WAIT_V(2); PG8_BAR;
        PG8_STAGE(PG8_SB(1, 0), cB + kstep, voffB); PG8_STAGE(PG8_SA(1, 0), cA + kstep, voffA); PG8_STAGE(PG8_SB(1, 1), cB + hstepB + kstep, voffB);
        PG8_WAIT_V(6); PG8_BAR;
    } else {
        PG8_STAGE(PG8_SB(0, 0), cB, voffB); PG8_STAGE(PG8_SA(0, 0), cA, voffA); PG8_STAGE(PG8_SB(0, 1), cB + hstepB, voffB); PG8_STAGE(PG8_SA(0, 1), cA + hstepA, voffA);
        if (wr == 1) PG8_BAR;
        PG8_WAIT_V(4); PG8_BAR;
        PG8_STAGE(PG8_SB(1, 0), cB + kstep, voffB); PG8_STAGE(PG8_SA(1, 0), cA + kstep, voffA); PG8_STAGE(PG8_SB(1, 1), cB + hstepB + kstep, voffB);
        PG8_WAIT_V(6); PG8_BAR;
    }
    for (;;) {
        const bool has_next = S.next(ui + 1, nxt);
        const char* nA = has_next ? a_base(g, nxt) + (size_t)nxt.pm * tstepA : cA; const char* nB = has_next ? (const char*)g.Bt + (size_t)nxt.pn * tstepB : cB;
        for (int t = 0; t < nt; t += 2) {
            const bool last = (t == nt - 2);
            const char* a1 = cA + (size_t)(t + 1) * kstep;
            const char* a2 = last ? nA : cA + (size_t)(t + 2) * kstep; const char* b2 = last ? nB : cB + (size_t)(t + 2) * kstep;
            const char* a3 = a2 + kstep; const char* b3 = b2 + kstep;
            if (last && has_next) S.a_ready(nxt);
            if constexpr (SP2) {
            PG8_LDB(B0, 0, 0); PG8_LDB(B1, 0, 1); PG8_SCHED; PG8_LDA(At, 0, 0); PG8_STAGE(PG8_SA(1, 1), a1 + hstepA, voffA);
            PG8_WAIT_V(8); PG8_WAIT_L(0); PG8_BAR; PG8_MMA(0, 0, At, B0); PG8_MMA(0, 1, At, B1); PG8_BAR; PG8_SCHED;
            PG8_LDA(At, 0, 1); PG8_STAGE(PG8_SB(0, 0), b2, voffB); PG8_STAGE(PG8_SB(0, 1), b2 + hstepB, voffB); PG8_STAGE(PG8_SA(0, 0), a2, voffA);
            PG8_WAIT_V(8); PG8_WAIT_L(0); PG8_BAR; PG8_MMA(1, 0, At, B0); PG8_MMA(1, 1, At, B1); PG8_BAR; PG8_SCHED;
            PG8_LDB(B0, 1, 0); PG8_LDB(B1, 1, 1); PG8_SCHED; PG8_LDA(At, 1, 0); PG8_STAGE(PG8_SA(0, 1), a2 + hstepA, voffA);
            PG8_WAIT_V(8); PG8_WAIT_L(0); PG8_BAR; PG8_MMA(0, 0, At, B0); PG8_MMA(0, 1, At, B1); PG8_BAR; PG8_SCHED;
            PG8_LDA(At, 1, 1); PG8_STAGE(PG8_SB(1, 0), b3, voffB); PG8_STAGE(PG8_SB(1, 1), b3 + hstepB, voffB); PG8_STAGE(PG8_SA(1, 0), a3, voffA);
            PG8_WAIT_V(8); PG8_WAIT_L(0); PG8_BAR; PG8_MMA(1, 0, At, B0); PG8_MMA(1, 1, At, B1); PG8_BAR; PG8_SCHED;
            } else {
            PG8_LDB(B0, 0, 0); PG8_SCHED; PG8_LDA(At, 0, 0); PG8_STAGE(PG8_SA(1, 1), a1 + hstepA, voffA);
            PG8_WAIT_L(8); PG8_BAR; PG8_WAIT_L(0); PG8_MMA(0, 0, At, B0); PG8_BAR; PG8_SCHED;
            PG8_LDB(B1, 0, 1); PG8_STAGE(PG8_SB(0, 0), b2, voffB);
            PG8_BAR; PG8_WAIT_L(0); PG8_MMA(0, 1, At, B1); PG8_BAR;
            PG8_LDA(At, 0, 1); PG8_STAGE(PG8_SA(0, 0), a2, voffA);
            PG8_BAR; PG8_WAIT_L(0); PG8_MMA(1, 0, At, B0); PG8_BAR; PG8_SCHED;
            PG8_STAGE(PG8_SB(0, 1), b2 + hstepB, voffB);
            PG8_WAIT_V(6); PG8_BAR; PG8_MMA(1, 1, At, B1); PG8_BAR;
            PG8_LDB(B0, 1, 0); PG8_SCHED; PG8_LDA(At, 1, 0); PG8_STAGE(PG8_SA(0, 1), a2 + hstepA, voffA);
            PG8_WAIT_L(8); PG8_BAR; PG8_WAIT_L(0); PG8_MMA(0, 0, At, B0); PG8_BAR; PG8_SCHED;
            PG8_LDB(B1, 1, 1); PG8_STAGE(PG8_SB(1, 0), b3, voffB);
            PG8_BAR; PG8_WAIT_L(0); PG8_MMA(0, 1, At, B1); PG8_BAR;
            PG8_LDA(At, 1, 1); PG8_STAGE(PG8_SA(1, 0), a3, voffA);
            PG8_BAR; PG8_WAIT_L(0); PG8_MMA(1, 0, At, B0); PG8_BAR; PG8_SCHED;
            PG8_STAGE(PG8_SB(1, 1), b3 + hstepB, voffB);
            PG8_WAIT_V(6); PG8_BAR; PG8_MMA(1, 1, At, B1); PG8_BAR;
            }
        }
        if constexpr (ALIGN_EPI) { if (wr == 0) PG8_BAR; }
        if constexpr (!Epi::AFTER_DRAIN) { E(acc, cur, wr, wc, fr, fq); S.done(cur); }
        if (!has_next) break;
#pragma unroll
        for (int a = 0; a < 2; ++a)
#pragma unroll
            for (int b = 0; b < 2; ++b)
#pragma unroll
                for (int m = 0; m < 4; ++m)
#pragma unroll
                    for (int n = 0; n < 2; ++n) acc[a][b][m][n] = (f32x4){0.f, 0.f, 0.f, 0.f};
        cur = nxt; cA = nA; cB = nB; ++ui;
        if constexpr (ALIGN_EPI) { if (wr == 1) PG8_BAR; }
    }
    PG8_WAIT_V(0);
    if constexpr (!ALIGN_EPI) { if (wr == 0) PG8_BAR; }
    PG8_BAR;
    if constexpr (Epi::AFTER_DRAIN) { E.fused(acc, cur, wr, wc, fr, fq, lds, wid, lane); S.done(cur); }
#undef PG8_SA
#undef PG8_SB
#undef PG8_STAGE
#undef PG8_LDA
#undef PG8_LDB
#undef PG8_MMA
#undef PG8_WAIT_V
#undef PG8_WAIT_L
#undef PG8_BAR
#undef PG8_SCHED
}
}

#define LAS __attribute__((address_space(3)))
typedef unsigned short bf16;
typedef unsigned v4u __attribute__((ext_vector_type(4)));
typedef unsigned v2u __attribute__((ext_vector_type(2)));
typedef float f32x4 __attribute__((ext_vector_type(4)));
typedef float f32x16 __attribute__((ext_vector_type(16)));
typedef short bf16x8 __attribute__((ext_vector_type(8)));
typedef short s16x4 __attribute__((ext_vector_type(4)));
typedef float f32x2_t __attribute__((ext_vector_type(2)));
typedef __bf16 bf16x2_t __attribute__((ext_vector_type(2)));

constexpr int NB = 8, SEQ = 2048, DM = 1024, TT = NB * SEQ;
constexpr int DIN = 7912, NP = 7936;
constexpr int PP = 3840, NZG = 4096;
constexpr int MEML = 256;
constexpr float EPS = 1e-6f, NEGF = -1e30f;
constexpr int C_QA = 0, C_KA = 512, C_VA = 1024, C_QI = 1536, C_KI = 2048, C_WI = 2112, C_CQ = 2120, C_CKV = 2504, C_KR = 2760, C_QM = 2792, C_ZM = 3304;
constexpr int C_YA = C_QI, C_YB = C_CQ, C_YM = C_VA;
constexpr float SCALE_A = 0.18033688011112042f;
constexpr float SCALE_B = 0.14724444602590306f;
constexpr float SCALE_M = 0.12751743082459868f;
constexpr float SCALE_I = 0.04419417382415922f;

__constant__ float INVA[8] = {1.0f, 0.1939227432012558f, 0.03760603070259094f, 0.007292664609849453f, 0.0014142135623842478f, 0.00027424818836152554f, 5.3182957344688475e-05f, 1.0313385246263351e-05f};
__constant__ float INVB[16] = {1.0f, 0.44036659598350525f, 0.1939227432012558f, 0.08539710193872452f, 0.03760603070259094f, 0.016560440883040428f, 0.007292664609849453f, 0.0032114461064338684f, 0.0014142135623842478f, 0.0006227724370546639f, 0.00027424818836152554f, 0.00012076973507646471f, 5.3182957344688475e-05f, 2.34199997066753e-05f, 1.0313385246263351e-05f, 4.541670477919979e-06f};

constexpr size_t MiB = 1u << 20;
constexpr size_t WS_CTL = 0;
constexpr size_t WS_WIN = 1 * MiB;
constexpr size_t WS_WUQ = 17 * MiB;
constexpr size_t WS_WUKV = 18 * MiB;
constexpr size_t WS_WMEM = 19 * MiB;
constexpr size_t WS_WBR = 21 * MiB;
constexpr size_t WS_WOUT = 24 * MiB;
constexpr size_t WS_ROPEA = 26 * MiB;
constexpr size_t WS_ROPEB = 27 * MiB;
constexpr size_t WS_MN = 29 * MiB;
constexpr size_t WS_KVM = 33 * MiB;
constexpr size_t WS_VTM = 37 * MiB;
constexpr size_t WS_WI = 39 * MiB;
constexpr size_t WS_MASK = 40 * MiB;
constexpr size_t WS_H = 44 * MiB;
constexpr size_t WS_P = 76 * MiB;
constexpr size_t WS_QB = 196 * MiB;
constexpr size_t WS_KVB = 220 * MiB;
constexpr size_t WS_G1 = 196 * MiB;
constexpr size_t WS_END = 256 * MiB;
constexpr size_t DO_VTA = 0;
constexpr size_t DO_VTB = 16 * MiB;
constexpr size_t DO_KB = 32 * MiB;
constexpr size_t DO_G0 = 0;

constexpr int REP_P0 = 1, REP_PH = 1, REP_G1 = 1, REP_G2 = 1, REP_IDX = 1, REP_ATT = 1, REP_G4 = 1, REP_G5 = 1;
constexpr int REP_IDX1 = 1, REP_SEL = 1;
constexpr int ATT_STRIP = 0;
constexpr int EXTRA_SYNCS = 0, REP_TR = 1, DUMMY_POST1 = 0, DUMMY_POST2 = 0;
constexpr int LDS_BYTES = 147456;
constexpr int LDS_SLOT = LDS_BYTES - 64;

__device__ __forceinline__ unsigned pk2(float lo, float hi) { f32x2_t v = {lo, hi}; bf16x2_t b = __builtin_convertvector(v, bf16x2_t); return __builtin_bit_cast(unsigned, b); }
__device__ __forceinline__ float bflo(unsigned w) { return __uint_as_float(w << 16); }
__device__ __forceinline__ float bfhi(unsigned w) { return __uint_as_float(w & 0xffff0000u); }
__device__ __forceinline__ float bf1(bf16 b) { return __uint_as_float(((unsigned)b) << 16); }
#define UNPACK8(W_, V_) do { V_[0] = bflo((W_)[0]); V_[1] = bfhi((W_)[0]); V_[2] = bflo((W_)[1]); V_[3] = bfhi((W_)[1]); V_[4] = bflo((W_)[2]); V_[5] = bfhi((W_)[2]); V_[6] = bflo((W_)[3]); V_[7] = bfhi((W_)[3]); } while (0)
#define PACK8(V_) (v4u){pk2(V_[0], V_[1]), pk2(V_[2], V_[3]), pk2(V_[4], V_[5]), pk2(V_[6], V_[7])}
template <int CTRL> __device__ __forceinline__ float dpp_f(float v) { return __int_as_float(__builtin_amdgcn_update_dpp(0, __float_as_int(v), CTRL, 0xF, 0xF, false)); }
#define SUM8(x) do { x += dpp_f<0xB1>(x); x += dpp_f<0x4E>(x); x += dpp_f<0x141>(x); } while (0)
#define SUM16(x) do { SUM8(x); x += dpp_f<0x140>(x); } while (0)
__device__ __forceinline__ float wave_sum(float v) {
    SUM16(v);
    return __int_as_float(__builtin_amdgcn_readlane(__float_as_int(v), 0)) + __int_as_float(__builtin_amdgcn_readlane(__float_as_int(v), 16))
         + __int_as_float(__builtin_amdgcn_readlane(__float_as_int(v), 32)) + __int_as_float(__builtin_amdgcn_readlane(__float_as_int(v), 48));
}
#define LDS_WAIT() asm volatile("s_waitcnt lgkmcnt(0)" ::: "memory")

__device__ __forceinline__ int win_src(int d) {
    if (d < 2120) return d;
    if (d < 2792) return d + 512;
    if (d < 3816) return d + 1024;
    if (d < 3840) return -1;
    if (d < 4352) return d - 3840 + 2120;
    if (d < 4864) return d - 4352 + 3304;
    return d - 4864 + 4840;
}
template <bool REMAP>
__device__ __forceinline__ void transpose_item(const float* W, int K, int N, int Npad, bf16* WT, LAS float* scr, int item, int lane) {
    const int nblk = Npad / 32, kb = item / nblk, nb = item % nblk, k0 = 64 * kb, n0 = 32 * nb;
    const int n4 = 4 * (lane & 7);
    const int nn = REMAP ? win_src(n0 + n4) : n0 + n4; const bool ok = nn >= 0 && nn < N;
#pragma unroll
    for (int i = 0; i < 8; ++i) { const int kk = 8 * i + (lane >> 3);
        f32x4 v = (f32x4){0.f, 0.f, 0.f, 0.f}; if (ok) v = __builtin_nontemporal_load((const f32x4*)(W + (size_t)(k0 + kk) * N + nn));
        LAS float* d = scr + kk * 33 + n4; d[0] = v[0]; d[1] = v[1]; d[2] = v[2]; d[3] = v[3]; }
    LDS_WAIT(); asm volatile("" ::: "memory");
    const int c = lane & 7;
#pragma unroll
    for (int j = 0; j < 4; ++j) { const int n = (lane >> 3) + 8 * j; const LAS float* s = scr + (8 * c) * 33 + n;
        v4u o; o.x = pk2(s[0 * 33], s[1 * 33]); o.y = pk2(s[2 * 33], s[3 * 33]); o.z = pk2(s[4 * 33], s[5 * 33]); o.w = pk2(s[6 * 33], s[7 * 33]);
        *(v4u*)(WT + (size_t)(n0 + n) * K + k0 + 8 * c) = o; }
    LDS_WAIT(); asm volatile("" ::: "memory");
}
__device__ __forceinline__ void rms_row_1024(const float* xrow, const float* g, bf16* orow, int lane) {
    const f32x4* xr = (const f32x4*)xrow + lane; const f32x4* gr = (const f32x4*)g + lane;
    f32x4 v[4]; float s = 0.f;
#pragma unroll
    for (int j = 0; j < 4; ++j) { v[j] = __builtin_nontemporal_load(xr + 64 * j); s += (v[j].x * v[j].x + v[j].y * v[j].y) + (v[j].z * v[j].z + v[j].w * v[j].w); }
    const float rstd = __builtin_amdgcn_rsqf(wave_sum(s) * (1.f / 1024.f) + EPS);
    v2u* o8 = (v2u*)orow + lane;
#pragma unroll
    for (int j = 0; j < 4; ++j) { const f32x4 gg = gr[64 * j]; v2u w; w.x = pk2(v[j].x * rstd * gg.x, v[j].y * rstd * gg.y); w.y = pk2(v[j].z * rstd * gg.z, v[j].w * rstd * gg.w); o8[64 * j] = w; }
}

#define ROPE8(v, sub, c8, s8) do { _Pragma("unroll") for (int j_ = 0; j_ < 8; ++j_) { const float pv_ = dpp_f<0xB1>(v[j_]); \
        const float r0_ = v[j_] * c8[j_] - pv_ * s8[j_], r1_ = v[j_] * c8[j_] + pv_ * s8[j_]; v[j_] = (sub) == 0 ? r0_ : ((sub) == 1 ? r1_ : v[j_]); } } while (0)

__device__ __forceinline__ void post1_row(const bf16* Prow, bf16* Orow, const float* ra, const float (&ga)[8], const float (&gk)[8], const float (&gq)[8], const float (&gc)[8], const float (&gm)[8], float* WIrow, int lane) {
    const int sub = lane & 7;
    const v4u z4 = (v4u){0u, 0u, 0u, 0u};
    const v4u w_qa = *(const v4u*)(Prow + C_QA + 8 * lane);
    const v4u w_ka = *(const v4u*)(Prow + C_KA + 8 * lane);
    const v4u w_qi = *(const v4u*)(Prow + C_QI + 8 * lane);
    v4u w_ki = z4, w_cq = z4, w_ckv = z4; float w_wi = 0.f;
    if (lane < 8) { w_ki = *(const v4u*)(Prow + C_KI + 8 * lane); w_wi = bf1(Prow[C_WI + lane]); }
    if (lane < 48) w_cq = *(const v4u*)(Prow + C_CQ + 8 * lane);
    if (lane < 32) w_ckv = *(const v4u*)(Prow + C_CKV + 8 * lane);
    float c8[8], s8[8];
    { const f32x4 r0 = *(const f32x4*)(ra), r1 = *(const f32x4*)(ra + 4), r2 = *(const f32x4*)(ra + 8), r3 = *(const f32x4*)(ra + 12);
      c8[0] = r0[0]; c8[1] = r0[1]; c8[2] = r0[2]; c8[3] = r0[3]; c8[4] = r1[0]; c8[5] = r1[1]; c8[6] = r1[2]; c8[7] = r1[3];
      s8[0] = r2[0]; s8[1] = r2[1]; s8[2] = r2[2]; s8[3] = r2[3]; s8[4] = r3[0]; s8[5] = r3[1]; s8[6] = r3[2]; s8[7] = r3[3]; }
    { float v[8]; UNPACK8(w_qa, v); float ss = 0.f;
#pragma unroll
      for (int j = 0; j < 8; ++j) ss += v[j] * v[j];
      SUM8(ss);
      const float rstd = __builtin_amdgcn_rsqf(ss * (1.f / 64.f) + EPS);
#pragma unroll
      for (int j = 0; j < 8; ++j) v[j] = v[j] * rstd * ga[j];
      ROPE8(v, sub, c8, s8);
#pragma unroll
      for (int j = 0; j < 8; ++j) v[j] *= SCALE_A;
      *(v4u*)(Orow + C_QA + 8 * lane) = PACK8(v); }
    { float v[8]; UNPACK8(w_ka, v); float ss = 0.f;
#pragma unroll
      for (int j = 0; j < 8; ++j) ss += v[j] * v[j];
      SUM8(ss);
      const float rstd = __builtin_amdgcn_rsqf(ss * (1.f / 64.f) + EPS);
#pragma unroll
      for (int j = 0; j < 8; ++j) v[j] = v[j] * rstd * gk[j];
      ROPE8(v, sub, c8, s8);
      *(v4u*)(Orow + C_KA + 8 * lane) = PACK8(v); }
    { float v[8]; UNPACK8(w_qi, v);
      ROPE8(v, sub, c8, s8);
      *(v4u*)(Orow + C_QI + 8 * lane) = PACK8(v); }
    { float v[8]; UNPACK8(w_ki, v);
      ROPE8(v, sub, c8, s8);
      if (lane < 8) *(v4u*)(Orow + C_KI + 8 * lane) = PACK8(v); }
    if (lane < 8) WIrow[lane] = w_wi * SCALE_I;
    { float v[8]; UNPACK8(w_cq, v); float ss = 0.f;
#pragma unroll
      for (int j = 0; j < 8; ++j) ss += v[j] * v[j];
      ss = wave_sum(ss); const float rstd = __builtin_amdgcn_rsqf(ss * (1.f / 384.f) + EPS);
      if (lane < 48) {
#pragma unroll
          for (int j = 0; j < 8; ++j) v[j] = v[j] * rstd * gq[j];
          *(v4u*)(Orow + C_CQ + 8 * lane) = PACK8(v); } }
    { float v[8]; UNPACK8(w_ckv, v); float ss = 0.f;
#pragma unroll
      for (int j = 0; j < 8; ++j) ss += v[j] * v[j];
      ss = wave_sum(ss); const float rstd = __builtin_amdgcn_rsqf(ss * (1.f / 256.f) + EPS);
      if (lane < 32) {
#pragma unroll
          for (int j = 0; j < 8; ++j) v[j] = v[j] * rstd * gc[j];
          *(v4u*)(Orow + C_CKV + 8 * lane) = PACK8(v); } }
}

__device__ __forceinline__ void km_row(bf16* row, const float* gkm, int lane) {
    v4u w = *(const v4u*)(row + 8 * lane); float v[8]; UNPACK8(w, v); float ss = 0.f;
#pragma unroll
    for (int j = 0; j < 8; ++j) ss += v[j] * v[j];
    SUM16(ss);
    const float rstd = __builtin_amdgcn_rsqf(ss * (1.f / 128.f) + EPS);
#pragma unroll
    for (int j = 0; j < 8; ++j) v[j] = v[j] * rstd * gkm[8 * (lane & 15) + j];
    *(v4u*)(row + 8 * lane) = PACK8(v);
}

__device__ __forceinline__ void transpose_v(const bf16* src, int pitch, int col0, int hstride, int H, int DV, int S, int nb, bf16* dst, int gw, int NGW, int lane) {
    const int ndq = DV / 64, nsc = S / 64, ntask = nb * H * nsc * ndq;
    for (int task = gw; task < ntask; task += NGW) {
        int x = task; const int dq = x % ndq; x /= ndq; const int sc = x % nsc; x /= nsc; const int h = x % H; const int b = x / H;
        const int s = sc * 64 + lane;
        const bf16* srow = src + (size_t)(b * S + s) * pitch + col0 + h * hstride + dq * 64;
        bf16* drow = dst + ((size_t)((b * H + h) * DV + dq * 64)) * S + s;
        v4u wv[8];
#pragma unroll
        for (int c = 0; c < 8; ++c) wv[c] = *(const v4u*)(srow + 8 * c);
#pragma unroll
        for (int c = 0; c < 8; ++c) { const v4u w = wv[c];
            drow[(size_t)(8 * c + 0) * S] = (bf16)(w.x & 0xffffu); drow[(size_t)(8 * c + 1) * S] = (bf16)(w.x >> 16);
            drow[(size_t)(8 * c + 2) * S] = (bf16)(w.y & 0xffffu); drow[(size_t)(8 * c + 3) * S] = (bf16)(w.y >> 16);
            drow[(size_t)(8 * c + 4) * S] = (bf16)(w.z & 0xffffu); drow[(size_t)(8 * c + 5) * S] = (bf16)(w.z >> 16);
            drow[(size_t)(8 * c + 6) * S] = (bf16)(w.w & 0xffffu); drow[(size_t)(8 * c + 7) * S] = (bf16)(w.w >> 16); }
    }
}

__device__ __forceinline__ void post2_row(const bf16* QBrow, bf16* QOrow, const bf16* KVBrow, const bf16* Prow, bf16* KBrow, const float* rb, const float (&gqv)[12], const float (&gkv)[12], LAS float* scr, int lane) {
    const int hd = lane >> 3, d0 = 12 * (lane & 7);
    float vq[12], vk[12], cc[12], sn[12];
    { const v2u* p = (const v2u*)(QBrow + 12 * lane);
      const v2u w0 = p[0], w1 = p[1], w2 = p[2];
      bf16 kr[12];
#pragma unroll
      for (int e = 0; e < 12; ++e) { const int d = d0 + e; kr[e] = d < 64 ? KVBrow[hd * 128 + d] : Prow[C_KR + d - 64]; }
#pragma unroll
      for (int e = 0; e < 12; ++e) { const int d = d0 + e; const int i = (d - 64) & 15; cc[e] = d < 64 ? 1.f : rb[i]; sn[e] = d < 64 ? 0.f : rb[16 + i]; }
      vq[0] = bflo(w0.x); vq[1] = bfhi(w0.x); vq[2] = bflo(w0.y); vq[3] = bfhi(w0.y); vq[4] = bflo(w1.x); vq[5] = bfhi(w1.x); vq[6] = bflo(w1.y); vq[7] = bfhi(w1.y);
      vq[8] = bflo(w2.x); vq[9] = bfhi(w2.x); vq[10] = bflo(w2.y); vq[11] = bfhi(w2.y);
#pragma unroll
      for (int e = 0; e < 12; ++e) vk[e] = bf1(kr[e]); }
    float sq = 0.f, sk = 0.f;
#pragma unroll
    for (int e = 0; e < 12; ++e) { sq += vq[e] * vq[e]; sk += vk[e] * vk[e]; }
    SUM8(sq); SUM8(sk);
    const float rq = __builtin_amdgcn_rsqf(sq * (1.f / 96.f) + EPS), rk = __builtin_amdgcn_rsqf(sk * (1.f / 96.f) + EPS);
#pragma unroll
    for (int e = 0; e < 12; ++e) { vq[e] = vq[e] * rq * gqv[e]; vk[e] = vk[e] * rk * gkv[e]; scr[12 * lane + e] = vq[e]; scr[768 + 12 * lane + e] = vk[e]; }
    LDS_WAIT(); asm volatile("" ::: "memory");
    float oq[12], ok[12];
#pragma unroll
    for (int e = 0; e < 12; ++e) { const int d = d0 + e;
        if (d < 64) { oq[e] = vq[e]; ok[e] = vk[e]; }
        else { const bool first = d < 80; const int off = first ? 16 : -16; const float pq = scr[12 * lane + e + off], pk = scr[768 + 12 * lane + e + off];
               oq[e] = first ? vq[e] * cc[e] - pq * sn[e] : vq[e] * cc[e] + pq * sn[e];
               ok[e] = first ? vk[e] * cc[e] - pk * sn[e] : vk[e] * cc[e] + pk * sn[e]; }
        oq[e] *= SCALE_B; }
    LDS_WAIT(); asm volatile("" ::: "memory");
    v2u* q = (v2u*)(QOrow + 12 * lane); v2u* k = (v2u*)(KBrow + 12 * lane);
#pragma unroll
    for (int i = 0; i < 3; ++i) { v2u w; w.x = pk2(oq[4 * i], oq[4 * i + 1]); w.y = pk2(oq[4 * i + 2], oq[4 * i + 3]); q[i] = w;
                                  v2u u; u.x = pk2(ok[4 * i], ok[4 * i + 1]); u.y = pk2(ok[4 * i + 2], ok[4 * i + 3]); k[i] = u; }
}

__device__ __forceinline__ int next_unit(unsigned* ctr, volatile LAS int* slot) {
    __syncthreads();
    if (threadIdx.x == 0) *slot = (int)atomicAdd(ctr, 1u);
    __syncthreads();
    return *slot;
}

constexpr int SCP = 2112;
__device__ __forceinline__ unsigned ord_key(float v) { const unsigned b = __float_as_uint(v); return b ^ ((unsigned)((int)b >> 31) | 0x80000000u); }
__device__ __forceinline__ void indexer_load_q(const bf16* P, const float* WI, int u, bf16x8 (&qf)[8][2], float (&wq)[8]) {
    const int lane = threadIdx.x & 63, n = lane & 15, g = lane >> 4;
    const int tb = 127 - (u >> 3), bb = u & 7;
    const size_t row = (size_t)(bb * SEQ + tb * 16 + n);
    const bf16* qrow = P + row * PP + C_QI + 8 * g;
#pragma unroll
    for (int h = 0; h < 8; ++h) { qf[h][0] = *(const bf16x8*)(qrow + h * 64); qf[h][1] = *(const bf16x8*)(qrow + h * 64 + 32); wq[h] = WI[row * 8 + h]; }
}
__device__ __forceinline__ void indexer_unit(LAS float* sc, const bf16* P, const float* WI, unsigned* MASK, int bb, int tb, bf16x8 (&qf)[8][2], float (&wq)[8],
                                             int tk, volatile LAS int* slot, int nunits, int& un) {
    int tid_ = threadIdx.x; asm volatile("" : "+v"(tid_));
    const int tid = tid_, lane = tid & 63, w = __builtin_amdgcn_readfirstlane(tid >> 6);
    const int n = lane & 15, g = lane >> 4;
    const int rowbase = bb * SEQ, t0 = tb * 16;
    {
        const int ntile = tb + 1;
        const int nmine = (ntile - w + 7) >> 3;
        const int ngrp = (nmine + 3) >> 2;
        const bf16* kbase = P + (size_t)(rowbase + n) * PP + C_KI + 8 * g;
        bf16x8 kb[2][4][2];
#define IDX_LOAD(BUF, GRP) do { _Pragma("unroll") for (int j_ = 0; j_ < 4; ++j_) { const int tile_ = w + 8 * (4 * (GRP) + j_); const int tl_ = tile_ < ntile ? tile_ : 0; \
            const bf16* kr_ = kbase + (size_t)(16 * tl_) * PP; kb[BUF][j_][0] = *(const bf16x8*)(kr_); kb[BUF][j_][1] = *(const bf16x8*)(kr_ + 32); } } while (0)
#define IDX_COMP(BUF, GRP) do { _Pragma("unroll") for (int j_ = 0; j_ < 4; ++j_) { const int tile_ = w + 8 * (4 * (GRP) + j_); if (tile_ < ntile) { \
            f32x4 idx_ = (f32x4){0.f, 0.f, 0.f, 0.f}; \
            _Pragma("unroll") for (int h_ = 0; h_ < 8; ++h_) { f32x4 a_ = (f32x4){0.f, 0.f, 0.f, 0.f}; \
                a_ = __builtin_amdgcn_mfma_f32_16x16x32_bf16(kb[BUF][j_][0], qf[h_][0], a_, 0, 0, 0); \
                a_ = __builtin_amdgcn_mfma_f32_16x16x32_bf16(kb[BUF][j_][1], qf[h_][1], a_, 0, 0, 0); \
                _Pragma("unroll") for (int i_ = 0; i_ < 4; ++i_) idx_[i_] = __builtin_fmaf(wq[h_], __builtin_fmaxf(a_[i_], 0.f), idx_[i_]); } \
            { const int k0_ = 16 * tile_ + 4 * g; LAS float* d_ = sc + n * SCP + k0_ + (k0_ >> 5); d_[0] = idx_[0]; d_[1] = idx_[1]; d_[2] = idx_[2]; d_[3] = idx_[3]; } } } } while (0)
        if (ngrp > 0) IDX_LOAD(0, 0);
        for (int gp = 0; gp < ngrp; gp += 2) {
            if (gp + 1 < ngrp) IDX_LOAD(1, gp + 1);
            IDX_COMP(0, gp);
            if (gp + 1 < ngrp) { if (gp + 2 < ngrp) IDX_LOAD(0, gp + 2); IDX_COMP(1, gp + 1); }
        }
#undef IDX_LOAD
#undef IDX_COMP
    }
    if (tid == 0) *slot = tk;
    __syncthreads();
    un = *slot;
    if (un < nunits) indexer_load_q(P, WI, un, qf, wq);
    for (int rs = 0; rs < REP_SEL; ++rs) {
        const int ta = t0 + 2 * w, tb2 = ta + 1;
        unsigned* mra = MASK + (size_t)(rowbase + ta) * 64; unsigned* mrb = mra + 64;
        const int nva = ta - 32 * lane + 1, nvb = nva + 1;
        const unsigned valid_a = nva >= 32 ? 0xffffffffu : (nva <= 0 ? 0u : ((1u << nva) - 1u));
        const unsigned valid_b = nvb >= 32 ? 0xffffffffu : (nvb <= 0 ? 0u : ((1u << nvb) - 1u));
        if (ta < 256) { mra[lane] = valid_a; mrb[lane] = valid_b; continue; }
        unsigned ua[32], ub[32];
        { const LAS float* sra = sc + (2 * w) * SCP + 33 * lane; const LAS float* srb = sra + SCP;
#pragma unroll
          for (int r = 0; r < 32; ++r) { const float va = sra[r], vb = srb[r]; ua[r] = ((valid_a >> r) & 1u) ? ord_key(va) : 0u; ub[r] = ((valid_b >> r) & 1u) ? ord_key(vb) : 0u; } }
#pragma unroll
        for (int k = 0; k < 16; ++k) {
            const unsigned a0 = ua[k], a1 = ua[k + 16]; ua[k] = __builtin_amdgcn_perm(a1, a0, 0x05040100u); ua[k + 16] = __builtin_amdgcn_perm(a1, a0, 0x07060302u);
            const unsigned b0 = ub[k], b1 = ub[k + 16]; ub[k] = __builtin_amdgcn_perm(b1, b0, 0x05040100u); ub[k + 16] = __builtin_amdgcn_perm(b1, b0, 0x07060302u); }
#pragma unroll
        for (int k = 0; k < 32; ++k) if (!(k & 8)) {
            const unsigned a0 = ua[k], a1 = ua[k + 8]; ua[k] = __builtin_amdgcn_perm(a1, a0, 0x06020400u); ua[k + 8] = __builtin_amdgcn_perm(a1, a0, 0x07030501u);
            const unsigned b0 = ub[k], b1 = ub[k + 8]; ub[k] = __builtin_amdgcn_perm(b1, b0, 0x06020400u); ub[k + 8] = __builtin_amdgcn_perm(b1, b0, 0x07030501u); }
#pragma unroll
        for (int si = 2; si < 5; ++si) { const int sft = 16 >> si;
            const unsigned msk = si == 2 ? 0x0f0f0f0fu : (si == 3 ? 0x33333333u : 0x55555555u);
#pragma unroll
            for (int k = 0; k < 32; ++k) if (!(k & sft)) {
                const unsigned a0 = ua[k], a1 = ua[k + sft]; ua[k] = (a0 & msk) | ((a1 << sft) & ~msk); ua[k + sft] = ((a0 >> sft) & msk) | (a1 & ~msk);
                const unsigned b0 = ub[k], b1 = ub[k + sft]; ub[k] = (b0 & msk) | ((b1 << sft) & ~msk); ub[k + sft] = ((b0 >> sft) & msk) | (b1 & ~msk); } }
        unsigned alive_a = valid_a, sel_a = 0u, alive_b = valid_b, sel_b = 0u; int need_a = 256, need_b = 256; bool run_a = true, run_b = true;
#pragma unroll
        for (int j = 31; j >= 0; --j) {
            const unsigned ones_a = alive_a & ua[j], ones_b = alive_b & ub[j];
            int v = (int)((unsigned)__popc(ones_a) | ((unsigned)__popc(ones_b) << 16));
            v += __builtin_amdgcn_update_dpp(0, v, 0xB1, 0xF, 0xF, false);
            v += __builtin_amdgcn_update_dpp(0, v, 0x4E, 0xF, 0xF, false);
            v += __builtin_amdgcn_update_dpp(0, v, 0x141, 0xF, 0xF, false);
            v += __builtin_amdgcn_update_dpp(0, v, 0x140, 0xF, 0xF, false);
            const unsigned tot = (unsigned)(__builtin_amdgcn_readlane(v, 0) + __builtin_amdgcn_readlane(v, 16) + __builtin_amdgcn_readlane(v, 32) + __builtin_amdgcn_readlane(v, 48));
            const int ca = (int)(tot & 0xffffu), cb = (int)(tot >> 16);
            if (run_a) { if (ca >= need_a) { alive_a = ones_a; if (ca == need_a) { sel_a |= ones_a; need_a = 0; run_a = false; } }
                         else { need_a -= ca; sel_a |= ones_a; alive_a &= ~ua[j]; } }
            if (run_b) { if (cb >= need_b) { alive_b = ones_b; if (cb == need_b) { sel_b |= ones_b; need_b = 0; run_b = false; } }
                         else { need_b -= cb; sel_b |= ones_b; alive_b &= ~ub[j]; } }
            if (!run_a && !run_b) break;
        }
        if (need_a > 0) {
            const int cnt = __popc(alive_a); int inc = cnt;
#pragma unroll
            for (int d = 1; d < 64; d <<= 1) { const int o = __shfl_up(inc, d); if (lane >= d) inc += o; }
            int k = need_a - (inc - cnt); k = k < 0 ? 0 : (k > cnt ? cnt : k);
            unsigned m = alive_a;
            for (int i = 0; i < k; ++i) { const unsigned low = m & (0u - m); sel_a |= low; m ^= low; }
        }
        if (need_b > 0) {
            const int cnt = __popc(alive_b); int inc = cnt;
#pragma unroll
            for (int d = 1; d < 64; d <<= 1) { const int o = __shfl_up(inc, d); if (lane >= d) inc += o; }
            int k = need_b - (inc - cnt); k = k < 0 ? 0 : (k > cnt ? cnt : k);
            unsigned m = alive_b;
            for (int i = 0; i < k; ++i) { const unsigned low = m & (0u - m); sel_b |= low; m ^= low; }
        }
        mra[lane] = sel_a; mrb[lane] = sel_b;
        (void)tb2;
    }
    __syncthreads();
}

__device__ __forceinline__ float half_max(float m) { auto rr = __builtin_amdgcn_permlane32_swap(__float_as_uint(m), __float_as_uint(m), false, false); return __builtin_fmaxf(__uint_as_float(rr[0]), __uint_as_float(rr[1])); }
__device__ __forceinline__ float half_sum(float m) { auto rr = __builtin_amdgcn_permlane32_swap(__float_as_uint(m), __float_as_uint(m), false, false); return __uint_as_float(rr[0]) + __uint_as_float(rr[1]); }
__device__ __forceinline__ int crow(int r, int hi) { return (r & 3) + 8 * (r >> 2) + 4 * hi; }
template <int DQK, int DV, int MODE, int STRIP = 0>
__device__ __forceinline__ void attn_unit(LAS unsigned char* lds, const bf16* Qb, int qpitch, const bf16* Kb, int kpitch, const bf16* VTb, int skv,
                                          const unsigned* maskb, const bf16* Zb, bf16* Ob, int q0) {
    constexpr int TK = 128, KP = DQK + 8, VP = TK + 8;
    LAS bf16* Ks = (LAS bf16*)lds; LAS bf16* Vs = Ks + TK * KP;
    constexpr int CPR = DQK / 8;
    constexpr int NCK = TK * CPR, NCV = DV * (TK / 8);
    constexpr int RK = (NCK + 511) / 512, RV = (NCV + 511) / 512;
    constexpr int NKS = DQK / 16, NMT = DV / 32;
    int tid_ = threadIdx.x; asm volatile("" : "+v"(tid_));
    const int tid = tid_, lane = tid & 63, w = __builtin_amdgcn_readfirstlane(tid >> 6), r = lane & 31, hh = lane >> 5;
    const int NT = MODE == 0 ? skv / TK : (q0 + 256) / TK;
    const int qlo = q0 + 32 * w;
    bf16x8 qf[NKS];
    { const bf16* qrow = Qb + (size_t)(qlo + r) * qpitch + 8 * hh;
#pragma unroll
      for (int ks = 0; ks < NKS; ++ks) qf[ks] = *(const bf16x8*)(qrow + 16 * ks); }
    f32x16 o[NMT];
#pragma unroll
    for (int mt = 0; mt < NMT; ++mt)
#pragma unroll
        for (int i = 0; i < 16; ++i) o[mt][i] = 0.f;
    float m_run = NEGF, l_run = 0.f;
    v4u kreg[RK], vreg[RV];
#define ATT_PREFETCH(tile_) do { \
        _Pragma("unroll") for (int i_ = 0; i_ < RK; ++i_) { const int c_ = tid + 512 * i_; if (c_ < NCK) { const int row_ = c_ / CPR, cc_ = c_ % CPR; kreg[i_] = *(const v4u*)(Kb + (size_t)(TK * (tile_) + row_) * kpitch + 8 * cc_); } } \
        _Pragma("unroll") for (int i_ = 0; i_ < RV; ++i_) { const int c_ = tid + 512 * i_; if (c_ < NCV) { const int d_ = c_ >> 4, cc_ = c_ & 15; vreg[i_] = *(const v4u*)(VTb + (size_t)d_ * skv + TK * (tile_) + 8 * cc_); } } } while (0)
    if (STRIP != 2) ATT_PREFETCH(0);
    for (int tile = 0; tile < NT; ++tile) {
        __syncthreads();
        if (STRIP != 2) {
#pragma unroll
        for (int i = 0; i < RK; ++i) { const int c = tid + 512 * i; if (c < NCK) { const int row = c / CPR, cc = c % CPR; *(LAS v4u*)(Ks + row * KP + 8 * cc) = kreg[i]; } }
#pragma unroll
        for (int i = 0; i < RV; ++i) { const int c = tid + 512 * i; if (c < NCV) { const int d = c >> 4, cc = c & 15; *(LAS v4u*)(Vs + d * VP + 8 * cc) = vreg[i]; } }
        }
        __syncthreads();
        if (STRIP != 2 && tile + 1 < NT) ATT_PREFETCH(tile + 1);
        __builtin_amdgcn_sched_barrier(0);
        if (STRIP == 1) continue;
#pragma unroll 1
        for (int sub = 0; sub < 2; ++sub) {
        const int t64 = 2 * tile + sub;
        if (MODE != 0 && 64 * t64 > qlo + 31) continue;
        const LAS bf16* Kc = Ks + 64 * sub * KP; const LAS bf16* Vc = Vs + 64 * sub;
        unsigned mw0 = 0u, mw1 = 0u;
        if (MODE == 2) { const v2u mm = *(const v2u*)(maskb + (size_t)(qlo + r) * 64 + 2 * t64); mw0 = mm.x >> (4 * hh); mw1 = mm.y >> (4 * hh); }
        f32x16 s0, s1;
#pragma unroll
        for (int i = 0; i < 16; ++i) { s0[i] = 0.f; s1[i] = 0.f; }
#pragma unroll
        for (int ks = 0; ks < NKS; ++ks) {
            const bf16x8 a0 = *(const LAS bf16x8*)(Kc + r * KP + 16 * ks + 8 * hh);
            const bf16x8 a1 = *(const LAS bf16x8*)(Kc + (32 + r) * KP + 16 * ks + 8 * hh);
            s0 = __builtin_amdgcn_mfma_f32_32x32x16_bf16(a0, qf[ks], s0, 0, 0, 0);
            s1 = __builtin_amdgcn_mfma_f32_32x32x16_bf16(a1, qf[ks], s1, 0, 0, 0);
        }
        if (MODE == 1) {
            if (64 * t64 + 63 > qlo) { const int qg = qlo + r;
#pragma unroll
                for (int i = 0; i < 16; ++i) { const int key = 64 * t64 + crow(i, hh); if (key > qg) s0[i] = NEGF; if (key + 32 > qg) s1[i] = NEGF; } }
        }
        if (MODE == 2) {
#pragma unroll
            for (int i = 0; i < 16; ++i) { const int bit = (i & 3) + 8 * (i >> 2); if (!((mw0 >> bit) & 1u)) s0[i] = NEGF; if (!((mw1 >> bit) & 1u)) s1[i] = NEGF; }
        }
        float mx = s0[0];
#pragma unroll
        for (int i = 1; i < 16; ++i) mx = __builtin_fmaxf(mx, s0[i]);
#pragma unroll
        for (int i = 0; i < 16; ++i) mx = __builtin_fmaxf(mx, s1[i]);
        mx = half_max(mx);
        const float m_new = __builtin_fmaxf(m_run, mx);
        const float alpha = __builtin_amdgcn_exp2f(m_run - m_new);
        m_run = m_new;
        float ls = 0.f;
#pragma unroll
        for (int i = 0; i < 16; ++i) { s0[i] = __builtin_amdgcn_exp2f(s0[i] - m_new); s1[i] = __builtin_amdgcn_exp2f(s1[i] - m_new); ls += s0[i] + s1[i]; }
        l_run = l_run * alpha + ls;
#pragma unroll
        for (int mt = 0; mt < NMT; ++mt)
#pragma unroll
            for (int i = 0; i < 16; ++i) o[mt][i] *= alpha;
        v4u pf[2][2];
#pragma unroll
        for (int s = 0; s < 2; ++s) {
            pf[0][s] = (v4u){pk2(s0[8 * s], s0[8 * s + 1]), pk2(s0[8 * s + 2], s0[8 * s + 3]), pk2(s0[8 * s + 4], s0[8 * s + 5]), pk2(s0[8 * s + 6], s0[8 * s + 7])};
            pf[1][s] = (v4u){pk2(s1[8 * s], s1[8 * s + 1]), pk2(s1[8 * s + 2], s1[8 * s + 3]), pk2(s1[8 * s + 4], s1[8 * s + 5]), pk2(s1[8 * s + 6], s1[8 * s + 7])};
        }
#pragma unroll
        for (int mt = 0; mt < NMT; ++mt)
#pragma unroll
            for (int p = 0; p < 2; ++p)
#pragma unroll
                for (int s = 0; s < 2; ++s) {
                    const LAS bf16* vp = Vc + (32 * mt + r) * VP + 32 * p + 16 * s + 4 * hh;
                    const s16x4 lo = *(const LAS s16x4*)(vp), hi = *(const LAS s16x4*)(vp + 8);
                    const bf16x8 a = (bf16x8){lo[0], lo[1], lo[2], lo[3], hi[0], hi[1], hi[2], hi[3]};
                    o[mt] = __builtin_amdgcn_mfma_f32_32x32x16_bf16(a, __builtin_bit_cast(bf16x8, pf[p][s]), o[mt], 0, 0, 0);
                }
        }
    }
#undef ATT_PREFETCH
    const float l_tot = half_sum(l_run);
    const float inv = 1.0f / l_tot;
    const size_t row = (size_t)(qlo + r);
#pragma unroll
    for (int mt = 0; mt < NMT; ++mt)
#pragma unroll
        for (int g4 = 0; g4 < 4; ++g4) {
            const int d = 32 * mt + 8 * g4 + 4 * hh;
            float ov[4];
#pragma unroll
            for (int i = 0; i < 4; ++i) ov[i] = o[mt][4 * g4 + i] * inv;
            if (Zb) { const v2u zw = *(const v2u*)(Zb + row * PP + d); const float z[4] = {bflo(zw.x), bfhi(zw.x), bflo(zw.y), bfhi(zw.y)};
#pragma unroll
                for (int i = 0; i < 4; ++i) ov[i] *= z[i] * __builtin_amdgcn_rcpf(1.0f + __expf(-z[i])); }
            v2u ow; ow.x = pk2(ov[0], ov[1]); ow.y = pk2(ov[2], ov[3]);
            *(v2u*)(Ob + row * PP + d) = ow;
        }
}

template <int DQK, int MODE>
__device__ __forceinline__ void attn_unit_pipe(LAS unsigned char* lds, const bf16* Qb, int qpitch, const bf16* Kb, int kpitch, const bf16* VTb, int skv,
                                               const unsigned* maskb, bf16* Ob, int q0) {
    constexpr int DV = 64, KP = DQK + 8, VP = 72, BUFE = 64 * KP + DV * VP;
    constexpr int CPR = DQK / 8, NCK = 64 * CPR, NCV = DV * 8, RK = (NCK + 511) / 512, RV = (NCV + 511) / 512, NKS = DQK / 16, NMT = DV / 32;
    static_assert(NCV == 512 && (NCK == 512 || NCK == 768), "staging map");
    int tid_ = threadIdx.x; asm volatile("" : "+v"(tid_));
    const int tid = tid_, lane = tid & 63, w = __builtin_amdgcn_readfirstlane(tid >> 6), r = lane & 31, hh = lane >> 5;
    const int NT = (q0 + 256) / 64;
    const int qlo = q0 + 32 * w;
    const int NTw = ((qlo + 31) >> 6) + 1;
    int krow[RK], kcc[RK];
#pragma unroll
    for (int i = 0; i < RK; ++i) { int c = tid + 512 * i; if (c >= NCK) c -= 256; krow[i] = c / CPR; kcc[i] = c % CPR; }
    const int vd = tid >> 3, vcc = tid & 7;
    bf16x8 qf[NKS];
    { const bf16* qrow = Qb + (size_t)(qlo + r) * qpitch + 8 * hh;
#pragma unroll
      for (int ks = 0; ks < NKS; ++ks) qf[ks] = *(const bf16x8*)(qrow + 16 * ks); }
    f32x16 o[NMT];
#pragma unroll
    for (int mt = 0; mt < NMT; ++mt)
#pragma unroll
        for (int i = 0; i < 16; ++i) o[mt][i] = 0.f;
    float m_run = NEGF, l_run = 0.f, alpha = 1.f;
    v4u kreg[2][RK], vreg[2][RV]; v2u mset[2];
    const unsigned* mrowp = MODE == 2 ? maskb + (size_t)(qlo + r) * 64 : nullptr;
#define PL_LOAD(S_, tile_) do { const int tl_ = (tile_) < NT ? (tile_) : NT - 1; \
        if (MODE == 2) { const int mt_ = (tile_) >= 2 ? ((tile_) - 2 < 32 ? (tile_) - 2 : 31) : 0; mset[S_] = *(const v2u*)(mrowp + 2 * mt_); }     \
        _Pragma("unroll") for (int i_ = 0; i_ < RK; ++i_) kreg[S_][i_] = *(const v4u*)(Kb + (size_t)(64 * tl_ + krow[i_]) * kpitch + 8 * kcc[i_]); \
        vreg[S_][0] = *(const v4u*)(VTb + (size_t)vd * skv + 64 * tl_ + 8 * vcc); } while (0)
#define PL_STAGE(S_, buf_) do { LAS bf16* Kd_ = (LAS bf16*)lds + (buf_) * BUFE; LAS bf16* Vd_ = Kd_ + 64 * KP; \
        _Pragma("unroll") for (int i_ = 0; i_ < RK; ++i_) *(LAS v4u*)(Kd_ + krow[i_] * KP + 8 * kcc[i_]) = kreg[S_][i_]; \
        *(LAS v4u*)(Vd_ + vd * VP + 8 * vcc) = vreg[S_][0]; } while (0)
#define PL_QK(t_, D0_, D1_) do { const LAS bf16* Kc_ = (const LAS bf16*)lds + ((t_) & 3) * BUFE; \
        _Pragma("unroll") for (int i_ = 0; i_ < 16; ++i_) { D0_[i_] = 0.f; D1_[i_] = 0.f; } \
        _Pragma("unroll") for (int ks_ = 0; ks_ < NKS; ++ks_) { \
            const bf16x8 a0_ = *(const LAS bf16x8*)(Kc_ + r * KP + 16 * ks_ + 8 * hh); const bf16x8 a1_ = *(const LAS bf16x8*)(Kc_ + (32 + r) * KP + 16 * ks_ + 8 * hh); \
            D0_ = __builtin_amdgcn_mfma_f32_32x32x16_bf16(a0_, qf[ks_], D0_, 0, 0, 0); D1_ = __builtin_amdgcn_mfma_f32_32x32x16_bf16(a1_, qf[ks_], D1_, 0, 0, 0); } } while (0)
#define PL_PV(t_) do { const LAS bf16* Vc_ = (const LAS bf16*)lds + ((t_) & 3) * BUFE + 64 * KP; \
        _Pragma("unroll") for (int mt_ = 0; mt_ < NMT; ++mt_) _Pragma("unroll") for (int i_ = 0; i_ < 16; ++i_) o[mt_][i_] *= alpha; \
        _Pragma("unroll") for (int mt_ = 0; mt_ < NMT; ++mt_) _Pragma("unroll") for (int p_ = 0; p_ < 2; ++p_) _Pragma("unroll") for (int s_ = 0; s_ < 2; ++s_) { \
            const LAS bf16* vp_ = Vc_ + (32 * mt_ + r) * VP + 32 * p_ + 16 * s_ + 4 * hh; \
            const s16x4 lo_ = *(const LAS s16x4*)(vp_), hi_ = *(const LAS s16x4*)(vp_ + 8); \
            const bf16x8 a_ = (bf16x8){lo_[0], lo_[1], lo_[2], lo_[3], hi_[0], hi_[1], hi_[2], hi_[3]}; \
            o[mt_] = __builtin_amdgcn_mfma_f32_32x32x16_bf16(a_, __builtin_bit_cast(bf16x8, pf[p_][s_]), o[mt_], 0, 0, 0); } } while (0)
#define PL_SOFTMAX(t_, C0_, C1_, MK_, CAUSAL_) do { \
        if (MODE == 2) { const unsigned w0_ = (MK_).x >> (4 * hh), w1_ = (MK_).y >> (4 * hh); \
            _Pragma("unroll") for (int i_ = 0; i_ < 16; ++i_) { const int bit_ = (i_ & 3) + 8 * (i_ >> 2); if (!((w0_ >> bit_) & 1u)) C0_[i_] = NEGF; if (!((w1_ >> bit_) & 1u)) C1_[i_] = NEGF; } } \
        if (CAUSAL_) { const int qg_ = qlo + r; \
            _Pragma("unroll") for (int i_ = 0; i_ < 16; ++i_) { const int key_ = 64 * (t_) + crow(i_, hh); if (key_ > qg_) C0_[i_] = NEGF; if (key_ + 32 > qg_) C1_[i_] = NEGF; } } \
        float mx_ = C0_[0]; \
        _Pragma("unroll") for (int i_ = 1; i_ < 16; ++i_) mx_ = __builtin_fmaxf(mx_, C0_[i_]); \
        _Pragma("unroll") for (int i_ = 0; i_ < 16; ++i_) mx_ = __builtin_fmaxf(mx_, C1_[i_]); \
        mx_ = half_max(mx_); \
        const float mn_ = __builtin_fmaxf(m_run, mx_); alpha = __builtin_amdgcn_exp2f(m_run - mn_); m_run = mn_; \
        float ls_ = 0.f; \
        _Pragma("unroll") for (int i_ = 0; i_ < 16; ++i_) { C0_[i_] = __builtin_amdgcn_exp2f(C0_[i_] - mn_); C1_[i_] = __builtin_amdgcn_exp2f(C1_[i_] - mn_); ls_ += C0_[i_] + C1_[i_]; } \
        l_run = l_run * alpha + ls_; \
        _Pragma("unroll") for (int s_ = 0; s_ < 2; ++s_) { \
            pf[0][s_] = (v4u){pk2(C0_[8 * s_], C0_[8 * s_ + 1]), pk2(C0_[8 * s_ + 2], C0_[8 * s_ + 3]), pk2(C0_[8 * s_ + 4], C0_[8 * s_ + 5]), pk2(C0_[8 * s_ + 6], C0_[8 * s_ + 7])}; \
            pf[1][s_] = (v4u){pk2(C1_[8 * s_], C1_[8 * s_ + 1]), pk2(C1_[8 * s_ + 2], C1_[8 * s_ + 3]), pk2(C1_[8 * s_ + 4], C1_[8 * s_ + 5]), pk2(C1_[8 * s_ + 6], C1_[8 * s_ + 7])}; } } while (0)
#define PL_IO(t_, S_) do { PL_STAGE(S_, ((t_) + 2) & 3); PL_LOAD(S_, (t_) + 4); } while (0)
#define PL_STEADY(t_, S_) do { const v2u mk_ = mset[S_]; PL_IO(t_, S_); if (MODE == 2) { asm volatile("" :: "v"(mk_.x), "v"(mk_.y)); } \
        PL_QK((t_) + 1, n0, n1); PL_PV((t_) - 1); PL_SOFTMAX(t_, c0, c1, mk_, false); c0 = n0; c1 = n1; __syncthreads(); } while (0)
#define PL_TAIL(t_, S_) do { const v2u mk_ = mset[S_]; PL_IO(t_, S_); if ((t_) >= 1) PL_PV((t_) - 1); PL_SOFTMAX(t_, c0, c1, mk_, MODE == 1); PL_PV(t_); __syncthreads(); } while (0)
    f32x16 c0, c1, n0, n1; v4u pf[2][2];
    PL_LOAD(0, 0); PL_LOAD(1, 1);
    PL_STAGE(0, 0); PL_STAGE(1, 1);
    PL_LOAD(0, 2); PL_LOAD(1, 3);
    __syncthreads();
    PL_QK(0, c0, c1);
    int t = 0;
    if (NTw >= 2) {
        { const v2u mk_ = mset[0]; PL_IO(0, 0); PL_QK(1, n0, n1); PL_SOFTMAX(0, c0, c1, mk_, false); c0 = n0; c1 = n1; __syncthreads(); }
        for (t = 1; t + 1 < NTw; ) {
            PL_STEADY(t, 1); ++t;
            if (t + 1 < NTw) { PL_STEADY(t, 0); ++t; }
        }
    }
    if (t & 1) PL_TAIL(t, 1); else PL_TAIL(t, 0);
    for (++t; t < NT; ++t) { if (t & 1) PL_IO(t, 1); else PL_IO(t, 0); __syncthreads(); }
#undef PL_LOAD
#undef PL_STAGE
#undef PL_QK
#undef PL_PV
#undef PL_SOFTMAX
#undef PL_IO
#undef PL_STEADY
#undef PL_TAIL
    const float l_tot = half_sum(l_run);
    const float inv = 1.0f / l_tot;
    const size_t row = (size_t)(qlo + r);
#pragma unroll
    for (int mt = 0; mt < NMT; ++mt)
#pragma unroll
        for (int g4 = 0; g4 < 4; ++g4) {
            const int d = 32 * mt + 8 * g4 + 4 * hh;
            v2u ow; ow.x = pk2(o[mt][4 * g4] * inv, o[mt][4 * g4 + 1] * inv); ow.y = pk2(o[mt][4 * g4 + 2] * inv, o[mt][4 * g4 + 3] * inv);
            *(v2u*)(Ob + row * PP + d) = ow;
        }
}

__device__ __forceinline__ void attn_unit_mem(LAS unsigned char* lds, const bf16* Qb, const float* gqm, const bf16* Kb, const bf16* VTb, const bf16* Zb, bf16* Ob, int q0) {
    constexpr int DQK = 128, KP = DQK + 8, VP = MEML + 8, NKS = DQK / 16, NMT = 4;
    LAS bf16* Ks = (LAS bf16*)lds; LAS bf16* Vs = Ks + MEML * KP;
    int tid_ = threadIdx.x; asm volatile("" : "+v"(tid_));
    const int tid = tid_, lane = tid & 63, w = __builtin_amdgcn_readfirstlane(tid >> 6), r = lane & 31, hh = lane >> 5;
    { v4u kk[8], vv[8];
#pragma unroll
      for (int i = 0; i < 8; ++i) { const int c = tid + 512 * i; kk[i] = *(const v4u*)(Kb + (size_t)(c >> 4) * 1024 + 8 * (c & 15)); vv[i] = *(const v4u*)(VTb + (size_t)(c >> 5) * MEML + 8 * (c & 31)); }
#pragma unroll
      for (int i = 0; i < 8; ++i) { const int c = tid + 512 * i; *(LAS v4u*)(Ks + (c >> 4) * KP + 8 * (c & 15)) = kk[i]; *(LAS v4u*)(Vs + (c >> 5) * VP + 8 * (c & 31)) = vv[i]; } }
    __syncthreads();
#pragma unroll 1
    for (int qb = 0; qb < 2; ++qb) {
        const int qlo = q0 + 256 * qb + 32 * w;
        bf16x8 qf[NKS];
        { const bf16* qrow = Qb + (size_t)(qlo + r) * PP + 8 * hh;
#pragma unroll
          for (int ks = 0; ks < NKS; ++ks) qf[ks] = *(const bf16x8*)(qrow + 16 * ks);
          float ss = 0.f;
#pragma unroll
          for (int ks = 0; ks < NKS; ++ks) { const v4u w = __builtin_bit_cast(v4u, qf[ks]); float v[8]; UNPACK8(w, v);
#pragma unroll
              for (int j = 0; j < 8; ++j) ss += v[j] * v[j]; }
          const float rs = __builtin_amdgcn_rsqf(half_sum(ss) * (1.f / 128.f) + EPS) * SCALE_M;
#pragma unroll
          for (int ks = 0; ks < NKS; ++ks) { const v4u w = __builtin_bit_cast(v4u, qf[ks]); float v[8]; UNPACK8(w, v);
              const f32x4 g0 = *(const f32x4*)(gqm + 16 * ks + 8 * hh), g1 = *(const f32x4*)(gqm + 16 * ks + 8 * hh + 4);
              v[0] *= rs * g0[0]; v[1] *= rs * g0[1]; v[2] *= rs * g0[2]; v[3] *= rs * g0[3]; v[4] *= rs * g1[0]; v[5] *= rs * g1[1]; v[6] *= rs * g1[2]; v[7] *= rs * g1[3];
              const v4u p = PACK8(v); qf[ks] = __builtin_bit_cast(bf16x8, p); } }
        f32x16 o[NMT];
#pragma unroll
        for (int mt = 0; mt < NMT; ++mt)
#pragma unroll
            for (int i = 0; i < 16; ++i) o[mt][i] = 0.f;
        float m_run = NEGF, l_run = 0.f;
#pragma unroll 1
        for (int sub = 0; sub < MEML / 64; ++sub) {
            const LAS bf16* Kc = Ks + 64 * sub * KP; const LAS bf16* Vc = Vs + 64 * sub;
            f32x16 s0, s1;
#pragma unroll
            for (int i = 0; i < 16; ++i) { s0[i] = 0.f; s1[i] = 0.f; }
#pragma unroll
            for (int ks = 0; ks < NKS; ++ks) {
                const bf16x8 a0 = *(const LAS bf16x8*)(Kc + r * KP + 16 * ks + 8 * hh);
                const bf16x8 a1 = *(const LAS bf16x8*)(Kc + (32 + r) * KP + 16 * ks + 8 * hh);
                s0 = __builtin_amdgcn_mfma_f32_32x32x16_bf16(a0, qf[ks], s0, 0, 0, 0);
                s1 = __builtin_amdgcn_mfma_f32_32x32x16_bf16(a1, qf[ks], s1, 0, 0, 0);
            }
            float mx = s0[0];
#pragma unroll
            for (int i = 1; i < 16; ++i) mx = __builtin_fmaxf(mx, s0[i]);
#pragma unroll
            for (int i = 0; i < 16; ++i) mx = __builtin_fmaxf(mx, s1[i]);
            mx = half_max(mx);
            const float m_new = __builtin_fmaxf(m_run, mx);
            const float alpha = __builtin_amdgcn_exp2f(m_run - m_new);
            m_run = m_new;
            float ls = 0.f;
#pragma unroll
            for (int i = 0; i < 16; ++i) { s0[i] = __builtin_amdgcn_exp2f(s0[i] - m_new); s1[i] = __builtin_amdgcn_exp2f(s1[i] - m_new); ls += s0[i] + s1[i]; }
            l_run = l_run * alpha + ls;
#pragma unroll
            for (int mt = 0; mt < NMT; ++mt)
#pragma unroll
                for (int i = 0; i < 16; ++i) o[mt][i] *= alpha;
            v4u pf[2][2];
#pragma unroll
            for (int s = 0; s < 2; ++s) {
                pf[0][s] = (v4u){pk2(s0[8 * s], s0[8 * s + 1]), pk2(s0[8 * s + 2], s0[8 * s + 3]), pk2(s0[8 * s + 4], s0[8 * s + 5]), pk2(s0[8 * s + 6], s0[8 * s + 7])};
                pf[1][s] = (v4u){pk2(s1[8 * s], s1[8 * s + 1]), pk2(s1[8 * s + 2], s1[8 * s + 3]), pk2(s1[8 * s + 4], s1[8 * s + 5]), pk2(s1[8 * s + 6], s1[8 * s + 7])};
            }
#pragma unroll
            for (int mt = 0; mt < NMT; ++mt)
#pragma unroll
                for (int p = 0; p < 2; ++p)
#pragma unroll
                    for (int s = 0; s < 2; ++s) {
                        const LAS bf16* vp = Vc + (32 * mt + r) * VP + 32 * p + 16 * s + 4 * hh;
                        const s16x4 lo = *(const LAS s16x4*)(vp), hi = *(const LAS s16x4*)(vp + 8);
                        const bf16x8 a = (bf16x8){lo[0], lo[1], lo[2], lo[3], hi[0], hi[1], hi[2], hi[3]};
                        o[mt] = __builtin_amdgcn_mfma_f32_32x32x16_bf16(a, __builtin_bit_cast(bf16x8, pf[p][s]), o[mt], 0, 0, 0);
                    }
        }
        const float inv = 1.0f / half_sum(l_run);
        const size_t row = (size_t)(qlo + r);
#pragma unroll
        for (int mt = 0; mt < NMT; ++mt)
#pragma unroll
            for (int g4 = 0; g4 < 4; ++g4) {
                const int d = 32 * mt + 8 * g4 + 4 * hh;
                const v2u zw = *(const v2u*)(Zb + row * PP + d); const float z[4] = {bflo(zw.x), bfhi(zw.x), bflo(zw.y), bfhi(zw.y)};
                float ov[4];
#pragma unroll
                for (int i = 0; i < 4; ++i) ov[i] = o[mt][4 * g4 + i] * inv * (z[i] * __builtin_amdgcn_rcpf(1.0f + __expf(-z[i])));
                v2u ow; ow.x = pk2(ov[0], ov[1]); ow.y = pk2(ov[2], ov[3]);
                *(v2u*)(Ob + row * PP + d) = ow;
            }
    }
}

__device__ __forceinline__ bf16* gate_row(bf16* G0, bf16* G1, size_t row) { return row < 8192 ? G0 + row * 3072 : G1 + (row - 8192) * 3072; }
struct EpiZG {
    static constexpr bool PERM = true, AFTER_DRAIN = false;
    bf16* P; bf16* G0; bf16* G1;
    __device__ __forceinline__ void operator()(const pg8::f32x4 (&acc)[2][2][4][2], const pg8::Unit& u, int wr, int wc, int fr, int fq) const {
        const int row0 = u.pm * 256 + wr * 64 + fr, cl = wc * 32 + 8 * fq;
        const bool isz = u.pn < 4;
        const int ycol = (u.pn < 2 ? C_YA : C_YB) + (u.pn & 1) * 256, gcol = (u.pn - 4) * 256;
#pragma unroll
        for (int ai = 0; ai < 2; ++ai)
#pragma unroll
            for (int m = 0; m < 4; ++m) { const size_t row = (size_t)(row0 + ai * 128 + m * 16);
#pragma unroll
                for (int bj = 0; bj < 2; ++bj) {
                    const pg8::f32x4 v0 = acc[ai][bj][m][0], v1 = acc[ai][bj][m][1];
                    float rr[8] = {v0[0], v0[1], v0[2], v0[3], v1[0], v1[1], v1[2], v1[3]};
                    if (isz) { bf16* dst = P + row * PP + ycol + cl + bj * 128; const v4u old = *(const v4u*)dst; float yv[8]; UNPACK8(old, yv);
#pragma unroll
                        for (int e = 0; e < 8; ++e) rr[e] = yv[e] * (rr[e] * __builtin_amdgcn_rcpf(1.0f + __expf(-rr[e])));
                        *(v4u*)dst = PACK8(rr); }
                    else { bf16* dst = gate_row(G0, G1, row) + gcol + cl + bj * 128;
#pragma unroll
                        for (int e = 0; e < 8; ++e) rr[e] = __builtin_amdgcn_rcpf(1.0f + __expf(-rr[e]));
                        *(v4u*)dst = PACK8(rr); } } }
    }
};
struct EpiStoreVT {
    static constexpr bool PERM = true, AFTER_DRAIN = false;
    bf16* O; int ldc; bf16* VT;
    int vbeg, vend, hshift, voff, DV, sshift;
    __device__ __forceinline__ void operator()(const pg8::f32x4 (&acc)[2][2][4][2], const pg8::Unit& u, int wr, int wc, int fr, int fq) const {
        const int row0 = u.pm * 256 + wr * 64 + fr, col0 = u.pn * 256 + wc * 32 + 8 * fq;
        const int H = (vend - vbeg) >> hshift, S = 1 << sshift;
        bool isv[2]; long voffs[2];
#pragma unroll
        for (int bj = 0; bj < 2; ++bj) { const int col = col0 + bj * 128, cr = col - vbeg, within = cr & ((1 << hshift) - 1);
            isv[bj] = col >= vbeg && col < vend && within >= voff;
            voffs[bj] = ((long)((cr >> hshift) * DV + within - voff)) << sshift; }
#pragma unroll
        for (int ai = 0; ai < 2; ++ai)
#pragma unroll
            for (int m = 0; m < 4; ++m) { const int row = row0 + ai * 128 + m * 16;
                const int b = row >> sshift, sp = row & (S - 1);
#pragma unroll
                for (int bj = 0; bj < 2; ++bj) {
                    const pg8::f32x4 v0 = acc[ai][bj][m][0], v1 = acc[ai][bj][m][1];
                    const unsigned w0 = pk2(v0[0], v0[1]), w1 = pk2(v0[2], v0[3]), w2 = pk2(v1[0], v1[1]), w3 = pk2(v1[2], v1[3]);
                    if (!isv[bj]) *(v4u*)(O + (size_t)row * ldc + col0 + bj * 128) = (v4u){w0, w1, w2, w3};
                    else { bf16* dst = VT + (((long)(b * H * DV)) << sshift) + voffs[bj] + sp;
                        dst[0] = (bf16)(w0 & 0xffffu); dst[(size_t)S] = (bf16)(w0 >> 16); dst[(size_t)2 * S] = (bf16)(w1 & 0xffffu); dst[(size_t)3 * S] = (bf16)(w1 >> 16);
                        dst[(size_t)4 * S] = (bf16)(w2 & 0xffffu); dst[(size_t)5 * S] = (bf16)(w2 >> 16); dst[(size_t)6 * S] = (bf16)(w3 & 0xffffu); dst[(size_t)7 * S] = (bf16)(w3 >> 16); } }
                asm volatile("" ::: "memory"); }
    }
};
struct MergeOrder {
    pg8::StaticOrder so;
    __device__ __forceinline__ bool next(int i, pg8::Unit& u) const { pg8::Unit b; if (!so.next(i / 3, b)) return false; u.pm = b.pm; u.pn = (i % 3) * 4 + b.pn; return true; }
    __device__ __forceinline__ void a_ready(const pg8::Unit&) const {}
    __device__ __forceinline__ void done(const pg8::Unit&) const {}
};
struct EpiMerge {
    static constexpr bool PERM = true, AFTER_DRAIN = false;
    bf16* Mg; bf16* G0; bf16* G1;
    __device__ __forceinline__ void operator()(const pg8::f32x4 (&acc)[2][2][4][2], const pg8::Unit& u, int wr, int wc, int fr, int fq) const {
        const int nbr = u.pn >> 2;
        const int row0 = u.pm * 256 + wr * 64 + fr, col0 = (u.pn & 3) * 256 + wc * 32 + 8 * fq;
#pragma unroll
        for (int ai = 0; ai < 2; ++ai)
#pragma unroll
            for (int m = 0; m < 4; ++m) { const size_t row = (size_t)(row0 + ai * 128 + m * 16);
#pragma unroll
                for (int bj = 0; bj < 2; ++bj) { const int col = col0 + bj * 128;
                    const v4u gwd = *(const v4u*)(gate_row(G0, G1, row) + nbr * 1024 + col);
                    float gl[8]; UNPACK8(gwd, gl);
                    const pg8::f32x4 v0 = acc[ai][bj][m][0], v1 = acc[ai][bj][m][1];
                    float rr[8] = {v0[0], v0[1], v0[2], v0[3], v1[0], v1[1], v1[2], v1[3]};
#pragma unroll
                    for (int e = 0; e < 8; ++e) rr[e] *= gl[e];
                    bf16* dst = Mg + row * 1024 + col;
                    if (nbr > 0) { const v4u old = *(const v4u*)dst; float ol[8]; UNPACK8(old, ol);
#pragma unroll
                        for (int e = 0; e < 8; ++e) rr[e] += ol[e]; }
                    *(v4u*)dst = PACK8(rr); } }
    }
};
struct EpiOut {
    static constexpr bool PERM = true, AFTER_DRAIN = false;
    const float* X; float* Out;
    __device__ __forceinline__ void operator()(const pg8::f32x4 (&acc)[2][2][4][2], const pg8::Unit& u, int wr, int wc, int fr, int fq) const {
        const int row0 = u.pm * 256 + wr * 64 + fr, col0 = u.pn * 256 + wc * 32 + 8 * fq;
#pragma unroll
        for (int ai = 0; ai < 2; ++ai)
#pragma unroll
            for (int m = 0; m < 4; ++m) { const size_t row = (size_t)(row0 + ai * 128 + m * 16);
#pragma unroll
                for (int bj = 0; bj < 2; ++bj) { const size_t p = row * 1024 + col0 + bj * 128;
                    const f32x4 x0 = __builtin_nontemporal_load((const f32x4*)(X + p)), x1 = __builtin_nontemporal_load((const f32x4*)(X + p + 4));
                    const pg8::f32x4 a0 = acc[ai][bj][m][0], a1 = acc[ai][bj][m][1];
                    __builtin_nontemporal_store((f32x4){x0[0] + a0[0], x0[1] + a0[1], x0[2] + a0[2], x0[3] + a0[3]}, (f32x4*)(Out + p));
                    __builtin_nontemporal_store((f32x4){x1[0] + a1[0], x1[1] + a1[1], x1[2] + a1[2], x1[3] + a1[3]}, (f32x4*)(Out + p + 4)); } }
    }
};

#define XB_TMO      128
#define XB_XCNT(j)  (256  + 64 * (j))
#define XB_XSUB(j)  (1280 + 64 * (j))
#define XB_XGEN(j)  (2304 + 64 * (j))
#define XB_TOP      3328
#define XB_TOPGEN   3392
#define XCD_BAR_WORDS 3456
#define XB_SPIN_CAP (1u << 18)

__device__ __forceinline__ unsigned xb_ld(unsigned* p)              { return __hip_atomic_load(p, __ATOMIC_RELAXED, __HIP_MEMORY_SCOPE_AGENT); }
__device__ __forceinline__ unsigned xb_add(unsigned* p, unsigned v) { return __hip_atomic_fetch_add(p, v, __ATOMIC_RELAXED, __HIP_MEMORY_SCOPE_AGENT); }
__device__ __forceinline__ unsigned xb_xcc_id() { return (unsigned)__builtin_amdgcn_s_getreg((3 << 11) | 20) & 0xFu; }
#define XB_SPIN(cond, bar) do { unsigned _sp = 0; while (cond) { __builtin_amdgcn_s_sleep(1); \
    if ((++_sp & 255u) == 0u) { if (xb_ld(&(bar)[XB_TMO])) break; if (_sp > XB_SPIN_CAP) { atomicAdd(&(bar)[XB_TMO], 1u); break; } } } } while (0)

struct XcdBarrier {
    unsigned* bar; unsigned x;
    volatile LAS unsigned* st;
};

__device__ __forceinline__ XcdBarrier xcd_barrier_post(unsigned* bar, volatile LAS unsigned* st) {
    XcdBarrier b; b.bar = bar; b.x = xb_xcc_id(); b.st = st;
    if (threadIdx.x == 0) (void)xb_add(&bar[XB_XCNT(b.x)], 1u);
    return b;
}
__device__ __forceinline__ void xcd_barrier_complete(unsigned* bar, unsigned x, unsigned& nloc, unsigned& nx) {
    const unsigned G = gridDim.x * gridDim.y * gridDim.z;
    unsigned sum, cnt, mine, sp = 0u;
    for (;;) {
        sum = 0u; cnt = 0u; mine = 0u;
#pragma unroll
        for (unsigned j = 0; j < 16; ++j) { const unsigned c = xb_ld(&bar[XB_XCNT(j)]); sum += c; cnt += (c > 0u) ? 1u : 0u; mine = (j == x) ? c : mine; }
        if (sum == G) break;
        __builtin_amdgcn_s_sleep(1);
        if ((++sp & 255u) == 0u) { if (xb_ld(&bar[XB_TMO])) break; if (sp > XB_SPIN_CAP) { atomicAdd(&bar[XB_TMO], 1u); break; } }
    }
    nloc = mine > 0u ? mine : 1u; nx = cnt > 0u ? cnt : 1u;
}

__device__ __forceinline__ void xcd_barrier(const XcdBarrier& b) {
    asm volatile("s_waitcnt vmcnt(0)" ::: "memory");
    __syncthreads();
    if (threadIdx.x == 0) {
        unsigned* bar = b.bar;
        __builtin_amdgcn_s_waitcnt(0);
        unsigned nloc = b.st[0], nx = b.st[1];
        if (nloc == 0u) { xcd_barrier_complete(bar, b.x, nloc, nx); b.st[0] = nloc; b.st[1] = nx; }
        const unsigned old = xb_add(&bar[XB_XSUB(b.x)], 1u);
        const unsigned gen = old / nloc;
        if (old + 1u == (gen + 1u) * nloc) {
            __builtin_amdgcn_fence(__ATOMIC_RELEASE, "agent");
            asm volatile("s_waitcnt vmcnt(0)" ::: "memory");
            const unsigned og = xb_add(&bar[XB_TOP], 1u);
            const unsigned tg = og / nx;
            if (og + 1u == (tg + 1u) * nx) xb_add(&bar[XB_TOPGEN], 1u);
            else XB_SPIN(xb_ld(&bar[XB_TOPGEN]) == tg, bar);
            __builtin_amdgcn_fence(__ATOMIC_ACQUIRE, "agent");
            xb_add(&bar[XB_XGEN(b.x)], 1u);
            asm volatile("s_waitcnt vmcnt(0)" ::: "memory");
        } else {
            XB_SPIN(xb_ld(&bar[XB_XGEN(b.x)]) == gen, bar);
            __builtin_amdgcn_fence(__ATOMIC_ACQUIRE, "agent");
            asm volatile("s_waitcnt vmcnt(0)" ::: "memory");
        }
    }
    __syncthreads();
}

template <int DQK, int DV, int MODE>
__device__ __forceinline__ void att_call(bool strip, LAS unsigned char* lds, const bf16* Qb, int qpitch, const bf16* Kb, int kpitch, const bf16* VTb, int skv, const unsigned* maskb, const bf16* Zb, bf16* Ob, int q0) {
    if (ATT_STRIP != 0 && strip) attn_unit<DQK, DV, MODE, ATT_STRIP>(lds, Qb, qpitch, Kb, kpitch, VTb, skv, maskb, Zb, Ob, q0);
    else attn_unit<DQK, DV, MODE, 0>(lds, Qb, qpitch, Kb, kpitch, VTb, skv, maskb, Zb, Ob, q0);
}
struct Args { const float* in[19]; const int* pos; float* out; unsigned char* ws; };
typedef const __attribute__((address_space(4))) Args* kargs_t;
#define PHASE_BEGIN \
    kargs_t ap_ = (kargs_t)__builtin_amdgcn_kernarg_segment_ptr(); asm volatile("" : "+s"(ap_)); \
    int tid = threadIdx.x; asm volatile("" : "+v"(tid)); \
    const int lane = tid & 63, wave = __builtin_amdgcn_readfirstlane(tid >> 6), G = gridDim.x, NGW = G * 8, gw = blockIdx.x * 8 + wave; \
    unsigned char* const ws = ap_->ws; unsigned char* const dob = (unsigned char*)ap_->out; const int* const pos = ap_->pos; float* const outp = ap_->out; unsigned* const ctl = (unsigned*)(ws + WS_CTL); \
    const float* const x = ap_->in[0]; const float* const mem = ap_->in[1]; \
    const float* const g_norm = ap_->in[3]; const float* const w_in = ap_->in[4]; const float* const g_qn_a = ap_->in[5]; const float* const g_kn_a = ap_->in[6]; \
    const float* const g_cq = ap_->in[7]; const float* const g_ckv = ap_->in[8]; const float* const w_uq = ap_->in[9]; const float* const w_ukv = ap_->in[10]; \
    const float* const g_qn_b = ap_->in[11]; const float* const g_kn_b = ap_->in[12]; const float* const g_mem = ap_->in[13]; const float* const w_mem_kv = ap_->in[14]; \
    const float* const g_qn_m = ap_->in[15]; const float* const g_kn_m = ap_->in[16]; const float* const w_branch = ap_->in[17]; const float* const w_out = ap_->in[18]; \
    bf16* const WinT = (bf16*)(ws + WS_WIN); bf16* const WuqT = (bf16*)(ws + WS_WUQ); bf16* const WukvT = (bf16*)(ws + WS_WUKV); bf16* const WmemT = (bf16*)(ws + WS_WMEM); \
    bf16* const WbrT = (bf16*)(ws + WS_WBR); bf16* const WoutT = (bf16*)(ws + WS_WOUT); \
    float* const ropeA = (float*)(ws + WS_ROPEA); float* const ropeB = (float*)(ws + WS_ROPEB); \
    bf16* const MN = (bf16*)(ws + WS_MN); bf16* const KVM = (bf16*)(ws + WS_KVM); bf16* const VTM = (bf16*)(ws + WS_VTM); \
    float* const WI = (float*)(ws + WS_WI); unsigned* const MASK = (unsigned*)(ws + WS_MASK); \
    bf16* const VTA = (bf16*)(dob + DO_VTA); bf16* const VTB = (bf16*)(dob + DO_VTB); bf16* const KB = (bf16*)(dob + DO_KB); \
    bf16* const Hh = (bf16*)(ws + WS_H); bf16* const MG = (bf16*)(ws + WS_H); bf16* const QB = (bf16*)(ws + WS_QB); \
    bf16* const KVB = (bf16*)(ws + WS_KVB); bf16* const GT0 = (bf16*)(dob + DO_G0); bf16* const GT1 = (bf16*)(ws + WS_G1); bf16* const P = (bf16*)(ws + WS_P); \
    (void)lane; (void)NGW; (void)gw; (void)ctl; \
    (void)pos; (void)outp; (void)x; (void)mem; (void)g_norm; (void)w_in; (void)g_qn_a; (void)g_kn_a; (void)g_cq; (void)g_ckv; (void)w_uq; (void)w_ukv; (void)g_qn_b; (void)g_kn_b; (void)g_mem; (void)w_mem_kv; \
    (void)g_qn_m; (void)g_kn_m; (void)w_branch; (void)w_out; (void)WinT; (void)WuqT; (void)WukvT; (void)WmemT; (void)WbrT; (void)WoutT; (void)ropeA; (void)ropeB; (void)MN; (void)KVM; (void)VTM; (void)WI; (void)MASK; \
    (void)VTA; (void)VTB; (void)Hh; (void)KB; (void)QB; (void)KVB; (void)MG; (void)GT0; (void)GT1; (void)P
#define GRID_BARRIER() do { kargs_t bp_ = (kargs_t)__builtin_amdgcn_kernarg_segment_ptr(); asm volatile("" : "+s"(bp_)); \
    XcdBarrier b_; b_.bar = (unsigned*)(bp_->ws + WS_CTL) + 4096; b_.x = xb_xcc_id(); b_.st = (volatile LAS unsigned*)(lds + LDS_BYTES - 32); xcd_barrier(b_); } while (0)

__global__ void __launch_bounds__(512, 2) fwd_kernel(Args a) {
    extern __shared__ __attribute__((aligned(16))) unsigned char lds_raw[];
    LAS unsigned char* const lds = (LAS unsigned char*)lds_raw;
    volatile LAS int* const slot = (volatile LAS int*)(lds + LDS_SLOT);
    if (threadIdx.x < 16) ((LAS unsigned*)(lds + LDS_BYTES - 64))[threadIdx.x] = 0u;
    __syncthreads();
    (void)xcd_barrier_post((unsigned*)(a.ws + WS_CTL) + 4096, (volatile LAS unsigned*)(lds + LDS_BYTES - 32));

    for (int rep = 0; rep < REP_P0; ++rep) { PHASE_BEGIN;
        LAS float* scr = (LAS float*)(lds + wave * 16384);
        constexpr int I_IN = 16 * (NP / 32), I_UQ = 6 * 24, I_UKV = 4 * 32, I_MEM = 16 * 32, I_BR = 8 * 32, I_OUT = 16 * 32;
        constexpr int NITEMS = I_IN + I_UQ + I_UKV + I_MEM + 3 * I_BR + I_OUT;
        for (int it = gw; it < NITEMS; it += NGW) {
            int r = it;
            if (r < I_IN) { transpose_item<true>(w_in, 1024, DIN, NP, WinT, scr, r, lane); continue; } r -= I_IN;
            if (r < I_UQ) { transpose_item<false>(w_uq, 384, 768, 768, WuqT, scr, r, lane); continue; } r -= I_UQ;
            if (r < I_UKV) { transpose_item<false>(w_ukv, 256, 1024, 1024, WukvT, scr, r, lane); continue; } r -= I_UKV;
            if (r < I_MEM) { transpose_item<false>(w_mem_kv, 1024, 1024, 1024, WmemT, scr, r, lane); continue; } r -= I_MEM;
            if (r < 3 * I_BR) { const int nb = r / I_BR; transpose_item<false>(w_branch + (size_t)nb * 512 * 1024, 512, 1024, 1024, WbrT + (size_t)nb * 1024 * 512, scr, r % I_BR, lane); continue; } r -= 3 * I_BR;
            transpose_item<false>(w_out, 1024, 1024, 1024, WoutT, scr, r, lane);
        }
        for (int idx = blockIdx.x * 512 + tid; idx < TT * 24; idx += G * 512) {
            const int t = idx / 24, i = idx % 24; const float pf = (float)pos[t];
            if (i < 8) { const float ang = pf * INVA[i]; ropeA[t * 16 + i] = cosf(ang); ropeA[t * 16 + 8 + i] = sinf(ang); }
            else { const int j = i - 8; const float ang = pf * INVB[j]; ropeB[t * 32 + j] = cosf(ang); ropeB[t * 32 + 16 + j] = sinf(ang); }
        }
        for (int m = gw; m < NB * MEML; m += NGW) rms_row_1024(mem + (size_t)m * DM, g_mem, MN + (size_t)m * DM, lane);
        for (int rp = 0; rp < REP_PH; ++rp)
        for (int m = gw; m < TT; m += NGW) rms_row_1024(x + (size_t)m * DM, g_norm, Hh + (size_t)m * DM, lane);
    }
    GRID_BARRIER();
    for (int es = 0; es < EXTRA_SYNCS; ++es) GRID_BARRIER();

    for (int rep = 0; rep < REP_G1; ++rep) { PHASE_BEGIN;
        pg8::Gemm g{Hh, WinT, TT, PP, 1024, 1024, nullptr, nullptr, nullptr, 0}; pg8::StaticOrder S; S.init(TT, PP, G, (int)blockIdx.x);
        EpiStoreVT E{P, PP, VTA, C_VA, C_VA + 512, 6, 0, 64, 11};
        pg8::gemm_phase<EpiStoreVT, pg8::StaticOrder, true, true>(lds, g, S, E);
    }
    { PHASE_BEGIN;
        pg8::Gemm g{MN, WmemT, NB * MEML, 1024, 1024, 1024, nullptr, nullptr, nullptr, 0}; pg8::StaticOrder S; S.init(NB * MEML, 1024, G, (int)((blockIdx.x + 64) % G));
        EpiStoreVT E{KVM, 1024, VTM, 512, 1024, 7, 0, 128, 8};
        pg8::gemm_phase<EpiStoreVT, pg8::StaticOrder, true, true>(lds, g, S, E);
    }
    GRID_BARRIER();
    { PHASE_BEGIN;
        float ga[8], gk[8], gq[8], gc[8], gm[8];
#pragma unroll
        for (int j = 0; j < 8; ++j) { ga[j] = g_qn_a[8 * (lane & 7) + j]; gk[j] = g_kn_a[8 * (lane & 7) + j]; gm[j] = g_qn_m[8 * (lane & 15) + j]; gq[j] = lane < 48 ? g_cq[8 * lane + j] : 0.f; gc[j] = lane < 32 ? g_ckv[8 * lane + j] : 0.f; }
        for (int dp = 0; dp < DUMMY_POST1; ++dp)
            for (int m = gw; m < TT; m += NGW)
                post1_row(P + (size_t)m * PP, QB + (size_t)(m & 1023) * 4096, ropeA + (size_t)m * 16, ga, gk, gq, gc, gm, (float*)KVB + (size_t)m * 8, lane);
        for (int m = gw; m < TT; m += NGW)
            post1_row(P + (size_t)m * PP, P + (size_t)m * PP, ropeA + (size_t)m * 16, ga, gk, gq, gc, gm, WI + (size_t)m * 8, lane);
        for (int m = gw; m < NB * MEML; m += NGW) km_row(KVM + (size_t)m * 1024, g_kn_m, lane);
    }
    GRID_BARRIER();
    for (int rep = 0; rep < REP_G2; ++rep) { PHASE_BEGIN;
        pg8::Gemm g{P + C_CQ, WuqT, TT, 768, 384, PP, nullptr, nullptr, nullptr, 0}; pg8::StaticOrder S; S.init(TT, 768, G, (int)blockIdx.x);
        pg8::EpiBf16<0> E{QB, 768, nullptr, 0, 0, 1.f};
        pg8::gemm_phase<pg8::EpiBf16<0>, pg8::StaticOrder, true, true>(lds, g, S, E);
    }
    for (int rep = 0; rep < REP_G2; ++rep) { PHASE_BEGIN;
        pg8::Gemm g{P + C_CKV, WukvT, TT, 1024, 256, PP, nullptr, nullptr, nullptr, 0}; pg8::StaticOrder S; S.init(TT, 1024, G, (int)((blockIdx.x + 192) % G));
        pg8::EpiBf16<0> E{KVB, 1024, nullptr, 0, 0, 1.f};
        pg8::gemm_phase<pg8::EpiBf16<0>, pg8::StaticOrder, true, true>(lds, g, S, E);
    }
    for (int rep = 0; rep < REP_IDX; ++rep) { if (rep > 0) GRID_BARRIER();
        PHASE_BEGIN;
        unsigned* const q_idx = ctl + 64 * (0 + 4 * rep);
        int u = next_unit(q_idx, slot);
        bf16x8 qf[8][2]; float wq[8];
        if (u < NB * 128) indexer_load_q(P, WI, u, qf, wq);
        while (u < NB * 128) {
            int tk = 0; if (tid == 0) tk = (int)atomicAdd(q_idx, 1u);
            const int tb = 127 - (u >> 3), bb = u & 7;
            int un;
            indexer_unit((LAS float*)lds, P, WI, MASK, bb, tb, qf, wq, tk, slot, NB * 128, un);
            u = un;
        }
    }
    GRID_BARRIER();
    { PHASE_BEGIN;
        LAS float* scr = (LAS float*)(lds + wave * 8192);
        float gqv[12], gkv[12];
#pragma unroll
        for (int e = 0; e < 12; ++e) { gqv[e] = g_qn_b[12 * (lane & 7) + e]; gkv[e] = g_kn_b[12 * (lane & 7) + e]; }
        for (int dp = 0; dp < DUMMY_POST2; ++dp)
            for (int m = gw; m < TT; m += NGW)
                post2_row(QB + (size_t)m * 768, (bf16*)MASK + (size_t)(m & 1023) * 768, KVB + (size_t)m * 1024, P + (size_t)m * PP, (bf16*)MASK + (size_t)(1024 + (m & 1023)) * 768, ropeB + (size_t)m * 32, gqv, gkv, scr, lane);
        for (int m = gw; m < TT; m += NGW)
            post2_row(QB + (size_t)m * 768, QB + (size_t)m * 768, KVB + (size_t)m * 1024, P + (size_t)m * PP, KB + (size_t)m * 768, ropeB + (size_t)m * 32, gqv, gkv, scr, lane);
        transpose_v(KVB, 1024, 64, 128, 8, 64, SEQ, NB, VTB, gw, NGW, lane);
    }
    GRID_BARRIER();
    for (int rep = 0; rep < REP_ATT; ++rep) { if (rep > 0) GRID_BARRIER();
        PHASE_BEGIN;
        unsigned* const q_att = ctl + 64 * (1 + 4 * rep);
        for (;;) {
            const int u = next_unit(q_att, slot);
            if (u >= 1152) break;
            if (u < 704 || u >= 832) {
                const int uu = u < 704 ? u : u - 128, cls = uu >> 6, bh = uu & 63, bb = bh >> 3, h = bh & 7;
                const bool isA = (0x52a7u >> cls) & 1u; const int qb = (int)((0x11232435467567ull >> (4 * cls)) & 15ull);
                const size_t r0 = (size_t)bb * SEQ;
                if (!isA) attn_unit_pipe<96, 1>(lds, QB + r0 * 768 + h * 96, 768, KB + r0 * 768 + h * 96, 768, VTB + (size_t)((bb * 8 + h) * 64) * SEQ, SEQ, nullptr,
                                                   P + r0 * PP + C_YB + h * 64, qb * 256);
                else attn_unit_pipe<64, 2>(lds, P + r0 * PP + C_QA + h * 64, PP, P + r0 * PP + C_KA + h * 64, PP, VTA + (size_t)((bb * 8 + h) * 64) * SEQ, SEQ, MASK + r0 * 64,
                                           P + r0 * PP + C_YA + h * 64, qb * 256);
            } else {
                const int v = u - 704, hq = v & 3, bh = v >> 2, bb = bh >> 2, h = bh & 3;
                const size_t r0 = (size_t)bb * SEQ;
                attn_unit_mem(lds, P + r0 * PP + C_QM + h * 128, g_qn_m, KVM + (size_t)bb * MEML * 1024 + h * 128, VTM + (size_t)((bb * 4 + h) * 128) * MEML,
                              P + r0 * PP + C_ZM + h * 128, P + r0 * PP + C_YM + h * 128, hq * 512);
            }
        }
    }
    GRID_BARRIER();
    for (int rep = 0; rep < 1; ++rep) { PHASE_BEGIN;
        pg8::Gemm g{Hh, WinT + (size_t)PP * 1024, TT, NZG, 1024, 1024, nullptr, nullptr, nullptr, 0}; pg8::StaticOrder S; S.init(TT, NZG, G, (int)blockIdx.x);
        EpiZG E{P, GT0, GT1};
        pg8::gemm_phase<EpiZG, pg8::StaticOrder, true, true>(lds, g, S, E);
    }
    GRID_BARRIER();
    for (int rep = 0; rep < REP_G4; ++rep) { PHASE_BEGIN;
        pg8::Gemm g{P + C_YA, WbrT, TT, 3072, 512, PP, P + C_YA, P + C_YB, P + C_YM, 4};
        MergeOrder S; S.so.init(TT, 1024, G, (int)blockIdx.x);
        EpiMerge E{MG, GT0, GT1};
        pg8::gemm_phase<EpiMerge, MergeOrder, true, true>(lds, g, S, E);
    }
    GRID_BARRIER();
    for (int rep = 0; rep < REP_G5; ++rep) { PHASE_BEGIN;
        pg8::Gemm g{MG, WoutT, TT, 1024, 1024, 1024, nullptr, nullptr, nullptr, 0}; pg8::StaticOrder S; S.init(TT, 1024, G, (int)blockIdx.x);
        EpiOut E{x, outp};
        pg8::gemm_phase<EpiOut, pg8::StaticOrder, true, true>(lds, g, S, E);
    }
}

extern "C" void kernel_launch(void* const* d_in, const int* in_sizes, int n_in, void* d_out, int out_size, void* d_ws, size_t ws_size, hipStream_t stream) {
    static int grid = 0;
    if (grid == 0) {
        if (n_in != 19 || out_size != TT * DM || ws_size < WS_END) { fprintf(stderr, "kernel_launch: unexpected problem (n_in %d, out %d, ws %zu); nothing launched\n", n_in, out_size, ws_size); grid = -1; return; }
        int dev = 0, cus = 0, per_cu = 0;
        if (hipGetDevice(&dev) != hipSuccess || hipDeviceGetAttribute(&cus, hipDeviceAttributeMultiprocessorCount, dev) != hipSuccess) { grid = -1; return; }
        if (hipFuncSetAttribute((const void*)fwd_kernel, hipFuncAttributeMaxDynamicSharedMemorySize, LDS_BYTES) != hipSuccess) { fprintf(stderr, "kernel_launch: hipFuncSetAttribute failed\n"); grid = -1; return; }
        if (hipOccupancyMaxActiveBlocksPerMultiprocessor(&per_cu, (const void*)fwd_kernel, 512, LDS_BYTES) != hipSuccess || per_cu < 1) { fprintf(stderr, "kernel_launch: occupancy query reports %d blocks per CU\n", per_cu); (void)hipGetLastError(); grid = -1; return; }
        grid = cus;
    }
    if (grid < 0) return;
    (void)hipMemsetAsync((char*)d_ws + WS_CTL, 0, 65536, stream);
    Args a{};
    for (int i = 0; i < 19; ++i) a.in[i] = (const float*)d_in[i];
    a.pos = (const int*)d_in[2]; a.out = (float*)d_out; a.ws = (unsigned char*)d_ws;
    hipLaunchKernelGGL(fwd_kernel, dim3(grid), dim3(512), LDS_BYTES, stream, a);
    const hipError_t e = hipPeekAtLastError();
    if (e != hipSuccess) fprintf(stderr, "kernel_launch: launch failed: %s (grid %d)\n", hipGetErrorString(e), grid);
}
```

```cpp
#include <hip/hip_runtime.h>
#include <cstdio>
#include <cstdint>
namespace pg8 {
#define PG8_LAS __attribute__((address_space(3)))
typedef unsigned short bf16_t;
typedef short bf16x8 __attribute__((ext_vector_type(8)));
typedef float f32x4 __attribute__((ext_vector_type(4)));
typedef unsigned u32x4 __attribute__((ext_vector_type(4)));
constexpr int BM = 256, BK = 64, HALF = 128, HTB = HALF * BK * 2  , STAGE_BYTES = 8 * HTB, NXCD = 8, WGM = 8;

__host__ __device__ __forceinline__ int lds_byte(int r, int c) { const int st = (r >> 4) * 2 + (c >> 5), rr = r & 15, cc = c & 31, ob = rr * 64 + cc * 2; return st * 1024 + (ob ^ (((ob >> 9) & 1) << 5)); }
__host__ __device__ __forceinline__ void stage_rc(int b, int& R, int& C) { const int st = b / 1024, sb = b % 1024, swz = sb ^ (((sb >> 9) & 1) << 5); R = (st >> 1) * 16 + swz / 64; C = (st & 1) * 32 + (swz % 64) / 2; }
__host__ __device__ __forceinline__ int perm32(int rho) { const int n = rho >> 4, i = rho & 15; return 8 * (i >> 2) + 4 * n + (i & 3); }

struct Unit { int pm, pn; };
struct Gemm { const bf16_t* A; const bf16_t* Bt; int M, N, K, lda; const bf16_t* Ag0; const bf16_t* Ag1; const bf16_t* Ag2; int ngrp; };
__device__ __forceinline__ const char* a_base(const Gemm& g, const Unit& u) { if (!g.ngrp) return (const char*)g.A; const int j = u.pn / g.ngrp; return (const char*)(j == 0 ? g.Ag0 : (j == 1 ? g.Ag1 : g.Ag2)); }

struct StaticOrder {
    int nM, nN, nwg, G, c;
    __host__ __device__ void init(int M, int N, int G_, int c_) { nM = M / BM; nN = N / BM; nwg = nM * nN; G = G_; c = c_; }
    __host__ __device__ bool next(int i, Unit& u) const {
        const long L = (long)i * G + c; if (L >= nwg) return false;
        int wgid = (int)L; { const int q = nwg / NXCD, r = nwg % NXCD, xcd = wgid % NXCD, off = wgid / NXCD; wgid = (xcd < r ? xcd * (q + 1) : r * (q + 1) + (xcd - r) * q) + off; }
        const int nig = WGM * nN, gid = wgid / nig, fm = gid * WGM, gsz = (nM - fm) < WGM ? (nM - fm) : WGM;
        u.pm = fm + ((wgid % nig) % gsz); u.pn = (wgid % nig) / gsz; return true;
    }
    __device__ __forceinline__ void a_ready(const Unit&) const {}
    __device__ __forceinline__ void done(const Unit&) const {}
};

__device__ __forceinline__ unsigned cvt_pk_bf16(float lo, float hi) { unsigned r; asm volatile("v_cvt_pk_bf16_f32 %0, %1, %2" : "=v"(r) : "v"(lo), "v"(hi)); return r; }
typedef float f32x2 __attribute__((ext_vector_type(2)));
__device__ __forceinline__ f32x2 gelu_pk(f32x2 v) {
    const f32x2 av = __builtin_elementwise_abs(v), d = av * 0.2316418882f + 1.0f;
    f32x2 t; t.x = __builtin_amdgcn_rcpf(d.x); t.y = __builtin_amdgcn_rcpf(d.y);
    f32x2 q = t * 0.5307027145f + (-0.7265760135f); q = q * t + 0.7107068705f; q = q * t + (-0.142248368f); q = q * t + 0.127414796f; q = q * t;
    const f32x2 s = (v * v) * (-0.72134752044f);
    f32x2 e; e.x = __builtin_amdgcn_exp2f(s.x); e.y = __builtin_amdgcn_exp2f(s.y);
    const f32x2 m = v * (q * e), r = v - m;
    f32x2 o; o.x = v.x < 0.f ? m.x : r.x; o.y = v.y < 0.f ? m.y : r.y; return o;
}

template <int ACT  > struct EpiBf16 {
    static constexpr bool PERM = true, AFTER_DRAIN = false; static_assert(ACT == 0 || ACT == 1, "EpiBf16: ACT is 0 (none) or 1 (gelu_pk)");
    bf16_t* O; int ldc; const float* bias; int split_cols; size_t split_stride; float scale0;
    __device__ __forceinline__ void operator()(const f32x4 (&acc)[2][2][4][2], const Unit& u, int wr, int wc, int fr, int fq) const {
        const int row0 = u.pm * BM + wr * 64 + fr; int colt = u.pn * BM; bf16_t* base = O;
        float sc = 1.f; if (split_cols) { const int t = colt / split_cols; base += (size_t)t * split_stride; colt -= t * split_cols; if (t == 0) sc = scale0; }
        const int col0 = colt + wc * 32 + 8 * fq, bcol0 = u.pn * BM + wc * 32 + 8 * fq;
        f32x4 bv[2][2];
#pragma unroll
        for (int bj = 0; bj < 2; ++bj)
#pragma unroll
            for (int n = 0; n < 2; ++n) bv[bj][n] = bias ? *(const f32x4*)(bias + bcol0 + bj * HALF + 4 * n) : (f32x4){0.f, 0.f, 0.f, 0.f};
#pragma unroll
        for (int ai = 0; ai < 2; ++ai)
#pragma unroll
            for (int m = 0; m < 4; ++m) { bf16_t* rowp = base + (size_t)(row0 + ai * HALF + m * 16) * ldc + col0;
#pragma unroll
                for (int bj = 0; bj < 2; ++bj) { f32x4 v0 = acc[ai][bj][m][0] + bv[bj][0], v1 = acc[ai][bj][m][1] + bv[bj][1];
                    if (ACT == 1) { f32x2 a = gelu_pk((f32x2){v0[0], v0[1]}), b = gelu_pk((f32x2){v0[2], v0[3]}), c = gelu_pk((f32x2){v1[0], v1[1]}), d = gelu_pk((f32x2){v1[2], v1[3]});
                        v0 = (f32x4){a.x, a.y, b.x, b.y}; v1 = (f32x4){c.x, c.y, d.x, d.y}; }
                    v0 = v0 * sc; v1 = v1 * sc; u32x4 w; w.x = cvt_pk_bf16(v0[0], v0[1]); w.y = cvt_pk_bf16(v0[2], v0[3]); w.z = cvt_pk_bf16(v1[0], v1[1]); w.w = cvt_pk_bf16(v1[2], v1[3]);
                    *(u32x4*)(rowp + bj * HALF) = w; } }
    }
};
template <class Epi, class Sched, bool ALIGN_EPI = false, bool SP2 = false>
__device__ __forceinline__ void gemm_phase(PG8_LAS unsigned char* lds, const Gemm g, const Sched& S, const Epi& E) {
    int tid_ = threadIdx.x; asm volatile("" : "+v"(tid_));
    const int tid = tid_, wid = __builtin_amdgcn_readfirstlane(tid >> 6), lane = tid & 63, wr = wid >> 2, wc = wid & 3, fr = lane & 15, fq = lane >> 4;
    const int K = g.K, nt = K / BK;
    unsigned voffA[2], voffB[2];
#pragma unroll
    for (int i = 0; i < 2; ++i) { int R, C; stage_rc(tid * 16 + i * 8192, R, C); const int Rb = Epi::PERM ? ((R & ~31) + perm32(R & 31)) : R;
        voffA[i] = (unsigned)(R * g.lda + C) * 2u; voffB[i] = (unsigned)(Rb * K + C) * 2u; }
    const size_t kstep = (size_t)(BK * 2);
    const size_t hstepA = (size_t)HALF * g.lda * 2, hstepB = (size_t)HALF * K * 2;
    const size_t tstepA = 2 * hstepA, tstepB = 2 * hstepB;
    const unsigned ldsw = (unsigned)wid * 1024u;
    const int aoff = lds_byte(wr * 64 + fr, fq * 8), boff = lds_byte(wc * 32 + fr, fq * 8);
#define PG8_SA(b, h) (((b) * 2 + (h)) * HTB)
#define PG8_SB(b, h) ((4 + (b) * 2 + (h)) * HTB)
#define PG8_STAGE(bufoff, gbase, voff) do { _Pragma("unroll") for (int _i = 0; _i < 2; ++_i) \
        __builtin_amdgcn_global_load_lds((const unsigned*)((const char*)(gbase) + (voff)[_i]), (PG8_LAS unsigned*)(lds + (bufoff) + ldsw + _i * 8192), 16, 0, 0); } while (0)
#define PG8_LDA(dst, b, h) do { _Pragma("unroll") for (int m = 0; m < 4; ++m) _Pragma("unroll") for (int k = 0; k < 2; ++k) dst[m][k] = *(const PG8_LAS bf16x8*)(lds + PG8_SA(b, h) + aoff + m * 2048 + k * 1024); } while (0)
#define PG8_LDB(dst, b, h) do { _Pragma("unroll") for (int n = 0; n < 2; ++n) _Pragma("unroll") for (int k = 0; k < 2; ++k) dst[n][k] = *(const PG8_LAS bf16x8*)(lds + PG8_SB(b, h) + boff + n * 2048 + k * 1024); } while (0)
#define PG8_MMA(ai, bj, At, Bt) do { __builtin_amdgcn_s_setprio(1); _Pragma("unroll") for (int m = 0; m < 4; ++m) _Pragma("unroll") for (int n = 0; n < 2; ++n) _Pragma("unroll") for (int k = 0; k < 2; ++k) \
        acc[ai][bj][m][n] = __builtin_amdgcn_mfma_f32_16x16x32_bf16(Bt[n][k], At[m][k], acc[ai][bj][m][n], 0, 0, 0); __builtin_amdgcn_s_setprio(0); } while (0)
#define PG8_WAIT_V(n) asm volatile("s_waitcnt vmcnt(" #n ")" ::: "memory")
#define PG8_WAIT_L(n) asm volatile("s_waitcnt lgkmcnt(" #n ")" ::: "memory")
#define PG8_BAR __builtin_amdgcn_s_barrier()
#define PG8_SCHED __builtin_amdgcn_sched_barrier(0)
    Unit cur, nxt; int ui = 0;
    if (!S.next(0, cur)) return;
    f32x4 acc[2][2][4][2];
#pragma unroll
    for (int a = 0; a < 2; ++a)
#pragma unroll
        for (int b = 0; b < 2; ++b)
#pragma unroll
            for (int m = 0; m < 4; ++m)
#pragma unroll
                for (int n = 0; n < 2; ++n) acc[a][b][m][n] = (f32x4){0.f, 0.f, 0.f, 0.f};
    bf16x8 At[4][2], B0[2][2], B1[2][2];
    const char* cA = a_base(g, cur) + (size_t)cur.pm * tstepA; const char* cB = (const char*)g.Bt + (size_t)cur.pn * tstepB;
    S.a_ready(cur);
    if constexpr (SP2) {
        PG8_STAGE(PG8_SB(0, 0), cB, voffB); PG8_STAGE(PG8_SB(0, 1), cB + hstepB, voffB); PG8_STAGE(PG8_SA(0, 0), cA, voffA); PG8_STAGE(PG8_SA(0, 1), cA + hstepA, voffA);
        if (wr == 1) PG8_BAR;
        PG8_WAIT_V(2); PG8_BAR;
        PG8_STAGE(PG8_SB(1, 0), cB + kstep, voffB); PG8_STAGE(PG8_SA(1, 0), cA + kstep, voffA); PG8_STAGE(PG8_SB(1, 1), cB + hstepB + kstep, voffB);
        PG8_WAIT_V(6); PG8_BAR;
    } else {
        PG8_STAGE(PG8_SB(0, 0), cB, voffB); PG8_STAGE(PG8_SA(0, 0), cA, voffA); PG8_STAGE(PG8_SB(0, 1), cB + hstepB, voffB); PG8_STAGE(PG8_SA(0, 1), cA + hstepA, voffA);
        if (wr == 1) PG8_BAR;
        PG8_WAIT_V(4); PG8_BAR;
        PG8_STAGE(PG8_SB(1, 0), cB + kstep, voffB); PG8_STAGE(PG8_SA(1, 0), cA + kstep, voffA); PG8_STAGE(PG8_SB(1, 1), cB + hstepB + kstep, voffB);
        PG8_WAIT_V(6); PG8_BAR;
    }
    for (;;) {
        const bool has_next = S.next(ui + 1, nxt);
        const char* nA = has_next ? a_base(g, nxt) + (size_t)nxt.pm * tstepA : cA; const char* nB = has_next ? (const char*)g.Bt + (size_t)nxt.pn * tstepB : cB;
        for (int t = 0; t < nt; t += 2) {
            const bool last = (t == nt - 2);
            const char* a1 = cA + (size_t)(t + 1) * kstep;
            const char* a2 = last ? nA : cA + (size_t)(t + 2) * kstep; const char* b2 = last ? nB : cB + (size_t)(t + 2) * kstep;
            const char* a3 = a2 + kstep; const char* b3 = b2 + kstep;
            if (last && has_next) S.a_ready(nxt);
            if constexpr (SP2) {
            PG8_LDB(B0, 0, 0); PG8_LDB(B1, 0, 1); PG8_SCHED; PG8_LDA(At, 0, 0); PG8_STAGE(PG8_SA(1, 1), a1 + hstepA, voffA);
            PG8_WAIT_V(8); PG8_WAIT_L(0); PG8_BAR; PG8_MMA(0, 0, At, B0); PG8_MMA(0, 1, At, B1); PG8_BAR; PG8_SCHED;
            PG8_LDA(At, 0, 1); PG8_STAGE(PG8_SB(0, 0), b2, voffB); PG8_STAGE(PG8_SB(0, 1), b2 + hstepB, voffB); PG8_STAGE(PG8_SA(0, 0), a2, voffA);
            PG8_WAIT_V(8); PG8_WAIT_L(0); PG8_BAR; PG8_MMA(1, 0, At, B0); PG8_MMA(1, 1, At, B1); PG8_BAR; PG8_SCHED;
            PG8_LDB(B0, 1, 0); PG8_LDB(B1, 1, 1); PG8_SCHED; PG8_LDA(At, 1, 0); PG8_STAGE(PG8_SA(0, 1), a2 + hstepA, voffA);
            PG8_WAIT_V(8); PG8_WAIT_L(0); PG8_BAR; PG8_MMA(0, 0, At, B0); PG8_MMA(0, 1, At, B1); PG8_BAR; PG8_SCHED;
            PG8_LDA(At, 1, 1); PG8_STAGE(PG8_SB(1, 0), b3, voffB); PG8_STAGE(PG8_SB(1, 1), b3 + hstepB, voffB); PG8_STAGE(PG8_SA(1, 0), a3, voffA);
            PG8_WAIT_V(8); PG8_WAIT_L(0); PG8_BAR; PG8_MMA(1, 0, At, B0); PG8_MMA(1, 1, At, B1); PG8_BAR; PG8_SCHED;
            } else {
            PG8_LDB(B0, 0, 0); PG8_SCHED; PG8_LDA(At, 0, 0); PG8_STAGE(PG8_SA(1, 1), a1 + hstepA, voffA);
            PG8_WAIT_L(8); PG8_BAR; PG8_WAIT_L(0); PG8_MMA(0, 0, At, B0); PG8_BAR; PG8_SCHED;
            PG8_LDB(B1, 0, 1); PG8_STAGE(PG8_SB(0, 0), b2, voffB);
            PG8_BAR; PG8_WAIT_L(0); PG8_MMA(0, 1, At, B1); PG8_BAR;
            PG8_LDA(At, 0, 1); PG8_STAGE(PG8_SA(0, 0), a2, voffA);
            PG8_BAR; PG8_WAIT_L(0); PG8_MMA(1, 0, At, B0); PG8_BAR; PG8_SCHED;
            PG8_STAGE(PG8_SB(0, 1), b2 + hstepB, voffB);
            PG8_WAIT_V(6); PG8_BAR; PG8_MMA(1, 1, At, B1); PG8_BAR;
            PG8_LDB(B0, 1, 0); PG8_SCHED; PG8_LDA(At, 1, 0); PG8_STAGE(PG8_SA(0, 1), a2 + hstepA, voffA);
            PG8_WAIT_L(8); PG8_BAR; PG8_WAIT_L(0); PG8_MMA(0, 0, At, B0); PG8_BAR; PG8_SCHED;
            PG8_LDB(B1, 1, 1); PG8_STAGE(PG8_SB(1, 0), b3, voffB);
            PG8_BAR; PG8_WAIT_L(0); PG8_MMA(0, 1, At, B1); PG8_BAR;
            PG8_LDA(At, 1, 1); PG8_STAGE(PG8_SA(1, 0), a3, voffA);
            PG8_BAR; PG8_WAIT_L(0); PG8_MMA(1, 0, At, B0); PG8_BAR; PG8_SCHED;
            PG8_STAGE(PG8_SB(1, 1), b3 + hstepB, voffB);
            PG8_WAIT_V(6); PG8_BAR; PG8_MMA(1, 1, At, B1); PG8_BAR;
            }
        }
        if constexpr (ALIGN_EPI) { if (wr == 0) PG8_BAR; }
        if constexpr (!Epi::AFTER_DRAIN) { E(acc, cur, wr, wc, fr, fq); S.done(cur); }
        if (!has_next) break;
#pragma unroll
        for (int a = 0; a < 2; ++a)
#pragma unroll
            for (int b = 0; b < 2; ++b)
#pragma unroll
                for (int m = 0; m < 4; ++m)
#pragma unroll
                    for (int n = 0; n < 2; ++n) acc[a][b][m][n] = (f32x4){0.f, 0.f, 0.f, 0.f};
        cur = nxt; cA = nA; cB = nB; ++ui;
        if constexpr (ALIGN_EPI) { if (wr == 1) PG8_BAR; }
    }
    PG8_WAIT_V(0);
    if constexpr (!ALIGN_EPI) { if (wr == 0) PG8_BAR; }
    PG8_BAR;
    if constexpr (Epi::AFTER_DRAIN) { E.fused(acc, cur, wr, wc, fr, fq, lds, wid, lane); S.done(cur); }
#undef PG8_SA
#undef PG8_SB
#undef PG8_STAGE
#undef PG8_LDA
#undef PG8_LDB
#undef PG8_MMA
#undef PG8_WAIT_V
#undef PG8_WAIT_L
#undef PG8_BAR
#undef PG8_SCHED
}
}

#define LAS __attribute__((address_space(3)))
typedef unsigned short bf16;
typedef unsigned v4u __attribute__((ext_vector_type(4)));
typedef unsigned v2u __attribute__((ext_vector_type(2)));
typedef float f32x4 __attribute__((ext_vector_type(4)));
typedef float f32x16 __attribute__((ext_vector_type(16)));
typedef short bf16x8 __attribute__((ext_vector_type(8)));
typedef short s16x4 __attribute__((ext_vector_type(4)));
typedef float f32x2_t __attribute__((ext_vector_type(2)));
typedef __bf16 bf16x2_t __attribute__((ext_vector_type(2)));

constexpr int NB = 8, SEQ = 2048, DM = 1024, TT = NB * SEQ;
constexpr int DIN = 7912, NP = 7936;
constexpr int PP = 3840, NZG = 4096;
constexpr int MEML = 256;
constexpr float EPS = 1e-6f, NEGF = -1e30f;
constexpr int C_QA = 0, C_KA = 512, C_VA = 1024, C_QI = 1536, C_KI = 2048, C_WI = 2112, C_CQ = 2120, C_CKV = 2504, C_KR = 2760, C_QM = 2792, C_ZM = 3304;
constexpr int C_YA = C_QI, C_YB = C_CQ, C_YM = C_VA;
constexpr float SCALE_A = 0.18033688011112042f;
constexpr float SCALE_B = 0.14724444602590306f;
constexpr float SCALE_M = 0.12751743082459868f;
constexpr float SCALE_I = 0.04419417382415922f;

__constant__ float INVA[8] = {1.0f, 0.1939227432012558f, 0.03760603070259094f, 0.007292664609849453f, 0.0014142135623842478f, 0.00027424818836152554f, 5.3182957344688475e-05f, 1.0313385246263351e-05f};
__constant__ float INVB[16] = {1.0f, 0.44036659598350525f, 0.1939227432012558f, 0.08539710193872452f, 0.03760603070259094f, 0.016560440883040428f, 0.007292664609849453f, 0.0032114461064338684f, 0.0014142135623842478f, 0.0006227724370546639f, 0.00027424818836152554f, 0.00012076973507646471f, 5.3182957344688475e-05f, 2.34199997066753e-05f, 1.0313385246263351e-05f, 4.541670477919979e-06f};

constexpr size_t MiB = 1u << 20;
constexpr size_t WS_CTL = 0;
constexpr size_t WS_WIN = 1 * MiB;
constexpr size_t WS_WUQ = 17 * MiB;
constexpr size_t WS_WUKV = 18 * MiB;
constexpr size_t WS_WMEM = 19 * MiB;
constexpr size_t WS_WBR = 21 * MiB;
constexpr size_t WS_WOUT = 24 * MiB;
constexpr size_t WS_ROPEA = 26 * MiB;
constexpr size_t WS_ROPEB = 27 * MiB;
constexpr size_t WS_MN = 29 * MiB;
constexpr size_t WS_KVM = 33 * MiB;
constexpr size_t WS_VTM = 37 * MiB;
constexpr size_t WS_WI = 39 * MiB;
constexpr size_t WS_MASK = 40 * MiB;
constexpr size_t WS_H = 44 * MiB;
constexpr size_t WS_P = 76 * MiB;
constexpr size_t WS_QB = 196 * MiB;
constexpr size_t WS_KVB = 220 * MiB;
constexpr size_t WS_G1 = 196 * MiB;
constexpr size_t WS_END = 256 * MiB;
constexpr size_t DO_VTA = 0;
constexpr size_t DO_VTB = 16 * MiB;
constexpr size_t DO_KB = 32 * MiB;
constexpr size_t DO_G0 = 0;

constexpr int REP_P0 = 1, REP_PH = 1, REP_G1 = 1, REP_G2 = 1, REP_IDX = 1, REP_ATT = 1, REP_G4 = 1, REP_G5 = 1;
constexpr int REP_IDX1 = 1, REP_SEL = 1;
constexpr int ATT_STRIP = 0;
constexpr int EXTRA_SYNCS = 0, REP_TR = 1, DUMMY_POST1 = 0, DUMMY_POST2 = 0;
constexpr int LDS_BYTES = 147456;
constexpr int LDS_SLOT = LDS_BYTES - 64;

__device__ __forceinline__ unsigned pk2(float lo, float hi) { f32x2_t v = {lo, hi}; bf16x2_t b = __builtin_convertvector(v, bf16x2_t); return __builtin_bit_cast(unsigned, b); }
__device__ __forceinline__ float bflo(unsigned w) { return __uint_as_float(w << 16); }
__device__ __forceinline__ float bfhi(unsigned w) { return __uint_as_float(w & 0xffff0000u); }
__device__ __forceinline__ float bf1(bf16 b) { return __uint_as_float(((unsigned)b) << 16); }
#define UNPACK8(W_, V_) do { V_[0] = bflo((W_)[0]); V_[1] = bfhi((W_)[0]); V_[2] = bflo((W_)[1]); V_[3] = bfhi((W_)[1]); V_[4] = bflo((W_)[2]); V_[5] = bfhi((W_)[2]); V_[6] = bflo((W_)[3]); V_[7] = bfhi((W_)[3]); } while (0)
#define PACK8(V_) (v4u){pk2(V_[0], V_[1]), pk2(V_[2], V_[3]), pk2(V_[4], V_[5]), pk2(V_[6], V_[7])}
template <int CTRL> __device__ __forceinline__ float dpp_f(float v) { return __int_as_float(__builtin_amdgcn_update_dpp(0, __float_as_int(v), CTRL, 0xF, 0xF, false)); }
#define SUM8(x) do { x += dpp_f<0xB1>(x); x += dpp_f<0x4E>(x); x += dpp_f<0x141>(x); } while (0)
#define SUM16(x) do { SUM8(x); x += dpp_f<0x140>(x); } while (0)
__device__ __forceinline__ float wave_sum(float v) {
    SUM16(v);
    return __int_as_float(__builtin_amdgcn_readlane(__float_as_int(v), 0)) + __int_as_float(__builtin_amdgcn_readlane(__float_as_int(v), 16))
         + __int_as_float(__builtin_amdgcn_readlane(__float_as_int(v), 32)) + __int_as_float(__builtin_amdgcn_readlane(__float_as_int(v), 48));
}
#define LDS_WAIT() asm volatile("s_waitcnt lgkmcnt(0)" ::: "memory")

__device__ __forceinline__ int win_src(int d) {
    if (d < 2120) return d;
    if (d < 2792) return d + 512;
    if (d < 3816) return d + 1024;
    if (d < 3840) return -1;
    if (d < 4352) return d - 3840 + 2120;
    if (d < 4864) return d - 4352 + 3304;
    return d - 4864 + 4840;
}
template <bool REMAP>
__device__ __forceinline__ void transpose_item(const float* W, int K, int N, int Npad, bf16* WT, LAS float* scr, int item, int lane) {
    const int nblk = Npad / 32, kb = item / nblk, nb = item % nblk, k0 = 64 * kb, n0 = 32 * nb;
    const int n4 = 4 * (lane & 7);
    const int nn = REMAP ? win_src(n0 + n4) : n0 + n4; const bool ok = nn >= 0 && nn < N;
#pragma unroll
    for (int i = 0; i < 8; ++i) { const int kk = 8 * i + (lane >> 3);
        f32x4 v = (f32x4){0.f, 0.f, 0.f, 0.f}; if (ok) v = __builtin_nontemporal_load((const f32x4*)(W + (size_t)(k0 + kk) * N + nn));
        LAS float* d = scr + kk * 33 + n4; d[0] = v[0]; d[1] = v[1]; d[2] = v[2]; d[3] = v[3]; }
    LDS_WAIT(); asm volatile("" ::: "memory");
    const int c = lane & 7;
#pragma unroll
    for (int j = 0; j < 4; ++j) { const int n = (lane >> 3) + 8 * j; const LAS float* s = scr + (8 * c) * 33 + n;
        v4u o; o.x = pk2(s[0 * 33], s[1 * 33]); o.y = pk2(s[2 * 33], s[3 * 33]); o.z = pk2(s[4 * 33], s[5 * 33]); o.w = pk2(s[6 * 33], s[7 * 33]);
        *(v4u*)(WT + (size_t)(n0 + n) * K + k0 + 8 * c) = o; }
    LDS_WAIT(); asm volatile("" ::: "memory");
}
__device__ __forceinline__ void rms_row_1024(const float* xrow, const float* g, bf16* orow, int lane) {
    const f32x4* xr = (const f32x4*)xrow + lane; const f32x4* gr = (const f32x4*)g + lane;
    f32x4 v[4]; float s = 0.f;
#pragma unroll
    for (int j = 0; j < 4; ++j) { v[j] = __builtin_nontemporal_load(xr + 64 * j); s += (v[j].x * v[j].x + v[j].y * v[j].y) + (v[j].z * v[j].z + v[j].w * v[j].w); }
    const float rstd = __builtin_amdgcn_rsqf(wave_sum(s) * (1.f / 1024.f) + EPS);
    v2u* o8 = (v2u*)orow + lane;
#pragma unroll
    for (int j = 0; j < 4; ++j) { const f32x4 gg = gr[64 * j]; v2u w; w.x = pk2(v[j].x * rstd * gg.x, v[j].y * rstd * gg.y); w.y = pk2(v[j].z * rstd * gg.z, v[j].w * rstd * gg.w); o8[64 * j] = w; }
}

#define ROPE8(v, sub, c8, s8) do { _Pragma("unroll") for (int j_ = 0; j_ < 8; ++j_) { const float pv_ = dpp_f<0xB1>(v[j_]); \
        const float r0_ = v[j_] * c8[j_] - pv_ * s8[j_], r1_ = v[j_] * c8[j_] + pv_ * s8[j_]; v[j_] = (sub) == 0 ? r0_ : ((sub) == 1 ? r1_ : v[j_]); } } while (0)

__device__ __forceinline__ void post1_row(const bf16* Prow, bf16* Orow, const float* ra, const float (&ga)[8], const float (&gk)[8], const float (&gq)[8], const float (&gc)[8], const float (&gm)[8], float* WIrow, int lane) {
    const int sub = lane & 7;
    const v4u z4 = (v4u){0u, 0u, 0u, 0u};
    const v4u w_qa = *(const v4u*)(Prow + C_QA + 8 * lane);
    const v4u w_ka = *(const v4u*)(Prow + C_KA + 8 * lane);
    const v4u w_qi = *(const v4u*)(Prow + C_QI + 8 * lane);
    v4u w_ki = z4, w_cq = z4, w_ckv = z4; float w_wi = 0.f;
    if (lane < 8) { w_ki = *(const v4u*)(Prow + C_KI + 8 * lane); w_wi = bf1(Prow[C_WI + lane]); }
    if (lane < 48) w_cq = *(const v4u*)(Prow + C_CQ + 8 * lane);
    if (lane < 32) w_ckv = *(const v4u*)(Prow + C_CKV + 8 * lane);
    float c8[8], s8[8];
    { const f32x4 r0 = *(const f32x4*)(ra), r1 = *(const f32x4*)(ra + 4), r2 = *(const f32x4*)(ra + 8), r3 = *(const f32x4*)(ra + 12);
      c8[0] = r0[0]; c8[1] = r0[1]; c8[2] = r0[2]; c8[3] = r0[3]; c8[4] = r1[0]; c8[5] = r1[1]; c8[6] = r1[2]; c8[7] = r1[3];
      s8[0] = r2[0]; s8[1] = r2[1]; s8[2] = r2[2]; s8[3] = r2[3]; s8[4] = r3[0]; s8[5] = r3[1]; s8[6] = r3[2]; s8[7] = r3[3]; }
    { float v[8]; UNPACK8(w_qa, v); float ss = 0.f;
#pragma unroll
      for (int j = 0; j < 8; ++j) ss += v[j] * v[j];
      SUM8(ss);
      const float rstd = __builtin_amdgcn_rsqf(ss * (1.f / 64.f) + EPS);
#pragma unroll
      for (int j = 0; j < 8; ++j) v[j] = v[j] * rstd * ga[j];
      ROPE8(v, sub, c8, s8);
#pragma unroll
      for (int j = 0; j < 8; ++j) v[j] *= SCALE_A;
      *(v4u*)(Orow + C_QA + 8 * lane) = PACK8(v); }
    { float v[8]; UNPACK8(w_ka, v); float ss = 0.f;
#pragma unroll
      for (int j = 0; j < 8; ++j) ss += v[j] * v[j];
      SUM8(ss);
      const float rstd = __builtin_amdgcn_rsqf(ss * (1.f / 64.f) + EPS);
#pragma unroll
      for (int j = 0; j < 8; ++j) v[j] = v[j] * rstd * gk[j];
      ROPE8(v, sub, c8, s8);
      *(v4u*)(Orow + C_KA + 8 * lane) = PACK8(v); }
    { float v[8]; UNPACK8(w_qi, v);
      ROPE8(v, sub, c8, s8);
      *(v4u*)(Orow + C_QI + 8 * lane) = PACK8(v); }
    { float v[8]; UNPACK8(w_ki, v);
      ROPE8(v, sub, c8, s8);
      if (lane < 8) *(v4u*)(Orow + C_KI + 8 * lane) = PACK8(v); }
    if (lane < 8) WIrow[lane] = w_wi * SCALE_I;
    { float v[8]; UNPACK8(w_cq, v); float ss = 0.f;
#pragma unroll
      for (int j = 0; j < 8; ++j) ss += v[j] * v[j];
      ss = wave_sum(ss); const float rstd = __builtin_amdgcn_rsqf(ss * (1.f / 384.f) + EPS);
      if (lane < 48) {
#pragma unroll
          for (int j = 0; j < 8; ++j) v[j] = v[j] * rstd * gq[j];
          *(v4u*)(Orow + C_CQ + 8 * lane) = PACK8(v); } }
    { float v[8]; UNPACK8(w_ckv, v); float ss = 0.f;
#pragma unroll
      for (int j = 0; j < 8; ++j) ss += v[j] * v[j];
      ss = wave_sum(ss); const float rstd = __builtin_amdgcn_rsqf(ss * (1.f / 256.f) + EPS);
      if (lane < 32) {
#pragma unroll
          for (int j = 0; j < 8; ++j) v[j] = v[j] * rstd * gc[j];
          *(v4u*)(Orow + C_CKV + 8 * lane) = PACK8(v); } }
}

__device__ __forceinline__ void km_row(bf16* row, const float* gkm, int lane) {
    v4u w = *(const v4u*)(row + 8 * lane); float v[8]; UNPACK8(w, v); float ss = 0.f;
#pragma unroll
    for (int j = 0; j < 8; ++j) ss += v[j] * v[j];
    SUM16(ss);
    const float rstd = __builtin_amdgcn_rsqf(ss * (1.f / 128.f) + EPS);
#pragma unroll
    for (int j = 0; j < 8; ++j) v[j] = v[j] * rstd * gkm[8 * (lane & 15) + j];
    *(v4u*)(row + 8 * lane) = PACK8(v);
}

__device__ __forceinline__ void transpose_v(const bf16* src, int pitch, int col0, int hstride, int H, int DV, int S, int nb, bf16* dst, int gw, int NGW, int lane) {
    const int ndq = DV / 64, nsc = S / 64, ntask = nb * H * nsc * ndq;
    for (int task = gw; task < ntask; task += NGW) {
        int x = task; const int dq = x % ndq; x /= ndq; const int sc = x % nsc; x /= nsc; const int h = x % H; const int b = x / H;
        const int s = sc * 64 + lane;
        const bf16* srow = src + (size_t)(b * S + s) * pitch + col0 + h * hstride + dq * 64;
        bf16* drow = dst + ((size_t)((b * H + h) * DV + dq * 64)) * S + s;
        v4u wv[8];
#pragma unroll
        for (int c = 0; c < 8; ++c) wv[c] = *(const v4u*)(srow + 8 * c);
#pragma unroll
        for (int c = 0; c < 8; ++c) { const v4u w = wv[c];
            drow[(size_t)(8 * c + 0) * S] = (bf16)(w.x & 0xffffu); drow[(size_t)(8 * c + 1) * S] = (bf16)(w.x >> 16);
            drow[(size_t)(8 * c + 2) * S] = (bf16)(w.y & 0xffffu); drow[(size_t)(8 * c + 3) * S] = (bf16)(w.y >> 16);
            drow[(size_t)(8 * c + 4) * S] = (bf16)(w.z & 0xffffu); drow[(size_t)(8 * c + 5) * S] = (bf16)(w.z >> 16);
            drow[(size_t)(8 * c + 6) * S] = (bf16)(w.w & 0xffffu); drow[(size_t)(8 * c + 7) * S] = (bf16)(w.w >> 16); }
    }
}

__device__ __forceinline__ void post2_row(const bf16* QBrow, bf16* QOrow, const bf16* KVBrow, const bf16* Prow, bf16* KBrow, const float* rb, const float (&gqv)[12], const float (&gkv)[12], LAS float* scr, int lane) {
    const int hd = lane >> 3, d0 = 12 * (lane & 7);
    float vq[12], vk[12], cc[12], sn[12];
    { const v2u* p = (const v2u*)(QBrow + 12 * lane);
      const v2u w0 = p[0], w1 = p[1], w2 = p[2];
      bf16 kr[12];
#pragma unroll
      for (int e = 0; e < 12; ++e) { const int d = d0 + e; kr[e] = d < 64 ? KVBrow[hd * 128 + d] : Prow[C_KR + d - 64]; }
#pragma unroll
      for (int e = 0; e < 12; ++e) { const int d = d0 + e; const int i = (d - 64) & 15; cc[e] = d < 64 ? 1.f : rb[i]; sn[e] = d < 64 ? 0.f : rb[16 + i]; }
      vq[0] = bflo(w0.x); vq[1] = bfhi(w0.x); vq[2] = bflo(w0.y); vq[3] = bfhi(w0.y); vq[4] = bflo(w1.x); vq[5] = bfhi(w1.x); vq[6] = bflo(w1.y); vq[7] = bfhi(w1.y);
      vq[8] = bflo(w2.x); vq[9] = bfhi(w2.x); vq[10] = bflo(w2.y); vq[11] = bfhi(w2.y);
#pragma unroll
      for (int e = 0; e < 12; ++e) vk[e] = bf1(kr[e]); }
    float sq = 0.f, sk = 0.f;
#pragma unroll
    for (int e = 0; e < 12; ++e) { sq += vq[e] * vq[e]; sk += vk[e] * vk[e]; }
    SUM8(sq); SUM8(sk);
    const float rq = __builtin_amdgcn_rsqf(sq * (1.f / 96.f) + EPS), rk = __builtin_amdgcn_rsqf(sk * (1.f / 96.f) + EPS);
#pragma unroll
    for (int e = 0; e < 12; ++e) { vq[e] = vq[e] * rq * gqv[e]; vk[e] = vk[e] * rk * gkv[e]; scr[12 * lane + e] = vq[e]; scr[768 + 12 * lane + e] = vk[e]; }
    LDS_WAIT(); asm volatile("" ::: "memory");
    float oq[12], ok[12];
#pragma unroll
    for (int e = 0; e < 12; ++e) { const int d = d0 + e;
        if (d < 64) { oq[e] = vq[e]; ok[e] = vk[e]; }
        else { const bool first = d < 80; const int off = first ? 16 : -16; const float pq = scr[12 * lane + e + off], pk = scr[768 + 12 * lane + e + off];
               oq[e] = first ? vq[e] * cc[e] - pq * sn[e] : vq[e] * cc[e] + pq * sn[e];
               ok[e] = first ? vk[e] * cc[e] - pk * sn[e] : vk[e] * cc[e] + pk * sn[e]; }
        oq[e] *= SCALE_B; }
    LDS_WAIT(); asm volatile("" ::: "memory");
    v2u* q = (v2u*)(QOrow + 12 * lane); v2u* k = (v2u*)(KBrow + 12 * lane);
#pragma unroll
    for (int i = 0; i < 3; ++i) { v2u w; w.x = pk2(oq[4 * i], oq[4 * i + 1]); w.y = pk2(oq[4 * i + 2], oq[4 * i + 3]); q[i] = w;
                                  v2u u; u.x = pk2(ok[4 * i], ok[4 * i + 1]); u.y = pk2(ok[4 * i + 2], ok[4 * i + 3]); k[i] = u; }
}

__device__ __forceinline__ int next_unit(unsigned* ctr, volatile LAS int* slot) {
    __syncthreads();
    if (threadIdx.x == 0) *slot = (int)atomicAdd(ctr, 1u);
    __syncthreads();
    return *slot;
}

constexpr int SCP = 2112;
__device__ __forceinline__ unsigned ord_key(float v) { const unsigned b = __float_as_uint(v); return b ^ ((unsigned)((int)b >> 31) | 0x80000000u); }
__device__ __forceinline__ void indexer_load_q(const bf16* P, const float* WI, int u, bf16x8 (&qf)[8][2], float (&wq)[8]) {
    const int lane = threadIdx.x & 63, n = lane & 15, g = lane >> 4;
    const int tb = 127 - (u >> 3), bb = u & 7;
    const size_t row = (size_t)(bb * SEQ + tb * 16 + n);
    const bf16* qrow = P + row * PP + C_QI + 8 * g;
#pragma unroll
    for (int h = 0; h < 8; ++h) { qf[h][0] = *(const bf16x8*)(qrow + h * 64); qf[h][1] = *(const bf16x8*)(qrow + h * 64 + 32); wq[h] = WI[row * 8 + h]; }
}
__device__ __forceinline__ void indexer_unit(LAS float* sc, const bf16* P, const float* WI, unsigned* MASK, int bb, int tb, bf16x8 (&qf)[8][2], float (&wq)[8],
                                             int tk, volatile LAS int* slot, int nunits, int& un) {
    int tid_ = threadIdx.x; asm volatile("" : "+v"(tid_));
    const int tid = tid_, lane = tid & 63, w = __builtin_amdgcn_readfirstlane(tid >> 6);
    const int n = lane & 15, g = lane >> 4;
    const int rowbase = bb * SEQ, t0 = tb * 16;
    {
        const int ntile = tb + 1;
        const int nmine = (ntile - w + 7) >> 3;
        const int ngrp = (nmine + 3) >> 2;
        const bf16* kbase = P + (size_t)(rowbase + n) * PP + C_KI + 8 * g;
        bf16x8 kb[2][4][2];
#define IDX_LOAD(BUF, GRP) do { _Pragma("unroll") for (int j_ = 0; j_ < 4; ++j_) { const int tile_ = w + 8 * (4 * (GRP) + j_); const int tl_ = tile_ < ntile ? tile_ : 0; \
            const bf16* kr_ = kbase + (size_t)(16 * tl_) * PP; kb[BUF][j_][0] = *(const bf16x8*)(kr_); kb[BUF][j_][1] = *(const bf16x8*)(kr_ + 32); } } while (0)
#define IDX_COMP(BUF, GRP) do { _Pragma("unroll") for (int j_ = 0; j_ < 4; ++j_) { const int tile_ = w + 8 * (4 * (GRP) + j_); if (tile_ < ntile) { \
            f32x4 idx_ = (f32x4){0.f, 0.f, 0.f, 0.f}; \
            _Pragma("unroll") for (int h_ = 0; h_ < 8; ++h_) { f32x4 a_ = (f32x4){0.f, 0.f, 0.f, 0.f}; \
                a_ = __builtin_amdgcn_mfma_f32_16x16x32_bf16(kb[BUF][j_][0], qf[h_][0], a_, 0, 0, 0); \
                a_ = __builtin_amdgcn_mfma_f32_16x16x32_bf16(kb[BUF][j_][1], qf[h_][1], a_, 0, 0, 0); \
                _Pragma("unroll") for (int i_ = 0; i_ < 4; ++i_) idx_[i_] = __builtin_fmaf(wq[h_], __builtin_fmaxf(a_[i_], 0.f), idx_[i_]); } \
            { const int k0_ = 16 * tile_ + 4 * g; LAS float* d_ = sc + n * SCP + k0_ + (k0_ >> 5); d_[0] = idx_[0]; d_[1] = idx_[1]; d_[2] = idx_[2]; d_[3] = idx_[3]; } } } } while (0)
        if (ngrp > 0) IDX_LOAD(0, 0);
        for (int gp = 0; gp < ngrp; gp += 2) {
            if (gp + 1 < ngrp) IDX_LOAD(1, gp + 1);
            IDX_COMP(0, gp);
            if (gp + 1 < ngrp) { if (gp + 2 < ngrp) IDX_LOAD(0, gp + 2); IDX_COMP(1, gp + 1); }
        }
#undef IDX_LOAD
#undef IDX_COMP
    }
    if (tid == 0) *slot = tk;
    __syncthreads();
    un = *slot;
    if (un < nunits) indexer_load_q(P, WI, un, qf, wq);
    for (int rs = 0; rs < REP_SEL; ++rs) {
        const int ta = t0 + 2 * w, tb2 = ta + 1;
        unsigned* mra = MASK + (size_t)(rowbase + ta) * 64; unsigned* mrb = mra + 64;
        const int nva = ta - 32 * lane + 1, nvb = nva + 1;
        const unsigned valid_a = nva >= 32 ? 0xffffffffu : (nva <= 0 ? 0u : ((1u << nva) - 1u));
        const unsigned valid_b = nvb >= 32 ? 0xffffffffu : (nvb <= 0 ? 0u : ((1u << nvb) - 1u));
        if (ta < 256) { mra[lane] = valid_a; mrb[lane] = valid_b; continue; }
        unsigned ua[32], ub[32];
        { const LAS float* sra = sc + (2 * w) * SCP + 33 * lane; const LAS float* srb = sra + SCP;
#pragma unroll
          for (int r = 0; r < 32; ++r) { const float va = sra[r], vb = srb[r]; ua[r] = ((valid_a >> r) & 1u) ? ord_key(va) : 0u; ub[r] = ((valid_b >> r) & 1u) ? ord_key(vb) : 0u; } }
#pragma unroll
        for (int k = 0; k < 16; ++k) {
            const unsigned a0 = ua[k], a1 = ua[k + 16]; ua[k] = __builtin_amdgcn_perm(a1, a0, 0x05040100u); ua[k + 16] = __builtin_amdgcn_perm(a1, a0, 0x07060302u);
            const unsigned b0 = ub[k], b1 = ub[k + 16]; ub[k] = __builtin_amdgcn_perm(b1, b0, 0x05040100u); ub[k + 16] = __builtin_amdgcn_perm(b1, b0, 0x07060302u); }
#pragma unroll
        for (int k = 0; k < 32; ++k) if (!(k & 8)) {
            const unsigned a0 = ua[k], a1 = ua[k + 8]; ua[k] = __builtin_amdgcn_perm(a1, a0, 0x06020400u); ua[k + 8] = __builtin_amdgcn_perm(a1, a0, 0x07030501u);
            const unsigned b0 = ub[k], b1 = ub[k + 8]; ub[k] = __builtin_amdgcn_perm(b1, b0, 0x06020400u); ub[k + 8] = __builtin_amdgcn_perm(b1, b0, 0x07030501u); }
#pragma unroll
        for (int si = 2; si < 5; ++si) { const int sft = 16 >> si;
            const unsigned msk = si == 2 ? 0x0f0f0f0fu : (si == 3 ? 0x33333333u : 0x55555555u);
#pragma unroll
            for (int k = 0; k < 32; ++k) if (!(k & sft)) {
                const unsigned a0 = ua[k], a1 = ua[k + sft]; ua[k] = (a0 & msk) | ((a1 << sft) & ~msk); ua[k + sft] = ((a0 >> sft) & msk) | (a1 & ~msk);
                const unsigned b0 = ub[k], b1 = ub[k + sft]; ub[k] = (b0 & msk) | ((b1 << sft) & ~msk); ub[k + sft] = ((b0 >> sft) & msk) | (b1 & ~msk); } }
        unsigned alive_a = valid_a, sel_a = 0u, alive_b = valid_b, sel_b = 0u; int need_a = 256, need_b = 256; bool run_a = true, run_b = true;
#pragma unroll
        for (int j = 31; j >= 0; --j) {
            const unsigned ones_a = alive_a & ua[j], ones_b = alive_b & ub[j];
            int v = (int)((unsigned)__popc(ones_a) | ((unsigned)__popc(ones_b) << 16));
            v += __builtin_amdgcn_update_dpp(0, v, 0xB1, 0xF, 0xF, false);
            v += __builtin_amdgcn_update_dpp(0, v, 0x4E, 0xF, 0xF, false);
            v += __builtin_amdgcn_update_dpp(0, v, 0x141, 0xF, 0xF, false);
            v += __builtin_amdgcn_update_dpp(0, v, 0x140, 0xF, 0xF, false);
            const unsigned tot = (unsigned)(__builtin_amdgcn_readlane(v, 0) + __builtin_amdgcn_readlane(v, 16) + __builtin_amdgcn_readlane(v, 32) + __builtin_amdgcn_readlane(v, 48));
            const int ca = (int)(tot & 0xffffu), cb = (int)(tot >> 16);
            if (run_a) { if (ca >= need_a) { alive_a = ones_a; if (ca == need_a) { sel_a |= ones_a; need_a = 0; run_a = false; } }
                         else { need_a -= ca; sel_a |= ones_a; alive_a &= ~ua[j]; } }
            if (run_b) { if (cb >= need_b) { alive_b = ones_b; if (cb == need_b) { sel_b |= ones_b; need_b = 0; run_b = false; } }
                         else { need_b -= cb; sel_b |= ones_b; alive_b &= ~ub[j]; } }
            if (!run_a && !run_b) break;
        }
        if (need_a > 0) {
            const int cnt = __popc(alive_a); int inc = cnt;
#pragma unroll
            for (int d = 1; d < 64; d <<= 1) { const int o = __shfl_up(inc, d); if (lane >= d) inc += o; }
            int k = need_a - (inc - cnt); k = k < 0 ? 0 : (k > cnt ? cnt : k);
            unsigned m = alive_a;
            for (int i = 0; i < k; ++i) { const unsigned low = m & (0u - m); sel_a |= low; m ^= low; }
        }
        if (need_b > 0) {
            const int cnt = __popc(alive_b); int inc = cnt;
#pragma unroll
            for (int d = 1; d < 64; d <<= 1) { const int o = __shfl_up(inc, d); if (lane >= d) inc += o; }
            int k = need_b - (inc - cnt); k = k < 0 ? 0 : (k > cnt ? cnt : k);
            unsigned m = alive_b;
            for (int i = 0; i < k; ++i) { const unsigned low = m & (0u - m); sel_b |= low; m ^= low; }
        }
        mra[lane] = sel_a; mrb[lane] = sel_b;
        (void)tb2;
    }
    __syncthreads();
}

__device__ __forceinline__ float half_max(float m) { auto rr = __builtin_amdgcn_permlane32_swap(__float_as_uint(m), __float_as_uint(m), false, false); return __builtin_fmaxf(__uint_as_float(rr[0]), __uint_as_float(rr[1])); }
__device__ __forceinline__ float half_sum(float m) { auto rr = __builtin_amdgcn_permlane32_swap(__float_as_uint(m), __float_as_uint(m), false, false); return __uint_as_float(rr[0]) + __uint_as_float(rr[1]); }
__device__ __forceinline__ int crow(int r, int hi) { return (r & 3) + 8 * (r >> 2) + 4 * hi; }
template <int DQK, int DV, int MODE, int STRIP = 0>
__device__ __forceinline__ void attn_unit(LAS unsigned char* lds, const bf16* Qb, int qpitch, const bf16* Kb, int kpitch, const bf16* VTb, int skv,
                                          const unsigned* maskb, const bf16* Zb, bf16* Ob, int q0) {
    constexpr int TK = 128, KP = DQK + 8, VP = TK + 8;
    LAS bf16* Ks = (LAS bf16*)lds; LAS bf16* Vs = Ks + TK * KP;
    constexpr int CPR = DQK / 8;
    constexpr int NCK = TK * CPR, NCV = DV * (TK / 8);
    constexpr int RK = (NCK + 511) / 512, RV = (NCV + 511) / 512;
    constexpr int NKS = DQK / 16, NMT = DV / 32;
    int tid_ = threadIdx.x; asm volatile("" : "+v"(tid_));
    const int tid = tid_, lane = tid & 63, w = __builtin_amdgcn_readfirstlane(tid >> 6), r = lane & 31, hh = lane >> 5;
    const int NT = MODE == 0 ? skv / TK : (q0 + 256) / TK;
    const int qlo = q0 + 32 * w;
    bf16x8 qf[NKS];
    { const bf16* qrow = Qb + (size_t)(qlo + r) * qpitch + 8 * hh;
#pragma unroll
      for (int ks = 0; ks < NKS; ++ks) qf[ks] = *(const bf16x8*)(qrow + 16 * ks); }
    f32x16 o[NMT];
#pragma unroll
    for (int mt = 0; mt < NMT; ++mt)
#pragma unroll
        for (int i = 0; i < 16; ++i) o[mt][i] = 0.f;
    float m_run = NEGF, l_run = 0.f;
    v4u kreg[RK], vreg[RV];
#define ATT_PREFETCH(tile_) do { \
        _Pragma("unroll") for (int i_ = 0; i_ < RK; ++i_) { const int c_ = tid + 512 * i_; if (c_ < NCK) { const int row_ = c_ / CPR, cc_ = c_ % CPR; kreg[i_] = *(const v4u*)(Kb + (size_t)(TK * (tile_) + row_) * kpitch + 8 * cc_); } } \
        _Pragma("unroll") for (int i_ = 0; i_ < RV; ++i_) { const int c_ = tid + 512 * i_; if (c_ < NCV) { const int d_ = c_ >> 4, cc_ = c_ & 15; vreg[i_] = *(const v4u*)(VTb + (size_t)d_ * skv + TK * (tile_) + 8 * cc_); } } } while (0)
    if (STRIP != 2) ATT_PREFETCH(0);
    for (int tile = 0; tile < NT; ++tile) {
        __syncthreads();
        if (STRIP != 2) {
#pragma unroll
        for (int i = 0; i < RK; ++i) { const int c = tid + 512 * i; if (c < NCK) { const int row = c / CPR, cc = c % CPR; *(LAS v4u*)(Ks + row * KP + 8 * cc) = kreg[i]; } }
#pragma unroll
        for (int i = 0; i < RV; ++i) { const int c = tid + 512 * i; if (c < NCV) { const int d = c >> 4, cc = c & 15; *(LAS v4u*)(Vs + d * VP + 8 * cc) = vreg[i]; } }
        }
        __syncthreads();
        if (STRIP != 2 && tile + 1 < NT) ATT_PREFETCH(tile + 1);
        __builtin_amdgcn_sched_barrier(0);
        if (STRIP == 1) continue;
#pragma unroll 1
        for (int sub = 0; sub < 2; ++sub) {
        const int t64 = 2 * tile + sub;
        if (MODE != 0 && 64 * t64 > qlo + 31) continue;
        const LAS bf16* Kc = Ks + 64 * sub * KP; const LAS bf16* Vc = Vs + 64 * sub;
        unsigned mw0 = 0u, mw1 = 0u;
        if (MODE == 2) { const v2u mm = *(const v2u*)(maskb + (size_t)(qlo + r) * 64 + 2 * t64); mw0 = mm.x >> (4 * hh); mw1 = mm.y >> (4 * hh); }
        f32x16 s0, s1;
#pragma unroll
        for (int i = 0; i < 16; ++i) { s0[i] = 0.f; s1[i] = 0.f; }
#pragma unroll
        for (int ks = 0; ks < NKS; ++ks) {
            const bf16x8 a0 = *(const LAS bf16x8*)(Kc + r * KP + 16 * ks + 8 * hh);
            const bf16x8 a1 = *(const LAS bf16x8*)(Kc + (32 + r) * KP + 16 * ks + 8 * hh);
            s0 = __builtin_amdgcn_mfma_f32_32x32x16_bf16(a0, qf[ks], s0, 0, 0, 0);
            s1 = __builtin_amdgcn_mfma_f32_32x32x16_bf16(a1, qf[ks], s1, 0, 0, 0);
        }
        if (MODE == 1) {
            if (64 * t64 + 63 > qlo) { const int qg = qlo + r;
#pragma unroll
                for (int i = 0; i < 16; ++i) { const int key = 64 * t64 + crow(i, hh); if (key > qg) s0[i] = NEGF; if (key + 32 > qg) s1[i] = NEGF; } }
        }
        if (MODE == 2) {
#pragma unroll
            for (int i = 0; i < 16; ++i) { const int bit = (i & 3) + 8 * (i >> 2); if (!((mw0 >> bit) & 1u)) s0[i] = NEGF; if (!((mw1 >> bit) & 1u)) s1[i] = NEGF; }
        }
        float mx = s0[0];
#pragma unroll
        for (int i = 1; i < 16; ++i) mx = __builtin_fmaxf(mx, s0[i]);
#pragma unroll
        for (int i = 0; i < 16; ++i) mx = __builtin_fmaxf(mx, s1[i]);
        mx = half_max(mx);
        const float m_new = __builtin_fmaxf(m_run, mx);
        const float alpha = __builtin_amdgcn_exp2f(m_run - m_new);
        m_run = m_new;
        float ls = 0.f;
#pragma unroll
        for (int i = 0; i < 16; ++i) { s0[i] = __builtin_amdgcn_exp2f(s0[i] - m_new); s1[i] = __builtin_amdgcn_exp2f(s1[i] - m_new); ls += s0[i] + s1[i]; }
        l_run = l_run * alpha + ls;
#pragma unroll
        for (int mt = 0; mt < NMT; ++mt)
#pragma unroll
            for (int i = 0; i < 16; ++i) o[mt][i] *= alpha;
        v4u pf[2][2];
#pragma unroll
        for (int s = 0; s < 2; ++s) {
            pf[0][s] = (v4u){pk2(s0[8 * s], s0[8 * s + 1]), pk2(s0[8 * s + 2], s0[8 * s + 3]), pk2(s0[8 * s + 4], s0[8 * s + 5]), pk2(s0[8 * s + 6], s0[8 * s + 7])};
            pf[1][s] = (v4u){pk2(s1[8 * s], s1[8 * s + 1]), pk2(s1[8 * s + 2], s1[8 * s + 3]), pk2(s1[8 * s + 4], s1[8 * s + 5]), pk2(s1[8 * s + 6], s1[8 * s + 7])};
        }
#pragma unroll
        for (int mt = 0; mt < NMT; ++mt)
#pragma unroll
            for (int p = 0; p < 2; ++p)
#pragma unroll
                for (int s = 0; s < 2; ++s) {
                    const LAS bf16* vp = Vc + (32 * mt + r) * VP + 32 * p + 16 * s + 4 * hh;
                    const s16x4 lo = *(const LAS s16x4*)(vp), hi = *(const LAS s16x4*)(vp + 8);
                    const bf16x8 a = (bf16x8){lo[0], lo[1], lo[2], lo[3], hi[0], hi[1], hi[2], hi[3]};
                    o[mt] = __builtin_amdgcn_mfma_f32_32x32x16_bf16(a, __builtin_bit_cast(bf16x8, pf[p][s]), o[mt], 0, 0, 0);
                }
        }
    }
#undef ATT_PREFETCH
    const float l_tot = half_sum(l_run);
    const float inv = 1.0f / l_tot;
    const size_t row = (size_t)(qlo + r);
#pragma unroll
    for (int mt = 0; mt < NMT; ++mt)
#pragma unroll
        for (int g4 = 0; g4 < 4; ++g4) {
            const int d = 32 * mt + 8 * g4 + 4 * hh;
            float ov[4];
#pragma unroll
            for (int i = 0; i < 4; ++i) ov[i] = o[mt][4 * g4 + i] * inv;
            if (Zb) { const v2u zw = *(const v2u*)(Zb + row * PP + d); const float z[4] = {bflo(zw.x), bfhi(zw.x), bflo(zw.y), bfhi(zw.y)};
#pragma unroll
                for (int i = 0; i < 4; ++i) ov[i] *= z[i] * __builtin_amdgcn_rcpf(1.0f + __expf(-z[i])); }
            v2u ow; ow.x = pk2(ov[0], ov[1]); ow.y = pk2(ov[2], ov[3]);
            *(v2u*)(Ob + row * PP + d) = ow;
        }
}

template <int DQK, int MODE>
__device__ __forceinline__ void attn_unit_pipe(LAS unsigned char* lds, const bf16* Qb, int qpitch, const bf16* Kb, int kpitch, const bf16* VTb, int skv,
                                               const unsigned* maskb, bf16* Ob, int q0) {
    constexpr int DV = 64, KP = DQK + 8, VP = 72, BUFE = 64 * KP + DV * VP;
    constexpr int CPR = DQK / 8, NCK = 64 * CPR, NCV = DV * 8, RK = (NCK + 511) / 512, RV = (NCV + 511) / 512, NKS = DQK / 16, NMT = DV / 32;
    static_assert(NCV == 512 && (NCK == 512 || NCK == 768), "staging map");
    int tid_ = threadIdx.x; asm volatile("" : "+v"(tid_));
    const int tid = tid_, lane = tid & 63, w = __builtin_amdgcn_readfirstlane(tid >> 6), r = lane & 31, hh = lane >> 5;
    const int NT = (q0 + 256) / 64;
    const int qlo = q0 + 32 * w;
    const int NTw = ((qlo + 31) >> 6) + 1;
    int krow[RK], kcc[RK];
#pragma unroll
    for (int i = 0; i < RK; ++i) { int c = tid + 512 * i; if (c >= NCK) c -= 256; krow[i] = c / CPR; kcc[i] = c % CPR; }
    const int vd = tid >> 3, vcc = tid & 7;
    bf16x8 qf[NKS];
    { const bf16* qrow = Qb + (size_t)(qlo + r) * qpitch + 8 * hh;
#pragma unroll
      for (int ks = 0; ks < NKS; ++ks) qf[ks] = *(const bf16x8*)(qrow + 16 * ks); }
    f32x16 o[NMT];
#pragma unroll
    for (int mt = 0; mt < NMT; ++mt)
#pragma unroll
        for (int i = 0; i < 16; ++i) o[mt][i] = 0.f;
    float m_run = NEGF, l_run = 0.f, alpha = 1.f;
    v4u kreg[2][RK], vreg[2][RV]; v2u mset[2];
    const unsigned* mrowp = MODE == 2 ? maskb + (size_t)(qlo + r) * 64 : nullptr;
#define PL_LOAD(S_, tile_) do { const int tl_ = (tile_) < NT ? (tile_) : NT - 1; \
        if (MODE == 2) { const int mt_ = (tile_) >= 2 ? ((tile_) - 2 < 32 ? (tile_) - 2 : 31) : 0; mset[S_] = *(const v2u*)(mrowp + 2 * mt_); }     \
        _Pragma("unroll") for (int i_ = 0; i_ < RK; ++i_) kreg[S_][i_] = *(const v4u*)(Kb + (size_t)(64 * tl_ + krow[i_]) * kpitch + 8 * kcc[i_]); \
        vreg[S_][0] = *(const v4u*)(VTb + (size_t)vd * skv + 64 * tl_ + 8 * vcc); } while (0)
#define PL_STAGE(S_, buf_) do { LAS bf16* Kd_ = (LAS bf16*)lds + (buf_) * BUFE; LAS bf16* Vd_ = Kd_ + 64 * KP; \
        _Pragma("unroll") for (int i_ = 0; i_ < RK; ++i_) *(LAS v4u*)(Kd_ + krow[i_] * KP + 8 * kcc[i_]) = kreg[S_][i_]; \
        *(LAS v4u*)(Vd_ + vd * VP + 8 * vcc) = vreg[S_][0]; } while (0)
#define PL_QK(t_, D0_, D1_) do { const LAS bf16* Kc_ = (const LAS bf16*)lds + ((t_) & 3) * BUFE; \
        _Pragma("unroll") for (int i_ = 0; i_ < 16; ++i_) { D0_[i_] = 0.f; D1_[i_] = 0.f; } \
        _Pragma("unroll") for (int ks_ = 0; ks_ < NKS; ++ks_) { \
            const bf16x8 a0_ = *(const LAS bf16x8*)(Kc_ + r * KP + 16 * ks_ + 8 * hh); const bf16x8 a1_ = *(const LAS bf16x8*)(Kc_ + (32 + r) * KP + 16 * ks_ + 8 * hh); \
            D0_ = __builtin_amdgcn_mfma_f32_32x32x16_bf16(a0_, qf[ks_], D0_, 0, 0, 0); D1_ = __builtin_amdgcn_mfma_f32_32x32x16_bf16(a1_, qf[ks_], D1_, 0, 0, 0); } } while (0)
#define PL_PV(t_) do { const LAS bf16* Vc_ = (const LAS bf16*)lds + ((t_) & 3) * BUFE + 64 * KP; \
        _Pragma("unroll") for (int mt_ = 0; mt_ < NMT; ++mt_) _Pragma("unroll") for (int i_ = 0; i_ < 16; ++i_) o[mt_][i_] *= alpha; \
        _Pragma("unroll") for (int mt_ = 0; mt_ < NMT; ++mt_) _Pragma("unroll") for (int p_ = 0; p_ < 2; ++p_) _Pragma("unroll") for (int s_ = 0; s_ < 2; ++s_) { \
            const LAS bf16* vp_ = Vc_ + (32 * mt_ + r) * VP + 32 * p_ + 16 * s_ + 4 * hh; \
            const s16x4 lo_ = *(const LAS s16x4*)(vp_), hi_ = *(const LAS s16x4*)(vp_ + 8); \
            const bf16x8 a_ = (bf16x8){lo_[0], lo_[1], lo_[2], lo_[3], hi_[0], hi_[1], hi_[2], hi_[3]}; \
            o[mt_] = __builtin_amdgcn_mfma_f32_32x32x16_bf16(a_, __builtin_bit_cast(bf16x8, pf[p_][s_]), o[mt_], 0, 0, 0); } } while (0)
#define PL_SOFTMAX(t_, C0_, C1_, MK_, CAUSAL_) do { \
        if (MODE == 2) { const unsigned w0_ = (MK_).x >> (4 * hh), w1_ = (MK_).y >> (4 * hh); \
            _Pragma("unroll") for (int i_ = 0; i_ < 16; ++i_) { const int bit_ = (i_ & 3) + 8 * (i_ >> 2); if (!((w0_ >> bit_) & 1u)) C0_[i_] = NEGF; if (!((w1_ >> bit_) & 1u)) C1_[i_] = NEGF; } } \
        if (CAUSAL_) { const int qg_ = qlo + r; \
            _Pragma("unroll") for (int i_ = 0; i_ < 16; ++i_) { const int key_ = 64 * (t_) + crow(i_, hh); if (key_ > qg_) C0_[i_] = NEGF; if (key_ + 32 > qg_) C1_[i_] = NEGF; } } \
        float mx_ = C0_[0]; \
        _Pragma("unroll") for (int i_ = 1; i_ < 16; ++i_) mx_ = __builtin_fmaxf(mx_, C0_[i_]); \
        _Pragma("unroll") for (int i_ = 0; i_ < 16; ++i_) mx_ = __builtin_fmaxf(mx_, C1_[i_]); \
        mx_ = half_max(mx_); \
        const float mn_ = __builtin_fmaxf(m_run, mx_); alpha = __builtin_amdgcn_exp2f(m_run - mn_); m_run = mn_; \
        float ls_ = 0.f; \
        _Pragma("unroll") for (int i_ = 0; i_ < 16; ++i_) { C0_[i_] = __builtin_amdgcn_exp2f(C0_[i_] - mn_); C1_[i_] = __builtin_amdgcn_exp2f(C1_[i_] - mn_); ls_ += C0_[i_] + C1_[i_]; } \
        l_run = l_run * alpha + ls_; \
        _Pragma("unroll") for (int s_ = 0; s_ < 2; ++s_) { \
            pf[0][s_] = (v4u){pk2(C0_[8 * s_], C0_[8 * s_ + 1]), pk2(C0_[8 * s_ + 2], C0_[8 * s_ + 3]), pk2(C0_[8 * s_ + 4], C0_[8 * s_ + 5]), pk2(C0_[8 * s_ + 6], C0_[8 * s_ + 7])}; \
            pf[1][s_] = (v4u){pk2(C1_[8 * s_], C1_[8 * s_ + 1]), pk2(C1_[8 * s_ + 2], C1_[8 * s_ + 3]), pk2(C1_[8 * s_ + 4], C1_[8 * s_ + 5]), pk2(C1_[8 * s_ + 6], C1_[8 * s_ + 7])}; } } while (0)
#define PL_IO(t_, S_) do { PL_STAGE(S_, ((t_) + 2) & 3); PL_LOAD(S_, (t_) + 4); } while (0)
#define PL_STEADY(t_, S_) do { const v2u mk_ = mset[S_]; PL_IO(t_, S_); if (MODE == 2) { asm volatile("" :: "v"(mk_.x), "v"(mk_.y)); } \
        PL_QK((t_) + 1, n0, n1); PL_PV((t_) - 1); PL_SOFTMAX(t_, c0, c1, mk_, false); c0 = n0; c1 = n1; __syncthreads(); } while (0)
#define PL_TAIL(t_, S_) do { const v2u mk_ = mset[S_]; PL_IO(t_, S_); if ((t_) >= 1) PL_PV((t_) - 1); PL_SOFTMAX(t_, c0, c1, mk_, MODE == 1); PL_PV(t_); __syncthreads(); } while (0)
    f32x16 c0, c1, n0, n1; v4u pf[2][2];
    PL_LOAD(0, 0); PL_LOAD(1, 1);
    PL_STAGE(0, 0); PL_STAGE(1, 1);
    PL_LOAD(0, 2); PL_LOAD(1, 3);
    __syncthreads();
    PL_QK(0, c0, c1);
    int t = 0;
    if (NTw >= 2) {
        { const v2u mk_ = mset[0]; PL_IO(0, 0); PL_QK(1, n0, n1); PL_SOFTMAX(0, c0, c1, mk_, false); c0 = n0; c1 = n1; __syncthreads(); }
        for (t = 1; t + 1 < NTw; ) {
            PL_STEADY(t, 1); ++t;
            if (t + 1 < NTw) { PL_STEADY(t, 0); ++t; }
        }
    }
    if (t & 1) PL_TAIL(t, 1); else PL_TAIL(t, 0);
    for (++t; t < NT; ++t) { if (t & 1) PL_IO(t, 1); else PL_IO(t, 0); __syncthreads(); }
#undef PL_LOAD
#undef PL_STAGE
#undef PL_QK
#undef PL_PV
#undef PL_SOFTMAX
#undef PL_IO
#undef PL_STEADY
#undef PL_TAIL
    const float l_tot = half_sum(l_run);
    const float inv = 1.0f / l_tot;
    const size_t row = (size_t)(qlo + r);
#pragma unroll
    for (int mt = 0; mt < NMT; ++mt)
#pragma unroll
        for (int k2 = 0; k2 < 2; ++k2) {
            const int ga = 2 * k2, gb = 2 * k2 + 1;
            const unsigned a0 = pk2(o[mt][4 * ga] * inv, o[mt][4 * ga + 1] * inv), a1 = pk2(o[mt][4 * ga + 2] * inv, o[mt][4 * ga + 3] * inv);
            const unsigned b0 = pk2(o[mt][4 * gb] * inv, o[mt][4 * gb + 1] * inv), b1 = pk2(o[mt][4 * gb + 2] * inv, o[mt][4 * gb + 3] * inv);
            const auto s0 = __builtin_amdgcn_permlane32_swap(a0, b0, false, false);
            const auto s1 = __builtin_amdgcn_permlane32_swap(a1, b1, false, false);
            *(v4u*)(Ob + row * PP + 32 * mt + 16 * k2 + 8 * hh) = (v4u){s0[0], s1[0], s0[1], s1[1]};
        }
}

__device__ __forceinline__ void attn_unit_mem(LAS unsigned char* lds, const bf16* Qb, const float* gqm, const bf16* Kb, const bf16* VTb, const bf16* Zb, bf16* Ob, int q0) {
    constexpr int DQK = 128, KP = DQK + 8, VP = MEML + 8, NKS = DQK / 16, NMT = 4;
    LAS bf16* Ks = (LAS bf16*)lds; LAS bf16* Vs = Ks + MEML * KP;
    int tid_ = threadIdx.x; asm volatile("" : "+v"(tid_));
    const int tid = tid_, lane = tid & 63, w = __builtin_amdgcn_readfirstlane(tid >> 6), r = lane & 31, hh = lane >> 5;
    { v4u kk[8], vv[8];
#pragma unroll
      for (int i = 0; i < 8; ++i) { const int c = tid + 512 * i; kk[i] = *(const v4u*)(Kb + (size_t)(c >> 4) * 1024 + 8 * (c & 15)); vv[i] = *(const v4u*)(VTb + (size_t)(c >> 5) * MEML + 8 * (c & 31)); }
#pragma unroll
      for (int i = 0; i < 8; ++i) { const int c = tid + 512 * i; *(LAS v4u*)(Ks + (c >> 4) * KP + 8 * (c & 15)) = kk[i]; *(LAS v4u*)(Vs + (c >> 5) * VP + 8 * (c & 31)) = vv[i]; } }
    __syncthreads();
#pragma unroll 1
    for (int qb = 0; qb < 2; ++qb) {
        const int qlo = q0 + 256 * qb + 32 * w;
        bf16x8 qf[NKS];
        { const bf16* qrow = Qb + (size_t)(qlo + r) * PP + 8 * hh;
#pragma unroll
          for (int ks = 0; ks < NKS; ++ks) qf[ks] = *(const bf16x8*)(qrow + 16 * ks);
          float ss = 0.f;
#pragma unroll
          for (int ks = 0; ks < NKS; ++ks) { const v4u w = __builtin_bit_cast(v4u, qf[ks]); float v[8]; UNPACK8(w, v);
#pragma unroll
              for (int j = 0; j < 8; ++j) ss += v[j] * v[j]; }
          const float rs = __builtin_amdgcn_rsqf(half_sum(ss) * (1.f / 128.f) + EPS) * SCALE_M;
#pragma unroll
          for (int ks = 0; ks < NKS; ++ks) { const v4u w = __builtin_bit_cast(v4u, qf[ks]); float v[8]; UNPACK8(w, v);
              const f32x4 g0 = *(const f32x4*)(gqm + 16 * ks + 8 * hh), g1 = *(const f32x4*)(gqm + 16 * ks + 8 * hh + 4);
              v[0] *= rs * g0[0]; v[1] *= rs * g0[1]; v[2] *= rs * g0[2]; v[3] *= rs * g0[3]; v[4] *= rs * g1[0]; v[5] *= rs * g1[1]; v[6] *= rs * g1[2]; v[7] *= rs * g1[3];
              const v4u p = PACK8(v); qf[ks] = __builtin_bit_cast(bf16x8, p); } }
        f32x16 o[NMT];
#pragma unroll
        for (int mt = 0; mt < NMT; ++mt)
#pragma unroll
            for (int i = 0; i < 16; ++i) o[mt][i] = 0.f;
        float m_run = NEGF, l_run = 0.f;
#pragma unroll 1
        for (int sub = 0; sub < MEML / 64; ++sub) {
            const LAS bf16* Kc = Ks + 64 * sub * KP; const LAS bf16* Vc = Vs + 64 * sub;
            f32x16 s0, s1;
#pragma unroll
            for (int i = 0; i < 16; ++i) { s0[i] = 0.f; s1[i] = 0.f; }
#pragma unroll
            for (int ks = 0; ks < NKS; ++ks) {
                const bf16x8 a0 = *(const LAS bf16x8*)(Kc + r * KP + 16 * ks + 8 * hh);
                const bf16x8 a1 = *(const LAS bf16x8*)(Kc + (32 + r) * KP + 16 * ks + 8 * hh);
                s0 = __builtin_amdgcn_mfma_f32_32x32x16_bf16(a0, qf[ks], s0, 0, 0, 0);
                s1 = __builtin_amdgcn_mfma_f32_32x32x16_bf16(a1, qf[ks], s1, 0, 0, 0);
            }
            float mx = s0[0];
#pragma unroll
            for (int i = 1; i < 16; ++i) mx = __builtin_fmaxf(mx, s0[i]);
#pragma unroll
            for (int i = 0; i < 16; ++i) mx = __builtin_fmaxf(mx, s1[i]);
            mx = half_max(mx);
            const float m_new = __builtin_fmaxf(m_run, mx);
            const float alpha = __builtin_amdgcn_exp2f(m_run - m_new);
            m_run = m_new;
            float ls = 0.f;
#pragma unroll
            for (int i = 0; i < 16; ++i) { s0[i] = __builtin_amdgcn_exp2f(s0[i] - m_new); s1[i] = __builtin_amdgcn_exp2f(s1[i] - m_new); ls += s0[i] + s1[i]; }
            l_run = l_run * alpha + ls;
#pragma unroll
            for (int mt = 0; mt < NMT; ++mt)
#pragma unroll
                for (int i = 0; i < 16; ++i) o[mt][i] *= alpha;
            v4u pf[2][2];
#pragma unroll
            for (int s = 0; s < 2; ++s) {
                pf[0][s] = (v4u){pk2(s0[8 * s], s0[8 * s + 1]), pk2(s0[8 * s + 2], s0[8 * s + 3]), pk2(s0[8 * s + 4], s0[8 * s + 5]), pk2(s0[8 * s + 6], s0[8 * s + 7])};
                pf[1][s] = (v4u){pk2(s1[8 * s], s1[8 * s + 1]), pk2(s1[8 * s + 2], s1[8 * s + 3]), pk2(s1[8 * s + 4], s1[8 * s + 5]), pk2(s1[8 * s + 6], s1[8 * s + 7])};
            }
#pragma unroll
            for (int mt = 0; mt < NMT; ++mt)
#pragma unroll
                for (int p = 0; p < 2; ++p)
#pragma unroll
                    for (int s = 0; s < 2; ++s) {
                        const LAS bf16* vp = Vc + (32 * mt + r) * VP + 32 * p + 16 * s + 4 * hh;
                        const s16x4 lo = *(const LAS s16x4*)(vp), hi = *(const LAS s16x4*)(vp + 8);
                        const bf16x8 a = (bf16x8){lo[0], lo[1], lo[2], lo[3], hi[0], hi[1], hi[2], hi[3]};
                        o[mt] = __builtin_amdgcn_mfma_f32_32x32x16_bf16(a, __builtin_bit_cast(bf16x8, pf[p][s]), o[mt], 0, 0, 0);
                    }
        }
        const float inv = 1.0f / half_sum(l_run);
        const size_t row = (size_t)(qlo + r);
#pragma unroll
        for (int mt = 0; mt < NMT; ++mt)
#pragma unroll
            for (int g4 = 0; g4 < 4; ++g4) {
                const int d = 32 * mt + 8 * g4 + 4 * hh;
                const v2u zw = *(const v2u*)(Zb + row * PP + d); const float z[4] = {bflo(zw.x), bfhi(zw.x), bflo(zw.y), bfhi(zw.y)};
                float ov[4];
#pragma unroll
                for (int i = 0; i < 4; ++i) ov[i] = o[mt][4 * g4 + i] * inv * (z[i] * __builtin_amdgcn_rcpf(1.0f + __expf(-z[i])));
                v2u ow; ow.x = pk2(ov[0], ov[1]); ow.y = pk2(ov[2], ov[3]);
                *(v2u*)(Ob + row * PP + d) = ow;
            }
    }
}

__device__ __forceinline__ bf16* gate_row(bf16* G0, bf16* G1, size_t row) { return row < 8192 ? G0 + row * 3072 : G1 + (row - 8192) * 3072; }
struct EpiZG {
    static constexpr bool PERM = true, AFTER_DRAIN = false;
    bf16* P; bf16* G0; bf16* G1;
    __device__ __forceinline__ void operator()(const pg8::f32x4 (&acc)[2][2][4][2], const pg8::Unit& u, int wr, int wc, int fr, int fq) const {
        const int row0 = u.pm * 256 + wr * 64 + fr, cl = wc * 32 + 8 * fq;
        const bool isz = u.pn < 4;
        const int ycol = (u.pn < 2 ? C_YA : C_YB) + (u.pn & 1) * 256, gcol = (u.pn - 4) * 256;
#pragma unroll
        for (int ai = 0; ai < 2; ++ai)
#pragma unroll
            for (int m = 0; m < 4; ++m) { const size_t row = (size_t)(row0 + ai * 128 + m * 16);
#pragma unroll
                for (int bj = 0; bj < 2; ++bj) {
                    const pg8::f32x4 v0 = acc[ai][bj][m][0], v1 = acc[ai][bj][m][1];
                    float rr[8] = {v0[0], v0[1], v0[2], v0[3], v1[0], v1[1], v1[2], v1[3]};
                    if (isz) { bf16* dst = P + row * PP + ycol + cl + bj * 128; const v4u old = *(const v4u*)dst; float yv[8]; UNPACK8(old, yv);
#pragma unroll
                        for (int e = 0; e < 8; ++e) rr[e] = yv[e] * (rr[e] * __builtin_amdgcn_rcpf(1.0f + __expf(-rr[e])));
                        *(v4u*)dst = PACK8(rr); }
                    else { bf16* dst = gate_row(G0, G1, row) + gcol + cl + bj * 128;
#pragma unroll
                        for (int e = 0; e < 8; ++e) rr[e] = __builtin_amdgcn_rcpf(1.0f + __expf(-rr[e]));
                        *(v4u*)dst = PACK8(rr); } } }
    }
};
struct EpiStoreVT {
    static constexpr bool PERM = true, AFTER_DRAIN = false;
    bf16* O; int ldc; bf16* VT;
    int vbeg, vend, hshift, voff, DV, sshift;
    __device__ __forceinline__ void operator()(const pg8::f32x4 (&acc)[2][2][4][2], const pg8::Unit& u, int wr, int wc, int fr, int fq) const {
        const int row0 = u.pm * 256 + wr * 64 + fr, col0 = u.pn * 256 + wc * 32 + 8 * fq;
        const int H = (vend - vbeg) >> hshift, S = 1 << sshift;
        bool isv[2]; long voffs[2];
#pragma unroll
        for (int bj = 0; bj < 2; ++bj) { const int col = col0 + bj * 128, cr = col - vbeg, within = cr & ((1 << hshift) - 1);
            isv[bj] = col >= vbeg && col < vend && within >= voff;
            voffs[bj] = ((long)((cr >> hshift) * DV + within - voff)) << sshift; }
#pragma unroll
        for (int ai = 0; ai < 2; ++ai)
#pragma unroll
            for (int m = 0; m < 4; ++m) { const int row = row0 + ai * 128 + m * 16;
                const int b = row >> sshift, sp = row & (S - 1);
#pragma unroll
                for (int bj = 0; bj < 2; ++bj) {
                    const pg8::f32x4 v0 = acc[ai][bj][m][0], v1 = acc[ai][bj][m][1];
                    const unsigned w0 = pk2(v0[0], v0[1]), w1 = pk2(v0[2], v0[3]), w2 = pk2(v1[0], v1[1]), w3 = pk2(v1[2], v1[3]);
                    if (!isv[bj]) *(v4u*)(O + (size_t)row * ldc + col0 + bj * 128) = (v4u){w0, w1, w2, w3};
                    else { bf16* dst = VT + (((long)(b * H * DV)) << sshift) + voffs[bj] + sp;
                        dst[0] = (bf16)(w0 & 0xffffu); dst[(size_t)S] = (bf16)(w0 >> 16); dst[(size_t)2 * S] = (bf16)(w1 & 0xffffu); dst[(size_t)3 * S] = (bf16)(w1 >> 16);
                        dst[(size_t)4 * S] = (bf16)(w2 & 0xffffu); dst[(size_t)5 * S] = (bf16)(w2 >> 16); dst[(size_t)6 * S] = (bf16)(w3 & 0xffffu); dst[(size_t)7 * S] = (bf16)(w3 >> 16); } }
                asm volatile("" ::: "memory"); }
    }
};
struct MergeOrder {
    pg8::StaticOrder so;
    __device__ __forceinline__ bool next(int i, pg8::Unit& u) const { pg8::Unit b; if (!so.next(i / 3, b)) return false; u.pm = b.pm; u.pn = (i % 3) * 4 + b.pn; return true; }
    __device__ __forceinline__ void a_ready(const pg8::Unit&) const {}
    __device__ __forceinline__ void done(const pg8::Unit&) const {}
};
struct EpiMerge {
    static constexpr bool PERM = true, AFTER_DRAIN = false;
    bf16* Mg; bf16* G0; bf16* G1;
    __device__ __forceinline__ void operator()(const pg8::f32x4 (&acc)[2][2][4][2], const pg8::Unit& u, int wr, int wc, int fr, int fq) const {
        const int nbr = u.pn >> 2;
        const int row0 = u.pm * 256 + wr * 64 + fr, col0 = (u.pn & 3) * 256 + wc * 32 + 8 * fq;
#pragma unroll
        for (int ai = 0; ai < 2; ++ai)
#pragma unroll
            for (int m = 0; m < 4; ++m) { const size_t row = (size_t)(row0 + ai * 128 + m * 16);
#pragma unroll
                for (int bj = 0; bj < 2; ++bj) { const int col = col0 + bj * 128;
                    const v4u gwd = *(const v4u*)(gate_row(G0, G1, row) + nbr * 1024 + col);
                    float gl[8]; UNPACK8(gwd, gl);
                    const pg8::f32x4 v0 = acc[ai][bj][m][0], v1 = acc[ai][bj][m][1];
                    float rr[8] = {v0[0], v0[1], v0[2], v0[3], v1[0], v1[1], v1[2], v1[3]};
#pragma unroll
                    for (int e = 0; e < 8; ++e) rr[e] *= gl[e];
                    bf16* dst = Mg + row * 1024 + col;
                    if (nbr > 0) { const v4u old = *(const v4u*)dst; float ol[8]; UNPACK8(old, ol);
#pragma unroll
                        for (int e = 0; e < 8; ++e) rr[e] += ol[e]; }
                    *(v4u*)dst = PACK8(rr); } }
    }
};
struct EpiOut {
    static constexpr bool PERM = true, AFTER_DRAIN = false;
    const float* X; float* Out;
    __device__ __forceinline__ void operator()(const pg8::f32x4 (&acc)[2][2][4][2], const pg8::Unit& u, int wr, int wc, int fr, int fq) const {
        const int row0 = u.pm * 256 + wr * 64 + fr, col0 = u.pn * 256 + wc * 32 + 8 * fq;
#pragma unroll
        for (int ai = 0; ai < 2; ++ai)
#pragma unroll
            for (int m = 0; m < 4; ++m) { const size_t row = (size_t)(row0 + ai * 128 + m * 16);
#pragma unroll
                for (int bj = 0; bj < 2; ++bj) { const size_t p = row * 1024 + col0 + bj * 128;
                    const f32x4 x0 = __builtin_nontemporal_load((const f32x4*)(X + p)), x1 = __builtin_nontemporal_load((const f32x4*)(X + p + 4));
                    const pg8::f32x4 a0 = acc[ai][bj][m][0], a1 = acc[ai][bj][m][1];
                    __builtin_nontemporal_store((f32x4){x0[0] + a0[0], x0[1] + a0[1], x0[2] + a0[2], x0[3] + a0[3]}, (f32x4*)(Out + p));
                    __builtin_nontemporal_store((f32x4){x1[0] + a1[0], x1[1] + a1[1], x1[2] + a1[2], x1[3] + a1[3]}, (f32x4*)(Out + p + 4)); } }
    }
};

#define XB_TMO      128
#define XB_XCNT(j)  (256  + 64 * (j))
#define XB_XSUB(j)  (1280 + 64 * (j))
#define XB_XGEN(j)  (2304 + 64 * (j))
#define XB_TOP      3328
#define XB_TOPGEN   3392
#define XCD_BAR_WORDS 3456
#define XB_SPIN_CAP (1u << 18)

__device__ __forceinline__ unsigned xb_ld(unsigned* p)              { return __hip_atomic_load(p, __ATOMIC_RELAXED, __HIP_MEMORY_SCOPE_AGENT); }
__device__ __forceinline__ unsigned xb_add(unsigned* p, unsigned v) { return __hip_atomic_fetch_add(p, v, __ATOMIC_RELAXED, __HIP_MEMORY_SCOPE_AGENT); }
__device__ __forceinline__ unsigned xb_xcc_id() { return (unsigned)__builtin_amdgcn_s_getreg((3 << 11) | 20) & 0xFu; }
#define XB_SPIN(cond, bar) do { unsigned _sp = 0; while (cond) { __builtin_amdgcn_s_sleep(1); \
    if ((++_sp & 255u) == 0u) { if (xb_ld(&(bar)[XB_TMO])) break; if (_sp > XB_SPIN_CAP) { atomicAdd(&(bar)[XB_TMO], 1u); break; } } } } while (0)

struct XcdBarrier {
    unsigned* bar; unsigned x;
    volatile LAS unsigned* st;
};

__device__ __forceinline__ XcdBarrier xcd_barrier_post(unsigned* bar, volatile LAS unsigned* st) {
    XcdBarrier b; b.bar = bar; b.x = xb_xcc_id(); b.st = st;
    if (threadIdx.x == 0) (void)xb_add(&bar[XB_XCNT(b.x)], 1u);
    return b;
}
__device__ __forceinline__ void xcd_barrier_complete(unsigned* bar, unsigned x, unsigned& nloc, unsigned& nx) {
    const unsigned G = gridDim.x * gridDim.y * gridDim.z;
    unsigned sum, cnt, mine, sp = 0u;
    for (;;) {
        sum = 0u; cnt = 0u; mine = 0u;
#pragma unroll
        for (unsigned j = 0; j < 16; ++j) { const unsigned c = xb_ld(&bar[XB_XCNT(j)]); sum += c; cnt += (c > 0u) ? 1u : 0u; mine = (j == x) ? c : mine; }
        if (sum == G) break;
        __builtin_amdgcn_s_sleep(1);
        if ((++sp & 255u) == 0u) { if (xb_ld(&bar[XB_TMO])) break; if (sp > XB_SPIN_CAP) { atomicAdd(&bar[XB_TMO], 1u); break; } }
    }
    nloc = mine > 0u ? mine : 1u; nx = cnt > 0u ? cnt : 1u;
}

__device__ __forceinline__ void xcd_barrier(const XcdBarrier& b) {
    asm volatile("s_waitcnt vmcnt(0)" ::: "memory");
    __syncthreads();
    if (threadIdx.x == 0) {
        unsigned* bar = b.bar;
        __builtin_amdgcn_s_waitcnt(0);
        unsigned nloc = b.st[0], nx = b.st[1];
        if (nloc == 0u) { xcd_barrier_complete(bar, b.x, nloc, nx); b.st[0] = nloc; b.st[1] = nx; }
        const unsigned old = xb_add(&bar[XB_XSUB(b.x)], 1u);
        const unsigned gen = old / nloc;
        if (old + 1u == (gen + 1u) * nloc) {
            __builtin_amdgcn_fence(__ATOMIC_RELEASE, "agent");
            asm volatile("s_waitcnt vmcnt(0)" ::: "memory");
            const unsigned og = xb_add(&bar[XB_TOP], 1u);
            const unsigned tg = og / nx;
            if (og + 1u == (tg + 1u) * nx) xb_add(&bar[XB_TOPGEN], 1u);
            else XB_SPIN(xb_ld(&bar[XB_TOPGEN]) == tg, bar);
            __builtin_amdgcn_fence(__ATOMIC_ACQUIRE, "agent");
            xb_add(&bar[XB_XGEN(b.x)], 1u);
            asm volatile("s_waitcnt vmcnt(0)" ::: "memory");
        } else {
            XB_SPIN(xb_ld(&bar[XB_XGEN(b.x)]) == gen, bar);
            __builtin_amdgcn_fence(__ATOMIC_ACQUIRE, "agent");
            asm volatile("s_waitcnt vmcnt(0)" ::: "memory");
        }
    }
    __syncthreads();
}

template <int DQK, int DV, int MODE>
__device__ __forceinline__ void att_call(bool strip, LAS unsigned char* lds, const bf16* Qb, int qpitch, const bf16* Kb, int kpitch, const bf16* VTb, int skv, const unsigned* maskb, const bf16* Zb, bf16* Ob, int q0) {
    if (ATT_STRIP != 0 && strip) attn_unit<DQK, DV, MODE, ATT_STRIP>(lds, Qb, qpitch, Kb, kpitch, VTb, skv, maskb, Zb, Ob, q0);
    else attn_unit<DQK, DV, MODE, 0>(lds, Qb, qpitch, Kb, kpitch, VTb, skv, maskb, Zb, Ob, q0);
}
struct Args { const float* in[19]; const int* pos; float* out; unsigned char* ws; };
typedef const __attribute__((address_space(4))) Args* kargs_t;
#define PHASE_BEGIN \
    kargs_t ap_ = (kargs_t)__builtin_amdgcn_kernarg_segment_ptr(); asm volatile("" : "+s"(ap_)); \
    int tid = threadIdx.x; asm volatile("" : "+v"(tid)); \
    const int lane = tid & 63, wave = __builtin_amdgcn_readfirstlane(tid >> 6), G = gridDim.x, NGW = G * 8, gw = blockIdx.x * 8 + wave; \
    unsigned char* const ws = ap_->ws; unsigned char* const dob = (unsigned char*)ap_->out; const int* const pos = ap_->pos; float* const outp = ap_->out; unsigned* const ctl = (unsigned*)(ws + WS_CTL); \
    const float* const x = ap_->in[0]; const float* const mem = ap_->in[1]; \
    const float* const g_norm = ap_->in[3]; const float* const w_in = ap_->in[4]; const float* const g_qn_a = ap_->in[5]; const float* const g_kn_a = ap_->in[6]; \
    const float* const g_cq = ap_->in[7]; const float* const g_ckv = ap_->in[8]; const float* const w_uq = ap_->in[9]; const float* const w_ukv = ap_->in[10]; \
    const float* const g_qn_b = ap_->in[11]; const float* const g_kn_b = ap_->in[12]; const float* const g_mem = ap_->in[13]; const float* const w_mem_kv = ap_->in[14]; \
    const float* const g_qn_m = ap_->in[15]; const float* const g_kn_m = ap_->in[16]; const float* const w_branch = ap_->in[17]; const float* const w_out = ap_->in[18]; \
    bf16* const WinT = (bf16*)(ws + WS_WIN); bf16* const WuqT = (bf16*)(ws + WS_WUQ); bf16* const WukvT = (bf16*)(ws + WS_WUKV); bf16* const WmemT = (bf16*)(ws + WS_WMEM); \
    bf16* const WbrT = (bf16*)(ws + WS_WBR); bf16* const WoutT = (bf16*)(ws + WS_WOUT); \
    float* const ropeA = (float*)(ws + WS_ROPEA); float* const ropeB = (float*)(ws + WS_ROPEB); \
    bf16* const MN = (bf16*)(ws + WS_MN); bf16* const KVM = (bf16*)(ws + WS_KVM); bf16* const VTM = (bf16*)(ws + WS_VTM); \
    float* const WI = (float*)(ws + WS_WI); unsigned* const MASK = (unsigned*)(ws + WS_MASK); \
    bf16* const VTA = (bf16*)(dob + DO_VTA); bf16* const VTB = (bf16*)(dob + DO_VTB); bf16* const KB = (bf16*)(dob + DO_KB); \
    bf16* const Hh = (bf16*)(ws + WS_H); bf16* const MG = (bf16*)(ws + WS_H); bf16* const QB = (bf16*)(ws + WS_QB); \
    bf16* const KVB = (bf16*)(ws + WS_KVB); bf16* const GT0 = (bf16*)(dob + DO_G0); bf16* const GT1 = (bf16*)(ws + WS_G1); bf16* const P = (bf16*)(ws + WS_P); \
    (void)lane; (void)NGW; (void)gw; (void)ctl; \
    (void)pos; (void)outp; (void)x; (void)mem; (void)g_norm; (void)w_in; (void)g_qn_a; (void)g_kn_a; (void)g_cq; (void)g_ckv; (void)w_uq; (void)w_ukv; (void)g_qn_b; (void)g_kn_b; (void)g_mem; (void)w_mem_kv; \
    (void)g_qn_m; (void)g_kn_m; (void)w_branch; (void)w_out; (void)WinT; (void)WuqT; (void)WukvT; (void)WmemT; (void)WbrT; (void)WoutT; (void)ropeA; (void)ropeB; (void)MN; (void)KVM; (void)VTM; (void)WI; (void)MASK; \
    (void)VTA; (void)VTB; (void)Hh; (void)KB; (void)QB; (void)KVB; (void)MG; (void)GT0; (void)GT1; (void)P
#define GRID_BARRIER() do { kargs_t bp_ = (kargs_t)__builtin_amdgcn_kernarg_segment_ptr(); asm volatile("" : "+s"(bp_)); \
    XcdBarrier b_; b_.bar = (unsigned*)(bp_->ws + WS_CTL) + 4096; b_.x = xb_xcc_id(); b_.st = (volatile LAS unsigned*)(lds + LDS_BYTES - 32); xcd_barrier(b_); } while (0)

__global__ void __launch_bounds__(512, 2) fwd_kernel(Args a) {
    extern __shared__ __attribute__((aligned(16))) unsigned char lds_raw[];
    LAS unsigned char* const lds = (LAS unsigned char*)lds_raw;
    volatile LAS int* const slot = (volatile LAS int*)(lds + LDS_SLOT);
    if (threadIdx.x < 16) ((LAS unsigned*)(lds + LDS_BYTES - 64))[threadIdx.x] = 0u;
    __syncthreads();
    (void)xcd_barrier_post((unsigned*)(a.ws + WS_CTL) + 4096, (volatile LAS unsigned*)(lds + LDS_BYTES - 32));

    for (int rep = 0; rep < REP_P0; ++rep) { PHASE_BEGIN;
        LAS float* scr = (LAS float*)(lds + wave * 16384);
        constexpr int I_IN = 16 * (NP / 32), I_UQ = 6 * 24, I_UKV = 4 * 32, I_MEM = 16 * 32, I_BR = 8 * 32, I_OUT = 16 * 32;
        constexpr int NITEMS = I_IN + I_UQ + I_UKV + I_MEM + 3 * I_BR + I_OUT;
        for (int it = gw; it < NITEMS; it += NGW) {
            int r = it;
            if (r < I_IN) { transpose_item<true>(w_in, 1024, DIN, NP, WinT, scr, r, lane); continue; } r -= I_IN;
            if (r < I_UQ) { transpose_item<false>(w_uq, 384, 768, 768, WuqT, scr, r, lane); continue; } r -= I_UQ;
            if (r < I_UKV) { transpose_item<false>(w_ukv, 256, 1024, 1024, WukvT, scr, r, lane); continue; } r -= I_UKV;
            if (r < I_MEM) { transpose_item<false>(w_mem_kv, 1024, 1024, 1024, WmemT, scr, r, lane); continue; } r -= I_MEM;
            if (r < 3 * I_BR) { const int nb = r / I_BR; transpose_item<false>(w_branch + (size_t)nb * 512 * 1024, 512, 1024, 1024, WbrT + (size_t)nb * 1024 * 512, scr, r % I_BR, lane); continue; } r -= 3 * I_BR;
            transpose_item<false>(w_out, 1024, 1024, 1024, WoutT, scr, r, lane);
        }
        for (int idx = blockIdx.x * 512 + tid; idx < TT * 24; idx += G * 512) {
            const int t = idx / 24, i = idx % 24; const float pf = (float)pos[t];
            if (i < 8) { const float ang = pf * INVA[i]; ropeA[t * 16 + i] = cosf(ang); ropeA[t * 16 + 8 + i] = sinf(ang); }
            else { const int j = i - 8; const float ang = pf * INVB[j]; ropeB[t * 32 + j] = cosf(ang); ropeB[t * 32 + 16 + j] = sinf(ang); }
        }
        for (int m = gw; m < NB * MEML; m += NGW) rms_row_1024(mem + (size_t)m * DM, g_mem, MN + (size_t)m * DM, lane);
        for (int rp = 0; rp < REP_PH; ++rp)
        for (int m = gw; m < TT; m += NGW) rms_row_1024(x + (size_t)m * DM, g_norm, Hh + (size_t)m * DM, lane);
    }
    GRID_BARRIER();
    for (int es = 0; es < EXTRA_SYNCS; ++es) GRID_BARRIER();

    for (int rep = 0; rep < REP_G1; ++rep) { PHASE_BEGIN;
        pg8::Gemm g{Hh, WinT, TT, PP, 1024, 1024, nullptr, nullptr, nullptr, 0}; pg8::StaticOrder S; S.init(TT, PP, G, (int)blockIdx.x);
        EpiStoreVT E{P, PP, VTA, C_VA, C_VA + 512, 6, 0, 64, 11};
        pg8::gemm_phase<EpiStoreVT, pg8::StaticOrder, true, true>(lds, g, S, E);
    }
    { PHASE_BEGIN;
        pg8::Gemm g{MN, WmemT, NB * MEML, 1024, 1024, 1024, nullptr, nullptr, nullptr, 0}; pg8::StaticOrder S; S.init(NB * MEML, 1024, G, (int)((blockIdx.x + 64) % G));
        EpiStoreVT E{KVM, 1024, VTM, 512, 1024, 7, 0, 128, 8};
        pg8::gemm_phase<EpiStoreVT, pg8::StaticOrder, true, true>(lds, g, S, E);
    }
    GRID_BARRIER();
    { PHASE_BEGIN;
        float ga[8], gk[8], gq[8], gc[8], gm[8];
#pragma unroll
        for (int j = 0; j < 8; ++j) { ga[j] = g_qn_a[8 * (lane & 7) + j]; gk[j] = g_kn_a[8 * (lane & 7) + j]; gm[j] = g_qn_m[8 * (lane & 15) + j]; gq[j] = lane < 48 ? g_cq[8 * lane + j] : 0.f; gc[j] = lane < 32 ? g_ckv[8 * lane + j] : 0.f; }
        for (int dp = 0; dp < DUMMY_POST1; ++dp)
            for (int m = gw; m < TT; m += NGW)
                post1_row(P + (size_t)m * PP, QB + (size_t)(m & 1023) * 4096, ropeA + (size_t)m * 16, ga, gk, gq, gc, gm, (float*)KVB + (size_t)m * 8, lane);
        for (int m = gw; m < TT; m += NGW)
            post1_row(P + (size_t)m * PP, P + (size_t)m * PP, ropeA + (size_t)m * 16, ga, gk, gq, gc, gm, WI + (size_t)m * 8, lane);
        for (int m = gw; m < NB * MEML; m += NGW) km_row(KVM + (size_t)m * 1024, g_kn_m, lane);
    }
    GRID_BARRIER();
    for (int rep = 0; rep < REP_G2; ++rep) { PHASE_BEGIN;
        pg8::Gemm g{P + C_CQ, WuqT, TT, 768, 384, PP, nullptr, nullptr, nullptr, 0}; pg8::StaticOrder S; S.init(TT, 768, G, (int)blockIdx.x);
        pg8::EpiBf16<0> E{QB, 768, nullptr, 0, 0, 1.f};
        pg8::gemm_phase<pg8::EpiBf16<0>, pg8::StaticOrder, true, true>(lds, g, S, E);
    }
    for (int rep = 0; rep < REP_G2; ++rep) { PHASE_BEGIN;
        pg8::Gemm g{P + C_CKV, WukvT, TT, 1024, 256, PP, nullptr, nullptr, nullptr, 0}; pg8::StaticOrder S; S.init(TT, 1024, G, (int)((blockIdx.x + 192) % G));
        pg8::EpiBf16<0> E{KVB, 1024, nullptr, 0, 0, 1.f};
        pg8::gemm_phase<pg8::EpiBf16<0>, pg8::StaticOrder, true, true>(lds, g, S, E);
    }
    for (int rep = 0; rep < REP_IDX; ++rep) { if (rep > 0) GRID_BARRIER();
        PHASE_BEGIN;
        unsigned* const q_idx = ctl + 64 * (0 + 4 * rep);
        int u = next_unit(q_idx, slot);
        bf16x8 qf[8][2]; float wq[8];
        if (u < NB * 128) indexer_load_q(P, WI, u, qf, wq);
        while (u < NB * 128) {
            int tk = 0; if (tid == 0) tk = (int)atomicAdd(q_idx, 1u);
            const int tb = 127 - (u >> 3), bb = u & 7;
            int un;
            indexer_unit((LAS float*)lds, P, WI, MASK, bb, tb, qf, wq, tk, slot, NB * 128, un);
            u = un;
        }
    }
    GRID_BARRIER();
    { PHASE_BEGIN;
        LAS float* scr = (LAS float*)(lds + wave * 8192);
        float gqv[12], gkv[12];
#pragma unroll
        for (int e = 0; e < 12; ++e) { gqv[e] = g_qn_b[12 * (lane & 7) + e]; gkv[e] = g_kn_b[12 * (lane & 7) + e]; }
        for (int dp = 0; dp < DUMMY_POST2; ++dp)
            for (int m = gw; m < TT; m += NGW)
                post2_row(QB + (size_t)m * 768, (bf16*)MASK + (size_t)(m & 1023) * 768, KVB + (size_t)m * 1024, P + (size_t)m * PP, (bf16*)MASK + (size_t)(1024 + (m & 1023)) * 768, ropeB + (size_t)m * 32, gqv, gkv, scr, lane);
        for (int m = gw; m < TT; m += NGW)
            post2_row(QB + (size_t)m * 768, QB + (size_t)m * 768, KVB + (size_t)m * 1024, P + (size_t)m * PP, KB + (size_t)m * 768, ropeB + (size_t)m * 32, gqv, gkv, scr, lane);
        transpose_v(KVB, 1024, 64, 128, 8, 64, SEQ, NB, VTB, gw, NGW, lane);
    }
    GRID_BARRIER();
    for (int rep = 0; rep < REP_ATT; ++rep) { if (rep > 0) GRID_BARRIER();
        PHASE_BEGIN;
        unsigned* const q_att = ctl + 64 * (1 + 4 * rep);
        for (;;) {
            const int u = next_unit(q_att, slot);
            if (u >= 1152) break;
            if (u < 704 || u >= 832) {
                const int uu = u < 704 ? u : u - 128, cls = uu >> 6, bh = uu & 63, bb = bh >> 3, h = bh & 7;
                const bool isA = (0x52a7u >> cls) & 1u; const int qb = (int)((0x11232435467567ull >> (4 * cls)) & 15ull);
                const size_t r0 = (size_t)bb * SEQ;
                if (!isA) attn_unit_pipe<96, 1>(lds, QB + r0 * 768 + h * 96, 768, KB + r0 * 768 + h * 96, 768, VTB + (size_t)((bb * 8 + h) * 64) * SEQ, SEQ, nullptr,
                                                   P + r0 * PP + C_YB + h * 64, qb * 256);
                else attn_unit_pipe<64, 2>(lds, P + r0 * PP + C_QA + h * 64, PP, P + r0 * PP + C_KA + h * 64, PP, VTA + (size_t)((bb * 8 + h) * 64) * SEQ, SEQ, MASK + r0 * 64,
                                           P + r0 * PP + C_YA + h * 64, qb * 256);
            } else {
                const int v = u - 704, hq = v & 3, bh = v >> 2, bb = bh >> 2, h = bh & 3;
                const size_t r0 = (size_t)bb * SEQ;
                attn_unit_mem(lds, P + r0 * PP + C_QM + h * 128, g_qn_m, KVM + (size_t)bb * MEML * 1024 + h * 128, VTM + (size_t)((bb * 4 + h) * 128) * MEML,
                              P + r0 * PP + C_ZM + h * 128, P + r0 * PP + C_YM + h * 128, hq * 512);
            }
        }
    }
    GRID_BARRIER();
    for (int rep = 0; rep < 1; ++rep) { PHASE_BEGIN;
        pg8::Gemm g{Hh, WinT + (size_t)PP * 1024, TT, NZG, 1024, 1024, nullptr, nullptr, nullptr, 0}; pg8::StaticOrder S; S.init(TT, NZG, G, (int)blockIdx.x);
        EpiZG E{P, GT0, GT1};
        pg8::gemm_phase<EpiZG, pg8::StaticOrder, true, true>(lds, g, S, E);
    }
    GRID_BARRIER();
    for (int rep = 0; rep < REP_G4; ++rep) { PHASE_BEGIN;
        pg8::Gemm g{P + C_YA, WbrT, TT, 3072, 512, PP, P + C_YA, P + C_YB, P + C_YM, 4};
        MergeOrder S; S.so.init(TT, 1024, G, (int)blockIdx.x);
        EpiMerge E{MG, GT0, GT1};
        pg8::gemm_phase<EpiMerge, MergeOrder, true, true>(lds, g, S, E);
    }
    GRID_BARRIER();
    for (int rep = 0; rep < REP_G5; ++rep) { PHASE_BEGIN;
        pg8::Gemm g{MG, WoutT, TT, 1024, 1024, 1024, nullptr, nullptr, nullptr, 0}; pg8::StaticOrder S; S.init(TT, 1024, G, (int)blockIdx.x);
        EpiOut E{x, outp};
        pg8::gemm_phase<EpiOut, pg8::StaticOrder, true, true>(lds, g, S, E);
    }
}

extern "C" void kernel_launch(void* const* d_in, const int* in_sizes, int n_in, void* d_out, int out_size, void* d_ws, size_t ws_size, hipStream_t stream) {
    static int grid = 0;
    if (grid == 0) {
        if (n_in != 19 || out_size != TT * DM || ws_size < WS_END) { fprintf(stderr, "kernel_launch: unexpected problem (n_in %d, out %d, ws %zu); nothing launched\n", n_in, out_size, ws_size); grid = -1; return; }
        int dev = 0, cus = 0, per_cu = 0;
        if (hipGetDevice(&dev) != hipSuccess || hipDeviceGetAttribute(&cus, hipDeviceAttributeMultiprocessorCount, dev) != hipSuccess) { grid = -1; return; }
        if (hipFuncSetAttribute((const void*)fwd_kernel, hipFuncAttributeMaxDynamicSharedMemorySize, LDS_BYTES) != hipSuccess) { fprintf(stderr, "kernel_launch: hipFuncSetAttribute failed\n"); grid = -1; return; }
        if (hipOccupancyMaxActiveBlocksPerMultiprocessor(&per_cu, (const void*)fwd_kernel, 512, LDS_BYTES) != hipSuccess || per_cu < 1) { fprintf(stderr, "kernel_launch: occupancy query reports %d blocks per CU\n", per_cu); (void)hipGetLastError(); grid = -1; return; }
        grid = cus;
    }
    if (grid < 0) return;
    (void)hipMemsetAsync((char*)d_ws + WS_CTL, 0, 65536, stream);
    Args a{};
    for (int i = 0; i < 19; ++i) a.in[i] = (const float*)d_in[i];
    a.pos = (const int*)d_in[2]; a.out = (float*)d_out; a.ws = (unsigned char*)d_ws;
    hipLaunchKernelGGL(fwd_kernel, dim3(grid), dim3(512), LDS_BYTES, stream, a);
    const hipError_t e = hipPeekAtLastError();
    if (e != hipSuccess) fprintf(stderr, "kernel_launch: launch failed: %s (grid %d)\n", hipGetErrorString(e), grid);
}
```

```cpp
#include <hip/hip_runtime.h>
#include <cstdio>
#include <cstdint>
namespace pg8 {
#define PG8_LAS __attribute__((address_space(3)))
typedef unsigned short bf16_t;
typedef short bf16x8 __attribute__((ext_vector_type(8)));
typedef float f32x4 __attribute__((ext_vector_type(4)));
typedef unsigned u32x4 __attribute__((ext_vector_type(4)));
constexpr int BM = 256, BK = 64, HALF = 128, HTB = HALF * BK * 2  , STAGE_BYTES = 8 * HTB, NXCD = 8, WGM = 8;

__host__ __device__ __forceinline__ int lds_byte(int r, int c) { const int st = (r >> 4) * 2 + (c >> 5), rr = r & 15, cc = c & 31, ob = rr * 64 + cc * 2; return st * 1024 + (ob ^ (((ob >> 9) & 1) << 5)); }
__host__ __device__ __forceinline__ void stage_rc(int b, int& R, int& C) { const int st = b / 1024, sb = b % 1024, swz = sb ^ (((sb >> 9) & 1) << 5); R = (st >> 1) * 16 + swz / 64; C = (st & 1) * 32 + (swz % 64) / 2; }
__host__ __device__ __forceinline__ int perm32(int rho) { const int n = rho >> 4, i = rho & 15; return 8 * (i >> 2) + 4 * n + (i & 3); }

struct Unit { int pm, pn; };
struct Gemm { const bf16_t* A; const bf16_t* Bt; int M, N, K, lda; const bf16_t* Ag0; const bf16_t* Ag1; const bf16_t* Ag2; int ngrp; };
__device__ __forceinline__ const char* a_base(const Gemm& g, const Unit& u) { if (!g.ngrp) return (const char*)g.A; const int j = u.pn / g.ngrp; return (const char*)(j == 0 ? g.Ag0 : (j == 1 ? g.Ag1 : g.Ag2)); }

struct StaticOrder {
    int nM, nN, nwg, G, c;
    __host__ __device__ void init(int M, int N, int G_, int c_) { nM = M / BM; nN = N / BM; nwg = nM * nN; G = G_; c = c_; }
    __host__ __device__ bool next(int i, Unit& u) const {
        const long L = (long)i * G + c; if (L >= nwg) return false;
        int wgid = (int)L; { const int q = nwg / NXCD, r = nwg % NXCD, xcd = wgid % NXCD, off = wgid / NXCD; wgid = (xcd < r ? xcd * (q + 1) : r * (q + 1) + (xcd - r) * q) + off; }
        const int nig = WGM * nN, gid = wgid / nig, fm = gid * WGM, gsz = (nM - fm) < WGM ? (nM - fm) : WGM;
        u.pm = fm + ((wgid % nig) % gsz); u.pn = (wgid % nig) / gsz; return true;
    }
    __device__ __forceinline__ void a_ready(const Unit&) const {}
    __device__ __forceinline__ void done(const Unit&) const {}
};

__device__ __forceinline__ unsigned cvt_pk_bf16(float lo, float hi) { unsigned r; asm volatile("v_cvt_pk_bf16_f32 %0, %1, %2" : "=v"(r) : "v"(lo), "v"(hi)); return r; }
typedef float f32x2 __attribute__((ext_vector_type(2)));
__device__ __forceinline__ f32x2 gelu_pk(f32x2 v) {
    const f32x2 av = __builtin_elementwise_abs(v), d = av * 0.2316418882f + 1.0f;
    f32x2 t; t.x = __builtin_amdgcn_rcpf(d.x); t.y = __builtin_amdgcn_rcpf(d.y);
    f32x2 q = t * 0.5307027145f + (-0.7265760135f); q = q * t + 0.7107068705f; q = q * t + (-0.142248368f); q = q * t + 0.127414796f; q = q * t;
    const f32x2 s = (v * v) * (-0.72134752044f);
    f32x2 e; e.x = __builtin_amdgcn_exp2f(s.x); e.y = __builtin_amdgcn_exp2f(s.y);
    const f32x2 m = v * (q * e), r = v - m;
    f32x2 o; o.x = v.x < 0.f ? m.x : r.x; o.y = v.y < 0.f ? m.y : r.y; return o;
}

template <int ACT  > struct EpiBf16 {
    static constexpr bool PERM = true, AFTER_DRAIN = false; static_assert(ACT == 0 || ACT == 1, "EpiBf16: ACT is 0 (none) or 1 (gelu_pk)");
    bf16_t* O; int ldc; const float* bias; int split_cols; size_t split_stride; float scale0;
    __device__ __forceinline__ void operator()(const f32x4 (&acc)[2][2][4][2], const Unit& u, int wr, int wc, int fr, int fq) const {
        const int row0 = u.pm * BM + wr * 64 + fr; int colt = u.pn * BM; bf16_t* base = O;
        float sc = 1.f; if (split_cols) { const int t = colt / split_cols; base += (size_t)t * split_stride; colt -= t * split_cols; if (t == 0) sc = scale0; }
        const int col0 = colt + wc * 32 + 8 * fq, bcol0 = u.pn * BM + wc * 32 + 8 * fq;
        f32x4 bv[2][2];
#pragma unroll
        for (int bj = 0; bj < 2; ++bj)
#pragma unroll
            for (int n = 0; n < 2; ++n) bv[bj][n] = bias ? *(const f32x4*)(bias + bcol0 + bj * HALF + 4 * n) : (f32x4){0.f, 0.f, 0.f, 0.f};
#pragma unroll
        for (int ai = 0; ai < 2; ++ai)
#pragma unroll
            for (int m = 0; m < 4; ++m) { bf16_t* rowp = base + (size_t)(row0 + ai * HALF + m * 16) * ldc + col0;
#pragma unroll
                for (int bj = 0; bj < 2; ++bj) { f32x4 v0 = acc[ai][bj][m][0] + bv[bj][0], v1 = acc[ai][bj][m][1] + bv[bj][1];
                    if (ACT == 1) { f32x2 a = gelu_pk((f32x2){v0[0], v0[1]}), b = gelu_pk((f32x2){v0[2], v0[3]}), c = gelu_pk((f32x2){v1[0], v1[1]}), d = gelu_pk((f32x2){v1[2], v1[3]});
                        v0 = (f32x4){a.x, a.y, b.x, b.y}; v1 = (f32x4){c.x, c.y, d.x, d.y}; }
                    v0 = v0 * sc; v1 = v1 * sc; u32x4 w; w.x = cvt_pk_bf16(v0[0], v0[1]); w.y = cvt_pk_bf16(v0[2], v0[3]); w.z = cvt_pk_bf16(v1[0], v1[1]); w.w = cvt_pk_bf16(v1[2], v1[3]);
                    *(u32x4*)(rowp + bj * HALF) = w; } }
    }
};
template <class Epi, class Sched, bool ALIGN_EPI = false, bool SP2 = false>
__device__ __forceinline__ void gemm_phase(PG8_LAS unsigned char* lds, const Gemm g, const Sched& S, const Epi& E) {
    int tid_ = threadIdx.x; asm volatile("" : "+v"(tid_));
    const int tid = tid_, wid = __builtin_amdgcn_readfirstlane(tid >> 6), lane = tid & 63, wr = wid >> 2, wc = wid & 3, fr = lane & 15, fq = lane >> 4;
    const int K = g.K, nt = K / BK;
    unsigned voffA[2], voffB[2];
#pragma unroll
    for (int i = 0; i < 2; ++i) { int R, C; stage_rc(tid * 16 + i * 8192, R, C); const int Rb = Epi::PERM ? ((R & ~31) + perm32(R & 31)) : R;
        voffA[i] = (unsigned)(R * g.lda + C) * 2u; voffB[i] = (unsigned)(Rb * K + C) * 2u; }
    const size_t kstep = (size_t)(BK * 2);
    const size_t hstepA = (size_t)HALF * g.lda * 2, hstepB = (size_t)HALF * K * 2;
    const size_t tstepA = 2 * hstepA, tstepB = 2 * hstepB;
    const unsigned ldsw = (unsigned)wid * 1024u;
    const int aoff = lds_byte(wr * 64 + fr, fq * 8), boff = lds_byte(wc * 32 + fr, fq * 8);
#define PG8_SA(b, h) (((b) * 2 + (h)) * HTB)
#define PG8_SB(b, h) ((4 + (b) * 2 + (h)) * HTB)
#define PG8_STAGE(bufoff, gbase, voff) do { _Pragma("unroll") for (int _i = 0; _i < 2; ++_i) \
        __builtin_amdgcn_global_load_lds((const unsigned*)((const char*)(gbase) + (voff)[_i]), (PG8_LAS unsigned*)(lds + (bufoff) + ldsw + _i * 8192), 16, 0, 0); } while (0)
#define PG8_LDA(dst, b, h) do { _Pragma("unroll") for (int m = 0; m < 4; ++m) _Pragma("unroll") for (int k = 0; k < 2; ++k) dst[m][k] = *(const PG8_LAS bf16x8*)(lds + PG8_SA(b, h) + aoff + m * 2048 + k * 1024); } while (0)
#define PG8_LDB(dst, b, h) do { _Pragma("unroll") for (int n = 0; n < 2; ++n) _Pragma("unroll") for (int k = 0; k < 2; ++k) dst[n][k] = *(const PG8_LAS bf16x8*)(lds + PG8_SB(b, h) + boff + n * 2048 + k * 1024); } while (0)
#define PG8_MMA(ai, bj, At, Bt) do { __builtin_amdgcn_s_setprio(1); _Pragma("unroll") for (int m = 0; m < 4; ++m) _Pragma("unroll") for (int n = 0; n < 2; ++n) _Pragma("unroll") for (int k = 0; k < 2; ++k) \
        acc[ai][bj][m][n] = __builtin_amdgcn_mfma_f32_16x16x32_bf16(Bt[n][k], At[m][k], acc[ai][bj][m][n], 0, 0, 0); __builtin_amdgcn_s_setprio(0); } while (0)
#define PG8_WAIT_V(n) asm volatile("s_waitcnt vmcnt(" #n ")" ::: "memory")
#define PG8_WAIT_L(n) asm volatile("s_waitcnt lgkmcnt(" #n ")" ::: "memory")
#define PG8_BAR __builtin_amdgcn_s_barrier()
#define PG8_SCHED __builtin_amdgcn_sched_barrier(0)
    Unit cur, nxt; int ui = 0;
    if (!S.next(0, cur)) return;
    f32x4 acc[2][2][4][2];
#pragma unroll
    for (int a = 0; a < 2; ++a)
#pragma unroll
        for (int b = 0; b < 2; ++b)
#pragma unroll
            for (int m = 0; m < 4; ++m)
#pragma unroll
                for (int n = 0; n < 2; ++n) acc[a][b][m][n] = (f32x4){0.f, 0.f, 0.f, 0.f};
    bf16x8 At[4][2], B0[2][2], B1[2][2];
    const char* cA = a_base(g, cur) + (size_t)cur.pm * tstepA; const char* cB = (const char*)g.Bt + (size_t)cur.pn * tstepB;
    S.a_ready(cur);
    if constexpr (SP2) {
        PG8_STAGE(PG8_SB(0, 0), cB, voffB); PG8_STAGE(PG8_SB(0, 1), cB + hstepB, voffB); PG8_STAGE(PG8_SA(0, 0), cA, voffA); PG8_STAGE(PG8_SA(0, 1), cA + hstepA, voffA);
        if (wr == 1) PG8_BAR;
        PG8_WAIT_V(2); PG8_BAR;
        PG8_STAGE(PG8_SB(1, 0), cB + kstep, voffB); PG8_STAGE(PG8_SA(1, 0), cA + kstep, voffA); PG8_STAGE(PG8_SB(1, 1), cB + hstepB + kstep, voffB);
        PG8_WAIT_V(6); PG8_BAR;
    } else {
        PG8_STAGE(PG8_SB(0, 0), cB, voffB); PG8_STAGE(PG8_SA(0, 0), cA, voffA); PG8_STAGE(PG8_SB(0, 1), cB + hstepB, voffB); PG8_STAGE(PG8_SA(0, 1), cA + hstepA, voffA);
        if (wr == 1) PG8_BAR;
        PG8_WAIT_V(4); PG8_BAR;
        PG8_STAGE(PG8_SB(1, 0), cB + kstep, voffB); PG8_STAGE(PG8_SA(1, 0), cA + kstep, voffA); PG8_STAGE(PG8_SB(1, 1), cB + hstepB + kstep, voffB);
        PG8_WAIT_V(6); PG8_BAR;
    }
    for (;;) {
        const bool has_next = S.next(ui + 1, nxt);
        const char* nA = has_next ? a_base(g, nxt) + (size_t)nxt.pm * tstepA : cA; const char* nB = has_next ? (const char*)g.Bt + (size_t)nxt.pn * tstepB : cB;
        for (int t = 0; t < nt; t += 2) {
            const bool last = (t == nt - 2);
            const char* a1 = cA + (size_t)(t + 1) * kstep;
            const char* a2 = last ? nA : cA + (size_t)(t + 2) * kstep; const char* b2 = last ? nB : cB + (size_t)(t + 2) * kstep;
            const char* a3 = a2 + kstep; const char* b3 = b2 + kstep;
            if (last && has_next) S.a_ready(nxt);
            if constexpr (SP2) {
            PG8_LDB(B0, 0, 0); PG8_LDB(B1, 0, 1); PG8_SCHED; PG8_LDA(At, 0, 0); PG8_STAGE(PG8_SA(1, 1), a1 + hstepA, voffA);
            PG8_WAIT_V(8); PG8_WAIT_L(0); PG8_BAR; PG8_MMA(0, 0, At, B0); PG8_MMA(0, 1, At, B1); PG8_BAR; PG8_SCHED;
            PG8_LDA(At, 0, 1); PG8_STAGE(PG8_SB(0, 0), b2, voffB); PG8_STAGE(PG8_SB(0, 1), b2 + hstepB, voffB); PG8_STAGE(PG8_SA(0, 0), a2, voffA);
            PG8_WAIT_V(8); PG8_WAIT_L(0); PG8_BAR; PG8_MMA(1, 0, At, B0); PG8_MMA(1, 1, At, B1); PG8_BAR; PG8_SCHED;
            PG8_LDB(B0, 1, 0); PG8_LDB(B1, 1, 1); PG8_SCHED; PG8_LDA(At, 1, 0); PG8_STAGE(PG8_SA(0, 1), a2 + hstepA, voffA);
            PG8_WAIT_V(8); PG8_WAIT_L(0); PG8_BAR; PG8_MMA(0, 0, At, B0); PG8_MMA(0, 1, At, B1); PG8_BAR; PG8_SCHED;
            PG8_LDA(At, 1, 1); PG8_STAGE(PG8_SB(1, 0), b3, voffB); PG8_STAGE(PG8_SB(1, 1), b3 + hstepB, voffB); PG8_STAGE(PG8_SA(1, 0), a3, voffA);
            PG8_WAIT_V(8); PG8_WAIT_L(0); PG8_BAR; PG8_MMA(1, 0, At, B0); PG8_MMA(1, 1, At, B1); PG8_BAR; PG8_SCHED;
            } else {
            PG8_LDB(B0, 0, 0); PG8_SCHED; PG8_LDA(At, 0, 0); PG8_STAGE(PG8_SA(1, 1), a1 + hstepA, voffA);
            PG8_WAIT_L(8); PG8_BAR; PG8_WAIT_L(0); PG8_MMA(0, 0, At, B0); PG8_BAR; PG8_SCHED;
            PG8_LDB(B1, 0, 1); PG8_STAGE(PG8_SB(0, 0), b2, voffB);
            PG8_BAR; PG8_WAIT_L(0); PG8_MMA(0, 1, At, B1); PG8_BAR;
            PG8_LDA(At, 0, 1); PG8_STAGE(PG8_SA(0, 0), a2, voffA);
            PG8_BAR; PG8_WAIT_L(0); PG8_MMA(1, 0, At, B0); PG8_BAR; PG8_SCHED;
            PG8_STAGE(PG8_SB(0, 1), b2 + hstepB, voffB);
            PG8_WAIT_V(6); PG8_BAR; PG8_MMA(1, 1, At, B1); PG8_BAR;
            PG8_LDB(B0, 1, 0); PG8_SCHED; PG8_LDA(At, 1, 0); PG8_STAGE(PG8_SA(0, 1), a2 + hstepA, voffA);
            PG8_WAIT_L(8); PG8_BAR; PG8_WAIT_L(0); PG8_MMA(0, 0, At, B0); PG8_BAR; PG8_SCHED;
            PG8_LDB(B1, 1, 1); PG8_STAGE(PG8_SB(1, 0), b3, voffB);
            PG8_BAR; PG8_WAIT_L(0); PG8_MMA(0, 1, At, B1); PG8_BAR;
            PG8_LDA(At, 1, 1); PG8_STAGE(PG8_SA(1, 0), a3, voffA);
            PG8_BAR; PG8_WAIT_L(0); PG8_MMA(1, 0, At, B0); PG8_BAR; PG8_SCHED;
            PG8_STAGE(PG8_SB(1, 1), b3 + hstepB, voffB);
            PG8_WAIT_V(6); PG8_BAR; PG8_MMA(1, 1, At, B1); PG8_BAR;
            }
        }
        if constexpr (ALIGN_EPI) { if (wr == 0) PG8_BAR; }
        if constexpr (!Epi::AFTER_DRAIN) { E(acc, cur, wr, wc, fr, fq); S.done(cur); }
        if (!has_next) break;
#pragma unroll
        for (int a = 0; a < 2; ++a)
#pragma unroll
            for (int b = 0; b < 2; ++b)
#pragma unroll
                for (int m = 0; m < 4; ++m)
#pragma unroll
                    for (int n = 0; n < 2; ++n) acc[a][b][m][n] = (f32x4){0.f, 0.f, 0.f, 0.f};
        cur = nxt; cA = nA; cB = nB; ++ui;
        if constexpr (ALIGN_EPI) { if (wr == 1) PG8_BAR; }
    }
    PG8_WAIT_V(0);
    if constexpr (!ALIGN_EPI) { if (wr == 0) PG8_BAR; }
    PG8_BAR;
    if constexpr (Epi::AFTER_DRAIN) { E.fused(acc, cur, wr, wc, fr, fq, lds, wid, lane); S.done(cur); }
#undef PG8_SA
#undef PG8_SB
#undef PG8_STAGE
#undef PG8_LDA
#undef PG8_LDB
#undef PG8_MMA
#undef PG8_WAIT_V
#undef PG8_WAIT_L
#undef PG8_BAR
#undef PG8_SCHED
}
}

#define LAS __attribute__((address_space(3)))
typedef unsigned short bf16;
typedef unsigned v4u __attribute__((ext_vector_type(4)));
typedef unsigned v2u __attribute__((ext_vector_type(2)));
typedef float f32x4 __attribute__((ext_vector_type(4)));
typedef float f32x16 __attribute__((ext_vector_type(16)));
typedef short bf16x8 __attribute__((ext_vector_type(8)));
typedef short s16x4 __attribute__((ext_vector_type(4)));
typedef float f32x2_t __attribute__((ext_vector_type(2)));
typedef __bf16 bf16x2_t __attribute__((ext_vector_type(2)));

constexpr int NB = 8, SEQ = 2048, DM = 1024, TT = NB * SEQ;
constexpr int DIN = 7912, NP = 7936;
constexpr int PP = 3840, NZG = 4096;
constexpr int MEML = 256;
constexpr float EPS = 1e-6f, NEGF = -1e30f;
constexpr int C_QA = 0, C_KA = 512, C_VA = 1024, C_QI = 1536, C_KI = 2048, C_WI = 2112, C_CQ = 2120, C_CKV = 2504, C_KR = 2760, C_QM = 2792, C_ZM = 3304;
constexpr int C_YA = C_QI, C_YB = C_CQ, C_YM = C_VA;
constexpr float SCALE_A = 0.18033688011112042f;
constexpr float SCALE_B = 0.14724444602590306f;
constexpr float SCALE_M = 0.12751743082459868f;
constexpr float SCALE_I = 0.04419417382415922f;

__constant__ float INVA[8] = {1.0f, 0.1939227432012558f, 0.03760603070259094f, 0.007292664609849453f, 0.0014142135623842478f, 0.00027424818836152554f, 5.3182957344688475e-05f, 1.0313385246263351e-05f};
__constant__ float INVB[16] = {1.0f, 0.44036659598350525f, 0.1939227432012558f, 0.08539710193872452f, 0.03760603070259094f, 0.016560440883040428f, 0.007292664609849453f, 0.0032114461064338684f, 0.0014142135623842478f, 0.0006227724370546639f, 0.00027424818836152554f, 0.00012076973507646471f, 5.3182957344688475e-05f, 2.34199997066753e-05f, 1.0313385246263351e-05f, 4.541670477919979e-06f};

constexpr size_t MiB = 1u << 20;
constexpr size_t WS_CTL = 0;
constexpr size_t WS_WIN = 1 * MiB;
constexpr size_t WS_WUQ = 17 * MiB;
constexpr size_t WS_WUKV = 18 * MiB;
constexpr size_t WS_WMEM = 19 * MiB;
constexpr size_t WS_WBR = 21 * MiB;
constexpr size_t WS_WOUT = 24 * MiB;
constexpr size_t WS_ROPEA = 26 * MiB;
constexpr size_t WS_ROPEB = 27 * MiB;
constexpr size_t WS_MN = 29 * MiB;
constexpr size_t WS_KVM = 33 * MiB;
constexpr size_t WS_VTM = 37 * MiB;
constexpr size_t WS_WI = 39 * MiB;
constexpr size_t WS_MASK = 40 * MiB;
constexpr size_t WS_H = 44 * MiB;
constexpr size_t WS_P = 76 * MiB;
constexpr size_t WS_QB = 196 * MiB;
constexpr size_t WS_KVB = 220 * MiB;
constexpr size_t WS_G1 = 196 * MiB;
constexpr size_t WS_END = 256 * MiB;
constexpr size_t DO_VTA = 0;
constexpr size_t DO_VTB = 16 * MiB;
constexpr size_t DO_KB = 32 * MiB;
constexpr size_t DO_G0 = 0;

constexpr int REP_P0 = 1, REP_PH = 1, REP_G1 = 1, REP_G2 = 1, REP_IDX = 1, REP_ATT = 1, REP_G4 = 1, REP_G5 = 1;
constexpr int REP_IDX1 = 1, REP_SEL = 1;
constexpr int ATT_STRIP = 0;
constexpr int EXTRA_SYNCS = 0, REP_TR = 1, DUMMY_POST1 = 0, DUMMY_POST2 = 0;
constexpr int LDS_BYTES = 147456;
constexpr int LDS_SLOT = LDS_BYTES - 64;

__device__ __forceinline__ unsigned pk2(float lo, float hi) { f32x2_t v = {lo, hi}; bf16x2_t b = __builtin_convertvector(v, bf16x2_t); return __builtin_bit_cast(unsigned, b); }
__device__ __forceinline__ float bflo(unsigned w) { return __uint_as_float(w << 16); }
__device__ __forceinline__ float bfhi(unsigned w) { return __uint_as_float(w & 0xffff0000u); }
__device__ __forceinline__ float bf1(bf16 b) { return __uint_as_float(((unsigned)b) << 16); }
#define UNPACK8(W_, V_) do { V_[0] = bflo((W_)[0]); V_[1] = bfhi((W_)[0]); V_[2] = bflo((W_)[1]); V_[3] = bfhi((W_)[1]); V_[4] = bflo((W_)[2]); V_[5] = bfhi((W_)[2]); V_[6] = bflo((W_)[3]); V_[7] = bfhi((W_)[3]); } while (0)
#define PACK8(V_) (v4u){pk2(V_[0], V_[1]), pk2(V_[2], V_[3]), pk2(V_[4], V_[5]), pk2(V_[6], V_[7])}
template <int CTRL> __device__ __forceinline__ float dpp_f(float v) { return __int_as_float(__builtin_amdgcn_update_dpp(0, __float_as_int(v), CTRL, 0xF, 0xF, false)); }
#define SUM8(x) do { x += dpp_f<0xB1>(x); x += dpp_f<0x4E>(x); x += dpp_f<0x141>(x); } while (0)
#define SUM16(x) do { SUM8(x); x += dpp_f<0x140>(x); } while (0)
__device__ __forceinline__ float wave_sum(float v) {
    SUM16(v);
    return __int_as_float(__builtin_amdgcn_readlane(__float_as_int(v), 0)) + __int_as_float(__builtin_amdgcn_readlane(__float_as_int(v), 16))
         + __int_as_float(__builtin_amdgcn_readlane(__float_as_int(v), 32)) + __int_as_float(__builtin_amdgcn_readlane(__float_as_int(v), 48));
}
#define LDS_WAIT() asm volatile("s_waitcnt lgkmcnt(0)" ::: "memory")

__device__ __forceinline__ int win_src(int d) {
    if (d < 2120) return d;
    if (d < 2792) return d + 512;
    if (d < 3816) return d + 1024;
    if (d < 3840) return -1;
    if (d < 4352) return d - 3840 + 2120;
    if (d < 4864) return d - 4352 + 3304;
    return d - 4864 + 4840;
}
template <bool REMAP>
__device__ __forceinline__ void transpose_item(const float* W, int K, int N, int Npad, bf16* WT, LAS float* scr, int item, int lane) {
    const int nblk = Npad / 32, kb = item / nblk, nb = item % nblk, k0 = 64 * kb, n0 = 32 * nb;
    const int n4 = 4 * (lane & 7);
    const int nn = REMAP ? win_src(n0 + n4) : n0 + n4; const bool ok = nn >= 0 && nn < N;
#pragma unroll
    for (int i = 0; i < 8; ++i) { const int kk = 8 * i + (lane >> 3);
        f32x4 v = (f32x4){0.f, 0.f, 0.f, 0.f}; if (ok) v = __builtin_nontemporal_load((const f32x4*)(W + (size_t)(k0 + kk) * N + nn));
        LAS float* d = scr + kk * 33 + n4; d[0] = v[0]; d[1] = v[1]; d[2] = v[2]; d[3] = v[3]; }
    LDS_WAIT(); asm volatile("" ::: "memory");
    const int c = lane & 7;
#pragma unroll
    for (int j = 0; j < 4; ++j) { const int n = (lane >> 3) + 8 * j; const LAS float* s = scr + (8 * c) * 33 + n;
        v4u o; o.x = pk2(s[0 * 33], s[1 * 33]); o.y = pk2(s[2 * 33], s[3 * 33]); o.z = pk2(s[4 * 33], s[5 * 33]); o.w = pk2(s[6 * 33], s[7 * 33]);
        *(v4u*)(WT + (size_t)(n0 + n) * K + k0 + 8 * c) = o; }
    LDS_WAIT(); asm volatile("" ::: "memory");
}
__device__ __forceinline__ void rms_row_1024(const float* xrow, const float* g, bf16* orow, int lane) {
    const f32x4* xr = (const f32x4*)xrow + lane; const f32x4* gr = (const f32x4*)g + lane;
    f32x4 v[4]; float s = 0.f;
#pragma unroll
    for (int j = 0; j < 4; ++j) { v[j] = __builtin_nontemporal_load(xr + 64 * j); s += (v[j].x * v[j].x + v[j].y * v[j].y) + (v[j].z * v[j].z + v[j].w * v[j].w); }
    const float rstd = __builtin_amdgcn_rsqf(wave_sum(s) * (1.f / 1024.f) + EPS);
    v2u* o8 = (v2u*)orow + lane;
#pragma unroll
    for (int j = 0; j < 4; ++j) { const f32x4 gg = gr[64 * j]; v2u w; w.x = pk2(v[j].x * rstd * gg.x, v[j].y * rstd * gg.y); w.y = pk2(v[j].z * rstd * gg.z, v[j].w * rstd * gg.w); o8[64 * j] = w; }
}

#define ROPE8(v, sub, c8, s8) do { _Pragma("unroll") for (int j_ = 0; j_ < 8; ++j_) { const float pv_ = dpp_f<0xB1>(v[j_]); \
        const float r0_ = v[j_] * c8[j_] - pv_ * s8[j_], r1_ = v[j_] * c8[j_] + pv_ * s8[j_]; v[j_] = (sub) == 0 ? r0_ : ((sub) == 1 ? r1_ : v[j_]); } } while (0)

__device__ __forceinline__ void post1_row(const bf16* Prow, bf16* Orow, const float* ra, const float (&ga)[8], const float (&gk)[8], const float (&gq)[8], const float (&gc)[8], const float (&gm)[8], float* WIrow, int lane) {
    const int sub = lane & 7;
    const v4u z4 = (v4u){0u, 0u, 0u, 0u};
    const v4u w_qa = *(const v4u*)(Prow + C_QA + 8 * lane);
    const v4u w_ka = *(const v4u*)(Prow + C_KA + 8 * lane);
    const v4u w_qi = *(const v4u*)(Prow + C_QI + 8 * lane);
    v4u w_ki = z4, w_cq = z4, w_ckv = z4; float w_wi = 0.f;
    if (lane < 8) { w_ki = *(const v4u*)(Prow + C_KI + 8 * lane); w_wi = bf1(Prow[C_WI + lane]); }
    if (lane < 48) w_cq = *(const v4u*)(Prow + C_CQ + 8 * lane);
    if (lane < 32) w_ckv = *(const v4u*)(Prow + C_CKV + 8 * lane);
    float c8[8], s8[8];
    { const f32x4 r0 = *(const f32x4*)(ra), r1 = *(const f32x4*)(ra + 4), r2 = *(const f32x4*)(ra + 8), r3 = *(const f32x4*)(ra + 12);
      c8[0] = r0[0]; c8[1] = r0[1]; c8[2] = r0[2]; c8[3] = r0[3]; c8[4] = r1[0]; c8[5] = r1[1]; c8[6] = r1[2]; c8[7] = r1[3];
      s8[0] = r2[0]; s8[1] = r2[1]; s8[2] = r2[2]; s8[3] = r2[3]; s8[4] = r3[0]; s8[5] = r3[1]; s8[6] = r3[2]; s8[7] = r3[3]; }
    { float v[8]; UNPACK8(w_qa, v); float ss = 0.f;
#pragma unroll
      for (int j = 0; j < 8; ++j) ss += v[j] * v[j];
      SUM8(ss);
      const float rstd = __builtin_amdgcn_rsqf(ss * (1.f / 64.f) + EPS);
#pragma unroll
      for (int j = 0; j < 8; ++j) v[j] = v[j] * rstd * ga[j];
      ROPE8(v, sub, c8, s8);
#pragma unroll
      for (int j = 0; j < 8; ++j) v[j] *= SCALE_A;
      *(v4u*)(Orow + C_QA + 8 * lane) = PACK8(v); }
    { float v[8]; UNPACK8(w_ka, v); float ss = 0.f;
#pragma unroll
      for (int j = 0; j < 8; ++j) ss += v[j] * v[j];
      SUM8(ss);
      const float rstd = __builtin_amdgcn_rsqf(ss * (1.f / 64.f) + EPS);
#pragma unroll
      for (int j = 0; j < 8; ++j) v[j] = v[j] * rstd * gk[j];
      ROPE8(v, sub, c8, s8);
      *(v4u*)(Orow + C_KA + 8 * lane) = PACK8(v); }
    { float v[8]; UNPACK8(w_qi, v);
      ROPE8(v, sub, c8, s8);
      *(v4u*)(Orow + C_QI + 8 * lane) = PACK8(v); }
    { float v[8]; UNPACK8(w_ki, v);
      ROPE8(v, sub, c8, s8);
      if (lane < 8) *(v4u*)(Orow + C_KI + 8 * lane) = PACK8(v); }
    if (lane < 8) WIrow[lane] = w_wi * SCALE_I;
    { float v[8]; UNPACK8(w_cq, v); float ss = 0.f;
#pragma unroll
      for (int j = 0; j < 8; ++j) ss += v[j] * v[j];
      ss = wave_sum(ss); const float rstd = __builtin_amdgcn_rsqf(ss * (1.f / 384.f) + EPS);
      if (lane < 48) {
#pragma unroll
          for (int j = 0; j < 8; ++j) v[j] = v[j] * rstd * gq[j];
          *(v4u*)(Orow + C_CQ + 8 * lane) = PACK8(v); } }
    { float v[8]; UNPACK8(w_ckv, v); float ss = 0.f;
#pragma unroll
      for (int j = 0; j < 8; ++j) ss += v[j] * v[j];
      ss = wave_sum(ss); const float rstd = __builtin_amdgcn_rsqf(ss * (1.f / 256.f) + EPS);
      if (lane < 32) {
#pragma unroll
          for (int j = 0; j < 8; ++j) v[j] = v[j] * rstd * gc[j];
          *(v4u*)(Orow + C_CKV + 8 * lane) = PACK8(v); } }
}

__device__ __forceinline__ void km_row(bf16* row, const float* gkm, int lane) {
    v4u w = *(const v4u*)(row + 8 * lane); float v[8]; UNPACK8(w, v); float ss = 0.f;
#pragma unroll
    for (int j = 0; j < 8; ++j) ss += v[j] * v[j];
    SUM16(ss);
    const float rstd = __builtin_amdgcn_rsqf(ss * (1.f / 128.f) + EPS);
#pragma unroll
    for (int j = 0; j < 8; ++j) v[j] = v[j] * rstd * gkm[8 * (lane & 15) + j];
    *(v4u*)(row + 8 * lane) = PACK8(v);
}

__device__ __forceinline__ void transpose_v(const bf16* src, int pitch, int col0, int hstride, int H, int DV, int S, int nb, bf16* dst, int gw, int NGW, int lane) {
    const int ndq = DV / 64, nsc = S / 64, ntask = nb * H * nsc * ndq;
    for (int task = gw; task < ntask; task += NGW) {
        int x = task; const int dq = x % ndq; x /= ndq; const int sc = x % nsc; x /= nsc; const int h = x % H; const int b = x / H;
        const int s = sc * 64 + lane;
        const bf16* srow = src + (size_t)(b * S + s) * pitch + col0 + h * hstride + dq * 64;
        bf16* drow = dst + ((size_t)((b * H + h) * DV + dq * 64)) * S + s;
        v4u wv[8];
#pragma unroll
        for (int c = 0; c < 8; ++c) wv[c] = *(const v4u*)(srow + 8 * c);
#pragma unroll
        for (int c = 0; c < 8; ++c) { const v4u w = wv[c];
            drow[(size_t)(8 * c + 0) * S] = (bf16)(w.x & 0xffffu); drow[(size_t)(8 * c + 1) * S] = (bf16)(w.x >> 16);
            drow[(size_t)(8 * c + 2) * S] = (bf16)(w.y & 0xffffu); drow[(size_t)(8 * c + 3) * S] = (bf16)(w.y >> 16);
            drow[(size_t)(8 * c + 4) * S] = (bf16)(w.z & 0xffffu); drow[(size_t)(8 * c + 5) * S] = (bf16)(w.z >> 16);
            drow[(size_t)(8 * c + 6) * S] = (bf16)(w.w & 0xffffu); drow[(size_t)(8 * c + 7) * S] = (bf16)(w.w >> 16); }
    }
}

__device__ __forceinline__ void post2_row(const bf16* QBrow, bf16* QOrow, const bf16* KVBrow, const bf16* Prow, bf16* KBrow, const float* rb, const float (&gqv)[12], const float (&gkv)[12], LAS float* scr, int lane) {
    const int hd = lane >> 3, d0 = 12 * (lane & 7);
    float vq[12], vk[12], cc[12], sn[12];
    { const v2u* p = (const v2u*)(QBrow + 12 * lane);
      const v2u w0 = p[0], w1 = p[1], w2 = p[2];
      bf16 kr[12];
#pragma unroll
      for (int e = 0; e < 12; ++e) { const int d = d0 + e; kr[e] = d < 64 ? KVBrow[hd * 128 + d] : Prow[C_KR + d - 64]; }
#pragma unroll
      for (int e = 0; e < 12; ++e) { const int d = d0 + e; const int i = (d - 64) & 15; cc[e] = d < 64 ? 1.f : rb[i]; sn[e] = d < 64 ? 0.f : rb[16 + i]; }
      vq[0] = bflo(w0.x); vq[1] = bfhi(w0.x); vq[2] = bflo(w0.y); vq[3] = bfhi(w0.y); vq[4] = bflo(w1.x); vq[5] = bfhi(w1.x); vq[6] = bflo(w1.y); vq[7] = bfhi(w1.y);
      vq[8] = bflo(w2.x); vq[9] = bfhi(w2.x); vq[10] = bflo(w2.y); vq[11] = bfhi(w2.y);
#pragma unroll
      for (int e = 0; e < 12; ++e) vk[e] = bf1(kr[e]); }
    float sq = 0.f, sk = 0.f;
#pragma unroll
    for (int e = 0; e < 12; ++e) { sq += vq[e] * vq[e]; sk += vk[e] * vk[e]; }
    SUM8(sq); SUM8(sk);
    const float rq = __builtin_amdgcn_rsqf(sq * (1.f / 96.f) + EPS), rk = __builtin_amdgcn_rsqf(sk * (1.f / 96.f) + EPS);
#pragma unroll
    for (int e = 0; e < 12; ++e) { vq[e] = vq[e] * rq * gqv[e]; vk[e] = vk[e] * rk * gkv[e]; scr[12 * lane + e] = vq[e]; scr[768 + 12 * lane + e] = vk[e]; }
    LDS_WAIT(); asm volatile("" ::: "memory");
    float oq[12], ok[12];
#pragma unroll
    for (int e = 0; e < 12; ++e) { const int d = d0 + e;
        if (d < 64) { oq[e] = vq[e]; ok[e] = vk[e]; }
        else { const bool first = d < 80; const int off = first ? 16 : -16; const float pq = scr[12 * lane + e + off], pk = scr[768 + 12 * lane + e + off];
               oq[e] = first ? vq[e] * cc[e] - pq * sn[e] : vq[e] * cc[e] + pq * sn[e];
               ok[e] = first ? vk[e] * cc[e] - pk * sn[e] : vk[e] * cc[e] + pk * sn[e]; }
        oq[e] *= SCALE_B; }
    LDS_WAIT(); asm volatile("" ::: "memory");
    v2u* q = (v2u*)(QOrow + 12 * lane); v2u* k = (v2u*)(KBrow + 12 * lane);
#pragma unroll
    for (int i = 0; i < 3; ++i) { v2u w; w.x = pk2(oq[4 * i], oq[4 * i + 1]); w.y = pk2(oq[4 * i + 2], oq[4 * i + 3]); q[i] = w;
                                  v2u u; u.x = pk2(ok[4 * i], ok[4 * i + 1]); u.y = pk2(ok[4 * i + 2], ok[4 * i + 3]); k[i] = u; }
}

__device__ __forceinline__ int next_unit(unsigned* ctr, volatile LAS int* slot) {
    __syncthreads();
    if (threadIdx.x == 0) *slot = (int)atomicAdd(ctr, 1u);
    __syncthreads();
    return *slot;
}

constexpr int SCP = 2112;
__device__ __forceinline__ unsigned ord_key(float v) { const unsigned b = __float_as_uint(v); return b ^ ((unsigned)((int)b >> 31) | 0x80000000u); }
__device__ __forceinline__ void indexer_load_q(const bf16* P, const float* WI, int u, bf16x8 (&qf)[8][2], float (&wq)[8]) {
    const int lane = threadIdx.x & 63, n = lane & 15, g = lane >> 4;
    const int tb = 127 - (u >> 3), bb = u & 7;
    const size_t row = (size_t)(bb * SEQ + tb * 16 + n);
    const bf16* qrow = P + row * PP + C_QI + 8 * g;
#pragma unroll
    for (int h = 0; h < 8; ++h) { qf[h][0] = *(const bf16x8*)(qrow + h * 64); qf[h][1] = *(const bf16x8*)(qrow + h * 64 + 32); wq[h] = WI[row * 8 + h]; }
}
__device__ __forceinline__ void indexer_unit(LAS float* sc, const bf16* P, const float* WI, unsigned* MASK, int bb, int tb, bf16x8 (&qf)[8][2], float (&wq)[8],
                                             int tk, volatile LAS int* slot, int nunits, int& un) {
    int tid_ = threadIdx.x; asm volatile("" : "+v"(tid_));
    const int tid = tid_, lane = tid & 63, w = __builtin_amdgcn_readfirstlane(tid >> 6);
    const int n = lane & 15, g = lane >> 4;
    const int rowbase = bb * SEQ, t0 = tb * 16;
    {
        const int ntile = tb + 1;
        const int nmine = (ntile - w + 7) >> 3;
        const int ngrp = (nmine + 3) >> 2;
        const bf16* kbase = P + (size_t)(rowbase + n) * PP + C_KI + 8 * g;
        bf16x8 kb[2][4][2];
#define IDX_LOAD(BUF, GRP) do { _Pragma("unroll") for (int j_ = 0; j_ < 4; ++j_) { const int tile_ = w + 8 * (4 * (GRP) + j_); const int tl_ = tile_ < ntile ? tile_ : 0; \
            const bf16* kr_ = kbase + (size_t)(16 * tl_) * PP; kb[BUF][j_][0] = *(const bf16x8*)(kr_); kb[BUF][j_][1] = *(const bf16x8*)(kr_ + 32); } } while (0)
#define IDX_COMP(BUF, GRP) do { _Pragma("unroll") for (int j_ = 0; j_ < 4; ++j_) { const int tile_ = w + 8 * (4 * (GRP) + j_); if (tile_ < ntile) { \
            f32x4 idx_ = (f32x4){0.f, 0.f, 0.f, 0.f}; \
            _Pragma("unroll") for (int h_ = 0; h_ < 8; ++h_) { f32x4 a_ = (f32x4){0.f, 0.f, 0.f, 0.f}; \
                a_ = __builtin_amdgcn_mfma_f32_16x16x32_bf16(kb[BUF][j_][0], qf[h_][0], a_, 0, 0, 0); \
                a_ = __builtin_amdgcn_mfma_f32_16x16x32_bf16(kb[BUF][j_][1], qf[h_][1], a_, 0, 0, 0); \
                _Pragma("unroll") for (int i_ = 0; i_ < 4; ++i_) idx_[i_] = __builtin_fmaf(wq[h_], __builtin_fmaxf(a_[i_], 0.f), idx_[i_]); } \
            { const int k0_ = 16 * tile_ + 4 * g; LAS float* d_ = sc + n * SCP + k0_ + (k0_ >> 5); d_[0] = idx_[0]; d_[1] = idx_[1]; d_[2] = idx_[2]; d_[3] = idx_[3]; } } } } while (0)
        if (ngrp > 0) IDX_LOAD(0, 0);
        for (int gp = 0; gp < ngrp; gp += 2) {
            if (gp + 1 < ngrp) IDX_LOAD(1, gp + 1);
            IDX_COMP(0, gp);
            if (gp + 1 < ngrp) { if (gp + 2 < ngrp) IDX_LOAD(0, gp + 2); IDX_COMP(1, gp + 1); }
        }
#undef IDX_LOAD
#undef IDX_COMP
    }
    if (tid == 0) *slot = tk;
    __syncthreads();
    un = *slot;
    if (un < nunits) indexer_load_q(P, WI, un, qf, wq);
    for (int rs = 0; rs < REP_SEL; ++rs) {
        const int ta = t0 + 2 * w, tb2 = ta + 1;
        unsigned* mra = MASK + (size_t)(rowbase + ta) * 64; unsigned* mrb = mra + 64;
        const int nva = ta - 32 * lane + 1, nvb = nva + 1;
        const unsigned valid_a = nva >= 32 ? 0xffffffffu : (nva <= 0 ? 0u : ((1u << nva) - 1u));
        const unsigned valid_b = nvb >= 32 ? 0xffffffffu : (nvb <= 0 ? 0u : ((1u << nvb) - 1u));
        if (ta < 256) { mra[lane] = valid_a; mrb[lane] = valid_b; continue; }
        unsigned ua[32], ub[32];
        { const LAS float* sra = sc + (2 * w) * SCP + 33 * lane; const LAS float* srb = sra + SCP;
#pragma unroll
          for (int r = 0; r < 32; ++r) { const float va = sra[r], vb = srb[r]; ua[r] = ((valid_a >> r) & 1u) ? ord_key(va) : 0u; ub[r] = ((valid_b >> r) & 1u) ? ord_key(vb) : 0u; } }
#pragma unroll
        for (int k = 0; k < 16; ++k) {
            const unsigned a0 = ua[k], a1 = ua[k + 16]; ua[k] = __builtin_amdgcn_perm(a1, a0, 0x05040100u); ua[k + 16] = __builtin_amdgcn_perm(a1, a0, 0x07060302u);
            const unsigned b0 = ub[k], b1 = ub[k + 16]; ub[k] = __builtin_amdgcn_perm(b1, b0, 0x05040100u); ub[k + 16] = __builtin_amdgcn_perm(b1, b0, 0x07060302u); }
#pragma unroll
        for (int k = 0; k < 32; ++k) if (!(k & 8)) {
            const unsigned a0 = ua[k], a1 = ua[k + 8]; ua[k] = __builtin_amdgcn_perm(a1, a0, 0x06020400u); ua[k + 8] = __builtin_amdgcn_perm(a1, a0, 0x07030501u);
            const unsigned b0 = ub[k], b1 = ub[k + 8]; ub[k] = __builtin_amdgcn_perm(b1, b0, 0x06020400u); ub[k + 8] = __builtin_amdgcn_perm(b1, b0, 0x07030501u); }
#pragma unroll
        for (int si = 2; si < 5; ++si) { const int sft = 16 >> si;
            const unsigned msk = si == 2 ? 0x0f0f0f0fu : (si == 3 ? 0x33333333u : 0x55555555u);
#pragma unroll
            for (int k = 0; k < 32; ++k) if (!(k & sft)) {
                const unsigned a0 = ua[k], a1 = ua[k + sft]; ua[k] = (a0 & msk) | ((a1 << sft) & ~msk); ua[k + sft] = ((a0 >> sft) & msk) | (a1 & ~msk);
                const unsigned b0 = ub[k], b1 = ub[k + sft]; ub[k] = (b0 & msk) | ((b1 << sft) & ~msk); ub[k + sft] = ((b0 >> sft) & msk) | (b1 & ~msk); } }
        unsigned alive_a = valid_a, sel_a = 0u, alive_b = valid_b, sel_b = 0u; int need_a = 256, need_b = 256; bool run_a = true, run_b = true;
#pragma unroll
        for (int j = 31; j >= 0; --j) {
            const unsigned ones_a = alive_a & ua[j], ones_b = alive_b & ub[j];
            int v = (int)((unsigned)__popc(ones_a) | ((unsigned)__popc(ones_b) << 16));
            v += __builtin_amdgcn_update_dpp(0, v, 0xB1, 0xF, 0xF, false);
            v += __builtin_amdgcn_update_dpp(0, v, 0x4E, 0xF, 0xF, false);
            v += __builtin_amdgcn_update_dpp(0, v, 0x141, 0xF, 0xF, false);
            v += __builtin_amdgcn_update_dpp(0, v, 0x140, 0xF, 0xF, false);
            const unsigned tot = (unsigned)(__builtin_amdgcn_readlane(v, 0) + __builtin_amdgcn_readlane(v, 16) + __builtin_amdgcn_readlane(v, 32) + __builtin_amdgcn_readlane(v, 48));
            const int ca = (int)(tot & 0xffffu), cb = (int)(tot >> 16);
            if (run_a) { if (ca >= need_a) { alive_a = ones_a; if (ca == need_a) { sel_a |= ones_a; need_a = 0; run_a = false; } }
                         else { need_a -= ca; sel_a |= ones_a; alive_a &= ~ua[j]; } }
            if (run_b) { if (cb >= need_b) { alive_b = ones_b; if (cb == need_b) { sel_b |= ones_b; need_b = 0; run_b = false; } }
                         else { need_b -= cb; sel_b |= ones_b; alive_b &= ~ub[j]; } }
            if (!run_a && !run_b) break;
        }
        if (need_a > 0) {
            const int cnt = __popc(alive_a); int inc = cnt;
#pragma unroll
            for (int d = 1; d < 64; d <<= 1) { const int o = __shfl_up(inc, d); if (lane >= d) inc += o; }
            int k = need_a - (inc - cnt); k = k < 0 ? 0 : (k > cnt ? cnt : k);
            unsigned m = alive_a;
            for (int i = 0; i < k; ++i) { const unsigned low = m & (0u - m); sel_a |= low; m ^= low; }
        }
        if (need_b > 0) {
            const int cnt = __popc(alive_b); int inc = cnt;
#pragma unroll
            for (int d = 1; d < 64; d <<= 1) { const int o = __shfl_up(inc, d); if (lane >= d) inc += o; }
            int k = need_b - (inc - cnt); k = k < 0 ? 0 : (k > cnt ? cnt : k);
            unsigned m = alive_b;
            for (int i = 0; i < k; ++i) { const unsigned low = m & (0u - m); sel_b |= low; m ^= low; }
        }
        mra[lane] = sel_a; mrb[lane] = sel_b;
        (void)tb2;
    }
    __syncthreads();
}

__device__ __forceinline__ float half_max(float m) { auto rr = __builtin_amdgcn_permlane32_swap(__float_as_uint(m), __float_as_uint(m), false, false); return __builtin_fmaxf(__uint_as_float(rr[0]), __uint_as_float(rr[1])); }
__device__ __forceinline__ float half_sum(float m) { auto rr = __builtin_amdgcn_permlane32_swap(__float_as_uint(m), __float_as_uint(m), false, false); return __uint_as_float(rr[0]) + __uint_as_float(rr[1]); }
__device__ __forceinline__ int crow(int r, int hi) { return (r & 3) + 8 * (r >> 2) + 4 * hi; }
template <int DQK, int DV, int MODE, int STRIP = 0>
__device__ __forceinline__ void attn_unit(LAS unsigned char* lds, const bf16* Qb, int qpitch, const bf16* Kb, int kpitch, const bf16* VTb, int skv,
                                          const unsigned* maskb, const bf16* Zb, bf16* Ob, int q0) {
    constexpr int TK = 128, KP = DQK + 8, VP = TK + 8;
    LAS bf16* Ks = (LAS bf16*)lds; LAS bf16* Vs = Ks + TK * KP;
    constexpr int CPR = DQK / 8;
    constexpr int NCK = TK * CPR, NCV = DV * (TK / 8);
    constexpr int RK = (NCK + 511) / 512, RV = (NCV + 511) / 512;
    constexpr int NKS = DQK / 16, NMT = DV / 32;
    int tid_ = threadIdx.x; asm volatile("" : "+v"(tid_));
    const int tid = tid_, lane = tid & 63, w = __builtin_amdgcn_readfirstlane(tid >> 6), r = lane & 31, hh = lane >> 5;
    const int NT = MODE == 0 ? skv / TK : (q0 + 256) / TK;
    const int qlo = q0 + 32 * w;
    bf16x8 qf[NKS];
    { const bf16* qrow = Qb + (size_t)(qlo + r) * qpitch + 8 * hh;
#pragma unroll
      for (int ks = 0; ks < NKS; ++ks) qf[ks] = *(const bf16x8*)(qrow + 16 * ks); }
    f32x16 o[NMT];
#pragma unroll
    for (int mt = 0; mt < NMT; ++mt)
#pragma unroll
        for (int i = 0; i < 16; ++i) o[mt][i] = 0.f;
    float m_run = NEGF, l_run = 0.f;
    v4u kreg[RK], vreg[RV];
#define ATT_PREFETCH(tile_) do { \
        _Pragma("unroll") for (int i_ = 0; i_ < RK; ++i_) { const int c_ = tid + 512 * i_; if (c_ < NCK) { const int row_ = c_ / CPR, cc_ = c_ % CPR; kreg[i_] = *(const v4u*)(Kb + (size_t)(TK * (tile_) + row_) * kpitch + 8 * cc_); } } \
        _Pragma("unroll") for (int i_ = 0; i_ < RV; ++i_) { const int c_ = tid + 512 * i_; if (c_ < NCV) { const int d_ = c_ >> 4, cc_ = c_ & 15; vreg[i_] = *(const v4u*)(VTb + (size_t)d_ * skv + TK * (tile_) + 8 * cc_); } } } while (0)
    if (STRIP != 2) ATT_PREFETCH(0);
    for (int tile = 0; tile < NT; ++tile) {
        __syncthreads();
        if (STRIP != 2) {
#pragma unroll
        for (int i = 0; i < RK; ++i) { const int c = tid + 512 * i; if (c < NCK) { const int row = c / CPR, cc = c % CPR; *(LAS v4u*)(Ks + row * KP + 8 * cc) = kreg[i]; } }
#pragma unroll
        for (int i = 0; i < RV; ++i) { const int c = tid + 512 * i; if (c < NCV) { const int d = c >> 4, cc = c & 15; *(LAS v4u*)(Vs + d * VP + 8 * cc) = vreg[i]; } }
        }
        __syncthreads();
        if (STRIP != 2 && tile + 1 < NT) ATT_PREFETCH(tile + 1);
        __builtin_amdgcn_sched_barrier(0);
        if (STRIP == 1) continue;
#pragma unroll 1
        for (int sub = 0; sub < 2; ++sub) {
        const int t64 = 2 * tile + sub;
        if (MODE != 0 && 64 * t64 > qlo + 31) continue;
        const LAS bf16* Kc = Ks + 64 * sub * KP; const LAS bf16* Vc = Vs + 64 * sub;
        unsigned mw0 = 0u, mw1 = 0u;
        if (MODE == 2) { const v2u mm = *(const v2u*)(maskb + (size_t)(qlo + r) * 64 + 2 * t64); mw0 = mm.x >> (4 * hh); mw1 = mm.y >> (4 * hh); }
        f32x16 s0, s1;
#pragma unroll
        for (int i = 0; i < 16; ++i) { s0[i] = 0.f; s1[i] = 0.f; }
#pragma unroll
        for (int ks = 0; ks < NKS; ++ks) {
            const bf16x8 a0 = *(const LAS bf16x8*)(Kc + r * KP + 16 * ks + 8 * hh);
            const bf16x8 a1 = *(const LAS bf16x8*)(Kc + (32 + r) * KP + 16 * ks + 8 * hh);
            s0 = __builtin_amdgcn_mfma_f32_32x32x16_bf16(a0, qf[ks], s0, 0, 0, 0);
            s1 = __builtin_amdgcn_mfma_f32_32x32x16_bf16(a1, qf[ks], s1, 0, 0, 0);
        }
        if (MODE == 1) {
            if (64 * t64 + 63 > qlo) { const int qg = qlo + r;
#pragma unroll
                for (int i = 0; i < 16; ++i) { const int key = 64 * t64 + crow(i, hh); if (key > qg) s0[i] = NEGF; if (key + 32 > qg) s1[i] = NEGF; } }
        }
        if (MODE == 2) {
#pragma unroll
            for (int i = 0; i < 16; ++i) { const int bit = (i & 3) + 8 * (i >> 2); if (!((mw0 >> bit) & 1u)) s0[i] = NEGF; if (!((mw1 >> bit) & 1u)) s1[i] = NEGF; }
        }
        float mx = s0[0];
#pragma unroll
        for (int i = 1; i < 16; ++i) mx = __builtin_fmaxf(mx, s0[i]);
#pragma unroll
        for (int i = 0; i < 16; ++i) mx = __builtin_fmaxf(mx, s1[i]);
        mx = half_max(mx);
        const float m_new = __builtin_fmaxf(m_run, mx);
        const float alpha = __builtin_amdgcn_exp2f(m_run - m_new);
        m_run = m_new;
        float ls = 0.f;
#pragma unroll
        for (int i = 0; i < 16; ++i) { s0[i] = __builtin_amdgcn_exp2f(s0[i] - m_new); s1[i] = __builtin_amdgcn_exp2f(s1[i] - m_new); ls += s0[i] + s1[i]; }
        l_run = l_run * alpha + ls;
#pragma unroll
        for (int mt = 0; mt < NMT; ++mt)
#pragma unroll
            for (int i = 0; i < 16; ++i) o[mt][i] *= alpha;
        v4u pf[2][2];
#pragma unroll
        for (int s = 0; s < 2; ++s) {
            pf[0][s] = (v4u){pk2(s0[8 * s], s0[8 * s + 1]), pk2(s0[8 * s + 2], s0[8 * s + 3]), pk2(s0[8 * s + 4], s0[8 * s + 5]), pk2(s0[8 * s + 6], s0[8 * s + 7])};
            pf[1][s] = (v4u){pk2(s1[8 * s], s1[8 * s + 1]), pk2(s1[8 * s + 2], s1[8 * s + 3]), pk2(s1[8 * s + 4], s1[8 * s + 5]), pk2(s1[8 * s + 6], s1[8 * s + 7])};
        }
#pragma unroll
        for (int mt = 0; mt < NMT; ++mt)
#pragma unroll
            for (int p = 0; p < 2; ++p)
#pragma unroll
                for (int s = 0; s < 2; ++s) {
                    const LAS bf16* vp = Vc + (32 * mt + r) * VP + 32 * p + 16 * s + 4 * hh;
                    const s16x4 lo = *(const LAS s16x4*)(vp), hi = *(const LAS s16x4*)(vp + 8);
                    const bf16x8 a = (bf16x8){lo[0], lo[1], lo[2], lo[3], hi[0], hi[1], hi[2], hi[3]};
                    o[mt] = __builtin_amdgcn_mfma_f32_32x32x16_bf16(a, __builtin_bit_cast(bf16x8, pf[p][s]), o[mt], 0, 0, 0);
                }
        }
    }
#undef ATT_PREFETCH
    const float l_tot = half_sum(l_run);
    const float inv = 1.0f / l_tot;
    const size_t row = (size_t)(qlo + r);
#pragma unroll
    for (int mt = 0; mt < NMT; ++mt)
#pragma unroll
        for (int g4 = 0; g4 < 4; ++g4) {
            const int d = 32 * mt + 8 * g4 + 4 * hh;
            float ov[4];
#pragma unroll
            for (int i = 0; i < 4; ++i) ov[i] = o[mt][4 * g4 + i] * inv;
            if (Zb) { const v2u zw = *(const v2u*)(Zb + row * PP + d); const float z[4] = {bflo(zw.x), bfhi(zw.x), bflo(zw.y), bfhi(zw.y)};
#pragma unroll
                for (int i = 0; i < 4; ++i) ov[i] *= z[i] * __builtin_amdgcn_rcpf(1.0f + __expf(-z[i])); }
            v2u ow; ow.x = pk2(ov[0], ov[1]); ow.y = pk2(ov[2], ov[3]);
            *(v2u*)(Ob + row * PP + d) = ow;
        }
}

template <int DQK, int MODE>
__device__ __forceinline__ void attn_unit_pipe(LAS unsigned char* lds, const bf16* Qb, int qpitch, const bf16* Kb, int kpitch, const bf16* VTb, int skv,
                                               const unsigned* maskb, bf16* Ob, int q0) {
    constexpr int DV = 64, KP = DQK + 8, VP = 72, BUFE = 64 * KP + DV * VP;
    constexpr int CPR = DQK / 8, NCK = 64 * CPR, NCV = DV * 8, RK = (NCK + 511) / 512, RV = (NCV + 511) / 512, NKS = DQK / 16, NMT = DV / 32;
    static_assert(NCV == 512 && (NCK == 512 || NCK == 768), "staging map");
    int tid_ = threadIdx.x; asm volatile("" : "+v"(tid_));
    const int tid = tid_, lane = tid & 63, w = __builtin_amdgcn_readfirstlane(tid >> 6), r = lane & 31, hh = lane >> 5;
    const int NT = (q0 + 256) / 64;
    const int qlo = q0 + 32 * w;
    const int NTw = ((qlo + 31) >> 6) + 1;
    int krow[RK], kcc[RK];
#pragma unroll
    for (int i = 0; i < RK; ++i) { int c = tid + 512 * i; if (c >= NCK) c -= 256; krow[i] = c / CPR; kcc[i] = c % CPR; }
    const int vd = tid >> 3, vcc = tid & 7;
    bf16x8 qf[NKS];
    { const bf16* qrow = Qb + (size_t)(qlo + r) * qpitch + 8 * hh;
#pragma unroll
      for (int ks = 0; ks < NKS; ++ks) qf[ks] = *(const bf16x8*)(qrow + 16 * ks); }
    f32x16 o[NMT];
#pragma unroll
    for (int mt = 0; mt < NMT; ++mt)
#pragma unroll
        for (int i = 0; i < 16; ++i) o[mt][i] = 0.f;
    float m_run = NEGF, l_run = 0.f, alpha = 1.f;
    v4u kreg[2][RK], vreg[2][RV]; v2u mset[2];
    const unsigned* mrowp = MODE == 2 ? maskb + (size_t)(qlo + r) * 64 : nullptr;
#define PL_LOAD(S_, tile_) do { const int tl_ = (tile_) < NT ? (tile_) : NT - 1; \
        if (MODE == 2) { const int mt_ = (tile_) >= 2 ? ((tile_) - 2 < 32 ? (tile_) - 2 : 31) : 0; mset[S_] = *(const v2u*)(mrowp + 2 * mt_); }     \
        _Pragma("unroll") for (int i_ = 0; i_ < RK; ++i_) kreg[S_][i_] = *(const v4u*)(Kb + (size_t)(64 * tl_ + krow[i_]) * kpitch + 8 * kcc[i_]); \
        vreg[S_][0] = *(const v4u*)(VTb + (size_t)vd * skv + 64 * tl_ + 8 * vcc); } while (0)
#define PL_STAGE(S_, buf_) do { LAS bf16* Kd_ = (LAS bf16*)lds + (buf_) * BUFE; LAS bf16* Vd_ = Kd_ + 64 * KP; \
        _Pragma("unroll") for (int i_ = 0; i_ < RK; ++i_) *(LAS v4u*)(Kd_ + krow[i_] * KP + 8 * kcc[i_]) = kreg[S_][i_]; \
        *(LAS v4u*)(Vd_ + vd * VP + 8 * vcc) = vreg[S_][0]; } while (0)
#define PL_QK(t_, D0_, D1_) do { const LAS bf16* Kc_ = (const LAS bf16*)lds + ((t_) & 3) * BUFE; \
        _Pragma("unroll") for (int i_ = 0; i_ < 16; ++i_) { D0_[i_] = 0.f; D1_[i_] = 0.f; } \
        _Pragma("unroll") for (int ks_ = 0; ks_ < NKS; ++ks_) { \
            const bf16x8 a0_ = *(const LAS bf16x8*)(Kc_ + r * KP + 16 * ks_ + 8 * hh); const bf16x8 a1_ = *(const LAS bf16x8*)(Kc_ + (32 + r) * KP + 16 * ks_ + 8 * hh); \
            D0_ = __builtin_amdgcn_mfma_f32_32x32x16_bf16(a0_, qf[ks_], D0_, 0, 0, 0); D1_ = __builtin_amdgcn_mfma_f32_32x32x16_bf16(a1_, qf[ks_], D1_, 0, 0, 0); } } while (0)
#define PL_PV(t_) do { const LAS bf16* Vc_ = (const LAS bf16*)lds + ((t_) & 3) * BUFE + 64 * KP; \
        _Pragma("unroll") for (int mt_ = 0; mt_ < NMT; ++mt_) _Pragma("unroll") for (int i_ = 0; i_ < 16; ++i_) o[mt_][i_] *= alpha; \
        _Pragma("unroll") for (int mt_ = 0; mt_ < NMT; ++mt_) _Pragma("unroll") for (int p_ = 0; p_ < 2; ++p_) _Pragma("unroll") for (int s_ = 0; s_ < 2; ++s_) { \
            const LAS bf16* vp_ = Vc_ + (32 * mt_ + r) * VP + 32 * p_ + 16 * s_ + 4 * hh; \
            const s16x4 lo_ = *(const LAS s16x4*)(vp_), hi_ = *(const LAS s16x4*)(vp_ + 8); \
            const bf16x8 a_ = (bf16x8){lo_[0], lo_[1], lo_[2], lo_[3], hi_[0], hi_[1], hi_[2], hi_[3]}; \
            o[mt_] = __builtin_amdgcn_mfma_f32_32x32x16_bf16(a_, __builtin_bit_cast(bf16x8, pf[p_][s_]), o[mt_], 0, 0, 0); } } while (0)
#define PL_SOFTMAX(t_, C0_, C1_, MK_, CAUSAL_) do { \
        if (MODE == 2) { const unsigned w0_ = (MK_).x >> (4 * hh), w1_ = (MK_).y >> (4 * hh); \
            _Pragma("unroll") for (int i_ = 0; i_ < 16; ++i_) { const int bit_ = (i_ & 3) + 8 * (i_ >> 2); if (!((w0_ >> bit_) & 1u)) C0_[i_] = NEGF; if (!((w1_ >> bit_) & 1u)) C1_[i_] = NEGF; } } \
        if (CAUSAL_) { const int qg_ = qlo + r; \
            _Pragma("unroll") for (int i_ = 0; i_ < 16; ++i_) { const int key_ = 64 * (t_) + crow(i_, hh); if (key_ > qg_) C0_[i_] = NEGF; if (key_ + 32 > qg_) C1_[i_] = NEGF; } } \
        float mx_ = C0_[0]; \
        _Pragma("unroll") for (int i_ = 1; i_ < 16; ++i_) mx_ = __builtin_fmaxf(mx_, C0_[i_]); \
        _Pragma("unroll") for (int i_ = 0; i_ < 16; ++i_) mx_ = __builtin_fmaxf(mx_, C1_[i_]); \
        mx_ = half_max(mx_); \
        const float mn_ = __builtin_fmaxf(m_run, mx_); alpha = __builtin_amdgcn_exp2f(m_run - mn_); m_run = mn_; \
        float ls_ = 0.f; \
        _Pragma("unroll") for (int i_ = 0; i_ < 16; ++i_) { C0_[i_] = __builtin_amdgcn_exp2f(C0_[i_] - mn_); C1_[i_] = __builtin_amdgcn_exp2f(C1_[i_] - mn_); ls_ += C0_[i_] + C1_[i_]; } \
        l_run = l_run * alpha + ls_; \
        _Pragma("unroll") for (int s_ = 0; s_ < 2; ++s_) { \
            pf[0][s_] = (v4u){pk2(C0_[8 * s_], C0_[8 * s_ + 1]), pk2(C0_[8 * s_ + 2], C0_[8 * s_ + 3]), pk2(C0_[8 * s_ + 4], C0_[8 * s_ + 5]), pk2(C0_[8 * s_ + 6], C0_[8 * s_ + 7])}; \
            pf[1][s_] = (v4u){pk2(C1_[8 * s_], C1_[8 * s_ + 1]), pk2(C1_[8 * s_ + 2], C1_[8 * s_ + 3]), pk2(C1_[8 * s_ + 4], C1_[8 * s_ + 5]), pk2(C1_[8 * s_ + 6], C1_[8 * s_ + 7])}; } } while (0)
#define PL_IO(t_, S_) do { PL_STAGE(S_, ((t_) + 2) & 3); PL_LOAD(S_, (t_) + 4); } while (0)
#define PL_STEADY(t_, S_) do { const v2u mk_ = mset[S_]; PL_IO(t_, S_); if (MODE == 2) { asm volatile("" :: "v"(mk_.x), "v"(mk_.y)); } \
        PL_QK((t_) + 1, n0, n1); PL_PV((t_) - 1); PL_SOFTMAX(t_, c0, c1, mk_, false); c0 = n0; c1 = n1; __syncthreads(); } while (0)
#define PL_TAIL(t_, S_) do { const v2u mk_ = mset[S_]; PL_IO(t_, S_); if ((t_) >= 1) PL_PV((t_) - 1); PL_SOFTMAX(t_, c0, c1, mk_, MODE == 1); PL_PV(t_); __syncthreads(); } while (0)
    f32x16 c0, c1, n0, n1; v4u pf[2][2];
    PL_LOAD(0, 0); PL_LOAD(1, 1);
    PL_STAGE(0, 0); PL_STAGE(1, 1);
    PL_LOAD(0, 2); PL_LOAD(1, 3);
    __syncthreads();
    PL_QK(0, c0, c1);
    int t = 0;
    if (NTw >= 2) {
        { const v2u mk_ = mset[0]; PL_IO(0, 0); PL_QK(1, n0, n1); PL_SOFTMAX(0, c0, c1, mk_, false); c0 = n0; c1 = n1; __syncthreads(); }
        for (t = 1; t + 1 < NTw; ) {
            PL_STEADY(t, 1); ++t;
            if (t + 1 < NTw) { PL_STEADY(t, 0); ++t; }
        }
    }
    if (t & 1) PL_TAIL(t, 1); else PL_TAIL(t, 0);
    for (++t; t < NT; ++t) { if (t & 1) PL_IO(t, 1); else PL_IO(t, 0); __syncthreads(); }
#undef PL_LOAD
#undef PL_STAGE
#undef PL_QK
#undef PL_PV
#undef PL_SOFTMAX
#undef PL_IO
#undef PL_STEADY
#undef PL_TAIL
    const float l_tot = half_sum(l_run);
    const float inv = 1.0f / l_tot;
    const size_t row = (size_t)(qlo + r);
#pragma unroll
    for (int mt = 0; mt < NMT; ++mt)
#pragma unroll
        for (int k2 = 0; k2 < 2; ++k2) {
            const int ga = 2 * k2, gb = 2 * k2 + 1;
            const unsigned a0 = pk2(o[mt][4 * ga] * inv, o[mt][4 * ga + 1] * inv), a1 = pk2(o[mt][4 * ga + 2] * inv, o[mt][4 * ga + 3] * inv);
            const unsigned b0 = pk2(o[mt][4 * gb] * inv, o[mt][4 * gb + 1] * inv), b1 = pk2(o[mt][4 * gb + 2] * inv, o[mt][4 * gb + 3] * inv);
            const auto s0 = __builtin_amdgcn_permlane32_swap(a0, b0, false, false);
            const auto s1 = __builtin_amdgcn_permlane32_swap(a1, b1, false, false);
            *(v4u*)(Ob + row * PP + 32 * mt + 16 * k2 + 8 * hh) = (v4u){s0[0], s1[0], s0[1], s1[1]};
        }
}

__device__ __forceinline__ void attn_unit_mem(LAS unsigned char* lds, const bf16* Qb, const float* gqm, const bf16* Kb, const bf16* VTb, const bf16* Zb, bf16* Ob, int q0) {
    constexpr int DQK = 128, KP = DQK + 8, VP = MEML + 8, NKS = DQK / 16, NMT = 4;
    LAS bf16* Ks = (LAS bf16*)lds; LAS bf16* Vs = Ks + MEML * KP;
    int tid_ = threadIdx.x; asm volatile("" : "+v"(tid_));
    const int tid = tid_, lane = tid & 63, w = __builtin_amdgcn_readfirstlane(tid >> 6), r = lane & 31, hh = lane >> 5;
    { v4u kk[8], vv[8];
#pragma unroll
      for (int i = 0; i < 8; ++i) { const int c = tid + 512 * i; kk[i] = *(const v4u*)(Kb + (size_t)(c >> 4) * 1024 + 8 * (c & 15)); vv[i] = *(const v4u*)(VTb + (size_t)(c >> 5) * MEML + 8 * (c & 31)); }
#pragma unroll
      for (int i = 0; i < 8; ++i) { const int c = tid + 512 * i; *(LAS v4u*)(Ks + (c >> 4) * KP + 8 * (c & 15)) = kk[i]; *(LAS v4u*)(Vs + (c >> 5) * VP + 8 * (c & 31)) = vv[i]; } }
    __syncthreads();
#pragma unroll 1
    for (int qb = 0; qb < 2; ++qb) {
        const int qlo = q0 + 256 * qb + 32 * w;
        bf16x8 qf[NKS];
        { const bf16* qrow = Qb + (size_t)(qlo + r) * PP + 8 * hh;
#pragma unroll
          for (int ks = 0; ks < NKS; ++ks) qf[ks] = *(const bf16x8*)(qrow + 16 * ks);
          float ss = 0.f;
#pragma unroll
          for (int ks = 0; ks < NKS; ++ks) { const v4u w = __builtin_bit_cast(v4u, qf[ks]); float v[8]; UNPACK8(w, v);
#pragma unroll
              for (int j = 0; j < 8; ++j) ss += v[j] * v[j]; }
          const float rs = __builtin_amdgcn_rsqf(half_sum(ss) * (1.f / 128.f) + EPS) * SCALE_M;
#pragma unroll
          for (int ks = 0; ks < NKS; ++ks) { const v4u w = __builtin_bit_cast(v4u, qf[ks]); float v[8]; UNPACK8(w, v);
              const f32x4 g0 = *(const f32x4*)(gqm + 16 * ks + 8 * hh), g1 = *(const f32x4*)(gqm + 16 * ks + 8 * hh + 4);
              v[0] *= rs * g0[0]; v[1] *= rs * g0[1]; v[2] *= rs * g0[2]; v[3] *= rs * g0[3]; v[4] *= rs * g1[0]; v[5] *= rs * g1[1]; v[6] *= rs * g1[2]; v[7] *= rs * g1[3];
              const v4u p = PACK8(v); qf[ks] = __builtin_bit_cast(bf16x8, p); } }
        f32x16 o[NMT];
#pragma unroll
        for (int mt = 0; mt < NMT; ++mt)
#pragma unroll
            for (int i = 0; i < 16; ++i) o[mt][i] = 0.f;
        float m_run = NEGF, l_run = 0.f;
#pragma unroll 1
        for (int sub = 0; sub < MEML / 64; ++sub) {
            const LAS bf16* Kc = Ks + 64 * sub * KP; const LAS bf16* Vc = Vs + 64 * sub;
            f32x16 s0, s1;
#pragma unroll
            for (int i = 0; i < 16; ++i) { s0[i] = 0.f; s1[i] = 0.f; }
#pragma unroll
            for (int ks = 0; ks < NKS; ++ks) {
                const bf16x8 a0 = *(const LAS bf16x8*)(Kc + r * KP + 16 * ks + 8 * hh);
                const bf16x8 a1 = *(const LAS bf16x8*)(Kc + (32 + r) * KP + 16 * ks + 8 * hh);
                s0 = __builtin_amdgcn_mfma_f32_32x32x16_bf16(a0, qf[ks], s0, 0, 0, 0);
                s1 = __builtin_amdgcn_mfma_f32_32x32x16_bf16(a1, qf[ks], s1, 0, 0, 0);
            }
            float mx = s0[0];
#pragma unroll
            for (int i = 1; i < 16; ++i) mx = __builtin_fmaxf(mx, s0[i]);
#pragma unroll
            for (int i = 0; i < 16; ++i) mx = __builtin_fmaxf(mx, s1[i]);
            mx = half_max(mx);
            const float m_new = __builtin_fmaxf(m_run, mx);
            const float alpha = __builtin_amdgcn_exp2f(m_run - m_new);
            m_run = m_new;
            float ls = 0.f;
#pragma unroll
            for (int i = 0; i < 16; ++i) { s0[i] = __builtin_amdgcn_exp2f(s0[i] - m_new); s1[i] = __builtin_amdgcn_exp2f(s1[i] - m_new); ls += s0[i] + s1[i]; }
            l_run = l_run * alpha + ls;
#pragma unroll
            for (int mt = 0; mt < NMT; ++mt)
#pragma unroll
                for (int i = 0; i < 16; ++i) o[mt][i] *= alpha;
            v4u pf[2][2];
#pragma unroll
            for (int s = 0; s < 2; ++s) {
                pf[0][s] = (v4u){pk2(s0[8 * s], s0[8 * s + 1]), pk2(s0[8 * s + 2], s0[8 * s + 3]), pk2(s0[8 * s + 4], s0[8 * s + 5]), pk2(s0[8 * s + 6], s0[8 * s + 7])};
                pf[1][s] = (v4u){pk2(s1[8 * s], s1[8 * s + 1]), pk2(s1[8 * s + 2], s1[8 * s + 3]), pk2(s1[8 * s + 4], s1[8 * s + 5]), pk2(s1[8 * s + 6], s1[8 * s + 7])};
            }
#pragma unroll
            for (int mt = 0; mt < NMT; ++mt)
#pragma unroll
                for (int p = 0; p < 2; ++p)
#pragma unroll
                    for (int s = 0; s < 2; ++s) {
                        const LAS bf16* vp = Vc + (32 * mt + r) * VP + 32 * p + 16 * s + 4 * hh;
                        const s16x4 lo = *(const LAS s16x4*)(vp), hi = *(const LAS s16x4*)(vp + 8);
                        const bf16x8 a = (bf16x8){lo[0], lo[1], lo[2], lo[3], hi[0], hi[1], hi[2], hi[3]};
                        o[mt] = __builtin_amdgcn_mfma_f32_32x32x16_bf16(a, __builtin_bit_cast(bf16x8, pf[p][s]), o[mt], 0, 0, 0);
                    }
        }
        const float inv = 1.0f / half_sum(l_run);
        const size_t row = (size_t)(qlo + r);
#pragma unroll
        for (int mt = 0; mt < NMT; ++mt)
#pragma unroll
            for (int g4 = 0; g4 < 4; ++g4) {
                const int d = 32 * mt + 8 * g4 + 4 * hh;
                const v2u zw = *(const v2u*)(Zb + row * PP + d); const float z[4] = {bflo(zw.x), bfhi(zw.x), bflo(zw.y), bfhi(zw.y)};
                float ov[4];
#pragma unroll
                for (int i = 0; i < 4; ++i) ov[i] = o[mt][4 * g4 + i] * inv * (z[i] * __builtin_amdgcn_rcpf(1.0f + __expf(-z[i])));
                v2u ow; ow.x = pk2(ov[0], ov[1]); ow.y = pk2(ov[2], ov[3]);
                *(v2u*)(Ob + row * PP + d) = ow;
            }
    }
}

__device__ __forceinline__ bf16* gate_row(bf16* G0, bf16* G1, size_t row) { return row < 8192 ? G0 + row * 3072 : G1 + (row - 8192) * 3072; }
struct EpiZG {
    static constexpr bool PERM = true, AFTER_DRAIN = false;
    bf16* P; bf16* G0; bf16* G1;
    __device__ __forceinline__ void operator()(const pg8::f32x4 (&acc)[2][2][4][2], const pg8::Unit& u, int wr, int wc, int fr, int fq) const {
        const int row0 = u.pm * 256 + wr * 64 + fr, cl = wc * 32 + 8 * fq;
        const bool isz = u.pn < 4;
        const int ycol = (u.pn < 2 ? C_YA : C_YB) + (u.pn & 1) * 256, gcol = (u.pn - 4) * 256;
#pragma unroll
        for (int ai = 0; ai < 2; ++ai)
#pragma unroll
            for (int m = 0; m < 4; ++m) { const size_t row = (size_t)(row0 + ai * 128 + m * 16);
#pragma unroll
                for (int bj = 0; bj < 2; ++bj) {
                    const pg8::f32x4 v0 = acc[ai][bj][m][0], v1 = acc[ai][bj][m][1];
                    float rr[8] = {v0[0], v0[1], v0[2], v0[3], v1[0], v1[1], v1[2], v1[3]};
                    if (isz) { bf16* dst = P + row * PP + ycol + cl + bj * 128; const v4u old = *(const v4u*)dst; float yv[8]; UNPACK8(old, yv);
#pragma unroll
                        for (int e = 0; e < 8; ++e) rr[e] = yv[e] * (rr[e] * __builtin_amdgcn_rcpf(1.0f + __expf(-rr[e])));
                        *(v4u*)dst = PACK8(rr); }
                    else { bf16* dst = gate_row(G0, G1, row) + gcol + cl + bj * 128;
#pragma unroll
                        for (int e = 0; e < 8; ++e) rr[e] = __builtin_amdgcn_rcpf(1.0f + __expf(-rr[e]));
                        *(v4u*)dst = PACK8(rr); } } }
    }
};
struct EpiStoreVT {
    static constexpr bool PERM = true, AFTER_DRAIN = false;
    bf16* O; int ldc; bf16* VT;
    int vbeg, vend, hshift, voff, DV, sshift;
    __device__ __forceinline__ void operator()(const pg8::f32x4 (&acc)[2][2][4][2], const pg8::Unit& u, int wr, int wc, int fr, int fq) const {
        const int row0 = u.pm * 256 + wr * 64 + fr, col0 = u.pn * 256 + wc * 32 + 8 * fq;
        const int H = (vend - vbeg) >> hshift, S = 1 << sshift;
        bool isv[2]; long voffs[2];
#pragma unroll
        for (int bj = 0; bj < 2; ++bj) { const int col = col0 + bj * 128, cr = col - vbeg, within = cr & ((1 << hshift) - 1);
            isv[bj] = col >= vbeg && col < vend && within >= voff;
            voffs[bj] = ((long)((cr >> hshift) * DV + within - voff)) << sshift; }
#pragma unroll
        for (int ai = 0; ai < 2; ++ai)
#pragma unroll
            for (int m = 0; m < 4; ++m) { const int row = row0 + ai * 128 + m * 16;
                const int b = row >> sshift, sp = row & (S - 1);
#pragma unroll
                for (int bj = 0; bj < 2; ++bj) {
                    const pg8::f32x4 v0 = acc[ai][bj][m][0], v1 = acc[ai][bj][m][1];
                    const unsigned w0 = pk2(v0[0], v0[1]), w1 = pk2(v0[2], v0[3]), w2 = pk2(v1[0], v1[1]), w3 = pk2(v1[2], v1[3]);
                    if (!isv[bj]) *(v4u*)(O + (size_t)row * ldc + col0 + bj * 128) = (v4u){w0, w1, w2, w3};
                    else { bf16* dst = VT + (((long)(b * H * DV)) << sshift) + voffs[bj] + sp;
                        dst[0] = (bf16)(w0 & 0xffffu); dst[(size_t)S] = (bf16)(w0 >> 16); dst[(size_t)2 * S] = (bf16)(w1 & 0xffffu); dst[(size_t)3 * S] = (bf16)(w1 >> 16);
                        dst[(size_t)4 * S] = (bf16)(w2 & 0xffffu); dst[(size_t)5 * S] = (bf16)(w2 >> 16); dst[(size_t)6 * S] = (bf16)(w3 & 0xffffu); dst[(size_t)7 * S] = (bf16)(w3 >> 16); } }
                asm volatile("" ::: "memory"); }
    }
};
struct MergeOrder {
    pg8::StaticOrder so;
    __device__ __forceinline__ bool next(int i, pg8::Unit& u) const { pg8::Unit b; if (!so.next(i / 3, b)) return false; u.pm = b.pm; u.pn = (i % 3) * 4 + b.pn; return true; }
    __device__ __forceinline__ void a_ready(const pg8::Unit&) const {}
    __device__ __forceinline__ void done(const pg8::Unit&) const {}
};
struct EpiMerge {
    static constexpr bool PERM = true, AFTER_DRAIN = false;
    bf16* Mg; bf16* G0; bf16* G1;
    __device__ __forceinline__ void operator()(const pg8::f32x4 (&acc)[2][2][4][2], const pg8::Unit& u, int wr, int wc, int fr, int fq) const {
        const int nbr = u.pn >> 2;
        const int row0 = u.pm * 256 + wr * 64 + fr, col0 = (u.pn & 3) * 256 + wc * 32 + 8 * fq;
#pragma unroll
        for (int ai = 0; ai < 2; ++ai)
#pragma unroll
            for (int m = 0; m < 4; ++m) { const size_t row = (size_t)(row0 + ai * 128 + m * 16);
#pragma unroll
                for (int bj = 0; bj < 2; ++bj) { const int col = col0 + bj * 128;
                    const v4u gwd = *(const v4u*)(gate_row(G0, G1, row) + nbr * 1024 + col);
                    float gl[8]; UNPACK8(gwd, gl);
                    const pg8::f32x4 v0 = acc[ai][bj][m][0], v1 = acc[ai][bj][m][1];
                    float rr[8] = {v0[0], v0[1], v0[2], v0[3], v1[0], v1[1], v1[2], v1[3]};
#pragma unroll
                    for (int e = 0; e < 8; ++e) rr[e] *= gl[e];
                    bf16* dst = Mg + row * 1024 + col;
                    if (nbr > 0) { const v4u old = *(const v4u*)dst; float ol[8]; UNPACK8(old, ol);
#pragma unroll
                        for (int e = 0; e < 8; ++e) rr[e] += ol[e]; }
                    *(v4u*)dst = PACK8(rr); } }
    }
};
struct EpiOut {
    static constexpr bool PERM = true, AFTER_DRAIN = false;
    const float* X; float* Out;
    __device__ __forceinline__ void operator()(const pg8::f32x4 (&acc)[2][2][4][2], const pg8::Unit& u, int wr, int wc, int fr, int fq) const {
        const int row0 = u.pm * 256 + wr * 64 + fr, col0 = u.pn * 256 + wc * 32 + 8 * fq;
#pragma unroll
        for (int ai = 0; ai < 2; ++ai)
#pragma unroll
            for (int m = 0; m < 4; ++m) { const size_t row = (size_t)(row0 + ai * 128 + m * 16);
#pragma unroll
                for (int bj = 0; bj < 2; ++bj) { const size_t p = row * 1024 + col0 + bj * 128;
                    const f32x4 x0 = *(const f32x4*)(X + p), x1 = *(const f32x4*)(X + p + 4);
                    const pg8::f32x4 a0 = acc[ai][bj][m][0], a1 = acc[ai][bj][m][1];
                    __builtin_nontemporal_store((f32x4){x0[0] + a0[0], x0[1] + a0[1], x0[2] + a0[2], x0[3] + a0[3]}, (f32x4*)(Out + p));
                    __builtin_nontemporal_store((f32x4){x1[0] + a1[0], x1[1] + a1[1], x1[2] + a1[2], x1[3] + a1[3]}, (f32x4*)(Out + p + 4)); } }
    }
};

#define XB_TMO      128
#define XB_XCNT(j)  (256  + 64 * (j))
#define XB_XSUB(j)  (1280 + 64 * (j))
#define XB_XGEN(j)  (2304 + 64 * (j))
#define XB_TOP      3328
#define XB_TOPGEN   3392
#define XCD_BAR_WORDS 3456
#define XB_SPIN_CAP (1u << 18)

__device__ __forceinline__ unsigned xb_ld(unsigned* p)              { return __hip_atomic_load(p, __ATOMIC_RELAXED, __HIP_MEMORY_SCOPE_AGENT); }
__device__ __forceinline__ unsigned xb_add(unsigned* p, unsigned v) { return __hip_atomic_fetch_add(p, v, __ATOMIC_RELAXED, __HIP_MEMORY_SCOPE_AGENT); }
__device__ __forceinline__ unsigned xb_xcc_id() { return (unsigned)__builtin_amdgcn_s_getreg((3 << 11) | 20) & 0xFu; }
#define XB_SPIN(cond, bar) do { unsigned _sp = 0; while (cond) { __builtin_amdgcn_s_sleep(1); \
    if ((++_sp & 255u) == 0u) { if (xb_ld(&(bar)[XB_TMO])) break; if (_sp > XB_SPIN_CAP) { atomicAdd(&(bar)[XB_TMO], 1u); break; } } } } while (0)

struct XcdBarrier {
    unsigned* bar; unsigned x;
    volatile LAS unsigned* st;
};

__device__ __forceinline__ XcdBarrier xcd_barrier_post(unsigned* bar, volatile LAS unsigned* st) {
    XcdBarrier b; b.bar = bar; b.x = xb_xcc_id(); b.st = st;
    if (threadIdx.x == 0) (void)xb_add(&bar[XB_XCNT(b.x)], 1u);
    return b;
}
__device__ __forceinline__ void xcd_barrier_complete(unsigned* bar, unsigned x, unsigned& nloc, unsigned& nx) {
    const unsigned G = gridDim.x * gridDim.y * gridDim.z;
    unsigned sum, cnt, mine, sp = 0u;
    for (;;) {
        sum = 0u; cnt = 0u; mine = 0u;
#pragma unroll
        for (unsigned j = 0; j < 16; ++j) { const unsigned c = xb_ld(&bar[XB_XCNT(j)]); sum += c; cnt += (c > 0u) ? 1u : 0u; mine = (j == x) ? c : mine; }
        if (sum == G) break;
        __builtin_amdgcn_s_sleep(1);
        if ((++sp & 255u) == 0u) { if (xb_ld(&bar[XB_TMO])) break; if (sp > XB_SPIN_CAP) { atomicAdd(&bar[XB_TMO], 1u); break; } }
    }
    nloc = mine > 0u ? mine : 1u; nx = cnt > 0u ? cnt : 1u;
}

__device__ __forceinline__ void xcd_barrier(const XcdBarrier& b) {
    asm volatile("s_waitcnt vmcnt(0)" ::: "memory");
    __syncthreads();
    if (threadIdx.x == 0) {
        unsigned* bar = b.bar;
        __builtin_amdgcn_s_waitcnt(0);
        unsigned nloc = b.st[0], nx = b.st[1];
        if (nloc == 0u) { xcd_barrier_complete(bar, b.x, nloc, nx); b.st[0] = nloc; b.st[1] = nx; }
        const unsigned old = xb_add(&bar[XB_XSUB(b.x)], 1u);
        const unsigned gen = old / nloc;
        if (old + 1u == (gen + 1u) * nloc) {
            __builtin_amdgcn_fence(__ATOMIC_RELEASE, "agent");
            asm volatile("s_waitcnt vmcnt(0)" ::: "memory");
            const unsigned og = xb_add(&bar[XB_TOP], 1u);
            const unsigned tg = og / nx;
            if (og + 1u == (tg + 1u) * nx) xb_add(&bar[XB_TOPGEN], 1u);
            else XB_SPIN(xb_ld(&bar[XB_TOPGEN]) == tg, bar);
            __builtin_amdgcn_fence(__ATOMIC_ACQUIRE, "agent");
            xb_add(&bar[XB_XGEN(b.x)], 1u);
            asm volatile("s_waitcnt vmcnt(0)" ::: "memory");
        } else {
            XB_SPIN(xb_ld(&bar[XB_XGEN(b.x)]) == gen, bar);
            __builtin_amdgcn_fence(__ATOMIC_ACQUIRE, "agent");
            asm volatile("s_waitcnt vmcnt(0)" ::: "memory");
        }
    }
    __syncthreads();
}

template <int DQK, int DV, int MODE>
__device__ __forceinline__ void att_call(bool strip, LAS unsigned char* lds, const bf16* Qb, int qpitch, const bf16* Kb, int kpitch, const bf16* VTb, int skv, const unsigned* maskb, const bf16* Zb, bf16* Ob, int q0) {
    if (ATT_STRIP != 0 && strip) attn_unit<DQK, DV, MODE, ATT_STRIP>(lds, Qb, qpitch, Kb, kpitch, VTb, skv, maskb, Zb, Ob, q0);
    else attn_unit<DQK, DV, MODE, 0>(lds, Qb, qpitch, Kb, kpitch, VTb, skv, maskb, Zb, Ob, q0);
}
struct Args { const float* in[19]; const int* pos; float* out; unsigned char* ws; };
typedef const __attribute__((address_space(4))) Args* kargs_t;
#define PHASE_BEGIN \
    kargs_t ap_ = (kargs_t)__builtin_amdgcn_kernarg_segment_ptr(); asm volatile("" : "+s"(ap_)); \
    int tid = threadIdx.x; asm volatile("" : "+v"(tid)); \
    const int lane = tid & 63, wave = __builtin_amdgcn_readfirstlane(tid >> 6), G = gridDim.x, NGW = G * 8, gw = blockIdx.x * 8 + wave; \
    unsigned char* const ws = ap_->ws; unsigned char* const dob = (unsigned char*)ap_->out; const int* const pos = ap_->pos; float* const outp = ap_->out; unsigned* const ctl = (unsigned*)(ws + WS_CTL); \
    const float* const x = ap_->in[0]; const float* const mem = ap_->in[1]; \
    const float* const g_norm = ap_->in[3]; const float* const w_in = ap_->in[4]; const float* const g_qn_a = ap_->in[5]; const float* const g_kn_a = ap_->in[6]; \
    const float* const g_cq = ap_->in[7]; const float* const g_ckv = ap_->in[8]; const float* const w_uq = ap_->in[9]; const float* const w_ukv = ap_->in[10]; \
    const float* const g_qn_b = ap_->in[11]; const float* const g_kn_b = ap_->in[12]; const float* const g_mem = ap_->in[13]; const float* const w_mem_kv = ap_->in[14]; \
    const float* const g_qn_m = ap_->in[15]; const float* const g_kn_m = ap_->in[16]; const float* const w_branch = ap_->in[17]; const float* const w_out = ap_->in[18]; \
    bf16* const WinT = (bf16*)(ws + WS_WIN); bf16* const WuqT = (bf16*)(ws + WS_WUQ); bf16* const WukvT = (bf16*)(ws + WS_WUKV); bf16* const WmemT = (bf16*)(ws + WS_WMEM); \
    bf16* const WbrT = (bf16*)(ws + WS_WBR); bf16* const WoutT = (bf16*)(ws + WS_WOUT); \
    float* const ropeA = (float*)(ws + WS_ROPEA); float* const ropeB = (float*)(ws + WS_ROPEB); \
    bf16* const MN = (bf16*)(ws + WS_MN); bf16* const KVM = (bf16*)(ws + WS_KVM); bf16* const VTM = (bf16*)(ws + WS_VTM); \
    float* const WI = (float*)(ws + WS_WI); unsigned* const MASK = (unsigned*)(ws + WS_MASK); \
    bf16* const VTA = (bf16*)(dob + DO_VTA); bf16* const VTB = (bf16*)(dob + DO_VTB); bf16* const KB = (bf16*)(dob + DO_KB); \
    bf16* const Hh = (bf16*)(ws + WS_H); bf16* const MG = (bf16*)(ws + WS_H); bf16* const QB = (bf16*)(ws + WS_QB); \
    bf16* const KVB = (bf16*)(ws + WS_KVB); bf16* const GT0 = (bf16*)(dob + DO_G0); bf16* const GT1 = (bf16*)(ws + WS_G1); bf16* const P = (bf16*)(ws + WS_P); \
    (void)lane; (void)NGW; (void)gw; (void)ctl; \
    (void)pos; (void)outp; (void)x; (void)mem; (void)g_norm; (void)w_in; (void)g_qn_a; (void)g_kn_a; (void)g_cq; (void)g_ckv; (void)w_uq; (void)w_ukv; (void)g_qn_b; (void)g_kn_b; (void)g_mem; (void)w_mem_kv; \
    (void)g_qn_m; (void)g_kn_m; (void)w_branch; (void)w_out; (void)WinT; (void)WuqT; (void)WukvT; (void)WmemT; (void)WbrT; (void)WoutT; (void)ropeA; (void)ropeB; (void)MN; (void)KVM; (void)VTM; (void)WI; (void)MASK; \
    (void)VTA; (void)VTB; (void)Hh; (void)KB; (void)QB; (void)KVB; (void)MG; (void)GT0; (void)GT1; (void)P
#define GRID_BARRIER() do { kargs_t bp_ = (kargs_t)__builtin_amdgcn_kernarg_segment_ptr(); asm volatile("" : "+s"(bp_)); \
    XcdBarrier b_; b_.bar = (unsigned*)(bp_->ws + WS_CTL) + 4096; b_.x = xb_xcc_id(); b_.st = (volatile LAS unsigned*)(lds + LDS_BYTES - 32); xcd_barrier(b_); } while (0)

__global__ void __launch_bounds__(512, 2) fwd_kernel(Args a) {
    extern __shared__ __attribute__((aligned(16))) unsigned char lds_raw[];
    LAS unsigned char* const lds = (LAS unsigned char*)lds_raw;
    volatile LAS int* const slot = (volatile LAS int*)(lds + LDS_SLOT);
    if (threadIdx.x < 16) ((LAS unsigned*)(lds + LDS_BYTES - 64))[threadIdx.x] = 0u;
    __syncthreads();
    (void)xcd_barrier_post((unsigned*)(a.ws + WS_CTL) + 4096, (volatile LAS unsigned*)(lds + LDS_BYTES - 32));

    for (int rep = 0; rep < REP_P0; ++rep) { PHASE_BEGIN;
        LAS float* scr = (LAS float*)(lds + wave * 16384);
        constexpr int I_IN = 16 * (NP / 32), I_UQ = 6 * 24, I_UKV = 4 * 32, I_MEM = 16 * 32, I_BR = 8 * 32, I_OUT = 16 * 32;
        constexpr int NITEMS = I_IN + I_UQ + I_UKV + I_MEM + 3 * I_BR + I_OUT;
        for (int it = gw; it < NITEMS; it += NGW) {
            int r = it;
            if (r < I_IN) { transpose_item<true>(w_in, 1024, DIN, NP, WinT, scr, r, lane); continue; } r -= I_IN;
            if (r < I_UQ) { transpose_item<false>(w_uq, 384, 768, 768, WuqT, scr, r, lane); continue; } r -= I_UQ;
            if (r < I_UKV) { transpose_item<false>(w_ukv, 256, 1024, 1024, WukvT, scr, r, lane); continue; } r -= I_UKV;
            if (r < I_MEM) { transpose_item<false>(w_mem_kv, 1024, 1024, 1024, WmemT, scr, r, lane); continue; } r -= I_MEM;
            if (r < 3 * I_BR) { const int nb = r / I_BR; transpose_item<false>(w_branch + (size_t)nb * 512 * 1024, 512, 1024, 1024, WbrT + (size_t)nb * 1024 * 512, scr, r % I_BR, lane); continue; } r -= 3 * I_BR;
            transpose_item<false>(w_out, 1024, 1024, 1024, WoutT, scr, r, lane);
        }
        for (int idx = blockIdx.x * 512 + tid; idx < TT * 24; idx += G * 512) {
            const int t = idx / 24, i = idx % 24; const float pf = (float)pos[t];
            if (i < 8) { const float ang = pf * INVA[i]; ropeA[t * 16 + i] = cosf(ang); ropeA[t * 16 + 8 + i] = sinf(ang); }
            else { const int j = i - 8; const float ang = pf * INVB[j]; ropeB[t * 32 + j] = cosf(ang); ropeB[t * 32 + 16 + j] = sinf(ang); }
        }
        for (int m = gw; m < NB * MEML; m += NGW) rms_row_1024(mem + (size_t)m * DM, g_mem, MN + (size_t)m * DM, lane);
        for (int rp = 0; rp < REP_PH; ++rp)
        for (int m = gw; m < TT; m += NGW) rms_row_1024(x + (size_t)m * DM, g_norm, Hh + (size_t)m * DM, lane);
    }
    GRID_BARRIER();
    for (int es = 0; es < EXTRA_SYNCS; ++es) GRID_BARRIER();

    for (int rep = 0; rep < REP_G1; ++rep) { PHASE_BEGIN;
        pg8::Gemm g{Hh, WinT, TT, PP, 1024, 1024, nullptr, nullptr, nullptr, 0}; pg8::StaticOrder S; S.init(TT, PP, G, (int)blockIdx.x);
        EpiStoreVT E{P, PP, VTA, C_VA, C_VA + 512, 6, 0, 64, 11};
        pg8::gemm_phase<EpiStoreVT, pg8::StaticOrder, true, true>(lds, g, S, E);
    }
    { PHASE_BEGIN;
        pg8::Gemm g{MN, WmemT, NB * MEML, 1024, 1024, 1024, nullptr, nullptr, nullptr, 0}; pg8::StaticOrder S; S.init(NB * MEML, 1024, G, (int)((blockIdx.x + 64) % G));
        EpiStoreVT E{KVM, 1024, VTM, 512, 1024, 7, 0, 128, 8};
        pg8::gemm_phase<EpiStoreVT, pg8::StaticOrder, true, true>(lds, g, S, E);
    }
    GRID_BARRIER();
    { PHASE_BEGIN;
        float ga[8], gk[8], gq[8], gc[8], gm[8];
#pragma unroll
        for (int j = 0; j < 8; ++j) { ga[j] = g_qn_a[8 * (lane & 7) + j]; gk[j] = g_kn_a[8 * (lane & 7) + j]; gm[j] = g_qn_m[8 * (lane & 15) + j]; gq[j] = lane < 48 ? g_cq[8 * lane + j] : 0.f; gc[j] = lane < 32 ? g_ckv[8 * lane + j] : 0.f; }
        for (int dp = 0; dp < DUMMY_POST1; ++dp)
            for (int m = gw; m < TT; m += NGW)
                post1_row(P + (size_t)m * PP, QB + (size_t)(m & 1023) * 4096, ropeA + (size_t)m * 16, ga, gk, gq, gc, gm, (float*)KVB + (size_t)m * 8, lane);
        for (int m = gw; m < TT; m += NGW)
            post1_row(P + (size_t)m * PP, P + (size_t)m * PP, ropeA + (size_t)m * 16, ga, gk, gq, gc, gm, WI + (size_t)m * 8, lane);
        for (int m = gw; m < NB * MEML; m += NGW) km_row(KVM + (size_t)m * 1024, g_kn_m, lane);
    }
    GRID_BARRIER();
    for (int rep = 0; rep < REP_G2; ++rep) { PHASE_BEGIN;
        pg8::Gemm g{P + C_CQ, WuqT, TT, 768, 384, PP, nullptr, nullptr, nullptr, 0}; pg8::StaticOrder S; S.init(TT, 768, G, (int)blockIdx.x);
        pg8::EpiBf16<0> E{QB, 768, nullptr, 0, 0, 1.f};
        pg8::gemm_phase<pg8::EpiBf16<0>, pg8::StaticOrder, true, true>(lds, g, S, E);
    }
    for (int rep = 0; rep < REP_G2; ++rep) { PHASE_BEGIN;
        pg8::Gemm g{P + C_CKV, WukvT, TT, 1024, 256, PP, nullptr, nullptr, nullptr, 0}; pg8::StaticOrder S; S.init(TT, 1024, G, (int)((blockIdx.x + 192) % G));
        pg8::EpiBf16<0> E{KVB, 1024, nullptr, 0, 0, 1.f};
        pg8::gemm_phase<pg8::EpiBf16<0>, pg8::StaticOrder, true, true>(lds, g, S, E);
    }
    for (int rep = 0; rep < REP_IDX; ++rep) { if (rep > 0) GRID_BARRIER();
        PHASE_BEGIN;
        unsigned* const q_idx = ctl + 64 * (0 + 4 * rep);
        int u = next_unit(q_idx, slot);
        bf16x8 qf[8][2]; float wq[8];
        if (u < NB * 128) indexer_load_q(P, WI, u, qf, wq);
        while (u < NB * 128) {
            int tk = 0; if (tid == 0) tk = (int)atomicAdd(q_idx, 1u);
            const int tb = 127 - (u >> 3), bb = u & 7;
            int un;
            indexer_unit((LAS float*)lds, P, WI, MASK, bb, tb, qf, wq, tk, slot, NB * 128, un);
            u = un;
        }
    }
    GRID_BARRIER();
    { PHASE_BEGIN;
        LAS float* scr = (LAS float*)(lds + wave * 8192);
        float gqv[12], gkv[12];
#pragma unroll
        for (int e = 0; e < 12; ++e) { gqv[e] = g_qn_b[12 * (lane & 7) + e]; gkv[e] = g_kn_b[12 * (lane & 7) + e]; }
        for (int dp = 0; dp < DUMMY_POST2; ++dp)
            for (int m = gw; m < TT; m += NGW)
                post2_row(QB + (size_t)m * 768, (bf16*)MASK + (size_t)(m & 1023) * 768, KVB + (size_t)m * 1024, P + (size_t)m * PP, (bf16*)MASK + (size_t)(1024 + (m & 1023)) * 768, ropeB + (size_t)m * 32, gqv, gkv, scr, lane);
        for (int m = gw; m < TT; m += NGW)
            post2_row(QB + (size_t)m * 768, QB + (size_t)m * 768, KVB + (size_t)m * 1024, P + (size_t)m * PP, KB + (size_t)m * 768, ropeB + (size_t)m * 32, gqv, gkv, scr, lane);
        transpose_v(KVB, 1024, 64, 128, 8, 64, SEQ, NB, VTB, gw, NGW, lane);
    }
    GRID_BARRIER();
    for (int rep = 0; rep < REP_ATT; ++rep) { if (rep > 0) GRID_BARRIER();
        PHASE_BEGIN;
        unsigned* const q_att = ctl + 64 * (1 + 4 * rep);
        for (;;) {
            const int u = next_unit(q_att, slot);
            if (u >= 1152) break;
            if (u < 704 || u >= 832) {
                const int uu = u < 704 ? u : u - 128, cls = uu >> 6, bh = uu & 63, bb = bh >> 3, h = bh & 7;
                const bool isA = (0x52a7u >> cls) & 1u; const int qb = (int)((0x11232435467567ull >> (4 * cls)) & 15ull);
                const size_t r0 = (size_t)bb * SEQ;
                if (!isA) attn_unit_pipe<96, 1>(lds, QB + r0 * 768 + h * 96, 768, KB + r0 * 768 + h * 96, 768, VTB + (size_t)((bb * 8 + h) * 64) * SEQ, SEQ, nullptr,
                                                   P + r0 * PP + C_YB + h * 64, qb * 256);
                else attn_unit_pipe<64, 2>(lds, P + r0 * PP + C_QA + h * 64, PP, P + r0 * PP + C_KA + h * 64, PP, VTA + (size_t)((bb * 8 + h) * 64) * SEQ, SEQ, MASK + r0 * 64,
                                           P + r0 * PP + C_YA + h * 64, qb * 256);
            } else {
                const int v = u - 704, hq = v & 3, bh = v >> 2, bb = bh >> 2, h = bh & 3;
                const size_t r0 = (size_t)bb * SEQ;
                attn_unit_mem(lds, P + r0 * PP + C_QM + h * 128, g_qn_m, KVM + (size_t)bb * MEML * 1024 + h * 128, VTM + (size_t)((bb * 4 + h) * 128) * MEML,
                              P + r0 * PP + C_ZM + h * 128, P + r0 * PP + C_YM + h * 128, hq * 512);
            }
        }
    }
    GRID_BARRIER();
    for (int rep = 0; rep < 1; ++rep) { PHASE_BEGIN;
        pg8::Gemm g{Hh, WinT + (size_t)PP * 1024, TT, NZG, 1024, 1024, nullptr, nullptr, nullptr, 0}; pg8::StaticOrder S; S.init(TT, NZG, G, (int)blockIdx.x);
        EpiZG E{P, GT0, GT1};
        pg8::gemm_phase<EpiZG, pg8::StaticOrder, true, true>(lds, g, S, E);
    }
    GRID_BARRIER();
    for (int rep = 0; rep < REP_G4; ++rep) { PHASE_BEGIN;
        pg8::Gemm g{P + C_YA, WbrT, TT, 3072, 512, PP, P + C_YA, P + C_YB, P + C_YM, 4};
        MergeOrder S; S.so.init(TT, 1024, G, (int)blockIdx.x);
        EpiMerge E{MG, GT0, GT1};
        pg8::gemm_phase<EpiMerge, MergeOrder, true, true>(lds, g, S, E);
    }
    GRID_BARRIER();
    for (int rep = 0; rep < REP_G5; ++rep) { PHASE_BEGIN;
        pg8::Gemm g{MG, WoutT, TT, 1024, 1024, 1024, nullptr, nullptr, nullptr, 0}; pg8::StaticOrder S; S.init(TT, 1024, G, (int)blockIdx.x);
        EpiOut E{x, outp};
        pg8::gemm_phase<EpiOut, pg8::StaticOrder, true, true>(lds, g, S, E);
    }
}

extern "C" void kernel_launch(void* const* d_in, const int* in_sizes, int n_in, void* d_out, int out_size, void* d_ws, size_t ws_size, hipStream_t stream) {
    static int grid = 0;
    if (grid == 0) {
        if (n_in != 19 || out_size != TT * DM || ws_size < WS_END) { fprintf(stderr, "kernel_launch: unexpected problem (n_in %d, out %d, ws %zu); nothing launched\n", n_in, out_size, ws_size); grid = -1; return; }
        int dev = 0, cus = 0, per_cu = 0;
        if (hipGetDevice(&dev) != hipSuccess || hipDeviceGetAttribute(&cus, hipDeviceAttributeMultiprocessorCount, dev) != hipSuccess) { grid = -1; return; }
        if (hipFuncSetAttribute((const void*)fwd_kernel, hipFuncAttributeMaxDynamicSharedMemorySize, LDS_BYTES) != hipSuccess) { fprintf(stderr, "kernel_launch: hipFuncSetAttribute failed\n"); grid = -1; return; }
        if (hipOccupancyMaxActiveBlocksPerMultiprocessor(&per_cu, (const void*)fwd_kernel, 512, LDS_BYTES) != hipSuccess || per_cu < 1) { fprintf(stderr, "kernel_launch: occupancy query reports %d blocks per CU\n", per_cu); (void)hipGetLastError(); grid = -1; return; }
        grid = cus;
    }
    if (grid < 0) return;
    (void)hipMemsetAsync((char*)d_ws + WS_CTL, 0, 65536, stream);
    Args a{};
    for (int i = 0; i < 19; ++i) a.in[i] = (const float*)d_in[i];
    a.pos = (const int*)d_in[2]; a.out = (float*)d_out; a.ws = (unsigned char*)d_ws;
    hipLaunchKernelGGL(fwd_kernel, dim3(grid), dim3(512), LDS_BYTES, stream, a);
    const hipError_t e = hipPeekAtLastError();
    if (e != hipSuccess) fprintf(stderr, "kernel_launch: launch failed: %s (grid %d)\n", hipGetErrorString(e), grid);
}
```

```cpp
#include <hip/hip_runtime.h>
#include <cstdio>
#include <cstdint>
namespace pg8 {
#define PG8_LAS __attribute__((address_space(3)))
typedef unsigned short bf16_t;
typedef short bf16x8 __attribute__((ext_vector_type(8)));
typedef float f32x4 __attribute__((ext_vector_type(4)));
typedef unsigned u32x4 __attribute__((ext_vector_type(4)));
constexpr int BM = 256, BK = 64, HALF = 128, HTB = HALF * BK * 2  , STAGE_BYTES = 8 * HTB, NXCD = 8, WGM = 8;

__host__ __device__ __forceinline__ int lds_byte(int r, int c) { const int st = (r >> 4) * 2 + (c >> 5), rr = r & 15, cc = c & 31, ob = rr * 64 + cc * 2; return st * 1024 + (ob ^ (((ob >> 9) & 1) << 5)); }
__host__ __device__ __forceinline__ void stage_rc(int b, int& R, int& C) { const int st = b / 1024, sb = b % 1024, swz = sb ^ (((sb >> 9) & 1) << 5); R = (st >> 1) * 16 + swz / 64; C = (st & 1) * 32 + (swz % 64) / 2; }
__host__ __device__ __forceinline__ int perm32(int rho) { const int n = rho >> 4, i = rho & 15; return 8 * (i >> 2) + 4 * n + (i & 3); }

struct Unit { int pm, pn; };
struct Gemm { const bf16_t* A; const bf16_t* Bt; int M, N, K, lda; const bf16_t* Ag0; const bf16_t* Ag1; const bf16_t* Ag2; int ngrp; };
__device__ __forceinline__ const char* a_base(const Gemm& g, const Unit& u) { if (!g.ngrp) return (const char*)g.A; const int j = u.pn / g.ngrp; return (const char*)(j == 0 ? g.Ag0 : (j == 1 ? g.Ag1 : g.Ag2)); }

struct StaticOrder {
    int nM, nN, nwg, G, c;
    __host__ __device__ void init(int M, int N, int G_, int c_) { nM = M / BM; nN = N / BM; nwg = nM * nN; G = G_; c = c_; }
    __host__ __device__ bool next(int i, Unit& u) const {
        const long L = (long)i * G + c; if (L >= nwg) return false;
        int wgid = (int)L; { const int q = nwg / NXCD, r = nwg % NXCD, xcd = wgid % NXCD, off = wgid / NXCD; wgid = (xcd < r ? xcd * (q + 1) : r * (q + 1) + (xcd - r) * q) + off; }
        const int nig = WGM * nN, gid = wgid / nig, fm = gid * WGM, gsz = (nM - fm) < WGM ? (nM - fm) : WGM;
        u.pm = fm + ((wgid % nig) % gsz); u.pn = (wgid % nig) / gsz; return true;
    }
    __device__ __forceinline__ void a_ready(const Unit&) const {}
    __device__ __forceinline__ void done(const Unit&) const {}
};

__device__ __forceinline__ unsigned cvt_pk_bf16(float lo, float hi) { unsigned r; asm volatile("v_cvt_pk_bf16_f32 %0, %1, %2" : "=v"(r) : "v"(lo), "v"(hi)); return r; }
typedef float f32x2 __attribute__((ext_vector_type(2)));
__device__ __forceinline__ f32x2 gelu_pk(f32x2 v) {
    const f32x2 av = __builtin_elementwise_abs(v), d = av * 0.2316418882f + 1.0f;
    f32x2 t; t.x = __builtin_amdgcn_rcpf(d.x); t.y = __builtin_amdgcn_rcpf(d.y);
    f32x2 q = t * 0.5307027145f + (-0.7265760135f); q = q * t + 0.7107068705f; q = q * t + (-0.142248368f); q = q * t + 0.127414796f; q = q * t;
    const f32x2 s = (v * v) * (-0.72134752044f);
    f32x2 e; e.x = __builtin_amdgcn_exp2f(s.x); e.y = __builtin_amdgcn_exp2f(s.y);
    const f32x2 m = v * (q * e), r = v - m;
    f32x2 o; o.x = v.x < 0.f ? m.x : r.x; o.y = v.y < 0.f ? m.y : r.y; return o;
}

template <int ACT  > struct EpiBf16 {
    static constexpr bool PERM = true, AFTER_DRAIN = false; static_assert(ACT == 0 || ACT == 1, "EpiBf16: ACT is 0 (none) or 1 (gelu_pk)");
    bf16_t* O; int ldc; const float* bias; int split_cols; size_t split_stride; float scale0;
    __device__ __forceinline__ void operator()(const f32x4 (&acc)[2][2][4][2], const Unit& u, int wr, int wc, int fr, int fq) const {
        const int row0 = u.pm * BM + wr * 64 + fr; int colt = u.pn * BM; bf16_t* base = O;
        float sc = 1.f; if (split_cols) { const int t = colt / split_cols; base += (size_t)t * split_stride; colt -= t * split_cols; if (t == 0) sc = scale0; }
        const int col0 = colt + wc * 32 + 8 * fq, bcol0 = u.pn * BM + wc * 32 + 8 * fq;
        f32x4 bv[2][2];
#pragma unroll
        for (int bj = 0; bj < 2; ++bj)
#pragma unroll
            for (int n = 0; n < 2; ++n) bv[bj][n] = bias ? *(const f32x4*)(bias + bcol0 + bj * HALF + 4 * n) : (f32x4){0.f, 0.f, 0.f, 0.f};
#pragma unroll
        for (int ai = 0; ai < 2; ++ai)
#pragma unroll
            for (int m = 0; m < 4; ++m) { bf16_t* rowp = base + (size_t)(row0 + ai * HALF + m * 16) * ldc + col0;
#pragma unroll
                for (int bj = 0; bj < 2; ++bj) { f32x4 v0 = acc[ai][bj][m][0] + bv[bj][0], v1 = acc[ai][bj][m][1] + bv[bj][1];
                    if (ACT == 1) { f32x2 a = gelu_pk((f32x2){v0[0], v0[1]}), b = gelu_pk((f32x2){v0[2], v0[3]}), c = gelu_pk((f32x2){v1[0], v1[1]}), d = gelu_pk((f32x2){v1[2], v1[3]});
                        v0 = (f32x4){a.x, a.y, b.x, b.y}; v1 = (f32x4){c.x, c.y, d.x, d.y}; }
                    v0 = v0 * sc; v1 = v1 * sc; u32x4 w; w.x = cvt_pk_bf16(v0[0], v0[1]); w.y = cvt_pk_bf16(v0[2], v0[3]); w.z = cvt_pk_bf16(v1[0], v1[1]); w.w = cvt_pk_bf16(v1[2], v1[3]);
                    *(u32x4*)(rowp + bj * HALF) = w; } }
    }
};
template <class Epi, class Sched, bool ALIGN_EPI = false, bool SP2 = false>
__device__ __forceinline__ void gemm_phase(PG8_LAS unsigned char* lds, const Gemm g, const Sched& S, const Epi& E) {
    int tid_ = threadIdx.x; asm volatile("" : "+v"(tid_));
    const int tid = tid_, wid = __builtin_amdgcn_readfirstlane(tid >> 6), lane = tid & 63, wr = wid >> 2, wc = wid & 3, fr = lane & 15, fq = lane >> 4;
    const int K = g.K, nt = K / BK;
    unsigned voffA[2], voffB[2];
#pragma unroll
    for (int i = 0; i < 2; ++i) { int R, C; stage_rc(tid * 16 + i * 8192, R, C); const int Rb = Epi::PERM ? ((R & ~31) + perm32(R & 31)) : R;
        voffA[i] = (unsigned)(R * g.lda + C) * 2u; voffB[i] = (unsigned)(Rb * K + C) * 2u; }
    const size_t kstep = (size_t)(BK * 2);
    const size_t hstepA = (size_t)HALF * g.lda * 2, hstepB = (size_t)HALF * K * 2;
    const size_t tstepA = 2 * hstepA, tstepB = 2 * hstepB;
    const unsigned ldsw = (unsigned)wid * 1024u;
    const int aoff = lds_byte(wr * 64 + fr, fq * 8), boff = lds_byte(wc * 32 + fr, fq * 8);
#define PG8_SA(b, h) (((b) * 2 + (h)) * HTB)
#define PG8_SB(b, h) ((4 + (b) * 2 + (h)) * HTB)
#define PG8_STAGE(bufoff, gbase, voff) do { _Pragma("unroll") for (int _i = 0; _i < 2; ++_i) \
        __builtin_amdgcn_global_load_lds((const unsigned*)((const char*)(gbase) + (voff)[_i]), (PG8_LAS unsigned*)(lds + (bufoff) + ldsw + _i * 8192), 16, 0, 0); } while (0)
#define PG8_LDA(dst, b, h) do { _Pragma("unroll") for (int m = 0; m < 4; ++m) _Pragma("unroll") for (int k = 0; k < 2; ++k) dst[m][k] = *(const PG8_LAS bf16x8*)(lds + PG8_SA(b, h) + aoff + m * 2048 + k * 1024); } while (0)
#define PG8_LDB(dst, b, h) do { _Pragma("unroll") for (int n = 0; n < 2; ++n) _Pragma("unroll") for (int k = 0; k < 2; ++k) dst[n][k] = *(const PG8_LAS bf16x8*)(lds + PG8_SB(b, h) + boff + n * 2048 + k * 1024); } while (0)
#define PG8_MMA(ai, bj, At, Bt) do { __builtin_amdgcn_s_setprio(1); _Pragma("unroll") for (int m = 0; m < 4; ++m) _Pragma("unroll") for (int n = 0; n < 2; ++n) _Pragma("unroll") for (int k = 0; k < 2; ++k) \
        acc[ai][bj][m][n] = __builtin_amdgcn_mfma_f32_16x16x32_bf16(Bt[n][k], At[m][k], acc[ai][bj][m][n], 0, 0, 0); __builtin_amdgcn_s_setprio(0); } while (0)
#define PG8_WAIT_V(n) asm volatile("s_waitcnt vmcnt(" #n ")" ::: "memory")
#define PG8_WAIT_L(n) asm volatile("s_waitcnt lgkmcnt(" #n ")" ::: "memory")
#define PG8_BAR __builtin_amdgcn_s_barrier()
#define PG8_SCHED __builtin_amdgcn_sched_barrier(0)
    Unit cur, nxt; int ui = 0;
    if (!S.next(0, cur)) return;
    f32x4 acc[2][2][4][2];
#pragma unroll
    for (int a = 0; a < 2; ++a)
#pragma unroll
        for (int b = 0; b < 2; ++b)
#pragma unroll
            for (int m = 0; m < 4; ++m)
#pragma unroll
                for (int n = 0; n < 2; ++n) acc[a][b][m][n] = (f32x4){0.f, 0.f, 0.f, 0.f};
    bf16x8 At[4][2], B0[2][2], B1[2][2];
    const char* cA = a_base(g, cur) + (size_t)cur.pm * tstepA; const char* cB = (const char*)g.Bt + (size_t)cur.pn * tstepB;
    S.a_ready(cur);
    if constexpr (SP2) {
        PG8_STAGE(PG8_SB(0, 0), cB, voffB); PG8_STAGE(PG8_SB(0, 1), cB + hstepB, voffB); PG8_STAGE(PG8_SA(0, 0), cA, voffA); PG8_STAGE(PG8_SA(0, 1), cA + hstepA, voffA);
        if (wr == 1) PG8_BAR;
        PG8_WAIT_V(2); PG8_BAR;
        PG8_STAGE(PG8_SB(1, 0), cB + kstep, voffB); PG8_STAGE(PG8_SA(1, 0), cA + kstep, voffA); PG8_STAGE(PG8_SB(1, 1), cB + hstepB + kstep, voffB);
        PG8_WAIT_V(6); PG8_BAR;
    } else {
        PG8_STAGE(PG8_SB(0, 0), cB, voffB); PG8_STAGE(PG8_SA(0, 0), cA, voffA); PG8_STAGE(PG8_SB(0, 1), cB + hstepB, voffB); PG8_STAGE(PG8_SA(0, 1), cA + hstepA, voffA);
        if (wr == 1) PG8_BAR;
        PG8_WAIT_V(4); PG8_BAR;
        PG8_STAGE(PG8_SB(1, 0), cB + kstep, voffB); PG8_STAGE(PG8_SA(1, 0), cA + kstep, voffA); PG8_STAGE(PG8_SB(1, 1), cB + hstepB + kstep, voffB);
        PG8_WAIT_V(6); PG8_BAR;
    }
    for (;;) {
        const bool has_next = S.next(ui + 1, nxt);
        const char* nA = has_next ? a_base(g, nxt) + (size_t)nxt.pm * tstepA : cA; const char* nB = has_next ? (const char*)g.Bt + (size_t)nxt.pn * tstepB : cB;
        for (int t = 0; t < nt; t += 2) {
            const bool last = (t == nt - 2);
            const char* a1 = cA + (size_t)(t + 1) * kstep;
            const char* a2 = last ? nA : cA + (size_t)(t + 2) * kstep; const char* b2 = last ? nB : cB + (size_t)(t + 2) * kstep;
            const char* a3 = a2 + kstep; const char* b3 = b2 + kstep;
            if (last && has_next) S.a_ready(nxt);
            if constexpr (SP2) {
            PG8_LDB(B0, 0, 0); PG8_LDB(B1, 0, 1); PG8_SCHED; PG8_LDA(At, 0, 0); PG8_STAGE(PG8_SA(1, 1), a1 + hstepA, voffA);
            PG8_WAIT_V(8); PG8_WAIT_L(0); PG8_BAR; PG8_MMA(0, 0, At, B0); PG8_MMA(0, 1, At, B1); PG8_BAR; PG8_SCHED;
            PG8_LDA(At, 0, 1); PG8_STAGE(PG8_SB(0, 0), b2, voffB); PG8_STAGE(PG8_SB(0, 1), b2 + hstepB, voffB); PG8_STAGE(PG8_SA(0, 0), a2, voffA);
            PG8_WAIT_V(8); PG8_WAIT_L(0); PG8_BAR; PG8_MMA(1, 0, At, B0); PG8_MMA(1, 1, At, B1); PG8_BAR; PG8_SCHED;
            PG8_LDB(B0, 1, 0); PG8_LDB(B1, 1, 1); PG8_SCHED; PG8_LDA(At, 1, 0); PG8_STAGE(PG8_SA(0, 1), a2 + hstepA, voffA);
            PG8_WAIT_V(8); PG8_WAIT_L(0); PG8_BAR; PG8_MMA(0, 0, At, B0); PG8_MMA(0, 1, At, B1); PG8_BAR; PG8_SCHED;
            PG8_LDA(At, 1, 1); PG8_STAGE(PG8_SB(1, 0), b3, voffB); PG8_STAGE(PG8_SB(1, 1), b3 + hstepB, voffB); PG8_STAGE(PG8_SA(1, 0), a3, voffA);
            PG8_WAIT_V(8); PG8_WAIT_L(0); PG8_BAR; PG8_MMA(1, 0, At, B0); PG8_MMA(1, 1, At, B1); PG8_BAR; PG8_SCHED;
            } else {
            PG8_LDB(B0, 0, 0); PG8_SCHED; PG8_LDA(At, 0, 0); PG8_STAGE(PG8_SA(1, 1), a1 + hstepA, voffA);
            PG8_WAIT_L(8); PG8_BAR; PG8_WAIT_L(0); PG8_MMA(0, 0, At, B0); PG8_BAR; PG8_SCHED;
            PG8_LDB(B1, 0, 1); PG8_STAGE(PG8_SB(0, 0), b2, voffB);
            PG8_BAR; PG8_WAIT_L(0); PG8_MMA(0, 1, At, B1); PG8_BAR;
            PG8_LDA(At, 0, 1); PG8_STAGE(PG8_SA(0, 0), a2, voffA);
            PG8_BAR; PG8_WAIT_L(0); PG8_MMA(1, 0, At, B0); PG8_BAR; PG8_SCHED;
            PG8_STAGE(PG8_SB(0, 1), b2 + hstepB, voffB);
            PG8_WAIT_V(6); PG8_BAR; PG8_MMA(1, 1, At, B1); PG8_BAR;
            PG8_LDB(B0, 1, 0); PG8_SCHED; PG8_LDA(At, 1, 0); PG8_STAGE(PG8_SA(0, 1), a2 + hstepA, voffA);
            PG8_WAIT_L(8); PG8_BAR; PG8_WAIT_L(0); PG8_MMA(0, 0, At, B0); PG8_BAR; PG8_SCHED;
            PG8_LDB(B1, 1, 1); PG8_STAGE(PG8_SB(1, 0), b3, voffB);
            PG8_BAR; PG8_WAIT_L(0); PG8_MMA(0, 1, At, B1); PG8_BAR;
            PG8_LDA(At, 1, 1); PG8_STAGE(PG8_SA(1, 0), a3, voffA);
            PG8_BAR; PG8_WAIT_L(0); PG8_MMA(1, 0, At, B0); PG8_BAR; PG8_SCHED;
            PG8_STAGE(PG8_SB(1, 1), b3 + hstepB, voffB);
            PG8_WAIT_V(6); PG8_BAR; PG8_MMA(1, 1, At, B1); PG8_BAR;
            }
        }
        if constexpr (ALIGN_EPI) { if (wr == 0) PG8_BAR; }
        if constexpr (!Epi::AFTER_DRAIN) { E(acc, cur, wr, wc, fr, fq); S.done(cur); }
        if (!has_next) break;
#pragma unroll
        for (int a = 0; a < 2; ++a)
#pragma unroll
            for (int b = 0; b < 2; ++b)
#pragma unroll
                for (int m = 0; m < 4; ++m)
#pragma unroll
                    for (int n = 0; n < 2; ++n) acc[a][b][m][n] = (f32x4){0.f, 0.f, 0.f, 0.f};
        cur = nxt; cA = nA; cB = nB; ++ui;
        if constexpr (ALIGN_EPI) { if (wr == 1) PG8_BAR; }
    }
    PG8_WAIT_V(0);
    if constexpr (!ALIGN_EPI) { if (wr == 0) PG8_BAR; }
    PG8_BAR;
    if constexpr (Epi::AFTER_DRAIN) { E.fused(acc, cur, wr, wc, fr, fq, lds, wid, lane); S.done(cur); }
#undef PG8_SA
#undef PG8_SB
#undef PG8_STAGE
#undef PG8_LDA
#undef PG8_LDB
#undef PG8_MMA
#undef PG8_WAIT_V
#undef PG8_WAIT_L
#undef PG8_BAR
#undef PG8_SCHED
}
}

#define LAS __attribute__((address_space(3)))
typedef unsigned short bf16;
typedef unsigned v4u __attribute__((ext_vector_type(4)));
typedef unsigned v2u __attribute__((ext_vector_type(2)));
typedef float f32x4 __attribute__((ext_vector_type(4)));
typedef float f32x16 __attribute__((ext_vector_type(16)));
typedef short bf16x8 __attribute__((ext_vector_type(8)));
typedef short s16x4 __attribute__((ext_vector_type(4)));
typedef float f32x2_t __attribute__((ext_vector_type(2)));
typedef __bf16 bf16x2_t __attribute__((ext_vector_type(2)));

constexpr int NB = 8, SEQ = 2048, DM = 1024, TT = NB * SEQ;
constexpr int DIN = 7912, NP = 7936;
constexpr int PP = 3840, NZG = 4096;
constexpr int MEML = 256;
constexpr float EPS = 1e-6f, NEGF = -1e30f;
constexpr int C_QA = 0, C_KA = 512, C_VA = 1024, C_QI = 1536, C_KI = 2048, C_WI = 2112, C_CQ = 2120, C_CKV = 2504, C_KR = 2760, C_QM = 2792, C_ZM = 3304;
constexpr int C_YA = C_QI, C_YB = C_CQ, C_YM = C_VA;
constexpr float SCALE_A = 0.18033688011112042f;
constexpr float SCALE_B = 0.14724444602590306f;
constexpr float SCALE_M = 0.12751743082459868f;
constexpr float SCALE_I = 0.04419417382415922f;

__constant__ float INVA[8] = {1.0f, 0.1939227432012558f, 0.03760603070259094f, 0.007292664609849453f, 0.0014142135623842478f, 0.00027424818836152554f, 5.3182957344688475e-05f, 1.0313385246263351e-05f};
__constant__ float INVB[16] = {1.0f, 0.44036659598350525f, 0.1939227432012558f, 0.08539710193872452f, 0.03760603070259094f, 0.016560440883040428f, 0.007292664609849453f, 0.0032114461064338684f, 0.0014142135623842478f, 0.0006227724370546639f, 0.00027424818836152554f, 0.00012076973507646471f, 5.3182957344688475e-05f, 2.34199997066753e-05f, 1.0313385246263351e-05f, 4.541670477919979e-06f};

constexpr size_t MiB = 1u << 20;
constexpr size_t WS_CTL = 0;
constexpr size_t WS_WIN = 1 * MiB;
constexpr size_t WS_WUQ = 17 * MiB;
constexpr size_t WS_WUKV = 18 * MiB;
constexpr size_t WS_WMEM = 19 * MiB;
constexpr size_t WS_WBR = 21 * MiB;
constexpr size_t WS_WOUT = 24 * MiB;
constexpr size_t WS_ROPEA = 26 * MiB;
constexpr size_t WS_ROPEB = 27 * MiB;
constexpr size_t WS_MN = 29 * MiB;
constexpr size_t WS_KVM = 33 * MiB;
constexpr size_t WS_VTM = 37 * MiB;
constexpr size_t WS_WI = 39 * MiB;
constexpr size_t WS_MASK = 40 * MiB;
constexpr size_t WS_H = 44 * MiB;
constexpr size_t WS_P = 76 * MiB;
constexpr size_t WS_QB = 196 * MiB;
constexpr size_t WS_KVB = 220 * MiB;
constexpr size_t WS_G1 = 196 * MiB;
constexpr size_t WS_END = 256 * MiB;
constexpr size_t DO_VTA = 0;
constexpr size_t DO_VTB = 16 * MiB;
constexpr size_t DO_KB = 32 * MiB;
constexpr size_t DO_G0 = 0;

constexpr int REP_P0 = 1, REP_PH = 1, REP_G1 = 1, REP_G2 = 1, REP_IDX = 1, REP_ATT = 1, REP_G4 = 1, REP_G5 = 1;
constexpr int REP_IDX1 = 1, REP_SEL = 1;
constexpr int ATT_STRIP = 0;
constexpr int EXTRA_SYNCS = 0, REP_TR = 1, DUMMY_POST1 = 0, DUMMY_POST2 = 0;
constexpr int LDS_BYTES = 147456;
constexpr int LDS_SLOT = LDS_BYTES - 64;

__device__ __forceinline__ unsigned pk2(float lo, float hi) { f32x2_t v = {lo, hi}; bf16x2_t b = __builtin_convertvector(v, bf16x2_t); return __builtin_bit_cast(unsigned, b); }
__device__ __forceinline__ float bflo(unsigned w) { return __uint_as_float(w << 16); }
__device__ __forceinline__ float bfhi(unsigned w) { return __uint_as_float(w & 0xffff0000u); }
__device__ __forceinline__ float bf1(bf16 b) { return __uint_as_float(((unsigned)b) << 16); }
#define UNPACK8(W_, V_) do { V_[0] = bflo((W_)[0]); V_[1] = bfhi((W_)[0]); V_[2] = bflo((W_)[1]); V_[3] = bfhi((W_)[1]); V_[4] = bflo((W_)[2]); V_[5] = bfhi((W_)[2]); V_[6] = bflo((W_)[3]); V_[7] = bfhi((W_)[3]); } while (0)
#define PACK8(V_) (v4u){pk2(V_[0], V_[1]), pk2(V_[2], V_[3]), pk2(V_[4], V_[5]), pk2(V_[6], V_[7])}
template <int CTRL> __device__ __forceinline__ float dpp_f(float v) { return __int_as_float(__builtin_amdgcn_update_dpp(0, __float_as_int(v), CTRL, 0xF, 0xF, false)); }
#define SUM8(x) do { x += dpp_f<0xB1>(x); x += dpp_f<0x4E>(x); x += dpp_f<0x141>(x); } while (0)
#define SUM16(x) do { SUM8(x); x += dpp_f<0x140>(x); } while (0)
__device__ __forceinline__ float wave_sum(float v) {
    SUM16(v);
    return __int_as_float(__builtin_amdgcn_readlane(__float_as_int(v), 0)) + __int_as_float(__builtin_amdgcn_readlane(__float_as_int(v), 16))
         + __int_as_float(__builtin_amdgcn_readlane(__float_as_int(v), 32)) + __int_as_float(__builtin_amdgcn_readlane(__float_as_int(v), 48));
}
#define LDS_WAIT() asm volatile("s_waitcnt lgkmcnt(0)" ::: "memory")

__device__ __forceinline__ int win_src(int d) {
    if (d < 2120) return d;
    if (d < 2792) return d + 512;
    if (d < 3816) return d + 1024;
    if (d < 3840) return -1;
    if (d < 4352) return d - 3840 + 2120;
    if (d < 4864) return d - 4352 + 3304;
    return d - 4864 + 4840;
}
template <bool REMAP>
__device__ __forceinline__ void transpose_item(const float* W, int K, int N, int Npad, bf16* WT, LAS float* scr, int item, int lane) {
    const int nblk = Npad / 32, kb = item / nblk, nb = item % nblk, k0 = 64 * kb, n0 = 32 * nb;
    const int n4 = 4 * (lane & 7);
    const int nn = REMAP ? win_src(n0 + n4) : n0 + n4; const bool ok = nn >= 0 && nn < N;
#pragma unroll
    for (int i = 0; i < 8; ++i) { const int kk = 8 * i + (lane >> 3);
        f32x4 v = (f32x4){0.f, 0.f, 0.f, 0.f}; if (ok) v = __builtin_nontemporal_load((const f32x4*)(W + (size_t)(k0 + kk) * N + nn));
        LAS float* d = scr + kk * 33 + n4; d[0] = v[0]; d[1] = v[1]; d[2] = v[2]; d[3] = v[3]; }
    LDS_WAIT(); asm volatile("" ::: "memory");
    const int c = lane & 7;
#pragma unroll
    for (int j = 0; j < 4; ++j) { const int n = (lane >> 3) + 8 * j; const LAS float* s = scr + (8 * c) * 33 + n;
        v4u o; o.x = pk2(s[0 * 33], s[1 * 33]); o.y = pk2(s[2 * 33], s[3 * 33]); o.z = pk2(s[4 * 33], s[5 * 33]); o.w = pk2(s[6 * 33], s[7 * 33]);
        *(v4u*)(WT + (size_t)(n0 + n) * K + k0 + 8 * c) = o; }
    LDS_WAIT(); asm volatile("" ::: "memory");
}
__device__ __forceinline__ void rms_row_1024(const float* xrow, const float* g, bf16* orow, int lane) {
    const f32x4* xr = (const f32x4*)xrow + lane; const f32x4* gr = (const f32x4*)g + lane;
    f32x4 v[4]; float s = 0.f;
#pragma unroll
    for (int j = 0; j < 4; ++j) { v[j] = __builtin_nontemporal_load(xr + 64 * j); s += (v[j].x * v[j].x + v[j].y * v[j].y) + (v[j].z * v[j].z + v[j].w * v[j].w); }
    const float rstd = __builtin_amdgcn_rsqf(wave_sum(s) * (1.f / 1024.f) + EPS);
    v2u* o8 = (v2u*)orow + lane;
#pragma unroll
    for (int j = 0; j < 4; ++j) { const f32x4 gg = gr[64 * j]; v2u w; w.x = pk2(v[j].x * rstd * gg.x, v[j].y * rstd * gg.y); w.y = pk2(v[j].z * rstd * gg.z, v[j].w * rstd * gg.w); o8[64 * j] = w; }
}

#define ROPE8(v, sub, c8, s8) do { _Pragma("unroll") for (int j_ = 0; j_ < 8; ++j_) { const float pv_ = dpp_f<0xB1>(v[j_]); \
        const float r0_ = v[j_] * c8[j_] - pv_ * s8[j_], r1_ = v[j_] * c8[j_] + pv_ * s8[j_]; v[j_] = (sub) == 0 ? r0_ : ((sub) == 1 ? r1_ : v[j_]); } } while (0)

__device__ __forceinline__ void post1_row(const bf16* Prow, bf16* Orow, const float* ra, const float (&ga)[8], const float (&gk)[8], const float (&gq)[8], const float (&gc)[8], const float (&gm)[8], float* WIrow, int lane) {
    const int sub = lane & 7;
    const v4u z4 = (v4u){0u, 0u, 0u, 0u};
    const v4u w_qa = *(const v4u*)(Prow + C_QA + 8 * lane);
    const v4u w_ka = *(const v4u*)(Prow + C_KA + 8 * lane);
    const v4u w_qi = *(const v4u*)(Prow + C_QI + 8 * lane);
    v4u w_ki = z4, w_cq = z4, w_ckv = z4; float w_wi = 0.f;
    if (lane < 8) { w_ki = *(const v4u*)(Prow + C_KI + 8 * lane); w_wi = bf1(Prow[C_WI + lane]); }
    if (lane < 48) w_cq = *(const v4u*)(Prow + C_CQ + 8 * lane);
    if (lane < 32) w_ckv = *(const v4u*)(Prow + C_CKV + 8 * lane);
    float c8[8], s8[8];
    { const f32x4 r0 = *(const f32x4*)(ra), r1 = *(const f32x4*)(ra + 4), r2 = *(const f32x4*)(ra + 8), r3 = *(const f32x4*)(ra + 12);
      c8[0] = r0[0]; c8[1] = r0[1]; c8[2] = r0[2]; c8[3] = r0[3]; c8[4] = r1[0]; c8[5] = r1[1]; c8[6] = r1[2]; c8[7] = r1[3];
      s8[0] = r2[0]; s8[1] = r2[1]; s8[2] = r2[2]; s8[3] = r2[3]; s8[4] = r3[0]; s8[5] = r3[1]; s8[6] = r3[2]; s8[7] = r3[3]; }
    { float v[8]; UNPACK8(w_qa, v); float ss = 0.f;
#pragma unroll
      for (int j = 0; j < 8; ++j) ss += v[j] * v[j];
      SUM8(ss);
      const float rstd = __builtin_amdgcn_rsqf(ss * (1.f / 64.f) + EPS);
#pragma unroll
      for (int j = 0; j < 8; ++j) v[j] = v[j] * rstd * ga[j];
      ROPE8(v, sub, c8, s8);
#pragma unroll
      for (int j = 0; j < 8; ++j) v[j] *= SCALE_A;
      *(v4u*)(Orow + C_QA + 8 * lane) = PACK8(v); }
    { float v[8]; UNPACK8(w_ka, v); float ss = 0.f;
#pragma unroll
      for (int j = 0; j < 8; ++j) ss += v[j] * v[j];
      SUM8(ss);
      const float rstd = __builtin_amdgcn_rsqf(ss * (1.f / 64.f) + EPS);
#pragma unroll
      for (int j = 0; j < 8; ++j) v[j] = v[j] * rstd * gk[j];
      ROPE8(v, sub, c8, s8);
      *(v4u*)(Orow + C_KA + 8 * lane) = PACK8(v); }
    { float v[8]; UNPACK8(w_qi, v);
      ROPE8(v, sub, c8, s8);
      *(v4u*)(Orow + C_QI + 8 * lane) = PACK8(v); }
    { float v[8]; UNPACK8(w_ki, v);
      ROPE8(v, sub, c8, s8);
      if (lane < 8) *(v4u*)(Orow + C_KI + 8 * lane) = PACK8(v); }
    if (lane < 8) WIrow[lane] = w_wi * SCALE_I;
    { float v[8]; UNPACK8(w_cq, v); float ss = 0.f;
#pragma unroll
      for (int j = 0; j < 8; ++j) ss += v[j] * v[j];
      ss = wave_sum(ss); const float rstd = __builtin_amdgcn_rsqf(ss * (1.f / 384.f) + EPS);
      if (lane < 48) {
#pragma unroll
          for (int j = 0; j < 8; ++j) v[j] = v[j] * rstd * gq[j];
          *(v4u*)(Orow + C_CQ + 8 * lane) = PACK8(v); } }
    { float v[8]; UNPACK8(w_ckv, v); float ss = 0.f;
#pragma unroll
      for (int j = 0; j < 8; ++j) ss += v[j] * v[j];
      ss = wave_sum(ss); const float rstd = __builtin_amdgcn_rsqf(ss * (1.f / 256.f) + EPS);
      if (lane < 32) {
#pragma unroll
          for (int j = 0; j < 8; ++j) v[j] = v[j] * rstd * gc[j];
          *(v4u*)(Orow + C_CKV + 8 * lane) = PACK8(v); } }
}

__device__ __forceinline__ void km_row(bf16* row, const float* gkm, int lane) {
    v4u w = *(const v4u*)(row + 8 * lane); float v[8]; UNPACK8(w, v); float ss = 0.f;
#pragma unroll
    for (int j = 0; j < 8; ++j) ss += v[j] * v[j];
    SUM16(ss);
    const float rstd = __builtin_amdgcn_rsqf(ss * (1.f / 128.f) + EPS);
#pragma unroll
    for (int j = 0; j < 8; ++j) v[j] = v[j] * rstd * gkm[8 * (lane & 15) + j];
    *(v4u*)(row + 8 * lane) = PACK8(v);
}

__device__ __forceinline__ void transpose_v(const bf16* src, int pitch, int col0, int hstride, int H, int DV, int S, int nb, bf16* dst, int gw, int NGW, int lane) {
    const int ndq = DV / 64, nsc = S / 64, ntask = nb * H * nsc * ndq;
    for (int task = gw; task < ntask; task += NGW) {
        int x = task; const int dq = x % ndq; x /= ndq; const int sc = x % nsc; x /= nsc; const int h = x % H; const int b = x / H;
        const int s = sc * 64 + lane;
        const bf16* srow = src + (size_t)(b * S + s) * pitch + col0 + h * hstride + dq * 64;
        bf16* drow = dst + ((size_t)((b * H + h) * DV + dq * 64)) * S + s;
        v4u wv[8];
#pragma unroll
        for (int c = 0; c < 8; ++c) wv[c] = *(const v4u*)(srow + 8 * c);
#pragma unroll
        for (int c = 0; c < 8; ++c) { const v4u w = wv[c];
            drow[(size_t)(8 * c + 0) * S] = (bf16)(w.x & 0xffffu); drow[(size_t)(8 * c + 1) * S] = (bf16)(w.x >> 16);
            drow[(size_t)(8 * c + 2) * S] = (bf16)(w.y & 0xffffu); drow[(size_t)(8 * c + 3) * S] = (bf16)(w.y >> 16);
            drow[(size_t)(8 * c + 4) * S] = (bf16)(w.z & 0xffffu); drow[(size_t)(8 * c + 5) * S] = (bf16)(w.z >> 16);
            drow[(size_t)(8 * c + 6) * S] = (bf16)(w.w & 0xffffu); drow[(size_t)(8 * c + 7) * S] = (bf16)(w.w >> 16); }
    }
}

__device__ __forceinline__ void post2_row(const bf16* QBrow, bf16* QOrow, const bf16* KVBrow, const bf16* Prow, bf16* KBrow, const float* rb, const float (&gqv)[12], const float (&gkv)[12], LAS float* scr, int lane) {
    const int hd = lane >> 3, d0 = 12 * (lane & 7);
    float vq[12], vk[12], cc[12], sn[12];
    { const v2u* p = (const v2u*)(QBrow + 12 * lane);
      const v2u w0 = p[0], w1 = p[1], w2 = p[2];
      bf16 kr[12];
#pragma unroll
      for (int e = 0; e < 12; ++e) { const int d = d0 + e; kr[e] = d < 64 ? KVBrow[hd * 128 + d] : Prow[C_KR + d - 64]; }
#pragma unroll
      for (int e = 0; e < 12; ++e) { const int d = d0 + e; const int i = (d - 64) & 15; cc[e] = d < 64 ? 1.f : rb[i]; sn[e] = d < 64 ? 0.f : rb[16 + i]; }
      vq[0] = bflo(w0.x); vq[1] = bfhi(w0.x); vq[2] = bflo(w0.y); vq[3] = bfhi(w0.y); vq[4] = bflo(w1.x); vq[5] = bfhi(w1.x); vq[6] = bflo(w1.y); vq[7] = bfhi(w1.y);
      vq[8] = bflo(w2.x); vq[9] = bfhi(w2.x); vq[10] = bflo(w2.y); vq[11] = bfhi(w2.y);
#pragma unroll
      for (int e = 0; e < 12; ++e) vk[e] = bf1(kr[e]); }
    float sq = 0.f, sk = 0.f;
#pragma unroll
    for (int e = 0; e < 12; ++e) { sq += vq[e] * vq[e]; sk += vk[e] * vk[e]; }
    SUM8(sq); SUM8(sk);
    const float rq = __builtin_amdgcn_rsqf(sq * (1.f / 96.f) + EPS), rk = __builtin_amdgcn_rsqf(sk * (1.f / 96.f) + EPS);
#pragma unroll
    for (int e = 0; e < 12; ++e) { vq[e] = vq[e] * rq * gqv[e]; vk[e] = vk[e] * rk * gkv[e]; scr[12 * lane + e] = vq[e]; scr[768 + 12 * lane + e] = vk[e]; }
    LDS_WAIT(); asm volatile("" ::: "memory");
    float oq[12], ok[12];
#pragma unroll
    for (int e = 0; e < 12; ++e) { const int d = d0 + e;
        if (d < 64) { oq[e] = vq[e]; ok[e] = vk[e]; }
        else { const bool first = d < 80; const int off = first ? 16 : -16; const float pq = scr[12 * lane + e + off], pk = scr[768 + 12 * lane + e + off];
               oq[e] = first ? vq[e] * cc[e] - pq * sn[e] : vq[e] * cc[e] + pq * sn[e];
               ok[e] = first ? vk[e] * cc[e] - pk * sn[e] : vk[e] * cc[e] + pk * sn[e]; }
        oq[e] *= SCALE_B; }
    LDS_WAIT(); asm volatile("" ::: "memory");
    v2u* q = (v2u*)(QOrow + 12 * lane); v2u* k = (v2u*)(KBrow + 12 * lane);
#pragma unroll
    for (int i = 0; i < 3; ++i) { v2u w; w.x = pk2(oq[4 * i], oq[4 * i + 1]); w.y = pk2(oq[4 * i + 2], oq[4 * i + 3]); q[i] = w;
                                  v2u u; u.x = pk2(ok[4 * i], ok[4 * i + 1]); u.y = pk2(ok[4 * i + 2], ok[4 * i + 3]); k[i] = u; }
}

__device__ __forceinline__ int next_unit(unsigned* ctr, volatile LAS int* slot) {
    __syncthreads();
    if (threadIdx.x == 0) *slot = (int)atomicAdd(ctr, 1u);
    __syncthreads();
    return *slot;
}

constexpr int SCP = 2112;
__device__ __forceinline__ unsigned ord_key(float v) { const unsigned b = __float_as_uint(v); return b ^ ((unsigned)((int)b >> 31) | 0x80000000u); }
__device__ __forceinline__ void indexer_load_q(const bf16* P, const float* WI, int u, bf16x8 (&qf)[8][2], float (&wq)[8]) {
    const int lane = threadIdx.x & 63, n = lane & 15, g = lane >> 4;
    const int tb = 127 - (u >> 3), bb = u & 7;
    const size_t row = (size_t)(bb * SEQ + tb * 16 + n);
    const bf16* qrow = P + row * PP + C_QI + 8 * g;
#pragma unroll
    for (int h = 0; h < 8; ++h) { qf[h][0] = *(const bf16x8*)(qrow + h * 64); qf[h][1] = *(const bf16x8*)(qrow + h * 64 + 32); wq[h] = WI[row * 8 + h]; }
}
__device__ __forceinline__ void indexer_unit(LAS float* sc, const bf16* P, const float* WI, unsigned* MASK, int bb, int tb, bf16x8 (&qf)[8][2], float (&wq)[8],
                                             int tk, volatile LAS int* slot, int nunits, int& un) {
    int tid_ = threadIdx.x; asm volatile("" : "+v"(tid_));
    const int tid = tid_, lane = tid & 63, w = __builtin_amdgcn_readfirstlane(tid >> 6);
    const int n = lane & 15, g = lane >> 4;
    const int rowbase = bb * SEQ, t0 = tb * 16;
    {
        const int ntile = tb + 1;
        const int nmine = (ntile - w + 7) >> 3;
        const int ngrp = (nmine + 3) >> 2;
        const bf16* kbase = P + (size_t)(rowbase + n) * PP + C_KI + 8 * g;
        bf16x8 kb[2][4][2];
#define IDX_LOAD(BUF, GRP) do { _Pragma("unroll") for (int j_ = 0; j_ < 4; ++j_) { const int tile_ = w + 8 * (4 * (GRP) + j_); const int tl_ = tile_ < ntile ? tile_ : 0; \
            const bf16* kr_ = kbase + (size_t)(16 * tl_) * PP; kb[BUF][j_][0] = *(const bf16x8*)(kr_); kb[BUF][j_][1] = *(const bf16x8*)(kr_ + 32); } } while (0)
#define IDX_COMP(BUF, GRP) do { _Pragma("unroll") for (int j_ = 0; j_ < 4; ++j_) { const int tile_ = w + 8 * (4 * (GRP) + j_); if (tile_ < ntile) { \
            f32x4 idx_ = (f32x4){0.f, 0.f, 0.f, 0.f}; \
            _Pragma("unroll") for (int h_ = 0; h_ < 8; ++h_) { f32x4 a_ = (f32x4){0.f, 0.f, 0.f, 0.f}; \
                a_ = __builtin_amdgcn_mfma_f32_16x16x32_bf16(kb[BUF][j_][0], qf[h_][0], a_, 0, 0, 0); \
                a_ = __builtin_amdgcn_mfma_f32_16x16x32_bf16(kb[BUF][j_][1], qf[h_][1], a_, 0, 0, 0); \
                _Pragma("unroll") for (int i_ = 0; i_ < 4; ++i_) idx_[i_] = __builtin_fmaf(wq[h_], __builtin_fmaxf(a_[i_], 0.f), idx_[i_]); } \
            { const int k0_ = 16 * tile_ + 4 * g; LAS float* d_ = sc + n * SCP + k0_ + (k0_ >> 5); d_[0] = idx_[0]; d_[1] = idx_[1]; d_[2] = idx_[2]; d_[3] = idx_[3]; } } } } while (0)
        if (ngrp > 0) IDX_LOAD(0, 0);
        for (int gp = 0; gp < ngrp; gp += 2) {
            if (gp + 1 < ngrp) IDX_LOAD(1, gp + 1);
            IDX_COMP(0, gp);
            if (gp + 1 < ngrp) { if (gp + 2 < ngrp) IDX_LOAD(0, gp + 2); IDX_COMP(1, gp + 1); }
        }
#undef IDX_LOAD
#undef IDX_COMP
    }
    if (tid == 0) *slot = tk;
    __syncthreads();
    un = *slot;
    if (un < nunits) indexer_load_q(P, WI, un, qf, wq);
    for (int rs = 0; rs < REP_SEL; ++rs) {
        const int ta = t0 + 2 * w, tb2 = ta + 1;
        unsigned* mra = MASK + (size_t)(rowbase + ta) * 64; unsigned* mrb = mra + 64;
        const int nva = ta - 32 * lane + 1, nvb = nva + 1;
        const unsigned valid_a = nva >= 32 ? 0xffffffffu : (nva <= 0 ? 0u : ((1u << nva) - 1u));
        const unsigned valid_b = nvb >= 32 ? 0xffffffffu : (nvb <= 0 ? 0u : ((1u << nvb) - 1u));
        if (ta < 256) { mra[lane] = valid_a; mrb[lane] = valid_b; continue; }
        unsigned ua[32], ub[32];
        { const LAS float* sra = sc + (2 * w) * SCP + 33 * lane; const LAS float* srb = sra + SCP;
#pragma unroll
          for (int r = 0; r < 32; ++r) { const float va = sra[r], vb = srb[r]; ua[r] = ((valid_a >> r) & 1u) ? ord_key(va) : 0u; ub[r] = ((valid_b >> r) & 1u) ? ord_key(vb) : 0u; } }
#pragma unroll
        for (int k = 0; k < 16; ++k) {
            const unsigned a0 = ua[k], a1 = ua[k + 16]; ua[k] = __builtin_amdgcn_perm(a1, a0, 0x05040100u); ua[k + 16] = __builtin_amdgcn_perm(a1, a0, 0x07060302u);
            const unsigned b0 = ub[k], b1 = ub[k + 16]; ub[k] = __builtin_amdgcn_perm(b1, b0, 0x05040100u); ub[k + 16] = __builtin_amdgcn_perm(b1, b0, 0x07060302u); }
#pragma unroll
        for (int k = 0; k < 32; ++k) if (!(k & 8)) {
            const unsigned a0 = ua[k], a1 = ua[k + 8]; ua[k] = __builtin_amdgcn_perm(a1, a0, 0x06020400u); ua[k + 8] = __builtin_amdgcn_perm(a1, a0, 0x07030501u);
            const unsigned b0 = ub[k], b1 = ub[k + 8]; ub[k] = __builtin_amdgcn_perm(b1, b0, 0x06020400u); ub[k + 8] = __builtin_amdgcn_perm(b1, b0, 0x07030501u); }
#pragma unroll
        for (int si = 2; si < 5; ++si) { const int sft = 16 >> si;
            const unsigned msk = si == 2 ? 0x0f0f0f0fu : (si == 3 ? 0x33333333u : 0x55555555u);
#pragma unroll
            for (int k = 0; k < 32; ++k) if (!(k & sft)) {
                const unsigned a0 = ua[k], a1 = ua[k + sft]; ua[k] = (a0 & msk) | ((a1 << sft) & ~msk); ua[k + sft] = ((a0 >> sft) & msk) | (a1 & ~msk);
                const unsigned b0 = ub[k], b1 = ub[k + sft]; ub[k] = (b0 & msk) | ((b1 << sft) & ~msk); ub[k + sft] = ((b0 >> sft) & msk) | (b1 & ~msk); } }
        unsigned alive_a = valid_a, sel_a = 0u, alive_b = valid_b, sel_b = 0u; int need_a = 256, need_b = 256; bool run_a = true, run_b = true;
#pragma unroll
        for (int j = 31; j >= 0; --j) {
            const unsigned ones_a = alive_a & ua[j], ones_b = alive_b & ub[j];
            int v = (int)((unsigned)__popc(ones_a) | ((unsigned)__popc(ones_b) << 16));
            v += __builtin_amdgcn_update_dpp(0, v, 0xB1, 0xF, 0xF, false);
            v += __builtin_amdgcn_update_dpp(0, v, 0x4E, 0xF, 0xF, false);
            v += __builtin_amdgcn_update_dpp(0, v, 0x141, 0xF, 0xF, false);
            v += __builtin_amdgcn_update_dpp(0, v, 0x140, 0xF, 0xF, false);
            const unsigned tot = (unsigned)(__builtin_amdgcn_readlane(v, 0) + __builtin_amdgcn_readlane(v, 16) + __builtin_amdgcn_readlane(v, 32) + __builtin_amdgcn_readlane(v, 48));
            const int ca = (int)(tot & 0xffffu), cb = (int)(tot >> 16);
            if (run_a) { if (ca >= need_a) { alive_a = ones_a; if (ca == need_a) { sel_a |= ones_a; need_a = 0; run_a = false; } }
                         else { need_a -= ca; sel_a |= ones_a; alive_a &= ~ua[j]; } }
            if (run_b) { if (cb >= need_b) { alive_b = ones_b; if (cb == need_b) { sel_b |= ones_b; need_b = 0; run_b = false; } }
                         else { need_b -= cb; sel_b |= ones_b; alive_b &= ~ub[j]; } }
            if (!run_a && !run_b) break;
        }
        if (need_a > 0) {
            const int cnt = __popc(alive_a); int inc = cnt;
#pragma unroll
            for (int d = 1; d < 64; d <<= 1) { const int o = __shfl_up(inc, d); if (lane >= d) inc += o; }
            int k = need_a - (inc - cnt); k = k < 0 ? 0 : (k > cnt ? cnt : k);
            unsigned m = alive_a;
            for (int i = 0; i < k; ++i) { const unsigned low = m & (0u - m); sel_a |= low; m ^= low; }
        }
        if (need_b > 0) {
            const int cnt = __popc(alive_b); int inc = cnt;
#pragma unroll
            for (int d = 1; d < 64; d <<= 1) { const int o = __shfl_up(inc, d); if (lane >= d) inc += o; }
            int k = need_b - (inc - cnt); k = k < 0 ? 0 : (k > cnt ? cnt : k);
            unsigned m = alive_b;
            for (int i = 0; i < k; ++i) { const unsigned low = m & (0u - m); sel_b |= low; m ^= low; }
        }
        mra[lane] = sel_a; mrb[lane] = sel_b;
        (void)tb2;
    }
    __syncthreads();
}

__device__ __forceinline__ float half_max(float m) { auto rr = __builtin_amdgcn_permlane32_swap(__float_as_uint(m), __float_as_uint(m), false, false); return __builtin_fmaxf(__uint_as_float(rr[0]), __uint_as_float(rr[1])); }
__device__ __forceinline__ float half_sum(float m) { auto rr = __builtin_amdgcn_permlane32_swap(__float_as_uint(m), __float_as_uint(m), false, false); return __uint_as_float(rr[0]) + __uint_as_float(rr[1]); }
__device__ __forceinline__ int crow(int r, int hi) { return (r & 3) + 8 * (r >> 2) + 4 * hi; }
template <int DQK, int DV, int MODE, int STRIP = 0>
__device__ __forceinline__ void attn_unit(LAS unsigned char* lds, const bf16* Qb, int qpitch, const bf16* Kb, int kpitch, const bf16* VTb, int skv,
                                          const unsigned* maskb, const bf16* Zb, bf16* Ob, int q0) {
    constexpr int TK = 128, KP = DQK + 8, VP = TK + 8;
    LAS bf16* Ks = (LAS bf16*)lds; LAS bf16* Vs = Ks + TK * KP;
    constexpr int CPR = DQK / 8;
    constexpr int NCK = TK * CPR, NCV = DV * (TK / 8);
    constexpr int RK = (NCK + 511) / 512, RV = (NCV + 511) / 512;
    constexpr int NKS = DQK / 16, NMT = DV / 32;
    int tid_ = threadIdx.x; asm volatile("" : "+v"(tid_));
    const int tid = tid_, lane = tid & 63, w = __builtin_amdgcn_readfirstlane(tid >> 6), r = lane & 31, hh = lane >> 5;
    const int NT = MODE == 0 ? skv / TK : (q0 + 256) / TK;
    const int qlo = q0 + 32 * w;
    bf16x8 qf[NKS];
    { const bf16* qrow = Qb + (size_t)(qlo + r) * qpitch + 8 * hh;
#pragma unroll
      for (int ks = 0; ks < NKS; ++ks) qf[ks] = *(const bf16x8*)(qrow + 16 * ks); }
    f32x16 o[NMT];
#pragma unroll
    for (int mt = 0; mt < NMT; ++mt)
#pragma unroll
        for (int i = 0; i < 16; ++i) o[mt][i] = 0.f;
    float m_run = NEGF, l_run = 0.f;
    v4u kreg[RK], vreg[RV];
#define ATT_PREFETCH(tile_) do { \
        _Pragma("unroll") for (int i_ = 0; i_ < RK; ++i_) { const int c_ = tid + 512 * i_; if (c_ < NCK) { const int row_ = c_ / CPR, cc_ = c_ % CPR; kreg[i_] = *(const v4u*)(Kb + (size_t)(TK * (tile_) + row_) * kpitch + 8 * cc_); } } \
        _Pragma("unroll") for (int i_ = 0; i_ < RV; ++i_) { const int c_ = tid + 512 * i_; if (c_ < NCV) { const int d_ = c_ >> 4, cc_ = c_ & 15; vreg[i_] = *(const v4u*)(VTb + (size_t)d_ * skv + TK * (tile_) + 8 * cc_); } } } while (0)
    if (STRIP != 2) ATT_PREFETCH(0);
    for (int tile = 0; tile < NT; ++tile) {
        __syncthreads();
        if (STRIP != 2) {
#pragma unroll
        for (int i = 0; i < RK; ++i) { const int c = tid + 512 * i; if (c < NCK) { const int row = c / CPR, cc = c % CPR; *(LAS v4u*)(Ks + row * KP + 8 * cc) = kreg[i]; } }
#pragma unroll
        for (int i = 0; i < RV; ++i) { const int c = tid + 512 * i; if (c < NCV) { const int d = c >> 4, cc = c & 15; *(LAS v4u*)(Vs + d * VP + 8 * cc) = vreg[i]; } }
        }
        __syncthreads();
        if (STRIP != 2 && tile + 1 < NT) ATT_PREFETCH(tile + 1);
        __builtin_amdgcn_sched_barrier(0);
        if (STRIP == 1) continue;
#pragma unroll 1
        for (int sub = 0; sub < 2; ++sub) {
        const int t64 = 2 * tile + sub;
        if (MODE != 0 && 64 * t64 > qlo + 31) continue;
        const LAS bf16* Kc = Ks + 64 * sub * KP; const LAS bf16* Vc = Vs + 64 * sub;
        unsigned mw0 = 0u, mw1 = 0u;
        if (MODE == 2) { const v2u mm = *(const v2u*)(maskb + (size_t)(qlo + r) * 64 + 2 * t64); mw0 = mm.x >> (4 * hh); mw1 = mm.y >> (4 * hh); }
        f32x16 s0, s1;
#pragma unroll
        for (int i = 0; i < 16; ++i) { s0[i] = 0.f; s1[i] = 0.f; }
#pragma unroll
        for (int ks = 0; ks < NKS; ++ks) {
            const bf16x8 a0 = *(const LAS bf16x8*)(Kc + r * KP + 16 * ks + 8 * hh);
            const bf16x8 a1 = *(const LAS bf16x8*)(Kc + (32 + r) * KP + 16 * ks + 8 * hh);
            s0 = __builtin_amdgcn_mfma_f32_32x32x16_bf16(a0, qf[ks], s0, 0, 0, 0);
            s1 = __builtin_amdgcn_mfma_f32_32x32x16_bf16(a1, qf[ks], s1, 0, 0, 0);
        }
        if (MODE == 1) {
            if (64 * t64 + 63 > qlo) { const int qg = qlo + r;
#pragma unroll
                for (int i = 0; i < 16; ++i) { const int key = 64 * t64 + crow(i, hh); if (key > qg) s0[i] = NEGF; if (key + 32 > qg) s1[i] = NEGF; } }
        }
        if (MODE == 2) {
#pragma unroll
            for (int i = 0; i < 16; ++i) { const int bit = (i & 3) + 8 * (i >> 2); if (!((mw0 >> bit) & 1u)) s0[i] = NEGF; if (!((mw1 >> bit) & 1u)) s1[i] = NEGF; }
        }
        float mx = s0[0];
#pragma unroll
        for (int i = 1; i < 16; ++i) mx = __builtin_fmaxf(mx, s0[i]);
#pragma unroll
        for (int i = 0; i < 16; ++i) mx = __builtin_fmaxf(mx, s1[i]);
        mx = half_max(mx);
        const float m_new = __builtin_fmaxf(m_run, mx);
        const float alpha = __builtin_amdgcn_exp2f(m_run - m_new);
        m_run = m_new;
        float ls = 0.f;
#pragma unroll
        for (int i = 0; i < 16; ++i) { s0[i] = __builtin_amdgcn_exp2f(s0[i] - m_new); s1[i] = __builtin_amdgcn_exp2f(s1[i] - m_new); ls += s0[i] + s1[i]; }
        l_run = l_run * alpha + ls;
#pragma unroll
        for (int mt = 0; mt < NMT; ++mt)
#pragma unroll
            for (int i = 0; i < 16; ++i) o[mt][i] *= alpha;
        v4u pf[2][2];
#pragma unroll
        for (int s = 0; s < 2; ++s) {
            pf[0][s] = (v4u){pk2(s0[8 * s], s0[8 * s + 1]), pk2(s0[8 * s + 2], s0[8 * s + 3]), pk2(s0[8 * s + 4], s0[8 * s + 5]), pk2(s0[8 * s + 6], s0[8 * s + 7])};
            pf[1][s] = (v4u){pk2(s1[8 * s], s1[8 * s + 1]), pk2(s1[8 * s + 2], s1[8 * s + 3]), pk2(s1[8 * s + 4], s1[8 * s + 5]), pk2(s1[8 * s + 6], s1[8 * s + 7])};
        }
#pragma unroll
        for (int mt = 0; mt < NMT; ++mt)
#pragma unroll
            for (int p = 0; p < 2; ++p)
#pragma unroll
                for (int s = 0; s < 2; ++s) {
                    const LAS bf16* vp = Vc + (32 * mt + r) * VP + 32 * p + 16 * s + 4 * hh;
                    const s16x4 lo = *(const LAS s16x4*)(vp), hi = *(const LAS s16x4*)(vp + 8);
                    const bf16x8 a = (bf16x8){lo[0], lo[1], lo[2], lo[3], hi[0], hi[1], hi[2], hi[3]};
                    o[mt] = __builtin_amdgcn_mfma_f32_32x32x16_bf16(a, __builtin_bit_cast(bf16x8, pf[p][s]), o[mt], 0, 0, 0);
                }
        }
    }
#undef ATT_PREFETCH
    const float l_tot = half_sum(l_run);
    const float inv = 1.0f / l_tot;
    const size_t row = (size_t)(qlo + r);
#pragma unroll
    for (int mt = 0; mt < NMT; ++mt)
#pragma unroll
        for (int g4 = 0; g4 < 4; ++g4) {
            const int d = 32 * mt + 8 * g4 + 4 * hh;
            float ov[4];
#pragma unroll
            for (int i = 0; i < 4; ++i) ov[i] = o[mt][4 * g4 + i] * inv;
            if (Zb) { const v2u zw = *(const v2u*)(Zb + row * PP + d); const float z[4] = {bflo(zw.x), bfhi(zw.x), bflo(zw.y), bfhi(zw.y)};
#pragma unroll
                for (int i = 0; i < 4; ++i) ov[i] *= z[i] * __builtin_amdgcn_rcpf(1.0f + __expf(-z[i])); }
            v2u ow; ow.x = pk2(ov[0], ov[1]); ow.y = pk2(ov[2], ov[3]);
            *(v2u*)(Ob + row * PP + d) = ow;
        }
}

template <int DQK, int MODE>
__device__ __forceinline__ void attn_unit_pipe(LAS unsigned char* lds, const bf16* Qb, int qpitch, const bf16* Kb, int kpitch, const bf16* VTb, int skv,
                                               const unsigned* maskb, bf16* Ob, int q0) {
    constexpr int DV = 64, KP = DQK + 8, VP = 72, BUFE = 64 * KP + DV * VP;
    constexpr int CPR = DQK / 8, NCK = 64 * CPR, NCV = DV * 8, RK = (NCK + 511) / 512, RV = (NCV + 511) / 512, NKS = DQK / 16, NMT = DV / 32;
    static_assert(NCV == 512 && (NCK == 512 || NCK == 768), "staging map");
    int tid_ = threadIdx.x; asm volatile("" : "+v"(tid_));
    const int tid = tid_, lane = tid & 63, w = __builtin_amdgcn_readfirstlane(tid >> 6), r = lane & 31, hh = lane >> 5;
    const int NT = (q0 + 256) / 64;
    const int qlo = q0 + 32 * w;
    const int NTw = ((qlo + 31) >> 6) + 1;
    int krow[RK], kcc[RK];
#pragma unroll
    for (int i = 0; i < RK; ++i) { int c = tid + 512 * i; if (c >= NCK) c -= 256; krow[i] = c / CPR; kcc[i] = c % CPR; }
    const int vd = tid >> 3, vcc = tid & 7;
    bf16x8 qf[NKS];
    { const bf16* qrow = Qb + (size_t)(qlo + r) * qpitch + 8 * hh;
#pragma unroll
      for (int ks = 0; ks < NKS; ++ks) qf[ks] = *(const bf16x8*)(qrow + 16 * ks); }
    f32x16 o[NMT];
#pragma unroll
    for (int mt = 0; mt < NMT; ++mt)
#pragma unroll
        for (int i = 0; i < 16; ++i) o[mt][i] = 0.f;
    float m_run = NEGF, l_run = 0.f, alpha = 1.f;
    v4u kreg[2][RK], vreg[2][RV]; v2u mset[2];
    const unsigned* mrowp = MODE == 2 ? maskb + (size_t)(qlo + r) * 64 : nullptr;
#define PL_LOAD(S_, tile_) do { const int tl_ = (tile_) < NT ? (tile_) : NT - 1; \
        if (MODE == 2) { const int mt_ = (tile_) >= 2 ? ((tile_) - 2 < 32 ? (tile_) - 2 : 31) : 0; mset[S_] = *(const v2u*)(mrowp + 2 * mt_); }     \
        _Pragma("unroll") for (int i_ = 0; i_ < RK; ++i_) kreg[S_][i_] = *(const v4u*)(Kb + (size_t)(64 * tl_ + krow[i_]) * kpitch + 8 * kcc[i_]); \
        vreg[S_][0] = *(const v4u*)(VTb + (size_t)vd * skv + 64 * tl_ + 8 * vcc); } while (0)
#define PL_STAGE(S_, buf_) do { LAS bf16* Kd_ = (LAS bf16*)lds + (buf_) * BUFE; LAS bf16* Vd_ = Kd_ + 64 * KP; \
        _Pragma("unroll") for (int i_ = 0; i_ < RK; ++i_) *(LAS v4u*)(Kd_ + krow[i_] * KP + 8 * kcc[i_]) = kreg[S_][i_]; \
        *(LAS v4u*)(Vd_ + vd * VP + 8 * vcc) = vreg[S_][0]; } while (0)
#define PL_QK(t_, D0_, D1_) do { const LAS bf16* Kc_ = (const LAS bf16*)lds + ((t_) & 3) * BUFE; \
        _Pragma("unroll") for (int i_ = 0; i_ < 16; ++i_) { D0_[i_] = 0.f; D1_[i_] = 0.f; } \
        _Pragma("unroll") for (int ks_ = 0; ks_ < NKS; ++ks_) { \
            const bf16x8 a0_ = *(const LAS bf16x8*)(Kc_ + r * KP + 16 * ks_ + 8 * hh); const bf16x8 a1_ = *(const LAS bf16x8*)(Kc_ + (32 + r) * KP + 16 * ks_ + 8 * hh); \
            D0_ = __builtin_amdgcn_mfma_f32_32x32x16_bf16(a0_, qf[ks_], D0_, 0, 0, 0); D1_ = __builtin_amdgcn_mfma_f32_32x32x16_bf16(a1_, qf[ks_], D1_, 0, 0, 0); } } while (0)
#define PL_PV(t_) do { const LAS bf16* Vc_ = (const LAS bf16*)lds + ((t_) & 3) * BUFE + 64 * KP; \
        _Pragma("unroll") for (int mt_ = 0; mt_ < NMT; ++mt_) _Pragma("unroll") for (int i_ = 0; i_ < 16; ++i_) o[mt_][i_] *= alpha; \
        _Pragma("unroll") for (int mt_ = 0; mt_ < NMT; ++mt_) _Pragma("unroll") for (int p_ = 0; p_ < 2; ++p_) _Pragma("unroll") for (int s_ = 0; s_ < 2; ++s_) { \
            const LAS bf16* vp_ = Vc_ + (32 * mt_ + r) * VP + 32 * p_ + 16 * s_ + 4 * hh; \
            const s16x4 lo_ = *(const LAS s16x4*)(vp_), hi_ = *(const LAS s16x4*)(vp_ + 8); \
            const bf16x8 a_ = (bf16x8){lo_[0], lo_[1], lo_[2], lo_[3], hi_[0], hi_[1], hi_[2], hi_[3]}; \
            o[mt_] = __builtin_amdgcn_mfma_f32_32x32x16_bf16(a_, __builtin_bit_cast(bf16x8, pf[p_][s_]), o[mt_], 0, 0, 0); } } while (0)
#define PL_SOFTMAX(t_, C0_, C1_, MK_, CAUSAL_) do { \
        if (MODE == 2) { const unsigned w0_ = (MK_).x >> (4 * hh), w1_ = (MK_).y >> (4 * hh); \
            _Pragma("unroll") for (int i_ = 0; i_ < 16; ++i_) { const int bit_ = (i_ & 3) + 8 * (i_ >> 2); if (!((w0_ >> bit_) & 1u)) C0_[i_] = NEGF; if (!((w1_ >> bit_) & 1u)) C1_[i_] = NEGF; } } \
        if (CAUSAL_) { const int qg_ = qlo + r; \
            _Pragma("unroll") for (int i_ = 0; i_ < 16; ++i_) { const int key_ = 64 * (t_) + crow(i_, hh); if (key_ > qg_) C0_[i_] = NEGF; if (key_ + 32 > qg_) C1_[i_] = NEGF; } } \
        float mx_ = C0_[0]; \
        _Pragma("unroll") for (int i_ = 1; i_ < 16; ++i_) mx_ = __builtin_fmaxf(mx_, C0_[i_]); \
        _Pragma("unroll") for (int i_ = 0; i_ < 16; ++i_) mx_ = __builtin_fmaxf(mx_, C1_[i_]); \
        mx_ = half_max(mx_); \
        const float mn_ = __builtin_fmaxf(m_run, mx_); alpha = __builtin_amdgcn_exp2f(m_run - mn_); m_run = mn_; \
        float ls_ = 0.f; \
        _Pragma("unroll") for (int i_ = 0; i_ < 16; ++i_) { C0_[i_] = __builtin_amdgcn_exp2f(C0_[i_] - mn_); C1_[i_] = __builtin_amdgcn_exp2f(C1_[i_] - mn_); ls_ += C0_[i_] + C1_[i_]; } \
        l_run = l_run * alpha + ls_; \
        _Pragma("unroll") for (int s_ = 0; s_ < 2; ++s_) { \
            pf[0][s_] = (v4u){pk2(C0_[8 * s_], C0_[8 * s_ + 1]), pk2(C0_[8 * s_ + 2], C0_[8 * s_ + 3]), pk2(C0_[8 * s_ + 4], C0_[8 * s_ + 5]), pk2(C0_[8 * s_ + 6], C0_[8 * s_ + 7])}; \
            pf[1][s_] = (v4u){pk2(C1_[8 * s_], C1_[8 * s_ + 1]), pk2(C1_[8 * s_ + 2], C1_[8 * s_ + 3]), pk2(C1_[8 * s_ + 4], C1_[8 * s_ + 5]), pk2(C1_[8 * s_ + 6], C1_[8 * s_ + 7])}; } } while (0)
#define PL_IO(t_, S_) do { PL_STAGE(S_, ((t_) + 2) & 3); PL_LOAD(S_, (t_) + 4); } while (0)
#define PL_STEADY(t_, S_) do { const v2u mk_ = mset[S_]; PL_IO(t_, S_); if (MODE == 2) { asm volatile("" :: "v"(mk_.x), "v"(mk_.y)); } \
        PL_QK((t_) + 1, n0, n1); PL_PV((t_) - 1); PL_SOFTMAX(t_, c0, c1, mk_, false); c0 = n0; c1 = n1; __syncthreads(); } while (0)
#define PL_TAIL(t_, S_) do { const v2u mk_ = mset[S_]; PL_IO(t_, S_); if ((t_) >= 1) PL_PV((t_) - 1); PL_SOFTMAX(t_, c0, c1, mk_, MODE == 1); PL_PV(t_); __syncthreads(); } while (0)
    f32x16 c0, c1, n0, n1; v4u pf[2][2];
    PL_LOAD(0, 0); PL_LOAD(1, 1);
    PL_STAGE(0, 0); PL_STAGE(1, 1);
    PL_LOAD(0, 2); PL_LOAD(1, 3);
    __syncthreads();
    PL_QK(0, c0, c1);
    int t = 0;
    if (NTw >= 2) {
        { const v2u mk_ = mset[0]; PL_IO(0, 0); PL_QK(1, n0, n1); PL_SOFTMAX(0, c0, c1, mk_, false); c0 = n0; c1 = n1; __syncthreads(); }
        for (t = 1; t + 1 < NTw; ) {
            PL_STEADY(t, 1); ++t;
            if (t + 1 < NTw) { PL_STEADY(t, 0); ++t; }
        }
    }
    if (t & 1) PL_TAIL(t, 1); else PL_TAIL(t, 0);
    for (++t; t < NT; ++t) { if (t & 1) PL_IO(t, 1); else PL_IO(t, 0); __syncthreads(); }
#undef PL_LOAD
#undef PL_STAGE
#undef PL_QK
#undef PL_PV
#undef PL_SOFTMAX
#undef PL_IO
#undef PL_STEADY
#undef PL_TAIL
    const float l_tot = half_sum(l_run);
    const float inv = 1.0f / l_tot;
    const size_t row = (size_t)(qlo + r);
#pragma unroll
    for (int mt = 0; mt < NMT; ++mt)
#pragma unroll
        for (int k2 = 0; k2 < 2; ++k2) {
            const int ga = 2 * k2, gb = 2 * k2 + 1;
            const unsigned a0 = pk2(o[mt][4 * ga] * inv, o[mt][4 * ga + 1] * inv), a1 = pk2(o[mt][4 * ga + 2] * inv, o[mt][4 * ga + 3] * inv);
            const unsigned b0 = pk2(o[mt][4 * gb] * inv, o[mt][4 * gb + 1] * inv), b1 = pk2(o[mt][4 * gb + 2] * inv, o[mt][4 * gb + 3] * inv);
            const auto s0 = __builtin_amdgcn_permlane32_swap(a0, b0, false, false);
            const auto s1 = __builtin_amdgcn_permlane32_swap(a1, b1, false, false);
            *(v4u*)(Ob + row * PP + 32 * mt + 16 * k2 + 8 * hh) = (v4u){s0[0], s1[0], s0[1], s1[1]};
        }
}

__device__ __forceinline__ void attn_unit_mem(LAS unsigned char* lds, const bf16* Qb, const float* gqm, const bf16* Kb, const bf16* VTb, const bf16* Zb, bf16* Ob, int q0) {
    constexpr int DQK = 128, KP = DQK + 8, VP = MEML + 8, NKS = DQK / 16, NMT = 4;
    LAS bf16* Ks = (LAS bf16*)lds; LAS bf16* Vs = Ks + MEML * KP;
    int tid_ = threadIdx.x; asm volatile("" : "+v"(tid_));
    const int tid = tid_, lane = tid & 63, w = __builtin_amdgcn_readfirstlane(tid >> 6), r = lane & 31, hh = lane >> 5;
    { v4u kk[8], vv[8];
#pragma unroll
      for (int i = 0; i < 8; ++i) { const int c = tid + 512 * i; kk[i] = *(const v4u*)(Kb + (size_t)(c >> 4) * 1024 + 8 * (c & 15)); vv[i] = *(const v4u*)(VTb + (size_t)(c >> 5) * MEML + 8 * (c & 31)); }
#pragma unroll
      for (int i = 0; i < 8; ++i) { const int c = tid + 512 * i; *(LAS v4u*)(Ks + (c >> 4) * KP + 8 * (c & 15)) = kk[i]; *(LAS v4u*)(Vs + (c >> 5) * VP + 8 * (c & 31)) = vv[i]; } }
    __syncthreads();
#pragma unroll 1
    for (int qb = 0; qb < 2; ++qb) {
        const int qlo = q0 + 256 * qb + 32 * w;
        bf16x8 qf[NKS];
        { const bf16* qrow = Qb + (size_t)(qlo + r) * PP + 8 * hh;
#pragma unroll
          for (int ks = 0; ks < NKS; ++ks) qf[ks] = *(const bf16x8*)(qrow + 16 * ks);
          float ss = 0.f;
#pragma unroll
          for (int ks = 0; ks < NKS; ++ks) { const v4u w = __builtin_bit_cast(v4u, qf[ks]); float v[8]; UNPACK8(w, v);
#pragma unroll
              for (int j = 0; j < 8; ++j) ss += v[j] * v[j]; }
          const float rs = __builtin_amdgcn_rsqf(half_sum(ss) * (1.f / 128.f) + EPS) * SCALE_M;
#pragma unroll
          for (int ks = 0; ks < NKS; ++ks) { const v4u w = __builtin_bit_cast(v4u, qf[ks]); float v[8]; UNPACK8(w, v);
              const f32x4 g0 = *(const f32x4*)(gqm + 16 * ks + 8 * hh), g1 = *(const f32x4*)(gqm + 16 * ks + 8 * hh + 4);
              v[0] *= rs * g0[0]; v[1] *= rs * g0[1]; v[2] *= rs * g0[2]; v[3] *= rs * g0[3]; v[4] *= rs * g1[0]; v[5] *= rs * g1[1]; v[6] *= rs * g1[2]; v[7] *= rs * g1[3];
              const v4u p = PACK8(v); qf[ks] = __builtin_bit_cast(bf16x8, p); } }
        f32x16 o[NMT];
#pragma unroll
        for (int mt = 0; mt < NMT; ++mt)
#pragma unroll
            for (int i = 0; i < 16; ++i) o[mt][i] = 0.f;
        float m_run = NEGF, l_run = 0.f;
#pragma unroll 1
        for (int sub = 0; sub < MEML / 64; ++sub) {
            const LAS bf16* Kc = Ks + 64 * sub * KP; const LAS bf16* Vc = Vs + 64 * sub;
            f32x16 s0, s1;
#pragma unroll
            for (int i = 0; i < 16; ++i) { s0[i] = 0.f; s1[i] = 0.f; }
#pragma unroll
            for (int ks = 0; ks < NKS; ++ks) {
                const bf16x8 a0 = *(const LAS bf16x8*)(Kc + r * KP + 16 * ks + 8 * hh);
                const bf16x8 a1 = *(const LAS bf16x8*)(Kc + (32 + r) * KP + 16 * ks + 8 * hh);
                s0 = __builtin_amdgcn_mfma_f32_32x32x16_bf16(a0, qf[ks], s0, 0, 0, 0);
                s1 = __builtin_amdgcn_mfma_f32_32x32x16_bf16(a1, qf[ks], s1, 0, 0, 0);
            }
            float mx = s0[0];
#pragma unroll
            for (int i = 1; i < 16; ++i) mx = __builtin_fmaxf(mx, s0[i]);
#pragma unroll
            for (int i = 0; i < 16; ++i) mx = __builtin_fmaxf(mx, s1[i]);
            mx = half_max(mx);
            const float m_new = __builtin_fmaxf(m_run, mx);
            const float alpha = __builtin_amdgcn_exp2f(m_run - m_new);
            m_run = m_new;
            float ls = 0.f;
#pragma unroll
            for (int i = 0; i < 16; ++i) { s0[i] = __builtin_amdgcn_exp2f(s0[i] - m_new); s1[i] = __builtin_amdgcn_exp2f(s1[i] - m_new); ls += s0[i] + s1[i]; }
            l_run = l_run * alpha + ls;
#pragma unroll
            for (int mt = 0; mt < NMT; ++mt)
#pragma unroll
                for (int i = 0; i < 16; ++i) o[mt][i] *= alpha;
            v4u pf[2][2];
#pragma unroll
            for (int s = 0; s < 2; ++s) {
                pf[0][s] = (v4u){pk2(s0[8 * s], s0[8 * s + 1]), pk2(s0[8 * s + 2], s0[8 * s + 3]), pk2(s0[8 * s + 4], s0[8 * s + 5]), pk2(s0[8 * s + 6], s0[8 * s + 7])};
                pf[1][s] = (v4u){pk2(s1[8 * s], s1[8 * s + 1]), pk2(s1[8 * s + 2], s1[8 * s + 3]), pk2(s1[8 * s + 4], s1[8 * s + 5]), pk2(s1[8 * s + 6], s1[8 * s + 7])};
            }
#pragma unroll
            for (int mt = 0; mt < NMT; ++mt)
#pragma unroll
                for (int p = 0; p < 2; ++p)
#pragma unroll
                    for (int s = 0; s < 2; ++s) {
                        const LAS bf16* vp = Vc + (32 * mt + r) * VP + 32 * p + 16 * s + 4 * hh;
                        const s16x4 lo = *(const LAS s16x4*)(vp), hi = *(const LAS s16x4*)(vp + 8);
                        const bf16x8 a = (bf16x8){lo[0], lo[1], lo[2], lo[3], hi[0], hi[1], hi[2], hi[3]};
                        o[mt] = __builtin_amdgcn_mfma_f32_32x32x16_bf16(a, __builtin_bit_cast(bf16x8, pf[p][s]), o[mt], 0, 0, 0);
                    }
        }
        const float inv = 1.0f / half_sum(l_run);
        const size_t row = (size_t)(qlo + r);
#pragma unroll
        for (int mt = 0; mt < NMT; ++mt)
#pragma unroll
            for (int g4 = 0; g4 < 4; ++g4) {
                const int d = 32 * mt + 8 * g4 + 4 * hh;
                const v2u zw = *(const v2u*)(Zb + row * PP + d); const float z[4] = {bflo(zw.x), bfhi(zw.x), bflo(zw.y), bfhi(zw.y)};
                float ov[4];
#pragma unroll
                for (int i = 0; i < 4; ++i) ov[i] = o[mt][4 * g4 + i] * inv * (z[i] * __builtin_amdgcn_rcpf(1.0f + __expf(-z[i])));
                v2u ow; ow.x = pk2(ov[0], ov[1]); ow.y = pk2(ov[2], ov[3]);
                *(v2u*)(Ob + row * PP + d) = ow;
            }
    }
}

__device__ __forceinline__ bf16* gate_row(bf16* G0, bf16* G1, size_t row) { return row < 8192 ? G0 + row * 3072 : G1 + (row - 8192) * 3072; }
struct EpiZG {
    static constexpr bool PERM = true, AFTER_DRAIN = false;
    bf16* P; bf16* G0; bf16* G1;
    __device__ __forceinline__ void operator()(const pg8::f32x4 (&acc)[2][2][4][2], const pg8::Unit& u, int wr, int wc, int fr, int fq) const {
        const int row0 = u.pm * 256 + wr * 64 + fr, cl = wc * 32 + 8 * fq;
        const bool isz = u.pn < 4;
        const int ycol = (u.pn < 2 ? C_YA : C_YB) + (u.pn & 1) * 256, gcol = (u.pn - 4) * 256;
#pragma unroll
        for (int ai = 0; ai < 2; ++ai)
#pragma unroll
            for (int m = 0; m < 4; ++m) { const size_t row = (size_t)(row0 + ai * 128 + m * 16);
#pragma unroll
                for (int bj = 0; bj < 2; ++bj) {
                    const pg8::f32x4 v0 = acc[ai][bj][m][0], v1 = acc[ai][bj][m][1];
                    float rr[8] = {v0[0], v0[1], v0[2], v0[3], v1[0], v1[1], v1[2], v1[3]};
                    if (isz) { bf16* dst = P + row * PP + ycol + cl + bj * 128; const v4u old = *(const v4u*)dst; float yv[8]; UNPACK8(old, yv);
#pragma unroll
                        for (int e = 0; e < 8; ++e) rr[e] = yv[e] * (rr[e] * __builtin_amdgcn_rcpf(1.0f + __expf(-rr[e])));
                        *(v4u*)dst = PACK8(rr); }
                    else { bf16* dst = gate_row(G0, G1, row) + gcol + cl + bj * 128;
#pragma unroll
                        for (int e = 0; e < 8; ++e) rr[e] = __builtin_amdgcn_rcpf(1.0f + __expf(-rr[e]));
                        *(v4u*)dst = PACK8(rr); } } }
    }
};
struct EpiStoreVT {
    static constexpr bool PERM = true, AFTER_DRAIN = false;
    bf16* O; int ldc; bf16* VT;
    int vbeg, vend, hshift, voff, DV, sshift;
    __device__ __forceinline__ void operator()(const pg8::f32x4 (&acc)[2][2][4][2], const pg8::Unit& u, int wr, int wc, int fr, int fq) const {
        const int row0 = u.pm * 256 + wr * 64 + fr, col0 = u.pn * 256 + wc * 32 + 8 * fq;
        const int H = (vend - vbeg) >> hshift, S = 1 << sshift;
        bool isv[2]; long voffs[2];
#pragma unroll
        for (int bj = 0; bj < 2; ++bj) { const int col = col0 + bj * 128, cr = col - vbeg, within = cr & ((1 << hshift) - 1);
            isv[bj] = col >= vbeg && col < vend && within >= voff;
            voffs[bj] = ((long)((cr >> hshift) * DV + within - voff)) << sshift; }
#pragma unroll
        for (int ai = 0; ai < 2; ++ai)
#pragma unroll
            for (int m = 0; m < 4; ++m) { const int row = row0 + ai * 128 + m * 16;
                const int b = row >> sshift, sp = row & (S - 1);
#pragma unroll
                for (int bj = 0; bj < 2; ++bj) {
                    const pg8::f32x4 v0 = acc[ai][bj][m][0], v1 = acc[ai][bj][m][1];
                    const unsigned w0 = pk2(v0[0], v0[1]), w1 = pk2(v0[2], v0[3]), w2 = pk2(v1[0], v1[1]), w3 = pk2(v1[2], v1[3]);
                    if (!isv[bj]) *(v4u*)(O + (size_t)row * ldc + col0 + bj * 128) = (v4u){w0, w1, w2, w3};
                    else { bf16* dst = VT + (((long)(b * H * DV)) << sshift) + voffs[bj] + sp;
                        dst[0] = (bf16)(w0 & 0xffffu); dst[(size_t)S] = (bf16)(w0 >> 16); dst[(size_t)2 * S] = (bf16)(w1 & 0xffffu); dst[(size_t)3 * S] = (bf16)(w1 >> 16);
                        dst[(size_t)4 * S] = (bf16)(w2 & 0xffffu); dst[(size_t)5 * S] = (bf16)(w2 >> 16); dst[(size_t)6 * S] = (bf16)(w3 & 0xffffu); dst[(size_t)7 * S] = (bf16)(w3 >> 16); } }
                asm volatile("" ::: "memory"); }
    }
};
struct MergeOrder {
    pg8::StaticOrder so;
    __device__ __forceinline__ bool next(int i, pg8::Unit& u) const { pg8::Unit b; if (!so.next(i / 3, b)) return false; u.pm = b.pm; u.pn = (i % 3) * 4 + b.pn; return true; }
    __device__ __forceinline__ void a_ready(const pg8::Unit&) const {}
    __device__ __forceinline__ void done(const pg8::Unit&) const {}
};
struct EpiMerge {
    static constexpr bool PERM = true, AFTER_DRAIN = false;
    bf16* Mg; bf16* G0; bf16* G1;
    __device__ __forceinline__ void operator()(const pg8::f32x4 (&acc)[2][2][4][2], const pg8::Unit& u, int wr, int wc, int fr, int fq) const {
        const int nbr = u.pn >> 2;
        const int row0 = u.pm * 256 + wr * 64 + fr, col0 = (u.pn & 3) * 256 + wc * 32 + 8 * fq;
#pragma unroll
        for (int ai = 0; ai < 2; ++ai)
#pragma unroll
            for (int m = 0; m < 4; ++m) { const size_t row = (size_t)(row0 + ai * 128 + m * 16);
#pragma unroll
                for (int bj = 0; bj < 2; ++bj) { const int col = col0 + bj * 128;
                    const v4u gwd = *(const v4u*)(gate_row(G0, G1, row) + nbr * 1024 + col);
                    float gl[8]; UNPACK8(gwd, gl);
                    const pg8::f32x4 v0 = acc[ai][bj][m][0], v1 = acc[ai][bj][m][1];
                    float rr[8] = {v0[0], v0[1], v0[2], v0[3], v1[0], v1[1], v1[2], v1[3]};
#pragma unroll
                    for (int e = 0; e < 8; ++e) rr[e] *= gl[e];
                    bf16* dst = Mg + row * 1024 + col;
                    if (nbr > 0) { const v4u old = *(const v4u*)dst; float ol[8]; UNPACK8(old, ol);
#pragma unroll
                        for (int e = 0; e < 8; ++e) rr[e] += ol[e]; }
                    *(v4u*)dst = PACK8(rr); } }
    }
};
struct EpiOut {
    static constexpr bool PERM = true, AFTER_DRAIN = false;
    const float* X; float* Out;
    __device__ __forceinline__ void operator()(const pg8::f32x4 (&acc)[2][2][4][2], const pg8::Unit& u, int wr, int wc, int fr, int fq) const {
        const int row0 = u.pm * 256 + wr * 64 + fr, col0 = u.pn * 256 + wc * 32 + 8 * fq;
#pragma unroll
        for (int ai = 0; ai < 2; ++ai)
#pragma unroll
            for (int m = 0; m < 4; ++m) { const size_t row = (size_t)(row0 + ai * 128 + m * 16);
#pragma unroll
                for (int bj = 0; bj < 2; ++bj) { const size_t p = row * 1024 + col0 + bj * 128;
                    const f32x4 x0 = *(const f32x4*)(X + p), x1 = *(const f32x4*)(X + p + 4);
                    const pg8::f32x4 a0 = acc[ai][bj][m][0], a1 = acc[ai][bj][m][1];
                    __builtin_nontemporal_store((f32x4){x0[0] + a0[0], x0[1] + a0[1], x0[2] + a0[2], x0[3] + a0[3]}, (f32x4*)(Out + p));
                    __builtin_nontemporal_store((f32x4){x1[0] + a1[0], x1[1] + a1[1], x1[2] + a1[2], x1[3] + a1[3]}, (f32x4*)(Out + p + 4)); } }
    }
};

#define XB_TMO      128
#define XB_XCNT(j)  (256  + 64 * (j))
#define XB_XSUB(j)  (1280 + 64 * (j))
#define XB_XGEN(j)  (2304 + 64 * (j))
#define XB_TOP      3328
#define XB_TOPGEN   3392
#define XCD_BAR_WORDS 3456
#define XB_SPIN_CAP (1u << 18)

__device__ __forceinline__ unsigned xb_ld(unsigned* p)              { return __hip_atomic_load(p, __ATOMIC_RELAXED, __HIP_MEMORY_SCOPE_AGENT); }
__device__ __forceinline__ unsigned xb_add(unsigned* p, unsigned v) { return __hip_atomic_fetch_add(p, v, __ATOMIC_RELAXED, __HIP_MEMORY_SCOPE_AGENT); }
__device__ __forceinline__ unsigned xb_xcc_id() { return (unsigned)__builtin_amdgcn_s_getreg((3 << 11) | 20) & 0xFu; }
#define XB_SPIN(cond, bar) do { unsigned _sp = 0; while (cond) { __builtin_amdgcn_s_sleep(1); \
    if ((++_sp & 255u) == 0u) { if (xb_ld(&(bar)[XB_TMO])) break; if (_sp > XB_SPIN_CAP) { atomicAdd(&(bar)[XB_TMO], 1u); break; } } } } while (0)

struct XcdBarrier {
    unsigned* bar; unsigned x;
    volatile LAS unsigned* st;
};

__device__ __forceinline__ XcdBarrier xcd_barrier_post(unsigned* bar, volatile LAS unsigned* st) {
    XcdBarrier b; b.bar = bar; b.x = xb_xcc_id(); b.st = st;
    if (threadIdx.x == 0) (void)xb_add(&bar[XB_XCNT(b.x)], 1u);
    return b;
}
__device__ __forceinline__ void xcd_barrier_complete(unsigned* bar, unsigned x, unsigned& nloc, unsigned& nx) {
    const unsigned G = gridDim.x * gridDim.y * gridDim.z;
    unsigned sum, cnt, mine, sp = 0u;
    for (;;) {
        sum = 0u; cnt = 0u; mine = 0u;
#pragma unroll
        for (unsigned j = 0; j < 16; ++j) { const unsigned c = xb_ld(&bar[XB_XCNT(j)]); sum += c; cnt += (c > 0u) ? 1u : 0u; mine = (j == x) ? c : mine; }
        if (sum == G) break;
        __builtin_amdgcn_s_sleep(1);
        if ((++sp & 255u) == 0u) { if (xb_ld(&bar[XB_TMO])) break; if (sp > XB_SPIN_CAP) { atomicAdd(&bar[XB_TMO], 1u); break; } }
    }
    nloc = mine > 0u ? mine : 1u; nx = cnt > 0u ? cnt : 1u;
}

__device__ __forceinline__ void xcd_barrier(const XcdBarrier& b) {
    asm volatile("s_waitcnt vmcnt(0)" ::: "memory");
    __syncthreads();
    if (threadIdx.x == 0) {
        unsigned* bar = b.bar;
        __builtin_amdgcn_s_waitcnt(0);
        unsigned nloc = b.st[0], nx = b.st[1];
        if (nloc == 0u) { xcd_barrier_complete(bar, b.x, nloc, nx); b.st[0] = nloc; b.st[1] = nx; }
        const unsigned old = xb_add(&bar[XB_XSUB(b.x)], 1u);
        const unsigned gen = old / nloc;
        if (old + 1u == (gen + 1u) * nloc) {
            __builtin_amdgcn_fence(__ATOMIC_RELEASE, "agent");
            asm volatile("s_waitcnt vmcnt(0)" ::: "memory");
            const unsigned og = xb_add(&bar[XB_TOP], 1u);
            const unsigned tg = og / nx;
            if (og + 1u == (tg + 1u) * nx) xb_add(&bar[XB_TOPGEN], 1u);
            else XB_SPIN(xb_ld(&bar[XB_TOPGEN]) == tg, bar);
            __builtin_amdgcn_fence(__ATOMIC_ACQUIRE, "agent");
            xb_add(&bar[XB_XGEN(b.x)], 1u);
            asm volatile("s_waitcnt vmcnt(0)" ::: "memory");
        } else {
            XB_SPIN(xb_ld(&bar[XB_XGEN(b.x)]) == gen, bar);
            __builtin_amdgcn_fence(__ATOMIC_ACQUIRE, "agent");
            asm volatile("s_waitcnt vmcnt(0)" ::: "memory");
        }
    }
    __syncthreads();
}

template <int DQK, int DV, int MODE>
__device__ __forceinline__ void att_call(bool strip, LAS unsigned char* lds, const bf16* Qb, int qpitch, const bf16* Kb, int kpitch, const bf16* VTb, int skv, const unsigned* maskb, const bf16* Zb, bf16* Ob, int q0) {
    if (ATT_STRIP != 0 && strip) attn_unit<DQK, DV, MODE, ATT_STRIP>(lds, Qb, qpitch, Kb, kpitch, VTb, skv, maskb, Zb, Ob, q0);
    else attn_unit<DQK, DV, MODE, 0>(lds, Qb, qpitch, Kb, kpitch, VTb, skv, maskb, Zb, Ob, q0);
}
struct Args { const float* in[19]; const int* pos; float* out; unsigned char* ws; };
typedef const __attribute__((address_space(4))) Args* kargs_t;
#define PHASE_BEGIN \
    kargs_t ap_ = (kargs_t)__builtin_amdgcn_kernarg_segment_ptr(); asm volatile("" : "+s"(ap_)); \
    int tid = threadIdx.x; asm volatile("" : "+v"(tid)); \
    const int lane = tid & 63, wave = __builtin_amdgcn_readfirstlane(tid >> 6), G = gridDim.x, NGW = G * 8, gw = blockIdx.x * 8 + wave; \
    unsigned char* const ws = ap_->ws; unsigned char* const dob = (unsigned char*)ap_->out; const int* const pos = ap_->pos; float* const outp = ap_->out; unsigned* const ctl = (unsigned*)(ws + WS_CTL); \
    const float* const x = ap_->in[0]; const float* const mem = ap_->in[1]; \
    const float* const g_norm = ap_->in[3]; const float* const w_in = ap_->in[4]; const float* const g_qn_a = ap_->in[5]; const float* const g_kn_a = ap_->in[6]; \
    const float* const g_cq = ap_->in[7]; const float* const g_ckv = ap_->in[8]; const float* const w_uq = ap_->in[9]; const float* const w_ukv = ap_->in[10]; \
    const float* const g_qn_b = ap_->in[11]; const float* const g_kn_b = ap_->in[12]; const float* const g_mem = ap_->in[13]; const float* const w_mem_kv = ap_->in[14]; \
    const float* const g_qn_m = ap_->in[15]; const float* const g_kn_m = ap_->in[16]; const float* const w_branch = ap_->in[17]; const float* const w_out = ap_->in[18]; \
    bf16* const WinT = (bf16*)(ws + WS_WIN); bf16* const WuqT = (bf16*)(ws + WS_WUQ); bf16* const WukvT = (bf16*)(ws + WS_WUKV); bf16* const WmemT = (bf16*)(ws + WS_WMEM); \
    bf16* const WbrT = (bf16*)(ws + WS_WBR); bf16* const WoutT = (bf16*)(ws + WS_WOUT); \
    float* const ropeA = (float*)(ws + WS_ROPEA); float* const ropeB = (float*)(ws + WS_ROPEB); \
    bf16* const MN = (bf16*)(ws + WS_MN); bf16* const KVM = (bf16*)(ws + WS_KVM); bf16* const VTM = (bf16*)(ws + WS_VTM); \
    float* const WI = (float*)(ws + WS_WI); unsigned* const MASK = (unsigned*)(ws + WS_MASK); \
    bf16* const VTA = (bf16*)(dob + DO_VTA); bf16* const VTB = (bf16*)(dob + DO_VTB); bf16* const KB = (bf16*)(dob + DO_KB); \
    bf16* const Hh = (bf16*)(ws + WS_H); bf16* const MG = (bf16*)(ws + WS_H); bf16* const QB = (bf16*)(ws + WS_QB); \
    bf16* const KVB = (bf16*)(ws + WS_KVB); bf16* const GT0 = (bf16*)(dob + DO_G0); bf16* const GT1 = (bf16*)(ws + WS_G1); bf16* const P = (bf16*)(ws + WS_P); \
    (void)lane; (void)NGW; (void)gw; (void)ctl; \
    (void)pos; (void)outp; (void)x; (void)mem; (void)g_norm; (void)w_in; (void)g_qn_a; (void)g_kn_a; (void)g_cq; (void)g_ckv; (void)w_uq; (void)w_ukv; (void)g_qn_b; (void)g_kn_b; (void)g_mem; (void)w_mem_kv; \
    (void)g_qn_m; (void)g_kn_m; (void)w_branch; (void)w_out; (void)WinT; (void)WuqT; (void)WukvT; (void)WmemT; (void)WbrT; (void)WoutT; (void)ropeA; (void)ropeB; (void)MN; (void)KVM; (void)VTM; (void)WI; (void)MASK; \
    (void)VTA; (void)VTB; (void)Hh; (void)KB; (void)QB; (void)KVB; (void)MG; (void)GT0; (void)GT1; (void)P
#define GRID_BARRIER() do { kargs_t bp_ = (kargs_t)__builtin_amdgcn_kernarg_segment_ptr(); asm volatile("" : "+s"(bp_)); \
    XcdBarrier b_; b_.bar = (unsigned*)(bp_->ws + WS_CTL) + 4096; b_.x = xb_xcc_id(); b_.st = (volatile LAS unsigned*)(lds + LDS_BYTES - 32); xcd_barrier(b_); } while (0)

__global__ void __launch_bounds__(512, 2) fwd_kernel(Args a) {
    extern __shared__ __attribute__((aligned(16))) unsigned char lds_raw[];
    LAS unsigned char* const lds = (LAS unsigned char*)lds_raw;
    volatile LAS int* const slot = (volatile LAS int*)(lds + LDS_SLOT);
    if (threadIdx.x < 16) ((LAS unsigned*)(lds + LDS_BYTES - 64))[threadIdx.x] = 0u;
    __syncthreads();
    (void)xcd_barrier_post((unsigned*)(a.ws + WS_CTL) + 4096, (volatile LAS unsigned*)(lds + LDS_BYTES - 32));

    for (int rep = 0; rep < REP_P0; ++rep) { PHASE_BEGIN;
        LAS float* scr = (LAS float*)(lds + wave * 16384);
        constexpr int I_IN = 16 * (NP / 32), I_UQ = 6 * 24, I_UKV = 4 * 32, I_MEM = 16 * 32, I_BR = 8 * 32, I_OUT = 16 * 32;
        constexpr int NITEMS = I_IN + I_UQ + I_UKV + I_MEM + 3 * I_BR + I_OUT;
        for (int it = gw; it < NITEMS; it += NGW) {
            int r = it;
            if (r < I_IN) { transpose_item<true>(w_in, 1024, DIN, NP, WinT, scr, r, lane); continue; } r -= I_IN;
            if (r < I_UQ) { transpose_item<false>(w_uq, 384, 768, 768, WuqT, scr, r, lane); continue; } r -= I_UQ;
            if (r < I_UKV) { transpose_item<false>(w_ukv, 256, 1024, 1024, WukvT, scr, r, lane); continue; } r -= I_UKV;
            if (r < I_MEM) { transpose_item<false>(w_mem_kv, 1024, 1024, 1024, WmemT, scr, r, lane); continue; } r -= I_MEM;
            continue;
        }
        for (int idx = blockIdx.x * 512 + tid; idx < TT * 24; idx += G * 512) {
            const int t = idx / 24, i = idx % 24; const float pf = (float)pos[t];
            if (i < 8) { const float ang = pf * INVA[i]; ropeA[t * 16 + i] = cosf(ang); ropeA[t * 16 + 8 + i] = sinf(ang); }
            else { const int j = i - 8; const float ang = pf * INVB[j]; ropeB[t * 32 + j] = cosf(ang); ropeB[t * 32 + 16 + j] = sinf(ang); }
        }
        for (int m = gw; m < NB * MEML; m += NGW) rms_row_1024(mem + (size_t)m * DM, g_mem, MN + (size_t)m * DM, lane);
        for (int rp = 0; rp < REP_PH; ++rp)
        for (int m = gw; m < TT; m += NGW) rms_row_1024(x + (size_t)m * DM, g_norm, Hh + (size_t)m * DM, lane);
    }
    GRID_BARRIER();
    for (int es = 0; es < EXTRA_SYNCS; ++es) GRID_BARRIER();

    for (int rep = 0; rep < REP_G1; ++rep) { PHASE_BEGIN;
        pg8::Gemm g{Hh, WinT, TT, PP, 1024, 1024, nullptr, nullptr, nullptr, 0}; pg8::StaticOrder S; S.init(TT, PP, G, (int)blockIdx.x);
        EpiStoreVT E{P, PP, VTA, C_VA, C_VA + 512, 6, 0, 64, 11};
        pg8::gemm_phase<EpiStoreVT, pg8::StaticOrder, true, true>(lds, g, S, E);
    }
    { PHASE_BEGIN;
        pg8::Gemm g{MN, WmemT, NB * MEML, 1024, 1024, 1024, nullptr, nullptr, nullptr, 0}; pg8::StaticOrder S; S.init(NB * MEML, 1024, G, (int)((blockIdx.x + 64) % G));
        EpiStoreVT E{KVM, 1024, VTM, 512, 1024, 7, 0, 128, 8};
        pg8::gemm_phase<EpiStoreVT, pg8::StaticOrder, true, true>(lds, g, S, E);
    }
    if (blockIdx.x >= 224) { PHASE_BEGIN;
        LAS float* scr = (LAS float*)(lds + wave * 16384);
        constexpr int I_IN = 16 * (NP / 32), I_UQ = 6 * 24, I_UKV = 4 * 32, I_MEM = 16 * 32, I_BR = 8 * 32, I_OUT = 16 * 32;
        constexpr int NITEMS = I_IN + I_UQ + I_UKV + I_MEM + 3 * I_BR + I_OUT;
        const int hw = (blockIdx.x - 224) * 8 + wave, NHW = (G - 224) * 8;
        for (int it = I_IN + I_UQ + I_UKV + I_MEM + hw; it < NITEMS; it += NHW) {
            int r = it;
            if (r < I_IN + I_UQ + I_UKV + I_MEM) continue; r -= I_IN + I_UQ + I_UKV + I_MEM;
            if (r < 3 * I_BR) { const int nb = r / I_BR; transpose_item<false>(w_branch + (size_t)nb * 512 * 1024, 512, 1024, 1024, WbrT + (size_t)nb * 1024 * 512, scr, r % I_BR, lane); continue; } r -= 3 * I_BR;
            transpose_item<false>(w_out, 1024, 1024, 1024, WoutT, scr, r, lane);
        }
    }
    GRID_BARRIER();
    { PHASE_BEGIN;
        float ga[8], gk[8], gq[8], gc[8], gm[8];
#pragma unroll
        for (int j = 0; j < 8; ++j) { ga[j] = g_qn_a[8 * (lane & 7) + j]; gk[j] = g_kn_a[8 * (lane & 7) + j]; gm[j] = g_qn_m[8 * (lane & 15) + j]; gq[j] = lane < 48 ? g_cq[8 * lane + j] : 0.f; gc[j] = lane < 32 ? g_ckv[8 * lane + j] : 0.f; }
        for (int dp = 0; dp < DUMMY_POST1; ++dp)
            for (int m = gw; m < TT; m += NGW)
                post1_row(P + (size_t)m * PP, QB + (size_t)(m & 1023) * 4096, ropeA + (size_t)m * 16, ga, gk, gq, gc, gm, (float*)KVB + (size_t)m * 8, lane);
        for (int m = gw; m < TT; m += NGW)
            post1_row(P + (size_t)m * PP, P + (size_t)m * PP, ropeA + (size_t)m * 16, ga, gk, gq, gc, gm, WI + (size_t)m * 8, lane);
        for (int m = gw; m < NB * MEML; m += NGW) km_row(KVM + (size_t)m * 1024, g_kn_m, lane);
    }
    GRID_BARRIER();
    for (int rep = 0; rep < REP_G2; ++rep) { PHASE_BEGIN;
        pg8::Gemm g{P + C_CQ, WuqT, TT, 768, 384, PP, nullptr, nullptr, nullptr, 0}; pg8::StaticOrder S; S.init(TT, 768, G, (int)blockIdx.x);
        pg8::EpiBf16<0> E{QB, 768, nullptr, 0, 0, 1.f};
        pg8::gemm_phase<pg8::EpiBf16<0>, pg8::StaticOrder, true, true>(lds, g, S, E);
    }
    for (int rep = 0; rep < REP_G2; ++rep) { PHASE_BEGIN;
        pg8::Gemm g{P + C_CKV, WukvT, TT, 1024, 256, PP, nullptr, nullptr, nullptr, 0}; pg8::StaticOrder S; S.init(TT, 1024, G, (int)((blockIdx.x + 192) % G));
        pg8::EpiBf16<0> E{KVB, 1024, nullptr, 0, 0, 1.f};
        pg8::gemm_phase<pg8::EpiBf16<0>, pg8::StaticOrder, true, true>(lds, g, S, E);
    }
    for (int rep = 0; rep < REP_IDX; ++rep) { if (rep > 0) GRID_BARRIER();
        PHASE_BEGIN;
        unsigned* const q_idx = ctl + 64 * (0 + 4 * rep);
        int u = next_unit(q_idx, slot);
        bf16x8 qf[8][2]; float wq[8];
        if (u < NB * 128) indexer_load_q(P, WI, u, qf, wq);
        while (u < NB * 128) {
            int tk = 0; if (tid == 0) tk = (int)atomicAdd(q_idx, 1u);
            const int tb = 127 - (u >> 3), bb = u & 7;
            int un;
            indexer_unit((LAS float*)lds, P, WI, MASK, bb, tb, qf, wq, tk, slot, NB * 128, un);
            u = un;
        }
    }
    GRID_BARRIER();
    { PHASE_BEGIN;
        LAS float* scr = (LAS float*)(lds + wave * 8192);
        float gqv[12], gkv[12];
#pragma unroll
        for (int e = 0; e < 12; ++e) { gqv[e] = g_qn_b[12 * (lane & 7) + e]; gkv[e] = g_kn_b[12 * (lane & 7) + e]; }
        for (int dp = 0; dp < DUMMY_POST2; ++dp)
            for (int m = gw; m < TT; m += NGW)
                post2_row(QB + (size_t)m * 768, (bf16*)MASK + (size_t)(m & 1023) * 768, KVB + (size_t)m * 1024, P + (size_t)m * PP, (bf16*)MASK + (size_t)(1024 + (m & 1023)) * 768, ropeB + (size_t)m * 32, gqv, gkv, scr, lane);
        for (int m = gw; m < TT; m += NGW)
            post2_row(QB + (size_t)m * 768, QB + (size_t)m * 768, KVB + (size_t)m * 1024, P + (size_t)m * PP, KB + (size_t)m * 768, ropeB + (size_t)m * 32, gqv, gkv, scr, lane);
        transpose_v(KVB, 1024, 64, 128, 8, 64, SEQ, NB, VTB, gw, NGW, lane);
    }
    GRID_BARRIER();
    for (int rep = 0; rep < REP_ATT; ++rep) { if (rep > 0) GRID_BARRIER();
        PHASE_BEGIN;
        unsigned* const q_att = ctl + 64 * (1 + 4 * rep);
        for (;;) {
            const int u = next_unit(q_att, slot);
            if (u >= 1152) break;
            if (u < 704 || u >= 832) {
                const int uu = u < 704 ? u : u - 128, cls = uu >> 6, bh = uu & 63, bb = bh >> 3, h = bh & 7;
                const bool isA = (0x52a7u >> cls) & 1u; const int qb = (int)((0x11232435467567ull >> (4 * cls)) & 15ull);
                const size_t r0 = (size_t)bb * SEQ;
                if (!isA) attn_unit_pipe<96, 1>(lds, QB + r0 * 768 + h * 96, 768, KB + r0 * 768 + h * 96, 768, VTB + (size_t)((bb * 8 + h) * 64) * SEQ, SEQ, nullptr,
                                                   P + r0 * PP + C_YB + h * 64, qb * 256);
                else attn_unit_pipe<64, 2>(lds, P + r0 * PP + C_QA + h * 64, PP, P + r0 * PP + C_KA + h * 64, PP, VTA + (size_t)((bb * 8 + h) * 64) * SEQ, SEQ, MASK + r0 * 64,
                                           P + r0 * PP + C_YA + h * 64, qb * 256);
            } else {
                const int v = u - 704, hq = v & 3, bh = v >> 2, bb = bh >> 2, h = bh & 3;
                const size_t r0 = (size_t)bb * SEQ;
                attn_unit_mem(lds, P + r0 * PP + C_QM + h * 128, g_qn_m, KVM + (size_t)bb * MEML * 1024 + h * 128, VTM + (size_t)((bb * 4 + h) * 128) * MEML,
                              P + r0 * PP + C_ZM + h * 128, P + r0 * PP + C_YM + h * 128, hq * 512);
            }
        }
    }
    GRID_BARRIER();
    for (int rep = 0; rep < 1; ++rep) { PHASE_BEGIN;
        pg8::Gemm g{Hh, WinT + (size_t)PP * 1024, TT, NZG, 1024, 1024, nullptr, nullptr, nullptr, 0}; pg8::StaticOrder S; S.init(TT, NZG, G, (int)blockIdx.x);
        EpiZG E{P, GT0, GT1};
        pg8::gemm_phase<EpiZG, pg8::StaticOrder, true, true>(lds, g, S, E);
    }
    GRID_BARRIER();
    for (int rep = 0; rep < REP_G4; ++rep) { PHASE_BEGIN;
        pg8::Gemm g{P + C_YA, WbrT, TT, 3072, 512, PP, P + C_YA, P + C_YB, P + C_YM, 4};
        MergeOrder S; S.so.init(TT, 1024, G, (int)blockIdx.x);
        EpiMerge E{MG, GT0, GT1};
        pg8::gemm_phase<EpiMerge, MergeOrder, true, true>(lds, g, S, E);
    }
    GRID_BARRIER();
    for (int rep = 0; rep < REP_G5; ++rep) { PHASE_BEGIN;
        pg8::Gemm g{MG, WoutT, TT, 1024, 1024, 1024, nullptr, nullptr, nullptr, 0}; pg8::StaticOrder S; S.init(TT, 1024, G, (int)blockIdx.x);
        EpiOut E{x, outp};
        pg8::gemm_phase<EpiOut, pg8::StaticOrder, true, true>(lds, g, S, E);
    }
}

extern "C" void kernel_launch(void* const* d_in, const int* in_sizes, int n_in, void* d_out, int out_size, void* d_ws, size_t ws_size, hipStream_t stream) {
    static int grid = 0;
    if (grid == 0) {
        if (n_in != 19 || out_size != TT * DM || ws_size < WS_END) { fprintf(stderr, "kernel_launch: unexpected problem (n_in %d, out %d, ws %zu); nothing launched\n", n_in, out_size, ws_size); grid = -1; return; }
        int dev = 0, cus = 0, per_cu = 0;
        if (hipGetDevice(&dev) != hipSuccess || hipDeviceGetAttribute(&cus, hipDeviceAttributeMultiprocessorCount, dev) != hipSuccess) { grid = -1; return; }
        if (hipFuncSetAttribute((const void*)fwd_kernel, hipFuncAttributeMaxDynamicSharedMemorySize, LDS_BYTES) != hipSuccess) { fprintf(stderr, "kernel_launch: hipFuncSetAttribute failed\n"); grid = -1; return; }
        if (hipOccupancyMaxActiveBlocksPerMultiprocessor(&per_cu, (const void*)fwd_kernel, 512, LDS_BYTES) != hipSuccess || per_cu < 1) { fprintf(stderr, "kernel_launch: occupancy query reports %d blocks per CU\n", per_cu); (void)hipGetLastError(); grid = -1; return; }
        grid = cus;
    }
    if (grid < 0) return;
    (void)hipMemsetAsync((char*)d_ws + WS_CTL, 0, 65536, stream);
    Args a{};
    for (int i = 0; i < 19; ++i) a.in[i] = (const float*)d_in[i];
    a.pos = (const int*)d_in[2]; a.out = (float*)d_out; a.ws = (unsigned char*)d_ws;
    hipLaunchKernelGGL(fwd_kernel, dim3(grid), dim3(512), LDS_BYTES, stream, a);
    const hipError_t e = hipPeekAtLastError();
    if (e != hipSuccess) fprintf(stderr, "kernel_launch: launch failed: %s (grid %d)\n", hipGetErrorString(e), grid);
}
```

```cpp
#include <hip/hip_runtime.h>
#include <cstdio>
#include <cstdint>
namespace pg8 {
#define PG8_LAS __attribute__((address_space(3)))
typedef unsigned short bf16_t;
typedef short bf16x8 __attribute__((ext_vector_type(8)));
typedef float f32x4 __attribute__((ext_vector_type(4)));
typedef unsigned u32x4 __attribute__((ext_vector_type(4)));
constexpr int BM = 256, BK = 64, HALF = 128, HTB = HALF * BK * 2  , STAGE_BYTES = 8 * HTB, NXCD = 8, WGM = 8;

__host__ __device__ __forceinline__ int lds_byte(int r, int c) { const int st = (r >> 4) * 2 + (c >> 5), rr = r & 15, cc = c & 31, ob = rr * 64 + cc * 2; return st * 1024 + (ob ^ (((ob >> 9) & 1) << 5)); }
__host__ __device__ __forceinline__ void stage_rc(int b, int& R, int& C) { const int st = b / 1024, sb = b % 1024, swz = sb ^ (((sb >> 9) & 1) << 5); R = (st >> 1) * 16 + swz / 64; C = (st & 1) * 32 + (swz % 64) / 2; }
__host__ __device__ __forceinline__ int perm32(int rho) { const int n = rho >> 4, i = rho & 15; return 8 * (i >> 2) + 4 * n + (i & 3); }

struct Unit { int pm, pn; };
struct Gemm { const bf16_t* A; const bf16_t* Bt; int M, N, K, lda; const bf16_t* Ag0; const bf16_t* Ag1; const bf16_t* Ag2; int ngrp; };
__device__ __forceinline__ const char* a_base(const Gemm& g, const Unit& u) { if (!g.ngrp) return (const char*)g.A; const int j = u.pn / g.ngrp; return (const char*)(j == 0 ? g.Ag0 : (j == 1 ? g.Ag1 : g.Ag2)); }

struct StaticOrder {
    int nM, nN, nwg, G, c;
    __host__ __device__ void init(int M, int N, int G_, int c_) { nM = M / BM; nN = N / BM; nwg = nM * nN; G = G_; c = c_; }
    __host__ __device__ bool next(int i, Unit& u) const {
        const long L = (long)i * G + c; if (L >= nwg) return false;
        int wgid = (int)L; { const int q = nwg / NXCD, r = nwg % NXCD, xcd = wgid % NXCD, off = wgid / NXCD; wgid = (xcd < r ? xcd * (q + 1) : r * (q + 1) + (xcd - r) * q) + off; }
        const int nig = WGM * nN, gid = wgid / nig, fm = gid * WGM, gsz = (nM - fm) < WGM ? (nM - fm) : WGM;
        u.pm = fm + ((wgid % nig) % gsz); u.pn = (wgid % nig) / gsz; return true;
    }
    __device__ __forceinline__ void a_ready(const Unit&) const {}
    __device__ __forceinline__ void done(const Unit&) const {}
};

__device__ __forceinline__ unsigned cvt_pk_bf16(float lo, float hi) { unsigned r; asm volatile("v_cvt_pk_bf16_f32 %0, %1, %2" : "=v"(r) : "v"(lo), "v"(hi)); return r; }
typedef float f32x2 __attribute__((ext_vector_type(2)));
__device__ __forceinline__ f32x2 gelu_pk(f32x2 v) {
    const f32x2 av = __builtin_elementwise_abs(v), d = av * 0.2316418882f + 1.0f;
    f32x2 t; t.x = __builtin_amdgcn_rcpf(d.x); t.y = __builtin_amdgcn_rcpf(d.y);
    f32x2 q = t * 0.5307027145f + (-0.7265760135f); q = q * t + 0.7107068705f; q = q * t + (-0.142248368f); q = q * t + 0.127414796f; q = q * t;
    const f32x2 s = (v * v) * (-0.72134752044f);
    f32x2 e; e.x = __builtin_amdgcn_exp2f(s.x); e.y = __builtin_amdgcn_exp2f(s.y);
    const f32x2 m = v * (q * e), r = v - m;
    f32x2 o; o.x = v.x < 0.f ? m.x : r.x; o.y = v.y < 0.f ? m.y : r.y; return o;
}

template <int ACT  > struct EpiBf16 {
    static constexpr bool PERM = true, AFTER_DRAIN = false; static_assert(ACT == 0 || ACT == 1, "EpiBf16: ACT is 0 (none) or 1 (gelu_pk)");
    bf16_t* O; int ldc; const float* bias; int split_cols; size_t split_stride; float scale0;
    __device__ __forceinline__ void operator()(const f32x4 (&acc)[2][2][4][2], const Unit& u, int wr, int wc, int fr, int fq) const {
        const int row0 = u.pm * BM + wr * 64 + fr; int colt = u.pn * BM; bf16_t* base = O;
        float sc = 1.f; if (split_cols) { const int t = colt / split_cols; base += (size_t)t * split_stride; colt -= t * split_cols; if (t == 0) sc = scale0; }
        const int col0 = colt + wc * 32 + 8 * fq, bcol0 = u.pn * BM + wc * 32 + 8 * fq;
        f32x4 bv[2][2];
#pragma unroll
        for (int bj = 0; bj < 2; ++bj)
#pragma unroll
            for (int n = 0; n < 2; ++n) bv[bj][n] = bias ? *(const f32x4*)(bias + bcol0 + bj * HALF + 4 * n) : (f32x4){0.f, 0.f, 0.f, 0.f};
#pragma unroll
        for (int ai = 0; ai < 2; ++ai)
#pragma unroll
            for (int m = 0; m < 4; ++m) { bf16_t* rowp = base + (size_t)(row0 + ai * HALF + m * 16) * ldc + col0;
#pragma unroll
                for (int bj = 0; bj < 2; ++bj) { f32x4 v0 = acc[ai][bj][m][0] + bv[bj][0], v1 = acc[ai][bj][m][1] + bv[bj][1];
                    if (ACT == 1) { f32x2 a = gelu_pk((f32x2){v0[0], v0[1]}), b = gelu_pk((f32x2){v0[2], v0[3]}), c = gelu_pk((f32x2){v1[0], v1[1]}), d = gelu_pk((f32x2){v1[2], v1[3]});
                        v0 = (f32x4){a.x, a.y, b.x, b.y}; v1 = (f32x4){c.x, c.y, d.x, d.y}; }
                    v0 = v0 * sc; v1 = v1 * sc; u32x4 w; w.x = cvt_pk_bf16(v0[0], v0[1]); w.y = cvt_pk_bf16(v0[2], v0[3]); w.z = cvt_pk_bf16(v1[0], v1[1]); w.w = cvt_pk_bf16(v1[2], v1[3]);
                    *(u32x4*)(rowp + bj * HALF) = w; } }
    }
};
template <class Epi, class Sched, bool ALIGN_EPI = false, bool SP2 = false>
__device__ __forceinline__ void gemm_phase(PG8_LAS unsigned char* lds, const Gemm g, const Sched& S, const Epi& E) {
    int tid_ = threadIdx.x; asm volatile("" : "+v"(tid_));
    const int tid = tid_, wid = __builtin_amdgcn_readfirstlane(tid >> 6), lane = tid & 63, wr = wid >> 2, wc = wid & 3, fr = lane & 15, fq = lane >> 4;
    const int K = g.K, nt = K / BK;
    unsigned voffA[2], voffB[2];
#pragma unroll
    for (int i = 0; i < 2; ++i) { int R, C; stage_rc(tid * 16 + i * 8192, R, C); const int Rb = Epi::PERM ? ((R & ~31) + perm32(R & 31)) : R;
        voffA[i] = (unsigned)(R * g.lda + C) * 2u; voffB[i] = (unsigned)(Rb * K + C) * 2u; }
    const size_t kstep = (size_t)(BK * 2);
    const size_t hstepA = (size_t)HALF * g.lda * 2, hstepB = (size_t)HALF * K * 2;
    const size_t tstepA = 2 * hstepA, tstepB = 2 * hstepB;
    const unsigned ldsw = (unsigned)wid * 1024u;
    const int aoff = lds_byte(wr * 64 + fr, fq * 8), boff = lds_byte(wc * 32 + fr, fq * 8);
#define PG8_SA(b, h) (((b) * 2 + (h)) * HTB)
#define PG8_SB(b, h) ((4 + (b) * 2 + (h)) * HTB)
#define PG8_STAGE(bufoff, gbase, voff) do { _Pragma("unroll") for (int _i = 0; _i < 2; ++_i) \
        __builtin_amdgcn_global_load_lds((const unsigned*)((const char*)(gbase) + (voff)[_i]), (PG8_LAS unsigned*)(lds + (bufoff) + ldsw + _i * 8192), 16, 0, 0); } while (0)
#define PG8_LDA(dst, b, h) do { _Pragma("unroll") for (int m = 0; m < 4; ++m) _Pragma("unroll") for (int k = 0; k < 2; ++k) dst[m][k] = *(const PG8_LAS bf16x8*)(lds + PG8_SA(b, h) + aoff + m * 2048 + k * 1024); } while (0)
#define PG8_LDB(dst, b, h) do { _Pragma("unroll") for (int n = 0; n < 2; ++n) _Pragma("unroll") for (int k = 0; k < 2; ++k) dst[n][k] = *(const PG8_LAS bf16x8*)(lds + PG8_SB(b, h) + boff + n * 2048 + k * 1024); } while (0)
#define PG8_MMA(ai, bj, At, Bt) do { __builtin_amdgcn_s_setprio(1); _Pragma("unroll") for (int m = 0; m < 4; ++m) _Pragma("unroll") for (int n = 0; n < 2; ++n) _Pragma("unroll") for (int k = 0; k < 2; ++k) \
        acc[ai][bj][m][n] = __builtin_amdgcn_mfma_f32_16x16x32_bf16(Bt[n][k], At[m][k], acc[ai][bj][m][n], 0, 0, 0); __builtin_amdgcn_s_setprio(0); } while (0)
#define PG8_WAIT_V(n) asm volatile("s_waitcnt vmcnt(" #n ")" ::: "memory")
#define PG8_WAIT_L(n) asm volatile("s_waitcnt lgkmcnt(" #n ")" ::: "memory")
#define PG8_BAR __builtin_amdgcn_s_barrier()
#define PG8_SCHED __builtin_amdgcn_sched_barrier(0)
    Unit cur, nxt; int ui = 0;
    if (!S.next(0, cur)) return;
    f32x4 acc[2][2][4][2];
#pragma unroll
    for (int a = 0; a < 2; ++a)
#pragma unroll
        for (int b = 0; b < 2; ++b)
#pragma unroll
            for (int m = 0; m < 4; ++m)
#pragma unroll
                for (int n = 0; n < 2; ++n) acc[a][b][m][n] = (f32x4){0.f, 0.f, 0.f, 0.f};
    bf16x8 At[4][2], B0[2][2], B1[2][2];
    const char* cA = a_base(g, cur) + (size_t)cur.pm * tstepA; const char* cB = (const char*)g.Bt + (size_t)cur.pn * tstepB;
    S.a_ready(cur);
    if constexpr (SP2) {
        PG8_STAGE(PG8_SB(0, 0), cB, voffB); PG8_STAGE(PG8_SB(0, 1), cB + hstepB, voffB); PG8_STAGE(PG8_SA(0, 0), cA, voffA); PG8_STAGE(PG8_SA(0, 1), cA + hstepA, voffA);
        if (wr == 1) PG8_BAR;
        PG8_WAIT_V(2); PG8_BAR;
        PG8_STAGE(PG8_SB(1, 0), cB + kstep, voffB); PG8_STAGE(PG8_SA(1, 0), cA + kstep, voffA); PG8_STAGE(PG8_SB(1, 1), cB + hstepB + kstep, voffB);
        PG8_WAIT_V(6); PG8_BAR;
    } else {
        PG8_STAGE(PG8_SB(0, 0), cB, voffB); PG8_STAGE(PG8_SA(0, 0), cA, voffA); PG8_STAGE(PG8_SB(0, 1), cB + hstepB, voffB); PG8_STAGE(PG8_SA(0, 1), cA + hstepA, voffA);
        if (wr == 1) PG8_BAR;
        PG8_WAIT_V(4); PG8_BAR;
        PG8_STAGE(PG8_SB(1, 0), cB + kstep, voffB); PG8_STAGE(PG8_SA(1, 0), cA + kstep, voffA); PG8_STAGE(PG8_SB(1, 1), cB + hstepB + kstep, voffB);
        PG8_WAIT_V(6); PG8_BAR;
    }
    for (;;) {
        const bool has_next = S.next(ui + 1, nxt);
        const char* nA = has_next ? a_base(g, nxt) + (size_t)nxt.pm * tstepA : cA; const char* nB = has_next ? (const char*)g.Bt + (size_t)nxt.pn * tstepB : cB;
        for (int t = 0; t < nt; t += 2) {
            const bool last = (t == nt - 2);
            const char* a1 = cA + (size_t)(t + 1) * kstep;
            const char* a2 = last ? nA : cA + (size_t)(t + 2) * kstep; const char* b2 = last ? nB : cB + (size_t)(t + 2) * kstep;
            const char* a3 = a2 + kstep; const char* b3 = b2 + kstep;
            if (last && has_next) S.a_ready(nxt);
            if constexpr (SP2) {
            PG8_LDB(B0, 0, 0); PG8_LDB(B1, 0, 1); PG8_SCHED; PG8_LDA(At, 0, 0); PG8_STAGE(PG8_SA(1, 1), a1 + hstepA, voffA);
            PG8_WAIT_V(8); PG8_WAIT_L(0); PG8_BAR; PG8_MMA(0, 0, At, B0); PG8_MMA(0, 1, At, B1); PG8_BAR; PG8_SCHED;
            PG8_LDA(At, 0, 1); PG8_STAGE(PG8_SB(0, 0), b2, voffB); PG8_STAGE(PG8_SB(0, 1), b2 + hstepB, voffB); PG8_STAGE(PG8_SA(0, 0), a2, voffA);
            PG8_WAIT_V(8); PG8_WAIT_L(0); PG8_BAR; PG8_MMA(1, 0, At, B0); PG8_MMA(1, 1, At, B1); PG8_BAR; PG8_SCHED;
            PG8_LDB(B0, 1, 0); PG8_LDB(B1, 1, 1); PG8_SCHED; PG8_LDA(At, 1, 0); PG8_STAGE(PG8_SA(0, 1), a2 + hstepA, voffA);
            PG8_WAIT_V(8); PG8_WAIT_L(0); PG8_BAR; PG8_MMA(0, 0, At, B0); PG8_MMA(0, 1, At, B1); PG8_BAR; PG8_SCHED;
            PG8_LDA(At, 1, 1); PG8_STAGE(PG8_SB(1, 0), b3, voffB); PG8_STAGE(PG8_SB(1, 1), b3 + hstepB, voffB); PG8_STAGE(PG8_SA(1, 0), a3, voffA);
            PG8_WAIT_V(8); PG8_WAIT_L(0); PG8_BAR; PG8_MMA(1, 0, At, B0); PG8_MMA(1, 1, At, B1); PG8_BAR; PG8_SCHED;
            } else {
            PG8_LDB(B0, 0, 0); PG8_SCHED; PG8_LDA(At, 0, 0); PG8_STAGE(PG8_SA(1, 1), a1 + hstepA, voffA);
            PG8_WAIT_L(8); PG8_BAR; PG8_WAIT_L(0); PG8_MMA(0, 0, At, B0); PG8_BAR; PG8_SCHED;
            PG8_LDB(B1, 0, 1); PG8_STAGE(PG8_SB(0, 0), b2, voffB);
            PG8_BAR; PG8_WAIT_L(0); PG8_MMA(0, 1, At, B1); PG8_BAR;
            PG8_LDA(At, 0, 1); PG8_STAGE(PG8_SA(0, 0), a2, voffA);
            PG8_BAR; PG8_WAIT_L(0); PG8_MMA(1, 0, At, B0); PG8_BAR; PG8_SCHED;
            PG8_STAGE(PG8_SB(0, 1), b2 + hstepB, voffB);
            PG8_WAIT_V(6); PG8_BAR; PG8_MMA(1, 1, At, B1); PG8_BAR;
            PG8_LDB(B0, 1, 0); PG8_SCHED; PG8_LDA(At, 1, 0); PG8_STAGE(PG8_SA(0, 1), a2 + hstepA, voffA);
            PG8_WAIT_L(8); PG8_BAR; PG8_WAIT_L(0); PG8_MMA(0, 0, At, B0); PG8_BAR; PG8_SCHED;
            PG8_LDB(B1, 1, 1); PG8_STAGE(PG8_SB(1, 0), b3, voffB);
            PG8_BAR; PG8_WAIT_L(0); PG8_MMA(0, 1, At, B1); PG8_BAR;
            PG8_LDA(At, 1, 1); PG8_STAGE(PG8_SA(1, 0), a3, voffA);
            PG8_BAR; PG8_WAIT_L(0); PG8_MMA(1, 0, At, B0); PG8_BAR; PG8_SCHED;
            PG8_STAGE(PG8_SB(1, 1), b3 + hstepB, voffB);
            PG8_WAIT_V(6); PG8_BAR; PG8_MMA(1, 1, At, B1); PG8_BAR;
            }
        }
        if constexpr (ALIGN_EPI) { if (wr == 0) PG8_BAR; }
        if constexpr (!Epi::AFTER_DRAIN) { E(acc, cur, wr, wc, fr, fq); S.done(cur); }
        if (!has_next) break;
#pragma unroll
        for (int a = 0; a < 2; ++a)
#pragma unroll
            for (int b = 0; b < 2; ++b)
#pragma unroll
                for (int m = 0; m < 4; ++m)
#pragma unroll
                    for (int n = 0; n < 2; ++n) acc[a][b][m][n] = (f32x4){0.f, 0.f, 0.f, 0.f};
        cur = nxt; cA = nA; cB = nB; ++ui;
        if constexpr (ALIGN_EPI) { if (wr == 1) PG8_BAR; }
    }
    PG8_WAIT_V(0);
    if constexpr (!ALIGN_EPI) { if (wr == 0) PG8_BAR; }
    PG8_BAR;
    if constexpr (Epi::AFTER_DRAIN) { E.fused(acc, cur, wr, wc, fr, fq, lds, wid, lane); S.done(cur); }
#undef PG8_SA
#undef PG8_SB
#undef PG8_STAGE
#undef PG8_LDA
#undef PG8_LDB
#undef PG8_MMA
#undef PG8_WAIT_V
#undef PG8_WAIT_L
#undef PG8_BAR
#undef PG8_SCHED
}
}

#define LAS __attribute__((address_space(3)))
typedef unsigned short bf16;
typedef unsigned v4u __attribute__((ext_vector_type(4)));
typedef unsigned v2u __attribute__((ext_vector_type(2)));
typedef float f32x4 __attribute__((ext_vector_type(4)));
typedef float f32x16 __attribute__((ext_vector_type(16)));
typedef short bf16x8 __attribute__((ext_vector_type(8)));
typedef short s16x4 __attribute__((ext_vector_type(4)));
typedef float f32x2_t __attribute__((ext_vector_type(2)));
typedef __bf16 bf16x2_t __attribute__((ext_vector_type(2)));

constexpr int NB = 8, SEQ = 2048, DM = 1024, TT = NB * SEQ;
constexpr int DIN = 7912, NP = 7936;
constexpr int PP = 3840, NZG = 4096;
constexpr int MEML = 256;
constexpr float EPS = 1e-6f, NEGF = -1e30f;
constexpr int C_QA = 0, C_KA = 512, C_VA = 1024, C_QI = 1536, C_KI = 2048, C_WI = 2112, C_CQ = 2120, C_CKV = 2504, C_KR = 2760, C_QM = 2792, C_ZM = 3304;
constexpr int C_YA = C_QI, C_YB = C_CQ, C_YM = C_VA;
constexpr float SCALE_A = 0.18033688011112042f;
constexpr float SCALE_B = 0.14724444602590306f;
constexpr float SCALE_M = 0.12751743082459868f;
constexpr float SCALE_I = 0.04419417382415922f;

__constant__ float INVA[8] = {1.0f, 0.1939227432012558f, 0.03760603070259094f, 0.007292664609849453f, 0.0014142135623842478f, 0.00027424818836152554f, 5.3182957344688475e-05f, 1.0313385246263351e-05f};
__constant__ float INVB[16] = {1.0f, 0.44036659598350525f, 0.1939227432012558f, 0.08539710193872452f, 0.03760603070259094f, 0.016560440883040428f, 0.007292664609849453f, 0.0032114461064338684f, 0.0014142135623842478f, 0.0006227724370546639f, 0.00027424818836152554f, 0.00012076973507646471f, 5.3182957344688475e-05f, 2.34199997066753e-05f, 1.0313385246263351e-05f, 4.541670477919979e-06f};

constexpr size_t MiB = 1u << 20;
constexpr size_t WS_CTL = 0;
constexpr size_t WS_WIN = 1 * MiB;
constexpr size_t WS_WUQ = 17 * MiB;
constexpr size_t WS_WUKV = 18 * MiB;
constexpr size_t WS_WMEM = 19 * MiB;
constexpr size_t WS_WBR = 21 * MiB;
constexpr size_t WS_WOUT = 24 * MiB;
constexpr size_t WS_ROPEA = 26 * MiB;
constexpr size_t WS_ROPEB = 27 * MiB;
constexpr size_t WS_MN = 29 * MiB;
constexpr size_t WS_KVM = 33 * MiB;
constexpr size_t WS_VTM = 37 * MiB;
constexpr size_t WS_WI = 39 * MiB;
constexpr size_t WS_MASK = 40 * MiB;
constexpr size_t WS_H = 44 * MiB;
constexpr size_t WS_P = 76 * MiB;
constexpr size_t WS_QB = 196 * MiB;
constexpr size_t WS_KVB = 220 * MiB;
constexpr size_t WS_G1 = 196 * MiB;
constexpr size_t WS_END = 256 * MiB;
constexpr size_t DO_VTA = 0;
constexpr size_t DO_VTB = 16 * MiB;
constexpr size_t DO_KB = 32 * MiB;
constexpr size_t DO_G0 = 0;

constexpr int REP_P0 = 1, REP_PH = 1, REP_G1 = 1, REP_G2 = 1, REP_IDX = 1, REP_ATT = 1, REP_G4 = 1, REP_G5 = 1;
constexpr int REP_IDX1 = 1, REP_SEL = 1;
constexpr int ATT_STRIP = 0;
constexpr int EXTRA_SYNCS = 0, REP_TR = 1, DUMMY_POST1 = 0, DUMMY_POST2 = 0;
constexpr int LDS_BYTES = 147456;
constexpr int LDS_SLOT = LDS_BYTES - 64;

__device__ __forceinline__ unsigned pk2(float lo, float hi) { f32x2_t v = {lo, hi}; bf16x2_t b = __builtin_convertvector(v, bf16x2_t); return __builtin_bit_cast(unsigned, b); }
__device__ __forceinline__ float bflo(unsigned w) { return __uint_as_float(w << 16); }
__device__ __forceinline__ float bfhi(unsigned w) { return __uint_as_float(w & 0xffff0000u); }
__device__ __forceinline__ float bf1(bf16 b) { return __uint_as_float(((unsigned)b) << 16); }
#define UNPACK8(W_, V_) do { V_[0] = bflo((W_)[0]); V_[1] = bfhi((W_)[0]); V_[2] = bflo((W_)[1]); V_[3] = bfhi((W_)[1]); V_[4] = bflo((W_)[2]); V_[5] = bfhi((W_)[2]); V_[6] = bflo((W_)[3]); V_[7] = bfhi((W_)[3]); } while (0)
#define PACK8(V_) (v4u){pk2(V_[0], V_[1]), pk2(V_[2], V_[3]), pk2(V_[4], V_[5]), pk2(V_[6], V_[7])}
template <int CTRL> __device__ __forceinline__ float dpp_f(float v) { return __int_as_float(__builtin_amdgcn_update_dpp(0, __float_as_int(v), CTRL, 0xF, 0xF, false)); }
#define SUM8(x) do { x += dpp_f<0xB1>(x); x += dpp_f<0x4E>(x); x += dpp_f<0x141>(x); } while (0)
#define SUM16(x) do { SUM8(x); x += dpp_f<0x140>(x); } while (0)
__device__ __forceinline__ float wave_sum(float v) {
    SUM16(v);
    return __int_as_float(__builtin_amdgcn_readlane(__float_as_int(v), 0)) + __int_as_float(__builtin_amdgcn_readlane(__float_as_int(v), 16))
         + __int_as_float(__builtin_amdgcn_readlane(__float_as_int(v), 32)) + __int_as_float(__builtin_amdgcn_readlane(__float_as_int(v), 48));
}
#define LDS_WAIT() asm volatile("s_waitcnt lgkmcnt(0)" ::: "memory")

__device__ __forceinline__ int win_src(int d) {
    if (d < 2120) return d;
    if (d < 2792) return d + 512;
    if (d < 3816) return d + 1024;
    if (d < 3840) return -1;
    if (d < 4352) return d - 3840 + 2120;
    if (d < 4864) return d - 4352 + 3304;
    return d - 4864 + 4840;
}
template <bool REMAP>
__device__ __forceinline__ void transpose_item(const float* W, int K, int N, int Npad, bf16* WT, LAS float* scr, int item, int lane) {
    const int nblk = Npad / 32, kb = item / nblk, nb = item % nblk, k0 = 64 * kb, n0 = 32 * nb;
    const int n4 = 4 * (lane & 7);
    const int nn = REMAP ? win_src(n0 + n4) : n0 + n4; const bool ok = nn >= 0 && nn < N;
#pragma unroll
    for (int i = 0; i < 8; ++i) { const int kk = 8 * i + (lane >> 3);
        f32x4 v = (f32x4){0.f, 0.f, 0.f, 0.f}; if (ok) v = __builtin_nontemporal_load((const f32x4*)(W + (size_t)(k0 + kk) * N + nn));
        LAS float* d = scr + kk * 33 + n4; d[0] = v[0]; d[1] = v[1]; d[2] = v[2]; d[3] = v[3]; }
    LDS_WAIT(); asm volatile("" ::: "memory");
    const int c = lane & 7;
#pragma unroll
    for (int j = 0; j < 4; ++j) { const int n = (lane >> 3) + 8 * j; const LAS float* s = scr + (8 * c) * 33 + n;
        v4u o; o.x = pk2(s[0 * 33], s[1 * 33]); o.y = pk2(s[2 * 33], s[3 * 33]); o.z = pk2(s[4 * 33], s[5 * 33]); o.w = pk2(s[6 * 33], s[7 * 33]);
        *(v4u*)(WT + (size_t)(n0 + n) * K + k0 + 8 * c) = o; }
    LDS_WAIT(); asm volatile("" ::: "memory");
}
__device__ __forceinline__ void rms_row_1024(const float* xrow, const float* g, bf16* orow, int lane) {
    const f32x4* xr = (const f32x4*)xrow + lane; const f32x4* gr = (const f32x4*)g + lane;
    f32x4 v[4]; float s = 0.f;
#pragma unroll
    for (int j = 0; j < 4; ++j) { v[j] = __builtin_nontemporal_load(xr + 64 * j); s += (v[j].x * v[j].x + v[j].y * v[j].y) + (v[j].z * v[j].z + v[j].w * v[j].w); }
    const float rstd = __builtin_amdgcn_rsqf(wave_sum(s) * (1.f / 1024.f) + EPS);
    v2u* o8 = (v2u*)orow + lane;
#pragma unroll
    for (int j = 0; j < 4; ++j) { const f32x4 gg = gr[64 * j]; v2u w; w.x = pk2(v[j].x * rstd * gg.x, v[j].y * rstd * gg.y); w.y = pk2(v[j].z * rstd * gg.z, v[j].w * rstd * gg.w); o8[64 * j] = w; }
}

#define ROPE8(v, sub, c8, s8) do { _Pragma("unroll") for (int j_ = 0; j_ < 8; ++j_) { const float pv_ = dpp_f<0xB1>(v[j_]); \
        const float r0_ = v[j_] * c8[j_] - pv_ * s8[j_], r1_ = v[j_] * c8[j_] + pv_ * s8[j_]; v[j_] = (sub) == 0 ? r0_ : ((sub) == 1 ? r1_ : v[j_]); } } while (0)

__device__ __forceinline__ void post1_row(const bf16* Prow, bf16* Orow, const float* ra, const float (&ga)[8], const float (&gk)[8], const float (&gq)[8], const float (&gc)[8], const float (&gm)[8], float* WIrow, int lane) {
    const int sub = lane & 7;
    const v4u z4 = (v4u){0u, 0u, 0u, 0u};
    const v4u w_qa = *(const v4u*)(Prow + C_QA + 8 * lane);
    const v4u w_ka = *(const v4u*)(Prow + C_KA + 8 * lane);
    const v4u w_qi = *(const v4u*)(Prow + C_QI + 8 * lane);
    v4u w_ki = z4, w_cq = z4, w_ckv = z4; float w_wi = 0.f;
    if (lane < 8) { w_ki = *(const v4u*)(Prow + C_KI + 8 * lane); w_wi = bf1(Prow[C_WI + lane]); }
    if (lane < 48) w_cq = *(const v4u*)(Prow + C_CQ + 8 * lane);
    if (lane < 32) w_ckv = *(const v4u*)(Prow + C_CKV + 8 * lane);
    float c8[8], s8[8];
    { const f32x4 r0 = *(const f32x4*)(ra), r1 = *(const f32x4*)(ra + 4), r2 = *(const f32x4*)(ra + 8), r3 = *(const f32x4*)(ra + 12);
      c8[0] = r0[0]; c8[1] = r0[1]; c8[2] = r0[2]; c8[3] = r0[3]; c8[4] = r1[0]; c8[5] = r1[1]; c8[6] = r1[2]; c8[7] = r1[3];
      s8[0] = r2[0]; s8[1] = r2[1]; s8[2] = r2[2]; s8[3] = r2[3]; s8[4] = r3[0]; s8[5] = r3[1]; s8[6] = r3[2]; s8[7] = r3[3]; }
    { float v[8]; UNPACK8(w_qa, v); float ss = 0.f;
#pragma unroll
      for (int j = 0; j < 8; ++j) ss += v[j] * v[j];
      SUM8(ss);
      const float rstd = __builtin_amdgcn_rsqf(ss * (1.f / 64.f) + EPS);
#pragma unroll
      for (int j = 0; j < 8; ++j) v[j] = v[j] * rstd * ga[j];
      ROPE8(v, sub, c8, s8);
#pragma unroll
      for (int j = 0; j < 8; ++j) v[j] *= SCALE_A;
      *(v4u*)(Orow + C_QA + 8 * lane) = PACK8(v); }
    { float v[8]; UNPACK8(w_ka, v); float ss = 0.f;
#pragma unroll
      for (int j = 0; j < 8; ++j) ss += v[j] * v[j];
      SUM8(ss);
      const float rstd = __builtin_amdgcn_rsqf(ss * (1.f / 64.f) + EPS);
#pragma unroll
      for (int j = 0; j < 8; ++j) v[j] = v[j] * rstd * gk[j];
      ROPE8(v, sub, c8, s8);
      *(v4u*)(Orow + C_KA + 8 * lane) = PACK8(v); }
    { float v[8]; UNPACK8(w_qi, v);
      ROPE8(v, sub, c8, s8);
      *(v4u*)(Orow + C_QI + 8 * lane) = PACK8(v); }
    { float v[8]; UNPACK8(w_ki, v);
      ROPE8(v, sub, c8, s8);
      if (lane < 8) *(v4u*)(Orow + C_KI + 8 * lane) = PACK8(v); }
    if (lane < 8) WIrow[lane] = w_wi * SCALE_I;
    { float v[8]; UNPACK8(w_cq, v); float ss = 0.f;
#pragma unroll
      for (int j = 0; j < 8; ++j) ss += v[j] * v[j];
      ss = wave_sum(ss); const float rstd = __builtin_amdgcn_rsqf(ss * (1.f / 384.f) + EPS);
      if (lane < 48) {
#pragma unroll
          for (int j = 0; j < 8; ++j) v[j] = v[j] * rstd * gq[j];
          *(v4u*)(Orow + C_CQ + 8 * lane) = PACK8(v); } }
    { float v[8]; UNPACK8(w_ckv, v); float ss = 0.f;
#pragma unroll
      for (int j = 0; j < 8; ++j) ss += v[j] * v[j];
      ss = wave_sum(ss); const float rstd = __builtin_amdgcn_rsqf(ss * (1.f / 256.f) + EPS);
      if (lane < 32) {
#pragma unroll
          for (int j = 0; j < 8; ++j) v[j] = v[j] * rstd * gc[j];
          *(v4u*)(Orow + C_CKV + 8 * lane) = PACK8(v); } }
}

__device__ __forceinline__ void km_row(bf16* row, const float* gkm, int lane) {
    v4u w = *(const v4u*)(row + 8 * lane); float v[8]; UNPACK8(w, v); float ss = 0.f;
#pragma unroll
    for (int j = 0; j < 8; ++j) ss += v[j] * v[j];
    SUM16(ss);
    const float rstd = __builtin_amdgcn_rsqf(ss * (1.f / 128.f) + EPS);
#pragma unroll
    for (int j = 0; j < 8; ++j) v[j] = v[j] * rstd * gkm[8 * (lane & 15) + j];
    *(v4u*)(row + 8 * lane) = PACK8(v);
}

__device__ __forceinline__ void transpose_v(const bf16* src, int pitch, int col0, int hstride, int H, int DV, int S, int nb, bf16* dst, int gw, int NGW, int lane) {
    const int ndq = DV / 64, nsc = S / 64, ntask = nb * H * nsc * ndq;
    for (int task = gw; task < ntask; task += NGW) {
        int x = task; const int dq = x % ndq; x /= ndq; const int sc = x % nsc; x /= nsc; const int h = x % H; const int b = x / H;
        const int s = sc * 64 + lane;
        const bf16* srow = src + (size_t)(b * S + s) * pitch + col0 + h * hstride + dq * 64;
        bf16* drow = dst + ((size_t)((b * H + h) * DV + dq * 64)) * S + s;
        v4u wv[8];
#pragma unroll
        for (int c = 0; c < 8; ++c) wv[c] = *(const v4u*)(srow + 8 * c);
#pragma unroll
        for (int c = 0; c < 8; ++c) { const v4u w = wv[c];
            drow[(size_t)(8 * c + 0) * S] = (bf16)(w.x & 0xffffu); drow[(size_t)(8 * c + 1) * S] = (bf16)(w.x >> 16);
            drow[(size_t)(8 * c + 2) * S] = (bf16)(w.y & 0xffffu); drow[(size_t)(8 * c + 3) * S] = (bf16)(w.y >> 16);
            drow[(size_t)(8 * c + 4) * S] = (bf16)(w.z & 0xffffu); drow[(size_t)(8 * c + 5) * S] = (bf16)(w.z >> 16);
            drow[(size_t)(8 * c + 6) * S] = (bf16)(w.w & 0xffffu); drow[(size_t)(8 * c + 7) * S] = (bf16)(w.w >> 16); }
    }
}

__device__ __forceinline__ void post2_row(const bf16* QBrow, bf16* QOrow, const bf16* KVBrow, const bf16* Prow, bf16* KBrow, const float* rb, const float (&gqv)[12], const float (&gkv)[12], LAS float* scr, int lane) {
    const int hd = lane >> 3, d0 = 12 * (lane & 7);
    float vq[12], vk[12], cc[12], sn[12];
    { const v2u* p = (const v2u*)(QBrow + 12 * lane);
      const v2u w0 = p[0], w1 = p[1], w2 = p[2];
      bf16 kr[12];
#pragma unroll
      for (int e = 0; e < 12; ++e) { const int d = d0 + e; kr[e] = d < 64 ? KVBrow[hd * 128 + d] : Prow[C_KR + d - 64]; }
#pragma unroll
      for (int e = 0; e < 12; ++e) { const int d = d0 + e; const int i = (d - 64) & 15; cc[e] = d < 64 ? 1.f : rb[i]; sn[e] = d < 64 ? 0.f : rb[16 + i]; }
      vq[0] = bflo(w0.x); vq[1] = bfhi(w0.x); vq[2] = bflo(w0.y); vq[3] = bfhi(w0.y); vq[4] = bflo(w1.x); vq[5] = bfhi(w1.x); vq[6] = bflo(w1.y); vq[7] = bfhi(w1.y);
      vq[8] = bflo(w2.x); vq[9] = bfhi(w2.x); vq[10] = bflo(w2.y); vq[11] = bfhi(w2.y);
#pragma unroll
      for (int e = 0; e < 12; ++e) vk[e] = bf1(kr[e]); }
    float sq = 0.f, sk = 0.f;
#pragma unroll
    for (int e = 0; e < 12; ++e) { sq += vq[e] * vq[e]; sk += vk[e] * vk[e]; }
    SUM8(sq); SUM8(sk);
    const float rq = __builtin_amdgcn_rsqf(sq * (1.f / 96.f) + EPS), rk = __builtin_amdgcn_rsqf(sk * (1.f / 96.f) + EPS);
#pragma unroll
    for (int e = 0; e < 12; ++e) { vq[e] = vq[e] * rq * gqv[e]; vk[e] = vk[e] * rk * gkv[e]; scr[12 * lane + e] = vq[e]; scr[768 + 12 * lane + e] = vk[e]; }
    LDS_WAIT(); asm volatile("" ::: "memory");
    float oq[12], ok[12];
#pragma unroll
    for (int e = 0; e < 12; ++e) { const int d = d0 + e;
        if (d < 64) { oq[e] = vq[e]; ok[e] = vk[e]; }
        else { const bool first = d < 80; const int off = first ? 16 : -16; const float pq = scr[12 * lane + e + off], pk = scr[768 + 12 * lane + e + off];
               oq[e] = first ? vq[e] * cc[e] - pq * sn[e] : vq[e] * cc[e] + pq * sn[e];
               ok[e] = first ? vk[e] * cc[e] - pk * sn[e] : vk[e] * cc[e] + pk * sn[e]; }
        oq[e] *= SCALE_B; }
    LDS_WAIT(); asm volatile("" ::: "memory");
    v2u* q = (v2u*)(QOrow + 12 * lane); v2u* k = (v2u*)(KBrow + 12 * lane);
#pragma unroll
    for (int i = 0; i < 3; ++i) { v2u w; w.x = pk2(oq[4 * i], oq[4 * i + 1]); w.y = pk2(oq[4 * i + 2], oq[4 * i + 3]); q[i] = w;
                                  v2u u; u.x = pk2(ok[4 * i], ok[4 * i + 1]); u.y = pk2(ok[4 * i + 2], ok[4 * i + 3]); k[i] = u; }
}

__device__ __forceinline__ int next_unit(unsigned* ctr, volatile LAS int* slot) {
    __syncthreads();
    if (threadIdx.x == 0) *slot = (int)atomicAdd(ctr, 1u);
    __syncthreads();
    return *slot;
}

constexpr int SCP = 2112;
__device__ __forceinline__ unsigned ord_key(float v) { const unsigned b = __float_as_uint(v); return b ^ ((unsigned)((int)b >> 31) | 0x80000000u); }
__device__ __forceinline__ void indexer_load_q(const bf16* P, const float* WI, int u, bf16x8 (&qf)[8][2], float (&wq)[8]) {
    const int lane = threadIdx.x & 63, n = lane & 15, g = lane >> 4;
    const int tb = 127 - (u >> 3), bb = u & 7;
    const size_t row = (size_t)(bb * SEQ + tb * 16 + n);
    const bf16* qrow = P + row * PP + C_QI + 8 * g;
#pragma unroll
    for (int h = 0; h < 8; ++h) { qf[h][0] = *(const bf16x8*)(qrow + h * 64); qf[h][1] = *(const bf16x8*)(qrow + h * 64 + 32); wq[h] = WI[row * 8 + h]; }
}
__device__ __forceinline__ void indexer_unit(LAS float* sc, const bf16* P, const float* WI, unsigned* MASK, int bb, int tb, bf16x8 (&qf)[8][2], float (&wq)[8],
                                             int tk, volatile LAS int* slot, int nunits, int& un) {
    int tid_ = threadIdx.x; asm volatile("" : "+v"(tid_));
    const int tid = tid_, lane = tid & 63, w = __builtin_amdgcn_readfirstlane(tid >> 6);
    const int n = lane & 15, g = lane >> 4;
    const int rowbase = bb * SEQ, t0 = tb * 16;
    {
        const int ntile = tb + 1;
        const int nmine = (ntile - w + 7) >> 3;
        const int ngrp = (nmine + 3) >> 2;
        const bf16* kbase = P + (size_t)(rowbase + n) * PP + C_KI + 8 * g;
        bf16x8 kb[2][4][2];
#define IDX_LOAD(BUF, GRP) do { _Pragma("unroll") for (int j_ = 0; j_ < 4; ++j_) { const int tile_ = w + 8 * (4 * (GRP) + j_); const int tl_ = tile_ < ntile ? tile_ : 0; \
            const bf16* kr_ = kbase + (size_t)(16 * tl_) * PP; kb[BUF][j_][0] = *(const bf16x8*)(kr_); kb[BUF][j_][1] = *(const bf16x8*)(kr_ + 32); } } while (0)
#define IDX_COMP(BUF, GRP) do { _Pragma("unroll") for (int j_ = 0; j_ < 4; ++j_) { const int tile_ = w + 8 * (4 * (GRP) + j_); if (tile_ < ntile) { \
            f32x4 idx_ = (f32x4){0.f, 0.f, 0.f, 0.f}; \
            _Pragma("unroll") for (int h_ = 0; h_ < 8; ++h_) { f32x4 a_ = (f32x4){0.f, 0.f, 0.f, 0.f}; \
                a_ = __builtin_amdgcn_mfma_f32_16x16x32_bf16(kb[BUF][j_][0], qf[h_][0], a_, 0, 0, 0); \
                a_ = __builtin_amdgcn_mfma_f32_16x16x32_bf16(kb[BUF][j_][1], qf[h_][1], a_, 0, 0, 0); \
                _Pragma("unroll") for (int i_ = 0; i_ < 4; ++i_) idx_[i_] = __builtin_fmaf(wq[h_], __builtin_fmaxf(a_[i_], 0.f), idx_[i_]); } \
            { const int k0_ = 16 * tile_ + 4 * g; LAS float* d_ = sc + n * SCP + k0_ + (k0_ >> 5); d_[0] = idx_[0]; d_[1] = idx_[1]; d_[2] = idx_[2]; d_[3] = idx_[3]; } } } } while (0)
        if (ngrp > 0) IDX_LOAD(0, 0);
        for (int gp = 0; gp < ngrp; gp += 2) {
            if (gp + 1 < ngrp) IDX_LOAD(1, gp + 1);
            IDX_COMP(0, gp);
            if (gp + 1 < ngrp) { if (gp + 2 < ngrp) IDX_LOAD(0, gp + 2); IDX_COMP(1, gp + 1); }
        }
#undef IDX_LOAD
#undef IDX_COMP
    }
    if (tid == 0) *slot = tk;
    __syncthreads();
    un = *slot;
    if (un < nunits) indexer_load_q(P, WI, un, qf, wq);
    for (int rs = 0; rs < REP_SEL; ++rs) {
        const int ta = t0 + 2 * w, tb2 = ta + 1;
        unsigned* mra = MASK + (size_t)(rowbase + ta) * 64; unsigned* mrb = mra + 64;
        const int nva = ta - 32 * lane + 1, nvb = nva + 1;
        const unsigned valid_a = nva >= 32 ? 0xffffffffu : (nva <= 0 ? 0u : ((1u << nva) - 1u));
        const unsigned valid_b = nvb >= 32 ? 0xffffffffu : (nvb <= 0 ? 0u : ((1u << nvb) - 1u));
        if (ta < 256) { mra[lane] = valid_a; mrb[lane] = valid_b; continue; }
        unsigned ua[32], ub[32];
        { const LAS float* sra = sc + (2 * w) * SCP + 33 * lane; const LAS float* srb = sra + SCP;
#pragma unroll
          for (int r = 0; r < 32; ++r) { const float va = sra[r], vb = srb[r]; ua[r] = ((valid_a >> r) & 1u) ? ord_key(va) : 0u; ub[r] = ((valid_b >> r) & 1u) ? ord_key(vb) : 0u; } }
#pragma unroll
        for (int k = 0; k < 16; ++k) {
            const unsigned a0 = ua[k], a1 = ua[k + 16]; ua[k] = __builtin_amdgcn_perm(a1, a0, 0x05040100u); ua[k + 16] = __builtin_amdgcn_perm(a1, a0, 0x07060302u);
            const unsigned b0 = ub[k], b1 = ub[k + 16]; ub[k] = __builtin_amdgcn_perm(b1, b0, 0x05040100u); ub[k + 16] = __builtin_amdgcn_perm(b1, b0, 0x07060302u); }
#pragma unroll
        for (int k = 0; k < 32; ++k) if (!(k & 8)) {
            const unsigned a0 = ua[k], a1 = ua[k + 8]; ua[k] = __builtin_amdgcn_perm(a1, a0, 0x06020400u); ua[k + 8] = __builtin_amdgcn_perm(a1, a0, 0x07030501u);
            const unsigned b0 = ub[k], b1 = ub[k + 8]; ub[k] = __builtin_amdgcn_perm(b1, b0, 0x06020400u); ub[k + 8] = __builtin_amdgcn_perm(b1, b0, 0x07030501u); }
#pragma unroll
        for (int si = 2; si < 5; ++si) { const int sft = 16 >> si;
            const unsigned msk = si == 2 ? 0x0f0f0f0fu : (si == 3 ? 0x33333333u : 0x55555555u);
#pragma unroll
            for (int k = 0; k < 32; ++k) if (!(k & sft)) {
                const unsigned a0 = ua[k], a1 = ua[k + sft]; ua[k] = (a0 & msk) | ((a1 << sft) & ~msk); ua[k + sft] = ((a0 >> sft) & msk) | (a1 & ~msk);
                const unsigned b0 = ub[k], b1 = ub[k + sft]; ub[k] = (b0 & msk) | ((b1 << sft) & ~msk); ub[k + sft] = ((b0 >> sft) & msk) | (b1 & ~msk); } }
        unsigned alive_a = valid_a, sel_a = 0u, alive_b = valid_b, sel_b = 0u; int need_a = 256, need_b = 256; bool run_a = true, run_b = true;
#pragma unroll
        for (int j = 31; j >= 0; --j) {
            const unsigned ones_a = alive_a & ua[j], ones_b = alive_b & ub[j];
            int v = (int)((unsigned)__popc(ones_a) | ((unsigned)__popc(ones_b) << 16));
            v += __builtin_amdgcn_update_dpp(0, v, 0xB1, 0xF, 0xF, false);
            v += __builtin_amdgcn_update_dpp(0, v, 0x4E, 0xF, 0xF, false);
            v += __builtin_amdgcn_update_dpp(0, v, 0x141, 0xF, 0xF, false);
            v += __builtin_amdgcn_update_dpp(0, v, 0x140, 0xF, 0xF, false);
            const unsigned tot = (unsigned)(__builtin_amdgcn_readlane(v, 0) + __builtin_amdgcn_readlane(v, 16) + __builtin_amdgcn_readlane(v, 32) + __builtin_amdgcn_readlane(v, 48));
            const int ca = (int)(tot & 0xffffu), cb = (int)(tot >> 16);
            if (run_a) { if (ca >= need_a) { alive_a = ones_a; if (ca == need_a) { sel_a |= ones_a; need_a = 0; run_a = false; } }
                         else { need_a -= ca; sel_a |= ones_a; alive_a &= ~ua[j]; } }
            if (run_b) { if (cb >= need_b) { alive_b = ones_b; if (cb == need_b) { sel_b |= ones_b; need_b = 0; run_b = false; } }
                         else { need_b -= cb; sel_b |= ones_b; alive_b &= ~ub[j]; } }
            if (!run_a && !run_b) break;
        }
        if (need_a > 0) {
            const int cnt = __popc(alive_a); int inc = cnt;
#pragma unroll
            for (int d = 1; d < 64; d <<= 1) { const int o = __shfl_up(inc, d); if (lane >= d) inc += o; }
            int k = need_a - (inc - cnt); k = k < 0 ? 0 : (k > cnt ? cnt : k);
            unsigned m = alive_a;
            for (int i = 0; i < k; ++i) { const unsigned low = m & (0u - m); sel_a |= low; m ^= low; }
        }
        if (need_b > 0) {
            const int cnt = __popc(alive_b); int inc = cnt;
#pragma unroll
            for (int d = 1; d < 64; d <<= 1) { const int o = __shfl_up(inc, d); if (lane >= d) inc += o; }
            int k = need_b - (inc - cnt); k = k < 0 ? 0 : (k > cnt ? cnt : k);
            unsigned m = alive_b;
            for (int i = 0; i < k; ++i) { const unsigned low = m & (0u - m); sel_b |= low; m ^= low; }
        }
        mra[lane] = sel_a; mrb[lane] = sel_b;
        (void)tb2;
    }
    __syncthreads();
}

__device__ __forceinline__ float half_max(float m) { auto rr = __builtin_amdgcn_permlane32_swap(__float_as_uint(m), __float_as_uint(m), false, false); return __builtin_fmaxf(__uint_as_float(rr[0]), __uint_as_float(rr[1])); }
__device__ __forceinline__ float half_sum(float m) { auto rr = __builtin_amdgcn_permlane32_swap(__float_as_uint(m), __float_as_uint(m), false, false); return __uint_as_float(rr[0]) + __uint_as_float(rr[1]); }
__device__ __forceinline__ int crow(int r, int hi) { return (r & 3) + 8 * (r >> 2) + 4 * hi; }
template <int DQK, int DV, int MODE, int STRIP = 0>
__device__ __forceinline__ void attn_unit(LAS unsigned char* lds, const bf16* Qb, int qpitch, const bf16* Kb, int kpitch, const bf16* VTb, int skv,
                                          const unsigned* maskb, const bf16* Zb, bf16* Ob, int q0) {
    constexpr int TK = 128, KP = DQK + 8, VP = TK + 8;
    LAS bf16* Ks = (LAS bf16*)lds; LAS bf16* Vs = Ks + TK * KP;
    constexpr int CPR = DQK / 8;
    constexpr int NCK = TK * CPR, NCV = DV * (TK / 8);
    constexpr int RK = (NCK + 511) / 512, RV = (NCV + 511) / 512;
    constexpr int NKS = DQK / 16, NMT = DV / 32;
    int tid_ = threadIdx.x; asm volatile("" : "+v"(tid_));
    const int tid = tid_, lane = tid & 63, w = __builtin_amdgcn_readfirstlane(tid >> 6), r = lane & 31, hh = lane >> 5;
    const int NT = MODE == 0 ? skv / TK : (q0 + 256) / TK;
    const int qlo = q0 + 32 * w;
    bf16x8 qf[NKS];
    { const bf16* qrow = Qb + (size_t)(qlo + r) * qpitch + 8 * hh;
#pragma unroll
      for (int ks = 0; ks < NKS; ++ks) qf[ks] = *(const bf16x8*)(qrow + 16 * ks); }
    f32x16 o[NMT];
#pragma unroll
    for (int mt = 0; mt < NMT; ++mt)
#pragma unroll
        for (int i = 0; i < 16; ++i) o[mt][i] = 0.f;
    float m_run = NEGF, l_run = 0.f;
    v4u kreg[RK], vreg[RV];
#define ATT_PREFETCH(tile_) do { \
        _Pragma("unroll") for (int i_ = 0; i_ < RK; ++i_) { const int c_ = tid + 512 * i_; if (c_ < NCK) { const int row_ = c_ / CPR, cc_ = c_ % CPR; kreg[i_] = *(const v4u*)(Kb + (size_t)(TK * (tile_) + row_) * kpitch + 8 * cc_); } } \
        _Pragma("unroll") for (int i_ = 0; i_ < RV; ++i_) { const int c_ = tid + 512 * i_; if (c_ < NCV) { const int d_ = c_ >> 4, cc_ = c_ & 15; vreg[i_] = *(const v4u*)(VTb + (size_t)d_ * skv + TK * (tile_) + 8 * cc_); } } } while (0)
    if (STRIP != 2) ATT_PREFETCH(0);
    for (int tile = 0; tile < NT; ++tile) {
        __syncthreads();
        if (STRIP != 2) {
#pragma unroll
        for (int i = 0; i < RK; ++i) { const int c = tid + 512 * i; if (c < NCK) { const int row = c / CPR, cc = c % CPR; *(LAS v4u*)(Ks + row * KP + 8 * cc) = kreg[i]; } }
#pragma unroll
        for (int i = 0; i < RV; ++i) { const int c = tid + 512 * i; if (c < NCV) { const int d = c >> 4, cc = c & 15; *(LAS v4u*)(Vs + d * VP + 8 * cc) = vreg[i]; } }
        }
        __syncthreads();
        if (STRIP != 2 && tile + 1 < NT) ATT_PREFETCH(tile + 1);
        __builtin_amdgcn_sched_barrier(0);
        if (STRIP == 1) continue;
#pragma unroll 1
        for (int sub = 0; sub < 2; ++sub) {
        const int t64 = 2 * tile + sub;
        if (MODE != 0 && 64 * t64 > qlo + 31) continue;
        const LAS bf16* Kc = Ks + 64 * sub * KP; const LAS bf16* Vc = Vs + 64 * sub;
        unsigned mw0 = 0u, mw1 = 0u;
        if (MODE == 2) { const v2u mm = *(const v2u*)(maskb + (size_t)(qlo + r) * 64 + 2 * t64); mw0 = mm.x >> (4 * hh); mw1 = mm.y >> (4 * hh); }
        f32x16 s0, s1;
#pragma unroll
        for (int i = 0; i < 16; ++i) { s0[i] = 0.f; s1[i] = 0.f; }
#pragma unroll
        for (int ks = 0; ks < NKS; ++ks) {
            const bf16x8 a0 = *(const LAS bf16x8*)(Kc + r * KP + 16 * ks + 8 * hh);
            const bf16x8 a1 = *(const LAS bf16x8*)(Kc + (32 + r) * KP + 16 * ks + 8 * hh);
            s0 = __builtin_amdgcn_mfma_f32_32x32x16_bf16(a0, qf[ks], s0, 0, 0, 0);
            s1 = __builtin_amdgcn_mfma_f32_32x32x16_bf16(a1, qf[ks], s1, 0, 0, 0);
        }
        if (MODE == 1) {
            if (64 * t64 + 63 > qlo) { const int qg = qlo + r;
#pragma unroll
                for (int i = 0; i < 16; ++i) { const int key = 64 * t64 + crow(i, hh); if (key > qg) s0[i] = NEGF; if (key + 32 > qg) s1[i] = NEGF; } }
        }
        if (MODE == 2) {
#pragma unroll
            for (int i = 0; i < 16; ++i) { const int bit = (i & 3) + 8 * (i >> 2); if (!((mw0 >> bit) & 1u)) s0[i] = NEGF; if (!((mw1 >> bit) & 1u)) s1[i] = NEGF; }
        }
        float mx = s0[0];
#pragma unroll
        for (int i = 1; i < 16; ++i) mx = __builtin_fmaxf(mx, s0[i]);
#pragma unroll
        for (int i = 0; i < 16; ++i) mx = __builtin_fmaxf(mx, s1[i]);
        mx = half_max(mx);
        const float m_new = __builtin_fmaxf(m_run, mx);
        const float alpha = __builtin_amdgcn_exp2f(m_run - m_new);
        m_run = m_new;
        float ls = 0.f;
#pragma unroll
        for (int i = 0; i < 16; ++i) { s0[i] = __builtin_amdgcn_exp2f(s0[i] - m_new); s1[i] = __builtin_amdgcn_exp2f(s1[i] - m_new); ls += s0[i] + s1[i]; }
        l_run = l_run * alpha + ls;
#pragma unroll
        for (int mt = 0; mt < NMT; ++mt)
#pragma unroll
            for (int i = 0; i < 16; ++i) o[mt][i] *= alpha;
        v4u pf[2][2];
#pragma unroll
        for (int s = 0; s < 2; ++s) {
            pf[0][s] = (v4u){pk2(s0[8 * s], s0[8 * s + 1]), pk2(s0[8 * s + 2], s0[8 * s + 3]), pk2(s0[8 * s + 4], s0[8 * s + 5]), pk2(s0[8 * s + 6], s0[8 * s + 7])};
            pf[1][s] = (v4u){pk2(s1[8 * s], s1[8 * s + 1]), pk2(s1[8 * s + 2], s1[8 * s + 3]), pk2(s1[8 * s + 4], s1[8 * s + 5]), pk2(s1[8 * s + 6], s1[8 * s + 7])};
        }
#pragma unroll
        for (int mt = 0; mt < NMT; ++mt)
#pragma unroll
            for (int p = 0; p < 2; ++p)
#pragma unroll
                for (int s = 0; s < 2; ++s) {
                    const LAS bf16* vp = Vc + (32 * mt + r) * VP + 32 * p + 16 * s + 4 * hh;
                    const s16x4 lo = *(const LAS s16x4*)(vp), hi = *(const LAS s16x4*)(vp + 8);
                    const bf16x8 a = (bf16x8){lo[0], lo[1], lo[2], lo[3], hi[0], hi[1], hi[2], hi[3]};
                    o[mt] = __builtin_amdgcn_mfma_f32_32x32x16_bf16(a, __builtin_bit_cast(bf16x8, pf[p][s]), o[mt], 0, 0, 0);
                }
        }
    }
#undef ATT_PREFETCH
    const float l_tot = half_sum(l_run);
    const float inv = 1.0f / l_tot;
    const size_t row = (size_t)(qlo + r);
#pragma unroll
    for (int mt = 0; mt < NMT; ++mt)
#pragma unroll
        for (int g4 = 0; g4 < 4; ++g4) {
            const int d = 32 * mt + 8 * g4 + 4 * hh;
            float ov[4];
#pragma unroll
            for (int i = 0; i < 4; ++i) ov[i] = o[mt][4 * g4 + i] * inv;
            if (Zb) { const v2u zw = *(const v2u*)(Zb + row * PP + d); const float z[4] = {bflo(zw.x), bfhi(zw.x), bflo(zw.y), bfhi(zw.y)};
#pragma unroll
                for (int i = 0; i < 4; ++i) ov[i] *= z[i] * __builtin_amdgcn_rcpf(1.0f + __expf(-z[i])); }
            v2u ow; ow.x = pk2(ov[0], ov[1]); ow.y = pk2(ov[2], ov[3]);
            *(v2u*)(Ob + row * PP + d) = ow;
        }
}

template <int DQK, int MODE>
__device__ __forceinline__ void attn_unit_pipe(LAS unsigned char* lds, const bf16* Qb, int qpitch, const bf16* Kb, int kpitch, const bf16* VTb, int skv,
                                               const unsigned* maskb, bf16* Ob, int q0) {
    constexpr int DV = 64, KP = DQK + 8, VP = 72, BUFE = 64 * KP + DV * VP;
    constexpr int CPR = DQK / 8, NCK = 64 * CPR, NCV = DV * 8, RK = (NCK + 511) / 512, RV = (NCV + 511) / 512, NKS = DQK / 16, NMT = DV / 32;
    static_assert(NCV == 512 && (NCK == 512 || NCK == 768), "staging map");
    int tid_ = threadIdx.x; asm volatile("" : "+v"(tid_));
    const int tid = tid_, lane = tid & 63, w = __builtin_amdgcn_readfirstlane(tid >> 6), r = lane & 31, hh = lane >> 5;
    const int NT = (q0 + 256) / 64;
    const int qlo = q0 + 32 * w;
    const int NTw = ((qlo + 31) >> 6) + 1;
    int krow[RK], kcc[RK];
#pragma unroll
    for (int i = 0; i < RK; ++i) { int c = tid + 512 * i; if (c >= NCK) c -= 256; krow[i] = c / CPR; kcc[i] = c % CPR; }
    const int vd = tid >> 3, vcc = tid & 7;
    bf16x8 qf[NKS];
    { const bf16* qrow = Qb + (size_t)(qlo + r) * qpitch + 8 * hh;
#pragma unroll
      for (int ks = 0; ks < NKS; ++ks) qf[ks] = *(const bf16x8*)(qrow + 16 * ks); }
    f32x16 o[NMT];
#pragma unroll
    for (int mt = 0; mt < NMT; ++mt)
#pragma unroll
        for (int i = 0; i < 16; ++i) o[mt][i] = 0.f;
    float m_run = NEGF, l_run = 0.f, alpha = 1.f;
    v4u kreg[2][RK], vreg[2][RV]; v2u mset[2];
    const unsigned* mrowp = MODE == 2 ? maskb + (size_t)(qlo + r) * 64 : nullptr;
#define PL_LOAD(S_, tile_) do { const int tl_ = (tile_) < NT ? (tile_) : NT - 1; \
        if (MODE == 2) { const int mt_ = (tile_) >= 2 ? ((tile_) - 2 < 32 ? (tile_) - 2 : 31) : 0; mset[S_] = *(const v2u*)(mrowp + 2 * mt_); }     \
        _Pragma("unroll") for (int i_ = 0; i_ < RK; ++i_) kreg[S_][i_] = *(const v4u*)(Kb + (size_t)(64 * tl_ + krow[i_]) * kpitch + 8 * kcc[i_]); \
        vreg[S_][0] = *(const v4u*)(VTb + (size_t)vd * skv + 64 * tl_ + 8 * vcc); } while (0)
#define PL_STAGE(S_, buf_) do { LAS bf16* Kd_ = (LAS bf16*)lds + (buf_) * BUFE; LAS bf16* Vd_ = Kd_ + 64 * KP; \
        _Pragma("unroll") for (int i_ = 0; i_ < RK; ++i_) *(LAS v4u*)(Kd_ + krow[i_] * KP + 8 * kcc[i_]) = kreg[S_][i_]; \
        *(LAS v4u*)(Vd_ + vd * VP + 8 * vcc) = vreg[S_][0]; } while (0)
#define PL_QK(t_, D0_, D1_) do { const LAS bf16* Kc_ = (const LAS bf16*)lds + ((t_) & 3) * BUFE; \
        _Pragma("unroll") for (int i_ = 0; i_ < 16; ++i_) { D0_[i_] = 0.f; D1_[i_] = 0.f; } \
        _Pragma("unroll") for (int ks_ = 0; ks_ < NKS; ++ks_) { \
            const bf16x8 a0_ = *(const LAS bf16x8*)(Kc_ + r * KP + 16 * ks_ + 8 * hh); const bf16x8 a1_ = *(const LAS bf16x8*)(Kc_ + (32 + r) * KP + 16 * ks_ + 8 * hh); \
            D0_ = __builtin_amdgcn_mfma_f32_32x32x16_bf16(a0_, qf[ks_], D0_, 0, 0, 0); D1_ = __builtin_amdgcn_mfma_f32_32x32x16_bf16(a1_, qf[ks_], D1_, 0, 0, 0); } } while (0)
#define PL_PV(t_) do { const LAS bf16* Vc_ = (const LAS bf16*)lds + ((t_) & 3) * BUFE + 64 * KP; \
        _Pragma("unroll") for (int mt_ = 0; mt_ < NMT; ++mt_) _Pragma("unroll") for (int i_ = 0; i_ < 16; ++i_) o[mt_][i_] *= alpha; \
        _Pragma("unroll") for (int mt_ = 0; mt_ < NMT; ++mt_) _Pragma("unroll") for (int p_ = 0; p_ < 2; ++p_) _Pragma("unroll") for (int s_ = 0; s_ < 2; ++s_) { \
            const LAS bf16* vp_ = Vc_ + (32 * mt_ + r) * VP + 32 * p_ + 16 * s_ + 4 * hh; \
            const s16x4 lo_ = *(const LAS s16x4*)(vp_), hi_ = *(const LAS s16x4*)(vp_ + 8); \
            const bf16x8 a_ = (bf16x8){lo_[0], lo_[1], lo_[2], lo_[3], hi_[0], hi_[1], hi_[2], hi_[3]}; \
            o[mt_] = __builtin_amdgcn_mfma_f32_32x32x16_bf16(a_, __builtin_bit_cast(bf16x8, pf[p_][s_]), o[mt_], 0, 0, 0); } } while (0)
#define PL_SOFTMAX(t_, C0_, C1_, MK_, CAUSAL_) do { \
        if (MODE == 2) { const unsigned w0_ = (MK_).x >> (4 * hh), w1_ = (MK_).y >> (4 * hh); \
            _Pragma("unroll") for (int i_ = 0; i_ < 16; ++i_) { const int bit_ = (i_ & 3) + 8 * (i_ >> 2); if (!((w0_ >> bit_) & 1u)) C0_[i_] = NEGF; if (!((w1_ >> bit_) & 1u)) C1_[i_] = NEGF; } } \
        if (CAUSAL_) { const int qg_ = qlo + r; \
            _Pragma("unroll") for (int i_ = 0; i_ < 16; ++i_) { const int key_ = 64 * (t_) + crow(i_, hh); if (key_ > qg_) C0_[i_] = NEGF; if (key_ + 32 > qg_) C1_[i_] = NEGF; } } \
        float mx_ = C0_[0]; \
        _Pragma("unroll") for (int i_ = 1; i_ < 16; ++i_) mx_ = __builtin_fmaxf(mx_, C0_[i_]); \
        _Pragma("unroll") for (int i_ = 0; i_ < 16; ++i_) mx_ = __builtin_fmaxf(mx_, C1_[i_]); \
        mx_ = half_max(mx_); \
        const float mn_ = __builtin_fmaxf(m_run, mx_); alpha = __builtin_amdgcn_exp2f(m_run - mn_); m_run = mn_; \
        float ls_ = 0.f; \
        _Pragma("unroll") for (int i_ = 0; i_ < 16; ++i_) { C0_[i_] = __builtin_amdgcn_exp2f(C0_[i_] - mn_); C1_[i_] = __builtin_amdgcn_exp2f(C1_[i_] - mn_); ls_ += C0_[i_] + C1_[i_]; } \
        l_run = l_run * alpha + ls_; \
        _Pragma("unroll") for (int s_ = 0; s_ < 2; ++s_) { \
            pf[0][s_] = (v4u){pk2(C0_[8 * s_], C0_[8 * s_ + 1]), pk2(C0_[8 * s_ + 2], C0_[8 * s_ + 3]), pk2(C0_[8 * s_ + 4], C0_[8 * s_ + 5]), pk2(C0_[8 * s_ + 6], C0_[8 * s_ + 7])}; \
            pf[1][s_] = (v4u){pk2(C1_[8 * s_], C1_[8 * s_ + 1]), pk2(C1_[8 * s_ + 2], C1_[8 * s_ + 3]), pk2(C1_[8 * s_ + 4], C1_[8 * s_ + 5]), pk2(C1_[8 * s_ + 6], C1_[8 * s_ + 7])}; } } while (0)
#define PL_IO(t_, S_) do { PL_STAGE(S_, ((t_) + 2) & 3); PL_LOAD(S_, (t_) + 4); } while (0)
#define PL_STEADY(t_, S_) do { const v2u mk_ = mset[S_]; PL_IO(t_, S_); if (MODE == 2) { asm volatile("" :: "v"(mk_.x), "v"(mk_.y)); } \
        PL_QK((t_) + 1, n0, n1); PL_PV((t_) - 1); PL_SOFTMAX(t_, c0, c1, mk_, false); c0 = n0; c1 = n1; __syncthreads(); } while (0)
#define PL_TAIL(t_, S_) do { const v2u mk_ = mset[S_]; PL_IO(t_, S_); if ((t_) >= 1) PL_PV((t_) - 1); PL_SOFTMAX(t_, c0, c1, mk_, MODE == 1); PL_PV(t_); __syncthreads(); } while (0)
    f32x16 c0, c1, n0, n1; v4u pf[2][2];
    PL_LOAD(0, 0); PL_LOAD(1, 1);
    PL_STAGE(0, 0); PL_STAGE(1, 1);
    PL_LOAD(0, 2); PL_LOAD(1, 3);
    __syncthreads();
    PL_QK(0, c0, c1);
    int t = 0;
    if (NTw >= 2) {
        { const v2u mk_ = mset[0]; PL_IO(0, 0); PL_QK(1, n0, n1); PL_SOFTMAX(0, c0, c1, mk_, false); c0 = n0; c1 = n1; __syncthreads(); }
        for (t = 1; t + 1 < NTw; ) {
            PL_STEADY(t, 1); ++t;
            if (t + 1 < NTw) { PL_STEADY(t, 0); ++t; }
        }
    }
    if (t & 1) PL_TAIL(t, 1); else PL_TAIL(t, 0);
    for (++t; t < NT; ++t) { if (t & 1) PL_IO(t, 1); else PL_IO(t, 0); __syncthreads(); }
#undef PL_LOAD
#undef PL_STAGE
#undef PL_QK
#undef PL_PV
#undef PL_SOFTMAX
#undef PL_IO
#undef PL_STEADY
#undef PL_TAIL
    const float l_tot = half_sum(l_run);
    const float inv = 1.0f / l_tot;
    const size_t row = (size_t)(qlo + r);
#pragma unroll
    for (int mt = 0; mt < NMT; ++mt)
#pragma unroll
        for (int k2 = 0; k2 < 2; ++k2) {
            const int ga = 2 * k2, gb = 2 * k2 + 1;
            const unsigned a0 = pk2(o[mt][4 * ga] * inv, o[mt][4 * ga + 1] * inv), a1 = pk2(o[mt][4 * ga + 2] * inv, o[mt][4 * ga + 3] * inv);
            const unsigned b0 = pk2(o[mt][4 * gb] * inv, o[mt][4 * gb + 1] * inv), b1 = pk2(o[mt][4 * gb + 2] * inv, o[mt][4 * gb + 3] * inv);
            const auto s0 = __builtin_amdgcn_permlane32_swap(a0, b0, false, false);
            const auto s1 = __builtin_amdgcn_permlane32_swap(a1, b1, false, false);
            *(v4u*)(Ob + row * PP + 32 * mt + 16 * k2 + 8 * hh) = (v4u){s0[0], s1[0], s0[1], s1[1]};
        }
}

__device__ __forceinline__ void attn_unit_mem(LAS unsigned char* lds, const bf16* Qb, const float* gqm, const bf16* Kb, const bf16* VTb, const bf16* Zb, bf16* Ob, int q0) {
    constexpr int DQK = 128, KP = DQK + 8, VP = MEML + 8, NKS = DQK / 16, NMT = 4;
    LAS bf16* Ks = (LAS bf16*)lds; LAS bf16* Vs = Ks + MEML * KP;
    int tid_ = threadIdx.x; asm volatile("" : "+v"(tid_));
    const int tid = tid_, lane = tid & 63, w = __builtin_amdgcn_readfirstlane(tid >> 6), r = lane & 31, hh = lane >> 5;
    { v4u kk[8], vv[8];
#pragma unroll
      for (int i = 0; i < 8; ++i) { const int c = tid + 512 * i; kk[i] = *(const v4u*)(Kb + (size_t)(c >> 4) * 1024 + 8 * (c & 15)); vv[i] = *(const v4u*)(VTb + (size_t)(c >> 5) * MEML + 8 * (c & 31)); }
#pragma unroll
      for (int i = 0; i < 8; ++i) { const int c = tid + 512 * i; *(LAS v4u*)(Ks + (c >> 4) * KP + 8 * (c & 15)) = kk[i]; *(LAS v4u*)(Vs + (c >> 5) * VP + 8 * (c & 31)) = vv[i]; } }
    __syncthreads();
#pragma unroll 1
    for (int qb = 0; qb < 2; ++qb) {
        const int qlo = q0 + 256 * qb + 32 * w;
        bf16x8 qf[NKS];
        { const bf16* qrow = Qb + (size_t)(qlo + r) * PP + 8 * hh;
#pragma unroll
          for (int ks = 0; ks < NKS; ++ks) qf[ks] = *(const bf16x8*)(qrow + 16 * ks);
          float ss = 0.f;
#pragma unroll
          for (int ks = 0; ks < NKS; ++ks) { const v4u w = __builtin_bit_cast(v4u, qf[ks]); float v[8]; UNPACK8(w, v);
#pragma unroll
              for (int j = 0; j < 8; ++j) ss += v[j] * v[j]; }
          const float rs = __builtin_amdgcn_rsqf(half_sum(ss) * (1.f / 128.f) + EPS) * SCALE_M;
#pragma unroll
          for (int ks = 0; ks < NKS; ++ks) { const v4u w = __builtin_bit_cast(v4u, qf[ks]); float v[8]; UNPACK8(w, v);
              const f32x4 g0 = *(const f32x4*)(gqm + 16 * ks + 8 * hh), g1 = *(const f32x4*)(gqm + 16 * ks + 8 * hh + 4);
              v[0] *= rs * g0[0]; v[1] *= rs * g0[1]; v[2] *= rs * g0[2]; v[3] *= rs * g0[3]; v[4] *= rs * g1[0]; v[5] *= rs * g1[1]; v[6] *= rs * g1[2]; v[7] *= rs * g1[3];
              const v4u p = PACK8(v); qf[ks] = __builtin_bit_cast(bf16x8, p); } }
        f32x16 o[NMT];
#pragma unroll
        for (int mt = 0; mt < NMT; ++mt)
#pragma unroll
            for (int i = 0; i < 16; ++i) o[mt][i] = 0.f;
        float m_run = NEGF, l_run = 0.f;
#pragma unroll 1
        for (int sub = 0; sub < MEML / 64; ++sub) {
            const LAS bf16* Kc = Ks + 64 * sub * KP; const LAS bf16* Vc = Vs + 64 * sub;
            f32x16 s0, s1;
#pragma unroll
            for (int i = 0; i < 16; ++i) { s0[i] = 0.f; s1[i] = 0.f; }
#pragma unroll
            for (int ks = 0; ks < NKS; ++ks) {
                const bf16x8 a0 = *(const LAS bf16x8*)(Kc + r * KP + 16 * ks + 8 * hh);
                const bf16x8 a1 = *(const LAS bf16x8*)(Kc + (32 + r) * KP + 16 * ks + 8 * hh);
                s0 = __builtin_amdgcn_mfma_f32_32x32x16_bf16(a0, qf[ks], s0, 0, 0, 0);
                s1 = __builtin_amdgcn_mfma_f32_32x32x16_bf16(a1, qf[ks], s1, 0, 0, 0);
            }
            float mx = s0[0];
#pragma unroll
            for (int i = 1; i < 16; ++i) mx = __builtin_fmaxf(mx, s0[i]);
#pragma unroll
            for (int i = 0; i < 16; ++i) mx = __builtin_fmaxf(mx, s1[i]);
            mx = half_max(mx);
            const float m_new = __builtin_fmaxf(m_run, mx);
            const float alpha = __builtin_amdgcn_exp2f(m_run - m_new);
            m_run = m_new;
            float ls = 0.f;
#pragma unroll
            for (int i = 0; i < 16; ++i) { s0[i] = __builtin_amdgcn_exp2f(s0[i] - m_new); s1[i] = __builtin_amdgcn_exp2f(s1[i] - m_new); ls += s0[i] + s1[i]; }
            l_run = l_run * alpha + ls;
#pragma unroll
            for (int mt = 0; mt < NMT; ++mt)
#pragma unroll
                for (int i = 0; i < 16; ++i) o[mt][i] *= alpha;
            v4u pf[2][2];
#pragma unroll
            for (int s = 0; s < 2; ++s) {
                pf[0][s] = (v4u){pk2(s0[8 * s], s0[8 * s + 1]), pk2(s0[8 * s + 2], s0[8 * s + 3]), pk2(s0[8 * s + 4], s0[8 * s + 5]), pk2(s0[8 * s + 6], s0[8 * s + 7])};
                pf[1][s] = (v4u){pk2(s1[8 * s], s1[8 * s + 1]), pk2(s1[8 * s + 2], s1[8 * s + 3]), pk2(s1[8 * s + 4], s1[8 * s + 5]), pk2(s1[8 * s + 6], s1[8 * s + 7])};
            }
#pragma unroll
            for (int mt = 0; mt < NMT; ++mt)
#pragma unroll
                for (int p = 0; p < 2; ++p)
#pragma unroll
                    for (int s = 0; s < 2; ++s) {
                        const LAS bf16* vp = Vc + (32 * mt + r) * VP + 32 * p + 16 * s + 4 * hh;
                        const s16x4 lo = *(const LAS s16x4*)(vp), hi = *(const LAS s16x4*)(vp + 8);
                        const bf16x8 a = (bf16x8){lo[0], lo[1], lo[2], lo[3], hi[0], hi[1], hi[2], hi[3]};
                        o[mt] = __builtin_amdgcn_mfma_f32_32x32x16_bf16(a, __builtin_bit_cast(bf16x8, pf[p][s]), o[mt], 0, 0, 0);
                    }
        }
        const float inv = 1.0f / half_sum(l_run);
        const size_t row = (size_t)(qlo + r);
#pragma unroll
        for (int mt = 0; mt < NMT; ++mt)
#pragma unroll
            for (int g4 = 0; g4 < 4; ++g4) {
                const int d = 32 * mt + 8 * g4 + 4 * hh;
                const v2u zw = *(const v2u*)(Zb + row * PP + d); const float z[4] = {bflo(zw.x), bfhi(zw.x), bflo(zw.y), bfhi(zw.y)};
                float ov[4];
#pragma unroll
                for (int i = 0; i < 4; ++i) ov[i] = o[mt][4 * g4 + i] * inv * (z[i] * __builtin_amdgcn_rcpf(1.0f + __expf(-z[i])));
                v2u ow; ow.x = pk2(ov[0], ov[1]); ow.y = pk2(ov[2], ov[3]);
                *(v2u*)(Ob + row * PP + d) = ow;
            }
    }
}

__device__ __forceinline__ bf16* gate_row(bf16* G0, bf16* G1, size_t row) { return row < 8192 ? G0 + row * 3072 : G1 + (row - 8192) * 3072; }
struct EpiZG {
    static constexpr bool PERM = true, AFTER_DRAIN = false;
    bf16* P; bf16* G0; bf16* G1;
    __device__ __forceinline__ void operator()(const pg8::f32x4 (&acc)[2][2][4][2], const pg8::Unit& u, int wr, int wc, int fr, int fq) const {
        const int row0 = u.pm * 256 + wr * 64 + fr, cl = wc * 32 + 8 * fq;
        const bool isz = u.pn < 4;
        const int ycol = (u.pn < 2 ? C_YA : C_YB) + (u.pn & 1) * 256, gcol = (u.pn - 4) * 256;
#pragma unroll
        for (int ai = 0; ai < 2; ++ai)
#pragma unroll
            for (int m = 0; m < 4; ++m) { const size_t row = (size_t)(row0 + ai * 128 + m * 16);
#pragma unroll
                for (int bj = 0; bj < 2; ++bj) {
                    const pg8::f32x4 v0 = acc[ai][bj][m][0], v1 = acc[ai][bj][m][1];
                    float rr[8] = {v0[0], v0[1], v0[2], v0[3], v1[0], v1[1], v1[2], v1[3]};
                    if (isz) { bf16* dst = P + row * PP + ycol + cl + bj * 128; const v4u old = *(const v4u*)dst; float yv[8]; UNPACK8(old, yv);
#pragma unroll
                        for (int e = 0; e < 8; ++e) rr[e] = yv[e] * (rr[e] * __builtin_amdgcn_rcpf(1.0f + __expf(-rr[e])));
                        *(v4u*)dst = PACK8(rr); }
                    else { bf16* dst = gate_row(G0, G1, row) + gcol + cl + bj * 128;
#pragma unroll
                        for (int e = 0; e < 8; ++e) rr[e] = __builtin_amdgcn_rcpf(1.0f + __expf(-rr[e]));
                        *(v4u*)dst = PACK8(rr); } } }
    }
};
struct EpiStoreVT {
    static constexpr bool PERM = true, AFTER_DRAIN = false;
    bf16* O; int ldc; bf16* VT;
    int vbeg, vend, hshift, voff, DV, sshift;
    __device__ __forceinline__ void operator()(const pg8::f32x4 (&acc)[2][2][4][2], const pg8::Unit& u, int wr, int wc, int fr, int fq) const {
        const int row0 = u.pm * 256 + wr * 64 + fr, col0 = u.pn * 256 + wc * 32 + 8 * fq;
        const int H = (vend - vbeg) >> hshift, S = 1 << sshift;
        bool isv[2]; long voffs[2];
#pragma unroll
        for (int bj = 0; bj < 2; ++bj) { const int col = col0 + bj * 128, cr = col - vbeg, within = cr & ((1 << hshift) - 1);
            isv[bj] = col >= vbeg && col < vend && within >= voff;
            voffs[bj] = ((long)((cr >> hshift) * DV + within - voff)) << sshift; }
#pragma unroll
        for (int ai = 0; ai < 2; ++ai)
#pragma unroll
            for (int m = 0; m < 4; ++m) { const int row = row0 + ai * 128 + m * 16;
                const int b = row >> sshift, sp = row & (S - 1);
#pragma unroll
                for (int bj = 0; bj < 2; ++bj) {
                    const pg8::f32x4 v0 = acc[ai][bj][m][0], v1 = acc[ai][bj][m][1];
                    const unsigned w0 = pk2(v0[0], v0[1]), w1 = pk2(v0[2], v0[3]), w2 = pk2(v1[0], v1[1]), w3 = pk2(v1[2], v1[3]);
                    if (!isv[bj]) *(v4u*)(O + (size_t)row * ldc + col0 + bj * 128) = (v4u){w0, w1, w2, w3};
                    else { bf16* dst = VT + (((long)(b * H * DV)) << sshift) + voffs[bj] + sp;
                        dst[0] = (bf16)(w0 & 0xffffu); dst[(size_t)S] = (bf16)(w0 >> 16); dst[(size_t)2 * S] = (bf16)(w1 & 0xffffu); dst[(size_t)3 * S] = (bf16)(w1 >> 16);
                        dst[(size_t)4 * S] = (bf16)(w2 & 0xffffu); dst[(size_t)5 * S] = (bf16)(w2 >> 16); dst[(size_t)6 * S] = (bf16)(w3 & 0xffffu); dst[(size_t)7 * S] = (bf16)(w3 >> 16); } }
                asm volatile("" ::: "memory"); }
    }
};
struct MergeOrder {
    pg8::StaticOrder so;
    __device__ __forceinline__ bool next(int i, pg8::Unit& u) const { pg8::Unit b; if (!so.next(i / 3, b)) return false; u.pm = b.pm; u.pn = (i % 3) * 4 + b.pn; return true; }
    __device__ __forceinline__ void a_ready(const pg8::Unit&) const {}
    __device__ __forceinline__ void done(const pg8::Unit&) const {}
};
struct EpiMerge {
    static constexpr bool PERM = true, AFTER_DRAIN = false;
    bf16* Mg; bf16* G0; bf16* G1;
    __device__ __forceinline__ void operator()(const pg8::f32x4 (&acc)[2][2][4][2], const pg8::Unit& u, int wr, int wc, int fr, int fq) const {
        const int nbr = u.pn >> 2;
        const int row0 = u.pm * 256 + wr * 64 + fr, col0 = (u.pn & 3) * 256 + wc * 32 + 8 * fq;
#pragma unroll
        for (int ai = 0; ai < 2; ++ai)
#pragma unroll
            for (int m = 0; m < 4; ++m) { const size_t row = (size_t)(row0 + ai * 128 + m * 16);
#pragma unroll
                for (int bj = 0; bj < 2; ++bj) { const int col = col0 + bj * 128;
                    const v4u gwd = *(const v4u*)(gate_row(G0, G1, row) + nbr * 1024 + col);
                    float gl[8]; UNPACK8(gwd, gl);
                    const pg8::f32x4 v0 = acc[ai][bj][m][0], v1 = acc[ai][bj][m][1];
                    float rr[8] = {v0[0], v0[1], v0[2], v0[3], v1[0], v1[1], v1[2], v1[3]};
#pragma unroll
                    for (int e = 0; e < 8; ++e) rr[e] *= gl[e];
                    bf16* dst = Mg + row * 1024 + col;
                    if (nbr > 0) { const v4u old = *(const v4u*)dst; float ol[8]; UNPACK8(old, ol);
#pragma unroll
                        for (int e = 0; e < 8; ++e) rr[e] += ol[e]; }
                    *(v4u*)dst = PACK8(rr); } }
    }
};
struct EpiOut {
    static constexpr bool PERM = true, AFTER_DRAIN = false;
    const float* X; float* Out;
    __device__ __forceinline__ void operator()(const pg8::f32x4 (&acc)[2][2][4][2], const pg8::Unit& u, int wr, int wc, int fr, int fq) const {
        const int row0 = u.pm * 256 + wr * 64 + fr, col0 = u.pn * 256 + wc * 32 + 8 * fq;
#pragma unroll
        for (int ai = 0; ai < 2; ++ai)
#pragma unroll
            for (int m = 0; m < 4; ++m) { const size_t row = (size_t)(row0 + ai * 128 + m * 16);
#pragma unroll
                for (int bj = 0; bj < 2; ++bj) { const size_t p = row * 1024 + col0 + bj * 128;
                    const f32x4 x0 = *(const f32x4*)(X + p), x1 = *(const f32x4*)(X + p + 4);
                    const pg8::f32x4 a0 = acc[ai][bj][m][0], a1 = acc[ai][bj][m][1];
                    __builtin_nontemporal_store((f32x4){x0[0] + a0[0], x0[1] + a0[1], x0[2] + a0[2], x0[3] + a0[3]}, (f32x4*)(Out + p));
                    __builtin_nontemporal_store((f32x4){x1[0] + a1[0], x1[1] + a1[1], x1[2] + a1[2], x1[3] + a1[3]}, (f32x4*)(Out + p + 4)); } }
    }
};

#define XB_TMO      128
#define XB_XCNT(j)  (256  + 64 * (j))
#define XB_XSUB(j)  (1280 + 64 * (j))
#define XB_XGEN(j)  (2304 + 64 * (j))
#define XB_TOP      3328
#define XB_TOPGEN   3392
#define XCD_BAR_WORDS 3456
#define XB_SPIN_CAP (1u << 18)

__device__ __forceinline__ unsigned xb_ld(unsigned* p)              { return __hip_atomic_load(p, __ATOMIC_RELAXED, __HIP_MEMORY_SCOPE_AGENT); }
__device__ __forceinline__ unsigned xb_add(unsigned* p, unsigned v) { return __hip_atomic_fetch_add(p, v, __ATOMIC_RELAXED, __HIP_MEMORY_SCOPE_AGENT); }
__device__ __forceinline__ unsigned xb_xcc_id() { return (unsigned)__builtin_amdgcn_s_getreg((3 << 11) | 20) & 0xFu; }
#define XB_SPIN(cond, bar) do { unsigned _sp = 0; while (cond) { __builtin_amdgcn_s_sleep(1); \
    if ((++_sp & 255u) == 0u) { if (xb_ld(&(bar)[XB_TMO])) break; if (_sp > XB_SPIN_CAP) { atomicAdd(&(bar)[XB_TMO], 1u); break; } } } } while (0)

struct XcdBarrier {
    unsigned* bar; unsigned x;
    volatile LAS unsigned* st;
};

__device__ __forceinline__ XcdBarrier xcd_barrier_post(unsigned* bar, volatile LAS unsigned* st) {
    XcdBarrier b; b.bar = bar; b.x = xb_xcc_id(); b.st = st;
    if (threadIdx.x == 0) (void)xb_add(&bar[XB_XCNT(b.x)], 1u);
    return b;
}
__device__ __forceinline__ void xcd_barrier_complete(unsigned* bar, unsigned x, unsigned& nloc, unsigned& nx) {
    const unsigned G = gridDim.x * gridDim.y * gridDim.z;
    unsigned sum, cnt, mine, sp = 0u;
    for (;;) {
        sum = 0u; cnt = 0u; mine = 0u;
#pragma unroll
        for (unsigned j = 0; j < 16; ++j) { const unsigned c = xb_ld(&bar[XB_XCNT(j)]); sum += c; cnt += (c > 0u) ? 1u : 0u; mine = (j == x) ? c : mine; }
        if (sum == G) break;
        __builtin_amdgcn_s_sleep(1);
        if ((++sp & 255u) == 0u) { if (xb_ld(&bar[XB_TMO])) break; if (sp > XB_SPIN_CAP) { atomicAdd(&bar[XB_TMO], 1u); break; } }
    }
    nloc = mine > 0u ? mine : 1u; nx = cnt > 0u ? cnt : 1u;
}

__device__ __forceinline__ void xcd_barrier(const XcdBarrier& b) {
    asm volatile("s_waitcnt vmcnt(0)" ::: "memory");
    __syncthreads();
    if (threadIdx.x == 0) {
        unsigned* bar = b.bar;
        __builtin_amdgcn_s_waitcnt(0);
        unsigned nloc = b.st[0], nx = b.st[1];
        if (nloc == 0u) { xcd_barrier_complete(bar, b.x, nloc, nx); b.st[0] = nloc; b.st[1] = nx; }
        const unsigned old = xb_add(&bar[XB_XSUB(b.x)], 1u);
        const unsigned gen = old / nloc;
        if (old + 1u == (gen + 1u) * nloc) {
            __builtin_amdgcn_fence(__ATOMIC_RELEASE, "agent");
            asm volatile("s_waitcnt vmcnt(0)" ::: "memory");
            const unsigned og = xb_add(&bar[XB_TOP], 1u);
            const unsigned tg = og / nx;
            if (og + 1u == (tg + 1u) * nx) xb_add(&bar[XB_TOPGEN], 1u);
            else XB_SPIN(xb_ld(&bar[XB_TOPGEN]) == tg, bar);
            __builtin_amdgcn_fence(__ATOMIC_ACQUIRE, "agent");
            xb_add(&bar[XB_XGEN(b.x)], 1u);
            asm volatile("s_waitcnt vmcnt(0)" ::: "memory");
        } else {
            XB_SPIN(xb_ld(&bar[XB_XGEN(b.x)]) == gen, bar);
            __builtin_amdgcn_fence(__ATOMIC_ACQUIRE, "agent");
            asm volatile("s_waitcnt vmcnt(0)" ::: "memory");
        }
    }
    __syncthreads();
}

template <int DQK, int DV, int MODE>
__device__ __forceinline__ void att_call(bool strip, LAS unsigned char* lds, const bf16* Qb, int qpitch, const bf16* Kb, int kpitch, const bf16* VTb, int skv, const unsigned* maskb, const bf16* Zb, bf16* Ob, int q0) {
    if (ATT_STRIP != 0 && strip) attn_unit<DQK, DV, MODE, ATT_STRIP>(lds, Qb, qpitch, Kb, kpitch, VTb, skv, maskb, Zb, Ob, q0);
    else attn_unit<DQK, DV, MODE, 0>(lds, Qb, qpitch, Kb, kpitch, VTb, skv, maskb, Zb, Ob, q0);
}
struct Args { const float* in[19]; const int* pos; float* out; unsigned char* ws; };
typedef const __attribute__((address_space(4))) Args* kargs_t;
#define PHASE_BEGIN \
    kargs_t ap_ = (kargs_t)__builtin_amdgcn_kernarg_segment_ptr(); asm volatile("" : "+s"(ap_)); \
    int tid = threadIdx.x; asm volatile("" : "+v"(tid)); \
    const int lane = tid & 63, wave = __builtin_amdgcn_readfirstlane(tid >> 6), G = gridDim.x, NGW = G * 8, gw = blockIdx.x * 8 + wave; \
    unsigned char* const ws = ap_->ws; unsigned char* const dob = (unsigned char*)ap_->out; const int* const pos = ap_->pos; float* const outp = ap_->out; unsigned* const ctl = (unsigned*)(ws + WS_CTL); \
    const float* const x = ap_->in[0]; const float* const mem = ap_->in[1]; \
    const float* const g_norm = ap_->in[3]; const float* const w_in = ap_->in[4]; const float* const g_qn_a = ap_->in[5]; const float* const g_kn_a = ap_->in[6]; \
    const float* const g_cq = ap_->in[7]; const float* const g_ckv = ap_->in[8]; const float* const w_uq = ap_->in[9]; const float* const w_ukv = ap_->in[10]; \
    const float* const g_qn_b = ap_->in[11]; const float* const g_kn_b = ap_->in[12]; const float* const g_mem = ap_->in[13]; const float* const w_mem_kv = ap_->in[14]; \
    const float* const g_qn_m = ap_->in[15]; const float* const g_kn_m = ap_->in[16]; const float* const w_branch = ap_->in[17]; const float* const w_out = ap_->in[18]; \
    bf16* const WinT = (bf16*)(ws + WS_WIN); bf16* const WuqT = (bf16*)(ws + WS_WUQ); bf16* const WukvT = (bf16*)(ws + WS_WUKV); bf16* const WmemT = (bf16*)(ws + WS_WMEM); \
    bf16* const WbrT = (bf16*)(ws + WS_WBR); bf16* const WoutT = (bf16*)(ws + WS_WOUT); \
    float* const ropeA = (float*)(ws + WS_ROPEA); float* const ropeB = (float*)(ws + WS_ROPEB); \
    bf16* const MN = (bf16*)(ws + WS_MN); bf16* const KVM = (bf16*)(ws + WS_KVM); bf16* const VTM = (bf16*)(ws + WS_VTM); \
    float* const WI = (float*)(ws + WS_WI); unsigned* const MASK = (unsigned*)(ws + WS_MASK); \
    bf16* const VTA = (bf16*)(dob + DO_VTA); bf16* const VTB = (bf16*)(dob + DO_VTB); bf16* const KB = (bf16*)(dob + DO_KB); \
    bf16* const Hh = (bf16*)(ws + WS_H); bf16* const MG = (bf16*)(ws + WS_H); bf16* const QB = (bf16*)(ws + WS_QB); \
    bf16* const KVB = (bf16*)(ws + WS_KVB); bf16* const GT0 = (bf16*)(dob + DO_G0); bf16* const GT1 = (bf16*)(ws + WS_G1); bf16* const P = (bf16*)(ws + WS_P); \
    (void)lane; (void)NGW; (void)gw; (void)ctl; \
    (void)pos; (void)outp; (void)x; (void)mem; (void)g_norm; (void)w_in; (void)g_qn_a; (void)g_kn_a; (void)g_cq; (void)g_ckv; (void)w_uq; (void)w_ukv; (void)g_qn_b; (void)g_kn_b; (void)g_mem; (void)w_mem_kv; \
    (void)g_qn_m; (void)g_kn_m; (void)w_branch; (void)w_out; (void)WinT; (void)WuqT; (void)WukvT; (void)WmemT; (void)WbrT; (void)WoutT; (void)ropeA; (void)ropeB; (void)MN; (void)KVM; (void)VTM; (void)WI; (void)MASK; \
    (void)VTA; (void)VTB; (void)Hh; (void)KB; (void)QB; (void)KVB; (void)MG; (void)GT0; (void)GT1; (void)P
#define GRID_BARRIER() do { kargs_t bp_ = (kargs_t)__builtin_amdgcn_kernarg_segment_ptr(); asm volatile("" : "+s"(bp_)); \
    XcdBarrier b_; b_.bar = (unsigned*)(bp_->ws + WS_CTL) + 4096; b_.x = xb_xcc_id(); b_.st = (volatile LAS unsigned*)(lds + LDS_BYTES - 32); xcd_barrier(b_); } while (0)

__global__ void __launch_bounds__(512, 2) fwd_kernel(Args a) {
    extern __shared__ __attribute__((aligned(16))) unsigned char lds_raw[];
    LAS unsigned char* const lds = (LAS unsigned char*)lds_raw;
    volatile LAS int* const slot = (volatile LAS int*)(lds + LDS_SLOT);
    if (threadIdx.x < 16) ((LAS unsigned*)(lds + LDS_BYTES - 64))[threadIdx.x] = 0u;
    __syncthreads();
    (void)xcd_barrier_post((unsigned*)(a.ws + WS_CTL) + 4096, (volatile LAS unsigned*)(lds + LDS_BYTES - 32));

    for (int rep = 0; rep < REP_P0; ++rep) { PHASE_BEGIN;
        LAS float* scr = (LAS float*)(lds + wave * 16384);
        constexpr int I_IN = 16 * (NP / 32), I_UQ = 6 * 24, I_UKV = 4 * 32, I_MEM = 16 * 32, I_BR = 8 * 32, I_OUT = 16 * 32;
        constexpr int NITEMS = I_IN + I_UQ + I_UKV + I_MEM + 3 * I_BR + I_OUT;
        for (int it = gw; it < NITEMS; it += NGW) {
            int r = it;
            if (r < I_IN) { const int nbk = r % (NP / 32); if (nbk < 120 || nbk >= 152) transpose_item<true>(w_in, 1024, DIN, NP, WinT, scr, r, lane); continue; } r -= I_IN;
            if (r < I_UQ) { transpose_item<false>(w_uq, 384, 768, 768, WuqT, scr, r, lane); continue; } r -= I_UQ;
            if (r < I_UKV) { transpose_item<false>(w_ukv, 256, 1024, 1024, WukvT, scr, r, lane); continue; } r -= I_UKV;
            if (r < I_MEM) { transpose_item<false>(w_mem_kv, 1024, 1024, 1024, WmemT, scr, r, lane); continue; } r -= I_MEM;
            continue;
        }
        for (int idx = blockIdx.x * 512 + tid; idx < TT * 24; idx += G * 512) {
            const int t = idx / 24, i = idx % 24; const float pf = (float)pos[t];
            if (i < 8) { const float ang = pf * INVA[i]; ropeA[t * 16 + i] = cosf(ang); ropeA[t * 16 + 8 + i] = sinf(ang); }
            else { const int j = i - 8; const float ang = pf * INVB[j]; ropeB[t * 32 + j] = cosf(ang); ropeB[t * 32 + 16 + j] = sinf(ang); }
        }
        for (int m = gw; m < NB * MEML; m += NGW) rms_row_1024(mem + (size_t)m * DM, g_mem, MN + (size_t)m * DM, lane);
        for (int rp = 0; rp < REP_PH; ++rp)
        for (int m = gw; m < TT; m += NGW) rms_row_1024(x + (size_t)m * DM, g_norm, Hh + (size_t)m * DM, lane);
    }
    GRID_BARRIER();
    for (int es = 0; es < EXTRA_SYNCS; ++es) GRID_BARRIER();

    for (int rep = 0; rep < REP_G1; ++rep) { PHASE_BEGIN;
        pg8::Gemm g{Hh, WinT, TT, PP, 1024, 1024, nullptr, nullptr, nullptr, 0}; pg8::StaticOrder S; S.init(TT, PP, G, (int)blockIdx.x);
        EpiStoreVT E{P, PP, VTA, C_VA, C_VA + 512, 6, 0, 64, 11};
        pg8::gemm_phase<EpiStoreVT, pg8::StaticOrder, true, true>(lds, g, S, E);
    }
    { PHASE_BEGIN;
        pg8::Gemm g{MN, WmemT, NB * MEML, 1024, 1024, 1024, nullptr, nullptr, nullptr, 0}; pg8::StaticOrder S; S.init(NB * MEML, 1024, G, (int)((blockIdx.x + 64) % G));
        EpiStoreVT E{KVM, 1024, VTM, 512, 1024, 7, 0, 128, 8};
        pg8::gemm_phase<EpiStoreVT, pg8::StaticOrder, true, true>(lds, g, S, E);
    }
    if (blockIdx.x >= 224) { PHASE_BEGIN;
        LAS float* scr = (LAS float*)(lds + wave * 16384);
        constexpr int I_IN = 16 * (NP / 32), I_UQ = 6 * 24, I_UKV = 4 * 32, I_MEM = 16 * 32, I_BR = 8 * 32, I_OUT = 16 * 32;
        constexpr int NITEMS = I_IN + I_UQ + I_UKV + I_MEM + 3 * I_BR + I_OUT;
        const int hw = (blockIdx.x - 224) * 8 + wave, NHW = (G - 224) * 8;
        for (int it = hw; it < 16 * 32; it += NHW) transpose_item<true>(w_in, 1024, DIN, NP, WinT, scr, (it >> 5) * (NP / 32) + 120 + (it & 31), lane);
        for (int it = I_IN + I_UQ + I_UKV + I_MEM + hw; it < NITEMS; it += NHW) {
            int r = it;
            if (r < I_IN + I_UQ + I_UKV + I_MEM) continue; r -= I_IN + I_UQ + I_UKV + I_MEM;
            if (r < 3 * I_BR) { const int nb = r / I_BR; transpose_item<false>(w_branch + (size_t)nb * 512 * 1024, 512, 1024, 1024, WbrT + (size_t)nb * 1024 * 512, scr, r % I_BR, lane); continue; } r -= 3 * I_BR;
            transpose_item<false>(w_out, 1024, 1024, 1024, WoutT, scr, r, lane);
        }
    }
    GRID_BARRIER();
    { PHASE_BEGIN;
        float ga[8], gk[8], gq[8], gc[8], gm[8];
#pragma unroll
        for (int j = 0; j < 8; ++j) { ga[j] = g_qn_a[8 * (lane & 7) + j]; gk[j] = g_kn_a[8 * (lane & 7) + j]; gm[j] = g_qn_m[8 * (lane & 15) + j]; gq[j] = lane < 48 ? g_cq[8 * lane + j] : 0.f; gc[j] = lane < 32 ? g_ckv[8 * lane + j] : 0.f; }
        for (int dp = 0; dp < DUMMY_POST1; ++dp)
            for (int m = gw; m < TT; m += NGW)
                post1_row(P + (size_t)m * PP, QB + (size_t)(m & 1023) * 4096, ropeA + (size_t)m * 16, ga, gk, gq, gc, gm, (float*)KVB + (size_t)m * 8, lane);
        for (int m = gw; m < TT; m += NGW)
            post1_row(P + (size_t)m * PP, P + (size_t)m * PP, ropeA + (size_t)m * 16, ga, gk, gq, gc, gm, WI + (size_t)m * 8, lane);
        for (int m = gw; m < NB * MEML; m += NGW) km_row(KVM + (size_t)m * 1024, g_kn_m, lane);
    }
    GRID_BARRIER();
    for (int rep = 0; rep < REP_G2; ++rep) { PHASE_BEGIN;
        pg8::Gemm g{P + C_CQ, WuqT, TT, 768, 384, PP, nullptr, nullptr, nullptr, 0}; pg8::StaticOrder S; S.init(TT, 768, G, (int)blockIdx.x);
        pg8::EpiBf16<0> E{QB, 768, nullptr, 0, 0, 1.f};
        pg8::gemm_phase<pg8::EpiBf16<0>, pg8::StaticOrder, true, true>(lds, g, S, E);
    }
    for (int rep = 0; rep < REP_G2; ++rep) { PHASE_BEGIN;
        pg8::Gemm g{P + C_CKV, WukvT, TT, 1024, 256, PP, nullptr, nullptr, nullptr, 0}; pg8::StaticOrder S; S.init(TT, 1024, G, (int)((blockIdx.x + 192) % G));
        pg8::EpiBf16<0> E{KVB, 1024, nullptr, 0, 0, 1.f};
        pg8::gemm_phase<pg8::EpiBf16<0>, pg8::StaticOrder, true, true>(lds, g, S, E);
    }
    for (int rep = 0; rep < REP_IDX; ++rep) { if (rep > 0) GRID_BARRIER();
        PHASE_BEGIN;
        unsigned* const q_idx = ctl + 64 * (0 + 4 * rep);
        int u = next_unit(q_idx, slot);
        bf16x8 qf[8][2]; float wq[8];
        if (u < NB * 128) indexer_load_q(P, WI, u, qf, wq);
        while (u < NB * 128) {
            int tk = 0; if (tid == 0) tk = (int)atomicAdd(q_idx, 1u);
            const int tb = 127 - (u >> 3), bb = u & 7;
            int un;
            indexer_unit((LAS float*)lds, P, WI, MASK, bb, tb, qf, wq, tk, slot, NB * 128, un);
            u = un;
        }
    }
    GRID_BARRIER();
    { PHASE_BEGIN;
        LAS float* scr = (LAS float*)(lds + wave * 8192);
        float gqv[12], gkv[12];
#pragma unroll
        for (int e = 0; e < 12; ++e) { gqv[e] = g_qn_b[12 * (lane & 7) + e]; gkv[e] = g_kn_b[12 * (lane & 7) + e]; }
        for (int dp = 0; dp < DUMMY_POST2; ++dp)
            for (int m = gw; m < TT; m += NGW)
                post2_row(QB + (size_t)m * 768, (bf16*)MASK + (size_t)(m & 1023) * 768, KVB + (size_t)m * 1024, P + (size_t)m * PP, (bf16*)MASK + (size_t)(1024 + (m & 1023)) * 768, ropeB + (size_t)m * 32, gqv, gkv, scr, lane);
        for (int m = gw; m < TT; m += NGW)
            post2_row(QB + (size_t)m * 768, QB + (size_t)m * 768, KVB + (size_t)m * 1024, P + (size_t)m * PP, KB + (size_t)m * 768, ropeB + (size_t)m * 32, gqv, gkv, scr, lane);
        transpose_v(KVB, 1024, 64, 128, 8, 64, SEQ, NB, VTB, gw, NGW, lane);
    }
    GRID_BARRIER();
    for (int rep = 0; rep < REP_ATT; ++rep) { if (rep > 0) GRID_BARRIER();
        PHASE_BEGIN;
        unsigned* const q_att = ctl + 64 * (1 + 4 * rep);
        for (;;) {
            const int u = next_unit(q_att, slot);
            if (u >= 1152) break;
            if (u < 704 || u >= 832) {
                const int uu = u < 704 ? u : u - 128, cls = uu >> 6, bh = uu & 63, bb = bh >> 3, h = bh & 7;
                const bool isA = (0x52a7u >> cls) & 1u; const int qb = (int)((0x11232435467567ull >> (4 * cls)) & 15ull);
                const size_t r0 = (size_t)bb * SEQ;
                if (!isA) attn_unit_pipe<96, 1>(lds, QB + r0 * 768 + h * 96, 768, KB + r0 * 768 + h * 96, 768, VTB + (size_t)((bb * 8 + h) * 64) * SEQ, SEQ, nullptr,
                                                   P + r0 * PP + C_YB + h * 64, qb * 256);
                else attn_unit_pipe<64, 2>(lds, P + r0 * PP + C_QA + h * 64, PP, P + r0 * PP + C_KA + h * 64, PP, VTA + (size_t)((bb * 8 + h) * 64) * SEQ, SEQ, MASK + r0 * 64,
                                           P + r0 * PP + C_YA + h * 64, qb * 256);
            } else {
                const int v = u - 704, hq = v & 3, bh = v >> 2, bb = bh >> 2, h = bh & 3;
                const size_t r0 = (size_t)bb * SEQ;
                attn_unit_mem(lds, P + r0 * PP + C_QM + h * 128, g_qn_m, KVM + (size_t)bb * MEML * 1024 + h * 128, VTM + (size_t)((bb * 4 + h) * 128) * MEML,
                              P + r0 * PP + C_ZM + h * 128, P + r0 * PP + C_YM + h * 128, hq * 512);
            }
        }
    }
    GRID_BARRIER();
    for (int rep = 0; rep < 1; ++rep) { PHASE_BEGIN;
        pg8::Gemm g{Hh, WinT + (size_t)PP * 1024, TT, NZG, 1024, 1024, nullptr, nullptr, nullptr, 0}; pg8::StaticOrder S; S.init(TT, NZG, G, (int)blockIdx.x);
        EpiZG E{P, GT0, GT1};
        pg8::gemm_phase<EpiZG, pg8::StaticOrder, true, true>(lds, g, S, E);
    }
    GRID_BARRIER();
    for (int rep = 0; rep < REP_G4; ++rep) { PHASE_BEGIN;
        pg8::Gemm g{P + C_YA, WbrT, TT, 3072, 512, PP, P + C_YA, P + C_YB, P + C_YM, 4};
        MergeOrder S; S.so.init(TT, 1024, G, (int)blockIdx.x);
        EpiMerge E{MG, GT0, GT1};
        pg8::gemm_phase<EpiMerge, MergeOrder, true, true>(lds, g, S, E);
    }
    GRID_BARRIER();
    for (int rep = 0; rep < REP_G5; ++rep) { PHASE_BEGIN;
        pg8::Gemm g{MG, WoutT, TT, 1024, 1024, 1024, nullptr, nullptr, nullptr, 0}; pg8::StaticOrder S; S.init(TT, 1024, G, (int)blockIdx.x);
        EpiOut E{x, outp};
        pg8::gemm_phase<EpiOut, pg8::StaticOrder, true, true>(lds, g, S, E);
    }
}

extern "C" void kernel_launch(void* const* d_in, const int* in_sizes, int n_in, void* d_out, int out_size, void* d_ws, size_t ws_size, hipStream_t stream) {
    static int grid = 0;
    if (grid == 0) {
        if (n_in != 19 || out_size != TT * DM || ws_size < WS_END) { fprintf(stderr, "kernel_launch: unexpected problem (n_in %d, out %d, ws %zu); nothing launched\n", n_in, out_size, ws_size); grid = -1; return; }
        int dev = 0, cus = 0, per_cu = 0;
        if (hipGetDevice(&dev) != hipSuccess || hipDeviceGetAttribute(&cus, hipDeviceAttributeMultiprocessorCount, dev) != hipSuccess) { grid = -1; return; }
        if (hipFuncSetAttribute((const void*)fwd_kernel, hipFuncAttributeMaxDynamicSharedMemorySize, LDS_BYTES) != hipSuccess) { fprintf(stderr, "kernel_launch: hipFuncSetAttribute failed\n"); grid = -1; return; }
        if (hipOccupancyMaxActiveBlocksPerMultiprocessor(&per_cu, (const void*)fwd_kernel, 512, LDS_BYTES) != hipSuccess || per_cu < 1) { fprintf(stderr, "kernel_launch: occupancy query reports %d blocks per CU\n", per_cu); (void)hipGetLastError(); grid = -1; return; }
        grid = cus;
    }
    if (grid < 0) return;
    (void)hipMemsetAsync((char*)d_ws + WS_CTL, 0, 65536, stream);
    Args a{};
    for (int i = 0; i < 19; ++i) a.in[i] = (const float*)d_in[i];
    a.pos = (const int*)d_in[2]; a.out = (float*)d_out; a.ws = (unsigned char*)d_ws;
    hipLaunchKernelGGL(fwd_kernel, dim3(grid), dim3(512), LDS_BYTES, stream, a);
    const hipError_t e = hipPeekAtLastError();
    if (e != hipSuccess) fprintf(stderr, "kernel_launch: launch failed: %s (grid %d)\n", hipGetErrorString(e), grid);
}
```
